# Optimizing an MI355X kernel written in HIP

```python
import math
import jax, jax.numpy as jnp
from jax import lax
import numpy as np

D_MODEL = 1024
BATCH = 8
SEQ = 4096
DEPTH = 1

N_META = 16
EPS = 1e-6

D_HY = 512
HY_GROUPS = 8
HY_SHORT = 3
HY_EMB = 33
HY_BANDS = (HY_EMB - 1) // 2
HY_FFN = 64
HY_TARGET = 1e-2
HY_DECAY_HI = 0.3
HY_DECAY_LO = 1.5

D_RG = 1024
RG_HEADS = 8
RG_HEAD_DIM = D_RG // RG_HEADS
RG_CONV = 4
RG_C = 8.0

PEER_HEADS = 8
N_KEYS = 128
N_EXPERTS = N_KEYS * N_KEYS
D_KEY = 256
D_HALF = D_KEY // 2
PEER_TOPK = 16
PEER_CHUNK = 16

D_IN = 3 * D_HY + 2 * D_RG + 2 * D_MODEL

kernel_name = 'hybrid_hyena_rglru_peer_encoder'


def rmsnorm(x, g):
    xf = x.astype(jnp.float32)
    y = xf * lax.rsqrt(jnp.mean(xf * xf, axis=-1, keepdims=True) + EPS)
    return (y * g.astype(jnp.float32)).astype(x.dtype)


def hyena_filter(L, w1, b1, w2, b2, w3, b3, freq):
    f32 = jnp.float32
    t = jnp.linspace(0.0, 1.0, L, dtype=f32)[:, None]
    w = (2.0 * math.pi / L) * jnp.arange(L, dtype=f32)[:, None]
    bands = jnp.linspace(1e-4, HY_BANDS - 1, HY_BANDS, dtype=f32)[None, :]
    z = jnp.concatenate([t, jnp.cos(bands * w), -jnp.sin(bands * w)], axis=-1)
    freq = freq.astype(f32)
    hdn = jnp.sin(freq[0] * (z @ w1.astype(f32) + b1.astype(f32)))
    hdn = jnp.sin(freq[1] * (hdn @ w2.astype(f32) + b2.astype(f32)))
    k = (hdn @ w3.astype(f32) + b3.astype(f32)).reshape(L, 2, D_HY)
    deltas = jnp.abs(jnp.linspace(math.log(HY_TARGET) / HY_DECAY_HI,
                                  math.log(HY_TARGET) / HY_DECAY_LO, D_HY, dtype=f32))
    k = k * jnp.exp(-t * deltas)[:, None, :]
    k_fwd, k_bwd = k[:, 0], k[:, 1]
    return jnp.concatenate([k_fwd, jnp.zeros((1, D_HY), f32), k_bwd[:0:-1]], axis=0)


def fft_long_conv(u, k_full, skip):
    L = u.shape[1]
    uf = u.astype(jnp.float32)
    U = jnp.fft.rfft(uf, n=2 * L, axis=1)
    K = jnp.fft.rfft(k_full, axis=0)
    y = jnp.fft.irfft(U * K[None], n=2 * L, axis=1)[:, :L]
    return (y + uf * skip.astype(jnp.float32)).astype(u.dtype)


def hyena_branch(hy_in, conv_w, conv_b, w1, b1, w2, b2, w3, b3, freq, skip, w_proj):
    B, L, _ = hy_in.shape
    hp = jnp.pad(hy_in, ((0, 0), (1, 1), (0, 0)))
    u = hp[:, 0:L] * conv_w[0] + hp[:, 1:L + 1] * conv_w[1] + hp[:, 2:L + 2] * conv_w[2] + conv_b
    x0, x1, v = u[..., :D_HY], u[..., D_HY:2 * D_HY], u[..., 2 * D_HY:]
    k_full = hyena_filter(L, w1, b1, w2, b2, w3, b3, freq)
    y = fft_long_conv(v * x1, k_full, skip) * x0
    return y @ w_proj


def rglru_direction(x, conv_w, conv_b, gate_w, gate_b, lam):
    B, L, _ = x.shape
    xp = jnp.pad(x, ((0, 0), (RG_CONV - 1, 0), (0, 0)))
    xc = conv_b + sum(xp[:, RG_CONV - 1 - j:RG_CONV - 1 - j + L] * conv_w[j] for j in range(RG_CONV))
    xh = xc.reshape(B, L, RG_HEADS, RG_HEAD_DIM)
    gates = jnp.einsum('blhi,ghij->gblhj', xh, gate_w).reshape(2, B, L, D_RG)
    gates = gates.astype(jnp.float32) + gate_b.astype(jnp.float32)[:, None, None, :]
    r = jax.nn.sigmoid(gates[0])
    i = jax.nn.sigmoid(gates[1])
    log_a = -RG_C * r * jax.nn.softplus(-lam.astype(jnp.float32))
    a = jnp.exp(log_a)
    mult = jnp.sqrt(-jnp.expm1(2.0 * log_a))
    mult = mult.at[:, 0].set(1.0)
    b = mult * i * xc.astype(jnp.float32)

    def combine(p, q):
        a1, b1 = p
        a2, b2 = q
        return a1 * a2, a2 * b1 + b2

    _, h = lax.associative_scan(combine, (a, b), axis=1)
    return h.astype(x.dtype)


def rglru_branch(rg_x, rg_g, conv_w, conv_b, gate_w, gate_b, lam, w_proj):
    h_f = rglru_direction(rg_x, conv_w[0], conv_b[0], gate_w[0], gate_b[0], lam[0])
    h_b = rglru_direction(rg_x[:, ::-1], conv_w[1], conv_b[1], gate_w[1], gate_b[1], lam[1])[:, ::-1]
    y = (h_f + h_b) * jax.nn.gelu(rg_g)
    return y @ w_proj


def peer(x, wq, keys, u_tab, v_tab):
    B, L, D = x.shape
    K = PEER_TOPK
    q = (x @ wq).reshape(B, L, PEER_HEADS, 2, D_HALF)
    s = jnp.einsum('blhpd,hpkd->blhpk', q, keys).astype(jnp.float32)
    ts, ti = lax.top_k(s, K)
    cand = ts[..., 0, :, None] + ts[..., 1, None, :]
    cs, ci = lax.top_k(cand.reshape(B, L, PEER_HEADS, K * K), K)
    e1 = jnp.take_along_axis(ti[..., 0, :], ci // K, axis=-1)
    e2 = jnp.take_along_axis(ti[..., 1, :], ci % K, axis=-1)
    experts = e1 * N_KEYS + e2
    g = jax.nn.softmax(cs, axis=-1).astype(x.dtype)

    nc = L // PEER_CHUNK
    hk = PEER_HEADS * K

    def to_chunks(a, last):
        return a.reshape(B, nc, PEER_CHUNK, last).transpose(1, 0, 2, 3).reshape(nc, B * PEER_CHUNK, last)

    xs = (to_chunks(x, D), to_chunks(experts.reshape(B, L, hk), hk), to_chunks(g.reshape(B, L, hk), hk))

    def chunk_fn(args):
        xt, et, gt = args
        act = jax.nn.gelu(jnp.einsum('td,tkd->tk', xt, u_tab[et])) * gt
        return jnp.einsum('tk,tkd->td', act, v_tab[et])

    out = lax.map(chunk_fn, xs)
    return out.reshape(nc, B, PEER_CHUNK, D).transpose(1, 0, 2, 3).reshape(B, L, D)


def setup_inputs(seed: int = 0) -> dict:
    key = jax.random.key(seed)
    ks = iter(jax.random.split(key, 40))
    f32 = jnp.float32

    def nrm(shape, scale):
        return jax.random.normal(next(ks), shape, f32) * scale

    L_TOT = SEQ + N_META
    x = nrm((BATCH, SEQ, D_MODEL), 1.0)
    meta = nrm((N_META, D_MODEL), 1.0)
    g_final = 1.0 + nrm((D_MODEL,), 0.02)
    g_mix = 1.0 + nrm((DEPTH, D_MODEL), 0.02)
    w_in = nrm((DEPTH, D_MODEL, D_IN), D_MODEL ** -0.5)
    b_gate = nrm((DEPTH, 2 * D_MODEL), 0.02)
    hy_conv_w = nrm((DEPTH, HY_SHORT, 3 * D_HY), HY_SHORT ** -0.5)
    hy_conv_b = nrm((DEPTH, 3 * D_HY), 0.02)
    hy_w1 = nrm((DEPTH, HY_EMB, HY_FFN), HY_EMB ** -0.5)
    hy_b1 = nrm((DEPTH, HY_FFN), 0.1)
    hy_w2 = nrm((DEPTH, HY_FFN, HY_FFN), HY_FFN ** -0.5)
    hy_b2 = nrm((DEPTH, HY_FFN), 0.1)
    hy_w3 = nrm((DEPTH, HY_FFN, 2 * D_HY), (HY_FFN * L_TOT / 4.0) ** -0.5)
    hy_b3 = nrm((DEPTH, 2 * D_HY), L_TOT ** -0.5)
    hy_freq = 1.0 + nrm((DEPTH, 2, HY_FFN), 0.02)
    hy_skip = nrm((DEPTH, D_HY), 1.0)
    hy_out = nrm((DEPTH, D_HY, D_MODEL), D_HY ** -0.5)
    rg_conv_w = nrm((DEPTH, 2, RG_CONV, D_RG), RG_CONV ** -0.5)
    rg_conv_b = nrm((DEPTH, 2, D_RG), 0.02)
    rg_gate_w = nrm((DEPTH, 2, 2, RG_HEADS, RG_HEAD_DIM, RG_HEAD_DIM), RG_HEAD_DIM ** -0.5)
    rg_gate_b = nrm((DEPTH, 2, 2, D_RG), 0.02)
    a_c = jax.random.uniform(next(ks), (DEPTH, 2, D_RG), f32, minval=0.9, maxval=0.999)
    a_base = a_c ** (1.0 / RG_C)
    rg_lambda = jnp.log(a_base) - jnp.log1p(-a_base)
    rg_out = nrm((DEPTH, D_RG, D_MODEL), D_RG ** -0.5)
    w_out = nrm((DEPTH, D_MODEL, D_MODEL), D_MODEL ** -0.5)
    g_ffn = 1.0 + nrm((DEPTH, D_MODEL), 0.02)
    peer_wq = nrm((DEPTH, D_MODEL, PEER_HEADS * D_KEY), D_MODEL ** -0.5)
    peer_keys = nrm((DEPTH, PEER_HEADS, 2, N_KEYS, D_HALF), D_HALF ** -0.5)
    peer_u = nrm((DEPTH, N_EXPERTS, D_MODEL), D_MODEL ** -0.5)
    peer_v = nrm((DEPTH, N_EXPERTS, D_MODEL), PEER_HEADS ** -0.5)
    return {'x': x, 'meta': meta, 'g_final': g_final, 'g_mix': g_mix, 'w_in': w_in, 'b_gate': b_gate,
            'hy_conv_w': hy_conv_w, 'hy_conv_b': hy_conv_b, 'hy_w1': hy_w1, 'hy_b1': hy_b1,
            'hy_w2': hy_w2, 'hy_b2': hy_b2, 'hy_w3': hy_w3, 'hy_b3': hy_b3, 'hy_freq': hy_freq,
            'hy_skip': hy_skip, 'hy_out': hy_out, 'rg_conv_w': rg_conv_w, 'rg_conv_b': rg_conv_b,
            'rg_gate_w': rg_gate_w, 'rg_gate_b': rg_gate_b, 'rg_lambda': rg_lambda, 'rg_out': rg_out,
            'w_out': w_out, 'g_ffn': g_ffn, 'peer_wq': peer_wq, 'peer_keys': peer_keys,
            'peer_u': peer_u, 'peer_v': peer_v}


def reference(x, meta, g_final, g_mix, w_in, b_gate, hy_conv_w, hy_conv_b, hy_w1, hy_b1, hy_w2, hy_b2,
              hy_w3, hy_b3, hy_freq, hy_skip, hy_out, rg_conv_w, rg_conv_b, rg_gate_w, rg_gate_b,
              rg_lambda, rg_out, w_out, g_ffn, peer_wq, peer_keys, peer_u, peer_v):
    B = x.shape[0]
    h = jnp.concatenate([jnp.broadcast_to(meta.astype(x.dtype)[None], (B, N_META, D_MODEL)), x], axis=1)
    s_hy = 3 * D_HY
    s_rx = s_hy + D_RG
    s_rg = s_rx + D_RG
    for l in range(DEPTH):
        n = rmsnorm(h, g_mix[l])
        proj = n @ w_in[l]
        y_hy = hyena_branch(proj[..., :s_hy], hy_conv_w[l], hy_conv_b[l], hy_w1[l], hy_b1[l], hy_w2[l],
                            hy_b2[l], hy_w3[l], hy_b3[l], hy_freq[l], hy_skip[l], hy_out[l])
        y_rg = rglru_branch(proj[..., s_hy:s_rx], proj[..., s_rx:s_rg], rg_conv_w[l], rg_conv_b[l],
                            rg_gate_w[l], rg_gate_b[l], rg_lambda[l], rg_out[l])
        gl = proj[..., s_rg:] + b_gate[l]
        merged = jax.nn.sigmoid(gl[..., :D_MODEL]) * y_hy + jax.nn.sigmoid(gl[..., D_MODEL:]) * y_rg
        h = h + merged @ w_out[l]
        h = h + peer(rmsnorm(h, g_ffn[l]), peer_wq[l], peer_keys[l], peer_u[l], peer_v[l])
    h = rmsnorm(h, g_final)
    return h[:, N_META:]
```

```cpp
#define ONE_LAUNCH 0
#include <hip/hip_runtime.h>
#include <hip/hip_cooperative_groups.h>
#include <cstdio>
#include <cstdint>
#include <cmath>
namespace cg = cooperative_groups;
namespace pg8 {
#define PG8_LAS __attribute__((address_space(3)))
typedef unsigned short bf16_t;
typedef short bf16x8 __attribute__((ext_vector_type(8)));
typedef float f32x4 __attribute__((ext_vector_type(4)));
typedef unsigned u32x4 __attribute__((ext_vector_type(4)));
constexpr int BM = 256, BK = 64, HALF = 128, HTB = HALF * BK * 2  , STAGE_BYTES = 8 * HTB, NXCD = 8, WGM = 8;

__host__ __device__ __forceinline__ int lds_byte(int r, int c) { const int st = (r >> 4) * 2 + (c >> 5), rr = r & 15, cc = c & 31, ob = rr * 64 + cc * 2; return st * 1024 + (ob ^ (((ob >> 9) & 1) << 5)); }
__host__ __device__ __forceinline__ void stage_rc(int b, int& R, int& C) { const int st = b / 1024, sb = b % 1024, swz = sb ^ (((sb >> 9) & 1) << 5); R = (st >> 1) * 16 + swz / 64; C = (st & 1) * 32 + (swz % 64) / 2; }
__host__ __device__ __forceinline__ int perm32(int rho) { const int n = rho >> 4, i = rho & 15; return 8 * (i >> 2) + 4 * n + (i & 3); }

struct Unit { int pm, pn; };
struct Gemm { const bf16_t* A; const bf16_t* Bt; int M, N, K; };

struct StaticOrder {
    int nM, nN, nwg, G, c;
    __host__ __device__ void init(int M, int N, int G_, int c_) { nM = M / BM; nN = N / BM; nwg = nM * nN; G = G_; c = c_; }
    __host__ __device__ bool next(int i, Unit& u) const {
        const long L = (long)i * G + c; if (L >= nwg) return false;
        int wgid = (int)L; { const int q = nwg / NXCD, r = nwg % NXCD, xcd = wgid % NXCD, off = wgid / NXCD; wgid = (xcd < r ? xcd * (q + 1) : r * (q + 1) + (xcd - r) * q) + off; }
        const int nig = WGM * nN, gid = wgid / nig, fm = gid * WGM, gsz = (nM - fm) < WGM ? (nM - fm) : WGM;
        u.pm = fm + ((wgid % nig) % gsz); u.pn = (wgid % nig) / gsz; return true;
    }
    __device__ __forceinline__ void a_ready(const Unit&) const {}
    __device__ __forceinline__ void done(const Unit&) const {}
};
__device__ __forceinline__ unsigned cvt_pk_bf16(float lo, float hi) { unsigned r; asm volatile("v_cvt_pk_bf16_f32 %0, %1, %2" : "=v"(r) : "v"(lo), "v"(hi)); return r; }
typedef float f32x2 __attribute__((ext_vector_type(2)));
__device__ __forceinline__ f32x2 gelu_pk(f32x2 v) {
    const f32x2 av = __builtin_elementwise_abs(v), d = av * 0.2316418882f + 1.0f;
    f32x2 t; t.x = __builtin_amdgcn_rcpf(d.x); t.y = __builtin_amdgcn_rcpf(d.y);
    f32x2 q = t * 0.5307027145f + (-0.7265760135f); q = q * t + 0.7107068705f; q = q * t + (-0.142248368f); q = q * t + 0.127414796f; q = q * t;
    const f32x2 s = (v * v) * (-0.72134752044f);
    f32x2 e; e.x = __builtin_amdgcn_exp2f(s.x); e.y = __builtin_amdgcn_exp2f(s.y);
    const f32x2 m = v * (q * e), r = v - m;
    f32x2 o; o.x = v.x < 0.f ? m.x : r.x; o.y = v.y < 0.f ? m.y : r.y; return o;
}
template <class Epi, class Sched, bool STAMP = false>
__device__ __forceinline__ void gemm_phase(PG8_LAS unsigned char* lds, const Gemm g, const Sched& S, const Epi& E, unsigned long long* stamps) {
    const int tid = threadIdx.x, wid = __builtin_amdgcn_readfirstlane(tid >> 6), lane = tid & 63, wr = wid >> 2, wc = wid & 3, fr = lane & 15, fq = lane >> 4;
    const int K = g.K, nt = K / BK;
    int ts_lo = 0, ts_hi = 0, nts = 0; const unsigned long long rt_entry = STAMP ? (unsigned long long)wall_clock64() : 0ull;
#define PG8_STAMP() do { if (STAMP && wid == 0 && nts < 64) { const unsigned long long _c = (unsigned long long)clock64(); \
        ts_lo = (lane == nts) ? (int)(unsigned)_c : ts_lo; ts_hi = (lane == nts) ? (int)(unsigned)(_c >> 32) : ts_hi; ++nts; } } while (0)
    PG8_STAMP();
    unsigned voffA[2], voffB[2];
#pragma unroll
    for (int i = 0; i < 2; ++i) { int R, C; stage_rc(tid * 16 + i * 8192, R, C); const int Rb = Epi::PERM ? ((R & ~31) + perm32(R & 31)) : R;
        voffA[i] = (unsigned)(R * K + C) * 2u; voffB[i] = (unsigned)(Rb * K + C) * 2u; }
    const size_t kstep = (size_t)(BK * 2);
    const size_t hstep = (size_t)HALF * K * 2;
    const size_t tstep = 2 * hstep;
    const unsigned ldsw = (unsigned)wid * 1024u;
    const int aoff = lds_byte(wr * 64 + fr, fq * 8), boff = lds_byte(wc * 32 + fr, fq * 8);
#define PG8_SA(b, h) (((b) * 2 + (h)) * HTB)
#define PG8_SB(b, h) ((4 + (b) * 2 + (h)) * HTB)
#define PG8_STAGE(bufoff, gbase, voff) do { _Pragma("unroll") for (int _i = 0; _i < 2; ++_i) \
        __builtin_amdgcn_global_load_lds((const unsigned*)((const char*)(gbase) + (voff)[_i]), (PG8_LAS unsigned*)(lds + (bufoff) + ldsw + _i * 8192), 16, 0, 0); } while (0)
#define PG8_LDA(dst, b, h) do { _Pragma("unroll") for (int m = 0; m < 4; ++m) _Pragma("unroll") for (int k = 0; k < 2; ++k) dst[m][k] = *(const PG8_LAS bf16x8*)(lds + PG8_SA(b, h) + aoff + m * 2048 + k * 1024); } while (0)
#define PG8_LDB(dst, b, h) do { _Pragma("unroll") for (int n = 0; n < 2; ++n) _Pragma("unroll") for (int k = 0; k < 2; ++k) dst[n][k] = *(const PG8_LAS bf16x8*)(lds + PG8_SB(b, h) + boff + n * 2048 + k * 1024); } while (0)
#define PG8_MMA(ai, bj, At, Bt) do { __builtin_amdgcn_s_setprio(1); _Pragma("unroll") for (int m = 0; m < 4; ++m) _Pragma("unroll") for (int n = 0; n < 2; ++n) _Pragma("unroll") for (int k = 0; k < 2; ++k) \
        acc[ai][bj][m][n] = __builtin_amdgcn_mfma_f32_16x16x32_bf16(Bt[n][k], At[m][k], acc[ai][bj][m][n], 0, 0, 0); __builtin_amdgcn_s_setprio(0); } while (0)
#define PG8_WAIT_V(n) asm volatile("s_waitcnt vmcnt(" #n ")" ::: "memory")
#define PG8_WAIT_L(n) asm volatile("s_waitcnt lgkmcnt(" #n ")" ::: "memory")
#define PG8_BAR __builtin_amdgcn_s_barrier()
#define PG8_SCHED __builtin_amdgcn_sched_barrier(0)
    Unit cur, nxt; int ui = 0;
    if (!S.next(0, cur)) return;
    f32x4 acc[2][2][4][2];
#pragma unroll
    for (int a = 0; a < 2; ++a)
#pragma unroll
        for (int b = 0; b < 2; ++b)
#pragma unroll
            for (int m = 0; m < 4; ++m)
#pragma unroll
                for (int n = 0; n < 2; ++n) acc[a][b][m][n] = (f32x4){0.f, 0.f, 0.f, 0.f};
    bf16x8 At[4][2], B0[2][2], B1[2][2];
    const char* cA = (const char*)g.A + (size_t)cur.pm * tstep; const char* cB = (const char*)g.Bt + (size_t)cur.pn * tstep;
    S.a_ready(cur);
    PG8_STAGE(PG8_SB(0, 0), cB, voffB); PG8_STAGE(PG8_SA(0, 0), cA, voffA); PG8_STAGE(PG8_SB(0, 1), cB + hstep, voffB); PG8_STAGE(PG8_SA(0, 1), cA + hstep, voffA);
    if (wr == 1) PG8_BAR;
    PG8_WAIT_V(4); PG8_BAR;
    PG8_STAGE(PG8_SB(1, 0), cB + kstep, voffB); PG8_STAGE(PG8_SA(1, 0), cA + kstep, voffA); PG8_STAGE(PG8_SB(1, 1), cB + hstep + kstep, voffB);
    PG8_WAIT_V(6); PG8_BAR;
    PG8_STAMP();
    for (;;) {
        const bool has_next = S.next(ui + 1, nxt);
        const char* nA = has_next ? (const char*)g.A + (size_t)nxt.pm * tstep : cA; const char* nB = has_next ? (const char*)g.Bt + (size_t)nxt.pn * tstep : cB;
        for (int t = 0; t < nt; t += 2) {
            const bool last = (t == nt - 2);
            const char* a1 = cA + (size_t)(t + 1) * kstep;
            const char* a2 = last ? nA : cA + (size_t)(t + 2) * kstep; const char* b2 = last ? nB : cB + (size_t)(t + 2) * kstep;
            const char* a3 = a2 + kstep; const char* b3 = b2 + kstep;
            if (last && has_next) S.a_ready(nxt);
            PG8_LDB(B0, 0, 0); PG8_SCHED; PG8_LDA(At, 0, 0); PG8_STAGE(PG8_SA(1, 1), a1 + hstep, voffA);
            PG8_WAIT_L(8); PG8_BAR; PG8_WAIT_L(0); PG8_MMA(0, 0, At, B0); PG8_BAR; PG8_SCHED;
            PG8_LDB(B1, 0, 1); PG8_STAGE(PG8_SB(0, 0), b2, voffB);
            PG8_BAR; PG8_WAIT_L(0); PG8_MMA(0, 1, At, B1); PG8_BAR;
            PG8_LDA(At, 0, 1); PG8_STAGE(PG8_SA(0, 0), a2, voffA);
            PG8_BAR; PG8_WAIT_L(0); PG8_MMA(1, 0, At, B0); PG8_BAR; PG8_SCHED;
            PG8_STAGE(PG8_SB(0, 1), b2 + hstep, voffB);
            PG8_WAIT_V(6); PG8_BAR; PG8_MMA(1, 1, At, B1); PG8_BAR;
            PG8_LDB(B0, 1, 0); PG8_SCHED; PG8_LDA(At, 1, 0); PG8_STAGE(PG8_SA(0, 1), a2 + hstep, voffA);
            PG8_WAIT_L(8); PG8_BAR; PG8_WAIT_L(0); PG8_MMA(0, 0, At, B0); PG8_BAR; PG8_SCHED;
            PG8_LDB(B1, 1, 1); PG8_STAGE(PG8_SB(1, 0), b3, voffB);
            PG8_BAR; PG8_WAIT_L(0); PG8_MMA(0, 1, At, B1); PG8_BAR;
            PG8_LDA(At, 1, 1); PG8_STAGE(PG8_SA(1, 0), a3, voffA);
            PG8_BAR; PG8_WAIT_L(0); PG8_MMA(1, 0, At, B0); PG8_BAR; PG8_SCHED;
            PG8_STAGE(PG8_SB(1, 1), b3 + hstep, voffB);
            PG8_WAIT_V(6); PG8_BAR; PG8_MMA(1, 1, At, B1); PG8_BAR;
        }
        PG8_STAMP();
        if constexpr (!Epi::AFTER_DRAIN) { E(acc, cur, wr, wc, fr, fq); S.done(cur); }
        PG8_STAMP();
        if (!has_next) break;
#pragma unroll
        for (int a = 0; a < 2; ++a)
#pragma unroll
            for (int b = 0; b < 2; ++b)
#pragma unroll
                for (int m = 0; m < 4; ++m)
#pragma unroll
                    for (int n = 0; n < 2; ++n) acc[a][b][m][n] = (f32x4){0.f, 0.f, 0.f, 0.f};
        cur = nxt; cA = nA; cB = nB; ++ui;
    }
    PG8_WAIT_V(0);
    if (wr == 0) PG8_BAR;
    PG8_BAR;
    if constexpr (Epi::AFTER_DRAIN) { E.fused(acc, cur, wr, wc, fr, fq, lds, wid, lane); S.done(cur); }
    PG8_STAMP();
    if (STAMP && wid == 0) { stamps[lane] = lane < nts ? (((unsigned long long)(unsigned)ts_hi << 32) | (unsigned)ts_lo) : 0ull;
        if (lane == 62) stamps[62] = rt_entry; if (lane == 63) stamps[63] = (unsigned long long)wall_clock64(); }
#undef PG8_STAMP
#undef PG8_SA
#undef PG8_SB
#undef PG8_STAGE
#undef PG8_LDA
#undef PG8_LDB
#undef PG8_MMA
#undef PG8_WAIT_V
#undef PG8_WAIT_L
#undef PG8_BAR
#undef PG8_SCHED
}
}

#define LAS __attribute__((address_space(3)))
typedef unsigned short bf16_t;
typedef float f32x4 __attribute__((ext_vector_type(4)));
typedef float f32x2 __attribute__((ext_vector_type(2)));
typedef unsigned u32x4 __attribute__((ext_vector_type(4)));
typedef unsigned u32x2 __attribute__((ext_vector_type(2)));

constexpr int NB = 8, SEQ = 4096, NMETA = 16, LT = SEQ + NMETA, DM = 1024, T = NB * SEQ;
constexpr int DHY = 512, DRG = 1024, DIN = 3 * DHY + 2 * DRG + 2 * DM;
constexpr int NTHR = 512, NWAVES = 8;
constexpr int LDS_BYTES = 160 * 1024;
constexpr float EPSF = 1e-6f;
constexpr int KFW = 2 * LT;
constexpr int SP = 4256;
constexpr int NEXP = 16384;

enum { I_X = 0, I_META, I_GFINAL, I_GMIX, I_WIN, I_BGATE, I_HYCW, I_HYCB, I_HYW1, I_HYB1, I_HYW2, I_HYB2, I_HYW3, I_HYB3, I_HYFREQ, I_HYSKIP,
       I_HYOUT, I_RGCW, I_RGCB, I_RGGW, I_RGGB, I_RGLAM, I_RGOUT, I_WOUT, I_GFFN, I_WQ, I_KEYS, I_PU, I_PV, N_IN };

constexpr size_t MiB = 1024ull * 1024ull;
constexpr size_t WS_ROWSS = 64 * 1024;
constexpr size_t WS_WINT = 1 * MiB;
constexpr size_t WS_WHT = 12 * MiB;
constexpr size_t WS_WRT = 13 * MiB;
constexpr size_t WS_WOT = 15 * MiB;
constexpr size_t WS_WST = 17 * MiB;
constexpr size_t WS_GWT = 21 * MiB;
constexpr size_t WS_KF = 22 * MiB;
constexpr size_t WS_KFB = 39 * MiB;
constexpr size_t WS_HYIN = 48 * MiB;
constexpr size_t WS_RGX = 145 * MiB;
constexpr size_t WS_GG = 210 * MiB;
constexpr size_t WS_GA = 274 * MiB;
constexpr size_t WS_GB = 338 * MiB;
constexpr size_t WS_XN1 = 402 * MiB;
constexpr size_t WS_UUT = 402 * MiB;
constexpr size_t WS_CONVT = 436 * MiB;
constexpr size_t WS_YH = 468 * MiB;
constexpr size_t WS_YR = WS_RGX;
constexpr size_t WS_MERGED = WS_HYIN;
constexpr size_t WS_TMP = WS_GG;
constexpr size_t WS_H1B = WS_RGX;
constexpr size_t WS_SCORES = WS_GG;
constexpr size_t WS_EIDX = 468 * MiB;
constexpr size_t WS_EG = 484 * MiB;
constexpr size_t WS_UB = 48 * MiB;
constexpr size_t WS_VB = 80 * MiB;
constexpr size_t WS_END = 500 * MiB;

struct Args { const float* in[N_IN]; float* out; unsigned char* ws; int ph_lo, ph_hi; };

__device__ __forceinline__ float bf2f(unsigned v) { return __uint_as_float(v << 16); }
__device__ __forceinline__ unsigned f2bf(float f) { unsigned u = __float_as_uint(f); return (u + 0x7fffu + ((u >> 16) & 1u)) >> 16; }
__device__ __forceinline__ unsigned pk2(float lo, float hi) { return f2bf(lo) | (f2bf(hi) << 16); }
__device__ __forceinline__ float bflo(unsigned w) { return __uint_as_float(w << 16); }
__device__ __forceinline__ float bfhi(unsigned w) { return __uint_as_float(w & 0xffff0000u); }
__device__ __forceinline__ float wave_sum(float v) {
#pragma unroll
    for (int o = 1; o < 64; o <<= 1) v += __shfl_xor(v, o);
    return v;
}
__device__ __forceinline__ float wave_max(float v) {
#pragma unroll
    for (int o = 1; o < 64; o <<= 1) v = fmaxf(v, __shfl_xor(v, o));
    return v;
}
__device__ __forceinline__ float sigmoidf_(float x) { return __builtin_amdgcn_rcpf(1.0f + __expf(-x)); }
__device__ __forceinline__ float gelu_tanh(float x) { const float u = 1.5957691216f * (x + 0.044715f * x * x * x); return x * __builtin_amdgcn_rcpf(1.0f + __expf(-u)); }
__device__ __forceinline__ void sincos_acc(float a, float& s, float& c) {
    const double x = (double)a;
    const double q = rint(x * 0.63661977236758134308);
    const double r = fma(-q, 1.57079632679489661923, x);
    const int n = (int)q;
    const float rf = (float)r, r2 = rf * rf;
    const float sp = rf * (1.f + r2 * (-1.6666667e-1f + r2 * (8.3333333e-3f + r2 * (-1.9841270e-4f + r2 * 2.7557319e-6f))));
    const float cp = 1.f + r2 * (-0.5f + r2 * (4.1666667e-2f + r2 * (-1.3888889e-3f + r2 * (2.4801587e-5f + r2 * (-2.7557319e-7f)))));
    const int k = n & 3;
    s = (k == 0) ? sp : (k == 1) ? cp : (k == 2) ? -sp : -cp;
    c = (k == 0) ? cp : (k == 1) ? -sp : (k == 2) ? -cp : sp;
}

__device__ __forceinline__ void p0_transpose_item(const float* W, int K, int N, bf16_t* WT, LAS float* scr, int item, int lane) {
    const int nblk = N / 32, kb = item / nblk, nb = item % nblk, k0 = 64 * kb, n0 = 32 * nb;
#pragma unroll 8
    for (int i = 0; i < 32; ++i) { const int kk = 2 * i + (lane >> 5); scr[kk * 33 + (lane & 31)] = W[(size_t)(k0 + kk) * N + n0 + (lane & 31)]; }
    asm volatile("s_waitcnt lgkmcnt(0)" ::: "memory");
    const int c = lane & 7;
#pragma unroll
    for (int j = 0; j < 4; ++j) { const int n = (lane >> 3) + 8 * j; const LAS float* s = scr + (8 * c) * 33 + n;
        u32x4 o; o.x = pk2(s[0 * 33], s[1 * 33]); o.y = pk2(s[2 * 33], s[3 * 33]); o.z = pk2(s[4 * 33], s[5 * 33]); o.w = pk2(s[6 * 33], s[7 * 33]);
        *(u32x4*)(WT + (size_t)(n0 + n) * K + k0 + 8 * c) = o; }
    asm volatile("s_waitcnt lgkmcnt(0)" ::: "memory");
}
__device__ __forceinline__ void p0_xn1_row(const float* xrow, const float* g, bf16_t* orow, int lane) {
    const f32x4* xr = (const f32x4*)xrow + lane; const f32x4* gr = (const f32x4*)g + lane;
    f32x4 v[4]; float s = 0.f;
#pragma unroll
    for (int j = 0; j < 4; ++j) { v[j] = xr[64 * j]; s += (v[j].x * v[j].x + v[j].y * v[j].y) + (v[j].z * v[j].z + v[j].w * v[j].w); }
    const float rstd = rsqrtf(wave_sum(s) * (1.f / DM) + EPSF);
    unsigned long long* o8 = (unsigned long long*)orow + lane;
#pragma unroll
    for (int j = 0; j < 4; ++j) { const f32x4 gv = gr[64 * j];
        o8[64 * j] = (unsigned long long)pk2(v[j].x * rstd * gv.x, v[j].y * rstd * gv.y) | ((unsigned long long)pk2(v[j].z * rstd * gv.z, v[j].w * rstd * gv.w) << 32); }
}
__device__ __forceinline__ void p0_fold_item(const Args& a, LAS unsigned char* lds, int item, int tid) {
    const int hp = item >> 4, k0 = (item & 15) * 64;
    LAS float* kl = (LAS float*)lds;
    LAS float* wl = (LAS float*)(lds + 128 * 129 * 4);
    const float* keys = a.in[I_KEYS] + (size_t)hp * 128 * 128; const float* wq = a.in[I_WQ];
    for (int i = tid; i < 128 * 128; i += NTHR) { const int key = i >> 7, d = i & 127; kl[key * 129 + d] = keys[i]; }
    for (int i = tid; i < 64 * 128; i += NTHR) { const int kk = i >> 7, d = i & 127; wl[i] = wq[(size_t)(k0 + kk) * 2048 + hp * 128 + d]; }
    __syncthreads();
    const int key = tid & 127, kq = tid >> 7;
    float acc[16];
#pragma unroll
    for (int i = 0; i < 16; ++i) acc[i] = 0.f;
#pragma unroll 2
    for (int d = 0; d < 128; ++d) { const float kv = kl[key * 129 + d];
#pragma unroll
        for (int i = 0; i < 16; ++i) acc[i] += wl[(kq * 16 + i) * 128 + d] * kv; }
    const float* gf = a.in[I_GFFN] + k0 + kq * 16;
    bf16_t* dst = (bf16_t*)(a.ws + WS_WST) + (size_t)(hp * 128 + key) * 1024 + k0 + kq * 16;
    u32x4 o0, o1;
    o0.x = pk2(acc[0] * gf[0], acc[1] * gf[1]); o0.y = pk2(acc[2] * gf[2], acc[3] * gf[3]); o0.z = pk2(acc[4] * gf[4], acc[5] * gf[5]); o0.w = pk2(acc[6] * gf[6], acc[7] * gf[7]);
    o1.x = pk2(acc[8] * gf[8], acc[9] * gf[9]); o1.y = pk2(acc[10] * gf[10], acc[11] * gf[11]); o1.z = pk2(acc[12] * gf[12], acc[13] * gf[13]); o1.w = pk2(acc[14] * gf[14], acc[15] * gf[15]);
    *(u32x4*)dst = o0; *(u32x4*)(dst + 8) = o1;
    __syncthreads();
}
__device__ __forceinline__ void p0_meta_item(const Args& a, LAS unsigned char* lds, int item, int tid, int wave, int lane) {
    LAS float* mt = (LAS float*)lds;
    for (int r = wave * 2; r < wave * 2 + 2; ++r) {
        const f32x4* xr = (const f32x4*)(a.in[I_META] + (size_t)r * DM) + lane; const f32x4* gr = (const f32x4*)a.in[I_GMIX] + lane;
        f32x4 v[4]; float s = 0.f;
#pragma unroll
        for (int j = 0; j < 4; ++j) { v[j] = xr[64 * j]; s += (v[j].x * v[j].x + v[j].y * v[j].y) + (v[j].z * v[j].z + v[j].w * v[j].w); }
        const float rstd = rsqrtf(wave_sum(s) * (1.f / DM) + EPSF);
#pragma unroll
        for (int j = 0; j < 4; ++j) { const f32x4 gv = gr[64 * j]; f32x4 o = v[j] * rstd * gv; *(LAS f32x4*)(mt + r * 1024 + 4 * (lane + 64 * j)) = o; }
    }
    __syncthreads();
    const int col = item * 256 + (tid & 255), rh = tid >> 8;
    float acc[8];
#pragma unroll
    for (int r = 0; r < 8; ++r) acc[r] = 0.f;
    const float* w = a.in[I_WIN] + col;
#pragma unroll 4
    for (int k = 0; k < 1024; ++k) { const float wv = w[(size_t)k * DIN];
#pragma unroll
        for (int r = 0; r < 8; ++r) acc[r] += mt[(rh * 8 + r) * 1024 + k] * wv; }
    bf16_t* hyin = (bf16_t*)(a.ws + WS_HYIN); bf16_t* rgx = (bf16_t*)(a.ws + WS_RGX);
#pragma unroll
    for (int r = 0; r < 8; ++r) { const int t = rh * 8 + r; const bf16_t v = (bf16_t)f2bf(acc[r]);
        for (int b = 0; b < NB; ++b) { if (col < 1536) hyin[((size_t)b * LT + t) * 1536 + col] = v; else rgx[((size_t)b * LT + t) * 1024 + (col - 1536)] = v; } }
    __syncthreads();
}
__device__ __forceinline__ void p0_filter_item(const Args& a, LAS unsigned char* lds, int item, int tid) {
    LAS float* z = (LAS float*)lds;
    LAS float* h1 = z + 16 * 33;
    LAS float* h2 = h1 + 16 * 64;
    LAS float* ko = h2 + 16 * 64;
    const int p0 = item * 16;
    for (int idx = tid; idx < 16 * 33; idx += NTHR) { const int pp = idx / 33, f = idx % 33, p = p0 + pp;
        float v;
        if (f == 0) v = (float)p * (1.0f / (float)(LT - 1));
        else { const int bi = (f - 1) & 15; const float band = 1e-4f + (float)bi * ((15.0f - 1e-4f) / 15.0f); const float w = (float)(6.283185307179586 / (double)LT) * (float)p;
            float s, c; sincos_acc(band * w, s, c); v = (f <= 16) ? c : -s; }
        z[idx] = v; }
    __syncthreads();
    const float* w1 = a.in[I_HYW1]; const float* b1 = a.in[I_HYB1]; const float* w2 = a.in[I_HYW2]; const float* b2 = a.in[I_HYB2];
    const float* w3 = a.in[I_HYW3]; const float* b3 = a.in[I_HYB3]; const float* fr = a.in[I_HYFREQ];
    for (int idx = tid; idx < 16 * 64; idx += NTHR) { const int pp = idx >> 6, j = idx & 63; float acc = b1[j];
#pragma unroll 3
        for (int f = 0; f < 33; ++f) acc += z[pp * 33 + f] * w1[f * 64 + j];
        float s, c; sincos_acc(fr[j] * acc, s, c); h1[idx] = s; }
    __syncthreads();
    for (int idx = tid; idx < 16 * 64; idx += NTHR) { const int pp = idx >> 6, j = idx & 63; float acc = b2[j];
#pragma unroll 4
        for (int f = 0; f < 64; ++f) acc += h1[pp * 64 + f] * w2[f * 64 + j];
        float s, c; sincos_acc(fr[64 + j] * acc, s, c); h2[idx] = s; }
    __syncthreads();
#pragma unroll 1
    for (int half = 0; half < 2; ++half) { const int o = half * 512 + tid;
        float acc[16];
#pragma unroll
        for (int pp = 0; pp < 16; ++pp) acc[pp] = b3[o];
#pragma unroll 2
        for (int i = 0; i < 64; ++i) { const float wv = w3[i * 1024 + o];
#pragma unroll
            for (int pp = 0; pp < 16; ++pp) acc[pp] += h2[pp * 64 + i] * wv; }
        const float delta = fabsf(-15.350567286626972f + (float)tid * ((-3.0701134573253945f + 15.350567286626972f) / 511.0f));
#pragma unroll
        for (int pp = 0; pp < 16; ++pp) { const float tn = (float)(p0 + pp) * (1.0f / (float)(LT - 1)); ko[o * 17 + pp] = acc[pp] * __expf(-tn * delta); }
    }
    __syncthreads();
    float* kf = (float*)(a.ws + WS_KF); bf16_t* kfb = (bf16_t*)(a.ws + WS_KFB);
    for (int idx = tid; idx < 1024 * 16; idx += NTHR) { const int o = idx >> 4, pp = idx & 15, dir = o >> 9, c = o & 511, p = p0 + pp;
        const float v = ko[o * 17 + pp];
        if (dir == 0) { kf[(size_t)c * KFW + (LT - 1) + p] = v; kfb[(size_t)c * KFW + (LT - 1) + p] = (bf16_t)f2bf(v); }
        else if (p >= 1) { kf[(size_t)c * KFW + (LT - 1) - p] = v; kfb[(size_t)c * KFW + (LT - 1) - p] = (bf16_t)f2bf(v); } }
    if (item == 0) for (int c = tid; c < 512; c += NTHR) { kf[(size_t)c * KFW + KFW - 1] = 0.f; kfb[(size_t)c * KFW + KFW - 1] = 0; }
    __syncthreads();
}
__device__ __forceinline__ void phase_p0(const Args& a, LAS unsigned char* lds, int tid, int wave, int lane) {
    const int G = gridDim.x, bx = blockIdx.x;
    { float* rs = (float*)(a.ws + WS_ROWSS); for (int i = bx * NTHR + tid; i < T; i += G * NTHR) rs[i] = 0.f; }
    for (int it = bx; it < 256 + 257 + 10; it += G) {
#ifndef P0M
#define P0M 7
#endif
        if (it < 256) { if (P0M & 1) p0_fold_item(a, lds, it, tid); }
        else if (it < 513) { if (P0M & 2) p0_filter_item(a, lds, it - 256, tid); }
        else { if (P0M & 4) p0_meta_item(a, lds, it - 513, tid, wave, lane); }
    }
    LAS float* scr = (LAS float*)(lds + wave * 16384);
    const int gw = bx * NWAVES + wave, NGW = G * NWAVES;
    constexpr int I_IN = (1024 / 64) * (DIN / 32), I_H = (512 / 64) * (1024 / 32), I_R = (1024 / 64) * (1024 / 32), I_O = I_R;
    for (int it = gw; it < I_IN + I_H + I_R + I_O; it += NGW) {
        int r = it;
        if (r < I_IN) { p0_transpose_item(a.in[I_WIN], 1024, DIN, (bf16_t*)(a.ws + WS_WINT), scr, r, lane); continue; } r -= I_IN;
        if (r < I_H) { p0_transpose_item(a.in[I_HYOUT], 512, 1024, (bf16_t*)(a.ws + WS_WHT), scr, r, lane); continue; } r -= I_H;
        if (r < I_R) { p0_transpose_item(a.in[I_RGOUT], 1024, 1024, (bf16_t*)(a.ws + WS_WRT), scr, r, lane); continue; } r -= I_R;
        p0_transpose_item(a.in[I_WOUT], 1024, 1024, (bf16_t*)(a.ws + WS_WOT), scr, r, lane);
    }
    for (int m = gw; m < T; m += NGW) p0_xn1_row(a.in[I_X] + (size_t)m * DM, a.in[I_GMIX], (bf16_t*)(a.ws + WS_XN1) + (size_t)m * DM, lane);
}

typedef pg8::f32x4 pf4;
struct EpiProj {
    static constexpr bool PERM = true, AFTER_DRAIN = false;
    bf16_t *hyin, *rgx, *gg, *ga, *gb; const float* bgate;
    __device__ __forceinline__ void operator()(const pf4 (&acc)[2][2][4][2], const pg8::Unit& u, int wr, int wc, int fr, int fq) const {
        const int pn = u.pn, row0 = u.pm * 256 + wr * 64 + fr, cl0 = wc * 32 + 8 * fq;
#pragma unroll
        for (int ai = 0; ai < 2; ++ai)
#pragma unroll
            for (int m = 0; m < 4; ++m) { const int r = row0 + ai * 128 + m * 16; const size_t rl = (size_t)(r >> 12) * LT + NMETA + (r & 4095);
#pragma unroll
                for (int bj = 0; bj < 2; ++bj) { const int col = pn * 256 + bj * 128 + cl0; pf4 v0 = acc[ai][bj][m][0], v1 = acc[ai][bj][m][1]; bf16_t* dst;
                    if (pn < 6) dst = hyin + rl * 1536 + col;
                    else if (pn < 10) dst = rgx + rl * 1024 + (col - 1536);
                    else if (pn < 14) { dst = gg + (size_t)r * 1024 + (col - 2560);
#pragma unroll
                        for (int j = 0; j < 4; ++j) { v0[j] = gelu_tanh(v0[j]); v1[j] = gelu_tanh(v1[j]); } }
                    else { const int gc = col - 3584;
                        dst = (gc < 1024 ? ga + (size_t)r * 1024 + gc : gb + (size_t)r * 1024 + (gc - 1024));
                        const pf4 b0 = *(const pf4*)(bgate + gc), b1 = *(const pf4*)(bgate + gc + 4);
#pragma unroll
                        for (int j = 0; j < 4; ++j) { v0[j] = sigmoidf_(v0[j] + b0[j]); v1[j] = sigmoidf_(v1[j] + b1[j]); } }
                    u32x4 w; w.x = pk2(v0[0], v0[1]); w.y = pk2(v0[2], v0[3]); w.z = pk2(v1[0], v1[1]); w.w = pk2(v1[2], v1[3]);
                    *(u32x4*)dst = w; } }
    }
};
template <int MODE  > struct EpiGate {
    static constexpr bool PERM = true, AFTER_DRAIN = false;
    const bf16_t* gate; const bf16_t* tin; bf16_t* outp;
    __device__ __forceinline__ void operator()(const pf4 (&acc)[2][2][4][2], const pg8::Unit& u, int wr, int wc, int fr, int fq) const {
        const int row0 = u.pm * 256 + wr * 64 + fr, col0 = u.pn * 256 + wc * 32 + 8 * fq;
#pragma unroll
        for (int ai = 0; ai < 2; ++ai)
#pragma unroll
            for (int m = 0; m < 4; ++m) { const size_t ro = (size_t)(row0 + ai * 128 + m * 16) * 1024 + col0;
#pragma unroll
                for (int bj = 0; bj < 2; ++bj) { const size_t o = ro + bj * 128; const pf4 v0 = acc[ai][bj][m][0], v1 = acc[ai][bj][m][1];
                    const u32x4 g = *(const u32x4*)(gate + o);
                    float r[8];
                    r[0] = v0[0] * bflo(g.x); r[1] = v0[1] * bfhi(g.x); r[2] = v0[2] * bflo(g.y); r[3] = v0[3] * bfhi(g.y);
                    r[4] = v1[0] * bflo(g.z); r[5] = v1[1] * bfhi(g.z); r[6] = v1[2] * bflo(g.w); r[7] = v1[3] * bfhi(g.w);
                    if (MODE == 1) { const u32x4 t = *(const u32x4*)(tin + o);
                        r[0] += bflo(t.x); r[1] += bfhi(t.x); r[2] += bflo(t.y); r[3] += bfhi(t.y); r[4] += bflo(t.z); r[5] += bfhi(t.z); r[6] += bflo(t.w); r[7] += bfhi(t.w); }
                    u32x4 w; w.x = pk2(r[0], r[1]); w.y = pk2(r[2], r[3]); w.z = pk2(r[4], r[5]); w.w = pk2(r[6], r[7]);
                    *(u32x4*)(outp + o) = w; } }
    }
};
struct EpiResid {
    static constexpr bool PERM = true, AFTER_DRAIN = false;
    const float* x; float* h1; bf16_t* h1b; float* rowss;
    __device__ __forceinline__ void operator()(const pf4 (&acc)[2][2][4][2], const pg8::Unit& u, int wr, int wc, int fr, int fq) const {
        const int row0 = u.pm * 256 + wr * 64 + fr, col0 = u.pn * 256 + wc * 32 + 8 * fq;
#pragma unroll
        for (int ai = 0; ai < 2; ++ai)
#pragma unroll
            for (int m = 0; m < 4; ++m) { const int r = row0 + ai * 128 + m * 16; const size_t ro = (size_t)r * 1024 + col0; float ss = 0.f;
#pragma unroll
                for (int bj = 0; bj < 2; ++bj) { const size_t o = ro + bj * 128;
                    const pf4 x0 = *(const pf4*)(x + o), x1 = *(const pf4*)(x + o + 4);
                    const pf4 v0 = acc[ai][bj][m][0] + x0, v1 = acc[ai][bj][m][1] + x1;
                    *(pf4*)(h1 + o) = v0; *(pf4*)(h1 + o + 4) = v1;
                    u32x4 w; w.x = pk2(v0[0], v0[1]); w.y = pk2(v0[2], v0[3]); w.z = pk2(v1[0], v1[1]); w.w = pk2(v1[2], v1[3]);
                    *(u32x4*)(h1b + o) = w;
                    ss += (v0[0] * v0[0] + v0[1] * v0[1]) + (v0[2] * v0[2] + v0[3] * v0[3]) + (v1[0] * v1[0] + v1[1] * v1[1]) + (v1[2] * v1[2] + v1[3] * v1[3]); }
                ss += __shfl_xor(ss, 16); ss += __shfl_xor(ss, 32);
                if (fq == 0) atomicAdd(rowss + r, ss); }
    }
};
struct EpiScores {
    static constexpr bool PERM = true, AFTER_DRAIN = false;
    const float* rowss; float* sc;
    __device__ __forceinline__ void operator()(const pf4 (&acc)[2][2][4][2], const pg8::Unit& u, int wr, int wc, int fr, int fq) const {
        const int row0 = u.pm * 256 + wr * 64 + fr, col0 = u.pn * 256 + wc * 32 + 8 * fq;
#pragma unroll
        for (int ai = 0; ai < 2; ++ai)
#pragma unroll
            for (int m = 0; m < 4; ++m) { const int r = row0 + ai * 128 + m * 16; const float rs = rsqrtf(rowss[r] * (1.f / DM) + EPSF); float* rp = sc + (size_t)r * 2048 + col0;
#pragma unroll
                for (int bj = 0; bj < 2; ++bj) { *(pf4*)(rp + bj * 128) = acc[ai][bj][m][0] * rs; *(pf4*)(rp + bj * 128 + 4) = acc[ai][bj][m][1] * rs; } }
    }
};

__device__ __forceinline__ void load8(const bf16_t* p, float (&f)[8]) { const u32x4 w = *(const u32x4*)p;
    f[0] = bflo(w.x); f[1] = bfhi(w.x); f[2] = bflo(w.y); f[3] = bfhi(w.y); f[4] = bflo(w.z); f[5] = bfhi(w.z); f[6] = bflo(w.w); f[7] = bfhi(w.w); }
__device__ __forceinline__ void short_conv8(const bf16_t* hb, const float* cw, const float* cb, int s, int ch, float (&o)[8]) {
    float xm[8], x0[8], xp[8];
    if (s >= 1) load8(hb + (size_t)(s - 1) * 1536 + ch, xm); else {
#pragma unroll
        for (int i = 0; i < 8; ++i) xm[i] = 0.f; }
    load8(hb + (size_t)s * 1536 + ch, x0);
    if (s + 1 < LT) load8(hb + (size_t)(s + 1) * 1536 + ch, xp); else {
#pragma unroll
        for (int i = 0; i < 8; ++i) xp[i] = 0.f; }
#pragma unroll
    for (int i = 0; i < 8; ++i) o[i] = xm[i] * cw[ch + i] + x0[i] * cw[1536 + ch + i] + xp[i] * cw[3072 + ch + i] + cb[ch + i];
}
__device__ __forceinline__ void phase_hy_pre(const Args& a, LAS unsigned char* lds, int tid) {
    LAS bf16_t* tl = (LAS bf16_t*)lds;
    const bf16_t* hyin = (const bf16_t*)(a.ws + WS_HYIN); bf16_t* uut = (bf16_t*)(a.ws + WS_UUT);
    const float* cw = a.in[I_HYCW]; const float* cb = a.in[I_HYCB];
    for (int it = blockIdx.x; it < NB * 67 * 8; it += gridDim.x) {
        const int ct = it & 7, ts = (it >> 3) % 67, b = (it >> 3) / 67;
        { const int sr = tid >> 3, cg = tid & 7, c0 = ct * 64 + cg * 8, sp = ts * 64 + sr, s = sp - 16;
            float uu[8];
            if (s >= 0 && s < LT) { float x1[8], v[8]; const bf16_t* hb = hyin + (size_t)b * LT * 1536;
                short_conv8(hb, cw, cb, s, 512 + c0, x1); short_conv8(hb, cw, cb, s, 1024 + c0, v);
#pragma unroll
                for (int i = 0; i < 8; ++i) uu[i] = v[i] * x1[i]; }
            else {
#pragma unroll
                for (int i = 0; i < 8; ++i) uu[i] = 0.f; }
#pragma unroll
            for (int i = 0; i < 8; ++i) tl[sr * 72 + cg * 8 + i] = (bf16_t)f2bf(uu[i]); }
        __syncthreads();
        { const int cl = tid >> 3, sg = tid & 7, sp0 = ts * 64 + sg * 8;
            if (sp0 < SP) { u32x4 w; unsigned h[8];
#pragma unroll
                for (int i = 0; i < 8; ++i) h[i] = tl[(sg * 8 + i) * 72 + cl];
                w.x = h[0] | (h[1] << 16); w.y = h[2] | (h[3] << 16); w.z = h[4] | (h[5] << 16); w.w = h[6] | (h[7] << 16);
                *(u32x4*)(uut + ((size_t)(ct * 64 + cl) * NB + b) * SP + sp0) = w; } }
        __syncthreads();
    }
}
__device__ __forceinline__ void phase_hy_conv_naive(const Args& a, LAS unsigned char* lds, int tid) {
    LAS bf16_t* uus = (LAS bf16_t*)lds;
    LAS float* filt = (LAS float*)(lds + LT * 16);
    const bf16_t* uut = (const bf16_t*)(a.ws + WS_UUT); const float* kf = (const float*)(a.ws + WS_KF); bf16_t* cvt = (bf16_t*)(a.ws + WS_CONVT);
    for (int c = blockIdx.x; c < DHY; c += gridDim.x) {
        for (int i = tid; i < NB * LT; i += NTHR) { const int b = i / LT, s = i - b * LT; uus[s * 8 + b] = uut[((size_t)c * NB + b) * SP + 16 + s]; }
        for (int i = tid; i < KFW; i += NTHR) filt[i] = kf[(size_t)c * KFW + i];
        __syncthreads();
        for (int tt = 0; tt < 8; ++tt) { const int tq = tt * 512 + tid, t = tq + 16; float acc[8];
#pragma unroll
            for (int b = 0; b < 8; ++b) acc[b] = 0.f;
            const LAS float* fp = filt + (LT - 1) + t;
            for (int s = 0; s < LT; ++s) { const float kv = fp[-s]; const u32x4 w = *(const LAS u32x4*)(uus + s * 8);
                acc[0] += kv * bflo(w.x); acc[1] += kv * bfhi(w.x); acc[2] += kv * bflo(w.y); acc[3] += kv * bfhi(w.y);
                acc[4] += kv * bflo(w.z); acc[5] += kv * bfhi(w.z); acc[6] += kv * bflo(w.w); acc[7] += kv * bfhi(w.w); }
#pragma unroll
            for (int b = 0; b < 8; ++b) cvt[((size_t)c * NB + b) * SEQ + tq] = (bf16_t)f2bf(acc[b]); }
        __syncthreads();
    }
}
__device__ __forceinline__ void phase_rg_naive(const Args& a, LAS unsigned char* lds, int tid) {
    LAS float* xc = (LAS float*)lds;
    LAS float* gbuf = xc + 32 * 128;
    const bf16_t* rgx = (const bf16_t*)(a.ws + WS_RGX);
    for (int it = blockIdx.x; it < NB * 2 * 8; it += gridDim.x) {
        const int head = it & 7, dir = (it >> 3) & 1, b = it >> 4;
        const float* cw = a.in[I_RGCW] + (size_t)dir * 4 * DRG + head * 128; const float* cb = a.in[I_RGCB] + (size_t)dir * DRG + head * 128;
        bf16_t* hout = (bf16_t*)a.out + (size_t)dir * T * DRG;
        const bf16_t* xb = rgx + (size_t)b * LT * DRG + head * 128;
        float h = 0.f, sp = 0.f;
        if (tid < 128) { const float lam = a.in[I_RGLAM][dir * DRG + head * 128 + tid]; sp = log1pf(__expf(-lam)); }
        for (int k = 0; k < 129; ++k) {
            { const int tok = tid >> 4, cg = tid & 15, u = 32 * k + tok; float o[8];
#pragma unroll
                for (int i = 0; i < 8; ++i) o[i] = (u < LT) ? cb[cg * 8 + i] : 0.f;
                if (u < LT) {
#pragma unroll
                    for (int j = 0; j < 4; ++j) { const int uu = u - j; if (uu >= 0) { const int t = dir ? (LT - 1 - uu) : uu; float xv[8]; load8(xb + (size_t)t * DRG + cg * 8, xv);
#pragma unroll
                            for (int i = 0; i < 8; ++i) o[i] += xv[i] * cw[j * DRG + cg * 8 + i]; } } }
#pragma unroll
                for (int i = 0; i < 8; ++i) xc[tok * 128 + cg * 8 + i] = o[i]; }
            __syncthreads();
            { const int j = tid & 127, g = (tid >> 7) & 1, th = tid >> 8; float acc[16];
#pragma unroll
                for (int q = 0; q < 16; ++q) acc[q] = 0.f;
                const float* gw = a.in[I_RGGW] + ((size_t)((dir * 2 + g) * 8 + head) * 128) * 128 + j;
                for (int i = 0; i < 128; ++i) { const float wv = gw[i * 128];
#pragma unroll
                    for (int q = 0; q < 16; ++q) acc[q] += xc[(th * 16 + q) * 128 + i] * wv; }
                const float gb = a.in[I_RGGB][(size_t)(dir * 2 + g) * DRG + head * 128 + j];
#pragma unroll
                for (int q = 0; q < 16; ++q) gbuf[(g * 32 + th * 16 + q) * 128 + j] = acc[q] + gb; }
            __syncthreads();
            if (tid < 128) {
                for (int tok = 0; tok < 32; ++tok) { const int u = 32 * k + tok; if (u >= LT) break;
                    const float r = sigmoidf_(gbuf[tok * 128 + tid]), ig = sigmoidf_(gbuf[(32 + tok) * 128 + tid]);
                    const float la = -8.0f * r * sp; const float av = __expf(la); const float mult = (u == 0) ? 1.0f : sqrtf(-expm1f(2.0f * la));
                    h = av * h + mult * ig * xc[tok * 128 + tid];
                    const int t = dir ? (LT - 1 - u) : u;
                    if (t >= NMETA) hout[((size_t)b * SEQ + (t - NMETA)) * DRG + head * 128 + tid] = (bf16_t)f2bf(h); } }
            __syncthreads();
        }
    }
}
__device__ __forceinline__ void phase_post(const Args& a, LAS unsigned char* lds, int tid) {
    LAS bf16_t* cv = (LAS bf16_t*)lds;
    const bf16_t* hyin = (const bf16_t*)(a.ws + WS_HYIN); const bf16_t* cvt = (const bf16_t*)(a.ws + WS_CONVT); bf16_t* yh = (bf16_t*)(a.ws + WS_YH);
    const float* cw = a.in[I_HYCW]; const float* cb = a.in[I_HYCB]; const float* skip = a.in[I_HYSKIP];
    for (int it = blockIdx.x; it < NB * 64 * 8; it += gridDim.x) {
        const int ct = it & 7, tt = (it >> 3) & 63, b = it >> 9;
        { const int cl = tid >> 3, tg = tid & 7; const u32x4 w = *(const u32x4*)(cvt + ((size_t)(ct * 64 + cl) * NB + b) * SEQ + tt * 64 + tg * 8);
            *(LAS u32x4*)(cv + cl * 72 + tg * 8) = w; }
        __syncthreads();
        { const int tr = tid >> 3, cg = tid & 7, c0 = ct * 64 + cg * 8, t = NMETA + tt * 64 + tr; const bf16_t* hb = hyin + (size_t)b * LT * 1536;
            float x0[8], x1[8], v[8]; short_conv8(hb, cw, cb, t, c0, x0); short_conv8(hb, cw, cb, t, 512 + c0, x1); short_conv8(hb, cw, cb, t, 1024 + c0, v);
            float y[8];
#pragma unroll
            for (int i = 0; i < 8; ++i) { const float cvv = bf2f(cv[(cg * 8 + i) * 72 + tr]); y[i] = (cvv + v[i] * x1[i] * skip[c0 + i]) * x0[i]; }
            u32x4 w; w.x = pk2(y[0], y[1]); w.y = pk2(y[2], y[3]); w.z = pk2(y[4], y[5]); w.w = pk2(y[6], y[7]);
            *(u32x4*)(yh + ((size_t)b * SEQ + tt * 64 + tr) * DHY + c0) = w; }
        __syncthreads();
    }
    const bf16_t* hf = (const bf16_t*)a.out; const bf16_t* hb2 = hf + (size_t)T * DRG; const bf16_t* gg = (const bf16_t*)(a.ws + WS_GG); bf16_t* yr = (bf16_t*)(a.ws + WS_YR);
    for (size_t i = (size_t)blockIdx.x * NTHR + tid; i < (size_t)T * DRG / 8; i += (size_t)gridDim.x * NTHR) {
        float f[8], g[8], q[8]; load8(hf + i * 8, f); load8(hb2 + i * 8, g); load8(gg + i * 8, q);
        u32x4 w; w.x = pk2((f[0] + g[0]) * q[0], (f[1] + g[1]) * q[1]); w.y = pk2((f[2] + g[2]) * q[2], (f[3] + g[3]) * q[3]);
        w.z = pk2((f[4] + g[4]) * q[4], (f[5] + g[5]) * q[5]); w.w = pk2((f[6] + g[6]) * q[6], (f[7] + g[7]) * q[7]);
        *(u32x4*)(yr + i * 8) = w; }
}
__device__ __forceinline__ void phase_tables(const Args& a, int wave, int lane) {
    const int gw = blockIdx.x * NWAVES + wave, NGW = gridDim.x * NWAVES;
    const float* gf = a.in[I_GFFN]; bf16_t* ub = (bf16_t*)(a.ws + WS_UB); bf16_t* vb = (bf16_t*)(a.ws + WS_VB);
    const f32x4 g0 = *(const f32x4*)(gf + 8 * lane), g1 = *(const f32x4*)(gf + 8 * lane + 4), g2 = *(const f32x4*)(gf + 512 + 8 * lane), g3 = *(const f32x4*)(gf + 512 + 8 * lane + 4);
    for (int e = gw; e < NEXP; e += NGW) {
        const float* ur = a.in[I_PU] + (size_t)e * DM; const float* vr = a.in[I_PV] + (size_t)e * DM;
        f32x4 u0 = *(const f32x4*)(ur + 8 * lane) * g0, u1 = *(const f32x4*)(ur + 8 * lane + 4) * g1, u2 = *(const f32x4*)(ur + 512 + 8 * lane) * g2, u3 = *(const f32x4*)(ur + 512 + 8 * lane + 4) * g3;
        f32x4 v0 = *(const f32x4*)(vr + 8 * lane), v1 = *(const f32x4*)(vr + 8 * lane + 4), v2 = *(const f32x4*)(vr + 512 + 8 * lane), v3 = *(const f32x4*)(vr + 512 + 8 * lane + 4);
        u32x4 w;
        w.x = pk2(u0[0], u0[1]); w.y = pk2(u0[2], u0[3]); w.z = pk2(u1[0], u1[1]); w.w = pk2(u1[2], u1[3]); *(u32x4*)(ub + (size_t)e * DM + 8 * lane) = w;
        w.x = pk2(u2[0], u2[1]); w.y = pk2(u2[2], u2[3]); w.z = pk2(u3[0], u3[1]); w.w = pk2(u3[2], u3[3]); *(u32x4*)(ub + (size_t)e * DM + 512 + 8 * lane) = w;
        w.x = pk2(v0[0], v0[1]); w.y = pk2(v0[2], v0[3]); w.z = pk2(v1[0], v1[1]); w.w = pk2(v1[2], v1[3]); *(u32x4*)(vb + (size_t)e * DM + 8 * lane) = w;
        w.x = pk2(v2[0], v2[1]); w.y = pk2(v2[2], v2[3]); w.z = pk2(v3[0], v3[1]); w.w = pk2(v3[2], v3[3]); *(u32x4*)(vb + (size_t)e * DM + 512 + 8 * lane) = w;
    }
}
__device__ __forceinline__ void wave_top16_2(float a, float b, int lane, float& tv, int& ti) {
    tv = 0.f; ti = 0;
    for (int r = 0; r < 16; ++r) {
        const float v = fmaxf(a, b); const float mx = wave_max(v);
        const unsigned long long bal = __ballot(v == mx); const int src = __ffsll((long long)bal) - 1;
        int idl = 0;
        if (lane == src) { if (a == mx) { idl = lane; a = -INFINITY; } else { idl = lane + 64; b = -INFINITY; } }
        const int idx = __shfl(idl, src);
        if (lane == r) { tv = mx; ti = idx; }
    }
}
__device__ __forceinline__ void phase_topk(const Args& a, int wave, int lane) {
    const int gw = blockIdx.x * NWAVES + wave, NGW = gridDim.x * NWAVES;
    const float* sc = (const float*)(a.ws + WS_SCORES); int* eidx = (int*)(a.ws + WS_EIDX); float* eg = (float*)(a.ws + WS_EG);
    for (int it = gw; it < T * 8; it += NGW) { const int m = it >> 3, hh = it & 7;
        const float* sp = sc + (size_t)m * 2048 + hh * 256;
        float tv0, tv1; int ti0, ti1;
        wave_top16_2(sp[lane], sp[64 + lane], lane, tv0, ti0);
        wave_top16_2(sp[128 + lane], sp[192 + lane], lane, tv1, ti1);
        float cd[4]; const float ci_ = __shfl(tv0, lane >> 2);
#pragma unroll
        for (int q = 0; q < 4; ++q) cd[q] = ci_ + __shfl(tv1, (lane & 3) * 4 + q);
        float cs = 0.f; int ci = 0;
        for (int r = 0; r < 16; ++r) {
            const float v = fmaxf(fmaxf(cd[0], cd[1]), fmaxf(cd[2], cd[3])); const float mx = wave_max(v);
            const unsigned long long bal = __ballot(v == mx); const int src = __ffsll((long long)bal) - 1;
            int idl = 0;
            if (lane == src) { if (cd[0] == mx) { idl = lane * 4; cd[0] = -INFINITY; } else if (cd[1] == mx) { idl = lane * 4 + 1; cd[1] = -INFINITY; }
                else if (cd[2] == mx) { idl = lane * 4 + 2; cd[2] = -INFINITY; } else { idl = lane * 4 + 3; cd[3] = -INFINITY; } }
            const int idx = __shfl(idl, src);
            if (lane == r) { cs = mx; ci = idx; }
        }
        const int e1 = __shfl(ti0, ci >> 4), e2 = __shfl(ti1, ci & 15);
        const float m0 = __shfl(cs, 0);
        const float ex = (lane < 16) ? __expf(cs - m0) : 0.f;
        const float sum = wave_sum(ex);
        if (lane < 16) { eidx[(size_t)m * 128 + hh * 16 + lane] = e1 * 128 + e2; eg[(size_t)m * 128 + hh * 16 + lane] = ex / sum; }
    }
}
__device__ __forceinline__ void unpack8(const u32x4 w, float (&f)[8]) {
    f[0] = bflo(w.x); f[1] = bfhi(w.x); f[2] = bflo(w.y); f[3] = bfhi(w.y); f[4] = bflo(w.z); f[5] = bfhi(w.z); f[6] = bflo(w.w); f[7] = bfhi(w.w); }
__device__ __forceinline__ void phase_peer(const Args& a, int wave, int lane) {
    const int gw = blockIdx.x * NWAVES + wave, NGW = gridDim.x * NWAVES;
    const bf16_t* h1b = (const bf16_t*)(a.ws + WS_H1B); const bf16_t* ub = (const bf16_t*)(a.ws + WS_UB); const bf16_t* vb = (const bf16_t*)(a.ws + WS_VB);
    const int* eidx = (const int*)(a.ws + WS_EIDX); const float* eg = (const float*)(a.ws + WS_EG); const float* rowss = (const float*)(a.ws + WS_ROWSS);
    const float* gfin = a.in[I_GFINAL];
    for (int m = gw; m < T; m += NGW) {
        float xa[8], xb[8]; load8(h1b + (size_t)m * DM + 8 * lane, xa); load8(h1b + (size_t)m * DM + 512 + 8 * lane, xb);
        const float rstd = rsqrtf(rowss[m] * (1.f / DM) + EPSF);
        const int ev0 = eidx[(size_t)m * 128 + lane], ev1 = eidx[(size_t)m * 128 + 64 + lane];
        const float gv0 = eg[(size_t)m * 128 + lane], gv1 = eg[(size_t)m * 128 + 64 + lane];
        float oa[8], ob[8];
#pragma unroll
        for (int i = 0; i < 8; ++i) { oa[i] = 0.f; ob[i] = 0.f; }
        for (int k0 = 0; k0 < 128; k0 += 8) {
            int e[8]; float g[8]; u32x4 ua[8], ubb[8];
#pragma unroll
            for (int q = 0; q < 8; ++q) { const int k = k0 + q; e[q] = __shfl(k < 64 ? ev0 : ev1, k & 63); g[q] = __shfl(k < 64 ? gv0 : gv1, k & 63);
                ua[q] = *(const u32x4*)(ub + (size_t)e[q] * DM + 8 * lane); ubb[q] = *(const u32x4*)(ub + (size_t)e[q] * DM + 512 + 8 * lane); }
            float d[8];
#pragma unroll
            for (int q = 0; q < 8; ++q) { float fa[8], fb[8]; unpack8(ua[q], fa); unpack8(ubb[q], fb); float s = 0.f;
#pragma unroll
                for (int i = 0; i < 8; ++i) s += fa[i] * xa[i] + fb[i] * xb[i];
                d[q] = s; }
#pragma unroll
            for (int q = 0; q < 8; ++q) d[q] = wave_sum(d[q]);
            u32x4 va[8], vbb[8];
#pragma unroll
            for (int q = 0; q < 8; ++q) { va[q] = *(const u32x4*)(vb + (size_t)e[q] * DM + 8 * lane); vbb[q] = *(const u32x4*)(vb + (size_t)e[q] * DM + 512 + 8 * lane); }
#pragma unroll
            for (int q = 0; q < 8; ++q) { const float act = gelu_tanh(d[q] * rstd) * g[q]; float fa[8], fb[8]; unpack8(va[q], fa); unpack8(vbb[q], fb);
#pragma unroll
                for (int i = 0; i < 8; ++i) { oa[i] += act * fa[i]; ob[i] += act * fb[i]; } }
        }
        float* orow = a.out + (size_t)m * DM;
        f32x4 h0 = *(const f32x4*)(orow + 8 * lane), h1 = *(const f32x4*)(orow + 8 * lane + 4), h2 = *(const f32x4*)(orow + 512 + 8 * lane), h3 = *(const f32x4*)(orow + 512 + 8 * lane + 4);
        h0 += (f32x4){oa[0], oa[1], oa[2], oa[3]}; h1 += (f32x4){oa[4], oa[5], oa[6], oa[7]}; h2 += (f32x4){ob[0], ob[1], ob[2], ob[3]}; h3 += (f32x4){ob[4], ob[5], ob[6], ob[7]};
        float ss = (h0.x * h0.x + h0.y * h0.y) + (h0.z * h0.z + h0.w * h0.w) + (h1.x * h1.x + h1.y * h1.y) + (h1.z * h1.z + h1.w * h1.w)
                 + (h2.x * h2.x + h2.y * h2.y) + (h2.z * h2.z + h2.w * h2.w) + (h3.x * h3.x + h3.y * h3.y) + (h3.z * h3.z + h3.w * h3.w);
        const float r2 = rsqrtf(wave_sum(ss) * (1.f / DM) + EPSF);
        const f32x4 q0 = *(const f32x4*)(gfin + 8 * lane), q1 = *(const f32x4*)(gfin + 8 * lane + 4), q2 = *(const f32x4*)(gfin + 512 + 8 * lane), q3 = *(const f32x4*)(gfin + 512 + 8 * lane + 4);
        *(f32x4*)(orow + 8 * lane) = h0 * r2 * q0; *(f32x4*)(orow + 8 * lane + 4) = h1 * r2 * q1; *(f32x4*)(orow + 512 + 8 * lane) = h2 * r2 * q2; *(f32x4*)(orow + 512 + 8 * lane + 4) = h3 * r2 * q3;
    }
}

#ifndef ONE_LAUNCH
#define ONE_LAUNCH 0
#endif
constexpr int NPHASE = 10;
__global__ void __launch_bounds__(NTHR, 2) mega(Args a) {
    extern __shared__ __attribute__((aligned(16))) unsigned char lds_raw[];
    LAS unsigned char* lds = (LAS unsigned char*)lds_raw;
    const int tid = threadIdx.x, lane = tid & 63, wave = __builtin_amdgcn_readfirstlane(tid >> 6);
    cg::grid_group grid = cg::this_grid();
    const int lo = a.ph_lo, hi = a.ph_hi, G = gridDim.x, bx = blockIdx.x;
#ifndef PHMASK
#define PHMASK 0x3ff
#endif
#define IN(k) (((PHMASK >> (k)) & 1) && lo <= (k) && (k) < hi)
#define SEAM(k) do { if (IN(k) && IN((k) + 1)) grid.sync(); } while (0)
    unsigned char* ws = a.ws;
    if (IN(0)) phase_p0(a, lds, tid, wave, lane);
    SEAM(0);
    if (IN(1)) {
        pg8::Gemm g{(const bf16_t*)(ws + WS_XN1), (const bf16_t*)(ws + WS_WINT), T, DIN, 1024}; pg8::StaticOrder S; S.init(T, DIN, G, bx);
        EpiProj E{(bf16_t*)(ws + WS_HYIN), (bf16_t*)(ws + WS_RGX), (bf16_t*)(ws + WS_GG), (bf16_t*)(ws + WS_GA), (bf16_t*)(ws + WS_GB), a.in[I_BGATE]};
        pg8::gemm_phase<EpiProj, pg8::StaticOrder>(lds, g, S, E, nullptr);
    }
    SEAM(1);
    if (IN(2)) phase_hy_pre(a, lds, tid);
    SEAM(2);
    if (IN(3)) { phase_hy_conv_naive(a, lds, tid); phase_rg_naive(a, lds, tid); }
    SEAM(3);
    if (IN(4)) phase_post(a, lds, tid);
    SEAM(4);
    if (IN(5)) {
        { pg8::Gemm g{(const bf16_t*)(ws + WS_YH), (const bf16_t*)(ws + WS_WHT), T, 1024, 512}; pg8::StaticOrder S; S.init(T, 1024, G, bx);
          EpiGate<0> E{(const bf16_t*)(ws + WS_GA), nullptr, (bf16_t*)(ws + WS_TMP)};
          pg8::gemm_phase<EpiGate<0>, pg8::StaticOrder>(lds, g, S, E, nullptr); }
        { pg8::Gemm g{(const bf16_t*)(ws + WS_YR), (const bf16_t*)(ws + WS_WRT), T, 1024, 1024}; pg8::StaticOrder S; S.init(T, 1024, G, bx);
          EpiGate<1> E{(const bf16_t*)(ws + WS_GB), (const bf16_t*)(ws + WS_TMP), (bf16_t*)(ws + WS_MERGED)};
          pg8::gemm_phase<EpiGate<1>, pg8::StaticOrder>(lds, g, S, E, nullptr); }
    }
    SEAM(5);
    if (IN(6)) {
        pg8::Gemm g{(const bf16_t*)(ws + WS_MERGED), (const bf16_t*)(ws + WS_WOT), T, 1024, 1024}; pg8::StaticOrder S; S.init(T, 1024, G, bx);
        EpiResid E{a.in[I_X], a.out, (bf16_t*)(ws + WS_H1B), (float*)(ws + WS_ROWSS)};
        pg8::gemm_phase<EpiResid, pg8::StaticOrder>(lds, g, S, E, nullptr);
    }
    SEAM(6);
    if (IN(7)) {
        phase_tables(a, wave, lane);
        pg8::Gemm g{(const bf16_t*)(ws + WS_H1B), (const bf16_t*)(ws + WS_WST), T, 2048, 1024}; pg8::StaticOrder S; S.init(T, 2048, G, bx);
        EpiScores E{(const float*)(ws + WS_ROWSS), (float*)(ws + WS_SCORES)};
        pg8::gemm_phase<EpiScores, pg8::StaticOrder>(lds, g, S, E, nullptr);
    }
    SEAM(7);
    if (IN(8)) phase_topk(a, wave, lane);
    SEAM(8);
    if (IN(9)) phase_peer(a, wave, lane);
#undef IN
#undef SEAM
}

extern "C" void kernel_launch(void* const* d_in, const int* in_sizes, int n_in, void* d_out, int out_size, void* d_ws, size_t ws_size, hipStream_t stream) {
    static int grid = 0;
    if (grid == 0) {
        if (n_in != N_IN || out_size != T * DM || ws_size < WS_END) { fprintf(stderr, "kernel_launch: unexpected shapes (n_in %d out %d ws %zu)\n", n_in, out_size, ws_size); grid = -1; return; }
        if (hipFuncSetAttribute((const void*)mega, hipFuncAttributeMaxDynamicSharedMemorySize, LDS_BYTES) != hipSuccess) { fprintf(stderr, "kernel_launch: hipFuncSetAttribute failed\n"); grid = -1; return; }
        int dev = 0, cus = 0, per_cu = 0;
        hipGetDevice(&dev); hipDeviceGetAttribute(&cus, hipDeviceAttributeMultiprocessorCount, dev);
        hipOccupancyMaxActiveBlocksPerMultiprocessor(&per_cu, (const void*)mega, NTHR, LDS_BYTES);
        if (per_cu < 1) { fprintf(stderr, "kernel_launch: occupancy query says %d blocks per CU\n", per_cu); per_cu = 1; }
        (void)hipGetLastError();
        grid = cus;
    }
    if (grid < 0) return;
    Args a{};
    for (int i = 0; i < N_IN; ++i) a.in[i] = (const float*)d_in[i];
    a.out = (float*)d_out; a.ws = (unsigned char*)d_ws;
#if ONE_LAUNCH
    a.ph_lo = 0; a.ph_hi = NPHASE;
    void* args[] = {&a};
    hipError_t e = hipLaunchCooperativeKernel((const void*)mega, dim3(grid), dim3(NTHR), args, LDS_BYTES, stream);
    if (e != hipSuccess) fprintf(stderr, "cooperative launch failed: %s (grid %d)\n", hipGetErrorString(e), grid);
#else
    for (int ph = 0; ph < NPHASE; ++ph) { a.ph_lo = ph; a.ph_hi = ph + 1;
        hipLaunchKernelGGL(mega, dim3(grid), dim3(NTHR), LDS_BYTES, stream, a);
        hipError_t e = hipPeekAtLastError(); if (e != hipSuccess) { fprintf(stderr, "launch %d failed: %s\n", ph, hipGetErrorString(e)); break; } }
#endif
}
```

```cpp
#define ONE_LAUNCH 1
#include <hip/hip_runtime.h>
#include <hip/hip_cooperative_groups.h>
#include <cstdio>
#include <cstdint>
#include <cmath>
namespace cg = cooperative_groups;
namespace pg8 {
#define PG8_LAS __attribute__((address_space(3)))
typedef unsigned short bf16_t;
typedef short bf16x8 __attribute__((ext_vector_type(8)));
typedef float f32x4 __attribute__((ext_vector_type(4)));
typedef unsigned u32x4 __attribute__((ext_vector_type(4)));
constexpr int BM = 256, BK = 64, HALF = 128, HTB = HALF * BK * 2  , STAGE_BYTES = 8 * HTB, NXCD = 8, WGM = 8;

__host__ __device__ __forceinline__ int lds_byte(int r, int c) { const int st = (r >> 4) * 2 + (c >> 5), rr = r & 15, cc = c & 31, ob = rr * 64 + cc * 2; return st * 1024 + (ob ^ (((ob >> 9) & 1) << 5)); }
__host__ __device__ __forceinline__ void stage_rc(int b, int& R, int& C) { const int st = b / 1024, sb = b % 1024, swz = sb ^ (((sb >> 9) & 1) << 5); R = (st >> 1) * 16 + swz / 64; C = (st & 1) * 32 + (swz % 64) / 2; }
__host__ __device__ __forceinline__ int perm32(int rho) { const int n = rho >> 4, i = rho & 15; return 8 * (i >> 2) + 4 * n + (i & 3); }

struct Unit { int pm, pn; };
struct Gemm { const bf16_t* A; const bf16_t* Bt; int M, N, K; };

struct StaticOrder {
    int nM, nN, nwg, G, c;
    __host__ __device__ void init(int M, int N, int G_, int c_) { nM = M / BM; nN = N / BM; nwg = nM * nN; G = G_; c = c_; }
    __host__ __device__ bool next(int i, Unit& u) const {
        const long L = (long)i * G + c; if (L >= nwg) return false;
        int wgid = (int)L; { const int q = nwg / NXCD, r = nwg % NXCD, xcd = wgid % NXCD, off = wgid / NXCD; wgid = (xcd < r ? xcd * (q + 1) : r * (q + 1) + (xcd - r) * q) + off; }
        const int nig = WGM * nN, gid = wgid / nig, fm = gid * WGM, gsz = (nM - fm) < WGM ? (nM - fm) : WGM;
        u.pm = fm + ((wgid % nig) % gsz); u.pn = (wgid % nig) / gsz; return true;
    }
    __device__ __forceinline__ void a_ready(const Unit&) const {}
    __device__ __forceinline__ void done(const Unit&) const {}
};
__device__ __forceinline__ unsigned cvt_pk_bf16(float lo, float hi) { unsigned r; asm volatile("v_cvt_pk_bf16_f32 %0, %1, %2" : "=v"(r) : "v"(lo), "v"(hi)); return r; }
typedef float f32x2 __attribute__((ext_vector_type(2)));
__device__ __forceinline__ f32x2 gelu_pk(f32x2 v) {
    const f32x2 av = __builtin_elementwise_abs(v), d = av * 0.2316418882f + 1.0f;
    f32x2 t; t.x = __builtin_amdgcn_rcpf(d.x); t.y = __builtin_amdgcn_rcpf(d.y);
    f32x2 q = t * 0.5307027145f + (-0.7265760135f); q = q * t + 0.7107068705f; q = q * t + (-0.142248368f); q = q * t + 0.127414796f; q = q * t;
    const f32x2 s = (v * v) * (-0.72134752044f);
    f32x2 e; e.x = __builtin_amdgcn_exp2f(s.x); e.y = __builtin_amdgcn_exp2f(s.y);
    const f32x2 m = v * (q * e), r = v - m;
    f32x2 o; o.x = v.x < 0.f ? m.x : r.x; o.y = v.y < 0.f ? m.y : r.y; return o;
}
template <class Epi, class Sched, bool STAMP = false>
__device__ __forceinline__ void gemm_phase(PG8_LAS unsigned char* lds, const Gemm g, const Sched& S, const Epi& E, unsigned long long* stamps) {
    const int tid = threadIdx.x, wid = __builtin_amdgcn_readfirstlane(tid >> 6), lane = tid & 63, wr = wid >> 2, wc = wid & 3, fr = lane & 15, fq = lane >> 4;
    const int K = g.K, nt = K / BK;
    int ts_lo = 0, ts_hi = 0, nts = 0; const unsigned long long rt_entry = STAMP ? (unsigned long long)wall_clock64() : 0ull;
#define PG8_STAMP() do { if (STAMP && wid == 0 && nts < 64) { const unsigned long long _c = (unsigned long long)clock64(); \
        ts_lo = (lane == nts) ? (int)(unsigned)_c : ts_lo; ts_hi = (lane == nts) ? (int)(unsigned)(_c >> 32) : ts_hi; ++nts; } } while (0)
    PG8_STAMP();
    unsigned voffA[2], voffB[2];
#pragma unroll
    for (int i = 0; i < 2; ++i) { int R, C; stage_rc(tid * 16 + i * 8192, R, C); const int Rb = Epi::PERM ? ((R & ~31) + perm32(R & 31)) : R;
        voffA[i] = (unsigned)(R * K + C) * 2u; voffB[i] = (unsigned)(Rb * K + C) * 2u; }
    const size_t kstep = (size_t)(BK * 2);
    const size_t hstep = (size_t)HALF * K * 2;
    const size_t tstep = 2 * hstep;
    const unsigned ldsw = (unsigned)wid * 1024u;
    const int aoff = lds_byte(wr * 64 + fr, fq * 8), boff = lds_byte(wc * 32 + fr, fq * 8);
#define PG8_SA(b, h) (((b) * 2 + (h)) * HTB)
#define PG8_SB(b, h) ((4 + (b) * 2 + (h)) * HTB)
#define PG8_STAGE(bufoff, gbase, voff) do { _Pragma("unroll") for (int _i = 0; _i < 2; ++_i) \
        __builtin_amdgcn_global_load_lds((const unsigned*)((const char*)(gbase) + (voff)[_i]), (PG8_LAS unsigned*)(lds + (bufoff) + ldsw + _i * 8192), 16, 0, 0); } while (0)
#define PG8_LDA(dst, b, h) do { _Pragma("unroll") for (int m = 0; m < 4; ++m) _Pragma("unroll") for (int k = 0; k < 2; ++k) dst[m][k] = *(const PG8_LAS bf16x8*)(lds + PG8_SA(b, h) + aoff + m * 2048 + k * 1024); } while (0)
#define PG8_LDB(dst, b, h) do { _Pragma("unroll") for (int n = 0; n < 2; ++n) _Pragma("unroll") for (int k = 0; k < 2; ++k) dst[n][k] = *(const PG8_LAS bf16x8*)(lds + PG8_SB(b, h) + boff + n * 2048 + k * 1024); } while (0)
#define PG8_MMA(ai, bj, At, Bt) do { __builtin_amdgcn_s_setprio(1); _Pragma("unroll") for (int m = 0; m < 4; ++m) _Pragma("unroll") for (int n = 0; n < 2; ++n) _Pragma("unroll") for (int k = 0; k < 2; ++k) \
        acc[ai][bj][m][n] = __builtin_amdgcn_mfma_f32_16x16x32_bf16(Bt[n][k], At[m][k], acc[ai][bj][m][n], 0, 0, 0); __builtin_amdgcn_s_setprio(0); } while (0)
#define PG8_WAIT_V(n) asm volatile("s_waitcnt vmcnt(" #n ")" ::: "memory")
#define PG8_WAIT_L(n) asm volatile("s_waitcnt lgkmcnt(" #n ")" ::: "memory")
#define PG8_BAR __builtin_amdgcn_s_barrier()
#define PG8_SCHED __builtin_amdgcn_sched_barrier(0)
    Unit cur, nxt; int ui = 0;
    if (!S.next(0, cur)) return;
    f32x4 acc[2][2][4][2];
#pragma unroll
    for (int a = 0; a < 2; ++a)
#pragma unroll
        for (int b = 0; b < 2; ++b)
#pragma unroll
            for (int m = 0; m < 4; ++m)
#pragma unroll
                for (int n = 0; n < 2; ++n) acc[a][b][m][n] = (f32x4){0.f, 0.f, 0.f, 0.f};
    bf16x8 At[4][2], B0[2][2], B1[2][2];
    const char* cA = (const char*)g.A + (size_t)cur.pm * tstep; const char* cB = (const char*)g.Bt + (size_t)cur.pn * tstep;
    S.a_ready(cur);
    PG8_STAGE(PG8_SB(0, 0), cB, voffB); PG8_STAGE(PG8_SA(0, 0), cA, voffA); PG8_STAGE(PG8_SB(0, 1), cB + hstep, voffB); PG8_STAGE(PG8_SA(0, 1), cA + hstep, voffA);
    if (wr == 1) PG8_BAR;
    PG8_WAIT_V(4); PG8_BAR;
    PG8_STAGE(PG8_SB(1, 0), cB + kstep, voffB); PG8_STAGE(PG8_SA(1, 0), cA + kstep, voffA); PG8_STAGE(PG8_SB(1, 1), cB + hstep + kstep, voffB);
    PG8_WAIT_V(6); PG8_BAR;
    PG8_STAMP();
    for (;;) {
        const bool has_next = S.next(ui + 1, nxt);
        const char* nA = has_next ? (const char*)g.A + (size_t)nxt.pm * tstep : cA; const char* nB = has_next ? (const char*)g.Bt + (size_t)nxt.pn * tstep : cB;
        for (int t = 0; t < nt; t += 2) {
            const bool last = (t == nt - 2);
            const char* a1 = cA + (size_t)(t + 1) * kstep;
            const char* a2 = last ? nA : cA + (size_t)(t + 2) * kstep; const char* b2 = last ? nB : cB + (size_t)(t + 2) * kstep;
            const char* a3 = a2 + kstep; const char* b3 = b2 + kstep;
            if (last && has_next) S.a_ready(nxt);
            PG8_LDB(B0, 0, 0); PG8_SCHED; PG8_LDA(At, 0, 0); PG8_STAGE(PG8_SA(1, 1), a1 + hstep, voffA);
            PG8_WAIT_L(8); PG8_BAR; PG8_WAIT_L(0); PG8_MMA(0, 0, At, B0); PG8_BAR; PG8_SCHED;
            PG8_LDB(B1, 0, 1); PG8_STAGE(PG8_SB(0, 0), b2, voffB);
            PG8_BAR; PG8_WAIT_L(0); PG8_MMA(0, 1, At, B1); PG8_BAR;
            PG8_LDA(At, 0, 1); PG8_STAGE(PG8_SA(0, 0), a2, voffA);
            PG8_BAR; PG8_WAIT_L(0); PG8_MMA(1, 0, At, B0); PG8_BAR; PG8_SCHED;
            PG8_STAGE(PG8_SB(0, 1), b2 + hstep, voffB);
            PG8_WAIT_V(6); PG8_BAR; PG8_MMA(1, 1, At, B1); PG8_BAR;
            PG8_LDB(B0, 1, 0); PG8_SCHED; PG8_LDA(At, 1, 0); PG8_STAGE(PG8_SA(0, 1), a2 + hstep, voffA);
            PG8_WAIT_L(8); PG8_BAR; PG8_WAIT_L(0); PG8_MMA(0, 0, At, B0); PG8_BAR; PG8_SCHED;
            PG8_LDB(B1, 1, 1); PG8_STAGE(PG8_SB(1, 0), b3, voffB);
            PG8_BAR; PG8_WAIT_L(0); PG8_MMA(0, 1, At, B1); PG8_BAR;
            PG8_LDA(At, 1, 1); PG8_STAGE(PG8_SA(1, 0), a3, voffA);
            PG8_BAR; PG8_WAIT_L(0); PG8_MMA(1, 0, At, B0); PG8_BAR; PG8_SCHED;
            PG8_STAGE(PG8_SB(1, 1), b3 + hstep, voffB);
            PG8_WAIT_V(6); PG8_BAR; PG8_MMA(1, 1, At, B1); PG8_BAR;
        }
        PG8_STAMP();
        if constexpr (!Epi::AFTER_DRAIN) { E(acc, cur, wr, wc, fr, fq); S.done(cur); }
        PG8_STAMP();
        if (!has_next) break;
#pragma unroll
        for (int a = 0; a < 2; ++a)
#pragma unroll
            for (int b = 0; b < 2; ++b)
#pragma unroll
                for (int m = 0; m < 4; ++m)
#pragma unroll
                    for (int n = 0; n < 2; ++n) acc[a][b][m][n] = (f32x4){0.f, 0.f, 0.f, 0.f};
        cur = nxt; cA = nA; cB = nB; ++ui;
    }
    PG8_WAIT_V(0);
    if (wr == 0) PG8_BAR;
    PG8_BAR;
    if constexpr (Epi::AFTER_DRAIN) { E.fused(acc, cur, wr, wc, fr, fq, lds, wid, lane); S.done(cur); }
    PG8_STAMP();
    if (STAMP && wid == 0) { stamps[lane] = lane < nts ? (((unsigned long long)(unsigned)ts_hi << 32) | (unsigned)ts_lo) : 0ull;
        if (lane == 62) stamps[62] = rt_entry; if (lane == 63) stamps[63] = (unsigned long long)wall_clock64(); }
#undef PG8_STAMP
#undef PG8_SA
#undef PG8_SB
#undef PG8_STAGE
#undef PG8_LDA
#undef PG8_LDB
#undef PG8_MMA
#undef PG8_WAIT_V
#undef PG8_WAIT_L
#undef PG8_BAR
#undef PG8_SCHED
}
}

#define LAS __attribute__((address_space(3)))
typedef unsigned short bf16_t;
typedef float f32x4 __attribute__((ext_vector_type(4)));
typedef float f32x2 __attribute__((ext_vector_type(2)));
typedef unsigned u32x4 __attribute__((ext_vector_type(4)));
typedef unsigned u32x2 __attribute__((ext_vector_type(2)));

constexpr int NB = 8, SEQ = 4096, NMETA = 16, LT = SEQ + NMETA, DM = 1024, T = NB * SEQ;
constexpr int DHY = 512, DRG = 1024, DIN = 3 * DHY + 2 * DRG + 2 * DM;
constexpr int NTHR = 512, NWAVES = 8;
constexpr int LDS_BYTES = 160 * 1024;
constexpr float EPSF = 1e-6f;
constexpr int KFW = 2 * LT;
constexpr int SP = 4256;
constexpr int NEXP = 16384;

enum { I_X = 0, I_META, I_GFINAL, I_GMIX, I_WIN, I_BGATE, I_HYCW, I_HYCB, I_HYW1, I_HYB1, I_HYW2, I_HYB2, I_HYW3, I_HYB3, I_HYFREQ, I_HYSKIP,
       I_HYOUT, I_RGCW, I_RGCB, I_RGGW, I_RGGB, I_RGLAM, I_RGOUT, I_WOUT, I_GFFN, I_WQ, I_KEYS, I_PU, I_PV, N_IN };

constexpr size_t MiB = 1024ull * 1024ull;
constexpr size_t WS_ROWSS = 64 * 1024;
constexpr size_t WS_WINT = 1 * MiB;
constexpr size_t WS_WHT = 12 * MiB;
constexpr size_t WS_WRT = 13 * MiB;
constexpr size_t WS_WOT = 15 * MiB;
constexpr size_t WS_WST = 17 * MiB;
constexpr size_t WS_GWT = 21 * MiB;
constexpr size_t WS_KF = 22 * MiB;
constexpr size_t WS_KFB = 39 * MiB;
constexpr size_t WS_HYIN = 48 * MiB;
constexpr size_t WS_RGX = 145 * MiB;
constexpr size_t WS_GG = 210 * MiB;
constexpr size_t WS_GA = 274 * MiB;
constexpr size_t WS_GB = 338 * MiB;
constexpr size_t WS_XN1 = 402 * MiB;
constexpr size_t WS_UUT = 402 * MiB;
constexpr size_t WS_CONVT = 436 * MiB;
constexpr size_t WS_YH = 468 * MiB;
constexpr size_t WS_YR = WS_RGX;
constexpr size_t WS_MERGED = WS_HYIN;
constexpr size_t WS_TMP = WS_GG;
constexpr size_t WS_H1B = WS_RGX;
constexpr size_t WS_SCORES = WS_GG;
constexpr size_t WS_EIDX = 468 * MiB;
constexpr size_t WS_EG = 484 * MiB;
constexpr size_t WS_UB = 48 * MiB;
constexpr size_t WS_VB = 80 * MiB;
constexpr size_t WS_END = 500 * MiB;

struct Args { const float* in[N_IN]; float* out; unsigned char* ws; int ph_lo, ph_hi; };

__device__ __forceinline__ float bf2f(unsigned v) { return __uint_as_float(v << 16); }
__device__ __forceinline__ unsigned f2bf(float f) { unsigned u = __float_as_uint(f); return (u + 0x7fffu + ((u >> 16) & 1u)) >> 16; }
__device__ __forceinline__ unsigned pk2(float lo, float hi) { return f2bf(lo) | (f2bf(hi) << 16); }
__device__ __forceinline__ float bflo(unsigned w) { return __uint_as_float(w << 16); }
__device__ __forceinline__ float bfhi(unsigned w) { return __uint_as_float(w & 0xffff0000u); }
__device__ __forceinline__ float wave_sum(float v) {
#pragma unroll
    for (int o = 1; o < 64; o <<= 1) v += __shfl_xor(v, o);
    return v;
}
__device__ __forceinline__ float wave_max(float v) {
#pragma unroll
    for (int o = 1; o < 64; o <<= 1) v = fmaxf(v, __shfl_xor(v, o));
    return v;
}
__device__ __forceinline__ float sigmoidf_(float x) { return __builtin_amdgcn_rcpf(1.0f + __expf(-x)); }
__device__ __forceinline__ float gelu_tanh(float x) { const float u = 1.5957691216f * (x + 0.044715f * x * x * x); return x * __builtin_amdgcn_rcpf(1.0f + __expf(-u)); }
__device__ __forceinline__ void sincos_acc(float a, float& s, float& c) {
    const double x = (double)a;
    const double q = rint(x * 0.63661977236758134308);
    const double r = fma(-q, 1.57079632679489661923, x);
    const int n = (int)q;
    const float rf = (float)r, r2 = rf * rf;
    const float sp = rf * (1.f + r2 * (-1.6666667e-1f + r2 * (8.3333333e-3f + r2 * (-1.9841270e-4f + r2 * 2.7557319e-6f))));
    const float cp = 1.f + r2 * (-0.5f + r2 * (4.1666667e-2f + r2 * (-1.3888889e-3f + r2 * (2.4801587e-5f + r2 * (-2.7557319e-7f)))));
    const int k = n & 3;
    s = (k == 0) ? sp : (k == 1) ? cp : (k == 2) ? -sp : -cp;
    c = (k == 0) ? cp : (k == 1) ? -sp : (k == 2) ? -cp : sp;
}

__device__ __forceinline__ void p0_transpose_item(const float* W, int K, int N, bf16_t* WT, LAS float* scr, int item, int lane) {
    const int nblk = N / 32, kb = item / nblk, nb = item % nblk, k0 = 64 * kb, n0 = 32 * nb;
#pragma unroll 8
    for (int i = 0; i < 32; ++i) { const int kk = 2 * i + (lane >> 5); scr[kk * 33 + (lane & 31)] = W[(size_t)(k0 + kk) * N + n0 + (lane & 31)]; }
    asm volatile("s_waitcnt lgkmcnt(0)" ::: "memory");
    const int c = lane & 7;
#pragma unroll
    for (int j = 0; j < 4; ++j) { const int n = (lane >> 3) + 8 * j; const LAS float* s = scr + (8 * c) * 33 + n;
        u32x4 o; o.x = pk2(s[0 * 33], s[1 * 33]); o.y = pk2(s[2 * 33], s[3 * 33]); o.z = pk2(s[4 * 33], s[5 * 33]); o.w = pk2(s[6 * 33], s[7 * 33]);
        *(u32x4*)(WT + (size_t)(n0 + n) * K + k0 + 8 * c) = o; }
    asm volatile("s_waitcnt lgkmcnt(0)" ::: "memory");
}
__device__ __forceinline__ void p0_xn1_row(const float* xrow, const float* g, bf16_t* orow, int lane) {
    const f32x4* xr = (const f32x4*)xrow + lane; const f32x4* gr = (const f32x4*)g + lane;
    f32x4 v[4]; float s = 0.f;
#pragma unroll
    for (int j = 0; j < 4; ++j) { v[j] = xr[64 * j]; s += (v[j].x * v[j].x + v[j].y * v[j].y) + (v[j].z * v[j].z + v[j].w * v[j].w); }
    const float rstd = rsqrtf(wave_sum(s) * (1.f / DM) + EPSF);
    unsigned long long* o8 = (unsigned long long*)orow + lane;
#pragma unroll
    for (int j = 0; j < 4; ++j) { const f32x4 gv = gr[64 * j];
        o8[64 * j] = (unsigned long long)pk2(v[j].x * rstd * gv.x, v[j].y * rstd * gv.y) | ((unsigned long long)pk2(v[j].z * rstd * gv.z, v[j].w * rstd * gv.w) << 32); }
}
__device__ __forceinline__ void p0_fold_item(const Args& a, LAS unsigned char* lds, int item, int tid) {
    const int hp = item >> 4, k0 = (item & 15) * 64;
    LAS float* kl = (LAS float*)lds;
    LAS float* wl = (LAS float*)(lds + 128 * 129 * 4);
    const float* keys = a.in[I_KEYS] + (size_t)hp * 128 * 128; const float* wq = a.in[I_WQ];
    for (int i = tid; i < 128 * 128; i += NTHR) { const int key = i >> 7, d = i & 127; kl[key * 129 + d] = keys[i]; }
    for (int i = tid; i < 64 * 128; i += NTHR) { const int kk = i >> 7, d = i & 127; wl[i] = wq[(size_t)(k0 + kk) * 2048 + hp * 128 + d]; }
    __syncthreads();
    const int key = tid & 127, kq = tid >> 7;
    float acc[16];
#pragma unroll
    for (int i = 0; i < 16; ++i) acc[i] = 0.f;
#pragma unroll 2
    for (int d = 0; d < 128; ++d) { const float kv = kl[key * 129 + d];
#pragma unroll
        for (int i = 0; i < 16; ++i) acc[i] += wl[(kq * 16 + i) * 128 + d] * kv; }
    const float* gf = a.in[I_GFFN] + k0 + kq * 16;
    bf16_t* dst = (bf16_t*)(a.ws + WS_WST) + (size_t)(hp * 128 + key) * 1024 + k0 + kq * 16;
    u32x4 o0, o1;
    o0.x = pk2(acc[0] * gf[0], acc[1] * gf[1]); o0.y = pk2(acc[2] * gf[2], acc[3] * gf[3]); o0.z = pk2(acc[4] * gf[4], acc[5] * gf[5]); o0.w = pk2(acc[6] * gf[6], acc[7] * gf[7]);
    o1.x = pk2(acc[8] * gf[8], acc[9] * gf[9]); o1.y = pk2(acc[10] * gf[10], acc[11] * gf[11]); o1.z = pk2(acc[12] * gf[12], acc[13] * gf[13]); o1.w = pk2(acc[14] * gf[14], acc[15] * gf[15]);
    *(u32x4*)dst = o0; *(u32x4*)(dst + 8) = o1;
    __syncthreads();
}
__device__ __forceinline__ void p0_meta_item(const Args& a, LAS unsigned char* lds, int item, int tid, int wave, int lane) {
    LAS float* mt = (LAS float*)lds;
    for (int r = wave * 2; r < wave * 2 + 2; ++r) {
        const f32x4* xr = (const f32x4*)(a.in[I_META] + (size_t)r * DM) + lane; const f32x4* gr = (const f32x4*)a.in[I_GMIX] + lane;
        f32x4 v[4]; float s = 0.f;
#pragma unroll
        for (int j = 0; j < 4; ++j) { v[j] = xr[64 * j]; s += (v[j].x * v[j].x + v[j].y * v[j].y) + (v[j].z * v[j].z + v[j].w * v[j].w); }
        const float rstd = rsqrtf(wave_sum(s) * (1.f / DM) + EPSF);
#pragma unroll
        for (int j = 0; j < 4; ++j) { const f32x4 gv = gr[64 * j]; f32x4 o = v[j] * rstd * gv; *(LAS f32x4*)(mt + r * 1024 + 4 * (lane + 64 * j)) = o; }
    }
    __syncthreads();
    const int col = item * 256 + (tid & 255), rh = tid >> 8;
    float acc[8];
#pragma unroll
    for (int r = 0; r < 8; ++r) acc[r] = 0.f;
    const float* w = a.in[I_WIN] + col;
#pragma unroll 4
    for (int k = 0; k < 1024; ++k) { const float wv = w[(size_t)k * DIN];
#pragma unroll
        for (int r = 0; r < 8; ++r) acc[r] += mt[(rh * 8 + r) * 1024 + k] * wv; }
    bf16_t* hyin = (bf16_t*)(a.ws + WS_HYIN); bf16_t* rgx = (bf16_t*)(a.ws + WS_RGX);
#pragma unroll
    for (int r = 0; r < 8; ++r) { const int t = rh * 8 + r; const bf16_t v = (bf16_t)f2bf(acc[r]);
        for (int b = 0; b < NB; ++b) { if (col < 1536) hyin[((size_t)b * LT + t) * 1536 + col] = v; else rgx[((size_t)b * LT + t) * 1024 + (col - 1536)] = v; } }
    __syncthreads();
}
__device__ __forceinline__ void p0_filter_item(const Args& a, LAS unsigned char* lds, int item, int tid) {
    LAS float* z = (LAS float*)lds;
    LAS float* h1 = z + 16 * 33;
    LAS float* h2 = h1 + 16 * 64;
    LAS float* ko = h2 + 16 * 64;
    const int p0 = item * 16;
    for (int idx = tid; idx < 16 * 33; idx += NTHR) { const int pp = idx / 33, f = idx % 33, p = p0 + pp;
        float v;
        if (f == 0) v = (float)p * (1.0f / (float)(LT - 1));
        else { const int bi = (f - 1) & 15; const float band = 1e-4f + (float)bi * ((15.0f - 1e-4f) / 15.0f); const float w = (float)(6.283185307179586 / (double)LT) * (float)p;
            float s, c; sincos_acc(band * w, s, c); v = (f <= 16) ? c : -s; }
        z[idx] = v; }
    __syncthreads();
    const float* w1 = a.in[I_HYW1]; const float* b1 = a.in[I_HYB1]; const float* w2 = a.in[I_HYW2]; const float* b2 = a.in[I_HYB2];
    const float* w3 = a.in[I_HYW3]; const float* b3 = a.in[I_HYB3]; const float* fr = a.in[I_HYFREQ];
    for (int idx = tid; idx < 16 * 64; idx += NTHR) { const int pp = idx >> 6, j = idx & 63; float acc = b1[j];
#pragma unroll 3
        for (int f = 0; f < 33; ++f) acc += z[pp * 33 + f] * w1[f * 64 + j];
        float s, c; sincos_acc(fr[j] * acc, s, c); h1[idx] = s; }
    __syncthreads();
    for (int idx = tid; idx < 16 * 64; idx += NTHR) { const int pp = idx >> 6, j = idx & 63; float acc = b2[j];
#pragma unroll 4
        for (int f = 0; f < 64; ++f) acc += h1[pp * 64 + f] * w2[f * 64 + j];
        float s, c; sincos_acc(fr[64 + j] * acc, s, c); h2[idx] = s; }
    __syncthreads();
#pragma unroll 1
    for (int half = 0; half < 2; ++half) { const int o = half * 512 + tid;
        float acc[16];
#pragma unroll
        for (int pp = 0; pp < 16; ++pp) acc[pp] = b3[o];
#pragma unroll 2
        for (int i = 0; i < 64; ++i) { const float wv = w3[i * 1024 + o];
#pragma unroll
            for (int pp = 0; pp < 16; ++pp) acc[pp] += h2[pp * 64 + i] * wv; }
        const float delta = fabsf(-15.350567286626972f + (float)tid * ((-3.0701134573253945f + 15.350567286626972f) / 511.0f));
#pragma unroll
        for (int pp = 0; pp < 16; ++pp) { const float tn = (float)(p0 + pp) * (1.0f / (float)(LT - 1)); ko[o * 17 + pp] = acc[pp] * __expf(-tn * delta); }
    }
    __syncthreads();
    float* kf = (float*)(a.ws + WS_KF); bf16_t* kfb = (bf16_t*)(a.ws + WS_KFB);
    for (int idx = tid; idx < 1024 * 16; idx += NTHR) { const int o = idx >> 4, pp = idx & 15, dir = o >> 9, c = o & 511, p = p0 + pp;
        const float v = ko[o * 17 + pp];
        if (dir == 0) { kf[(size_t)c * KFW + (LT - 1) + p] = v; kfb[(size_t)c * KFW + (LT - 1) + p] = (bf16_t)f2bf(v); }
        else if (p >= 1) { kf[(size_t)c * KFW + (LT - 1) - p] = v; kfb[(size_t)c * KFW + (LT - 1) - p] = (bf16_t)f2bf(v); } }
    if (item == 0) for (int c = tid; c < 512; c += NTHR) { kf[(size_t)c * KFW + KFW - 1] = 0.f; kfb[(size_t)c * KFW + KFW - 1] = 0; }
    __syncthreads();
}
__device__ __forceinline__ void phase_p0(const Args& a, LAS unsigned char* lds, int tid, int wave, int lane) {
    const int G = gridDim.x, bx = blockIdx.x;
    { float* rs = (float*)(a.ws + WS_ROWSS); for (int i = bx * NTHR + tid; i < T; i += G * NTHR) rs[i] = 0.f; }
    for (int it = bx; it < 256 + 257 + 10; it += G) {
#ifndef P0M
#define P0M 7
#endif
        if (it < 256) { if (P0M & 1) p0_fold_item(a, lds, it, tid); }
        else if (it < 513) { if (P0M & 2) p0_filter_item(a, lds, it - 256, tid); }
        else { if (P0M & 4) p0_meta_item(a, lds, it - 513, tid, wave, lane); }
    }
    LAS float* scr = (LAS float*)(lds + wave * 16384);
    const int gw = bx * NWAVES + wave, NGW = G * NWAVES;
    constexpr int I_IN = (1024 / 64) * (DIN / 32), I_H = (512 / 64) * (1024 / 32), I_R = (1024 / 64) * (1024 / 32), I_O = I_R;
    for (int it = gw; it < I_IN + I_H + I_R + I_O; it += NGW) {
        int r = it;
        if (r < I_IN) { p0_transpose_item(a.in[I_WIN], 1024, DIN, (bf16_t*)(a.ws + WS_WINT), scr, r, lane); continue; } r -= I_IN;
        if (r < I_H) { p0_transpose_item(a.in[I_HYOUT], 512, 1024, (bf16_t*)(a.ws + WS_WHT), scr, r, lane); continue; } r -= I_H;
        if (r < I_R) { p0_transpose_item(a.in[I_RGOUT], 1024, 1024, (bf16_t*)(a.ws + WS_WRT), scr, r, lane); continue; } r -= I_R;
        p0_transpose_item(a.in[I_WOUT], 1024, 1024, (bf16_t*)(a.ws + WS_WOT), scr, r, lane);
    }
    for (int m = gw; m < T; m += NGW) p0_xn1_row(a.in[I_X] + (size_t)m * DM, a.in[I_GMIX], (bf16_t*)(a.ws + WS_XN1) + (size_t)m * DM, lane);
}

typedef pg8::f32x4 pf4;
struct EpiProj {
    static constexpr bool PERM = true, AFTER_DRAIN = false;
    bf16_t *hyin, *rgx, *gg, *ga, *gb; const float* bgate;
    __device__ __forceinline__ void operator()(const pf4 (&acc)[2][2][4][2], const pg8::Unit& u, int wr, int wc, int fr, int fq) const {
        const int pn = u.pn, row0 = u.pm * 256 + wr * 64 + fr, cl0 = wc * 32 + 8 * fq;
#pragma unroll
        for (int ai = 0; ai < 2; ++ai)
#pragma unroll
            for (int m = 0; m < 4; ++m) { const int r = row0 + ai * 128 + m * 16; const size_t rl = (size_t)(r >> 12) * LT + NMETA + (r & 4095);
#pragma unroll
                for (int bj = 0; bj < 2; ++bj) { const int col = pn * 256 + bj * 128 + cl0; pf4 v0 = acc[ai][bj][m][0], v1 = acc[ai][bj][m][1]; bf16_t* dst;
                    if (pn < 6) dst = hyin + rl * 1536 + col;
                    else if (pn < 10) dst = rgx + rl * 1024 + (col - 1536);
                    else if (pn < 14) { dst = gg + (size_t)r * 1024 + (col - 2560);
#pragma unroll
                        for (int j = 0; j < 4; ++j) { v0[j] = gelu_tanh(v0[j]); v1[j] = gelu_tanh(v1[j]); } }
                    else { const int gc = col - 3584;
                        dst = (gc < 1024 ? ga + (size_t)r * 1024 + gc : gb + (size_t)r * 1024 + (gc - 1024));
                        const pf4 b0 = *(const pf4*)(bgate + gc), b1 = *(const pf4*)(bgate + gc + 4);
#pragma unroll
                        for (int j = 0; j < 4; ++j) { v0[j] = sigmoidf_(v0[j] + b0[j]); v1[j] = sigmoidf_(v1[j] + b1[j]); } }
                    u32x4 w; w.x = pk2(v0[0], v0[1]); w.y = pk2(v0[2], v0[3]); w.z = pk2(v1[0], v1[1]); w.w = pk2(v1[2], v1[3]);
                    *(u32x4*)dst = w; } }
    }
};
template <int MODE  > struct EpiGate {
    static constexpr bool PERM = true, AFTER_DRAIN = false;
    const bf16_t* gate; const bf16_t* tin; bf16_t* outp;
    __device__ __forceinline__ void operator()(const pf4 (&acc)[2][2][4][2], const pg8::Unit& u, int wr, int wc, int fr, int fq) const {
        const int row0 = u.pm * 256 + wr * 64 + fr, col0 = u.pn * 256 + wc * 32 + 8 * fq;
#pragma unroll
        for (int ai = 0; ai < 2; ++ai)
#pragma unroll
            for (int m = 0; m < 4; ++m) { const size_t ro = (size_t)(row0 + ai * 128 + m * 16) * 1024 + col0;
#pragma unroll
                for (int bj = 0; bj < 2; ++bj) { const size_t o = ro + bj * 128; const pf4 v0 = acc[ai][bj][m][0], v1 = acc[ai][bj][m][1];
                    const u32x4 g = *(const u32x4*)(gate + o);
                    float r[8];
                    r[0] = v0[0] * bflo(g.x); r[1] = v0[1] * bfhi(g.x); r[2] = v0[2] * bflo(g.y); r[3] = v0[3] * bfhi(g.y);
                    r[4] = v1[0] * bflo(g.z); r[5] = v1[1] * bfhi(g.z); r[6] = v1[2] * bflo(g.w); r[7] = v1[3] * bfhi(g.w);
                    if (MODE == 1) { const u32x4 t = *(const u32x4*)(tin + o);
                        r[0] += bflo(t.x); r[1] += bfhi(t.x); r[2] += bflo(t.y); r[3] += bfhi(t.y); r[4] += bflo(t.z); r[5] += bfhi(t.z); r[6] += bflo(t.w); r[7] += bfhi(t.w); }
                    u32x4 w; w.x = pk2(r[0], r[1]); w.y = pk2(r[2], r[3]); w.z = pk2(r[4], r[5]); w.w = pk2(r[6], r[7]);
                    *(u32x4*)(outp + o) = w; } }
    }
};
struct EpiResid {
    static constexpr bool PERM = true, AFTER_DRAIN = false;
    const float* x; float* h1; bf16_t* h1b; float* rowss;
    __device__ __forceinline__ void operator()(const pf4 (&acc)[2][2][4][2], const pg8::Unit& u, int wr, int wc, int fr, int fq) const {
        const int row0 = u.pm * 256 + wr * 64 + fr, col0 = u.pn * 256 + wc * 32 + 8 * fq;
#pragma unroll
        for (int ai = 0; ai < 2; ++ai)
#pragma unroll
            for (int m = 0; m < 4; ++m) { const int r = row0 + ai * 128 + m * 16; const size_t ro = (size_t)r * 1024 + col0; float ss = 0.f;
#pragma unroll
                for (int bj = 0; bj < 2; ++bj) { const size_t o = ro + bj * 128;
                    const pf4 x0 = *(const pf4*)(x + o), x1 = *(const pf4*)(x + o + 4);
                    const pf4 v0 = acc[ai][bj][m][0] + x0, v1 = acc[ai][bj][m][1] + x1;
                    *(pf4*)(h1 + o) = v0; *(pf4*)(h1 + o + 4) = v1;
                    u32x4 w; w.x = pk2(v0[0], v0[1]); w.y = pk2(v0[2], v0[3]); w.z = pk2(v1[0], v1[1]); w.w = pk2(v1[2], v1[3]);
                    *(u32x4*)(h1b + o) = w;
                    ss += (v0[0] * v0[0] + v0[1] * v0[1]) + (v0[2] * v0[2] + v0[3] * v0[3]) + (v1[0] * v1[0] + v1[1] * v1[1]) + (v1[2] * v1[2] + v1[3] * v1[3]); }
                ss += __shfl_xor(ss, 16); ss += __shfl_xor(ss, 32);
                if (fq == 0) atomicAdd(rowss + r, ss); }
    }
};
struct EpiScores {
    static constexpr bool PERM = true, AFTER_DRAIN = false;
    const float* rowss; float* sc;
    __device__ __forceinline__ void operator()(const pf4 (&acc)[2][2][4][2], const pg8::Unit& u, int wr, int wc, int fr, int fq) const {
        const int row0 = u.pm * 256 + wr * 64 + fr, col0 = u.pn * 256 + wc * 32 + 8 * fq;
#pragma unroll
        for (int ai = 0; ai < 2; ++ai)
#pragma unroll
            for (int m = 0; m < 4; ++m) { const int r = row0 + ai * 128 + m * 16; const float rs = rsqrtf(rowss[r] * (1.f / DM) + EPSF); float* rp = sc + (size_t)r * 2048 + col0;
#pragma unroll
                for (int bj = 0; bj < 2; ++bj) { *(pf4*)(rp + bj * 128) = acc[ai][bj][m][0] * rs; *(pf4*)(rp + bj * 128 + 4) = acc[ai][bj][m][1] * rs; } }
    }
};

__device__ __forceinline__ void load8(const bf16_t* p, float (&f)[8]) { const u32x4 w = *(const u32x4*)p;
    f[0] = bflo(w.x); f[1] = bfhi(w.x); f[2] = bflo(w.y); f[3] = bfhi(w.y); f[4] = bflo(w.z); f[5] = bfhi(w.z); f[6] = bflo(w.w); f[7] = bfhi(w.w); }
__device__ __forceinline__ void short_conv8(const bf16_t* hb, const float* cw, const float* cb, int s, int ch, float (&o)[8]) {
    float xm[8], x0[8], xp[8];
    if (s >= 1) load8(hb + (size_t)(s - 1) * 1536 + ch, xm); else {
#pragma unroll
        for (int i = 0; i < 8; ++i) xm[i] = 0.f; }
    load8(hb + (size_t)s * 1536 + ch, x0);
    if (s + 1 < LT) load8(hb + (size_t)(s + 1) * 1536 + ch, xp); else {
#pragma unroll
        for (int i = 0; i < 8; ++i) xp[i] = 0.f; }
#pragma unroll
    for (int i = 0; i < 8; ++i) o[i] = xm[i] * cw[ch + i] + x0[i] * cw[1536 + ch + i] + xp[i] * cw[3072 + ch + i] + cb[ch + i];
}
__device__ __forceinline__ void phase_hy_pre(const Args& a, LAS unsigned char* lds, int tid) {
    LAS bf16_t* tl = (LAS bf16_t*)lds;
    const bf16_t* hyin = (const bf16_t*)(a.ws + WS_HYIN); bf16_t* uut = (bf16_t*)(a.ws + WS_UUT);
    const float* cw = a.in[I_HYCW]; const float* cb = a.in[I_HYCB];
    for (int it = blockIdx.x; it < NB * 67 * 8; it += gridDim.x) {
        const int ct = it & 7, ts = (it >> 3) % 67, b = (it >> 3) / 67;
        { const int sr = tid >> 3, cg = tid & 7, c0 = ct * 64 + cg * 8, sp = ts * 64 + sr, s = sp - 16;
            float uu[8];
            if (s >= 0 && s < LT) { float x1[8], v[8]; const bf16_t* hb = hyin + (size_t)b * LT * 1536;
                short_conv8(hb, cw, cb, s, 512 + c0, x1); short_conv8(hb, cw, cb, s, 1024 + c0, v);
#pragma unroll
                for (int i = 0; i < 8; ++i) uu[i] = v[i] * x1[i]; }
            else {
#pragma unroll
                for (int i = 0; i < 8; ++i) uu[i] = 0.f; }
#pragma unroll
            for (int i = 0; i < 8; ++i) tl[sr * 72 + cg * 8 + i] = (bf16_t)f2bf(uu[i]); }
        __syncthreads();
        { const int cl = tid >> 3, sg = tid & 7, sp0 = ts * 64 + sg * 8;
            if (sp0 < SP) { u32x4 w; unsigned h[8];
#pragma unroll
                for (int i = 0; i < 8; ++i) h[i] = tl[(sg * 8 + i) * 72 + cl];
                w.x = h[0] | (h[1] << 16); w.y = h[2] | (h[3] << 16); w.z = h[4] | (h[5] << 16); w.w = h[6] | (h[7] << 16);
                *(u32x4*)(uut + ((size_t)(ct * 64 + cl) * NB + b) * SP + sp0) = w; } }
        __syncthreads();
    }
}
__device__ __forceinline__ void phase_hy_conv_naive(const Args& a, LAS unsigned char* lds, int tid) {
    LAS bf16_t* uus = (LAS bf16_t*)lds;
    LAS float* filt = (LAS float*)(lds + LT * 16);
    const bf16_t* uut = (const bf16_t*)(a.ws + WS_UUT); const float* kf = (const float*)(a.ws + WS_KF); bf16_t* cvt = (bf16_t*)(a.ws + WS_CONVT);
    for (int c = blockIdx.x; c < DHY; c += gridDim.x) {
        for (int i = tid; i < NB * LT; i += NTHR) { const int b = i / LT, s = i - b * LT; uus[s * 8 + b] = uut[((size_t)c * NB + b) * SP + 16 + s]; }
        for (int i = tid; i < KFW; i += NTHR) filt[i] = kf[(size_t)c * KFW + i];
        __syncthreads();
        for (int tt = 0; tt < 8; ++tt) { const int tq = tt * 512 + tid, t = tq + 16; float acc[8];
#pragma unroll
            for (int b = 0; b < 8; ++b) acc[b] = 0.f;
            const LAS float* fp = filt + (LT - 1) + t;
            for (int s = 0; s < LT; ++s) { const float kv = fp[-s]; const u32x4 w = *(const LAS u32x4*)(uus + s * 8);
                acc[0] += kv * bflo(w.x); acc[1] += kv * bfhi(w.x); acc[2] += kv * bflo(w.y); acc[3] += kv * bfhi(w.y);
                acc[4] += kv * bflo(w.z); acc[5] += kv * bfhi(w.z); acc[6] += kv * bflo(w.w); acc[7] += kv * bfhi(w.w); }
#pragma unroll
            for (int b = 0; b < 8; ++b) cvt[((size_t)c * NB + b) * SEQ + tq] = (bf16_t)f2bf(acc[b]); }
        __syncthreads();
    }
}
__device__ __forceinline__ void phase_rg_naive(const Args& a, LAS unsigned char* lds, int tid) {
    LAS float* xc = (LAS float*)lds;
    LAS float* gbuf = xc + 32 * 128;
    const bf16_t* rgx = (const bf16_t*)(a.ws + WS_RGX);
    for (int it = blockIdx.x; it < NB * 2 * 8; it += gridDim.x) {
        const int head = it & 7, dir = (it >> 3) & 1, b = it >> 4;
        const float* cw = a.in[I_RGCW] + (size_t)dir * 4 * DRG + head * 128; const float* cb = a.in[I_RGCB] + (size_t)dir * DRG + head * 128;
        bf16_t* hout = (bf16_t*)a.out + (size_t)dir * T * DRG;
        const bf16_t* xb = rgx + (size_t)b * LT * DRG + head * 128;
        float h = 0.f, sp = 0.f;
        if (tid < 128) { const float lam = a.in[I_RGLAM][dir * DRG + head * 128 + tid]; sp = log1pf(__expf(-lam)); }
        for (int k = 0; k < 129; ++k) {
            { const int tok = tid >> 4, cg = tid & 15, u = 32 * k + tok; float o[8];
#pragma unroll
                for (int i = 0; i < 8; ++i) o[i] = (u < LT) ? cb[cg * 8 + i] : 0.f;
                if (u < LT) {
#pragma unroll
                    for (int j = 0; j < 4; ++j) { const int uu = u - j; if (uu >= 0) { const int t = dir ? (LT - 1 - uu) : uu; float xv[8]; load8(xb + (size_t)t * DRG + cg * 8, xv);
#pragma unroll
                            for (int i = 0; i < 8; ++i) o[i] += xv[i] * cw[j * DRG + cg * 8 + i]; } } }
#pragma unroll
                for (int i = 0; i < 8; ++i) xc[tok * 128 + cg * 8 + i] = o[i]; }
            __syncthreads();
            { const int j = tid & 127, g = (tid >> 7) & 1, th = tid >> 8; float acc[16];
#pragma unroll
                for (int q = 0; q < 16; ++q) acc[q] = 0.f;
                const float* gw = a.in[I_RGGW] + ((size_t)((dir * 2 + g) * 8 + head) * 128) * 128 + j;
                for (int i = 0; i < 128; ++i) { const float wv = gw[i * 128];
#pragma unroll
                    for (int q = 0; q < 16; ++q) acc[q] += xc[(th * 16 + q) * 128 + i] * wv; }
                const float gb = a.in[I_RGGB][(size_t)(dir * 2 + g) * DRG + head * 128 + j];
#pragma unroll
                for (int q = 0; q < 16; ++q) gbuf[(g * 32 + th * 16 + q) * 128 + j] = acc[q] + gb; }
            __syncthreads();
            if (tid < 128) {
                for (int tok = 0; tok < 32; ++tok) { const int u = 32 * k + tok; if (u >= LT) break;
                    const float r = sigmoidf_(gbuf[tok * 128 + tid]), ig = sigmoidf_(gbuf[(32 + tok) * 128 + tid]);
                    const float la = -8.0f * r * sp; const float av = __expf(la); const float mult = (u == 0) ? 1.0f : sqrtf(-expm1f(2.0f * la));
                    h = av * h + mult * ig * xc[tok * 128 + tid];
                    const int t = dir ? (LT - 1 - u) : u;
                    if (t >= NMETA) hout[((size_t)b * SEQ + (t - NMETA)) * DRG + head * 128 + tid] = (bf16_t)f2bf(h); } }
            __syncthreads();
        }
    }
}
__device__ __forceinline__ void phase_post(const Args& a, LAS unsigned char* lds, int tid) {
    LAS bf16_t* cv = (LAS bf16_t*)lds;
    const bf16_t* hyin = (const bf16_t*)(a.ws + WS_HYIN); const bf16_t* cvt = (const bf16_t*)(a.ws + WS_CONVT); bf16_t* yh = (bf16_t*)(a.ws + WS_YH);
    const float* cw = a.in[I_HYCW]; const float* cb = a.in[I_HYCB]; const float* skip = a.in[I_HYSKIP];
    for (int it = blockIdx.x; it < NB * 64 * 8; it += gridDim.x) {
        const int ct = it & 7, tt = (it >> 3) & 63, b = it >> 9;
        { const int cl = tid >> 3, tg = tid & 7; const u32x4 w = *(const u32x4*)(cvt + ((size_t)(ct * 64 + cl) * NB + b) * SEQ + tt * 64 + tg * 8);
            *(LAS u32x4*)(cv + cl * 72 + tg * 8) = w; }
        __syncthreads();
        { const int tr = tid >> 3, cg = tid & 7, c0 = ct * 64 + cg * 8, t = NMETA + tt * 64 + tr; const bf16_t* hb = hyin + (size_t)b * LT * 1536;
            float x0[8], x1[8], v[8]; short_conv8(hb, cw, cb, t, c0, x0); short_conv8(hb, cw, cb, t, 512 + c0, x1); short_conv8(hb, cw, cb, t, 1024 + c0, v);
            float y[8];
#pragma unroll
            for (int i = 0; i < 8; ++i) { const float cvv = bf2f(cv[(cg * 8 + i) * 72 + tr]); y[i] = (cvv + v[i] * x1[i] * skip[c0 + i]) * x0[i]; }
            u32x4 w; w.x = pk2(y[0], y[1]); w.y = pk2(y[2], y[3]); w.z = pk2(y[4], y[5]); w.w = pk2(y[6], y[7]);
            *(u32x4*)(yh + ((size_t)b * SEQ + tt * 64 + tr) * DHY + c0) = w; }
        __syncthreads();
    }
    const bf16_t* hf = (const bf16_t*)a.out; const bf16_t* hb2 = hf + (size_t)T * DRG; const bf16_t* gg = (const bf16_t*)(a.ws + WS_GG); bf16_t* yr = (bf16_t*)(a.ws + WS_YR);
    for (size_t i = (size_t)blockIdx.x * NTHR + tid; i < (size_t)T * DRG / 8; i += (size_t)gridDim.x * NTHR) {
        float f[8], g[8], q[8]; load8(hf + i * 8, f); load8(hb2 + i * 8, g); load8(gg + i * 8, q);
        u32x4 w; w.x = pk2((f[0] + g[0]) * q[0], (f[1] + g[1]) * q[1]); w.y = pk2((f[2] + g[2]) * q[2], (f[3] + g[3]) * q[3]);
        w.z = pk2((f[4] + g[4]) * q[4], (f[5] + g[5]) * q[5]); w.w = pk2((f[6] + g[6]) * q[6], (f[7] + g[7]) * q[7]);
        *(u32x4*)(yr + i * 8) = w; }
}
__device__ __forceinline__ void phase_tables(const Args& a, int wave, int lane) {
    const int gw = blockIdx.x * NWAVES + wave, NGW = gridDim.x * NWAVES;
    const float* gf = a.in[I_GFFN]; bf16_t* ub = (bf16_t*)(a.ws + WS_UB); bf16_t* vb = (bf16_t*)(a.ws + WS_VB);
    const f32x4 g0 = *(const f32x4*)(gf + 8 * lane), g1 = *(const f32x4*)(gf + 8 * lane + 4), g2 = *(const f32x4*)(gf + 512 + 8 * lane), g3 = *(const f32x4*)(gf + 512 + 8 * lane + 4);
    for (int e = gw; e < NEXP; e += NGW) {
        const float* ur = a.in[I_PU] + (size_t)e * DM; const float* vr = a.in[I_PV] + (size_t)e * DM;
        f32x4 u0 = *(const f32x4*)(ur + 8 * lane) * g0, u1 = *(const f32x4*)(ur + 8 * lane + 4) * g1, u2 = *(const f32x4*)(ur + 512 + 8 * lane) * g2, u3 = *(const f32x4*)(ur + 512 + 8 * lane + 4) * g3;
        f32x4 v0 = *(const f32x4*)(vr + 8 * lane), v1 = *(const f32x4*)(vr + 8 * lane + 4), v2 = *(const f32x4*)(vr + 512 + 8 * lane), v3 = *(const f32x4*)(vr + 512 + 8 * lane + 4);
        u32x4 w;
        w.x = pk2(u0[0], u0[1]); w.y = pk2(u0[2], u0[3]); w.z = pk2(u1[0], u1[1]); w.w = pk2(u1[2], u1[3]); *(u32x4*)(ub + (size_t)e * DM + 8 * lane) = w;
        w.x = pk2(u2[0], u2[1]); w.y = pk2(u2[2], u2[3]); w.z = pk2(u3[0], u3[1]); w.w = pk2(u3[2], u3[3]); *(u32x4*)(ub + (size_t)e * DM + 512 + 8 * lane) = w;
        w.x = pk2(v0[0], v0[1]); w.y = pk2(v0[2], v0[3]); w.z = pk2(v1[0], v1[1]); w.w = pk2(v1[2], v1[3]); *(u32x4*)(vb + (size_t)e * DM + 8 * lane) = w;
        w.x = pk2(v2[0], v2[1]); w.y = pk2(v2[2], v2[3]); w.z = pk2(v3[0], v3[1]); w.w = pk2(v3[2], v3[3]); *(u32x4*)(vb + (size_t)e * DM + 512 + 8 * lane) = w;
    }
}
__device__ __forceinline__ void wave_top16_2(float a, float b, int lane, float& tv, int& ti) {
    tv = 0.f; ti = 0;
    for (int r = 0; r < 16; ++r) {
        const float v = fmaxf(a, b); const float mx = wave_max(v);
        const unsigned long long bal = __ballot(v == mx); const int src = __ffsll((long long)bal) - 1;
        int idl = 0;
        if (lane == src) { if (a == mx) { idl = lane; a = -INFINITY; } else { idl = lane + 64; b = -INFINITY; } }
        const int idx = __shfl(idl, src);
        if (lane == r) { tv = mx; ti = idx; }
    }
}
__device__ __forceinline__ void phase_topk(const Args& a, int wave, int lane) {
    const int gw = blockIdx.x * NWAVES + wave, NGW = gridDim.x * NWAVES;
    const float* sc = (const float*)(a.ws + WS_SCORES); int* eidx = (int*)(a.ws + WS_EIDX); float* eg = (float*)(a.ws + WS_EG);
    for (int it = gw; it < T * 8; it += NGW) { const int m = it >> 3, hh = it & 7;
        const float* sp = sc + (size_t)m * 2048 + hh * 256;
        float tv0, tv1; int ti0, ti1;
        wave_top16_2(sp[lane], sp[64 + lane], lane, tv0, ti0);
        wave_top16_2(sp[128 + lane], sp[192 + lane], lane, tv1, ti1);
        float cd[4]; const float ci_ = __shfl(tv0, lane >> 2);
#pragma unroll
        for (int q = 0; q < 4; ++q) cd[q] = ci_ + __shfl(tv1, (lane & 3) * 4 + q);
        float cs = 0.f; int ci = 0;
        for (int r = 0; r < 16; ++r) {
            const float v = fmaxf(fmaxf(cd[0], cd[1]), fmaxf(cd[2], cd[3])); const float mx = wave_max(v);
            const unsigned long long bal = __ballot(v == mx); const int src = __ffsll((long long)bal) - 1;
            int idl = 0;
            if (lane == src) { if (cd[0] == mx) { idl = lane * 4; cd[0] = -INFINITY; } else if (cd[1] == mx) { idl = lane * 4 + 1; cd[1] = -INFINITY; }
                else if (cd[2] == mx) { idl = lane * 4 + 2; cd[2] = -INFINITY; } else { idl = lane * 4 + 3; cd[3] = -INFINITY; } }
            const int idx = __shfl(idl, src);
            if (lane == r) { cs = mx; ci = idx; }
        }
        const int e1 = __shfl(ti0, ci >> 4), e2 = __shfl(ti1, ci & 15);
        const float m0 = __shfl(cs, 0);
        const float ex = (lane < 16) ? __expf(cs - m0) : 0.f;
        const float sum = wave_sum(ex);
        if (lane < 16) { eidx[(size_t)m * 128 + hh * 16 + lane] = e1 * 128 + e2; eg[(size_t)m * 128 + hh * 16 + lane] = ex / sum; }
    }
}
__device__ __forceinline__ void unpack8(const u32x4 w, float (&f)[8]) {
    f[0] = bflo(w.x); f[1] = bfhi(w.x); f[2] = bflo(w.y); f[3] = bfhi(w.y); f[4] = bflo(w.z); f[5] = bfhi(w.z); f[6] = bflo(w.w); f[7] = bfhi(w.w); }
__device__ __forceinline__ void phase_peer(const Args& a, int wave, int lane) {
    const int gw = blockIdx.x * NWAVES + wave, NGW = gridDim.x * NWAVES;
    const bf16_t* h1b = (const bf16_t*)(a.ws + WS_H1B); const bf16_t* ub = (const bf16_t*)(a.ws + WS_UB); const bf16_t* vb = (const bf16_t*)(a.ws + WS_VB);
    const int* eidx = (const int*)(a.ws + WS_EIDX); const float* eg = (const float*)(a.ws + WS_EG); const float* rowss = (const float*)(a.ws + WS_ROWSS);
    const float* gfin = a.in[I_GFINAL];
    for (int m = gw; m < T; m += NGW) {
        float xa[8], xb[8]; load8(h1b + (size_t)m * DM + 8 * lane, xa); load8(h1b + (size_t)m * DM + 512 + 8 * lane, xb);
        const float rstd = rsqrtf(rowss[m] * (1.f / DM) + EPSF);
        const int ev0 = eidx[(size_t)m * 128 + lane], ev1 = eidx[(size_t)m * 128 + 64 + lane];
        const float gv0 = eg[(size_t)m * 128 + lane], gv1 = eg[(size_t)m * 128 + 64 + lane];
        float oa[8], ob[8];
#pragma unroll
        for (int i = 0; i < 8; ++i) { oa[i] = 0.f; ob[i] = 0.f; }
        for (int k0 = 0; k0 < 128; k0 += 8) {
            int e[8]; float g[8]; u32x4 ua[8], ubb[8];
#pragma unroll
            for (int q = 0; q < 8; ++q) { const int k = k0 + q; e[q] = __shfl(k < 64 ? ev0 : ev1, k & 63); g[q] = __shfl(k < 64 ? gv0 : gv1, k & 63);
                ua[q] = *(const u32x4*)(ub + (size_t)e[q] * DM + 8 * lane); ubb[q] = *(const u32x4*)(ub + (size_t)e[q] * DM + 512 + 8 * lane); }
            float d[8];
#pragma unroll
            for (int q = 0; q < 8; ++q) { float fa[8], fb[8]; unpack8(ua[q], fa); unpack8(ubb[q], fb); float s = 0.f;
#pragma unroll
                for (int i = 0; i < 8; ++i) s += fa[i] * xa[i] + fb[i] * xb[i];
                d[q] = s; }
#pragma unroll
            for (int q = 0; q < 8; ++q) d[q] = wave_sum(d[q]);
            u32x4 va[8], vbb[8];
#pragma unroll
            for (int q = 0; q < 8; ++q) { va[q] = *(const u32x4*)(vb + (size_t)e[q] * DM + 8 * lane); vbb[q] = *(const u32x4*)(vb + (size_t)e[q] * DM + 512 + 8 * lane); }
#pragma unroll
            for (int q = 0; q < 8; ++q) { const float act = gelu_tanh(d[q] * rstd) * g[q]; float fa[8], fb[8]; unpack8(va[q], fa); unpack8(vbb[q], fb);
#pragma unroll
                for (int i = 0; i < 8; ++i) { oa[i] += act * fa[i]; ob[i] += act * fb[i]; } }
        }
        float* orow = a.out + (size_t)m * DM;
        f32x4 h0 = *(const f32x4*)(orow + 8 * lane), h1 = *(const f32x4*)(orow + 8 * lane + 4), h2 = *(const f32x4*)(orow + 512 + 8 * lane), h3 = *(const f32x4*)(orow + 512 + 8 * lane + 4);
        h0 += (f32x4){oa[0], oa[1], oa[2], oa[3]}; h1 += (f32x4){oa[4], oa[5], oa[6], oa[7]}; h2 += (f32x4){ob[0], ob[1], ob[2], ob[3]}; h3 += (f32x4){ob[4], ob[5], ob[6], ob[7]};
        float ss = (h0.x * h0.x + h0.y * h0.y) + (h0.z * h0.z + h0.w * h0.w) + (h1.x * h1.x + h1.y * h1.y) + (h1.z * h1.z + h1.w * h1.w)
                 + (h2.x * h2.x + h2.y * h2.y) + (h2.z * h2.z + h2.w * h2.w) + (h3.x * h3.x + h3.y * h3.y) + (h3.z * h3.z + h3.w * h3.w);
        const float r2 = rsqrtf(wave_sum(ss) * (1.f / DM) + EPSF);
        const f32x4 q0 = *(const f32x4*)(gfin + 8 * lane), q1 = *(const f32x4*)(gfin + 8 * lane + 4), q2 = *(const f32x4*)(gfin + 512 + 8 * lane), q3 = *(const f32x4*)(gfin + 512 + 8 * lane + 4);
        *(f32x4*)(orow + 8 * lane) = h0 * r2 * q0; *(f32x4*)(orow + 8 * lane + 4) = h1 * r2 * q1; *(f32x4*)(orow + 512 + 8 * lane) = h2 * r2 * q2; *(f32x4*)(orow + 512 + 8 * lane + 4) = h3 * r2 * q3;
    }
}

#ifndef ONE_LAUNCH
#define ONE_LAUNCH 0
#endif
constexpr int NPHASE = 10;
__global__ void __launch_bounds__(NTHR, 2) mega(Args a) {
    extern __shared__ __attribute__((aligned(16))) unsigned char lds_raw[];
    LAS unsigned char* lds = (LAS unsigned char*)lds_raw;
    const int tid = threadIdx.x, lane = tid & 63, wave = __builtin_amdgcn_readfirstlane(tid >> 6);
    cg::grid_group grid = cg::this_grid();
    const int lo = a.ph_lo, hi = a.ph_hi, G = gridDim.x, bx = blockIdx.x;
#ifndef PHMASK
#define PHMASK 0x3ff
#endif
#define IN(k) (((PHMASK >> (k)) & 1) && lo <= (k) && (k) < hi)
#define SEAM(k) do { if (IN(k) && IN((k) + 1)) grid.sync(); } while (0)
    unsigned char* ws = a.ws;
    if (IN(0)) phase_p0(a, lds, tid, wave, lane);
    SEAM(0);
    if (IN(1)) {
        pg8::Gemm g{(const bf16_t*)(ws + WS_XN1), (const bf16_t*)(ws + WS_WINT), T, DIN, 1024}; pg8::StaticOrder S; S.init(T, DIN, G, bx);
        EpiProj E{(bf16_t*)(ws + WS_HYIN), (bf16_t*)(ws + WS_RGX), (bf16_t*)(ws + WS_GG), (bf16_t*)(ws + WS_GA), (bf16_t*)(ws + WS_GB), a.in[I_BGATE]};
        pg8::gemm_phase<EpiProj, pg8::StaticOrder>(lds, g, S, E, nullptr);
    }
    SEAM(1);
    if (IN(2)) phase_hy_pre(a, lds, tid);
    SEAM(2);
    if (IN(3)) { phase_hy_conv_naive(a, lds, tid); phase_rg_naive(a, lds, tid); }
    SEAM(3);
    if (IN(4)) phase_post(a, lds, tid);
    SEAM(4);
    if (IN(5)) {
        { pg8::Gemm g{(const bf16_t*)(ws + WS_YH), (const bf16_t*)(ws + WS_WHT), T, 1024, 512}; pg8::StaticOrder S; S.init(T, 1024, G, bx);
          EpiGate<0> E{(const bf16_t*)(ws + WS_GA), nullptr, (bf16_t*)(ws + WS_TMP)};
          pg8::gemm_phase<EpiGate<0>, pg8::StaticOrder>(lds, g, S, E, nullptr); }
        { pg8::Gemm g{(const bf16_t*)(ws + WS_YR), (const bf16_t*)(ws + WS_WRT), T, 1024, 1024}; pg8::StaticOrder S; S.init(T, 1024, G, bx);
          EpiGate<1> E{(const bf16_t*)(ws + WS_GB), (const bf16_t*)(ws + WS_TMP), (bf16_t*)(ws + WS_MERGED)};
          pg8::gemm_phase<EpiGate<1>, pg8::StaticOrder>(lds, g, S, E, nullptr); }
    }
    SEAM(5);
    if (IN(6)) {
        pg8::Gemm g{(const bf16_t*)(ws + WS_MERGED), (const bf16_t*)(ws + WS_WOT), T, 1024, 1024}; pg8::StaticOrder S; S.init(T, 1024, G, bx);
        EpiResid E{a.in[I_X], a.out, (bf16_t*)(ws + WS_H1B), (float*)(ws + WS_ROWSS)};
        pg8::gemm_phase<EpiResid, pg8::StaticOrder>(lds, g, S, E, nullptr);
    }
    SEAM(6);
    if (IN(7)) {
        phase_tables(a, wave, lane);
        pg8::Gemm g{(const bf16_t*)(ws + WS_H1B), (const bf16_t*)(ws + WS_WST), T, 2048, 1024}; pg8::StaticOrder S; S.init(T, 2048, G, bx);
        EpiScores E{(const float*)(ws + WS_ROWSS), (float*)(ws + WS_SCORES)};
        pg8::gemm_phase<EpiScores, pg8::StaticOrder>(lds, g, S, E, nullptr);
    }
    SEAM(7);
    if (IN(8)) phase_topk(a, wave, lane);
    SEAM(8);
    if (IN(9)) phase_peer(a, wave, lane);
#undef IN
#undef SEAM
}

extern "C" void kernel_launch(void* const* d_in, const int* in_sizes, int n_in, void* d_out, int out_size, void* d_ws, size_t ws_size, hipStream_t stream) {
    static int grid = 0;
    if (grid == 0) {
        if (n_in != N_IN || out_size != T * DM || ws_size < WS_END) { fprintf(stderr, "kernel_launch: unexpected shapes (n_in %d out %d ws %zu)\n", n_in, out_size, ws_size); grid = -1; return; }
        if (hipFuncSetAttribute((const void*)mega, hipFuncAttributeMaxDynamicSharedMemorySize, LDS_BYTES) != hipSuccess) { fprintf(stderr, "kernel_launch: hipFuncSetAttribute failed\n"); grid = -1; return; }
        int dev = 0, cus = 0, per_cu = 0;
        hipGetDevice(&dev); hipDeviceGetAttribute(&cus, hipDeviceAttributeMultiprocessorCount, dev);
        hipOccupancyMaxActiveBlocksPerMultiprocessor(&per_cu, (const void*)mega, NTHR, LDS_BYTES);
        if (per_cu < 1) { fprintf(stderr, "kernel_launch: occupancy query says %d blocks per CU\n", per_cu); per_cu = 1; }
        (void)hipGetLastError();
        grid = cus;
    }
    if (grid < 0) return;
    Args a{};
    for (int i = 0; i < N_IN; ++i) a.in[i] = (const float*)d_in[i];
    a.out = (float*)d_out; a.ws = (unsigned char*)d_ws;
#if ONE_LAUNCH
    a.ph_lo = 0; a.ph_hi = NPHASE;
    void* args[] = {&a};
    hipError_t e = hipLaunchCooperativeKernel((const void*)mega, dim3(grid), dim3(NTHR), args, LDS_BYTES, stream);
    if (e != hipSuccess) fprintf(stderr, "cooperative launch failed: %s (grid %d)\n", hipGetErrorString(e), grid);
#else
    for (int ph = 0; ph < NPHASE; ++ph) { a.ph_lo = ph; a.ph_hi = ph + 1;
        hipLaunchKernelGGL(mega, dim3(grid), dim3(NTHR), LDS_BYTES, stream, a);
        hipError_t e = hipPeekAtLastError(); if (e != hipSuccess) { fprintf(stderr, "launch %d failed: %s\n", ph, hipGetErrorString(e)); break; } }
#endif
}
```

```cpp
#define ONE_LAUNCH 1
#include <hip/hip_runtime.h>
#include <hip/hip_cooperative_groups.h>
#include <cstdio>
#include <cstdint>
#include <cmath>
namespace cg = cooperative_groups;
namespace pg8 {
#define PG8_LAS __attribute__((address_space(3)))
typedef unsigned short bf16_t;
typedef short bf16x8 __attribute__((ext_vector_type(8)));
typedef float f32x4 __attribute__((ext_vector_type(4)));
typedef unsigned u32x4 __attribute__((ext_vector_type(4)));
constexpr int BM = 256, BK = 64, HALF = 128, HTB = HALF * BK * 2  , STAGE_BYTES = 8 * HTB, NXCD = 8, WGM = 8;

__host__ __device__ __forceinline__ int lds_byte(int r, int c) { const int st = (r >> 4) * 2 + (c >> 5), rr = r & 15, cc = c & 31, ob = rr * 64 + cc * 2; return st * 1024 + (ob ^ (((ob >> 9) & 1) << 5)); }
__host__ __device__ __forceinline__ void stage_rc(int b, int& R, int& C) { const int st = b / 1024, sb = b % 1024, swz = sb ^ (((sb >> 9) & 1) << 5); R = (st >> 1) * 16 + swz / 64; C = (st & 1) * 32 + (swz % 64) / 2; }
__host__ __device__ __forceinline__ int perm32(int rho) { const int n = rho >> 4, i = rho & 15; return 8 * (i >> 2) + 4 * n + (i & 3); }

struct Unit { int pm, pn; };
struct Gemm { const bf16_t* A; const bf16_t* Bt; int M, N, K; };

struct StaticOrder {
    int nM, nN, nwg, G, c;
    __host__ __device__ void init(int M, int N, int G_, int c_) { nM = M / BM; nN = N / BM; nwg = nM * nN; G = G_; c = c_; }
    __host__ __device__ bool next(int i, Unit& u) const {
        const long L = (long)i * G + c; if (L >= nwg) return false;
        int wgid = (int)L; { const int q = nwg / NXCD, r = nwg % NXCD, xcd = wgid % NXCD, off = wgid / NXCD; wgid = (xcd < r ? xcd * (q + 1) : r * (q + 1) + (xcd - r) * q) + off; }
        const int nig = WGM * nN, gid = wgid / nig, fm = gid * WGM, gsz = (nM - fm) < WGM ? (nM - fm) : WGM;
        u.pm = fm + ((wgid % nig) % gsz); u.pn = (wgid % nig) / gsz; return true;
    }
    __device__ __forceinline__ void a_ready(const Unit&) const {}
    __device__ __forceinline__ void done(const Unit&) const {}
};
__device__ __forceinline__ unsigned cvt_pk_bf16(float lo, float hi) { unsigned r; asm volatile("v_cvt_pk_bf16_f32 %0, %1, %2" : "=v"(r) : "v"(lo), "v"(hi)); return r; }
typedef float f32x2 __attribute__((ext_vector_type(2)));
__device__ __forceinline__ f32x2 gelu_pk(f32x2 v) {
    const f32x2 av = __builtin_elementwise_abs(v), d = av * 0.2316418882f + 1.0f;
    f32x2 t; t.x = __builtin_amdgcn_rcpf(d.x); t.y = __builtin_amdgcn_rcpf(d.y);
    f32x2 q = t * 0.5307027145f + (-0.7265760135f); q = q * t + 0.7107068705f; q = q * t + (-0.142248368f); q = q * t + 0.127414796f; q = q * t;
    const f32x2 s = (v * v) * (-0.72134752044f);
    f32x2 e; e.x = __builtin_amdgcn_exp2f(s.x); e.y = __builtin_amdgcn_exp2f(s.y);
    const f32x2 m = v * (q * e), r = v - m;
    f32x2 o; o.x = v.x < 0.f ? m.x : r.x; o.y = v.y < 0.f ? m.y : r.y; return o;
}
template <class Epi, class Sched, bool STAMP = false>
__device__ __forceinline__ void gemm_phase(PG8_LAS unsigned char* lds, const Gemm g, const Sched& S, const Epi& E, unsigned long long* stamps) {
    const int tid = threadIdx.x, wid = __builtin_amdgcn_readfirstlane(tid >> 6), lane = tid & 63, wr = wid >> 2, wc = wid & 3, fr = lane & 15, fq = lane >> 4;
    const int K = g.K, nt = K / BK;
    int ts_lo = 0, ts_hi = 0, nts = 0; const unsigned long long rt_entry = STAMP ? (unsigned long long)wall_clock64() : 0ull;
#define PG8_STAMP() do { if (STAMP && wid == 0 && nts < 64) { const unsigned long long _c = (unsigned long long)clock64(); \
        ts_lo = (lane == nts) ? (int)(unsigned)_c : ts_lo; ts_hi = (lane == nts) ? (int)(unsigned)(_c >> 32) : ts_hi; ++nts; } } while (0)
    PG8_STAMP();
    unsigned voffA[2], voffB[2];
#pragma unroll
    for (int i = 0; i < 2; ++i) { int R, C; stage_rc(tid * 16 + i * 8192, R, C); const int Rb = Epi::PERM ? ((R & ~31) + perm32(R & 31)) : R;
        voffA[i] = (unsigned)(R * K + C) * 2u; voffB[i] = (unsigned)(Rb * K + C) * 2u; }
    const size_t kstep = (size_t)(BK * 2);
    const size_t hstep = (size_t)HALF * K * 2;
    const size_t tstep = 2 * hstep;
    const unsigned ldsw = (unsigned)wid * 1024u;
    const int aoff = lds_byte(wr * 64 + fr, fq * 8), boff = lds_byte(wc * 32 + fr, fq * 8);
#define PG8_SA(b, h) (((b) * 2 + (h)) * HTB)
#define PG8_SB(b, h) ((4 + (b) * 2 + (h)) * HTB)
#define PG8_STAGE(bufoff, gbase, voff) do { _Pragma("unroll") for (int _i = 0; _i < 2; ++_i) \
        __builtin_amdgcn_global_load_lds((const unsigned*)((const char*)(gbase) + (voff)[_i]), (PG8_LAS unsigned*)(lds + (bufoff) + ldsw + _i * 8192), 16, 0, 0); } while (0)
#define PG8_LDA(dst, b, h) do { _Pragma("unroll") for (int m = 0; m < 4; ++m) _Pragma("unroll") for (int k = 0; k < 2; ++k) dst[m][k] = *(const PG8_LAS bf16x8*)(lds + PG8_SA(b, h) + aoff + m * 2048 + k * 1024); } while (0)
#define PG8_LDB(dst, b, h) do { _Pragma("unroll") for (int n = 0; n < 2; ++n) _Pragma("unroll") for (int k = 0; k < 2; ++k) dst[n][k] = *(const PG8_LAS bf16x8*)(lds + PG8_SB(b, h) + boff + n * 2048 + k * 1024); } while (0)
#define PG8_MMA(ai, bj, At, Bt) do { __builtin_amdgcn_s_setprio(1); _Pragma("unroll") for (int m = 0; m < 4; ++m) _Pragma("unroll") for (int n = 0; n < 2; ++n) _Pragma("unroll") for (int k = 0; k < 2; ++k) \
        acc[ai][bj][m][n] = __builtin_amdgcn_mfma_f32_16x16x32_bf16(Bt[n][k], At[m][k], acc[ai][bj][m][n], 0, 0, 0); __builtin_amdgcn_s_setprio(0); } while (0)
#define PG8_WAIT_V(n) asm volatile("s_waitcnt vmcnt(" #n ")" ::: "memory")
#define PG8_WAIT_L(n) asm volatile("s_waitcnt lgkmcnt(" #n ")" ::: "memory")
#define PG8_BAR __builtin_amdgcn_s_barrier()
#define PG8_SCHED __builtin_amdgcn_sched_barrier(0)
    Unit cur, nxt; int ui = 0;
    if (!S.next(0, cur)) return;
    f32x4 acc[2][2][4][2];
#pragma unroll
    for (int a = 0; a < 2; ++a)
#pragma unroll
        for (int b = 0; b < 2; ++b)
#pragma unroll
            for (int m = 0; m < 4; ++m)
#pragma unroll
                for (int n = 0; n < 2; ++n) acc[a][b][m][n] = (f32x4){0.f, 0.f, 0.f, 0.f};
    bf16x8 At[4][2], B0[2][2], B1[2][2];
    const char* cA = (const char*)g.A + (size_t)cur.pm * tstep; const char* cB = (const char*)g.Bt + (size_t)cur.pn * tstep;
    S.a_ready(cur);
    PG8_STAGE(PG8_SB(0, 0), cB, voffB); PG8_STAGE(PG8_SA(0, 0), cA, voffA); PG8_STAGE(PG8_SB(0, 1), cB + hstep, voffB); PG8_STAGE(PG8_SA(0, 1), cA + hstep, voffA);
    if (wr == 1) PG8_BAR;
    PG8_WAIT_V(4); PG8_BAR;
    PG8_STAGE(PG8_SB(1, 0), cB + kstep, voffB); PG8_STAGE(PG8_SA(1, 0), cA + kstep, voffA); PG8_STAGE(PG8_SB(1, 1), cB + hstep + kstep, voffB);
    PG8_WAIT_V(6); PG8_BAR;
    PG8_STAMP();
    for (;;) {
        const bool has_next = S.next(ui + 1, nxt);
        const char* nA = has_next ? (const char*)g.A + (size_t)nxt.pm * tstep : cA; const char* nB = has_next ? (const char*)g.Bt + (size_t)nxt.pn * tstep : cB;
        for (int t = 0; t < nt; t += 2) {
            const bool last = (t == nt - 2);
            const char* a1 = cA + (size_t)(t + 1) * kstep;
            const char* a2 = last ? nA : cA + (size_t)(t + 2) * kstep; const char* b2 = last ? nB : cB + (size_t)(t + 2) * kstep;
            const char* a3 = a2 + kstep; const char* b3 = b2 + kstep;
            if (last && has_next) S.a_ready(nxt);
            PG8_LDB(B0, 0, 0); PG8_SCHED; PG8_LDA(At, 0, 0); PG8_STAGE(PG8_SA(1, 1), a1 + hstep, voffA);
            PG8_WAIT_L(8); PG8_BAR; PG8_WAIT_L(0); PG8_MMA(0, 0, At, B0); PG8_BAR; PG8_SCHED;
            PG8_LDB(B1, 0, 1); PG8_STAGE(PG8_SB(0, 0), b2, voffB);
            PG8_BAR; PG8_WAIT_L(0); PG8_MMA(0, 1, At, B1); PG8_BAR;
            PG8_LDA(At, 0, 1); PG8_STAGE(PG8_SA(0, 0), a2, voffA);
            PG8_BAR; PG8_WAIT_L(0); PG8_MMA(1, 0, At, B0); PG8_BAR; PG8_SCHED;
            PG8_STAGE(PG8_SB(0, 1), b2 + hstep, voffB);
            PG8_WAIT_V(6); PG8_BAR; PG8_MMA(1, 1, At, B1); PG8_BAR;
            PG8_LDB(B0, 1, 0); PG8_SCHED; PG8_LDA(At, 1, 0); PG8_STAGE(PG8_SA(0, 1), a2 + hstep, voffA);
            PG8_WAIT_L(8); PG8_BAR; PG8_WAIT_L(0); PG8_MMA(0, 0, At, B0); PG8_BAR; PG8_SCHED;
            PG8_LDB(B1, 1, 1); PG8_STAGE(PG8_SB(1, 0), b3, voffB);
            PG8_BAR; PG8_WAIT_L(0); PG8_MMA(0, 1, At, B1); PG8_BAR;
            PG8_LDA(At, 1, 1); PG8_STAGE(PG8_SA(1, 0), a3, voffA);
            PG8_BAR; PG8_WAIT_L(0); PG8_MMA(1, 0, At, B0); PG8_BAR; PG8_SCHED;
            PG8_STAGE(PG8_SB(1, 1), b3 + hstep, voffB);
            PG8_WAIT_V(6); PG8_BAR; PG8_MMA(1, 1, At, B1); PG8_BAR;
        }
        PG8_STAMP();
        if constexpr (!Epi::AFTER_DRAIN) { E(acc, cur, wr, wc, fr, fq); S.done(cur); }
        PG8_STAMP();
        if (!has_next) break;
#pragma unroll
        for (int a = 0; a < 2; ++a)
#pragma unroll
            for (int b = 0; b < 2; ++b)
#pragma unroll
                for (int m = 0; m < 4; ++m)
#pragma unroll
                    for (int n = 0; n < 2; ++n) acc[a][b][m][n] = (f32x4){0.f, 0.f, 0.f, 0.f};
        cur = nxt; cA = nA; cB = nB; ++ui;
    }
    PG8_WAIT_V(0);
    if (wr == 0) PG8_BAR;
    PG8_BAR;
    if constexpr (Epi::AFTER_DRAIN) { E.fused(acc, cur, wr, wc, fr, fq, lds, wid, lane); S.done(cur); }
    PG8_STAMP();
    if (STAMP && wid == 0) { stamps[lane] = lane < nts ? (((unsigned long long)(unsigned)ts_hi << 32) | (unsigned)ts_lo) : 0ull;
        if (lane == 62) stamps[62] = rt_entry; if (lane == 63) stamps[63] = (unsigned long long)wall_clock64(); }
#undef PG8_STAMP
#undef PG8_SA
#undef PG8_SB
#undef PG8_STAGE
#undef PG8_LDA
#undef PG8_LDB
#undef PG8_MMA
#undef PG8_WAIT_V
#undef PG8_WAIT_L
#undef PG8_BAR
#undef PG8_SCHED
}
}

#define LAS __attribute__((address_space(3)))
typedef unsigned short bf16_t;
typedef float f32x4 __attribute__((ext_vector_type(4)));
typedef float f32x2 __attribute__((ext_vector_type(2)));
typedef unsigned u32x4 __attribute__((ext_vector_type(4)));
typedef unsigned u32x2 __attribute__((ext_vector_type(2)));

constexpr int NB = 8, SEQ = 4096, NMETA = 16, LT = SEQ + NMETA, DM = 1024, T = NB * SEQ;
constexpr int DHY = 512, DRG = 1024, DIN = 3 * DHY + 2 * DRG + 2 * DM;
constexpr int NTHR = 512, NWAVES = 8;
constexpr int LDS_BYTES = 160 * 1024;
constexpr float EPSF = 1e-6f;
constexpr int KFW = 2 * LT;
constexpr int SP = 4256;
constexpr int NEXP = 16384;

enum { I_X = 0, I_META, I_GFINAL, I_GMIX, I_WIN, I_BGATE, I_HYCW, I_HYCB, I_HYW1, I_HYB1, I_HYW2, I_HYB2, I_HYW3, I_HYB3, I_HYFREQ, I_HYSKIP,
       I_HYOUT, I_RGCW, I_RGCB, I_RGGW, I_RGGB, I_RGLAM, I_RGOUT, I_WOUT, I_GFFN, I_WQ, I_KEYS, I_PU, I_PV, N_IN };

constexpr size_t MiB = 1024ull * 1024ull;
constexpr size_t WS_ROWSS = 64 * 1024;
constexpr size_t WS_WINT = 1 * MiB;
constexpr size_t WS_WHT = 12 * MiB;
constexpr size_t WS_WRT = 13 * MiB;
constexpr size_t WS_WOT = 15 * MiB;
constexpr size_t WS_WST = 17 * MiB;
constexpr size_t WS_GWT = 21 * MiB;
constexpr size_t WS_KF = 22 * MiB;
constexpr size_t WS_KFB = 39 * MiB;
constexpr size_t WS_HYIN = 48 * MiB;
constexpr size_t WS_RGX = 145 * MiB;
constexpr size_t WS_GG = 210 * MiB;
constexpr size_t WS_GA = 274 * MiB;
constexpr size_t WS_GB = 338 * MiB;
constexpr size_t WS_XN1 = 402 * MiB;
constexpr size_t WS_UUT = 402 * MiB;
constexpr size_t WS_CONVT = 436 * MiB;
constexpr size_t WS_YH = 468 * MiB;
constexpr size_t WS_YR = WS_RGX;
constexpr size_t WS_MERGED = WS_HYIN;
constexpr size_t WS_TMP = WS_GG;
constexpr size_t WS_H1B = WS_RGX;
constexpr size_t WS_SCORES = WS_GG;
constexpr size_t WS_EIDX = 468 * MiB;
constexpr size_t WS_EG = 484 * MiB;
constexpr size_t WS_UB = 48 * MiB;
constexpr size_t WS_VB = 80 * MiB;
constexpr size_t WS_END = 500 * MiB;

struct Args { const float* in[N_IN]; float* out; unsigned char* ws; int ph_lo, ph_hi; };

__device__ __forceinline__ float bf2f(unsigned v) { return __uint_as_float(v << 16); }
__device__ __forceinline__ unsigned f2bf(float f) { unsigned u = __float_as_uint(f); return (u + 0x7fffu + ((u >> 16) & 1u)) >> 16; }
__device__ __forceinline__ unsigned pk2(float lo, float hi) { return f2bf(lo) | (f2bf(hi) << 16); }
__device__ __forceinline__ float bflo(unsigned w) { return __uint_as_float(w << 16); }
__device__ __forceinline__ float bfhi(unsigned w) { return __uint_as_float(w & 0xffff0000u); }
__device__ __forceinline__ float wave_sum(float v) {
#pragma unroll
    for (int o = 1; o < 64; o <<= 1) v += __shfl_xor(v, o);
    return v;
}
__device__ __forceinline__ float wave_max(float v) {
#pragma unroll
    for (int o = 1; o < 64; o <<= 1) v = fmaxf(v, __shfl_xor(v, o));
    return v;
}
__device__ __forceinline__ float sigmoidf_(float x) { return __builtin_amdgcn_rcpf(1.0f + __expf(-x)); }
__device__ __forceinline__ float gelu_tanh(float x) { const float u = 1.5957691216f * (x + 0.044715f * x * x * x); return x * __builtin_amdgcn_rcpf(1.0f + __expf(-u)); }
__device__ __forceinline__ void sincos_acc(float a, float& s, float& c) {
    const double x = (double)a;
    const double q = rint(x * 0.63661977236758134308);
    const double r = fma(-q, 1.57079632679489661923, x);
    const int n = (int)q;
    const float rf = (float)r, r2 = rf * rf;
    const float sp = rf * (1.f + r2 * (-1.6666667e-1f + r2 * (8.3333333e-3f + r2 * (-1.9841270e-4f + r2 * 2.7557319e-6f))));
    const float cp = 1.f + r2 * (-0.5f + r2 * (4.1666667e-2f + r2 * (-1.3888889e-3f + r2 * (2.4801587e-5f + r2 * (-2.7557319e-7f)))));
    const int k = n & 3;
    s = (k == 0) ? sp : (k == 1) ? cp : (k == 2) ? -sp : -cp;
    c = (k == 0) ? cp : (k == 1) ? -sp : (k == 2) ? -cp : sp;
}

__device__ __forceinline__ void p0_transpose_item(const float* W, int K, int N, bf16_t* WT, LAS float* scr, int item, int lane) {
    const int nblk = N / 32, kb = item / nblk, nb = item % nblk, k0 = 64 * kb, n0 = 32 * nb;
#pragma unroll 8
    for (int i = 0; i < 32; ++i) { const int kk = 2 * i + (lane >> 5); scr[kk * 33 + (lane & 31)] = W[(size_t)(k0 + kk) * N + n0 + (lane & 31)]; }
    asm volatile("s_waitcnt lgkmcnt(0)" ::: "memory");
    const int c = lane & 7;
#pragma unroll
    for (int j = 0; j < 4; ++j) { const int n = (lane >> 3) + 8 * j; const LAS float* s = scr + (8 * c) * 33 + n;
        u32x4 o; o.x = pk2(s[0 * 33], s[1 * 33]); o.y = pk2(s[2 * 33], s[3 * 33]); o.z = pk2(s[4 * 33], s[5 * 33]); o.w = pk2(s[6 * 33], s[7 * 33]);
        *(u32x4*)(WT + (size_t)(n0 + n) * K + k0 + 8 * c) = o; }
    asm volatile("s_waitcnt lgkmcnt(0)" ::: "memory");
}
__device__ __forceinline__ void p0_xn1_row(const float* xrow, const float* g, bf16_t* orow, int lane) {
    const f32x4* xr = (const f32x4*)xrow + lane; const f32x4* gr = (const f32x4*)g + lane;
    f32x4 v[4]; float s = 0.f;
#pragma unroll
    for (int j = 0; j < 4; ++j) { v[j] = xr[64 * j]; s += (v[j].x * v[j].x + v[j].y * v[j].y) + (v[j].z * v[j].z + v[j].w * v[j].w); }
    const float rstd = rsqrtf(wave_sum(s) * (1.f / DM) + EPSF);
    unsigned long long* o8 = (unsigned long long*)orow + lane;
#pragma unroll
    for (int j = 0; j < 4; ++j) { const f32x4 gv = gr[64 * j];
        o8[64 * j] = (unsigned long long)pk2(v[j].x * rstd * gv.x, v[j].y * rstd * gv.y) | ((unsigned long long)pk2(v[j].z * rstd * gv.z, v[j].w * rstd * gv.w) << 32); }
}
__device__ __forceinline__ void p0_fold_item(const Args& a, LAS unsigned char* lds, int item, int tid) {
    const int hp = item >> 4, k0 = (item & 15) * 64;
    LAS float* kl = (LAS float*)lds;
    LAS float* wl = (LAS float*)(lds + 128 * 129 * 4);
    const float* keys = a.in[I_KEYS] + (size_t)hp * 128 * 128; const float* wq = a.in[I_WQ];
    for (int i = tid; i < 128 * 128; i += NTHR) { const int key = i >> 7, d = i & 127; kl[key * 129 + d] = keys[i]; }
    for (int i = tid; i < 64 * 128; i += NTHR) { const int kk = i >> 7, d = i & 127; wl[i] = wq[(size_t)(k0 + kk) * 2048 + hp * 128 + d]; }
    __syncthreads();
    const int key = tid & 127, kq = tid >> 7;
    float acc[16];
#pragma unroll
    for (int i = 0; i < 16; ++i) acc[i] = 0.f;
#pragma unroll 2
    for (int d = 0; d < 128; ++d) { const float kv = kl[key * 129 + d];
#pragma unroll
        for (int i = 0; i < 16; ++i) acc[i] += wl[(kq * 16 + i) * 128 + d] * kv; }
    const float* gf = a.in[I_GFFN] + k0 + kq * 16;
    bf16_t* dst = (bf16_t*)(a.ws + WS_WST) + (size_t)(hp * 128 + key) * 1024 + k0 + kq * 16;
    u32x4 o0, o1;
    o0.x = pk2(acc[0] * gf[0], acc[1] * gf[1]); o0.y = pk2(acc[2] * gf[2], acc[3] * gf[3]); o0.z = pk2(acc[4] * gf[4], acc[5] * gf[5]); o0.w = pk2(acc[6] * gf[6], acc[7] * gf[7]);
    o1.x = pk2(acc[8] * gf[8], acc[9] * gf[9]); o1.y = pk2(acc[10] * gf[10], acc[11] * gf[11]); o1.z = pk2(acc[12] * gf[12], acc[13] * gf[13]); o1.w = pk2(acc[14] * gf[14], acc[15] * gf[15]);
    *(u32x4*)dst = o0; *(u32x4*)(dst + 8) = o1;
    __syncthreads();
}
__device__ __forceinline__ void p0_meta_item(const Args& a, LAS unsigned char* lds, int item, int tid, int wave, int lane) {
    LAS float* mt = (LAS float*)lds;
    for (int r = wave * 2; r < wave * 2 + 2; ++r) {
        const f32x4* xr = (const f32x4*)(a.in[I_META] + (size_t)r * DM) + lane; const f32x4* gr = (const f32x4*)a.in[I_GMIX] + lane;
        f32x4 v[4]; float s = 0.f;
#pragma unroll
        for (int j = 0; j < 4; ++j) { v[j] = xr[64 * j]; s += (v[j].x * v[j].x + v[j].y * v[j].y) + (v[j].z * v[j].z + v[j].w * v[j].w); }
        const float rstd = rsqrtf(wave_sum(s) * (1.f / DM) + EPSF);
#pragma unroll
        for (int j = 0; j < 4; ++j) { const f32x4 gv = gr[64 * j]; f32x4 o = v[j] * rstd * gv; *(LAS f32x4*)(mt + r * 1024 + 4 * (lane + 64 * j)) = o; }
    }
    __syncthreads();
    const int col = item * 256 + (tid & 255), rh = tid >> 8;
    float acc[8];
#pragma unroll
    for (int r = 0; r < 8; ++r) acc[r] = 0.f;
    const float* w = a.in[I_WIN] + col;
#pragma unroll 4
    for (int k = 0; k < 1024; ++k) { const float wv = w[(size_t)k * DIN];
#pragma unroll
        for (int r = 0; r < 8; ++r) acc[r] += mt[(rh * 8 + r) * 1024 + k] * wv; }
    bf16_t* hyin = (bf16_t*)(a.ws + WS_HYIN); bf16_t* rgx = (bf16_t*)(a.ws + WS_RGX);
#pragma unroll
    for (int r = 0; r < 8; ++r) { const int t = rh * 8 + r; const bf16_t v = (bf16_t)f2bf(acc[r]);
        for (int b = 0; b < NB; ++b) { if (col < 1536) hyin[((size_t)b * LT + t) * 1536 + col] = v; else rgx[((size_t)b * LT + t) * 1024 + (col - 1536)] = v; } }
    __syncthreads();
}
__device__ __forceinline__ void p0_filter_item(const Args& a, LAS unsigned char* lds, int item, int tid) {
    LAS float* z = (LAS float*)lds;
    LAS float* h1 = z + 16 * 33;
    LAS float* h2 = h1 + 16 * 64;
    LAS float* ko = h2 + 16 * 64;
    const int p0 = item * 16;
    for (int idx = tid; idx < 16 * 33; idx += NTHR) { const int pp = idx / 33, f = idx % 33, p = p0 + pp;
        float v;
        if (f == 0) v = (float)p * (1.0f / (float)(LT - 1));
        else { const int bi = (f - 1) & 15; const float band = 1e-4f + (float)bi * ((15.0f - 1e-4f) / 15.0f); const float w = (float)(6.283185307179586 / (double)LT) * (float)p;
            float s, c; sincos_acc(band * w, s, c); v = (f <= 16) ? c : -s; }
        z[idx] = v; }
    __syncthreads();
    const float* w1 = a.in[I_HYW1]; const float* b1 = a.in[I_HYB1]; const float* w2 = a.in[I_HYW2]; const float* b2 = a.in[I_HYB2];
    const float* w3 = a.in[I_HYW3]; const float* b3 = a.in[I_HYB3]; const float* fr = a.in[I_HYFREQ];
    for (int idx = tid; idx < 16 * 64; idx += NTHR) { const int pp = idx >> 6, j = idx & 63; float acc = b1[j];
#pragma unroll 3
        for (int f = 0; f < 33; ++f) acc += z[pp * 33 + f] * w1[f * 64 + j];
        float s, c; sincos_acc(fr[j] * acc, s, c); h1[idx] = s; }
    __syncthreads();
    for (int idx = tid; idx < 16 * 64; idx += NTHR) { const int pp = idx >> 6, j = idx & 63; float acc = b2[j];
#pragma unroll 4
        for (int f = 0; f < 64; ++f) acc += h1[pp * 64 + f] * w2[f * 64 + j];
        float s, c; sincos_acc(fr[64 + j] * acc, s, c); h2[idx] = s; }
    __syncthreads();
#pragma unroll 1
    for (int half = 0; half < 2; ++half) { const int o = half * 512 + tid;
        float acc[16];
#pragma unroll
        for (int pp = 0; pp < 16; ++pp) acc[pp] = b3[o];
#pragma unroll 2
        for (int i = 0; i < 64; ++i) { const float wv = w3[i * 1024 + o];
#pragma unroll
            for (int pp = 0; pp < 16; ++pp) acc[pp] += h2[pp * 64 + i] * wv; }
        const float delta = fabsf(-15.350567286626972f + (float)tid * ((-3.0701134573253945f + 15.350567286626972f) / 511.0f));
#pragma unroll
        for (int pp = 0; pp < 16; ++pp) { const float tn = (float)(p0 + pp) * (1.0f / (float)(LT - 1)); ko[o * 17 + pp] = acc[pp] * __expf(-tn * delta); }
    }
    __syncthreads();
    float* kf = (float*)(a.ws + WS_KF); bf16_t* kfb = (bf16_t*)(a.ws + WS_KFB);
    for (int idx = tid; idx < 1024 * 16; idx += NTHR) { const int o = idx >> 4, pp = idx & 15, dir = o >> 9, c = o & 511, p = p0 + pp;
        const float v = ko[o * 17 + pp];
        if (dir == 0) { kf[(size_t)c * KFW + (LT - 1) + p] = v; kfb[(size_t)c * KFW + (LT - 1) + p] = (bf16_t)f2bf(v); }
        else if (p >= 1) { kf[(size_t)c * KFW + (LT - 1) - p] = v; kfb[(size_t)c * KFW + (LT - 1) - p] = (bf16_t)f2bf(v); } }
    if (item == 0) for (int c = tid; c < 512; c += NTHR) { kf[(size_t)c * KFW + KFW - 1] = 0.f; kfb[(size_t)c * KFW + KFW - 1] = 0; }
    __syncthreads();
}
__device__ __forceinline__ void phase_p0(const Args& a, LAS unsigned char* lds, int tid, int wave, int lane) {
    const int G = gridDim.x, bx = blockIdx.x;
    { float* rs = (float*)(a.ws + WS_ROWSS); for (int i = bx * NTHR + tid; i < T; i += G * NTHR) rs[i] = 0.f; }
    for (int it = bx; it < 256 + 257 + 10; it += G) {
#ifndef P0M
#define P0M 7
#endif
        if (it < 256) { if (P0M & 1) p0_fold_item(a, lds, it, tid); }
        else if (it < 513) { if (P0M & 2) p0_filter_item(a, lds, it - 256, tid); }
        else { if (P0M & 4) p0_meta_item(a, lds, it - 513, tid, wave, lane); }
    }
    LAS float* scr = (LAS float*)(lds + wave * 16384);
    const int gw = bx * NWAVES + wave, NGW = G * NWAVES;
    constexpr int I_IN = (1024 / 64) * (DIN / 32), I_H = (512 / 64) * (1024 / 32), I_R = (1024 / 64) * (1024 / 32), I_O = I_R;
    for (int it = gw; it < I_IN + I_H + I_R + I_O; it += NGW) {
        int r = it;
        if (r < I_IN) { p0_transpose_item(a.in[I_WIN], 1024, DIN, (bf16_t*)(a.ws + WS_WINT), scr, r, lane); continue; } r -= I_IN;
        if (r < I_H) { p0_transpose_item(a.in[I_HYOUT], 512, 1024, (bf16_t*)(a.ws + WS_WHT), scr, r, lane); continue; } r -= I_H;
        if (r < I_R) { p0_transpose_item(a.in[I_RGOUT], 1024, 1024, (bf16_t*)(a.ws + WS_WRT), scr, r, lane); continue; } r -= I_R;
        p0_transpose_item(a.in[I_WOUT], 1024, 1024, (bf16_t*)(a.ws + WS_WOT), scr, r, lane);
    }
    for (int m = gw; m < T; m += NGW) p0_xn1_row(a.in[I_X] + (size_t)m * DM, a.in[I_GMIX], (bf16_t*)(a.ws + WS_XN1) + (size_t)m * DM, lane);
}

typedef pg8::f32x4 pf4;
struct EpiProj {
    static constexpr bool PERM = true, AFTER_DRAIN = false;
    bf16_t *hyin, *rgx, *gg, *ga, *gb; const float* bgate;
    __device__ __forceinline__ void operator()(const pf4 (&acc)[2][2][4][2], const pg8::Unit& u, int wr, int wc, int fr, int fq) const {
        const int pn = u.pn, row0 = u.pm * 256 + wr * 64 + fr, cl0 = wc * 32 + 8 * fq;
#pragma unroll
        for (int ai = 0; ai < 2; ++ai)
#pragma unroll
            for (int m = 0; m < 4; ++m) { const int r = row0 + ai * 128 + m * 16; const size_t rl = (size_t)(r >> 12) * LT + NMETA + (r & 4095);
#pragma unroll
                for (int bj = 0; bj < 2; ++bj) { const int col = pn * 256 + bj * 128 + cl0; pf4 v0 = acc[ai][bj][m][0], v1 = acc[ai][bj][m][1]; bf16_t* dst;
                    if (pn < 6) dst = hyin + rl * 1536 + col;
                    else if (pn < 10) dst = rgx + rl * 1024 + (col - 1536);
                    else if (pn < 14) { dst = gg + (size_t)r * 1024 + (col - 2560);
#pragma unroll
                        for (int j = 0; j < 4; ++j) { v0[j] = gelu_tanh(v0[j]); v1[j] = gelu_tanh(v1[j]); } }
                    else { const int gc = col - 3584;
                        dst = (gc < 1024 ? ga + (size_t)r * 1024 + gc : gb + (size_t)r * 1024 + (gc - 1024));
                        const pf4 b0 = *(const pf4*)(bgate + gc), b1 = *(const pf4*)(bgate + gc + 4);
#pragma unroll
                        for (int j = 0; j < 4; ++j) { v0[j] = sigmoidf_(v0[j] + b0[j]); v1[j] = sigmoidf_(v1[j] + b1[j]); } }
                    u32x4 w; w.x = pk2(v0[0], v0[1]); w.y = pk2(v0[2], v0[3]); w.z = pk2(v1[0], v1[1]); w.w = pk2(v1[2], v1[3]);
                    *(u32x4*)dst = w; } }
    }
};
template <int MODE  > struct EpiGate {
    static constexpr bool PERM = true, AFTER_DRAIN = false;
    const bf16_t* gate; const bf16_t* tin; bf16_t* outp;
    __device__ __forceinline__ void operator()(const pf4 (&acc)[2][2][4][2], const pg8::Unit& u, int wr, int wc, int fr, int fq) const {
        const int row0 = u.pm * 256 + wr * 64 + fr, col0 = u.pn * 256 + wc * 32 + 8 * fq;
#pragma unroll
        for (int ai = 0; ai < 2; ++ai)
#pragma unroll
            for (int m = 0; m < 4; ++m) { const size_t ro = (size_t)(row0 + ai * 128 + m * 16) * 1024 + col0;
#pragma unroll
                for (int bj = 0; bj < 2; ++bj) { const size_t o = ro + bj * 128; const pf4 v0 = acc[ai][bj][m][0], v1 = acc[ai][bj][m][1];
                    const u32x4 g = *(const u32x4*)(gate + o);
                    float r[8];
                    r[0] = v0[0] * bflo(g.x); r[1] = v0[1] * bfhi(g.x); r[2] = v0[2] * bflo(g.y); r[3] = v0[3] * bfhi(g.y);
                    r[4] = v1[0] * bflo(g.z); r[5] = v1[1] * bfhi(g.z); r[6] = v1[2] * bflo(g.w); r[7] = v1[3] * bfhi(g.w);
                    if (MODE == 1) { const u32x4 t = *(const u32x4*)(tin + o);
                        r[0] += bflo(t.x); r[1] += bfhi(t.x); r[2] += bflo(t.y); r[3] += bfhi(t.y); r[4] += bflo(t.z); r[5] += bfhi(t.z); r[6] += bflo(t.w); r[7] += bfhi(t.w); }
                    u32x4 w; w.x = pk2(r[0], r[1]); w.y = pk2(r[2], r[3]); w.z = pk2(r[4], r[5]); w.w = pk2(r[6], r[7]);
                    *(u32x4*)(outp + o) = w; } }
    }
};
struct EpiResid {
    static constexpr bool PERM = true, AFTER_DRAIN = false;
    const float* x; float* h1; bf16_t* h1b; float* rowss;
    __device__ __forceinline__ void operator()(const pf4 (&acc)[2][2][4][2], const pg8::Unit& u, int wr, int wc, int fr, int fq) const {
        const int row0 = u.pm * 256 + wr * 64 + fr, col0 = u.pn * 256 + wc * 32 + 8 * fq;
#pragma unroll
        for (int ai = 0; ai < 2; ++ai)
#pragma unroll
            for (int m = 0; m < 4; ++m) { const int r = row0 + ai * 128 + m * 16; const size_t ro = (size_t)r * 1024 + col0; float ss = 0.f;
#pragma unroll
                for (int bj = 0; bj < 2; ++bj) { const size_t o = ro + bj * 128;
                    const pf4 x0 = *(const pf4*)(x + o), x1 = *(const pf4*)(x + o + 4);
                    const pf4 v0 = acc[ai][bj][m][0] + x0, v1 = acc[ai][bj][m][1] + x1;
                    *(pf4*)(h1 + o) = v0; *(pf4*)(h1 + o + 4) = v1;
                    u32x4 w; w.x = pk2(v0[0], v0[1]); w.y = pk2(v0[2], v0[3]); w.z = pk2(v1[0], v1[1]); w.w = pk2(v1[2], v1[3]);
                    *(u32x4*)(h1b + o) = w;
                    ss += (v0[0] * v0[0] + v0[1] * v0[1]) + (v0[2] * v0[2] + v0[3] * v0[3]) + (v1[0] * v1[0] + v1[1] * v1[1]) + (v1[2] * v1[2] + v1[3] * v1[3]); }
                ss += __shfl_xor(ss, 16); ss += __shfl_xor(ss, 32);
                if (fq == 0) atomicAdd(rowss + r, ss); }
    }
};
struct EpiScores {
    static constexpr bool PERM = true, AFTER_DRAIN = false;
    const float* rowss; float* sc;
    __device__ __forceinline__ void operator()(const pf4 (&acc)[2][2][4][2], const pg8::Unit& u, int wr, int wc, int fr, int fq) const {
        const int row0 = u.pm * 256 + wr * 64 + fr, col0 = u.pn * 256 + wc * 32 + 8 * fq;
#pragma unroll
        for (int ai = 0; ai < 2; ++ai)
#pragma unroll
            for (int m = 0; m < 4; ++m) { const int r = row0 + ai * 128 + m * 16; const float rs = rsqrtf(rowss[r] * (1.f / DM) + EPSF); float* rp = sc + (size_t)r * 2048 + col0;
#pragma unroll
                for (int bj = 0; bj < 2; ++bj) { *(pf4*)(rp + bj * 128) = acc[ai][bj][m][0] * rs; *(pf4*)(rp + bj * 128 + 4) = acc[ai][bj][m][1] * rs; } }
    }
};

__device__ __forceinline__ void load8(const bf16_t* p, float (&f)[8]) { const u32x4 w = *(const u32x4*)p;
    f[0] = bflo(w.x); f[1] = bfhi(w.x); f[2] = bflo(w.y); f[3] = bfhi(w.y); f[4] = bflo(w.z); f[5] = bfhi(w.z); f[6] = bflo(w.w); f[7] = bfhi(w.w); }
__device__ __forceinline__ void short_conv8(const bf16_t* hb, const float* cw, const float* cb, int s, int ch, float (&o)[8]) {
    float xm[8], x0[8], xp[8];
    if (s >= 1) load8(hb + (size_t)(s - 1) * 1536 + ch, xm); else {
#pragma unroll
        for (int i = 0; i < 8; ++i) xm[i] = 0.f; }
    load8(hb + (size_t)s * 1536 + ch, x0);
    if (s + 1 < LT) load8(hb + (size_t)(s + 1) * 1536 + ch, xp); else {
#pragma unroll
        for (int i = 0; i < 8; ++i) xp[i] = 0.f; }
#pragma unroll
    for (int i = 0; i < 8; ++i) o[i] = xm[i] * cw[ch + i] + x0[i] * cw[1536 + ch + i] + xp[i] * cw[3072 + ch + i] + cb[ch + i];
}
__device__ __forceinline__ void phase_hy_pre(const Args& a, LAS unsigned char* lds, int tid) {
    LAS bf16_t* tl = (LAS bf16_t*)lds;
    const bf16_t* hyin = (const bf16_t*)(a.ws + WS_HYIN); bf16_t* uut = (bf16_t*)(a.ws + WS_UUT);
    const float* cw = a.in[I_HYCW]; const float* cb = a.in[I_HYCB];
    for (int it = blockIdx.x; it < NB * 67 * 8; it += gridDim.x) {
        const int ct = it & 7, ts = (it >> 3) % 67, b = (it >> 3) / 67;
        { const int sr = tid >> 3, cg = tid & 7, c0 = ct * 64 + cg * 8, sp = ts * 64 + sr, s = sp - 16;
            float uu[8];
            if (s >= 0 && s < LT) { float x1[8], v[8]; const bf16_t* hb = hyin + (size_t)b * LT * 1536;
                short_conv8(hb, cw, cb, s, 512 + c0, x1); short_conv8(hb, cw, cb, s, 1024 + c0, v);
#pragma unroll
                for (int i = 0; i < 8; ++i) uu[i] = v[i] * x1[i]; }
            else {
#pragma unroll
                for (int i = 0; i < 8; ++i) uu[i] = 0.f; }
#pragma unroll
            for (int i = 0; i < 8; ++i) tl[sr * 72 + cg * 8 + i] = (bf16_t)f2bf(uu[i]); }
        __syncthreads();
        { const int cl = tid >> 3, sg = tid & 7, sp0 = ts * 64 + sg * 8;
            if (sp0 < SP) { u32x4 w; unsigned h[8];
#pragma unroll
                for (int i = 0; i < 8; ++i) h[i] = tl[(sg * 8 + i) * 72 + cl];
                w.x = h[0] | (h[1] << 16); w.y = h[2] | (h[3] << 16); w.z = h[4] | (h[5] << 16); w.w = h[6] | (h[7] << 16);
                *(u32x4*)(uut + ((size_t)(ct * 64 + cl) * NB + b) * SP + sp0) = w; } }
        __syncthreads();
    }
}
__device__ __forceinline__ void phase_hy_conv_naive(const Args& a, LAS unsigned char* lds, int tid) {
    LAS bf16_t* uus = (LAS bf16_t*)lds;
    LAS float* filt = (LAS float*)(lds + LT * 16);
    const bf16_t* uut = (const bf16_t*)(a.ws + WS_UUT); const float* kf = (const float*)(a.ws + WS_KF); bf16_t* cvt = (bf16_t*)(a.ws + WS_CONVT);
    for (int c = blockIdx.x; c < DHY; c += gridDim.x) {
        for (int i = tid; i < NB * LT; i += NTHR) { const int b = i / LT, s = i - b * LT; uus[s * 8 + b] = uut[((size_t)c * NB + b) * SP + 16 + s]; }
        for (int i = tid; i < KFW; i += NTHR) filt[i] = kf[(size_t)c * KFW + i];
        __syncthreads();
        for (int tt = 0; tt < 8; ++tt) { const int tq = tt * 512 + tid, t = tq + 16; float acc[8];
#pragma unroll
            for (int b = 0; b < 8; ++b) acc[b] = 0.f;
            const LAS float* fp = filt + (LT - 1) + t;
            for (int s = 0; s < LT; ++s) { const float kv = fp[-s]; const u32x4 w = *(const LAS u32x4*)(uus + s * 8);
                acc[0] += kv * bflo(w.x); acc[1] += kv * bfhi(w.x); acc[2] += kv * bflo(w.y); acc[3] += kv * bfhi(w.y);
                acc[4] += kv * bflo(w.z); acc[5] += kv * bfhi(w.z); acc[6] += kv * bflo(w.w); acc[7] += kv * bfhi(w.w); }
#pragma unroll
            for (int b = 0; b < 8; ++b) cvt[((size_t)c * NB + b) * SEQ + tq] = (bf16_t)f2bf(acc[b]); }
        __syncthreads();
    }
}
__device__ __forceinline__ void phase_rg_naive(const Args& a, LAS unsigned char* lds, int tid) {
    LAS float* xc = (LAS float*)lds;
    LAS float* gbuf = xc + 32 * 128;
    const bf16_t* rgx = (const bf16_t*)(a.ws + WS_RGX);
    for (int it = blockIdx.x; it < NB * 2 * 8; it += gridDim.x) {
        const int head = it & 7, dir = (it >> 3) & 1, b = it >> 4;
        const float* cw = a.in[I_RGCW] + (size_t)dir * 4 * DRG + head * 128; const float* cb = a.in[I_RGCB] + (size_t)dir * DRG + head * 128;
        bf16_t* hout = (bf16_t*)a.out + (size_t)dir * T * DRG;
        const bf16_t* xb = rgx + (size_t)b * LT * DRG + head * 128;
        float h = 0.f, sp = 0.f;
        if (tid < 128) { const float lam = a.in[I_RGLAM][dir * DRG + head * 128 + tid]; sp = log1pf(__expf(-lam)); }
        for (int k = 0; k < 129; ++k) {
            { const int tok = tid >> 4, cg = tid & 15, u = 32 * k + tok; float o[8];
#pragma unroll
                for (int i = 0; i < 8; ++i) o[i] = (u < LT) ? cb[cg * 8 + i] : 0.f;
                if (u < LT) {
#pragma unroll
                    for (int j = 0; j < 4; ++j) { const int uu = u - j; if (uu >= 0) { const int t = dir ? (LT - 1 - uu) : uu; float xv[8]; load8(xb + (size_t)t * DRG + cg * 8, xv);
#pragma unroll
                            for (int i = 0; i < 8; ++i) o[i] += xv[i] * cw[j * DRG + cg * 8 + i]; } } }
#pragma unroll
                for (int i = 0; i < 8; ++i) xc[tok * 128 + cg * 8 + i] = o[i]; }
            __syncthreads();
            { const int j = tid & 127, g = (tid >> 7) & 1, th = tid >> 8; float acc[16];
#pragma unroll
                for (int q = 0; q < 16; ++q) acc[q] = 0.f;
                const float* gw = a.in[I_RGGW] + ((size_t)((dir * 2 + g) * 8 + head) * 128) * 128 + j;
                for (int i = 0; i < 128; ++i) { const float wv = gw[i * 128];
#pragma unroll
                    for (int q = 0; q < 16; ++q) acc[q] += xc[(th * 16 + q) * 128 + i] * wv; }
                const float gb = a.in[I_RGGB][(size_t)(dir * 2 + g) * DRG + head * 128 + j];
#pragma unroll
                for (int q = 0; q < 16; ++q) gbuf[(g * 32 + th * 16 + q) * 128 + j] = acc[q] + gb; }
            __syncthreads();
            if (tid < 128) {
                for (int tok = 0; tok < 32; ++tok) { const int u = 32 * k + tok; if (u >= LT) break;
                    const float r = sigmoidf_(gbuf[tok * 128 + tid]), ig = sigmoidf_(gbuf[(32 + tok) * 128 + tid]);
                    const float la = -8.0f * r * sp; const float av = __expf(la); const float mult = (u == 0) ? 1.0f : sqrtf(-expm1f(2.0f * la));
                    h = av * h + mult * ig * xc[tok * 128 + tid];
                    const int t = dir ? (LT - 1 - u) : u;
                    if (t >= NMETA) hout[((size_t)b * SEQ + (t - NMETA)) * DRG + head * 128 + tid] = (bf16_t)f2bf(h); } }
            __syncthreads();
        }
    }
}
__device__ __forceinline__ void phase_post(const Args& a, LAS unsigned char* lds, int tid) {
    LAS bf16_t* cv = (LAS bf16_t*)lds;
    const bf16_t* hyin = (const bf16_t*)(a.ws + WS_HYIN); const bf16_t* cvt = (const bf16_t*)(a.ws + WS_CONVT); bf16_t* yh = (bf16_t*)(a.ws + WS_YH);
    const float* cw = a.in[I_HYCW]; const float* cb = a.in[I_HYCB]; const float* skip = a.in[I_HYSKIP];
    for (int it = blockIdx.x; it < NB * 64 * 8; it += gridDim.x) {
        const int ct = it & 7, tt = (it >> 3) & 63, b = it >> 9;
        { const int cl = tid >> 3, tg = tid & 7; const u32x4 w = *(const u32x4*)(cvt + ((size_t)(ct * 64 + cl) * NB + b) * SEQ + tt * 64 + tg * 8);
            *(LAS u32x4*)(cv + cl * 72 + tg * 8) = w; }
        __syncthreads();
        { const int tr = tid >> 3, cg = tid & 7, c0 = ct * 64 + cg * 8, t = NMETA + tt * 64 + tr; const bf16_t* hb = hyin + (size_t)b * LT * 1536;
            float x0[8], x1[8], v[8]; short_conv8(hb, cw, cb, t, c0, x0); short_conv8(hb, cw, cb, t, 512 + c0, x1); short_conv8(hb, cw, cb, t, 1024 + c0, v);
            float y[8];
#pragma unroll
            for (int i = 0; i < 8; ++i) { const float cvv = bf2f(cv[(cg * 8 + i) * 72 + tr]); y[i] = (cvv + v[i] * x1[i] * skip[c0 + i]) * x0[i]; }
            u32x4 w; w.x = pk2(y[0], y[1]); w.y = pk2(y[2], y[3]); w.z = pk2(y[4], y[5]); w.w = pk2(y[6], y[7]);
            *(u32x4*)(yh + ((size_t)b * SEQ + tt * 64 + tr) * DHY + c0) = w; }
        __syncthreads();
    }
    const bf16_t* hf = (const bf16_t*)a.out; const bf16_t* hb2 = hf + (size_t)T * DRG; const bf16_t* gg = (const bf16_t*)(a.ws + WS_GG); bf16_t* yr = (bf16_t*)(a.ws + WS_YR);
    for (size_t i = (size_t)blockIdx.x * NTHR + tid; i < (size_t)T * DRG / 8; i += (size_t)gridDim.x * NTHR) {
        float f[8], g[8], q[8]; load8(hf + i * 8, f); load8(hb2 + i * 8, g); load8(gg + i * 8, q);
        u32x4 w; w.x = pk2((f[0] + g[0]) * q[0], (f[1] + g[1]) * q[1]); w.y = pk2((f[2] + g[2]) * q[2], (f[3] + g[3]) * q[3]);
        w.z = pk2((f[4] + g[4]) * q[4], (f[5] + g[5]) * q[5]); w.w = pk2((f[6] + g[6]) * q[6], (f[7] + g[7]) * q[7]);
        *(u32x4*)(yr + i * 8) = w; }
}
__device__ __forceinline__ void phase_tables(const Args& a, int wave, int lane) {
    const int gw = blockIdx.x * NWAVES + wave, NGW = gridDim.x * NWAVES;
    const float* gf = a.in[I_GFFN]; bf16_t* ub = (bf16_t*)(a.ws + WS_UB); bf16_t* vb = (bf16_t*)(a.ws + WS_VB);
    const f32x4 g0 = *(const f32x4*)(gf + 8 * lane), g1 = *(const f32x4*)(gf + 8 * lane + 4), g2 = *(const f32x4*)(gf + 512 + 8 * lane), g3 = *(const f32x4*)(gf + 512 + 8 * lane + 4);
    for (int e = gw; e < NEXP; e += NGW) {
        const float* ur = a.in[I_PU] + (size_t)e * DM; const float* vr = a.in[I_PV] + (size_t)e * DM;
        f32x4 u0 = *(const f32x4*)(ur + 8 * lane) * g0, u1 = *(const f32x4*)(ur + 8 * lane + 4) * g1, u2 = *(const f32x4*)(ur + 512 + 8 * lane) * g2, u3 = *(const f32x4*)(ur + 512 + 8 * lane + 4) * g3;
        f32x4 v0 = *(const f32x4*)(vr + 8 * lane), v1 = *(const f32x4*)(vr + 8 * lane + 4), v2 = *(const f32x4*)(vr + 512 + 8 * lane), v3 = *(const f32x4*)(vr + 512 + 8 * lane + 4);
        u32x4 w;
        w.x = pk2(u0[0], u0[1]); w.y = pk2(u0[2], u0[3]); w.z = pk2(u1[0], u1[1]); w.w = pk2(u1[2], u1[3]); *(u32x4*)(ub + (size_t)e * DM + 8 * lane) = w;
        w.x = pk2(u2[0], u2[1]); w.y = pk2(u2[2], u2[3]); w.z = pk2(u3[0], u3[1]); w.w = pk2(u3[2], u3[3]); *(u32x4*)(ub + (size_t)e * DM + 512 + 8 * lane) = w;
        w.x = pk2(v0[0], v0[1]); w.y = pk2(v0[2], v0[3]); w.z = pk2(v1[0], v1[1]); w.w = pk2(v1[2], v1[3]); *(u32x4*)(vb + (size_t)e * DM + 8 * lane) = w;
        w.x = pk2(v2[0], v2[1]); w.y = pk2(v2[2], v2[3]); w.z = pk2(v3[0], v3[1]); w.w = pk2(v3[2], v3[3]); *(u32x4*)(vb + (size_t)e * DM + 512 + 8 * lane) = w;
    }
}
__device__ __forceinline__ void wave_top16_2(float a, float b, int lane, float& tv, int& ti) {
    tv = 0.f; ti = 0;
    for (int r = 0; r < 16; ++r) {
        const float v = fmaxf(a, b); const float mx = wave_max(v);
        const unsigned long long bal = __ballot(v == mx); const int src = __ffsll((long long)bal) - 1;
        int idl = 0;
        if (lane == src) { if (a == mx) { idl = lane; a = -INFINITY; } else { idl = lane + 64; b = -INFINITY; } }
        const int idx = __shfl(idl, src);
        if (lane == r) { tv = mx; ti = idx; }
    }
}
__device__ __forceinline__ void phase_topk(const Args& a, int wave, int lane) {
    const int gw = blockIdx.x * NWAVES + wave, NGW = gridDim.x * NWAVES;
    const float* sc = (const float*)(a.ws + WS_SCORES); int* eidx = (int*)(a.ws + WS_EIDX); float* eg = (float*)(a.ws + WS_EG);
    for (int it = gw; it < T * 8; it += NGW) { const int m = it >> 3, hh = it & 7;
        const float* sp = sc + (size_t)m * 2048 + hh * 256;
        float tv0, tv1; int ti0, ti1;
        wave_top16_2(sp[lane], sp[64 + lane], lane, tv0, ti0);
        wave_top16_2(sp[128 + lane], sp[192 + lane], lane, tv1, ti1);
        float cd[4]; const float ci_ = __shfl(tv0, lane >> 2);
#pragma unroll
        for (int q = 0; q < 4; ++q) cd[q] = ci_ + __shfl(tv1, (lane & 3) * 4 + q);
        float cs = 0.f; int ci = 0;
        for (int r = 0; r < 16; ++r) {
            const float v = fmaxf(fmaxf(cd[0], cd[1]), fmaxf(cd[2], cd[3])); const float mx = wave_max(v);
            const unsigned long long bal = __ballot(v == mx); const int src = __ffsll((long long)bal) - 1;
            int idl = 0;
            if (lane == src) { if (cd[0] == mx) { idl = lane * 4; cd[0] = -INFINITY; } else if (cd[1] == mx) { idl = lane * 4 + 1; cd[1] = -INFINITY; }
                else if (cd[2] == mx) { idl = lane * 4 + 2; cd[2] = -INFINITY; } else { idl = lane * 4 + 3; cd[3] = -INFINITY; } }
            const int idx = __shfl(idl, src);
            if (lane == r) { cs = mx; ci = idx; }
        }
        const int e1 = __shfl(ti0, ci >> 4), e2 = __shfl(ti1, ci & 15);
        const float m0 = __shfl(cs, 0);
        const float ex = (lane < 16) ? __expf(cs - m0) : 0.f;
        const float sum = wave_sum(ex);
        if (lane < 16) { eidx[(size_t)m * 128 + hh * 16 + lane] = e1 * 128 + e2; eg[(size_t)m * 128 + hh * 16 + lane] = ex / sum; }
    }
}
__device__ __forceinline__ void unpack8(const u32x4 w, float (&f)[8]) {
    f[0] = bflo(w.x); f[1] = bfhi(w.x); f[2] = bflo(w.y); f[3] = bfhi(w.y); f[4] = bflo(w.z); f[5] = bfhi(w.z); f[6] = bflo(w.w); f[7] = bfhi(w.w); }
__device__ __forceinline__ void phase_peer(const Args& a, int wave, int lane) {
    const int gw = blockIdx.x * NWAVES + wave, NGW = gridDim.x * NWAVES;
    const bf16_t* h1b = (const bf16_t*)(a.ws + WS_H1B); const bf16_t* ub = (const bf16_t*)(a.ws + WS_UB); const bf16_t* vb = (const bf16_t*)(a.ws + WS_VB);
    const int* eidx = (const int*)(a.ws + WS_EIDX); const float* eg = (const float*)(a.ws + WS_EG); const float* rowss = (const float*)(a.ws + WS_ROWSS);
    const float* gfin = a.in[I_GFINAL];
    for (int m = gw; m < T; m += NGW) {
        float xa[8], xb[8]; load8(h1b + (size_t)m * DM + 8 * lane, xa); load8(h1b + (size_t)m * DM + 512 + 8 * lane, xb);
        const float rstd = rsqrtf(rowss[m] * (1.f / DM) + EPSF);
        const int ev0 = eidx[(size_t)m * 128 + lane], ev1 = eidx[(size_t)m * 128 + 64 + lane];
        const float gv0 = eg[(size_t)m * 128 + lane], gv1 = eg[(size_t)m * 128 + 64 + lane];
        float oa[8], ob[8];
#pragma unroll
        for (int i = 0; i < 8; ++i) { oa[i] = 0.f; ob[i] = 0.f; }
        for (int k0 = 0; k0 < 128; k0 += 8) {
            int e[8]; float g[8]; u32x4 ua[8], ubb[8];
#pragma unroll
            for (int q = 0; q < 8; ++q) { const int k = k0 + q; e[q] = __shfl(k < 64 ? ev0 : ev1, k & 63); g[q] = __shfl(k < 64 ? gv0 : gv1, k & 63);
                ua[q] = *(const u32x4*)(ub + (size_t)e[q] * DM + 8 * lane); ubb[q] = *(const u32x4*)(ub + (size_t)e[q] * DM + 512 + 8 * lane); }
            float d[8];
#pragma unroll
            for (int q = 0; q < 8; ++q) { float fa[8], fb[8]; unpack8(ua[q], fa); unpack8(ubb[q], fb); float s = 0.f;
#pragma unroll
                for (int i = 0; i < 8; ++i) s += fa[i] * xa[i] + fb[i] * xb[i];
                d[q] = s; }
#pragma unroll
            for (int q = 0; q < 8; ++q) d[q] = wave_sum(d[q]);
            u32x4 va[8], vbb[8];
#pragma unroll
            for (int q = 0; q < 8; ++q) { va[q] = *(const u32x4*)(vb + (size_t)e[q] * DM + 8 * lane); vbb[q] = *(const u32x4*)(vb + (size_t)e[q] * DM + 512 + 8 * lane); }
#pragma unroll
            for (int q = 0; q < 8; ++q) { const float act = gelu_tanh(d[q] * rstd) * g[q]; float fa[8], fb[8]; unpack8(va[q], fa); unpack8(vbb[q], fb);
#pragma unroll
                for (int i = 0; i < 8; ++i) { oa[i] += act * fa[i]; ob[i] += act * fb[i]; } }
        }
        float* orow = a.out + (size_t)m * DM;
        f32x4 h0 = *(const f32x4*)(orow + 8 * lane), h1 = *(const f32x4*)(orow + 8 * lane + 4), h2 = *(const f32x4*)(orow + 512 + 8 * lane), h3 = *(const f32x4*)(orow + 512 + 8 * lane + 4);
        h0 += (f32x4){oa[0], oa[1], oa[2], oa[3]}; h1 += (f32x4){oa[4], oa[5], oa[6], oa[7]}; h2 += (f32x4){ob[0], ob[1], ob[2], ob[3]}; h3 += (f32x4){ob[4], ob[5], ob[6], ob[7]};
        float ss = (h0.x * h0.x + h0.y * h0.y) + (h0.z * h0.z + h0.w * h0.w) + (h1.x * h1.x + h1.y * h1.y) + (h1.z * h1.z + h1.w * h1.w)
                 + (h2.x * h2.x + h2.y * h2.y) + (h2.z * h2.z + h2.w * h2.w) + (h3.x * h3.x + h3.y * h3.y) + (h3.z * h3.z + h3.w * h3.w);
        const float r2 = rsqrtf(wave_sum(ss) * (1.f / DM) + EPSF);
        const f32x4 q0 = *(const f32x4*)(gfin + 8 * lane), q1 = *(const f32x4*)(gfin + 8 * lane + 4), q2 = *(const f32x4*)(gfin + 512 + 8 * lane), q3 = *(const f32x4*)(gfin + 512 + 8 * lane + 4);
        *(f32x4*)(orow + 8 * lane) = h0 * r2 * q0; *(f32x4*)(orow + 8 * lane + 4) = h1 * r2 * q1; *(f32x4*)(orow + 512 + 8 * lane) = h2 * r2 * q2; *(f32x4*)(orow + 512 + 8 * lane + 4) = h3 * r2 * q3;
    }
}
typedef short bf16x8_t __attribute__((ext_vector_type(8)));
__device__ __forceinline__ bf16x8_t toep_frag(const LAS unsigned* R32, int base) {
    const int e = base >> 1, sh = (base & 1) * 16;
    const unsigned d0 = R32[e], d1 = R32[e + 1], d2 = R32[e + 2], d3 = R32[e + 3], d4 = R32[e + 4];
    u32x4 o; o.x = __builtin_amdgcn_alignbit(d1, d0, sh); o.y = __builtin_amdgcn_alignbit(d2, d1, sh); o.z = __builtin_amdgcn_alignbit(d3, d2, sh); o.w = __builtin_amdgcn_alignbit(d4, d3, sh);
    return __builtin_bit_cast(bf16x8_t, o);
}
__device__ __forceinline__ void hy_conv_channel(const Args& a, LAS unsigned char* lds, int c, int tid, int wave, int lane) {
    constexpr int UROW = SP * 2;
    LAS unsigned char* uus = lds;
    LAS unsigned short* R = (LAS unsigned short*)(lds + 8 * UROW);
    const bf16_t* uut = (const bf16_t*)(a.ws + WS_UUT); const bf16_t* kfb = (const bf16_t*)(a.ws + WS_KFB); bf16_t* cvt = (bf16_t*)(a.ws + WS_CONVT);
    { const u32x4* src = (const u32x4*)(uut + (size_t)c * NB * SP); for (int i = tid; i < 8 * UROW / 16; i += NTHR) ((LAS u32x4*)uus)[i] = src[i]; }
    for (int n = tid; n < KFW + 16; n += NTHR) R[n] = (n < KFW) ? kfb[(size_t)c * KFW + (KFW - 1) - n] : (unsigned short)0;
    __syncthreads();
    const LAS unsigned* R32 = (const LAS unsigned*)R;
    const int i = lane & 15, g = lane >> 4, p = (lane >> 3) & 1, b = lane & 7;
    f32x4 C[16]; bf16x8_t A[16];
    const int abase = LT - 32 * (1 + 16 * wave) - i + 8 * g;
#pragma unroll
    for (int tb = 0; tb < 16; ++tb) { C[tb] = (f32x4){0.f, 0.f, 0.f, 0.f}; A[tb] = toep_frag(R32, abase - 32 * tb); }
    const LAS unsigned char* bptr = uus + b * UROW + (16 * p + 8 * g) * 2;
#define HC_STEP(ph, n) do { A[(16 - (ph)) & 15] = toep_frag(R32, abase + 32 * (n)); const bf16x8_t Bf = *(const LAS bf16x8_t*)(bptr + (n) * 64); \
        _Pragma("unroll") for (int tb = 0; tb < 16; ++tb) C[tb] = __builtin_amdgcn_mfma_f32_16x16x32_bf16(A[(tb - (ph)) & 15], Bf, C[tb], 0, 0, 0); } while (0)
    for (int G = 0; G < 8; ++G) { const int n0 = G * 16;
        HC_STEP(0, n0); HC_STEP(1, n0 + 1); HC_STEP(2, n0 + 2); HC_STEP(3, n0 + 3); HC_STEP(4, n0 + 4); HC_STEP(5, n0 + 5); HC_STEP(6, n0 + 6); HC_STEP(7, n0 + 7);
        HC_STEP(8, n0 + 8); HC_STEP(9, n0 + 9); HC_STEP(10, n0 + 10); HC_STEP(11, n0 + 11); HC_STEP(12, n0 + 12); HC_STEP(13, n0 + 13); HC_STEP(14, n0 + 14); HC_STEP(15, n0 + 15); }
    HC_STEP(0, 128);
#undef HC_STEP
#pragma unroll
    for (int tb = 0; tb < 16; ++tb) { const int tq = 512 * wave + 32 * tb + 16 * p + 4 * g;
        u32x2 w; w.x = pk2(C[tb][0], C[tb][1]); w.y = pk2(C[tb][2], C[tb][3]);
        *(u32x2*)(cvt + ((size_t)c * NB + b) * SEQ + tq) = w; }
    __syncthreads();
}
__device__ __forceinline__ void rg_item(const Args& a, LAS unsigned char* lds, int it, int tid, int wave, int lane) {
    constexpr int XROW = 272;
    const int head = it & 7, dir = (it >> 3) & 1, b = it >> 4;
    const bf16_t* xb = (const bf16_t*)(a.ws + WS_RGX) + (size_t)b * LT * DRG + head * 128;
    bf16_t* hout = (bf16_t*)a.out + (size_t)dir * T * DRG + (size_t)b * SEQ * DRG + head * 128 + 16 * wave + (lane & 15);
    const int col = lane & 15, g = lane >> 4, ch = head * 128 + 16 * wave + col;
    LAS unsigned char* wl = lds + 2 * 64 * XROW + wave * 1024 + lane * 16;
#pragma unroll
    for (int gt = 0; gt < 2; ++gt)
#pragma unroll
        for (int ks = 0; ks < 4; ++ks) { const float* wp = a.in[I_RGGW] + ((size_t)((dir * 2 + gt) * 8 + head) * 128 + 32 * ks + 8 * g) * 128 + 16 * wave + col;
            u32x4 o; o.x = pk2(wp[0], wp[128]); o.y = pk2(wp[256], wp[384]); o.z = pk2(wp[512], wp[640]); o.w = pk2(wp[768], wp[896]); *(LAS u32x4*)(wl + (gt * 4 + ks) * 8192) = o; }
    const float br = a.in[I_RGGB][(size_t)(dir * 2 + 0) * DRG + ch], bi = a.in[I_RGGB][(size_t)(dir * 2 + 1) * DRG + ch];
    const float sp8 = -8.0f * log1pf(__expf(-a.in[I_RGLAM][dir * DRG + ch]));
    const int ctr = tid >> 4, ccg = tid & 15;
    float cwv[4][8], cbv[8];
#pragma unroll
    for (int i = 0; i < 8; ++i) { cbv[i] = a.in[I_RGCB][(size_t)dir * DRG + head * 128 + 8 * ccg + i];
#pragma unroll
        for (int j = 0; j < 4; ++j) cwv[j][i] = a.in[I_RGCW][((size_t)dir * 4 + j) * DRG + head * 128 + 8 * ccg + i]; }
    u32x4 xr[2][4];
#define RG_LOAD(k) do { _Pragma("unroll") for (int h_ = 0; h_ < 2; ++h_) { const int u_ = 64 * (k) + ctr + 32 * h_; _Pragma("unroll") for (int j = 0; j < 4; ++j) { const int uu_ = u_ - j; \
        if (uu_ >= 0 && uu_ < LT) { const int t_ = dir ? (LT - 1 - uu_) : uu_; xr[h_][j] = *(const u32x4*)(xb + (size_t)t_ * DRG + 8 * ccg); } \
        else xr[h_][j] = (u32x4){0u, 0u, 0u, 0u}; } } } while (0)
#define RG_CONV(k) do { _Pragma("unroll") for (int h_ = 0; h_ < 2; ++h_) { const int u_ = 64 * (k) + ctr + 32 * h_; float o_[8]; _Pragma("unroll") for (int i = 0; i < 8; ++i) o_[i] = (u_ < LT) ? cbv[i] : 0.f; \
        _Pragma("unroll") for (int j = 0; j < 4; ++j) { float f_[8]; unpack8(xr[h_][j], f_); _Pragma("unroll") for (int i = 0; i < 8; ++i) o_[i] += f_[i] * cwv[j][i]; } \
        u32x4 w0_; w0_.x = pk2(o_[0], o_[1]); w0_.y = pk2(o_[2], o_[3]); w0_.z = pk2(o_[4], o_[5]); w0_.w = pk2(o_[6], o_[7]); \
        *(LAS u32x4*)(lds + ((k) & 1) * (64 * XROW) + (ctr + 32 * h_) * XROW + ccg * 16) = w0_; } } while (0)
    RG_LOAD(0); RG_CONV(0); RG_LOAD(1);
    __syncthreads();
    float carry = 0.f;
    const int arow = 16 * (col >> 2) + (col & 3);
    for (int k = 0; k < 65; ++k) {
        if (k + 1 < 65) RG_CONV(k + 1);
        if (k + 2 < 65) RG_LOAD(k + 2);
        const LAS unsigned char* xa = lds + (k & 1) * (64 * XROW);
        unsigned hp[16]; float hh = 0.f, PP = 1.f;
#pragma unroll
        for (int mp = 0; mp < 2; ++mp) {
            f32x4 acc[2][2];
#pragma unroll
            for (int m2 = 0; m2 < 2; ++m2) { const int mb = 2 * mp + m2; acc[0][m2] = (f32x4){0.f, 0.f, 0.f, 0.f}; acc[1][m2] = (f32x4){0.f, 0.f, 0.f, 0.f};
#pragma unroll
                for (int ks = 0; ks < 4; ++ks) { const bf16x8_t Af = *(const LAS bf16x8_t*)(xa + (arow + 4 * mb) * XROW + (32 * ks + 8 * g) * 2);
                    acc[0][m2] = __builtin_amdgcn_mfma_f32_16x16x32_bf16(Af, *(const LAS bf16x8_t*)(wl + ks * 8192), acc[0][m2], 0, 0, 0);
                    acc[1][m2] = __builtin_amdgcn_mfma_f32_16x16x32_bf16(Af, *(const LAS bf16x8_t*)(wl + (4 + ks) * 8192), acc[1][m2], 0, 0, 0); } }
#pragma unroll
            for (int m2 = 0; m2 < 2; ++m2)
#pragma unroll
                for (int r = 0; r < 4; ++r) { const int e = 8 * mp + 4 * m2 + r, tau = 16 * g + e, u = 64 * k + tau;
                    const float rr = sigmoidf_(acc[0][m2][r] + br), ii = sigmoidf_(acc[1][m2][r] + bi);
                    float av = __expf(sp8 * rr); float mult = sqrtf(fmaxf(1.0f - av * av, 0.f)); mult = (u == 0) ? 1.0f : mult;
                    const float xcv = bf2f(*(const LAS unsigned short*)(xa + tau * XROW + (16 * wave + col) * 2));
                    float bq = mult * ii * xcv; if (u >= LT) { av = 1.f; bq = 0.f; }
                    hh = av * hh + bq; PP *= av; hp[e] = pk2(hh, PP); }
        }
        float Pg[4], hg[4];
#pragma unroll
        for (int q = 0; q < 4; ++q) { Pg[q] = __shfl(PP, col + 16 * q); hg[q] = __shfl(hh, col + 16 * q); }
        const float H0 = carry, H1 = Pg[0] * H0 + hg[0], H2 = Pg[1] * H1 + hg[1], H3 = Pg[2] * H2 + hg[2], H4 = Pg[3] * H3 + hg[3];
        const float Hin = (g == 0) ? H0 : (g == 1) ? H1 : (g == 2) ? H2 : H3;
        carry = H4;
#pragma unroll
        for (int e = 0; e < 16; ++e) { const int u = 64 * k + 16 * g + e; const int t = dir ? (LT - 1 - u) : u;
            if (u < LT && t >= NMETA) hout[(size_t)(t - NMETA) * DRG] = (bf16_t)f2bf(bflo(hp[e]) + bfhi(hp[e]) * Hin); }
        __syncthreads();
    }
#undef RG_LOAD
#undef RG_CONV
}

#ifndef RG_NAIVE
#define RG_NAIVE 0
#endif
#ifndef CONV_NAIVE
#define CONV_NAIVE 0
#endif
#ifndef ONE_LAUNCH
#define ONE_LAUNCH 0
#endif
constexpr int NPHASE = 10;
#ifndef NVGPR
#define NVGPR 248
#endif
__global__ void __launch_bounds__(NTHR, 2) __attribute__((amdgpu_num_vgpr(NVGPR))) mega(Args a) {
    extern __shared__ __attribute__((aligned(16))) unsigned char lds_raw[];
    LAS unsigned char* lds = (LAS unsigned char*)lds_raw;
    const int tid = threadIdx.x, lane = tid & 63, wave = __builtin_amdgcn_readfirstlane(tid >> 6);
    cg::grid_group grid = cg::this_grid();
    const int lo = a.ph_lo, hi = a.ph_hi, G = gridDim.x, bx = blockIdx.x;
#ifndef PHMASK
#define PHMASK 0x3ff
#endif
#ifndef REPMASK
#define REPMASK 0
#endif
#define IN(k) (((PHMASK >> (k)) & 1) && lo <= (k) && (k) < hi)
#define REP(k)
#define SEAM(k) do { if (IN(k) && IN((k) + 1)) grid.sync(); } while (0)
    unsigned char* ws = a.ws;
    REP(0) if (IN(0)) phase_p0(a, lds, tid, wave, lane);
    SEAM(0);
    REP(1) if (IN(1)) {
        pg8::Gemm g{(const bf16_t*)(ws + WS_XN1), (const bf16_t*)(ws + WS_WINT), T, DIN, 1024}; pg8::StaticOrder S; S.init(T, DIN, G, bx);
        EpiProj E{(bf16_t*)(ws + WS_HYIN), (bf16_t*)(ws + WS_RGX), (bf16_t*)(ws + WS_GG), (bf16_t*)(ws + WS_GA), (bf16_t*)(ws + WS_GB), a.in[I_BGATE]};
        pg8::gemm_phase<EpiProj, pg8::StaticOrder>(lds, g, S, E, nullptr);
    }
    SEAM(1);
    REP(2) if (IN(2)) phase_hy_pre(a, lds, tid);
    SEAM(2);
    REP(3) if (IN(3)) {
#if CONV_NAIVE
        phase_hy_conv_naive(a, lds, tid);
#else
        for (int c = bx; c < DHY; c += G) hy_conv_channel(a, lds, c, tid, wave, lane);
#endif
#if RG_NAIVE
        phase_rg_naive(a, lds, tid);
#else
        for (int it = bx; it < NB * 2 * 8; it += G) rg_item(a, lds, it, tid, wave, lane);
#endif
    }
    SEAM(3);
    REP(4) if (IN(4)) phase_post(a, lds, tid);
    SEAM(4);
    REP(5) if (IN(5)) {
        { pg8::Gemm g{(const bf16_t*)(ws + WS_YH), (const bf16_t*)(ws + WS_WHT), T, 1024, 512}; pg8::StaticOrder S; S.init(T, 1024, G, bx);
          EpiGate<0> E{(const bf16_t*)(ws + WS_GA), nullptr, (bf16_t*)(ws + WS_TMP)};
          pg8::gemm_phase<EpiGate<0>, pg8::StaticOrder>(lds, g, S, E, nullptr); }
        { pg8::Gemm g{(const bf16_t*)(ws + WS_YR), (const bf16_t*)(ws + WS_WRT), T, 1024, 1024}; pg8::StaticOrder S; S.init(T, 1024, G, bx);
          EpiGate<1> E{(const bf16_t*)(ws + WS_GB), (const bf16_t*)(ws + WS_TMP), (bf16_t*)(ws + WS_MERGED)};
          pg8::gemm_phase<EpiGate<1>, pg8::StaticOrder>(lds, g, S, E, nullptr); }
    }
    SEAM(5);
    REP(6) if (IN(6)) {
        pg8::Gemm g{(const bf16_t*)(ws + WS_MERGED), (const bf16_t*)(ws + WS_WOT), T, 1024, 1024}; pg8::StaticOrder S; S.init(T, 1024, G, bx);
        EpiResid E{a.in[I_X], a.out, (bf16_t*)(ws + WS_H1B), (float*)(ws + WS_ROWSS)};
        pg8::gemm_phase<EpiResid, pg8::StaticOrder>(lds, g, S, E, nullptr);
    }
    SEAM(6);
    REP(7) if (IN(7)) {
        phase_tables(a, wave, lane);
        pg8::Gemm g{(const bf16_t*)(ws + WS_H1B), (const bf16_t*)(ws + WS_WST), T, 2048, 1024}; pg8::StaticOrder S; S.init(T, 2048, G, bx);
        EpiScores E{(const float*)(ws + WS_ROWSS), (float*)(ws + WS_SCORES)};
        pg8::gemm_phase<EpiScores, pg8::StaticOrder>(lds, g, S, E, nullptr);
    }
    SEAM(7);
    REP(8) if (IN(8)) phase_topk(a, wave, lane);
    SEAM(8);
    REP(9) if (IN(9)) phase_peer(a, wave, lane);
#undef IN
#undef SEAM
}

extern "C" void kernel_launch(void* const* d_in, const int* in_sizes, int n_in, void* d_out, int out_size, void* d_ws, size_t ws_size, hipStream_t stream) {
    static int grid = 0;
    if (grid == 0) {
        if (n_in != N_IN || out_size != T * DM || ws_size < WS_END) { fprintf(stderr, "kernel_launch: unexpected shapes (n_in %d out %d ws %zu)\n", n_in, out_size, ws_size); grid = -1; return; }
        if (hipFuncSetAttribute((const void*)mega, hipFuncAttributeMaxDynamicSharedMemorySize, LDS_BYTES) != hipSuccess) { fprintf(stderr, "kernel_launch: hipFuncSetAttribute failed\n"); grid = -1; return; }
        int dev = 0, cus = 0, per_cu = 0;
        hipGetDevice(&dev); hipDeviceGetAttribute(&cus, hipDeviceAttributeMultiprocessorCount, dev);
        hipOccupancyMaxActiveBlocksPerMultiprocessor(&per_cu, (const void*)mega, NTHR, LDS_BYTES);
        if (per_cu < 1) { fprintf(stderr, "kernel_launch: occupancy query says %d blocks per CU\n", per_cu); per_cu = 1; }
        (void)hipGetLastError();
        grid = cus;
    }
    if (grid < 0) return;
    Args a{};
    for (int i = 0; i < N_IN; ++i) a.in[i] = (const float*)d_in[i];
    a.out = (float*)d_out; a.ws = (unsigned char*)d_ws;
#if ONE_LAUNCH
    a.ph_lo = 0; a.ph_hi = NPHASE;
    void* args[] = {&a};
    hipError_t e = hipLaunchCooperativeKernel((const void*)mega, dim3(grid), dim3(NTHR), args, LDS_BYTES, stream);
    if (e != hipSuccess) fprintf(stderr, "cooperative launch failed: %s (grid %d)\n", hipGetErrorString(e), grid);
#else
    for (int ph = 0; ph < NPHASE; ++ph) for (int rep = 0; rep < 1 + ((REPMASK >> ph) & 1); ++rep) { a.ph_lo = ph; a.ph_hi = ph + 1;
        hipLaunchKernelGGL(mega, dim3(grid), dim3(NTHR), LDS_BYTES, stream, a);
        hipError_t e = hipPeekAtLastError(); if (e != hipSuccess) { fprintf(stderr, "launch %d failed: %s\n", ph, hipGetErrorString(e)); break; } }
#endif
}
```

```cpp
#define ONE_LAUNCH 1
#include <hip/hip_runtime.h>
#include <hip/hip_cooperative_groups.h>
#include <cstdio>
#include <cstdint>
#include <cmath>
namespace cg = cooperative_groups;
namespace pg8 {
#define PG8_LAS __attribute__((address_space(3)))
typedef unsigned short bf16_t;
typedef short bf16x8 __attribute__((ext_vector_type(8)));
typedef float f32x4 __attribute__((ext_vector_type(4)));
typedef unsigned u32x4 __attribute__((ext_vector_type(4)));
constexpr int BM = 256, BK = 64, HALF = 128, HTB = HALF * BK * 2  , STAGE_BYTES = 8 * HTB, NXCD = 8, WGM = 8;

__host__ __device__ __forceinline__ int lds_byte(int r, int c) { const int st = (r >> 4) * 2 + (c >> 5), rr = r & 15, cc = c & 31, ob = rr * 64 + cc * 2; return st * 1024 + (ob ^ (((ob >> 9) & 1) << 5)); }
__host__ __device__ __forceinline__ void stage_rc(int b, int& R, int& C) { const int st = b / 1024, sb = b % 1024, swz = sb ^ (((sb >> 9) & 1) << 5); R = (st >> 1) * 16 + swz / 64; C = (st & 1) * 32 + (swz % 64) / 2; }
__host__ __device__ __forceinline__ int perm32(int rho) { const int n = rho >> 4, i = rho & 15; return 8 * (i >> 2) + 4 * n + (i & 3); }

struct Unit { int pm, pn; };
struct Gemm { const bf16_t* A; const bf16_t* Bt; int M, N, K; };

struct StaticOrder {
    int nM, nN, nwg, G, c;
    __host__ __device__ void init(int M, int N, int G_, int c_) { nM = M / BM; nN = N / BM; nwg = nM * nN; G = G_; c = c_; }
    __host__ __device__ bool next(int i, Unit& u) const {
        const long L = (long)i * G + c; if (L >= nwg) return false;
        int wgid = (int)L; { const int q = nwg / NXCD, r = nwg % NXCD, xcd = wgid % NXCD, off = wgid / NXCD; wgid = (xcd < r ? xcd * (q + 1) : r * (q + 1) + (xcd - r) * q) + off; }
        const int nig = WGM * nN, gid = wgid / nig, fm = gid * WGM, gsz = (nM - fm) < WGM ? (nM - fm) : WGM;
        u.pm = fm + ((wgid % nig) % gsz); u.pn = (wgid % nig) / gsz; return true;
    }
    __device__ __forceinline__ void a_ready(const Unit&) const {}
    __device__ __forceinline__ void done(const Unit&) const {}
};
__device__ __forceinline__ unsigned cvt_pk_bf16(float lo, float hi) { unsigned r; asm volatile("v_cvt_pk_bf16_f32 %0, %1, %2" : "=v"(r) : "v"(lo), "v"(hi)); return r; }
typedef float f32x2 __attribute__((ext_vector_type(2)));
__device__ __forceinline__ f32x2 gelu_pk(f32x2 v) {
    const f32x2 av = __builtin_elementwise_abs(v), d = av * 0.2316418882f + 1.0f;
    f32x2 t; t.x = __builtin_amdgcn_rcpf(d.x); t.y = __builtin_amdgcn_rcpf(d.y);
    f32x2 q = t * 0.5307027145f + (-0.7265760135f); q = q * t + 0.7107068705f; q = q * t + (-0.142248368f); q = q * t + 0.127414796f; q = q * t;
    const f32x2 s = (v * v) * (-0.72134752044f);
    f32x2 e; e.x = __builtin_amdgcn_exp2f(s.x); e.y = __builtin_amdgcn_exp2f(s.y);
    const f32x2 m = v * (q * e), r = v - m;
    f32x2 o; o.x = v.x < 0.f ? m.x : r.x; o.y = v.y < 0.f ? m.y : r.y; return o;
}
template <class Epi, class Sched, bool STAMP = false>
__device__ __forceinline__ void gemm_phase(PG8_LAS unsigned char* lds, const Gemm g, const Sched& S, const Epi& E, unsigned long long* stamps) {
    const int tid = threadIdx.x, wid = __builtin_amdgcn_readfirstlane(tid >> 6), lane = tid & 63, wr = wid >> 2, wc = wid & 3, fr = lane & 15, fq = lane >> 4;
    const int K = g.K, nt = K / BK;
    int ts_lo = 0, ts_hi = 0, nts = 0; const unsigned long long rt_entry = STAMP ? (unsigned long long)wall_clock64() : 0ull;
#define PG8_STAMP() do { if (STAMP && wid == 0 && nts < 64) { const unsigned long long _c = (unsigned long long)clock64(); \
        ts_lo = (lane == nts) ? (int)(unsigned)_c : ts_lo; ts_hi = (lane == nts) ? (int)(unsigned)(_c >> 32) : ts_hi; ++nts; } } while (0)
    PG8_STAMP();
    unsigned voffA[2], voffB[2];
#pragma unroll
    for (int i = 0; i < 2; ++i) { int R, C; stage_rc(tid * 16 + i * 8192, R, C); const int Rb = Epi::PERM ? ((R & ~31) + perm32(R & 31)) : R;
        voffA[i] = (unsigned)(R * K + C) * 2u; voffB[i] = (unsigned)(Rb * K + C) * 2u; }
    const size_t kstep = (size_t)(BK * 2);
    const size_t hstep = (size_t)HALF * K * 2;
    const size_t tstep = 2 * hstep;
    const unsigned ldsw = (unsigned)wid * 1024u;
    const int aoff = lds_byte(wr * 64 + fr, fq * 8), boff = lds_byte(wc * 32 + fr, fq * 8);
#define PG8_SA(b, h) (((b) * 2 + (h)) * HTB)
#define PG8_SB(b, h) ((4 + (b) * 2 + (h)) * HTB)
#define PG8_STAGE(bufoff, gbase, voff) do { _Pragma("unroll") for (int _i = 0; _i < 2; ++_i) \
        __builtin_amdgcn_global_load_lds((const unsigned*)((const char*)(gbase) + (voff)[_i]), (PG8_LAS unsigned*)(lds + (bufoff) + ldsw + _i * 8192), 16, 0, 0); } while (0)
#define PG8_LDA(dst, b, h) do { _Pragma("unroll") for (int m = 0; m < 4; ++m) _Pragma("unroll") for (int k = 0; k < 2; ++k) dst[m][k] = *(const PG8_LAS bf16x8*)(lds + PG8_SA(b, h) + aoff + m * 2048 + k * 1024); } while (0)
#define PG8_LDB(dst, b, h) do { _Pragma("unroll") for (int n = 0; n < 2; ++n) _Pragma("unroll") for (int k = 0; k < 2; ++k) dst[n][k] = *(const PG8_LAS bf16x8*)(lds + PG8_SB(b, h) + boff + n * 2048 + k * 1024); } while (0)
#define PG8_MMA(ai, bj, At, Bt) do { __builtin_amdgcn_s_setprio(1); _Pragma("unroll") for (int m = 0; m < 4; ++m) _Pragma("unroll") for (int n = 0; n < 2; ++n) _Pragma("unroll") for (int k = 0; k < 2; ++k) \
        acc[ai][bj][m][n] = __builtin_amdgcn_mfma_f32_16x16x32_bf16(Bt[n][k], At[m][k], acc[ai][bj][m][n], 0, 0, 0); __builtin_amdgcn_s_setprio(0); } while (0)
#define PG8_WAIT_V(n) asm volatile("s_waitcnt vmcnt(" #n ")" ::: "memory")
#define PG8_WAIT_L(n) asm volatile("s_waitcnt lgkmcnt(" #n ")" ::: "memory")
#define PG8_BAR __builtin_amdgcn_s_barrier()
#define PG8_SCHED __builtin_amdgcn_sched_barrier(0)
    Unit cur, nxt; int ui = 0;
    if (!S.next(0, cur)) return;
    f32x4 acc[2][2][4][2];
#pragma unroll
    for (int a = 0; a < 2; ++a)
#pragma unroll
        for (int b = 0; b < 2; ++b)
#pragma unroll
            for (int m = 0; m < 4; ++m)
#pragma unroll
                for (int n = 0; n < 2; ++n) acc[a][b][m][n] = (f32x4){0.f, 0.f, 0.f, 0.f};
    bf16x8 At[4][2], B0[2][2], B1[2][2];
    const char* cA = (const char*)g.A + (size_t)cur.pm * tstep; const char* cB = (const char*)g.Bt + (size_t)cur.pn * tstep;
    S.a_ready(cur);
    PG8_STAGE(PG8_SB(0, 0), cB, voffB); PG8_STAGE(PG8_SA(0, 0), cA, voffA); PG8_STAGE(PG8_SB(0, 1), cB + hstep, voffB); PG8_STAGE(PG8_SA(0, 1), cA + hstep, voffA);
    if (wr == 1) PG8_BAR;
    PG8_WAIT_V(4); PG8_BAR;
    PG8_STAGE(PG8_SB(1, 0), cB + kstep, voffB); PG8_STAGE(PG8_SA(1, 0), cA + kstep, voffA); PG8_STAGE(PG8_SB(1, 1), cB + hstep + kstep, voffB);
    PG8_WAIT_V(6); PG8_BAR;
    PG8_STAMP();
    for (;;) {
        const bool has_next = S.next(ui + 1, nxt);
        const char* nA = has_next ? (const char*)g.A + (size_t)nxt.pm * tstep : cA; const char* nB = has_next ? (const char*)g.Bt + (size_t)nxt.pn * tstep : cB;
        for (int t = 0; t < nt; t += 2) {
            const bool last = (t == nt - 2);
            const char* a1 = cA + (size_t)(t + 1) * kstep;
            const char* a2 = last ? nA : cA + (size_t)(t + 2) * kstep; const char* b2 = last ? nB : cB + (size_t)(t + 2) * kstep;
            const char* a3 = a2 + kstep; const char* b3 = b2 + kstep;
            if (last && has_next) S.a_ready(nxt);
            PG8_LDB(B0, 0, 0); PG8_SCHED; PG8_LDA(At, 0, 0); PG8_STAGE(PG8_SA(1, 1), a1 + hstep, voffA);
            PG8_WAIT_L(8); PG8_BAR; PG8_WAIT_L(0); PG8_MMA(0, 0, At, B0); PG8_BAR; PG8_SCHED;
            PG8_LDB(B1, 0, 1); PG8_STAGE(PG8_SB(0, 0), b2, voffB);
            PG8_BAR; PG8_WAIT_L(0); PG8_MMA(0, 1, At, B1); PG8_BAR;
            PG8_LDA(At, 0, 1); PG8_STAGE(PG8_SA(0, 0), a2, voffA);
            PG8_BAR; PG8_WAIT_L(0); PG8_MMA(1, 0, At, B0); PG8_BAR; PG8_SCHED;
            PG8_STAGE(PG8_SB(0, 1), b2 + hstep, voffB);
            PG8_WAIT_V(6); PG8_BAR; PG8_MMA(1, 1, At, B1); PG8_BAR;
            PG8_LDB(B0, 1, 0); PG8_SCHED; PG8_LDA(At, 1, 0); PG8_STAGE(PG8_SA(0, 1), a2 + hstep, voffA);
            PG8_WAIT_L(8); PG8_BAR; PG8_WAIT_L(0); PG8_MMA(0, 0, At, B0); PG8_BAR; PG8_SCHED;
            PG8_LDB(B1, 1, 1); PG8_STAGE(PG8_SB(1, 0), b3, voffB);
            PG8_BAR; PG8_WAIT_L(0); PG8_MMA(0, 1, At, B1); PG8_BAR;
            PG8_LDA(At, 1, 1); PG8_STAGE(PG8_SA(1, 0), a3, voffA);
            PG8_BAR; PG8_WAIT_L(0); PG8_MMA(1, 0, At, B0); PG8_BAR; PG8_SCHED;
            PG8_STAGE(PG8_SB(1, 1), b3 + hstep, voffB);
            PG8_WAIT_V(6); PG8_BAR; PG8_MMA(1, 1, At, B1); PG8_BAR;
        }
        PG8_STAMP();
        if constexpr (!Epi::AFTER_DRAIN) { E(acc, cur, wr, wc, fr, fq); S.done(cur); }
        PG8_STAMP();
        if (!has_next) break;
#pragma unroll
        for (int a = 0; a < 2; ++a)
#pragma unroll
            for (int b = 0; b < 2; ++b)
#pragma unroll
                for (int m = 0; m < 4; ++m)
#pragma unroll
                    for (int n = 0; n < 2; ++n) acc[a][b][m][n] = (f32x4){0.f, 0.f, 0.f, 0.f};
        cur = nxt; cA = nA; cB = nB; ++ui;
    }
    PG8_WAIT_V(0);
    if (wr == 0) PG8_BAR;
    PG8_BAR;
    if constexpr (Epi::AFTER_DRAIN) { E.fused(acc, cur, wr, wc, fr, fq, lds, wid, lane); S.done(cur); }
    PG8_STAMP();
    if (STAMP && wid == 0) { stamps[lane] = lane < nts ? (((unsigned long long)(unsigned)ts_hi << 32) | (unsigned)ts_lo) : 0ull;
        if (lane == 62) stamps[62] = rt_entry; if (lane == 63) stamps[63] = (unsigned long long)wall_clock64(); }
#undef PG8_STAMP
#undef PG8_SA
#undef PG8_SB
#undef PG8_STAGE
#undef PG8_LDA
#undef PG8_LDB
#undef PG8_MMA
#undef PG8_WAIT_V
#undef PG8_WAIT_L
#undef PG8_BAR
#undef PG8_SCHED
}
}

#define LAS __attribute__((address_space(3)))
typedef unsigned short bf16_t;
typedef float f32x4 __attribute__((ext_vector_type(4)));
typedef float f32x2 __attribute__((ext_vector_type(2)));
typedef unsigned u32x4 __attribute__((ext_vector_type(4)));
typedef unsigned u32x2 __attribute__((ext_vector_type(2)));

constexpr int NB = 8, SEQ = 4096, NMETA = 16, LT = SEQ + NMETA, DM = 1024, T = NB * SEQ;
constexpr int DHY = 512, DRG = 1024, DIN = 3 * DHY + 2 * DRG + 2 * DM;
constexpr int NTHR = 512, NWAVES = 8;
constexpr int LDS_BYTES = 160 * 1024;
constexpr float EPSF = 1e-6f;
constexpr int KFW = 2 * LT;
constexpr int SP = 4256;
constexpr int NEXP = 16384;

enum { I_X = 0, I_META, I_GFINAL, I_GMIX, I_WIN, I_BGATE, I_HYCW, I_HYCB, I_HYW1, I_HYB1, I_HYW2, I_HYB2, I_HYW3, I_HYB3, I_HYFREQ, I_HYSKIP,
       I_HYOUT, I_RGCW, I_RGCB, I_RGGW, I_RGGB, I_RGLAM, I_RGOUT, I_WOUT, I_GFFN, I_WQ, I_KEYS, I_PU, I_PV, N_IN };

constexpr size_t MiB = 1024ull * 1024ull;
constexpr size_t WS_ROWSS = 64 * 1024;
constexpr size_t WS_SU = 256 * 1024;
constexpr size_t WS_SV = 320 * 1024;
constexpr size_t WS_WINT = 1 * MiB;
constexpr size_t WS_WHT = 12 * MiB;
constexpr size_t WS_WRT = 13 * MiB;
constexpr size_t WS_WOT = 15 * MiB;
constexpr size_t WS_WST = 17 * MiB;
constexpr size_t WS_GWT = 21 * MiB;
constexpr size_t WS_KF = 22 * MiB;
constexpr size_t WS_KFB = 39 * MiB;
constexpr size_t WS_HYIN = 48 * MiB;
constexpr size_t WS_RGX = 145 * MiB;
constexpr size_t WS_GG = 210 * MiB;
constexpr size_t WS_GA = 274 * MiB;
constexpr size_t WS_GB = 338 * MiB;
constexpr size_t WS_XN1 = 402 * MiB;
constexpr size_t WS_UUT = 402 * MiB;
constexpr size_t WS_CONVT = 436 * MiB;
constexpr size_t WS_YH = 468 * MiB;
constexpr size_t WS_YR = WS_RGX;
constexpr size_t WS_MERGED = WS_HYIN;
constexpr size_t WS_TMP = WS_GG;
constexpr size_t WS_H1B = WS_RGX;
constexpr size_t WS_SCORES = WS_GG;
constexpr size_t WS_EIDX = 468 * MiB;
constexpr size_t WS_EG = 484 * MiB;
constexpr size_t WS_UB = 48 * MiB;
constexpr size_t WS_VB = 64 * MiB;
constexpr size_t WS_END = 500 * MiB;

struct Args { const float* in[N_IN]; float* out; unsigned char* ws; int ph_lo, ph_hi; };

__device__ __forceinline__ float bf2f(unsigned v) { return __uint_as_float(v << 16); }
__device__ __forceinline__ unsigned f2bf(float f) { unsigned u = __float_as_uint(f); return (u + 0x7fffu + ((u >> 16) & 1u)) >> 16; }
__device__ __forceinline__ unsigned pk2(float lo, float hi) { return f2bf(lo) | (f2bf(hi) << 16); }
__device__ __forceinline__ float bflo(unsigned w) { return __uint_as_float(w << 16); }
__device__ __forceinline__ float bfhi(unsigned w) { return __uint_as_float(w & 0xffff0000u); }
__device__ __forceinline__ float wave_sum(float v) {
#pragma unroll
    for (int o = 1; o < 64; o <<= 1) v += __shfl_xor(v, o);
    return v;
}
__device__ __forceinline__ float wave_max(float v) {
#pragma unroll
    for (int o = 1; o < 64; o <<= 1) v = fmaxf(v, __shfl_xor(v, o));
    return v;
}
__device__ __forceinline__ float sigmoidf_(float x) { return __builtin_amdgcn_rcpf(1.0f + __expf(-x)); }
__device__ __forceinline__ float gelu_tanh(float x) { const float u = 1.5957691216f * (x + 0.044715f * x * x * x); return x * __builtin_amdgcn_rcpf(1.0f + __expf(-u)); }
__device__ __forceinline__ void sincos_acc(float a, float& s, float& c) {
    const double x = (double)a;
    const double q = rint(x * 0.63661977236758134308);
    const double r = fma(-q, 1.57079632679489661923, x);
    const int n = (int)q;
    const float rf = (float)r, r2 = rf * rf;
    const float sp = rf * (1.f + r2 * (-1.6666667e-1f + r2 * (8.3333333e-3f + r2 * (-1.9841270e-4f + r2 * 2.7557319e-6f))));
    const float cp = 1.f + r2 * (-0.5f + r2 * (4.1666667e-2f + r2 * (-1.3888889e-3f + r2 * (2.4801587e-5f + r2 * (-2.7557319e-7f)))));
    const int k = n & 3;
    s = (k == 0) ? sp : (k == 1) ? cp : (k == 2) ? -sp : -cp;
    c = (k == 0) ? cp : (k == 1) ? -sp : (k == 2) ? -cp : sp;
}

typedef float f32x2v __attribute__((ext_vector_type(2)));
__device__ __forceinline__ float wave_sum_dpp(float v) {
    v += __int_as_float(__builtin_amdgcn_update_dpp(0, __float_as_int(v), 0xB1, 0xF, 0xF, true));
    v += __int_as_float(__builtin_amdgcn_update_dpp(0, __float_as_int(v), 0x4E, 0xF, 0xF, true));
    v += __int_as_float(__builtin_amdgcn_update_dpp(0, __float_as_int(v), 0x141, 0xF, 0xF, true));
    v += __int_as_float(__builtin_amdgcn_update_dpp(0, __float_as_int(v), 0x140, 0xF, 0xF, true));
    const int vi = __float_as_int(v);
    return (__int_as_float(__builtin_amdgcn_readlane(vi, 0)) + __int_as_float(__builtin_amdgcn_readlane(vi, 16))) + (__int_as_float(__builtin_amdgcn_readlane(vi, 32)) + __int_as_float(__builtin_amdgcn_readlane(vi, 48)));
}
__device__ __forceinline__ float wave_max_dpp(float v) {
    v = fmaxf(v, __int_as_float(__builtin_amdgcn_update_dpp(0, __float_as_int(v), 0xB1, 0xF, 0xF, true)));
    v = fmaxf(v, __int_as_float(__builtin_amdgcn_update_dpp(0, __float_as_int(v), 0x4E, 0xF, 0xF, true)));
    v = fmaxf(v, __int_as_float(__builtin_amdgcn_update_dpp(0, __float_as_int(v), 0x141, 0xF, 0xF, true)));
    v = fmaxf(v, __int_as_float(__builtin_amdgcn_update_dpp(0, __float_as_int(v), 0x140, 0xF, 0xF, true)));
    const int vi = __float_as_int(v);
    return fmaxf(fmaxf(__int_as_float(__builtin_amdgcn_readlane(vi, 0)), __int_as_float(__builtin_amdgcn_readlane(vi, 16))), fmaxf(__int_as_float(__builtin_amdgcn_readlane(vi, 32)), __int_as_float(__builtin_amdgcn_readlane(vi, 48))));
}

__device__ __forceinline__ void p0_transpose_item(const float* W, int K, int N, bf16_t* WT, LAS float* scr, int item, int lane) {
    const int nblk = N / 32, kb = item / nblk, nb = item % nblk, k0 = 64 * kb, n0 = 32 * nb;
#pragma unroll 8
    for (int i = 0; i < 32; ++i) { const int kk = 2 * i + (lane >> 5); scr[kk * 33 + (lane & 31)] = W[(size_t)(k0 + kk) * N + n0 + (lane & 31)]; }
    asm volatile("s_waitcnt lgkmcnt(0)" ::: "memory");
    const int c = lane & 7;
#pragma unroll
    for (int j = 0; j < 4; ++j) { const int n = (lane >> 3) + 8 * j; const LAS float* s = scr + (8 * c) * 33 + n;
        u32x4 o; o.x = pk2(s[0 * 33], s[1 * 33]); o.y = pk2(s[2 * 33], s[3 * 33]); o.z = pk2(s[4 * 33], s[5 * 33]); o.w = pk2(s[6 * 33], s[7 * 33]);
        *(u32x4*)(WT + (size_t)(n0 + n) * K + k0 + 8 * c) = o; }
    asm volatile("s_waitcnt lgkmcnt(0)" ::: "memory");
}
__device__ __forceinline__ void p0_xn1_row(const float* xrow, const float* g, bf16_t* orow, int lane) {
    const f32x4* xr = (const f32x4*)xrow + lane; const f32x4* gr = (const f32x4*)g + lane;
    f32x4 v[4]; float s = 0.f;
#pragma unroll
    for (int j = 0; j < 4; ++j) { v[j] = xr[64 * j]; s += (v[j].x * v[j].x + v[j].y * v[j].y) + (v[j].z * v[j].z + v[j].w * v[j].w); }
    const float rstd = rsqrtf(wave_sum(s) * (1.f / DM) + EPSF);
    unsigned long long* o8 = (unsigned long long*)orow + lane;
#pragma unroll
    for (int j = 0; j < 4; ++j) { const f32x4 gv = gr[64 * j];
        o8[64 * j] = (unsigned long long)pk2(v[j].x * rstd * gv.x, v[j].y * rstd * gv.y) | ((unsigned long long)pk2(v[j].z * rstd * gv.z, v[j].w * rstd * gv.w) << 32); }
}
__device__ __forceinline__ void p0_fold_item(const Args& a, LAS unsigned char* lds, int item, int tid) {
    const int hp = item >> 4, k0 = (item & 15) * 64;
    LAS float* kl = (LAS float*)lds;
    LAS float* wl = (LAS float*)(lds + 128 * 129 * 4);
    const float* keys = a.in[I_KEYS] + (size_t)hp * 128 * 128; const float* wq = a.in[I_WQ];
    for (int i = tid; i < 128 * 128; i += NTHR) { const int key = i >> 7, d = i & 127; kl[key * 129 + d] = keys[i]; }
    for (int i = tid; i < 64 * 128; i += NTHR) { const int kk = i >> 7, d = i & 127; wl[i] = wq[(size_t)(k0 + kk) * 2048 + hp * 128 + d]; }
    __syncthreads();
    const int key = tid & 127, kq = tid >> 7;
    float acc[16];
#pragma unroll
    for (int i = 0; i < 16; ++i) acc[i] = 0.f;
#pragma unroll 2
    for (int d = 0; d < 128; ++d) { const float kv = kl[key * 129 + d];
#pragma unroll
        for (int i = 0; i < 16; ++i) acc[i] += wl[(kq * 16 + i) * 128 + d] * kv; }
    const float* gf = a.in[I_GFFN] + k0 + kq * 16;
    bf16_t* dst = (bf16_t*)(a.ws + WS_WST) + (size_t)(hp * 128 + key) * 1024 + k0 + kq * 16;
    u32x4 o0, o1;
    o0.x = pk2(acc[0] * gf[0], acc[1] * gf[1]); o0.y = pk2(acc[2] * gf[2], acc[3] * gf[3]); o0.z = pk2(acc[4] * gf[4], acc[5] * gf[5]); o0.w = pk2(acc[6] * gf[6], acc[7] * gf[7]);
    o1.x = pk2(acc[8] * gf[8], acc[9] * gf[9]); o1.y = pk2(acc[10] * gf[10], acc[11] * gf[11]); o1.z = pk2(acc[12] * gf[12], acc[13] * gf[13]); o1.w = pk2(acc[14] * gf[14], acc[15] * gf[15]);
    *(u32x4*)dst = o0; *(u32x4*)(dst + 8) = o1;
    __syncthreads();
}
__device__ __forceinline__ void p0_meta_item(const Args& a, LAS unsigned char* lds, int item, int tid, int wave, int lane) {
    LAS float* mt = (LAS float*)lds;
    for (int r = wave * 2; r < wave * 2 + 2; ++r) {
        const f32x4* xr = (const f32x4*)(a.in[I_META] + (size_t)r * DM) + lane; const f32x4* gr = (const f32x4*)a.in[I_GMIX] + lane;
        f32x4 v[4]; float s = 0.f;
#pragma unroll
        for (int j = 0; j < 4; ++j) { v[j] = xr[64 * j]; s += (v[j].x * v[j].x + v[j].y * v[j].y) + (v[j].z * v[j].z + v[j].w * v[j].w); }
        const float rstd = rsqrtf(wave_sum(s) * (1.f / DM) + EPSF);
#pragma unroll
        for (int j = 0; j < 4; ++j) { const f32x4 gv = gr[64 * j]; f32x4 o = v[j] * rstd * gv; *(LAS f32x4*)(mt + r * 1024 + 4 * (lane + 64 * j)) = o; }
    }
    __syncthreads();
    const int col = item * 256 + (tid & 255), rh = tid >> 8;
    float acc[8];
#pragma unroll
    for (int r = 0; r < 8; ++r) acc[r] = 0.f;
    const float* w = a.in[I_WIN] + col;
#pragma unroll 4
    for (int k = 0; k < 1024; ++k) { const float wv = w[(size_t)k * DIN];
#pragma unroll
        for (int r = 0; r < 8; ++r) acc[r] += mt[(rh * 8 + r) * 1024 + k] * wv; }
    bf16_t* hyin = (bf16_t*)(a.ws + WS_HYIN); bf16_t* rgx = (bf16_t*)(a.ws + WS_RGX);
#pragma unroll
    for (int r = 0; r < 8; ++r) { const int t = rh * 8 + r; const bf16_t v = (bf16_t)f2bf(acc[r]);
        for (int b = 0; b < NB; ++b) { if (col < 1536) hyin[((size_t)b * LT + t) * 1536 + col] = v; else rgx[((size_t)b * LT + t) * 1024 + (col - 1536)] = v; } }
    __syncthreads();
}
__device__ __forceinline__ void p0_filter_item(const Args& a, LAS unsigned char* lds, int item, int tid) {
    LAS float* z = (LAS float*)lds;
    LAS float* h1 = z + 16 * 33;
    LAS float* h2 = h1 + 16 * 64;
    LAS float* ko = h2 + 16 * 64;
    const int p0 = item * 16;
    for (int idx = tid; idx < 16 * 33; idx += NTHR) { const int pp = idx / 33, f = idx % 33, p = p0 + pp;
        float v;
        if (f == 0) v = (float)p * (1.0f / (float)(LT - 1));
        else { const int bi = (f - 1) & 15; const float band = 1e-4f + (float)bi * ((15.0f - 1e-4f) / 15.0f); const float w = (float)(6.283185307179586 / (double)LT) * (float)p;
            float s, c; sincos_acc(band * w, s, c); v = (f <= 16) ? c : -s; }
        z[idx] = v; }
    __syncthreads();
    const float* w1 = a.in[I_HYW1]; const float* b1 = a.in[I_HYB1]; const float* w2 = a.in[I_HYW2]; const float* b2 = a.in[I_HYB2];
    const float* w3 = a.in[I_HYW3]; const float* b3 = a.in[I_HYB3]; const float* fr = a.in[I_HYFREQ];
    for (int idx = tid; idx < 16 * 64; idx += NTHR) { const int pp = idx >> 6, j = idx & 63; float acc = b1[j];
#pragma unroll 3
        for (int f = 0; f < 33; ++f) acc += z[pp * 33 + f] * w1[f * 64 + j];
        float s, c; sincos_acc(fr[j] * acc, s, c); h1[idx] = s; }
    __syncthreads();
    for (int idx = tid; idx < 16 * 64; idx += NTHR) { const int pp = idx >> 6, j = idx & 63; float acc = b2[j];
#pragma unroll 4
        for (int f = 0; f < 64; ++f) acc += h1[pp * 64 + f] * w2[f * 64 + j];
        float s, c; sincos_acc(fr[64 + j] * acc, s, c); h2[idx] = s; }
    __syncthreads();
#pragma unroll 1
    for (int half = 0; half < 2; ++half) { const int o = half * 512 + tid;
        float acc[16];
#pragma unroll
        for (int pp = 0; pp < 16; ++pp) acc[pp] = b3[o];
#pragma unroll 2
        for (int i = 0; i < 64; ++i) { const float wv = w3[i * 1024 + o];
#pragma unroll
            for (int pp = 0; pp < 16; ++pp) acc[pp] += h2[pp * 64 + i] * wv; }
        const float delta = fabsf(-15.350567286626972f + (float)tid * ((-3.0701134573253945f + 15.350567286626972f) / 511.0f));
#pragma unroll
        for (int pp = 0; pp < 16; ++pp) { const float tn = (float)(p0 + pp) * (1.0f / (float)(LT - 1)); ko[o * 17 + pp] = acc[pp] * __expf(-tn * delta); }
    }
    __syncthreads();
    float* kf = (float*)(a.ws + WS_KF); bf16_t* kfb = (bf16_t*)(a.ws + WS_KFB);
    for (int idx = tid; idx < 1024 * 16; idx += NTHR) { const int o = idx >> 4, pp = idx & 15, dir = o >> 9, c = o & 511, p = p0 + pp;
        const float v = ko[o * 17 + pp];
        if (dir == 0) { kf[(size_t)c * KFW + (LT - 1) + p] = v; kfb[(size_t)c * KFW + (LT - 1) + p] = (bf16_t)f2bf(v); }
        else if (p >= 1) { kf[(size_t)c * KFW + (LT - 1) - p] = v; kfb[(size_t)c * KFW + (LT - 1) - p] = (bf16_t)f2bf(v); } }
    if (item == 0) for (int c = tid; c < 512; c += NTHR) { kf[(size_t)c * KFW + KFW - 1] = 0.f; kfb[(size_t)c * KFW + KFW - 1] = 0; }
    __syncthreads();
}
__device__ __forceinline__ void phase_p0(const Args& a, LAS unsigned char* lds, int tid, int wave, int lane) {
    const int G = gridDim.x, bx = blockIdx.x;
    { float* rs = (float*)(a.ws + WS_ROWSS); for (int i = bx * NTHR + tid; i < T; i += G * NTHR) rs[i] = 0.f; }
    for (int it = bx; it < 256 + 257 + 10; it += G) {
#ifndef P0M
#define P0M 7
#endif
        if (it < 256) { if (P0M & 1) p0_fold_item(a, lds, it, tid); }
        else if (it < 513) { if (P0M & 2) p0_filter_item(a, lds, it - 256, tid); }
        else { if (P0M & 4) p0_meta_item(a, lds, it - 513, tid, wave, lane); }
    }
    LAS float* scr = (LAS float*)(lds + wave * 16384);
    const int gw = bx * NWAVES + wave, NGW = G * NWAVES;
    constexpr int I_IN = (1024 / 64) * (DIN / 32), I_H = (512 / 64) * (1024 / 32), I_R = (1024 / 64) * (1024 / 32), I_O = I_R;
    for (int it = gw; it < I_IN + I_H + I_R + I_O; it += NGW) {
        int r = it;
        if (r < I_IN) { p0_transpose_item(a.in[I_WIN], 1024, DIN, (bf16_t*)(a.ws + WS_WINT), scr, r, lane); continue; } r -= I_IN;
        if (r < I_H) { p0_transpose_item(a.in[I_HYOUT], 512, 1024, (bf16_t*)(a.ws + WS_WHT), scr, r, lane); continue; } r -= I_H;
        if (r < I_R) { p0_transpose_item(a.in[I_RGOUT], 1024, 1024, (bf16_t*)(a.ws + WS_WRT), scr, r, lane); continue; } r -= I_R;
        p0_transpose_item(a.in[I_WOUT], 1024, 1024, (bf16_t*)(a.ws + WS_WOT), scr, r, lane);
    }
    for (int m = gw; m < T; m += NGW) p0_xn1_row(a.in[I_X] + (size_t)m * DM, a.in[I_GMIX], (bf16_t*)(a.ws + WS_XN1) + (size_t)m * DM, lane);
}

typedef pg8::f32x4 pf4;
struct EpiProj {
    static constexpr bool PERM = true, AFTER_DRAIN = false;
    bf16_t *hyin, *rgx, *gg, *ga, *gb; const float* bgate;
    __device__ __forceinline__ void operator()(const pf4 (&acc)[2][2][4][2], const pg8::Unit& u, int wr, int wc, int fr, int fq) const {
        const int pn = u.pn, row0 = u.pm * 256 + wr * 64 + fr, cl0 = wc * 32 + 8 * fq;
#pragma unroll
        for (int ai = 0; ai < 2; ++ai)
#pragma unroll
            for (int m = 0; m < 4; ++m) { const int r = row0 + ai * 128 + m * 16; const size_t rl = (size_t)(r >> 12) * LT + NMETA + (r & 4095);
#pragma unroll
                for (int bj = 0; bj < 2; ++bj) { const int col = pn * 256 + bj * 128 + cl0; pf4 v0 = acc[ai][bj][m][0], v1 = acc[ai][bj][m][1]; bf16_t* dst;
                    if (pn < 6) dst = hyin + rl * 1536 + col;
                    else if (pn < 10) dst = rgx + rl * 1024 + (col - 1536);
                    else if (pn < 14) { dst = gg + (size_t)r * 1024 + (col - 2560);
#pragma unroll
                        for (int j = 0; j < 4; ++j) { v0[j] = gelu_tanh(v0[j]); v1[j] = gelu_tanh(v1[j]); } }
                    else { const int gc = col - 3584;
                        dst = (gc < 1024 ? ga + (size_t)r * 1024 + gc : gb + (size_t)r * 1024 + (gc - 1024));
                        const pf4 b0 = *(const pf4*)(bgate + gc), b1 = *(const pf4*)(bgate + gc + 4);
#pragma unroll
                        for (int j = 0; j < 4; ++j) { v0[j] = sigmoidf_(v0[j] + b0[j]); v1[j] = sigmoidf_(v1[j] + b1[j]); } }
                    u32x4 w; w.x = pk2(v0[0], v0[1]); w.y = pk2(v0[2], v0[3]); w.z = pk2(v1[0], v1[1]); w.w = pk2(v1[2], v1[3]);
                    *(u32x4*)dst = w; } }
    }
};
template <int MODE  > struct EpiGate {
    static constexpr bool PERM = true, AFTER_DRAIN = false;
    const bf16_t* gate; const bf16_t* tin; bf16_t* outp;
    __device__ __forceinline__ void operator()(const pf4 (&acc)[2][2][4][2], const pg8::Unit& u, int wr, int wc, int fr, int fq) const {
        const int row0 = u.pm * 256 + wr * 64 + fr, col0 = u.pn * 256 + wc * 32 + 8 * fq;
#pragma unroll
        for (int ai = 0; ai < 2; ++ai)
#pragma unroll
            for (int m = 0; m < 4; ++m) { const size_t ro = (size_t)(row0 + ai * 128 + m * 16) * 1024 + col0;
#pragma unroll
                for (int bj = 0; bj < 2; ++bj) { const size_t o = ro + bj * 128; const pf4 v0 = acc[ai][bj][m][0], v1 = acc[ai][bj][m][1];
                    const u32x4 g = *(const u32x4*)(gate + o);
                    float r[8];
                    r[0] = v0[0] * bflo(g.x); r[1] = v0[1] * bfhi(g.x); r[2] = v0[2] * bflo(g.y); r[3] = v0[3] * bfhi(g.y);
                    r[4] = v1[0] * bflo(g.z); r[5] = v1[1] * bfhi(g.z); r[6] = v1[2] * bflo(g.w); r[7] = v1[3] * bfhi(g.w);
                    if (MODE == 1) { const u32x4 t = *(const u32x4*)(tin + o);
                        r[0] += bflo(t.x); r[1] += bfhi(t.x); r[2] += bflo(t.y); r[3] += bfhi(t.y); r[4] += bflo(t.z); r[5] += bfhi(t.z); r[6] += bflo(t.w); r[7] += bfhi(t.w); }
                    u32x4 w; w.x = pk2(r[0], r[1]); w.y = pk2(r[2], r[3]); w.z = pk2(r[4], r[5]); w.w = pk2(r[6], r[7]);
                    *(u32x4*)(outp + o) = w; } }
    }
};
struct EpiResid {
    static constexpr bool PERM = true, AFTER_DRAIN = false;
    const float* x; float* h1; bf16_t* h1b; float* rowss;
    __device__ __forceinline__ void operator()(const pf4 (&acc)[2][2][4][2], const pg8::Unit& u, int wr, int wc, int fr, int fq) const {
        const int row0 = u.pm * 256 + wr * 64 + fr, col0 = u.pn * 256 + wc * 32 + 8 * fq;
#pragma unroll
        for (int ai = 0; ai < 2; ++ai)
#pragma unroll
            for (int m = 0; m < 4; ++m) { const int r = row0 + ai * 128 + m * 16; const size_t ro = (size_t)r * 1024 + col0; float ss = 0.f;
#pragma unroll
                for (int bj = 0; bj < 2; ++bj) { const size_t o = ro + bj * 128;
                    const pf4 x0 = *(const pf4*)(x + o), x1 = *(const pf4*)(x + o + 4);
                    const pf4 v0 = acc[ai][bj][m][0] + x0, v1 = acc[ai][bj][m][1] + x1;
                    *(pf4*)(h1 + o) = v0; *(pf4*)(h1 + o + 4) = v1;
                    u32x4 w; w.x = pk2(v0[0], v0[1]); w.y = pk2(v0[2], v0[3]); w.z = pk2(v1[0], v1[1]); w.w = pk2(v1[2], v1[3]);
                    *(u32x4*)(h1b + o) = w;
                    ss += (v0[0] * v0[0] + v0[1] * v0[1]) + (v0[2] * v0[2] + v0[3] * v0[3]) + (v1[0] * v1[0] + v1[1] * v1[1]) + (v1[2] * v1[2] + v1[3] * v1[3]); }
                ss += __shfl_xor(ss, 16); ss += __shfl_xor(ss, 32);
                if (fq == 0) atomicAdd(rowss + r, ss); }
    }
};
struct EpiScores {
    static constexpr bool PERM = true, AFTER_DRAIN = false;
    const float* rowss; float* sc;
    __device__ __forceinline__ void operator()(const pf4 (&acc)[2][2][4][2], const pg8::Unit& u, int wr, int wc, int fr, int fq) const {
        const int row0 = u.pm * 256 + wr * 64 + fr, k0 = wc * 32 + 8 * fq;
#pragma unroll
        for (int ai = 0; ai < 2; ++ai)
#pragma unroll
            for (int m = 0; m < 4; ++m) { const int r = row0 + ai * 128 + m * 16; const float rs = rsqrtf(rowss[r] * (1.f / DM) + EPSF);
#pragma unroll
                for (int bj = 0; bj < 2; ++bj) { float* p = sc + ((size_t)(((r >> 6) * 8 + u.pn) * 2 + bj) * 128 + k0) * 64 + (r & 63);
#pragma unroll
                    for (int j = 0; j < 4; ++j) { p[j * 64] = acc[ai][bj][m][0][j] * rs; p[(4 + j) * 64] = acc[ai][bj][m][1][j] * rs; } } }
    }
};

__device__ __forceinline__ void load8(const bf16_t* p, float (&f)[8]) { const u32x4 w = *(const u32x4*)p;
    f[0] = bflo(w.x); f[1] = bfhi(w.x); f[2] = bflo(w.y); f[3] = bfhi(w.y); f[4] = bflo(w.z); f[5] = bfhi(w.z); f[6] = bflo(w.w); f[7] = bfhi(w.w); }
__device__ __forceinline__ void short_conv8(const bf16_t* hb, const float* cw, const float* cb, int s, int ch, float (&o)[8]) {
    float xm[8], x0[8], xp[8];
    if (s >= 1) load8(hb + (size_t)(s - 1) * 1536 + ch, xm); else {
#pragma unroll
        for (int i = 0; i < 8; ++i) xm[i] = 0.f; }
    load8(hb + (size_t)s * 1536 + ch, x0);
    if (s + 1 < LT) load8(hb + (size_t)(s + 1) * 1536 + ch, xp); else {
#pragma unroll
        for (int i = 0; i < 8; ++i) xp[i] = 0.f; }
#pragma unroll
    for (int i = 0; i < 8; ++i) o[i] = xm[i] * cw[ch + i] + x0[i] * cw[1536 + ch + i] + xp[i] * cw[3072 + ch + i] + cb[ch + i];
}
__device__ __forceinline__ void phase_hy_pre(const Args& a, LAS unsigned char* lds, int tid) {
    LAS bf16_t* tl = (LAS bf16_t*)lds;
    const bf16_t* hyin = (const bf16_t*)(a.ws + WS_HYIN); bf16_t* uut = (bf16_t*)(a.ws + WS_UUT);
    const float* cw = a.in[I_HYCW]; const float* cb = a.in[I_HYCB];
    for (int it = blockIdx.x; it < NB * 67 * 8; it += gridDim.x) {
        const int ct = it & 7, ts = (it >> 3) % 67, b = (it >> 3) / 67;
        { const int sr = tid >> 3, cg = tid & 7, c0 = ct * 64 + cg * 8, sp = ts * 64 + sr, s = sp - 16;
            float uu[8];
            if (s >= 0 && s < LT) { float x1[8], v[8]; const bf16_t* hb = hyin + (size_t)b * LT * 1536;
                short_conv8(hb, cw, cb, s, 512 + c0, x1); short_conv8(hb, cw, cb, s, 1024 + c0, v);
#pragma unroll
                for (int i = 0; i < 8; ++i) uu[i] = v[i] * x1[i]; }
            else {
#pragma unroll
                for (int i = 0; i < 8; ++i) uu[i] = 0.f; }
#pragma unroll
            for (int i = 0; i < 8; ++i) tl[sr * 72 + cg * 8 + i] = (bf16_t)f2bf(uu[i]); }
        __syncthreads();
        { const int cl = tid >> 3, sg = tid & 7, sp0 = ts * 64 + sg * 8;
            if (sp0 < SP) { u32x4 w; unsigned h[8];
#pragma unroll
                for (int i = 0; i < 8; ++i) h[i] = tl[(sg * 8 + i) * 72 + cl];
                w.x = h[0] | (h[1] << 16); w.y = h[2] | (h[3] << 16); w.z = h[4] | (h[5] << 16); w.w = h[6] | (h[7] << 16);
                *(u32x4*)(uut + ((size_t)(ct * 64 + cl) * NB + b) * SP + sp0) = w; } }
        __syncthreads();
    }
}
__device__ __forceinline__ void phase_hy_conv_naive(const Args& a, LAS unsigned char* lds, int tid) {
    LAS bf16_t* uus = (LAS bf16_t*)lds;
    LAS float* filt = (LAS float*)(lds + LT * 16);
    const bf16_t* uut = (const bf16_t*)(a.ws + WS_UUT); const float* kf = (const float*)(a.ws + WS_KF); bf16_t* cvt = (bf16_t*)(a.ws + WS_CONVT);
    for (int c = blockIdx.x; c < DHY; c += gridDim.x) {
        for (int i = tid; i < NB * LT; i += NTHR) { const int b = i / LT, s = i - b * LT; uus[s * 8 + b] = uut[((size_t)c * NB + b) * SP + 16 + s]; }
        for (int i = tid; i < KFW; i += NTHR) filt[i] = kf[(size_t)c * KFW + i];
        __syncthreads();
        for (int tt = 0; tt < 8; ++tt) { const int tq = tt * 512 + tid, t = tq + 16; float acc[8];
#pragma unroll
            for (int b = 0; b < 8; ++b) acc[b] = 0.f;
            const LAS float* fp = filt + (LT - 1) + t;
            for (int s = 0; s < LT; ++s) { const float kv = fp[-s]; const u32x4 w = *(const LAS u32x4*)(uus + s * 8);
                acc[0] += kv * bflo(w.x); acc[1] += kv * bfhi(w.x); acc[2] += kv * bflo(w.y); acc[3] += kv * bfhi(w.y);
                acc[4] += kv * bflo(w.z); acc[5] += kv * bfhi(w.z); acc[6] += kv * bflo(w.w); acc[7] += kv * bfhi(w.w); }
#pragma unroll
            for (int b = 0; b < 8; ++b) cvt[((size_t)c * NB + b) * SEQ + tq] = (bf16_t)f2bf(acc[b]); }
        __syncthreads();
    }
}
__device__ __forceinline__ void phase_rg_naive(const Args& a, LAS unsigned char* lds, int tid) {
    LAS float* xc = (LAS float*)lds;
    LAS float* gbuf = xc + 32 * 128;
    const bf16_t* rgx = (const bf16_t*)(a.ws + WS_RGX);
    for (int it = blockIdx.x; it < NB * 2 * 8; it += gridDim.x) {
        const int head = it & 7, dir = (it >> 3) & 1, b = it >> 4;
        const float* cw = a.in[I_RGCW] + (size_t)dir * 4 * DRG + head * 128; const float* cb = a.in[I_RGCB] + (size_t)dir * DRG + head * 128;
        bf16_t* hout = (bf16_t*)a.out + (size_t)dir * T * DRG;
        const bf16_t* xb = rgx + (size_t)b * LT * DRG + head * 128;
        float h = 0.f, sp = 0.f;
        if (tid < 128) { const float lam = a.in[I_RGLAM][dir * DRG + head * 128 + tid]; sp = log1pf(__expf(-lam)); }
        for (int k = 0; k < 129; ++k) {
            { const int tok = tid >> 4, cg = tid & 15, u = 32 * k + tok; float o[8];
#pragma unroll
                for (int i = 0; i < 8; ++i) o[i] = (u < LT) ? cb[cg * 8 + i] : 0.f;
                if (u < LT) {
#pragma unroll
                    for (int j = 0; j < 4; ++j) { const int uu = u - j; if (uu >= 0) { const int t = dir ? (LT - 1 - uu) : uu; float xv[8]; load8(xb + (size_t)t * DRG + cg * 8, xv);
#pragma unroll
                            for (int i = 0; i < 8; ++i) o[i] += xv[i] * cw[j * DRG + cg * 8 + i]; } } }
#pragma unroll
                for (int i = 0; i < 8; ++i) xc[tok * 128 + cg * 8 + i] = o[i]; }
            __syncthreads();
            { const int j = tid & 127, g = (tid >> 7) & 1, th = tid >> 8; float acc[16];
#pragma unroll
                for (int q = 0; q < 16; ++q) acc[q] = 0.f;
                const float* gw = a.in[I_RGGW] + ((size_t)((dir * 2 + g) * 8 + head) * 128) * 128 + j;
                for (int i = 0; i < 128; ++i) { const float wv = gw[i * 128];
#pragma unroll
                    for (int q = 0; q < 16; ++q) acc[q] += xc[(th * 16 + q) * 128 + i] * wv; }
                const float gb = a.in[I_RGGB][(size_t)(dir * 2 + g) * DRG + head * 128 + j];
#pragma unroll
                for (int q = 0; q < 16; ++q) gbuf[(g * 32 + th * 16 + q) * 128 + j] = acc[q] + gb; }
            __syncthreads();
            if (tid < 128) {
                for (int tok = 0; tok < 32; ++tok) { const int u = 32 * k + tok; if (u >= LT) break;
                    const float r = sigmoidf_(gbuf[tok * 128 + tid]), ig = sigmoidf_(gbuf[(32 + tok) * 128 + tid]);
                    const float la = -8.0f * r * sp; const float av = __expf(la); const float mult = (u == 0) ? 1.0f : sqrtf(-expm1f(2.0f * la));
                    h = av * h + mult * ig * xc[tok * 128 + tid];
                    const int t = dir ? (LT - 1 - u) : u;
                    if (t >= NMETA) hout[((size_t)b * SEQ + (t - NMETA)) * DRG + head * 128 + tid] = (bf16_t)f2bf(h); } }
            __syncthreads();
        }
    }
}
__device__ __forceinline__ void phase_post(const Args& a, LAS unsigned char* lds, int tid) {
    LAS bf16_t* cv = (LAS bf16_t*)lds;
    const bf16_t* hyin = (const bf16_t*)(a.ws + WS_HYIN); const bf16_t* cvt = (const bf16_t*)(a.ws + WS_CONVT); bf16_t* yh = (bf16_t*)(a.ws + WS_YH);
    const float* cw = a.in[I_HYCW]; const float* cb = a.in[I_HYCB]; const float* skip = a.in[I_HYSKIP];
    for (int it = blockIdx.x; it < NB * 64 * 8; it += gridDim.x) {
        const int ct = it & 7, tt = (it >> 3) & 63, b = it >> 9;
        { const int cl = tid >> 3, tg = tid & 7; const u32x4 w = *(const u32x4*)(cvt + ((size_t)(ct * 64 + cl) * NB + b) * SEQ + tt * 64 + tg * 8);
            *(LAS u32x4*)(cv + cl * 72 + tg * 8) = w; }
        __syncthreads();
        { const int tr = tid >> 3, cg = tid & 7, c0 = ct * 64 + cg * 8, t = NMETA + tt * 64 + tr; const bf16_t* hb = hyin + (size_t)b * LT * 1536;
            float x0[8], x1[8], v[8]; short_conv8(hb, cw, cb, t, c0, x0); short_conv8(hb, cw, cb, t, 512 + c0, x1); short_conv8(hb, cw, cb, t, 1024 + c0, v);
            float y[8];
#pragma unroll
            for (int i = 0; i < 8; ++i) { const float cvv = bf2f(cv[(cg * 8 + i) * 72 + tr]); y[i] = (cvv + v[i] * x1[i] * skip[c0 + i]) * x0[i]; }
            u32x4 w; w.x = pk2(y[0], y[1]); w.y = pk2(y[2], y[3]); w.z = pk2(y[4], y[5]); w.w = pk2(y[6], y[7]);
            *(u32x4*)(yh + ((size_t)b * SEQ + tt * 64 + tr) * DHY + c0) = w; }
        __syncthreads();
    }
    const bf16_t* hf = (const bf16_t*)a.out; const bf16_t* hb2 = hf + (size_t)T * DRG; const bf16_t* gg = (const bf16_t*)(a.ws + WS_GG); bf16_t* yr = (bf16_t*)(a.ws + WS_YR);
    for (size_t i = (size_t)blockIdx.x * NTHR + tid; i < (size_t)T * DRG / 8; i += (size_t)gridDim.x * NTHR) {
        float f[8], g[8], q[8]; load8(hf + i * 8, f); load8(hb2 + i * 8, g); load8(gg + i * 8, q);
        u32x4 w; w.x = pk2((f[0] + g[0]) * q[0], (f[1] + g[1]) * q[1]); w.y = pk2((f[2] + g[2]) * q[2], (f[3] + g[3]) * q[3]);
        w.z = pk2((f[4] + g[4]) * q[4], (f[5] + g[5]) * q[5]); w.w = pk2((f[6] + g[6]) * q[6], (f[7] + g[7]) * q[7]);
        *(u32x4*)(yr + i * 8) = w; }
}
__device__ __forceinline__ u32x4 quant_row16(const f32x4 (&v)[4], float amax, float& deq) {
    const float sc = (amax > 0.f) ? 256.0f / amax : 1.0f; deq = (amax > 0.f) ? amax * (1.0f / 256.0f) : 1.0f;
    u32x4 w; int t;
    t = __builtin_amdgcn_cvt_pk_fp8_f32(v[0].x * sc, v[0].y * sc, 0, false); t = __builtin_amdgcn_cvt_pk_fp8_f32(v[0].z * sc, v[0].w * sc, t, true); w.x = (unsigned)t;
    t = __builtin_amdgcn_cvt_pk_fp8_f32(v[1].x * sc, v[1].y * sc, 0, false); t = __builtin_amdgcn_cvt_pk_fp8_f32(v[1].z * sc, v[1].w * sc, t, true); w.y = (unsigned)t;
    t = __builtin_amdgcn_cvt_pk_fp8_f32(v[2].x * sc, v[2].y * sc, 0, false); t = __builtin_amdgcn_cvt_pk_fp8_f32(v[2].z * sc, v[2].w * sc, t, true); w.z = (unsigned)t;
    t = __builtin_amdgcn_cvt_pk_fp8_f32(v[3].x * sc, v[3].y * sc, 0, false); t = __builtin_amdgcn_cvt_pk_fp8_f32(v[3].z * sc, v[3].w * sc, t, true); w.w = (unsigned)t;
    return w;
}
__device__ __forceinline__ void phase_tables(const Args& a, int wave, int lane) {
    const int gw = blockIdx.x * NWAVES + wave, NGW = gridDim.x * NWAVES;
    const float* gf = a.in[I_GFFN] + 16 * lane; unsigned char* uq = a.ws + WS_UB; unsigned char* vq = a.ws + WS_VB; float* su = (float*)(a.ws + WS_SU); float* sv = (float*)(a.ws + WS_SV);
    f32x4 g[4];
#pragma unroll
    for (int j = 0; j < 4; ++j) g[j] = *(const f32x4*)(gf + 4 * j);
    for (int e = gw; e < NEXP; e += NGW) {
        const float* ur = a.in[I_PU] + (size_t)e * DM + 16 * lane; const float* vr = a.in[I_PV] + (size_t)e * DM + 16 * lane;
        f32x4 u[4], v[4]; float mu = 0.f, mv = 0.f;
#pragma unroll
        for (int j = 0; j < 4; ++j) { u[j] = *(const f32x4*)(ur + 4 * j) * g[j]; v[j] = *(const f32x4*)(vr + 4 * j);
            mu = fmaxf(mu, fmaxf(fmaxf(fabsf(u[j].x), fabsf(u[j].y)), fmaxf(fabsf(u[j].z), fabsf(u[j].w))));
            mv = fmaxf(mv, fmaxf(fmaxf(fabsf(v[j].x), fabsf(v[j].y)), fmaxf(fabsf(v[j].z), fabsf(v[j].w)))); }
        mu = wave_max_dpp(mu); mv = wave_max_dpp(mv);
        float du, dv; const u32x4 qu = quant_row16(u, mu, du), qv = quant_row16(v, mv, dv);
        *(u32x4*)(uq + (size_t)e * DM + 16 * lane) = qu; *(u32x4*)(vq + (size_t)e * DM + 16 * lane) = qv;
        if (lane == 0) { su[e] = du; sv[e] = dv; }
    }
}
__device__ __forceinline__ void ce_desc(float& a, float& b) { const float hi = fmaxf(a, b), lo = fminf(a, b); a = hi; b = lo; }
__device__ __forceinline__ void sort16_desc(float (&x)[16]) {
#pragma unroll
    for (int k = 2; k <= 16; k <<= 1)
#pragma unroll
        for (int j = k >> 1; j > 0; j >>= 1)
#pragma unroll
            for (int i = 0; i < 16; ++i) { const int l = i ^ j; if (l > i) { if ((i & k) == 0) ce_desc(x[i], x[l]); else ce_desc(x[l], x[i]); } }
}
__device__ __forceinline__ void merge_top16(float (&L)[16], const float (&X)[16]) {
#pragma unroll
    for (int i = 0; i < 16; ++i) L[i] = fmaxf(L[i], X[15 - i]);
#pragma unroll
    for (int j = 8; j > 0; j >>= 1)
#pragma unroll
        for (int i = 0; i < 16; ++i) { const int l = i ^ j; if (l > i) ce_desc(L[i], L[l]); }
}
__device__ __forceinline__ void top16_of_128(const float* base  , float (&L)[16]) {
#pragma unroll 1
    for (int ch = 0; ch < 8; ++ch) { float X[16];
#pragma unroll
        for (int i = 0; i < 16; ++i) X[i] = __uint_as_float((__float_as_uint(base[(ch * 16 + i) * 64]) & ~0x7Fu) | (unsigned)(ch * 16 + i));
        sort16_desc(X);
        if (ch == 0) {
#pragma unroll
            for (int i = 0; i < 16; ++i) L[i] = X[i]; }
        else merge_top16(L, X); }
}
struct CandTab { int ci[64], cj[64]; };
__host__ __device__ constexpr CandTab make_cand() { CandTab t{}; int n = 0; for (int i = 0; i < 16; ++i) for (int j = 0; j < 16; ++j) if ((i + 1) * (j + 1) <= 16) { t.ci[n] = i; t.cj[n] = j; ++n; }
    for (; n < 64; ++n) { t.ci[n] = -1; t.cj[n] = -1; } return t; }
__device__ __forceinline__ void phase_topk(const Args& a, LAS unsigned char* lds, int wave, int lane) {
    constexpr CandTab CT = make_cand();
    const int gw = blockIdx.x * NWAVES + wave, NGW = gridDim.x * NWAVES;
    const float* st = (const float*)(a.ws + WS_SCORES); int* eidx = (int*)(a.ws + WS_EIDX); float* eg = (float*)(a.ws + WS_EG);
    LAS unsigned char* tab = lds + wave * (64 * 36) + lane * 36;
    for (int it = gw; it < (T / 64) * 8; it += NGW) { const int tg = it >> 3, hh = it & 7; const int m = tg * 64 + lane;
        float A[16], B[16];
        top16_of_128(st + (size_t)((tg * 8 + hh) * 2 + 0) * 128 * 64 + lane, A);
        top16_of_128(st + (size_t)((tg * 8 + hh) * 2 + 1) * 128 * 64 + lane, B);
#pragma unroll
        for (int q = 0; q < 4; ++q) {
            const unsigned wa = (__float_as_uint(A[4 * q]) & 0x7Fu) | ((__float_as_uint(A[4 * q + 1]) & 0x7Fu) << 8) | ((__float_as_uint(A[4 * q + 2]) & 0x7Fu) << 16) | ((__float_as_uint(A[4 * q + 3]) & 0x7Fu) << 24);
            const unsigned wb = (__float_as_uint(B[4 * q]) & 0x7Fu) | ((__float_as_uint(B[4 * q + 1]) & 0x7Fu) << 8) | ((__float_as_uint(B[4 * q + 2]) & 0x7Fu) << 16) | ((__float_as_uint(B[4 * q + 3]) & 0x7Fu) << 24);
            *(LAS unsigned*)(tab + 4 * q) = wa; *(LAS unsigned*)(tab + 16 + 4 * q) = wb; }
#pragma unroll
        for (int i = 0; i < 16; ++i) { A[i] = __uint_as_float(__float_as_uint(A[i]) & ~0x7Fu); B[i] = __uint_as_float(__float_as_uint(B[i]) & ~0x7Fu); }
        float K[16];
#pragma unroll
        for (int c0 = 0; c0 < 64; c0 += 16) { float X[16];
#pragma unroll
            for (int i = 0; i < 16; ++i) { const int c = c0 + i;
                if (CT.ci[c] >= 0) X[i] = __uint_as_float((__float_as_uint(A[CT.ci[c] < 0 ? 0 : CT.ci[c]] + B[CT.cj[c] < 0 ? 0 : CT.cj[c]]) & ~0xFFu) | (unsigned)(CT.ci[c] * 16 + CT.cj[c]));
                else X[i] = -INFINITY; }
            sort16_desc(X);
            if (c0 == 0) {
#pragma unroll
                for (int i = 0; i < 16; ++i) K[i] = X[i]; }
            else merge_top16(K, X); }
        asm volatile("s_waitcnt lgkmcnt(0)" ::: "memory");
        int ex_[16]; float cs[16]; float sum = 0.f;
#pragma unroll
        for (int r = 0; r < 16; ++r) { const unsigned kb = __float_as_uint(K[r]); const int id = kb & 0xFF; cs[r] = __expf(__uint_as_float(kb & ~0xFFu) - __uint_as_float(__float_as_uint(K[0]) & ~0xFFu)); sum += cs[r];
            ex_[r] = (int)tab[id >> 4] * 128 + (int)tab[16 + (id & 15)]; }
        const float inv = 1.0f / sum;
        int* ep = eidx + (size_t)m * 128 + hh * 16; float* gp = eg + (size_t)m * 128 + hh * 16;
#pragma unroll
        for (int q = 0; q < 4; ++q) { *(int4*)(ep + 4 * q) = make_int4(ex_[4 * q], ex_[4 * q + 1], ex_[4 * q + 2], ex_[4 * q + 3]);
            *(f32x4*)(gp + 4 * q) = (f32x4){cs[4 * q] * inv, cs[4 * q + 1] * inv, cs[4 * q + 2] * inv, cs[4 * q + 3] * inv}; }
    }
}
__device__ __forceinline__ void unpack8(const u32x4 w, float (&f)[8]) {
    f[0] = bflo(w.x); f[1] = bfhi(w.x); f[2] = bflo(w.y); f[3] = bfhi(w.y); f[4] = bflo(w.z); f[5] = bfhi(w.z); f[6] = bflo(w.w); f[7] = bfhi(w.w); }
__device__ __forceinline__ void fp8x16_to_f32(const u32x4 w, float (&f)[16]) {
    f32x2v t;
    t = __builtin_amdgcn_cvt_pk_f32_fp8((int)w.x, false); f[0] = t.x; f[1] = t.y; t = __builtin_amdgcn_cvt_pk_f32_fp8((int)w.x, true); f[2] = t.x; f[3] = t.y;
    t = __builtin_amdgcn_cvt_pk_f32_fp8((int)w.y, false); f[4] = t.x; f[5] = t.y; t = __builtin_amdgcn_cvt_pk_f32_fp8((int)w.y, true); f[6] = t.x; f[7] = t.y;
    t = __builtin_amdgcn_cvt_pk_f32_fp8((int)w.z, false); f[8] = t.x; f[9] = t.y; t = __builtin_amdgcn_cvt_pk_f32_fp8((int)w.z, true); f[10] = t.x; f[11] = t.y;
    t = __builtin_amdgcn_cvt_pk_f32_fp8((int)w.w, false); f[12] = t.x; f[13] = t.y; t = __builtin_amdgcn_cvt_pk_f32_fp8((int)w.w, true); f[14] = t.x; f[15] = t.y;
}
__device__ __forceinline__ void peer_batch8(const unsigned char* uq, const unsigned char* vq, const float* su, const float* sv, int ev, float gv, int kl, float rstd, int lane,
                                            const float (&x)[16], float (&o)[16]) {
    int e[8]; u32x4 uw[8], vw[8]; float sc[8];
#pragma unroll
    for (int q = 0; q < 8; ++q) { e[q] = __builtin_amdgcn_readlane(ev, kl + q); uw[q] = *(const u32x4*)(uq + (size_t)e[q] * DM + 16 * lane); }
#pragma unroll
    for (int q = 0; q < 8; ++q) vw[q] = *(const u32x4*)(vq + (size_t)e[q] * DM + 16 * lane);
#pragma unroll
    for (int q = 0; q < 8; ++q) sc[q] = su[e[q]] * rstd;
    float d[8];
#pragma unroll
    for (int q = 0; q < 8; ++q) { float f[16]; fp8x16_to_f32(uw[q], f); float s0 = 0.f, s1 = 0.f;
#pragma unroll
        for (int i = 0; i < 16; i += 2) { s0 += f[i] * x[i]; s1 += f[i + 1] * x[i + 1]; }
        d[q] = s0 + s1; }
#pragma unroll
    for (int q = 0; q < 8; ++q) d[q] = wave_sum_dpp(d[q]);
#pragma unroll
    for (int q = 0; q < 8; ++q) { const float gq = __int_as_float(__builtin_amdgcn_readlane(__float_as_int(gv), kl + q));
        const float act = gelu_tanh(d[q] * sc[q]) * gq * sv[e[q]]; float f[16]; fp8x16_to_f32(vw[q], f);
#pragma unroll
        for (int i = 0; i < 16; ++i) o[i] += act * f[i]; }
}
__device__ __forceinline__ void phase_peer(const Args& a, int wave, int lane) {
    const int gw = blockIdx.x * NWAVES + wave, NGW = gridDim.x * NWAVES;
    const bf16_t* h1b = (const bf16_t*)(a.ws + WS_H1B); const unsigned char* uq = a.ws + WS_UB; const unsigned char* vq = a.ws + WS_VB;
    const float* su = (const float*)(a.ws + WS_SU); const float* sv = (const float*)(a.ws + WS_SV);
    const int* eidx = (const int*)(a.ws + WS_EIDX); const float* eg = (const float*)(a.ws + WS_EG); const float* rowss = (const float*)(a.ws + WS_ROWSS);
    const float* gfin = a.in[I_GFINAL] + 16 * lane;
    for (int m = gw; m < T; m += NGW) {
        float x[16]; { float t0[8], t1[8]; load8(h1b + (size_t)m * DM + 16 * lane, t0); load8(h1b + (size_t)m * DM + 16 * lane + 8, t1);
#pragma unroll
            for (int i = 0; i < 8; ++i) { x[i] = t0[i]; x[8 + i] = t1[i]; } }
        const float rstd = rsqrtf(rowss[m] * (1.f / DM) + EPSF);
        const int ev0 = eidx[(size_t)m * 128 + lane], ev1 = eidx[(size_t)m * 128 + 64 + lane];
        const float gv0 = eg[(size_t)m * 128 + lane], gv1 = eg[(size_t)m * 128 + 64 + lane];
        float o[16];
#pragma unroll
        for (int i = 0; i < 16; ++i) o[i] = 0.f;
#pragma unroll 1
        for (int kl = 0; kl < 64; kl += 8) peer_batch8(uq, vq, su, sv, ev0, gv0, kl, rstd, lane, x, o);
#pragma unroll 1
        for (int kl = 0; kl < 64; kl += 8) peer_batch8(uq, vq, su, sv, ev1, gv1, kl, rstd, lane, x, o);
        float* orow = a.out + (size_t)m * DM + 16 * lane;
        f32x4 h[4]; float ss = 0.f;
#pragma unroll
        for (int j = 0; j < 4; ++j) { h[j] = *(const f32x4*)(orow + 4 * j) + (f32x4){o[4 * j], o[4 * j + 1], o[4 * j + 2], o[4 * j + 3]};
            ss += (h[j].x * h[j].x + h[j].y * h[j].y) + (h[j].z * h[j].z + h[j].w * h[j].w); }
        const float r2 = rsqrtf(wave_sum_dpp(ss) * (1.f / DM) + EPSF);
#pragma unroll
        for (int j = 0; j < 4; ++j) *(f32x4*)(orow + 4 * j) = h[j] * r2 * *(const f32x4*)(gfin + 4 * j);
    }
}
typedef short bf16x8_t __attribute__((ext_vector_type(8)));
__device__ __forceinline__ bf16x8_t toep_frag(const LAS unsigned* R32, int base) {
    const int e = base >> 1, sh = (base & 1) * 16;
    const unsigned d0 = R32[e], d1 = R32[e + 1], d2 = R32[e + 2], d3 = R32[e + 3], d4 = R32[e + 4];
    u32x4 o; o.x = __builtin_amdgcn_alignbit(d1, d0, sh); o.y = __builtin_amdgcn_alignbit(d2, d1, sh); o.z = __builtin_amdgcn_alignbit(d3, d2, sh); o.w = __builtin_amdgcn_alignbit(d4, d3, sh);
    return __builtin_bit_cast(bf16x8_t, o);
}
__device__ __forceinline__ void hy_conv_channel(const Args& a, LAS unsigned char* lds, int c, int tid, int wave, int lane) {
    constexpr int UROW = SP * 2;
    LAS unsigned char* uus = lds;
    LAS unsigned short* R = (LAS unsigned short*)(lds + 8 * UROW);
    const bf16_t* uut = (const bf16_t*)(a.ws + WS_UUT); const bf16_t* kfb = (const bf16_t*)(a.ws + WS_KFB); bf16_t* cvt = (bf16_t*)(a.ws + WS_CONVT);
    { const u32x4* src = (const u32x4*)(uut + (size_t)c * NB * SP); for (int i = tid; i < 8 * UROW / 16; i += NTHR) ((LAS u32x4*)uus)[i] = src[i]; }
    for (int n = tid; n < KFW + 16; n += NTHR) R[n] = (n < KFW) ? kfb[(size_t)c * KFW + (KFW - 1) - n] : (unsigned short)0;
    __syncthreads();
    const LAS unsigned* R32 = (const LAS unsigned*)R;
    const int i = lane & 15, g = lane >> 4, p = (lane >> 3) & 1, b = lane & 7;
    f32x4 C[16]; bf16x8_t A[16];
    const int abase = LT - 32 * (1 + 16 * wave) - i + 8 * g;
#pragma unroll
    for (int tb = 0; tb < 16; ++tb) { C[tb] = (f32x4){0.f, 0.f, 0.f, 0.f}; A[tb] = toep_frag(R32, abase - 32 * tb); }
    const LAS unsigned char* bptr = uus + b * UROW + (16 * p + 8 * g) * 2;
#define HC_STEP(ph, n) do { A[(16 - (ph)) & 15] = toep_frag(R32, abase + 32 * (n)); const bf16x8_t Bf = *(const LAS bf16x8_t*)(bptr + (n) * 64); \
        _Pragma("unroll") for (int tb = 0; tb < 16; ++tb) C[tb] = __builtin_amdgcn_mfma_f32_16x16x32_bf16(A[(tb - (ph)) & 15], Bf, C[tb], 0, 0, 0); } while (0)
    for (int G = 0; G < 8; ++G) { const int n0 = G * 16;
        HC_STEP(0, n0); HC_STEP(1, n0 + 1); HC_STEP(2, n0 + 2); HC_STEP(3, n0 + 3); HC_STEP(4, n0 + 4); HC_STEP(5, n0 + 5); HC_STEP(6, n0 + 6); HC_STEP(7, n0 + 7);
        HC_STEP(8, n0 + 8); HC_STEP(9, n0 + 9); HC_STEP(10, n0 + 10); HC_STEP(11, n0 + 11); HC_STEP(12, n0 + 12); HC_STEP(13, n0 + 13); HC_STEP(14, n0 + 14); HC_STEP(15, n0 + 15); }
    HC_STEP(0, 128);
#undef HC_STEP
#pragma unroll
    for (int tb = 0; tb < 16; ++tb) { const int tq = 512 * wave + 32 * tb + 16 * p + 4 * g;
        u32x2 w; w.x = pk2(C[tb][0], C[tb][1]); w.y = pk2(C[tb][2], C[tb][3]);
        *(u32x2*)(cvt + ((size_t)c * NB + b) * SEQ + tq) = w; }
    __syncthreads();
}
__device__ __forceinline__ void rg_item(const Args& a, LAS unsigned char* lds, int it, int tid, int wave, int lane) {
    constexpr int XROW = 272;
    const int head = it & 7, dir = (it >> 3) & 1, b = it >> 4;
    const bf16_t* xb = (const bf16_t*)(a.ws + WS_RGX) + (size_t)b * LT * DRG + head * 128;
    bf16_t* hout = (bf16_t*)a.out + (size_t)dir * T * DRG + (size_t)b * SEQ * DRG + head * 128 + 16 * wave + (lane & 15);
    const int col = lane & 15, g = lane >> 4, ch = head * 128 + 16 * wave + col;
    LAS unsigned char* wl = lds + 2 * 64 * XROW + wave * 1024 + lane * 16;
#pragma unroll
    for (int gt = 0; gt < 2; ++gt)
#pragma unroll
        for (int ks = 0; ks < 4; ++ks) { const float* wp = a.in[I_RGGW] + ((size_t)((dir * 2 + gt) * 8 + head) * 128 + 32 * ks + 8 * g) * 128 + 16 * wave + col;
            u32x4 o; o.x = pk2(wp[0], wp[128]); o.y = pk2(wp[256], wp[384]); o.z = pk2(wp[512], wp[640]); o.w = pk2(wp[768], wp[896]); *(LAS u32x4*)(wl + (gt * 4 + ks) * 8192) = o; }
    const float br = a.in[I_RGGB][(size_t)(dir * 2 + 0) * DRG + ch], bi = a.in[I_RGGB][(size_t)(dir * 2 + 1) * DRG + ch];
    const float sp8 = -8.0f * log1pf(__expf(-a.in[I_RGLAM][dir * DRG + ch]));
    const int ctr = tid >> 4, ccg = tid & 15;
    float cwv[4][8], cbv[8];
#pragma unroll
    for (int i = 0; i < 8; ++i) { cbv[i] = a.in[I_RGCB][(size_t)dir * DRG + head * 128 + 8 * ccg + i];
#pragma unroll
        for (int j = 0; j < 4; ++j) cwv[j][i] = a.in[I_RGCW][((size_t)dir * 4 + j) * DRG + head * 128 + 8 * ccg + i]; }
    u32x4 xr[2][4];
#define RG_LOAD(k) do { _Pragma("unroll") for (int h_ = 0; h_ < 2; ++h_) { const int u_ = 64 * (k) + ctr + 32 * h_; _Pragma("unroll") for (int j = 0; j < 4; ++j) { const int uu_ = u_ - j; \
        if (uu_ >= 0 && uu_ < LT) { const int t_ = dir ? (LT - 1 - uu_) : uu_; xr[h_][j] = *(const u32x4*)(xb + (size_t)t_ * DRG + 8 * ccg); } \
        else xr[h_][j] = (u32x4){0u, 0u, 0u, 0u}; } } } while (0)
#define RG_CONV(k) do { _Pragma("unroll") for (int h_ = 0; h_ < 2; ++h_) { const int u_ = 64 * (k) + ctr + 32 * h_; float o_[8]; _Pragma("unroll") for (int i = 0; i < 8; ++i) o_[i] = (u_ < LT) ? cbv[i] : 0.f; \
        _Pragma("unroll") for (int j = 0; j < 4; ++j) { float f_[8]; unpack8(xr[h_][j], f_); _Pragma("unroll") for (int i = 0; i < 8; ++i) o_[i] += f_[i] * cwv[j][i]; } \
        u32x4 w0_; w0_.x = pk2(o_[0], o_[1]); w0_.y = pk2(o_[2], o_[3]); w0_.z = pk2(o_[4], o_[5]); w0_.w = pk2(o_[6], o_[7]); \
        *(LAS u32x4*)(lds + ((k) & 1) * (64 * XROW) + (ctr + 32 * h_) * XROW + ccg * 16) = w0_; } } while (0)
    RG_LOAD(0); RG_CONV(0); RG_LOAD(1);
    __syncthreads();
    float carry = 0.f;
    const int arow = 16 * (col >> 2) + (col & 3);
    for (int k = 0; k < 65; ++k) {
        if (k + 1 < 65) RG_CONV(k + 1);
        if (k + 2 < 65) RG_LOAD(k + 2);
        const LAS unsigned char* xa = lds + (k & 1) * (64 * XROW);
        unsigned hp[16]; float hh = 0.f, PP = 1.f;
#pragma unroll
        for (int mp = 0; mp < 2; ++mp) {
            f32x4 acc[2][2];
#pragma unroll
            for (int m2 = 0; m2 < 2; ++m2) { const int mb = 2 * mp + m2; acc[0][m2] = (f32x4){0.f, 0.f, 0.f, 0.f}; acc[1][m2] = (f32x4){0.f, 0.f, 0.f, 0.f};
#pragma unroll
                for (int ks = 0; ks < 4; ++ks) { const bf16x8_t Af = *(const LAS bf16x8_t*)(xa + (arow + 4 * mb) * XROW + (32 * ks + 8 * g) * 2);
                    acc[0][m2] = __builtin_amdgcn_mfma_f32_16x16x32_bf16(Af, *(const LAS bf16x8_t*)(wl + ks * 8192), acc[0][m2], 0, 0, 0);
                    acc[1][m2] = __builtin_amdgcn_mfma_f32_16x16x32_bf16(Af, *(const LAS bf16x8_t*)(wl + (4 + ks) * 8192), acc[1][m2], 0, 0, 0); } }
#pragma unroll
            for (int m2 = 0; m2 < 2; ++m2)
#pragma unroll
                for (int r = 0; r < 4; ++r) { const int e = 8 * mp + 4 * m2 + r, tau = 16 * g + e, u = 64 * k + tau;
                    const float rr = sigmoidf_(acc[0][m2][r] + br), ii = sigmoidf_(acc[1][m2][r] + bi);
                    float av = __expf(sp8 * rr); float mult = sqrtf(fmaxf(1.0f - av * av, 0.f)); mult = (u == 0) ? 1.0f : mult;
                    const float xcv = bf2f(*(const LAS unsigned short*)(xa + tau * XROW + (16 * wave + col) * 2));
                    float bq = mult * ii * xcv; if (u >= LT) { av = 1.f; bq = 0.f; }
                    hh = av * hh + bq; PP *= av; hp[e] = pk2(hh, PP); }
        }
        float Pg[4], hg[4];
#pragma unroll
        for (int q = 0; q < 4; ++q) { Pg[q] = __shfl(PP, col + 16 * q); hg[q] = __shfl(hh, col + 16 * q); }
        const float H0 = carry, H1 = Pg[0] * H0 + hg[0], H2 = Pg[1] * H1 + hg[1], H3 = Pg[2] * H2 + hg[2], H4 = Pg[3] * H3 + hg[3];
        const float Hin = (g == 0) ? H0 : (g == 1) ? H1 : (g == 2) ? H2 : H3;
        carry = H4;
#pragma unroll
        for (int e = 0; e < 16; ++e) { const int u = 64 * k + 16 * g + e; const int t = dir ? (LT - 1 - u) : u;
            if (u < LT && t >= NMETA) hout[(size_t)(t - NMETA) * DRG] = (bf16_t)f2bf(bflo(hp[e]) + bfhi(hp[e]) * Hin); }
        __syncthreads();
    }
#undef RG_LOAD
#undef RG_CONV
}

#ifndef RG_NAIVE
#define RG_NAIVE 0
#endif
#ifndef CONV_NAIVE
#define CONV_NAIVE 0
#endif
#ifndef ONE_LAUNCH
#define ONE_LAUNCH 0
#endif
constexpr int NPHASE = 10;
#ifndef NVGPR
#define NVGPR 248
#endif
__global__ void __launch_bounds__(NTHR, 2) __attribute__((amdgpu_num_vgpr(NVGPR))) mega(Args a) {
    extern __shared__ __attribute__((aligned(16))) unsigned char lds_raw[];
    LAS unsigned char* lds = (LAS unsigned char*)lds_raw;
    const int tid = threadIdx.x, lane = tid & 63, wave = __builtin_amdgcn_readfirstlane(tid >> 6);
    cg::grid_group grid = cg::this_grid();
    const int lo = a.ph_lo, hi = a.ph_hi, G = gridDim.x, bx = blockIdx.x;
#ifndef PHMASK
#define PHMASK 0x3ff
#endif
#ifndef REPMASK
#define REPMASK 0
#endif
#define IN(k) (((PHMASK >> (k)) & 1) && lo <= (k) && (k) < hi)
#define REP(k)
#define SEAM(k) do { if (IN(k) && IN((k) + 1)) grid.sync(); } while (0)
    unsigned char* ws = a.ws;
    REP(0) if (IN(0)) phase_p0(a, lds, tid, wave, lane);
    SEAM(0);
    REP(1) if (IN(1)) {
        pg8::Gemm g{(const bf16_t*)(ws + WS_XN1), (const bf16_t*)(ws + WS_WINT), T, DIN, 1024}; pg8::StaticOrder S; S.init(T, DIN, G, bx);
        EpiProj E{(bf16_t*)(ws + WS_HYIN), (bf16_t*)(ws + WS_RGX), (bf16_t*)(ws + WS_GG), (bf16_t*)(ws + WS_GA), (bf16_t*)(ws + WS_GB), a.in[I_BGATE]};
        pg8::gemm_phase<EpiProj, pg8::StaticOrder>(lds, g, S, E, nullptr);
    }
    SEAM(1);
    REP(2) if (IN(2)) phase_hy_pre(a, lds, tid);
    SEAM(2);
    REP(3) if (IN(3)) {
#if CONV_NAIVE
        phase_hy_conv_naive(a, lds, tid);
#else
        for (int c = bx; c < DHY; c += G) hy_conv_channel(a, lds, c, tid, wave, lane);
#endif
#if RG_NAIVE
        phase_rg_naive(a, lds, tid);
#else
        for (int it = bx; it < NB * 2 * 8; it += G) rg_item(a, lds, it, tid, wave, lane);
#endif
    }
    SEAM(3);
    REP(4) if (IN(4)) phase_post(a, lds, tid);
    SEAM(4);
    REP(5) if (IN(5)) {
        { pg8::Gemm g{(const bf16_t*)(ws + WS_YH), (const bf16_t*)(ws + WS_WHT), T, 1024, 512}; pg8::StaticOrder S; S.init(T, 1024, G, bx);
          EpiGate<0> E{(const bf16_t*)(ws + WS_GA), nullptr, (bf16_t*)(ws + WS_TMP)};
          pg8::gemm_phase<EpiGate<0>, pg8::StaticOrder>(lds, g, S, E, nullptr); }
        { pg8::Gemm g{(const bf16_t*)(ws + WS_YR), (const bf16_t*)(ws + WS_WRT), T, 1024, 1024}; pg8::StaticOrder S; S.init(T, 1024, G, bx);
          EpiGate<1> E{(const bf16_t*)(ws + WS_GB), (const bf16_t*)(ws + WS_TMP), (bf16_t*)(ws + WS_MERGED)};
          pg8::gemm_phase<EpiGate<1>, pg8::StaticOrder>(lds, g, S, E, nullptr); }
    }
    SEAM(5);
    REP(6) if (IN(6)) {
        pg8::Gemm g{(const bf16_t*)(ws + WS_MERGED), (const bf16_t*)(ws + WS_WOT), T, 1024, 1024}; pg8::StaticOrder S; S.init(T, 1024, G, bx);
        EpiResid E{a.in[I_X], a.out, (bf16_t*)(ws + WS_H1B), (float*)(ws + WS_ROWSS)};
        pg8::gemm_phase<EpiResid, pg8::StaticOrder>(lds, g, S, E, nullptr);
    }
    SEAM(6);
    REP(7) if (IN(7)) {
        phase_tables(a, wave, lane);
        pg8::Gemm g{(const bf16_t*)(ws + WS_H1B), (const bf16_t*)(ws + WS_WST), T, 2048, 1024}; pg8::StaticOrder S; S.init(T, 2048, G, bx);
        EpiScores E{(const float*)(ws + WS_ROWSS), (float*)(ws + WS_SCORES)};
        pg8::gemm_phase<EpiScores, pg8::StaticOrder>(lds, g, S, E, nullptr);
    }
    SEAM(7);
    REP(8) if (IN(8)) phase_topk(a, lds, wave, lane);
    SEAM(8);
    REP(9) if (IN(9)) phase_peer(a, wave, lane);
#undef IN
#undef SEAM
}

extern "C" void kernel_launch(void* const* d_in, const int* in_sizes, int n_in, void* d_out, int out_size, void* d_ws, size_t ws_size, hipStream_t stream) {
    static int grid = 0;
    if (grid == 0) {
        if (n_in != N_IN || out_size != T * DM || ws_size < WS_END) { fprintf(stderr, "kernel_launch: unexpected shapes (n_in %d out %d ws %zu)\n", n_in, out_size, ws_size); grid = -1; return; }
        if (hipFuncSetAttribute((const void*)mega, hipFuncAttributeMaxDynamicSharedMemorySize, LDS_BYTES) != hipSuccess) { fprintf(stderr, "kernel_launch: hipFuncSetAttribute failed\n"); grid = -1; return; }
        int dev = 0, cus = 0, per_cu = 0;
        hipGetDevice(&dev); hipDeviceGetAttribute(&cus, hipDeviceAttributeMultiprocessorCount, dev);
        hipOccupancyMaxActiveBlocksPerMultiprocessor(&per_cu, (const void*)mega, NTHR, LDS_BYTES);
        if (per_cu < 1) { fprintf(stderr, "kernel_launch: occupancy query says %d blocks per CU\n", per_cu); per_cu = 1; }
        (void)hipGetLastError();
        grid = cus;
    }
    if (grid < 0) return;
    Args a{};
    for (int i = 0; i < N_IN; ++i) a.in[i] = (const float*)d_in[i];
    a.out = (float*)d_out; a.ws = (unsigned char*)d_ws;
#if ONE_LAUNCH
    a.ph_lo = 0; a.ph_hi = NPHASE;
    void* args[] = {&a};
    hipError_t e = hipLaunchCooperativeKernel((const void*)mega, dim3(grid), dim3(NTHR), args, LDS_BYTES, stream);
    if (e != hipSuccess) fprintf(stderr, "cooperative launch failed: %s (grid %d)\n", hipGetErrorString(e), grid);
#else
    for (int ph = 0; ph < NPHASE; ++ph) for (int rep = 0; rep < 1 + ((REPMASK >> ph) & 1); ++rep) { a.ph_lo = ph; a.ph_hi = ph + 1;
        hipLaunchKernelGGL(mega, dim3(grid), dim3(NTHR), LDS_BYTES, stream, a);
        hipError_t e = hipPeekAtLastError(); if (e != hipSuccess) { fprintf(stderr, "launch %d failed: %s\n", ph, hipGetErrorString(e)); break; } }
#endif
}
```

```cpp
#define ONE_LAUNCH 1
#include <hip/hip_runtime.h>
#include <hip/hip_cooperative_groups.h>
#include <cstdio>
#include <cstdint>
#include <cmath>
namespace cg = cooperative_groups;
namespace pg8 {
#define PG8_LAS __attribute__((address_space(3)))
typedef unsigned short bf16_t;
typedef short bf16x8 __attribute__((ext_vector_type(8)));
typedef float f32x4 __attribute__((ext_vector_type(4)));
typedef unsigned u32x4 __attribute__((ext_vector_type(4)));
constexpr int BM = 256, BK = 64, HALF = 128, HTB = HALF * BK * 2  , STAGE_BYTES = 8 * HTB, NXCD = 8, WGM = 8;

__host__ __device__ __forceinline__ int lds_byte(int r, int c) { const int st = (r >> 4) * 2 + (c >> 5), rr = r & 15, cc = c & 31, ob = rr * 64 + cc * 2; return st * 1024 + (ob ^ (((ob >> 9) & 1) << 5)); }
__host__ __device__ __forceinline__ void stage_rc(int b, int& R, int& C) { const int st = b / 1024, sb = b % 1024, swz = sb ^ (((sb >> 9) & 1) << 5); R = (st >> 1) * 16 + swz / 64; C = (st & 1) * 32 + (swz % 64) / 2; }
__host__ __device__ __forceinline__ int perm32(int rho) { const int n = rho >> 4, i = rho & 15; return 8 * (i >> 2) + 4 * n + (i & 3); }

struct Unit { int pm, pn; };
struct Gemm { const bf16_t* A; const bf16_t* Bt; int M, N, K; };

struct StaticOrder {
    int nM, nN, nwg, G, c;
    __host__ __device__ void init(int M, int N, int G_, int c_) { nM = M / BM; nN = N / BM; nwg = nM * nN; G = G_; c = c_; }
    __host__ __device__ bool next(int i, Unit& u) const {
        const long L = (long)i * G + c; if (L >= nwg) return false;
        int wgid = (int)L; { const int q = nwg / NXCD, r = nwg % NXCD, xcd = wgid % NXCD, off = wgid / NXCD; wgid = (xcd < r ? xcd * (q + 1) : r * (q + 1) + (xcd - r) * q) + off; }
        const int nig = WGM * nN, gid = wgid / nig, fm = gid * WGM, gsz = (nM - fm) < WGM ? (nM - fm) : WGM;
        u.pm = fm + ((wgid % nig) % gsz); u.pn = (wgid % nig) / gsz; return true;
    }
    __device__ __forceinline__ void a_ready(const Unit&) const {}
    __device__ __forceinline__ void done(const Unit&) const {}
};
__device__ __forceinline__ unsigned cvt_pk_bf16(float lo, float hi) { unsigned r; asm volatile("v_cvt_pk_bf16_f32 %0, %1, %2" : "=v"(r) : "v"(lo), "v"(hi)); return r; }
typedef float f32x2 __attribute__((ext_vector_type(2)));
__device__ __forceinline__ f32x2 gelu_pk(f32x2 v) {
    const f32x2 av = __builtin_elementwise_abs(v), d = av * 0.2316418882f + 1.0f;
    f32x2 t; t.x = __builtin_amdgcn_rcpf(d.x); t.y = __builtin_amdgcn_rcpf(d.y);
    f32x2 q = t * 0.5307027145f + (-0.7265760135f); q = q * t + 0.7107068705f; q = q * t + (-0.142248368f); q = q * t + 0.127414796f; q = q * t;
    const f32x2 s = (v * v) * (-0.72134752044f);
    f32x2 e; e.x = __builtin_amdgcn_exp2f(s.x); e.y = __builtin_amdgcn_exp2f(s.y);
    const f32x2 m = v * (q * e), r = v - m;
    f32x2 o; o.x = v.x < 0.f ? m.x : r.x; o.y = v.y < 0.f ? m.y : r.y; return o;
}
template <class Epi, class Sched, bool STAMP = false>
__device__ __forceinline__ void gemm_phase(PG8_LAS unsigned char* lds, const Gemm g, const Sched& S, const Epi& E, unsigned long long* stamps) {
    const int tid = threadIdx.x, wid = __builtin_amdgcn_readfirstlane(tid >> 6), lane = tid & 63, wr = wid >> 2, wc = wid & 3, fr = lane & 15, fq = lane >> 4;
    const int K = g.K, nt = K / BK;
    int ts_lo = 0, ts_hi = 0, nts = 0; const unsigned long long rt_entry = STAMP ? (unsigned long long)wall_clock64() : 0ull;
#define PG8_STAMP() do { if (STAMP && wid == 0 && nts < 64) { const unsigned long long _c = (unsigned long long)clock64(); \
        ts_lo = (lane == nts) ? (int)(unsigned)_c : ts_lo; ts_hi = (lane == nts) ? (int)(unsigned)(_c >> 32) : ts_hi; ++nts; } } while (0)
    PG8_STAMP();
    unsigned voffA[2], voffB[2];
#pragma unroll
    for (int i = 0; i < 2; ++i) { int R, C; stage_rc(tid * 16 + i * 8192, R, C); const int Rb = Epi::PERM ? ((R & ~31) + perm32(R & 31)) : R;
        voffA[i] = (unsigned)(R * K + C) * 2u; voffB[i] = (unsigned)(Rb * K + C) * 2u; }
    const size_t kstep = (size_t)(BK * 2);
    const size_t hstep = (size_t)HALF * K * 2;
    const size_t tstep = 2 * hstep;
    const unsigned ldsw = (unsigned)wid * 1024u;
    const int aoff = lds_byte(wr * 64 + fr, fq * 8), boff = lds_byte(wc * 32 + fr, fq * 8);
#define PG8_SA(b, h) (((b) * 2 + (h)) * HTB)
#define PG8_SB(b, h) ((4 + (b) * 2 + (h)) * HTB)
#define PG8_STAGE(bufoff, gbase, voff) do { _Pragma("unroll") for (int _i = 0; _i < 2; ++_i) \
        __builtin_amdgcn_global_load_lds((const unsigned*)((const char*)(gbase) + (voff)[_i]), (PG8_LAS unsigned*)(lds + (bufoff) + ldsw + _i * 8192), 16, 0, 0); } while (0)
#define PG8_LDA(dst, b, h) do { _Pragma("unroll") for (int m = 0; m < 4; ++m) _Pragma("unroll") for (int k = 0; k < 2; ++k) dst[m][k] = *(const PG8_LAS bf16x8*)(lds + PG8_SA(b, h) + aoff + m * 2048 + k * 1024); } while (0)
#define PG8_LDB(dst, b, h) do { _Pragma("unroll") for (int n = 0; n < 2; ++n) _Pragma("unroll") for (int k = 0; k < 2; ++k) dst[n][k] = *(const PG8_LAS bf16x8*)(lds + PG8_SB(b, h) + boff + n * 2048 + k * 1024); } while (0)
#define PG8_MMA(ai, bj, At, Bt) do { __builtin_amdgcn_s_setprio(1); _Pragma("unroll") for (int m = 0; m < 4; ++m) _Pragma("unroll") for (int n = 0; n < 2; ++n) _Pragma("unroll") for (int k = 0; k < 2; ++k) \
        acc[ai][bj][m][n] = __builtin_amdgcn_mfma_f32_16x16x32_bf16(Bt[n][k], At[m][k], acc[ai][bj][m][n], 0, 0, 0); __builtin_amdgcn_s_setprio(0); } while (0)
#define PG8_WAIT_V(n) asm volatile("s_waitcnt vmcnt(" #n ")" ::: "memory")
#define PG8_WAIT_L(n) asm volatile("s_waitcnt lgkmcnt(" #n ")" ::: "memory")
#define PG8_BAR __builtin_amdgcn_s_barrier()
#define PG8_SCHED __builtin_amdgcn_sched_barrier(0)
    Unit cur, nxt; int ui = 0;
    if (!S.next(0, cur)) return;
    f32x4 acc[2][2][4][2];
#pragma unroll
    for (int a = 0; a < 2; ++a)
#pragma unroll
        for (int b = 0; b < 2; ++b)
#pragma unroll
            for (int m = 0; m < 4; ++m)
#pragma unroll
                for (int n = 0; n < 2; ++n) acc[a][b][m][n] = (f32x4){0.f, 0.f, 0.f, 0.f};
    bf16x8 At[4][2], B0[2][2], B1[2][2];
    const char* cA = (const char*)g.A + (size_t)cur.pm * tstep; const char* cB = (const char*)g.Bt + (size_t)cur.pn * tstep;
    S.a_ready(cur);
    PG8_STAGE(PG8_SB(0, 0), cB, voffB); PG8_STAGE(PG8_SA(0, 0), cA, voffA); PG8_STAGE(PG8_SB(0, 1), cB + hstep, voffB); PG8_STAGE(PG8_SA(0, 1), cA + hstep, voffA);
    if (wr == 1) PG8_BAR;
    PG8_WAIT_V(4); PG8_BAR;
    PG8_STAGE(PG8_SB(1, 0), cB + kstep, voffB); PG8_STAGE(PG8_SA(1, 0), cA + kstep, voffA); PG8_STAGE(PG8_SB(1, 1), cB + hstep + kstep, voffB);
    PG8_WAIT_V(6); PG8_BAR;
    PG8_STAMP();
    for (;;) {
        const bool has_next = S.next(ui + 1, nxt);
        const char* nA = has_next ? (const char*)g.A + (size_t)nxt.pm * tstep : cA; const char* nB = has_next ? (const char*)g.Bt + (size_t)nxt.pn * tstep : cB;
        for (int t = 0; t < nt; t += 2) {
            const bool last = (t == nt - 2);
            const char* a1 = cA + (size_t)(t + 1) * kstep;
            const char* a2 = last ? nA : cA + (size_t)(t + 2) * kstep; const char* b2 = last ? nB : cB + (size_t)(t + 2) * kstep;
            const char* a3 = a2 + kstep; const char* b3 = b2 + kstep;
            if (last && has_next) S.a_ready(nxt);
            PG8_LDB(B0, 0, 0); PG8_SCHED; PG8_LDA(At, 0, 0); PG8_STAGE(PG8_SA(1, 1), a1 + hstep, voffA);
            PG8_WAIT_L(8); PG8_BAR; PG8_WAIT_L(0); PG8_MMA(0, 0, At, B0); PG8_BAR; PG8_SCHED;
            PG8_LDB(B1, 0, 1); PG8_STAGE(PG8_SB(0, 0), b2, voffB);
            PG8_BAR; PG8_WAIT_L(0); PG8_MMA(0, 1, At, B1); PG8_BAR;
            PG8_LDA(At, 0, 1); PG8_STAGE(PG8_SA(0, 0), a2, voffA);
            PG8_BAR; PG8_WAIT_L(0); PG8_MMA(1, 0, At, B0); PG8_BAR; PG8_SCHED;
            PG8_STAGE(PG8_SB(0, 1), b2 + hstep, voffB);
            PG8_WAIT_V(6); PG8_BAR; PG8_MMA(1, 1, At, B1); PG8_BAR;
            PG8_LDB(B0, 1, 0); PG8_SCHED; PG8_LDA(At, 1, 0); PG8_STAGE(PG8_SA(0, 1), a2 + hstep, voffA);
            PG8_WAIT_L(8); PG8_BAR; PG8_WAIT_L(0); PG8_MMA(0, 0, At, B0); PG8_BAR; PG8_SCHED;
            PG8_LDB(B1, 1, 1); PG8_STAGE(PG8_SB(1, 0), b3, voffB);
            PG8_BAR; PG8_WAIT_L(0); PG8_MMA(0, 1, At, B1); PG8_BAR;
            PG8_LDA(At, 1, 1); PG8_STAGE(PG8_SA(1, 0), a3, voffA);
            PG8_BAR; PG8_WAIT_L(0); PG8_MMA(1, 0, At, B0); PG8_BAR; PG8_SCHED;
            PG8_STAGE(PG8_SB(1, 1), b3 + hstep, voffB);
            PG8_WAIT_V(6); PG8_BAR; PG8_MMA(1, 1, At, B1); PG8_BAR;
        }
        PG8_STAMP();
        if constexpr (!Epi::AFTER_DRAIN) { E(acc, cur, wr, wc, fr, fq); S.done(cur); }
        PG8_STAMP();
        if (!has_next) break;
#pragma unroll
        for (int a = 0; a < 2; ++a)
#pragma unroll
            for (int b = 0; b < 2; ++b)
#pragma unroll
                for (int m = 0; m < 4; ++m)
#pragma unroll
                    for (int n = 0; n < 2; ++n) acc[a][b][m][n] = (f32x4){0.f, 0.f, 0.f, 0.f};
        cur = nxt; cA = nA; cB = nB; ++ui;
    }
    PG8_WAIT_V(0);
    if (wr == 0) PG8_BAR;
    PG8_BAR;
    if constexpr (Epi::AFTER_DRAIN) { E.fused(acc, cur, wr, wc, fr, fq, lds, wid, lane); S.done(cur); }
    PG8_STAMP();
    if (STAMP && wid == 0) { stamps[lane] = lane < nts ? (((unsigned long long)(unsigned)ts_hi << 32) | (unsigned)ts_lo) : 0ull;
        if (lane == 62) stamps[62] = rt_entry; if (lane == 63) stamps[63] = (unsigned long long)wall_clock64(); }
#undef PG8_STAMP
#undef PG8_SA
#undef PG8_SB
#undef PG8_STAGE
#undef PG8_LDA
#undef PG8_LDB
#undef PG8_MMA
#undef PG8_WAIT_V
#undef PG8_WAIT_L
#undef PG8_BAR
#undef PG8_SCHED
}
}

#define LAS __attribute__((address_space(3)))
typedef unsigned short bf16_t;
typedef float f32x4 __attribute__((ext_vector_type(4)));
typedef float f32x2 __attribute__((ext_vector_type(2)));
typedef unsigned u32x4 __attribute__((ext_vector_type(4)));
typedef unsigned u32x2 __attribute__((ext_vector_type(2)));

constexpr int NB = 8, SEQ = 4096, NMETA = 16, LT = SEQ + NMETA, DM = 1024, T = NB * SEQ;
constexpr int DHY = 512, DRG = 1024, DIN = 3 * DHY + 2 * DRG + 2 * DM;
constexpr int NTHR = 512, NWAVES = 8;
constexpr int LDS_BYTES = 160 * 1024;
constexpr float EPSF = 1e-6f;
constexpr int KFW = 2 * LT;
constexpr int SP = 4256;
constexpr int NEXP = 16384;

enum { I_X = 0, I_META, I_GFINAL, I_GMIX, I_WIN, I_BGATE, I_HYCW, I_HYCB, I_HYW1, I_HYB1, I_HYW2, I_HYB2, I_HYW3, I_HYB3, I_HYFREQ, I_HYSKIP,
       I_HYOUT, I_RGCW, I_RGCB, I_RGGW, I_RGGB, I_RGLAM, I_RGOUT, I_WOUT, I_GFFN, I_WQ, I_KEYS, I_PU, I_PV, N_IN };

constexpr size_t MiB = 1024ull * 1024ull;
constexpr size_t WS_ROWSS = 64 * 1024;
constexpr size_t WS_SU = 256 * 1024;
constexpr size_t WS_SV = 320 * 1024;
constexpr size_t WS_ROWSS2 = 384 * 1024;
constexpr size_t WS_WINT = 1 * MiB;
constexpr size_t WS_WHT = 12 * MiB;
constexpr size_t WS_WRT = 13 * MiB;
constexpr size_t WS_WOT = 15 * MiB;
constexpr size_t WS_WST = 17 * MiB;
constexpr size_t WS_GWT = 21 * MiB;
constexpr size_t WS_KF = 22 * MiB;
constexpr size_t WS_KFB = 39 * MiB;
constexpr size_t WS_HYIN = 48 * MiB;
constexpr size_t WS_RGX = 145 * MiB;
constexpr size_t WS_GG = 210 * MiB;
constexpr size_t WS_GA = 274 * MiB;
constexpr size_t WS_GB = 338 * MiB;
constexpr size_t WS_XN1 = 402 * MiB;
constexpr size_t WS_UUT = 402 * MiB;
constexpr size_t WS_CONVT = 436 * MiB;
constexpr size_t WS_YH = 468 * MiB;
constexpr size_t WS_YR = WS_RGX;
constexpr size_t WS_MERGED = WS_HYIN;
constexpr size_t WS_TMP = WS_GG;
constexpr size_t WS_H1B = WS_RGX;
constexpr size_t WS_SCORES = WS_GG;
constexpr size_t WS_EIDX = 468 * MiB;
constexpr size_t WS_EG = 484 * MiB;
constexpr size_t WS_UB = 48 * MiB;
constexpr size_t WS_VB = 64 * MiB;
constexpr size_t WS_PD = 210 * MiB;
constexpr size_t WS_PO = WS_PD;
constexpr size_t WS_ACT = 338 * MiB;
constexpr size_t WS_END = 500 * MiB;

struct Args { const float* in[N_IN]; float* out; unsigned char* ws; int ph_lo, ph_hi; };

__device__ __forceinline__ float bf2f(unsigned v) { return __uint_as_float(v << 16); }
__device__ __forceinline__ unsigned f2bf(float f) { unsigned u = __float_as_uint(f); return (u + 0x7fffu + ((u >> 16) & 1u)) >> 16; }
__device__ __forceinline__ unsigned pk2(float lo, float hi) { return f2bf(lo) | (f2bf(hi) << 16); }
__device__ __forceinline__ float bflo(unsigned w) { return __uint_as_float(w << 16); }
__device__ __forceinline__ float bfhi(unsigned w) { return __uint_as_float(w & 0xffff0000u); }
__device__ __forceinline__ float wave_sum(float v) {
#pragma unroll
    for (int o = 1; o < 64; o <<= 1) v += __shfl_xor(v, o);
    return v;
}
__device__ __forceinline__ float wave_max(float v) {
#pragma unroll
    for (int o = 1; o < 64; o <<= 1) v = fmaxf(v, __shfl_xor(v, o));
    return v;
}
__device__ __forceinline__ float fexp(float x) { return __builtin_amdgcn_exp2f(x * 1.4426950408889634f); }
__device__ __forceinline__ float sigmoidf_(float x) { return __builtin_amdgcn_rcpf(1.0f + fexp(-x)); }
__device__ __forceinline__ float gelu_tanh(float x) { const float u = 1.5957691216f * (x + 0.044715f * x * x * x); return x * __builtin_amdgcn_rcpf(1.0f + fexp(-u)); }
__device__ __forceinline__ void sincos_acc(float a, float& s, float& c) {
    const double x = (double)a;
    const double q = rint(x * 0.63661977236758134308);
    const double r = fma(-q, 1.57079632679489661923, x);
    const int n = (int)q;
    const float rf = (float)r, r2 = rf * rf;
    const float sp = rf * (1.f + r2 * (-1.6666667e-1f + r2 * (8.3333333e-3f + r2 * (-1.9841270e-4f + r2 * 2.7557319e-6f))));
    const float cp = 1.f + r2 * (-0.5f + r2 * (4.1666667e-2f + r2 * (-1.3888889e-3f + r2 * (2.4801587e-5f + r2 * (-2.7557319e-7f)))));
    const int k = n & 3;
    s = (k == 0) ? sp : (k == 1) ? cp : (k == 2) ? -sp : -cp;
    c = (k == 0) ? cp : (k == 1) ? -sp : (k == 2) ? -cp : sp;
}

typedef float f32x2v __attribute__((ext_vector_type(2)));
__device__ __forceinline__ float wave_sum_dpp(float v) {
    v += __int_as_float(__builtin_amdgcn_update_dpp(0, __float_as_int(v), 0xB1, 0xF, 0xF, true));
    v += __int_as_float(__builtin_amdgcn_update_dpp(0, __float_as_int(v), 0x4E, 0xF, 0xF, true));
    v += __int_as_float(__builtin_amdgcn_update_dpp(0, __float_as_int(v), 0x141, 0xF, 0xF, true));
    v += __int_as_float(__builtin_amdgcn_update_dpp(0, __float_as_int(v), 0x140, 0xF, 0xF, true));
    const int vi = __float_as_int(v);
    return (__int_as_float(__builtin_amdgcn_readlane(vi, 0)) + __int_as_float(__builtin_amdgcn_readlane(vi, 16))) + (__int_as_float(__builtin_amdgcn_readlane(vi, 32)) + __int_as_float(__builtin_amdgcn_readlane(vi, 48)));
}
__device__ __forceinline__ float wave_max_dpp(float v) {
    v = fmaxf(v, __int_as_float(__builtin_amdgcn_update_dpp(0, __float_as_int(v), 0xB1, 0xF, 0xF, true)));
    v = fmaxf(v, __int_as_float(__builtin_amdgcn_update_dpp(0, __float_as_int(v), 0x4E, 0xF, 0xF, true)));
    v = fmaxf(v, __int_as_float(__builtin_amdgcn_update_dpp(0, __float_as_int(v), 0x141, 0xF, 0xF, true)));
    v = fmaxf(v, __int_as_float(__builtin_amdgcn_update_dpp(0, __float_as_int(v), 0x140, 0xF, 0xF, true)));
    const int vi = __float_as_int(v);
    return fmaxf(fmaxf(__int_as_float(__builtin_amdgcn_readlane(vi, 0)), __int_as_float(__builtin_amdgcn_readlane(vi, 16))), fmaxf(__int_as_float(__builtin_amdgcn_readlane(vi, 32)), __int_as_float(__builtin_amdgcn_readlane(vi, 48))));
}

#ifndef SLICE_PROBE
#define SLICE_OF(b) ((b) & 7)
#define RANK_OF(b) ((b) >> 3)
#else
#define SLICE_OF(b) ((b) >> 5)
#define RANK_OF(b) ((b) & 31)
#endif

__device__ __forceinline__ void p0_transpose_item(const float* W, int K, int N, bf16_t* WT, LAS float* scr, int item, int lane) {
    const int nblk = N / 32, kb = item / nblk, nb = item % nblk, k0 = 64 * kb, n0 = 32 * nb;
#pragma unroll 8
    for (int i = 0; i < 32; ++i) { const int kk = 2 * i + (lane >> 5); scr[kk * 33 + (lane & 31)] = W[(size_t)(k0 + kk) * N + n0 + (lane & 31)]; }
    asm volatile("s_waitcnt lgkmcnt(0)" ::: "memory");
    const int c = lane & 7;
#pragma unroll
    for (int j = 0; j < 4; ++j) { const int n = (lane >> 3) + 8 * j; const LAS float* s = scr + (8 * c) * 33 + n;
        u32x4 o; o.x = pk2(s[0 * 33], s[1 * 33]); o.y = pk2(s[2 * 33], s[3 * 33]); o.z = pk2(s[4 * 33], s[5 * 33]); o.w = pk2(s[6 * 33], s[7 * 33]);
        *(u32x4*)(WT + (size_t)(n0 + n) * K + k0 + 8 * c) = o; }
    asm volatile("s_waitcnt lgkmcnt(0)" ::: "memory");
}
__device__ __forceinline__ void p0_xn1_row(const float* xrow, const float* g, bf16_t* orow, int lane) {
    const f32x4* xr = (const f32x4*)xrow + lane; const f32x4* gr = (const f32x4*)g + lane;
    f32x4 v[4]; float s = 0.f;
#pragma unroll
    for (int j = 0; j < 4; ++j) { v[j] = xr[64 * j]; s += (v[j].x * v[j].x + v[j].y * v[j].y) + (v[j].z * v[j].z + v[j].w * v[j].w); }
    const float rstd = rsqrtf(wave_sum(s) * (1.f / DM) + EPSF);
    unsigned long long* o8 = (unsigned long long*)orow + lane;
#pragma unroll
    for (int j = 0; j < 4; ++j) { const f32x4 gv = gr[64 * j];
        o8[64 * j] = (unsigned long long)pk2(v[j].x * rstd * gv.x, v[j].y * rstd * gv.y) | ((unsigned long long)pk2(v[j].z * rstd * gv.z, v[j].w * rstd * gv.w) << 32); }
}
__device__ __forceinline__ void p0_fold_item(const Args& a, LAS unsigned char* lds, int item, int tid) {
    const int hp = item >> 4, k0 = (item & 15) * 64;
    LAS float* kl = (LAS float*)lds;
    LAS float* wl = (LAS float*)(lds + 128 * 129 * 4);
    const float* keys = a.in[I_KEYS] + (size_t)hp * 128 * 128; const float* wq = a.in[I_WQ];
    for (int i = tid; i < 128 * 128; i += NTHR) { const int key = i >> 7, d = i & 127; kl[key * 129 + d] = keys[i]; }
    for (int i = tid; i < 64 * 128; i += NTHR) { const int kk = i >> 7, d = i & 127; wl[i] = wq[(size_t)(k0 + kk) * 2048 + hp * 128 + d]; }
    __syncthreads();
    const int key = tid & 127, kq = tid >> 7;
    float acc[16];
#pragma unroll
    for (int i = 0; i < 16; ++i) acc[i] = 0.f;
#pragma unroll 2
    for (int d = 0; d < 128; ++d) { const float kv = kl[key * 129 + d];
#pragma unroll
        for (int i = 0; i < 16; ++i) acc[i] += wl[(kq * 16 + i) * 128 + d] * kv; }
    const float* gf = a.in[I_GFFN] + k0 + kq * 16;
    bf16_t* dst = (bf16_t*)(a.ws + WS_WST) + (size_t)(hp * 128 + key) * 1024 + k0 + kq * 16;
    u32x4 o0, o1;
    o0.x = pk2(acc[0] * gf[0], acc[1] * gf[1]); o0.y = pk2(acc[2] * gf[2], acc[3] * gf[3]); o0.z = pk2(acc[4] * gf[4], acc[5] * gf[5]); o0.w = pk2(acc[6] * gf[6], acc[7] * gf[7]);
    o1.x = pk2(acc[8] * gf[8], acc[9] * gf[9]); o1.y = pk2(acc[10] * gf[10], acc[11] * gf[11]); o1.z = pk2(acc[12] * gf[12], acc[13] * gf[13]); o1.w = pk2(acc[14] * gf[14], acc[15] * gf[15]);
    *(u32x4*)dst = o0; *(u32x4*)(dst + 8) = o1;
    __syncthreads();
}
__device__ __forceinline__ void p0_meta_item(const Args& a, LAS unsigned char* lds, int item, int tid, int wave, int lane) {
    LAS float* mt = (LAS float*)lds;
    for (int r = wave * 2; r < wave * 2 + 2; ++r) {
        const f32x4* xr = (const f32x4*)(a.in[I_META] + (size_t)r * DM) + lane; const f32x4* gr = (const f32x4*)a.in[I_GMIX] + lane;
        f32x4 v[4]; float s = 0.f;
#pragma unroll
        for (int j = 0; j < 4; ++j) { v[j] = xr[64 * j]; s += (v[j].x * v[j].x + v[j].y * v[j].y) + (v[j].z * v[j].z + v[j].w * v[j].w); }
        const float rstd = rsqrtf(wave_sum(s) * (1.f / DM) + EPSF);
#pragma unroll
        for (int j = 0; j < 4; ++j) { const f32x4 gv = gr[64 * j]; f32x4 o = v[j] * rstd * gv; *(LAS f32x4*)(mt + r * 1024 + 4 * (lane + 64 * j)) = o; }
    }
    __syncthreads();
    const int col = item * 256 + (tid & 255), rh = tid >> 8;
    float acc[8];
#pragma unroll
    for (int r = 0; r < 8; ++r) acc[r] = 0.f;
    const float* w = a.in[I_WIN] + col;
#pragma unroll 4
    for (int k = 0; k < 1024; ++k) { const float wv = w[(size_t)k * DIN];
#pragma unroll
        for (int r = 0; r < 8; ++r) acc[r] += mt[(rh * 8 + r) * 1024 + k] * wv; }
    bf16_t* hyin = (bf16_t*)(a.ws + WS_HYIN); bf16_t* rgx = (bf16_t*)(a.ws + WS_RGX);
#pragma unroll
    for (int r = 0; r < 8; ++r) { const int t = rh * 8 + r; const bf16_t v = (bf16_t)f2bf(acc[r]);
        for (int b = 0; b < NB; ++b) { if (col < 1536) hyin[((size_t)b * LT + t) * 1536 + col] = v; else rgx[((size_t)b * LT + t) * 1024 + (col - 1536)] = v; } }
    __syncthreads();
}
__device__ __forceinline__ void p0_filter_item(const Args& a, LAS unsigned char* lds, int item, int tid) {
    LAS float* z = (LAS float*)lds;
    LAS float* h1 = z + 16 * 33;
    LAS float* h2 = h1 + 16 * 64;
    LAS float* ko = h2 + 16 * 64;
    const int p0 = item * 16;
    for (int idx = tid; idx < 16 * 33; idx += NTHR) { const int pp = idx / 33, f = idx % 33, p = p0 + pp;
        float v;
        if (f == 0) v = (float)p * (1.0f / (float)(LT - 1));
        else { const int bi = (f - 1) & 15; const float band = 1e-4f + (float)bi * ((15.0f - 1e-4f) / 15.0f); const float w = (float)(6.283185307179586 / (double)LT) * (float)p;
            float s, c; sincos_acc(band * w, s, c); v = (f <= 16) ? c : -s; }
        z[idx] = v; }
    __syncthreads();
    const float* w1 = a.in[I_HYW1]; const float* b1 = a.in[I_HYB1]; const float* w2 = a.in[I_HYW2]; const float* b2 = a.in[I_HYB2];
    const float* w3 = a.in[I_HYW3]; const float* b3 = a.in[I_HYB3]; const float* fr = a.in[I_HYFREQ];
    for (int idx = tid; idx < 16 * 64; idx += NTHR) { const int pp = idx >> 6, j = idx & 63; float acc = b1[j];
#pragma unroll 3
        for (int f = 0; f < 33; ++f) acc += z[pp * 33 + f] * w1[f * 64 + j];
        float s, c; sincos_acc(fr[j] * acc, s, c); h1[idx] = s; }
    __syncthreads();
    for (int idx = tid; idx < 16 * 64; idx += NTHR) { const int pp = idx >> 6, j = idx & 63; float acc = b2[j];
#pragma unroll 4
        for (int f = 0; f < 64; ++f) acc += h1[pp * 64 + f] * w2[f * 64 + j];
        float s, c; sincos_acc(fr[64 + j] * acc, s, c); h2[idx] = s; }
    __syncthreads();
#pragma unroll 1
    for (int half = 0; half < 2; ++half) { const int o = half * 512 + tid;
        float acc[16];
#pragma unroll
        for (int pp = 0; pp < 16; ++pp) acc[pp] = b3[o];
#pragma unroll 2
        for (int i = 0; i < 64; ++i) { const float wv = w3[i * 1024 + o];
#pragma unroll
            for (int pp = 0; pp < 16; ++pp) acc[pp] += h2[pp * 64 + i] * wv; }
        const float delta = fabsf(-15.350567286626972f + (float)tid * ((-3.0701134573253945f + 15.350567286626972f) / 511.0f));
#pragma unroll
        for (int pp = 0; pp < 16; ++pp) { const float tn = (float)(p0 + pp) * (1.0f / (float)(LT - 1)); ko[o * 17 + pp] = acc[pp] * __expf(-tn * delta); }
    }
    __syncthreads();
    float* kf = (float*)(a.ws + WS_KF); bf16_t* kfb = (bf16_t*)(a.ws + WS_KFB);
    for (int idx = tid; idx < 1024 * 16; idx += NTHR) { const int o = idx >> 4, pp = idx & 15, dir = o >> 9, c = o & 511, p = p0 + pp;
        const float v = ko[o * 17 + pp];
        if (dir == 0) { kf[(size_t)c * KFW + (LT - 1) + p] = v; kfb[(size_t)c * KFW + (LT - 1) + p] = (bf16_t)f2bf(v); }
        else if (p >= 1) { kf[(size_t)c * KFW + (LT - 1) - p] = v; kfb[(size_t)c * KFW + (LT - 1) - p] = (bf16_t)f2bf(v); } }
    if (item == 0) for (int c = tid; c < 512; c += NTHR) { kf[(size_t)c * KFW + KFW - 1] = 0.f; kfb[(size_t)c * KFW + KFW - 1] = 0; }
    __syncthreads();
}
__device__ __forceinline__ void phase_p0(const Args& a, LAS unsigned char* lds, int tid, int wave, int lane) {
    const int G = gridDim.x, bx = blockIdx.x;
    { float* rs = (float*)(a.ws + WS_ROWSS); float* rs2 = (float*)(a.ws + WS_ROWSS2); for (int i = bx * NTHR + tid; i < T; i += G * NTHR) { rs[i] = 0.f; rs2[i] = 0.f; } }
    for (int it = bx; it < 256 + 257; it += G) {
#ifndef P0M
#define P0M 7
#endif
        if (it < 256) { if (P0M & 1) p0_fold_item(a, lds, it, tid); }
        else { if (P0M & 2) p0_filter_item(a, lds, it - 256, tid); }

    }
    LAS float* scr = (LAS float*)(lds + wave * 16384);
    const int gw = bx * NWAVES + wave, NGW = G * NWAVES;
    constexpr int I_IN = (1024 / 64) * (DIN / 32), I_H = (512 / 64) * (1024 / 32), I_R = (1024 / 64) * (1024 / 32), I_O = I_R;
    for (int it = gw; it < I_IN + I_H + I_R + I_O; it += NGW) {
        int r = it;
        if (r < I_IN) { p0_transpose_item(a.in[I_WIN], 1024, DIN, (bf16_t*)(a.ws + WS_WINT), scr, r, lane); continue; } r -= I_IN;
        if (r < I_H) { p0_transpose_item(a.in[I_HYOUT], 512, 1024, (bf16_t*)(a.ws + WS_WHT), scr, r, lane); continue; } r -= I_H;
        if (r < I_R) { p0_transpose_item(a.in[I_RGOUT], 1024, 1024, (bf16_t*)(a.ws + WS_WRT), scr, r, lane); continue; } r -= I_R;
        p0_transpose_item(a.in[I_WOUT], 1024, 1024, (bf16_t*)(a.ws + WS_WOT), scr, r, lane);
    }
    for (int m = gw; m < T; m += 2 * NGW) { p0_xn1_row(a.in[I_X] + (size_t)m * DM, a.in[I_GMIX], (bf16_t*)(a.ws + WS_XN1) + (size_t)m * DM, lane);
        if (m + NGW < T) p0_xn1_row(a.in[I_X] + (size_t)(m + NGW) * DM, a.in[I_GMIX], (bf16_t*)(a.ws + WS_XN1) + (size_t)(m + NGW) * DM, lane); }
}

__device__ __forceinline__ void p1_meta(const Args& a, LAS unsigned char* lds, int tid, int wave, int lane) {
    LAS float* mt = (LAS float*)lds;
    for (int r = wave * 2; r < wave * 2 + 2; ++r) {
        const f32x4* xr = (const f32x4*)(a.in[I_META] + (size_t)r * DM) + lane; const f32x4* gr = (const f32x4*)a.in[I_GMIX] + lane;
        f32x4 v[4]; float s = 0.f;
#pragma unroll
        for (int j = 0; j < 4; ++j) { v[j] = xr[64 * j]; s += (v[j].x * v[j].x + v[j].y * v[j].y) + (v[j].z * v[j].z + v[j].w * v[j].w); }
        const float rstd = rsqrtf(wave_sum(s) * (1.f / DM) + EPSF);
#pragma unroll
        for (int j = 0; j < 4; ++j) { const f32x4 gv = gr[64 * j]; f32x4 o = v[j] * rstd * gv; *(LAS f32x4*)(mt + r * 1024 + 4 * (lane + 64 * j)) = o; }
    }
    __syncthreads();
    const bf16_t* wint = (const bf16_t*)(a.ws + WS_WINT); bf16_t* hyin = (bf16_t*)(a.ws + WS_HYIN); bf16_t* rgx = (bf16_t*)(a.ws + WS_RGX);
    for (int cc = wave; cc < 10; cc += NWAVES) { const int n = blockIdx.x * 10 + cc; if (n >= 2560) break;
        float w[16]; { float t0[8], t1[8]; const bf16_t* wp = wint + (size_t)n * 1024; const u32x4 q0 = *(const u32x4*)(wp + 8 * lane), q1 = *(const u32x4*)(wp + 512 + 8 * lane);
            w[0] = bflo(q0.x); w[1] = bfhi(q0.x); w[2] = bflo(q0.y); w[3] = bfhi(q0.y); w[4] = bflo(q0.z); w[5] = bfhi(q0.z); w[6] = bflo(q0.w); w[7] = bfhi(q0.w);
            w[8] = bflo(q1.x); w[9] = bfhi(q1.x); w[10] = bflo(q1.y); w[11] = bfhi(q1.y); w[12] = bflo(q1.z); w[13] = bfhi(q1.z); w[14] = bflo(q1.w); w[15] = bfhi(q1.w); (void)t0; (void)t1; }
        float mine = 0.f;
#pragma unroll
        for (int r = 0; r < 16; ++r) { const LAS f32x4* mp = (const LAS f32x4*)(mt + r * 1024 + 8 * lane); const f32x4 m0 = mp[0], m1 = mp[1], m2 = mp[128], m3 = mp[129];
            float s = (w[0] * m0.x + w[1] * m0.y) + (w[2] * m0.z + w[3] * m0.w) + (w[4] * m1.x + w[5] * m1.y) + (w[6] * m1.z + w[7] * m1.w)
                    + (w[8] * m2.x + w[9] * m2.y) + (w[10] * m2.z + w[11] * m2.w) + (w[12] * m3.x + w[13] * m3.y) + (w[14] * m3.z + w[15] * m3.w);
            s = wave_sum_dpp(s); mine = ((lane & 15) == r) ? s : mine; }
        const bf16_t v = (bf16_t)f2bf(mine); const int t = lane & 15;
#pragma unroll
        for (int h = 0; h < 2; ++h) { const int b = (lane >> 4) + 4 * h;
            if (n < 1536) hyin[((size_t)b * LT + t) * 1536 + n] = v; else rgx[((size_t)b * LT + t) * 1024 + (n - 1536)] = v; }
    }
    __syncthreads();
}

typedef pg8::f32x4 pf4;
struct EpiProj {
    static constexpr bool PERM = true, AFTER_DRAIN = false;
    bf16_t *hyin, *rgx, *gg, *ga, *gb; const float* bgate;
    __device__ __forceinline__ void operator()(const pf4 (&acc)[2][2][4][2], const pg8::Unit& u, int wr, int wc, int fr, int fq) const {
        const int pn = u.pn, row0 = u.pm * 256 + wr * 64 + fr, cl0 = wc * 32 + 8 * fq;
#pragma unroll
        for (int ai = 0; ai < 2; ++ai)
#pragma unroll
            for (int m = 0; m < 4; ++m) { const int r = row0 + ai * 128 + m * 16; const size_t rl = (size_t)(r >> 12) * LT + NMETA + (r & 4095);
#pragma unroll
                for (int bj = 0; bj < 2; ++bj) { const int col = pn * 256 + bj * 128 + cl0; pf4 v0 = acc[ai][bj][m][0], v1 = acc[ai][bj][m][1]; bf16_t* dst;
                    if (pn < 6) dst = hyin + rl * 1536 + col;
                    else if (pn < 10) dst = rgx + rl * 1024 + (col - 1536);
                    else if (pn < 14) { dst = gg + (size_t)r * 1024 + (col - 2560);
#pragma unroll
                        for (int j = 0; j < 4; ++j) { v0[j] = gelu_tanh(v0[j]); v1[j] = gelu_tanh(v1[j]); } }
                    else { const int gc = col - 3584;
                        dst = (gc < 1024 ? ga + (size_t)r * 1024 + gc : gb + (size_t)r * 1024 + (gc - 1024));
                        const pf4 b0 = *(const pf4*)(bgate + gc), b1 = *(const pf4*)(bgate + gc + 4);
#pragma unroll
                        for (int j = 0; j < 4; ++j) { v0[j] = sigmoidf_(v0[j] + b0[j]); v1[j] = sigmoidf_(v1[j] + b1[j]); } }
                    u32x4 w; w.x = pk2(v0[0], v0[1]); w.y = pk2(v0[2], v0[3]); w.z = pk2(v1[0], v1[1]); w.w = pk2(v1[2], v1[3]);
                    *(u32x4*)dst = w; } }
    }
};
template <int MODE  > struct EpiGate {
    static constexpr bool PERM = true, AFTER_DRAIN = false;
    const bf16_t* gate; const bf16_t* tin; bf16_t* outp;
    __device__ __forceinline__ void operator()(const pf4 (&acc)[2][2][4][2], const pg8::Unit& u, int wr, int wc, int fr, int fq) const {
        const int row0 = u.pm * 256 + wr * 64 + fr, col0 = u.pn * 256 + wc * 32 + 8 * fq;
#pragma unroll
        for (int ai = 0; ai < 2; ++ai)
#pragma unroll
            for (int m = 0; m < 4; ++m) { const size_t ro = (size_t)(row0 + ai * 128 + m * 16) * 1024 + col0;
#pragma unroll
                for (int bj = 0; bj < 2; ++bj) { const size_t o = ro + bj * 128; const pf4 v0 = acc[ai][bj][m][0], v1 = acc[ai][bj][m][1];
                    const u32x4 g = *(const u32x4*)(gate + o);
                    float r[8];
                    r[0] = v0[0] * bflo(g.x); r[1] = v0[1] * bfhi(g.x); r[2] = v0[2] * bflo(g.y); r[3] = v0[3] * bfhi(g.y);
                    r[4] = v1[0] * bflo(g.z); r[5] = v1[1] * bfhi(g.z); r[6] = v1[2] * bflo(g.w); r[7] = v1[3] * bfhi(g.w);
                    if (MODE == 1) { const u32x4 t = *(const u32x4*)(tin + o);
                        r[0] += bflo(t.x); r[1] += bfhi(t.x); r[2] += bflo(t.y); r[3] += bfhi(t.y); r[4] += bflo(t.z); r[5] += bfhi(t.z); r[6] += bflo(t.w); r[7] += bfhi(t.w); }
                    u32x4 w; w.x = pk2(r[0], r[1]); w.y = pk2(r[2], r[3]); w.z = pk2(r[4], r[5]); w.w = pk2(r[6], r[7]);
                    *(u32x4*)(outp + o) = w; } }
    }
};
struct EpiResid {
    static constexpr bool PERM = true, AFTER_DRAIN = false;
    const float* x; bf16_t* h1b; float* rowss;
    __device__ __forceinline__ void operator()(const pf4 (&acc)[2][2][4][2], const pg8::Unit& u, int wr, int wc, int fr, int fq) const {
        const int row0 = u.pm * 256 + wr * 64 + fr, col0 = u.pn * 256 + wc * 32 + 8 * fq;
#pragma unroll
        for (int ai = 0; ai < 2; ++ai)
#pragma unroll
            for (int m = 0; m < 4; ++m) { const int r = row0 + ai * 128 + m * 16; const size_t ro = (size_t)r * 1024 + col0; float ss = 0.f;
#pragma unroll
                for (int bj = 0; bj < 2; ++bj) { const size_t o = ro + bj * 128;
                    const pf4 x0 = *(const pf4*)(x + o), x1 = *(const pf4*)(x + o + 4);
                    const pf4 v0 = acc[ai][bj][m][0] + x0, v1 = acc[ai][bj][m][1] + x1;
                    u32x4 w; w.x = pk2(v0[0], v0[1]); w.y = pk2(v0[2], v0[3]); w.z = pk2(v1[0], v1[1]); w.w = pk2(v1[2], v1[3]);
                    *(u32x4*)(h1b + o) = w;
                    ss += (v0[0] * v0[0] + v0[1] * v0[1]) + (v0[2] * v0[2] + v0[3] * v0[3]) + (v1[0] * v1[0] + v1[1] * v1[1]) + (v1[2] * v1[2] + v1[3] * v1[3]); }
                ss += __shfl_xor(ss, 16); ss += __shfl_xor(ss, 32);
                if (fq == 0) atomicAdd(rowss + r, ss); }
    }
};
struct EpiScores {
    static constexpr bool PERM = true, AFTER_DRAIN = false;
    const float* rowss; _Float16* sc;
    __device__ __forceinline__ void operator()(const pf4 (&acc)[2][2][4][2], const pg8::Unit& u, int wr, int wc, int fr, int fq) const {
        const int row0 = u.pm * 256 + wr * 64 + fr, k0 = wc * 32 + 8 * fq;
#pragma unroll
        for (int ai = 0; ai < 2; ++ai)
#pragma unroll
            for (int m = 0; m < 4; ++m) { const int r = row0 + ai * 128 + m * 16; const float rs = rsqrtf(rowss[r] * (1.f / DM) + EPSF);
#pragma unroll
                for (int bj = 0; bj < 2; ++bj) { _Float16* p = sc + ((size_t)(((r >> 6) * 8 + u.pn) * 2 + bj) * 128 + k0) * 64 + (r & 63);
#pragma unroll
                    for (int j = 0; j < 4; ++j) { p[j * 64] = (_Float16)(acc[ai][bj][m][0][j] * rs); p[(4 + j) * 64] = (_Float16)(acc[ai][bj][m][1][j] * rs); } } }
    }
};

__device__ __forceinline__ void load8(const bf16_t* p, float (&f)[8]) { const u32x4 w = *(const u32x4*)p;
    f[0] = bflo(w.x); f[1] = bfhi(w.x); f[2] = bflo(w.y); f[3] = bfhi(w.y); f[4] = bflo(w.z); f[5] = bfhi(w.z); f[6] = bflo(w.w); f[7] = bfhi(w.w); }
__device__ __forceinline__ void short_conv8(const bf16_t* hb, const float* cw, const float* cb, int s, int ch, float (&o)[8]) {
    float xm[8], x0[8], xp[8];
    if (s >= 1) load8(hb + (size_t)(s - 1) * 1536 + ch, xm); else {
#pragma unroll
        for (int i = 0; i < 8; ++i) xm[i] = 0.f; }
    load8(hb + (size_t)s * 1536 + ch, x0);
    if (s + 1 < LT) load8(hb + (size_t)(s + 1) * 1536 + ch, xp); else {
#pragma unroll
        for (int i = 0; i < 8; ++i) xp[i] = 0.f; }
#pragma unroll
    for (int i = 0; i < 8; ++i) o[i] = xm[i] * cw[ch + i] + x0[i] * cw[1536 + ch + i] + xp[i] * cw[3072 + ch + i] + cb[ch + i];
}
__device__ __forceinline__ void phase_hy_pre(const Args& a, LAS unsigned char* lds, int tid) {
    LAS bf16_t* tl = (LAS bf16_t*)lds;
    const bf16_t* hyin = (const bf16_t*)(a.ws + WS_HYIN); bf16_t* uut = (bf16_t*)(a.ws + WS_UUT);
    const float* cw = a.in[I_HYCW]; const float* cb = a.in[I_HYCB];
    for (int it = blockIdx.x; it < NB * 67 * 8; it += gridDim.x) {
        const int ct = it & 7, ts = (it >> 3) % 67, b = (it >> 3) / 67;
        { const int sr = tid >> 3, cg = tid & 7, c0 = ct * 64 + cg * 8, sp = ts * 64 + sr, s = sp - 16;
            float uu[8];
            if (s >= 0 && s < LT) { float x1[8], v[8]; const bf16_t* hb = hyin + (size_t)b * LT * 1536;
                short_conv8(hb, cw, cb, s, 512 + c0, x1); short_conv8(hb, cw, cb, s, 1024 + c0, v);
#pragma unroll
                for (int i = 0; i < 8; ++i) uu[i] = v[i] * x1[i]; }
            else {
#pragma unroll
                for (int i = 0; i < 8; ++i) uu[i] = 0.f; }
#pragma unroll
            for (int i = 0; i < 8; ++i) tl[sr * 72 + cg * 8 + i] = (bf16_t)f2bf(uu[i]); }
        __syncthreads();
        { const int cl = tid >> 3, sg = tid & 7, sp0 = ts * 64 + sg * 8;
            if (sp0 < SP) { u32x4 w; unsigned h[8];
#pragma unroll
                for (int i = 0; i < 8; ++i) h[i] = tl[(sg * 8 + i) * 72 + cl];
                w.x = h[0] | (h[1] << 16); w.y = h[2] | (h[3] << 16); w.z = h[4] | (h[5] << 16); w.w = h[6] | (h[7] << 16);
                *(u32x4*)(uut + ((size_t)(ct * 64 + cl) * NB + b) * SP + sp0) = w; } }
        __syncthreads();
    }
}
__device__ __forceinline__ void phase_hy_conv_naive(const Args& a, LAS unsigned char* lds, int tid) {
    LAS bf16_t* uus = (LAS bf16_t*)lds;
    LAS float* filt = (LAS float*)(lds + LT * 16);
    const bf16_t* uut = (const bf16_t*)(a.ws + WS_UUT); const float* kf = (const float*)(a.ws + WS_KF); bf16_t* cvt = (bf16_t*)(a.ws + WS_CONVT);
    for (int c = blockIdx.x; c < DHY; c += gridDim.x) {
        for (int i = tid; i < NB * LT; i += NTHR) { const int b = i / LT, s = i - b * LT; uus[s * 8 + b] = uut[((size_t)c * NB + b) * SP + 16 + s]; }
        for (int i = tid; i < KFW; i += NTHR) filt[i] = kf[(size_t)c * KFW + i];
        __syncthreads();
        for (int tt = 0; tt < 8; ++tt) { const int tq = tt * 512 + tid, t = tq + 16; float acc[8];
#pragma unroll
            for (int b = 0; b < 8; ++b) acc[b] = 0.f;
            const LAS float* fp = filt + (LT - 1) + t;
            for (int s = 0; s < LT; ++s) { const float kv = fp[-s]; const u32x4 w = *(const LAS u32x4*)(uus + s * 8);
                acc[0] += kv * bflo(w.x); acc[1] += kv * bfhi(w.x); acc[2] += kv * bflo(w.y); acc[3] += kv * bfhi(w.y);
                acc[4] += kv * bflo(w.z); acc[5] += kv * bfhi(w.z); acc[6] += kv * bflo(w.w); acc[7] += kv * bfhi(w.w); }
#pragma unroll
            for (int b = 0; b < 8; ++b) cvt[((size_t)c * NB + b) * SEQ + tq] = (bf16_t)f2bf(acc[b]); }
        __syncthreads();
    }
}
__device__ __forceinline__ void phase_rg_naive(const Args& a, LAS unsigned char* lds, int tid) {
    LAS float* xc = (LAS float*)lds;
    LAS float* gbuf = xc + 32 * 128;
    const bf16_t* rgx = (const bf16_t*)(a.ws + WS_RGX);
    for (int it = blockIdx.x; it < NB * 2 * 8; it += gridDim.x) {
        const int head = it & 7, dir = (it >> 3) & 1, b = it >> 4;
        const float* cw = a.in[I_RGCW] + (size_t)dir * 4 * DRG + head * 128; const float* cb = a.in[I_RGCB] + (size_t)dir * DRG + head * 128;
        bf16_t* hout = (bf16_t*)a.out + (size_t)dir * T * DRG;
        const bf16_t* xb = rgx + (size_t)b * LT * DRG + head * 128;
        float h = 0.f, sp = 0.f;
        if (tid < 128) { const float lam = a.in[I_RGLAM][dir * DRG + head * 128 + tid]; sp = log1pf(__expf(-lam)); }
        for (int k = 0; k < 129; ++k) {
            { const int tok = tid >> 4, cg = tid & 15, u = 32 * k + tok; float o[8];
#pragma unroll
                for (int i = 0; i < 8; ++i) o[i] = (u < LT) ? cb[cg * 8 + i] : 0.f;
                if (u < LT) {
#pragma unroll
                    for (int j = 0; j < 4; ++j) { const int uu = u - j; if (uu >= 0) { const int t = dir ? (LT - 1 - uu) : uu; float xv[8]; load8(xb + (size_t)t * DRG + cg * 8, xv);
#pragma unroll
                            for (int i = 0; i < 8; ++i) o[i] += xv[i] * cw[j * DRG + cg * 8 + i]; } } }
#pragma unroll
                for (int i = 0; i < 8; ++i) xc[tok * 128 + cg * 8 + i] = o[i]; }
            __syncthreads();
            { const int j = tid & 127, g = (tid >> 7) & 1, th = tid >> 8; float acc[16];
#pragma unroll
                for (int q = 0; q < 16; ++q) acc[q] = 0.f;
                const float* gw = a.in[I_RGGW] + ((size_t)((dir * 2 + g) * 8 + head) * 128) * 128 + j;
                for (int i = 0; i < 128; ++i) { const float wv = gw[i * 128];
#pragma unroll
                    for (int q = 0; q < 16; ++q) acc[q] += xc[(th * 16 + q) * 128 + i] * wv; }
                const float gb = a.in[I_RGGB][(size_t)(dir * 2 + g) * DRG + head * 128 + j];
#pragma unroll
                for (int q = 0; q < 16; ++q) gbuf[(g * 32 + th * 16 + q) * 128 + j] = acc[q] + gb; }
            __syncthreads();
            if (tid < 128) {
                for (int tok = 0; tok < 32; ++tok) { const int u = 32 * k + tok; if (u >= LT) break;
                    const float r = sigmoidf_(gbuf[tok * 128 + tid]), ig = sigmoidf_(gbuf[(32 + tok) * 128 + tid]);
                    const float la = -8.0f * r * sp; const float av = __expf(la); const float mult = (u == 0) ? 1.0f : sqrtf(-expm1f(2.0f * la));
                    h = av * h + mult * ig * xc[tok * 128 + tid];
                    const int t = dir ? (LT - 1 - u) : u;
                    if (t >= NMETA) hout[((size_t)b * SEQ + (t - NMETA)) * DRG + head * 128 + tid] = (bf16_t)f2bf(h); } }
            __syncthreads();
        }
    }
}
__device__ __forceinline__ void phase_post(const Args& a, LAS unsigned char* lds, int tid) {
    LAS bf16_t* cv = (LAS bf16_t*)lds;
    const bf16_t* hyin = (const bf16_t*)(a.ws + WS_HYIN); const bf16_t* cvt = (const bf16_t*)(a.ws + WS_CONVT); bf16_t* yh = (bf16_t*)(a.ws + WS_YH);
    const float* cw = a.in[I_HYCW]; const float* cb = a.in[I_HYCB]; const float* skip = a.in[I_HYSKIP];
    for (int it = blockIdx.x; it < NB * 64 * 8; it += gridDim.x) {
        const int ct = it & 7, tt = (it >> 3) & 63, b = it >> 9;
        { const int cl = tid >> 3, tg = tid & 7; const u32x4 w = *(const u32x4*)(cvt + ((size_t)(ct * 64 + cl) * NB + b) * SEQ + tt * 64 + tg * 8);
            *(LAS u32x4*)(cv + cl * 72 + tg * 8) = w; }
        __syncthreads();
        { const int tr = tid >> 3, cg = tid & 7, c0 = ct * 64 + cg * 8, t = NMETA + tt * 64 + tr; const bf16_t* hb = hyin + (size_t)b * LT * 1536;
            float x0[8], x1[8], v[8]; short_conv8(hb, cw, cb, t, c0, x0); short_conv8(hb, cw, cb, t, 512 + c0, x1); short_conv8(hb, cw, cb, t, 1024 + c0, v);
            float y[8];
#pragma unroll
            for (int i = 0; i < 8; ++i) { const float cvv = bf2f(cv[(cg * 8 + i) * 72 + tr]); y[i] = (cvv + v[i] * x1[i] * skip[c0 + i]) * x0[i]; }
            u32x4 w; w.x = pk2(y[0], y[1]); w.y = pk2(y[2], y[3]); w.z = pk2(y[4], y[5]); w.w = pk2(y[6], y[7]);
            *(u32x4*)(yh + ((size_t)b * SEQ + tt * 64 + tr) * DHY + c0) = w; }
        __syncthreads();
    }
    const bf16_t* hf = (const bf16_t*)a.out; const bf16_t* hb2 = hf + (size_t)T * DRG; const bf16_t* gg = (const bf16_t*)(a.ws + WS_GG); bf16_t* yr = (bf16_t*)(a.ws + WS_YR);
    for (size_t i = (size_t)blockIdx.x * NTHR + tid; i < (size_t)T * DRG / 8; i += (size_t)gridDim.x * NTHR) {
        float f[8], g[8], q[8]; load8(hf + i * 8, f); load8(hb2 + i * 8, g); load8(gg + i * 8, q);
        u32x4 w; w.x = pk2((f[0] + g[0]) * q[0], (f[1] + g[1]) * q[1]); w.y = pk2((f[2] + g[2]) * q[2], (f[3] + g[3]) * q[3]);
        w.z = pk2((f[4] + g[4]) * q[4], (f[5] + g[5]) * q[5]); w.w = pk2((f[6] + g[6]) * q[6], (f[7] + g[7]) * q[7]);
        *(u32x4*)(yr + i * 8) = w; }
}
__device__ __forceinline__ u32x4 quant_row16(const f32x4 (&v)[4], float amax, float& deq) {
    const float sc = (amax > 0.f) ? 256.0f / amax : 1.0f; deq = (amax > 0.f) ? amax * (1.0f / 256.0f) : 1.0f;
    u32x4 w; int t;
    t = __builtin_amdgcn_cvt_pk_fp8_f32(v[0].x * sc, v[0].y * sc, 0, false); t = __builtin_amdgcn_cvt_pk_fp8_f32(v[0].z * sc, v[0].w * sc, t, true); w.x = (unsigned)t;
    t = __builtin_amdgcn_cvt_pk_fp8_f32(v[1].x * sc, v[1].y * sc, 0, false); t = __builtin_amdgcn_cvt_pk_fp8_f32(v[1].z * sc, v[1].w * sc, t, true); w.y = (unsigned)t;
    t = __builtin_amdgcn_cvt_pk_fp8_f32(v[2].x * sc, v[2].y * sc, 0, false); t = __builtin_amdgcn_cvt_pk_fp8_f32(v[2].z * sc, v[2].w * sc, t, true); w.z = (unsigned)t;
    t = __builtin_amdgcn_cvt_pk_fp8_f32(v[3].x * sc, v[3].y * sc, 0, false); t = __builtin_amdgcn_cvt_pk_fp8_f32(v[3].z * sc, v[3].w * sc, t, true); w.w = (unsigned)t;
    return w;
}
__device__ __forceinline__ void phase_tables(const Args& a, int wave, int lane) {
    const int gw = blockIdx.x * NWAVES + wave, NGW = gridDim.x * NWAVES;
    const float* gf = a.in[I_GFFN] + 16 * lane; unsigned char* uq = a.ws + WS_UB; unsigned char* vq = a.ws + WS_VB; float* su = (float*)(a.ws + WS_SU); float* sv = (float*)(a.ws + WS_SV);
    f32x4 g[4];
#pragma unroll
    for (int j = 0; j < 4; ++j) g[j] = *(const f32x4*)(gf + 4 * j);
    for (int e = gw; e < NEXP; e += NGW) {
        const float* ur = a.in[I_PU] + (size_t)e * DM + 16 * lane; const float* vr = a.in[I_PV] + (size_t)e * DM + 16 * lane;
        f32x4 u[4], v[4]; float mu = 0.f, mv = 0.f;
#pragma unroll
        for (int j = 0; j < 4; ++j) { u[j] = *(const f32x4*)(ur + 4 * j) * g[j]; v[j] = *(const f32x4*)(vr + 4 * j);
            mu = fmaxf(mu, fmaxf(fmaxf(fabsf(u[j].x), fabsf(u[j].y)), fmaxf(fabsf(u[j].z), fabsf(u[j].w))));
            mv = fmaxf(mv, fmaxf(fmaxf(fabsf(v[j].x), fabsf(v[j].y)), fmaxf(fabsf(v[j].z), fabsf(v[j].w)))); }
        mu = wave_max_dpp(mu); mv = wave_max_dpp(mv);
        float du, dv; const u32x4 qu = quant_row16(u, mu, du), qv = quant_row16(v, mv, dv);
        { const size_t so = ((size_t)(lane >> 3) * NEXP + e) * 128 + 16 * (lane & 7); *(u32x4*)(uq + so) = qu; *(u32x4*)(vq + so) = qv; }
        if (lane == 0) { su[e] = du; sv[e] = dv; }
    }
}
__device__ __forceinline__ void ce_desc(float& a, float& b) { const float hi = fmaxf(a, b), lo = fminf(a, b); a = hi; b = lo; }
__device__ __forceinline__ void sort16_desc(float (&x)[16]) {
#pragma unroll
    for (int k = 2; k <= 16; k <<= 1)
#pragma unroll
        for (int j = k >> 1; j > 0; j >>= 1)
#pragma unroll
            for (int i = 0; i < 16; ++i) { const int l = i ^ j; if (l > i) { if ((i & k) == 0) ce_desc(x[i], x[l]); else ce_desc(x[l], x[i]); } }
}
__device__ __forceinline__ void merge_top16(float (&L)[16], const float (&X)[16]) {
#pragma unroll
    for (int i = 0; i < 16; ++i) L[i] = fmaxf(L[i], X[15 - i]);
#pragma unroll
    for (int j = 8; j > 0; j >>= 1)
#pragma unroll
        for (int i = 0; i < 16; ++i) { const int l = i ^ j; if (l > i) ce_desc(L[i], L[l]); }
}
__device__ __forceinline__ void top16_of_128(const _Float16* base  , float (&L)[16]) {
#pragma unroll 1
    for (int ch = 0; ch < 8; ++ch) { float X[16];
#pragma unroll
        for (int i = 0; i < 16; ++i) X[i] = __uint_as_float((__float_as_uint((float)base[(ch * 16 + i) * 64]) & ~0x7Fu) | (unsigned)(ch * 16 + i));
        sort16_desc(X);
        if (ch == 0) {
#pragma unroll
            for (int i = 0; i < 16; ++i) L[i] = X[i]; }
        else merge_top16(L, X); }
}
struct CandTab { int ci[64], cj[64]; };
__host__ __device__ constexpr CandTab make_cand() { CandTab t{}; int n = 0; for (int i = 0; i < 16; ++i) for (int j = 0; j < 16; ++j) if ((i + 1) * (j + 1) <= 16) { t.ci[n] = i; t.cj[n] = j; ++n; }
    for (; n < 64; ++n) { t.ci[n] = -1; t.cj[n] = -1; } return t; }
__device__ __forceinline__ void phase_topk(const Args& a, LAS unsigned char* lds, int wave, int lane) {
    constexpr CandTab CT = make_cand();
    const int gw = blockIdx.x * NWAVES + wave, NGW = gridDim.x * NWAVES;
    const _Float16* st = (const _Float16*)(a.ws + WS_SCORES); int* eidx = (int*)(a.ws + WS_EIDX); float* eg = (float*)(a.ws + WS_EG);
    LAS unsigned char* tab = lds + wave * (64 * 36) + lane * 36;
    for (int it = gw; it < (T / 64) * 8; it += NGW) { const int tg = it >> 3, hh = it & 7; const int m = tg * 64 + lane;
        float A[16], B[16];
        top16_of_128(st + (size_t)((tg * 8 + hh) * 2 + 0) * 128 * 64 + lane, A);
        top16_of_128(st + (size_t)((tg * 8 + hh) * 2 + 1) * 128 * 64 + lane, B);
#pragma unroll
        for (int q = 0; q < 4; ++q) {
            const unsigned wa = (__float_as_uint(A[4 * q]) & 0x7Fu) | ((__float_as_uint(A[4 * q + 1]) & 0x7Fu) << 8) | ((__float_as_uint(A[4 * q + 2]) & 0x7Fu) << 16) | ((__float_as_uint(A[4 * q + 3]) & 0x7Fu) << 24);
            const unsigned wb = (__float_as_uint(B[4 * q]) & 0x7Fu) | ((__float_as_uint(B[4 * q + 1]) & 0x7Fu) << 8) | ((__float_as_uint(B[4 * q + 2]) & 0x7Fu) << 16) | ((__float_as_uint(B[4 * q + 3]) & 0x7Fu) << 24);
            *(LAS unsigned*)(tab + 4 * q) = wa; *(LAS unsigned*)(tab + 16 + 4 * q) = wb; }
#pragma unroll
        for (int i = 0; i < 16; ++i) { A[i] = __uint_as_float(__float_as_uint(A[i]) & ~0x7Fu); B[i] = __uint_as_float(__float_as_uint(B[i]) & ~0x7Fu); }
        float K[16];
#pragma unroll
        for (int c0 = 0; c0 < 64; c0 += 16) { float X[16];
#pragma unroll
            for (int i = 0; i < 16; ++i) { const int c = c0 + i;
                if (CT.ci[c] >= 0) X[i] = __uint_as_float((__float_as_uint(A[CT.ci[c] < 0 ? 0 : CT.ci[c]] + B[CT.cj[c] < 0 ? 0 : CT.cj[c]]) & ~0xFFu) | (unsigned)(CT.ci[c] * 16 + CT.cj[c]));
                else X[i] = -INFINITY; }
            sort16_desc(X);
            if (c0 == 0) {
#pragma unroll
                for (int i = 0; i < 16; ++i) K[i] = X[i]; }
            else merge_top16(K, X); }
        asm volatile("s_waitcnt lgkmcnt(0)" ::: "memory");
        int ex_[16]; float cs[16]; float sum = 0.f;
#pragma unroll
        for (int r = 0; r < 16; ++r) { const unsigned kb = __float_as_uint(K[r]); const int id = kb & 0xFF; cs[r] = __expf(__uint_as_float(kb & ~0xFFu) - __uint_as_float(__float_as_uint(K[0]) & ~0xFFu)); sum += cs[r];
            ex_[r] = (int)tab[id >> 4] * 128 + (int)tab[16 + (id & 15)]; }
        const float inv = 1.0f / sum;
        unsigned short* ep = (unsigned short*)eidx + (size_t)m * 128 + hh * 16; float* gp = eg + (size_t)m * 128 + hh * 16;
        { u32x4 p0, p1; p0.x = ex_[0] | (ex_[1] << 16); p0.y = ex_[2] | (ex_[3] << 16); p0.z = ex_[4] | (ex_[5] << 16); p0.w = ex_[6] | (ex_[7] << 16);
          p1.x = ex_[8] | (ex_[9] << 16); p1.y = ex_[10] | (ex_[11] << 16); p1.z = ex_[12] | (ex_[13] << 16); p1.w = ex_[14] | (ex_[15] << 16); *(u32x4*)ep = p0; *(u32x4*)(ep + 8) = p1; }
#pragma unroll
        for (int q = 0; q < 4; ++q) {
            *(f32x4*)(gp + 4 * q) = (f32x4){cs[4 * q] * inv, cs[4 * q + 1] * inv, cs[4 * q + 2] * inv, cs[4 * q + 3] * inv}; }
    }
}
__device__ __forceinline__ void unpack8(const u32x4 w, float (&f)[8]) {
    f[0] = bflo(w.x); f[1] = bfhi(w.x); f[2] = bflo(w.y); f[3] = bfhi(w.y); f[4] = bflo(w.z); f[5] = bfhi(w.z); f[6] = bflo(w.w); f[7] = bfhi(w.w); }
__device__ __forceinline__ void fp8x16_to_f32(const u32x4 w, float (&f)[16]) {
    f32x2v t;
    t = __builtin_amdgcn_cvt_pk_f32_fp8((int)w.x, false); f[0] = t.x; f[1] = t.y; t = __builtin_amdgcn_cvt_pk_f32_fp8((int)w.x, true); f[2] = t.x; f[3] = t.y;
    t = __builtin_amdgcn_cvt_pk_f32_fp8((int)w.y, false); f[4] = t.x; f[5] = t.y; t = __builtin_amdgcn_cvt_pk_f32_fp8((int)w.y, true); f[6] = t.x; f[7] = t.y;
    t = __builtin_amdgcn_cvt_pk_f32_fp8((int)w.z, false); f[8] = t.x; f[9] = t.y; t = __builtin_amdgcn_cvt_pk_f32_fp8((int)w.z, true); f[10] = t.x; f[11] = t.y;
    t = __builtin_amdgcn_cvt_pk_f32_fp8((int)w.w, false); f[12] = t.x; f[13] = t.y; t = __builtin_amdgcn_cvt_pk_f32_fp8((int)w.w, true); f[14] = t.x; f[15] = t.y;
}
__device__ __forceinline__ void fp8x16_to_f32x2(const u32x4 w, f32x2v (&f)[8]) {
    f[0] = __builtin_amdgcn_cvt_pk_f32_fp8((int)w.x, false); f[1] = __builtin_amdgcn_cvt_pk_f32_fp8((int)w.x, true);
    f[2] = __builtin_amdgcn_cvt_pk_f32_fp8((int)w.y, false); f[3] = __builtin_amdgcn_cvt_pk_f32_fp8((int)w.y, true);
    f[4] = __builtin_amdgcn_cvt_pk_f32_fp8((int)w.z, false); f[5] = __builtin_amdgcn_cvt_pk_f32_fp8((int)w.z, true);
    f[6] = __builtin_amdgcn_cvt_pk_f32_fp8((int)w.w, false); f[7] = __builtin_amdgcn_cvt_pk_f32_fp8((int)w.w, true);
}
__device__ __forceinline__ float dpp_sum8(float v) {
    v += __int_as_float(__builtin_amdgcn_update_dpp(0, __float_as_int(v), 0xB1, 0xF, 0xF, true));
    v += __int_as_float(__builtin_amdgcn_update_dpp(0, __float_as_int(v), 0x4E, 0xF, 0xF, true));
    v += __int_as_float(__builtin_amdgcn_update_dpp(0, __float_as_int(v), 0x141, 0xF, 0xF, true));
    return v;
}
struct UTok { u32x4 e0, e1, xa, xb; };
struct VTok { u32x4 e0, e1; f32x4 av[4]; };
__device__ __forceinline__ void pu_issue(const unsigned char* tab, unsigned loff, const u32x4& e, u32x4 (&w)[8]) {
    w[0] = *(const u32x4*)(tab + ((e.x & 0xffffu) * 128u + loff)); w[1] = *(const u32x4*)(tab + ((e.x >> 16) * 128u + loff));
    w[2] = *(const u32x4*)(tab + ((e.y & 0xffffu) * 128u + loff)); w[3] = *(const u32x4*)(tab + ((e.y >> 16) * 128u + loff));
    w[4] = *(const u32x4*)(tab + ((e.z & 0xffffu) * 128u + loff)); w[5] = *(const u32x4*)(tab + ((e.z >> 16) * 128u + loff));
    w[6] = *(const u32x4*)(tab + ((e.w & 0xffffu) * 128u + loff)); w[7] = *(const u32x4*)(tab + ((e.w >> 16) * 128u + loff));
}
__device__ __forceinline__ float pu_compute(const f32x2v (&x)[8], const u32x4 (&w)[8], int i) {
    float keep = 0.f;
#pragma unroll
    for (int q = 0; q < 8; ++q) { f32x2v f[8]; fp8x16_to_f32x2(w[q], f); f32x2v s0 = f[0] * x[0], s1 = f[1] * x[1];
#pragma unroll
        for (int c = 2; c < 8; c += 2) { s0 += f[c] * x[c]; s1 += f[c + 1] * x[c + 1]; }
        s0 += s1; const float d = dpp_sum8(s0.x + s0.y); keep = (q == i) ? d : keep; }
    return keep;
}
__device__ __forceinline__ void phase_peer_u(const Args& a, int wave, int lane) {
    const int s = SLICE_OF(blockIdx.x), rk = RANK_OF(blockIdx.x), nrk = gridDim.x >> 3, tper = T / nrk, i = lane & 7, j = lane >> 3;
    const bf16_t* h1b = (const bf16_t*)(a.ws + WS_H1B) + 128 * s + 16 * i; const unsigned char* uqs = a.ws + WS_UB + (size_t)s * NEXP * 128; const unsigned loff = 16u * (unsigned)i;
    const unsigned short* eidx = (const unsigned short*)(a.ws + WS_EIDX) + 16 * j; float* pd = (float*)(a.ws + WS_PD) + (size_t)s * T * 128 + 16 * j + i;
    const int m0 = rk * tper + wave, mlast = (rk + 1) * tper - NWAVES + wave;
#define PU_LOAD(t, mm) do { const int m_ = (mm) < mlast ? (mm) : mlast; const u32x4* ep_ = (const u32x4*)(eidx + (size_t)m_ * 128); (t).e0 = ep_[0]; (t).e1 = ep_[1]; \
        (t).xa = *(const u32x4*)(h1b + (size_t)m_ * DM); (t).xb = *(const u32x4*)(h1b + (size_t)m_ * DM + 8); } while (0)
#define PU_DO(t, w0, w1, mm) do { f32x2v x[8]; \
        x[0] = (f32x2v){bflo((t).xa.x), bfhi((t).xa.x)}; x[1] = (f32x2v){bflo((t).xa.y), bfhi((t).xa.y)}; x[2] = (f32x2v){bflo((t).xa.z), bfhi((t).xa.z)}; x[3] = (f32x2v){bflo((t).xa.w), bfhi((t).xa.w)}; \
        x[4] = (f32x2v){bflo((t).xb.x), bfhi((t).xb.x)}; x[5] = (f32x2v){bflo((t).xb.y), bfhi((t).xb.y)}; x[6] = (f32x2v){bflo((t).xb.z), bfhi((t).xb.z)}; x[7] = (f32x2v){bflo((t).xb.w), bfhi((t).xb.w)}; \
        const float k0_ = pu_compute(x, w0, i), k1_ = pu_compute(x, w1, i); pd[(size_t)(mm) * 128] = k0_; pd[(size_t)(mm) * 128 + 8] = k1_; } while (0)
    UTok tC, tN, tNN; u32x4 wA[8], wB[8], wC[8], wD[8];
    PU_LOAD(tC, m0); PU_LOAD(tN, m0 + NWAVES); PU_LOAD(tNN, m0 + 2 * NWAVES); pu_issue(uqs, loff, tC.e0, wA); pu_issue(uqs, loff, tC.e1, wB);
    for (int m = m0; m <= mlast; m += 2 * NWAVES) {
        pu_issue(uqs, loff, tN.e0, wC); pu_issue(uqs, loff, tN.e1, wD);
        PU_DO(tC, wA, wB, m);
        tC = tN; tN = tNN; PU_LOAD(tNN, m + 3 * NWAVES);
        pu_issue(uqs, loff, tN.e0, wA); pu_issue(uqs, loff, tN.e1, wB);
        PU_DO(tC, wC, wD, m + NWAVES);
        tC = tN; tN = tNN; PU_LOAD(tNN, m + 4 * NWAVES);
    }
#undef PU_LOAD
#undef PU_DO
}
__device__ __forceinline__ void phase_peer_act(const Args& a, int tid) {
    const float* pd = (const float*)(a.ws + WS_PD); const unsigned short* eidx = (const unsigned short*)(a.ws + WS_EIDX); const float* eg = (const float*)(a.ws + WS_EG);
    const float* su = (const float*)(a.ws + WS_SU); const float* sv = (const float*)(a.ws + WS_SV); const float* rowss = (const float*)(a.ws + WS_ROWSS); float* act = (float*)(a.ws + WS_ACT);
    for (size_t i4 = (size_t)blockIdx.x * NTHR + tid; i4 < (size_t)T * 32; i4 += (size_t)gridDim.x * NTHR) { const size_t idx = i4 * 4;
        f32x4 d = *(const f32x4*)(pd + idx);
#pragma unroll
        for (int s = 1; s < 8; ++s) d += *(const f32x4*)(pd + (size_t)s * T * 128 + idx);
        const u32x2 ew = *(const u32x2*)(eidx + idx); const f32x4 g = *(const f32x4*)(eg + idx); const float rstd = rsqrtf(rowss[idx >> 7] * (1.f / DM) + EPSF);
        const unsigned e0 = ew.x & 0xffffu, e1 = ew.x >> 16, e2 = ew.y & 0xffffu, e3 = ew.y >> 16;
        f32x4 o; o.x = gelu_tanh(d.x * su[e0] * rstd) * g.x * sv[e0]; o.y = gelu_tanh(d.y * su[e1] * rstd) * g.y * sv[e1];
        o.z = gelu_tanh(d.z * su[e2] * rstd) * g.z * sv[e2]; o.w = gelu_tanh(d.w * su[e3] * rstd) * g.w * sv[e3];
        *(f32x4*)(act + idx) = o;
    }
}
__device__ __forceinline__ void pv_accum(const u32x4 (&w)[8], const f32x4& a0, const f32x4& a1, f32x2v (&o)[8]) {
#pragma unroll
    for (int q = 0; q < 8; ++q) { f32x2v f[8]; fp8x16_to_f32x2(w[q], f); const float aq = (q < 4) ? a0[q & 3] : a1[q & 3]; const f32x2v a2 = (f32x2v){aq, aq};
#pragma unroll
        for (int c = 0; c < 8; ++c) o[c] += a2 * f[c]; }
}
__device__ __forceinline__ void pv_finish(const f32x2v (&o2)[8], float* orow, int j) {
    float o[16];
#pragma unroll
    for (int c = 0; c < 8; ++c) { o[2 * c] = o2[c].x; o[2 * c + 1] = o2[c].y; }
#pragma unroll
    for (int c = 0; c < 16; ++c) { o[c] += __int_as_float(__builtin_amdgcn_update_dpp(0, __float_as_int(o[c]), 0x128, 0xF, 0xF, true));
        o[c] += __shfl_xor(o[c], 16); o[c] += __shfl_xor(o[c], 32); }
    if (j == 0) {
#pragma unroll
        for (int c4 = 0; c4 < 4; ++c4) *(f32x4*)(orow + 4 * c4) = (f32x4){o[4 * c4], o[4 * c4 + 1], o[4 * c4 + 2], o[4 * c4 + 3]}; }
}
__device__ __forceinline__ void phase_peer_v(const Args& a, int wave, int lane) {
    const int s = SLICE_OF(blockIdx.x), rk = RANK_OF(blockIdx.x), nrk = gridDim.x >> 3, tper = T / nrk, i = lane & 7, j = lane >> 3;
    const unsigned char* vqs = a.ws + WS_VB + (size_t)s * NEXP * 128; const unsigned loff = 16u * (unsigned)i;
    const unsigned short* eidx = (const unsigned short*)(a.ws + WS_EIDX) + 16 * j; const float* act = (const float*)(a.ws + WS_ACT) + 16 * j;
    float* obase = (float*)(a.ws + WS_PO) + 128 * s + 16 * i;
    const int m0 = rk * tper + wave, mlast = (rk + 1) * tper - NWAVES + wave;
#define PV_LOAD(t, mm) do { const int m_ = (mm) < mlast ? (mm) : mlast; const u32x4* ep_ = (const u32x4*)(eidx + (size_t)m_ * 128); const f32x4* ap_ = (const f32x4*)(act + (size_t)m_ * 128); \
        (t).e0 = ep_[0]; (t).e1 = ep_[1]; (t).av[0] = ap_[0]; (t).av[1] = ap_[1]; (t).av[2] = ap_[2]; (t).av[3] = ap_[3]; } while (0)
#define PV_DO(t, w0, w1, mm) do { f32x2v o[8]; _Pragma("unroll") for (int c = 0; c < 8; ++c) o[c] = (f32x2v){0.f, 0.f}; \
        pv_accum(w0, (t).av[0], (t).av[1], o); pv_accum(w1, (t).av[2], (t).av[3], o); pv_finish(o, obase + (size_t)(mm) * DM, j); } while (0)
    VTok tC, tN, tNN; u32x4 wA[8], wB[8], wC[8], wD[8];
    PV_LOAD(tC, m0); PV_LOAD(tN, m0 + NWAVES); PV_LOAD(tNN, m0 + 2 * NWAVES); pu_issue(vqs, loff, tC.e0, wA); pu_issue(vqs, loff, tC.e1, wB);
    for (int m = m0; m <= mlast; m += 2 * NWAVES) {
        pu_issue(vqs, loff, tN.e0, wC); pu_issue(vqs, loff, tN.e1, wD);
        PV_DO(tC, wA, wB, m);
        tC = tN; tN = tNN; PV_LOAD(tNN, m + 3 * NWAVES);
        pu_issue(vqs, loff, tN.e0, wA); pu_issue(vqs, loff, tN.e1, wB);
        PV_DO(tC, wC, wD, m + NWAVES);
        tC = tN; tN = tNN; PV_LOAD(tNN, m + 4 * NWAVES);
    }
#undef PV_LOAD
#undef PV_DO
}
__device__ __forceinline__ void phase_final(const Args& a, int wave, int lane) {
    const int gw = blockIdx.x * NWAVES + wave, NGW = gridDim.x * NWAVES; const float* po = (const float*)(a.ws + WS_PO) + 16 * lane; const bf16_t* h1b = (const bf16_t*)(a.ws + WS_H1B) + 16 * lane;
    f32x4 gf[4];
#pragma unroll
    for (int jj = 0; jj < 4; ++jj) gf[jj] = *(const f32x4*)(a.in[I_GFINAL] + 16 * lane + 4 * jj);
    for (int m = gw; m < T; m += NGW) { float hb[16]; load8(h1b + (size_t)m * DM, *(float(*)[8])&hb[0]); load8(h1b + (size_t)m * DM + 8, *(float(*)[8])&hb[8]);
        f32x4 h[4]; float ss = 0.f;
#pragma unroll
        for (int jj = 0; jj < 4; ++jj) { h[jj] = *(const f32x4*)(po + (size_t)m * DM + 4 * jj) + (f32x4){hb[4 * jj], hb[4 * jj + 1], hb[4 * jj + 2], hb[4 * jj + 3]};
            ss += (h[jj].x * h[jj].x + h[jj].y * h[jj].y) + (h[jj].z * h[jj].z + h[jj].w * h[jj].w); }
        const float r2 = rsqrtf(wave_sum_dpp(ss) * (1.f / DM) + EPSF);
        float* orow = a.out + (size_t)m * DM + 16 * lane;
#pragma unroll
        for (int jj = 0; jj < 4; ++jj) *(f32x4*)(orow + 4 * jj) = h[jj] * r2 * gf[jj]; }
}
typedef short bf16x8_t __attribute__((ext_vector_type(8)));
__device__ __forceinline__ bf16x8_t toep_frag(const LAS unsigned* R32, int base) {
    const int e = base >> 1, sh = (base & 1) * 16;
    const unsigned d0 = R32[e], d1 = R32[e + 1], d2 = R32[e + 2], d3 = R32[e + 3], d4 = R32[e + 4];
    u32x4 o; o.x = __builtin_amdgcn_alignbit(d1, d0, sh); o.y = __builtin_amdgcn_alignbit(d2, d1, sh); o.z = __builtin_amdgcn_alignbit(d3, d2, sh); o.w = __builtin_amdgcn_alignbit(d4, d3, sh);
    return __builtin_bit_cast(bf16x8_t, o);
}
__device__ __forceinline__ void hy_conv_channel(const Args& a, LAS unsigned char* lds, int c, int tid, int wave, int lane) {
    constexpr int UROW = SP * 2;
    LAS unsigned char* uus = lds;
    LAS unsigned short* R = (LAS unsigned short*)(lds + 8 * UROW);
    const bf16_t* uut = (const bf16_t*)(a.ws + WS_UUT); const bf16_t* kfb = (const bf16_t*)(a.ws + WS_KFB); bf16_t* cvt = (bf16_t*)(a.ws + WS_CONVT);
    { const u32x4* src = (const u32x4*)(uut + (size_t)c * NB * SP); for (int i = tid; i < 8 * UROW / 16; i += NTHR) ((LAS u32x4*)uus)[i] = src[i]; }
    for (int n = tid; n < KFW + 16; n += NTHR) R[n] = (n < KFW) ? kfb[(size_t)c * KFW + (KFW - 1) - n] : (unsigned short)0;
    __syncthreads();
    const LAS unsigned* R32 = (const LAS unsigned*)R;
    const int i = lane & 15, g = lane >> 4, p = (lane >> 3) & 1, b = lane & 7;
    f32x4 C[16]; bf16x8_t A[16];
    const int abase = LT - 32 * (1 + 16 * wave) - i + 8 * g;
#pragma unroll
    for (int tb = 0; tb < 16; ++tb) { C[tb] = (f32x4){0.f, 0.f, 0.f, 0.f}; A[tb] = toep_frag(R32, abase - 32 * tb); }
    const LAS unsigned char* bptr = uus + b * UROW + (16 * p + 8 * g) * 2;
#define HC_STEP(ph, n) do { A[(16 - (ph)) & 15] = toep_frag(R32, abase + 32 * (n)); const bf16x8_t Bf = *(const LAS bf16x8_t*)(bptr + (n) * 64); \
        _Pragma("unroll") for (int tb = 0; tb < 16; ++tb) C[tb] = __builtin_amdgcn_mfma_f32_16x16x32_bf16(A[(tb - (ph)) & 15], Bf, C[tb], 0, 0, 0); } while (0)
    for (int G = 0; G < 8; ++G) { const int n0 = G * 16;
        HC_STEP(0, n0); HC_STEP(1, n0 + 1); HC_STEP(2, n0 + 2); HC_STEP(3, n0 + 3); HC_STEP(4, n0 + 4); HC_STEP(5, n0 + 5); HC_STEP(6, n0 + 6); HC_STEP(7, n0 + 7);
        HC_STEP(8, n0 + 8); HC_STEP(9, n0 + 9); HC_STEP(10, n0 + 10); HC_STEP(11, n0 + 11); HC_STEP(12, n0 + 12); HC_STEP(13, n0 + 13); HC_STEP(14, n0 + 14); HC_STEP(15, n0 + 15); }
    HC_STEP(0, 128);
#undef HC_STEP
#pragma unroll
    for (int tb = 0; tb < 16; ++tb) { const int tq = 512 * wave + 32 * tb + 16 * p + 4 * g;
        u32x2 w; w.x = pk2(C[tb][0], C[tb][1]); w.y = pk2(C[tb][2], C[tb][3]);
        *(u32x2*)(cvt + ((size_t)c * NB + b) * SEQ + tq) = w; }
    __syncthreads();
}
__device__ __forceinline__ void rg_item(const Args& a, LAS unsigned char* lds, int it, int tid, int wave, int lane) {
    constexpr int XROW = 272;
    const int head = it & 7, dir = (it >> 3) & 1, b = it >> 4;
    const bf16_t* xb = (const bf16_t*)(a.ws + WS_RGX) + (size_t)b * LT * DRG + head * 128;
    bf16_t* hout = (bf16_t*)a.out + (size_t)dir * T * DRG + (size_t)b * SEQ * DRG + head * 128 + 16 * wave + (lane & 15);
    const int col = lane & 15, g = lane >> 4, ch = head * 128 + 16 * wave + col;
    LAS unsigned char* wl = lds + 2 * 64 * XROW + wave * 1024 + lane * 16;
#pragma unroll
    for (int gt = 0; gt < 2; ++gt)
#pragma unroll
        for (int ks = 0; ks < 4; ++ks) { const float* wp = a.in[I_RGGW] + ((size_t)((dir * 2 + gt) * 8 + head) * 128 + 32 * ks + 8 * g) * 128 + 16 * wave + col;
            u32x4 o; o.x = pk2(wp[0], wp[128]); o.y = pk2(wp[256], wp[384]); o.z = pk2(wp[512], wp[640]); o.w = pk2(wp[768], wp[896]); *(LAS u32x4*)(wl + (gt * 4 + ks) * 8192) = o; }
    const float br = a.in[I_RGGB][(size_t)(dir * 2 + 0) * DRG + ch], bi = a.in[I_RGGB][(size_t)(dir * 2 + 1) * DRG + ch];
    const float sp8 = -8.0f * log1pf(__expf(-a.in[I_RGLAM][dir * DRG + ch]));
    const int ctr = tid >> 4, ccg = tid & 15;
    float cwv[4][8], cbv[8];
#pragma unroll
    for (int i = 0; i < 8; ++i) { cbv[i] = a.in[I_RGCB][(size_t)dir * DRG + head * 128 + 8 * ccg + i];
#pragma unroll
        for (int j = 0; j < 4; ++j) cwv[j][i] = a.in[I_RGCW][((size_t)dir * 4 + j) * DRG + head * 128 + 8 * ccg + i]; }
    u32x4 xr[2][4];
#define RG_LOAD(k) do { _Pragma("unroll") for (int h_ = 0; h_ < 2; ++h_) { const int u_ = 64 * (k) + ctr + 32 * h_; _Pragma("unroll") for (int j = 0; j < 4; ++j) { const int uu_ = u_ - j; \
        if (uu_ >= 0 && uu_ < LT) { const int t_ = dir ? (LT - 1 - uu_) : uu_; xr[h_][j] = *(const u32x4*)(xb + (size_t)t_ * DRG + 8 * ccg); } \
        else xr[h_][j] = (u32x4){0u, 0u, 0u, 0u}; } } } while (0)
#define RG_CONV(k) do { _Pragma("unroll") for (int h_ = 0; h_ < 2; ++h_) { const int u_ = 64 * (k) + ctr + 32 * h_; float o_[8]; _Pragma("unroll") for (int i = 0; i < 8; ++i) o_[i] = (u_ < LT) ? cbv[i] : 0.f; \
        _Pragma("unroll") for (int j = 0; j < 4; ++j) { float f_[8]; unpack8(xr[h_][j], f_); _Pragma("unroll") for (int i = 0; i < 8; ++i) o_[i] += f_[i] * cwv[j][i]; } \
        u32x4 w0_; w0_.x = pk2(o_[0], o_[1]); w0_.y = pk2(o_[2], o_[3]); w0_.z = pk2(o_[4], o_[5]); w0_.w = pk2(o_[6], o_[7]); \
        *(LAS u32x4*)(lds + ((k) & 1) * (64 * XROW) + (ctr + 32 * h_) * XROW + ccg * 16) = w0_; } } while (0)
    RG_LOAD(0); RG_CONV(0); RG_LOAD(1);
    __syncthreads();
    float carry = 0.f;
    const int arow = 16 * (col >> 2) + (col & 3);
    for (int k = 0; k < 65; ++k) {
        if (k + 1 < 65) RG_CONV(k + 1);
        if (k + 2 < 65) RG_LOAD(k + 2);
        const LAS unsigned char* xa = lds + (k & 1) * (64 * XROW);
        unsigned hp[16]; float hh = 0.f, PP = 1.f;
#pragma unroll
        for (int mp = 0; mp < 2; ++mp) {
            f32x4 acc[2][2];
#pragma unroll
            for (int m2 = 0; m2 < 2; ++m2) { const int mb = 2 * mp + m2; acc[0][m2] = (f32x4){0.f, 0.f, 0.f, 0.f}; acc[1][m2] = (f32x4){0.f, 0.f, 0.f, 0.f};
#pragma unroll
                for (int ks = 0; ks < 4; ++ks) { const bf16x8_t Af = *(const LAS bf16x8_t*)(xa + (arow + 4 * mb) * XROW + (32 * ks + 8 * g) * 2);
                    acc[0][m2] = __builtin_amdgcn_mfma_f32_16x16x32_bf16(Af, *(const LAS bf16x8_t*)(wl + ks * 8192), acc[0][m2], 0, 0, 0);
                    acc[1][m2] = __builtin_amdgcn_mfma_f32_16x16x32_bf16(Af, *(const LAS bf16x8_t*)(wl + (4 + ks) * 8192), acc[1][m2], 0, 0, 0); } }
#pragma unroll
            for (int m2 = 0; m2 < 2; ++m2)
#pragma unroll
                for (int r = 0; r < 4; ++r) { const int e = 8 * mp + 4 * m2 + r, tau = 16 * g + e, u = 64 * k + tau;
                    const float rr = sigmoidf_(acc[0][m2][r] + br), ii = sigmoidf_(acc[1][m2][r] + bi);
                    float av = fexp(sp8 * rr); float mult = __builtin_amdgcn_sqrtf(fmaxf(1.0f - av * av, 0.f)); mult = (u == 0) ? 1.0f : mult;
                    const float xcv = bf2f(*(const LAS unsigned short*)(xa + tau * XROW + (16 * wave + col) * 2));
                    float bq = mult * ii * xcv; if (u >= LT) { av = 1.f; bq = 0.f; }
                    hh = av * hh + bq; PP *= av; hp[e] = pk2(hh, PP); }
        }
        float Pg[4], hg[4];
#pragma unroll
        for (int q = 0; q < 4; ++q) { Pg[q] = __shfl(PP, col + 16 * q); hg[q] = __shfl(hh, col + 16 * q); }
        const float H0 = carry, H1 = Pg[0] * H0 + hg[0], H2 = Pg[1] * H1 + hg[1], H3 = Pg[2] * H2 + hg[2], H4 = Pg[3] * H3 + hg[3];
        const float Hin = (g == 0) ? H0 : (g == 1) ? H1 : (g == 2) ? H2 : H3;
        carry = H4;
#pragma unroll
        for (int e = 0; e < 16; ++e) { const int u = 64 * k + 16 * g + e; const int t = dir ? (LT - 1 - u) : u;
            if (u < LT && t >= NMETA) hout[(size_t)(t - NMETA) * DRG] = (bf16_t)f2bf(bflo(hp[e]) + bfhi(hp[e]) * Hin); }
        __syncthreads();
    }
#undef RG_LOAD
#undef RG_CONV
}

#ifndef RG_NAIVE
#define RG_NAIVE 0
#endif
#ifndef CONV_NAIVE
#define CONV_NAIVE 0
#endif
#ifndef ONE_LAUNCH
#define ONE_LAUNCH 0
#endif
constexpr int NPHASE = 13;
#ifndef NVGPR
#define NVGPR 248
#endif
__global__ void __launch_bounds__(NTHR, 2) __attribute__((amdgpu_num_vgpr(NVGPR))) mega(Args a) {
    extern __shared__ __attribute__((aligned(16))) unsigned char lds_raw[];
    LAS unsigned char* lds = (LAS unsigned char*)lds_raw;
    const int tid = threadIdx.x, lane = tid & 63, wave = __builtin_amdgcn_readfirstlane(tid >> 6);
    cg::grid_group grid = cg::this_grid();
    const int lo = a.ph_lo, hi = a.ph_hi, G = gridDim.x, bx = blockIdx.x;
#ifndef PHMASK
#define PHMASK 0x1fff
#endif
#ifndef REPMASK
#define REPMASK 0
#endif
#define IN(k) (((PHMASK >> (k)) & 1) && lo <= (k) && (k) < hi)
#define REP(k)
#define SEAM(k) do { if (IN(k) && IN((k) + 1)) grid.sync(); } while (0)
    unsigned char* ws = a.ws;
    REP(0) if (IN(0)) phase_p0(a, lds, tid, wave, lane);
    SEAM(0);
    REP(1) if (IN(1)) {
        p1_meta(a, lds, tid, wave, lane);
        pg8::Gemm g{(const bf16_t*)(ws + WS_XN1), (const bf16_t*)(ws + WS_WINT), T, DIN, 1024}; pg8::StaticOrder S; S.init(T, DIN, G, bx);
        EpiProj E{(bf16_t*)(ws + WS_HYIN), (bf16_t*)(ws + WS_RGX), (bf16_t*)(ws + WS_GG), (bf16_t*)(ws + WS_GA), (bf16_t*)(ws + WS_GB), a.in[I_BGATE]};
        pg8::gemm_phase<EpiProj, pg8::StaticOrder>(lds, g, S, E, nullptr);
    }
    SEAM(1);
    REP(2) if (IN(2)) phase_hy_pre(a, lds, tid);
    SEAM(2);
    REP(3) if (IN(3)) {
#if CONV_NAIVE
        phase_hy_conv_naive(a, lds, tid);
#else
        if (G >= 256) { if (bx >= 128) for (int c = bx - 128; c < DHY; c += G - 128) hy_conv_channel(a, lds, c, tid, wave, lane); }
        else for (int c = bx; c < DHY; c += G) hy_conv_channel(a, lds, c, tid, wave, lane);
#endif
#if RG_NAIVE
        phase_rg_naive(a, lds, tid);
#else
        for (int it = bx; it < NB * 2 * 8; it += G) rg_item(a, lds, it, tid, wave, lane);
#endif
    }
    SEAM(3);
    REP(4) if (IN(4)) phase_post(a, lds, tid);
    SEAM(4);
    REP(5) if (IN(5)) {
        { pg8::Gemm g{(const bf16_t*)(ws + WS_YH), (const bf16_t*)(ws + WS_WHT), T, 1024, 512}; pg8::StaticOrder S; S.init(T, 1024, G, bx);
          EpiGate<0> E{(const bf16_t*)(ws + WS_GA), nullptr, (bf16_t*)(ws + WS_TMP)};
          pg8::gemm_phase<EpiGate<0>, pg8::StaticOrder>(lds, g, S, E, nullptr); }
        { pg8::Gemm g{(const bf16_t*)(ws + WS_YR), (const bf16_t*)(ws + WS_WRT), T, 1024, 1024}; pg8::StaticOrder S; S.init(T, 1024, G, bx);
          EpiGate<1> E{(const bf16_t*)(ws + WS_GB), (const bf16_t*)(ws + WS_TMP), (bf16_t*)(ws + WS_MERGED)};
          pg8::gemm_phase<EpiGate<1>, pg8::StaticOrder>(lds, g, S, E, nullptr); }
    }
    SEAM(5);
    REP(6) if (IN(6)) {
        pg8::Gemm g{(const bf16_t*)(ws + WS_MERGED), (const bf16_t*)(ws + WS_WOT), T, 1024, 1024}; pg8::StaticOrder S; S.init(T, 1024, G, bx);
        EpiResid E{a.in[I_X], (bf16_t*)(ws + WS_H1B), (float*)(ws + WS_ROWSS)};
        pg8::gemm_phase<EpiResid, pg8::StaticOrder>(lds, g, S, E, nullptr);
    }
    SEAM(6);
    REP(7) if (IN(7)) {
        phase_tables(a, wave, lane);
        pg8::Gemm g{(const bf16_t*)(ws + WS_H1B), (const bf16_t*)(ws + WS_WST), T, 2048, 1024}; pg8::StaticOrder S; S.init(T, 2048, G, bx);
        EpiScores E{(const float*)(ws + WS_ROWSS), (_Float16*)(ws + WS_SCORES)};
        pg8::gemm_phase<EpiScores, pg8::StaticOrder>(lds, g, S, E, nullptr);
    }
    SEAM(7);
    REP(8) if (IN(8)) phase_topk(a, lds, wave, lane);
    SEAM(8);
    REP(9) if (IN(9)) phase_peer_u(a, wave, lane);
    SEAM(9);
    if (IN(10)) phase_peer_act(a, tid);
    SEAM(10);
    if (IN(11)) phase_peer_v(a, wave, lane);
    SEAM(11);
    if (IN(12)) phase_final(a, wave, lane);
#undef IN
#undef SEAM
}

extern "C" void kernel_launch(void* const* d_in, const int* in_sizes, int n_in, void* d_out, int out_size, void* d_ws, size_t ws_size, hipStream_t stream) {
    static int grid = 0;
    if (grid == 0) {
        if (n_in != N_IN || out_size != T * DM || ws_size < WS_END) { fprintf(stderr, "kernel_launch: unexpected shapes (n_in %d out %d ws %zu)\n", n_in, out_size, ws_size); grid = -1; return; }
        if (hipFuncSetAttribute((const void*)mega, hipFuncAttributeMaxDynamicSharedMemorySize, LDS_BYTES) != hipSuccess) { fprintf(stderr, "kernel_launch: hipFuncSetAttribute failed\n"); grid = -1; return; }
        int dev = 0, cus = 0, per_cu = 0;
        hipGetDevice(&dev); hipDeviceGetAttribute(&cus, hipDeviceAttributeMultiprocessorCount, dev);
        hipOccupancyMaxActiveBlocksPerMultiprocessor(&per_cu, (const void*)mega, NTHR, LDS_BYTES);
        if (per_cu < 1) { fprintf(stderr, "kernel_launch: occupancy query says %d blocks per CU\n", per_cu); per_cu = 1; }
        (void)hipGetLastError();
        grid = cus;
    }
    if (grid < 0) return;
    Args a{};
    for (int i = 0; i < N_IN; ++i) a.in[i] = (const float*)d_in[i];
    a.out = (float*)d_out; a.ws = (unsigned char*)d_ws;
#if ONE_LAUNCH
    a.ph_lo = 0; a.ph_hi = NPHASE;
    void* args[] = {&a};
    hipError_t e = hipLaunchCooperativeKernel((const void*)mega, dim3(grid), dim3(NTHR), args, LDS_BYTES, stream);
    if (e != hipSuccess) fprintf(stderr, "cooperative launch failed: %s (grid %d)\n", hipGetErrorString(e), grid);
#else
    for (int ph = 0; ph < NPHASE; ++ph) for (int rep = 0; rep < 1 + ((REPMASK >> ph) & 1); ++rep) { a.ph_lo = ph; a.ph_hi = ph + 1;
        hipLaunchKernelGGL(mega, dim3(grid), dim3(NTHR), LDS_BYTES, stream, a);
        hipError_t e = hipPeekAtLastError(); if (e != hipSuccess) { fprintf(stderr, "launch %d failed: %s\n", ph, hipGetErrorString(e)); break; } }
#endif
}
```

```cpp
#define ONE_LAUNCH 1
#include <hip/hip_runtime.h>
#include <hip/hip_cooperative_groups.h>
#include <cstdio>
#include <cstdint>
#include <cmath>
namespace cg = cooperative_groups;
namespace pg8 {
#define PG8_LAS __attribute__((address_space(3)))
typedef unsigned short bf16_t;
typedef short bf16x8 __attribute__((ext_vector_type(8)));
typedef float f32x4 __attribute__((ext_vector_type(4)));
typedef unsigned u32x4 __attribute__((ext_vector_type(4)));
constexpr int BM = 256, BK = 64, HALF = 128, HTB = HALF * BK * 2  , STAGE_BYTES = 8 * HTB, NXCD = 8, WGM = 8;

__host__ __device__ __forceinline__ int lds_byte(int r, int c) { const int st = (r >> 4) * 2 + (c >> 5), rr = r & 15, cc = c & 31, ob = rr * 64 + cc * 2; return st * 1024 + (ob ^ (((ob >> 9) & 1) << 5)); }
__host__ __device__ __forceinline__ void stage_rc(int b, int& R, int& C) { const int st = b / 1024, sb = b % 1024, swz = sb ^ (((sb >> 9) & 1) << 5); R = (st >> 1) * 16 + swz / 64; C = (st & 1) * 32 + (swz % 64) / 2; }
__host__ __device__ __forceinline__ int perm32(int rho) { const int n = rho >> 4, i = rho & 15; return 8 * (i >> 2) + 4 * n + (i & 3); }

struct Unit { int pm, pn; };
struct Gemm { const bf16_t* A; const bf16_t* Bt; int M, N, K; };

struct StaticOrder {
    int nM, nN, nwg, G, c;
    __host__ __device__ void init(int M, int N, int G_, int c_) { nM = M / BM; nN = N / BM; nwg = nM * nN; G = G_; c = c_; }
    __host__ __device__ bool next(int i, Unit& u) const {
        const long L = (long)i * G + c; if (L >= nwg) return false;
        int wgid = (int)L; { const int q = nwg / NXCD, r = nwg % NXCD, xcd = wgid % NXCD, off = wgid / NXCD; wgid = (xcd < r ? xcd * (q + 1) : r * (q + 1) + (xcd - r) * q) + off; }
        const int nig = WGM * nN, gid = wgid / nig, fm = gid * WGM, gsz = (nM - fm) < WGM ? (nM - fm) : WGM;
        u.pm = fm + ((wgid % nig) % gsz); u.pn = (wgid % nig) / gsz; return true;
    }
    __device__ __forceinline__ void a_ready(const Unit&) const {}
    __device__ __forceinline__ void done(const Unit&) const {}
};
__device__ __forceinline__ unsigned cvt_pk_bf16(float lo, float hi) { unsigned r; asm volatile("v_cvt_pk_bf16_f32 %0, %1, %2" : "=v"(r) : "v"(lo), "v"(hi)); return r; }
typedef float f32x2 __attribute__((ext_vector_type(2)));
__device__ __forceinline__ f32x2 gelu_pk(f32x2 v) {
    const f32x2 av = __builtin_elementwise_abs(v), d = av * 0.2316418882f + 1.0f;
    f32x2 t; t.x = __builtin_amdgcn_rcpf(d.x); t.y = __builtin_amdgcn_rcpf(d.y);
    f32x2 q = t * 0.5307027145f + (-0.7265760135f); q = q * t + 0.7107068705f; q = q * t + (-0.142248368f); q = q * t + 0.127414796f; q = q * t;
    const f32x2 s = (v * v) * (-0.72134752044f);
    f32x2 e; e.x = __builtin_amdgcn_exp2f(s.x); e.y = __builtin_amdgcn_exp2f(s.y);
    const f32x2 m = v * (q * e), r = v - m;
    f32x2 o; o.x = v.x < 0.f ? m.x : r.x; o.y = v.y < 0.f ? m.y : r.y; return o;
}
template <class Epi, class Sched, bool STAMP = false>
__device__ __forceinline__ void gemm_phase(PG8_LAS unsigned char* lds, const Gemm g, const Sched& S, const Epi& E, unsigned long long* stamps) {
    const int tid = threadIdx.x, wid = __builtin_amdgcn_readfirstlane(tid >> 6), lane = tid & 63, wr = wid >> 2, wc = wid & 3, fr = lane & 15, fq = lane >> 4;
    const int K = g.K, nt = K / BK;
    int ts_lo = 0, ts_hi = 0, nts = 0; const unsigned long long rt_entry = STAMP ? (unsigned long long)wall_clock64() : 0ull;
#define PG8_STAMP() do { if (STAMP && wid == 0 && nts < 64) { const unsigned long long _c = (unsigned long long)clock64(); \
        ts_lo = (lane == nts) ? (int)(unsigned)_c : ts_lo; ts_hi = (lane == nts) ? (int)(unsigned)(_c >> 32) : ts_hi; ++nts; } } while (0)
    PG8_STAMP();
    unsigned voffA[2], voffB[2];
#pragma unroll
    for (int i = 0; i < 2; ++i) { int R, C; stage_rc(tid * 16 + i * 8192, R, C); const int Rb = Epi::PERM ? ((R & ~31) + perm32(R & 31)) : R;
        voffA[i] = (unsigned)(R * K + C) * 2u; voffB[i] = (unsigned)(Rb * K + C) * 2u; }
    const size_t kstep = (size_t)(BK * 2);
    const size_t hstep = (size_t)HALF * K * 2;
    const size_t tstep = 2 * hstep;
    const unsigned ldsw = (unsigned)wid * 1024u;
    const int aoff = lds_byte(wr * 64 + fr, fq * 8), boff = lds_byte(wc * 32 + fr, fq * 8);
#define PG8_SA(b, h) (((b) * 2 + (h)) * HTB)
#define PG8_SB(b, h) ((4 + (b) * 2 + (h)) * HTB)
#define PG8_STAGE(bufoff, gbase, voff) do { _Pragma("unroll") for (int _i = 0; _i < 2; ++_i) \
        __builtin_amdgcn_global_load_lds((const unsigned*)((const char*)(gbase) + (voff)[_i]), (PG8_LAS unsigned*)(lds + (bufoff) + ldsw + _i * 8192), 16, 0, 0); } while (0)
#define PG8_LDA(dst, b, h) do { _Pragma("unroll") for (int m = 0; m < 4; ++m) _Pragma("unroll") for (int k = 0; k < 2; ++k) dst[m][k] = *(const PG8_LAS bf16x8*)(lds + PG8_SA(b, h) + aoff + m * 2048 + k * 1024); } while (0)
#define PG8_LDB(dst, b, h) do { _Pragma("unroll") for (int n = 0; n < 2; ++n) _Pragma("unroll") for (int k = 0; k < 2; ++k) dst[n][k] = *(const PG8_LAS bf16x8*)(lds + PG8_SB(b, h) + boff + n * 2048 + k * 1024); } while (0)
#define PG8_MMA(ai, bj, At, Bt) do { __builtin_amdgcn_s_setprio(1); _Pragma("unroll") for (int m = 0; m < 4; ++m) _Pragma("unroll") for (int n = 0; n < 2; ++n) _Pragma("unroll") for (int k = 0; k < 2; ++k) \
        acc[ai][bj][m][n] = __builtin_amdgcn_mfma_f32_16x16x32_bf16(Bt[n][k], At[m][k], acc[ai][bj][m][n], 0, 0, 0); __builtin_amdgcn_s_setprio(0); } while (0)
#define PG8_WAIT_V(n) asm volatile("s_waitcnt vmcnt(" #n ")" ::: "memory")
#define PG8_WAIT_L(n) asm volatile("s_waitcnt lgkmcnt(" #n ")" ::: "memory")
#define PG8_BAR __builtin_amdgcn_s_barrier()
#define PG8_SCHED __builtin_amdgcn_sched_barrier(0)
    Unit cur, nxt; int ui = 0;
    if (!S.next(0, cur)) return;
    f32x4 acc[2][2][4][2];
#pragma unroll
    for (int a = 0; a < 2; ++a)
#pragma unroll
        for (int b = 0; b < 2; ++b)
#pragma unroll
            for (int m = 0; m < 4; ++m)
#pragma unroll
                for (int n = 0; n < 2; ++n) acc[a][b][m][n] = (f32x4){0.f, 0.f, 0.f, 0.f};
    bf16x8 At[4][2], B0[2][2], B1[2][2];
    const char* cA = (const char*)g.A + (size_t)cur.pm * tstep; const char* cB = (const char*)g.Bt + (size_t)cur.pn * tstep;
    S.a_ready(cur);
    PG8_STAGE(PG8_SB(0, 0), cB, voffB); PG8_STAGE(PG8_SA(0, 0), cA, voffA); PG8_STAGE(PG8_SB(0, 1), cB + hstep, voffB); PG8_STAGE(PG8_SA(0, 1), cA + hstep, voffA);
    if (wr == 1) PG8_BAR;
    PG8_WAIT_V(4); PG8_BAR;
    PG8_STAGE(PG8_SB(1, 0), cB + kstep, voffB); PG8_STAGE(PG8_SA(1, 0), cA + kstep, voffA); PG8_STAGE(PG8_SB(1, 1), cB + hstep + kstep, voffB);
    PG8_WAIT_V(6); PG8_BAR;
    PG8_STAMP();
    for (;;) {
        const bool has_next = S.next(ui + 1, nxt);
        const char* nA = has_next ? (const char*)g.A + (size_t)nxt.pm * tstep : cA; const char* nB = has_next ? (const char*)g.Bt + (size_t)nxt.pn * tstep : cB;
        for (int t = 0; t < nt; t += 2) {
            const bool last = (t == nt - 2);
            const char* a1 = cA + (size_t)(t + 1) * kstep;
            const char* a2 = last ? nA : cA + (size_t)(t + 2) * kstep; const char* b2 = last ? nB : cB + (size_t)(t + 2) * kstep;
            const char* a3 = a2 + kstep; const char* b3 = b2 + kstep;
            if (last && has_next) S.a_ready(nxt);
            PG8_LDB(B0, 0, 0); PG8_SCHED; PG8_LDA(At, 0, 0); PG8_STAGE(PG8_SA(1, 1), a1 + hstep, voffA);
            PG8_WAIT_L(8); PG8_BAR; PG8_WAIT_L(0); PG8_MMA(0, 0, At, B0); PG8_BAR; PG8_SCHED;
            PG8_LDB(B1, 0, 1); PG8_STAGE(PG8_SB(0, 0), b2, voffB);
            PG8_BAR; PG8_WAIT_L(0); PG8_MMA(0, 1, At, B1); PG8_BAR;
            PG8_LDA(At, 0, 1); PG8_STAGE(PG8_SA(0, 0), a2, voffA);
            PG8_BAR; PG8_WAIT_L(0); PG8_MMA(1, 0, At, B0); PG8_BAR; PG8_SCHED;
            PG8_STAGE(PG8_SB(0, 1), b2 + hstep, voffB);
            PG8_WAIT_V(6); PG8_BAR; PG8_MMA(1, 1, At, B1); PG8_BAR;
            PG8_LDB(B0, 1, 0); PG8_SCHED; PG8_LDA(At, 1, 0); PG8_STAGE(PG8_SA(0, 1), a2 + hstep, voffA);
            PG8_WAIT_L(8); PG8_BAR; PG8_WAIT_L(0); PG8_MMA(0, 0, At, B0); PG8_BAR; PG8_SCHED;
            PG8_LDB(B1, 1, 1); PG8_STAGE(PG8_SB(1, 0), b3, voffB);
            PG8_BAR; PG8_WAIT_L(0); PG8_MMA(0, 1, At, B1); PG8_BAR;
            PG8_LDA(At, 1, 1); PG8_STAGE(PG8_SA(1, 0), a3, voffA);
            PG8_BAR; PG8_WAIT_L(0); PG8_MMA(1, 0, At, B0); PG8_BAR; PG8_SCHED;
            PG8_STAGE(PG8_SB(1, 1), b3 + hstep, voffB);
            PG8_WAIT_V(6); PG8_BAR; PG8_MMA(1, 1, At, B1); PG8_BAR;
        }
        PG8_STAMP();
        if constexpr (!Epi::AFTER_DRAIN) { E(acc, cur, wr, wc, fr, fq); S.done(cur); }
        PG8_STAMP();
        if (!has_next) break;
#pragma unroll
        for (int a = 0; a < 2; ++a)
#pragma unroll
            for (int b = 0; b < 2; ++b)
#pragma unroll
                for (int m = 0; m < 4; ++m)
#pragma unroll
                    for (int n = 0; n < 2; ++n) acc[a][b][m][n] = (f32x4){0.f, 0.f, 0.f, 0.f};
        cur = nxt; cA = nA; cB = nB; ++ui;
    }
    PG8_WAIT_V(0);
    if (wr == 0) PG8_BAR;
    PG8_BAR;
    if constexpr (Epi::AFTER_DRAIN) { E.fused(acc, cur, wr, wc, fr, fq, lds, wid, lane); S.done(cur); }
    PG8_STAMP();
    if (STAMP && wid == 0) { stamps[lane] = lane < nts ? (((unsigned long long)(unsigned)ts_hi << 32) | (unsigned)ts_lo) : 0ull;
        if (lane == 62) stamps[62] = rt_entry; if (lane == 63) stamps[63] = (unsigned long long)wall_clock64(); }
#undef PG8_STAMP
#undef PG8_SA
#undef PG8_SB
#undef PG8_STAGE
#undef PG8_LDA
#undef PG8_LDB
#undef PG8_MMA
#undef PG8_WAIT_V
#undef PG8_WAIT_L
#undef PG8_BAR
#undef PG8_SCHED
}
}

#define LAS __attribute__((address_space(3)))
typedef unsigned short bf16_t;
typedef float f32x4 __attribute__((ext_vector_type(4)));
typedef float f32x2 __attribute__((ext_vector_type(2)));
typedef unsigned u32x4 __attribute__((ext_vector_type(4)));
typedef unsigned u32x2 __attribute__((ext_vector_type(2)));

constexpr int NB = 8, SEQ = 4096, NMETA = 16, LT = SEQ + NMETA, DM = 1024, T = NB * SEQ;
constexpr int DHY = 512, DRG = 1024, DIN = 3 * DHY + 2 * DRG + 2 * DM;
constexpr int NTHR = 512, NWAVES = 8;
constexpr int LDS_BYTES = 160 * 1024;
constexpr float EPSF = 1e-6f;
constexpr int KFW = 2 * LT;
constexpr int SP = 4256;
constexpr int NEXP = 16384;

enum { I_X = 0, I_META, I_GFINAL, I_GMIX, I_WIN, I_BGATE, I_HYCW, I_HYCB, I_HYW1, I_HYB1, I_HYW2, I_HYB2, I_HYW3, I_HYB3, I_HYFREQ, I_HYSKIP,
       I_HYOUT, I_RGCW, I_RGCB, I_RGGW, I_RGGB, I_RGLAM, I_RGOUT, I_WOUT, I_GFFN, I_WQ, I_KEYS, I_PU, I_PV, N_IN };

constexpr size_t MiB = 1024ull * 1024ull;
constexpr size_t WS_ROWSS = 64 * 1024;
constexpr size_t WS_SU = 256 * 1024;
constexpr size_t WS_SV = 320 * 1024;
constexpr size_t WS_ROWSS2 = 384 * 1024;
constexpr size_t WS_BAR = 512 * 1024;
constexpr size_t WS_WINT = 1 * MiB;
constexpr size_t WS_WHT = 12 * MiB;
constexpr size_t WS_WRT = 13 * MiB;
constexpr size_t WS_WOT = 15 * MiB;
constexpr size_t WS_WST = 17 * MiB;
constexpr size_t WS_GWT = 21 * MiB;
constexpr size_t WS_KF = 22 * MiB;
constexpr size_t WS_KFB = 39 * MiB;
constexpr size_t WS_HYIN = 48 * MiB;
constexpr size_t WS_RGX = 145 * MiB;
constexpr size_t WS_GG = 210 * MiB;
constexpr size_t WS_GA = 274 * MiB;
constexpr size_t WS_GB = 338 * MiB;
constexpr size_t WS_XN1 = 402 * MiB;
constexpr size_t WS_UUT = 402 * MiB;
constexpr size_t WS_CONVT = 436 * MiB;
constexpr size_t WS_YH = 468 * MiB;
constexpr size_t WS_YR = WS_RGX;
constexpr size_t WS_MERGED = WS_HYIN;
constexpr size_t WS_TMP = WS_GG;
constexpr size_t WS_H1B = WS_RGX;
constexpr size_t WS_SCORES = WS_GG;
constexpr size_t WS_EIDX = 468 * MiB;
constexpr size_t WS_EG = 484 * MiB;
constexpr size_t WS_UB = 48 * MiB;
constexpr size_t WS_VB = 64 * MiB;
constexpr size_t WS_PD = 210 * MiB;
constexpr size_t WS_PO = WS_PD;
constexpr size_t WS_ACT = 338 * MiB;
constexpr size_t WS_END = 500 * MiB;

struct Args { const float* in[N_IN]; float* out; unsigned char* ws; int ph_lo, ph_hi; };

__device__ __forceinline__ float bf2f(unsigned v) { return __uint_as_float(v << 16); }
__device__ __forceinline__ unsigned f2bf(float f) { unsigned u = __float_as_uint(f); return (u + 0x7fffu + ((u >> 16) & 1u)) >> 16; }
__device__ __forceinline__ unsigned pk2(float lo, float hi) { return f2bf(lo) | (f2bf(hi) << 16); }
__device__ __forceinline__ float bflo(unsigned w) { return __uint_as_float(w << 16); }
__device__ __forceinline__ float bfhi(unsigned w) { return __uint_as_float(w & 0xffff0000u); }
__device__ __forceinline__ float wave_sum(float v) {
#pragma unroll
    for (int o = 1; o < 64; o <<= 1) v += __shfl_xor(v, o);
    return v;
}
__device__ __forceinline__ float wave_max(float v) {
#pragma unroll
    for (int o = 1; o < 64; o <<= 1) v = fmaxf(v, __shfl_xor(v, o));
    return v;
}
__device__ __forceinline__ float fexp(float x) { return __builtin_amdgcn_exp2f(x * 1.4426950408889634f); }
__device__ __forceinline__ float sigmoidf_(float x) { return __builtin_amdgcn_rcpf(1.0f + fexp(-x)); }
__device__ __forceinline__ float gelu_tanh(float x) { const float u = 1.5957691216f * (x + 0.044715f * x * x * x); return x * __builtin_amdgcn_rcpf(1.0f + fexp(-u)); }
__device__ __forceinline__ void sincos_acc(float a, float& s, float& c) {
    const double x = (double)a;
    const double q = rint(x * 0.63661977236758134308);
    const double r = fma(-q, 1.57079632679489661923, x);
    const int n = (int)q;
    const float rf = (float)r, r2 = rf * rf;
    const float sp = rf * (1.f + r2 * (-1.6666667e-1f + r2 * (8.3333333e-3f + r2 * (-1.9841270e-4f + r2 * 2.7557319e-6f))));
    const float cp = 1.f + r2 * (-0.5f + r2 * (4.1666667e-2f + r2 * (-1.3888889e-3f + r2 * (2.4801587e-5f + r2 * (-2.7557319e-7f)))));
    const int k = n & 3;
    s = (k == 0) ? sp : (k == 1) ? cp : (k == 2) ? -sp : -cp;
    c = (k == 0) ? cp : (k == 1) ? -sp : (k == 2) ? -cp : sp;
}

typedef float f32x2v __attribute__((ext_vector_type(2)));
__device__ __forceinline__ float wave_sum_dpp(float v) {
    v += __int_as_float(__builtin_amdgcn_update_dpp(0, __float_as_int(v), 0xB1, 0xF, 0xF, true));
    v += __int_as_float(__builtin_amdgcn_update_dpp(0, __float_as_int(v), 0x4E, 0xF, 0xF, true));
    v += __int_as_float(__builtin_amdgcn_update_dpp(0, __float_as_int(v), 0x141, 0xF, 0xF, true));
    v += __int_as_float(__builtin_amdgcn_update_dpp(0, __float_as_int(v), 0x140, 0xF, 0xF, true));
    const int vi = __float_as_int(v);
    return (__int_as_float(__builtin_amdgcn_readlane(vi, 0)) + __int_as_float(__builtin_amdgcn_readlane(vi, 16))) + (__int_as_float(__builtin_amdgcn_readlane(vi, 32)) + __int_as_float(__builtin_amdgcn_readlane(vi, 48)));
}
__device__ __forceinline__ float wave_max_dpp(float v) {
    v = fmaxf(v, __int_as_float(__builtin_amdgcn_update_dpp(0, __float_as_int(v), 0xB1, 0xF, 0xF, true)));
    v = fmaxf(v, __int_as_float(__builtin_amdgcn_update_dpp(0, __float_as_int(v), 0x4E, 0xF, 0xF, true)));
    v = fmaxf(v, __int_as_float(__builtin_amdgcn_update_dpp(0, __float_as_int(v), 0x141, 0xF, 0xF, true)));
    v = fmaxf(v, __int_as_float(__builtin_amdgcn_update_dpp(0, __float_as_int(v), 0x140, 0xF, 0xF, true)));
    const int vi = __float_as_int(v);
    return fmaxf(fmaxf(__int_as_float(__builtin_amdgcn_readlane(vi, 0)), __int_as_float(__builtin_amdgcn_readlane(vi, 16))), fmaxf(__int_as_float(__builtin_amdgcn_readlane(vi, 32)), __int_as_float(__builtin_amdgcn_readlane(vi, 48))));
}

#ifndef SLICE_PROBE
#define SLICE_OF(b) ((b) & 7)
#define RANK_OF(b) ((b) >> 3)
#else
#define SLICE_OF(b) ((b) >> 5)
#define RANK_OF(b) ((b) & 31)
#endif
#define XB_TMO      128
#define XB_XCNT(j)  (256  + 64 * (j))
#define XB_XSUB(j)  (1280 + 64 * (j))
#define XB_XGEN(j)  (2304 + 64 * (j))
#define XB_TOP      3328
#define XB_TOPGEN   3392
#define XCD_BAR_WORDS 3456
#define XB_SPIN_CAP (1u << 18)

__device__ __forceinline__ unsigned xb_ld(unsigned* p)              { return __hip_atomic_load(p, __ATOMIC_RELAXED, __HIP_MEMORY_SCOPE_AGENT); }
__device__ __forceinline__ unsigned xb_add(unsigned* p, unsigned v) { return __hip_atomic_fetch_add(p, v, __ATOMIC_RELAXED, __HIP_MEMORY_SCOPE_AGENT); }
__device__ __forceinline__ unsigned xb_xcc_id() { return (unsigned)__builtin_amdgcn_s_getreg((3 << 11) | 20) & 0xFu; }
#define XB_SPIN(cond, bar) do { unsigned _sp = 0; while (cond) { __builtin_amdgcn_s_sleep(1); \
    if ((++_sp & 255u) == 0u) { if (xb_ld(&(bar)[XB_TMO])) break; if (_sp > XB_SPIN_CAP) { atomicAdd(&(bar)[XB_TMO], 1u); break; } } } } while (0)

struct XcdBarrier {
    unsigned* bar; unsigned x;
    volatile LAS unsigned* st;
};

__device__ __forceinline__ XcdBarrier xcd_barrier_post(unsigned* bar, volatile LAS unsigned* st) {
    XcdBarrier b; b.bar = bar; b.x = xb_xcc_id(); b.st = st;
    if (threadIdx.x == 0) (void)xb_add(&bar[XB_XCNT(b.x)], 1u);
    return b;
}
__device__ __forceinline__ void xcd_barrier_complete(unsigned* bar, unsigned x, unsigned& nloc, unsigned& nx) {
    const unsigned G = gridDim.x * gridDim.y * gridDim.z;
    unsigned sum, cnt, mine, sp = 0u;
    for (;;) {
        sum = 0u; cnt = 0u; mine = 0u;
#pragma unroll
        for (unsigned j = 0; j < 16; ++j) { const unsigned c = xb_ld(&bar[XB_XCNT(j)]); sum += c; cnt += (c > 0u) ? 1u : 0u; mine = (j == x) ? c : mine; }
        if (sum == G) break;
        __builtin_amdgcn_s_sleep(1);
        if ((++sp & 255u) == 0u) { if (xb_ld(&bar[XB_TMO])) break; if (sp > XB_SPIN_CAP) { atomicAdd(&bar[XB_TMO], 1u); break; } }
    }
    nloc = mine > 0u ? mine : 1u; nx = cnt > 0u ? cnt : 1u;
}

__device__ __forceinline__ void xcd_barrier(const XcdBarrier& b) {
    asm volatile("s_waitcnt vmcnt(0)" ::: "memory");
    __syncthreads();
    if (threadIdx.x == 0) {
        unsigned* bar = b.bar;
        __builtin_amdgcn_s_waitcnt(0);
        unsigned nloc = b.st[0], nx = b.st[1];
        if (nloc == 0u) { xcd_barrier_complete(bar, b.x, nloc, nx); b.st[0] = nloc; b.st[1] = nx; }
        const unsigned old = xb_add(&bar[XB_XSUB(b.x)], 1u);
        const unsigned gen = old / nloc;
        if (old + 1u == (gen + 1u) * nloc) {
            __builtin_amdgcn_fence(__ATOMIC_RELEASE, "agent");
            asm volatile("s_waitcnt vmcnt(0)" ::: "memory");
            const unsigned og = xb_add(&bar[XB_TOP], 1u);
            const unsigned tg = og / nx;
            if (og + 1u == (tg + 1u) * nx) xb_add(&bar[XB_TOPGEN], 1u);
            else XB_SPIN(xb_ld(&bar[XB_TOPGEN]) == tg, bar);
            __builtin_amdgcn_fence(__ATOMIC_ACQUIRE, "agent");
            xb_add(&bar[XB_XGEN(b.x)], 1u);
            asm volatile("s_waitcnt vmcnt(0)" ::: "memory");
        } else {
            XB_SPIN(xb_ld(&bar[XB_XGEN(b.x)]) == gen, bar);
            __builtin_amdgcn_fence(__ATOMIC_ACQUIRE, "agent");
            asm volatile("s_waitcnt vmcnt(0)" ::: "memory");
        }
    }
    __syncthreads();
}

__device__ __forceinline__ void p0_transpose_item(const float* W, int K, int N, bf16_t* WT, LAS float* scr, int item, int lane) {
    const int nblk = N / 32, kb = item / nblk, nb = item % nblk, k0 = 64 * kb, n0 = 32 * nb;
#pragma unroll 8
    for (int i = 0; i < 32; ++i) { const int kk = 2 * i + (lane >> 5); scr[kk * 33 + (lane & 31)] = W[(size_t)(k0 + kk) * N + n0 + (lane & 31)]; }
    asm volatile("s_waitcnt lgkmcnt(0)" ::: "memory");
    const int c = lane & 7;
#pragma unroll
    for (int j = 0; j < 4; ++j) { const int n = (lane >> 3) + 8 * j; const LAS float* s = scr + (8 * c) * 33 + n;
        u32x4 o; o.x = pk2(s[0 * 33], s[1 * 33]); o.y = pk2(s[2 * 33], s[3 * 33]); o.z = pk2(s[4 * 33], s[5 * 33]); o.w = pk2(s[6 * 33], s[7 * 33]);
        *(u32x4*)(WT + (size_t)(n0 + n) * K + k0 + 8 * c) = o; }
    asm volatile("s_waitcnt lgkmcnt(0)" ::: "memory");
}
__device__ __forceinline__ void p0_xn1_row(const float* xrow, const float* g, bf16_t* orow, int lane) {
    const f32x4* xr = (const f32x4*)xrow + lane; const f32x4* gr = (const f32x4*)g + lane;
    f32x4 v[4]; float s = 0.f;
#pragma unroll
    for (int j = 0; j < 4; ++j) { v[j] = xr[64 * j]; s += (v[j].x * v[j].x + v[j].y * v[j].y) + (v[j].z * v[j].z + v[j].w * v[j].w); }
    const float rstd = rsqrtf(wave_sum(s) * (1.f / DM) + EPSF);
    unsigned long long* o8 = (unsigned long long*)orow + lane;
#pragma unroll
    for (int j = 0; j < 4; ++j) { const f32x4 gv = gr[64 * j];
        o8[64 * j] = (unsigned long long)pk2(v[j].x * rstd * gv.x, v[j].y * rstd * gv.y) | ((unsigned long long)pk2(v[j].z * rstd * gv.z, v[j].w * rstd * gv.w) << 32); }
}
__device__ __forceinline__ void p0_fold_item(const Args& a, LAS unsigned char* lds, int item, int tid) {
    const int hp = item >> 4, k0 = (item & 15) * 64;
    LAS float* kl = (LAS float*)lds;
    LAS float* wl = (LAS float*)(lds + 128 * 129 * 4);
    const float* keys = a.in[I_KEYS] + (size_t)hp * 128 * 128; const float* wq = a.in[I_WQ];
    for (int i = tid; i < 128 * 128; i += NTHR) { const int key = i >> 7, d = i & 127; kl[key * 129 + d] = keys[i]; }
    for (int i = tid; i < 64 * 128; i += NTHR) { const int kk = i >> 7, d = i & 127; wl[i] = wq[(size_t)(k0 + kk) * 2048 + hp * 128 + d]; }
    __syncthreads();
    const int key = tid & 127, kq = tid >> 7;
    float acc[16];
#pragma unroll
    for (int i = 0; i < 16; ++i) acc[i] = 0.f;
#pragma unroll 2
    for (int d = 0; d < 128; ++d) { const float kv = kl[key * 129 + d];
#pragma unroll
        for (int i = 0; i < 16; ++i) acc[i] += wl[(kq * 16 + i) * 128 + d] * kv; }
    const float* gf = a.in[I_GFFN] + k0 + kq * 16;
    bf16_t* dst = (bf16_t*)(a.ws + WS_WST) + (size_t)(hp * 128 + key) * 1024 + k0 + kq * 16;
    u32x4 o0, o1;
    o0.x = pk2(acc[0] * gf[0], acc[1] * gf[1]); o0.y = pk2(acc[2] * gf[2], acc[3] * gf[3]); o0.z = pk2(acc[4] * gf[4], acc[5] * gf[5]); o0.w = pk2(acc[6] * gf[6], acc[7] * gf[7]);
    o1.x = pk2(acc[8] * gf[8], acc[9] * gf[9]); o1.y = pk2(acc[10] * gf[10], acc[11] * gf[11]); o1.z = pk2(acc[12] * gf[12], acc[13] * gf[13]); o1.w = pk2(acc[14] * gf[14], acc[15] * gf[15]);
    *(u32x4*)dst = o0; *(u32x4*)(dst + 8) = o1;
    __syncthreads();
}
__device__ __forceinline__ void p0_meta_item(const Args& a, LAS unsigned char* lds, int item, int tid, int wave, int lane) {
    LAS float* mt = (LAS float*)lds;
    for (int r = wave * 2; r < wave * 2 + 2; ++r) {
        const f32x4* xr = (const f32x4*)(a.in[I_META] + (size_t)r * DM) + lane; const f32x4* gr = (const f32x4*)a.in[I_GMIX] + lane;
        f32x4 v[4]; float s = 0.f;
#pragma unroll
        for (int j = 0; j < 4; ++j) { v[j] = xr[64 * j]; s += (v[j].x * v[j].x + v[j].y * v[j].y) + (v[j].z * v[j].z + v[j].w * v[j].w); }
        const float rstd = rsqrtf(wave_sum(s) * (1.f / DM) + EPSF);
#pragma unroll
        for (int j = 0; j < 4; ++j) { const f32x4 gv = gr[64 * j]; f32x4 o = v[j] * rstd * gv; *(LAS f32x4*)(mt + r * 1024 + 4 * (lane + 64 * j)) = o; }
    }
    __syncthreads();
    const int col = item * 256 + (tid & 255), rh = tid >> 8;
    float acc[8];
#pragma unroll
    for (int r = 0; r < 8; ++r) acc[r] = 0.f;
    const float* w = a.in[I_WIN] + col;
#pragma unroll 4
    for (int k = 0; k < 1024; ++k) { const float wv = w[(size_t)k * DIN];
#pragma unroll
        for (int r = 0; r < 8; ++r) acc[r] += mt[(rh * 8 + r) * 1024 + k] * wv; }
    bf16_t* hyin = (bf16_t*)(a.ws + WS_HYIN); bf16_t* rgx = (bf16_t*)(a.ws + WS_RGX);
#pragma unroll
    for (int r = 0; r < 8; ++r) { const int t = rh * 8 + r; const bf16_t v = (bf16_t)f2bf(acc[r]);
        for (int b = 0; b < NB; ++b) { if (col < 1536) hyin[((size_t)b * LT + t) * 1536 + col] = v; else rgx[((size_t)b * LT + t) * 1024 + (col - 1536)] = v; } }
    __syncthreads();
}
__device__ __forceinline__ void p0_filter_item(const Args& a, LAS unsigned char* lds, int item, int tid) {
    LAS float* z = (LAS float*)lds;
    LAS float* h1 = z + 16 * 33;
    LAS float* h2 = h1 + 16 * 64;
    LAS float* ko = h2 + 16 * 64;
    const int p0 = item * 16;
    for (int idx = tid; idx < 16 * 33; idx += NTHR) { const int pp = idx / 33, f = idx % 33, p = p0 + pp;
        float v;
        if (f == 0) v = (float)p * (1.0f / (float)(LT - 1));
        else { const int bi = (f - 1) & 15; const float band = 1e-4f + (float)bi * ((15.0f - 1e-4f) / 15.0f); const float w = (float)(6.283185307179586 / (double)LT) * (float)p;
            float s, c; sincos_acc(band * w, s, c); v = (f <= 16) ? c : -s; }
        z[idx] = v; }
    __syncthreads();
    const float* w1 = a.in[I_HYW1]; const float* b1 = a.in[I_HYB1]; const float* w2 = a.in[I_HYW2]; const float* b2 = a.in[I_HYB2];
    const float* w3 = a.in[I_HYW3]; const float* b3 = a.in[I_HYB3]; const float* fr = a.in[I_HYFREQ];
    for (int idx = tid; idx < 16 * 64; idx += NTHR) { const int pp = idx >> 6, j = idx & 63; float acc = b1[j];
#pragma unroll 3
        for (int f = 0; f < 33; ++f) acc += z[pp * 33 + f] * w1[f * 64 + j];
        float s, c; sincos_acc(fr[j] * acc, s, c); h1[idx] = s; }
    __syncthreads();
    for (int idx = tid; idx < 16 * 64; idx += NTHR) { const int pp = idx >> 6, j = idx & 63; float acc = b2[j];
#pragma unroll 4
        for (int f = 0; f < 64; ++f) acc += h1[pp * 64 + f] * w2[f * 64 + j];
        float s, c; sincos_acc(fr[64 + j] * acc, s, c); h2[idx] = s; }
    __syncthreads();
#pragma unroll 1
    for (int half = 0; half < 2; ++half) { const int o = half * 512 + tid;
        float acc[16];
#pragma unroll
        for (int pp = 0; pp < 16; ++pp) acc[pp] = b3[o];
#pragma unroll 2
        for (int i = 0; i < 64; ++i) { const float wv = w3[i * 1024 + o];
#pragma unroll
            for (int pp = 0; pp < 16; ++pp) acc[pp] += h2[pp * 64 + i] * wv; }
        const float delta = fabsf(-15.350567286626972f + (float)tid * ((-3.0701134573253945f + 15.350567286626972f) / 511.0f));
#pragma unroll
        for (int pp = 0; pp < 16; ++pp) { const float tn = (float)(p0 + pp) * (1.0f / (float)(LT - 1)); ko[o * 17 + pp] = acc[pp] * __expf(-tn * delta); }
    }
    __syncthreads();
    float* kf = (float*)(a.ws + WS_KF); bf16_t* kfb = (bf16_t*)(a.ws + WS_KFB);
    for (int idx = tid; idx < 1024 * 16; idx += NTHR) { const int o = idx >> 4, pp = idx & 15, dir = o >> 9, c = o & 511, p = p0 + pp;
        const float v = ko[o * 17 + pp];
        if (dir == 0) { kf[(size_t)c * KFW + (LT - 1) + p] = v; kfb[(size_t)c * KFW + (LT - 1) + p] = (bf16_t)f2bf(v); }
        else if (p >= 1) { kf[(size_t)c * KFW + (LT - 1) - p] = v; kfb[(size_t)c * KFW + (LT - 1) - p] = (bf16_t)f2bf(v); } }
    if (item == 0) for (int c = tid; c < 512; c += NTHR) { kf[(size_t)c * KFW + KFW - 1] = 0.f; kfb[(size_t)c * KFW + KFW - 1] = 0; }
    __syncthreads();
}
__device__ __forceinline__ void phase_p0(const Args& a, LAS unsigned char* lds, int tid, int wave, int lane) {
    const int G = gridDim.x, bx = blockIdx.x;
    { float* rs = (float*)(a.ws + WS_ROWSS); float* rs2 = (float*)(a.ws + WS_ROWSS2); for (int i = bx * NTHR + tid; i < T; i += G * NTHR) { rs[i] = 0.f; rs2[i] = 0.f; } }
    for (int it = bx; it < 256 + 257; it += G) {
#ifndef P0M
#define P0M 7
#endif
        if (it < 256) { if (P0M & 1) p0_fold_item(a, lds, it, tid); }
        else { if (P0M & 2) p0_filter_item(a, lds, it - 256, tid); }

    }
    LAS float* scr = (LAS float*)(lds + wave * 16384);
    const int gw = bx * NWAVES + wave, NGW = G * NWAVES;
    constexpr int I_IN = (1024 / 64) * (DIN / 32), I_H = (512 / 64) * (1024 / 32), I_R = (1024 / 64) * (1024 / 32), I_O = I_R;
    for (int it = gw; it < I_IN + I_H + I_R + I_O; it += NGW) {
        int r = it;
        if (r < I_IN) { p0_transpose_item(a.in[I_WIN], 1024, DIN, (bf16_t*)(a.ws + WS_WINT), scr, r, lane); continue; } r -= I_IN;
        if (r < I_H) { p0_transpose_item(a.in[I_HYOUT], 512, 1024, (bf16_t*)(a.ws + WS_WHT), scr, r, lane); continue; } r -= I_H;
        if (r < I_R) { p0_transpose_item(a.in[I_RGOUT], 1024, 1024, (bf16_t*)(a.ws + WS_WRT), scr, r, lane); continue; } r -= I_R;
        p0_transpose_item(a.in[I_WOUT], 1024, 1024, (bf16_t*)(a.ws + WS_WOT), scr, r, lane);
    }
    for (int m = gw; m < T; m += 2 * NGW) { p0_xn1_row(a.in[I_X] + (size_t)m * DM, a.in[I_GMIX], (bf16_t*)(a.ws + WS_XN1) + (size_t)m * DM, lane);
        if (m + NGW < T) p0_xn1_row(a.in[I_X] + (size_t)(m + NGW) * DM, a.in[I_GMIX], (bf16_t*)(a.ws + WS_XN1) + (size_t)(m + NGW) * DM, lane); }
}

__device__ __forceinline__ void p1_meta(const Args& a, LAS unsigned char* lds, int tid, int wave, int lane) {
    LAS float* mt = (LAS float*)lds;
    for (int r = wave * 2; r < wave * 2 + 2; ++r) {
        const f32x4* xr = (const f32x4*)(a.in[I_META] + (size_t)r * DM) + lane; const f32x4* gr = (const f32x4*)a.in[I_GMIX] + lane;
        f32x4 v[4]; float s = 0.f;
#pragma unroll
        for (int j = 0; j < 4; ++j) { v[j] = xr[64 * j]; s += (v[j].x * v[j].x + v[j].y * v[j].y) + (v[j].z * v[j].z + v[j].w * v[j].w); }
        const float rstd = rsqrtf(wave_sum(s) * (1.f / DM) + EPSF);
#pragma unroll
        for (int j = 0; j < 4; ++j) { const f32x4 gv = gr[64 * j]; f32x4 o = v[j] * rstd * gv; *(LAS f32x4*)(mt + r * 1024 + 4 * (lane + 64 * j)) = o; }
    }
    __syncthreads();
    const bf16_t* wint = (const bf16_t*)(a.ws + WS_WINT); bf16_t* hyin = (bf16_t*)(a.ws + WS_HYIN); bf16_t* rgx = (bf16_t*)(a.ws + WS_RGX);
    for (int cc = wave; cc < 10; cc += NWAVES) { const int n = blockIdx.x * 10 + cc; if (n >= 2560) break;
        float w[16]; { float t0[8], t1[8]; const bf16_t* wp = wint + (size_t)n * 1024; const u32x4 q0 = *(const u32x4*)(wp + 8 * lane), q1 = *(const u32x4*)(wp + 512 + 8 * lane);
            w[0] = bflo(q0.x); w[1] = bfhi(q0.x); w[2] = bflo(q0.y); w[3] = bfhi(q0.y); w[4] = bflo(q0.z); w[5] = bfhi(q0.z); w[6] = bflo(q0.w); w[7] = bfhi(q0.w);
            w[8] = bflo(q1.x); w[9] = bfhi(q1.x); w[10] = bflo(q1.y); w[11] = bfhi(q1.y); w[12] = bflo(q1.z); w[13] = bfhi(q1.z); w[14] = bflo(q1.w); w[15] = bfhi(q1.w); (void)t0; (void)t1; }
        float mine = 0.f;
#pragma unroll
        for (int r = 0; r < 16; ++r) { const LAS f32x4* mp = (const LAS f32x4*)(mt + r * 1024 + 8 * lane); const f32x4 m0 = mp[0], m1 = mp[1], m2 = mp[128], m3 = mp[129];
            float s = (w[0] * m0.x + w[1] * m0.y) + (w[2] * m0.z + w[3] * m0.w) + (w[4] * m1.x + w[5] * m1.y) + (w[6] * m1.z + w[7] * m1.w)
                    + (w[8] * m2.x + w[9] * m2.y) + (w[10] * m2.z + w[11] * m2.w) + (w[12] * m3.x + w[13] * m3.y) + (w[14] * m3.z + w[15] * m3.w);
            s = wave_sum_dpp(s); mine = ((lane & 15) == r) ? s : mine; }
        const bf16_t v = (bf16_t)f2bf(mine); const int t = lane & 15;
#pragma unroll
        for (int h = 0; h < 2; ++h) { const int b = (lane >> 4) + 4 * h;
            if (n < 1536) hyin[((size_t)b * LT + t) * 1536 + n] = v; else rgx[((size_t)b * LT + t) * 1024 + (n - 1536)] = v; }
    }
    __syncthreads();
}

typedef pg8::f32x4 pf4;
struct EpiProj {
    static constexpr bool PERM = true, AFTER_DRAIN = false;
    bf16_t *hyin, *rgx, *gg, *ga, *gb; const float* bgate;
    __device__ __forceinline__ void operator()(const pf4 (&acc)[2][2][4][2], const pg8::Unit& u, int wr, int wc, int fr, int fq) const {
        const int pn = u.pn, row0 = u.pm * 256 + wr * 64 + fr, cl0 = wc * 32 + 8 * fq;
#pragma unroll
        for (int ai = 0; ai < 2; ++ai)
#pragma unroll
            for (int m = 0; m < 4; ++m) { const int r = row0 + ai * 128 + m * 16; const size_t rl = (size_t)(r >> 12) * LT + NMETA + (r & 4095);
#pragma unroll
                for (int bj = 0; bj < 2; ++bj) { const int col = pn * 256 + bj * 128 + cl0; pf4 v0 = acc[ai][bj][m][0], v1 = acc[ai][bj][m][1]; bf16_t* dst;
                    if (pn < 6) dst = hyin + rl * 1536 + col;
                    else if (pn < 10) dst = rgx + rl * 1024 + (col - 1536);
                    else if (pn < 14) { dst = gg + (size_t)r * 1024 + (col - 2560);
#pragma unroll
                        for (int j = 0; j < 4; ++j) { v0[j] = gelu_tanh(v0[j]); v1[j] = gelu_tanh(v1[j]); } }
                    else { const int gc = col - 3584;
                        dst = (gc < 1024 ? ga + (size_t)r * 1024 + gc : gb + (size_t)r * 1024 + (gc - 1024));
                        const pf4 b0 = *(const pf4*)(bgate + gc), b1 = *(const pf4*)(bgate + gc + 4);
#pragma unroll
                        for (int j = 0; j < 4; ++j) { v0[j] = sigmoidf_(v0[j] + b0[j]); v1[j] = sigmoidf_(v1[j] + b1[j]); } }
                    u32x4 w; w.x = pk2(v0[0], v0[1]); w.y = pk2(v0[2], v0[3]); w.z = pk2(v1[0], v1[1]); w.w = pk2(v1[2], v1[3]);
                    *(u32x4*)dst = w; } }
    }
};
template <int MODE  > struct EpiGate {
    static constexpr bool PERM = true, AFTER_DRAIN = false;
    const bf16_t* gate; const bf16_t* tin; bf16_t* outp;
    __device__ __forceinline__ void operator()(const pf4 (&acc)[2][2][4][2], const pg8::Unit& u, int wr, int wc, int fr, int fq) const {
        const int row0 = u.pm * 256 + wr * 64 + fr, col0 = u.pn * 256 + wc * 32 + 8 * fq;
#pragma unroll
        for (int ai = 0; ai < 2; ++ai)
#pragma unroll
            for (int m = 0; m < 4; ++m) { const size_t ro = (size_t)(row0 + ai * 128 + m * 16) * 1024 + col0;
#pragma unroll
                for (int bj = 0; bj < 2; ++bj) { const size_t o = ro + bj * 128; const pf4 v0 = acc[ai][bj][m][0], v1 = acc[ai][bj][m][1];
                    const u32x4 g = *(const u32x4*)(gate + o);
                    float r[8];
                    r[0] = v0[0] * bflo(g.x); r[1] = v0[1] * bfhi(g.x); r[2] = v0[2] * bflo(g.y); r[3] = v0[3] * bfhi(g.y);
                    r[4] = v1[0] * bflo(g.z); r[5] = v1[1] * bfhi(g.z); r[6] = v1[2] * bflo(g.w); r[7] = v1[3] * bfhi(g.w);
                    if (MODE == 1) { const u32x4 t = *(const u32x4*)(tin + o);
                        r[0] += bflo(t.x); r[1] += bfhi(t.x); r[2] += bflo(t.y); r[3] += bfhi(t.y); r[4] += bflo(t.z); r[5] += bfhi(t.z); r[6] += bflo(t.w); r[7] += bfhi(t.w); }
                    u32x4 w; w.x = pk2(r[0], r[1]); w.y = pk2(r[2], r[3]); w.z = pk2(r[4], r[5]); w.w = pk2(r[6], r[7]);
                    *(u32x4*)(outp + o) = w; } }
    }
};
struct EpiResid {
    static constexpr bool PERM = true, AFTER_DRAIN = false;
    const float* x; bf16_t* h1b; float* rowss;
    __device__ __forceinline__ void operator()(const pf4 (&acc)[2][2][4][2], const pg8::Unit& u, int wr, int wc, int fr, int fq) const {
        const int row0 = u.pm * 256 + wr * 64 + fr, col0 = u.pn * 256 + wc * 32 + 8 * fq;
#pragma unroll
        for (int ai = 0; ai < 2; ++ai)
#pragma unroll
            for (int m = 0; m < 4; ++m) { const int r = row0 + ai * 128 + m * 16; const size_t ro = (size_t)r * 1024 + col0; float ss = 0.f;
#pragma unroll
                for (int bj = 0; bj < 2; ++bj) { const size_t o = ro + bj * 128;
                    const pf4 x0 = *(const pf4*)(x + o), x1 = *(const pf4*)(x + o + 4);
                    const pf4 v0 = acc[ai][bj][m][0] + x0, v1 = acc[ai][bj][m][1] + x1;
                    u32x4 w; w.x = pk2(v0[0], v0[1]); w.y = pk2(v0[2], v0[3]); w.z = pk2(v1[0], v1[1]); w.w = pk2(v1[2], v1[3]);
                    *(u32x4*)(h1b + o) = w;
                    ss += (v0[0] * v0[0] + v0[1] * v0[1]) + (v0[2] * v0[2] + v0[3] * v0[3]) + (v1[0] * v1[0] + v1[1] * v1[1]) + (v1[2] * v1[2] + v1[3] * v1[3]); }
                ss += __shfl_xor(ss, 16); ss += __shfl_xor(ss, 32);
                if (fq == 0) atomicAdd(rowss + r, ss); }
    }
};
struct EpiScores {
    static constexpr bool PERM = true, AFTER_DRAIN = false;
    const float* rowss; _Float16* sc;
    __device__ __forceinline__ void operator()(const pf4 (&acc)[2][2][4][2], const pg8::Unit& u, int wr, int wc, int fr, int fq) const {
        const int row0 = u.pm * 256 + wr * 64 + fr, k0 = wc * 32 + 8 * fq;
#pragma unroll
        for (int ai = 0; ai < 2; ++ai)
#pragma unroll
            for (int m = 0; m < 4; ++m) { const int r = row0 + ai * 128 + m * 16; const float rs = rsqrtf(rowss[r] * (1.f / DM) + EPSF);
#pragma unroll
                for (int bj = 0; bj < 2; ++bj) { _Float16* p = sc + ((size_t)(((r >> 6) * 8 + u.pn) * 2 + bj) * 128 + k0) * 64 + (r & 63);
#pragma unroll
                    for (int j = 0; j < 4; ++j) { p[j * 64] = (_Float16)(acc[ai][bj][m][0][j] * rs); p[(4 + j) * 64] = (_Float16)(acc[ai][bj][m][1][j] * rs); } } }
    }
};

__device__ __forceinline__ void load8(const bf16_t* p, float (&f)[8]) { const u32x4 w = *(const u32x4*)p;
    f[0] = bflo(w.x); f[1] = bfhi(w.x); f[2] = bflo(w.y); f[3] = bfhi(w.y); f[4] = bflo(w.z); f[5] = bfhi(w.z); f[6] = bflo(w.w); f[7] = bfhi(w.w); }
__device__ __forceinline__ void short_conv8(const bf16_t* hb, const float* cw, const float* cb, int s, int ch, float (&o)[8]) {
    float xm[8], x0[8], xp[8];
    if (s >= 1) load8(hb + (size_t)(s - 1) * 1536 + ch, xm); else {
#pragma unroll
        for (int i = 0; i < 8; ++i) xm[i] = 0.f; }
    load8(hb + (size_t)s * 1536 + ch, x0);
    if (s + 1 < LT) load8(hb + (size_t)(s + 1) * 1536 + ch, xp); else {
#pragma unroll
        for (int i = 0; i < 8; ++i) xp[i] = 0.f; }
#pragma unroll
    for (int i = 0; i < 8; ++i) o[i] = xm[i] * cw[ch + i] + x0[i] * cw[1536 + ch + i] + xp[i] * cw[3072 + ch + i] + cb[ch + i];
}
__device__ __forceinline__ void phase_hy_pre(const Args& a, LAS unsigned char* lds, int tid) {
    LAS bf16_t* tl = (LAS bf16_t*)lds;
    const bf16_t* hyin = (const bf16_t*)(a.ws + WS_HYIN); bf16_t* uut = (bf16_t*)(a.ws + WS_UUT);
    const float* cw = a.in[I_HYCW]; const float* cb = a.in[I_HYCB];
    for (int it = blockIdx.x; it < NB * 67 * 8; it += gridDim.x) {
        const int ct = it & 7, ts = (it >> 3) % 67, b = (it >> 3) / 67;
        { const int sr = tid >> 3, cg = tid & 7, c0 = ct * 64 + cg * 8, sp = ts * 64 + sr, s = sp - 16;
            float uu[8];
            if (s >= 0 && s < LT) { float x1[8], v[8]; const bf16_t* hb = hyin + (size_t)b * LT * 1536;
                short_conv8(hb, cw, cb, s, 512 + c0, x1); short_conv8(hb, cw, cb, s, 1024 + c0, v);
#pragma unroll
                for (int i = 0; i < 8; ++i) uu[i] = v[i] * x1[i]; }
            else {
#pragma unroll
                for (int i = 0; i < 8; ++i) uu[i] = 0.f; }
#pragma unroll
            for (int i = 0; i < 8; ++i) tl[sr * 72 + cg * 8 + i] = (bf16_t)f2bf(uu[i]); }
        __syncthreads();
        { const int cl = tid >> 3, sg = tid & 7, sp0 = ts * 64 + sg * 8;
            if (sp0 < SP) { u32x4 w; unsigned h[8];
#pragma unroll
                for (int i = 0; i < 8; ++i) h[i] = tl[(sg * 8 + i) * 72 + cl];
                w.x = h[0] | (h[1] << 16); w.y = h[2] | (h[3] << 16); w.z = h[4] | (h[5] << 16); w.w = h[6] | (h[7] << 16);
                *(u32x4*)(uut + ((size_t)(ct * 64 + cl) * NB + b) * SP + sp0) = w; } }
        __syncthreads();
    }
}
__device__ __forceinline__ void phase_hy_conv_naive(const Args& a, LAS unsigned char* lds, int tid) {
    LAS bf16_t* uus = (LAS bf16_t*)lds;
    LAS float* filt = (LAS float*)(lds + LT * 16);
    const bf16_t* uut = (const bf16_t*)(a.ws + WS_UUT); const float* kf = (const float*)(a.ws + WS_KF); bf16_t* cvt = (bf16_t*)(a.ws + WS_CONVT);
    for (int c = blockIdx.x; c < DHY; c += gridDim.x) {
        for (int i = tid; i < NB * LT; i += NTHR) { const int b = i / LT, s = i - b * LT; uus[s * 8 + b] = uut[((size_t)c * NB + b) * SP + 16 + s]; }
        for (int i = tid; i < KFW; i += NTHR) filt[i] = kf[(size_t)c * KFW + i];
        __syncthreads();
        for (int tt = 0; tt < 8; ++tt) { const int tq = tt * 512 + tid, t = tq + 16; float acc[8];
#pragma unroll
            for (int b = 0; b < 8; ++b) acc[b] = 0.f;
            const LAS float* fp = filt + (LT - 1) + t;
            for (int s = 0; s < LT; ++s) { const float kv = fp[-s]; const u32x4 w = *(const LAS u32x4*)(uus + s * 8);
                acc[0] += kv * bflo(w.x); acc[1] += kv * bfhi(w.x); acc[2] += kv * bflo(w.y); acc[3] += kv * bfhi(w.y);
                acc[4] += kv * bflo(w.z); acc[5] += kv * bfhi(w.z); acc[6] += kv * bflo(w.w); acc[7] += kv * bfhi(w.w); }
#pragma unroll
            for (int b = 0; b < 8; ++b) cvt[((size_t)c * NB + b) * SEQ + tq] = (bf16_t)f2bf(acc[b]); }
        __syncthreads();
    }
}
__device__ __forceinline__ void phase_rg_naive(const Args& a, LAS unsigned char* lds, int tid) {
    LAS float* xc = (LAS float*)lds;
    LAS float* gbuf = xc + 32 * 128;
    const bf16_t* rgx = (const bf16_t*)(a.ws + WS_RGX);
    for (int it = blockIdx.x; it < NB * 2 * 8; it += gridDim.x) {
        const int head = it & 7, dir = (it >> 3) & 1, b = it >> 4;
        const float* cw = a.in[I_RGCW] + (size_t)dir * 4 * DRG + head * 128; const float* cb = a.in[I_RGCB] + (size_t)dir * DRG + head * 128;
        bf16_t* hout = (bf16_t*)a.out + (size_t)dir * T * DRG;
        const bf16_t* xb = rgx + (size_t)b * LT * DRG + head * 128;
        float h = 0.f, sp = 0.f;
        if (tid < 128) { const float lam = a.in[I_RGLAM][dir * DRG + head * 128 + tid]; sp = log1pf(__expf(-lam)); }
        for (int k = 0; k < 129; ++k) {
            { const int tok = tid >> 4, cg = tid & 15, u = 32 * k + tok; float o[8];
#pragma unroll
                for (int i = 0; i < 8; ++i) o[i] = (u < LT) ? cb[cg * 8 + i] : 0.f;
                if (u < LT) {
#pragma unroll
                    for (int j = 0; j < 4; ++j) { const int uu = u - j; if (uu >= 0) { const int t = dir ? (LT - 1 - uu) : uu; float xv[8]; load8(xb + (size_t)t * DRG + cg * 8, xv);
#pragma unroll
                            for (int i = 0; i < 8; ++i) o[i] += xv[i] * cw[j * DRG + cg * 8 + i]; } } }
#pragma unroll
                for (int i = 0; i < 8; ++i) xc[tok * 128 + cg * 8 + i] = o[i]; }
            __syncthreads();
            { const int j = tid & 127, g = (tid >> 7) & 1, th = tid >> 8; float acc[16];
#pragma unroll
                for (int q = 0; q < 16; ++q) acc[q] = 0.f;
                const float* gw = a.in[I_RGGW] + ((size_t)((dir * 2 + g) * 8 + head) * 128) * 128 + j;
                for (int i = 0; i < 128; ++i) { const float wv = gw[i * 128];
#pragma unroll
                    for (int q = 0; q < 16; ++q) acc[q] += xc[(th * 16 + q) * 128 + i] * wv; }
                const float gb = a.in[I_RGGB][(size_t)(dir * 2 + g) * DRG + head * 128 + j];
#pragma unroll
                for (int q = 0; q < 16; ++q) gbuf[(g * 32 + th * 16 + q) * 128 + j] = acc[q] + gb; }
            __syncthreads();
            if (tid < 128) {
                for (int tok = 0; tok < 32; ++tok) { const int u = 32 * k + tok; if (u >= LT) break;
                    const float r = sigmoidf_(gbuf[tok * 128 + tid]), ig = sigmoidf_(gbuf[(32 + tok) * 128 + tid]);
                    const float la = -8.0f * r * sp; const float av = __expf(la); const float mult = (u == 0) ? 1.0f : sqrtf(-expm1f(2.0f * la));
                    h = av * h + mult * ig * xc[tok * 128 + tid];
                    const int t = dir ? (LT - 1 - u) : u;
                    if (t >= NMETA) hout[((size_t)b * SEQ + (t - NMETA)) * DRG + head * 128 + tid] = (bf16_t)f2bf(h); } }
            __syncthreads();
        }
    }
}
__device__ __forceinline__ void phase_post(const Args& a, LAS unsigned char* lds, int tid) {
    LAS bf16_t* cv = (LAS bf16_t*)lds;
    const bf16_t* hyin = (const bf16_t*)(a.ws + WS_HYIN); const bf16_t* cvt = (const bf16_t*)(a.ws + WS_CONVT); bf16_t* yh = (bf16_t*)(a.ws + WS_YH);
    const float* cw = a.in[I_HYCW]; const float* cb = a.in[I_HYCB]; const float* skip = a.in[I_HYSKIP];
    for (int it = blockIdx.x; it < NB * 64 * 8; it += gridDim.x) {
        const int ct = it & 7, tt = (it >> 3) & 63, b = it >> 9;
        { const int cl = tid >> 3, tg = tid & 7; const u32x4 w = *(const u32x4*)(cvt + ((size_t)(ct * 64 + cl) * NB + b) * SEQ + tt * 64 + tg * 8);
            *(LAS u32x4*)(cv + cl * 72 + tg * 8) = w; }
        __syncthreads();
        { const int tr = tid >> 3, cg = tid & 7, c0 = ct * 64 + cg * 8, t = NMETA + tt * 64 + tr; const bf16_t* hb = hyin + (size_t)b * LT * 1536;
            float x0[8], x1[8], v[8]; short_conv8(hb, cw, cb, t, c0, x0); short_conv8(hb, cw, cb, t, 512 + c0, x1); short_conv8(hb, cw, cb, t, 1024 + c0, v);
            float y[8];
#pragma unroll
            for (int i = 0; i < 8; ++i) { const float cvv = bf2f(cv[(cg * 8 + i) * 72 + tr]); y[i] = (cvv + v[i] * x1[i] * skip[c0 + i]) * x0[i]; }
            u32x4 w; w.x = pk2(y[0], y[1]); w.y = pk2(y[2], y[3]); w.z = pk2(y[4], y[5]); w.w = pk2(y[6], y[7]);
            *(u32x4*)(yh + ((size_t)b * SEQ + tt * 64 + tr) * DHY + c0) = w; }
        __syncthreads();
    }
    const bf16_t* hf = (const bf16_t*)a.out; const bf16_t* hb2 = hf + (size_t)T * DRG; const bf16_t* gg = (const bf16_t*)(a.ws + WS_GG); bf16_t* yr = (bf16_t*)(a.ws + WS_YR);
    for (size_t i = (size_t)blockIdx.x * NTHR + tid; i < (size_t)T * DRG / 8; i += (size_t)gridDim.x * NTHR) {
        float f[8], g[8], q[8]; load8(hf + i * 8, f); load8(hb2 + i * 8, g); load8(gg + i * 8, q);
        u32x4 w; w.x = pk2((f[0] + g[0]) * q[0], (f[1] + g[1]) * q[1]); w.y = pk2((f[2] + g[2]) * q[2], (f[3] + g[3]) * q[3]);
        w.z = pk2((f[4] + g[4]) * q[4], (f[5] + g[5]) * q[5]); w.w = pk2((f[6] + g[6]) * q[6], (f[7] + g[7]) * q[7]);
        *(u32x4*)(yr + i * 8) = w; }
}
__device__ __forceinline__ u32x4 quant_row16(const f32x4 (&v)[4], float amax, float& deq) {
    const float sc = (amax > 0.f) ? 256.0f / amax : 1.0f; deq = (amax > 0.f) ? amax * (1.0f / 256.0f) : 1.0f;
    u32x4 w; int t;
    t = __builtin_amdgcn_cvt_pk_fp8_f32(v[0].x * sc, v[0].y * sc, 0, false); t = __builtin_amdgcn_cvt_pk_fp8_f32(v[0].z * sc, v[0].w * sc, t, true); w.x = (unsigned)t;
    t = __builtin_amdgcn_cvt_pk_fp8_f32(v[1].x * sc, v[1].y * sc, 0, false); t = __builtin_amdgcn_cvt_pk_fp8_f32(v[1].z * sc, v[1].w * sc, t, true); w.y = (unsigned)t;
    t = __builtin_amdgcn_cvt_pk_fp8_f32(v[2].x * sc, v[2].y * sc, 0, false); t = __builtin_amdgcn_cvt_pk_fp8_f32(v[2].z * sc, v[2].w * sc, t, true); w.z = (unsigned)t;
    t = __builtin_amdgcn_cvt_pk_fp8_f32(v[3].x * sc, v[3].y * sc, 0, false); t = __builtin_amdgcn_cvt_pk_fp8_f32(v[3].z * sc, v[3].w * sc, t, true); w.w = (unsigned)t;
    return w;
}
__device__ __forceinline__ void phase_tables(const Args& a, int wave, int lane) {
    const int gw = blockIdx.x * NWAVES + wave, NGW = gridDim.x * NWAVES;
    const float* gf = a.in[I_GFFN] + 16 * lane; unsigned char* uq = a.ws + WS_UB; unsigned char* vq = a.ws + WS_VB; float* su = (float*)(a.ws + WS_SU); float* sv = (float*)(a.ws + WS_SV);
    f32x4 g[4];
#pragma unroll
    for (int j = 0; j < 4; ++j) g[j] = *(const f32x4*)(gf + 4 * j);
    for (int e = gw; e < NEXP; e += NGW) {
        const float* ur = a.in[I_PU] + (size_t)e * DM + 16 * lane; const float* vr = a.in[I_PV] + (size_t)e * DM + 16 * lane;
        f32x4 u[4], v[4]; float mu = 0.f, mv = 0.f;
#pragma unroll
        for (int j = 0; j < 4; ++j) { u[j] = *(const f32x4*)(ur + 4 * j) * g[j]; v[j] = *(const f32x4*)(vr + 4 * j);
            mu = fmaxf(mu, fmaxf(fmaxf(fabsf(u[j].x), fabsf(u[j].y)), fmaxf(fabsf(u[j].z), fabsf(u[j].w))));
            mv = fmaxf(mv, fmaxf(fmaxf(fabsf(v[j].x), fabsf(v[j].y)), fmaxf(fabsf(v[j].z), fabsf(v[j].w)))); }
        mu = wave_max_dpp(mu); mv = wave_max_dpp(mv);
        float du, dv; const u32x4 qu = quant_row16(u, mu, du), qv = quant_row16(v, mv, dv);
        { const size_t so = ((size_t)(lane >> 3) * NEXP + e) * 128 + 16 * (lane & 7); *(u32x4*)(uq + so) = qu; *(u32x4*)(vq + so) = qv; }
        if (lane == 0) { su[e] = du; sv[e] = dv; }
    }
}
__device__ __forceinline__ void ce_desc(float& a, float& b) { const float hi = fmaxf(a, b), lo = fminf(a, b); a = hi; b = lo; }
__device__ __forceinline__ void sort16_desc(float (&x)[16]) {
#pragma unroll
    for (int k = 2; k <= 16; k <<= 1)
#pragma unroll
        for (int j = k >> 1; j > 0; j >>= 1)
#pragma unroll
            for (int i = 0; i < 16; ++i) { const int l = i ^ j; if (l > i) { if ((i & k) == 0) ce_desc(x[i], x[l]); else ce_desc(x[l], x[i]); } }
}
__device__ __forceinline__ void merge_top16(float (&L)[16], const float (&X)[16]) {
#pragma unroll
    for (int i = 0; i < 16; ++i) L[i] = fmaxf(L[i], X[15 - i]);
#pragma unroll
    for (int j = 8; j > 0; j >>= 1)
#pragma unroll
        for (int i = 0; i < 16; ++i) { const int l = i ^ j; if (l > i) ce_desc(L[i], L[l]); }
}
__device__ __forceinline__ void top16_of_128(const _Float16* base  , float (&L)[16]) {
#pragma unroll 1
    for (int ch = 0; ch < 8; ++ch) { float X[16];
#pragma unroll
        for (int i = 0; i < 16; ++i) X[i] = __uint_as_float((__float_as_uint((float)base[(ch * 16 + i) * 64]) & ~0x7Fu) | (unsigned)(ch * 16 + i));
        sort16_desc(X);
        if (ch == 0) {
#pragma unroll
            for (int i = 0; i < 16; ++i) L[i] = X[i]; }
        else merge_top16(L, X); }
}
struct CandTab { int ci[64], cj[64]; };
__host__ __device__ constexpr CandTab make_cand() { CandTab t{}; int n = 0; for (int i = 0; i < 16; ++i) for (int j = 0; j < 16; ++j) if ((i + 1) * (j + 1) <= 16) { t.ci[n] = i; t.cj[n] = j; ++n; }
    for (; n < 64; ++n) { t.ci[n] = -1; t.cj[n] = -1; } return t; }
__device__ __forceinline__ void phase_topk(const Args& a, LAS unsigned char* lds, int wave, int lane) {
    constexpr CandTab CT = make_cand();
    const int gw = blockIdx.x * NWAVES + wave, NGW = gridDim.x * NWAVES;
    const _Float16* st = (const _Float16*)(a.ws + WS_SCORES); int* eidx = (int*)(a.ws + WS_EIDX); float* eg = (float*)(a.ws + WS_EG);
    LAS unsigned char* tab = lds + wave * (64 * 36) + lane * 36;
    for (int it = gw; it < (T / 64) * 8; it += NGW) { const int tg = it >> 3, hh = it & 7; const int m = tg * 64 + lane;
        float A[16], B[16];
        top16_of_128(st + (size_t)((tg * 8 + hh) * 2 + 0) * 128 * 64 + lane, A);
        top16_of_128(st + (size_t)((tg * 8 + hh) * 2 + 1) * 128 * 64 + lane, B);
#pragma unroll
        for (int q = 0; q < 4; ++q) {
            const unsigned wa = (__float_as_uint(A[4 * q]) & 0x7Fu) | ((__float_as_uint(A[4 * q + 1]) & 0x7Fu) << 8) | ((__float_as_uint(A[4 * q + 2]) & 0x7Fu) << 16) | ((__float_as_uint(A[4 * q + 3]) & 0x7Fu) << 24);
            const unsigned wb = (__float_as_uint(B[4 * q]) & 0x7Fu) | ((__float_as_uint(B[4 * q + 1]) & 0x7Fu) << 8) | ((__float_as_uint(B[4 * q + 2]) & 0x7Fu) << 16) | ((__float_as_uint(B[4 * q + 3]) & 0x7Fu) << 24);
            *(LAS unsigned*)(tab + 4 * q) = wa; *(LAS unsigned*)(tab + 16 + 4 * q) = wb; }
#pragma unroll
        for (int i = 0; i < 16; ++i) { A[i] = __uint_as_float(__float_as_uint(A[i]) & ~0x7Fu); B[i] = __uint_as_float(__float_as_uint(B[i]) & ~0x7Fu); }
        float K[16];
#pragma unroll
        for (int c0 = 0; c0 < 64; c0 += 16) { float X[16];
#pragma unroll
            for (int i = 0; i < 16; ++i) { const int c = c0 + i;
                if (CT.ci[c] >= 0) X[i] = __uint_as_float((__float_as_uint(A[CT.ci[c] < 0 ? 0 : CT.ci[c]] + B[CT.cj[c] < 0 ? 0 : CT.cj[c]]) & ~0xFFu) | (unsigned)(CT.ci[c] * 16 + CT.cj[c]));
                else X[i] = -INFINITY; }
            sort16_desc(X);
            if (c0 == 0) {
#pragma unroll
                for (int i = 0; i < 16; ++i) K[i] = X[i]; }
            else merge_top16(K, X); }
        asm volatile("s_waitcnt lgkmcnt(0)" ::: "memory");
        int ex_[16]; float cs[16]; float sum = 0.f;
#pragma unroll
        for (int r = 0; r < 16; ++r) { const unsigned kb = __float_as_uint(K[r]); const int id = kb & 0xFF; cs[r] = __expf(__uint_as_float(kb & ~0xFFu) - __uint_as_float(__float_as_uint(K[0]) & ~0xFFu)); sum += cs[r];
            ex_[r] = (int)tab[id >> 4] * 128 + (int)tab[16 + (id & 15)]; }
        const float inv = 1.0f / sum;
        unsigned short* ep = (unsigned short*)eidx + (size_t)m * 128 + hh * 16; float* gp = eg + (size_t)m * 128 + hh * 16;
        { u32x4 p0, p1; p0.x = ex_[0] | (ex_[1] << 16); p0.y = ex_[2] | (ex_[3] << 16); p0.z = ex_[4] | (ex_[5] << 16); p0.w = ex_[6] | (ex_[7] << 16);
          p1.x = ex_[8] | (ex_[9] << 16); p1.y = ex_[10] | (ex_[11] << 16); p1.z = ex_[12] | (ex_[13] << 16); p1.w = ex_[14] | (ex_[15] << 16); *(u32x4*)ep = p0; *(u32x4*)(ep + 8) = p1; }
#pragma unroll
        for (int q = 0; q < 4; ++q) {
            *(f32x4*)(gp + 4 * q) = (f32x4){cs[4 * q] * inv, cs[4 * q + 1] * inv, cs[4 * q + 2] * inv, cs[4 * q + 3] * inv}; }
    }
}
__device__ __forceinline__ void unpack8(const u32x4 w, float (&f)[8]) {
    f[0] = bflo(w.x); f[1] = bfhi(w.x); f[2] = bflo(w.y); f[3] = bfhi(w.y); f[4] = bflo(w.z); f[5] = bfhi(w.z); f[6] = bflo(w.w); f[7] = bfhi(w.w); }
__device__ __forceinline__ void fp8x16_to_f32(const u32x4 w, float (&f)[16]) {
    f32x2v t;
    t = __builtin_amdgcn_cvt_pk_f32_fp8((int)w.x, false); f[0] = t.x; f[1] = t.y; t = __builtin_amdgcn_cvt_pk_f32_fp8((int)w.x, true); f[2] = t.x; f[3] = t.y;
    t = __builtin_amdgcn_cvt_pk_f32_fp8((int)w.y, false); f[4] = t.x; f[5] = t.y; t = __builtin_amdgcn_cvt_pk_f32_fp8((int)w.y, true); f[6] = t.x; f[7] = t.y;
    t = __builtin_amdgcn_cvt_pk_f32_fp8((int)w.z, false); f[8] = t.x; f[9] = t.y; t = __builtin_amdgcn_cvt_pk_f32_fp8((int)w.z, true); f[10] = t.x; f[11] = t.y;
    t = __builtin_amdgcn_cvt_pk_f32_fp8((int)w.w, false); f[12] = t.x; f[13] = t.y; t = __builtin_amdgcn_cvt_pk_f32_fp8((int)w.w, true); f[14] = t.x; f[15] = t.y;
}
__device__ __forceinline__ void fp8x16_to_f32x2(const u32x4 w, f32x2v (&f)[8]) {
    f[0] = __builtin_amdgcn_cvt_pk_f32_fp8((int)w.x, false); f[1] = __builtin_amdgcn_cvt_pk_f32_fp8((int)w.x, true);
    f[2] = __builtin_amdgcn_cvt_pk_f32_fp8((int)w.y, false); f[3] = __builtin_amdgcn_cvt_pk_f32_fp8((int)w.y, true);
    f[4] = __builtin_amdgcn_cvt_pk_f32_fp8((int)w.z, false); f[5] = __builtin_amdgcn_cvt_pk_f32_fp8((int)w.z, true);
    f[6] = __builtin_amdgcn_cvt_pk_f32_fp8((int)w.w, false); f[7] = __builtin_amdgcn_cvt_pk_f32_fp8((int)w.w, true);
}
__device__ __forceinline__ float dpp_sum8(float v) {
    v += __int_as_float(__builtin_amdgcn_update_dpp(0, __float_as_int(v), 0xB1, 0xF, 0xF, true));
    v += __int_as_float(__builtin_amdgcn_update_dpp(0, __float_as_int(v), 0x4E, 0xF, 0xF, true));
    v += __int_as_float(__builtin_amdgcn_update_dpp(0, __float_as_int(v), 0x141, 0xF, 0xF, true));
    return v;
}
struct UTok { u32x4 e0, e1, xa, xb; };
struct VTok { u32x4 e0, e1; f32x4 av[4]; };
__device__ __forceinline__ void pu_issue(const unsigned char* tab, unsigned loff, const u32x4& e, u32x4 (&w)[8]) {
    w[0] = *(const u32x4*)(tab + ((e.x & 0xffffu) * 128u + loff)); w[1] = *(const u32x4*)(tab + ((e.x >> 16) * 128u + loff));
    w[2] = *(const u32x4*)(tab + ((e.y & 0xffffu) * 128u + loff)); w[3] = *(const u32x4*)(tab + ((e.y >> 16) * 128u + loff));
    w[4] = *(const u32x4*)(tab + ((e.z & 0xffffu) * 128u + loff)); w[5] = *(const u32x4*)(tab + ((e.z >> 16) * 128u + loff));
    w[6] = *(const u32x4*)(tab + ((e.w & 0xffffu) * 128u + loff)); w[7] = *(const u32x4*)(tab + ((e.w >> 16) * 128u + loff));
}
__device__ __forceinline__ float pu_compute(const f32x2v (&x)[8], const u32x4 (&w)[8], int i) {
    float keep = 0.f;
#pragma unroll
    for (int q = 0; q < 8; ++q) { f32x2v f[8]; fp8x16_to_f32x2(w[q], f); f32x2v s0 = f[0] * x[0], s1 = f[1] * x[1];
#pragma unroll
        for (int c = 2; c < 8; c += 2) { s0 += f[c] * x[c]; s1 += f[c + 1] * x[c + 1]; }
        s0 += s1; const float d = dpp_sum8(s0.x + s0.y); keep = (q == i) ? d : keep; }
    return keep;
}
__device__ __forceinline__ void phase_peer_u(const Args& a, int wave, int lane) {
    const int s = SLICE_OF(blockIdx.x), rk = RANK_OF(blockIdx.x), nrk = gridDim.x >> 3, tper = T / nrk, i = lane & 7, j = lane >> 3;
    const bf16_t* h1b = (const bf16_t*)(a.ws + WS_H1B) + 128 * s + 16 * i; const unsigned char* uqs = a.ws + WS_UB + (size_t)s * NEXP * 128; const unsigned loff = 16u * (unsigned)i;
    const unsigned short* eidx = (const unsigned short*)(a.ws + WS_EIDX) + 16 * j; float* pd = (float*)(a.ws + WS_PD) + (size_t)s * T * 128 + 16 * j + i;
    const int m0 = rk * tper + wave, mlast = (rk + 1) * tper - NWAVES + wave;
#define PU_LOAD(t, mm) do { const int m_ = (mm) < mlast ? (mm) : mlast; const u32x4* ep_ = (const u32x4*)(eidx + (size_t)m_ * 128); (t).e0 = ep_[0]; (t).e1 = ep_[1]; \
        (t).xa = *(const u32x4*)(h1b + (size_t)m_ * DM); (t).xb = *(const u32x4*)(h1b + (size_t)m_ * DM + 8); } while (0)
#define PU_DO(t, w0, w1, mm) do { f32x2v x[8]; \
        x[0] = (f32x2v){bflo((t).xa.x), bfhi((t).xa.x)}; x[1] = (f32x2v){bflo((t).xa.y), bfhi((t).xa.y)}; x[2] = (f32x2v){bflo((t).xa.z), bfhi((t).xa.z)}; x[3] = (f32x2v){bflo((t).xa.w), bfhi((t).xa.w)}; \
        x[4] = (f32x2v){bflo((t).xb.x), bfhi((t).xb.x)}; x[5] = (f32x2v){bflo((t).xb.y), bfhi((t).xb.y)}; x[6] = (f32x2v){bflo((t).xb.z), bfhi((t).xb.z)}; x[7] = (f32x2v){bflo((t).xb.w), bfhi((t).xb.w)}; \
        const float k0_ = pu_compute(x, w0, i), k1_ = pu_compute(x, w1, i); pd[(size_t)(mm) * 128] = k0_; pd[(size_t)(mm) * 128 + 8] = k1_; } while (0)
    UTok tC, tN, tNN; u32x4 wA[8], wB[8], wC[8], wD[8];
    PU_LOAD(tC, m0); PU_LOAD(tN, m0 + NWAVES); PU_LOAD(tNN, m0 + 2 * NWAVES); pu_issue(uqs, loff, tC.e0, wA); pu_issue(uqs, loff, tC.e1, wB);
    for (int m = m0; m <= mlast; m += 2 * NWAVES) {
        pu_issue(uqs, loff, tN.e0, wC); pu_issue(uqs, loff, tN.e1, wD);
        PU_DO(tC, wA, wB, m);
        tC = tN; tN = tNN; PU_LOAD(tNN, m + 3 * NWAVES);
        pu_issue(uqs, loff, tN.e0, wA); pu_issue(uqs, loff, tN.e1, wB);
        PU_DO(tC, wC, wD, m + NWAVES);
        tC = tN; tN = tNN; PU_LOAD(tNN, m + 4 * NWAVES);
    }
#undef PU_LOAD
#undef PU_DO
}
__device__ __forceinline__ void phase_peer_act(const Args& a, int tid) {
    const float* pd = (const float*)(a.ws + WS_PD); const unsigned short* eidx = (const unsigned short*)(a.ws + WS_EIDX); const float* eg = (const float*)(a.ws + WS_EG);
    const float* su = (const float*)(a.ws + WS_SU); const float* sv = (const float*)(a.ws + WS_SV); const float* rowss = (const float*)(a.ws + WS_ROWSS); float* act = (float*)(a.ws + WS_ACT);
    for (size_t i4 = (size_t)blockIdx.x * NTHR + tid; i4 < (size_t)T * 32; i4 += (size_t)gridDim.x * NTHR) { const size_t idx = i4 * 4;
        f32x4 d = *(const f32x4*)(pd + idx);
#pragma unroll
        for (int s = 1; s < 8; ++s) d += *(const f32x4*)(pd + (size_t)s * T * 128 + idx);
        const u32x2 ew = *(const u32x2*)(eidx + idx); const f32x4 g = *(const f32x4*)(eg + idx); const float rstd = rsqrtf(rowss[idx >> 7] * (1.f / DM) + EPSF);
        const unsigned e0 = ew.x & 0xffffu, e1 = ew.x >> 16, e2 = ew.y & 0xffffu, e3 = ew.y >> 16;
        f32x4 o; o.x = gelu_tanh(d.x * su[e0] * rstd) * g.x * sv[e0]; o.y = gelu_tanh(d.y * su[e1] * rstd) * g.y * sv[e1];
        o.z = gelu_tanh(d.z * su[e2] * rstd) * g.z * sv[e2]; o.w = gelu_tanh(d.w * su[e3] * rstd) * g.w * sv[e3];
        *(f32x4*)(act + idx) = o;
    }
}
__device__ __forceinline__ void pv_accum(const u32x4 (&w)[8], const f32x4& a0, const f32x4& a1, f32x2v (&o)[8]) {
#pragma unroll
    for (int q = 0; q < 8; ++q) { f32x2v f[8]; fp8x16_to_f32x2(w[q], f); const float aq = (q < 4) ? a0[q & 3] : a1[q & 3]; const f32x2v a2 = (f32x2v){aq, aq};
#pragma unroll
        for (int c = 0; c < 8; ++c) o[c] += a2 * f[c]; }
}
__device__ __forceinline__ void pv_finish(const f32x2v (&o2)[8], float* orow, int j) {
    float o[16];
#pragma unroll
    for (int c = 0; c < 8; ++c) { o[2 * c] = o2[c].x; o[2 * c + 1] = o2[c].y; }
#pragma unroll
    for (int c = 0; c < 16; ++c) { o[c] += __int_as_float(__builtin_amdgcn_update_dpp(0, __float_as_int(o[c]), 0x128, 0xF, 0xF, true));
        o[c] += __shfl_xor(o[c], 16); o[c] += __shfl_xor(o[c], 32); }
    if (j == 0) {
#pragma unroll
        for (int c4 = 0; c4 < 4; ++c4) *(f32x4*)(orow + 4 * c4) = (f32x4){o[4 * c4], o[4 * c4 + 1], o[4 * c4 + 2], o[4 * c4 + 3]}; }
}
__device__ __forceinline__ void phase_peer_v(const Args& a, int wave, int lane) {
    const int s = SLICE_OF(blockIdx.x), rk = RANK_OF(blockIdx.x), nrk = gridDim.x >> 3, tper = T / nrk, i = lane & 7, j = lane >> 3;
    const unsigned char* vqs = a.ws + WS_VB + (size_t)s * NEXP * 128; const unsigned loff = 16u * (unsigned)i;
    const unsigned short* eidx = (const unsigned short*)(a.ws + WS_EIDX) + 16 * j; const float* act = (const float*)(a.ws + WS_ACT) + 16 * j;
    float* obase = (float*)(a.ws + WS_PO) + 128 * s + 16 * i;
    const int m0 = rk * tper + wave, mlast = (rk + 1) * tper - NWAVES + wave;
#define PV_LOAD(t, mm) do { const int m_ = (mm) < mlast ? (mm) : mlast; const u32x4* ep_ = (const u32x4*)(eidx + (size_t)m_ * 128); const f32x4* ap_ = (const f32x4*)(act + (size_t)m_ * 128); \
        (t).e0 = ep_[0]; (t).e1 = ep_[1]; (t).av[0] = ap_[0]; (t).av[1] = ap_[1]; (t).av[2] = ap_[2]; (t).av[3] = ap_[3]; } while (0)
#define PV_DO(t, w0, w1, mm) do { f32x2v o[8]; _Pragma("unroll") for (int c = 0; c < 8; ++c) o[c] = (f32x2v){0.f, 0.f}; \
        pv_accum(w0, (t).av[0], (t).av[1], o); pv_accum(w1, (t).av[2], (t).av[3], o); pv_finish(o, obase + (size_t)(mm) * DM, j); } while (0)
    VTok tC, tN, tNN; u32x4 wA[8], wB[8], wC[8], wD[8];
    PV_LOAD(tC, m0); PV_LOAD(tN, m0 + NWAVES); PV_LOAD(tNN, m0 + 2 * NWAVES); pu_issue(vqs, loff, tC.e0, wA); pu_issue(vqs, loff, tC.e1, wB);
    for (int m = m0; m <= mlast; m += 2 * NWAVES) {
        pu_issue(vqs, loff, tN.e0, wC); pu_issue(vqs, loff, tN.e1, wD);
        PV_DO(tC, wA, wB, m);
        tC = tN; tN = tNN; PV_LOAD(tNN, m + 3 * NWAVES);
        pu_issue(vqs, loff, tN.e0, wA); pu_issue(vqs, loff, tN.e1, wB);
        PV_DO(tC, wC, wD, m + NWAVES);
        tC = tN; tN = tNN; PV_LOAD(tNN, m + 4 * NWAVES);
    }
#undef PV_LOAD
#undef PV_DO
}
__device__ __forceinline__ void phase_final(const Args& a, int wave, int lane) {
    const int gw = blockIdx.x * NWAVES + wave, NGW = gridDim.x * NWAVES; const float* po = (const float*)(a.ws + WS_PO) + 16 * lane; const bf16_t* h1b = (const bf16_t*)(a.ws + WS_H1B) + 16 * lane;
    f32x4 gf[4];
#pragma unroll
    for (int jj = 0; jj < 4; ++jj) gf[jj] = *(const f32x4*)(a.in[I_GFINAL] + 16 * lane + 4 * jj);
    for (int m = gw; m < T; m += NGW) { float hb[16]; load8(h1b + (size_t)m * DM, *(float(*)[8])&hb[0]); load8(h1b + (size_t)m * DM + 8, *(float(*)[8])&hb[8]);
        f32x4 h[4]; float ss = 0.f;
#pragma unroll
        for (int jj = 0; jj < 4; ++jj) { h[jj] = *(const f32x4*)(po + (size_t)m * DM + 4 * jj) + (f32x4){hb[4 * jj], hb[4 * jj + 1], hb[4 * jj + 2], hb[4 * jj + 3]};
            ss += (h[jj].x * h[jj].x + h[jj].y * h[jj].y) + (h[jj].z * h[jj].z + h[jj].w * h[jj].w); }
        const float r2 = rsqrtf(wave_sum_dpp(ss) * (1.f / DM) + EPSF);
        float* orow = a.out + (size_t)m * DM + 16 * lane;
#pragma unroll
        for (int jj = 0; jj < 4; ++jj) *(f32x4*)(orow + 4 * jj) = h[jj] * r2 * gf[jj]; }
}
typedef short bf16x8_t __attribute__((ext_vector_type(8)));
__device__ __forceinline__ bf16x8_t toep_frag(const LAS unsigned* R32, int base) {
    const int e = base >> 1, sh = (base & 1) * 16;
    const unsigned d0 = R32[e], d1 = R32[e + 1], d2 = R32[e + 2], d3 = R32[e + 3], d4 = R32[e + 4];
    u32x4 o; o.x = __builtin_amdgcn_alignbit(d1, d0, sh); o.y = __builtin_amdgcn_alignbit(d2, d1, sh); o.z = __builtin_amdgcn_alignbit(d3, d2, sh); o.w = __builtin_amdgcn_alignbit(d4, d3, sh);
    return __builtin_bit_cast(bf16x8_t, o);
}
__device__ __forceinline__ void hy_conv_channel(const Args& a, LAS unsigned char* lds, int c, int tid, int wave, int lane) {
    constexpr int UROW = SP * 2;
    LAS unsigned char* uus = lds;
    LAS unsigned short* R = (LAS unsigned short*)(lds + 8 * UROW);
    const bf16_t* uut = (const bf16_t*)(a.ws + WS_UUT); const bf16_t* kfb = (const bf16_t*)(a.ws + WS_KFB); bf16_t* cvt = (bf16_t*)(a.ws + WS_CONVT);
    { const u32x4* src = (const u32x4*)(uut + (size_t)c * NB * SP); for (int i = tid; i < 8 * UROW / 16; i += NTHR) ((LAS u32x4*)uus)[i] = src[i]; }
    for (int n = tid; n < KFW + 16; n += NTHR) R[n] = (n < KFW) ? kfb[(size_t)c * KFW + (KFW - 1) - n] : (unsigned short)0;
    __syncthreads();
    const LAS unsigned* R32 = (const LAS unsigned*)R;
    const int i = lane & 15, g = lane >> 4, p = (lane >> 3) & 1, b = lane & 7;
    f32x4 C[16]; bf16x8_t A[16];
    const int abase = LT - 32 * (1 + 16 * wave) - i + 8 * g;
#pragma unroll
    for (int tb = 0; tb < 16; ++tb) { C[tb] = (f32x4){0.f, 0.f, 0.f, 0.f}; A[tb] = toep_frag(R32, abase - 32 * tb); }
    const LAS unsigned char* bptr = uus + b * UROW + (16 * p + 8 * g) * 2;
#define HC_STEP(ph, n) do { A[(16 - (ph)) & 15] = toep_frag(R32, abase + 32 * (n)); const bf16x8_t Bf = *(const LAS bf16x8_t*)(bptr + (n) * 64); \
        _Pragma("unroll") for (int tb = 0; tb < 16; ++tb) C[tb] = __builtin_amdgcn_mfma_f32_16x16x32_bf16(A[(tb - (ph)) & 15], Bf, C[tb], 0, 0, 0); } while (0)
    for (int G = 0; G < 8; ++G) { const int n0 = G * 16;
        HC_STEP(0, n0); HC_STEP(1, n0 + 1); HC_STEP(2, n0 + 2); HC_STEP(3, n0 + 3); HC_STEP(4, n0 + 4); HC_STEP(5, n0 + 5); HC_STEP(6, n0 + 6); HC_STEP(7, n0 + 7);
        HC_STEP(8, n0 + 8); HC_STEP(9, n0 + 9); HC_STEP(10, n0 + 10); HC_STEP(11, n0 + 11); HC_STEP(12, n0 + 12); HC_STEP(13, n0 + 13); HC_STEP(14, n0 + 14); HC_STEP(15, n0 + 15); }
    HC_STEP(0, 128);
#undef HC_STEP
#pragma unroll
    for (int tb = 0; tb < 16; ++tb) { const int tq = 512 * wave + 32 * tb + 16 * p + 4 * g;
        u32x2 w; w.x = pk2(C[tb][0], C[tb][1]); w.y = pk2(C[tb][2], C[tb][3]);
        *(u32x2*)(cvt + ((size_t)c * NB + b) * SEQ + tq) = w; }
    __syncthreads();
}
__device__ __forceinline__ void rg_item(const Args& a, LAS unsigned char* lds, int it, int tid, int wave, int lane) {
    constexpr int XROW = 272;
    const int head = it & 7, dir = (it >> 3) & 1, b = it >> 4;
    const bf16_t* xb = (const bf16_t*)(a.ws + WS_RGX) + (size_t)b * LT * DRG + head * 128;
    bf16_t* hout = (bf16_t*)a.out + (size_t)dir * T * DRG + (size_t)b * SEQ * DRG + head * 128 + 16 * wave + (lane & 15);
    const int col = lane & 15, g = lane >> 4, ch = head * 128 + 16 * wave + col;
    LAS unsigned char* wl = lds + 2 * 64 * XROW + wave * 1024 + lane * 16;
#pragma unroll
    for (int gt = 0; gt < 2; ++gt)
#pragma unroll
        for (int ks = 0; ks < 4; ++ks) { const float* wp = a.in[I_RGGW] + ((size_t)((dir * 2 + gt) * 8 + head) * 128 + 32 * ks + 8 * g) * 128 + 16 * wave + col;
            u32x4 o; o.x = pk2(wp[0], wp[128]); o.y = pk2(wp[256], wp[384]); o.z = pk2(wp[512], wp[640]); o.w = pk2(wp[768], wp[896]); *(LAS u32x4*)(wl + (gt * 4 + ks) * 8192) = o; }
    const float br = a.in[I_RGGB][(size_t)(dir * 2 + 0) * DRG + ch], bi = a.in[I_RGGB][(size_t)(dir * 2 + 1) * DRG + ch];
    const float sp8 = -8.0f * log1pf(__expf(-a.in[I_RGLAM][dir * DRG + ch]));
    const int ctr = tid >> 4, ccg = tid & 15;
    float cwv[4][8], cbv[8];
#pragma unroll
    for (int i = 0; i < 8; ++i) { cbv[i] = a.in[I_RGCB][(size_t)dir * DRG + head * 128 + 8 * ccg + i];
#pragma unroll
        for (int j = 0; j < 4; ++j) cwv[j][i] = a.in[I_RGCW][((size_t)dir * 4 + j) * DRG + head * 128 + 8 * ccg + i]; }
    u32x4 xr[2][4];
#define RG_LOAD(k) do { _Pragma("unroll") for (int h_ = 0; h_ < 2; ++h_) { const int u_ = 64 * (k) + ctr + 32 * h_; _Pragma("unroll") for (int j = 0; j < 4; ++j) { const int uu_ = u_ - j; \
        if (uu_ >= 0 && uu_ < LT) { const int t_ = dir ? (LT - 1 - uu_) : uu_; xr[h_][j] = *(const u32x4*)(xb + (size_t)t_ * DRG + 8 * ccg); } \
        else xr[h_][j] = (u32x4){0u, 0u, 0u, 0u}; } } } while (0)
#define RG_CONV(k) do { _Pragma("unroll") for (int h_ = 0; h_ < 2; ++h_) { const int u_ = 64 * (k) + ctr + 32 * h_; float o_[8]; _Pragma("unroll") for (int i = 0; i < 8; ++i) o_[i] = (u_ < LT) ? cbv[i] : 0.f; \
        _Pragma("unroll") for (int j = 0; j < 4; ++j) { float f_[8]; unpack8(xr[h_][j], f_); _Pragma("unroll") for (int i = 0; i < 8; ++i) o_[i] += f_[i] * cwv[j][i]; } \
        u32x4 w0_; w0_.x = pk2(o_[0], o_[1]); w0_.y = pk2(o_[2], o_[3]); w0_.z = pk2(o_[4], o_[5]); w0_.w = pk2(o_[6], o_[7]); \
        *(LAS u32x4*)(lds + ((k) & 1) * (64 * XROW) + (ctr + 32 * h_) * XROW + ccg * 16) = w0_; } } while (0)
    RG_LOAD(0); RG_CONV(0); RG_LOAD(1);
    __syncthreads();
    float carry = 0.f;
    const int arow = 16 * (col >> 2) + (col & 3);
    for (int k = 0; k < 65; ++k) {
        if (k + 1 < 65) RG_CONV(k + 1);
        if (k + 2 < 65) RG_LOAD(k + 2);
        const LAS unsigned char* xa = lds + (k & 1) * (64 * XROW);
        unsigned hp[16]; float hh = 0.f, PP = 1.f;
#pragma unroll
        for (int mp = 0; mp < 2; ++mp) {
            f32x4 acc[2][2];
#pragma unroll
            for (int m2 = 0; m2 < 2; ++m2) { const int mb = 2 * mp + m2; acc[0][m2] = (f32x4){0.f, 0.f, 0.f, 0.f}; acc[1][m2] = (f32x4){0.f, 0.f, 0.f, 0.f};
#pragma unroll
                for (int ks = 0; ks < 4; ++ks) { const bf16x8_t Af = *(const LAS bf16x8_t*)(xa + (arow + 4 * mb) * XROW + (32 * ks + 8 * g) * 2);
                    acc[0][m2] = __builtin_amdgcn_mfma_f32_16x16x32_bf16(Af, *(const LAS bf16x8_t*)(wl + ks * 8192), acc[0][m2], 0, 0, 0);
                    acc[1][m2] = __builtin_amdgcn_mfma_f32_16x16x32_bf16(Af, *(const LAS bf16x8_t*)(wl + (4 + ks) * 8192), acc[1][m2], 0, 0, 0); } }
#pragma unroll
            for (int m2 = 0; m2 < 2; ++m2)
#pragma unroll
                for (int r = 0; r < 4; ++r) { const int e = 8 * mp + 4 * m2 + r, tau = 16 * g + e, u = 64 * k + tau;
                    const float rr = sigmoidf_(acc[0][m2][r] + br), ii = sigmoidf_(acc[1][m2][r] + bi);
                    float av = fexp(sp8 * rr); float mult = __builtin_amdgcn_sqrtf(fmaxf(1.0f - av * av, 0.f)); mult = (u == 0) ? 1.0f : mult;
                    const float xcv = bf2f(*(const LAS unsigned short*)(xa + tau * XROW + (16 * wave + col) * 2));
                    float bq = mult * ii * xcv; if (u >= LT) { av = 1.f; bq = 0.f; }
                    hh = av * hh + bq; PP *= av; hp[e] = pk2(hh, PP); }
        }
        float Pg[4], hg[4];
#pragma unroll
        for (int q = 0; q < 4; ++q) { Pg[q] = __shfl(PP, col + 16 * q); hg[q] = __shfl(hh, col + 16 * q); }
        const float H0 = carry, H1 = Pg[0] * H0 + hg[0], H2 = Pg[1] * H1 + hg[1], H3 = Pg[2] * H2 + hg[2], H4 = Pg[3] * H3 + hg[3];
        const float Hin = (g == 0) ? H0 : (g == 1) ? H1 : (g == 2) ? H2 : H3;
        carry = H4;
#pragma unroll
        for (int e = 0; e < 16; ++e) { const int u = 64 * k + 16 * g + e; const int t = dir ? (LT - 1 - u) : u;
            if (u < LT && t >= NMETA) hout[(size_t)(t - NMETA) * DRG] = (bf16_t)f2bf(bflo(hp[e]) + bfhi(hp[e]) * Hin); }
        __syncthreads();
    }
#undef RG_LOAD
#undef RG_CONV
}

#ifndef RG_NAIVE
#define RG_NAIVE 0
#endif
#ifndef CONV_NAIVE
#define CONV_NAIVE 0
#endif
#ifndef ONE_LAUNCH
#define ONE_LAUNCH 0
#endif
constexpr int NPHASE = 13;
#ifndef NVGPR
#define NVGPR 248
#endif
__global__ void __launch_bounds__(NTHR, 2) __attribute__((amdgpu_num_vgpr(NVGPR))) mega(Args a) {
    extern __shared__ __attribute__((aligned(16))) unsigned char lds_raw[];
    LAS unsigned char* lds = (LAS unsigned char*)lds_raw;
    const int tid = threadIdx.x, lane = tid & 63, wave = __builtin_amdgcn_readfirstlane(tid >> 6);
    cg::grid_group grid = cg::this_grid();
    volatile LAS unsigned* bst = (volatile LAS unsigned*)(lds + LDS_BYTES - 64);
    if (tid == 0) { bst[0] = 0u; bst[1] = 0u; }
    __syncthreads();
    XcdBarrier xbar; xbar.bar = (unsigned*)(a.ws + WS_BAR); xbar.x = 0; xbar.st = bst;
    if (a.ph_hi - a.ph_lo > 1) xbar = xcd_barrier_post((unsigned*)(a.ws + WS_BAR), bst);
    const int lo = a.ph_lo, hi = a.ph_hi, G = gridDim.x, bx = blockIdx.x;
#ifndef PHMASK
#define PHMASK 0x1fff
#endif
#ifndef REPMASK
#define REPMASK 0
#endif
#define IN(k) (((PHMASK >> (k)) & 1) && lo <= (k) && (k) < hi)
#define REP(k)
#define SEAM(k) do { if (IN(k) && IN((k) + 1)) { if ((k) == 0) grid.sync(); else xcd_barrier(xbar); } } while (0)
    unsigned char* ws = a.ws;
    REP(0) if (IN(0)) phase_p0(a, lds, tid, wave, lane);
    SEAM(0);
    REP(1) if (IN(1)) {
        p1_meta(a, lds, tid, wave, lane);
        pg8::Gemm g{(const bf16_t*)(ws + WS_XN1), (const bf16_t*)(ws + WS_WINT), T, DIN, 1024}; pg8::StaticOrder S; S.init(T, DIN, G, bx);
        EpiProj E{(bf16_t*)(ws + WS_HYIN), (bf16_t*)(ws + WS_RGX), (bf16_t*)(ws + WS_GG), (bf16_t*)(ws + WS_GA), (bf16_t*)(ws + WS_GB), a.in[I_BGATE]};
        pg8::gemm_phase<EpiProj, pg8::StaticOrder>(lds, g, S, E, nullptr);
    }
    SEAM(1);
    REP(2) if (IN(2)) phase_hy_pre(a, lds, tid);
    SEAM(2);
    REP(3) if (IN(3)) {
#if CONV_NAIVE
        phase_hy_conv_naive(a, lds, tid);
#else
        if (G >= 256) { if (bx >= 128) for (int c = bx - 128; c < DHY; c += G - 128) hy_conv_channel(a, lds, c, tid, wave, lane); }
        else for (int c = bx; c < DHY; c += G) hy_conv_channel(a, lds, c, tid, wave, lane);
#endif
#if RG_NAIVE
        phase_rg_naive(a, lds, tid);
#else
        for (int it = bx; it < NB * 2 * 8; it += G) rg_item(a, lds, it, tid, wave, lane);
#endif
    }
    SEAM(3);
    REP(4) if (IN(4)) phase_post(a, lds, tid);
    SEAM(4);
    REP(5) if (IN(5)) {
        { pg8::Gemm g{(const bf16_t*)(ws + WS_YH), (const bf16_t*)(ws + WS_WHT), T, 1024, 512}; pg8::StaticOrder S; S.init(T, 1024, G, bx);
          EpiGate<0> E{(const bf16_t*)(ws + WS_GA), nullptr, (bf16_t*)(ws + WS_TMP)};
          pg8::gemm_phase<EpiGate<0>, pg8::StaticOrder>(lds, g, S, E, nullptr); }
        { pg8::Gemm g{(const bf16_t*)(ws + WS_YR), (const bf16_t*)(ws + WS_WRT), T, 1024, 1024}; pg8::StaticOrder S; S.init(T, 1024, G, bx);
          EpiGate<1> E{(const bf16_t*)(ws + WS_GB), (const bf16_t*)(ws + WS_TMP), (bf16_t*)(ws + WS_MERGED)};
          pg8::gemm_phase<EpiGate<1>, pg8::StaticOrder>(lds, g, S, E, nullptr); }
    }
    SEAM(5);
    REP(6) if (IN(6)) {
        pg8::Gemm g{(const bf16_t*)(ws + WS_MERGED), (const bf16_t*)(ws + WS_WOT), T, 1024, 1024}; pg8::StaticOrder S; S.init(T, 1024, G, bx);
        EpiResid E{a.in[I_X], (bf16_t*)(ws + WS_H1B), (float*)(ws + WS_ROWSS)};
        pg8::gemm_phase<EpiResid, pg8::StaticOrder>(lds, g, S, E, nullptr);
    }
    SEAM(6);
    REP(7) if (IN(7)) {
        phase_tables(a, wave, lane);
        pg8::Gemm g{(const bf16_t*)(ws + WS_H1B), (const bf16_t*)(ws + WS_WST), T, 2048, 1024}; pg8::StaticOrder S; S.init(T, 2048, G, bx);
        EpiScores E{(const float*)(ws + WS_ROWSS), (_Float16*)(ws + WS_SCORES)};
        pg8::gemm_phase<EpiScores, pg8::StaticOrder>(lds, g, S, E, nullptr);
    }
    SEAM(7);
    REP(8) if (IN(8)) phase_topk(a, lds, wave, lane);
    SEAM(8);
    REP(9) if (IN(9)) phase_peer_u(a, wave, lane);
    SEAM(9);
    if (IN(10)) phase_peer_act(a, tid);
    SEAM(10);
    if (IN(11)) phase_peer_v(a, wave, lane);
    SEAM(11);
    if (IN(12)) phase_final(a, wave, lane);
#undef IN
#undef SEAM
}

extern "C" void kernel_launch(void* const* d_in, const int* in_sizes, int n_in, void* d_out, int out_size, void* d_ws, size_t ws_size, hipStream_t stream) {
    static int grid = 0;
    if (grid == 0) {
        if (n_in != N_IN || out_size != T * DM || ws_size < WS_END) { fprintf(stderr, "kernel_launch: unexpected shapes (n_in %d out %d ws %zu)\n", n_in, out_size, ws_size); grid = -1; return; }
        if (hipFuncSetAttribute((const void*)mega, hipFuncAttributeMaxDynamicSharedMemorySize, LDS_BYTES) != hipSuccess) { fprintf(stderr, "kernel_launch: hipFuncSetAttribute failed\n"); grid = -1; return; }
        int dev = 0, cus = 0, per_cu = 0;
        hipGetDevice(&dev); hipDeviceGetAttribute(&cus, hipDeviceAttributeMultiprocessorCount, dev);
        hipOccupancyMaxActiveBlocksPerMultiprocessor(&per_cu, (const void*)mega, NTHR, LDS_BYTES);
        if (per_cu < 1) { fprintf(stderr, "kernel_launch: occupancy query says %d blocks per CU\n", per_cu); per_cu = 1; }
        (void)hipGetLastError();
        grid = cus;
    }
    if (grid < 0) return;
    Args a{};
    for (int i = 0; i < N_IN; ++i) a.in[i] = (const float*)d_in[i];
    a.out = (float*)d_out; a.ws = (unsigned char*)d_ws;
#if ONE_LAUNCH
    if (hipMemsetAsync((char*)d_ws + WS_BAR, 0, XCD_BAR_WORDS * 4, stream) != hipSuccess) { fprintf(stderr, "kernel_launch: memset of the barrier words failed\n"); return; }
    a.ph_lo = 0; a.ph_hi = NPHASE;
    void* args[] = {&a};
    hipError_t e = hipLaunchCooperativeKernel((const void*)mega, dim3(grid), dim3(NTHR), args, LDS_BYTES, stream);
    if (e != hipSuccess) fprintf(stderr, "cooperative launch failed: %s (grid %d)\n", hipGetErrorString(e), grid);
#else
    for (int ph = 0; ph < NPHASE; ++ph) for (int rep = 0; rep < 1 + ((REPMASK >> ph) & 1); ++rep) { a.ph_lo = ph; a.ph_hi = ph + 1;
        hipLaunchKernelGGL(mega, dim3(grid), dim3(NTHR), LDS_BYTES, stream, a);
        hipError_t e = hipPeekAtLastError(); if (e != hipSuccess) { fprintf(stderr, "launch %d failed: %s\n", ph, hipGetErrorString(e)); break; } }
#endif
}
```

```cpp
#define ONE_LAUNCH 1
#include <hip/hip_runtime.h>
#include <hip/hip_cooperative_groups.h>
#include <cstdio>
#include <cstdint>
#include <cmath>
namespace cg = cooperative_groups;
namespace pg8 {
#define PG8_LAS __attribute__((address_space(3)))
typedef unsigned short bf16_t;
typedef short bf16x8 __attribute__((ext_vector_type(8)));
typedef float f32x4 __attribute__((ext_vector_type(4)));
typedef unsigned u32x4 __attribute__((ext_vector_type(4)));
constexpr int BM = 256, BK = 64, HALF = 128, HTB = HALF * BK * 2  , STAGE_BYTES = 8 * HTB, NXCD = 8, WGM = 8;

__host__ __device__ __forceinline__ int lds_byte(int r, int c) { const int st = (r >> 4) * 2 + (c >> 5), rr = r & 15, cc = c & 31, ob = rr * 64 + cc * 2; return st * 1024 + (ob ^ (((ob >> 9) & 1) << 5)); }
__host__ __device__ __forceinline__ void stage_rc(int b, int& R, int& C) { const int st = b / 1024, sb = b % 1024, swz = sb ^ (((sb >> 9) & 1) << 5); R = (st >> 1) * 16 + swz / 64; C = (st & 1) * 32 + (swz % 64) / 2; }
__host__ __device__ __forceinline__ int perm32(int rho) { const int n = rho >> 4, i = rho & 15; return 8 * (i >> 2) + 4 * n + (i & 3); }

struct Unit { int pm, pn; };
struct Gemm { const bf16_t* A; const bf16_t* Bt; int M, N, K; };

struct StaticOrder {
    int nM, nN, nwg, G, c;
    __host__ __device__ void init(int M, int N, int G_, int c_) { nM = M / BM; nN = N / BM; nwg = nM * nN; G = G_; c = c_; }
    __host__ __device__ bool next(int i, Unit& u) const {
        const long L = (long)i * G + c; if (L >= nwg) return false;
        int wgid = (int)L; { const int q = nwg / NXCD, r = nwg % NXCD, xcd = wgid % NXCD, off = wgid / NXCD; wgid = (xcd < r ? xcd * (q + 1) : r * (q + 1) + (xcd - r) * q) + off; }
        const int nig = WGM * nN, gid = wgid / nig, fm = gid * WGM, gsz = (nM - fm) < WGM ? (nM - fm) : WGM;
        u.pm = fm + ((wgid % nig) % gsz); u.pn = (wgid % nig) / gsz; return true;
    }
    __device__ __forceinline__ void a_ready(const Unit&) const {}
    __device__ __forceinline__ void done(const Unit&) const {}
};
__device__ __forceinline__ unsigned cvt_pk_bf16(float lo, float hi) { unsigned r; asm volatile("v_cvt_pk_bf16_f32 %0, %1, %2" : "=v"(r) : "v"(lo), "v"(hi)); return r; }
typedef float f32x2 __attribute__((ext_vector_type(2)));
__device__ __forceinline__ f32x2 gelu_pk(f32x2 v) {
    const f32x2 av = __builtin_elementwise_abs(v), d = av * 0.2316418882f + 1.0f;
    f32x2 t; t.x = __builtin_amdgcn_rcpf(d.x); t.y = __builtin_amdgcn_rcpf(d.y);
    f32x2 q = t * 0.5307027145f + (-0.7265760135f); q = q * t + 0.7107068705f; q = q * t + (-0.142248368f); q = q * t + 0.127414796f; q = q * t;
    const f32x2 s = (v * v) * (-0.72134752044f);
    f32x2 e; e.x = __builtin_amdgcn_exp2f(s.x); e.y = __builtin_amdgcn_exp2f(s.y);
    const f32x2 m = v * (q * e), r = v - m;
    f32x2 o; o.x = v.x < 0.f ? m.x : r.x; o.y = v.y < 0.f ? m.y : r.y; return o;
}
template <class Epi, class Sched, bool STAMP = false>
__device__ __forceinline__ void gemm_phase(PG8_LAS unsigned char* lds, const Gemm g, const Sched& S, const Epi& E, unsigned long long* stamps) {
    const int tid = threadIdx.x, wid = __builtin_amdgcn_readfirstlane(tid >> 6), lane = tid & 63, wr = wid >> 2, wc = wid & 3, fr = lane & 15, fq = lane >> 4;
    const int K = g.K, nt = K / BK;
    int ts_lo = 0, ts_hi = 0, nts = 0; const unsigned long long rt_entry = STAMP ? (unsigned long long)wall_clock64() : 0ull;
#define PG8_STAMP() do { if (STAMP && wid == 0 && nts < 64) { const unsigned long long _c = (unsigned long long)clock64(); \
        ts_lo = (lane == nts) ? (int)(unsigned)_c : ts_lo; ts_hi = (lane == nts) ? (int)(unsigned)(_c >> 32) : ts_hi; ++nts; } } while (0)
    PG8_STAMP();
    unsigned voffA[2], voffB[2];
#pragma unroll
    for (int i = 0; i < 2; ++i) { int R, C; stage_rc(tid * 16 + i * 8192, R, C); const int Rb = Epi::PERM ? ((R & ~31) + perm32(R & 31)) : R;
        voffA[i] = (unsigned)(R * K + C) * 2u; voffB[i] = (unsigned)(Rb * K + C) * 2u; }
    const size_t kstep = (size_t)(BK * 2);
    const size_t hstep = (size_t)HALF * K * 2;
    const size_t tstep = 2 * hstep;
    const unsigned ldsw = (unsigned)wid * 1024u;
    const int aoff = lds_byte(wr * 64 + fr, fq * 8), boff = lds_byte(wc * 32 + fr, fq * 8);
#define PG8_SA(b, h) (((b) * 2 + (h)) * HTB)
#define PG8_SB(b, h) ((4 + (b) * 2 + (h)) * HTB)
#define PG8_STAGE(bufoff, gbase, voff) do { _Pragma("unroll") for (int _i = 0; _i < 2; ++_i) \
        __builtin_amdgcn_global_load_lds((const unsigned*)((const char*)(gbase) + (voff)[_i]), (PG8_LAS unsigned*)(lds + (bufoff) + ldsw + _i * 8192), 16, 0, 0); } while (0)
#define PG8_LDA(dst, b, h) do { _Pragma("unroll") for (int m = 0; m < 4; ++m) _Pragma("unroll") for (int k = 0; k < 2; ++k) dst[m][k] = *(const PG8_LAS bf16x8*)(lds + PG8_SA(b, h) + aoff + m * 2048 + k * 1024); } while (0)
#define PG8_LDB(dst, b, h) do { _Pragma("unroll") for (int n = 0; n < 2; ++n) _Pragma("unroll") for (int k = 0; k < 2; ++k) dst[n][k] = *(const PG8_LAS bf16x8*)(lds + PG8_SB(b, h) + boff + n * 2048 + k * 1024); } while (0)
#define PG8_MMA(ai, bj, At, Bt) do { __builtin_amdgcn_s_setprio(1); _Pragma("unroll") for (int m = 0; m < 4; ++m) _Pragma("unroll") for (int n = 0; n < 2; ++n) _Pragma("unroll") for (int k = 0; k < 2; ++k) \
        acc[ai][bj][m][n] = __builtin_amdgcn_mfma_f32_16x16x32_bf16(Bt[n][k], At[m][k], acc[ai][bj][m][n], 0, 0, 0); __builtin_amdgcn_s_setprio(0); } while (0)
#define PG8_WAIT_V(n) asm volatile("s_waitcnt vmcnt(" #n ")" ::: "memory")
#define PG8_WAIT_L(n) asm volatile("s_waitcnt lgkmcnt(" #n ")" ::: "memory")
#define PG8_BAR __builtin_amdgcn_s_barrier()
#define PG8_SCHED __builtin_amdgcn_sched_barrier(0)
    Unit cur, nxt; int ui = 0;
    if (!S.next(0, cur)) return;
    f32x4 acc[2][2][4][2];
#pragma unroll
    for (int a = 0; a < 2; ++a)
#pragma unroll
        for (int b = 0; b < 2; ++b)
#pragma unroll
            for (int m = 0; m < 4; ++m)
#pragma unroll
                for (int n = 0; n < 2; ++n) acc[a][b][m][n] = (f32x4){0.f, 0.f, 0.f, 0.f};
    bf16x8 At[4][2], B0[2][2], B1[2][2];
    const char* cA = (const char*)g.A + (size_t)cur.pm * tstep; const char* cB = (const char*)g.Bt + (size_t)cur.pn * tstep;
    S.a_ready(cur);
    PG8_STAGE(PG8_SB(0, 0), cB, voffB); PG8_STAGE(PG8_SA(0, 0), cA, voffA); PG8_STAGE(PG8_SB(0, 1), cB + hstep, voffB); PG8_STAGE(PG8_SA(0, 1), cA + hstep, voffA);
    if (wr == 1) PG8_BAR;
    PG8_WAIT_V(4); PG8_BAR;
    PG8_STAGE(PG8_SB(1, 0), cB + kstep, voffB); PG8_STAGE(PG8_SA(1, 0), cA + kstep, voffA); PG8_STAGE(PG8_SB(1, 1), cB + hstep + kstep, voffB);
    PG8_WAIT_V(6); PG8_BAR;
    PG8_STAMP();
    for (;;) {
        const bool has_next = S.next(ui + 1, nxt);
        const char* nA = has_next ? (const char*)g.A + (size_t)nxt.pm * tstep : cA; const char* nB = has_next ? (const char*)g.Bt + (size_t)nxt.pn * tstep : cB;
        for (int t = 0; t < nt; t += 2) {
            const bool last = (t == nt - 2);
            const char* a1 = cA + (size_t)(t + 1) * kstep;
            const char* a2 = last ? nA : cA + (size_t)(t + 2) * kstep; const char* b2 = last ? nB : cB + (size_t)(t + 2) * kstep;
            const char* a3 = a2 + kstep; const char* b3 = b2 + kstep;
            if (last && has_next) S.a_ready(nxt);
            PG8_LDB(B0, 0, 0); PG8_SCHED; PG8_LDA(At, 0, 0); PG8_STAGE(PG8_SA(1, 1), a1 + hstep, voffA);
            PG8_WAIT_L(8); PG8_BAR; PG8_WAIT_L(0); PG8_MMA(0, 0, At, B0); PG8_BAR; PG8_SCHED;
            PG8_LDB(B1, 0, 1); PG8_STAGE(PG8_SB(0, 0), b2, voffB);
            PG8_BAR; PG8_WAIT_L(0); PG8_MMA(0, 1, At, B1); PG8_BAR;
            PG8_LDA(At, 0, 1); PG8_STAGE(PG8_SA(0, 0), a2, voffA);
            PG8_BAR; PG8_WAIT_L(0); PG8_MMA(1, 0, At, B0); PG8_BAR; PG8_SCHED;
            PG8_STAGE(PG8_SB(0, 1), b2 + hstep, voffB);
            PG8_WAIT_V(6); PG8_BAR; PG8_MMA(1, 1, At, B1); PG8_BAR;
            PG8_LDB(B0, 1, 0); PG8_SCHED; PG8_LDA(At, 1, 0); PG8_STAGE(PG8_SA(0, 1), a2 + hstep, voffA);
            PG8_WAIT_L(8); PG8_BAR; PG8_WAIT_L(0); PG8_MMA(0, 0, At, B0); PG8_BAR; PG8_SCHED;
            PG8_LDB(B1, 1, 1); PG8_STAGE(PG8_SB(1, 0), b3, voffB);
            PG8_BAR; PG8_WAIT_L(0); PG8_MMA(0, 1, At, B1); PG8_BAR;
            PG8_LDA(At, 1, 1); PG8_STAGE(PG8_SA(1, 0), a3, voffA);
            PG8_BAR; PG8_WAIT_L(0); PG8_MMA(1, 0, At, B0); PG8_BAR; PG8_SCHED;
            PG8_STAGE(PG8_SB(1, 1), b3 + hstep, voffB);
            PG8_WAIT_V(6); PG8_BAR; PG8_MMA(1, 1, At, B1); PG8_BAR;
        }
        PG8_STAMP();
        if constexpr (!Epi::AFTER_DRAIN) { E(acc, cur, wr, wc, fr, fq); S.done(cur); }
        PG8_STAMP();
        if (!has_next) break;
#pragma unroll
        for (int a = 0; a < 2; ++a)
#pragma unroll
            for (int b = 0; b < 2; ++b)
#pragma unroll
                for (int m = 0; m < 4; ++m)
#pragma unroll
                    for (int n = 0; n < 2; ++n) acc[a][b][m][n] = (f32x4){0.f, 0.f, 0.f, 0.f};
        cur = nxt; cA = nA; cB = nB; ++ui;
    }
    PG8_WAIT_V(0);
    if (wr == 0) PG8_BAR;
    PG8_BAR;
    if constexpr (Epi::AFTER_DRAIN) { E.fused(acc, cur, wr, wc, fr, fq, lds, wid, lane); S.done(cur); }
    PG8_STAMP();
    if (STAMP && wid == 0) { stamps[lane] = lane < nts ? (((unsigned long long)(unsigned)ts_hi << 32) | (unsigned)ts_lo) : 0ull;
        if (lane == 62) stamps[62] = rt_entry; if (lane == 63) stamps[63] = (unsigned long long)wall_clock64(); }
#undef PG8_STAMP
#undef PG8_SA
#undef PG8_SB
#undef PG8_STAGE
#undef PG8_LDA
#undef PG8_LDB
#undef PG8_MMA
#undef PG8_WAIT_V
#undef PG8_WAIT_L
#undef PG8_BAR
#undef PG8_SCHED
}
}

#define LAS __attribute__((address_space(3)))
typedef unsigned short bf16_t;
typedef float f32x4 __attribute__((ext_vector_type(4)));
typedef float f32x2 __attribute__((ext_vector_type(2)));
typedef unsigned u32x4 __attribute__((ext_vector_type(4)));
typedef unsigned u32x2 __attribute__((ext_vector_type(2)));

constexpr int NB = 8, SEQ = 4096, NMETA = 16, LT = SEQ + NMETA, DM = 1024, T = NB * SEQ;
constexpr int DHY = 512, DRG = 1024, DIN = 3 * DHY + 2 * DRG + 2 * DM;
constexpr int NTHR = 512, NWAVES = 8;
constexpr int LDS_BYTES = 160 * 1024;
constexpr float EPSF = 1e-6f;
constexpr int KFW = 2 * LT;
constexpr int SP = 4256;
constexpr int NEXP = 16384;

enum { I_X = 0, I_META, I_GFINAL, I_GMIX, I_WIN, I_BGATE, I_HYCW, I_HYCB, I_HYW1, I_HYB1, I_HYW2, I_HYB2, I_HYW3, I_HYB3, I_HYFREQ, I_HYSKIP,
       I_HYOUT, I_RGCW, I_RGCB, I_RGGW, I_RGGB, I_RGLAM, I_RGOUT, I_WOUT, I_GFFN, I_WQ, I_KEYS, I_PU, I_PV, N_IN };

constexpr size_t MiB = 1024ull * 1024ull;
constexpr size_t WS_ROWSS = 64 * 1024;
constexpr size_t WS_SU = 256 * 1024;
constexpr size_t WS_SV = 320 * 1024;
constexpr size_t WS_ROWSS2 = 384 * 1024;
constexpr size_t WS_BAR = 512 * 1024;
constexpr size_t WS_WINT = 1 * MiB;
constexpr size_t WS_WHT = 12 * MiB;
constexpr size_t WS_WRT = 13 * MiB;
constexpr size_t WS_WOT = 15 * MiB;
constexpr size_t WS_WST = 17 * MiB;
constexpr size_t WS_GWT = 21 * MiB;
constexpr size_t WS_KF = 22 * MiB;
constexpr size_t WS_KFB = 39 * MiB;
constexpr size_t WS_HYIN = 48 * MiB;
constexpr size_t WS_RGX = 145 * MiB;
constexpr size_t WS_GG = 210 * MiB;
constexpr size_t WS_GA = 274 * MiB;
constexpr size_t WS_GB = 338 * MiB;
constexpr size_t WS_XN1 = 402 * MiB;
constexpr size_t WS_UUT = 402 * MiB;
constexpr size_t WS_CONVT = 436 * MiB;
constexpr size_t WS_YH = 468 * MiB;
constexpr size_t WS_YR = WS_RGX;
constexpr size_t WS_MERGED = WS_HYIN;
constexpr size_t WS_TMP = WS_GG;
constexpr size_t WS_H1B = WS_RGX;
constexpr size_t WS_SCORES = WS_GG;
constexpr size_t WS_EIDX = 468 * MiB;
constexpr size_t WS_EG = 484 * MiB;
constexpr size_t WS_UB = 48 * MiB;
constexpr size_t WS_VB = 64 * MiB;
constexpr size_t WS_PD = 210 * MiB;
constexpr size_t WS_PO = WS_PD;
constexpr size_t WS_ACT = 338 * MiB;
constexpr size_t WS_END = 500 * MiB;

struct Args { const float* in[N_IN]; float* out; unsigned char* ws; int ph_lo, ph_hi; };

__device__ __forceinline__ float bf2f(unsigned v) { return __uint_as_float(v << 16); }
__device__ __forceinline__ unsigned f2bf(float f) { unsigned u = __float_as_uint(f); return (u + 0x7fffu + ((u >> 16) & 1u)) >> 16; }
__device__ __forceinline__ unsigned pk2(float lo, float hi) { return f2bf(lo) | (f2bf(hi) << 16); }
__device__ __forceinline__ float bflo(unsigned w) { return __uint_as_float(w << 16); }
__device__ __forceinline__ float bfhi(unsigned w) { return __uint_as_float(w & 0xffff0000u); }
__device__ __forceinline__ float wave_sum(float v) {
#pragma unroll
    for (int o = 1; o < 64; o <<= 1) v += __shfl_xor(v, o);
    return v;
}
__device__ __forceinline__ float wave_max(float v) {
#pragma unroll
    for (int o = 1; o < 64; o <<= 1) v = fmaxf(v, __shfl_xor(v, o));
    return v;
}
__device__ __forceinline__ float fexp(float x) { return __builtin_amdgcn_exp2f(x * 1.4426950408889634f); }
__device__ __forceinline__ float sigmoidf_(float x) { return __builtin_amdgcn_rcpf(1.0f + fexp(-x)); }
__device__ __forceinline__ float gelu_tanh(float x) { const float u = 1.5957691216f * (x + 0.044715f * x * x * x); return x * __builtin_amdgcn_rcpf(1.0f + fexp(-u)); }
__device__ __forceinline__ void sincos_acc(float a, float& s, float& c) {
    const double x = (double)a;
    const double q = rint(x * 0.63661977236758134308);
    const double r = fma(-q, 1.57079632679489661923, x);
    const int n = (int)q;
    const float rf = (float)r, r2 = rf * rf;
    const float sp = rf * (1.f + r2 * (-1.6666667e-1f + r2 * (8.3333333e-3f + r2 * (-1.9841270e-4f + r2 * 2.7557319e-6f))));
    const float cp = 1.f + r2 * (-0.5f + r2 * (4.1666667e-2f + r2 * (-1.3888889e-3f + r2 * (2.4801587e-5f + r2 * (-2.7557319e-7f)))));
    const int k = n & 3;
    s = (k == 0) ? sp : (k == 1) ? cp : (k == 2) ? -sp : -cp;
    c = (k == 0) ? cp : (k == 1) ? -sp : (k == 2) ? -cp : sp;
}

typedef float f32x2v __attribute__((ext_vector_type(2)));
__device__ __forceinline__ float wave_sum_dpp(float v) {
    v += __int_as_float(__builtin_amdgcn_update_dpp(0, __float_as_int(v), 0xB1, 0xF, 0xF, true));
    v += __int_as_float(__builtin_amdgcn_update_dpp(0, __float_as_int(v), 0x4E, 0xF, 0xF, true));
    v += __int_as_float(__builtin_amdgcn_update_dpp(0, __float_as_int(v), 0x141, 0xF, 0xF, true));
    v += __int_as_float(__builtin_amdgcn_update_dpp(0, __float_as_int(v), 0x140, 0xF, 0xF, true));
    const int vi = __float_as_int(v);
    return (__int_as_float(__builtin_amdgcn_readlane(vi, 0)) + __int_as_float(__builtin_amdgcn_readlane(vi, 16))) + (__int_as_float(__builtin_amdgcn_readlane(vi, 32)) + __int_as_float(__builtin_amdgcn_readlane(vi, 48)));
}
__device__ __forceinline__ float wave_max_dpp(float v) {
    v = fmaxf(v, __int_as_float(__builtin_amdgcn_update_dpp(0, __float_as_int(v), 0xB1, 0xF, 0xF, true)));
    v = fmaxf(v, __int_as_float(__builtin_amdgcn_update_dpp(0, __float_as_int(v), 0x4E, 0xF, 0xF, true)));
    v = fmaxf(v, __int_as_float(__builtin_amdgcn_update_dpp(0, __float_as_int(v), 0x141, 0xF, 0xF, true)));
    v = fmaxf(v, __int_as_float(__builtin_amdgcn_update_dpp(0, __float_as_int(v), 0x140, 0xF, 0xF, true)));
    const int vi = __float_as_int(v);
    return fmaxf(fmaxf(__int_as_float(__builtin_amdgcn_readlane(vi, 0)), __int_as_float(__builtin_amdgcn_readlane(vi, 16))), fmaxf(__int_as_float(__builtin_amdgcn_readlane(vi, 32)), __int_as_float(__builtin_amdgcn_readlane(vi, 48))));
}

#ifndef SLICE_PROBE
#define SLICE_OF(b) ((b) & 7)
#define RANK_OF(b) ((b) >> 3)
#else
#define SLICE_OF(b) ((b) >> 5)
#define RANK_OF(b) ((b) & 31)
#endif
#define XB_TMO      128
#define XB_XCNT(j)  (256  + 64 * (j))
#define XB_XSUB(j)  (1280 + 64 * (j))
#define XB_XGEN(j)  (2304 + 64 * (j))
#define XB_TOP      3328
#define XB_TOPGEN   3392
#define XCD_BAR_WORDS 3456
#define XB_SPIN_CAP (1u << 18)

__device__ __forceinline__ unsigned xb_ld(unsigned* p)              { return __hip_atomic_load(p, __ATOMIC_RELAXED, __HIP_MEMORY_SCOPE_AGENT); }
__device__ __forceinline__ unsigned xb_add(unsigned* p, unsigned v) { return __hip_atomic_fetch_add(p, v, __ATOMIC_RELAXED, __HIP_MEMORY_SCOPE_AGENT); }
__device__ __forceinline__ unsigned xb_xcc_id() { return (unsigned)__builtin_amdgcn_s_getreg((3 << 11) | 20) & 0xFu; }
#define XB_SPIN(cond, bar) do { unsigned _sp = 0; while (cond) { __builtin_amdgcn_s_sleep(1); \
    if ((++_sp & 255u) == 0u) { if (xb_ld(&(bar)[XB_TMO])) break; if (_sp > XB_SPIN_CAP) { atomicAdd(&(bar)[XB_TMO], 1u); break; } } } } while (0)

struct XcdBarrier {
    unsigned* bar; unsigned x;
    volatile LAS unsigned* st;
};

__device__ __forceinline__ XcdBarrier xcd_barrier_post(unsigned* bar, volatile LAS unsigned* st) {
    XcdBarrier b; b.bar = bar; b.x = xb_xcc_id(); b.st = st;
    if (threadIdx.x == 0) (void)xb_add(&bar[XB_XCNT(b.x)], 1u);
    return b;
}
__device__ __forceinline__ void xcd_barrier_complete(unsigned* bar, unsigned x, unsigned& nloc, unsigned& nx) {
    const unsigned G = gridDim.x * gridDim.y * gridDim.z;
    unsigned sum, cnt, mine, sp = 0u;
    for (;;) {
        sum = 0u; cnt = 0u; mine = 0u;
#pragma unroll
        for (unsigned j = 0; j < 16; ++j) { const unsigned c = xb_ld(&bar[XB_XCNT(j)]); sum += c; cnt += (c > 0u) ? 1u : 0u; mine = (j == x) ? c : mine; }
        if (sum == G) break;
        __builtin_amdgcn_s_sleep(1);
        if ((++sp & 255u) == 0u) { if (xb_ld(&bar[XB_TMO])) break; if (sp > XB_SPIN_CAP) { atomicAdd(&bar[XB_TMO], 1u); break; } }
    }
    nloc = mine > 0u ? mine : 1u; nx = cnt > 0u ? cnt : 1u;
}

__device__ __forceinline__ void xcd_barrier(const XcdBarrier& b) {
    asm volatile("s_waitcnt vmcnt(0)" ::: "memory");
    __syncthreads();
    if (threadIdx.x == 0) {
        unsigned* bar = b.bar;
        __builtin_amdgcn_s_waitcnt(0);
        unsigned nloc = b.st[0], nx = b.st[1];
        if (nloc == 0u) { xcd_barrier_complete(bar, b.x, nloc, nx); b.st[0] = nloc; b.st[1] = nx; }
        const unsigned old = xb_add(&bar[XB_XSUB(b.x)], 1u);
        const unsigned gen = old / nloc;
        if (old + 1u == (gen + 1u) * nloc) {
            __builtin_amdgcn_fence(__ATOMIC_RELEASE, "agent");
            asm volatile("s_waitcnt vmcnt(0)" ::: "memory");
            const unsigned og = xb_add(&bar[XB_TOP], 1u);
            const unsigned tg = og / nx;
            if (og + 1u == (tg + 1u) * nx) xb_add(&bar[XB_TOPGEN], 1u);
            else XB_SPIN(xb_ld(&bar[XB_TOPGEN]) == tg, bar);
            __builtin_amdgcn_fence(__ATOMIC_ACQUIRE, "agent");
            xb_add(&bar[XB_XGEN(b.x)], 1u);
            asm volatile("s_waitcnt vmcnt(0)" ::: "memory");
        } else {
            XB_SPIN(xb_ld(&bar[XB_XGEN(b.x)]) == gen, bar);
            __builtin_amdgcn_fence(__ATOMIC_ACQUIRE, "agent");
            asm volatile("s_waitcnt vmcnt(0)" ::: "memory");
        }
    }
    __syncthreads();
}

__device__ __forceinline__ void p0_transpose_item(const float* W, int K, int N, bf16_t* WT, LAS float* scr, int item, int lane) {
    const int nblk = N / 32, kb = item / nblk, nb = item % nblk, k0 = 64 * kb, n0 = 32 * nb;
#pragma unroll 8
    for (int i = 0; i < 32; ++i) { const int kk = 2 * i + (lane >> 5); scr[kk * 33 + (lane & 31)] = W[(size_t)(k0 + kk) * N + n0 + (lane & 31)]; }
    asm volatile("s_waitcnt lgkmcnt(0)" ::: "memory");
    const int c = lane & 7;
#pragma unroll
    for (int j = 0; j < 4; ++j) { const int n = (lane >> 3) + 8 * j; const LAS float* s = scr + (8 * c) * 33 + n;
        u32x4 o; o.x = pk2(s[0 * 33], s[1 * 33]); o.y = pk2(s[2 * 33], s[3 * 33]); o.z = pk2(s[4 * 33], s[5 * 33]); o.w = pk2(s[6 * 33], s[7 * 33]);
        *(u32x4*)(WT + (size_t)(n0 + n) * K + k0 + 8 * c) = o; }
    asm volatile("s_waitcnt lgkmcnt(0)" ::: "memory");
}
__device__ __forceinline__ void p0_xn1_row(const float* xrow, const float* g, bf16_t* orow, int lane) {
    const f32x4* xr = (const f32x4*)xrow + lane; const f32x4* gr = (const f32x4*)g + lane;
    f32x4 v[4]; float s = 0.f;
#pragma unroll
    for (int j = 0; j < 4; ++j) { v[j] = xr[64 * j]; s += (v[j].x * v[j].x + v[j].y * v[j].y) + (v[j].z * v[j].z + v[j].w * v[j].w); }
    const float rstd = rsqrtf(wave_sum(s) * (1.f / DM) + EPSF);
    unsigned long long* o8 = (unsigned long long*)orow + lane;
#pragma unroll
    for (int j = 0; j < 4; ++j) { const f32x4 gv = gr[64 * j];
        o8[64 * j] = (unsigned long long)pk2(v[j].x * rstd * gv.x, v[j].y * rstd * gv.y) | ((unsigned long long)pk2(v[j].z * rstd * gv.z, v[j].w * rstd * gv.w) << 32); }
}
__device__ __forceinline__ void p0_fold_item(const Args& a, LAS unsigned char* lds, int item, int tid) {
    const int hp = item >> 4, k0 = (item & 15) * 64;
    LAS float* kl = (LAS float*)lds;
    LAS float* wl = (LAS float*)(lds + 128 * 129 * 4);
    const float* keys = a.in[I_KEYS] + (size_t)hp * 128 * 128; const float* wq = a.in[I_WQ];
    for (int i = tid; i < 128 * 128; i += NTHR) { const int key = i >> 7, d = i & 127; kl[key * 129 + d] = keys[i]; }
    for (int i = tid; i < 64 * 128; i += NTHR) { const int kk = i >> 7, d = i & 127; wl[i] = wq[(size_t)(k0 + kk) * 2048 + hp * 128 + d]; }
    __syncthreads();
    const int key = tid & 127, kq = tid >> 7;
    float acc[16];
#pragma unroll
    for (int i = 0; i < 16; ++i) acc[i] = 0.f;
#pragma unroll 2
    for (int d = 0; d < 128; ++d) { const float kv = kl[key * 129 + d];
#pragma unroll
        for (int i = 0; i < 16; ++i) acc[i] += wl[(kq * 16 + i) * 128 + d] * kv; }
    const float* gf = a.in[I_GFFN] + k0 + kq * 16;
    bf16_t* dst = (bf16_t*)(a.ws + WS_WST) + (size_t)(hp * 128 + key) * 1024 + k0 + kq * 16;
    u32x4 o0, o1;
    o0.x = pk2(acc[0] * gf[0], acc[1] * gf[1]); o0.y = pk2(acc[2] * gf[2], acc[3] * gf[3]); o0.z = pk2(acc[4] * gf[4], acc[5] * gf[5]); o0.w = pk2(acc[6] * gf[6], acc[7] * gf[7]);
    o1.x = pk2(acc[8] * gf[8], acc[9] * gf[9]); o1.y = pk2(acc[10] * gf[10], acc[11] * gf[11]); o1.z = pk2(acc[12] * gf[12], acc[13] * gf[13]); o1.w = pk2(acc[14] * gf[14], acc[15] * gf[15]);
    *(u32x4*)dst = o0; *(u32x4*)(dst + 8) = o1;
    __syncthreads();
}
__device__ __forceinline__ void p0_meta_item(const Args& a, LAS unsigned char* lds, int item, int tid, int wave, int lane) {
    LAS float* mt = (LAS float*)lds;
    for (int r = wave * 2; r < wave * 2 + 2; ++r) {
        const f32x4* xr = (const f32x4*)(a.in[I_META] + (size_t)r * DM) + lane; const f32x4* gr = (const f32x4*)a.in[I_GMIX] + lane;
        f32x4 v[4]; float s = 0.f;
#pragma unroll
        for (int j = 0; j < 4; ++j) { v[j] = xr[64 * j]; s += (v[j].x * v[j].x + v[j].y * v[j].y) + (v[j].z * v[j].z + v[j].w * v[j].w); }
        const float rstd = rsqrtf(wave_sum(s) * (1.f / DM) + EPSF);
#pragma unroll
        for (int j = 0; j < 4; ++j) { const f32x4 gv = gr[64 * j]; f32x4 o = v[j] * rstd * gv; *(LAS f32x4*)(mt + r * 1024 + 4 * (lane + 64 * j)) = o; }
    }
    __syncthreads();
    const int col = item * 256 + (tid & 255), rh = tid >> 8;
    float acc[8];
#pragma unroll
    for (int r = 0; r < 8; ++r) acc[r] = 0.f;
    const float* w = a.in[I_WIN] + col;
#pragma unroll 4
    for (int k = 0; k < 1024; ++k) { const float wv = w[(size_t)k * DIN];
#pragma unroll
        for (int r = 0; r < 8; ++r) acc[r] += mt[(rh * 8 + r) * 1024 + k] * wv; }
    bf16_t* hyin = (bf16_t*)(a.ws + WS_HYIN); bf16_t* rgx = (bf16_t*)(a.ws + WS_RGX);
#pragma unroll
    for (int r = 0; r < 8; ++r) { const int t = rh * 8 + r; const bf16_t v = (bf16_t)f2bf(acc[r]);
        for (int b = 0; b < NB; ++b) { if (col < 1536) hyin[((size_t)b * LT + t) * 1536 + col] = v; else rgx[((size_t)b * LT + t) * 1024 + (col - 1536)] = v; } }
    __syncthreads();
}
__device__ __forceinline__ void p0_filter_item(const Args& a, LAS unsigned char* lds, int item, int tid) {
    LAS float* z = (LAS float*)lds;
    LAS float* h1 = z + 16 * 33;
    LAS float* h2 = h1 + 16 * 64;
    LAS float* ko = h2 + 16 * 64;
    const int p0 = item * 16;
    for (int idx = tid; idx < 16 * 33; idx += NTHR) { const int pp = idx / 33, f = idx % 33, p = p0 + pp;
        float v;
        if (f == 0) v = (float)p * (1.0f / (float)(LT - 1));
        else { const int bi = (f - 1) & 15; const float band = 1e-4f + (float)bi * ((15.0f - 1e-4f) / 15.0f); const float w = (float)(6.283185307179586 / (double)LT) * (float)p;
            float s, c; sincos_acc(band * w, s, c); v = (f <= 16) ? c : -s; }
        z[idx] = v; }
    __syncthreads();
    const float* w1 = a.in[I_HYW1]; const float* b1 = a.in[I_HYB1]; const float* w2 = a.in[I_HYW2]; const float* b2 = a.in[I_HYB2];
    const float* w3 = a.in[I_HYW3]; const float* b3 = a.in[I_HYB3]; const float* fr = a.in[I_HYFREQ];
    for (int idx = tid; idx < 16 * 64; idx += NTHR) { const int pp = idx >> 6, j = idx & 63; float acc = b1[j];
#pragma unroll 3
        for (int f = 0; f < 33; ++f) acc += z[pp * 33 + f] * w1[f * 64 + j];
        float s, c; sincos_acc(fr[j] * acc, s, c); h1[idx] = s; }
    __syncthreads();
    for (int idx = tid; idx < 16 * 64; idx += NTHR) { const int pp = idx >> 6, j = idx & 63; float acc = b2[j];
#pragma unroll 4
        for (int f = 0; f < 64; ++f) acc += h1[pp * 64 + f] * w2[f * 64 + j];
        float s, c; sincos_acc(fr[64 + j] * acc, s, c); h2[idx] = s; }
    __syncthreads();
#pragma unroll 1
    for (int half = 0; half < 2; ++half) { const int o = half * 512 + tid;
        float acc[16];
#pragma unroll
        for (int pp = 0; pp < 16; ++pp) acc[pp] = b3[o];
#pragma unroll 2
        for (int i = 0; i < 64; ++i) { const float wv = w3[i * 1024 + o];
#pragma unroll
            for (int pp = 0; pp < 16; ++pp) acc[pp] += h2[pp * 64 + i] * wv; }
        const float delta = fabsf(-15.350567286626972f + (float)tid * ((-3.0701134573253945f + 15.350567286626972f) / 511.0f));
#pragma unroll
        for (int pp = 0; pp < 16; ++pp) { const float tn = (float)(p0 + pp) * (1.0f / (float)(LT - 1)); ko[o * 17 + pp] = acc[pp] * __expf(-tn * delta); }
    }
    __syncthreads();
    float* kf = (float*)(a.ws + WS_KF); bf16_t* kfb = (bf16_t*)(a.ws + WS_KFB);
    for (int idx = tid; idx < 1024 * 16; idx += NTHR) { const int o = idx >> 4, pp = idx & 15, dir = o >> 9, c = o & 511, p = p0 + pp;
        const float v = ko[o * 17 + pp];
        if (dir == 0) { kf[(size_t)c * KFW + (LT - 1) + p] = v; kfb[(size_t)c * KFW + (LT - 1) + p] = (bf16_t)f2bf(v); }
        else if (p >= 1) { kf[(size_t)c * KFW + (LT - 1) - p] = v; kfb[(size_t)c * KFW + (LT - 1) - p] = (bf16_t)f2bf(v); } }
    if (item == 0) for (int c = tid; c < 512; c += NTHR) { kf[(size_t)c * KFW + KFW - 1] = 0.f; kfb[(size_t)c * KFW + KFW - 1] = 0; }
    __syncthreads();
}
__device__ __forceinline__ void phase_p0(const Args& a, LAS unsigned char* lds, int tid, int wave, int lane) {
    const int G = gridDim.x, bx = blockIdx.x;
    { float* rs = (float*)(a.ws + WS_ROWSS); float* rs2 = (float*)(a.ws + WS_ROWSS2); for (int i = bx * NTHR + tid; i < T; i += G * NTHR) { rs[i] = 0.f; rs2[i] = 0.f; } }
    for (int it = bx; it < 256 + 257; it += G) {
#ifndef P0M
#define P0M 7
#endif
        if (it < 256) { if (P0M & 1) p0_fold_item(a, lds, it, tid); }
        else { if (P0M & 2) p0_filter_item(a, lds, it - 256, tid); }

    }
    LAS float* scr = (LAS float*)(lds + wave * 16384);
    const int gw = bx * NWAVES + wave, NGW = G * NWAVES;
    constexpr int I_IN = (1024 / 64) * (DIN / 32), I_H = (512 / 64) * (1024 / 32), I_R = (1024 / 64) * (1024 / 32), I_O = I_R;
    for (int it = gw; it < I_IN + I_H + I_R + I_O; it += NGW) {
        int r = it;
        if (r < I_IN) { p0_transpose_item(a.in[I_WIN], 1024, DIN, (bf16_t*)(a.ws + WS_WINT), scr, r, lane); continue; } r -= I_IN;
        if (r < I_H) { p0_transpose_item(a.in[I_HYOUT], 512, 1024, (bf16_t*)(a.ws + WS_WHT), scr, r, lane); continue; } r -= I_H;
        if (r < I_R) { p0_transpose_item(a.in[I_RGOUT], 1024, 1024, (bf16_t*)(a.ws + WS_WRT), scr, r, lane); continue; } r -= I_R;
        p0_transpose_item(a.in[I_WOUT], 1024, 1024, (bf16_t*)(a.ws + WS_WOT), scr, r, lane);
    }
    for (int m = gw; m < T; m += 2 * NGW) { p0_xn1_row(a.in[I_X] + (size_t)m * DM, a.in[I_GMIX], (bf16_t*)(a.ws + WS_XN1) + (size_t)m * DM, lane);
        if (m + NGW < T) p0_xn1_row(a.in[I_X] + (size_t)(m + NGW) * DM, a.in[I_GMIX], (bf16_t*)(a.ws + WS_XN1) + (size_t)(m + NGW) * DM, lane); }
}

__device__ __forceinline__ void p1_meta(const Args& a, LAS unsigned char* lds, int tid, int wave, int lane) {
    LAS float* mt = (LAS float*)lds;
    for (int r = wave * 2; r < wave * 2 + 2; ++r) {
        const f32x4* xr = (const f32x4*)(a.in[I_META] + (size_t)r * DM) + lane; const f32x4* gr = (const f32x4*)a.in[I_GMIX] + lane;
        f32x4 v[4]; float s = 0.f;
#pragma unroll
        for (int j = 0; j < 4; ++j) { v[j] = xr[64 * j]; s += (v[j].x * v[j].x + v[j].y * v[j].y) + (v[j].z * v[j].z + v[j].w * v[j].w); }
        const float rstd = rsqrtf(wave_sum(s) * (1.f / DM) + EPSF);
#pragma unroll
        for (int j = 0; j < 4; ++j) { const f32x4 gv = gr[64 * j]; f32x4 o = v[j] * rstd * gv; *(LAS f32x4*)(mt + r * 1024 + 4 * (lane + 64 * j)) = o; }
    }
    __syncthreads();
    const bf16_t* wint = (const bf16_t*)(a.ws + WS_WINT); bf16_t* hyin = (bf16_t*)(a.ws + WS_HYIN); bf16_t* rgx = (bf16_t*)(a.ws + WS_RGX);
    for (int cc = wave; cc < 10; cc += NWAVES) { const int n = blockIdx.x * 10 + cc; if (n >= 2560) break;
        float w[16]; { float t0[8], t1[8]; const bf16_t* wp = wint + (size_t)n * 1024; const u32x4 q0 = *(const u32x4*)(wp + 8 * lane), q1 = *(const u32x4*)(wp + 512 + 8 * lane);
            w[0] = bflo(q0.x); w[1] = bfhi(q0.x); w[2] = bflo(q0.y); w[3] = bfhi(q0.y); w[4] = bflo(q0.z); w[5] = bfhi(q0.z); w[6] = bflo(q0.w); w[7] = bfhi(q0.w);
            w[8] = bflo(q1.x); w[9] = bfhi(q1.x); w[10] = bflo(q1.y); w[11] = bfhi(q1.y); w[12] = bflo(q1.z); w[13] = bfhi(q1.z); w[14] = bflo(q1.w); w[15] = bfhi(q1.w); (void)t0; (void)t1; }
        float mine = 0.f;
#pragma unroll
        for (int r = 0; r < 16; ++r) { const LAS f32x4* mp = (const LAS f32x4*)(mt + r * 1024 + 8 * lane); const f32x4 m0 = mp[0], m1 = mp[1], m2 = mp[128], m3 = mp[129];
            float s = (w[0] * m0.x + w[1] * m0.y) + (w[2] * m0.z + w[3] * m0.w) + (w[4] * m1.x + w[5] * m1.y) + (w[6] * m1.z + w[7] * m1.w)
                    + (w[8] * m2.x + w[9] * m2.y) + (w[10] * m2.z + w[11] * m2.w) + (w[12] * m3.x + w[13] * m3.y) + (w[14] * m3.z + w[15] * m3.w);
            s = wave_sum_dpp(s); mine = ((lane & 15) == r) ? s : mine; }
        const bf16_t v = (bf16_t)f2bf(mine); const int t = lane & 15;
#pragma unroll
        for (int h = 0; h < 2; ++h) { const int b = (lane >> 4) + 4 * h;
            if (n < 1536) hyin[((size_t)b * LT + t) * 1536 + n] = v; else rgx[((size_t)b * LT + t) * 1024 + (n - 1536)] = v; }
    }
    __syncthreads();
}

typedef pg8::f32x4 pf4;
struct EpiProj {
    static constexpr bool PERM = true, AFTER_DRAIN = false;
    bf16_t *hyin, *rgx, *gg, *ga, *gb; const float* bgate;
    __device__ __forceinline__ void operator()(const pf4 (&acc)[2][2][4][2], const pg8::Unit& u, int wr, int wc, int fr, int fq) const {
        const int pn = u.pn, row0 = u.pm * 256 + wr * 64 + fr, cl0 = wc * 32 + 8 * fq;
#pragma unroll
        for (int ai = 0; ai < 2; ++ai)
#pragma unroll
            for (int m = 0; m < 4; ++m) { const int r = row0 + ai * 128 + m * 16; const size_t rl = (size_t)(r >> 12) * LT + NMETA + (r & 4095);
#pragma unroll
                for (int bj = 0; bj < 2; ++bj) { const int col = pn * 256 + bj * 128 + cl0; pf4 v0 = acc[ai][bj][m][0], v1 = acc[ai][bj][m][1]; bf16_t* dst;
                    if (pn < 6) dst = hyin + rl * 1536 + col;
                    else if (pn < 10) dst = rgx + rl * 1024 + (col - 1536);
                    else if (pn < 14) { dst = gg + (size_t)r * 1024 + (col - 2560);
#pragma unroll
                        for (int j = 0; j < 4; ++j) { v0[j] = gelu_tanh(v0[j]); v1[j] = gelu_tanh(v1[j]); } }
                    else { const int gc = col - 3584;
                        dst = (gc < 1024 ? ga + (size_t)r * 1024 + gc : gb + (size_t)r * 1024 + (gc - 1024));
                        const pf4 b0 = *(const pf4*)(bgate + gc), b1 = *(const pf4*)(bgate + gc + 4);
#pragma unroll
                        for (int j = 0; j < 4; ++j) { v0[j] = sigmoidf_(v0[j] + b0[j]); v1[j] = sigmoidf_(v1[j] + b1[j]); } }
                    u32x4 w; w.x = pk2(v0[0], v0[1]); w.y = pk2(v0[2], v0[3]); w.z = pk2(v1[0], v1[1]); w.w = pk2(v1[2], v1[3]);
                    *(u32x4*)dst = w; } }
    }
};
template <int MODE  > struct EpiGate {
    static constexpr bool PERM = true, AFTER_DRAIN = false;
    const bf16_t* gate; const bf16_t* tin; bf16_t* outp;
    __device__ __forceinline__ void operator()(const pf4 (&acc)[2][2][4][2], const pg8::Unit& u, int wr, int wc, int fr, int fq) const {
        const int row0 = u.pm * 256 + wr * 64 + fr, col0 = u.pn * 256 + wc * 32 + 8 * fq;
#pragma unroll
        for (int ai = 0; ai < 2; ++ai)
#pragma unroll
            for (int m = 0; m < 4; ++m) { const size_t ro = (size_t)(row0 + ai * 128 + m * 16) * 1024 + col0;
#pragma unroll
                for (int bj = 0; bj < 2; ++bj) { const size_t o = ro + bj * 128; const pf4 v0 = acc[ai][bj][m][0], v1 = acc[ai][bj][m][1];
                    const u32x4 g = *(const u32x4*)(gate + o);
                    float r[8];
                    r[0] = v0[0] * bflo(g.x); r[1] = v0[1] * bfhi(g.x); r[2] = v0[2] * bflo(g.y); r[3] = v0[3] * bfhi(g.y);
                    r[4] = v1[0] * bflo(g.z); r[5] = v1[1] * bfhi(g.z); r[6] = v1[2] * bflo(g.w); r[7] = v1[3] * bfhi(g.w);
                    if (MODE == 1) { const u32x4 t = *(const u32x4*)(tin + o);
                        r[0] += bflo(t.x); r[1] += bfhi(t.x); r[2] += bflo(t.y); r[3] += bfhi(t.y); r[4] += bflo(t.z); r[5] += bfhi(t.z); r[6] += bflo(t.w); r[7] += bfhi(t.w); }
                    u32x4 w; w.x = pk2(r[0], r[1]); w.y = pk2(r[2], r[3]); w.z = pk2(r[4], r[5]); w.w = pk2(r[6], r[7]);
                    *(u32x4*)(outp + o) = w; } }
    }
};
struct EpiResid {
    static constexpr bool PERM = true, AFTER_DRAIN = false;
    const float* x; bf16_t* h1b; float* rowss;
    __device__ __forceinline__ void operator()(const pf4 (&acc)[2][2][4][2], const pg8::Unit& u, int wr, int wc, int fr, int fq) const {
        const int row0 = u.pm * 256 + wr * 64 + fr, col0 = u.pn * 256 + wc * 32 + 8 * fq;
#pragma unroll
        for (int ai = 0; ai < 2; ++ai)
#pragma unroll
            for (int m = 0; m < 4; ++m) { const int r = row0 + ai * 128 + m * 16; const size_t ro = (size_t)r * 1024 + col0; float ss = 0.f;
#pragma unroll
                for (int bj = 0; bj < 2; ++bj) { const size_t o = ro + bj * 128;
                    const pf4 x0 = *(const pf4*)(x + o), x1 = *(const pf4*)(x + o + 4);
                    const pf4 v0 = acc[ai][bj][m][0] + x0, v1 = acc[ai][bj][m][1] + x1;
                    u32x4 w; w.x = pk2(v0[0], v0[1]); w.y = pk2(v0[2], v0[3]); w.z = pk2(v1[0], v1[1]); w.w = pk2(v1[2], v1[3]);
                    *(u32x4*)(h1b + o) = w;
                    ss += (v0[0] * v0[0] + v0[1] * v0[1]) + (v0[2] * v0[2] + v0[3] * v0[3]) + (v1[0] * v1[0] + v1[1] * v1[1]) + (v1[2] * v1[2] + v1[3] * v1[3]); }
                ss += __shfl_xor(ss, 16); ss += __shfl_xor(ss, 32);
                if (fq == 0) atomicAdd(rowss + r, ss); }
    }
};
struct EpiScores {
    static constexpr bool PERM = true, AFTER_DRAIN = false;
    const float* rowss; _Float16* sc;
    __device__ __forceinline__ void operator()(const pf4 (&acc)[2][2][4][2], const pg8::Unit& u, int wr, int wc, int fr, int fq) const {
        const int row0 = u.pm * 256 + wr * 64 + fr, k0 = wc * 32 + 8 * fq;
#pragma unroll
        for (int ai = 0; ai < 2; ++ai)
#pragma unroll
            for (int m = 0; m < 4; ++m) { const int r = row0 + ai * 128 + m * 16; const float rs = rsqrtf(rowss[r] * (1.f / DM) + EPSF);
#pragma unroll
                for (int bj = 0; bj < 2; ++bj) { _Float16* p = sc + (((size_t)(((r >> 6) * 8 + u.pn) * 2 + bj) * 16 + (k0 >> 3)) * 64 + (r & 63)) * 8;
                    typedef _Float16 h8 __attribute__((ext_vector_type(8)));
                    h8 v; v[0] = (_Float16)(acc[ai][bj][m][0][0] * rs); v[1] = (_Float16)(acc[ai][bj][m][0][1] * rs); v[2] = (_Float16)(acc[ai][bj][m][0][2] * rs); v[3] = (_Float16)(acc[ai][bj][m][0][3] * rs);
                    v[4] = (_Float16)(acc[ai][bj][m][1][0] * rs); v[5] = (_Float16)(acc[ai][bj][m][1][1] * rs); v[6] = (_Float16)(acc[ai][bj][m][1][2] * rs); v[7] = (_Float16)(acc[ai][bj][m][1][3] * rs);
                    *(h8*)p = v; } }
    }
};

__device__ __forceinline__ void load8(const bf16_t* p, float (&f)[8]) { const u32x4 w = *(const u32x4*)p;
    f[0] = bflo(w.x); f[1] = bfhi(w.x); f[2] = bflo(w.y); f[3] = bfhi(w.y); f[4] = bflo(w.z); f[5] = bfhi(w.z); f[6] = bflo(w.w); f[7] = bfhi(w.w); }
__device__ __forceinline__ void short_conv8(const bf16_t* hb, const float* cw, const float* cb, int s, int ch, float (&o)[8]) {
    float xm[8], x0[8], xp[8];
    if (s >= 1) load8(hb + (size_t)(s - 1) * 1536 + ch, xm); else {
#pragma unroll
        for (int i = 0; i < 8; ++i) xm[i] = 0.f; }
    load8(hb + (size_t)s * 1536 + ch, x0);
    if (s + 1 < LT) load8(hb + (size_t)(s + 1) * 1536 + ch, xp); else {
#pragma unroll
        for (int i = 0; i < 8; ++i) xp[i] = 0.f; }
#pragma unroll
    for (int i = 0; i < 8; ++i) o[i] = xm[i] * cw[ch + i] + x0[i] * cw[1536 + ch + i] + xp[i] * cw[3072 + ch + i] + cb[ch + i];
}
__device__ __forceinline__ void phase_hy_pre(const Args& a, LAS unsigned char* lds, int tid) {
    LAS bf16_t* tl = (LAS bf16_t*)lds;
    const bf16_t* hyin = (const bf16_t*)(a.ws + WS_HYIN); bf16_t* uut = (bf16_t*)(a.ws + WS_UUT);
    const float* cw = a.in[I_HYCW]; const float* cb = a.in[I_HYCB];
    for (int it = blockIdx.x; it < NB * 67 * 8; it += gridDim.x) {
        const int ct = it & 7, ts = (it >> 3) % 67, b = (it >> 3) / 67;
        { const int sr = tid >> 3, cg = tid & 7, c0 = ct * 64 + cg * 8, sp = ts * 64 + sr, s = sp - 16;
            float uu[8];
            if (s >= 0 && s < LT) { float x1[8], v[8]; const bf16_t* hb = hyin + (size_t)b * LT * 1536;
                short_conv8(hb, cw, cb, s, 512 + c0, x1); short_conv8(hb, cw, cb, s, 1024 + c0, v);
#pragma unroll
                for (int i = 0; i < 8; ++i) uu[i] = v[i] * x1[i]; }
            else {
#pragma unroll
                for (int i = 0; i < 8; ++i) uu[i] = 0.f; }
#pragma unroll
            for (int i = 0; i < 8; ++i) tl[sr * 72 + cg * 8 + i] = (bf16_t)f2bf(uu[i]); }
        __syncthreads();
        { const int cl = tid >> 3, sg = tid & 7, sp0 = ts * 64 + sg * 8;
            if (sp0 < SP) { u32x4 w; unsigned h[8];
#pragma unroll
                for (int i = 0; i < 8; ++i) h[i] = tl[(sg * 8 + i) * 72 + cl];
                w.x = h[0] | (h[1] << 16); w.y = h[2] | (h[3] << 16); w.z = h[4] | (h[5] << 16); w.w = h[6] | (h[7] << 16);
                *(u32x4*)(uut + ((size_t)(ct * 64 + cl) * NB + b) * SP + sp0) = w; } }
        __syncthreads();
    }
}
__device__ __forceinline__ void phase_hy_conv_naive(const Args& a, LAS unsigned char* lds, int tid) {
    LAS bf16_t* uus = (LAS bf16_t*)lds;
    LAS float* filt = (LAS float*)(lds + LT * 16);
    const bf16_t* uut = (const bf16_t*)(a.ws + WS_UUT); const float* kf = (const float*)(a.ws + WS_KF); bf16_t* cvt = (bf16_t*)(a.ws + WS_CONVT);
    for (int c = blockIdx.x; c < DHY; c += gridDim.x) {
        for (int i = tid; i < NB * LT; i += NTHR) { const int b = i / LT, s = i - b * LT; uus[s * 8 + b] = uut[((size_t)c * NB + b) * SP + 16 + s]; }
        for (int i = tid; i < KFW; i += NTHR) filt[i] = kf[(size_t)c * KFW + i];
        __syncthreads();
        for (int tt = 0; tt < 8; ++tt) { const int tq = tt * 512 + tid, t = tq + 16; float acc[8];
#pragma unroll
            for (int b = 0; b < 8; ++b) acc[b] = 0.f;
            const LAS float* fp = filt + (LT - 1) + t;
            for (int s = 0; s < LT; ++s) { const float kv = fp[-s]; const u32x4 w = *(const LAS u32x4*)(uus + s * 8);
                acc[0] += kv * bflo(w.x); acc[1] += kv * bfhi(w.x); acc[2] += kv * bflo(w.y); acc[3] += kv * bfhi(w.y);
                acc[4] += kv * bflo(w.z); acc[5] += kv * bfhi(w.z); acc[6] += kv * bflo(w.w); acc[7] += kv * bfhi(w.w); }
#pragma unroll
            for (int b = 0; b < 8; ++b) cvt[((size_t)c * NB + b) * SEQ + tq] = (bf16_t)f2bf(acc[b]); }
        __syncthreads();
    }
}
__device__ __forceinline__ void phase_rg_naive(const Args& a, LAS unsigned char* lds, int tid) {
    LAS float* xc = (LAS float*)lds;
    LAS float* gbuf = xc + 32 * 128;
    const bf16_t* rgx = (const bf16_t*)(a.ws + WS_RGX);
    for (int it = blockIdx.x; it < NB * 2 * 8; it += gridDim.x) {
        const int head = it & 7, dir = (it >> 3) & 1, b = it >> 4;
        const float* cw = a.in[I_RGCW] + (size_t)dir * 4 * DRG + head * 128; const float* cb = a.in[I_RGCB] + (size_t)dir * DRG + head * 128;
        bf16_t* hout = (bf16_t*)a.out + (size_t)dir * T * DRG;
        const bf16_t* xb = rgx + (size_t)b * LT * DRG + head * 128;
        float h = 0.f, sp = 0.f;
        if (tid < 128) { const float lam = a.in[I_RGLAM][dir * DRG + head * 128 + tid]; sp = log1pf(__expf(-lam)); }
        for (int k = 0; k < 129; ++k) {
            { const int tok = tid >> 4, cg = tid & 15, u = 32 * k + tok; float o[8];
#pragma unroll
                for (int i = 0; i < 8; ++i) o[i] = (u < LT) ? cb[cg * 8 + i] : 0.f;
                if (u < LT) {
#pragma unroll
                    for (int j = 0; j < 4; ++j) { const int uu = u - j; if (uu >= 0) { const int t = dir ? (LT - 1 - uu) : uu; float xv[8]; load8(xb + (size_t)t * DRG + cg * 8, xv);
#pragma unroll
                            for (int i = 0; i < 8; ++i) o[i] += xv[i] * cw[j * DRG + cg * 8 + i]; } } }
#pragma unroll
                for (int i = 0; i < 8; ++i) xc[tok * 128 + cg * 8 + i] = o[i]; }
            __syncthreads();
            { const int j = tid & 127, g = (tid >> 7) & 1, th = tid >> 8; float acc[16];
#pragma unroll
                for (int q = 0; q < 16; ++q) acc[q] = 0.f;
                const float* gw = a.in[I_RGGW] + ((size_t)((dir * 2 + g) * 8 + head) * 128) * 128 + j;
                for (int i = 0; i < 128; ++i) { const float wv = gw[i * 128];
#pragma unroll
                    for (int q = 0; q < 16; ++q) acc[q] += xc[(th * 16 + q) * 128 + i] * wv; }
                const float gb = a.in[I_RGGB][(size_t)(dir * 2 + g) * DRG + head * 128 + j];
#pragma unroll
                for (int q = 0; q < 16; ++q) gbuf[(g * 32 + th * 16 + q) * 128 + j] = acc[q] + gb; }
            __syncthreads();
            if (tid < 128) {
                for (int tok = 0; tok < 32; ++tok) { const int u = 32 * k + tok; if (u >= LT) break;
                    const float r = sigmoidf_(gbuf[tok * 128 + tid]), ig = sigmoidf_(gbuf[(32 + tok) * 128 + tid]);
                    const float la = -8.0f * r * sp; const float av = __expf(la); const float mult = (u == 0) ? 1.0f : sqrtf(-expm1f(2.0f * la));
                    h = av * h + mult * ig * xc[tok * 128 + tid];
                    const int t = dir ? (LT - 1 - u) : u;
                    if (t >= NMETA) hout[((size_t)b * SEQ + (t - NMETA)) * DRG + head * 128 + tid] = (bf16_t)f2bf(h); } }
            __syncthreads();
        }
    }
}
__device__ __forceinline__ void phase_post(const Args& a, LAS unsigned char* lds, int tid) {
    LAS bf16_t* cv = (LAS bf16_t*)lds;
    const bf16_t* hyin = (const bf16_t*)(a.ws + WS_HYIN); const bf16_t* cvt = (const bf16_t*)(a.ws + WS_CONVT); bf16_t* yh = (bf16_t*)(a.ws + WS_YH);
    const float* cw = a.in[I_HYCW]; const float* cb = a.in[I_HYCB]; const float* skip = a.in[I_HYSKIP];
    for (int it = blockIdx.x; it < NB * 64 * 8; it += gridDim.x) {
        const int ct = it & 7, tt = (it >> 3) & 63, b = it >> 9;
        { const int cl = tid >> 3, tg = tid & 7; const u32x4 w = *(const u32x4*)(cvt + ((size_t)(ct * 64 + cl) * NB + b) * SEQ + tt * 64 + tg * 8);
            *(LAS u32x4*)(cv + cl * 72 + tg * 8) = w; }
        __syncthreads();
        { const int tr = tid >> 3, cg = tid & 7, c0 = ct * 64 + cg * 8, t = NMETA + tt * 64 + tr; const bf16_t* hb = hyin + (size_t)b * LT * 1536;
            float x0[8], x1[8], v[8]; short_conv8(hb, cw, cb, t, c0, x0); short_conv8(hb, cw, cb, t, 512 + c0, x1); short_conv8(hb, cw, cb, t, 1024 + c0, v);
            float y[8];
#pragma unroll
            for (int i = 0; i < 8; ++i) { const float cvv = bf2f(cv[(cg * 8 + i) * 72 + tr]); y[i] = (cvv + v[i] * x1[i] * skip[c0 + i]) * x0[i]; }
            u32x4 w; w.x = pk2(y[0], y[1]); w.y = pk2(y[2], y[3]); w.z = pk2(y[4], y[5]); w.w = pk2(y[6], y[7]);
            *(u32x4*)(yh + ((size_t)b * SEQ + tt * 64 + tr) * DHY + c0) = w; }
        __syncthreads();
    }
    const bf16_t* hf = (const bf16_t*)a.out; const bf16_t* hb2 = hf + (size_t)T * DRG; const bf16_t* gg = (const bf16_t*)(a.ws + WS_GG); bf16_t* yr = (bf16_t*)(a.ws + WS_YR);
    for (size_t i = (size_t)blockIdx.x * NTHR + tid; i < (size_t)T * DRG / 8; i += (size_t)gridDim.x * NTHR) {
        float f[8], g[8], q[8]; load8(hf + i * 8, f); load8(hb2 + i * 8, g); load8(gg + i * 8, q);
        u32x4 w; w.x = pk2((f[0] + g[0]) * q[0], (f[1] + g[1]) * q[1]); w.y = pk2((f[2] + g[2]) * q[2], (f[3] + g[3]) * q[3]);
        w.z = pk2((f[4] + g[4]) * q[4], (f[5] + g[5]) * q[5]); w.w = pk2((f[6] + g[6]) * q[6], (f[7] + g[7]) * q[7]);
        *(u32x4*)(yr + i * 8) = w; }
}
__device__ __forceinline__ u32x4 quant_row16(const f32x4 (&v)[4], float amax, float& deq) {
    const float sc = (amax > 0.f) ? 256.0f / amax : 1.0f; deq = (amax > 0.f) ? amax * (1.0f / 256.0f) : 1.0f;
    u32x4 w; int t;
    t = __builtin_amdgcn_cvt_pk_fp8_f32(v[0].x * sc, v[0].y * sc, 0, false); t = __builtin_amdgcn_cvt_pk_fp8_f32(v[0].z * sc, v[0].w * sc, t, true); w.x = (unsigned)t;
    t = __builtin_amdgcn_cvt_pk_fp8_f32(v[1].x * sc, v[1].y * sc, 0, false); t = __builtin_amdgcn_cvt_pk_fp8_f32(v[1].z * sc, v[1].w * sc, t, true); w.y = (unsigned)t;
    t = __builtin_amdgcn_cvt_pk_fp8_f32(v[2].x * sc, v[2].y * sc, 0, false); t = __builtin_amdgcn_cvt_pk_fp8_f32(v[2].z * sc, v[2].w * sc, t, true); w.z = (unsigned)t;
    t = __builtin_amdgcn_cvt_pk_fp8_f32(v[3].x * sc, v[3].y * sc, 0, false); t = __builtin_amdgcn_cvt_pk_fp8_f32(v[3].z * sc, v[3].w * sc, t, true); w.w = (unsigned)t;
    return w;
}
__device__ __forceinline__ void phase_tables(const Args& a, int wave, int lane) {
    const int gw = blockIdx.x * NWAVES + wave, NGW = gridDim.x * NWAVES;
    const float* gf = a.in[I_GFFN] + 16 * lane; unsigned char* uq = a.ws + WS_UB; unsigned char* vq = a.ws + WS_VB; float* su = (float*)(a.ws + WS_SU); float* sv = (float*)(a.ws + WS_SV);
    f32x4 g[4];
#pragma unroll
    for (int j = 0; j < 4; ++j) g[j] = *(const f32x4*)(gf + 4 * j);
    for (int e = gw; e < NEXP; e += NGW) {
        const float* ur = a.in[I_PU] + (size_t)e * DM + 16 * lane; const float* vr = a.in[I_PV] + (size_t)e * DM + 16 * lane;
        f32x4 u[4], v[4]; float mu = 0.f, mv = 0.f;
#pragma unroll
        for (int j = 0; j < 4; ++j) { u[j] = *(const f32x4*)(ur + 4 * j) * g[j]; v[j] = *(const f32x4*)(vr + 4 * j);
            mu = fmaxf(mu, fmaxf(fmaxf(fabsf(u[j].x), fabsf(u[j].y)), fmaxf(fabsf(u[j].z), fabsf(u[j].w))));
            mv = fmaxf(mv, fmaxf(fmaxf(fabsf(v[j].x), fabsf(v[j].y)), fmaxf(fabsf(v[j].z), fabsf(v[j].w)))); }
        mu = wave_max_dpp(mu); mv = wave_max_dpp(mv);
        float du, dv; const u32x4 qu = quant_row16(u, mu, du), qv = quant_row16(v, mv, dv);
        { const size_t so = ((size_t)(lane >> 3) * NEXP + e) * 128 + 16 * (lane & 7); *(u32x4*)(uq + so) = qu; *(u32x4*)(vq + so) = qv; }
        if (lane == 0) { su[e] = du; sv[e] = dv; }
    }
}
__device__ __forceinline__ void ce_desc(float& a, float& b) { const float hi = fmaxf(a, b), lo = fminf(a, b); a = hi; b = lo; }
__device__ __forceinline__ void sort16_desc(float (&x)[16]) {
#pragma unroll
    for (int k = 2; k <= 16; k <<= 1)
#pragma unroll
        for (int j = k >> 1; j > 0; j >>= 1)
#pragma unroll
            for (int i = 0; i < 16; ++i) { const int l = i ^ j; if (l > i) { if ((i & k) == 0) ce_desc(x[i], x[l]); else ce_desc(x[l], x[i]); } }
}
__device__ __forceinline__ void merge_top16(float (&L)[16], const float (&X)[16]) {
#pragma unroll
    for (int i = 0; i < 16; ++i) L[i] = fmaxf(L[i], X[15 - i]);
#pragma unroll
    for (int j = 8; j > 0; j >>= 1)
#pragma unroll
        for (int i = 0; i < 16; ++i) { const int l = i ^ j; if (l > i) ce_desc(L[i], L[l]); }
}
__device__ __forceinline__ void top16_of_128(const _Float16* base  , float (&L)[16]) {
    typedef _Float16 h8 __attribute__((ext_vector_type(8)));
    h8 v0 = *(const h8*)(base), v1 = *(const h8*)(base + 512);
#pragma unroll 1
    for (int ch = 0; ch < 8; ++ch) { float X[16]; const int cn = (ch < 7) ? ch + 1 : 7;
        const h8 n0 = *(const h8*)(base + (2 * cn) * 512), n1 = *(const h8*)(base + (2 * cn + 1) * 512);
#pragma unroll
        for (int i = 0; i < 8; ++i) { X[i] = __uint_as_float((__float_as_uint((float)v0[i]) & ~0x7Fu) | (unsigned)(ch * 16 + i));
            X[8 + i] = __uint_as_float((__float_as_uint((float)v1[i]) & ~0x7Fu) | (unsigned)(ch * 16 + 8 + i)); }
        sort16_desc(X);
        if (ch == 0) {
#pragma unroll
            for (int i = 0; i < 16; ++i) L[i] = X[i]; }
        else merge_top16(L, X);
        v0 = n0; v1 = n1; }
}
struct CandTab { int ci[64], cj[64]; };
__host__ __device__ constexpr CandTab make_cand() { CandTab t{}; int n = 0; for (int i = 0; i < 16; ++i) for (int j = 0; j < 16; ++j) if ((i + 1) * (j + 1) <= 16) { t.ci[n] = i; t.cj[n] = j; ++n; }
    for (; n < 64; ++n) { t.ci[n] = -1; t.cj[n] = -1; } return t; }
__device__ __forceinline__ void phase_topk(const Args& a, LAS unsigned char* lds, int wave, int lane) {
    constexpr CandTab CT = make_cand();
    const int gw = blockIdx.x * NWAVES + wave, NGW = gridDim.x * NWAVES;
    const _Float16* st = (const _Float16*)(a.ws + WS_SCORES); int* eidx = (int*)(a.ws + WS_EIDX); float* eg = (float*)(a.ws + WS_EG);
    LAS unsigned char* tab = lds + wave * (64 * 36) + lane * 36;
    for (int it = gw; it < (T / 64) * 8; it += NGW) { const int tg = it >> 3, hh = it & 7; const int m = tg * 64 + lane;
        float A[16], B[16];
        top16_of_128(st + (size_t)((tg * 8 + hh) * 2 + 0) * 128 * 64 + lane * 8, A);
        top16_of_128(st + (size_t)((tg * 8 + hh) * 2 + 1) * 128 * 64 + lane * 8, B);
#pragma unroll
        for (int q = 0; q < 4; ++q) {
            const unsigned wa = (__float_as_uint(A[4 * q]) & 0x7Fu) | ((__float_as_uint(A[4 * q + 1]) & 0x7Fu) << 8) | ((__float_as_uint(A[4 * q + 2]) & 0x7Fu) << 16) | ((__float_as_uint(A[4 * q + 3]) & 0x7Fu) << 24);
            const unsigned wb = (__float_as_uint(B[4 * q]) & 0x7Fu) | ((__float_as_uint(B[4 * q + 1]) & 0x7Fu) << 8) | ((__float_as_uint(B[4 * q + 2]) & 0x7Fu) << 16) | ((__float_as_uint(B[4 * q + 3]) & 0x7Fu) << 24);
            *(LAS unsigned*)(tab + 4 * q) = wa; *(LAS unsigned*)(tab + 16 + 4 * q) = wb; }
#pragma unroll
        for (int i = 0; i < 16; ++i) { A[i] = __uint_as_float(__float_as_uint(A[i]) & ~0x7Fu); B[i] = __uint_as_float(__float_as_uint(B[i]) & ~0x7Fu); }
        float K[16];
#pragma unroll
        for (int c0 = 0; c0 < 64; c0 += 16) { float X[16];
#pragma unroll
            for (int i = 0; i < 16; ++i) { const int c = c0 + i;
                if (CT.ci[c] >= 0) X[i] = __uint_as_float((__float_as_uint(A[CT.ci[c] < 0 ? 0 : CT.ci[c]] + B[CT.cj[c] < 0 ? 0 : CT.cj[c]]) & ~0xFFu) | (unsigned)(CT.ci[c] * 16 + CT.cj[c]));
                else X[i] = -INFINITY; }
            sort16_desc(X);
            if (c0 == 0) {
#pragma unroll
                for (int i = 0; i < 16; ++i) K[i] = X[i]; }
            else merge_top16(K, X); }
        asm volatile("s_waitcnt lgkmcnt(0)" ::: "memory");
        int ex_[16]; float cs[16]; float sum = 0.f;
#pragma unroll
        for (int r = 0; r < 16; ++r) { const unsigned kb = __float_as_uint(K[r]); const int id = kb & 0xFF; cs[r] = __expf(__uint_as_float(kb & ~0xFFu) - __uint_as_float(__float_as_uint(K[0]) & ~0xFFu)); sum += cs[r];
            ex_[r] = (int)tab[id >> 4] * 128 + (int)tab[16 + (id & 15)]; }
        const float inv = 1.0f / sum;
        unsigned short* ep = (unsigned short*)eidx + (size_t)m * 128 + hh * 16; float* gp = eg + (size_t)m * 128 + hh * 16;
        { u32x4 p0, p1; p0.x = ex_[0] | (ex_[1] << 16); p0.y = ex_[2] | (ex_[3] << 16); p0.z = ex_[4] | (ex_[5] << 16); p0.w = ex_[6] | (ex_[7] << 16);
          p1.x = ex_[8] | (ex_[9] << 16); p1.y = ex_[10] | (ex_[11] << 16); p1.z = ex_[12] | (ex_[13] << 16); p1.w = ex_[14] | (ex_[15] << 16); *(u32x4*)ep = p0; *(u32x4*)(ep + 8) = p1; }
#pragma unroll
        for (int q = 0; q < 4; ++q) {
            *(f32x4*)(gp + 4 * q) = (f32x4){cs[4 * q] * inv, cs[4 * q + 1] * inv, cs[4 * q + 2] * inv, cs[4 * q + 3] * inv}; }
    }
}
__device__ __forceinline__ void unpack8(const u32x4 w, float (&f)[8]) {
    f[0] = bflo(w.x); f[1] = bfhi(w.x); f[2] = bflo(w.y); f[3] = bfhi(w.y); f[4] = bflo(w.z); f[5] = bfhi(w.z); f[6] = bflo(w.w); f[7] = bfhi(w.w); }
__device__ __forceinline__ void fp8x16_to_f32(const u32x4 w, float (&f)[16]) {
    f32x2v t;
    t = __builtin_amdgcn_cvt_pk_f32_fp8((int)w.x, false); f[0] = t.x; f[1] = t.y; t = __builtin_amdgcn_cvt_pk_f32_fp8((int)w.x, true); f[2] = t.x; f[3] = t.y;
    t = __builtin_amdgcn_cvt_pk_f32_fp8((int)w.y, false); f[4] = t.x; f[5] = t.y; t = __builtin_amdgcn_cvt_pk_f32_fp8((int)w.y, true); f[6] = t.x; f[7] = t.y;
    t = __builtin_amdgcn_cvt_pk_f32_fp8((int)w.z, false); f[8] = t.x; f[9] = t.y; t = __builtin_amdgcn_cvt_pk_f32_fp8((int)w.z, true); f[10] = t.x; f[11] = t.y;
    t = __builtin_amdgcn_cvt_pk_f32_fp8((int)w.w, false); f[12] = t.x; f[13] = t.y; t = __builtin_amdgcn_cvt_pk_f32_fp8((int)w.w, true); f[14] = t.x; f[15] = t.y;
}
__device__ __forceinline__ void fp8x16_to_f32x2(const u32x4 w, f32x2v (&f)[8]) {
    f[0] = __builtin_amdgcn_cvt_pk_f32_fp8((int)w.x, false); f[1] = __builtin_amdgcn_cvt_pk_f32_fp8((int)w.x, true);
    f[2] = __builtin_amdgcn_cvt_pk_f32_fp8((int)w.y, false); f[3] = __builtin_amdgcn_cvt_pk_f32_fp8((int)w.y, true);
    f[4] = __builtin_amdgcn_cvt_pk_f32_fp8((int)w.z, false); f[5] = __builtin_amdgcn_cvt_pk_f32_fp8((int)w.z, true);
    f[6] = __builtin_amdgcn_cvt_pk_f32_fp8((int)w.w, false); f[7] = __builtin_amdgcn_cvt_pk_f32_fp8((int)w.w, true);
}
__device__ __forceinline__ float dpp_sum8(float v) {
    v += __int_as_float(__builtin_amdgcn_update_dpp(0, __float_as_int(v), 0xB1, 0xF, 0xF, true));
    v += __int_as_float(__builtin_amdgcn_update_dpp(0, __float_as_int(v), 0x4E, 0xF, 0xF, true));
    v += __int_as_float(__builtin_amdgcn_update_dpp(0, __float_as_int(v), 0x141, 0xF, 0xF, true));
    return v;
}
struct UTok { u32x4 e0, e1, xa, xb; };
struct VTok { u32x4 e0, e1; f32x4 av[4]; };
__device__ __forceinline__ void pu_issue(const unsigned char* tab, unsigned loff, const u32x4& e, u32x4 (&w)[8]) {
    w[0] = *(const u32x4*)(tab + ((e.x & 0xffffu) * 128u + loff)); w[1] = *(const u32x4*)(tab + ((e.x >> 16) * 128u + loff));
    w[2] = *(const u32x4*)(tab + ((e.y & 0xffffu) * 128u + loff)); w[3] = *(const u32x4*)(tab + ((e.y >> 16) * 128u + loff));
    w[4] = *(const u32x4*)(tab + ((e.z & 0xffffu) * 128u + loff)); w[5] = *(const u32x4*)(tab + ((e.z >> 16) * 128u + loff));
    w[6] = *(const u32x4*)(tab + ((e.w & 0xffffu) * 128u + loff)); w[7] = *(const u32x4*)(tab + ((e.w >> 16) * 128u + loff));
}
__device__ __forceinline__ float pu_compute(const f32x2v (&x)[8], const u32x4 (&w)[8], int i) {
    float keep = 0.f;
#pragma unroll
    for (int q = 0; q < 8; ++q) { f32x2v f[8]; fp8x16_to_f32x2(w[q], f); f32x2v s0 = f[0] * x[0], s1 = f[1] * x[1];
#pragma unroll
        for (int c = 2; c < 8; c += 2) { s0 += f[c] * x[c]; s1 += f[c + 1] * x[c + 1]; }
        s0 += s1; const float d = dpp_sum8(s0.x + s0.y); keep = (q == i) ? d : keep; }
    return keep;
}
__device__ __forceinline__ void phase_peer_u(const Args& a, int wave, int lane) {
    const int s = SLICE_OF(blockIdx.x), rk = RANK_OF(blockIdx.x), nrk = gridDim.x >> 3, tper = T / nrk, i = lane & 7, j = lane >> 3;
    const bf16_t* h1b = (const bf16_t*)(a.ws + WS_H1B) + 128 * s + 16 * i; const unsigned char* uqs = a.ws + WS_UB + (size_t)s * NEXP * 128; const unsigned loff = 16u * (unsigned)i;
    const unsigned short* eidx = (const unsigned short*)(a.ws + WS_EIDX) + 16 * j; float* pd = (float*)(a.ws + WS_PD) + (size_t)s * T * 128 + 16 * j + i;
    const int m0 = rk * tper + wave, mlast = (rk + 1) * tper - NWAVES + wave;
#define PU_LOAD(t, mm) do { const int m_ = (mm) < mlast ? (mm) : mlast; const u32x4* ep_ = (const u32x4*)(eidx + (size_t)m_ * 128); (t).e0 = ep_[0]; (t).e1 = ep_[1]; \
        (t).xa = *(const u32x4*)(h1b + (size_t)m_ * DM); (t).xb = *(const u32x4*)(h1b + (size_t)m_ * DM + 8); } while (0)
#define PU_DO(t, w0, w1, mm) do { f32x2v x[8]; \
        x[0] = (f32x2v){bflo((t).xa.x), bfhi((t).xa.x)}; x[1] = (f32x2v){bflo((t).xa.y), bfhi((t).xa.y)}; x[2] = (f32x2v){bflo((t).xa.z), bfhi((t).xa.z)}; x[3] = (f32x2v){bflo((t).xa.w), bfhi((t).xa.w)}; \
        x[4] = (f32x2v){bflo((t).xb.x), bfhi((t).xb.x)}; x[5] = (f32x2v){bflo((t).xb.y), bfhi((t).xb.y)}; x[6] = (f32x2v){bflo((t).xb.z), bfhi((t).xb.z)}; x[7] = (f32x2v){bflo((t).xb.w), bfhi((t).xb.w)}; \
        const float k0_ = pu_compute(x, w0, i), k1_ = pu_compute(x, w1, i); pd[(size_t)(mm) * 128] = k0_; pd[(size_t)(mm) * 128 + 8] = k1_; } while (0)
    UTok tC, tN, tNN; u32x4 wA[8], wB[8], wC[8], wD[8];
    PU_LOAD(tC, m0); PU_LOAD(tN, m0 + NWAVES); PU_LOAD(tNN, m0 + 2 * NWAVES); pu_issue(uqs, loff, tC.e0, wA); pu_issue(uqs, loff, tC.e1, wB);
    for (int m = m0; m <= mlast; m += 2 * NWAVES) {
        pu_issue(uqs, loff, tN.e0, wC); pu_issue(uqs, loff, tN.e1, wD);
        PU_DO(tC, wA, wB, m);
        tC = tN; tN = tNN; PU_LOAD(tNN, m + 3 * NWAVES);
        pu_issue(uqs, loff, tN.e0, wA); pu_issue(uqs, loff, tN.e1, wB);
        PU_DO(tC, wC, wD, m + NWAVES);
        tC = tN; tN = tNN; PU_LOAD(tNN, m + 4 * NWAVES);
    }
#undef PU_LOAD
#undef PU_DO
}
__device__ __forceinline__ void phase_peer_act(const Args& a, int tid) {
    const float* pd = (const float*)(a.ws + WS_PD); const unsigned short* eidx = (const unsigned short*)(a.ws + WS_EIDX); const float* eg = (const float*)(a.ws + WS_EG);
    const float* su = (const float*)(a.ws + WS_SU); const float* sv = (const float*)(a.ws + WS_SV); const float* rowss = (const float*)(a.ws + WS_ROWSS); float* act = (float*)(a.ws + WS_ACT);
    for (size_t i4 = (size_t)blockIdx.x * NTHR + tid; i4 < (size_t)T * 32; i4 += (size_t)gridDim.x * NTHR) { const size_t idx = i4 * 4;
        f32x4 d = *(const f32x4*)(pd + idx);
#pragma unroll
        for (int s = 1; s < 8; ++s) d += *(const f32x4*)(pd + (size_t)s * T * 128 + idx);
        const u32x2 ew = *(const u32x2*)(eidx + idx); const f32x4 g = *(const f32x4*)(eg + idx); const float rstd = rsqrtf(rowss[idx >> 7] * (1.f / DM) + EPSF);
        const unsigned e0 = ew.x & 0xffffu, e1 = ew.x >> 16, e2 = ew.y & 0xffffu, e3 = ew.y >> 16;
        f32x4 o; o.x = gelu_tanh(d.x * su[e0] * rstd) * g.x * sv[e0]; o.y = gelu_tanh(d.y * su[e1] * rstd) * g.y * sv[e1];
        o.z = gelu_tanh(d.z * su[e2] * rstd) * g.z * sv[e2]; o.w = gelu_tanh(d.w * su[e3] * rstd) * g.w * sv[e3];
        *(f32x4*)(act + idx) = o;
    }
}
__device__ __forceinline__ void pv_accum(const u32x4 (&w)[8], const f32x4& a0, const f32x4& a1, f32x2v (&o)[8]) {
#pragma unroll
    for (int q = 0; q < 8; ++q) { f32x2v f[8]; fp8x16_to_f32x2(w[q], f); const float aq = (q < 4) ? a0[q & 3] : a1[q & 3]; const f32x2v a2 = (f32x2v){aq, aq};
#pragma unroll
        for (int c = 0; c < 8; ++c) o[c] += a2 * f[c]; }
}
__device__ __forceinline__ void pv_finish(const f32x2v (&o2)[8], float* orow, int j) {
    float o[16];
#pragma unroll
    for (int c = 0; c < 8; ++c) { o[2 * c] = o2[c].x; o[2 * c + 1] = o2[c].y; }
#pragma unroll
    for (int c = 0; c < 16; ++c) { o[c] += __int_as_float(__builtin_amdgcn_update_dpp(0, __float_as_int(o[c]), 0x128, 0xF, 0xF, true));
        o[c] += __shfl_xor(o[c], 16); o[c] += __shfl_xor(o[c], 32); }
    if (j == 0) {
#pragma unroll
        for (int c4 = 0; c4 < 4; ++c4) *(f32x4*)(orow + 4 * c4) = (f32x4){o[4 * c4], o[4 * c4 + 1], o[4 * c4 + 2], o[4 * c4 + 3]}; }
}
__device__ __forceinline__ void phase_peer_v(const Args& a, int wave, int lane) {
    const int s = SLICE_OF(blockIdx.x), rk = RANK_OF(blockIdx.x), nrk = gridDim.x >> 3, tper = T / nrk, i = lane & 7, j = lane >> 3;
    const unsigned char* vqs = a.ws + WS_VB + (size_t)s * NEXP * 128; const unsigned loff = 16u * (unsigned)i;
    const unsigned short* eidx = (const unsigned short*)(a.ws + WS_EIDX) + 16 * j; const float* act = (const float*)(a.ws + WS_ACT) + 16 * j;
    float* obase = (float*)(a.ws + WS_PO) + 128 * s + 16 * i;
    const int m0 = rk * tper + wave, mlast = (rk + 1) * tper - NWAVES + wave;
#define PV_LOAD(t, mm) do { const int m_ = (mm) < mlast ? (mm) : mlast; const u32x4* ep_ = (const u32x4*)(eidx + (size_t)m_ * 128); const f32x4* ap_ = (const f32x4*)(act + (size_t)m_ * 128); \
        (t).e0 = ep_[0]; (t).e1 = ep_[1]; (t).av[0] = ap_[0]; (t).av[1] = ap_[1]; (t).av[2] = ap_[2]; (t).av[3] = ap_[3]; } while (0)
#define PV_DO(t, w0, w1, mm) do { f32x2v o[8]; _Pragma("unroll") for (int c = 0; c < 8; ++c) o[c] = (f32x2v){0.f, 0.f}; \
        pv_accum(w0, (t).av[0], (t).av[1], o); pv_accum(w1, (t).av[2], (t).av[3], o); pv_finish(o, obase + (size_t)(mm) * DM, j); } while (0)
    VTok tC, tN, tNN; u32x4 wA[8], wB[8], wC[8], wD[8];
    PV_LOAD(tC, m0); PV_LOAD(tN, m0 + NWAVES); PV_LOAD(tNN, m0 + 2 * NWAVES); pu_issue(vqs, loff, tC.e0, wA); pu_issue(vqs, loff, tC.e1, wB);
    for (int m = m0; m <= mlast; m += 2 * NWAVES) {
        pu_issue(vqs, loff, tN.e0, wC); pu_issue(vqs, loff, tN.e1, wD);
        PV_DO(tC, wA, wB, m);
        tC = tN; tN = tNN; PV_LOAD(tNN, m + 3 * NWAVES);
        pu_issue(vqs, loff, tN.e0, wA); pu_issue(vqs, loff, tN.e1, wB);
        PV_DO(tC, wC, wD, m + NWAVES);
        tC = tN; tN = tNN; PV_LOAD(tNN, m + 4 * NWAVES);
    }
#undef PV_LOAD
#undef PV_DO
}
__device__ __forceinline__ void phase_final(const Args& a, int wave, int lane) {
    const int gw = blockIdx.x * NWAVES + wave, NGW = gridDim.x * NWAVES; const float* po = (const float*)(a.ws + WS_PO) + 16 * lane; const bf16_t* h1b = (const bf16_t*)(a.ws + WS_H1B) + 16 * lane;
    f32x4 gf[4];
#pragma unroll
    for (int jj = 0; jj < 4; ++jj) gf[jj] = *(const f32x4*)(a.in[I_GFINAL] + 16 * lane + 4 * jj);
    for (int m = gw; m < T; m += NGW) { float hb[16]; load8(h1b + (size_t)m * DM, *(float(*)[8])&hb[0]); load8(h1b + (size_t)m * DM + 8, *(float(*)[8])&hb[8]);
        f32x4 h[4]; float ss = 0.f;
#pragma unroll
        for (int jj = 0; jj < 4; ++jj) { h[jj] = *(const f32x4*)(po + (size_t)m * DM + 4 * jj) + (f32x4){hb[4 * jj], hb[4 * jj + 1], hb[4 * jj + 2], hb[4 * jj + 3]};
            ss += (h[jj].x * h[jj].x + h[jj].y * h[jj].y) + (h[jj].z * h[jj].z + h[jj].w * h[jj].w); }
        const float r2 = rsqrtf(wave_sum_dpp(ss) * (1.f / DM) + EPSF);
        float* orow = a.out + (size_t)m * DM + 16 * lane;
#pragma unroll
        for (int jj = 0; jj < 4; ++jj) *(f32x4*)(orow + 4 * jj) = h[jj] * r2 * gf[jj]; }
}
typedef short bf16x8_t __attribute__((ext_vector_type(8)));
__device__ __forceinline__ bf16x8_t toep_frag(const LAS unsigned* R32, int base) {
    const int e = base >> 1, sh = (base & 1) * 16;
    const unsigned d0 = R32[e], d1 = R32[e + 1], d2 = R32[e + 2], d3 = R32[e + 3], d4 = R32[e + 4];
    u32x4 o; o.x = __builtin_amdgcn_alignbit(d1, d0, sh); o.y = __builtin_amdgcn_alignbit(d2, d1, sh); o.z = __builtin_amdgcn_alignbit(d3, d2, sh); o.w = __builtin_amdgcn_alignbit(d4, d3, sh);
    return __builtin_bit_cast(bf16x8_t, o);
}
__device__ __forceinline__ void hy_conv_channel(const Args& a, LAS unsigned char* lds, int c, int tid, int wave, int lane) {
    constexpr int UROW = SP * 2;
    LAS unsigned char* uus = lds;
    LAS unsigned short* R = (LAS unsigned short*)(lds + 8 * UROW);
    const bf16_t* uut = (const bf16_t*)(a.ws + WS_UUT); const bf16_t* kfb = (const bf16_t*)(a.ws + WS_KFB); bf16_t* cvt = (bf16_t*)(a.ws + WS_CONVT);
    { const u32x4* src = (const u32x4*)(uut + (size_t)c * NB * SP); for (int i = tid; i < 8 * UROW / 16; i += NTHR) ((LAS u32x4*)uus)[i] = src[i]; }
    for (int n = tid; n < KFW + 16; n += NTHR) R[n] = (n < KFW) ? kfb[(size_t)c * KFW + (KFW - 1) - n] : (unsigned short)0;
    __syncthreads();
    const LAS unsigned* R32 = (const LAS unsigned*)R;
    const int i = lane & 15, g = lane >> 4, p = (lane >> 3) & 1, b = lane & 7;
    f32x4 C[16]; bf16x8_t A[16];
    const int abase = LT - 32 * (1 + 16 * wave) - i + 8 * g;
#pragma unroll
    for (int tb = 0; tb < 16; ++tb) { C[tb] = (f32x4){0.f, 0.f, 0.f, 0.f}; A[tb] = toep_frag(R32, abase - 32 * tb); }
    const LAS unsigned char* bptr = uus + b * UROW + (16 * p + 8 * g) * 2;
#define HC_STEP(ph, n) do { A[(16 - (ph)) & 15] = toep_frag(R32, abase + 32 * (n)); const bf16x8_t Bf = *(const LAS bf16x8_t*)(bptr + (n) * 64); \
        _Pragma("unroll") for (int tb = 0; tb < 16; ++tb) C[tb] = __builtin_amdgcn_mfma_f32_16x16x32_bf16(A[(tb - (ph)) & 15], Bf, C[tb], 0, 0, 0); } while (0)
    for (int G = 0; G < 8; ++G) { const int n0 = G * 16;
        HC_STEP(0, n0); HC_STEP(1, n0 + 1); HC_STEP(2, n0 + 2); HC_STEP(3, n0 + 3); HC_STEP(4, n0 + 4); HC_STEP(5, n0 + 5); HC_STEP(6, n0 + 6); HC_STEP(7, n0 + 7);
        HC_STEP(8, n0 + 8); HC_STEP(9, n0 + 9); HC_STEP(10, n0 + 10); HC_STEP(11, n0 + 11); HC_STEP(12, n0 + 12); HC_STEP(13, n0 + 13); HC_STEP(14, n0 + 14); HC_STEP(15, n0 + 15); }
    HC_STEP(0, 128);
#undef HC_STEP
#pragma unroll
    for (int tb = 0; tb < 16; ++tb) { const int tq = 512 * wave + 32 * tb + 16 * p + 4 * g;
        u32x2 w; w.x = pk2(C[tb][0], C[tb][1]); w.y = pk2(C[tb][2], C[tb][3]);
        *(u32x2*)(cvt + ((size_t)c * NB + b) * SEQ + tq) = w; }
    __syncthreads();
}
__device__ __forceinline__ void rg_item(const Args& a, LAS unsigned char* lds, int it, int tid, int wave, int lane) {
    constexpr int XROW = 272;
    const int head = it & 7, dir = (it >> 3) & 1, b = it >> 4;
    const bf16_t* xb = (const bf16_t*)(a.ws + WS_RGX) + (size_t)b * LT * DRG + head * 128;
    bf16_t* hout = (bf16_t*)a.out + (size_t)dir * T * DRG + (size_t)b * SEQ * DRG + head * 128 + 16 * wave + (lane & 15);
    const int col = lane & 15, g = lane >> 4, ch = head * 128 + 16 * wave + col;
    LAS unsigned char* wl = lds + 2 * 64 * XROW + wave * 1024 + lane * 16;
#pragma unroll
    for (int gt = 0; gt < 2; ++gt)
#pragma unroll
        for (int ks = 0; ks < 4; ++ks) { const float* wp = a.in[I_RGGW] + ((size_t)((dir * 2 + gt) * 8 + head) * 128 + 32 * ks + 8 * g) * 128 + 16 * wave + col;
            u32x4 o; o.x = pk2(wp[0], wp[128]); o.y = pk2(wp[256], wp[384]); o.z = pk2(wp[512], wp[640]); o.w = pk2(wp[768], wp[896]); *(LAS u32x4*)(wl + (gt * 4 + ks) * 8192) = o; }
    const float br = a.in[I_RGGB][(size_t)(dir * 2 + 0) * DRG + ch], bi = a.in[I_RGGB][(size_t)(dir * 2 + 1) * DRG + ch];
    const float sp8 = -8.0f * log1pf(__expf(-a.in[I_RGLAM][dir * DRG + ch]));
    const int ctr = tid >> 4, ccg = tid & 15;
    float cwv[4][8], cbv[8];
#pragma unroll
    for (int i = 0; i < 8; ++i) { cbv[i] = a.in[I_RGCB][(size_t)dir * DRG + head * 128 + 8 * ccg + i];
#pragma unroll
        for (int j = 0; j < 4; ++j) cwv[j][i] = a.in[I_RGCW][((size_t)dir * 4 + j) * DRG + head * 128 + 8 * ccg + i]; }
    u32x4 xr[2][4];
#define RG_LOAD(k) do { _Pragma("unroll") for (int h_ = 0; h_ < 2; ++h_) { const int u_ = 64 * (k) + ctr + 32 * h_; _Pragma("unroll") for (int j = 0; j < 4; ++j) { const int uu_ = u_ - j; \
        if (uu_ >= 0 && uu_ < LT) { const int t_ = dir ? (LT - 1 - uu_) : uu_; xr[h_][j] = *(const u32x4*)(xb + (size_t)t_ * DRG + 8 * ccg); } \
        else xr[h_][j] = (u32x4){0u, 0u, 0u, 0u}; } } } while (0)
#define RG_CONV(k) do { _Pragma("unroll") for (int h_ = 0; h_ < 2; ++h_) { const int u_ = 64 * (k) + ctr + 32 * h_; float o_[8]; _Pragma("unroll") for (int i = 0; i < 8; ++i) o_[i] = (u_ < LT) ? cbv[i] : 0.f; \
        _Pragma("unroll") for (int j = 0; j < 4; ++j) { float f_[8]; unpack8(xr[h_][j], f_); _Pragma("unroll") for (int i = 0; i < 8; ++i) o_[i] += f_[i] * cwv[j][i]; } \
        u32x4 w0_; w0_.x = pk2(o_[0], o_[1]); w0_.y = pk2(o_[2], o_[3]); w0_.z = pk2(o_[4], o_[5]); w0_.w = pk2(o_[6], o_[7]); \
        *(LAS u32x4*)(lds + ((k) & 1) * (64 * XROW) + (ctr + 32 * h_) * XROW + ccg * 16) = w0_; } } while (0)
    RG_LOAD(0); RG_CONV(0); RG_LOAD(1);
    __syncthreads();
    float carry = 0.f;
    const int arow = 16 * (col >> 2) + (col & 3);
    for (int k = 0; k < 65; ++k) {
        if (k + 1 < 65) RG_CONV(k + 1);
        if (k + 2 < 65) RG_LOAD(k + 2);
        const LAS unsigned char* xa = lds + (k & 1) * (64 * XROW);
        unsigned hp[16]; float hh = 0.f, PP = 1.f;
#pragma unroll
        for (int mp = 0; mp < 2; ++mp) {
            f32x4 acc[2][2];
#pragma unroll
            for (int m2 = 0; m2 < 2; ++m2) { const int mb = 2 * mp + m2; acc[0][m2] = (f32x4){0.f, 0.f, 0.f, 0.f}; acc[1][m2] = (f32x4){0.f, 0.f, 0.f, 0.f};
#pragma unroll
                for (int ks = 0; ks < 4; ++ks) { const bf16x8_t Af = *(const LAS bf16x8_t*)(xa + (arow + 4 * mb) * XROW + (32 * ks + 8 * g) * 2);
                    acc[0][m2] = __builtin_amdgcn_mfma_f32_16x16x32_bf16(Af, *(const LAS bf16x8_t*)(wl + ks * 8192), acc[0][m2], 0, 0, 0);
                    acc[1][m2] = __builtin_amdgcn_mfma_f32_16x16x32_bf16(Af, *(const LAS bf16x8_t*)(wl + (4 + ks) * 8192), acc[1][m2], 0, 0, 0); } }
#pragma unroll
            for (int m2 = 0; m2 < 2; ++m2)
#pragma unroll
                for (int r = 0; r < 4; ++r) { const int e = 8 * mp + 4 * m2 + r, tau = 16 * g + e, u = 64 * k + tau;
                    const float rr = sigmoidf_(acc[0][m2][r] + br), ii = sigmoidf_(acc[1][m2][r] + bi);
                    float av = fexp(sp8 * rr); float mult = __builtin_amdgcn_sqrtf(fmaxf(1.0f - av * av, 0.f)); mult = (u == 0) ? 1.0f : mult;
                    const float xcv = bf2f(*(const LAS unsigned short*)(xa + tau * XROW + (16 * wave + col) * 2));
                    float bq = mult * ii * xcv; if (u >= LT) { av = 1.f; bq = 0.f; }
                    hh = av * hh + bq; PP *= av; hp[e] = pk2(hh, PP); }
        }
        float Pg[4], hg[4];
#pragma unroll
        for (int q = 0; q < 4; ++q) { Pg[q] = __shfl(PP, col + 16 * q); hg[q] = __shfl(hh, col + 16 * q); }
        const float H0 = carry, H1 = Pg[0] * H0 + hg[0], H2 = Pg[1] * H1 + hg[1], H3 = Pg[2] * H2 + hg[2], H4 = Pg[3] * H3 + hg[3];
        const float Hin = (g == 0) ? H0 : (g == 1) ? H1 : (g == 2) ? H2 : H3;
        carry = H4;
#pragma unroll
        for (int e = 0; e < 16; ++e) { const int u = 64 * k + 16 * g + e; const int t = dir ? (LT - 1 - u) : u;
            if (u < LT && t >= NMETA) hout[(size_t)(t - NMETA) * DRG] = (bf16_t)f2bf(bflo(hp[e]) + bfhi(hp[e]) * Hin); }
        __syncthreads();
    }
#undef RG_LOAD
#undef RG_CONV
}

#ifndef RG_NAIVE
#define RG_NAIVE 0
#endif
#ifndef CONV_NAIVE
#define CONV_NAIVE 0
#endif
#ifndef ONE_LAUNCH
#define ONE_LAUNCH 0
#endif
constexpr int NPHASE = 13;
#ifndef NVGPR
#define NVGPR 248
#endif
__global__ void __launch_bounds__(NTHR, 2) __attribute__((amdgpu_num_vgpr(NVGPR))) mega(Args a) {
    extern __shared__ __attribute__((aligned(16))) unsigned char lds_raw[];
    LAS unsigned char* lds = (LAS unsigned char*)lds_raw;
    const int tid = threadIdx.x, lane = tid & 63, wave = __builtin_amdgcn_readfirstlane(tid >> 6);
    cg::grid_group grid = cg::this_grid();
    volatile LAS unsigned* bst = (volatile LAS unsigned*)(lds + LDS_BYTES - 64);
    if (tid == 0) { bst[0] = 0u; bst[1] = 0u; }
    __syncthreads();
    XcdBarrier xbar; xbar.bar = (unsigned*)(a.ws + WS_BAR); xbar.x = 0; xbar.st = bst;
    if (a.ph_hi - a.ph_lo > 1) xbar = xcd_barrier_post((unsigned*)(a.ws + WS_BAR), bst);
    const int lo = a.ph_lo, hi = a.ph_hi, G = gridDim.x, bx = blockIdx.x;
#ifndef PHMASK
#define PHMASK 0x1fff
#endif
#ifndef REPMASK
#define REPMASK 0
#endif
#define IN(k) (((PHMASK >> (k)) & 1) && lo <= (k) && (k) < hi)
#define REP(k)
#define SEAM(k) do { if (IN(k) && IN((k) + 1)) xcd_barrier(xbar); } while (0)
    if (a.ph_lo < 0) grid.sync();
    unsigned char* ws = a.ws;
    REP(0) if (IN(0)) phase_p0(a, lds, tid, wave, lane);
    SEAM(0);
    REP(1) if (IN(1)) {
        p1_meta(a, lds, tid, wave, lane);
        pg8::Gemm g{(const bf16_t*)(ws + WS_XN1), (const bf16_t*)(ws + WS_WINT), T, DIN, 1024}; pg8::StaticOrder S; S.init(T, DIN, G, bx);
        EpiProj E{(bf16_t*)(ws + WS_HYIN), (bf16_t*)(ws + WS_RGX), (bf16_t*)(ws + WS_GG), (bf16_t*)(ws + WS_GA), (bf16_t*)(ws + WS_GB), a.in[I_BGATE]};
        pg8::gemm_phase<EpiProj, pg8::StaticOrder>(lds, g, S, E, nullptr);
    }
    SEAM(1);
    REP(2) if (IN(2)) phase_hy_pre(a, lds, tid);
    SEAM(2);
    REP(3) if (IN(3)) {
#if CONV_NAIVE
        phase_hy_conv_naive(a, lds, tid);
#else
        if (G >= 256) { if (bx >= 128) for (int c = bx - 128; c < DHY; c += G - 128) hy_conv_channel(a, lds, c, tid, wave, lane); }
        else for (int c = bx; c < DHY; c += G) hy_conv_channel(a, lds, c, tid, wave, lane);
#endif
#if RG_NAIVE
        phase_rg_naive(a, lds, tid);
#else
        for (int it = bx; it < NB * 2 * 8; it += G) rg_item(a, lds, it, tid, wave, lane);
#endif
    }
    SEAM(3);
    REP(4) if (IN(4)) phase_post(a, lds, tid);
    SEAM(4);
    REP(5) if (IN(5)) {
        { pg8::Gemm g{(const bf16_t*)(ws + WS_YH), (const bf16_t*)(ws + WS_WHT), T, 1024, 512}; pg8::StaticOrder S; S.init(T, 1024, G, bx);
          EpiGate<0> E{(const bf16_t*)(ws + WS_GA), nullptr, (bf16_t*)(ws + WS_TMP)};
          pg8::gemm_phase<EpiGate<0>, pg8::StaticOrder>(lds, g, S, E, nullptr); }
        { pg8::Gemm g{(const bf16_t*)(ws + WS_YR), (const bf16_t*)(ws + WS_WRT), T, 1024, 1024}; pg8::StaticOrder S; S.init(T, 1024, G, bx);
          EpiGate<1> E{(const bf16_t*)(ws + WS_GB), (const bf16_t*)(ws + WS_TMP), (bf16_t*)(ws + WS_MERGED)};
          pg8::gemm_phase<EpiGate<1>, pg8::StaticOrder>(lds, g, S, E, nullptr); }
    }
    SEAM(5);
    REP(6) if (IN(6)) {
        pg8::Gemm g{(const bf16_t*)(ws + WS_MERGED), (const bf16_t*)(ws + WS_WOT), T, 1024, 1024}; pg8::StaticOrder S; S.init(T, 1024, G, bx);
        EpiResid E{a.in[I_X], (bf16_t*)(ws + WS_H1B), (float*)(ws + WS_ROWSS)};
        pg8::gemm_phase<EpiResid, pg8::StaticOrder>(lds, g, S, E, nullptr);
    }
    SEAM(6);
    REP(7) if (IN(7)) {
        phase_tables(a, wave, lane);
        pg8::Gemm g{(const bf16_t*)(ws + WS_H1B), (const bf16_t*)(ws + WS_WST), T, 2048, 1024}; pg8::StaticOrder S; S.init(T, 2048, G, bx);
        EpiScores E{(const float*)(ws + WS_ROWSS), (_Float16*)(ws + WS_SCORES)};
        pg8::gemm_phase<EpiScores, pg8::StaticOrder>(lds, g, S, E, nullptr);
    }
    SEAM(7);
    REP(8) if (IN(8)) phase_topk(a, lds, wave, lane);
    SEAM(8);
    REP(9) if (IN(9)) phase_peer_u(a, wave, lane);
    SEAM(9);
    if (IN(10)) phase_peer_act(a, tid);
    SEAM(10);
    if (IN(11)) phase_peer_v(a, wave, lane);
    SEAM(11);
    if (IN(12)) phase_final(a, wave, lane);
#undef IN
#undef SEAM
}

extern "C" void kernel_launch(void* const* d_in, const int* in_sizes, int n_in, void* d_out, int out_size, void* d_ws, size_t ws_size, hipStream_t stream) {
    static int grid = 0;
    if (grid == 0) {
        if (n_in != N_IN || out_size != T * DM || ws_size < WS_END) { fprintf(stderr, "kernel_launch: unexpected shapes (n_in %d out %d ws %zu)\n", n_in, out_size, ws_size); grid = -1; return; }
        if (hipFuncSetAttribute((const void*)mega, hipFuncAttributeMaxDynamicSharedMemorySize, LDS_BYTES) != hipSuccess) { fprintf(stderr, "kernel_launch: hipFuncSetAttribute failed\n"); grid = -1; return; }
        int dev = 0, cus = 0, per_cu = 0;
        hipGetDevice(&dev); hipDeviceGetAttribute(&cus, hipDeviceAttributeMultiprocessorCount, dev);
        hipOccupancyMaxActiveBlocksPerMultiprocessor(&per_cu, (const void*)mega, NTHR, LDS_BYTES);
        if (per_cu < 1) { fprintf(stderr, "kernel_launch: occupancy query says %d blocks per CU\n", per_cu); per_cu = 1; }
        (void)hipGetLastError();
        grid = cus;
    }
    if (grid < 0) return;
    Args a{};
    for (int i = 0; i < N_IN; ++i) a.in[i] = (const float*)d_in[i];
    a.out = (float*)d_out; a.ws = (unsigned char*)d_ws;
#if ONE_LAUNCH
    if (hipMemsetAsync((char*)d_ws + WS_BAR, 0, XCD_BAR_WORDS * 4, stream) != hipSuccess) { fprintf(stderr, "kernel_launch: memset of the barrier words failed\n"); return; }
    a.ph_lo = 0; a.ph_hi = NPHASE;
    void* args[] = {&a};
    hipError_t e = hipLaunchCooperativeKernel((const void*)mega, dim3(grid), dim3(NTHR), args, LDS_BYTES, stream);
    if (e != hipSuccess) fprintf(stderr, "cooperative launch failed: %s (grid %d)\n", hipGetErrorString(e), grid);
#else
    for (int ph = 0; ph < NPHASE; ++ph) for (int rep = 0; rep < 1 + ((REPMASK >> ph) & 1); ++rep) { a.ph_lo = ph; a.ph_hi = ph + 1;
        hipLaunchKernelGGL(mega, dim3(grid), dim3(NTHR), LDS_BYTES, stream, a);
        hipError_t e = hipPeekAtLastError(); if (e != hipSuccess) { fprintf(stderr, "launch %d failed: %s\n", ph, hipGetErrorString(e)); break; } }
#endif
}
```

```cpp
#define ONE_LAUNCH 1
#include <hip/hip_runtime.h>
#include <hip/hip_cooperative_groups.h>
#include <cstdio>
#include <cstdint>
#include <cmath>
namespace cg = cooperative_groups;
namespace pg8 {
#define PG8_LAS __attribute__((address_space(3)))
typedef unsigned short bf16_t;
typedef short bf16x8 __attribute__((ext_vector_type(8)));
typedef float f32x4 __attribute__((ext_vector_type(4)));
typedef unsigned u32x4 __attribute__((ext_vector_type(4)));
constexpr int BM = 256, BK = 64, HALF = 128, HTB = HALF * BK * 2  , STAGE_BYTES = 8 * HTB, NXCD = 8, WGM = 8;

__host__ __device__ __forceinline__ int lds_byte(int r, int c) { const int st = (r >> 4) * 2 + (c >> 5), rr = r & 15, cc = c & 31, ob = rr * 64 + cc * 2; return st * 1024 + (ob ^ (((ob >> 9) & 1) << 5)); }
__host__ __device__ __forceinline__ void stage_rc(int b, int& R, int& C) { const int st = b / 1024, sb = b % 1024, swz = sb ^ (((sb >> 9) & 1) << 5); R = (st >> 1) * 16 + swz / 64; C = (st & 1) * 32 + (swz % 64) / 2; }
__host__ __device__ __forceinline__ int perm32(int rho) { const int n = rho >> 4, i = rho & 15; return 8 * (i >> 2) + 4 * n + (i & 3); }

struct Unit { int pm, pn; };
struct Gemm { const bf16_t* A; const bf16_t* Bt; int M, N, K; };

struct StaticOrder {
    int nM, nN, nwg, G, c;
    __host__ __device__ void init(int M, int N, int G_, int c_) { nM = M / BM; nN = N / BM; nwg = nM * nN; G = G_; c = c_; }
    __host__ __device__ bool next(int i, Unit& u) const {
        const long L = (long)i * G + c; if (L >= nwg) return false;
        int wgid = (int)L; { const int q = nwg / NXCD, r = nwg % NXCD, xcd = wgid % NXCD, off = wgid / NXCD; wgid = (xcd < r ? xcd * (q + 1) : r * (q + 1) + (xcd - r) * q) + off; }
        const int nig = WGM * nN, gid = wgid / nig, fm = gid * WGM, gsz = (nM - fm) < WGM ? (nM - fm) : WGM;
        u.pm = fm + ((wgid % nig) % gsz); u.pn = (wgid % nig) / gsz; return true;
    }
    __device__ __forceinline__ void a_ready(const Unit&) const {}
    __device__ __forceinline__ void done(const Unit&) const {}
};
__device__ __forceinline__ unsigned cvt_pk_bf16(float lo, float hi) { unsigned r; asm volatile("v_cvt_pk_bf16_f32 %0, %1, %2" : "=v"(r) : "v"(lo), "v"(hi)); return r; }
typedef float f32x2 __attribute__((ext_vector_type(2)));
__device__ __forceinline__ f32x2 gelu_pk(f32x2 v) {
    const f32x2 av = __builtin_elementwise_abs(v), d = av * 0.2316418882f + 1.0f;
    f32x2 t; t.x = __builtin_amdgcn_rcpf(d.x); t.y = __builtin_amdgcn_rcpf(d.y);
    f32x2 q = t * 0.5307027145f + (-0.7265760135f); q = q * t + 0.7107068705f; q = q * t + (-0.142248368f); q = q * t + 0.127414796f; q = q * t;
    const f32x2 s = (v * v) * (-0.72134752044f);
    f32x2 e; e.x = __builtin_amdgcn_exp2f(s.x); e.y = __builtin_amdgcn_exp2f(s.y);
    const f32x2 m = v * (q * e), r = v - m;
    f32x2 o; o.x = v.x < 0.f ? m.x : r.x; o.y = v.y < 0.f ? m.y : r.y; return o;
}
template <class Epi, class Sched, bool STAMP = false>
__device__ __forceinline__ void gemm_phase(PG8_LAS unsigned char* lds, const Gemm g, const Sched& S, const Epi& E, unsigned long long* stamps) {
    const int tid = threadIdx.x, wid = __builtin_amdgcn_readfirstlane(tid >> 6), lane = tid & 63, wr = wid >> 2, wc = wid & 3, fr = lane & 15, fq = lane >> 4;
    const int K = g.K, nt = K / BK;
    int ts_lo = 0, ts_hi = 0, nts = 0; const unsigned long long rt_entry = STAMP ? (unsigned long long)wall_clock64() : 0ull;
#define PG8_STAMP() do { if (STAMP && wid == 0 && nts < 64) { const unsigned long long _c = (unsigned long long)clock64(); \
        ts_lo = (lane == nts) ? (int)(unsigned)_c : ts_lo; ts_hi = (lane == nts) ? (int)(unsigned)(_c >> 32) : ts_hi; ++nts; } } while (0)
    PG8_STAMP();
    unsigned voffA[2], voffB[2];
#pragma unroll
    for (int i = 0; i < 2; ++i) { int R, C; stage_rc(tid * 16 + i * 8192, R, C); const int Rb = Epi::PERM ? ((R & ~31) + perm32(R & 31)) : R;
        voffA[i] = (unsigned)(R * K + C) * 2u; voffB[i] = (unsigned)(Rb * K + C) * 2u; }
    const size_t kstep = (size_t)(BK * 2);
    const size_t hstep = (size_t)HALF * K * 2;
    const size_t tstep = 2 * hstep;
    const unsigned ldsw = (unsigned)wid * 1024u;
    const int aoff = lds_byte(wr * 64 + fr, fq * 8), boff = lds_byte(wc * 32 + fr, fq * 8);
#define PG8_SA(b, h) (((b) * 2 + (h)) * HTB)
#define PG8_SB(b, h) ((4 + (b) * 2 + (h)) * HTB)
#define PG8_STAGE(bufoff, gbase, voff) do { _Pragma("unroll") for (int _i = 0; _i < 2; ++_i) \
        __builtin_amdgcn_global_load_lds((const unsigned*)((const char*)(gbase) + (voff)[_i]), (PG8_LAS unsigned*)(lds + (bufoff) + ldsw + _i * 8192), 16, 0, 0); } while (0)
#define PG8_LDA(dst, b, h) do { _Pragma("unroll") for (int m = 0; m < 4; ++m) _Pragma("unroll") for (int k = 0; k < 2; ++k) dst[m][k] = *(const PG8_LAS bf16x8*)(lds + PG8_SA(b, h) + aoff + m * 2048 + k * 1024); } while (0)
#define PG8_LDB(dst, b, h) do { _Pragma("unroll") for (int n = 0; n < 2; ++n) _Pragma("unroll") for (int k = 0; k < 2; ++k) dst[n][k] = *(const PG8_LAS bf16x8*)(lds + PG8_SB(b, h) + boff + n * 2048 + k * 1024); } while (0)
#define PG8_MMA(ai, bj, At, Bt) do { __builtin_amdgcn_s_setprio(1); _Pragma("unroll") for (int m = 0; m < 4; ++m) _Pragma("unroll") for (int n = 0; n < 2; ++n) _Pragma("unroll") for (int k = 0; k < 2; ++k) \
        acc[ai][bj][m][n] = __builtin_amdgcn_mfma_f32_16x16x32_bf16(Bt[n][k], At[m][k], acc[ai][bj][m][n], 0, 0, 0); __builtin_amdgcn_s_setprio(0); } while (0)
#define PG8_WAIT_V(n) asm volatile("s_waitcnt vmcnt(" #n ")" ::: "memory")
#define PG8_WAIT_L(n) asm volatile("s_waitcnt lgkmcnt(" #n ")" ::: "memory")
#define PG8_BAR __builtin_amdgcn_s_barrier()
#define PG8_SCHED __builtin_amdgcn_sched_barrier(0)
    Unit cur, nxt; int ui = 0;
    if (!S.next(0, cur)) return;
    f32x4 acc[2][2][4][2];
#pragma unroll
    for (int a = 0; a < 2; ++a)
#pragma unroll
        for (int b = 0; b < 2; ++b)
#pragma unroll
            for (int m = 0; m < 4; ++m)
#pragma unroll
                for (int n = 0; n < 2; ++n) acc[a][b][m][n] = (f32x4){0.f, 0.f, 0.f, 0.f};
    bf16x8 At[4][2], B0[2][2], B1[2][2];
    const char* cA = (const char*)g.A + (size_t)cur.pm * tstep; const char* cB = (const char*)g.Bt + (size_t)cur.pn * tstep;
    S.a_ready(cur);
    PG8_STAGE(PG8_SB(0, 0), cB, voffB); PG8_STAGE(PG8_SA(0, 0), cA, voffA); PG8_STAGE(PG8_SB(0, 1), cB + hstep, voffB); PG8_STAGE(PG8_SA(0, 1), cA + hstep, voffA);
    if (wr == 1) PG8_BAR;
    PG8_WAIT_V(4); PG8_BAR;
    PG8_STAGE(PG8_SB(1, 0), cB + kstep, voffB); PG8_STAGE(PG8_SA(1, 0), cA + kstep, voffA); PG8_STAGE(PG8_SB(1, 1), cB + hstep + kstep, voffB);
    PG8_WAIT_V(6); PG8_BAR;
    PG8_STAMP();
    for (;;) {
        const bool has_next = S.next(ui + 1, nxt);
        const char* nA = has_next ? (const char*)g.A + (size_t)nxt.pm * tstep : cA; const char* nB = has_next ? (const char*)g.Bt + (size_t)nxt.pn * tstep : cB;
        for (int t = 0; t < nt; t += 2) {
            const bool last = (t == nt - 2);
            const char* a1 = cA + (size_t)(t + 1) * kstep;
            const char* a2 = last ? nA : cA + (size_t)(t + 2) * kstep; const char* b2 = last ? nB : cB + (size_t)(t + 2) * kstep;
            const char* a3 = a2 + kstep; const char* b3 = b2 + kstep;
            if (last && has_next) S.a_ready(nxt);
            PG8_LDB(B0, 0, 0); PG8_SCHED; PG8_LDA(At, 0, 0); PG8_STAGE(PG8_SA(1, 1), a1 + hstep, voffA);
            PG8_WAIT_L(8); PG8_BAR; PG8_WAIT_L(0); PG8_MMA(0, 0, At, B0); PG8_BAR; PG8_SCHED;
            PG8_LDB(B1, 0, 1); PG8_STAGE(PG8_SB(0, 0), b2, voffB);
            PG8_BAR; PG8_WAIT_L(0); PG8_MMA(0, 1, At, B1); PG8_BAR;
            PG8_LDA(At, 0, 1); PG8_STAGE(PG8_SA(0, 0), a2, voffA);
            PG8_BAR; PG8_WAIT_L(0); PG8_MMA(1, 0, At, B0); PG8_BAR; PG8_SCHED;
            PG8_STAGE(PG8_SB(0, 1), b2 + hstep, voffB);
            PG8_WAIT_V(6); PG8_BAR; PG8_MMA(1, 1, At, B1); PG8_BAR;
            PG8_LDB(B0, 1, 0); PG8_SCHED; PG8_LDA(At, 1, 0); PG8_STAGE(PG8_SA(0, 1), a2 + hstep, voffA);
            PG8_WAIT_L(8); PG8_BAR; PG8_WAIT_L(0); PG8_MMA(0, 0, At, B0); PG8_BAR; PG8_SCHED;
            PG8_LDB(B1, 1, 1); PG8_STAGE(PG8_SB(1, 0), b3, voffB);
            PG8_BAR; PG8_WAIT_L(0); PG8_MMA(0, 1, At, B1); PG8_BAR;
            PG8_LDA(At, 1, 1); PG8_STAGE(PG8_SA(1, 0), a3, voffA);
            PG8_BAR; PG8_WAIT_L(0); PG8_MMA(1, 0, At, B0); PG8_BAR; PG8_SCHED;
            PG8_STAGE(PG8_SB(1, 1), b3 + hstep, voffB);
            PG8_WAIT_V(6); PG8_BAR; PG8_MMA(1, 1, At, B1); PG8_BAR;
        }
        PG8_STAMP();
        if constexpr (!Epi::AFTER_DRAIN) { E(acc, cur, wr, wc, fr, fq); S.done(cur); }
        PG8_STAMP();
        if (!has_next) break;
#pragma unroll
        for (int a = 0; a < 2; ++a)
#pragma unroll
            for (int b = 0; b < 2; ++b)
#pragma unroll
                for (int m = 0; m < 4; ++m)
#pragma unroll
                    for (int n = 0; n < 2; ++n) acc[a][b][m][n] = (f32x4){0.f, 0.f, 0.f, 0.f};
        cur = nxt; cA = nA; cB = nB; ++ui;
    }
    PG8_WAIT_V(0);
    if (wr == 0) PG8_BAR;
    PG8_BAR;
    if constexpr (Epi::AFTER_DRAIN) { E.fused(acc, cur, wr, wc, fr, fq, lds, wid, lane); S.done(cur); }
    PG8_STAMP();
    if (STAMP && wid == 0) { stamps[lane] = lane < nts ? (((unsigned long long)(unsigned)ts_hi << 32) | (unsigned)ts_lo) : 0ull;
        if (lane == 62) stamps[62] = rt_entry; if (lane == 63) stamps[63] = (unsigned long long)wall_clock64(); }
#undef PG8_STAMP
#undef PG8_SA
#undef PG8_SB
#undef PG8_STAGE
#undef PG8_LDA
#undef PG8_LDB
#undef PG8_MMA
#undef PG8_WAIT_V
#undef PG8_WAIT_L
#undef PG8_BAR
#undef PG8_SCHED
}
}

#define LAS __attribute__((address_space(3)))
typedef unsigned short bf16_t;
typedef float f32x4 __attribute__((ext_vector_type(4)));
typedef float f32x2 __attribute__((ext_vector_type(2)));
typedef unsigned u32x4 __attribute__((ext_vector_type(4)));
typedef unsigned u32x2 __attribute__((ext_vector_type(2)));

constexpr int NB = 8, SEQ = 4096, NMETA = 16, LT = SEQ + NMETA, DM = 1024, T = NB * SEQ;
constexpr int DHY = 512, DRG = 1024, DIN = 3 * DHY + 2 * DRG + 2 * DM;
constexpr int NTHR = 512, NWAVES = 8;
constexpr int LDS_BYTES = 160 * 1024;
constexpr float EPSF = 1e-6f;
constexpr int KFW = 2 * LT;
constexpr int SP = 4256;
constexpr int NEXP = 16384;

enum { I_X = 0, I_META, I_GFINAL, I_GMIX, I_WIN, I_BGATE, I_HYCW, I_HYCB, I_HYW1, I_HYB1, I_HYW2, I_HYB2, I_HYW3, I_HYB3, I_HYFREQ, I_HYSKIP,
       I_HYOUT, I_RGCW, I_RGCB, I_RGGW, I_RGGB, I_RGLAM, I_RGOUT, I_WOUT, I_GFFN, I_WQ, I_KEYS, I_PU, I_PV, N_IN };

constexpr size_t MiB = 1024ull * 1024ull;
constexpr size_t WS_ROWSS = 64 * 1024;
constexpr size_t WS_SU = 256 * 1024;
constexpr size_t WS_SV = 320 * 1024;
constexpr size_t WS_ROWSS2 = 384 * 1024;
constexpr size_t WS_BAR = 512 * 1024;
constexpr size_t WS_WINT = 1 * MiB;
constexpr size_t WS_WHT = 12 * MiB;
constexpr size_t WS_WRT = 13 * MiB;
constexpr size_t WS_WOT = 15 * MiB;
constexpr size_t WS_WST = 17 * MiB;
constexpr size_t WS_GWT = 21 * MiB;
constexpr size_t WS_KF = 22 * MiB;
constexpr size_t WS_KFB = 39 * MiB;
constexpr size_t WS_HYIN = 48 * MiB;
constexpr size_t WS_RGX = 145 * MiB;
constexpr size_t WS_GG = 210 * MiB;
constexpr size_t WS_GA = 274 * MiB;
constexpr size_t WS_GB = 338 * MiB;
constexpr size_t WS_XN1 = 402 * MiB;
constexpr size_t WS_UUT = 402 * MiB;
constexpr size_t WS_CONVT = 436 * MiB;
constexpr size_t WS_YH = 468 * MiB;
constexpr size_t WS_YR = WS_RGX;
constexpr size_t WS_MERGED = WS_HYIN;
constexpr size_t WS_TMP = WS_GG;
constexpr size_t WS_H1B = WS_RGX;
constexpr size_t WS_SCORES = WS_GG;
constexpr size_t WS_EIDX = 468 * MiB;
constexpr size_t WS_EG = 484 * MiB;
constexpr size_t WS_UB = 48 * MiB;
constexpr size_t WS_VB = 64 * MiB;
constexpr size_t WS_PD = 210 * MiB;
constexpr size_t WS_PO = WS_PD;
constexpr size_t WS_ACT = 338 * MiB;
constexpr size_t WS_END = 500 * MiB;

struct Args { const float* in[N_IN]; float* out; unsigned char* ws; int ph_lo, ph_hi; };

__device__ __forceinline__ float bf2f(unsigned v) { return __uint_as_float(v << 16); }
typedef __bf16 bf16x2_t __attribute__((ext_vector_type(2)));
__device__ __forceinline__ unsigned pk2(float lo, float hi) { bf16x2_t v; v.x = (__bf16)lo; v.y = (__bf16)hi; return __builtin_bit_cast(unsigned, v); }
__device__ __forceinline__ unsigned f2bf(float f) { return pk2(f, f) & 0xffffu; }
__device__ __forceinline__ float bflo(unsigned w) { return __uint_as_float(w << 16); }
__device__ __forceinline__ float bfhi(unsigned w) { return __uint_as_float(w & 0xffff0000u); }
__device__ __forceinline__ float wave_sum(float v) {
#pragma unroll
    for (int o = 1; o < 64; o <<= 1) v += __shfl_xor(v, o);
    return v;
}
__device__ __forceinline__ float wave_max(float v) {
#pragma unroll
    for (int o = 1; o < 64; o <<= 1) v = fmaxf(v, __shfl_xor(v, o));
    return v;
}
__device__ __forceinline__ float fexp(float x) { return __builtin_amdgcn_exp2f(x * 1.4426950408889634f); }
__device__ __forceinline__ float sigmoidf_(float x) { return __builtin_amdgcn_rcpf(1.0f + fexp(-x)); }
__device__ __forceinline__ float gelu_tanh(float x) { const float u = 1.5957691216f * (x + 0.044715f * x * x * x); return x * __builtin_amdgcn_rcpf(1.0f + fexp(-u)); }
__device__ __forceinline__ void sincos_acc(float a, float& s, float& c) {
    const double x = (double)a;
    const double q = rint(x * 0.63661977236758134308);
    const double r = fma(-q, 1.57079632679489661923, x);
    const int n = (int)q;
    const float rf = (float)r, r2 = rf * rf;
    const float sp = rf * (1.f + r2 * (-1.6666667e-1f + r2 * (8.3333333e-3f + r2 * (-1.9841270e-4f + r2 * 2.7557319e-6f))));
    const float cp = 1.f + r2 * (-0.5f + r2 * (4.1666667e-2f + r2 * (-1.3888889e-3f + r2 * (2.4801587e-5f + r2 * (-2.7557319e-7f)))));
    const int k = n & 3;
    s = (k == 0) ? sp : (k == 1) ? cp : (k == 2) ? -sp : -cp;
    c = (k == 0) ? cp : (k == 1) ? -sp : (k == 2) ? -cp : sp;
}

typedef float f32x2v __attribute__((ext_vector_type(2)));
__device__ __forceinline__ float wave_sum_dpp(float v) {
    v += __int_as_float(__builtin_amdgcn_update_dpp(0, __float_as_int(v), 0xB1, 0xF, 0xF, true));
    v += __int_as_float(__builtin_amdgcn_update_dpp(0, __float_as_int(v), 0x4E, 0xF, 0xF, true));
    v += __int_as_float(__builtin_amdgcn_update_dpp(0, __float_as_int(v), 0x141, 0xF, 0xF, true));
    v += __int_as_float(__builtin_amdgcn_update_dpp(0, __float_as_int(v), 0x140, 0xF, 0xF, true));
    const int vi = __float_as_int(v);
    return (__int_as_float(__builtin_amdgcn_readlane(vi, 0)) + __int_as_float(__builtin_amdgcn_readlane(vi, 16))) + (__int_as_float(__builtin_amdgcn_readlane(vi, 32)) + __int_as_float(__builtin_amdgcn_readlane(vi, 48)));
}
__device__ __forceinline__ float wave_max_dpp(float v) {
    v = fmaxf(v, __int_as_float(__builtin_amdgcn_update_dpp(0, __float_as_int(v), 0xB1, 0xF, 0xF, true)));
    v = fmaxf(v, __int_as_float(__builtin_amdgcn_update_dpp(0, __float_as_int(v), 0x4E, 0xF, 0xF, true)));
    v = fmaxf(v, __int_as_float(__builtin_amdgcn_update_dpp(0, __float_as_int(v), 0x141, 0xF, 0xF, true)));
    v = fmaxf(v, __int_as_float(__builtin_amdgcn_update_dpp(0, __float_as_int(v), 0x140, 0xF, 0xF, true)));
    const int vi = __float_as_int(v);
    return fmaxf(fmaxf(__int_as_float(__builtin_amdgcn_readlane(vi, 0)), __int_as_float(__builtin_amdgcn_readlane(vi, 16))), fmaxf(__int_as_float(__builtin_amdgcn_readlane(vi, 32)), __int_as_float(__builtin_amdgcn_readlane(vi, 48))));
}

#ifndef SLICE_PROBE
#define SLICE_OF(b) ((b) & 7)
#define RANK_OF(b) ((b) >> 3)
#else
#define SLICE_OF(b) ((b) >> 5)
#define RANK_OF(b) ((b) & 31)
#endif
#define XB_TMO      128
#define XB_XCNT(j)  (256  + 64 * (j))
#define XB_XSUB(j)  (1280 + 64 * (j))
#define XB_XGEN(j)  (2304 + 64 * (j))
#define XB_TOP      3328
#define XB_TOPGEN   3392
#define XCD_BAR_WORDS 3456
#define XB_SPIN_CAP (1u << 18)

__device__ __forceinline__ unsigned xb_ld(unsigned* p)              { return __hip_atomic_load(p, __ATOMIC_RELAXED, __HIP_MEMORY_SCOPE_AGENT); }
__device__ __forceinline__ unsigned xb_add(unsigned* p, unsigned v) { return __hip_atomic_fetch_add(p, v, __ATOMIC_RELAXED, __HIP_MEMORY_SCOPE_AGENT); }
__device__ __forceinline__ unsigned xb_xcc_id() { return (unsigned)__builtin_amdgcn_s_getreg((3 << 11) | 20) & 0xFu; }
#define XB_SPIN(cond, bar) do { unsigned _sp = 0; while (cond) { __builtin_amdgcn_s_sleep(1); \
    if ((++_sp & 255u) == 0u) { if (xb_ld(&(bar)[XB_TMO])) break; if (_sp > XB_SPIN_CAP) { atomicAdd(&(bar)[XB_TMO], 1u); break; } } } } while (0)

struct XcdBarrier {
    unsigned* bar; unsigned x;
    volatile LAS unsigned* st;
};

__device__ __forceinline__ XcdBarrier xcd_barrier_post(unsigned* bar, volatile LAS unsigned* st) {
    XcdBarrier b; b.bar = bar; b.x = xb_xcc_id(); b.st = st;
    if (threadIdx.x == 0) (void)xb_add(&bar[XB_XCNT(b.x)], 1u);
    return b;
}
__device__ __forceinline__ void xcd_barrier_complete(unsigned* bar, unsigned x, unsigned& nloc, unsigned& nx) {
    const unsigned G = gridDim.x * gridDim.y * gridDim.z;
    unsigned sum, cnt, mine, sp = 0u;
    for (;;) {
        sum = 0u; cnt = 0u; mine = 0u;
#pragma unroll
        for (unsigned j = 0; j < 16; ++j) { const unsigned c = xb_ld(&bar[XB_XCNT(j)]); sum += c; cnt += (c > 0u) ? 1u : 0u; mine = (j == x) ? c : mine; }
        if (sum == G) break;
        __builtin_amdgcn_s_sleep(1);
        if ((++sp & 255u) == 0u) { if (xb_ld(&bar[XB_TMO])) break; if (sp > XB_SPIN_CAP) { atomicAdd(&bar[XB_TMO], 1u); break; } }
    }
    nloc = mine > 0u ? mine : 1u; nx = cnt > 0u ? cnt : 1u;
}

__device__ __forceinline__ void xcd_barrier(const XcdBarrier& b) {
    asm volatile("s_waitcnt vmcnt(0)" ::: "memory");
    __syncthreads();
    if (threadIdx.x == 0) {
        unsigned* bar = b.bar;
        __builtin_amdgcn_s_waitcnt(0);
        unsigned nloc = b.st[0], nx = b.st[1];
        if (nloc == 0u) { xcd_barrier_complete(bar, b.x, nloc, nx); b.st[0] = nloc; b.st[1] = nx; }
        const unsigned old = xb_add(&bar[XB_XSUB(b.x)], 1u);
        const unsigned gen = old / nloc;
        if (old + 1u == (gen + 1u) * nloc) {
            __builtin_amdgcn_fence(__ATOMIC_RELEASE, "agent");
            asm volatile("s_waitcnt vmcnt(0)" ::: "memory");
            const unsigned og = xb_add(&bar[XB_TOP], 1u);
            const unsigned tg = og / nx;
            if (og + 1u == (tg + 1u) * nx) xb_add(&bar[XB_TOPGEN], 1u);
            else XB_SPIN(xb_ld(&bar[XB_TOPGEN]) == tg, bar);
            __builtin_amdgcn_fence(__ATOMIC_ACQUIRE, "agent");
            xb_add(&bar[XB_XGEN(b.x)], 1u);
            asm volatile("s_waitcnt vmcnt(0)" ::: "memory");
        } else {
            XB_SPIN(xb_ld(&bar[XB_XGEN(b.x)]) == gen, bar);
            __builtin_amdgcn_fence(__ATOMIC_ACQUIRE, "agent");
            asm volatile("s_waitcnt vmcnt(0)" ::: "memory");
        }
    }
    __syncthreads();
}

__device__ __forceinline__ void p0_transpose_item(const float* W, int K, int N, bf16_t* WT, LAS float* scr, int item, int lane) {
    const int nblk = N / 32, kb = item / nblk, nb = item % nblk, k0 = 64 * kb, n0 = 32 * nb;
#pragma unroll 8
    for (int i = 0; i < 32; ++i) { const int kk = 2 * i + (lane >> 5); scr[kk * 33 + (lane & 31)] = W[(size_t)(k0 + kk) * N + n0 + (lane & 31)]; }
    asm volatile("s_waitcnt lgkmcnt(0)" ::: "memory");
    const int c = lane & 7;
#pragma unroll
    for (int j = 0; j < 4; ++j) { const int n = (lane >> 3) + 8 * j; const LAS float* s = scr + (8 * c) * 33 + n;
        u32x4 o; o.x = pk2(s[0 * 33], s[1 * 33]); o.y = pk2(s[2 * 33], s[3 * 33]); o.z = pk2(s[4 * 33], s[5 * 33]); o.w = pk2(s[6 * 33], s[7 * 33]);
        *(u32x4*)(WT + (size_t)(n0 + n) * K + k0 + 8 * c) = o; }
    asm volatile("s_waitcnt lgkmcnt(0)" ::: "memory");
}
__device__ __forceinline__ void p0_xn1_row(const float* xrow, const float* g, bf16_t* orow, int lane) {
    const f32x4* xr = (const f32x4*)xrow + lane; const f32x4* gr = (const f32x4*)g + lane;
    f32x4 v[4]; float s = 0.f;
#pragma unroll
    for (int j = 0; j < 4; ++j) { v[j] = xr[64 * j]; s += (v[j].x * v[j].x + v[j].y * v[j].y) + (v[j].z * v[j].z + v[j].w * v[j].w); }
    const float rstd = rsqrtf(wave_sum(s) * (1.f / DM) + EPSF);
    unsigned long long* o8 = (unsigned long long*)orow + lane;
#pragma unroll
    for (int j = 0; j < 4; ++j) { const f32x4 gv = gr[64 * j];
        o8[64 * j] = (unsigned long long)pk2(v[j].x * rstd * gv.x, v[j].y * rstd * gv.y) | ((unsigned long long)pk2(v[j].z * rstd * gv.z, v[j].w * rstd * gv.w) << 32); }
}
__device__ __forceinline__ void p0_fold_item(const Args& a, LAS unsigned char* lds, int item, int tid) {
    const int hp = item >> 4, k0 = (item & 15) * 64;
    LAS float* kl = (LAS float*)lds;
    LAS float* wl = (LAS float*)(lds + 128 * 129 * 4);
    const float* keys = a.in[I_KEYS] + (size_t)hp * 128 * 128; const float* wq = a.in[I_WQ];
    for (int i = tid; i < 128 * 128; i += NTHR) { const int key = i >> 7, d = i & 127; kl[key * 129 + d] = keys[i]; }
    for (int i = tid; i < 64 * 128; i += NTHR) { const int kk = i >> 7, d = i & 127; wl[i] = wq[(size_t)(k0 + kk) * 2048 + hp * 128 + d]; }
    __syncthreads();
    const int key = tid & 127, kq = tid >> 7;
    float acc[16];
#pragma unroll
    for (int i = 0; i < 16; ++i) acc[i] = 0.f;
#pragma unroll 2
    for (int d = 0; d < 128; ++d) { const float kv = kl[key * 129 + d];
#pragma unroll
        for (int i = 0; i < 16; ++i) acc[i] += wl[(kq * 16 + i) * 128 + d] * kv; }
    const float* gf = a.in[I_GFFN] + k0 + kq * 16;
    bf16_t* dst = (bf16_t*)(a.ws + WS_WST) + (size_t)(hp * 128 + key) * 1024 + k0 + kq * 16;
    u32x4 o0, o1;
    o0.x = pk2(acc[0] * gf[0], acc[1] * gf[1]); o0.y = pk2(acc[2] * gf[2], acc[3] * gf[3]); o0.z = pk2(acc[4] * gf[4], acc[5] * gf[5]); o0.w = pk2(acc[6] * gf[6], acc[7] * gf[7]);
    o1.x = pk2(acc[8] * gf[8], acc[9] * gf[9]); o1.y = pk2(acc[10] * gf[10], acc[11] * gf[11]); o1.z = pk2(acc[12] * gf[12], acc[13] * gf[13]); o1.w = pk2(acc[14] * gf[14], acc[15] * gf[15]);
    *(u32x4*)dst = o0; *(u32x4*)(dst + 8) = o1;
    __syncthreads();
}
__device__ __forceinline__ void p0_meta_item(const Args& a, LAS unsigned char* lds, int item, int tid, int wave, int lane) {
    LAS float* mt = (LAS float*)lds;
    for (int r = wave * 2; r < wave * 2 + 2; ++r) {
        const f32x4* xr = (const f32x4*)(a.in[I_META] + (size_t)r * DM) + lane; const f32x4* gr = (const f32x4*)a.in[I_GMIX] + lane;
        f32x4 v[4]; float s = 0.f;
#pragma unroll
        for (int j = 0; j < 4; ++j) { v[j] = xr[64 * j]; s += (v[j].x * v[j].x + v[j].y * v[j].y) + (v[j].z * v[j].z + v[j].w * v[j].w); }
        const float rstd = rsqrtf(wave_sum(s) * (1.f / DM) + EPSF);
#pragma unroll
        for (int j = 0; j < 4; ++j) { const f32x4 gv = gr[64 * j]; f32x4 o = v[j] * rstd * gv; *(LAS f32x4*)(mt + r * 1024 + 4 * (lane + 64 * j)) = o; }
    }
    __syncthreads();
    const int col = item * 256 + (tid & 255), rh = tid >> 8;
    float acc[8];
#pragma unroll
    for (int r = 0; r < 8; ++r) acc[r] = 0.f;
    const float* w = a.in[I_WIN] + col;
#pragma unroll 4
    for (int k = 0; k < 1024; ++k) { const float wv = w[(size_t)k * DIN];
#pragma unroll
        for (int r = 0; r < 8; ++r) acc[r] += mt[(rh * 8 + r) * 1024 + k] * wv; }
    bf16_t* hyin = (bf16_t*)(a.ws + WS_HYIN); bf16_t* rgx = (bf16_t*)(a.ws + WS_RGX);
#pragma unroll
    for (int r = 0; r < 8; ++r) { const int t = rh * 8 + r; const bf16_t v = (bf16_t)f2bf(acc[r]);
        for (int b = 0; b < NB; ++b) { if (col < 1536) hyin[((size_t)b * LT + t) * 1536 + col] = v; else rgx[((size_t)b * LT + t) * 1024 + (col - 1536)] = v; } }
    __syncthreads();
}
__device__ __forceinline__ void p0_filter_item(const Args& a, LAS unsigned char* lds, int item, int tid) {
    LAS float* z = (LAS float*)lds;
    LAS float* h1 = z + 16 * 33;
    LAS float* h2 = h1 + 16 * 64;
    LAS float* ko = h2 + 16 * 64;
    const int p0 = item * 16;
    for (int idx = tid; idx < 16 * 33; idx += NTHR) { const int pp = idx / 33, f = idx % 33, p = p0 + pp;
        float v;
        if (f == 0) v = (float)p * (1.0f / (float)(LT - 1));
        else { const int bi = (f - 1) & 15; const float band = 1e-4f + (float)bi * ((15.0f - 1e-4f) / 15.0f); const float w = (float)(6.283185307179586 / (double)LT) * (float)p;
            float s, c; sincos_acc(band * w, s, c); v = (f <= 16) ? c : -s; }
        z[idx] = v; }
    __syncthreads();
    const float* w1 = a.in[I_HYW1]; const float* b1 = a.in[I_HYB1]; const float* w2 = a.in[I_HYW2]; const float* b2 = a.in[I_HYB2];
    const float* w3 = a.in[I_HYW3]; const float* b3 = a.in[I_HYB3]; const float* fr = a.in[I_HYFREQ];
    for (int idx = tid; idx < 16 * 64; idx += NTHR) { const int pp = idx >> 6, j = idx & 63; float acc = b1[j];
#pragma unroll 3
        for (int f = 0; f < 33; ++f) acc += z[pp * 33 + f] * w1[f * 64 + j];
        float s, c; sincos_acc(fr[j] * acc, s, c); h1[idx] = s; }
    __syncthreads();
    for (int idx = tid; idx < 16 * 64; idx += NTHR) { const int pp = idx >> 6, j = idx & 63; float acc = b2[j];
#pragma unroll 4
        for (int f = 0; f < 64; ++f) acc += h1[pp * 64 + f] * w2[f * 64 + j];
        float s, c; sincos_acc(fr[64 + j] * acc, s, c); h2[idx] = s; }
    __syncthreads();
#pragma unroll 1
    for (int half = 0; half < 2; ++half) { const int o = half * 512 + tid;
        float acc[16];
#pragma unroll
        for (int pp = 0; pp < 16; ++pp) acc[pp] = b3[o];
#pragma unroll 2
        for (int i = 0; i < 64; ++i) { const float wv = w3[i * 1024 + o];
#pragma unroll
            for (int pp = 0; pp < 16; ++pp) acc[pp] += h2[pp * 64 + i] * wv; }
        const float delta = fabsf(-15.350567286626972f + (float)tid * ((-3.0701134573253945f + 15.350567286626972f) / 511.0f));
#pragma unroll
        for (int pp = 0; pp < 16; ++pp) { const float tn = (float)(p0 + pp) * (1.0f / (float)(LT - 1)); ko[o * 17 + pp] = acc[pp] * __expf(-tn * delta); }
    }
    __syncthreads();
    float* kf = (float*)(a.ws + WS_KF); bf16_t* kfb = (bf16_t*)(a.ws + WS_KFB);
    for (int idx = tid; idx < 1024 * 16; idx += NTHR) { const int o = idx >> 4, pp = idx & 15, dir = o >> 9, c = o & 511, p = p0 + pp;
        const float v = ko[o * 17 + pp];
        if (dir == 0) { kf[(size_t)c * KFW + (LT - 1) + p] = v; kfb[(size_t)c * KFW + (LT - 1) + p] = (bf16_t)f2bf(v); }
        else if (p >= 1) { kf[(size_t)c * KFW + (LT - 1) - p] = v; kfb[(size_t)c * KFW + (LT - 1) - p] = (bf16_t)f2bf(v); } }
    if (item == 0) for (int c = tid; c < 512; c += NTHR) { kf[(size_t)c * KFW + KFW - 1] = 0.f; kfb[(size_t)c * KFW + KFW - 1] = 0; }
    __syncthreads();
}
__device__ __forceinline__ void phase_p0(const Args& a, LAS unsigned char* lds, int tid, int wave, int lane) {
    const int G = gridDim.x, bx = blockIdx.x;
    { float* rs = (float*)(a.ws + WS_ROWSS); float* rs2 = (float*)(a.ws + WS_ROWSS2); for (int i = bx * NTHR + tid; i < T; i += G * NTHR) { rs[i] = 0.f; rs2[i] = 0.f; } }
    for (int it = bx; it < 256 + 257; it += G) {
#ifndef P0M
#define P0M 7
#endif
        if (it < 256) { if (P0M & 1) p0_fold_item(a, lds, it, tid); }
        else { if (P0M & 2) p0_filter_item(a, lds, it - 256, tid); }

    }
    LAS float* scr = (LAS float*)(lds + wave * 16384);
    const int gw = bx * NWAVES + wave, NGW = G * NWAVES;
    constexpr int I_IN = (1024 / 64) * (DIN / 32), I_H = (512 / 64) * (1024 / 32), I_R = (1024 / 64) * (1024 / 32), I_O = I_R;
    for (int it = gw; it < I_IN + I_H + I_R + I_O; it += NGW) {
        int r = it;
        if (r < I_IN) { p0_transpose_item(a.in[I_WIN], 1024, DIN, (bf16_t*)(a.ws + WS_WINT), scr, r, lane); continue; } r -= I_IN;
        if (r < I_H) { p0_transpose_item(a.in[I_HYOUT], 512, 1024, (bf16_t*)(a.ws + WS_WHT), scr, r, lane); continue; } r -= I_H;
        if (r < I_R) { p0_transpose_item(a.in[I_RGOUT], 1024, 1024, (bf16_t*)(a.ws + WS_WRT), scr, r, lane); continue; } r -= I_R;
        p0_transpose_item(a.in[I_WOUT], 1024, 1024, (bf16_t*)(a.ws + WS_WOT), scr, r, lane);
    }
    for (int m = gw; m < T; m += 2 * NGW) { p0_xn1_row(a.in[I_X] + (size_t)m * DM, a.in[I_GMIX], (bf16_t*)(a.ws + WS_XN1) + (size_t)m * DM, lane);
        if (m + NGW < T) p0_xn1_row(a.in[I_X] + (size_t)(m + NGW) * DM, a.in[I_GMIX], (bf16_t*)(a.ws + WS_XN1) + (size_t)(m + NGW) * DM, lane); }
}

__device__ __forceinline__ void p1_meta(const Args& a, LAS unsigned char* lds, int tid, int wave, int lane) {
    LAS float* mt = (LAS float*)lds;
    for (int r = wave * 2; r < wave * 2 + 2; ++r) {
        const f32x4* xr = (const f32x4*)(a.in[I_META] + (size_t)r * DM) + lane; const f32x4* gr = (const f32x4*)a.in[I_GMIX] + lane;
        f32x4 v[4]; float s = 0.f;
#pragma unroll
        for (int j = 0; j < 4; ++j) { v[j] = xr[64 * j]; s += (v[j].x * v[j].x + v[j].y * v[j].y) + (v[j].z * v[j].z + v[j].w * v[j].w); }
        const float rstd = rsqrtf(wave_sum(s) * (1.f / DM) + EPSF);
#pragma unroll
        for (int j = 0; j < 4; ++j) { const f32x4 gv = gr[64 * j]; f32x4 o = v[j] * rstd * gv; *(LAS f32x4*)(mt + r * 1024 + 4 * (lane + 64 * j)) = o; }
    }
    __syncthreads();
    const bf16_t* wint = (const bf16_t*)(a.ws + WS_WINT); bf16_t* hyin = (bf16_t*)(a.ws + WS_HYIN); bf16_t* rgx = (bf16_t*)(a.ws + WS_RGX);
    for (int cc = wave; cc < 10; cc += NWAVES) { const int n = blockIdx.x * 10 + cc; if (n >= 2560) break;
        float w[16]; { float t0[8], t1[8]; const bf16_t* wp = wint + (size_t)n * 1024; const u32x4 q0 = *(const u32x4*)(wp + 8 * lane), q1 = *(const u32x4*)(wp + 512 + 8 * lane);
            w[0] = bflo(q0.x); w[1] = bfhi(q0.x); w[2] = bflo(q0.y); w[3] = bfhi(q0.y); w[4] = bflo(q0.z); w[5] = bfhi(q0.z); w[6] = bflo(q0.w); w[7] = bfhi(q0.w);
            w[8] = bflo(q1.x); w[9] = bfhi(q1.x); w[10] = bflo(q1.y); w[11] = bfhi(q1.y); w[12] = bflo(q1.z); w[13] = bfhi(q1.z); w[14] = bflo(q1.w); w[15] = bfhi(q1.w); (void)t0; (void)t1; }
        float mine = 0.f;
#pragma unroll
        for (int r = 0; r < 16; ++r) { const LAS f32x4* mp = (const LAS f32x4*)(mt + r * 1024 + 8 * lane); const f32x4 m0 = mp[0], m1 = mp[1], m2 = mp[128], m3 = mp[129];
            float s = (w[0] * m0.x + w[1] * m0.y) + (w[2] * m0.z + w[3] * m0.w) + (w[4] * m1.x + w[5] * m1.y) + (w[6] * m1.z + w[7] * m1.w)
                    + (w[8] * m2.x + w[9] * m2.y) + (w[10] * m2.z + w[11] * m2.w) + (w[12] * m3.x + w[13] * m3.y) + (w[14] * m3.z + w[15] * m3.w);
            s = wave_sum_dpp(s); mine = ((lane & 15) == r) ? s : mine; }
        const bf16_t v = (bf16_t)f2bf(mine); const int t = lane & 15;
#pragma unroll
        for (int h = 0; h < 2; ++h) { const int b = (lane >> 4) + 4 * h;
            if (n < 1536) hyin[((size_t)b * LT + t) * 1536 + n] = v; else rgx[((size_t)b * LT + t) * 1024 + (n - 1536)] = v; }
    }
    __syncthreads();
}

typedef pg8::f32x4 pf4;
struct EpiProj {
    static constexpr bool PERM = true, AFTER_DRAIN = false;
    bf16_t *hyin, *rgx, *gg, *ga, *gb; const float* bgate;
    __device__ __forceinline__ void operator()(const pf4 (&acc)[2][2][4][2], const pg8::Unit& u, int wr, int wc, int fr, int fq) const {
        const int pn = u.pn, row0 = u.pm * 256 + wr * 64 + fr, cl0 = wc * 32 + 8 * fq;
#pragma unroll
        for (int ai = 0; ai < 2; ++ai)
#pragma unroll
            for (int m = 0; m < 4; ++m) { const int r = row0 + ai * 128 + m * 16; const size_t rl = (size_t)(r >> 12) * LT + NMETA + (r & 4095);
#pragma unroll
                for (int bj = 0; bj < 2; ++bj) { const int col = pn * 256 + bj * 128 + cl0; pf4 v0 = acc[ai][bj][m][0], v1 = acc[ai][bj][m][1]; bf16_t* dst;
                    if (pn < 6) dst = hyin + rl * 1536 + col;
                    else if (pn < 10) dst = rgx + rl * 1024 + (col - 1536);
                    else if (pn < 14) { dst = gg + (size_t)r * 1024 + (col - 2560);
#pragma unroll
                        for (int j = 0; j < 4; ++j) { v0[j] = gelu_tanh(v0[j]); v1[j] = gelu_tanh(v1[j]); } }
                    else { const int gc = col - 3584;
                        dst = (gc < 1024 ? ga + (size_t)r * 1024 + gc : gb + (size_t)r * 1024 + (gc - 1024));
                        const pf4 b0 = *(const pf4*)(bgate + gc), b1 = *(const pf4*)(bgate + gc + 4);
#pragma unroll
                        for (int j = 0; j < 4; ++j) { v0[j] = sigmoidf_(v0[j] + b0[j]); v1[j] = sigmoidf_(v1[j] + b1[j]); } }
                    u32x4 w; w.x = pk2(v0[0], v0[1]); w.y = pk2(v0[2], v0[3]); w.z = pk2(v1[0], v1[1]); w.w = pk2(v1[2], v1[3]);
                    *(u32x4*)dst = w; } }
    }
};
template <int MODE  > struct EpiGate {
    static constexpr bool PERM = true, AFTER_DRAIN = false;
    const bf16_t* gate; const bf16_t* tin; bf16_t* outp;
    __device__ __forceinline__ void operator()(const pf4 (&acc)[2][2][4][2], const pg8::Unit& u, int wr, int wc, int fr, int fq) const {
        const int row0 = u.pm * 256 + wr * 64 + fr, col0 = u.pn * 256 + wc * 32 + 8 * fq;
        u32x4 gq[2], tq[2];
#define EG_OFF(i) ((size_t)(row0 + ((i) >> 3) * 128 + (((i) >> 1) & 3) * 16) * 1024 + col0 + ((i) & 1) * 128)
        gq[0] = *(const u32x4*)(gate + EG_OFF(0)); if (MODE == 1) tq[0] = *(const u32x4*)(tin + EG_OFF(0));
#pragma unroll
        for (int i = 0; i < 16; ++i) { const int ai = i >> 3, m = (i >> 1) & 3, bj = i & 1; const size_t o = EG_OFF(i);
            if (i + 1 < 16) { gq[(i + 1) & 1] = *(const u32x4*)(gate + EG_OFF(i + 1)); if (MODE == 1) tq[(i + 1) & 1] = *(const u32x4*)(tin + EG_OFF(i + 1)); }
            const pf4 v0 = acc[ai][bj][m][0], v1 = acc[ai][bj][m][1]; const u32x4 g = gq[i & 1];
            float r[8];
            r[0] = v0[0] * bflo(g.x); r[1] = v0[1] * bfhi(g.x); r[2] = v0[2] * bflo(g.y); r[3] = v0[3] * bfhi(g.y);
            r[4] = v1[0] * bflo(g.z); r[5] = v1[1] * bfhi(g.z); r[6] = v1[2] * bflo(g.w); r[7] = v1[3] * bfhi(g.w);
            if (MODE == 1) { const u32x4 t = tq[i & 1];
                r[0] += bflo(t.x); r[1] += bfhi(t.x); r[2] += bflo(t.y); r[3] += bfhi(t.y); r[4] += bflo(t.z); r[5] += bfhi(t.z); r[6] += bflo(t.w); r[7] += bfhi(t.w); }
            u32x4 w; w.x = pk2(r[0], r[1]); w.y = pk2(r[2], r[3]); w.z = pk2(r[4], r[5]); w.w = pk2(r[6], r[7]);
            *(u32x4*)(outp + o) = w; }
#undef EG_OFF
    }
};
struct EpiResid {
    static constexpr bool PERM = true, AFTER_DRAIN = false;
    const float* x; bf16_t* h1b; float* rowss;
    __device__ __forceinline__ void operator()(const pf4 (&acc)[2][2][4][2], const pg8::Unit& u, int wr, int wc, int fr, int fq) const {
        const int row0 = u.pm * 256 + wr * 64 + fr, col0 = u.pn * 256 + wc * 32 + 8 * fq;
        pf4 xq[2][4];
#define ER_ROW(i) (row0 + ((i) >> 2) * 128 + ((i) & 3) * 16)
#define ER_LOAD(buf, i) do { const float* p_ = x + (size_t)ER_ROW(i) * 1024 + col0; xq[buf][0] = *(const pf4*)p_; xq[buf][1] = *(const pf4*)(p_ + 4); xq[buf][2] = *(const pf4*)(p_ + 128); xq[buf][3] = *(const pf4*)(p_ + 132); } while (0)
        ER_LOAD(0, 0);
#pragma unroll
        for (int i = 0; i < 8; ++i) { const int ai = i >> 2, m = i & 3, r = ER_ROW(i); const size_t ro = (size_t)r * 1024 + col0; float ss = 0.f;
            if (i + 1 < 8) ER_LOAD((i + 1) & 1, i + 1);
#pragma unroll
            for (int bj = 0; bj < 2; ++bj) { const size_t o = ro + bj * 128;
                const pf4 v0 = acc[ai][bj][m][0] + xq[i & 1][2 * bj], v1 = acc[ai][bj][m][1] + xq[i & 1][2 * bj + 1];
                u32x4 w; w.x = pk2(v0[0], v0[1]); w.y = pk2(v0[2], v0[3]); w.z = pk2(v1[0], v1[1]); w.w = pk2(v1[2], v1[3]);
                *(u32x4*)(h1b + o) = w;
                ss += (v0[0] * v0[0] + v0[1] * v0[1]) + (v0[2] * v0[2] + v0[3] * v0[3]) + (v1[0] * v1[0] + v1[1] * v1[1]) + (v1[2] * v1[2] + v1[3] * v1[3]); }
            ss += __shfl_xor(ss, 16); ss += __shfl_xor(ss, 32);
            if (fq == 0) atomicAdd(rowss + r, ss); }
#undef ER_ROW
#undef ER_LOAD
    }
};
struct EpiScores {
    static constexpr bool PERM = true, AFTER_DRAIN = false;
    const float* rowss; _Float16* sc;
    __device__ __forceinline__ void operator()(const pf4 (&acc)[2][2][4][2], const pg8::Unit& u, int wr, int wc, int fr, int fq) const {
        const int row0 = u.pm * 256 + wr * 64 + fr, k0 = wc * 32 + 8 * fq;
#pragma unroll
        for (int ai = 0; ai < 2; ++ai)
#pragma unroll
            for (int m = 0; m < 4; ++m) { const int r = row0 + ai * 128 + m * 16; const float rs = rsqrtf(rowss[r] * (1.f / DM) + EPSF);
#pragma unroll
                for (int bj = 0; bj < 2; ++bj) { _Float16* p = sc + (((size_t)(((r >> 6) * 8 + u.pn) * 2 + bj) * 16 + (k0 >> 3)) * 64 + (r & 63)) * 8;
                    typedef _Float16 h8 __attribute__((ext_vector_type(8)));
                    h8 v; v[0] = (_Float16)(acc[ai][bj][m][0][0] * rs); v[1] = (_Float16)(acc[ai][bj][m][0][1] * rs); v[2] = (_Float16)(acc[ai][bj][m][0][2] * rs); v[3] = (_Float16)(acc[ai][bj][m][0][3] * rs);
                    v[4] = (_Float16)(acc[ai][bj][m][1][0] * rs); v[5] = (_Float16)(acc[ai][bj][m][1][1] * rs); v[6] = (_Float16)(acc[ai][bj][m][1][2] * rs); v[7] = (_Float16)(acc[ai][bj][m][1][3] * rs);
                    *(h8*)p = v; } }
    }
};

__device__ __forceinline__ void load8(const bf16_t* p, float (&f)[8]) { const u32x4 w = *(const u32x4*)p;
    f[0] = bflo(w.x); f[1] = bfhi(w.x); f[2] = bflo(w.y); f[3] = bfhi(w.y); f[4] = bflo(w.z); f[5] = bfhi(w.z); f[6] = bflo(w.w); f[7] = bfhi(w.w); }
__device__ __forceinline__ void short_conv8(const bf16_t* hb, const float* cw, const float* cb, int s, int ch, float (&o)[8]) {
    float xm[8], x0[8], xp[8];
    if (s >= 1) load8(hb + (size_t)(s - 1) * 1536 + ch, xm); else {
#pragma unroll
        for (int i = 0; i < 8; ++i) xm[i] = 0.f; }
    load8(hb + (size_t)s * 1536 + ch, x0);
    if (s + 1 < LT) load8(hb + (size_t)(s + 1) * 1536 + ch, xp); else {
#pragma unroll
        for (int i = 0; i < 8; ++i) xp[i] = 0.f; }
#pragma unroll
    for (int i = 0; i < 8; ++i) o[i] = xm[i] * cw[ch + i] + x0[i] * cw[1536 + ch + i] + xp[i] * cw[3072 + ch + i] + cb[ch + i];
}
__device__ __forceinline__ void phase_hy_pre(const Args& a, LAS unsigned char* lds, int tid) {
    LAS bf16_t* tl = (LAS bf16_t*)lds;
    const bf16_t* hyin = (const bf16_t*)(a.ws + WS_HYIN); bf16_t* uut = (bf16_t*)(a.ws + WS_UUT);
    const float* cw = a.in[I_HYCW]; const float* cb = a.in[I_HYCB];
    for (int it = blockIdx.x; it < NB * 67 * 8; it += gridDim.x) {
        const int ct = it & 7, ts = (it >> 3) % 67, b = (it >> 3) / 67;
        { const int sr = tid >> 3, cg = tid & 7, c0 = ct * 64 + cg * 8, sp = ts * 64 + sr, s = sp - 16;
            float uu[8];
            if (s >= 0 && s < LT) { float x1[8], v[8]; const bf16_t* hb = hyin + (size_t)b * LT * 1536;
                short_conv8(hb, cw, cb, s, 512 + c0, x1); short_conv8(hb, cw, cb, s, 1024 + c0, v);
#pragma unroll
                for (int i = 0; i < 8; ++i) uu[i] = v[i] * x1[i]; }
            else {
#pragma unroll
                for (int i = 0; i < 8; ++i) uu[i] = 0.f; }
#pragma unroll
            for (int i = 0; i < 8; ++i) tl[sr * 72 + cg * 8 + i] = (bf16_t)f2bf(uu[i]); }
        __syncthreads();
        { const int cl = tid >> 3, sg = tid & 7, sp0 = ts * 64 + sg * 8;
            if (sp0 < SP) { u32x4 w; unsigned h[8];
#pragma unroll
                for (int i = 0; i < 8; ++i) h[i] = tl[(sg * 8 + i) * 72 + cl];
                w.x = h[0] | (h[1] << 16); w.y = h[2] | (h[3] << 16); w.z = h[4] | (h[5] << 16); w.w = h[6] | (h[7] << 16);
                *(u32x4*)(uut + ((size_t)(ct * 64 + cl) * NB + b) * SP + sp0) = w; } }
        __syncthreads();
    }
}
__device__ __forceinline__ void phase_hy_conv_naive(const Args& a, LAS unsigned char* lds, int tid) {
    LAS bf16_t* uus = (LAS bf16_t*)lds;
    LAS float* filt = (LAS float*)(lds + LT * 16);
    const bf16_t* uut = (const bf16_t*)(a.ws + WS_UUT); const float* kf = (const float*)(a.ws + WS_KF); bf16_t* cvt = (bf16_t*)(a.ws + WS_CONVT);
    for (int c = blockIdx.x; c < DHY; c += gridDim.x) {
        for (int i = tid; i < NB * LT; i += NTHR) { const int b = i / LT, s = i - b * LT; uus[s * 8 + b] = uut[((size_t)c * NB + b) * SP + 16 + s]; }
        for (int i = tid; i < KFW; i += NTHR) filt[i] = kf[(size_t)c * KFW + i];
        __syncthreads();
        for (int tt = 0; tt < 8; ++tt) { const int tq = tt * 512 + tid, t = tq + 16; float acc[8];
#pragma unroll
            for (int b = 0; b < 8; ++b) acc[b] = 0.f;
            const LAS float* fp = filt + (LT - 1) + t;
            for (int s = 0; s < LT; ++s) { const float kv = fp[-s]; const u32x4 w = *(const LAS u32x4*)(uus + s * 8);
                acc[0] += kv * bflo(w.x); acc[1] += kv * bfhi(w.x); acc[2] += kv * bflo(w.y); acc[3] += kv * bfhi(w.y);
                acc[4] += kv * bflo(w.z); acc[5] += kv * bfhi(w.z); acc[6] += kv * bflo(w.w); acc[7] += kv * bfhi(w.w); }
#pragma unroll
            for (int b = 0; b < 8; ++b) cvt[((size_t)c * NB + b) * SEQ + tq] = (bf16_t)f2bf(acc[b]); }
        __syncthreads();
    }
}
__device__ __forceinline__ void phase_rg_naive(const Args& a, LAS unsigned char* lds, int tid) {
    LAS float* xc = (LAS float*)lds;
    LAS float* gbuf = xc + 32 * 128;
    const bf16_t* rgx = (const bf16_t*)(a.ws + WS_RGX);
    for (int it = blockIdx.x; it < NB * 2 * 8; it += gridDim.x) {
        const int head = it & 7, dir = (it >> 3) & 1, b = it >> 4;
        const float* cw = a.in[I_RGCW] + (size_t)dir * 4 * DRG + head * 128; const float* cb = a.in[I_RGCB] + (size_t)dir * DRG + head * 128;
        bf16_t* hout = (bf16_t*)a.out + (size_t)dir * T * DRG;
        const bf16_t* xb = rgx + (size_t)b * LT * DRG + head * 128;
        float h = 0.f, sp = 0.f;
        if (tid < 128) { const float lam = a.in[I_RGLAM][dir * DRG + head * 128 + tid]; sp = log1pf(__expf(-lam)); }
        for (int k = 0; k < 129; ++k) {
            { const int tok = tid >> 4, cg = tid & 15, u = 32 * k + tok; float o[8];
#pragma unroll
                for (int i = 0; i < 8; ++i) o[i] = (u < LT) ? cb[cg * 8 + i] : 0.f;
                if (u < LT) {
#pragma unroll
                    for (int j = 0; j < 4; ++j) { const int uu = u - j; if (uu >= 0) { const int t = dir ? (LT - 1 - uu) : uu; float xv[8]; load8(xb + (size_t)t * DRG + cg * 8, xv);
#pragma unroll
                            for (int i = 0; i < 8; ++i) o[i] += xv[i] * cw[j * DRG + cg * 8 + i]; } } }
#pragma unroll
                for (int i = 0; i < 8; ++i) xc[tok * 128 + cg * 8 + i] = o[i]; }
            __syncthreads();
            { const int j = tid & 127, g = (tid >> 7) & 1, th = tid >> 8; float acc[16];
#pragma unroll
                for (int q = 0; q < 16; ++q) acc[q] = 0.f;
                const float* gw = a.in[I_RGGW] + ((size_t)((dir * 2 + g) * 8 + head) * 128) * 128 + j;
                for (int i = 0; i < 128; ++i) { const float wv = gw[i * 128];
#pragma unroll
                    for (int q = 0; q < 16; ++q) acc[q] += xc[(th * 16 + q) * 128 + i] * wv; }
                const float gb = a.in[I_RGGB][(size_t)(dir * 2 + g) * DRG + head * 128 + j];
#pragma unroll
                for (int q = 0; q < 16; ++q) gbuf[(g * 32 + th * 16 + q) * 128 + j] = acc[q] + gb; }
            __syncthreads();
            if (tid < 128) {
                for (int tok = 0; tok < 32; ++tok) { const int u = 32 * k + tok; if (u >= LT) break;
                    const float r = sigmoidf_(gbuf[tok * 128 + tid]), ig = sigmoidf_(gbuf[(32 + tok) * 128 + tid]);
                    const float la = -8.0f * r * sp; const float av = __expf(la); const float mult = (u == 0) ? 1.0f : sqrtf(-expm1f(2.0f * la));
                    h = av * h + mult * ig * xc[tok * 128 + tid];
                    const int t = dir ? (LT - 1 - u) : u;
                    if (t >= NMETA) hout[((size_t)b * SEQ + (t - NMETA)) * DRG + head * 128 + tid] = (bf16_t)f2bf(h); } }
            __syncthreads();
        }
    }
}
__device__ __forceinline__ void phase_post(const Args& a, LAS unsigned char* lds, int tid) {
    LAS bf16_t* cv = (LAS bf16_t*)lds;
    const bf16_t* hyin = (const bf16_t*)(a.ws + WS_HYIN); const bf16_t* cvt = (const bf16_t*)(a.ws + WS_CONVT); bf16_t* yh = (bf16_t*)(a.ws + WS_YH);
    const float* cw = a.in[I_HYCW]; const float* cb = a.in[I_HYCB]; const float* skip = a.in[I_HYSKIP];
    for (int it = blockIdx.x; it < NB * 64 * 8; it += gridDim.x) {
        const int ct = it & 7, tt = (it >> 3) & 63, b = it >> 9;
        { const int cl = tid >> 3, tg = tid & 7; const u32x4 w = *(const u32x4*)(cvt + ((size_t)(ct * 64 + cl) * NB + b) * SEQ + tt * 64 + tg * 8);
            *(LAS u32x4*)(cv + cl * 72 + tg * 8) = w; }
        __syncthreads();
        { const int tr = tid >> 3, cg = tid & 7, c0 = ct * 64 + cg * 8, t = NMETA + tt * 64 + tr; const bf16_t* hb = hyin + (size_t)b * LT * 1536;
            float x0[8], x1[8], v[8]; short_conv8(hb, cw, cb, t, c0, x0); short_conv8(hb, cw, cb, t, 512 + c0, x1); short_conv8(hb, cw, cb, t, 1024 + c0, v);
            float y[8];
#pragma unroll
            for (int i = 0; i < 8; ++i) { const float cvv = bf2f(cv[(cg * 8 + i) * 72 + tr]); y[i] = (cvv + v[i] * x1[i] * skip[c0 + i]) * x0[i]; }
            u32x4 w; w.x = pk2(y[0], y[1]); w.y = pk2(y[2], y[3]); w.z = pk2(y[4], y[5]); w.w = pk2(y[6], y[7]);
            *(u32x4*)(yh + ((size_t)b * SEQ + tt * 64 + tr) * DHY + c0) = w; }
        __syncthreads();
    }
    const bf16_t* hf = (const bf16_t*)a.out; const bf16_t* hb2 = hf + (size_t)T * DRG; const bf16_t* gg = (const bf16_t*)(a.ws + WS_GG); bf16_t* yr = (bf16_t*)(a.ws + WS_YR);
    for (size_t i = (size_t)blockIdx.x * NTHR + tid; i < (size_t)T * DRG / 8; i += (size_t)gridDim.x * NTHR) {
        float f[8], g[8], q[8]; load8(hf + i * 8, f); load8(hb2 + i * 8, g); load8(gg + i * 8, q);
        u32x4 w; w.x = pk2((f[0] + g[0]) * q[0], (f[1] + g[1]) * q[1]); w.y = pk2((f[2] + g[2]) * q[2], (f[3] + g[3]) * q[3]);
        w.z = pk2((f[4] + g[4]) * q[4], (f[5] + g[5]) * q[5]); w.w = pk2((f[6] + g[6]) * q[6], (f[7] + g[7]) * q[7]);
        *(u32x4*)(yr + i * 8) = w; }
}
__device__ __forceinline__ u32x4 quant_row16(const f32x4 (&v)[4], float amax, float& deq) {
    const float sc = (amax > 0.f) ? 256.0f / amax : 1.0f; deq = (amax > 0.f) ? amax * (1.0f / 256.0f) : 1.0f;
    u32x4 w; int t;
    t = __builtin_amdgcn_cvt_pk_fp8_f32(v[0].x * sc, v[0].y * sc, 0, false); t = __builtin_amdgcn_cvt_pk_fp8_f32(v[0].z * sc, v[0].w * sc, t, true); w.x = (unsigned)t;
    t = __builtin_amdgcn_cvt_pk_fp8_f32(v[1].x * sc, v[1].y * sc, 0, false); t = __builtin_amdgcn_cvt_pk_fp8_f32(v[1].z * sc, v[1].w * sc, t, true); w.y = (unsigned)t;
    t = __builtin_amdgcn_cvt_pk_fp8_f32(v[2].x * sc, v[2].y * sc, 0, false); t = __builtin_amdgcn_cvt_pk_fp8_f32(v[2].z * sc, v[2].w * sc, t, true); w.z = (unsigned)t;
    t = __builtin_amdgcn_cvt_pk_fp8_f32(v[3].x * sc, v[3].y * sc, 0, false); t = __builtin_amdgcn_cvt_pk_fp8_f32(v[3].z * sc, v[3].w * sc, t, true); w.w = (unsigned)t;
    return w;
}
__device__ __forceinline__ void phase_tables(const Args& a, int wave, int lane) {
    const int gw = blockIdx.x * NWAVES + wave, NGW = gridDim.x * NWAVES;
    const float* gf = a.in[I_GFFN] + 16 * lane; unsigned char* uq = a.ws + WS_UB; unsigned char* vq = a.ws + WS_VB; float* su = (float*)(a.ws + WS_SU); float* sv = (float*)(a.ws + WS_SV);
    f32x4 g[4];
#pragma unroll
    for (int j = 0; j < 4; ++j) g[j] = *(const f32x4*)(gf + 4 * j);
    for (int e = gw; e < NEXP; e += NGW) {
        const float* ur = a.in[I_PU] + (size_t)e * DM + 16 * lane; const float* vr = a.in[I_PV] + (size_t)e * DM + 16 * lane;
        f32x4 u[4], v[4]; float mu = 0.f, mv = 0.f;
#pragma unroll
        for (int j = 0; j < 4; ++j) { u[j] = *(const f32x4*)(ur + 4 * j) * g[j]; v[j] = *(const f32x4*)(vr + 4 * j);
            mu = fmaxf(mu, fmaxf(fmaxf(fabsf(u[j].x), fabsf(u[j].y)), fmaxf(fabsf(u[j].z), fabsf(u[j].w))));
            mv = fmaxf(mv, fmaxf(fmaxf(fabsf(v[j].x), fabsf(v[j].y)), fmaxf(fabsf(v[j].z), fabsf(v[j].w)))); }
        mu = wave_max_dpp(mu); mv = wave_max_dpp(mv);
        float du, dv; const u32x4 qu = quant_row16(u, mu, du), qv = quant_row16(v, mv, dv);
        { const size_t so = ((size_t)(lane >> 3) * NEXP + e) * 128 + 16 * (lane & 7); *(u32x4*)(uq + so) = qu; *(u32x4*)(vq + so) = qv; }
        if (lane == 0) { su[e] = du; sv[e] = dv; }
    }
}
__device__ __forceinline__ void ce_desc(float& a, float& b) { const float hi = fmaxf(a, b), lo = fminf(a, b); a = hi; b = lo; }
__device__ __forceinline__ void sort16_desc(float (&x)[16]) {
#pragma unroll
    for (int k = 2; k <= 16; k <<= 1)
#pragma unroll
        for (int j = k >> 1; j > 0; j >>= 1)
#pragma unroll
            for (int i = 0; i < 16; ++i) { const int l = i ^ j; if (l > i) { if ((i & k) == 0) ce_desc(x[i], x[l]); else ce_desc(x[l], x[i]); } }
}
__device__ __forceinline__ void merge_top16(float (&L)[16], const float (&X)[16]) {
#pragma unroll
    for (int i = 0; i < 16; ++i) L[i] = fmaxf(L[i], X[15 - i]);
#pragma unroll
    for (int j = 8; j > 0; j >>= 1)
#pragma unroll
        for (int i = 0; i < 16; ++i) { const int l = i ^ j; if (l > i) ce_desc(L[i], L[l]); }
}
__device__ __forceinline__ void top16_of_128(const _Float16* base  , float (&L)[16]) {
    typedef _Float16 h8 __attribute__((ext_vector_type(8)));
    h8 v0 = *(const h8*)(base), v1 = *(const h8*)(base + 512);
#pragma unroll 1
    for (int ch = 0; ch < 8; ++ch) { float X[16]; const int cn = (ch < 7) ? ch + 1 : 7;
        const h8 n0 = *(const h8*)(base + (2 * cn) * 512), n1 = *(const h8*)(base + (2 * cn + 1) * 512);
#pragma unroll
        for (int i = 0; i < 8; ++i) { X[i] = __uint_as_float((__float_as_uint((float)v0[i]) & ~0x7Fu) | (unsigned)(ch * 16 + i));
            X[8 + i] = __uint_as_float((__float_as_uint((float)v1[i]) & ~0x7Fu) | (unsigned)(ch * 16 + 8 + i)); }
        sort16_desc(X);
        if (ch == 0) {
#pragma unroll
            for (int i = 0; i < 16; ++i) L[i] = X[i]; }
        else merge_top16(L, X);
        v0 = n0; v1 = n1; }
}
struct CandTab { int ci[64], cj[64]; };
__host__ __device__ constexpr CandTab make_cand() { CandTab t{}; int n = 0; for (int i = 0; i < 16; ++i) for (int j = 0; j < 16; ++j) if ((i + 1) * (j + 1) <= 16) { t.ci[n] = i; t.cj[n] = j; ++n; }
    for (; n < 64; ++n) { t.ci[n] = -1; t.cj[n] = -1; } return t; }
__device__ __forceinline__ void phase_topk(const Args& a, LAS unsigned char* lds, int wave, int lane) {
    constexpr CandTab CT = make_cand();
    const int gw = blockIdx.x * NWAVES + wave, NGW = gridDim.x * NWAVES;
    const _Float16* st = (const _Float16*)(a.ws + WS_SCORES); int* eidx = (int*)(a.ws + WS_EIDX); float* eg = (float*)(a.ws + WS_EG);
    LAS unsigned char* tab = lds + wave * (64 * 36) + lane * 36;
    for (int it = gw; it < (T / 64) * 8; it += NGW) { const int tg = it >> 3, hh = it & 7; const int m = tg * 64 + lane;
        float A[16], B[16];
        top16_of_128(st + (size_t)((tg * 8 + hh) * 2 + 0) * 128 * 64 + lane * 8, A);
        top16_of_128(st + (size_t)((tg * 8 + hh) * 2 + 1) * 128 * 64 + lane * 8, B);
#pragma unroll
        for (int q = 0; q < 4; ++q) {
            const unsigned wa = (__float_as_uint(A[4 * q]) & 0x7Fu) | ((__float_as_uint(A[4 * q + 1]) & 0x7Fu) << 8) | ((__float_as_uint(A[4 * q + 2]) & 0x7Fu) << 16) | ((__float_as_uint(A[4 * q + 3]) & 0x7Fu) << 24);
            const unsigned wb = (__float_as_uint(B[4 * q]) & 0x7Fu) | ((__float_as_uint(B[4 * q + 1]) & 0x7Fu) << 8) | ((__float_as_uint(B[4 * q + 2]) & 0x7Fu) << 16) | ((__float_as_uint(B[4 * q + 3]) & 0x7Fu) << 24);
            *(LAS unsigned*)(tab + 4 * q) = wa; *(LAS unsigned*)(tab + 16 + 4 * q) = wb; }
#pragma unroll
        for (int i = 0; i < 16; ++i) { A[i] = __uint_as_float(__float_as_uint(A[i]) & ~0x7Fu); B[i] = __uint_as_float(__float_as_uint(B[i]) & ~0x7Fu); }
        float K[16];
#pragma unroll
        for (int c0 = 0; c0 < 64; c0 += 16) { float X[16];
#pragma unroll
            for (int i = 0; i < 16; ++i) { const int c = c0 + i;
                if (CT.ci[c] >= 0) X[i] = __uint_as_float((__float_as_uint(A[CT.ci[c] < 0 ? 0 : CT.ci[c]] + B[CT.cj[c] < 0 ? 0 : CT.cj[c]]) & ~0xFFu) | (unsigned)(CT.ci[c] * 16 + CT.cj[c]));
                else X[i] = -INFINITY; }
            sort16_desc(X);
            if (c0 == 0) {
#pragma unroll
                for (int i = 0; i < 16; ++i) K[i] = X[i]; }
            else merge_top16(K, X); }
        asm volatile("s_waitcnt lgkmcnt(0)" ::: "memory");
        int ex_[16]; float cs[16]; float sum = 0.f;
#pragma unroll
        for (int r = 0; r < 16; ++r) { const unsigned kb = __float_as_uint(K[r]); const int id = kb & 0xFF; cs[r] = __expf(__uint_as_float(kb & ~0xFFu) - __uint_as_float(__float_as_uint(K[0]) & ~0xFFu)); sum += cs[r];
            ex_[r] = (int)tab[id >> 4] * 128 + (int)tab[16 + (id & 15)]; }
        const float inv = 1.0f / sum;
        unsigned short* ep = (unsigned short*)eidx + (size_t)m * 128 + hh * 16; float* gp = eg + (size_t)m * 128 + hh * 16;
        { u32x4 p0, p1; p0.x = ex_[0] | (ex_[1] << 16); p0.y = ex_[2] | (ex_[3] << 16); p0.z = ex_[4] | (ex_[5] << 16); p0.w = ex_[6] | (ex_[7] << 16);
          p1.x = ex_[8] | (ex_[9] << 16); p1.y = ex_[10] | (ex_[11] << 16); p1.z = ex_[12] | (ex_[13] << 16); p1.w = ex_[14] | (ex_[15] << 16); *(u32x4*)ep = p0; *(u32x4*)(ep + 8) = p1; }
#pragma unroll
        for (int q = 0; q < 4; ++q) {
            *(f32x4*)(gp + 4 * q) = (f32x4){cs[4 * q] * inv, cs[4 * q + 1] * inv, cs[4 * q + 2] * inv, cs[4 * q + 3] * inv}; }
    }
}
__device__ __forceinline__ void unpack8(const u32x4 w, float (&f)[8]) {
    f[0] = bflo(w.x); f[1] = bfhi(w.x); f[2] = bflo(w.y); f[3] = bfhi(w.y); f[4] = bflo(w.z); f[5] = bfhi(w.z); f[6] = bflo(w.w); f[7] = bfhi(w.w); }
__device__ __forceinline__ void fp8x16_to_f32(const u32x4 w, float (&f)[16]) {
    f32x2v t;
    t = __builtin_amdgcn_cvt_pk_f32_fp8((int)w.x, false); f[0] = t.x; f[1] = t.y; t = __builtin_amdgcn_cvt_pk_f32_fp8((int)w.x, true); f[2] = t.x; f[3] = t.y;
    t = __builtin_amdgcn_cvt_pk_f32_fp8((int)w.y, false); f[4] = t.x; f[5] = t.y; t = __builtin_amdgcn_cvt_pk_f32_fp8((int)w.y, true); f[6] = t.x; f[7] = t.y;
    t = __builtin_amdgcn_cvt_pk_f32_fp8((int)w.z, false); f[8] = t.x; f[9] = t.y; t = __builtin_amdgcn_cvt_pk_f32_fp8((int)w.z, true); f[10] = t.x; f[11] = t.y;
    t = __builtin_amdgcn_cvt_pk_f32_fp8((int)w.w, false); f[12] = t.x; f[13] = t.y; t = __builtin_amdgcn_cvt_pk_f32_fp8((int)w.w, true); f[14] = t.x; f[15] = t.y;
}
__device__ __forceinline__ void fp8x16_to_f32x2(const u32x4 w, f32x2v (&f)[8]) {
    f[0] = __builtin_amdgcn_cvt_pk_f32_fp8((int)w.x, false); f[1] = __builtin_amdgcn_cvt_pk_f32_fp8((int)w.x, true);
    f[2] = __builtin_amdgcn_cvt_pk_f32_fp8((int)w.y, false); f[3] = __builtin_amdgcn_cvt_pk_f32_fp8((int)w.y, true);
    f[4] = __builtin_amdgcn_cvt_pk_f32_fp8((int)w.z, false); f[5] = __builtin_amdgcn_cvt_pk_f32_fp8((int)w.z, true);
    f[6] = __builtin_amdgcn_cvt_pk_f32_fp8((int)w.w, false); f[7] = __builtin_amdgcn_cvt_pk_f32_fp8((int)w.w, true);
}
__device__ __forceinline__ float dpp_sum8(float v) {
    v += __int_as_float(__builtin_amdgcn_update_dpp(0, __float_as_int(v), 0xB1, 0xF, 0xF, true));
    v += __int_as_float(__builtin_amdgcn_update_dpp(0, __float_as_int(v), 0x4E, 0xF, 0xF, true));
    v += __int_as_float(__builtin_amdgcn_update_dpp(0, __float_as_int(v), 0x141, 0xF, 0xF, true));
    return v;
}
struct UTok { u32x4 e0, e1, xa, xb; };
struct VTok { u32x4 e0, e1; f32x4 av[4]; };
__device__ __forceinline__ void pu_issue(const unsigned char* tab, unsigned loff, const u32x4& e, u32x4 (&w)[8]) {
    w[0] = *(const u32x4*)(tab + ((e.x & 0xffffu) * 128u + loff)); w[1] = *(const u32x4*)(tab + ((e.x >> 16) * 128u + loff));
    w[2] = *(const u32x4*)(tab + ((e.y & 0xffffu) * 128u + loff)); w[3] = *(const u32x4*)(tab + ((e.y >> 16) * 128u + loff));
    w[4] = *(const u32x4*)(tab + ((e.z & 0xffffu) * 128u + loff)); w[5] = *(const u32x4*)(tab + ((e.z >> 16) * 128u + loff));
    w[6] = *(const u32x4*)(tab + ((e.w & 0xffffu) * 128u + loff)); w[7] = *(const u32x4*)(tab + ((e.w >> 16) * 128u + loff));
}
__device__ __forceinline__ float pu_compute(const f32x2v (&x)[8], const u32x4 (&w)[8], int i) {
    float keep = 0.f;
#pragma unroll
    for (int q = 0; q < 8; ++q) { f32x2v f[8]; fp8x16_to_f32x2(w[q], f); f32x2v s0 = f[0] * x[0], s1 = f[1] * x[1];
#pragma unroll
        for (int c = 2; c < 8; c += 2) { s0 += f[c] * x[c]; s1 += f[c + 1] * x[c + 1]; }
        s0 += s1; const float d = dpp_sum8(s0.x + s0.y); keep = (q == i) ? d : keep;
#ifdef PROBE_U2X
        { u32x4 w2 = w[q]; asm volatile("" : "+v"(w2.x), "+v"(w2.y), "+v"(w2.z), "+v"(w2.w)); f32x2v f2[8]; fp8x16_to_f32x2(w2, f2); f32x2v t0 = f2[0] * x[0], t1 = f2[1] * x[1];
#pragma unroll
          for (int c = 2; c < 8; c += 2) { t0 += f2[c] * x[c]; t1 += f2[c + 1] * x[c + 1]; }
          t0 += t1; float dd = t0.x + t0.y; asm volatile("" :: "v"(dd)); }
#endif
    }
    return keep;
}
__device__ __forceinline__ void phase_peer_u(const Args& a, int wave, int lane) {
    const int s = SLICE_OF(blockIdx.x), rk = RANK_OF(blockIdx.x), nrk = gridDim.x >> 3, tper = T / nrk, i = lane & 7, j = lane >> 3;
    const bf16_t* h1b = (const bf16_t*)(a.ws + WS_H1B) + 128 * s + 16 * i; const unsigned char* uqs = a.ws + WS_UB + (size_t)s * NEXP * 128; const unsigned loff = 16u * (unsigned)i;
    const unsigned short* eidx = (const unsigned short*)(a.ws + WS_EIDX) + 16 * j; float* pd = (float*)(a.ws + WS_PD) + (size_t)s * T * 128 + 16 * j + i;
    const int m0 = rk * tper + wave, mlast = (rk + 1) * tper - NWAVES + wave;
#define PU_LOAD(t, mm) do { const int m_ = (mm) < mlast ? (mm) : mlast; const u32x4* ep_ = (const u32x4*)(eidx + (size_t)m_ * 128); (t).e0 = ep_[0]; (t).e1 = ep_[1]; \
        (t).xa = *(const u32x4*)(h1b + (size_t)m_ * DM); (t).xb = *(const u32x4*)(h1b + (size_t)m_ * DM + 8); } while (0)
#define PU_DO(t, w0, w1, mm) do { f32x2v x[8]; \
        x[0] = (f32x2v){bflo((t).xa.x), bfhi((t).xa.x)}; x[1] = (f32x2v){bflo((t).xa.y), bfhi((t).xa.y)}; x[2] = (f32x2v){bflo((t).xa.z), bfhi((t).xa.z)}; x[3] = (f32x2v){bflo((t).xa.w), bfhi((t).xa.w)}; \
        x[4] = (f32x2v){bflo((t).xb.x), bfhi((t).xb.x)}; x[5] = (f32x2v){bflo((t).xb.y), bfhi((t).xb.y)}; x[6] = (f32x2v){bflo((t).xb.z), bfhi((t).xb.z)}; x[7] = (f32x2v){bflo((t).xb.w), bfhi((t).xb.w)}; \
        const float k0_ = pu_compute(x, w0, i), k1_ = pu_compute(x, w1, i); pd[(size_t)(mm) * 128] = k0_; pd[(size_t)(mm) * 128 + 8] = k1_; } while (0)
    UTok tC, tN, tNN; u32x4 wA[8], wB[8], wC[8], wD[8];
    PU_LOAD(tC, m0); PU_LOAD(tN, m0 + NWAVES); PU_LOAD(tNN, m0 + 2 * NWAVES); pu_issue(uqs, loff, tC.e0, wA); pu_issue(uqs, loff, tC.e1, wB);
    for (int m = m0; m <= mlast; m += 2 * NWAVES) {
        pu_issue(uqs, loff, tN.e0, wC); pu_issue(uqs, loff, tN.e1, wD);
        PU_DO(tC, wA, wB, m);
        tC = tN; tN = tNN; PU_LOAD(tNN, m + 3 * NWAVES);
        pu_issue(uqs, loff, tN.e0, wA); pu_issue(uqs, loff, tN.e1, wB);
        PU_DO(tC, wC, wD, m + NWAVES);
        tC = tN; tN = tNN; PU_LOAD(tNN, m + 4 * NWAVES);
    }
#undef PU_LOAD
#undef PU_DO
}
typedef long i64_t;
__device__ __forceinline__ i64_t pack64(unsigned lo, unsigned hi) { return (i64_t)(((unsigned long long)hi << 32) | (unsigned long long)lo); }
struct MTokI { u32x4 ia, ib; };
struct MTokX { u32x4 xq[4]; };
__device__ __forceinline__ unsigned id16(const u32x4& v, int c) { const unsigned wv = (c >> 1) == 0 ? v.x : (c >> 1) == 1 ? v.y : (c >> 1) == 2 ? v.z : v.w; return (c & 1) ? (wv >> 16) : (wv & 0xffffu); }
__device__ __forceinline__ void pm_issue(const unsigned char* tab, unsigned loff, const MTokI& t, u32x4 (&W)[16]) {
#pragma unroll
    for (int c = 0; c < 8; ++c) { W[2 * c] = *(const u32x4*)(tab + (id16(t.ia, c) * 128u + loff)); W[2 * c + 1] = *(const u32x4*)(tab + (id16(t.ib, c) * 128u + loff)); }
}
template <bool HI> __device__ __forceinline__ unsigned bf2_to_fp8x2(unsigned w, int old) { const float a = fminf(fmaxf(bflo(w), -448.f), 448.f), b = fminf(fmaxf(bfhi(w), -448.f), 448.f); return (unsigned)__builtin_amdgcn_cvt_pk_fp8_f32(a, b, old, HI); }
__device__ __forceinline__ void pm_compute(const MTokX& t, const u32x4 (&W)[16], LAS unsigned char* wl  , float* pdrow  , int lane) {
    unsigned xb[8];
#pragma unroll
    for (int q = 0; q < 4; ++q) { unsigned lo = bf2_to_fp8x2<false>(t.xq[q].x, 0); lo = bf2_to_fp8x2<true>(t.xq[q].y, (int)lo); unsigned hi = bf2_to_fp8x2<false>(t.xq[q].z, 0); hi = bf2_to_fp8x2<true>(t.xq[q].w, (int)hi); xb[2 * q] = lo; xb[2 * q + 1] = hi; }
    const i64_t B0 = pack64(xb[0], xb[1]), B1 = pack64(xb[2], xb[3]), B2 = pack64(xb[4], xb[5]), B3 = pack64(xb[6], xb[7]);
    const int j8 = lane >> 3, i = lane & 7, r = lane & 15, g = lane >> 4;
    LAS unsigned char* wr0 = wl + j8 * 144 + i * 16;
    const LAS unsigned char* rd0 = wl + r * 144 + g * 32;
    f32x4 C[8];
#pragma unroll
    for (int c = 0; c < 8; ++c) { const int bo = (c & 1) * 2304;
        *(LAS u32x4*)(wr0 + bo) = W[2 * c]; *(LAS u32x4*)(wr0 + bo + 8 * 144) = W[2 * c + 1];
        const u32x4 a0 = *(const LAS u32x4*)(rd0 + bo), a1 = *(const LAS u32x4*)(rd0 + bo + 16);
        f32x4 acc = (f32x4){0.f, 0.f, 0.f, 0.f};
        acc = __builtin_amdgcn_mfma_f32_16x16x32_fp8_fp8(pack64(a0.x, a0.y), B0, acc, 0, 0, 0);
        acc = __builtin_amdgcn_mfma_f32_16x16x32_fp8_fp8(pack64(a0.z, a0.w), B1, acc, 0, 0, 0);
        acc = __builtin_amdgcn_mfma_f32_16x16x32_fp8_fp8(pack64(a1.x, a1.y), B2, acc, 0, 0, 0);
        acc = __builtin_amdgcn_mfma_f32_16x16x32_fp8_fp8(pack64(a1.z, a1.w), B3, acc, 0, 0, 0); C[c] = acc; }
    if ((lane & 15) == 0) {
#pragma unroll
        for (int reg = 0; reg < 4; ++reg) { *(f32x4*)(pdrow + 8 * reg) = (f32x4){C[0][reg], C[1][reg], C[2][reg], C[3][reg]}; *(f32x4*)(pdrow + 8 * reg + 4) = (f32x4){C[4][reg], C[5][reg], C[6][reg], C[7][reg]}; } }
}
__device__ __forceinline__ void phase_peer_u_mfma(const Args& a, LAS unsigned char* lds, int wave, int lane) {
    const int s = SLICE_OF(blockIdx.x), rk = RANK_OF(blockIdx.x), nrk = gridDim.x >> 3, tper = T / nrk, g = lane >> 4, j8 = lane >> 3;
    const bf16_t* h1b = (const bf16_t*)(a.ws + WS_H1B) + 128 * s + 32 * g; const unsigned char* uqs = a.ws + WS_UB + (size_t)s * NEXP * 128; const unsigned loff = 16u * (unsigned)(lane & 7);
    const unsigned short* eidx = (const unsigned short*)(a.ws + WS_EIDX) + 8 * j8; float* pd = (float*)(a.ws + WS_PD) + (size_t)s * T * 128 + 32 * g;
    LAS unsigned char* wl = lds + wave * 4608;
    const int m0 = rk * tper + wave, mlast = (rk + 1) * tper - NWAVES + wave;
#define PM_LOADI(t, mm) do { const int m_ = (mm) < mlast ? (mm) : mlast; (t).ia = *(const u32x4*)(eidx + (size_t)m_ * 128); (t).ib = *(const u32x4*)(eidx + (size_t)m_ * 128 + 64); } while (0)
#define PM_LOADX(t, mm) do { const int m_ = (mm) < mlast ? (mm) : mlast; const u32x4* xp_ = (const u32x4*)(h1b + (size_t)m_ * DM); (t).xq[0] = xp_[0]; (t).xq[1] = xp_[1]; (t).xq[2] = xp_[2]; (t).xq[3] = xp_[3]; } while (0)
    MTokI iC, iN, iNN; MTokX xC, xN; u32x4 WA[16], WB[16];
    PM_LOADI(iC, m0); PM_LOADI(iN, m0 + NWAVES); PM_LOADI(iNN, m0 + 2 * NWAVES); PM_LOADX(xC, m0); PM_LOADX(xN, m0 + NWAVES); pm_issue(uqs, loff, iC, WA);
    for (int m = m0; m <= mlast; m += 2 * NWAVES) {
        pm_issue(uqs, loff, iN, WB);
        pm_compute(xC, WA, wl, pd + (size_t)m * 128, lane);
        iC = iN; iN = iNN; PM_LOADI(iNN, m + 3 * NWAVES); xC = xN; PM_LOADX(xN, m + 2 * NWAVES);
        pm_issue(uqs, loff, iN, WA);
        pm_compute(xC, WB, wl, pd + (size_t)(m + NWAVES) * 128, lane);
        iC = iN; iN = iNN; PM_LOADI(iNN, m + 4 * NWAVES); xC = xN; PM_LOADX(xN, m + 3 * NWAVES);
    }
#undef PM_LOADI
#undef PM_LOADX
}
__device__ __forceinline__ void phase_peer_act(const Args& a, int tid) {
    const float* pd = (const float*)(a.ws + WS_PD); const unsigned short* eidx = (const unsigned short*)(a.ws + WS_EIDX); const float* eg = (const float*)(a.ws + WS_EG);
    const float* su = (const float*)(a.ws + WS_SU); const float* sv = (const float*)(a.ws + WS_SV); const float* rowss = (const float*)(a.ws + WS_ROWSS); float* act = (float*)(a.ws + WS_ACT);
    for (size_t i4 = (size_t)blockIdx.x * NTHR + tid; i4 < (size_t)T * 32; i4 += (size_t)gridDim.x * NTHR) { const size_t idx = i4 * 4;
        f32x4 d = *(const f32x4*)(pd + idx);
#pragma unroll
        for (int s = 1; s < 8; ++s) d += *(const f32x4*)(pd + (size_t)s * T * 128 + idx);
        const u32x2 ew = *(const u32x2*)(eidx + idx); const f32x4 g = *(const f32x4*)(eg + idx); const float rstd = rsqrtf(rowss[idx >> 7] * (1.f / DM) + EPSF);
        const unsigned e0 = ew.x & 0xffffu, e1 = ew.x >> 16, e2 = ew.y & 0xffffu, e3 = ew.y >> 16;
        f32x4 o; o.x = gelu_tanh(d.x * su[e0] * rstd) * g.x * sv[e0]; o.y = gelu_tanh(d.y * su[e1] * rstd) * g.y * sv[e1];
        o.z = gelu_tanh(d.z * su[e2] * rstd) * g.z * sv[e2]; o.w = gelu_tanh(d.w * su[e3] * rstd) * g.w * sv[e3];
        *(f32x4*)(act + idx) = o;
    }
}
__device__ __forceinline__ void pv_accum(const u32x4 (&w)[8], const f32x4& a0, const f32x4& a1, f32x2v (&o)[8]) {
#pragma unroll
    for (int q = 0; q < 8; ++q) { f32x2v f[8]; fp8x16_to_f32x2(w[q], f); const float aq = (q < 4) ? a0[q & 3] : a1[q & 3]; const f32x2v a2 = (f32x2v){aq, aq};
#pragma unroll
        for (int c = 0; c < 8; ++c) o[c] += a2 * f[c]; }
}
__device__ __forceinline__ void pv_finish(const f32x2v (&o2)[8], float* orow, int j) {
    float o[16];
#pragma unroll
    for (int c = 0; c < 8; ++c) { o[2 * c] = o2[c].x; o[2 * c + 1] = o2[c].y; }
#pragma unroll
    for (int c = 0; c < 16; ++c) { o[c] += __int_as_float(__builtin_amdgcn_update_dpp(0, __float_as_int(o[c]), 0x128, 0xF, 0xF, true));
        o[c] += __shfl_xor(o[c], 16); o[c] += __shfl_xor(o[c], 32); }
    if (j == 0) {
#pragma unroll
        for (int c4 = 0; c4 < 4; ++c4) *(f32x4*)(orow + 4 * c4) = (f32x4){o[4 * c4], o[4 * c4 + 1], o[4 * c4 + 2], o[4 * c4 + 3]}; }
}
__device__ __forceinline__ void phase_peer_v(const Args& a, int wave, int lane) {
    const int s = SLICE_OF(blockIdx.x), rk = RANK_OF(blockIdx.x), nrk = gridDim.x >> 3, tper = T / nrk, i = lane & 7, j = lane >> 3;
    const unsigned char* vqs = a.ws + WS_VB + (size_t)s * NEXP * 128; const unsigned loff = 16u * (unsigned)i;
    const unsigned short* eidx = (const unsigned short*)(a.ws + WS_EIDX) + 16 * j; const float* act = (const float*)(a.ws + WS_ACT) + 16 * j;
    float* obase = (float*)(a.ws + WS_PO) + 128 * s + 16 * i;
    const int m0 = rk * tper + wave, mlast = (rk + 1) * tper - NWAVES + wave;
#define PV_LOAD(t, mm) do { const int m_ = (mm) < mlast ? (mm) : mlast; const u32x4* ep_ = (const u32x4*)(eidx + (size_t)m_ * 128); const f32x4* ap_ = (const f32x4*)(act + (size_t)m_ * 128); \
        (t).e0 = ep_[0]; (t).e1 = ep_[1]; (t).av[0] = ap_[0]; (t).av[1] = ap_[1]; (t).av[2] = ap_[2]; (t).av[3] = ap_[3]; } while (0)
#define PV_DO(t, w0, w1, mm) do { f32x2v o[8]; _Pragma("unroll") for (int c = 0; c < 8; ++c) o[c] = (f32x2v){0.f, 0.f}; \
        pv_accum(w0, (t).av[0], (t).av[1], o); pv_accum(w1, (t).av[2], (t).av[3], o); pv_finish(o, obase + (size_t)(mm) * DM, j); } while (0)
    VTok tC, tN, tNN; u32x4 wA[8], wB[8], wC[8], wD[8];
    PV_LOAD(tC, m0); PV_LOAD(tN, m0 + NWAVES); PV_LOAD(tNN, m0 + 2 * NWAVES); pu_issue(vqs, loff, tC.e0, wA); pu_issue(vqs, loff, tC.e1, wB);
    for (int m = m0; m <= mlast; m += 2 * NWAVES) {
        pu_issue(vqs, loff, tN.e0, wC); pu_issue(vqs, loff, tN.e1, wD);
        PV_DO(tC, wA, wB, m);
        tC = tN; tN = tNN; PV_LOAD(tNN, m + 3 * NWAVES);
        pu_issue(vqs, loff, tN.e0, wA); pu_issue(vqs, loff, tN.e1, wB);
        PV_DO(tC, wC, wD, m + NWAVES);
        tC = tN; tN = tNN; PV_LOAD(tNN, m + 4 * NWAVES);
    }
#undef PV_LOAD
#undef PV_DO
}
__device__ __forceinline__ void phase_final(const Args& a, int wave, int lane) {
    const int gw = blockIdx.x * NWAVES + wave, NGW = gridDim.x * NWAVES; const float* po = (const float*)(a.ws + WS_PO) + 16 * lane; const bf16_t* h1b = (const bf16_t*)(a.ws + WS_H1B) + 16 * lane;
    f32x4 gf[4];
#pragma unroll
    for (int jj = 0; jj < 4; ++jj) gf[jj] = *(const f32x4*)(a.in[I_GFINAL] + 16 * lane + 4 * jj);
    for (int m = gw; m < T; m += NGW) { float hb[16]; load8(h1b + (size_t)m * DM, *(float(*)[8])&hb[0]); load8(h1b + (size_t)m * DM + 8, *(float(*)[8])&hb[8]);
        f32x4 h[4]; float ss = 0.f;
#pragma unroll
        for (int jj = 0; jj < 4; ++jj) { h[jj] = *(const f32x4*)(po + (size_t)m * DM + 4 * jj) + (f32x4){hb[4 * jj], hb[4 * jj + 1], hb[4 * jj + 2], hb[4 * jj + 3]};
            ss += (h[jj].x * h[jj].x + h[jj].y * h[jj].y) + (h[jj].z * h[jj].z + h[jj].w * h[jj].w); }
        const float r2 = rsqrtf(wave_sum_dpp(ss) * (1.f / DM) + EPSF);
        float* orow = a.out + (size_t)m * DM + 16 * lane;
#pragma unroll
        for (int jj = 0; jj < 4; ++jj) *(f32x4*)(orow + 4 * jj) = h[jj] * r2 * gf[jj]; }
}
typedef short bf16x8_t __attribute__((ext_vector_type(8)));
__device__ __forceinline__ bf16x8_t toep_frag(const LAS unsigned* R32, int base) {
    const int e = base >> 1, sh = (base & 1) * 16;
    const unsigned d0 = R32[e], d1 = R32[e + 1], d2 = R32[e + 2], d3 = R32[e + 3], d4 = R32[e + 4];
    u32x4 o; o.x = __builtin_amdgcn_alignbit(d1, d0, sh); o.y = __builtin_amdgcn_alignbit(d2, d1, sh); o.z = __builtin_amdgcn_alignbit(d3, d2, sh); o.w = __builtin_amdgcn_alignbit(d4, d3, sh);
    return __builtin_bit_cast(bf16x8_t, o);
}
__device__ __forceinline__ void hy_conv_channel(const Args& a, LAS unsigned char* lds, int c, int tid, int wave, int lane) {
    constexpr int UROW = SP * 2;
    LAS unsigned char* uus = lds;
    LAS unsigned short* R = (LAS unsigned short*)(lds + 8 * UROW);
    const bf16_t* uut = (const bf16_t*)(a.ws + WS_UUT); const bf16_t* kfb = (const bf16_t*)(a.ws + WS_KFB); bf16_t* cvt = (bf16_t*)(a.ws + WS_CONVT);
    { const u32x4* src = (const u32x4*)(uut + (size_t)c * NB * SP); for (int i = tid; i < 8 * UROW / 16; i += NTHR) ((LAS u32x4*)uus)[i] = src[i]; }
    for (int n = tid; n < KFW + 16; n += NTHR) R[n] = (n < KFW) ? kfb[(size_t)c * KFW + (KFW - 1) - n] : (unsigned short)0;
    __syncthreads();
    const LAS unsigned* R32 = (const LAS unsigned*)R;
    const int i = lane & 15, g = lane >> 4, p = (lane >> 3) & 1, b = lane & 7;
    f32x4 C[16]; bf16x8_t A[16];
    const int abase = LT - 32 * (1 + 16 * wave) - i + 8 * g;
#pragma unroll
    for (int tb = 0; tb < 16; ++tb) { C[tb] = (f32x4){0.f, 0.f, 0.f, 0.f}; A[tb] = toep_frag(R32, abase - 32 * tb); }
    const LAS unsigned char* bptr = uus + b * UROW + (16 * p + 8 * g) * 2;
#define HC_STEP(ph, n) do { A[(16 - (ph)) & 15] = toep_frag(R32, abase + 32 * (n)); const bf16x8_t Bf = *(const LAS bf16x8_t*)(bptr + (n) * 64); \
        _Pragma("unroll") for (int tb = 0; tb < 16; ++tb) C[tb] = __builtin_amdgcn_mfma_f32_16x16x32_bf16(A[(tb - (ph)) & 15], Bf, C[tb], 0, 0, 0); } while (0)
    for (int G = 0; G < 8; ++G) { const int n0 = G * 16;
        HC_STEP(0, n0); HC_STEP(1, n0 + 1); HC_STEP(2, n0 + 2); HC_STEP(3, n0 + 3); HC_STEP(4, n0 + 4); HC_STEP(5, n0 + 5); HC_STEP(6, n0 + 6); HC_STEP(7, n0 + 7);
        HC_STEP(8, n0 + 8); HC_STEP(9, n0 + 9); HC_STEP(10, n0 + 10); HC_STEP(11, n0 + 11); HC_STEP(12, n0 + 12); HC_STEP(13, n0 + 13); HC_STEP(14, n0 + 14); HC_STEP(15, n0 + 15); }
    HC_STEP(0, 128);
#undef HC_STEP
#pragma unroll
    for (int tb = 0; tb < 16; ++tb) { const int tq = 512 * wave + 32 * tb + 16 * p + 4 * g;
        u32x2 w; w.x = pk2(C[tb][0], C[tb][1]); w.y = pk2(C[tb][2], C[tb][3]);
        *(u32x2*)(cvt + ((size_t)c * NB + b) * SEQ + tq) = w; }
    __syncthreads();
}
__device__ __forceinline__ void rg_item(const Args& a, LAS unsigned char* lds, int it, int tid, int wave, int lane) {
    constexpr int XROW = 272;
    const int head = it & 7, dir = (it >> 3) & 1, b = it >> 4;
    const bf16_t* xb = (const bf16_t*)(a.ws + WS_RGX) + (size_t)b * LT * DRG + head * 128;
    bf16_t* hout = (bf16_t*)a.out + (size_t)dir * T * DRG + (size_t)b * SEQ * DRG + head * 128 + 16 * wave + (lane & 15);
    const int col = lane & 15, g = lane >> 4, ch = head * 128 + 16 * wave + col;
    LAS unsigned char* wl = lds + 2 * 64 * XROW + wave * 1024 + lane * 16;
#pragma unroll
    for (int gt = 0; gt < 2; ++gt)
#pragma unroll
        for (int ks = 0; ks < 4; ++ks) { const float* wp = a.in[I_RGGW] + ((size_t)((dir * 2 + gt) * 8 + head) * 128 + 32 * ks + 8 * g) * 128 + 16 * wave + col;
            u32x4 o; o.x = pk2(wp[0], wp[128]); o.y = pk2(wp[256], wp[384]); o.z = pk2(wp[512], wp[640]); o.w = pk2(wp[768], wp[896]); *(LAS u32x4*)(wl + (gt * 4 + ks) * 8192) = o; }
    const float br = a.in[I_RGGB][(size_t)(dir * 2 + 0) * DRG + ch], bi = a.in[I_RGGB][(size_t)(dir * 2 + 1) * DRG + ch];
    const float sp8 = -8.0f * log1pf(__expf(-a.in[I_RGLAM][dir * DRG + ch]));
    const int ctr = tid >> 4, ccg = tid & 15;
    float cwv[4][8], cbv[8];
#pragma unroll
    for (int i = 0; i < 8; ++i) { cbv[i] = a.in[I_RGCB][(size_t)dir * DRG + head * 128 + 8 * ccg + i];
#pragma unroll
        for (int j = 0; j < 4; ++j) cwv[j][i] = a.in[I_RGCW][((size_t)dir * 4 + j) * DRG + head * 128 + 8 * ccg + i]; }
    u32x4 xr[2][4];
#define RG_LOAD(k) do { _Pragma("unroll") for (int h_ = 0; h_ < 2; ++h_) { const int u_ = 64 * (k) + ctr + 32 * h_; _Pragma("unroll") for (int j = 0; j < 4; ++j) { const int uu_ = u_ - j; \
        if (uu_ >= 0 && uu_ < LT) { const int t_ = dir ? (LT - 1 - uu_) : uu_; xr[h_][j] = *(const u32x4*)(xb + (size_t)t_ * DRG + 8 * ccg); } \
        else xr[h_][j] = (u32x4){0u, 0u, 0u, 0u}; } } } while (0)
#define RG_CONV(k) do { _Pragma("unroll") for (int h_ = 0; h_ < 2; ++h_) { const int u_ = 64 * (k) + ctr + 32 * h_; float o_[8]; _Pragma("unroll") for (int i = 0; i < 8; ++i) o_[i] = (u_ < LT) ? cbv[i] : 0.f; \
        _Pragma("unroll") for (int j = 0; j < 4; ++j) { float f_[8]; unpack8(xr[h_][j], f_); _Pragma("unroll") for (int i = 0; i < 8; ++i) o_[i] += f_[i] * cwv[j][i]; } \
        u32x4 w0_; w0_.x = pk2(o_[0], o_[1]); w0_.y = pk2(o_[2], o_[3]); w0_.z = pk2(o_[4], o_[5]); w0_.w = pk2(o_[6], o_[7]); \
        *(LAS u32x4*)(lds + ((k) & 1) * (64 * XROW) + (ctr + 32 * h_) * XROW + ccg * 16) = w0_; } } while (0)
    RG_LOAD(0); RG_CONV(0); RG_LOAD(1);
    __syncthreads();
    float carry = 0.f;
    const int arow = 16 * (col >> 2) + (col & 3);
    for (int k = 0; k < 65; ++k) {
        if (k + 1 < 65) RG_CONV(k + 1);
        if (k + 2 < 65) RG_LOAD(k + 2);
        const LAS unsigned char* xa = lds + (k & 1) * (64 * XROW);
        unsigned hp[16]; float hh = 0.f, PP = 1.f;
#pragma unroll
        for (int mp = 0; mp < 2; ++mp) {
            f32x4 acc[2][2];
#pragma unroll
            for (int m2 = 0; m2 < 2; ++m2) { const int mb = 2 * mp + m2; acc[0][m2] = (f32x4){0.f, 0.f, 0.f, 0.f}; acc[1][m2] = (f32x4){0.f, 0.f, 0.f, 0.f};
#pragma unroll
                for (int ks = 0; ks < 4; ++ks) { const bf16x8_t Af = *(const LAS bf16x8_t*)(xa + (arow + 4 * mb) * XROW + (32 * ks + 8 * g) * 2);
                    acc[0][m2] = __builtin_amdgcn_mfma_f32_16x16x32_bf16(Af, *(const LAS bf16x8_t*)(wl + ks * 8192), acc[0][m2], 0, 0, 0);
                    acc[1][m2] = __builtin_amdgcn_mfma_f32_16x16x32_bf16(Af, *(const LAS bf16x8_t*)(wl + (4 + ks) * 8192), acc[1][m2], 0, 0, 0); } }
#pragma unroll
            for (int m2 = 0; m2 < 2; ++m2)
#pragma unroll
                for (int r = 0; r < 4; ++r) { const int e = 8 * mp + 4 * m2 + r, tau = 16 * g + e, u = 64 * k + tau;
                    const float rr = sigmoidf_(acc[0][m2][r] + br), ii = sigmoidf_(acc[1][m2][r] + bi);
                    float av = fexp(sp8 * rr); float mult = __builtin_amdgcn_sqrtf(fmaxf(1.0f - av * av, 0.f)); mult = (u == 0) ? 1.0f : mult;
                    const float xcv = bf2f(*(const LAS unsigned short*)(xa + tau * XROW + (16 * wave + col) * 2));
                    float bq = mult * ii * xcv; if (u >= LT) { av = 1.f; bq = 0.f; }
                    hh = av * hh + bq; PP *= av; hp[e] = pk2(hh, PP); }
        }
        float Pg[4], hg[4];
#pragma unroll
        for (int q = 0; q < 4; ++q) { Pg[q] = __shfl(PP, col + 16 * q); hg[q] = __shfl(hh, col + 16 * q); }
        const float H0 = carry, H1 = Pg[0] * H0 + hg[0], H2 = Pg[1] * H1 + hg[1], H3 = Pg[2] * H2 + hg[2], H4 = Pg[3] * H3 + hg[3];
        const float Hin = (g == 0) ? H0 : (g == 1) ? H1 : (g == 2) ? H2 : H3;
        carry = H4;
#pragma unroll
        for (int e = 0; e < 16; ++e) { const int u = 64 * k + 16 * g + e; const int t = dir ? (LT - 1 - u) : u;
            if (u < LT && t >= NMETA) hout[(size_t)(t - NMETA) * DRG] = (bf16_t)f2bf(bflo(hp[e]) + bfhi(hp[e]) * Hin); }
        __syncthreads();
    }
#undef RG_LOAD
#undef RG_CONV
}
__device__ __forceinline__ float dpp_xor8(float v) { return __int_as_float(__builtin_amdgcn_update_dpp(0, __float_as_int(v), 0x128, 0xF, 0xF, true)); }
__device__ __forceinline__ void rg_item2(const Args& a, LAS unsigned char* lds, int it, int tid, int wave, int lane) {
    constexpr int XROW = 272;
    const int hh = it & 1, head = (it >> 1) & 7, dir = (it >> 4) & 1, b = it >> 5;
    const bf16_t* xb = (const bf16_t*)(a.ws + WS_RGX) + (size_t)b * LT * DRG + head * 128;
    const int col = lane & 15, g = lane >> 4, gate = col >> 3, cj = col & 7, chl = 64 * hh + 8 * wave + cj, ch = head * 128 + chl, qg = 2 * g + gate;
    bf16_t* hout = (bf16_t*)a.out + (size_t)dir * T * DRG + (size_t)b * SEQ * DRG + ch;
    bf16x8_t Wf[4];
#pragma unroll
    for (int ks = 0; ks < 4; ++ks) { const float* wp = a.in[I_RGGW] + ((size_t)((dir * 2 + gate) * 8 + head) * 128 + 32 * ks + 8 * g) * 128 + chl;
        u32x4 o; o.x = pk2(wp[0], wp[128]); o.y = pk2(wp[256], wp[384]); o.z = pk2(wp[512], wp[640]); o.w = pk2(wp[768], wp[896]); Wf[ks] = __builtin_bit_cast(bf16x8_t, o); }
    const float LOG2E = 1.4426950408889634f;
    const float bgl = a.in[I_RGGB][(size_t)(dir * 2 + gate) * DRG + ch] * LOG2E;
    const float sp8l = -8.0f * log1pf(__expf(-a.in[I_RGLAM][dir * DRG + ch])) * LOG2E;
    const int ctr = tid >> 4, ccg = tid & 15;
    float cwv[4][8], cbv[8];
#pragma unroll
    for (int i = 0; i < 8; ++i) { cbv[i] = a.in[I_RGCB][(size_t)dir * DRG + head * 128 + 8 * ccg + i];
#pragma unroll
        for (int j = 0; j < 4; ++j) cwv[j][i] = a.in[I_RGCW][((size_t)dir * 4 + j) * DRG + head * 128 + 8 * ccg + i]; }
    u32x4 xr[2][4];
#define RG_LOAD(k) do { _Pragma("unroll") for (int h_ = 0; h_ < 2; ++h_) { const int u_ = 64 * (k) + ctr + 32 * h_; _Pragma("unroll") for (int j = 0; j < 4; ++j) { const int uu_ = u_ - j; \
        if (uu_ >= 0 && uu_ < LT) { const int t_ = dir ? (LT - 1 - uu_) : uu_; xr[h_][j] = *(const u32x4*)(xb + (size_t)t_ * DRG + 8 * ccg); } \
        else xr[h_][j] = (u32x4){0u, 0u, 0u, 0u}; } } } while (0)
#define RG_CONV(k) do { _Pragma("unroll") for (int h_ = 0; h_ < 2; ++h_) { const int u_ = 64 * (k) + ctr + 32 * h_; float o_[8]; _Pragma("unroll") for (int i = 0; i < 8; ++i) o_[i] = (u_ < LT) ? cbv[i] : 0.f; \
        _Pragma("unroll") for (int j = 0; j < 4; ++j) { float f_[8]; unpack8(xr[h_][j], f_); _Pragma("unroll") for (int i = 0; i < 8; ++i) o_[i] += f_[i] * cwv[j][i]; } \
        u32x4 w0_; w0_.x = pk2(o_[0], o_[1]); w0_.y = pk2(o_[2], o_[3]); w0_.z = pk2(o_[4], o_[5]); w0_.w = pk2(o_[6], o_[7]); \
        *(LAS u32x4*)(lds + ((k) & 1) * (64 * XROW) + (ctr + 32 * h_) * XROW + ccg * 16) = w0_; } } while (0)
    RG_LOAD(0); RG_CONV(0); RG_LOAD(1);
    __syncthreads();
    float carry = 0.f;
    const int arow = 16 * (col >> 2) + (col & 3);
    for (int k = 0; k < 65; ++k) {
        if (k + 1 < 65) RG_CONV(k + 1);
        if (k + 2 < 65) RG_LOAD(k + 2);
        const LAS unsigned char* xa = lds + (k & 1) * (64 * XROW);
        f32x4 acc[4];
#pragma unroll
        for (int mb = 0; mb < 4; ++mb) { acc[mb] = (f32x4){0.f, 0.f, 0.f, 0.f};
#pragma unroll
            for (int ks = 0; ks < 4; ++ks) acc[mb] = __builtin_amdgcn_mfma_f32_16x16x32_bf16(*(const LAS bf16x8_t*)(xa + (arow + 4 * mb) * XROW + (32 * ks + 8 * g) * 2), Wf[ks], acc[mb], 0, 0, 0); }
        float sg[16], ot[16];
#pragma unroll
        for (int e = 0; e < 16; ++e) { sg[e] = __builtin_amdgcn_rcpf(1.0f + __builtin_amdgcn_exp2f(-(acc[e >> 2][e & 3] * LOG2E + bgl))); ot[e] = dpp_xor8(sg[e]); }
        unsigned hp[8]; float hs = 0.f, PP = 1.f;
#pragma unroll
        for (int t = 0; t < 8; ++t) { const float rr = gate ? ot[8 + t] : sg[t], ii = gate ? sg[8 + t] : ot[t]; const int tau = 8 * qg + t, u = 64 * k + tau;
            float av = __builtin_amdgcn_exp2f(sp8l * rr); float mult = __builtin_amdgcn_sqrtf(fmaxf(1.0f - av * av, 0.f)); mult = (u == 0) ? 1.0f : mult;
            const float xcv = bf2f(*(const LAS unsigned short*)(xa + tau * XROW + chl * 2));
            float bq = mult * ii * xcv; if (u >= LT) { av = 1.f; bq = 0.f; }
            hs = av * hs + bq; PP *= av; hp[t] = pk2(hs, PP); }
        float H = carry, Hin = carry;
#pragma unroll
        for (int q = 0; q < 8; ++q) { const int src = cj + 8 * (q & 1) + 16 * (q >> 1); const float Pq = __shfl(PP, src), hq = __shfl(hs, src);
            Hin = (qg == q) ? H : Hin; H = Pq * H + hq; }
        carry = H;
#pragma unroll
        for (int t = 0; t < 8; ++t) { const int u = 64 * k + 8 * qg + t; const int tt = dir ? (LT - 1 - u) : u;
            if (u < LT && tt >= NMETA) hout[(size_t)(tt - NMETA) * DRG] = (bf16_t)f2bf(bflo(hp[t]) + bfhi(hp[t]) * Hin); }
        __syncthreads();
    }
#undef RG_LOAD
#undef RG_CONV
}

#ifndef RG_NAIVE
#define RG_NAIVE 0
#endif
#ifndef CONV_NAIVE
#define CONV_NAIVE 0
#endif
#ifndef ONE_LAUNCH
#define ONE_LAUNCH 0
#endif
constexpr int NPHASE = 13;
#ifndef NVGPR
#define NVGPR 248
#endif
__global__ void __launch_bounds__(NTHR, 2) __attribute__((amdgpu_num_vgpr(NVGPR))) mega(Args a) {
    extern __shared__ __attribute__((aligned(16))) unsigned char lds_raw[];
    LAS unsigned char* lds = (LAS unsigned char*)lds_raw;
    const int tid = threadIdx.x, lane = tid & 63, wave = __builtin_amdgcn_readfirstlane(tid >> 6);
    cg::grid_group grid = cg::this_grid();
    volatile LAS unsigned* bst = (volatile LAS unsigned*)(lds + LDS_BYTES - 64);
    if (tid == 0) { bst[0] = 0u; bst[1] = 0u; }
    __syncthreads();
    XcdBarrier xbar; xbar.bar = (unsigned*)(a.ws + WS_BAR); xbar.x = 0; xbar.st = bst;
    if (a.ph_hi - a.ph_lo > 1) xbar = xcd_barrier_post((unsigned*)(a.ws + WS_BAR), bst);
    const int lo = a.ph_lo, hi = a.ph_hi, G = gridDim.x, bx = blockIdx.x;
#ifndef PHMASK
#define PHMASK 0x1fff
#endif
#ifndef REPMASK
#define REPMASK 0
#endif
#define IN(k) (((PHMASK >> (k)) & 1) && lo <= (k) && (k) < hi)
#define REP(k)
#define SEAM(k) do { if (IN(k) && IN((k) + 1)) xcd_barrier(xbar); } while (0)
    if (a.ph_lo < 0) grid.sync();
    unsigned char* ws = a.ws;
    REP(0) if (IN(0)) phase_p0(a, lds, tid, wave, lane);
    SEAM(0);
    REP(1) if (IN(1)) {
        p1_meta(a, lds, tid, wave, lane);
        pg8::Gemm g{(const bf16_t*)(ws + WS_XN1), (const bf16_t*)(ws + WS_WINT), T, DIN, 1024}; pg8::StaticOrder S; S.init(T, DIN, G, bx);
        EpiProj E{(bf16_t*)(ws + WS_HYIN), (bf16_t*)(ws + WS_RGX), (bf16_t*)(ws + WS_GG), (bf16_t*)(ws + WS_GA), (bf16_t*)(ws + WS_GB), a.in[I_BGATE]};
        pg8::gemm_phase<EpiProj, pg8::StaticOrder>(lds, g, S, E, nullptr);
    }
    SEAM(1);
    REP(2) if (IN(2)) phase_hy_pre(a, lds, tid);
    SEAM(2);
    REP(3) if (IN(3)) {
#if CONV_NAIVE
        phase_hy_conv_naive(a, lds, tid);
#else
        for (int c = bx; c < DHY; c += G) hy_conv_channel(a, lds, c, tid, wave, lane);
#endif
#if RG_NAIVE
        phase_rg_naive(a, lds, tid);
#else
        for (int it = bx; it < NB * 2 * 8 * 2; it += G) rg_item2(a, lds, it, tid, wave, lane);
#endif
    }
    SEAM(3);
    REP(4) if (IN(4)) phase_post(a, lds, tid);
    SEAM(4);
    REP(5) if (IN(5)) {
        { pg8::Gemm g{(const bf16_t*)(ws + WS_YH), (const bf16_t*)(ws + WS_WHT), T, 1024, 512}; pg8::StaticOrder S; S.init(T, 1024, G, bx);
          EpiGate<0> E{(const bf16_t*)(ws + WS_GA), nullptr, (bf16_t*)(ws + WS_TMP)};
          pg8::gemm_phase<EpiGate<0>, pg8::StaticOrder>(lds, g, S, E, nullptr); }
        { pg8::Gemm g{(const bf16_t*)(ws + WS_YR), (const bf16_t*)(ws + WS_WRT), T, 1024, 1024}; pg8::StaticOrder S; S.init(T, 1024, G, bx);
          EpiGate<1> E{(const bf16_t*)(ws + WS_GB), (const bf16_t*)(ws + WS_TMP), (bf16_t*)(ws + WS_MERGED)};
          pg8::gemm_phase<EpiGate<1>, pg8::StaticOrder>(lds, g, S, E, nullptr); }
    }
    SEAM(5);
    REP(6) if (IN(6)) {
        pg8::Gemm g{(const bf16_t*)(ws + WS_MERGED), (const bf16_t*)(ws + WS_WOT), T, 1024, 1024}; pg8::StaticOrder S; S.init(T, 1024, G, bx);
        EpiResid E{a.in[I_X], (bf16_t*)(ws + WS_H1B), (float*)(ws + WS_ROWSS)};
        pg8::gemm_phase<EpiResid, pg8::StaticOrder>(lds, g, S, E, nullptr);
    }
    SEAM(6);
    REP(7) if (IN(7)) {
        phase_tables(a, wave, lane);
        pg8::Gemm g{(const bf16_t*)(ws + WS_H1B), (const bf16_t*)(ws + WS_WST), T, 2048, 1024}; pg8::StaticOrder S; S.init(T, 2048, G, bx);
        EpiScores E{(const float*)(ws + WS_ROWSS), (_Float16*)(ws + WS_SCORES)};
        pg8::gemm_phase<EpiScores, pg8::StaticOrder>(lds, g, S, E, nullptr);
    }
    SEAM(7);
    REP(8) if (IN(8)) phase_topk(a, lds, wave, lane);
    SEAM(8);
#ifndef U_VALU
#define U_VALU 1
#endif
    REP(9) if (IN(9)) { if (U_VALU) phase_peer_u(a, wave, lane); else phase_peer_u_mfma(a, lds, wave, lane); }
    SEAM(9);
    if (IN(10)) phase_peer_act(a, tid);
    SEAM(10);
    if (IN(11)) phase_peer_v(a, wave, lane);
    SEAM(11);
    if (IN(12)) phase_final(a, wave, lane);
#undef IN
#undef SEAM
}

extern "C" void kernel_launch(void* const* d_in, const int* in_sizes, int n_in, void* d_out, int out_size, void* d_ws, size_t ws_size, hipStream_t stream) {
    static int grid = 0;
    if (grid == 0) {
        if (n_in != N_IN || out_size != T * DM || ws_size < WS_END) { fprintf(stderr, "kernel_launch: unexpected shapes (n_in %d out %d ws %zu)\n", n_in, out_size, ws_size); grid = -1; return; }
        if (hipFuncSetAttribute((const void*)mega, hipFuncAttributeMaxDynamicSharedMemorySize, LDS_BYTES) != hipSuccess) { fprintf(stderr, "kernel_launch: hipFuncSetAttribute failed\n"); grid = -1; return; }
        int dev = 0, cus = 0, per_cu = 0;
        hipGetDevice(&dev); hipDeviceGetAttribute(&cus, hipDeviceAttributeMultiprocessorCount, dev);
        hipOccupancyMaxActiveBlocksPerMultiprocessor(&per_cu, (const void*)mega, NTHR, LDS_BYTES);
        if (per_cu < 1) { fprintf(stderr, "kernel_launch: occupancy query says %d blocks per CU\n", per_cu); per_cu = 1; }
        (void)hipGetLastError();
        grid = cus;
    }
    if (grid < 0) return;
    Args a{};
    for (int i = 0; i < N_IN; ++i) a.in[i] = (const float*)d_in[i];
    a.out = (float*)d_out; a.ws = (unsigned char*)d_ws;
#if ONE_LAUNCH
    if (hipMemsetAsync((char*)d_ws + WS_BAR, 0, XCD_BAR_WORDS * 4, stream) != hipSuccess) { fprintf(stderr, "kernel_launch: memset of the barrier words failed\n"); return; }
    a.ph_lo = 0; a.ph_hi = NPHASE;
    void* args[] = {&a};
    hipError_t e = hipLaunchCooperativeKernel((const void*)mega, dim3(grid), dim3(NTHR), args, LDS_BYTES, stream);
    if (e != hipSuccess) fprintf(stderr, "cooperative launch failed: %s (grid %d)\n", hipGetErrorString(e), grid);
#else
    for (int ph = 0; ph < NPHASE; ++ph) for (int rep = 0; rep < 1 + ((REPMASK >> ph) & 1); ++rep) { a.ph_lo = ph; a.ph_hi = ph + 1;
        if (ph == 6 && rep == 1) (void)hipMemsetAsync((char*)d_ws + WS_ROWSS, 0, T * 4, stream);
        hipLaunchKernelGGL(mega, dim3(grid), dim3(NTHR), LDS_BYTES, stream, a);
        hipError_t e = hipPeekAtLastError(); if (e != hipSuccess) { fprintf(stderr, "launch %d failed: %s\n", ph, hipGetErrorString(e)); break; } }
#endif
}
```

```cpp
#define ONE_LAUNCH 1
#include <hip/hip_runtime.h>
#include <hip/hip_cooperative_groups.h>
#include <cstdio>
#include <cstdint>
#include <cmath>
namespace cg = cooperative_groups;
namespace pg8 {
#define PG8_LAS __attribute__((address_space(3)))
typedef unsigned short bf16_t;
typedef short bf16x8 __attribute__((ext_vector_type(8)));
typedef float f32x4 __attribute__((ext_vector_type(4)));
typedef unsigned u32x4 __attribute__((ext_vector_type(4)));
constexpr int BM = 256, BK = 64, HALF = 128, HTB = HALF * BK * 2  , STAGE_BYTES = 8 * HTB, NXCD = 8, WGM = 8;

__host__ __device__ __forceinline__ int lds_byte(int r, int c) { const int st = (r >> 4) * 2 + (c >> 5), rr = r & 15, cc = c & 31, ob = rr * 64 + cc * 2; return st * 1024 + (ob ^ (((ob >> 9) & 1) << 5)); }
__host__ __device__ __forceinline__ void stage_rc(int b, int& R, int& C) { const int st = b / 1024, sb = b % 1024, swz = sb ^ (((sb >> 9) & 1) << 5); R = (st >> 1) * 16 + swz / 64; C = (st & 1) * 32 + (swz % 64) / 2; }
__host__ __device__ __forceinline__ int perm32(int rho) { const int n = rho >> 4, i = rho & 15; return 8 * (i >> 2) + 4 * n + (i & 3); }

struct Unit { int pm, pn; };
struct Gemm { const bf16_t* A; const bf16_t* Bt; int M, N, K; };

struct StaticOrder {
    int nM, nN, nwg, G, c;
    __host__ __device__ void init(int M, int N, int G_, int c_) { nM = M / BM; nN = N / BM; nwg = nM * nN; G = G_; c = c_; }
    __host__ __device__ bool next(int i, Unit& u) const {
        const long L = (long)i * G + c; if (L >= nwg) return false;
        int wgid = (int)L; { const int q = nwg / NXCD, r = nwg % NXCD, xcd = wgid % NXCD, off = wgid / NXCD; wgid = (xcd < r ? xcd * (q + 1) : r * (q + 1) + (xcd - r) * q) + off; }
        const int nig = WGM * nN, gid = wgid / nig, fm = gid * WGM, gsz = (nM - fm) < WGM ? (nM - fm) : WGM;
        u.pm = fm + ((wgid % nig) % gsz); u.pn = (wgid % nig) / gsz; return true;
    }
    __device__ __forceinline__ void a_ready(const Unit&) const {}
    __device__ __forceinline__ void done(const Unit&) const {}
};
__device__ __forceinline__ unsigned cvt_pk_bf16(float lo, float hi) { unsigned r; asm volatile("v_cvt_pk_bf16_f32 %0, %1, %2" : "=v"(r) : "v"(lo), "v"(hi)); return r; }
typedef float f32x2 __attribute__((ext_vector_type(2)));
__device__ __forceinline__ f32x2 gelu_pk(f32x2 v) {
    const f32x2 av = __builtin_elementwise_abs(v), d = av * 0.2316418882f + 1.0f;
    f32x2 t; t.x = __builtin_amdgcn_rcpf(d.x); t.y = __builtin_amdgcn_rcpf(d.y);
    f32x2 q = t * 0.5307027145f + (-0.7265760135f); q = q * t + 0.7107068705f; q = q * t + (-0.142248368f); q = q * t + 0.127414796f; q = q * t;
    const f32x2 s = (v * v) * (-0.72134752044f);
    f32x2 e; e.x = __builtin_amdgcn_exp2f(s.x); e.y = __builtin_amdgcn_exp2f(s.y);
    const f32x2 m = v * (q * e), r = v - m;
    f32x2 o; o.x = v.x < 0.f ? m.x : r.x; o.y = v.y < 0.f ? m.y : r.y; return o;
}
template <class Epi, class Sched, bool STAMP = false>
__device__ __forceinline__ void gemm_phase(PG8_LAS unsigned char* lds, const Gemm g, const Sched& S, const Epi& E, unsigned long long* stamps) {
    const int tid = threadIdx.x, wid = __builtin_amdgcn_readfirstlane(tid >> 6), lane = tid & 63, wr = wid >> 2, wc = wid & 3, fr = lane & 15, fq = lane >> 4;
    const int K = g.K, nt = K / BK;
    int ts_lo = 0, ts_hi = 0, nts = 0; const unsigned long long rt_entry = STAMP ? (unsigned long long)wall_clock64() : 0ull;
#define PG8_STAMP() do { if (STAMP && wid == 0 && nts < 64) { const unsigned long long _c = (unsigned long long)clock64(); \
        ts_lo = (lane == nts) ? (int)(unsigned)_c : ts_lo; ts_hi = (lane == nts) ? (int)(unsigned)(_c >> 32) : ts_hi; ++nts; } } while (0)
    PG8_STAMP();
    unsigned voffA[2], voffB[2];
#pragma unroll
    for (int i = 0; i < 2; ++i) { int R, C; stage_rc(tid * 16 + i * 8192, R, C); const int Rb = Epi::PERM ? ((R & ~31) + perm32(R & 31)) : R;
        voffA[i] = (unsigned)(R * K + C) * 2u; voffB[i] = (unsigned)(Rb * K + C) * 2u; }
    const size_t kstep = (size_t)(BK * 2);
    const size_t hstep = (size_t)HALF * K * 2;
    const size_t tstep = 2 * hstep;
    const unsigned ldsw = (unsigned)wid * 1024u;
    const int aoff = lds_byte(wr * 64 + fr, fq * 8), boff = lds_byte(wc * 32 + fr, fq * 8);
#define PG8_SA(b, h) (((b) * 2 + (h)) * HTB)
#define PG8_SB(b, h) ((4 + (b) * 2 + (h)) * HTB)
#define PG8_STAGE(bufoff, gbase, voff) do { _Pragma("unroll") for (int _i = 0; _i < 2; ++_i) \
        __builtin_amdgcn_global_load_lds((const unsigned*)((const char*)(gbase) + (voff)[_i]), (PG8_LAS unsigned*)(lds + (bufoff) + ldsw + _i * 8192), 16, 0, 0); } while (0)
#define PG8_LDA(dst, b, h) do { _Pragma("unroll") for (int m = 0; m < 4; ++m) _Pragma("unroll") for (int k = 0; k < 2; ++k) dst[m][k] = *(const PG8_LAS bf16x8*)(lds + PG8_SA(b, h) + aoff + m * 2048 + k * 1024); } while (0)
#define PG8_LDB(dst, b, h) do { _Pragma("unroll") for (int n = 0; n < 2; ++n) _Pragma("unroll") for (int k = 0; k < 2; ++k) dst[n][k] = *(const PG8_LAS bf16x8*)(lds + PG8_SB(b, h) + boff + n * 2048 + k * 1024); } while (0)
#define PG8_MMA(ai, bj, At, Bt) do { __builtin_amdgcn_s_setprio(1); _Pragma("unroll") for (int m = 0; m < 4; ++m) _Pragma("unroll") for (int n = 0; n < 2; ++n) _Pragma("unroll") for (int k = 0; k < 2; ++k) \
        acc[ai][bj][m][n] = __builtin_amdgcn_mfma_f32_16x16x32_bf16(Bt[n][k], At[m][k], acc[ai][bj][m][n], 0, 0, 0); __builtin_amdgcn_s_setprio(0); } while (0)
#define PG8_WAIT_V(n) asm volatile("s_waitcnt vmcnt(" #n ")" ::: "memory")
#define PG8_WAIT_L(n) asm volatile("s_waitcnt lgkmcnt(" #n ")" ::: "memory")
#define PG8_BAR __builtin_amdgcn_s_barrier()
#define PG8_SCHED __builtin_amdgcn_sched_barrier(0)
    Unit cur, nxt; int ui = 0;
    if (!S.next(0, cur)) return;
    f32x4 acc[2][2][4][2];
#pragma unroll
    for (int a = 0; a < 2; ++a)
#pragma unroll
        for (int b = 0; b < 2; ++b)
#pragma unroll
            for (int m = 0; m < 4; ++m)
#pragma unroll
                for (int n = 0; n < 2; ++n) acc[a][b][m][n] = (f32x4){0.f, 0.f, 0.f, 0.f};
    bf16x8 At[4][2], B0[2][2], B1[2][2];
    const char* cA = (const char*)g.A + (size_t)cur.pm * tstep; const char* cB = (const char*)g.Bt + (size_t)cur.pn * tstep;
    S.a_ready(cur);
    PG8_STAGE(PG8_SB(0, 0), cB, voffB); PG8_STAGE(PG8_SA(0, 0), cA, voffA); PG8_STAGE(PG8_SB(0, 1), cB + hstep, voffB); PG8_STAGE(PG8_SA(0, 1), cA + hstep, voffA);
    if (wr == 1) PG8_BAR;
    PG8_WAIT_V(4); PG8_BAR;
    PG8_STAGE(PG8_SB(1, 0), cB + kstep, voffB); PG8_STAGE(PG8_SA(1, 0), cA + kstep, voffA); PG8_STAGE(PG8_SB(1, 1), cB + hstep + kstep, voffB);
    PG8_WAIT_V(6); PG8_BAR;
    PG8_STAMP();
    for (;;) {
        const bool has_next = S.next(ui + 1, nxt);
        const char* nA = has_next ? (const char*)g.A + (size_t)nxt.pm * tstep : cA; const char* nB = has_next ? (const char*)g.Bt + (size_t)nxt.pn * tstep : cB;
        for (int t = 0; t < nt; t += 2) {
            const bool last = (t == nt - 2);
            const char* a1 = cA + (size_t)(t + 1) * kstep;
            const char* a2 = last ? nA : cA + (size_t)(t + 2) * kstep; const char* b2 = last ? nB : cB + (size_t)(t + 2) * kstep;
            const char* a3 = a2 + kstep; const char* b3 = b2 + kstep;
            if (last && has_next) S.a_ready(nxt);
            PG8_LDB(B0, 0, 0); PG8_SCHED; PG8_LDA(At, 0, 0); PG8_STAGE(PG8_SA(1, 1), a1 + hstep, voffA);
            PG8_WAIT_L(8); PG8_BAR; PG8_WAIT_L(0); PG8_MMA(0, 0, At, B0); PG8_BAR; PG8_SCHED;
            PG8_LDB(B1, 0, 1); PG8_STAGE(PG8_SB(0, 0), b2, voffB);
            PG8_BAR; PG8_WAIT_L(0); PG8_MMA(0, 1, At, B1); PG8_BAR;
            PG8_LDA(At, 0, 1); PG8_STAGE(PG8_SA(0, 0), a2, voffA);
            PG8_BAR; PG8_WAIT_L(0); PG8_MMA(1, 0, At, B0); PG8_BAR; PG8_SCHED;
            PG8_STAGE(PG8_SB(0, 1), b2 + hstep, voffB);
            PG8_WAIT_V(6); PG8_BAR; PG8_MMA(1, 1, At, B1); PG8_BAR;
            PG8_LDB(B0, 1, 0); PG8_SCHED; PG8_LDA(At, 1, 0); PG8_STAGE(PG8_SA(0, 1), a2 + hstep, voffA);
            PG8_WAIT_L(8); PG8_BAR; PG8_WAIT_L(0); PG8_MMA(0, 0, At, B0); PG8_BAR; PG8_SCHED;
            PG8_LDB(B1, 1, 1); PG8_STAGE(PG8_SB(1, 0), b3, voffB);
            PG8_BAR; PG8_WAIT_L(0); PG8_MMA(0, 1, At, B1); PG8_BAR;
            PG8_LDA(At, 1, 1); PG8_STAGE(PG8_SA(1, 0), a3, voffA);
            PG8_BAR; PG8_WAIT_L(0); PG8_MMA(1, 0, At, B0); PG8_BAR; PG8_SCHED;
            PG8_STAGE(PG8_SB(1, 1), b3 + hstep, voffB);
            PG8_WAIT_V(6); PG8_BAR; PG8_MMA(1, 1, At, B1); PG8_BAR;
        }
        PG8_STAMP();
        if constexpr (!Epi::AFTER_DRAIN) { E(acc, cur, wr, wc, fr, fq); S.done(cur); }
        PG8_STAMP();
        if (!has_next) break;
#pragma unroll
        for (int a = 0; a < 2; ++a)
#pragma unroll
            for (int b = 0; b < 2; ++b)
#pragma unroll
                for (int m = 0; m < 4; ++m)
#pragma unroll
                    for (int n = 0; n < 2; ++n) acc[a][b][m][n] = (f32x4){0.f, 0.f, 0.f, 0.f};
        cur = nxt; cA = nA; cB = nB; ++ui;
    }
    PG8_WAIT_V(0);
    if (wr == 0) PG8_BAR;
    PG8_BAR;
    if constexpr (Epi::AFTER_DRAIN) { E.fused(acc, cur, wr, wc, fr, fq, lds, wid, lane); S.done(cur); }
    PG8_STAMP();
    if (STAMP && wid == 0) { stamps[lane] = lane < nts ? (((unsigned long long)(unsigned)ts_hi << 32) | (unsigned)ts_lo) : 0ull;
        if (lane == 62) stamps[62] = rt_entry; if (lane == 63) stamps[63] = (unsigned long long)wall_clock64(); }
#undef PG8_STAMP
#undef PG8_SA
#undef PG8_SB
#undef PG8_STAGE
#undef PG8_LDA
#undef PG8_LDB
#undef PG8_MMA
#undef PG8_WAIT_V
#undef PG8_WAIT_L
#undef PG8_BAR
#undef PG8_SCHED
}
}

#define LAS __attribute__((address_space(3)))
typedef unsigned short bf16_t;
typedef float f32x4 __attribute__((ext_vector_type(4)));
typedef float f32x2 __attribute__((ext_vector_type(2)));
typedef unsigned u32x4 __attribute__((ext_vector_type(4)));
typedef unsigned u32x2 __attribute__((ext_vector_type(2)));

constexpr int NB = 8, SEQ = 4096, NMETA = 16, LT = SEQ + NMETA, DM = 1024, T = NB * SEQ;
constexpr int DHY = 512, DRG = 1024, DIN = 3 * DHY + 2 * DRG + 2 * DM;
constexpr int NTHR = 512, NWAVES = 8;
constexpr int LDS_BYTES = 160 * 1024;
constexpr float EPSF = 1e-6f;
constexpr int KFW = 2 * LT;
constexpr int SP = 4256;
constexpr int NEXP = 16384;
constexpr int RG_SPLIT = 33, RG_U1 = RG_SPLIT * 64;
constexpr int RG_NF = LT - RG_U1;

enum { I_X = 0, I_META, I_GFINAL, I_GMIX, I_WIN, I_BGATE, I_HYCW, I_HYCB, I_HYW1, I_HYB1, I_HYW2, I_HYB2, I_HYW3, I_HYB3, I_HYFREQ, I_HYSKIP,
       I_HYOUT, I_RGCW, I_RGCB, I_RGGW, I_RGGB, I_RGLAM, I_RGOUT, I_WOUT, I_GFFN, I_WQ, I_KEYS, I_PU, I_PV, N_IN };

constexpr size_t MiB = 1024ull * 1024ull;
constexpr size_t WS_ROWSS = 64 * 1024;
constexpr size_t WS_SU = 256 * 1024;
constexpr size_t WS_SV = 320 * 1024;
constexpr size_t WS_ROWSS2 = 384 * 1024;
constexpr size_t WS_BAR = 512 * 1024;
constexpr size_t WS_WINT = 1 * MiB;
constexpr size_t WS_WHT = 12 * MiB;
constexpr size_t WS_WRT = 13 * MiB;
constexpr size_t WS_WOT = 15 * MiB;
constexpr size_t WS_WST = 17 * MiB;
constexpr size_t WS_GWT = 21 * MiB;
constexpr size_t WS_KF = 22 * MiB;
constexpr size_t WS_KFB = 39 * MiB;
constexpr size_t WS_HYIN = 48 * MiB;
constexpr size_t WS_RGX = 145 * MiB;
constexpr size_t WS_GG = 210 * MiB;
constexpr size_t WS_GA = 274 * MiB;
constexpr size_t WS_GB = 338 * MiB;
constexpr size_t WS_XN1 = 402 * MiB;
constexpr size_t WS_UUT = 402 * MiB;
constexpr size_t WS_CONVT = 436 * MiB;
constexpr size_t WS_YH = 468 * MiB;
constexpr size_t WS_YR = WS_RGX;
constexpr size_t WS_MERGED = WS_HYIN;
constexpr size_t WS_TMP = WS_GG;
constexpr size_t WS_H1B = WS_RGX;
constexpr size_t WS_SCORES = WS_GG;
constexpr size_t WS_EIDX = 468 * MiB;
constexpr size_t WS_EG = 484 * MiB;
constexpr size_t WS_UB = 48 * MiB;
constexpr size_t WS_VB = 64 * MiB;
constexpr size_t WS_PD = 210 * MiB;
constexpr size_t WS_PO = WS_PD;
constexpr size_t WS_ACT = 338 * MiB;
constexpr size_t WS_RGP = 48 * MiB;
constexpr size_t WS_RGC = 576 * 1024;
constexpr size_t WS_END = 500 * MiB;

struct Args { const float* in[N_IN]; float* out; unsigned char* ws; int ph_lo, ph_hi; };

__device__ __forceinline__ float bf2f(unsigned v) { return __uint_as_float(v << 16); }
typedef __bf16 bf16x2_t __attribute__((ext_vector_type(2)));
__device__ __forceinline__ unsigned pk2(float lo, float hi) { bf16x2_t v; v.x = (__bf16)lo; v.y = (__bf16)hi; return __builtin_bit_cast(unsigned, v); }
__device__ __forceinline__ unsigned f2bf(float f) { return pk2(f, f) & 0xffffu; }
__device__ __forceinline__ float bflo(unsigned w) { return __uint_as_float(w << 16); }
__device__ __forceinline__ float bfhi(unsigned w) { return __uint_as_float(w & 0xffff0000u); }
__device__ __forceinline__ float wave_sum(float v) {
#pragma unroll
    for (int o = 1; o < 64; o <<= 1) v += __shfl_xor(v, o);
    return v;
}
__device__ __forceinline__ float wave_max(float v) {
#pragma unroll
    for (int o = 1; o < 64; o <<= 1) v = fmaxf(v, __shfl_xor(v, o));
    return v;
}
__device__ __forceinline__ float fexp(float x) { return __builtin_amdgcn_exp2f(x * 1.4426950408889634f); }
__device__ __forceinline__ float sigmoidf_(float x) { return __builtin_amdgcn_rcpf(1.0f + fexp(-x)); }
__device__ __forceinline__ float gelu_tanh(float x) { const float u = 1.5957691216f * (x + 0.044715f * x * x * x); return x * __builtin_amdgcn_rcpf(1.0f + fexp(-u)); }
__device__ __forceinline__ void sincos_acc(float a, float& s, float& c) {
    const double x = (double)a;
    const double q = rint(x * 0.63661977236758134308);
    const double r = fma(-q, 1.57079632679489661923, x);
    const int n = (int)q;
    const float rf = (float)r, r2 = rf * rf;
    const float sp = rf * (1.f + r2 * (-1.6666667e-1f + r2 * (8.3333333e-3f + r2 * (-1.9841270e-4f + r2 * 2.7557319e-6f))));
    const float cp = 1.f + r2 * (-0.5f + r2 * (4.1666667e-2f + r2 * (-1.3888889e-3f + r2 * (2.4801587e-5f + r2 * (-2.7557319e-7f)))));
    const int k = n & 3;
    s = (k == 0) ? sp : (k == 1) ? cp : (k == 2) ? -sp : -cp;
    c = (k == 0) ? cp : (k == 1) ? -sp : (k == 2) ? -cp : sp;
}

typedef float f32x2v __attribute__((ext_vector_type(2)));
__device__ __forceinline__ float wave_sum_dpp(float v) {
    v += __int_as_float(__builtin_amdgcn_update_dpp(0, __float_as_int(v), 0xB1, 0xF, 0xF, true));
    v += __int_as_float(__builtin_amdgcn_update_dpp(0, __float_as_int(v), 0x4E, 0xF, 0xF, true));
    v += __int_as_float(__builtin_amdgcn_update_dpp(0, __float_as_int(v), 0x141, 0xF, 0xF, true));
    v += __int_as_float(__builtin_amdgcn_update_dpp(0, __float_as_int(v), 0x140, 0xF, 0xF, true));
    const int vi = __float_as_int(v);
    return (__int_as_float(__builtin_amdgcn_readlane(vi, 0)) + __int_as_float(__builtin_amdgcn_readlane(vi, 16))) + (__int_as_float(__builtin_amdgcn_readlane(vi, 32)) + __int_as_float(__builtin_amdgcn_readlane(vi, 48)));
}
__device__ __forceinline__ float wave_max_dpp(float v) {
    v = fmaxf(v, __int_as_float(__builtin_amdgcn_update_dpp(0, __float_as_int(v), 0xB1, 0xF, 0xF, true)));
    v = fmaxf(v, __int_as_float(__builtin_amdgcn_update_dpp(0, __float_as_int(v), 0x4E, 0xF, 0xF, true)));
    v = fmaxf(v, __int_as_float(__builtin_amdgcn_update_dpp(0, __float_as_int(v), 0x141, 0xF, 0xF, true)));
    v = fmaxf(v, __int_as_float(__builtin_amdgcn_update_dpp(0, __float_as_int(v), 0x140, 0xF, 0xF, true)));
    const int vi = __float_as_int(v);
    return fmaxf(fmaxf(__int_as_float(__builtin_amdgcn_readlane(vi, 0)), __int_as_float(__builtin_amdgcn_readlane(vi, 16))), fmaxf(__int_as_float(__builtin_amdgcn_readlane(vi, 32)), __int_as_float(__builtin_amdgcn_readlane(vi, 48))));
}

#ifndef SLICE_PROBE
#define SLICE_OF(b) ((b) & 7)
#define RANK_OF(b) ((b) >> 3)
#else
#define SLICE_OF(b) ((b) >> 5)
#define RANK_OF(b) ((b) & 31)
#endif
#define XB_TMO      128
#define XB_XCNT(j)  (256  + 64 * (j))
#define XB_XSUB(j)  (1280 + 64 * (j))
#define XB_XGEN(j)  (2304 + 64 * (j))
#define XB_TOP      3328
#define XB_TOPGEN   3392
#define XCD_BAR_WORDS 3456
#define XB_SPIN_CAP (1u << 18)

__device__ __forceinline__ unsigned xb_ld(unsigned* p)              { return __hip_atomic_load(p, __ATOMIC_RELAXED, __HIP_MEMORY_SCOPE_AGENT); }
__device__ __forceinline__ unsigned xb_add(unsigned* p, unsigned v) { return __hip_atomic_fetch_add(p, v, __ATOMIC_RELAXED, __HIP_MEMORY_SCOPE_AGENT); }
__device__ __forceinline__ unsigned xb_xcc_id() { return (unsigned)__builtin_amdgcn_s_getreg((3 << 11) | 20) & 0xFu; }
#define XB_SPIN(cond, bar) do { unsigned _sp = 0; while (cond) { __builtin_amdgcn_s_sleep(1); \
    if ((++_sp & 255u) == 0u) { if (xb_ld(&(bar)[XB_TMO])) break; if (_sp > XB_SPIN_CAP) { atomicAdd(&(bar)[XB_TMO], 1u); break; } } } } while (0)

struct XcdBarrier {
    unsigned* bar; unsigned x;
    volatile LAS unsigned* st;
};

__device__ __forceinline__ XcdBarrier xcd_barrier_post(unsigned* bar, volatile LAS unsigned* st) {
    XcdBarrier b; b.bar = bar; b.x = xb_xcc_id(); b.st = st;
    if (threadIdx.x == 0) (void)xb_add(&bar[XB_XCNT(b.x)], 1u);
    return b;
}
__device__ __forceinline__ void xcd_barrier_complete(unsigned* bar, unsigned x, unsigned& nloc, unsigned& nx) {
    const unsigned G = gridDim.x * gridDim.y * gridDim.z;
    unsigned sum, cnt, mine, sp = 0u;
    for (;;) {
        sum = 0u; cnt = 0u; mine = 0u;
#pragma unroll
        for (unsigned j = 0; j < 16; ++j) { const unsigned c = xb_ld(&bar[XB_XCNT(j)]); sum += c; cnt += (c > 0u) ? 1u : 0u; mine = (j == x) ? c : mine; }
        if (sum == G) break;
        __builtin_amdgcn_s_sleep(1);
        if ((++sp & 255u) == 0u) { if (xb_ld(&bar[XB_TMO])) break; if (sp > XB_SPIN_CAP) { atomicAdd(&bar[XB_TMO], 1u); break; } }
    }
    nloc = mine > 0u ? mine : 1u; nx = cnt > 0u ? cnt : 1u;
}

__device__ __forceinline__ void xcd_barrier(const XcdBarrier& b) {
    asm volatile("s_waitcnt vmcnt(0)" ::: "memory");
    __syncthreads();
    if (threadIdx.x == 0) {
        unsigned* bar = b.bar;
        __builtin_amdgcn_s_waitcnt(0);
        unsigned nloc = b.st[0], nx = b.st[1];
        if (nloc == 0u) { xcd_barrier_complete(bar, b.x, nloc, nx); b.st[0] = nloc; b.st[1] = nx; }
        const unsigned old = xb_add(&bar[XB_XSUB(b.x)], 1u);
        const unsigned gen = old / nloc;
        if (old + 1u == (gen + 1u) * nloc) {
            __builtin_amdgcn_fence(__ATOMIC_RELEASE, "agent");
            asm volatile("s_waitcnt vmcnt(0)" ::: "memory");
            const unsigned og = xb_add(&bar[XB_TOP], 1u);
            const unsigned tg = og / nx;
            if (og + 1u == (tg + 1u) * nx) xb_add(&bar[XB_TOPGEN], 1u);
            else XB_SPIN(xb_ld(&bar[XB_TOPGEN]) == tg, bar);
            __builtin_amdgcn_fence(__ATOMIC_ACQUIRE, "agent");
            xb_add(&bar[XB_XGEN(b.x)], 1u);
            asm volatile("s_waitcnt vmcnt(0)" ::: "memory");
        } else {
            XB_SPIN(xb_ld(&bar[XB_XGEN(b.x)]) == gen, bar);
            __builtin_amdgcn_fence(__ATOMIC_ACQUIRE, "agent");
            asm volatile("s_waitcnt vmcnt(0)" ::: "memory");
        }
    }
    __syncthreads();
}

__device__ __forceinline__ void p0_transpose_item(const float* W, int K, int N, bf16_t* WT, LAS float* scr, int item, int lane) {
    const int nblk = N / 32, kb = item / nblk, nb = item % nblk, k0 = 64 * kb, n0 = 32 * nb;
#pragma unroll 8
    for (int i = 0; i < 32; ++i) { const int kk = 2 * i + (lane >> 5); scr[kk * 33 + (lane & 31)] = W[(size_t)(k0 + kk) * N + n0 + (lane & 31)]; }
    asm volatile("s_waitcnt lgkmcnt(0)" ::: "memory");
    const int c = lane & 7;
#pragma unroll
    for (int j = 0; j < 4; ++j) { const int n = (lane >> 3) + 8 * j; const LAS float* s = scr + (8 * c) * 33 + n;
        u32x4 o; o.x = pk2(s[0 * 33], s[1 * 33]); o.y = pk2(s[2 * 33], s[3 * 33]); o.z = pk2(s[4 * 33], s[5 * 33]); o.w = pk2(s[6 * 33], s[7 * 33]);
        *(u32x4*)(WT + (size_t)(n0 + n) * K + k0 + 8 * c) = o; }
    asm volatile("s_waitcnt lgkmcnt(0)" ::: "memory");
}
__device__ __forceinline__ void p0_xn1_row(const float* xrow, const float* g, bf16_t* orow, int lane) {
    const f32x4* xr = (const f32x4*)xrow + lane; const f32x4* gr = (const f32x4*)g + lane;
    f32x4 v[4]; float s = 0.f;
#pragma unroll
    for (int j = 0; j < 4; ++j) { v[j] = xr[64 * j]; s += (v[j].x * v[j].x + v[j].y * v[j].y) + (v[j].z * v[j].z + v[j].w * v[j].w); }
    const float rstd = rsqrtf(wave_sum(s) * (1.f / DM) + EPSF);
    unsigned long long* o8 = (unsigned long long*)orow + lane;
#pragma unroll
    for (int j = 0; j < 4; ++j) { const f32x4 gv = gr[64 * j];
        o8[64 * j] = (unsigned long long)pk2(v[j].x * rstd * gv.x, v[j].y * rstd * gv.y) | ((unsigned long long)pk2(v[j].z * rstd * gv.z, v[j].w * rstd * gv.w) << 32); }
}
__device__ __forceinline__ void p0_fold_item(const Args& a, LAS unsigned char* lds, int item, int tid) {
    const int hp = item >> 4, k0 = (item & 15) * 64;
    LAS float* kl = (LAS float*)lds;
    LAS float* wl = (LAS float*)(lds + 128 * 129 * 4);
    const float* keys = a.in[I_KEYS] + (size_t)hp * 128 * 128; const float* wq = a.in[I_WQ];
    for (int i = tid; i < 128 * 128; i += NTHR) { const int key = i >> 7, d = i & 127; kl[key * 129 + d] = keys[i]; }
    for (int i = tid; i < 64 * 128; i += NTHR) { const int kk = i >> 7, d = i & 127; wl[i] = wq[(size_t)(k0 + kk) * 2048 + hp * 128 + d]; }
    __syncthreads();
    const int key = tid & 127, kq = tid >> 7;
    float acc[16];
#pragma unroll
    for (int i = 0; i < 16; ++i) acc[i] = 0.f;
#pragma unroll 2
    for (int d = 0; d < 128; ++d) { const float kv = kl[key * 129 + d];
#pragma unroll
        for (int i = 0; i < 16; ++i) acc[i] += wl[(kq * 16 + i) * 128 + d] * kv; }
    const float* gf = a.in[I_GFFN] + k0 + kq * 16;
    bf16_t* dst = (bf16_t*)(a.ws + WS_WST) + (size_t)(hp * 128 + key) * 1024 + k0 + kq * 16;
    u32x4 o0, o1;
    o0.x = pk2(acc[0] * gf[0], acc[1] * gf[1]); o0.y = pk2(acc[2] * gf[2], acc[3] * gf[3]); o0.z = pk2(acc[4] * gf[4], acc[5] * gf[5]); o0.w = pk2(acc[6] * gf[6], acc[7] * gf[7]);
    o1.x = pk2(acc[8] * gf[8], acc[9] * gf[9]); o1.y = pk2(acc[10] * gf[10], acc[11] * gf[11]); o1.z = pk2(acc[12] * gf[12], acc[13] * gf[13]); o1.w = pk2(acc[14] * gf[14], acc[15] * gf[15]);
    *(u32x4*)dst = o0; *(u32x4*)(dst + 8) = o1;
    __syncthreads();
}
__device__ __forceinline__ void p0_meta_item(const Args& a, LAS unsigned char* lds, int item, int tid, int wave, int lane) {
    LAS float* mt = (LAS float*)lds;
    for (int r = wave * 2; r < wave * 2 + 2; ++r) {
        const f32x4* xr = (const f32x4*)(a.in[I_META] + (size_t)r * DM) + lane; const f32x4* gr = (const f32x4*)a.in[I_GMIX] + lane;
        f32x4 v[4]; float s = 0.f;
#pragma unroll
        for (int j = 0; j < 4; ++j) { v[j] = xr[64 * j]; s += (v[j].x * v[j].x + v[j].y * v[j].y) + (v[j].z * v[j].z + v[j].w * v[j].w); }
        const float rstd = rsqrtf(wave_sum(s) * (1.f / DM) + EPSF);
#pragma unroll
        for (int j = 0; j < 4; ++j) { const f32x4 gv = gr[64 * j]; f32x4 o = v[j] * rstd * gv; *(LAS f32x4*)(mt + r * 1024 + 4 * (lane + 64 * j)) = o; }
    }
    __syncthreads();
    const int col = item * 256 + (tid & 255), rh = tid >> 8;
    float acc[8];
#pragma unroll
    for (int r = 0; r < 8; ++r) acc[r] = 0.f;
    const float* w = a.in[I_WIN] + col;
#pragma unroll 4
    for (int k = 0; k < 1024; ++k) { const float wv = w[(size_t)k * DIN];
#pragma unroll
        for (int r = 0; r < 8; ++r) acc[r] += mt[(rh * 8 + r) * 1024 + k] * wv; }
    bf16_t* hyin = (bf16_t*)(a.ws + WS_HYIN); bf16_t* rgx = (bf16_t*)(a.ws + WS_RGX);
#pragma unroll
    for (int r = 0; r < 8; ++r) { const int t = rh * 8 + r; const bf16_t v = (bf16_t)f2bf(acc[r]);
        for (int b = 0; b < NB; ++b) { if (col < 1536) hyin[((size_t)b * LT + t) * 1536 + col] = v; else rgx[((size_t)b * LT + t) * 1024 + (col - 1536)] = v; } }
    __syncthreads();
}
constexpr int FPP = 17, NFILT = (LT + FPP - 1) / FPP;
__device__ __forceinline__ void p0_filter_item(const Args& a, LAS unsigned char* lds, int item, int tid) {
    LAS float* z = (LAS float*)lds;
    LAS float* h1 = z + FPP * 33;
    LAS float* h2 = h1 + FPP * 64;
    LAS float* ko = h2 + FPP * 64;
    const int p0 = item * FPP;
    for (int idx = tid; idx < FPP * 33; idx += NTHR) { const int pp = idx / 33, f = idx % 33, p = p0 + pp;
        float v;
        if (f == 0) v = (float)p * (1.0f / (float)(LT - 1));
        else { const int bi = (f - 1) & 15; const float band = 1e-4f + (float)bi * ((15.0f - 1e-4f) / 15.0f); const float w = (float)(6.283185307179586 / (double)LT) * (float)p;
            float s, c; sincos_acc(band * w, s, c); v = (f <= 16) ? c : -s; }
        z[idx] = v; }
    __syncthreads();
    const float* w1 = a.in[I_HYW1]; const float* b1 = a.in[I_HYB1]; const float* w2 = a.in[I_HYW2]; const float* b2 = a.in[I_HYB2];
    const float* w3 = a.in[I_HYW3]; const float* b3 = a.in[I_HYB3]; const float* fr = a.in[I_HYFREQ];
    { const int j = tid & 63, pq = tid >> 6;
        float wv[33];
#pragma unroll
        for (int f = 0; f < 33; ++f) wv[f] = w1[f * 64 + j];
        const float bj = b1[j], fj = fr[j];
        for (int pp = pq; pp < FPP; pp += 8) { float acc = bj;
#pragma unroll
            for (int f = 0; f < 33; ++f) acc += z[pp * 33 + f] * wv[f];
            float s, c; sincos_acc(fj * acc, s, c); h1[pp * 64 + j] = s; } }
    __syncthreads();
    { const int j = tid & 63, pq = tid >> 6;
        float wv[64];
#pragma unroll
        for (int f = 0; f < 64; ++f) wv[f] = w2[f * 64 + j];
        const float bj = b2[j], fj = fr[64 + j];
        for (int pp = pq; pp < FPP; pp += 8) { float acc = bj;
#pragma unroll
            for (int f = 0; f < 64; ++f) acc += h1[pp * 64 + f] * wv[f];
            float s, c; sincos_acc(fj * acc, s, c); h2[pp * 64 + j] = s; } }
    __syncthreads();
#pragma unroll 1
    for (int half = 0; half < 2; ++half) { const int o = half * 512 + tid;
        float wv[64];
#pragma unroll
        for (int i = 0; i < 64; ++i) wv[i] = w3[i * 1024 + o];
        const float bo = b3[o];
        const float delta = fabsf(-15.350567286626972f + (float)tid * ((-3.0701134573253945f + 15.350567286626972f) / 511.0f));
#pragma unroll 1
        for (int pp = 0; pp < FPP; ++pp) { float acc = bo;
#pragma unroll
            for (int i = 0; i < 64; ++i) acc += h2[pp * 64 + i] * wv[i];
            const float tn = (float)(p0 + pp) * (1.0f / (float)(LT - 1)); ko[o * (FPP + 1) + pp] = acc * __expf(-tn * delta); }
    }
    __syncthreads();
    bf16_t* kfb = (bf16_t*)(a.ws + WS_KFB);
    for (int idx = tid; idx < 1024 * FPP; idx += NTHR) { const int o = idx / FPP, pp = idx - o * FPP, dir = o >> 9, c = o & 511, p = p0 + pp;
        if (p < LT) { const float v = ko[o * (FPP + 1) + pp];
            if (dir == 0) kfb[(size_t)c * KFW + (LT - 1) + p] = (bf16_t)f2bf(p == 0 ? v + a.in[I_HYSKIP][c] : v);
            else if (p >= 1) kfb[(size_t)c * KFW + (LT - 1) - p] = (bf16_t)f2bf(v); } }
    if (item == 0) for (int c = tid; c < 512; c += NTHR) kfb[(size_t)c * KFW + KFW - 1] = 0;
    __syncthreads();
}
__device__ __forceinline__ void phase_p0(const Args& a, LAS unsigned char* lds, int tid, int wave, int lane) {
    const int G = gridDim.x, bx = blockIdx.x;
    { float* rs = (float*)(a.ws + WS_ROWSS); float* rs2 = (float*)(a.ws + WS_ROWSS2); for (int i = bx * NTHR + tid; i < T; i += G * NTHR) { rs[i] = 0.f; rs2[i] = 0.f; } }
    for (int it = bx; it < 256 + NFILT; it += G) {
#ifndef P0M
#define P0M 7
#endif
        if (it < 256) { if (P0M & 1) p0_fold_item(a, lds, it, tid); }
        else { if (P0M & 2) p0_filter_item(a, lds, it - 256, tid); }

    }
    LAS float* scr = (LAS float*)(lds + wave * 16384);
    const int gw = bx * NWAVES + wave, NGW = G * NWAVES;
    constexpr int I_IN = (1024 / 64) * (DIN / 32), I_H = (512 / 64) * (1024 / 32), I_R = (1024 / 64) * (1024 / 32), I_O = I_R;
    for (int it = gw; it < I_IN + I_H + I_R + I_O; it += NGW) {
        int r = it;
        if (r < I_IN) { p0_transpose_item(a.in[I_WIN], 1024, DIN, (bf16_t*)(a.ws + WS_WINT), scr, r, lane); continue; } r -= I_IN;
        if (r < I_H) { p0_transpose_item(a.in[I_HYOUT], 512, 1024, (bf16_t*)(a.ws + WS_WHT), scr, r, lane); continue; } r -= I_H;
        if (r < I_R) { p0_transpose_item(a.in[I_RGOUT], 1024, 1024, (bf16_t*)(a.ws + WS_WRT), scr, r, lane); continue; } r -= I_R;
        p0_transpose_item(a.in[I_WOUT], 1024, 1024, (bf16_t*)(a.ws + WS_WOT), scr, r, lane);
    }
    for (int m = gw; m < T; m += 2 * NGW) { p0_xn1_row(a.in[I_X] + (size_t)m * DM, a.in[I_GMIX], (bf16_t*)(a.ws + WS_XN1) + (size_t)m * DM, lane);
        if (m + NGW < T) p0_xn1_row(a.in[I_X] + (size_t)(m + NGW) * DM, a.in[I_GMIX], (bf16_t*)(a.ws + WS_XN1) + (size_t)(m + NGW) * DM, lane); }
}

__device__ __forceinline__ void p1_meta(const Args& a, LAS unsigned char* lds, int tid, int wave, int lane) {
    LAS float* mt = (LAS float*)lds;
    for (int r = wave * 2; r < wave * 2 + 2; ++r) {
        const f32x4* xr = (const f32x4*)(a.in[I_META] + (size_t)r * DM) + lane; const f32x4* gr = (const f32x4*)a.in[I_GMIX] + lane;
        f32x4 v[4]; float s = 0.f;
#pragma unroll
        for (int j = 0; j < 4; ++j) { v[j] = xr[64 * j]; s += (v[j].x * v[j].x + v[j].y * v[j].y) + (v[j].z * v[j].z + v[j].w * v[j].w); }
        const float rstd = rsqrtf(wave_sum(s) * (1.f / DM) + EPSF);
#pragma unroll
        for (int j = 0; j < 4; ++j) { const f32x4 gv = gr[64 * j]; f32x4 o = v[j] * rstd * gv; *(LAS f32x4*)(mt + r * 1024 + 4 * (lane + 64 * j)) = o; }
    }
    __syncthreads();
    const bf16_t* wint = (const bf16_t*)(a.ws + WS_WINT); bf16_t* hyin = (bf16_t*)(a.ws + WS_HYIN); bf16_t* rgx = (bf16_t*)(a.ws + WS_RGX);
    for (int cc = wave; cc < 10; cc += NWAVES) { const int n = blockIdx.x * 10 + cc; if (n >= 2560) break;
        float w[16]; { float t0[8], t1[8]; const bf16_t* wp = wint + (size_t)n * 1024; const u32x4 q0 = *(const u32x4*)(wp + 8 * lane), q1 = *(const u32x4*)(wp + 512 + 8 * lane);
            w[0] = bflo(q0.x); w[1] = bfhi(q0.x); w[2] = bflo(q0.y); w[3] = bfhi(q0.y); w[4] = bflo(q0.z); w[5] = bfhi(q0.z); w[6] = bflo(q0.w); w[7] = bfhi(q0.w);
            w[8] = bflo(q1.x); w[9] = bfhi(q1.x); w[10] = bflo(q1.y); w[11] = bfhi(q1.y); w[12] = bflo(q1.z); w[13] = bfhi(q1.z); w[14] = bflo(q1.w); w[15] = bfhi(q1.w); (void)t0; (void)t1; }
        float mine = 0.f;
#pragma unroll
        for (int r = 0; r < 16; ++r) { const LAS f32x4* mp = (const LAS f32x4*)(mt + r * 1024 + 8 * lane); const f32x4 m0 = mp[0], m1 = mp[1], m2 = mp[128], m3 = mp[129];
            float s = (w[0] * m0.x + w[1] * m0.y) + (w[2] * m0.z + w[3] * m0.w) + (w[4] * m1.x + w[5] * m1.y) + (w[6] * m1.z + w[7] * m1.w)
                    + (w[8] * m2.x + w[9] * m2.y) + (w[10] * m2.z + w[11] * m2.w) + (w[12] * m3.x + w[13] * m3.y) + (w[14] * m3.z + w[15] * m3.w);
            s = wave_sum_dpp(s); mine = ((lane & 15) == r) ? s : mine; }
        const bf16_t v = (bf16_t)f2bf(mine); const int t = lane & 15;
#pragma unroll
        for (int h = 0; h < 2; ++h) { const int b = (lane >> 4) + 4 * h;
            if (n < 1536) hyin[((size_t)b * LT + t) * 1536 + n] = v; else rgx[((size_t)b * LT + t) * 1024 + (n - 1536)] = v; }
    }
    __syncthreads();
}

typedef pg8::f32x4 pf4;
struct EpiProj {
    static constexpr bool PERM = true, AFTER_DRAIN = false;
    bf16_t *hyin, *rgx, *gg, *ga, *gb; const float* bgate;
    __device__ __forceinline__ void operator()(const pf4 (&acc)[2][2][4][2], const pg8::Unit& u, int wr, int wc, int fr, int fq) const {
        const int pn = u.pn, row0 = u.pm * 256 + wr * 64 + fr, cl0 = wc * 32 + 8 * fq;
#pragma unroll
        for (int ai = 0; ai < 2; ++ai)
#pragma unroll
            for (int m = 0; m < 4; ++m) { const int r = row0 + ai * 128 + m * 16; const size_t rl = (size_t)(r >> 12) * LT + NMETA + (r & 4095);
#pragma unroll
                for (int bj = 0; bj < 2; ++bj) { const int col = pn * 256 + bj * 128 + cl0; pf4 v0 = acc[ai][bj][m][0], v1 = acc[ai][bj][m][1]; bf16_t* dst;
                    if (pn < 6) dst = hyin + rl * 1536 + col;
                    else if (pn < 10) dst = rgx + rl * 1024 + (col - 1536);
                    else if (pn < 14) { dst = gg + (size_t)r * 1024 + (col - 2560);
#pragma unroll
                        for (int j = 0; j < 4; ++j) { v0[j] = gelu_tanh(v0[j]); v1[j] = gelu_tanh(v1[j]); } }
                    else { const int gc = col - 3584;
                        dst = (gc < 1024 ? ga + (size_t)r * 1024 + gc : gb + (size_t)r * 1024 + (gc - 1024));
                        const pf4 b0 = *(const pf4*)(bgate + gc), b1 = *(const pf4*)(bgate + gc + 4);
#pragma unroll
                        for (int j = 0; j < 4; ++j) { v0[j] = sigmoidf_(v0[j] + b0[j]); v1[j] = sigmoidf_(v1[j] + b1[j]); } }
                    u32x4 w; w.x = pk2(v0[0], v0[1]); w.y = pk2(v0[2], v0[3]); w.z = pk2(v1[0], v1[1]); w.w = pk2(v1[2], v1[3]);
                    *(u32x4*)dst = w; } }
    }
};
template <int MODE  > struct EpiGate {
    static constexpr bool PERM = true, AFTER_DRAIN = false;
    const bf16_t* gate; const bf16_t* tin; bf16_t* outp;
    __device__ __forceinline__ void operator()(const pf4 (&acc)[2][2][4][2], const pg8::Unit& u, int wr, int wc, int fr, int fq) const {
        const int row0 = u.pm * 256 + wr * 64 + fr, col0 = u.pn * 256 + wc * 32 + 8 * fq;
        u32x4 gq[2], tq[2];
#define EG_OFF(i) ((size_t)(row0 + ((i) >> 3) * 128 + (((i) >> 1) & 3) * 16) * 1024 + col0 + ((i) & 1) * 128)
        gq[0] = *(const u32x4*)(gate + EG_OFF(0)); if (MODE == 1) tq[0] = *(const u32x4*)(tin + EG_OFF(0));
#pragma unroll
        for (int i = 0; i < 16; ++i) { const int ai = i >> 3, m = (i >> 1) & 3, bj = i & 1; const size_t o = EG_OFF(i);
            if (i + 1 < 16) { gq[(i + 1) & 1] = *(const u32x4*)(gate + EG_OFF(i + 1)); if (MODE == 1) tq[(i + 1) & 1] = *(const u32x4*)(tin + EG_OFF(i + 1)); }
            const pf4 v0 = acc[ai][bj][m][0], v1 = acc[ai][bj][m][1]; const u32x4 g = gq[i & 1];
            float r[8];
            r[0] = v0[0] * bflo(g.x); r[1] = v0[1] * bfhi(g.x); r[2] = v0[2] * bflo(g.y); r[3] = v0[3] * bfhi(g.y);
            r[4] = v1[0] * bflo(g.z); r[5] = v1[1] * bfhi(g.z); r[6] = v1[2] * bflo(g.w); r[7] = v1[3] * bfhi(g.w);
            if (MODE == 1) { const u32x4 t = tq[i & 1];
                r[0] += bflo(t.x); r[1] += bfhi(t.x); r[2] += bflo(t.y); r[3] += bfhi(t.y); r[4] += bflo(t.z); r[5] += bfhi(t.z); r[6] += bflo(t.w); r[7] += bfhi(t.w); }
            u32x4 w; w.x = pk2(r[0], r[1]); w.y = pk2(r[2], r[3]); w.z = pk2(r[4], r[5]); w.w = pk2(r[6], r[7]);
            *(u32x4*)(outp + o) = w; }
#undef EG_OFF
    }
};
struct EpiResid {
    static constexpr bool PERM = true, AFTER_DRAIN = false;
    const float* x; bf16_t* h1b; float* rowss;
    __device__ __forceinline__ void operator()(const pf4 (&acc)[2][2][4][2], const pg8::Unit& u, int wr, int wc, int fr, int fq) const {
        const int row0 = u.pm * 256 + wr * 64 + fr, col0 = u.pn * 256 + wc * 32 + 8 * fq;
        pf4 xq[2][4];
#define ER_ROW(i) (row0 + ((i) >> 2) * 128 + ((i) & 3) * 16)
#define ER_LOAD(buf, i) do { const float* p_ = x + (size_t)ER_ROW(i) * 1024 + col0; xq[buf][0] = *(const pf4*)p_; xq[buf][1] = *(const pf4*)(p_ + 4); xq[buf][2] = *(const pf4*)(p_ + 128); xq[buf][3] = *(const pf4*)(p_ + 132); } while (0)
        ER_LOAD(0, 0);
#pragma unroll
        for (int i = 0; i < 8; ++i) { const int ai = i >> 2, m = i & 3, r = ER_ROW(i); const size_t ro = (size_t)r * 1024 + col0; float ss = 0.f;
            if (i + 1 < 8) ER_LOAD((i + 1) & 1, i + 1);
#pragma unroll
            for (int bj = 0; bj < 2; ++bj) { const size_t o = ro + bj * 128;
                const pf4 v0 = acc[ai][bj][m][0] + xq[i & 1][2 * bj], v1 = acc[ai][bj][m][1] + xq[i & 1][2 * bj + 1];
                u32x4 w; w.x = pk2(v0[0], v0[1]); w.y = pk2(v0[2], v0[3]); w.z = pk2(v1[0], v1[1]); w.w = pk2(v1[2], v1[3]);
                *(u32x4*)(h1b + o) = w;
                ss += (v0[0] * v0[0] + v0[1] * v0[1]) + (v0[2] * v0[2] + v0[3] * v0[3]) + (v1[0] * v1[0] + v1[1] * v1[1]) + (v1[2] * v1[2] + v1[3] * v1[3]); }
            ss += __shfl_xor(ss, 16); ss += __shfl_xor(ss, 32);
            if (fq == 0) atomicAdd(rowss + r, ss); }
#undef ER_ROW
#undef ER_LOAD
    }
};
struct EpiScores {
    static constexpr bool PERM = true, AFTER_DRAIN = false;
    const float* rowss; _Float16* sc;
    __device__ __forceinline__ void operator()(const pf4 (&acc)[2][2][4][2], const pg8::Unit& u, int wr, int wc, int fr, int fq) const {
        const int row0 = u.pm * 256 + wr * 64 + fr, k0 = wc * 32 + 8 * fq;
#pragma unroll
        for (int ai = 0; ai < 2; ++ai)
#pragma unroll
            for (int m = 0; m < 4; ++m) { const int r = row0 + ai * 128 + m * 16; const float rs = rsqrtf(rowss[r] * (1.f / DM) + EPSF);
#pragma unroll
                for (int bj = 0; bj < 2; ++bj) { _Float16* p = sc + (((size_t)(((r >> 6) * 8 + u.pn) * 2 + bj) * 16 + (k0 >> 3)) * 64 + (r & 63)) * 8;
                    typedef _Float16 h8 __attribute__((ext_vector_type(8)));
                    h8 v; v[0] = (_Float16)(acc[ai][bj][m][0][0] * rs); v[1] = (_Float16)(acc[ai][bj][m][0][1] * rs); v[2] = (_Float16)(acc[ai][bj][m][0][2] * rs); v[3] = (_Float16)(acc[ai][bj][m][0][3] * rs);
                    v[4] = (_Float16)(acc[ai][bj][m][1][0] * rs); v[5] = (_Float16)(acc[ai][bj][m][1][1] * rs); v[6] = (_Float16)(acc[ai][bj][m][1][2] * rs); v[7] = (_Float16)(acc[ai][bj][m][1][3] * rs);
                    *(h8*)p = v; } }
    }
};

__device__ __forceinline__ void unpack8(const u32x4 w, float (&f)[8]) {
    f[0] = bflo(w.x); f[1] = bfhi(w.x); f[2] = bflo(w.y); f[3] = bfhi(w.y); f[4] = bflo(w.z); f[5] = bfhi(w.z); f[6] = bflo(w.w); f[7] = bfhi(w.w); }
__device__ __forceinline__ void load8(const bf16_t* p, float (&f)[8]) { const u32x4 w = *(const u32x4*)p;
    f[0] = bflo(w.x); f[1] = bfhi(w.x); f[2] = bflo(w.y); f[3] = bfhi(w.y); f[4] = bflo(w.z); f[5] = bfhi(w.z); f[6] = bflo(w.w); f[7] = bfhi(w.w); }
__device__ __forceinline__ void short_conv8(const bf16_t* hb, const float* cw, const float* cb, int s, int ch, float (&o)[8]) {
    float xm[8], x0[8], xp[8];
    if (s >= 1) load8(hb + (size_t)(s - 1) * 1536 + ch, xm); else {
#pragma unroll
        for (int i = 0; i < 8; ++i) xm[i] = 0.f; }
    load8(hb + (size_t)s * 1536 + ch, x0);
    if (s + 1 < LT) load8(hb + (size_t)(s + 1) * 1536 + ch, xp); else {
#pragma unroll
        for (int i = 0; i < 8; ++i) xp[i] = 0.f; }
#pragma unroll
    for (int i = 0; i < 8; ++i) o[i] = xm[i] * cw[ch + i] + x0[i] * cw[1536 + ch + i] + xp[i] * cw[3072 + ch + i] + cb[ch + i];
}
__device__ __forceinline__ void phase_hy_pre(const Args& a, LAS unsigned char* lds, int tid) {
    LAS bf16_t* tl = (LAS bf16_t*)lds;
    const bf16_t* hyin = (const bf16_t*)(a.ws + WS_HYIN); bf16_t* uut = (bf16_t*)(a.ws + WS_UUT); bf16_t* x0out = (bf16_t*)(a.ws + WS_YH);
    const float* cw = a.in[I_HYCW]; const float* cb = a.in[I_HYCB];
    for (int it = blockIdx.x; it < NB * 67 * 8; it += gridDim.x) {
        const int ct = it & 7, ts = (it >> 3) % 67, b = (it >> 3) / 67;
        { const int sr = tid >> 3, cg = tid & 7, c0 = ct * 64 + cg * 8, sp = ts * 64 + sr, s = sp - 16;
            float uu[8];
            if (s >= 0 && s < LT) { float x1[8], v[8]; const bf16_t* hb = hyin + (size_t)b * LT * 1536;
                short_conv8(hb, cw, cb, s, 512 + c0, x1); short_conv8(hb, cw, cb, s, 1024 + c0, v);
#pragma unroll
                for (int i = 0; i < 8; ++i) uu[i] = v[i] * x1[i];
                if (s >= NMETA) { float x0[8]; short_conv8(hb, cw, cb, s, c0, x0);
                    u32x4 w; w.x = pk2(x0[0], x0[1]); w.y = pk2(x0[2], x0[3]); w.z = pk2(x0[4], x0[5]); w.w = pk2(x0[6], x0[7]);
                    *(u32x4*)(x0out + ((size_t)b * SEQ + (s - NMETA)) * DHY + c0) = w; } }
            else {
#pragma unroll
                for (int i = 0; i < 8; ++i) uu[i] = 0.f; }
#pragma unroll
            for (int i = 0; i < 8; ++i) tl[sr * 72 + cg * 8 + i] = (bf16_t)f2bf(uu[i]); }
        __syncthreads();
        { const int cl = tid >> 3, sg = tid & 7, sp0 = ts * 64 + sg * 8;
            if (sp0 < SP) { u32x4 w; unsigned h[8];
#pragma unroll
                for (int i = 0; i < 8; ++i) h[i] = tl[(sg * 8 + i) * 72 + cl];
                w.x = h[0] | (h[1] << 16); w.y = h[2] | (h[3] << 16); w.z = h[4] | (h[5] << 16); w.w = h[6] | (h[7] << 16);
                *(u32x4*)(uut + ((size_t)(ct * 64 + cl) * NB + b) * SP + sp0) = w; } }
        __syncthreads();
    }
}
__device__ __forceinline__ void phase_hy_conv_naive(const Args& a, LAS unsigned char* lds, int tid) {
    LAS bf16_t* uus = (LAS bf16_t*)lds;
    LAS float* filt = (LAS float*)(lds + LT * 16);
    const bf16_t* uut = (const bf16_t*)(a.ws + WS_UUT); const float* kf = (const float*)(a.ws + WS_KF); bf16_t* cvt = (bf16_t*)(a.ws + WS_CONVT);
    for (int c = blockIdx.x; c < DHY; c += gridDim.x) {
        for (int i = tid; i < NB * LT; i += NTHR) { const int b = i / LT, s = i - b * LT; uus[s * 8 + b] = uut[((size_t)c * NB + b) * SP + 16 + s]; }
        for (int i = tid; i < KFW; i += NTHR) filt[i] = kf[(size_t)c * KFW + i];
        __syncthreads();
        for (int tt = 0; tt < 8; ++tt) { const int tq = tt * 512 + tid, t = tq + 16; float acc[8];
#pragma unroll
            for (int b = 0; b < 8; ++b) acc[b] = 0.f;
            const LAS float* fp = filt + (LT - 1) + t;
            for (int s = 0; s < LT; ++s) { const float kv = fp[-s]; const u32x4 w = *(const LAS u32x4*)(uus + s * 8);
                acc[0] += kv * bflo(w.x); acc[1] += kv * bfhi(w.x); acc[2] += kv * bflo(w.y); acc[3] += kv * bfhi(w.y);
                acc[4] += kv * bflo(w.z); acc[5] += kv * bfhi(w.z); acc[6] += kv * bflo(w.w); acc[7] += kv * bfhi(w.w); }
#pragma unroll
            for (int b = 0; b < 8; ++b) cvt[((size_t)c * NB + b) * SEQ + tq] = (bf16_t)f2bf(acc[b]); }
        __syncthreads();
    }
}
__device__ __forceinline__ void phase_rg_naive(const Args& a, LAS unsigned char* lds, int tid) {
    LAS float* xc = (LAS float*)lds;
    LAS float* gbuf = xc + 32 * 128;
    const bf16_t* rgx = (const bf16_t*)(a.ws + WS_RGX);
    for (int it = blockIdx.x; it < NB * 2 * 8; it += gridDim.x) {
        const int head = it & 7, dir = (it >> 3) & 1, b = it >> 4;
        const float* cw = a.in[I_RGCW] + (size_t)dir * 4 * DRG + head * 128; const float* cb = a.in[I_RGCB] + (size_t)dir * DRG + head * 128;
        bf16_t* hout = (bf16_t*)a.out + (size_t)dir * T * DRG;
        const bf16_t* xb = rgx + (size_t)b * LT * DRG + head * 128;
        float h = 0.f, sp = 0.f;
        if (tid < 128) { const float lam = a.in[I_RGLAM][dir * DRG + head * 128 + tid]; sp = log1pf(__expf(-lam)); }
        for (int k = 0; k < 129; ++k) {
            { const int tok = tid >> 4, cg = tid & 15, u = 32 * k + tok; float o[8];
#pragma unroll
                for (int i = 0; i < 8; ++i) o[i] = (u < LT) ? cb[cg * 8 + i] : 0.f;
                if (u < LT) {
#pragma unroll
                    for (int j = 0; j < 4; ++j) { const int uu = u - j; if (uu >= 0) { const int t = dir ? (LT - 1 - uu) : uu; float xv[8]; load8(xb + (size_t)t * DRG + cg * 8, xv);
#pragma unroll
                            for (int i = 0; i < 8; ++i) o[i] += xv[i] * cw[j * DRG + cg * 8 + i]; } } }
#pragma unroll
                for (int i = 0; i < 8; ++i) xc[tok * 128 + cg * 8 + i] = o[i]; }
            __syncthreads();
            { const int j = tid & 127, g = (tid >> 7) & 1, th = tid >> 8; float acc[16];
#pragma unroll
                for (int q = 0; q < 16; ++q) acc[q] = 0.f;
                const float* gw = a.in[I_RGGW] + ((size_t)((dir * 2 + g) * 8 + head) * 128) * 128 + j;
                for (int i = 0; i < 128; ++i) { const float wv = gw[i * 128];
#pragma unroll
                    for (int q = 0; q < 16; ++q) acc[q] += xc[(th * 16 + q) * 128 + i] * wv; }
                const float gb = a.in[I_RGGB][(size_t)(dir * 2 + g) * DRG + head * 128 + j];
#pragma unroll
                for (int q = 0; q < 16; ++q) gbuf[(g * 32 + th * 16 + q) * 128 + j] = acc[q] + gb; }
            __syncthreads();
            if (tid < 128) {
                for (int tok = 0; tok < 32; ++tok) { const int u = 32 * k + tok; if (u >= LT) break;
                    const float r = sigmoidf_(gbuf[tok * 128 + tid]), ig = sigmoidf_(gbuf[(32 + tok) * 128 + tid]);
                    const float la = -8.0f * r * sp; const float av = __expf(la); const float mult = (u == 0) ? 1.0f : sqrtf(-expm1f(2.0f * la));
                    h = av * h + mult * ig * xc[tok * 128 + tid];
                    const int t = dir ? (LT - 1 - u) : u;
                    if (t >= NMETA) hout[((size_t)b * SEQ + (t - NMETA)) * DRG + head * 128 + tid] = (bf16_t)f2bf(h); } }
            __syncthreads();
        }
    }
}
__device__ __forceinline__ void phase_post(const Args& a, LAS unsigned char* lds, int tid) {
    const int wave = tid >> 6, lane = tid & 63, gw = blockIdx.x * NWAVES + wave, NGW = gridDim.x * NWAVES;
    LAS bf16_t* cv = (LAS bf16_t*)(lds + wave * (64 * 144));
    const bf16_t* cvt = (const bf16_t*)(a.ws + WS_CONVT); bf16_t* yh = (bf16_t*)(a.ws + WS_YH);
    const int l8 = lane >> 3, l7 = lane & 7;
    for (int it = gw; it < NB * 64 * 8; it += NGW) {
        const int ct = it & 7, tt = (it >> 3) & 63, b = it >> 9;
        u32x4 cw_[8], xw[8];
#pragma unroll
        for (int k = 0; k < 8; ++k) cw_[k] = *(const u32x4*)(cvt + ((size_t)(ct * 64 + 8 * k + l8) * NB + b) * SEQ + tt * 64 + l7 * 8);
        bf16_t* yp = yh + ((size_t)b * SEQ + tt * 64 + l8) * DHY + ct * 64 + l7 * 8;
#pragma unroll
        for (int k = 0; k < 8; ++k) xw[k] = *(const u32x4*)(yp + (size_t)(8 * k) * DHY);
#pragma unroll
        for (int k = 0; k < 8; ++k) *(LAS u32x4*)(cv + (8 * k + l8) * 72 + l7 * 8) = cw_[k];
#pragma unroll
        for (int k = 0; k < 8; ++k) { const int tr = 8 * k + l8; float x0[8], y[8]; unpack8(xw[k], x0);
#pragma unroll
            for (int i = 0; i < 8; ++i) y[i] = bf2f(cv[(l7 * 8 + i) * 72 + tr]) * x0[i];
            u32x4 w; w.x = pk2(y[0], y[1]); w.y = pk2(y[2], y[3]); w.z = pk2(y[4], y[5]); w.w = pk2(y[6], y[7]);
            *(u32x4*)(yp + (size_t)(8 * k) * DHY) = w; }
    }
    const bf16_t* hf = (const bf16_t*)a.out; const bf16_t* hb2 = hf + (size_t)T * DRG; const bf16_t* gg = (const bf16_t*)(a.ws + WS_GG); bf16_t* yr = (bf16_t*)(a.ws + WS_YR);
    const bf16_t* rgp = (const bf16_t*)(a.ws + WS_RGP); const float* rgc = (const float*)(a.ws + WS_RGC);
    for (size_t i = (size_t)blockIdx.x * NTHR + tid; i < (size_t)T * DRG / 8; i += (size_t)gridDim.x * NTHR) {
        const int c8 = (int)(i & 127) * 8, m = (int)(i >> 7), b = m >> 12, t = (m & 4095) + NMETA;
        float f[8], g[8], q[8]; load8(hf + i * 8, f); load8(hb2 + i * 8, g); load8(gg + i * 8, q);
        if (t >= RG_U1) { float p[8]; load8(rgp + ((size_t)(0 * NB + b) * RG_NF + (t - RG_U1)) * DRG + c8, p); const float* cc = rgc + (size_t)(0 * NB + b) * DRG + c8;
#pragma unroll
            for (int j = 0; j < 8; ++j) f[j] += p[j] * cc[j]; }
        const int ub = LT - 1 - t;
        if (ub >= RG_U1) { float p[8]; load8(rgp + ((size_t)(1 * NB + b) * RG_NF + (ub - RG_U1)) * DRG + c8, p); const float* cc = rgc + (size_t)(1 * NB + b) * DRG + c8;
#pragma unroll
            for (int j = 0; j < 8; ++j) g[j] += p[j] * cc[j]; }
        u32x4 w; w.x = pk2((f[0] + g[0]) * q[0], (f[1] + g[1]) * q[1]); w.y = pk2((f[2] + g[2]) * q[2], (f[3] + g[3]) * q[3]);
        w.z = pk2((f[4] + g[4]) * q[4], (f[5] + g[5]) * q[5]); w.w = pk2((f[6] + g[6]) * q[6], (f[7] + g[7]) * q[7]);
        *(u32x4*)(yr + i * 8) = w; }
}
__device__ __forceinline__ u32x4 quant_row16(const f32x4 (&v)[4], float amax, float& deq) {
    const float sc = (amax > 0.f) ? 256.0f / amax : 1.0f; deq = (amax > 0.f) ? amax * (1.0f / 256.0f) : 1.0f;
    u32x4 w; int t;
    t = __builtin_amdgcn_cvt_pk_fp8_f32(v[0].x * sc, v[0].y * sc, 0, false); t = __builtin_amdgcn_cvt_pk_fp8_f32(v[0].z * sc, v[0].w * sc, t, true); w.x = (unsigned)t;
    t = __builtin_amdgcn_cvt_pk_fp8_f32(v[1].x * sc, v[1].y * sc, 0, false); t = __builtin_amdgcn_cvt_pk_fp8_f32(v[1].z * sc, v[1].w * sc, t, true); w.y = (unsigned)t;
    t = __builtin_amdgcn_cvt_pk_fp8_f32(v[2].x * sc, v[2].y * sc, 0, false); t = __builtin_amdgcn_cvt_pk_fp8_f32(v[2].z * sc, v[2].w * sc, t, true); w.z = (unsigned)t;
    t = __builtin_amdgcn_cvt_pk_fp8_f32(v[3].x * sc, v[3].y * sc, 0, false); t = __builtin_amdgcn_cvt_pk_fp8_f32(v[3].z * sc, v[3].w * sc, t, true); w.w = (unsigned)t;
    return w;
}
__device__ __forceinline__ unsigned q8x4(f32x4 v, float sc) {
    const int a = (int)rintf(v.x * sc), b = (int)rintf(v.y * sc), c = (int)rintf(v.z * sc), d = (int)rintf(v.w * sc);
    return ((unsigned)a & 0xffu) | (((unsigned)b & 0xffu) << 8) | (((unsigned)c & 0xffu) << 16) | ((unsigned)d << 24);
}
__device__ __forceinline__ void phase_tables(const Args& a, int wave, int lane) {
    const int gw = blockIdx.x * NWAVES + wave, NGW = gridDim.x * NWAVES;
    const float* gf = a.in[I_GFFN] + 16 * lane; unsigned char* uq = a.ws + WS_UB; unsigned char* vq = a.ws + WS_VB; float* su = (float*)(a.ws + WS_SU); float* sv = (float*)(a.ws + WS_SV);
    f32x4 g[4];
#pragma unroll
    for (int j = 0; j < 4; ++j) g[j] = *(const f32x4*)(gf + 4 * j);
    for (int e = gw; e < NEXP; e += NGW) {
        const float* ur = a.in[I_PU] + (size_t)e * DM + 16 * lane; const float* vr = a.in[I_PV] + (size_t)e * DM + 16 * lane;
        f32x4 u[4], v[4]; float mu = 0.f, mv = 0.f;
#pragma unroll
        for (int j = 0; j < 4; ++j) { u[j] = *(const f32x4*)(ur + 4 * j) * g[j]; v[j] = *(const f32x4*)(vr + 4 * j);
            mu = fmaxf(mu, fmaxf(fmaxf(fabsf(u[j].x), fabsf(u[j].y)), fmaxf(fabsf(u[j].z), fabsf(u[j].w))));
            mv = fmaxf(mv, fmaxf(fmaxf(fabsf(v[j].x), fabsf(v[j].y)), fmaxf(fabsf(v[j].z), fabsf(v[j].w)))); }
        mu = wave_max_dpp(mu); mv = wave_max_dpp(mv);
        const float scu = (mu > 0.f) ? 127.0f / mu : 1.0f, du = (mu > 0.f) ? mu * (1.0f / 127.0f) : 1.0f;
        u32x4 qu; qu.x = q8x4(u[0], scu); qu.y = q8x4(u[1], scu); qu.z = q8x4(u[2], scu); qu.w = q8x4(u[3], scu);
        float dv; const u32x4 qv = quant_row16(v, mv, dv);
        { const size_t so = ((size_t)(lane >> 3) * NEXP + e) * 128 + 16 * (lane & 7); *(u32x4*)(uq + so) = qu; *(u32x4*)(vq + so) = qv; }
        if (lane == 0) { su[e] = du; sv[e] = dv; }
    }
}
__device__ __forceinline__ void ce_desc(float& a, float& b) { const float hi = fmaxf(a, b), lo = fminf(a, b); a = hi; b = lo; }
__device__ __forceinline__ void sort16_desc(float (&x)[16]) {
#pragma unroll
    for (int k = 2; k <= 16; k <<= 1)
#pragma unroll
        for (int j = k >> 1; j > 0; j >>= 1)
#pragma unroll
            for (int i = 0; i < 16; ++i) { const int l = i ^ j; if (l > i) { if ((i & k) == 0) ce_desc(x[i], x[l]); else ce_desc(x[l], x[i]); } }
}
__device__ __forceinline__ void merge_top16(float (&L)[16], const float (&X)[16]) {
#pragma unroll
    for (int i = 0; i < 16; ++i) L[i] = fmaxf(L[i], X[15 - i]);
#pragma unroll
    for (int j = 8; j > 0; j >>= 1)
#pragma unroll
        for (int i = 0; i < 16; ++i) { const int l = i ^ j; if (l > i) ce_desc(L[i], L[l]); }
}
__device__ __forceinline__ void top16_of_128(const _Float16* base  , float (&L)[16]) {
    typedef _Float16 h8 __attribute__((ext_vector_type(8)));
    h8 v0 = *(const h8*)(base), v1 = *(const h8*)(base + 512);
#pragma unroll 1
    for (int ch = 0; ch < 8; ++ch) { float X[16]; const int cn = (ch < 7) ? ch + 1 : 7;
        const h8 n0 = *(const h8*)(base + (2 * cn) * 512), n1 = *(const h8*)(base + (2 * cn + 1) * 512);
#pragma unroll
        for (int i = 0; i < 8; ++i) { X[i] = __uint_as_float((__float_as_uint((float)v0[i]) & ~0x7Fu) | (unsigned)(ch * 16 + i));
            X[8 + i] = __uint_as_float((__float_as_uint((float)v1[i]) & ~0x7Fu) | (unsigned)(ch * 16 + 8 + i)); }
        sort16_desc(X);
        if (ch == 0) {
#pragma unroll
            for (int i = 0; i < 16; ++i) L[i] = X[i]; }
        else merge_top16(L, X);
        v0 = n0; v1 = n1; }
}
struct CandTab { int ci[64], cj[64]; };
__host__ __device__ constexpr CandTab make_cand() { CandTab t{}; int n = 0; for (int i = 0; i < 16; ++i) for (int j = 0; j < 16; ++j) if ((i + 1) * (j + 1) <= 16) { t.ci[n] = i; t.cj[n] = j; ++n; }
    for (; n < 64; ++n) { t.ci[n] = -1; t.cj[n] = -1; } return t; }
__device__ __forceinline__ void phase_topk(const Args& a, LAS unsigned char* lds, const pg8::StaticOrder& S, int wave, int lane) {
    constexpr CandTab CT = make_cand();
    const _Float16* st = (const _Float16*)(a.ws + WS_SCORES); int* eidx = (int*)(a.ws + WS_EIDX); float* eg = (float*)(a.ws + WS_EG);
    LAS unsigned char* tab = lds + wave * (64 * 36) + lane * 36;
    for (int j = wave; ; j += NWAVES) { pg8::Unit un; if (!S.next(j >> 2, un)) break; const int tg = 4 * un.pm + (j & 3), hh = un.pn; const int m = tg * 64 + lane;
        float A[16], B[16];
        top16_of_128(st + (size_t)((tg * 8 + hh) * 2 + 0) * 128 * 64 + lane * 8, A);
        top16_of_128(st + (size_t)((tg * 8 + hh) * 2 + 1) * 128 * 64 + lane * 8, B);
#pragma unroll
        for (int q = 0; q < 4; ++q) {
            const unsigned wa = (__float_as_uint(A[4 * q]) & 0x7Fu) | ((__float_as_uint(A[4 * q + 1]) & 0x7Fu) << 8) | ((__float_as_uint(A[4 * q + 2]) & 0x7Fu) << 16) | ((__float_as_uint(A[4 * q + 3]) & 0x7Fu) << 24);
            const unsigned wb = (__float_as_uint(B[4 * q]) & 0x7Fu) | ((__float_as_uint(B[4 * q + 1]) & 0x7Fu) << 8) | ((__float_as_uint(B[4 * q + 2]) & 0x7Fu) << 16) | ((__float_as_uint(B[4 * q + 3]) & 0x7Fu) << 24);
            *(LAS unsigned*)(tab + 4 * q) = wa; *(LAS unsigned*)(tab + 16 + 4 * q) = wb; }
#pragma unroll
        for (int i = 0; i < 16; ++i) { A[i] = __uint_as_float(__float_as_uint(A[i]) & ~0x7Fu); B[i] = __uint_as_float(__float_as_uint(B[i]) & ~0x7Fu); }
        float K[16];
#pragma unroll
        for (int c0 = 0; c0 < 64; c0 += 16) { float X[16];
#pragma unroll
            for (int i = 0; i < 16; ++i) { const int c = c0 + i;
                if (CT.ci[c] >= 0) X[i] = __uint_as_float((__float_as_uint(A[CT.ci[c] < 0 ? 0 : CT.ci[c]] + B[CT.cj[c] < 0 ? 0 : CT.cj[c]]) & ~0xFFu) | (unsigned)(CT.ci[c] * 16 + CT.cj[c]));
                else X[i] = -INFINITY; }
            sort16_desc(X);
            if (c0 == 0) {
#pragma unroll
                for (int i = 0; i < 16; ++i) K[i] = X[i]; }
            else merge_top16(K, X); }
        asm volatile("s_waitcnt lgkmcnt(0)" ::: "memory");
        int ex_[16]; float cs[16]; float sum = 0.f;
#pragma unroll
        for (int r = 0; r < 16; ++r) { const unsigned kb = __float_as_uint(K[r]); const int id = kb & 0xFF; cs[r] = __expf(__uint_as_float(kb & ~0xFFu) - __uint_as_float(__float_as_uint(K[0]) & ~0xFFu)); sum += cs[r];
            ex_[r] = (int)tab[id >> 4] * 128 + (int)tab[16 + (id & 15)]; }
        const float inv = 1.0f / sum;
        unsigned short* ep = (unsigned short*)eidx + (size_t)m * 128 + hh * 16; float* gp = eg + (size_t)m * 128 + hh * 16;
        { u32x4 p0, p1; p0.x = ex_[0] | (ex_[1] << 16); p0.y = ex_[2] | (ex_[3] << 16); p0.z = ex_[4] | (ex_[5] << 16); p0.w = ex_[6] | (ex_[7] << 16);
          p1.x = ex_[8] | (ex_[9] << 16); p1.y = ex_[10] | (ex_[11] << 16); p1.z = ex_[12] | (ex_[13] << 16); p1.w = ex_[14] | (ex_[15] << 16); *(u32x4*)ep = p0; *(u32x4*)(ep + 8) = p1; }
#pragma unroll
        for (int q = 0; q < 4; ++q) {
            *(f32x4*)(gp + 4 * q) = (f32x4){cs[4 * q] * inv, cs[4 * q + 1] * inv, cs[4 * q + 2] * inv, cs[4 * q + 3] * inv}; }
    }
}
__device__ __forceinline__ void fp8x16_to_f32(const u32x4 w, float (&f)[16]) {
    f32x2v t;
    t = __builtin_amdgcn_cvt_pk_f32_fp8((int)w.x, false); f[0] = t.x; f[1] = t.y; t = __builtin_amdgcn_cvt_pk_f32_fp8((int)w.x, true); f[2] = t.x; f[3] = t.y;
    t = __builtin_amdgcn_cvt_pk_f32_fp8((int)w.y, false); f[4] = t.x; f[5] = t.y; t = __builtin_amdgcn_cvt_pk_f32_fp8((int)w.y, true); f[6] = t.x; f[7] = t.y;
    t = __builtin_amdgcn_cvt_pk_f32_fp8((int)w.z, false); f[8] = t.x; f[9] = t.y; t = __builtin_amdgcn_cvt_pk_f32_fp8((int)w.z, true); f[10] = t.x; f[11] = t.y;
    t = __builtin_amdgcn_cvt_pk_f32_fp8((int)w.w, false); f[12] = t.x; f[13] = t.y; t = __builtin_amdgcn_cvt_pk_f32_fp8((int)w.w, true); f[14] = t.x; f[15] = t.y;
}
__device__ __forceinline__ void fp8x16_to_f32x2(const u32x4 w, f32x2v (&f)[8]) {
    f[0] = __builtin_amdgcn_cvt_pk_f32_fp8((int)w.x, false); f[1] = __builtin_amdgcn_cvt_pk_f32_fp8((int)(w.x >> 16), false);
    f[2] = __builtin_amdgcn_cvt_pk_f32_fp8((int)w.y, false); f[3] = __builtin_amdgcn_cvt_pk_f32_fp8((int)(w.y >> 16), false);
    f[4] = __builtin_amdgcn_cvt_pk_f32_fp8((int)w.z, false); f[5] = __builtin_amdgcn_cvt_pk_f32_fp8((int)(w.z >> 16), false);
    f[6] = __builtin_amdgcn_cvt_pk_f32_fp8((int)w.w, false); f[7] = __builtin_amdgcn_cvt_pk_f32_fp8((int)(w.w >> 16), false);
}
__device__ __forceinline__ float dpp_sum8(float v) {
    v += __int_as_float(__builtin_amdgcn_update_dpp(0, __float_as_int(v), 0xB1, 0xF, 0xF, true));
    v += __int_as_float(__builtin_amdgcn_update_dpp(0, __float_as_int(v), 0x4E, 0xF, 0xF, true));
    v += __int_as_float(__builtin_amdgcn_update_dpp(0, __float_as_int(v), 0x141, 0xF, 0xF, true));
    return v;
}
struct UTok { u32x4 e0, e1, xa, xb; };
struct VTok { u32x4 e0, e1; f32x4 av[4]; };
__device__ __forceinline__ void pu_issue(const unsigned char* tab, unsigned loff, const u32x4& e, u32x4 (&w)[8]) {
    w[0] = *(const u32x4*)(tab + ((e.x & 0xffffu) * 128u + loff)); w[1] = *(const u32x4*)(tab + ((e.x >> 16) * 128u + loff));
    w[2] = *(const u32x4*)(tab + ((e.y & 0xffffu) * 128u + loff)); w[3] = *(const u32x4*)(tab + ((e.y >> 16) * 128u + loff));
    w[4] = *(const u32x4*)(tab + ((e.z & 0xffffu) * 128u + loff)); w[5] = *(const u32x4*)(tab + ((e.z >> 16) * 128u + loff));
    w[6] = *(const u32x4*)(tab + ((e.w & 0xffffu) * 128u + loff)); w[7] = *(const u32x4*)(tab + ((e.w >> 16) * 128u + loff));
}
__device__ __forceinline__ float pu_compute(const int (&xq)[4], const u32x4 (&w)[8], int i) {
    float keep = 0.f;
#pragma unroll
    for (int q = 0; q < 8; ++q) { int d = __builtin_amdgcn_sdot4((int)w[q].x, xq[0], 0, false); d = __builtin_amdgcn_sdot4((int)w[q].y, xq[1], d, false);
        d = __builtin_amdgcn_sdot4((int)w[q].z, xq[2], d, false); d = __builtin_amdgcn_sdot4((int)w[q].w, xq[3], d, false);
        d += __builtin_amdgcn_update_dpp(0, d, 0xB1, 0xF, 0xF, true); d += __builtin_amdgcn_update_dpp(0, d, 0x4E, 0xF, 0xF, true); d += __builtin_amdgcn_update_dpp(0, d, 0x141, 0xF, 0xF, true);
        keep = (q == i) ? (float)d : keep; }
    return keep;
}
__device__ __forceinline__ float pu_quant_x(const u32x4& xa, const u32x4& xb, int (&xq)[4]) {
    float f[16]; unpack8(xa, *(float(*)[8])&f[0]); unpack8(xb, *(float(*)[8])&f[8]);
    float mx = 0.f;
#pragma unroll
    for (int c = 0; c < 16; ++c) mx = fmaxf(mx, fabsf(f[c]));
    mx = fmaxf(mx, __int_as_float(__builtin_amdgcn_update_dpp(0, __float_as_int(mx), 0xB1, 0xF, 0xF, true)));
    mx = fmaxf(mx, __int_as_float(__builtin_amdgcn_update_dpp(0, __float_as_int(mx), 0x4E, 0xF, 0xF, true)));
    mx = fmaxf(mx, __int_as_float(__builtin_amdgcn_update_dpp(0, __float_as_int(mx), 0x141, 0xF, 0xF, true)));
    const float sc = (mx > 0.f) ? 127.0f * __builtin_amdgcn_rcpf(mx) * 0.99999f : 0.f;
#pragma unroll
    for (int c4 = 0; c4 < 4; ++c4) xq[c4] = (int)q8x4((f32x4){f[4 * c4], f[4 * c4 + 1], f[4 * c4 + 2], f[4 * c4 + 3]}, sc);
    return mx * (1.0f / 127.0f);
}
__device__ __forceinline__ void phase_peer_u(const Args& a, int wave, int lane) {
    const int s = SLICE_OF(blockIdx.x), rk = RANK_OF(blockIdx.x), nrk = gridDim.x >> 3, tper = T / nrk, i = lane & 7, j = lane >> 3;
    const bf16_t* h1b = (const bf16_t*)(a.ws + WS_H1B) + 128 * s + 16 * i; const unsigned char* uqs = a.ws + WS_UB + (size_t)s * NEXP * 128; const unsigned loff = 16u * (unsigned)i;
    const unsigned short* eidx = (const unsigned short*)(a.ws + WS_EIDX) + 16 * j; float* pd = (float*)(a.ws + WS_PD) + (size_t)s * T * 128 + 16 * j + i;
    const int m0 = rk * tper + wave, mlast = (rk + 1) * tper - NWAVES + wave;
#define PU_LOAD(t, mm) do { const int m_ = (mm) < mlast ? (mm) : mlast; const u32x4* ep_ = (const u32x4*)(eidx + (size_t)m_ * 128); (t).e0 = ep_[0]; (t).e1 = ep_[1]; \
        (t).xa = *(const u32x4*)(h1b + (size_t)m_ * DM); (t).xb = *(const u32x4*)(h1b + (size_t)m_ * DM + 8); } while (0)
#define PU_DO(t, w0, w1, mm) do { int xq_[4]; const float sx_ = pu_quant_x((t).xa, (t).xb, xq_); \
        const float k0_ = pu_compute(xq_, w0, i) * sx_, k1_ = pu_compute(xq_, w1, i) * sx_; pd[(size_t)(mm) * 128] = k0_; pd[(size_t)(mm) * 128 + 8] = k1_; } while (0)
    UTok tC, tN, tNN; u32x4 wA[8], wB[8], wC[8], wD[8];
    PU_LOAD(tC, m0); PU_LOAD(tN, m0 + NWAVES); PU_LOAD(tNN, m0 + 2 * NWAVES); pu_issue(uqs, loff, tC.e0, wA); pu_issue(uqs, loff, tC.e1, wB);
    for (int m = m0; m <= mlast; m += 2 * NWAVES) {
        pu_issue(uqs, loff, tN.e0, wC); pu_issue(uqs, loff, tN.e1, wD);
        PU_DO(tC, wA, wB, m);
        tC = tN; tN = tNN; PU_LOAD(tNN, m + 3 * NWAVES);
        pu_issue(uqs, loff, tN.e0, wA); pu_issue(uqs, loff, tN.e1, wB);
        PU_DO(tC, wC, wD, m + NWAVES);
        tC = tN; tN = tNN; PU_LOAD(tNN, m + 4 * NWAVES);
    }
#undef PU_LOAD
#undef PU_DO
}
typedef long i64_t;
__device__ __forceinline__ i64_t pack64(unsigned lo, unsigned hi) { return (i64_t)(((unsigned long long)hi << 32) | (unsigned long long)lo); }
struct MTokI { u32x4 ia, ib; };
struct MTokX { u32x4 xq[4]; };
__device__ __forceinline__ unsigned id16(const u32x4& v, int c) { const unsigned wv = (c >> 1) == 0 ? v.x : (c >> 1) == 1 ? v.y : (c >> 1) == 2 ? v.z : v.w; return (c & 1) ? (wv >> 16) : (wv & 0xffffu); }
__device__ __forceinline__ void pm_issue(const unsigned char* tab, unsigned loff, const MTokI& t, u32x4 (&W)[16]) {
#pragma unroll
    for (int c = 0; c < 8; ++c) { W[2 * c] = *(const u32x4*)(tab + (id16(t.ia, c) * 128u + loff)); W[2 * c + 1] = *(const u32x4*)(tab + (id16(t.ib, c) * 128u + loff)); }
}
template <bool HI> __device__ __forceinline__ unsigned bf2_to_fp8x2(unsigned w, int old) { const float a = fminf(fmaxf(bflo(w), -448.f), 448.f), b = fminf(fmaxf(bfhi(w), -448.f), 448.f); return (unsigned)__builtin_amdgcn_cvt_pk_fp8_f32(a, b, old, HI); }
__device__ __forceinline__ void pm_compute(const MTokX& t, const u32x4 (&W)[16], LAS unsigned char* wl  , float* pdrow  , int lane) {
    unsigned xb[8];
#pragma unroll
    for (int q = 0; q < 4; ++q) { unsigned lo = bf2_to_fp8x2<false>(t.xq[q].x, 0); lo = bf2_to_fp8x2<true>(t.xq[q].y, (int)lo); unsigned hi = bf2_to_fp8x2<false>(t.xq[q].z, 0); hi = bf2_to_fp8x2<true>(t.xq[q].w, (int)hi); xb[2 * q] = lo; xb[2 * q + 1] = hi; }
    const i64_t B0 = pack64(xb[0], xb[1]), B1 = pack64(xb[2], xb[3]), B2 = pack64(xb[4], xb[5]), B3 = pack64(xb[6], xb[7]);
    const int j8 = lane >> 3, i = lane & 7, r = lane & 15, g = lane >> 4;
    LAS unsigned char* wr0 = wl + j8 * 144 + i * 16;
    const LAS unsigned char* rd0 = wl + r * 144 + g * 32;
    f32x4 C[8];
#pragma unroll
    for (int c = 0; c < 8; ++c) { const int bo = (c & 1) * 2304;
        *(LAS u32x4*)(wr0 + bo) = W[2 * c]; *(LAS u32x4*)(wr0 + bo + 8 * 144) = W[2 * c + 1];
        const u32x4 a0 = *(const LAS u32x4*)(rd0 + bo), a1 = *(const LAS u32x4*)(rd0 + bo + 16);
        f32x4 acc = (f32x4){0.f, 0.f, 0.f, 0.f};
        acc = __builtin_amdgcn_mfma_f32_16x16x32_fp8_fp8(pack64(a0.x, a0.y), B0, acc, 0, 0, 0);
        acc = __builtin_amdgcn_mfma_f32_16x16x32_fp8_fp8(pack64(a0.z, a0.w), B1, acc, 0, 0, 0);
        acc = __builtin_amdgcn_mfma_f32_16x16x32_fp8_fp8(pack64(a1.x, a1.y), B2, acc, 0, 0, 0);
        acc = __builtin_amdgcn_mfma_f32_16x16x32_fp8_fp8(pack64(a1.z, a1.w), B3, acc, 0, 0, 0); C[c] = acc; }
    if ((lane & 15) == 0) {
#pragma unroll
        for (int reg = 0; reg < 4; ++reg) { *(f32x4*)(pdrow + 8 * reg) = (f32x4){C[0][reg], C[1][reg], C[2][reg], C[3][reg]}; *(f32x4*)(pdrow + 8 * reg + 4) = (f32x4){C[4][reg], C[5][reg], C[6][reg], C[7][reg]}; } }
}
__device__ __forceinline__ void phase_peer_u_mfma(const Args& a, LAS unsigned char* lds, int wave, int lane) {
    const int s = SLICE_OF(blockIdx.x), rk = RANK_OF(blockIdx.x), nrk = gridDim.x >> 3, tper = T / nrk, g = lane >> 4, j8 = lane >> 3;
    const bf16_t* h1b = (const bf16_t*)(a.ws + WS_H1B) + 128 * s + 32 * g; const unsigned char* uqs = a.ws + WS_UB + (size_t)s * NEXP * 128; const unsigned loff = 16u * (unsigned)(lane & 7);
    const unsigned short* eidx = (const unsigned short*)(a.ws + WS_EIDX) + 8 * j8; float* pd = (float*)(a.ws + WS_PD) + (size_t)s * T * 128 + 32 * g;
    LAS unsigned char* wl = lds + wave * 4608;
    const int m0 = rk * tper + wave, mlast = (rk + 1) * tper - NWAVES + wave;
#define PM_LOADI(t, mm) do { const int m_ = (mm) < mlast ? (mm) : mlast; (t).ia = *(const u32x4*)(eidx + (size_t)m_ * 128); (t).ib = *(const u32x4*)(eidx + (size_t)m_ * 128 + 64); } while (0)
#define PM_LOADX(t, mm) do { const int m_ = (mm) < mlast ? (mm) : mlast; const u32x4* xp_ = (const u32x4*)(h1b + (size_t)m_ * DM); (t).xq[0] = xp_[0]; (t).xq[1] = xp_[1]; (t).xq[2] = xp_[2]; (t).xq[3] = xp_[3]; } while (0)
    MTokI iC, iN, iNN; MTokX xC, xN; u32x4 WA[16], WB[16];
    PM_LOADI(iC, m0); PM_LOADI(iN, m0 + NWAVES); PM_LOADI(iNN, m0 + 2 * NWAVES); PM_LOADX(xC, m0); PM_LOADX(xN, m0 + NWAVES); pm_issue(uqs, loff, iC, WA);
    for (int m = m0; m <= mlast; m += 2 * NWAVES) {
        pm_issue(uqs, loff, iN, WB);
        pm_compute(xC, WA, wl, pd + (size_t)m * 128, lane);
        iC = iN; iN = iNN; PM_LOADI(iNN, m + 3 * NWAVES); xC = xN; PM_LOADX(xN, m + 2 * NWAVES);
        pm_issue(uqs, loff, iN, WA);
        pm_compute(xC, WB, wl, pd + (size_t)(m + NWAVES) * 128, lane);
        iC = iN; iN = iNN; PM_LOADI(iNN, m + 4 * NWAVES); xC = xN; PM_LOADX(xN, m + 3 * NWAVES);
    }
#undef PM_LOADI
#undef PM_LOADX
}
__device__ __forceinline__ void phase_peer_act(const Args& a, int tid) {
    const float* pd = (const float*)(a.ws + WS_PD); const unsigned short* eidx = (const unsigned short*)(a.ws + WS_EIDX); const float* eg = (const float*)(a.ws + WS_EG);
    const float* su = (const float*)(a.ws + WS_SU); const float* sv = (const float*)(a.ws + WS_SV); const float* rowss = (const float*)(a.ws + WS_ROWSS); float* act = (float*)(a.ws + WS_ACT);
    for (size_t i4 = (size_t)blockIdx.x * NTHR + tid; i4 < (size_t)T * 32; i4 += (size_t)gridDim.x * NTHR) { const size_t idx = i4 * 4;
        f32x4 d = *(const f32x4*)(pd + idx);
#pragma unroll
        for (int s = 1; s < 8; ++s) d += *(const f32x4*)(pd + (size_t)s * T * 128 + idx);
        const u32x2 ew = *(const u32x2*)(eidx + idx); const f32x4 g = *(const f32x4*)(eg + idx); const float rstd = rsqrtf(rowss[idx >> 7] * (1.f / DM) + EPSF);
        const unsigned e0 = ew.x & 0xffffu, e1 = ew.x >> 16, e2 = ew.y & 0xffffu, e3 = ew.y >> 16;
        f32x4 o; o.x = gelu_tanh(d.x * su[e0] * rstd) * g.x * sv[e0]; o.y = gelu_tanh(d.y * su[e1] * rstd) * g.y * sv[e1];
        o.z = gelu_tanh(d.z * su[e2] * rstd) * g.z * sv[e2]; o.w = gelu_tanh(d.w * su[e3] * rstd) * g.w * sv[e3];
        *(f32x4*)(act + idx) = o;
    }
}
__device__ __forceinline__ void pv_accum(const u32x4 (&w)[8], const f32x4& a0, const f32x4& a1, f32x2v (&o)[8]) {
#pragma unroll
    for (int q = 0; q < 8; ++q) { f32x2v f[8]; fp8x16_to_f32x2(w[q], f); const float aq = (q < 4) ? a0[q & 3] : a1[q & 3]; const f32x2v a2 = (f32x2v){aq, aq};
#pragma unroll
        for (int c = 0; c < 8; ++c) o[c] += a2 * f[c]; }
}
__device__ __forceinline__ void pv_finish(const f32x2v (&o2)[8], bf16_t* orow, int j) {
    float o[16];
#pragma unroll
    for (int c = 0; c < 8; ++c) { o[2 * c] = o2[c].x; o[2 * c + 1] = o2[c].y; }
#pragma unroll
    for (int c = 0; c < 16; ++c) { o[c] += __int_as_float(__builtin_amdgcn_update_dpp(0, __float_as_int(o[c]), 0x128, 0xF, 0xF, true));
        o[c] += __shfl_xor(o[c], 16); o[c] += __shfl_xor(o[c], 32); }
    if (j == 0) { u32x4 w0, w1; w0.x = pk2(o[0], o[1]); w0.y = pk2(o[2], o[3]); w0.z = pk2(o[4], o[5]); w0.w = pk2(o[6], o[7]);
        w1.x = pk2(o[8], o[9]); w1.y = pk2(o[10], o[11]); w1.z = pk2(o[12], o[13]); w1.w = pk2(o[14], o[15]);
        *(u32x4*)orow = w0; *(u32x4*)(orow + 8) = w1; }
}
__device__ __forceinline__ void phase_peer_v(const Args& a, int wave, int lane) {
    const int s = SLICE_OF(blockIdx.x), rk = RANK_OF(blockIdx.x), nrk = gridDim.x >> 3, tper = T / nrk, i = lane & 7, j = lane >> 3;
    const unsigned char* vqs = a.ws + WS_VB + (size_t)s * NEXP * 128; const unsigned loff = 16u * (unsigned)i;
    const unsigned short* eidx = (const unsigned short*)(a.ws + WS_EIDX) + 16 * j; const float* act = (const float*)(a.ws + WS_ACT) + 16 * j;
    bf16_t* obase = (bf16_t*)(a.ws + WS_PO) + 128 * s + 16 * i;
    const int m0 = rk * tper + wave, mlast = (rk + 1) * tper - NWAVES + wave;
#define PV_LOAD(t, mm) do { const int m_ = (mm) < mlast ? (mm) : mlast; const u32x4* ep_ = (const u32x4*)(eidx + (size_t)m_ * 128); const f32x4* ap_ = (const f32x4*)(act + (size_t)m_ * 128); \
        (t).e0 = ep_[0]; (t).e1 = ep_[1]; (t).av[0] = ap_[0]; (t).av[1] = ap_[1]; (t).av[2] = ap_[2]; (t).av[3] = ap_[3]; } while (0)
#define PV_DO(t, w0, w1, mm) do { f32x2v o[8]; _Pragma("unroll") for (int c = 0; c < 8; ++c) o[c] = (f32x2v){0.f, 0.f}; \
        pv_accum(w0, (t).av[0], (t).av[1], o); pv_accum(w1, (t).av[2], (t).av[3], o); pv_finish(o, obase + (size_t)(mm) * DM, j); } while (0)
    VTok tC, tN, tNN; u32x4 wA[8], wB[8], wC[8], wD[8];
    PV_LOAD(tC, m0); PV_LOAD(tN, m0 + NWAVES); PV_LOAD(tNN, m0 + 2 * NWAVES); pu_issue(vqs, loff, tC.e0, wA); pu_issue(vqs, loff, tC.e1, wB);
    for (int m = m0; m <= mlast; m += 2 * NWAVES) {
        pu_issue(vqs, loff, tN.e0, wC); pu_issue(vqs, loff, tN.e1, wD);
        PV_DO(tC, wA, wB, m);
        tC = tN; tN = tNN; PV_LOAD(tNN, m + 3 * NWAVES);
        pu_issue(vqs, loff, tN.e0, wA); pu_issue(vqs, loff, tN.e1, wB);
        PV_DO(tC, wC, wD, m + NWAVES);
        tC = tN; tN = tNN; PV_LOAD(tNN, m + 4 * NWAVES);
    }
#undef PV_LOAD
#undef PV_DO
}
__device__ __forceinline__ void phase_final(const Args& a, int wave, int lane) {
    const int gw = blockIdx.x * NWAVES + wave, NGW = gridDim.x * NWAVES; const bf16_t* po = (const bf16_t*)(a.ws + WS_PO) + 16 * lane; const bf16_t* h1b = (const bf16_t*)(a.ws + WS_H1B) + 16 * lane;
    f32x4 gf[4];
#pragma unroll
    for (int jj = 0; jj < 4; ++jj) gf[jj] = *(const f32x4*)(a.in[I_GFINAL] + 16 * lane + 4 * jj);
    for (int m0 = gw; m0 < T; m0 += 4 * NGW) {
        u32x4 hq[4][2], pq[4][2];
#pragma unroll
        for (int r = 0; r < 4; ++r) { const int m = (m0 + r * NGW < T) ? m0 + r * NGW : m0;
            hq[r][0] = *(const u32x4*)(h1b + (size_t)m * DM); hq[r][1] = *(const u32x4*)(h1b + (size_t)m * DM + 8); pq[r][0] = *(const u32x4*)(po + (size_t)m * DM); pq[r][1] = *(const u32x4*)(po + (size_t)m * DM + 8); }
#pragma unroll
        for (int r = 0; r < 4; ++r) { const int m = m0 + r * NGW; if (m >= T) break;
            float hb[16], pp[16]; unpack8(hq[r][0], *(float(*)[8])&hb[0]); unpack8(hq[r][1], *(float(*)[8])&hb[8]); unpack8(pq[r][0], *(float(*)[8])&pp[0]); unpack8(pq[r][1], *(float(*)[8])&pp[8]);
            f32x4 h[4]; float ss = 0.f;
#pragma unroll
            for (int jj = 0; jj < 4; ++jj) { h[jj] = (f32x4){hb[4 * jj] + pp[4 * jj], hb[4 * jj + 1] + pp[4 * jj + 1], hb[4 * jj + 2] + pp[4 * jj + 2], hb[4 * jj + 3] + pp[4 * jj + 3]};
                ss += (h[jj].x * h[jj].x + h[jj].y * h[jj].y) + (h[jj].z * h[jj].z + h[jj].w * h[jj].w); }
            const float r2 = rsqrtf(wave_sum_dpp(ss) * (1.f / DM) + EPSF);
            float* orow = a.out + (size_t)m * DM + 16 * lane;
#pragma unroll
            for (int jj = 0; jj < 4; ++jj) *(f32x4*)(orow + 4 * jj) = h[jj] * r2 * gf[jj]; }
    }
}
typedef short bf16x8_t __attribute__((ext_vector_type(8)));
__device__ __forceinline__ bf16x8_t toep_frag(const LAS unsigned* R32, int base) {
    const int e = base >> 1, sh = (base & 1) * 16;
    const unsigned d0 = R32[e], d1 = R32[e + 1], d2 = R32[e + 2], d3 = R32[e + 3], d4 = R32[e + 4];
    u32x4 o; o.x = __builtin_amdgcn_alignbit(d1, d0, sh); o.y = __builtin_amdgcn_alignbit(d2, d1, sh); o.z = __builtin_amdgcn_alignbit(d3, d2, sh); o.w = __builtin_amdgcn_alignbit(d4, d3, sh);
    return __builtin_bit_cast(bf16x8_t, o);
}
__device__ __forceinline__ void hy_conv_channel(const Args& a, LAS unsigned char* lds, int c, int tid, int wave, int lane) {
    constexpr int UROW = SP * 2;
    LAS unsigned char* uus = lds;
    LAS unsigned short* R = (LAS unsigned short*)(lds + 8 * UROW);
    const bf16_t* uut = (const bf16_t*)(a.ws + WS_UUT); const bf16_t* kfb = (const bf16_t*)(a.ws + WS_KFB); bf16_t* cvt = (bf16_t*)(a.ws + WS_CONVT);
    { const u32x4* src = (const u32x4*)(uut + (size_t)c * NB * SP); for (int i = tid; i < 8 * UROW / 16; i += NTHR) ((LAS u32x4*)uus)[i] = src[i]; }
    for (int n = tid; n < KFW + 16; n += NTHR) R[n] = (n < KFW) ? kfb[(size_t)c * KFW + (KFW - 1) - n] : (unsigned short)0;
    __syncthreads();
    const LAS unsigned* R32 = (const LAS unsigned*)R;
    const int i = lane & 15, g = lane >> 4, p = (lane >> 3) & 1, b = lane & 7;
    f32x4 C[16]; bf16x8_t A[16];
    const int abase = LT - 32 * (1 + 16 * wave) - i + 8 * g;
#pragma unroll
    for (int tb = 0; tb < 16; ++tb) { C[tb] = (f32x4){0.f, 0.f, 0.f, 0.f}; A[tb] = toep_frag(R32, abase - 32 * tb); }
    const LAS unsigned char* bptr = uus + b * UROW + (16 * p + 8 * g) * 2;
#define HC_STEP(ph, n) do { A[(16 - (ph)) & 15] = toep_frag(R32, abase + 32 * (n)); const bf16x8_t Bf = *(const LAS bf16x8_t*)(bptr + (n) * 64); \
        _Pragma("unroll") for (int tb = 0; tb < 16; ++tb) C[tb] = __builtin_amdgcn_mfma_f32_16x16x32_bf16(A[(tb - (ph)) & 15], Bf, C[tb], 0, 0, 0); } while (0)
    for (int G = 0; G < 8; ++G) { const int n0 = G * 16;
        HC_STEP(0, n0); HC_STEP(1, n0 + 1); HC_STEP(2, n0 + 2); HC_STEP(3, n0 + 3); HC_STEP(4, n0 + 4); HC_STEP(5, n0 + 5); HC_STEP(6, n0 + 6); HC_STEP(7, n0 + 7);
        HC_STEP(8, n0 + 8); HC_STEP(9, n0 + 9); HC_STEP(10, n0 + 10); HC_STEP(11, n0 + 11); HC_STEP(12, n0 + 12); HC_STEP(13, n0 + 13); HC_STEP(14, n0 + 14); HC_STEP(15, n0 + 15); }
    HC_STEP(0, 128);
#undef HC_STEP
#pragma unroll
    for (int tb = 0; tb < 16; ++tb) { const int tq = 512 * wave + 32 * tb + 16 * p + 4 * g;
        u32x2 w; w.x = pk2(C[tb][0], C[tb][1]); w.y = pk2(C[tb][2], C[tb][3]);
        *(u32x2*)(cvt + ((size_t)c * NB + b) * SEQ + tq) = w; }
    __syncthreads();
}
__device__ __forceinline__ void rg_item(const Args& a, LAS unsigned char* lds, int it, int tid, int wave, int lane) {
    constexpr int XROW = 272;
    const int head = it & 7, dir = (it >> 3) & 1, b = it >> 4;
    const bf16_t* xb = (const bf16_t*)(a.ws + WS_RGX) + (size_t)b * LT * DRG + head * 128;
    bf16_t* hout = (bf16_t*)a.out + (size_t)dir * T * DRG + (size_t)b * SEQ * DRG + head * 128 + 16 * wave + (lane & 15);
    const int col = lane & 15, g = lane >> 4, ch = head * 128 + 16 * wave + col;
    LAS unsigned char* wl = lds + 2 * 64 * XROW + wave * 1024 + lane * 16;
#pragma unroll
    for (int gt = 0; gt < 2; ++gt)
#pragma unroll
        for (int ks = 0; ks < 4; ++ks) { const float* wp = a.in[I_RGGW] + ((size_t)((dir * 2 + gt) * 8 + head) * 128 + 32 * ks + 8 * g) * 128 + 16 * wave + col;
            u32x4 o; o.x = pk2(wp[0], wp[128]); o.y = pk2(wp[256], wp[384]); o.z = pk2(wp[512], wp[640]); o.w = pk2(wp[768], wp[896]); *(LAS u32x4*)(wl + (gt * 4 + ks) * 8192) = o; }
    const float br = a.in[I_RGGB][(size_t)(dir * 2 + 0) * DRG + ch], bi = a.in[I_RGGB][(size_t)(dir * 2 + 1) * DRG + ch];
    const float sp8 = -8.0f * log1pf(__expf(-a.in[I_RGLAM][dir * DRG + ch]));
    const int ctr = tid >> 4, ccg = tid & 15;
    float cwv[4][8], cbv[8];
#pragma unroll
    for (int i = 0; i < 8; ++i) { cbv[i] = a.in[I_RGCB][(size_t)dir * DRG + head * 128 + 8 * ccg + i];
#pragma unroll
        for (int j = 0; j < 4; ++j) cwv[j][i] = a.in[I_RGCW][((size_t)dir * 4 + j) * DRG + head * 128 + 8 * ccg + i]; }
    u32x4 xr[2][4];
#define RG_LOAD(k) do { _Pragma("unroll") for (int h_ = 0; h_ < 2; ++h_) { const int u_ = 64 * (k) + ctr + 32 * h_; _Pragma("unroll") for (int j = 0; j < 4; ++j) { const int uu_ = u_ - j; \
        if (uu_ >= 0 && uu_ < LT) { const int t_ = dir ? (LT - 1 - uu_) : uu_; xr[h_][j] = *(const u32x4*)(xb + (size_t)t_ * DRG + 8 * ccg); } \
        else xr[h_][j] = (u32x4){0u, 0u, 0u, 0u}; } } } while (0)
#define RG_CONV(k) do { _Pragma("unroll") for (int h_ = 0; h_ < 2; ++h_) { const int u_ = 64 * (k) + ctr + 32 * h_; float o_[8]; _Pragma("unroll") for (int i = 0; i < 8; ++i) o_[i] = (u_ < LT) ? cbv[i] : 0.f; \
        _Pragma("unroll") for (int j = 0; j < 4; ++j) { float f_[8]; unpack8(xr[h_][j], f_); _Pragma("unroll") for (int i = 0; i < 8; ++i) o_[i] += f_[i] * cwv[j][i]; } \
        u32x4 w0_; w0_.x = pk2(o_[0], o_[1]); w0_.y = pk2(o_[2], o_[3]); w0_.z = pk2(o_[4], o_[5]); w0_.w = pk2(o_[6], o_[7]); \
        *(LAS u32x4*)(lds + ((k) & 1) * (64 * XROW) + (ctr + 32 * h_) * XROW + ccg * 16) = w0_; } } while (0)
    RG_LOAD(0); RG_CONV(0); RG_LOAD(1);
    __syncthreads();
    float carry = 0.f;
    const int arow = 16 * (col >> 2) + (col & 3);
    for (int k = 0; k < 65; ++k) {
        if (k + 1 < 65) RG_CONV(k + 1);
        if (k + 2 < 65) RG_LOAD(k + 2);
        const LAS unsigned char* xa = lds + (k & 1) * (64 * XROW);
        unsigned hp[16]; float hh = 0.f, PP = 1.f;
#pragma unroll
        for (int mp = 0; mp < 2; ++mp) {
            f32x4 acc[2][2];
#pragma unroll
            for (int m2 = 0; m2 < 2; ++m2) { const int mb = 2 * mp + m2; acc[0][m2] = (f32x4){0.f, 0.f, 0.f, 0.f}; acc[1][m2] = (f32x4){0.f, 0.f, 0.f, 0.f};
#pragma unroll
                for (int ks = 0; ks < 4; ++ks) { const bf16x8_t Af = *(const LAS bf16x8_t*)(xa + (arow + 4 * mb) * XROW + (32 * ks + 8 * g) * 2);
                    acc[0][m2] = __builtin_amdgcn_mfma_f32_16x16x32_bf16(Af, *(const LAS bf16x8_t*)(wl + ks * 8192), acc[0][m2], 0, 0, 0);
                    acc[1][m2] = __builtin_amdgcn_mfma_f32_16x16x32_bf16(Af, *(const LAS bf16x8_t*)(wl + (4 + ks) * 8192), acc[1][m2], 0, 0, 0); } }
#pragma unroll
            for (int m2 = 0; m2 < 2; ++m2)
#pragma unroll
                for (int r = 0; r < 4; ++r) { const int e = 8 * mp + 4 * m2 + r, tau = 16 * g + e, u = 64 * k + tau;
                    const float rr = sigmoidf_(acc[0][m2][r] + br), ii = sigmoidf_(acc[1][m2][r] + bi);
                    float av = fexp(sp8 * rr); float mult = __builtin_amdgcn_sqrtf(fmaxf(1.0f - av * av, 0.f)); mult = (u == 0) ? 1.0f : mult;
                    const float xcv = bf2f(*(const LAS unsigned short*)(xa + tau * XROW + (16 * wave + col) * 2));
                    float bq = mult * ii * xcv; if (u >= LT) { av = 1.f; bq = 0.f; }
                    hh = av * hh + bq; PP *= av; hp[e] = pk2(hh, PP); }
        }
        float Pg[4], hg[4];
#pragma unroll
        for (int q = 0; q < 4; ++q) { Pg[q] = __shfl(PP, col + 16 * q); hg[q] = __shfl(hh, col + 16 * q); }
        const float H0 = carry, H1 = Pg[0] * H0 + hg[0], H2 = Pg[1] * H1 + hg[1], H3 = Pg[2] * H2 + hg[2], H4 = Pg[3] * H3 + hg[3];
        const float Hin = (g == 0) ? H0 : (g == 1) ? H1 : (g == 2) ? H2 : H3;
        carry = H4;
#pragma unroll
        for (int e = 0; e < 16; ++e) { const int u = 64 * k + 16 * g + e; const int t = dir ? (LT - 1 - u) : u;
            if (u < LT && t >= NMETA) hout[(size_t)(t - NMETA) * DRG] = (bf16_t)f2bf(bflo(hp[e]) + bfhi(hp[e]) * Hin); }
        __syncthreads();
    }
#undef RG_LOAD
#undef RG_CONV
}
__device__ __forceinline__ float dpp_xor8(float v) { return __int_as_float(__builtin_amdgcn_update_dpp(0, __float_as_int(v), 0x128, 0xF, 0xF, true)); }
__device__ __forceinline__ void rg_item2(const Args& a, LAS unsigned char* lds, int it, int tid, int wave, int lane) {
    constexpr int XROW = 272;
    const int hh = it & 1, head = (it >> 1) & 7, dir = (it >> 4) & 1, b = it >> 5;
    const bf16_t* xb = (const bf16_t*)(a.ws + WS_RGX) + (size_t)b * LT * DRG + head * 128;
    const int col = lane & 15, g = lane >> 4, gate = col >> 3, cj = col & 7, chl = 64 * hh + 8 * wave + cj, ch = head * 128 + chl, qg = 2 * g + gate;
    bf16_t* hout = (bf16_t*)a.out + (size_t)dir * T * DRG + (size_t)b * SEQ * DRG + ch;
    bf16x8_t Wf[4];
#pragma unroll
    for (int ks = 0; ks < 4; ++ks) { const float* wp = a.in[I_RGGW] + ((size_t)((dir * 2 + gate) * 8 + head) * 128 + 32 * ks + 8 * g) * 128 + chl;
        u32x4 o; o.x = pk2(wp[0], wp[128]); o.y = pk2(wp[256], wp[384]); o.z = pk2(wp[512], wp[640]); o.w = pk2(wp[768], wp[896]); Wf[ks] = __builtin_bit_cast(bf16x8_t, o); }
    const float LOG2E = 1.4426950408889634f;
    const float bgl = a.in[I_RGGB][(size_t)(dir * 2 + gate) * DRG + ch] * LOG2E;
    const float sp8l = -8.0f * log1pf(__expf(-a.in[I_RGLAM][dir * DRG + ch])) * LOG2E;
    const int ctr = tid >> 4, ccg = tid & 15;
    float cwv[4][8], cbv[8];
#pragma unroll
    for (int i = 0; i < 8; ++i) { cbv[i] = a.in[I_RGCB][(size_t)dir * DRG + head * 128 + 8 * ccg + i];
#pragma unroll
        for (int j = 0; j < 4; ++j) cwv[j][i] = a.in[I_RGCW][((size_t)dir * 4 + j) * DRG + head * 128 + 8 * ccg + i]; }
    u32x4 xr[2][4];
#define RG_LOAD(k) do { _Pragma("unroll") for (int h_ = 0; h_ < 2; ++h_) { const int u_ = 64 * (k) + ctr + 32 * h_; _Pragma("unroll") for (int j = 0; j < 4; ++j) { const int uu_ = u_ - j; \
        if (uu_ >= 0 && uu_ < LT) { const int t_ = dir ? (LT - 1 - uu_) : uu_; xr[h_][j] = *(const u32x4*)(xb + (size_t)t_ * DRG + 8 * ccg); } \
        else xr[h_][j] = (u32x4){0u, 0u, 0u, 0u}; } } } while (0)
#define RG_CONV(k) do { _Pragma("unroll") for (int h_ = 0; h_ < 2; ++h_) { const int u_ = 64 * (k) + ctr + 32 * h_; float o_[8]; _Pragma("unroll") for (int i = 0; i < 8; ++i) o_[i] = (u_ < LT) ? cbv[i] : 0.f; \
        _Pragma("unroll") for (int j = 0; j < 4; ++j) { float f_[8]; unpack8(xr[h_][j], f_); _Pragma("unroll") for (int i = 0; i < 8; ++i) o_[i] += f_[i] * cwv[j][i]; } \
        u32x4 w0_; w0_.x = pk2(o_[0], o_[1]); w0_.y = pk2(o_[2], o_[3]); w0_.z = pk2(o_[4], o_[5]); w0_.w = pk2(o_[6], o_[7]); \
        *(LAS u32x4*)(lds + ((k) & 1) * (64 * XROW) + (ctr + 32 * h_) * XROW + ccg * 16) = w0_; } } while (0)
    RG_LOAD(0); RG_CONV(0); RG_LOAD(1);
    __syncthreads();
    float carry = 0.f;
    const int arow = 16 * (col >> 2) + (col & 3);
    for (int k = 0; k < 65; ++k) {
        if (k + 1 < 65) RG_CONV(k + 1);
        if (k + 2 < 65) RG_LOAD(k + 2);
        const LAS unsigned char* xa = lds + (k & 1) * (64 * XROW);
        f32x4 acc[4];
#pragma unroll
        for (int mb = 0; mb < 4; ++mb) { acc[mb] = (f32x4){0.f, 0.f, 0.f, 0.f};
#pragma unroll
            for (int ks = 0; ks < 4; ++ks) acc[mb] = __builtin_amdgcn_mfma_f32_16x16x32_bf16(*(const LAS bf16x8_t*)(xa + (arow + 4 * mb) * XROW + (32 * ks + 8 * g) * 2), Wf[ks], acc[mb], 0, 0, 0); }
        float sg[16], ot[16];
#pragma unroll
        for (int e = 0; e < 16; ++e) { sg[e] = __builtin_amdgcn_rcpf(1.0f + __builtin_amdgcn_exp2f(-(acc[e >> 2][e & 3] * LOG2E + bgl))); ot[e] = dpp_xor8(sg[e]); }
        unsigned hp[8]; float hs = 0.f, PP = 1.f;
#pragma unroll
        for (int t = 0; t < 8; ++t) { const float rr = gate ? ot[8 + t] : sg[t], ii = gate ? sg[8 + t] : ot[t]; const int tau = 8 * qg + t, u = 64 * k + tau;
            float av = __builtin_amdgcn_exp2f(sp8l * rr); float mult = __builtin_amdgcn_sqrtf(fmaxf(1.0f - av * av, 0.f)); mult = (u == 0) ? 1.0f : mult;
            const float xcv = bf2f(*(const LAS unsigned short*)(xa + tau * XROW + chl * 2));
            float bq = mult * ii * xcv; if (u >= LT) { av = 1.f; bq = 0.f; }
            hs = av * hs + bq; PP *= av; hp[t] = pk2(hs, PP); }
        float H = carry, Hin = carry;
#pragma unroll
        for (int q = 0; q < 8; ++q) { const int src = cj + 8 * (q & 1) + 16 * (q >> 1); const float Pq = __shfl(PP, src), hq = __shfl(hs, src);
            Hin = (qg == q) ? H : Hin; H = Pq * H + hq; }
        carry = H;
#pragma unroll
        for (int t = 0; t < 8; ++t) { const int u = 64 * k + 8 * qg + t; const int tt = dir ? (LT - 1 - u) : u;
            if (u < LT && tt >= NMETA) hout[(size_t)(tt - NMETA) * DRG] = (bf16_t)f2bf(bflo(hp[t]) + bfhi(hp[t]) * Hin); }
        __syncthreads();
    }
#undef RG_LOAD
#undef RG_CONV
}

__device__ __forceinline__ int rg_lds_off(int row, int chunk) { return row * 320 + (((chunk + 2 * (row >> 4)) & 15) << 4); }
__device__ __forceinline__ void rg_item3(const Args& a, LAS unsigned char* lds, int it, int tid, int wave, int lane) {
    constexpr int XT = 64 * 320;
    const int th = it & 1, head = (it >> 1) & 7, dir = (it >> 4) & 1, b = it >> 5;
    const int k0 = th ? RG_SPLIT : 0, k1 = th ? 65 : RG_SPLIT;
    const bf16_t* xb = (const bf16_t*)(a.ws + WS_RGX) + (size_t)b * LT * DRG + head * 128;
    const int col = lane & 15, g = lane >> 4, chl = 16 * wave + col, ch = head * 128 + chl;
    bf16_t* hout = (bf16_t*)a.out + (size_t)dir * T * DRG + (size_t)b * SEQ * DRG + ch;
    bf16_t* pout = (bf16_t*)(a.ws + WS_RGP) + ((size_t)dir * NB + b) * RG_NF * DRG + ch;
    LAS unsigned char* wl = lds + 2 * XT + wave * 1024 + lane * 16;
#pragma unroll
    for (int gt = 0; gt < 2; ++gt)
#pragma unroll
        for (int ks = 0; ks < 4; ++ks) { const float* wp = a.in[I_RGGW] + ((size_t)((dir * 2 + gt) * 8 + head) * 128 + 32 * ks + 8 * g) * 128 + chl;
            u32x4 o; o.x = pk2(wp[0], wp[128]); o.y = pk2(wp[256], wp[384]); o.z = pk2(wp[512], wp[640]); o.w = pk2(wp[768], wp[896]); *(LAS u32x4*)(wl + (gt * 4 + ks) * 8192) = o; }
    const float LOG2E = 1.4426950408889634f;
    const float brl = a.in[I_RGGB][(size_t)(dir * 2 + 0) * DRG + ch] * LOG2E, bil = a.in[I_RGGB][(size_t)(dir * 2 + 1) * DRG + ch] * LOG2E;
    const float sp8l = -8.0f * log1pf(__expf(-a.in[I_RGLAM][dir * DRG + ch])) * LOG2E;
    const int ctr = tid >> 4, ccg = tid & 15;
    float cwv[4][8], cbv[8];
#pragma unroll
    for (int i = 0; i < 8; ++i) { cbv[i] = a.in[I_RGCB][(size_t)dir * DRG + head * 128 + 8 * ccg + i];
#pragma unroll
        for (int j = 0; j < 4; ++j) cwv[j][i] = a.in[I_RGCW][((size_t)dir * 4 + j) * DRG + head * 128 + 8 * ccg + i]; }
    u32x4 xr[2][4];
#define RG_LOAD(k) do { _Pragma("unroll") for (int h_ = 0; h_ < 2; ++h_) { const int u_ = 64 * (k) + ctr + 32 * h_; _Pragma("unroll") for (int j = 0; j < 4; ++j) { int uu_ = u_ - j; \
        const bool ok_ = (uu_ >= 0 && uu_ < LT); uu_ = ok_ ? uu_ : 0; const int t_ = dir ? (LT - 1 - uu_) : uu_; const u32x4 v_ = *(const u32x4*)(xb + (size_t)t_ * DRG + 8 * ccg); \
        xr[h_][j] = ok_ ? v_ : (u32x4){0u, 0u, 0u, 0u}; } } } while (0)
#define RG_CONV(k) do { _Pragma("unroll") for (int h_ = 0; h_ < 2; ++h_) { const int u_ = 64 * (k) + ctr + 32 * h_; float o_[8]; _Pragma("unroll") for (int i = 0; i < 8; ++i) o_[i] = (u_ < LT) ? cbv[i] : 0.f; \
        _Pragma("unroll") for (int j = 0; j < 4; ++j) { float f_[8]; unpack8(xr[h_][j], f_); _Pragma("unroll") for (int i = 0; i < 8; ++i) o_[i] += f_[i] * cwv[j][i]; } \
        u32x4 w0_; w0_.x = pk2(o_[0], o_[1]); w0_.y = pk2(o_[2], o_[3]); w0_.z = pk2(o_[4], o_[5]); w0_.w = pk2(o_[6], o_[7]); \
        *(LAS u32x4*)(lds + ((k) & 1) * XT + rg_lds_off(ctr + 32 * h_, ccg)) = w0_; } } while (0)
    RG_LOAD(k0); RG_CONV(k0); RG_LOAD(k0 + 1);
    __syncthreads();
    float carry = 0.f, pcar = 1.f;
    const int arow = 16 * (col >> 2) + (col & 3);
    const int xoff = (chl & 7) * 2, xch = chl >> 3;
    unsigned char* hbase = (unsigned char*)((bf16_t*)a.out + (size_t)dir * T * DRG + (size_t)b * SEQ * DRG);
    unsigned char* pbase = (unsigned char*)((bf16_t*)(a.ws + WS_RGP) + ((size_t)dir * NB + b) * RG_NF * DRG);
    const int tsgn = dir ? -1 : 1, t0 = dir ? (LT - 1 - NMETA) : -NMETA;
#define RG_TILE(EDGE) do { \
        unsigned hp[16]; float hh = 0.f, PP = 1.f; \
        _Pragma("unroll") for (int mp = 0; mp < 2; ++mp) { f32x4 acc[2][2]; \
            _Pragma("unroll") for (int m2 = 0; m2 < 2; ++m2) { const int mb = 2 * mp + m2; acc[0][m2] = (f32x4){0.f, 0.f, 0.f, 0.f}; acc[1][m2] = (f32x4){0.f, 0.f, 0.f, 0.f}; \
                _Pragma("unroll") for (int ks = 0; ks < 4; ++ks) { const bf16x8_t Af = *(const LAS bf16x8_t*)(xa + rg_lds_off(arow + 4 * mb, 4 * ks + g)); \
                    acc[0][m2] = __builtin_amdgcn_mfma_f32_16x16x32_bf16(Af, *(const LAS bf16x8_t*)(wl + ks * 8192), acc[0][m2], 0, 0, 0); \
                    acc[1][m2] = __builtin_amdgcn_mfma_f32_16x16x32_bf16(Af, *(const LAS bf16x8_t*)(wl + (4 + ks) * 8192), acc[1][m2], 0, 0, 0); } } \
            _Pragma("unroll") for (int m2 = 0; m2 < 2; ++m2) _Pragma("unroll") for (int r = 0; r < 4; ++r) { const int e = 8 * mp + 4 * m2 + r, tau = 16 * g + e, u = 64 * k + tau; \
                    const float rr = __builtin_amdgcn_rcpf(1.0f + __builtin_amdgcn_exp2f(-(acc[0][m2][r] * LOG2E + brl))), ii = __builtin_amdgcn_rcpf(1.0f + __builtin_amdgcn_exp2f(-(acc[1][m2][r] * LOG2E + bil))); \
                    float av = __builtin_amdgcn_exp2f(sp8l * rr); float mult = __builtin_amdgcn_sqrtf(fmaxf(1.0f - av * av, 0.f)); if (EDGE) mult = (u == 0) ? 1.0f : mult; \
                    const float xcv = bf2f(*(const LAS unsigned short*)(xa + rg_lds_off(tau, xch) + xoff)); \
                    float bq = mult * ii * xcv; if (EDGE) { if (u >= LT) { av = 1.f; bq = 0.f; } } \
                    hh = av * hh + bq; PP *= av; hp[e] = pk2(hh, PP); } } \
        float Pg[4], hg[4]; \
        _Pragma("unroll") for (int q = 0; q < 4; ++q) { Pg[q] = __shfl(PP, col + 16 * q); hg[q] = __shfl(hh, col + 16 * q); } \
        const float H0 = carry, H1 = Pg[0] * H0 + hg[0], H2 = Pg[1] * H1 + hg[1], H3 = Pg[2] * H2 + hg[2], H4 = Pg[3] * H3 + hg[3]; \
        const float Q0 = pcar, Q1 = Pg[0] * Q0, Q2 = Pg[1] * Q1, Q3 = Pg[2] * Q2, Q4 = Pg[3] * Q3; \
        const float Hin = (g == 0) ? H0 : (g == 1) ? H1 : (g == 2) ? H2 : H3, Qin = (g == 0) ? Q0 : (g == 1) ? Q1 : (g == 2) ? Q2 : Q3; \
        carry = H4; pcar = Q4; \
        const int ub = 64 * k + 16 * g; \
        unsigned ho = (unsigned)((t0 + tsgn * ub) * (DRG * 2) + ch * 2), po = (unsigned)((ub - RG_U1) * (DRG * 2) + ch * 2); const unsigned hstep = (unsigned)(tsgn * DRG * 2); \
        _Pragma("unroll") for (int e = 0; e < 16; ++e) { const int u = ub + e; const int t = dir ? (LT - 1 - u) : u; \
            if (!EDGE || (u < LT && t >= NMETA)) { *(bf16_t*)(hbase + ho) = (bf16_t)f2bf(bflo(hp[e]) + bfhi(hp[e]) * Hin); \
                if (th) *(bf16_t*)(pbase + po) = (bf16_t)f2bf(bfhi(hp[e]) * Qin); } \
            ho += hstep; po += (unsigned)(DRG * 2); } \
    } while (0)
    for (int k = k0; k < k1; ++k) {
        if (k + 1 < k1) RG_CONV(k + 1);
        if (k + 2 < k1) RG_LOAD(k + 2);
        const LAS unsigned char* xa = lds + (k & 1) * XT;
        if (k == 0 || k >= 63) RG_TILE(true); else RG_TILE(false);
        __syncthreads();
    }
#undef RG_TILE
    if (th == 0 && g == 0) ((float*)(a.ws + WS_RGC))[((size_t)dir * NB + b) * DRG + ch] = carry;
#undef RG_LOAD
#undef RG_CONV
}

#ifndef RG_NAIVE
#define RG_NAIVE 0
#endif
#ifndef CONV_NAIVE
#define CONV_NAIVE 0
#endif
#ifndef ONE_LAUNCH
#define ONE_LAUNCH 0
#endif
constexpr int NPHASE = 13;
#ifndef NVGPR
#define NVGPR 248
#endif
__global__ void __launch_bounds__(NTHR, 2) __attribute__((amdgpu_num_vgpr(NVGPR))) mega(Args a) {
    extern __shared__ __attribute__((aligned(16))) unsigned char lds_raw[];
    LAS unsigned char* lds = (LAS unsigned char*)lds_raw;
    const int tid = threadIdx.x, lane = tid & 63, wave = __builtin_amdgcn_readfirstlane(tid >> 6);
    cg::grid_group grid = cg::this_grid();
    volatile LAS unsigned* bst = (volatile LAS unsigned*)(lds + LDS_BYTES - 64);
    if (tid == 0) { bst[0] = 0u; bst[1] = 0u; }
    __syncthreads();
    XcdBarrier xbar; xbar.bar = (unsigned*)(a.ws + WS_BAR); xbar.x = 0; xbar.st = bst;
    if (a.ph_hi - a.ph_lo > 1) xbar = xcd_barrier_post((unsigned*)(a.ws + WS_BAR), bst);
    const int lo = a.ph_lo, hi = a.ph_hi, G = gridDim.x, bx = blockIdx.x;
#ifndef PHMASK
#define PHMASK 0x1fff
#endif
#ifndef REPMASK
#define REPMASK 0
#endif
#define IN(k) (((PHMASK >> (k)) & 1) && lo <= (k) && (k) < hi)
#define REP(k)
#define SEAM(k) do { if (IN(k) && ((k) + 1) < hi) xcd_barrier(xbar); } while (0)
    if (a.ph_lo < 0) grid.sync();
    unsigned char* ws = a.ws;
    REP(0) if (IN(0)) phase_p0(a, lds, tid, wave, lane);
    SEAM(0);
    REP(1) if (IN(1)) {
        p1_meta(a, lds, tid, wave, lane);
        pg8::Gemm g{(const bf16_t*)(ws + WS_XN1), (const bf16_t*)(ws + WS_WINT), T, DIN, 1024}; pg8::StaticOrder S; S.init(T, DIN, G, bx);
        EpiProj E{(bf16_t*)(ws + WS_HYIN), (bf16_t*)(ws + WS_RGX), (bf16_t*)(ws + WS_GG), (bf16_t*)(ws + WS_GA), (bf16_t*)(ws + WS_GB), a.in[I_BGATE]};
        pg8::gemm_phase<EpiProj, pg8::StaticOrder>(lds, g, S, E, nullptr);
    }
    SEAM(1);
    REP(2) if (IN(2)) phase_hy_pre(a, lds, tid);
    SEAM(2);
    REP(3) if (IN(3)) {
#if CONV_NAIVE
        phase_hy_conv_naive(a, lds, tid);
#else
        for (int c = bx; c < DHY; c += G) hy_conv_channel(a, lds, c, tid, wave, lane);
#endif
#if RG_NAIVE
        phase_rg_naive(a, lds, tid);
#else
        for (int it = bx; it < NB * 2 * 8 * 2; it += G) rg_item3(a, lds, it, tid, wave, lane);
#endif
    }
    SEAM(3);
    REP(4) if (IN(4)) phase_post(a, lds, tid);
    SEAM(4);
    REP(5) if (IN(5)) {
        { pg8::Gemm g{(const bf16_t*)(ws + WS_YH), (const bf16_t*)(ws + WS_WHT), T, 1024, 512}; pg8::StaticOrder S; S.init(T, 1024, G, bx);
          EpiGate<0> E{(const bf16_t*)(ws + WS_GA), nullptr, (bf16_t*)(ws + WS_TMP)};
          pg8::gemm_phase<EpiGate<0>, pg8::StaticOrder>(lds, g, S, E, nullptr); }
        { pg8::Gemm g{(const bf16_t*)(ws + WS_YR), (const bf16_t*)(ws + WS_WRT), T, 1024, 1024}; pg8::StaticOrder S; S.init(T, 1024, G, bx);
          EpiGate<1> E{(const bf16_t*)(ws + WS_GB), (const bf16_t*)(ws + WS_TMP), (bf16_t*)(ws + WS_MERGED)};
          pg8::gemm_phase<EpiGate<1>, pg8::StaticOrder>(lds, g, S, E, nullptr); }
    }
    SEAM(5);
    REP(6) if (IN(6)) {
        pg8::Gemm g{(const bf16_t*)(ws + WS_MERGED), (const bf16_t*)(ws + WS_WOT), T, 1024, 1024}; pg8::StaticOrder S; S.init(T, 1024, G, bx);
        EpiResid E{a.in[I_X], (bf16_t*)(ws + WS_H1B), (float*)(ws + WS_ROWSS)};
        pg8::gemm_phase<EpiResid, pg8::StaticOrder>(lds, g, S, E, nullptr);
    }
    SEAM(6);
    REP(7) if (IN(7)) {
        phase_tables(a, wave, lane);
        pg8::Gemm g{(const bf16_t*)(ws + WS_H1B), (const bf16_t*)(ws + WS_WST), T, 2048, 1024}; pg8::StaticOrder S; S.init(T, 2048, G, bx);
        EpiScores E{(const float*)(ws + WS_ROWSS), (_Float16*)(ws + WS_SCORES)};
        pg8::gemm_phase<EpiScores, pg8::StaticOrder>(lds, g, S, E, nullptr);
        __syncthreads();
        phase_topk(a, lds, S, wave, lane);
    }
    SEAM(8);
#ifndef U_VALU
#define U_VALU 1
#endif
    REP(9) if (IN(9)) { if (U_VALU) phase_peer_u(a, wave, lane); else phase_peer_u_mfma(a, lds, wave, lane); }
    SEAM(9);
    if (IN(10)) phase_peer_act(a, tid);
    SEAM(10);
    if (IN(11)) phase_peer_v(a, wave, lane);
    SEAM(11);
    if (IN(12)) phase_final(a, wave, lane);
#undef IN
#undef SEAM
}

extern "C" void kernel_launch(void* const* d_in, const int* in_sizes, int n_in, void* d_out, int out_size, void* d_ws, size_t ws_size, hipStream_t stream) {
    static int grid = 0;
    if (grid == 0) {
        if (n_in != N_IN || out_size != T * DM || ws_size < WS_END) { fprintf(stderr, "kernel_launch: unexpected shapes (n_in %d out %d ws %zu)\n", n_in, out_size, ws_size); grid = -1; return; }
        if (hipFuncSetAttribute((const void*)mega, hipFuncAttributeMaxDynamicSharedMemorySize, LDS_BYTES) != hipSuccess) { fprintf(stderr, "kernel_launch: hipFuncSetAttribute failed\n"); grid = -1; return; }
        int dev = 0, cus = 0, per_cu = 0;
        hipGetDevice(&dev); hipDeviceGetAttribute(&cus, hipDeviceAttributeMultiprocessorCount, dev);
        hipOccupancyMaxActiveBlocksPerMultiprocessor(&per_cu, (const void*)mega, NTHR, LDS_BYTES);
        if (per_cu < 1) { fprintf(stderr, "kernel_launch: occupancy query says %d blocks per CU\n", per_cu); per_cu = 1; }
        (void)hipGetLastError();
        grid = cus;
    }
    if (grid < 0) return;
    Args a{};
    for (int i = 0; i < N_IN; ++i) a.in[i] = (const float*)d_in[i];
    a.out = (float*)d_out; a.ws = (unsigned char*)d_ws;
#if ONE_LAUNCH
    if (hipMemsetAsync((char*)d_ws + WS_BAR, 0, XCD_BAR_WORDS * 4, stream) != hipSuccess) { fprintf(stderr, "kernel_launch: memset of the barrier words failed\n"); return; }
    a.ph_lo = 0; a.ph_hi = NPHASE;
    void* args[] = {&a};
    hipError_t e = hipLaunchCooperativeKernel((const void*)mega, dim3(grid), dim3(NTHR), args, LDS_BYTES, stream);
    if (e != hipSuccess) fprintf(stderr, "cooperative launch failed: %s (grid %d)\n", hipGetErrorString(e), grid);
#else
    for (int ph = 0; ph < NPHASE; ++ph) for (int rep = 0; rep < 1 + ((REPMASK >> ph) & 1); ++rep) { a.ph_lo = ph; a.ph_hi = ph + 1;
        if (ph == 6 && rep == 1) (void)hipMemsetAsync((char*)d_ws + WS_ROWSS, 0, T * 4, stream);
        hipLaunchKernelGGL(mega, dim3(grid), dim3(NTHR), LDS_BYTES, stream, a);
        hipError_t e = hipPeekAtLastError(); if (e != hipSuccess) { fprintf(stderr, "launch %d failed: %s\n", ph, hipGetErrorString(e)); break; } }
#endif
}
```

```cpp
#define ONE_LAUNCH 1
#include <hip/hip_runtime.h>
#include <hip/hip_cooperative_groups.h>
#include <cstdio>
#include <cstdint>
#include <cmath>
namespace cg = cooperative_groups;
namespace pg8 {
#define PG8_LAS __attribute__((address_space(3)))
typedef unsigned short bf16_t;
typedef short bf16x8 __attribute__((ext_vector_type(8)));
typedef float f32x4 __attribute__((ext_vector_type(4)));
typedef unsigned u32x4 __attribute__((ext_vector_type(4)));
constexpr int BM = 256, BK = 64, HALF = 128, HTB = HALF * BK * 2  , STAGE_BYTES = 8 * HTB, NXCD = 8, WGM = 8;

__host__ __device__ __forceinline__ int lds_byte(int r, int c) { const int st = (r >> 4) * 2 + (c >> 5), rr = r & 15, cc = c & 31, ob = rr * 64 + cc * 2; return st * 1024 + (ob ^ (((ob >> 9) & 1) << 5)); }
__host__ __device__ __forceinline__ void stage_rc(int b, int& R, int& C) { const int st = b / 1024, sb = b % 1024, swz = sb ^ (((sb >> 9) & 1) << 5); R = (st >> 1) * 16 + swz / 64; C = (st & 1) * 32 + (swz % 64) / 2; }
__host__ __device__ __forceinline__ int perm32(int rho) { const int n = rho >> 4, i = rho & 15; return 8 * (i >> 2) + 4 * n + (i & 3); }

struct Unit { int pm, pn; };
struct Gemm { const bf16_t* A; const bf16_t* Bt; int M, N, K; };

struct StaticOrder {
    int nM, nN, nwg, G, c;
    __host__ __device__ void init(int M, int N, int G_, int c_) { nM = M / BM; nN = N / BM; nwg = nM * nN; G = G_; c = c_; }
    __host__ __device__ bool next(int i, Unit& u) const {
        const long L = (long)i * G + c; if (L >= nwg) return false;
        int wgid = (int)L; { const int q = nwg / NXCD, r = nwg % NXCD, xcd = wgid % NXCD, off = wgid / NXCD; wgid = (xcd < r ? xcd * (q + 1) : r * (q + 1) + (xcd - r) * q) + off; }
        const int nig = WGM * nN, gid = wgid / nig, fm = gid * WGM, gsz = (nM - fm) < WGM ? (nM - fm) : WGM;
        u.pm = fm + ((wgid % nig) % gsz); u.pn = (wgid % nig) / gsz; return true;
    }
    __device__ __forceinline__ void a_ready(const Unit&) const {}
    __device__ __forceinline__ void done(const Unit&) const {}
};
__device__ __forceinline__ unsigned cvt_pk_bf16(float lo, float hi) { unsigned r; asm volatile("v_cvt_pk_bf16_f32 %0, %1, %2" : "=v"(r) : "v"(lo), "v"(hi)); return r; }
typedef float f32x2 __attribute__((ext_vector_type(2)));
__device__ __forceinline__ f32x2 gelu_pk(f32x2 v) {
    const f32x2 av = __builtin_elementwise_abs(v), d = av * 0.2316418882f + 1.0f;
    f32x2 t; t.x = __builtin_amdgcn_rcpf(d.x); t.y = __builtin_amdgcn_rcpf(d.y);
    f32x2 q = t * 0.5307027145f + (-0.7265760135f); q = q * t + 0.7107068705f; q = q * t + (-0.142248368f); q = q * t + 0.127414796f; q = q * t;
    const f32x2 s = (v * v) * (-0.72134752044f);
    f32x2 e; e.x = __builtin_amdgcn_exp2f(s.x); e.y = __builtin_amdgcn_exp2f(s.y);
    const f32x2 m = v * (q * e), r = v - m;
    f32x2 o; o.x = v.x < 0.f ? m.x : r.x; o.y = v.y < 0.f ? m.y : r.y; return o;
}
template <class Epi, class Sched, bool STAMP = false>
__device__ __forceinline__ void gemm_phase(PG8_LAS unsigned char* lds, const Gemm g, const Sched& S, const Epi& E, unsigned long long* stamps) {
    const int tid = threadIdx.x, wid = __builtin_amdgcn_readfirstlane(tid >> 6), lane = tid & 63, wr = wid >> 2, wc = wid & 3, fr = lane & 15, fq = lane >> 4;
    const int K = g.K, nt = K / BK;
    int ts_lo = 0, ts_hi = 0, nts = 0; const unsigned long long rt_entry = STAMP ? (unsigned long long)wall_clock64() : 0ull;
#define PG8_STAMP() do { if (STAMP && wid == 0 && nts < 64) { const unsigned long long _c = (unsigned long long)clock64(); \
        ts_lo = (lane == nts) ? (int)(unsigned)_c : ts_lo; ts_hi = (lane == nts) ? (int)(unsigned)(_c >> 32) : ts_hi; ++nts; } } while (0)
    PG8_STAMP();
    unsigned voffA[2], voffB[2];
#pragma unroll
    for (int i = 0; i < 2; ++i) { int R, C; stage_rc(tid * 16 + i * 8192, R, C); const int Rb = Epi::PERM ? ((R & ~31) + perm32(R & 31)) : R;
        voffA[i] = (unsigned)(R * K + C) * 2u; voffB[i] = (unsigned)(Rb * K + C) * 2u; }
    const size_t kstep = (size_t)(BK * 2);
    const size_t hstep = (size_t)HALF * K * 2;
    const size_t tstep = 2 * hstep;
    const unsigned ldsw = (unsigned)wid * 1024u;
    const int aoff = lds_byte(wr * 64 + fr, fq * 8), boff = lds_byte(wc * 32 + fr, fq * 8);
#define PG8_SA(b, h) (((b) * 2 + (h)) * HTB)
#define PG8_SB(b, h) ((4 + (b) * 2 + (h)) * HTB)
#define PG8_STAGE(bufoff, gbase, voff) do { _Pragma("unroll") for (int _i = 0; _i < 2; ++_i) \
        __builtin_amdgcn_global_load_lds((const unsigned*)((const char*)(gbase) + (voff)[_i]), (PG8_LAS unsigned*)(lds + (bufoff) + ldsw + _i * 8192), 16, 0, 0); } while (0)
#define PG8_LDA(dst, b, h) do { _Pragma("unroll") for (int m = 0; m < 4; ++m) _Pragma("unroll") for (int k = 0; k < 2; ++k) dst[m][k] = *(const PG8_LAS bf16x8*)(lds + PG8_SA(b, h) + aoff + m * 2048 + k * 1024); } while (0)
#define PG8_LDB(dst, b, h) do { _Pragma("unroll") for (int n = 0; n < 2; ++n) _Pragma("unroll") for (int k = 0; k < 2; ++k) dst[n][k] = *(const PG8_LAS bf16x8*)(lds + PG8_SB(b, h) + boff + n * 2048 + k * 1024); } while (0)
#define PG8_MMA(ai, bj, At, Bt) do { __builtin_amdgcn_s_setprio(1); _Pragma("unroll") for (int m = 0; m < 4; ++m) _Pragma("unroll") for (int n = 0; n < 2; ++n) _Pragma("unroll") for (int k = 0; k < 2; ++k) \
        acc[ai][bj][m][n] = __builtin_amdgcn_mfma_f32_16x16x32_bf16(Bt[n][k], At[m][k], acc[ai][bj][m][n], 0, 0, 0); __builtin_amdgcn_s_setprio(0); } while (0)
#define PG8_WAIT_V(n) asm volatile("s_waitcnt vmcnt(" #n ")" ::: "memory")
#define PG8_WAIT_L(n) asm volatile("s_waitcnt lgkmcnt(" #n ")" ::: "memory")
#define PG8_BAR __builtin_amdgcn_s_barrier()
#define PG8_SCHED __builtin_amdgcn_sched_barrier(0)
    Unit cur, nxt; int ui = 0;
    if (!S.next(0, cur)) return;
    f32x4 acc[2][2][4][2];
#pragma unroll
    for (int a = 0; a < 2; ++a)
#pragma unroll
        for (int b = 0; b < 2; ++b)
#pragma unroll
            for (int m = 0; m < 4; ++m)
#pragma unroll
                for (int n = 0; n < 2; ++n) acc[a][b][m][n] = (f32x4){0.f, 0.f, 0.f, 0.f};
    bf16x8 At[4][2], B0[2][2], B1[2][2];
    const char* cA = (const char*)g.A + (size_t)cur.pm * tstep; const char* cB = (const char*)g.Bt + (size_t)cur.pn * tstep;
    S.a_ready(cur);
    PG8_STAGE(PG8_SB(0, 0), cB, voffB); PG8_STAGE(PG8_SA(0, 0), cA, voffA); PG8_STAGE(PG8_SB(0, 1), cB + hstep, voffB); PG8_STAGE(PG8_SA(0, 1), cA + hstep, voffA);
    if (wr == 1) PG8_BAR;
    PG8_WAIT_V(4); PG8_BAR;
    PG8_STAGE(PG8_SB(1, 0), cB + kstep, voffB); PG8_STAGE(PG8_SA(1, 0), cA + kstep, voffA); PG8_STAGE(PG8_SB(1, 1), cB + hstep + kstep, voffB);
    PG8_WAIT_V(6); PG8_BAR;
    PG8_STAMP();
    for (;;) {
        const bool has_next = S.next(ui + 1, nxt);
        const char* nA = has_next ? (const char*)g.A + (size_t)nxt.pm * tstep : cA; const char* nB = has_next ? (const char*)g.Bt + (size_t)nxt.pn * tstep : cB;
        for (int t = 0; t < nt; t += 2) {
            const bool last = (t == nt - 2);
            const char* a1 = cA + (size_t)(t + 1) * kstep;
            const char* a2 = last ? nA : cA + (size_t)(t + 2) * kstep; const char* b2 = last ? nB : cB + (size_t)(t + 2) * kstep;
            const char* a3 = a2 + kstep; const char* b3 = b2 + kstep;
            if (last && has_next) S.a_ready(nxt);
            PG8_LDB(B0, 0, 0); PG8_SCHED; PG8_LDA(At, 0, 0); PG8_STAGE(PG8_SA(1, 1), a1 + hstep, voffA);
            PG8_WAIT_L(8); PG8_BAR; PG8_WAIT_L(0); PG8_MMA(0, 0, At, B0); PG8_BAR; PG8_SCHED;
            PG8_LDB(B1, 0, 1); PG8_STAGE(PG8_SB(0, 0), b2, voffB);
            PG8_BAR; PG8_WAIT_L(0); PG8_MMA(0, 1, At, B1); PG8_BAR;
            PG8_LDA(At, 0, 1); PG8_STAGE(PG8_SA(0, 0), a2, voffA);
            PG8_BAR; PG8_WAIT_L(0); PG8_MMA(1, 0, At, B0); PG8_BAR; PG8_SCHED;
            PG8_STAGE(PG8_SB(0, 1), b2 + hstep, voffB);
            PG8_WAIT_V(6); PG8_BAR; PG8_MMA(1, 1, At, B1); PG8_BAR;
            PG8_LDB(B0, 1, 0); PG8_SCHED; PG8_LDA(At, 1, 0); PG8_STAGE(PG8_SA(0, 1), a2 + hstep, voffA);
            PG8_WAIT_L(8); PG8_BAR; PG8_WAIT_L(0); PG8_MMA(0, 0, At, B0); PG8_BAR; PG8_SCHED;
            PG8_LDB(B1, 1, 1); PG8_STAGE(PG8_SB(1, 0), b3, voffB);
            PG8_BAR; PG8_WAIT_L(0); PG8_MMA(0, 1, At, B1); PG8_BAR;
            PG8_LDA(At, 1, 1); PG8_STAGE(PG8_SA(1, 0), a3, voffA);
            PG8_BAR; PG8_WAIT_L(0); PG8_MMA(1, 0, At, B0); PG8_BAR; PG8_SCHED;
            PG8_STAGE(PG8_SB(1, 1), b3 + hstep, voffB);
            PG8_WAIT_V(6); PG8_BAR; PG8_MMA(1, 1, At, B1); PG8_BAR;
        }
        PG8_STAMP();
        if constexpr (!Epi::AFTER_DRAIN) { E(acc, cur, wr, wc, fr, fq); S.done(cur); }
        PG8_STAMP();
        if (!has_next) break;
#pragma unroll
        for (int a = 0; a < 2; ++a)
#pragma unroll
            for (int b = 0; b < 2; ++b)
#pragma unroll
                for (int m = 0; m < 4; ++m)
#pragma unroll
                    for (int n = 0; n < 2; ++n) acc[a][b][m][n] = (f32x4){0.f, 0.f, 0.f, 0.f};
        cur = nxt; cA = nA; cB = nB; ++ui;
    }
    PG8_WAIT_V(0);
    if (wr == 0) PG8_BAR;
    PG8_BAR;
    if constexpr (Epi::AFTER_DRAIN) { E.fused(acc, cur, wr, wc, fr, fq, lds, wid, lane); S.done(cur); }
    PG8_STAMP();
    if (STAMP && wid == 0) { stamps[lane] = lane < nts ? (((unsigned long long)(unsigned)ts_hi << 32) | (unsigned)ts_lo) : 0ull;
        if (lane == 62) stamps[62] = rt_entry; if (lane == 63) stamps[63] = (unsigned long long)wall_clock64(); }
#undef PG8_STAMP
#undef PG8_SA
#undef PG8_SB
#undef PG8_STAGE
#undef PG8_LDA
#undef PG8_LDB
#undef PG8_MMA
#undef PG8_WAIT_V
#undef PG8_WAIT_L
#undef PG8_BAR
#undef PG8_SCHED
}
}

#define LAS __attribute__((address_space(3)))
typedef unsigned short bf16_t;
typedef float f32x4 __attribute__((ext_vector_type(4)));
typedef float f32x2 __attribute__((ext_vector_type(2)));
typedef unsigned u32x4 __attribute__((ext_vector_type(4)));
typedef unsigned u32x2 __attribute__((ext_vector_type(2)));

constexpr int NB = 8, SEQ = 4096, NMETA = 16, LT = SEQ + NMETA, DM = 1024, T = NB * SEQ;
constexpr int DHY = 512, DRG = 1024, DIN = 3 * DHY + 2 * DRG + 2 * DM;
constexpr int NTHR = 512, NWAVES = 8;
constexpr int LDS_BYTES = 160 * 1024;
constexpr float EPSF = 1e-6f;
constexpr int KFW = 2 * LT;
constexpr int SP = 4256;
constexpr int NEXP = 16384;
constexpr int RG_SPLIT = 33, RG_U1 = RG_SPLIT * 64;
constexpr int RG_NF = LT - RG_U1;

enum { I_X = 0, I_META, I_GFINAL, I_GMIX, I_WIN, I_BGATE, I_HYCW, I_HYCB, I_HYW1, I_HYB1, I_HYW2, I_HYB2, I_HYW3, I_HYB3, I_HYFREQ, I_HYSKIP,
       I_HYOUT, I_RGCW, I_RGCB, I_RGGW, I_RGGB, I_RGLAM, I_RGOUT, I_WOUT, I_GFFN, I_WQ, I_KEYS, I_PU, I_PV, N_IN };

constexpr size_t MiB = 1024ull * 1024ull;
constexpr size_t WS_ROWSS = 64 * 1024;
constexpr size_t WS_SU = 256 * 1024;
constexpr size_t WS_SV = 320 * 1024;
constexpr size_t WS_ROWSS2 = 384 * 1024;
constexpr size_t WS_BAR = 512 * 1024;
constexpr size_t WS_WINT = 1 * MiB;
constexpr size_t WS_WHT = 12 * MiB;
constexpr size_t WS_WRT = 13 * MiB;
constexpr size_t WS_WOT = 15 * MiB;
constexpr size_t WS_WST = 17 * MiB;
constexpr size_t WS_GWT = 21 * MiB;
constexpr size_t WS_KF = 22 * MiB;
constexpr size_t WS_KFB = 39 * MiB;
constexpr size_t WS_HYIN = 48 * MiB;
constexpr size_t WS_RGX = 145 * MiB;
constexpr size_t WS_GG = 210 * MiB;
constexpr size_t WS_GA = 274 * MiB;
constexpr size_t WS_GB = 338 * MiB;
constexpr size_t WS_XN1 = 402 * MiB;
constexpr size_t WS_UUT = 402 * MiB;
constexpr size_t WS_CONVT = 436 * MiB;
constexpr size_t WS_YH = 468 * MiB;
constexpr size_t WS_YR = WS_RGX;
constexpr size_t WS_MERGED = WS_HYIN;
constexpr size_t WS_TMP = WS_GG;
constexpr size_t WS_H1B = WS_RGX;
constexpr size_t WS_SCORES = WS_GG;
constexpr size_t WS_EIDX = 468 * MiB;
constexpr size_t WS_EG = 484 * MiB;
constexpr size_t WS_UB = 48 * MiB;
constexpr size_t WS_VB = 64 * MiB;
constexpr size_t WS_PD = 210 * MiB;
constexpr size_t WS_PO = WS_PD;
constexpr size_t WS_ACT = 338 * MiB;
constexpr size_t WS_RGP = 48 * MiB;
constexpr size_t WS_RGC = 576 * 1024;
constexpr size_t WS_END = 500 * MiB;

struct Args { const float* in[N_IN]; float* out; unsigned char* ws; int ph_lo, ph_hi; };

__device__ __forceinline__ float bf2f(unsigned v) { return __uint_as_float(v << 16); }
typedef __bf16 bf16x2_t __attribute__((ext_vector_type(2)));
__device__ __forceinline__ unsigned pk2(float lo, float hi) { bf16x2_t v; v.x = (__bf16)lo; v.y = (__bf16)hi; return __builtin_bit_cast(unsigned, v); }
__device__ __forceinline__ unsigned f2bf(float f) { return pk2(f, f) & 0xffffu; }
__device__ __forceinline__ float bflo(unsigned w) { return __uint_as_float(w << 16); }
__device__ __forceinline__ float bfhi(unsigned w) { return __uint_as_float(w & 0xffff0000u); }
__device__ __forceinline__ float wave_sum(float v) {
#pragma unroll
    for (int o = 1; o < 64; o <<= 1) v += __shfl_xor(v, o);
    return v;
}
__device__ __forceinline__ float wave_max(float v) {
#pragma unroll
    for (int o = 1; o < 64; o <<= 1) v = fmaxf(v, __shfl_xor(v, o));
    return v;
}
__device__ __forceinline__ float fexp(float x) { return __builtin_amdgcn_exp2f(x * 1.4426950408889634f); }
__device__ __forceinline__ float sigmoidf_(float x) { return __builtin_amdgcn_rcpf(1.0f + fexp(-x)); }
__device__ __forceinline__ float gelu_tanh(float x) { const float u = 1.5957691216f * (x + 0.044715f * x * x * x); return x * __builtin_amdgcn_rcpf(1.0f + fexp(-u)); }
__device__ __forceinline__ void sincos_acc(float a, float& s, float& c) {
    const double x = (double)a;
    const double q = rint(x * 0.63661977236758134308);
    const double r = fma(-q, 1.57079632679489661923, x);
    const int n = (int)q;
    const float rf = (float)r, r2 = rf * rf;
    const float sp = rf * (1.f + r2 * (-1.6666667e-1f + r2 * (8.3333333e-3f + r2 * (-1.9841270e-4f + r2 * 2.7557319e-6f))));
    const float cp = 1.f + r2 * (-0.5f + r2 * (4.1666667e-2f + r2 * (-1.3888889e-3f + r2 * (2.4801587e-5f + r2 * (-2.7557319e-7f)))));
    const int k = n & 3;
    s = (k == 0) ? sp : (k == 1) ? cp : (k == 2) ? -sp : -cp;
    c = (k == 0) ? cp : (k == 1) ? -sp : (k == 2) ? -cp : sp;
}

typedef float f32x2v __attribute__((ext_vector_type(2)));
__device__ __forceinline__ float wave_sum_dpp(float v) {
    v += __int_as_float(__builtin_amdgcn_update_dpp(0, __float_as_int(v), 0xB1, 0xF, 0xF, true));
    v += __int_as_float(__builtin_amdgcn_update_dpp(0, __float_as_int(v), 0x4E, 0xF, 0xF, true));
    v += __int_as_float(__builtin_amdgcn_update_dpp(0, __float_as_int(v), 0x141, 0xF, 0xF, true));
    v += __int_as_float(__builtin_amdgcn_update_dpp(0, __float_as_int(v), 0x140, 0xF, 0xF, true));
    const int vi = __float_as_int(v);
    return (__int_as_float(__builtin_amdgcn_readlane(vi, 0)) + __int_as_float(__builtin_amdgcn_readlane(vi, 16))) + (__int_as_float(__builtin_amdgcn_readlane(vi, 32)) + __int_as_float(__builtin_amdgcn_readlane(vi, 48)));
}
__device__ __forceinline__ float wave_max_dpp(float v) {
    v = fmaxf(v, __int_as_float(__builtin_amdgcn_update_dpp(0, __float_as_int(v), 0xB1, 0xF, 0xF, true)));
    v = fmaxf(v, __int_as_float(__builtin_amdgcn_update_dpp(0, __float_as_int(v), 0x4E, 0xF, 0xF, true)));
    v = fmaxf(v, __int_as_float(__builtin_amdgcn_update_dpp(0, __float_as_int(v), 0x141, 0xF, 0xF, true)));
    v = fmaxf(v, __int_as_float(__builtin_amdgcn_update_dpp(0, __float_as_int(v), 0x140, 0xF, 0xF, true)));
    const int vi = __float_as_int(v);
    return fmaxf(fmaxf(__int_as_float(__builtin_amdgcn_readlane(vi, 0)), __int_as_float(__builtin_amdgcn_readlane(vi, 16))), fmaxf(__int_as_float(__builtin_amdgcn_readlane(vi, 32)), __int_as_float(__builtin_amdgcn_readlane(vi, 48))));
}

#ifndef SLICE_PROBE
#define SLICE_OF(b) ((b) & 7)
#define RANK_OF(b) ((b) >> 3)
#else
#define SLICE_OF(b) ((b) >> 5)
#define RANK_OF(b) ((b) & 31)
#endif

__device__ __forceinline__ float dpp_xor8(float v) { return __int_as_float(__builtin_amdgcn_update_dpp(0, __float_as_int(v), 0x128, 0xF, 0xF, true)); }
#define XB_TMO      128
#define XB_XCNT(j)  (256  + 64 * (j))
#define XB_XSUB(j)  (1280 + 64 * (j))
#define XB_XGEN(j)  (2304 + 64 * (j))
#define XB_TOP      3328
#define XB_TOPGEN   3392
#define XCD_BAR_WORDS 3456
#define XB_SPIN_CAP (1u << 18)

__device__ __forceinline__ unsigned xb_ld(unsigned* p)              { return __hip_atomic_load(p, __ATOMIC_RELAXED, __HIP_MEMORY_SCOPE_AGENT); }
__device__ __forceinline__ unsigned xb_add(unsigned* p, unsigned v) { return __hip_atomic_fetch_add(p, v, __ATOMIC_RELAXED, __HIP_MEMORY_SCOPE_AGENT); }
__device__ __forceinline__ unsigned xb_xcc_id() { return (unsigned)__builtin_amdgcn_s_getreg((3 << 11) | 20) & 0xFu; }
#define XB_SPIN(cond, bar) do { unsigned _sp = 0; while (cond) { __builtin_amdgcn_s_sleep(1); \
    if ((++_sp & 255u) == 0u) { if (xb_ld(&(bar)[XB_TMO])) break; if (_sp > XB_SPIN_CAP) { atomicAdd(&(bar)[XB_TMO], 1u); break; } } } } while (0)

struct XcdBarrier {
    unsigned* bar; unsigned x;
    volatile LAS unsigned* st;
};

__device__ __forceinline__ XcdBarrier xcd_barrier_post(unsigned* bar, volatile LAS unsigned* st) {
    XcdBarrier b; b.bar = bar; b.x = xb_xcc_id(); b.st = st;
    if (threadIdx.x == 0) (void)xb_add(&bar[XB_XCNT(b.x)], 1u);
    return b;
}
__device__ __forceinline__ void xcd_barrier_complete(unsigned* bar, unsigned x, unsigned& nloc, unsigned& nx) {
    const unsigned G = gridDim.x * gridDim.y * gridDim.z;
    unsigned sum, cnt, mine, sp = 0u;
    for (;;) {
        sum = 0u; cnt = 0u; mine = 0u;
#pragma unroll
        for (unsigned j = 0; j < 16; ++j) { const unsigned c = xb_ld(&bar[XB_XCNT(j)]); sum += c; cnt += (c > 0u) ? 1u : 0u; mine = (j == x) ? c : mine; }
        if (sum == G) break;
        __builtin_amdgcn_s_sleep(1);
        if ((++sp & 255u) == 0u) { if (xb_ld(&bar[XB_TMO])) break; if (sp > XB_SPIN_CAP) { atomicAdd(&bar[XB_TMO], 1u); break; } }
    }
    nloc = mine > 0u ? mine : 1u; nx = cnt > 0u ? cnt : 1u;
}

__device__ __forceinline__ void xcd_barrier(const XcdBarrier& b) {
    asm volatile("s_waitcnt vmcnt(0)" ::: "memory");
    __syncthreads();
    if (threadIdx.x == 0) {
        unsigned* bar = b.bar;
        __builtin_amdgcn_s_waitcnt(0);
        unsigned nloc = b.st[0], nx = b.st[1];
        if (nloc == 0u) { xcd_barrier_complete(bar, b.x, nloc, nx); b.st[0] = nloc; b.st[1] = nx; }
        const unsigned old = xb_add(&bar[XB_XSUB(b.x)], 1u);
        const unsigned gen = old / nloc;
        if (old + 1u == (gen + 1u) * nloc) {
            __builtin_amdgcn_fence(__ATOMIC_RELEASE, "agent");
            asm volatile("s_waitcnt vmcnt(0)" ::: "memory");
            const unsigned og = xb_add(&bar[XB_TOP], 1u);
            const unsigned tg = og / nx;
            if (og + 1u == (tg + 1u) * nx) xb_add(&bar[XB_TOPGEN], 1u);
            else XB_SPIN(xb_ld(&bar[XB_TOPGEN]) == tg, bar);
            __builtin_amdgcn_fence(__ATOMIC_ACQUIRE, "agent");
            xb_add(&bar[XB_XGEN(b.x)], 1u);
            asm volatile("s_waitcnt vmcnt(0)" ::: "memory");
        } else {
            XB_SPIN(xb_ld(&bar[XB_XGEN(b.x)]) == gen, bar);
            __builtin_amdgcn_fence(__ATOMIC_ACQUIRE, "agent");
            asm volatile("s_waitcnt vmcnt(0)" ::: "memory");
        }
    }
    __syncthreads();
}

__device__ __forceinline__ void p0_transpose_item(const float* W, int K, int N, bf16_t* WT, LAS float* scr, int item, int lane) {
    const int nblk = N / 32, kb = item / nblk, nb = item % nblk, k0 = 64 * kb, n0 = 32 * nb;
#pragma unroll 8
    for (int i = 0; i < 32; ++i) { const int kk = 2 * i + (lane >> 5); scr[kk * 33 + (lane & 31)] = W[(size_t)(k0 + kk) * N + n0 + (lane & 31)]; }
    asm volatile("s_waitcnt lgkmcnt(0)" ::: "memory");
    const int c = lane & 7;
#pragma unroll
    for (int j = 0; j < 4; ++j) { const int n = (lane >> 3) + 8 * j; const LAS float* s = scr + (8 * c) * 33 + n;
        u32x4 o; o.x = pk2(s[0 * 33], s[1 * 33]); o.y = pk2(s[2 * 33], s[3 * 33]); o.z = pk2(s[4 * 33], s[5 * 33]); o.w = pk2(s[6 * 33], s[7 * 33]);
        *(u32x4*)(WT + (size_t)(n0 + n) * K + k0 + 8 * c) = o; }
    asm volatile("s_waitcnt lgkmcnt(0)" ::: "memory");
}
__device__ __forceinline__ void p0_xn1_row(const float* xrow, const float* g, bf16_t* orow, int lane) {
    const f32x4* xr = (const f32x4*)xrow + lane; const f32x4* gr = (const f32x4*)g + lane;
    f32x4 v[4]; float s = 0.f;
#pragma unroll
    for (int j = 0; j < 4; ++j) { v[j] = xr[64 * j]; s += (v[j].x * v[j].x + v[j].y * v[j].y) + (v[j].z * v[j].z + v[j].w * v[j].w); }
    const float rstd = rsqrtf(wave_sum(s) * (1.f / DM) + EPSF);
    unsigned long long* o8 = (unsigned long long*)orow + lane;
#pragma unroll
    for (int j = 0; j < 4; ++j) { const f32x4 gv = gr[64 * j];
        o8[64 * j] = (unsigned long long)pk2(v[j].x * rstd * gv.x, v[j].y * rstd * gv.y) | ((unsigned long long)pk2(v[j].z * rstd * gv.z, v[j].w * rstd * gv.w) << 32); }
}
__device__ __forceinline__ void p0_fold_item(const Args& a, LAS unsigned char* lds, int item, int tid) {
    const int hp = item >> 4, k0 = (item & 15) * 64;
    LAS float* kl = (LAS float*)lds;
    LAS float* wl = (LAS float*)(lds + 128 * 129 * 4);
    const float* keys = a.in[I_KEYS] + (size_t)hp * 128 * 128; const float* wq = a.in[I_WQ];
    for (int i = tid; i < 128 * 128; i += NTHR) { const int key = i >> 7, d = i & 127; kl[key * 129 + d] = keys[i]; }
    for (int i = tid; i < 64 * 128; i += NTHR) { const int kk = i >> 7, d = i & 127; wl[i] = wq[(size_t)(k0 + kk) * 2048 + hp * 128 + d]; }
    __syncthreads();
    const int key = tid & 127, kq = tid >> 7;
    float acc[16];
#pragma unroll
    for (int i = 0; i < 16; ++i) acc[i] = 0.f;
#pragma unroll 2
    for (int d = 0; d < 128; ++d) { const float kv = kl[key * 129 + d];
#pragma unroll
        for (int i = 0; i < 16; ++i) acc[i] += wl[(kq * 16 + i) * 128 + d] * kv; }
    const float* gf = a.in[I_GFFN] + k0 + kq * 16;
    bf16_t* dst = (bf16_t*)(a.ws + WS_WST) + (size_t)(hp * 128 + key) * 1024 + k0 + kq * 16;
    u32x4 o0, o1;
    o0.x = pk2(acc[0] * gf[0], acc[1] * gf[1]); o0.y = pk2(acc[2] * gf[2], acc[3] * gf[3]); o0.z = pk2(acc[4] * gf[4], acc[5] * gf[5]); o0.w = pk2(acc[6] * gf[6], acc[7] * gf[7]);
    o1.x = pk2(acc[8] * gf[8], acc[9] * gf[9]); o1.y = pk2(acc[10] * gf[10], acc[11] * gf[11]); o1.z = pk2(acc[12] * gf[12], acc[13] * gf[13]); o1.w = pk2(acc[14] * gf[14], acc[15] * gf[15]);
    *(u32x4*)dst = o0; *(u32x4*)(dst + 8) = o1;
    __syncthreads();
}
__device__ __forceinline__ void p0_meta_item(const Args& a, LAS unsigned char* lds, int item, int tid, int wave, int lane) {
    LAS float* mt = (LAS float*)lds;
    for (int r = wave * 2; r < wave * 2 + 2; ++r) {
        const f32x4* xr = (const f32x4*)(a.in[I_META] + (size_t)r * DM) + lane; const f32x4* gr = (const f32x4*)a.in[I_GMIX] + lane;
        f32x4 v[4]; float s = 0.f;
#pragma unroll
        for (int j = 0; j < 4; ++j) { v[j] = xr[64 * j]; s += (v[j].x * v[j].x + v[j].y * v[j].y) + (v[j].z * v[j].z + v[j].w * v[j].w); }
        const float rstd = rsqrtf(wave_sum(s) * (1.f / DM) + EPSF);
#pragma unroll
        for (int j = 0; j < 4; ++j) { const f32x4 gv = gr[64 * j]; f32x4 o = v[j] * rstd * gv; *(LAS f32x4*)(mt + r * 1024 + 4 * (lane + 64 * j)) = o; }
    }
    __syncthreads();
    const int col = item * 256 + (tid & 255), rh = tid >> 8;
    float acc[8];
#pragma unroll
    for (int r = 0; r < 8; ++r) acc[r] = 0.f;
    const float* w = a.in[I_WIN] + col;
#pragma unroll 4
    for (int k = 0; k < 1024; ++k) { const float wv = w[(size_t)k * DIN];
#pragma unroll
        for (int r = 0; r < 8; ++r) acc[r] += mt[(rh * 8 + r) * 1024 + k] * wv; }
    bf16_t* hyin = (bf16_t*)(a.ws + WS_HYIN); bf16_t* rgx = (bf16_t*)(a.ws + WS_RGX);
#pragma unroll
    for (int r = 0; r < 8; ++r) { const int t = rh * 8 + r; const bf16_t v = (bf16_t)f2bf(acc[r]);
        for (int b = 0; b < NB; ++b) { if (col < 1536) hyin[((size_t)b * LT + t) * 1536 + col] = v; else rgx[((size_t)b * LT + t) * 1024 + (col - 1536)] = v; } }
    __syncthreads();
}
constexpr int FPP = 17, NFILT = (LT + FPP - 1) / FPP;
__device__ __forceinline__ void p0_filter_item(const Args& a, LAS unsigned char* lds, int item, int tid) {
    LAS float* z = (LAS float*)lds;
    LAS float* h1 = z + FPP * 33;
    LAS float* h2 = h1 + FPP * 64;
    LAS float* ko = h2 + FPP * 64;
    const int p0 = item * FPP;
    for (int idx = tid; idx < FPP * 33; idx += NTHR) { const int pp = idx / 33, f = idx % 33, p = p0 + pp;
        float v;
        if (f == 0) v = (float)p * (1.0f / (float)(LT - 1));
        else { const int bi = (f - 1) & 15; const float band = 1e-4f + (float)bi * ((15.0f - 1e-4f) / 15.0f); const float w = (float)(6.283185307179586 / (double)LT) * (float)p;
            float s, c; sincos_acc(band * w, s, c); v = (f <= 16) ? c : -s; }
        z[idx] = v; }
    __syncthreads();
    const float* w1 = a.in[I_HYW1]; const float* b1 = a.in[I_HYB1]; const float* w2 = a.in[I_HYW2]; const float* b2 = a.in[I_HYB2];
    const float* w3 = a.in[I_HYW3]; const float* b3 = a.in[I_HYB3]; const float* fr = a.in[I_HYFREQ];
    { const int j = tid & 63, pq = tid >> 6;
        float wv[33];
#pragma unroll
        for (int f = 0; f < 33; ++f) wv[f] = w1[f * 64 + j];
        const float bj = b1[j], fj = fr[j];
        for (int pp = pq; pp < FPP; pp += 8) { float acc = bj;
#pragma unroll
            for (int f = 0; f < 33; ++f) acc += z[pp * 33 + f] * wv[f];
            float s, c; sincos_acc(fj * acc, s, c); h1[pp * 64 + j] = s; } }
    __syncthreads();
    { const int j = tid & 63, pq = tid >> 6;
        const float bj = b2[j], fj = fr[64 + j]; float accp[3] = {bj, bj, bj};
#pragma unroll 1
        for (int fh = 0; fh < 2; ++fh) { float wv[32];
#pragma unroll
            for (int f = 0; f < 32; ++f) wv[f] = w2[(fh * 32 + f) * 64 + j];
#pragma unroll
            for (int t3 = 0; t3 < 3; ++t3) { const int pp = pq + 8 * t3; if (pp < FPP) { float acc = accp[t3];
#pragma unroll
                for (int f = 0; f < 32; ++f) acc += h1[pp * 64 + fh * 32 + f] * wv[f];
                accp[t3] = acc; } } }
#pragma unroll
        for (int t3 = 0; t3 < 3; ++t3) { const int pp = pq + 8 * t3; if (pp < FPP) { float s, c; sincos_acc(fj * accp[t3], s, c); h2[pp * 64 + j] = s; } } }
    __syncthreads();
#pragma unroll 1
    for (int half = 0; half < 2; ++half) { const int o = half * 512 + tid;
        const float bo = b3[o];
        const float delta = fabsf(-15.350567286626972f + (float)tid * ((-3.0701134573253945f + 15.350567286626972f) / 511.0f));
#pragma unroll 1
        for (int ih = 0; ih < 2; ++ih) { float wv[32];
#pragma unroll
            for (int i = 0; i < 32; ++i) wv[i] = w3[(ih * 32 + i) * 1024 + o];
#pragma unroll 1
            for (int pp = 0; pp < FPP; ++pp) { float acc = ih ? ko[o * (FPP + 1) + pp] : bo;
#pragma unroll
                for (int i = 0; i < 32; ++i) acc += h2[pp * 64 + ih * 32 + i] * wv[i];
                if (ih) { const float tn = (float)(p0 + pp) * (1.0f / (float)(LT - 1)); acc *= __expf(-tn * delta); }
                ko[o * (FPP + 1) + pp] = acc; } }
    }
    __syncthreads();
    bf16_t* kfb = (bf16_t*)(a.ws + WS_KFB);
    for (int idx = tid; idx < 1024 * FPP; idx += NTHR) { const int o = idx / FPP, pp = idx - o * FPP, dir = o >> 9, c = o & 511, p = p0 + pp;
        if (p < LT) { const float v = ko[o * (FPP + 1) + pp];
            if (dir == 0) kfb[(size_t)c * KFW + (LT - 1) + p] = (bf16_t)f2bf(p == 0 ? v + a.in[I_HYSKIP][c] : v);
            else if (p >= 1) kfb[(size_t)c * KFW + (LT - 1) - p] = (bf16_t)f2bf(v); } }
    if (item == 0) for (int c = tid; c < 512; c += NTHR) kfb[(size_t)c * KFW + KFW - 1] = 0;
    __syncthreads();
}
__device__ __forceinline__ void phase_p0(const Args& a, LAS unsigned char* lds, int tid, int wave, int lane) {
    const int G = gridDim.x, bx = blockIdx.x;
    { float* rs = (float*)(a.ws + WS_ROWSS); float* rs2 = (float*)(a.ws + WS_ROWSS2); for (int i = bx * NTHR + tid; i < T; i += G * NTHR) { rs[i] = 0.f; rs2[i] = 0.f; } }
    for (int it = bx; it < 256 + NFILT; it += G) {
#ifndef P0M
#define P0M 7
#endif
        if (it < 256) { if (P0M & 1) p0_fold_item(a, lds, it, tid); }
        else { if (P0M & 2) p0_filter_item(a, lds, it - 256, tid); }

    }
    LAS float* scr = (LAS float*)(lds + wave * 16384);
    const int gw = bx * NWAVES + wave, NGW = G * NWAVES;
    constexpr int I_IN = (1024 / 64) * (DIN / 32), I_H = (512 / 64) * (1024 / 32), I_R = (1024 / 64) * (1024 / 32), I_O = I_R;
    for (int it = gw; it < I_IN + I_H + I_R + I_O; it += NGW) {
        int r = it;
        if (r < I_IN) { p0_transpose_item(a.in[I_WIN], 1024, DIN, (bf16_t*)(a.ws + WS_WINT), scr, r, lane); continue; } r -= I_IN;
        if (r < I_H) { p0_transpose_item(a.in[I_HYOUT], 512, 1024, (bf16_t*)(a.ws + WS_WHT), scr, r, lane); continue; } r -= I_H;
        if (r < I_R) { p0_transpose_item(a.in[I_RGOUT], 1024, 1024, (bf16_t*)(a.ws + WS_WRT), scr, r, lane); continue; } r -= I_R;
        p0_transpose_item(a.in[I_WOUT], 1024, 1024, (bf16_t*)(a.ws + WS_WOT), scr, r, lane);
    }
    for (int m = gw; m < T; m += 2 * NGW) { p0_xn1_row(a.in[I_X] + (size_t)m * DM, a.in[I_GMIX], (bf16_t*)(a.ws + WS_XN1) + (size_t)m * DM, lane);
        if (m + NGW < T) p0_xn1_row(a.in[I_X] + (size_t)(m + NGW) * DM, a.in[I_GMIX], (bf16_t*)(a.ws + WS_XN1) + (size_t)(m + NGW) * DM, lane); }
}

__device__ __forceinline__ void p1_meta(const Args& a, LAS unsigned char* lds, int tid, int wave, int lane) {
    LAS float* mt = (LAS float*)lds;
    for (int r = wave * 2; r < wave * 2 + 2; ++r) {
        const f32x4* xr = (const f32x4*)(a.in[I_META] + (size_t)r * DM) + lane; const f32x4* gr = (const f32x4*)a.in[I_GMIX] + lane;
        f32x4 v[4]; float s = 0.f;
#pragma unroll
        for (int j = 0; j < 4; ++j) { v[j] = xr[64 * j]; s += (v[j].x * v[j].x + v[j].y * v[j].y) + (v[j].z * v[j].z + v[j].w * v[j].w); }
        const float rstd = rsqrtf(wave_sum(s) * (1.f / DM) + EPSF);
#pragma unroll
        for (int j = 0; j < 4; ++j) { const f32x4 gv = gr[64 * j]; f32x4 o = v[j] * rstd * gv; *(LAS f32x4*)(mt + r * 1024 + 4 * (lane + 64 * j)) = o; }
    }
    __syncthreads();
    const bf16_t* wint = (const bf16_t*)(a.ws + WS_WINT); bf16_t* hyin = (bf16_t*)(a.ws + WS_HYIN); bf16_t* rgx = (bf16_t*)(a.ws + WS_RGX);
    for (int cc = wave; cc < 10; cc += NWAVES) { const int n = blockIdx.x * 10 + cc; if (n >= 2560) break;
        float w[16]; { float t0[8], t1[8]; const bf16_t* wp = wint + (size_t)n * 1024; const u32x4 q0 = *(const u32x4*)(wp + 8 * lane), q1 = *(const u32x4*)(wp + 512 + 8 * lane);
            w[0] = bflo(q0.x); w[1] = bfhi(q0.x); w[2] = bflo(q0.y); w[3] = bfhi(q0.y); w[4] = bflo(q0.z); w[5] = bfhi(q0.z); w[6] = bflo(q0.w); w[7] = bfhi(q0.w);
            w[8] = bflo(q1.x); w[9] = bfhi(q1.x); w[10] = bflo(q1.y); w[11] = bfhi(q1.y); w[12] = bflo(q1.z); w[13] = bfhi(q1.z); w[14] = bflo(q1.w); w[15] = bfhi(q1.w); (void)t0; (void)t1; }
        float mine = 0.f;
#pragma unroll
        for (int r = 0; r < 16; ++r) { const LAS f32x4* mp = (const LAS f32x4*)(mt + r * 1024 + 8 * lane); const f32x4 m0 = mp[0], m1 = mp[1], m2 = mp[128], m3 = mp[129];
            float s = (w[0] * m0.x + w[1] * m0.y) + (w[2] * m0.z + w[3] * m0.w) + (w[4] * m1.x + w[5] * m1.y) + (w[6] * m1.z + w[7] * m1.w)
                    + (w[8] * m2.x + w[9] * m2.y) + (w[10] * m2.z + w[11] * m2.w) + (w[12] * m3.x + w[13] * m3.y) + (w[14] * m3.z + w[15] * m3.w);
            s = wave_sum_dpp(s); mine = ((lane & 15) == r) ? s : mine; }
        const bf16_t v = (bf16_t)f2bf(mine); const int t = lane & 15;
#pragma unroll
        for (int h = 0; h < 2; ++h) { const int b = (lane >> 4) + 4 * h;
            if (n < 1536) hyin[((size_t)b * LT + t) * 1536 + n] = v; else rgx[((size_t)b * LT + t) * 1024 + (n - 1536)] = v; }
    }
    __syncthreads();
}

typedef pg8::f32x4 pf4;
struct EpiProj {
    static constexpr bool PERM = true, AFTER_DRAIN = false;
    bf16_t *hyin, *rgx, *gg, *ga, *gb; const float* bgate;
    __device__ __forceinline__ void operator()(const pf4 (&acc)[2][2][4][2], const pg8::Unit& u, int wr, int wc, int fr, int fq) const {
        const int pn = u.pn, row0 = u.pm * 256 + wr * 64 + fr, cl0 = wc * 32 + 8 * fq;
#pragma unroll
        for (int ai = 0; ai < 2; ++ai)
#pragma unroll
            for (int m = 0; m < 4; ++m) { const int r = row0 + ai * 128 + m * 16; const size_t rl = (size_t)(r >> 12) * LT + NMETA + (r & 4095);
#pragma unroll
                for (int bj = 0; bj < 2; ++bj) { const int col = pn * 256 + bj * 128 + cl0; pf4 v0 = acc[ai][bj][m][0], v1 = acc[ai][bj][m][1]; bf16_t* dst;
                    if (pn < 6) dst = hyin + rl * 1536 + col;
                    else if (pn < 10) dst = rgx + rl * 1024 + (col - 1536);
                    else if (pn < 14) { dst = gg + (size_t)r * 1024 + (col - 2560);
#pragma unroll
                        for (int j = 0; j < 4; ++j) { v0[j] = gelu_tanh(v0[j]); v1[j] = gelu_tanh(v1[j]); } }
                    else { const int gc = col - 3584;
                        dst = (gc < 1024 ? ga + (size_t)r * 1024 + gc : gb + (size_t)r * 1024 + (gc - 1024));
                        const pf4 b0 = *(const pf4*)(bgate + gc), b1 = *(const pf4*)(bgate + gc + 4);
#pragma unroll
                        for (int j = 0; j < 4; ++j) { v0[j] = sigmoidf_(v0[j] + b0[j]); v1[j] = sigmoidf_(v1[j] + b1[j]); } }
                    u32x4 w; w.x = pk2(v0[0], v0[1]); w.y = pk2(v0[2], v0[3]); w.z = pk2(v1[0], v1[1]); w.w = pk2(v1[2], v1[3]);
                    *(u32x4*)dst = w; } }
    }
};
template <int MODE  > struct EpiGate {
    static constexpr bool PERM = true, AFTER_DRAIN = false;
    const bf16_t* gate; const bf16_t* tin; bf16_t* outp;
    __device__ __forceinline__ void operator()(const pf4 (&acc)[2][2][4][2], const pg8::Unit& u, int wr, int wc, int fr, int fq) const {
        const int row0 = u.pm * 256 + wr * 64 + fr, col0 = u.pn * 256 + wc * 32 + 8 * fq;
        u32x4 gq[2], tq[2];
#define EG_OFF(i) ((size_t)(row0 + ((i) >> 3) * 128 + (((i) >> 1) & 3) * 16) * 1024 + col0 + ((i) & 1) * 128)
        gq[0] = *(const u32x4*)(gate + EG_OFF(0)); if (MODE == 1) tq[0] = *(const u32x4*)(tin + EG_OFF(0));
#pragma unroll
        for (int i = 0; i < 16; ++i) { const int ai = i >> 3, m = (i >> 1) & 3, bj = i & 1; const size_t o = EG_OFF(i);
            if (i + 1 < 16) { gq[(i + 1) & 1] = *(const u32x4*)(gate + EG_OFF(i + 1)); if (MODE == 1) tq[(i + 1) & 1] = *(const u32x4*)(tin + EG_OFF(i + 1)); }
            const pf4 v0 = acc[ai][bj][m][0], v1 = acc[ai][bj][m][1]; const u32x4 g = gq[i & 1];
            float r[8];
            r[0] = v0[0] * bflo(g.x); r[1] = v0[1] * bfhi(g.x); r[2] = v0[2] * bflo(g.y); r[3] = v0[3] * bfhi(g.y);
            r[4] = v1[0] * bflo(g.z); r[5] = v1[1] * bfhi(g.z); r[6] = v1[2] * bflo(g.w); r[7] = v1[3] * bfhi(g.w);
            if (MODE == 1) { const u32x4 t = tq[i & 1];
                r[0] += bflo(t.x); r[1] += bfhi(t.x); r[2] += bflo(t.y); r[3] += bfhi(t.y); r[4] += bflo(t.z); r[5] += bfhi(t.z); r[6] += bflo(t.w); r[7] += bfhi(t.w); }
            u32x4 w; w.x = pk2(r[0], r[1]); w.y = pk2(r[2], r[3]); w.z = pk2(r[4], r[5]); w.w = pk2(r[6], r[7]);
            *(u32x4*)(outp + o) = w; }
#undef EG_OFF
    }
};
struct EpiResid {
    static constexpr bool PERM = true, AFTER_DRAIN = false;
    const float* x; bf16_t* h1b; float* rowss;
    __device__ __forceinline__ void operator()(const pf4 (&acc)[2][2][4][2], const pg8::Unit& u, int wr, int wc, int fr, int fq) const {
        const int row0 = u.pm * 256 + wr * 64 + fr, col0 = u.pn * 256 + wc * 32 + 8 * fq;
        pf4 xq[2][4];
#define ER_ROW(i) (row0 + ((i) >> 2) * 128 + ((i) & 3) * 16)
#define ER_LOAD(buf, i) do { const float* p_ = x + (size_t)ER_ROW(i) * 1024 + col0; xq[buf][0] = *(const pf4*)p_; xq[buf][1] = *(const pf4*)(p_ + 4); xq[buf][2] = *(const pf4*)(p_ + 128); xq[buf][3] = *(const pf4*)(p_ + 132); } while (0)
        ER_LOAD(0, 0);
#pragma unroll
        for (int i = 0; i < 8; ++i) { const int ai = i >> 2, m = i & 3, r = ER_ROW(i); const size_t ro = (size_t)r * 1024 + col0; float ss = 0.f;
            if (i + 1 < 8) ER_LOAD((i + 1) & 1, i + 1);
#pragma unroll
            for (int bj = 0; bj < 2; ++bj) { const size_t o = ro + bj * 128;
                const pf4 v0 = acc[ai][bj][m][0] + xq[i & 1][2 * bj], v1 = acc[ai][bj][m][1] + xq[i & 1][2 * bj + 1];
                u32x4 w; w.x = pk2(v0[0], v0[1]); w.y = pk2(v0[2], v0[3]); w.z = pk2(v1[0], v1[1]); w.w = pk2(v1[2], v1[3]);
                *(u32x4*)(h1b + o) = w;
                ss += (v0[0] * v0[0] + v0[1] * v0[1]) + (v0[2] * v0[2] + v0[3] * v0[3]) + (v1[0] * v1[0] + v1[1] * v1[1]) + (v1[2] * v1[2] + v1[3] * v1[3]); }
            ss += __shfl_xor(ss, 16); ss += __shfl_xor(ss, 32);
            if (fq == 0) atomicAdd(rowss + r, ss); }
#undef ER_ROW
#undef ER_LOAD
    }
};
struct EpiScores {
    static constexpr bool PERM = true, AFTER_DRAIN = false;
    const float* rowss; _Float16* sc;
    __device__ __forceinline__ void operator()(const pf4 (&acc)[2][2][4][2], const pg8::Unit& u, int wr, int wc, int fr, int fq) const {
        const int row0 = u.pm * 256 + wr * 64 + fr, k0 = wc * 32 + 8 * fq;
#pragma unroll
        for (int ai = 0; ai < 2; ++ai)
#pragma unroll
            for (int m = 0; m < 4; ++m) { const int r = row0 + ai * 128 + m * 16; const float rs = rsqrtf(rowss[r] * (1.f / DM) + EPSF);
#pragma unroll
                for (int bj = 0; bj < 2; ++bj) { _Float16* p = sc + (((size_t)(((r >> 6) * 8 + u.pn) * 2 + bj) * 16 + (k0 >> 3)) * 64 + (r & 63)) * 8;
                    typedef _Float16 h8 __attribute__((ext_vector_type(8)));
                    h8 v; v[0] = (_Float16)(acc[ai][bj][m][0][0] * rs); v[1] = (_Float16)(acc[ai][bj][m][0][1] * rs); v[2] = (_Float16)(acc[ai][bj][m][0][2] * rs); v[3] = (_Float16)(acc[ai][bj][m][0][3] * rs);
                    v[4] = (_Float16)(acc[ai][bj][m][1][0] * rs); v[5] = (_Float16)(acc[ai][bj][m][1][1] * rs); v[6] = (_Float16)(acc[ai][bj][m][1][2] * rs); v[7] = (_Float16)(acc[ai][bj][m][1][3] * rs);
                    *(h8*)p = v; } }
    }
};

__device__ __forceinline__ void unpack8(const u32x4 w, float (&f)[8]) {
    f[0] = bflo(w.x); f[1] = bfhi(w.x); f[2] = bflo(w.y); f[3] = bfhi(w.y); f[4] = bflo(w.z); f[5] = bfhi(w.z); f[6] = bflo(w.w); f[7] = bfhi(w.w); }
__device__ __forceinline__ void load8(const bf16_t* p, float (&f)[8]) { const u32x4 w = *(const u32x4*)p;
    f[0] = bflo(w.x); f[1] = bfhi(w.x); f[2] = bflo(w.y); f[3] = bfhi(w.y); f[4] = bflo(w.z); f[5] = bfhi(w.z); f[6] = bflo(w.w); f[7] = bfhi(w.w); }
__device__ __forceinline__ void short_conv8(const bf16_t* hb, const float* cw, const float* cb, int s, int ch, float (&o)[8]) {
    float xm[8], x0[8], xp[8];
    if (s >= 1) load8(hb + (size_t)(s - 1) * 1536 + ch, xm); else {
#pragma unroll
        for (int i = 0; i < 8; ++i) xm[i] = 0.f; }
    load8(hb + (size_t)s * 1536 + ch, x0);
    if (s + 1 < LT) load8(hb + (size_t)(s + 1) * 1536 + ch, xp); else {
#pragma unroll
        for (int i = 0; i < 8; ++i) xp[i] = 0.f; }
#pragma unroll
    for (int i = 0; i < 8; ++i) o[i] = xm[i] * cw[ch + i] + x0[i] * cw[1536 + ch + i] + xp[i] * cw[3072 + ch + i] + cb[ch + i];
}
__device__ __forceinline__ void phase_hy_pre(const Args& a, LAS unsigned char* lds, int tid) {
    LAS bf16_t* tl = (LAS bf16_t*)lds;
    const bf16_t* hyin = (const bf16_t*)(a.ws + WS_HYIN); bf16_t* uut = (bf16_t*)(a.ws + WS_UUT); bf16_t* x0out = (bf16_t*)(a.ws + WS_YH);
    const float* cw = a.in[I_HYCW]; const float* cb = a.in[I_HYCB];
    for (int it = blockIdx.x; it < NB * 67 * 8; it += gridDim.x) {
        const int ct = it & 7, ts = (it >> 3) % 67, b = (it >> 3) / 67;
        { const int sr = tid >> 3, cg = tid & 7, c0 = ct * 64 + cg * 8, sp = ts * 64 + sr, s = sp - 16;
            float uu[8];
            if (s >= 0 && s < LT) { float x1[8], v[8]; const bf16_t* hb = hyin + (size_t)b * LT * 1536;
                short_conv8(hb, cw, cb, s, 512 + c0, x1); short_conv8(hb, cw, cb, s, 1024 + c0, v);
#pragma unroll
                for (int i = 0; i < 8; ++i) uu[i] = v[i] * x1[i];
                if (s >= NMETA) { float x0[8]; short_conv8(hb, cw, cb, s, c0, x0);
                    u32x4 w; w.x = pk2(x0[0], x0[1]); w.y = pk2(x0[2], x0[3]); w.z = pk2(x0[4], x0[5]); w.w = pk2(x0[6], x0[7]);
                    *(u32x4*)(x0out + ((size_t)b * SEQ + (s - NMETA)) * DHY + c0) = w; } }
            else {
#pragma unroll
                for (int i = 0; i < 8; ++i) uu[i] = 0.f; }
#pragma unroll
            for (int i = 0; i < 8; ++i) tl[sr * 72 + cg * 8 + i] = (bf16_t)f2bf(uu[i]); }
        __syncthreads();
        { const int cl = tid >> 3, sg = tid & 7, sp0 = ts * 64 + sg * 8;
            if (sp0 < SP) { u32x4 w; unsigned h[8];
#pragma unroll
                for (int i = 0; i < 8; ++i) h[i] = tl[(sg * 8 + i) * 72 + cl];
                w.x = h[0] | (h[1] << 16); w.y = h[2] | (h[3] << 16); w.z = h[4] | (h[5] << 16); w.w = h[6] | (h[7] << 16);
                *(u32x4*)(uut + ((size_t)(ct * 64 + cl) * NB + b) * SP + sp0) = w; } }
        __syncthreads();
    }
}
__device__ __forceinline__ void phase_hy_conv_naive(const Args& a, LAS unsigned char* lds, int tid) {
    LAS bf16_t* uus = (LAS bf16_t*)lds;
    LAS float* filt = (LAS float*)(lds + LT * 16);
    const bf16_t* uut = (const bf16_t*)(a.ws + WS_UUT); const float* kf = (const float*)(a.ws + WS_KF); bf16_t* cvt = (bf16_t*)(a.ws + WS_CONVT);
    for (int c = blockIdx.x; c < DHY; c += gridDim.x) {
        for (int i = tid; i < NB * LT; i += NTHR) { const int b = i / LT, s = i - b * LT; uus[s * 8 + b] = uut[((size_t)c * NB + b) * SP + 16 + s]; }
        for (int i = tid; i < KFW; i += NTHR) filt[i] = kf[(size_t)c * KFW + i];
        __syncthreads();
        for (int tt = 0; tt < 8; ++tt) { const int tq = tt * 512 + tid, t = tq + 16; float acc[8];
#pragma unroll
            for (int b = 0; b < 8; ++b) acc[b] = 0.f;
            const LAS float* fp = filt + (LT - 1) + t;
            for (int s = 0; s < LT; ++s) { const float kv = fp[-s]; const u32x4 w = *(const LAS u32x4*)(uus + s * 8);
                acc[0] += kv * bflo(w.x); acc[1] += kv * bfhi(w.x); acc[2] += kv * bflo(w.y); acc[3] += kv * bfhi(w.y);
                acc[4] += kv * bflo(w.z); acc[5] += kv * bfhi(w.z); acc[6] += kv * bflo(w.w); acc[7] += kv * bfhi(w.w); }
#pragma unroll
            for (int b = 0; b < 8; ++b) cvt[((size_t)c * NB + b) * SEQ + tq] = (bf16_t)f2bf(acc[b]); }
        __syncthreads();
    }
}
__device__ __forceinline__ void phase_rg_naive(const Args& a, LAS unsigned char* lds, int tid) {
    LAS float* xc = (LAS float*)lds;
    LAS float* gbuf = xc + 32 * 128;
    const bf16_t* rgx = (const bf16_t*)(a.ws + WS_RGX);
    for (int it = blockIdx.x; it < NB * 2 * 8; it += gridDim.x) {
        const int head = it & 7, dir = (it >> 3) & 1, b = it >> 4;
        const float* cw = a.in[I_RGCW] + (size_t)dir * 4 * DRG + head * 128; const float* cb = a.in[I_RGCB] + (size_t)dir * DRG + head * 128;
        bf16_t* hout = (bf16_t*)a.out + (size_t)dir * T * DRG;
        const bf16_t* xb = rgx + (size_t)b * LT * DRG + head * 128;
        float h = 0.f, sp = 0.f;
        if (tid < 128) { const float lam = a.in[I_RGLAM][dir * DRG + head * 128 + tid]; sp = log1pf(__expf(-lam)); }
        for (int k = 0; k < 129; ++k) {
            { const int tok = tid >> 4, cg = tid & 15, u = 32 * k + tok; float o[8];
#pragma unroll
                for (int i = 0; i < 8; ++i) o[i] = (u < LT) ? cb[cg * 8 + i] : 0.f;
                if (u < LT) {
#pragma unroll
                    for (int j = 0; j < 4; ++j) { const int uu = u - j; if (uu >= 0) { const int t = dir ? (LT - 1 - uu) : uu; float xv[8]; load8(xb + (size_t)t * DRG + cg * 8, xv);
#pragma unroll
                            for (int i = 0; i < 8; ++i) o[i] += xv[i] * cw[j * DRG + cg * 8 + i]; } } }
#pragma unroll
                for (int i = 0; i < 8; ++i) xc[tok * 128 + cg * 8 + i] = o[i]; }
            __syncthreads();
            { const int j = tid & 127, g = (tid >> 7) & 1, th = tid >> 8; float acc[16];
#pragma unroll
                for (int q = 0; q < 16; ++q) acc[q] = 0.f;
                const float* gw = a.in[I_RGGW] + ((size_t)((dir * 2 + g) * 8 + head) * 128) * 128 + j;
                for (int i = 0; i < 128; ++i) { const float wv = gw[i * 128];
#pragma unroll
                    for (int q = 0; q < 16; ++q) acc[q] += xc[(th * 16 + q) * 128 + i] * wv; }
                const float gb = a.in[I_RGGB][(size_t)(dir * 2 + g) * DRG + head * 128 + j];
#pragma unroll
                for (int q = 0; q < 16; ++q) gbuf[(g * 32 + th * 16 + q) * 128 + j] = acc[q] + gb; }
            __syncthreads();
            if (tid < 128) {
                for (int tok = 0; tok < 32; ++tok) { const int u = 32 * k + tok; if (u >= LT) break;
                    const float r = sigmoidf_(gbuf[tok * 128 + tid]), ig = sigmoidf_(gbuf[(32 + tok) * 128 + tid]);
                    const float la = -8.0f * r * sp; const float av = __expf(la); const float mult = (u == 0) ? 1.0f : sqrtf(-expm1f(2.0f * la));
                    h = av * h + mult * ig * xc[tok * 128 + tid];
                    const int t = dir ? (LT - 1 - u) : u;
                    if (t >= NMETA) hout[((size_t)b * SEQ + (t - NMETA)) * DRG + head * 128 + tid] = (bf16_t)f2bf(h); } }
            __syncthreads();
        }
    }
}
__device__ __forceinline__ void phase_post(const Args& a, LAS unsigned char* lds, int tid) {
    const int wave = tid >> 6, lane = tid & 63, gw = blockIdx.x * NWAVES + wave, NGW = gridDim.x * NWAVES;
    LAS bf16_t* cv = (LAS bf16_t*)(lds + wave * (64 * 144));
    const bf16_t* cvt = (const bf16_t*)(a.ws + WS_CONVT); bf16_t* yh = (bf16_t*)(a.ws + WS_YH);
    const int l8 = lane >> 3, l7 = lane & 7;
    for (int it = gw; it < NB * 64 * 8; it += NGW) {
        const int ct = it & 7, tt = (it >> 3) & 63, b = it >> 9;
        u32x4 cw_[8], xw[8];
#pragma unroll
        for (int k = 0; k < 8; ++k) cw_[k] = *(const u32x4*)(cvt + ((size_t)(ct * 64 + 8 * k + l8) * NB + b) * SEQ + tt * 64 + l7 * 8);
        bf16_t* yp = yh + ((size_t)b * SEQ + tt * 64 + l8) * DHY + ct * 64 + l7 * 8;
#pragma unroll
        for (int k = 0; k < 8; ++k) xw[k] = *(const u32x4*)(yp + (size_t)(8 * k) * DHY);
#pragma unroll
        for (int k = 0; k < 8; ++k) *(LAS u32x4*)(cv + (8 * k + l8) * 72 + l7 * 8) = cw_[k];
#pragma unroll
        for (int k = 0; k < 8; ++k) { const int tr = 8 * k + l8; float x0[8], y[8]; unpack8(xw[k], x0);
#pragma unroll
            for (int i = 0; i < 8; ++i) y[i] = bf2f(cv[(l7 * 8 + i) * 72 + tr]) * x0[i];
            u32x4 w; w.x = pk2(y[0], y[1]); w.y = pk2(y[2], y[3]); w.z = pk2(y[4], y[5]); w.w = pk2(y[6], y[7]);
            *(u32x4*)(yp + (size_t)(8 * k) * DHY) = w; }
    }
    const bf16_t* hf = (const bf16_t*)a.out; const bf16_t* hb2 = hf + (size_t)T * DRG; const bf16_t* gg = (const bf16_t*)(a.ws + WS_GG); bf16_t* yr = (bf16_t*)(a.ws + WS_YR);
    const bf16_t* rgp = (const bf16_t*)(a.ws + WS_RGP); const float* rgc = (const float*)(a.ws + WS_RGC);
    for (size_t i = (size_t)blockIdx.x * NTHR + tid; i < (size_t)T * DRG / 8; i += (size_t)gridDim.x * NTHR) {
        const int c8 = (int)(i & 127) * 8, m = (int)(i >> 7), b = m >> 12, t = (m & 4095) + NMETA;
        float f[8], g[8], q[8]; load8(hf + i * 8, f); load8(hb2 + i * 8, g); load8(gg + i * 8, q);
        if (t >= RG_U1) { float p[8]; load8(rgp + ((size_t)(0 * NB + b) * RG_NF + (t - RG_U1)) * DRG + c8, p); const float* cc = rgc + (size_t)(0 * NB + b) * DRG + c8;
#pragma unroll
            for (int j = 0; j < 8; ++j) f[j] += p[j] * cc[j]; }
        const int ub = LT - 1 - t;
        if (ub >= RG_U1) { float p[8]; load8(rgp + ((size_t)(1 * NB + b) * RG_NF + (ub - RG_U1)) * DRG + c8, p); const float* cc = rgc + (size_t)(1 * NB + b) * DRG + c8;
#pragma unroll
            for (int j = 0; j < 8; ++j) g[j] += p[j] * cc[j]; }
        u32x4 w; w.x = pk2((f[0] + g[0]) * q[0], (f[1] + g[1]) * q[1]); w.y = pk2((f[2] + g[2]) * q[2], (f[3] + g[3]) * q[3]);
        w.z = pk2((f[4] + g[4]) * q[4], (f[5] + g[5]) * q[5]); w.w = pk2((f[6] + g[6]) * q[6], (f[7] + g[7]) * q[7]);
        *(u32x4*)(yr + i * 8) = w; }
}
__device__ __forceinline__ u32x4 quant_row16(const f32x4 (&v)[4], float amax, float& deq) {
    const float sc = (amax > 0.f) ? 256.0f / amax : 1.0f; deq = (amax > 0.f) ? amax * (1.0f / 256.0f) : 1.0f;
    u32x4 w; int t;
    t = __builtin_amdgcn_cvt_pk_fp8_f32(v[0].x * sc, v[0].y * sc, 0, false); t = __builtin_amdgcn_cvt_pk_fp8_f32(v[0].z * sc, v[0].w * sc, t, true); w.x = (unsigned)t;
    t = __builtin_amdgcn_cvt_pk_fp8_f32(v[1].x * sc, v[1].y * sc, 0, false); t = __builtin_amdgcn_cvt_pk_fp8_f32(v[1].z * sc, v[1].w * sc, t, true); w.y = (unsigned)t;
    t = __builtin_amdgcn_cvt_pk_fp8_f32(v[2].x * sc, v[2].y * sc, 0, false); t = __builtin_amdgcn_cvt_pk_fp8_f32(v[2].z * sc, v[2].w * sc, t, true); w.z = (unsigned)t;
    t = __builtin_amdgcn_cvt_pk_fp8_f32(v[3].x * sc, v[3].y * sc, 0, false); t = __builtin_amdgcn_cvt_pk_fp8_f32(v[3].z * sc, v[3].w * sc, t, true); w.w = (unsigned)t;
    return w;
}
__device__ __forceinline__ unsigned q8x4(f32x4 v, float sc) {
    const int a = (int)rintf(v.x * sc), b = (int)rintf(v.y * sc), c = (int)rintf(v.z * sc), d = (int)rintf(v.w * sc);
    return ((unsigned)a & 0xffu) | (((unsigned)b & 0xffu) << 8) | (((unsigned)c & 0xffu) << 16) | ((unsigned)d << 24);
}
__device__ __forceinline__ void phase_tables(const Args& a, int wave, int lane) {
    const int gw = blockIdx.x * NWAVES + wave, NGW = gridDim.x * NWAVES;
    const float* gf = a.in[I_GFFN] + 16 * lane; unsigned char* uq = a.ws + WS_UB; unsigned char* vq = a.ws + WS_VB; float* su = (float*)(a.ws + WS_SU); float* sv = (float*)(a.ws + WS_SV);
    f32x4 g[4];
#pragma unroll
    for (int j = 0; j < 4; ++j) g[j] = *(const f32x4*)(gf + 4 * j);
    for (int e = gw; e < NEXP; e += NGW) {
        const float* ur = a.in[I_PU] + (size_t)e * DM + 16 * lane; const float* vr = a.in[I_PV] + (size_t)e * DM + 16 * lane;
        f32x4 u[4], v[4]; float mu = 0.f, mv = 0.f;
#pragma unroll
        for (int j = 0; j < 4; ++j) { u[j] = *(const f32x4*)(ur + 4 * j) * g[j]; v[j] = *(const f32x4*)(vr + 4 * j);
            mu = fmaxf(mu, fmaxf(fmaxf(fabsf(u[j].x), fabsf(u[j].y)), fmaxf(fabsf(u[j].z), fabsf(u[j].w))));
            mv = fmaxf(mv, fmaxf(fmaxf(fabsf(v[j].x), fabsf(v[j].y)), fmaxf(fabsf(v[j].z), fabsf(v[j].w)))); }
        mu = wave_max_dpp(mu); mv = wave_max_dpp(mv);
        const float scu = (mu > 0.f) ? 127.0f / mu : 1.0f, du = (mu > 0.f) ? mu * (1.0f / 127.0f) : 1.0f;
        u32x4 qu; qu.x = q8x4(u[0], scu); qu.y = q8x4(u[1], scu); qu.z = q8x4(u[2], scu); qu.w = q8x4(u[3], scu);
        const float scv = (mv > 0.f) ? 127.0f / mv : 1.0f, dv = (mv > 0.f) ? mv * (1.0f / 127.0f) : 1.0f;
        u32x4 qv; qv.x = q8x4(v[0], scv); qv.y = q8x4(v[1], scv); qv.z = q8x4(v[2], scv); qv.w = q8x4(v[3], scv);
        { const size_t so = ((size_t)(lane >> 3) * NEXP + e) * 128 + 16 * (lane & 7); *(u32x4*)(uq + so) = qu; *(u32x4*)(vq + so) = qv; }
        if (lane == 0) { su[e] = du; sv[e] = dv; }
    }
}
__device__ __forceinline__ void ce_desc(float& a, float& b) { const float hi = fmaxf(a, b), lo = fminf(a, b); a = hi; b = lo; }
__device__ __forceinline__ void sort16_desc(float (&x)[16]) {
#pragma unroll
    for (int k = 2; k <= 16; k <<= 1)
#pragma unroll
        for (int j = k >> 1; j > 0; j >>= 1)
#pragma unroll
            for (int i = 0; i < 16; ++i) { const int l = i ^ j; if (l > i) { if ((i & k) == 0) ce_desc(x[i], x[l]); else ce_desc(x[l], x[i]); } }
}
__device__ __forceinline__ void merge_top16(float (&L)[16], const float (&X)[16]) {
#pragma unroll
    for (int i = 0; i < 16; ++i) L[i] = fmaxf(L[i], X[15 - i]);
#pragma unroll
    for (int j = 8; j > 0; j >>= 1)
#pragma unroll
        for (int i = 0; i < 16; ++i) { const int l = i ^ j; if (l > i) ce_desc(L[i], L[l]); }
}
__device__ __forceinline__ void top16_of_128(const _Float16* base  , float (&L)[16]) {
    typedef _Float16 h8 __attribute__((ext_vector_type(8)));
    h8 v0 = *(const h8*)(base), v1 = *(const h8*)(base + 512);
#pragma unroll 1
    for (int ch = 0; ch < 8; ++ch) { float X[16]; const int cn = (ch < 7) ? ch + 1 : 7;
        const h8 n0 = *(const h8*)(base + (2 * cn) * 512), n1 = *(const h8*)(base + (2 * cn + 1) * 512);
#pragma unroll
        for (int i = 0; i < 8; ++i) { X[i] = __uint_as_float((__float_as_uint((float)v0[i]) & ~0x7Fu) | (unsigned)(ch * 16 + i));
            X[8 + i] = __uint_as_float((__float_as_uint((float)v1[i]) & ~0x7Fu) | (unsigned)(ch * 16 + 8 + i)); }
        sort16_desc(X);
        if (ch == 0) {
#pragma unroll
            for (int i = 0; i < 16; ++i) L[i] = X[i]; }
        else merge_top16(L, X);
        v0 = n0; v1 = n1; }
}
struct CandTab { int ci[64], cj[64]; };
__host__ __device__ constexpr CandTab make_cand() { CandTab t{}; int n = 0; for (int i = 0; i < 16; ++i) for (int j = 0; j < 16; ++j) if ((i + 1) * (j + 1) <= 16) { t.ci[n] = i; t.cj[n] = j; ++n; }
    for (; n < 64; ++n) { t.ci[n] = -1; t.cj[n] = -1; } return t; }
__device__ __forceinline__ void phase_topk(const Args& a, LAS unsigned char* lds, const pg8::StaticOrder& S, int wave, int lane) {
    constexpr CandTab CT = make_cand();
    const _Float16* st = (const _Float16*)(a.ws + WS_SCORES); int* eidx = (int*)(a.ws + WS_EIDX); float* eg = (float*)(a.ws + WS_EG);
    LAS unsigned char* tab = lds + wave * (64 * 36) + lane * 36;
    for (int j = wave; ; j += NWAVES) { pg8::Unit un; if (!S.next(j >> 2, un)) break; const int tg = 4 * un.pm + (j & 3), hh = un.pn; const int m = tg * 64 + lane;
        float A[16], B[16];
        top16_of_128(st + (size_t)((tg * 8 + hh) * 2 + 0) * 128 * 64 + lane * 8, A);
        top16_of_128(st + (size_t)((tg * 8 + hh) * 2 + 1) * 128 * 64 + lane * 8, B);
#pragma unroll
        for (int q = 0; q < 4; ++q) {
            const unsigned wa = (__float_as_uint(A[4 * q]) & 0x7Fu) | ((__float_as_uint(A[4 * q + 1]) & 0x7Fu) << 8) | ((__float_as_uint(A[4 * q + 2]) & 0x7Fu) << 16) | ((__float_as_uint(A[4 * q + 3]) & 0x7Fu) << 24);
            const unsigned wb = (__float_as_uint(B[4 * q]) & 0x7Fu) | ((__float_as_uint(B[4 * q + 1]) & 0x7Fu) << 8) | ((__float_as_uint(B[4 * q + 2]) & 0x7Fu) << 16) | ((__float_as_uint(B[4 * q + 3]) & 0x7Fu) << 24);
            *(LAS unsigned*)(tab + 4 * q) = wa; *(LAS unsigned*)(tab + 16 + 4 * q) = wb; }
#pragma unroll
        for (int i = 0; i < 16; ++i) { A[i] = __uint_as_float(__float_as_uint(A[i]) & ~0x7Fu); B[i] = __uint_as_float(__float_as_uint(B[i]) & ~0x7Fu); }
        float K[16];
#pragma unroll
        for (int c0 = 0; c0 < 64; c0 += 16) { float X[16];
#pragma unroll
            for (int i = 0; i < 16; ++i) { const int c = c0 + i;
                if (CT.ci[c] >= 0) X[i] = __uint_as_float((__float_as_uint(A[CT.ci[c] < 0 ? 0 : CT.ci[c]] + B[CT.cj[c] < 0 ? 0 : CT.cj[c]]) & ~0xFFu) | (unsigned)(CT.ci[c] * 16 + CT.cj[c]));
                else X[i] = -INFINITY; }
            sort16_desc(X);
            if (c0 == 0) {
#pragma unroll
                for (int i = 0; i < 16; ++i) K[i] = X[i]; }
            else merge_top16(K, X); }
        asm volatile("s_waitcnt lgkmcnt(0)" ::: "memory");
        int ex_[16]; float cs[16]; float sum = 0.f;
#pragma unroll
        for (int r = 0; r < 16; ++r) { const unsigned kb = __float_as_uint(K[r]); const int id = kb & 0xFF; cs[r] = __expf(__uint_as_float(kb & ~0xFFu) - __uint_as_float(__float_as_uint(K[0]) & ~0xFFu)); sum += cs[r];
            ex_[r] = (int)tab[id >> 4] * 128 + (int)tab[16 + (id & 15)]; }
        const float inv = 1.0f / sum;
        unsigned short* ep = (unsigned short*)eidx + (size_t)m * 128 + hh * 16; float* gp = eg + (size_t)m * 128 + hh * 16;
        { u32x4 p0, p1; p0.x = ex_[0] | (ex_[1] << 16); p0.y = ex_[2] | (ex_[3] << 16); p0.z = ex_[4] | (ex_[5] << 16); p0.w = ex_[6] | (ex_[7] << 16);
          p1.x = ex_[8] | (ex_[9] << 16); p1.y = ex_[10] | (ex_[11] << 16); p1.z = ex_[12] | (ex_[13] << 16); p1.w = ex_[14] | (ex_[15] << 16); *(u32x4*)ep = p0; *(u32x4*)(ep + 8) = p1; }
#pragma unroll
        for (int q = 0; q < 4; ++q) {
            *(f32x4*)(gp + 4 * q) = (f32x4){cs[4 * q] * inv, cs[4 * q + 1] * inv, cs[4 * q + 2] * inv, cs[4 * q + 3] * inv}; }
    }
}
__device__ __forceinline__ void fp8x16_to_f32(const u32x4 w, float (&f)[16]) {
    f32x2v t;
    t = __builtin_amdgcn_cvt_pk_f32_fp8((int)w.x, false); f[0] = t.x; f[1] = t.y; t = __builtin_amdgcn_cvt_pk_f32_fp8((int)w.x, true); f[2] = t.x; f[3] = t.y;
    t = __builtin_amdgcn_cvt_pk_f32_fp8((int)w.y, false); f[4] = t.x; f[5] = t.y; t = __builtin_amdgcn_cvt_pk_f32_fp8((int)w.y, true); f[6] = t.x; f[7] = t.y;
    t = __builtin_amdgcn_cvt_pk_f32_fp8((int)w.z, false); f[8] = t.x; f[9] = t.y; t = __builtin_amdgcn_cvt_pk_f32_fp8((int)w.z, true); f[10] = t.x; f[11] = t.y;
    t = __builtin_amdgcn_cvt_pk_f32_fp8((int)w.w, false); f[12] = t.x; f[13] = t.y; t = __builtin_amdgcn_cvt_pk_f32_fp8((int)w.w, true); f[14] = t.x; f[15] = t.y;
}
__device__ __forceinline__ void fp8x16_to_f32x2(const u32x4 w, f32x2v (&f)[8]) {
    f[0] = __builtin_amdgcn_cvt_pk_f32_fp8((int)w.x, false); f[1] = __builtin_amdgcn_cvt_pk_f32_fp8((int)(w.x >> 16), false);
    f[2] = __builtin_amdgcn_cvt_pk_f32_fp8((int)w.y, false); f[3] = __builtin_amdgcn_cvt_pk_f32_fp8((int)(w.y >> 16), false);
    f[4] = __builtin_amdgcn_cvt_pk_f32_fp8((int)w.z, false); f[5] = __builtin_amdgcn_cvt_pk_f32_fp8((int)(w.z >> 16), false);
    f[6] = __builtin_amdgcn_cvt_pk_f32_fp8((int)w.w, false); f[7] = __builtin_amdgcn_cvt_pk_f32_fp8((int)(w.w >> 16), false);
}
__device__ __forceinline__ float dpp_sum8(float v) {
    v += __int_as_float(__builtin_amdgcn_update_dpp(0, __float_as_int(v), 0xB1, 0xF, 0xF, true));
    v += __int_as_float(__builtin_amdgcn_update_dpp(0, __float_as_int(v), 0x4E, 0xF, 0xF, true));
    v += __int_as_float(__builtin_amdgcn_update_dpp(0, __float_as_int(v), 0x141, 0xF, 0xF, true));
    return v;
}
struct UTok { u32x4 e0, e1, xa, xb; };
struct VTok { u32x4 e0, e1; f32x4 av[4]; };
__device__ __forceinline__ void pu_issue(const unsigned char* tab, unsigned loff, const u32x4& e, u32x4 (&w)[8]) {
    w[0] = *(const u32x4*)(tab + ((e.x & 0xffffu) * 128u + loff)); w[1] = *(const u32x4*)(tab + ((e.x >> 16) * 128u + loff));
    w[2] = *(const u32x4*)(tab + ((e.y & 0xffffu) * 128u + loff)); w[3] = *(const u32x4*)(tab + ((e.y >> 16) * 128u + loff));
    w[4] = *(const u32x4*)(tab + ((e.z & 0xffffu) * 128u + loff)); w[5] = *(const u32x4*)(tab + ((e.z >> 16) * 128u + loff));
    w[6] = *(const u32x4*)(tab + ((e.w & 0xffffu) * 128u + loff)); w[7] = *(const u32x4*)(tab + ((e.w >> 16) * 128u + loff));
}
__device__ __forceinline__ float pu_compute(const int (&xq)[4], const u32x4 (&w)[8], int i) {
    float keep = 0.f;
#pragma unroll
    for (int q = 0; q < 8; ++q) { int d = __builtin_amdgcn_sdot4((int)w[q].x, xq[0], 0, false); d = __builtin_amdgcn_sdot4((int)w[q].y, xq[1], d, false);
        d = __builtin_amdgcn_sdot4((int)w[q].z, xq[2], d, false); d = __builtin_amdgcn_sdot4((int)w[q].w, xq[3], d, false);
        d += __builtin_amdgcn_update_dpp(0, d, 0xB1, 0xF, 0xF, true); d += __builtin_amdgcn_update_dpp(0, d, 0x4E, 0xF, 0xF, true); d += __builtin_amdgcn_update_dpp(0, d, 0x141, 0xF, 0xF, true);
        keep = (q == i) ? (float)d : keep; }
    return keep;
}
__device__ __forceinline__ float pu_quant_x(const u32x4& xa, const u32x4& xb, int (&xq)[4]) {
    float f[16]; unpack8(xa, *(float(*)[8])&f[0]); unpack8(xb, *(float(*)[8])&f[8]);
    float mx = 0.f;
#pragma unroll
    for (int c = 0; c < 16; ++c) mx = fmaxf(mx, fabsf(f[c]));
    mx = fmaxf(mx, __int_as_float(__builtin_amdgcn_update_dpp(0, __float_as_int(mx), 0xB1, 0xF, 0xF, true)));
    mx = fmaxf(mx, __int_as_float(__builtin_amdgcn_update_dpp(0, __float_as_int(mx), 0x4E, 0xF, 0xF, true)));
    mx = fmaxf(mx, __int_as_float(__builtin_amdgcn_update_dpp(0, __float_as_int(mx), 0x141, 0xF, 0xF, true)));
    const float sc = (mx > 0.f) ? 127.0f * __builtin_amdgcn_rcpf(mx) * 0.99999f : 0.f;
#pragma unroll
    for (int c4 = 0; c4 < 4; ++c4) xq[c4] = (int)q8x4((f32x4){f[4 * c4], f[4 * c4 + 1], f[4 * c4 + 2], f[4 * c4 + 3]}, sc);
    return mx * (1.0f / 127.0f);
}
__device__ __forceinline__ void phase_peer_u(const Args& a, int wave, int lane) {
    const int s = SLICE_OF(blockIdx.x), rk = RANK_OF(blockIdx.x), nrk = gridDim.x >> 3, tper = T / nrk, i = lane & 7, j = lane >> 3;
    const bf16_t* h1b = (const bf16_t*)(a.ws + WS_H1B) + 128 * s + 16 * i; const unsigned char* uqs = a.ws + WS_UB + (size_t)s * NEXP * 128; const unsigned loff = 16u * (unsigned)i;
    const unsigned short* eidx = (const unsigned short*)(a.ws + WS_EIDX) + 16 * j; float* pd = (float*)(a.ws + WS_PD) + (size_t)s * T * 128 + 16 * j + i;
    const int m0 = rk * tper + wave, mlast = (rk + 1) * tper - NWAVES + wave;
#define PU_LOAD(t, mm) do { const int m_ = (mm) < mlast ? (mm) : mlast; const u32x4* ep_ = (const u32x4*)(eidx + (size_t)m_ * 128); (t).e0 = ep_[0]; (t).e1 = ep_[1]; \
        (t).xa = *(const u32x4*)(h1b + (size_t)m_ * DM); (t).xb = *(const u32x4*)(h1b + (size_t)m_ * DM + 8); } while (0)
#define PU_DO(t, w0, w1, mm) do { int xq_[4]; const float sx_ = pu_quant_x((t).xa, (t).xb, xq_); \
        const float k0_ = pu_compute(xq_, w0, i) * sx_, k1_ = pu_compute(xq_, w1, i) * sx_; pd[(size_t)(mm) * 128] = k0_; pd[(size_t)(mm) * 128 + 8] = k1_; } while (0)
    UTok tC, tN, tNN; u32x4 wA[8], wB[8], wC[8], wD[8];
    PU_LOAD(tC, m0); PU_LOAD(tN, m0 + NWAVES); PU_LOAD(tNN, m0 + 2 * NWAVES); pu_issue(uqs, loff, tC.e0, wA); pu_issue(uqs, loff, tC.e1, wB);
    for (int m = m0; m <= mlast; m += 2 * NWAVES) {
        pu_issue(uqs, loff, tN.e0, wC); pu_issue(uqs, loff, tN.e1, wD);
        PU_DO(tC, wA, wB, m);
        tC = tN; tN = tNN; PU_LOAD(tNN, m + 3 * NWAVES);
        pu_issue(uqs, loff, tN.e0, wA); pu_issue(uqs, loff, tN.e1, wB);
        PU_DO(tC, wC, wD, m + NWAVES);
        tC = tN; tN = tNN; PU_LOAD(tNN, m + 4 * NWAVES);
    }
#undef PU_LOAD
#undef PU_DO
}
typedef long i64_t;
__device__ __forceinline__ i64_t pack64(unsigned lo, unsigned hi) { return (i64_t)(((unsigned long long)hi << 32) | (unsigned long long)lo); }
struct MTokI { u32x4 ia, ib; };
struct MTokX { u32x4 xq[4]; };
__device__ __forceinline__ unsigned id16(const u32x4& v, int c) { const unsigned wv = (c >> 1) == 0 ? v.x : (c >> 1) == 1 ? v.y : (c >> 1) == 2 ? v.z : v.w; return (c & 1) ? (wv >> 16) : (wv & 0xffffu); }
__device__ __forceinline__ void pm_issue(const unsigned char* tab, unsigned loff, const MTokI& t, u32x4 (&W)[16]) {
#pragma unroll
    for (int c = 0; c < 8; ++c) { W[2 * c] = *(const u32x4*)(tab + (id16(t.ia, c) * 128u + loff)); W[2 * c + 1] = *(const u32x4*)(tab + (id16(t.ib, c) * 128u + loff)); }
}
template <bool HI> __device__ __forceinline__ unsigned bf2_to_fp8x2(unsigned w, int old) { const float a = fminf(fmaxf(bflo(w), -448.f), 448.f), b = fminf(fmaxf(bfhi(w), -448.f), 448.f); return (unsigned)__builtin_amdgcn_cvt_pk_fp8_f32(a, b, old, HI); }
__device__ __forceinline__ void pm_compute(const MTokX& t, const u32x4 (&W)[16], LAS unsigned char* wl  , float* pdrow  , int lane) {
    unsigned xb[8];
#pragma unroll
    for (int q = 0; q < 4; ++q) { unsigned lo = bf2_to_fp8x2<false>(t.xq[q].x, 0); lo = bf2_to_fp8x2<true>(t.xq[q].y, (int)lo); unsigned hi = bf2_to_fp8x2<false>(t.xq[q].z, 0); hi = bf2_to_fp8x2<true>(t.xq[q].w, (int)hi); xb[2 * q] = lo; xb[2 * q + 1] = hi; }
    const i64_t B0 = pack64(xb[0], xb[1]), B1 = pack64(xb[2], xb[3]), B2 = pack64(xb[4], xb[5]), B3 = pack64(xb[6], xb[7]);
    const int j8 = lane >> 3, i = lane & 7, r = lane & 15, g = lane >> 4;
    LAS unsigned char* wr0 = wl + j8 * 144 + i * 16;
    const LAS unsigned char* rd0 = wl + r * 144 + g * 32;
    f32x4 C[8];
#pragma unroll
    for (int c = 0; c < 8; ++c) { const int bo = (c & 1) * 2304;
        *(LAS u32x4*)(wr0 + bo) = W[2 * c]; *(LAS u32x4*)(wr0 + bo + 8 * 144) = W[2 * c + 1];
        const u32x4 a0 = *(const LAS u32x4*)(rd0 + bo), a1 = *(const LAS u32x4*)(rd0 + bo + 16);
        f32x4 acc = (f32x4){0.f, 0.f, 0.f, 0.f};
        acc = __builtin_amdgcn_mfma_f32_16x16x32_fp8_fp8(pack64(a0.x, a0.y), B0, acc, 0, 0, 0);
        acc = __builtin_amdgcn_mfma_f32_16x16x32_fp8_fp8(pack64(a0.z, a0.w), B1, acc, 0, 0, 0);
        acc = __builtin_amdgcn_mfma_f32_16x16x32_fp8_fp8(pack64(a1.x, a1.y), B2, acc, 0, 0, 0);
        acc = __builtin_amdgcn_mfma_f32_16x16x32_fp8_fp8(pack64(a1.z, a1.w), B3, acc, 0, 0, 0); C[c] = acc; }
    if ((lane & 15) == 0) {
#pragma unroll
        for (int reg = 0; reg < 4; ++reg) { *(f32x4*)(pdrow + 8 * reg) = (f32x4){C[0][reg], C[1][reg], C[2][reg], C[3][reg]}; *(f32x4*)(pdrow + 8 * reg + 4) = (f32x4){C[4][reg], C[5][reg], C[6][reg], C[7][reg]}; } }
}
__device__ __forceinline__ void phase_peer_u_mfma(const Args& a, LAS unsigned char* lds, int wave, int lane) {
    const int s = SLICE_OF(blockIdx.x), rk = RANK_OF(blockIdx.x), nrk = gridDim.x >> 3, tper = T / nrk, g = lane >> 4, j8 = lane >> 3;
    const bf16_t* h1b = (const bf16_t*)(a.ws + WS_H1B) + 128 * s + 32 * g; const unsigned char* uqs = a.ws + WS_UB + (size_t)s * NEXP * 128; const unsigned loff = 16u * (unsigned)(lane & 7);
    const unsigned short* eidx = (const unsigned short*)(a.ws + WS_EIDX) + 8 * j8; float* pd = (float*)(a.ws + WS_PD) + (size_t)s * T * 128 + 32 * g;
    LAS unsigned char* wl = lds + wave * 4608;
    const int m0 = rk * tper + wave, mlast = (rk + 1) * tper - NWAVES + wave;
#define PM_LOADI(t, mm) do { const int m_ = (mm) < mlast ? (mm) : mlast; (t).ia = *(const u32x4*)(eidx + (size_t)m_ * 128); (t).ib = *(const u32x4*)(eidx + (size_t)m_ * 128 + 64); } while (0)
#define PM_LOADX(t, mm) do { const int m_ = (mm) < mlast ? (mm) : mlast; const u32x4* xp_ = (const u32x4*)(h1b + (size_t)m_ * DM); (t).xq[0] = xp_[0]; (t).xq[1] = xp_[1]; (t).xq[2] = xp_[2]; (t).xq[3] = xp_[3]; } while (0)
    MTokI iC, iN, iNN; MTokX xC, xN; u32x4 WA[16], WB[16];
    PM_LOADI(iC, m0); PM_LOADI(iN, m0 + NWAVES); PM_LOADI(iNN, m0 + 2 * NWAVES); PM_LOADX(xC, m0); PM_LOADX(xN, m0 + NWAVES); pm_issue(uqs, loff, iC, WA);
    for (int m = m0; m <= mlast; m += 2 * NWAVES) {
        pm_issue(uqs, loff, iN, WB);
        pm_compute(xC, WA, wl, pd + (size_t)m * 128, lane);
        iC = iN; iN = iNN; PM_LOADI(iNN, m + 3 * NWAVES); xC = xN; PM_LOADX(xN, m + 2 * NWAVES);
        pm_issue(uqs, loff, iN, WA);
        pm_compute(xC, WB, wl, pd + (size_t)(m + NWAVES) * 128, lane);
        iC = iN; iN = iNN; PM_LOADI(iNN, m + 4 * NWAVES); xC = xN; PM_LOADX(xN, m + 3 * NWAVES);
    }
#undef PM_LOADI
#undef PM_LOADX
}
__device__ __forceinline__ void phase_peer_act(const Args& a, int tid) {
    const float* pd = (const float*)(a.ws + WS_PD); const unsigned short* eidx = (const unsigned short*)(a.ws + WS_EIDX); const float* eg = (const float*)(a.ws + WS_EG);
    const float* su = (const float*)(a.ws + WS_SU); const float* sv = (const float*)(a.ws + WS_SV); const float* rowss = (const float*)(a.ws + WS_ROWSS); float* act = (float*)(a.ws + WS_ACT);
    for (size_t i4 = (size_t)blockIdx.x * NTHR + tid; i4 < (size_t)T * 32; i4 += (size_t)gridDim.x * NTHR) { const size_t idx = i4 * 4;
        f32x4 d = *(const f32x4*)(pd + idx);
#pragma unroll
        for (int s = 1; s < 8; ++s) d += *(const f32x4*)(pd + (size_t)s * T * 128 + idx);
        const u32x2 ew = *(const u32x2*)(eidx + idx); const f32x4 g = *(const f32x4*)(eg + idx); const float rstd = rsqrtf(rowss[idx >> 7] * (1.f / DM) + EPSF);
        const unsigned e0 = ew.x & 0xffffu, e1 = ew.x >> 16, e2 = ew.y & 0xffffu, e3 = ew.y >> 16;
        f32x4 o; o.x = gelu_tanh(d.x * su[e0] * rstd) * g.x * sv[e0]; o.y = gelu_tanh(d.y * su[e1] * rstd) * g.y * sv[e1];
        o.z = gelu_tanh(d.z * su[e2] * rstd) * g.z * sv[e2]; o.w = gelu_tanh(d.w * su[e3] * rstd) * g.w * sv[e3];
        *(f32x4*)(act + idx) = o;
    }
}
__device__ __forceinline__ void pv_quad(const u32x4& w0, const u32x4& w1, const u32x4& w2, const u32x4& w3, int a4, int (&oi)[16]) {
#define PV_BLK(d, base) do { const unsigned lo01 = __builtin_amdgcn_perm(w1.d, w0.d, 0x05010400u), hi01 = __builtin_amdgcn_perm(w1.d, w0.d, 0x07030602u); \
        const unsigned lo23 = __builtin_amdgcn_perm(w3.d, w2.d, 0x05010400u), hi23 = __builtin_amdgcn_perm(w3.d, w2.d, 0x07030602u); \
        oi[base + 0] = __builtin_amdgcn_sdot4((int)__builtin_amdgcn_perm(lo23, lo01, 0x05040100u), a4, oi[base + 0], false); \
        oi[base + 1] = __builtin_amdgcn_sdot4((int)__builtin_amdgcn_perm(lo23, lo01, 0x07060302u), a4, oi[base + 1], false); \
        oi[base + 2] = __builtin_amdgcn_sdot4((int)__builtin_amdgcn_perm(hi23, hi01, 0x05040100u), a4, oi[base + 2], false); \
        oi[base + 3] = __builtin_amdgcn_sdot4((int)__builtin_amdgcn_perm(hi23, hi01, 0x07060302u), a4, oi[base + 3], false); } while (0)
    PV_BLK(x, 0); PV_BLK(y, 4); PV_BLK(z, 8); PV_BLK(w, 12);
#undef PV_BLK
}
__device__ __forceinline__ float pv_quant_act(const f32x4 (&av)[4], int (&a4)[4]) {
    float mx = 0.f;
#pragma unroll
    for (int q = 0; q < 4; ++q) mx = fmaxf(mx, fmaxf(fmaxf(fabsf(av[q].x), fabsf(av[q].y)), fmaxf(fabsf(av[q].z), fabsf(av[q].w))));
    const float sc = (mx > 0.f) ? 127.0f * __builtin_amdgcn_rcpf(mx) * 0.99999f : 0.f;
#pragma unroll
    for (int q = 0; q < 4; ++q) a4[q] = (int)q8x4(av[q], sc);
    return mx * (1.0f / 127.0f);
}
__device__ __forceinline__ void pv_finish(const int (&oi)[16], float sa, bf16_t* orow  , int lane) {
    float o[16];
#pragma unroll
    for (int c = 0; c < 16; ++c) o[c] = (float)oi[c] * sa;
    const bool b3 = (lane & 8) != 0, b4 = (lane & 16) != 0, b5 = (lane & 32) != 0;
    float k8[8], k4[4], k2[2];
#pragma unroll
    for (int c = 0; c < 8; ++c) { const float snd = b3 ? o[c] : o[8 + c], kp = b3 ? o[8 + c] : o[c]; k8[c] = kp + dpp_xor8(snd); }
#pragma unroll
    for (int c = 0; c < 4; ++c) { const float snd = b4 ? k8[c] : k8[4 + c], kp = b4 ? k8[4 + c] : k8[c]; k4[c] = kp + __shfl_xor(snd, 16); }
#pragma unroll
    for (int c = 0; c < 2; ++c) { const float snd = b5 ? k4[c] : k4[2 + c], kp = b5 ? k4[2 + c] : k4[c]; k2[c] = kp + __shfl_xor(snd, 32); }
    *(unsigned*)(orow + ((lane & 8) ? 8 : 0) + ((lane & 16) ? 4 : 0) + ((lane & 32) ? 2 : 0)) = pk2(k2[0], k2[1]);
}
__device__ __forceinline__ void phase_peer_v(const Args& a, int wave, int lane) {
    const int s = SLICE_OF(blockIdx.x), rk = RANK_OF(blockIdx.x), nrk = gridDim.x >> 3, tper = T / nrk, i = lane & 7, j = lane >> 3;
    const unsigned char* vqs = a.ws + WS_VB + (size_t)s * NEXP * 128; const unsigned loff = 16u * (unsigned)i;
    const unsigned short* eidx = (const unsigned short*)(a.ws + WS_EIDX) + 16 * j; const float* act = (const float*)(a.ws + WS_ACT) + 16 * j;
    bf16_t* obase = (bf16_t*)(a.ws + WS_PO) + 128 * s + 16 * i;
    const int m0 = rk * tper + wave, mlast = (rk + 1) * tper - NWAVES + wave;
#define PV_LOAD(t, mm) do { const int m_ = (mm) < mlast ? (mm) : mlast; const u32x4* ep_ = (const u32x4*)(eidx + (size_t)m_ * 128); const f32x4* ap_ = (const f32x4*)(act + (size_t)m_ * 128); \
        (t).e0 = ep_[0]; (t).e1 = ep_[1]; (t).av[0] = ap_[0]; (t).av[1] = ap_[1]; (t).av[2] = ap_[2]; (t).av[3] = ap_[3]; } while (0)
    VTok tC, tN, tNN; u32x4 wA[8], wB[8];
    PV_LOAD(tC, m0); PV_LOAD(tN, m0 + NWAVES); PV_LOAD(tNN, m0 + 2 * NWAVES); pu_issue(vqs, loff, tC.e0, wA);
    for (int m = m0; m <= mlast; m += NWAVES) {
        pu_issue(vqs, loff, tC.e1, wB);
        int oi_[16];
#pragma unroll
        for (int c = 0; c < 16; ++c) oi_[c] = 0;
        int a4_[4]; const float sa_ = pv_quant_act(tC.av, a4_);
        pv_quad(wA[0], wA[1], wA[2], wA[3], a4_[0], oi_); pv_quad(wA[4], wA[5], wA[6], wA[7], a4_[1], oi_);
        pu_issue(vqs, loff, tN.e0, wA);
        pv_quad(wB[0], wB[1], wB[2], wB[3], a4_[2], oi_); pv_quad(wB[4], wB[5], wB[6], wB[7], a4_[3], oi_);
        pv_finish(oi_, sa_, obase + (size_t)m * DM, lane);
        tC = tN; tN = tNN; PV_LOAD(tNN, m + 3 * NWAVES);
    }
#undef PV_LOAD
}
__device__ __forceinline__ void phase_final(const Args& a, int wave, int lane) {
    const int gw = blockIdx.x * NWAVES + wave, NGW = gridDim.x * NWAVES; const bf16_t* po = (const bf16_t*)(a.ws + WS_PO) + 16 * lane; const bf16_t* h1b = (const bf16_t*)(a.ws + WS_H1B) + 16 * lane;
    f32x4 gf[4];
#pragma unroll
    for (int jj = 0; jj < 4; ++jj) gf[jj] = *(const f32x4*)(a.in[I_GFINAL] + 16 * lane + 4 * jj);
    for (int m0 = gw; m0 < T; m0 += 4 * NGW) {
        u32x4 hq[4][2], pq[4][2];
#pragma unroll
        for (int r = 0; r < 4; ++r) { const int m = (m0 + r * NGW < T) ? m0 + r * NGW : m0;
            hq[r][0] = *(const u32x4*)(h1b + (size_t)m * DM); hq[r][1] = *(const u32x4*)(h1b + (size_t)m * DM + 8); pq[r][0] = *(const u32x4*)(po + (size_t)m * DM); pq[r][1] = *(const u32x4*)(po + (size_t)m * DM + 8); }
#pragma unroll
        for (int r = 0; r < 4; ++r) { const int m = m0 + r * NGW; if (m >= T) break;
            float hb[16], pp[16]; unpack8(hq[r][0], *(float(*)[8])&hb[0]); unpack8(hq[r][1], *(float(*)[8])&hb[8]); unpack8(pq[r][0], *(float(*)[8])&pp[0]); unpack8(pq[r][1], *(float(*)[8])&pp[8]);
            f32x4 h[4]; float ss = 0.f;
#pragma unroll
            for (int jj = 0; jj < 4; ++jj) { h[jj] = (f32x4){hb[4 * jj] + pp[4 * jj], hb[4 * jj + 1] + pp[4 * jj + 1], hb[4 * jj + 2] + pp[4 * jj + 2], hb[4 * jj + 3] + pp[4 * jj + 3]};
                ss += (h[jj].x * h[jj].x + h[jj].y * h[jj].y) + (h[jj].z * h[jj].z + h[jj].w * h[jj].w); }
            const float r2 = rsqrtf(wave_sum_dpp(ss) * (1.f / DM) + EPSF);
            float* orow = a.out + (size_t)m * DM + 16 * lane;
#pragma unroll
            for (int jj = 0; jj < 4; ++jj) *(f32x4*)(orow + 4 * jj) = h[jj] * r2 * gf[jj]; }
    }
}
typedef short bf16x8_t __attribute__((ext_vector_type(8)));
__device__ __forceinline__ bf16x8_t toep_frag(const LAS unsigned* R32, int base) {
    const int e = base >> 1, sh = (base & 1) * 16;
    const unsigned d0 = R32[e], d1 = R32[e + 1], d2 = R32[e + 2], d3 = R32[e + 3], d4 = R32[e + 4];
    u32x4 o; o.x = __builtin_amdgcn_alignbit(d1, d0, sh); o.y = __builtin_amdgcn_alignbit(d2, d1, sh); o.z = __builtin_amdgcn_alignbit(d3, d2, sh); o.w = __builtin_amdgcn_alignbit(d4, d3, sh);
    return __builtin_bit_cast(bf16x8_t, o);
}
__device__ __forceinline__ void hy_conv_channel(const Args& a, LAS unsigned char* lds, int c, int tid, int wave, int lane) {
    constexpr int UROW = SP * 2;
    LAS unsigned char* uus = lds;
    LAS unsigned short* R = (LAS unsigned short*)(lds + 8 * UROW);
    const bf16_t* uut = (const bf16_t*)(a.ws + WS_UUT); const bf16_t* kfb = (const bf16_t*)(a.ws + WS_KFB); bf16_t* cvt = (bf16_t*)(a.ws + WS_CONVT);
    { const u32x4* src = (const u32x4*)(uut + (size_t)c * NB * SP); for (int i = tid; i < 8 * UROW / 16; i += NTHR) ((LAS u32x4*)uus)[i] = src[i]; }
    for (int n = tid; n < KFW + 16; n += NTHR) R[n] = (n < KFW) ? kfb[(size_t)c * KFW + (KFW - 1) - n] : (unsigned short)0;
    __syncthreads();
    const LAS unsigned* R32 = (const LAS unsigned*)R;
    const int i = lane & 15, g = lane >> 4, p = (lane >> 3) & 1, b = lane & 7;
    f32x4 C[16]; bf16x8_t A[16];
    const int abase = LT - 32 * (1 + 16 * wave) - i + 8 * g;
#pragma unroll
    for (int tb = 0; tb < 16; ++tb) { C[tb] = (f32x4){0.f, 0.f, 0.f, 0.f}; A[tb] = toep_frag(R32, abase - 32 * tb); }
    const LAS unsigned char* bptr = uus + b * UROW + (16 * p + 8 * g) * 2;
#define HC_STEP(ph, n) do { A[(16 - (ph)) & 15] = toep_frag(R32, abase + 32 * (n)); const bf16x8_t Bf = *(const LAS bf16x8_t*)(bptr + (n) * 64); \
        _Pragma("unroll") for (int tb = 0; tb < 16; ++tb) C[tb] = __builtin_amdgcn_mfma_f32_16x16x32_bf16(A[(tb - (ph)) & 15], Bf, C[tb], 0, 0, 0); __builtin_amdgcn_sched_barrier(0); } while (0)
    for (int G = 0; G < 8; ++G) { const int n0 = G * 16;
        HC_STEP(0, n0); HC_STEP(1, n0 + 1); HC_STEP(2, n0 + 2); HC_STEP(3, n0 + 3); HC_STEP(4, n0 + 4); HC_STEP(5, n0 + 5); HC_STEP(6, n0 + 6); HC_STEP(7, n0 + 7);
        HC_STEP(8, n0 + 8); HC_STEP(9, n0 + 9); HC_STEP(10, n0 + 10); HC_STEP(11, n0 + 11); HC_STEP(12, n0 + 12); HC_STEP(13, n0 + 13); HC_STEP(14, n0 + 14); HC_STEP(15, n0 + 15); }
    HC_STEP(0, 128);
#undef HC_STEP
#pragma unroll
    for (int tb = 0; tb < 16; ++tb) { const int tq = 512 * wave + 32 * tb + 16 * p + 4 * g;
        u32x2 w; w.x = pk2(C[tb][0], C[tb][1]); w.y = pk2(C[tb][2], C[tb][3]);
        *(u32x2*)(cvt + ((size_t)c * NB + b) * SEQ + tq) = w; }
    __syncthreads();
}
__device__ __forceinline__ void rg_item(const Args& a, LAS unsigned char* lds, int it, int tid, int wave, int lane) {
    constexpr int XROW = 272;
    const int head = it & 7, dir = (it >> 3) & 1, b = it >> 4;
    const bf16_t* xb = (const bf16_t*)(a.ws + WS_RGX) + (size_t)b * LT * DRG + head * 128;
    bf16_t* hout = (bf16_t*)a.out + (size_t)dir * T * DRG + (size_t)b * SEQ * DRG + head * 128 + 16 * wave + (lane & 15);
    const int col = lane & 15, g = lane >> 4, ch = head * 128 + 16 * wave + col;
    LAS unsigned char* wl = lds + 2 * 64 * XROW + wave * 1024 + lane * 16;
#pragma unroll
    for (int gt = 0; gt < 2; ++gt)
#pragma unroll
        for (int ks = 0; ks < 4; ++ks) { const float* wp = a.in[I_RGGW] + ((size_t)((dir * 2 + gt) * 8 + head) * 128 + 32 * ks + 8 * g) * 128 + 16 * wave + col;
            u32x4 o; o.x = pk2(wp[0], wp[128]); o.y = pk2(wp[256], wp[384]); o.z = pk2(wp[512], wp[640]); o.w = pk2(wp[768], wp[896]); *(LAS u32x4*)(wl + (gt * 4 + ks) * 8192) = o; }
    const float br = a.in[I_RGGB][(size_t)(dir * 2 + 0) * DRG + ch], bi = a.in[I_RGGB][(size_t)(dir * 2 + 1) * DRG + ch];
    const float sp8 = -8.0f * log1pf(__expf(-a.in[I_RGLAM][dir * DRG + ch]));
    const int ctr = tid >> 4, ccg = tid & 15;
    float cwv[4][8], cbv[8];
#pragma unroll
    for (int i = 0; i < 8; ++i) { cbv[i] = a.in[I_RGCB][(size_t)dir * DRG + head * 128 + 8 * ccg + i];
#pragma unroll
        for (int j = 0; j < 4; ++j) cwv[j][i] = a.in[I_RGCW][((size_t)dir * 4 + j) * DRG + head * 128 + 8 * ccg + i]; }
    u32x4 xr[2][4];
#define RG_LOAD(k) do { _Pragma("unroll") for (int h_ = 0; h_ < 2; ++h_) { const int u_ = 64 * (k) + ctr + 32 * h_; _Pragma("unroll") for (int j = 0; j < 4; ++j) { const int uu_ = u_ - j; \
        if (uu_ >= 0 && uu_ < LT) { const int t_ = dir ? (LT - 1 - uu_) : uu_; xr[h_][j] = *(const u32x4*)(xb + (size_t)t_ * DRG + 8 * ccg); } \
        else xr[h_][j] = (u32x4){0u, 0u, 0u, 0u}; } } } while (0)
#define RG_CONV(k) do { _Pragma("unroll") for (int h_ = 0; h_ < 2; ++h_) { const int u_ = 64 * (k) + ctr + 32 * h_; float o_[8]; _Pragma("unroll") for (int i = 0; i < 8; ++i) o_[i] = (u_ < LT) ? cbv[i] : 0.f; \
        _Pragma("unroll") for (int j = 0; j < 4; ++j) { float f_[8]; unpack8(xr[h_][j], f_); _Pragma("unroll") for (int i = 0; i < 8; ++i) o_[i] += f_[i] * cwv[j][i]; } \
        u32x4 w0_; w0_.x = pk2(o_[0], o_[1]); w0_.y = pk2(o_[2], o_[3]); w0_.z = pk2(o_[4], o_[5]); w0_.w = pk2(o_[6], o_[7]); \
        *(LAS u32x4*)(lds + ((k) & 1) * (64 * XROW) + (ctr + 32 * h_) * XROW + ccg * 16) = w0_; } } while (0)
    RG_LOAD(0); RG_CONV(0); RG_LOAD(1);
    __syncthreads();
    float carry = 0.f;
    const int arow = 16 * (col >> 2) + (col & 3);
    for (int k = 0; k < 65; ++k) {
        if (k + 1 < 65) RG_CONV(k + 1);
        if (k + 2 < 65) RG_LOAD(k + 2);
        const LAS unsigned char* xa = lds + (k & 1) * (64 * XROW);
        unsigned hp[16]; float hh = 0.f, PP = 1.f;
#pragma unroll
        for (int mp = 0; mp < 2; ++mp) {
            f32x4 acc[2][2];
#pragma unroll
            for (int m2 = 0; m2 < 2; ++m2) { const int mb = 2 * mp + m2; acc[0][m2] = (f32x4){0.f, 0.f, 0.f, 0.f}; acc[1][m2] = (f32x4){0.f, 0.f, 0.f, 0.f};
#pragma unroll
                for (int ks = 0; ks < 4; ++ks) { const bf16x8_t Af = *(const LAS bf16x8_t*)(xa + (arow + 4 * mb) * XROW + (32 * ks + 8 * g) * 2);
                    acc[0][m2] = __builtin_amdgcn_mfma_f32_16x16x32_bf16(Af, *(const LAS bf16x8_t*)(wl + ks * 8192), acc[0][m2], 0, 0, 0);
                    acc[1][m2] = __builtin_amdgcn_mfma_f32_16x16x32_bf16(Af, *(const LAS bf16x8_t*)(wl + (4 + ks) * 8192), acc[1][m2], 0, 0, 0); } }
#pragma unroll
            for (int m2 = 0; m2 < 2; ++m2)
#pragma unroll
                for (int r = 0; r < 4; ++r) { const int e = 8 * mp + 4 * m2 + r, tau = 16 * g + e, u = 64 * k + tau;
                    const float rr = sigmoidf_(acc[0][m2][r] + br), ii = sigmoidf_(acc[1][m2][r] + bi);
                    float av = fexp(sp8 * rr); float mult = __builtin_amdgcn_sqrtf(fmaxf(1.0f - av * av, 0.f)); mult = (u == 0) ? 1.0f : mult;
                    const float xcv = bf2f(*(const LAS unsigned short*)(xa + tau * XROW + (16 * wave + col) * 2));
                    float bq = mult * ii * xcv; if (u >= LT) { av = 1.f; bq = 0.f; }
                    hh = av * hh + bq; PP *= av; hp[e] = pk2(hh, PP); }
        }
        float Pg[4], hg[4];
#pragma unroll
        for (int q = 0; q < 4; ++q) { Pg[q] = __shfl(PP, col + 16 * q); hg[q] = __shfl(hh, col + 16 * q); }
        const float H0 = carry, H1 = Pg[0] * H0 + hg[0], H2 = Pg[1] * H1 + hg[1], H3 = Pg[2] * H2 + hg[2], H4 = Pg[3] * H3 + hg[3];
        const float Hin = (g == 0) ? H0 : (g == 1) ? H1 : (g == 2) ? H2 : H3;
        carry = H4;
#pragma unroll
        for (int e = 0; e < 16; ++e) { const int u = 64 * k + 16 * g + e; const int t = dir ? (LT - 1 - u) : u;
            if (u < LT && t >= NMETA) hout[(size_t)(t - NMETA) * DRG] = (bf16_t)f2bf(bflo(hp[e]) + bfhi(hp[e]) * Hin); }
        __syncthreads();
    }
#undef RG_LOAD
#undef RG_CONV
}
__device__ __forceinline__ void rg_item2(const Args& a, LAS unsigned char* lds, int it, int tid, int wave, int lane) {
    constexpr int XROW = 272;
    const int hh = it & 1, head = (it >> 1) & 7, dir = (it >> 4) & 1, b = it >> 5;
    const bf16_t* xb = (const bf16_t*)(a.ws + WS_RGX) + (size_t)b * LT * DRG + head * 128;
    const int col = lane & 15, g = lane >> 4, gate = col >> 3, cj = col & 7, chl = 64 * hh + 8 * wave + cj, ch = head * 128 + chl, qg = 2 * g + gate;
    bf16_t* hout = (bf16_t*)a.out + (size_t)dir * T * DRG + (size_t)b * SEQ * DRG + ch;
    bf16x8_t Wf[4];
#pragma unroll
    for (int ks = 0; ks < 4; ++ks) { const float* wp = a.in[I_RGGW] + ((size_t)((dir * 2 + gate) * 8 + head) * 128 + 32 * ks + 8 * g) * 128 + chl;
        u32x4 o; o.x = pk2(wp[0], wp[128]); o.y = pk2(wp[256], wp[384]); o.z = pk2(wp[512], wp[640]); o.w = pk2(wp[768], wp[896]); Wf[ks] = __builtin_bit_cast(bf16x8_t, o); }
    const float LOG2E = 1.4426950408889634f;
    const float bgl = a.in[I_RGGB][(size_t)(dir * 2 + gate) * DRG + ch] * LOG2E;
    const float sp8l = -8.0f * log1pf(__expf(-a.in[I_RGLAM][dir * DRG + ch])) * LOG2E;
    const int ctr = tid >> 4, ccg = tid & 15;
    float cwv[4][8], cbv[8];
#pragma unroll
    for (int i = 0; i < 8; ++i) { cbv[i] = a.in[I_RGCB][(size_t)dir * DRG + head * 128 + 8 * ccg + i];
#pragma unroll
        for (int j = 0; j < 4; ++j) cwv[j][i] = a.in[I_RGCW][((size_t)dir * 4 + j) * DRG + head * 128 + 8 * ccg + i]; }
    u32x4 xr[2][4];
#define RG_LOAD(k) do { _Pragma("unroll") for (int h_ = 0; h_ < 2; ++h_) { const int u_ = 64 * (k) + ctr + 32 * h_; _Pragma("unroll") for (int j = 0; j < 4; ++j) { const int uu_ = u_ - j; \
        if (uu_ >= 0 && uu_ < LT) { const int t_ = dir ? (LT - 1 - uu_) : uu_; xr[h_][j] = *(const u32x4*)(xb + (size_t)t_ * DRG + 8 * ccg); } \
        else xr[h_][j] = (u32x4){0u, 0u, 0u, 0u}; } } } while (0)
#define RG_CONV(k) do { _Pragma("unroll") for (int h_ = 0; h_ < 2; ++h_) { const int u_ = 64 * (k) + ctr + 32 * h_; float o_[8]; _Pragma("unroll") for (int i = 0; i < 8; ++i) o_[i] = (u_ < LT) ? cbv[i] : 0.f; \
        _Pragma("unroll") for (int j = 0; j < 4; ++j) { float f_[8]; unpack8(xr[h_][j], f_); _Pragma("unroll") for (int i = 0; i < 8; ++i) o_[i] += f_[i] * cwv[j][i]; } \
        u32x4 w0_; w0_.x = pk2(o_[0], o_[1]); w0_.y = pk2(o_[2], o_[3]); w0_.z = pk2(o_[4], o_[5]); w0_.w = pk2(o_[6], o_[7]); \
        *(LAS u32x4*)(lds + ((k) & 1) * (64 * XROW) + (ctr + 32 * h_) * XROW + ccg * 16) = w0_; } } while (0)
    RG_LOAD(0); RG_CONV(0); RG_LOAD(1);
    __syncthreads();
    float carry = 0.f;
    const int arow = 16 * (col >> 2) + (col & 3);
    for (int k = 0; k < 65; ++k) {
        if (k + 1 < 65) RG_CONV(k + 1);
        if (k + 2 < 65) RG_LOAD(k + 2);
        const LAS unsigned char* xa = lds + (k & 1) * (64 * XROW);
        f32x4 acc[4];
#pragma unroll
        for (int mb = 0; mb < 4; ++mb) { acc[mb] = (f32x4){0.f, 0.f, 0.f, 0.f};
#pragma unroll
            for (int ks = 0; ks < 4; ++ks) acc[mb] = __builtin_amdgcn_mfma_f32_16x16x32_bf16(*(const LAS bf16x8_t*)(xa + (arow + 4 * mb) * XROW + (32 * ks + 8 * g) * 2), Wf[ks], acc[mb], 0, 0, 0); }
        float sg[16], ot[16];
#pragma unroll
        for (int e = 0; e < 16; ++e) { sg[e] = __builtin_amdgcn_rcpf(1.0f + __builtin_amdgcn_exp2f(-(acc[e >> 2][e & 3] * LOG2E + bgl))); ot[e] = dpp_xor8(sg[e]); }
        unsigned hp[8]; float hs = 0.f, PP = 1.f;
#pragma unroll
        for (int t = 0; t < 8; ++t) { const float rr = gate ? ot[8 + t] : sg[t], ii = gate ? sg[8 + t] : ot[t]; const int tau = 8 * qg + t, u = 64 * k + tau;
            float av = __builtin_amdgcn_exp2f(sp8l * rr); float mult = __builtin_amdgcn_sqrtf(fmaxf(1.0f - av * av, 0.f)); mult = (u == 0) ? 1.0f : mult;
            const float xcv = bf2f(*(const LAS unsigned short*)(xa + tau * XROW + chl * 2));
            float bq = mult * ii * xcv; if (u >= LT) { av = 1.f; bq = 0.f; }
            hs = av * hs + bq; PP *= av; hp[t] = pk2(hs, PP); }
        float H = carry, Hin = carry;
#pragma unroll
        for (int q = 0; q < 8; ++q) { const int src = cj + 8 * (q & 1) + 16 * (q >> 1); const float Pq = __shfl(PP, src), hq = __shfl(hs, src);
            Hin = (qg == q) ? H : Hin; H = Pq * H + hq; }
        carry = H;
#pragma unroll
        for (int t = 0; t < 8; ++t) { const int u = 64 * k + 8 * qg + t; const int tt = dir ? (LT - 1 - u) : u;
            if (u < LT && tt >= NMETA) hout[(size_t)(tt - NMETA) * DRG] = (bf16_t)f2bf(bflo(hp[t]) + bfhi(hp[t]) * Hin); }
        __syncthreads();
    }
#undef RG_LOAD
#undef RG_CONV
}

__device__ __forceinline__ int rg_lds_off(int row, int chunk) { return row * 320 + (((chunk + 2 * (row >> 4)) & 15) << 4); }
__device__ __forceinline__ void rg_item3(const Args& a, LAS unsigned char* lds, int it, int tid, int wave, int lane) {
    constexpr int XT = 64 * 320;
    const int th = it & 1, head = (it >> 1) & 7, dir = (it >> 4) & 1, b = it >> 5;
    const int k0 = th ? RG_SPLIT : 0, k1 = th ? 65 : RG_SPLIT;
    const bf16_t* xb = (const bf16_t*)(a.ws + WS_RGX) + (size_t)b * LT * DRG + head * 128;
    const int col = lane & 15, g = lane >> 4, chl = 16 * wave + col, ch = head * 128 + chl;
    bf16_t* hout = (bf16_t*)a.out + (size_t)dir * T * DRG + (size_t)b * SEQ * DRG + ch;
    bf16_t* pout = (bf16_t*)(a.ws + WS_RGP) + ((size_t)dir * NB + b) * RG_NF * DRG + ch;
    LAS unsigned char* wl = lds + 2 * XT + wave * 1024 + lane * 16;
#pragma unroll
    for (int gt = 0; gt < 2; ++gt)
#pragma unroll
        for (int ks = 0; ks < 4; ++ks) { const float* wp = a.in[I_RGGW] + ((size_t)((dir * 2 + gt) * 8 + head) * 128 + 32 * ks + 8 * g) * 128 + chl;
            u32x4 o; o.x = pk2(wp[0], wp[128]); o.y = pk2(wp[256], wp[384]); o.z = pk2(wp[512], wp[640]); o.w = pk2(wp[768], wp[896]); *(LAS u32x4*)(wl + (gt * 4 + ks) * 8192) = o; }
    const float LOG2E = 1.4426950408889634f;
    const float brl = a.in[I_RGGB][(size_t)(dir * 2 + 0) * DRG + ch] * LOG2E, bil = a.in[I_RGGB][(size_t)(dir * 2 + 1) * DRG + ch] * LOG2E;
    const float sp8l = -8.0f * log1pf(__expf(-a.in[I_RGLAM][dir * DRG + ch])) * LOG2E;
    const int ctr = tid >> 4, ccg = tid & 15;
    LAS float* cwl = (LAS float*)(lds + 2 * XT + 8 * 8192);
    for (int i = tid; i < 5 * 128; i += NTHR) { const int j = i >> 7, c = i & 127; cwl[i] = (j < 4) ? a.in[I_RGCW][((size_t)dir * 4 + j) * DRG + head * 128 + c] : a.in[I_RGCB][(size_t)dir * DRG + head * 128 + c]; }
    __syncthreads();
    u32x4 xr[2][4];
#define RG_LOAD(k) do { _Pragma("unroll") for (int h_ = 0; h_ < 2; ++h_) { const int u_ = 64 * (k) + ctr + 32 * h_; _Pragma("unroll") for (int j = 0; j < 4; ++j) { int uu_ = u_ - j; \
        const bool ok_ = (uu_ >= 0 && uu_ < LT); uu_ = ok_ ? uu_ : 0; const int t_ = dir ? (LT - 1 - uu_) : uu_; const u32x4 v_ = *(const u32x4*)(xb + (size_t)t_ * DRG + 8 * ccg); \
        xr[h_][j] = ok_ ? v_ : (u32x4){0u, 0u, 0u, 0u}; } } } while (0)
#define RG_CONV(k) do { _Pragma("unroll") for (int h_ = 0; h_ < 2; ++h_) { const int u_ = 64 * (k) + ctr + 32 * h_; float o_[8]; \
        { const f32x4 b0_ = *(const LAS f32x4*)(cwl + 4 * 128 + 8 * ccg), b1_ = *(const LAS f32x4*)(cwl + 4 * 128 + 8 * ccg + 4); const bool in_ = (u_ < LT); \
          o_[0] = in_ ? b0_.x : 0.f; o_[1] = in_ ? b0_.y : 0.f; o_[2] = in_ ? b0_.z : 0.f; o_[3] = in_ ? b0_.w : 0.f; o_[4] = in_ ? b1_.x : 0.f; o_[5] = in_ ? b1_.y : 0.f; o_[6] = in_ ? b1_.z : 0.f; o_[7] = in_ ? b1_.w : 0.f; } \
        _Pragma("unroll") for (int j = 0; j < 4; ++j) { float f_[8]; unpack8(xr[h_][j], f_); const f32x4 w0_ = *(const LAS f32x4*)(cwl + j * 128 + 8 * ccg), w1_ = *(const LAS f32x4*)(cwl + j * 128 + 8 * ccg + 4); \
            o_[0] += f_[0] * w0_.x; o_[1] += f_[1] * w0_.y; o_[2] += f_[2] * w0_.z; o_[3] += f_[3] * w0_.w; o_[4] += f_[4] * w1_.x; o_[5] += f_[5] * w1_.y; o_[6] += f_[6] * w1_.z; o_[7] += f_[7] * w1_.w; } \
        u32x4 w0_; w0_.x = pk2(o_[0], o_[1]); w0_.y = pk2(o_[2], o_[3]); w0_.z = pk2(o_[4], o_[5]); w0_.w = pk2(o_[6], o_[7]); \
        *(LAS u32x4*)(lds + ((k) & 1) * XT + rg_lds_off(ctr + 32 * h_, ccg)) = w0_; } } while (0)
    RG_LOAD(k0); RG_CONV(k0); RG_LOAD(k0 + 1);
    __syncthreads();
    float carry = 0.f, pcar = 1.f;
    const int arow = 16 * (col >> 2) + (col & 3);
    const int xoff = (chl & 7) * 2, xch = chl >> 3;
    unsigned char* hbase = (unsigned char*)((bf16_t*)a.out + (size_t)dir * T * DRG + (size_t)b * SEQ * DRG);
    unsigned char* pbase = (unsigned char*)((bf16_t*)(a.ws + WS_RGP) + ((size_t)dir * NB + b) * RG_NF * DRG);
    const int tsgn = dir ? -1 : 1, t0 = dir ? (LT - 1 - NMETA) : -NMETA;
#define RG_TILE(EDGE) do { \
        unsigned hp[16]; float hh = 0.f, PP = 1.f; \
        _Pragma("unroll") for (int mp = 0; mp < 2; ++mp) { f32x4 acc[2][2]; \
            _Pragma("unroll") for (int m2 = 0; m2 < 2; ++m2) { const int mb = 2 * mp + m2; acc[0][m2] = (f32x4){0.f, 0.f, 0.f, 0.f}; acc[1][m2] = (f32x4){0.f, 0.f, 0.f, 0.f}; \
                _Pragma("unroll") for (int ks = 0; ks < 4; ++ks) { const bf16x8_t Af = *(const LAS bf16x8_t*)(xa + rg_lds_off(arow + 4 * mb, 4 * ks + g)); \
                    acc[0][m2] = __builtin_amdgcn_mfma_f32_16x16x32_bf16(Af, *(const LAS bf16x8_t*)(wl + ks * 8192), acc[0][m2], 0, 0, 0); \
                    acc[1][m2] = __builtin_amdgcn_mfma_f32_16x16x32_bf16(Af, *(const LAS bf16x8_t*)(wl + (4 + ks) * 8192), acc[1][m2], 0, 0, 0); } } \
            _Pragma("unroll") for (int m2 = 0; m2 < 2; ++m2) _Pragma("unroll") for (int r = 0; r < 4; ++r) { const int e = 8 * mp + 4 * m2 + r, tau = 16 * g + e, u = 64 * k + tau; \
                    const float rr = __builtin_amdgcn_rcpf(1.0f + __builtin_amdgcn_exp2f(-(acc[0][m2][r] * LOG2E + brl))), ii = __builtin_amdgcn_rcpf(1.0f + __builtin_amdgcn_exp2f(-(acc[1][m2][r] * LOG2E + bil))); \
                    float av = __builtin_amdgcn_exp2f(sp8l * rr); float mult = __builtin_amdgcn_sqrtf(fmaxf(1.0f - av * av, 0.f)); if (EDGE) mult = (u == 0) ? 1.0f : mult; \
                    const float xcv = bf2f(*(const LAS unsigned short*)(xa + rg_lds_off(tau, xch) + xoff)); \
                    float bq = mult * ii * xcv; if (EDGE) { if (u >= LT) { av = 1.f; bq = 0.f; } } \
                    hh = av * hh + bq; PP *= av; hp[e] = pk2(hh, PP); } } \
        float Pg[4], hg[4]; \
        _Pragma("unroll") for (int q = 0; q < 4; ++q) { Pg[q] = __shfl(PP, col + 16 * q); hg[q] = __shfl(hh, col + 16 * q); } \
        const float H0 = carry, H1 = Pg[0] * H0 + hg[0], H2 = Pg[1] * H1 + hg[1], H3 = Pg[2] * H2 + hg[2], H4 = Pg[3] * H3 + hg[3]; \
        const float Q0 = pcar, Q1 = Pg[0] * Q0, Q2 = Pg[1] * Q1, Q3 = Pg[2] * Q2, Q4 = Pg[3] * Q3; \
        const float Hin = (g == 0) ? H0 : (g == 1) ? H1 : (g == 2) ? H2 : H3, Qin = (g == 0) ? Q0 : (g == 1) ? Q1 : (g == 2) ? Q2 : Q3; \
        carry = H4; pcar = Q4; \
        const int ub = 64 * k + 16 * g; \
        unsigned ho = (unsigned)((t0 + tsgn * ub) * (DRG * 2) + ch * 2), po = (unsigned)((ub - RG_U1) * (DRG * 2) + ch * 2); const unsigned hstep = (unsigned)(tsgn * DRG * 2); \
        _Pragma("unroll") for (int e = 0; e < 16; ++e) { const int u = ub + e; const int t = dir ? (LT - 1 - u) : u; \
            if (!EDGE || (u < LT && t >= NMETA)) { *(bf16_t*)(hbase + ho) = (bf16_t)f2bf(bflo(hp[e]) + bfhi(hp[e]) * Hin); \
                if (th) *(bf16_t*)(pbase + po) = (bf16_t)f2bf(bfhi(hp[e]) * Qin); } \
            ho += hstep; po += (unsigned)(DRG * 2); } \
    } while (0)
    for (int k = k0; k < k1; ++k) {
        if (k + 1 < k1) RG_CONV(k + 1);
        if (k + 2 < k1) RG_LOAD(k + 2);
        const LAS unsigned char* xa = lds + (k & 1) * XT;
        if (k == 0 || k >= 63) RG_TILE(true); else RG_TILE(false);
        __syncthreads();
    }
#undef RG_TILE
    if (th == 0 && g == 0) ((float*)(a.ws + WS_RGC))[((size_t)dir * NB + b) * DRG + ch] = carry;
#undef RG_LOAD
#undef RG_CONV
}

#ifndef RG_NAIVE
#define RG_NAIVE 0
#endif
#ifndef CONV_NAIVE
#define CONV_NAIVE 0
#endif
#ifndef ONE_LAUNCH
#define ONE_LAUNCH 0
#endif
constexpr int NPHASE = 13;
#ifndef NVGPR
#define NVGPR 248
#endif
__global__ void __launch_bounds__(NTHR, 2) __attribute__((amdgpu_num_vgpr(NVGPR))) mega(Args a) {
    extern __shared__ __attribute__((aligned(16))) unsigned char lds_raw[];
    LAS unsigned char* lds = (LAS unsigned char*)lds_raw;
    const int tid = threadIdx.x, lane = tid & 63, wave = __builtin_amdgcn_readfirstlane(tid >> 6);
    cg::grid_group grid = cg::this_grid();
    volatile LAS unsigned* bst = (volatile LAS unsigned*)(lds + LDS_BYTES - 64);
    if (tid == 0) { bst[0] = 0u; bst[1] = 0u; }
    __syncthreads();
    XcdBarrier xbar; xbar.bar = (unsigned*)(a.ws + WS_BAR); xbar.x = 0; xbar.st = bst;
    if (a.ph_hi - a.ph_lo > 1) xbar = xcd_barrier_post((unsigned*)(a.ws + WS_BAR), bst);
    const int lo = a.ph_lo, hi = a.ph_hi, G = gridDim.x, bx = blockIdx.x;
#ifndef PHMASK
#define PHMASK 0x1fff
#endif
#ifndef REPMASK
#define REPMASK 0
#endif
#define IN(k) (((PHMASK >> (k)) & 1) && lo <= (k) && (k) < hi)
#define REP(k)
#define SEAM(k) do { if (IN(k) && ((k) + 1) < hi) xcd_barrier(xbar); } while (0)
    if (a.ph_lo < 0) grid.sync();
    unsigned char* ws = a.ws;
    REP(0) if (IN(0)) phase_p0(a, lds, tid, wave, lane);
    SEAM(0);
    REP(1) if (IN(1)) {
        p1_meta(a, lds, tid, wave, lane);
        pg8::Gemm g{(const bf16_t*)(ws + WS_XN1), (const bf16_t*)(ws + WS_WINT), T, DIN, 1024}; pg8::StaticOrder S; S.init(T, DIN, G, bx);
        EpiProj E{(bf16_t*)(ws + WS_HYIN), (bf16_t*)(ws + WS_RGX), (bf16_t*)(ws + WS_GG), (bf16_t*)(ws + WS_GA), (bf16_t*)(ws + WS_GB), a.in[I_BGATE]};
        pg8::gemm_phase<EpiProj, pg8::StaticOrder>(lds, g, S, E, nullptr);
    }
    SEAM(1);
    REP(2) if (IN(2)) phase_hy_pre(a, lds, tid);
    SEAM(2);
    REP(3) if (IN(3)) {
#if CONV_NAIVE
        phase_hy_conv_naive(a, lds, tid);
#else
        for (int c = bx; c < DHY; c += G) hy_conv_channel(a, lds, c, tid, wave, lane);
#endif
#if RG_NAIVE
        phase_rg_naive(a, lds, tid);
#else
        for (int it = bx; it < NB * 2 * 8 * 2; it += G) rg_item3(a, lds, it, tid, wave, lane);
#endif
    }
    SEAM(3);
    REP(4) if (IN(4)) phase_post(a, lds, tid);
    SEAM(4);
    REP(5) if (IN(5)) {
        { pg8::Gemm g{(const bf16_t*)(ws + WS_YH), (const bf16_t*)(ws + WS_WHT), T, 1024, 512}; pg8::StaticOrder S; S.init(T, 1024, G, bx);
          EpiGate<0> E{(const bf16_t*)(ws + WS_GA), nullptr, (bf16_t*)(ws + WS_TMP)};
          pg8::gemm_phase<EpiGate<0>, pg8::StaticOrder>(lds, g, S, E, nullptr); }
        { pg8::Gemm g{(const bf16_t*)(ws + WS_YR), (const bf16_t*)(ws + WS_WRT), T, 1024, 1024}; pg8::StaticOrder S; S.init(T, 1024, G, bx);
          EpiGate<1> E{(const bf16_t*)(ws + WS_GB), (const bf16_t*)(ws + WS_TMP), (bf16_t*)(ws + WS_MERGED)};
          pg8::gemm_phase<EpiGate<1>, pg8::StaticOrder>(lds, g, S, E, nullptr); }
    }
    SEAM(5);
    REP(6) if (IN(6)) {
        pg8::Gemm g{(const bf16_t*)(ws + WS_MERGED), (const bf16_t*)(ws + WS_WOT), T, 1024, 1024}; pg8::StaticOrder S; S.init(T, 1024, G, bx);
        EpiResid E{a.in[I_X], (bf16_t*)(ws + WS_H1B), (float*)(ws + WS_ROWSS)};
        pg8::gemm_phase<EpiResid, pg8::StaticOrder>(lds, g, S, E, nullptr);
    }
    SEAM(6);
    REP(7) if (IN(7)) {
        phase_tables(a, wave, lane);
        pg8::Gemm g{(const bf16_t*)(ws + WS_H1B), (const bf16_t*)(ws + WS_WST), T, 2048, 1024}; pg8::StaticOrder S; S.init(T, 2048, G, bx);
        EpiScores E{(const float*)(ws + WS_ROWSS), (_Float16*)(ws + WS_SCORES)};
        pg8::gemm_phase<EpiScores, pg8::StaticOrder>(lds, g, S, E, nullptr);
        __syncthreads();
        phase_topk(a, lds, S, wave, lane);
    }
    SEAM(8);
#ifndef U_VALU
#define U_VALU 1
#endif
    REP(9) if (IN(9)) { if (U_VALU) phase_peer_u(a, wave, lane); else phase_peer_u_mfma(a, lds, wave, lane); }
    SEAM(9);
    if (IN(10)) phase_peer_act(a, tid);
    SEAM(10);
    if (IN(11)) phase_peer_v(a, wave, lane);
    SEAM(11);
    if (IN(12)) phase_final(a, wave, lane);
#undef IN
#undef SEAM
}

extern "C" void kernel_launch(void* const* d_in, const int* in_sizes, int n_in, void* d_out, int out_size, void* d_ws, size_t ws_size, hipStream_t stream) {
    static int grid = 0;
    if (grid == 0) {
        if (n_in != N_IN || out_size != T * DM || ws_size < WS_END) { fprintf(stderr, "kernel_launch: unexpected shapes (n_in %d out %d ws %zu)\n", n_in, out_size, ws_size); grid = -1; return; }
        if (hipFuncSetAttribute((const void*)mega, hipFuncAttributeMaxDynamicSharedMemorySize, LDS_BYTES) != hipSuccess) { fprintf(stderr, "kernel_launch: hipFuncSetAttribute failed\n"); grid = -1; return; }
        int dev = 0, cus = 0, per_cu = 0;
        hipGetDevice(&dev); hipDeviceGetAttribute(&cus, hipDeviceAttributeMultiprocessorCount, dev);
        hipOccupancyMaxActiveBlocksPerMultiprocessor(&per_cu, (const void*)mega, NTHR, LDS_BYTES);
        if (per_cu < 1) { fprintf(stderr, "kernel_launch: occupancy query says %d blocks per CU\n", per_cu); per_cu = 1; }
        (void)hipGetLastError();
        grid = cus;
    }
    if (grid < 0) return;
    Args a{};
    for (int i = 0; i < N_IN; ++i) a.in[i] = (const float*)d_in[i];
    a.out = (float*)d_out; a.ws = (unsigned char*)d_ws;
#if ONE_LAUNCH
    if (hipMemsetAsync((char*)d_ws + WS_BAR, 0, XCD_BAR_WORDS * 4, stream) != hipSuccess) { fprintf(stderr, "kernel_launch: memset of the barrier words failed\n"); return; }
    a.ph_lo = 0; a.ph_hi = NPHASE;
    void* args[] = {&a};
    hipError_t e = hipLaunchCooperativeKernel((const void*)mega, dim3(grid), dim3(NTHR), args, LDS_BYTES, stream);
    if (e != hipSuccess) fprintf(stderr, "cooperative launch failed: %s (grid %d)\n", hipGetErrorString(e), grid);
#else
    for (int ph = 0; ph < NPHASE; ++ph) for (int rep = 0; rep < 1 + ((REPMASK >> ph) & 1); ++rep) { a.ph_lo = ph; a.ph_hi = ph + 1;
        if (ph == 6 && rep == 1) (void)hipMemsetAsync((char*)d_ws + WS_ROWSS, 0, T * 4, stream);
        hipLaunchKernelGGL(mega, dim3(grid), dim3(NTHR), LDS_BYTES, stream, a);
        hipError_t e = hipPeekAtLastError(); if (e != hipSuccess) { fprintf(stderr, "launch %d failed: %s\n", ph, hipGetErrorString(e)); break; } }
#endif
}
```

```cpp
#define ONE_LAUNCH 1
#include <hip/hip_runtime.h>
#include <hip/hip_cooperative_groups.h>
#include <cstdio>
#include <cstdint>
#include <cmath>
namespace cg = cooperative_groups;
namespace pg8 {
#define PG8_LAS __attribute__((address_space(3)))
typedef unsigned short bf16_t;
typedef short bf16x8 __attribute__((ext_vector_type(8)));
typedef float f32x4 __attribute__((ext_vector_type(4)));
typedef unsigned u32x4 __attribute__((ext_vector_type(4)));
constexpr int BM = 256, BK = 64, HALF = 128, HTB = HALF * BK * 2  , STAGE_BYTES = 8 * HTB, NXCD = 8, WGM = 8;

__host__ __device__ __forceinline__ int lds_byte(int r, int c) { const int st = (r >> 4) * 2 + (c >> 5), rr = r & 15, cc = c & 31, ob = rr * 64 + cc * 2; return st * 1024 + (ob ^ (((ob >> 9) & 1) << 5)); }
__host__ __device__ __forceinline__ void stage_rc(int b, int& R, int& C) { const int st = b / 1024, sb = b % 1024, swz = sb ^ (((sb >> 9) & 1) << 5); R = (st >> 1) * 16 + swz / 64; C = (st & 1) * 32 + (swz % 64) / 2; }
__host__ __device__ __forceinline__ int perm32(int rho) { const int n = rho >> 4, i = rho & 15; return 8 * (i >> 2) + 4 * n + (i & 3); }

struct Unit { int pm, pn; };
struct Gemm { const bf16_t* A; const bf16_t* Bt; int M, N, K; };

struct StaticOrder {
    int nM, nN, nwg, G, c;
    __host__ __device__ void init(int M, int N, int G_, int c_) { nM = M / BM; nN = N / BM; nwg = nM * nN; G = G_; c = c_; }
    __host__ __device__ bool next(int i, Unit& u) const {
        const long L = (long)i * G + c; if (L >= nwg) return false;
        int wgid = (int)L; { const int q = nwg / NXCD, r = nwg % NXCD, xcd = wgid % NXCD, off = wgid / NXCD; wgid = (xcd < r ? xcd * (q + 1) : r * (q + 1) + (xcd - r) * q) + off; }
        const int nig = WGM * nN, gid = wgid / nig, fm = gid * WGM, gsz = (nM - fm) < WGM ? (nM - fm) : WGM;
        u.pm = fm + ((wgid % nig) % gsz); u.pn = (wgid % nig) / gsz; return true;
    }
    __device__ __forceinline__ void a_ready(const Unit&) const {}
    __device__ __forceinline__ void done(const Unit&) const {}
};
__device__ __forceinline__ unsigned cvt_pk_bf16(float lo, float hi) { unsigned r; asm volatile("v_cvt_pk_bf16_f32 %0, %1, %2" : "=v"(r) : "v"(lo), "v"(hi)); return r; }
typedef float f32x2 __attribute__((ext_vector_type(2)));
__device__ __forceinline__ f32x2 gelu_pk(f32x2 v) {
    const f32x2 av = __builtin_elementwise_abs(v), d = av * 0.2316418882f + 1.0f;
    f32x2 t; t.x = __builtin_amdgcn_rcpf(d.x); t.y = __builtin_amdgcn_rcpf(d.y);
    f32x2 q = t * 0.5307027145f + (-0.7265760135f); q = q * t + 0.7107068705f; q = q * t + (-0.142248368f); q = q * t + 0.127414796f; q = q * t;
    const f32x2 s = (v * v) * (-0.72134752044f);
    f32x2 e; e.x = __builtin_amdgcn_exp2f(s.x); e.y = __builtin_amdgcn_exp2f(s.y);
    const f32x2 m = v * (q * e), r = v - m;
    f32x2 o; o.x = v.x < 0.f ? m.x : r.x; o.y = v.y < 0.f ? m.y : r.y; return o;
}
template <class Epi, class Sched, bool STAMP = false>
__device__ __forceinline__ void gemm_phase(PG8_LAS unsigned char* lds, const Gemm g, const Sched& S, const Epi& E, unsigned long long* stamps) {
    const int tid = threadIdx.x, wid = __builtin_amdgcn_readfirstlane(tid >> 6), lane = tid & 63, wr = wid >> 2, wc = wid & 3, fr = lane & 15, fq = lane >> 4;
    const int K = g.K, nt = K / BK;
    int ts_lo = 0, ts_hi = 0, nts = 0; const unsigned long long rt_entry = STAMP ? (unsigned long long)wall_clock64() : 0ull;
#define PG8_STAMP() do { if (STAMP && wid == 0 && nts < 64) { const unsigned long long _c = (unsigned long long)clock64(); \
        ts_lo = (lane == nts) ? (int)(unsigned)_c : ts_lo; ts_hi = (lane == nts) ? (int)(unsigned)(_c >> 32) : ts_hi; ++nts; } } while (0)
    PG8_STAMP();
    unsigned voffA[2], voffB[2];
#pragma unroll
    for (int i = 0; i < 2; ++i) { int R, C; stage_rc(tid * 16 + i * 8192, R, C); const int Rb = Epi::PERM ? ((R & ~31) + perm32(R & 31)) : R;
        voffA[i] = (unsigned)(R * K + C) * 2u; voffB[i] = (unsigned)(Rb * K + C) * 2u; }
    const size_t kstep = (size_t)(BK * 2);
    const size_t hstep = (size_t)HALF * K * 2;
    const size_t tstep = 2 * hstep;
    const unsigned ldsw = (unsigned)wid * 1024u;
    const int aoff = lds_byte(wr * 64 + fr, fq * 8), boff = lds_byte(wc * 32 + fr, fq * 8);
#define PG8_SA(b, h) (((b) * 2 + (h)) * HTB)
#define PG8_SB(b, h) ((4 + (b) * 2 + (h)) * HTB)
#define PG8_STAGE(bufoff, gbase, voff) do { _Pragma("unroll") for (int _i = 0; _i < 2; ++_i) \
        __builtin_amdgcn_global_load_lds((const unsigned*)((const char*)(gbase) + (voff)[_i]), (PG8_LAS unsigned*)(lds + (bufoff) + ldsw + _i * 8192), 16, 0, 0); } while (0)
#define PG8_LDA(dst, b, h) do { _Pragma("unroll") for (int m = 0; m < 4; ++m) _Pragma("unroll") for (int k = 0; k < 2; ++k) dst[m][k] = *(const PG8_LAS bf16x8*)(lds + PG8_SA(b, h) + aoff + m * 2048 + k * 1024); } while (0)
#define PG8_LDB(dst, b, h) do { _Pragma("unroll") for (int n = 0; n < 2; ++n) _Pragma("unroll") for (int k = 0; k < 2; ++k) dst[n][k] = *(const PG8_LAS bf16x8*)(lds + PG8_SB(b, h) + boff + n * 2048 + k * 1024); } while (0)
#define PG8_MMA(ai, bj, At, Bt) do { __builtin_amdgcn_s_setprio(1); _Pragma("unroll") for (int m = 0; m < 4; ++m) _Pragma("unroll") for (int n = 0; n < 2; ++n) _Pragma("unroll") for (int k = 0; k < 2; ++k) \
        acc[ai][bj][m][n] = __builtin_amdgcn_mfma_f32_16x16x32_bf16(Bt[n][k], At[m][k], acc[ai][bj][m][n], 0, 0, 0); __builtin_amdgcn_s_setprio(0); } while (0)
#define PG8_WAIT_V(n) asm volatile("s_waitcnt vmcnt(" #n ")" ::: "memory")
#define PG8_WAIT_L(n) asm volatile("s_waitcnt lgkmcnt(" #n ")" ::: "memory")
#define PG8_BAR __builtin_amdgcn_s_barrier()
#define PG8_SCHED __builtin_amdgcn_sched_barrier(0)
    Unit cur, nxt; int ui = 0;
    if (!S.next(0, cur)) return;
    f32x4 acc[2][2][4][2];
#pragma unroll
    for (int a = 0; a < 2; ++a)
#pragma unroll
        for (int b = 0; b < 2; ++b)
#pragma unroll
            for (int m = 0; m < 4; ++m)
#pragma unroll
                for (int n = 0; n < 2; ++n) acc[a][b][m][n] = (f32x4){0.f, 0.f, 0.f, 0.f};
    bf16x8 At[4][2], B0[2][2], B1[2][2];
    const char* cA = (const char*)g.A + (size_t)cur.pm * tstep; const char* cB = (const char*)g.Bt + (size_t)cur.pn * tstep;
    S.a_ready(cur);
    PG8_STAGE(PG8_SB(0, 0), cB, voffB); PG8_STAGE(PG8_SA(0, 0), cA, voffA); PG8_STAGE(PG8_SB(0, 1), cB + hstep, voffB); PG8_STAGE(PG8_SA(0, 1), cA + hstep, voffA);
    if (wr == 1) PG8_BAR;
    PG8_WAIT_V(4); PG8_BAR;
    PG8_STAGE(PG8_SB(1, 0), cB + kstep, voffB); PG8_STAGE(PG8_SA(1, 0), cA + kstep, voffA); PG8_STAGE(PG8_SB(1, 1), cB + hstep + kstep, voffB);
    PG8_WAIT_V(6); PG8_BAR;
    PG8_STAMP();
    for (;;) {
        const bool has_next = S.next(ui + 1, nxt);
        const char* nA = has_next ? (const char*)g.A + (size_t)nxt.pm * tstep : cA; const char* nB = has_next ? (const char*)g.Bt + (size_t)nxt.pn * tstep : cB;
        for (int t = 0; t < nt; t += 2) {
            const bool last = (t == nt - 2);
            const char* a1 = cA + (size_t)(t + 1) * kstep;
            const char* a2 = last ? nA : cA + (size_t)(t + 2) * kstep; const char* b2 = last ? nB : cB + (size_t)(t + 2) * kstep;
            const char* a3 = a2 + kstep; const char* b3 = b2 + kstep;
            if (last && has_next) S.a_ready(nxt);
            PG8_LDB(B0, 0, 0); PG8_SCHED; PG8_LDA(At, 0, 0); PG8_STAGE(PG8_SA(1, 1), a1 + hstep, voffA);
            PG8_WAIT_L(8); PG8_BAR; PG8_WAIT_L(0); PG8_MMA(0, 0, At, B0); PG8_BAR; PG8_SCHED;
            PG8_LDB(B1, 0, 1); PG8_STAGE(PG8_SB(0, 0), b2, voffB);
            PG8_BAR; PG8_WAIT_L(0); PG8_MMA(0, 1, At, B1); PG8_BAR;
            PG8_LDA(At, 0, 1); PG8_STAGE(PG8_SA(0, 0), a2, voffA);
            PG8_BAR; PG8_WAIT_L(0); PG8_MMA(1, 0, At, B0); PG8_BAR; PG8_SCHED;
            PG8_STAGE(PG8_SB(0, 1), b2 + hstep, voffB);
            PG8_WAIT_V(6); PG8_BAR; PG8_MMA(1, 1, At, B1); PG8_BAR;
            PG8_LDB(B0, 1, 0); PG8_SCHED; PG8_LDA(At, 1, 0); PG8_STAGE(PG8_SA(0, 1), a2 + hstep, voffA);
            PG8_WAIT_L(8); PG8_BAR; PG8_WAIT_L(0); PG8_MMA(0, 0, At, B0); PG8_BAR; PG8_SCHED;
            PG8_LDB(B1, 1, 1); PG8_STAGE(PG8_SB(1, 0), b3, voffB);
            PG8_BAR; PG8_WAIT_L(0); PG8_MMA(0, 1, At, B1); PG8_BAR;
            PG8_LDA(At, 1, 1); PG8_STAGE(PG8_SA(1, 0), a3, voffA);
            PG8_BAR; PG8_WAIT_L(0); PG8_MMA(1, 0, At, B0); PG8_BAR; PG8_SCHED;
            PG8_STAGE(PG8_SB(1, 1), b3 + hstep, voffB);
            PG8_WAIT_V(6); PG8_BAR; PG8_MMA(1, 1, At, B1); PG8_BAR;
        }
        PG8_STAMP();
        if constexpr (!Epi::AFTER_DRAIN) { E(acc, cur, wr, wc, fr, fq); S.done(cur); }
        PG8_STAMP();
        if (!has_next) break;
#pragma unroll
        for (int a = 0; a < 2; ++a)
#pragma unroll
            for (int b = 0; b < 2; ++b)
#pragma unroll
                for (int m = 0; m < 4; ++m)
#pragma unroll
                    for (int n = 0; n < 2; ++n) acc[a][b][m][n] = (f32x4){0.f, 0.f, 0.f, 0.f};
        cur = nxt; cA = nA; cB = nB; ++ui;
    }
    PG8_WAIT_V(0);
    if (wr == 0) PG8_BAR;
    PG8_BAR;
    if constexpr (Epi::AFTER_DRAIN) { E.fused(acc, cur, wr, wc, fr, fq, lds, wid, lane); S.done(cur); }
    PG8_STAMP();
    if (STAMP && wid == 0) { stamps[lane] = lane < nts ? (((unsigned long long)(unsigned)ts_hi << 32) | (unsigned)ts_lo) : 0ull;
        if (lane == 62) stamps[62] = rt_entry; if (lane == 63) stamps[63] = (unsigned long long)wall_clock64(); }
#undef PG8_STAMP
#undef PG8_SA
#undef PG8_SB
#undef PG8_STAGE
#undef PG8_LDA
#undef PG8_LDB
#undef PG8_MMA
#undef PG8_WAIT_V
#undef PG8_WAIT_L
#undef PG8_BAR
#undef PG8_SCHED
}
}

#define LAS __attribute__((address_space(3)))
typedef unsigned short bf16_t;
typedef float f32x4 __attribute__((ext_vector_type(4)));
typedef float f32x2 __attribute__((ext_vector_type(2)));
typedef unsigned u32x4 __attribute__((ext_vector_type(4)));
typedef unsigned u32x2 __attribute__((ext_vector_type(2)));

constexpr int NB = 8, SEQ = 4096, NMETA = 16, LT = SEQ + NMETA, DM = 1024, T = NB * SEQ;
constexpr int DHY = 512, DRG = 1024, DIN = 3 * DHY + 2 * DRG + 2 * DM;
constexpr int NTHR = 512, NWAVES = 8;
constexpr int LDS_BYTES = 160 * 1024;
constexpr float EPSF = 1e-6f;
constexpr int KFW = 2 * LT;
constexpr int SP = 4256;
constexpr int NEXP = 16384;
constexpr int RG_SPLIT = 33, RG_U1 = RG_SPLIT * 64;
constexpr int RG_NF = LT - RG_U1;

enum { I_X = 0, I_META, I_GFINAL, I_GMIX, I_WIN, I_BGATE, I_HYCW, I_HYCB, I_HYW1, I_HYB1, I_HYW2, I_HYB2, I_HYW3, I_HYB3, I_HYFREQ, I_HYSKIP,
       I_HYOUT, I_RGCW, I_RGCB, I_RGGW, I_RGGB, I_RGLAM, I_RGOUT, I_WOUT, I_GFFN, I_WQ, I_KEYS, I_PU, I_PV, N_IN };

constexpr size_t MiB = 1024ull * 1024ull;
constexpr size_t WS_ROWSS = 64 * 1024;
constexpr size_t WS_SU = 256 * 1024;
constexpr size_t WS_SV = 320 * 1024;
constexpr size_t WS_ROWSS2 = 384 * 1024;
constexpr size_t WS_BAR = 512 * 1024;
constexpr size_t WS_WINT = 1 * MiB;
constexpr size_t WS_WHT = 12 * MiB;
constexpr size_t WS_WRT = 13 * MiB;
constexpr size_t WS_WOT = 15 * MiB;
constexpr size_t WS_WST = 17 * MiB;
constexpr size_t WS_GWT = 21 * MiB;
constexpr size_t WS_KF = 22 * MiB;
constexpr size_t WS_KFB = 39 * MiB;
constexpr size_t WS_HYIN = 48 * MiB;
constexpr size_t WS_RGX = 145 * MiB;
constexpr size_t WS_GG = 210 * MiB;
constexpr size_t WS_GA = 274 * MiB;
constexpr size_t WS_GB = 338 * MiB;
constexpr size_t WS_XN1 = 402 * MiB;
constexpr size_t WS_UUT = 402 * MiB;
constexpr size_t WS_CONVT = 436 * MiB;
constexpr size_t WS_YH = 468 * MiB;
constexpr size_t WS_YR = WS_RGX;
constexpr size_t WS_MERGED = WS_HYIN;
constexpr size_t WS_TMP = WS_GG;
constexpr size_t WS_H1B = WS_RGX;
constexpr size_t WS_SCORES = WS_GG;
constexpr size_t WS_EIDX = 468 * MiB;
constexpr size_t WS_EG = 484 * MiB;
constexpr size_t WS_UB = 48 * MiB;
constexpr size_t WS_VB = 64 * MiB;
constexpr size_t WS_PD = 210 * MiB;
constexpr size_t WS_PO = WS_PD;
constexpr size_t WS_ACT = 338 * MiB;
constexpr size_t WS_RGP = 48 * MiB;
constexpr size_t WS_RGC = 576 * 1024;
constexpr size_t WS_END = 500 * MiB;

struct Args { const float* in[N_IN]; float* out; unsigned char* ws; int ph_lo, ph_hi; };

__device__ __forceinline__ float bf2f(unsigned v) { return __uint_as_float(v << 16); }
typedef __bf16 bf16x2_t __attribute__((ext_vector_type(2)));
__device__ __forceinline__ unsigned pk2(float lo, float hi) { bf16x2_t v; v.x = (__bf16)lo; v.y = (__bf16)hi; return __builtin_bit_cast(unsigned, v); }
__device__ __forceinline__ unsigned f2bf(float f) { return pk2(f, f) & 0xffffu; }
__device__ __forceinline__ float bflo(unsigned w) { return __uint_as_float(w << 16); }
__device__ __forceinline__ float bfhi(unsigned w) { return __uint_as_float(w & 0xffff0000u); }
__device__ __forceinline__ float wave_sum(float v) {
#pragma unroll
    for (int o = 1; o < 64; o <<= 1) v += __shfl_xor(v, o);
    return v;
}
__device__ __forceinline__ float wave_max(float v) {
#pragma unroll
    for (int o = 1; o < 64; o <<= 1) v = fmaxf(v, __shfl_xor(v, o));
    return v;
}
__device__ __forceinline__ float fexp(float x) { return __builtin_amdgcn_exp2f(x * 1.4426950408889634f); }
__device__ __forceinline__ float sigmoidf_(float x) { return __builtin_amdgcn_rcpf(1.0f + fexp(-x)); }
__device__ __forceinline__ float gelu_tanh(float x) { const float u = 1.5957691216f * (x + 0.044715f * x * x * x); return x * __builtin_amdgcn_rcpf(1.0f + fexp(-u)); }
__device__ __forceinline__ void sincos_acc(float a, float& s, float& c) {
    const double x = (double)a;
    const double q = rint(x * 0.63661977236758134308);
    const double r = fma(-q, 1.57079632679489661923, x);
    const int n = (int)q;
    const float rf = (float)r, r2 = rf * rf;
    const float sp = rf * (1.f + r2 * (-1.6666667e-1f + r2 * (8.3333333e-3f + r2 * (-1.9841270e-4f + r2 * 2.7557319e-6f))));
    const float cp = 1.f + r2 * (-0.5f + r2 * (4.1666667e-2f + r2 * (-1.3888889e-3f + r2 * (2.4801587e-5f + r2 * (-2.7557319e-7f)))));
    const int k = n & 3;
    s = (k == 0) ? sp : (k == 1) ? cp : (k == 2) ? -sp : -cp;
    c = (k == 0) ? cp : (k == 1) ? -sp : (k == 2) ? -cp : sp;
}

typedef float f32x2v __attribute__((ext_vector_type(2)));
__device__ __forceinline__ float wave_sum_dpp(float v) {
    v += __int_as_float(__builtin_amdgcn_update_dpp(0, __float_as_int(v), 0xB1, 0xF, 0xF, true));
    v += __int_as_float(__builtin_amdgcn_update_dpp(0, __float_as_int(v), 0x4E, 0xF, 0xF, true));
    v += __int_as_float(__builtin_amdgcn_update_dpp(0, __float_as_int(v), 0x141, 0xF, 0xF, true));
    v += __int_as_float(__builtin_amdgcn_update_dpp(0, __float_as_int(v), 0x140, 0xF, 0xF, true));
    const int vi = __float_as_int(v);
    return (__int_as_float(__builtin_amdgcn_readlane(vi, 0)) + __int_as_float(__builtin_amdgcn_readlane(vi, 16))) + (__int_as_float(__builtin_amdgcn_readlane(vi, 32)) + __int_as_float(__builtin_amdgcn_readlane(vi, 48)));
}
__device__ __forceinline__ float wave_max_dpp(float v) {
    v = fmaxf(v, __int_as_float(__builtin_amdgcn_update_dpp(0, __float_as_int(v), 0xB1, 0xF, 0xF, true)));
    v = fmaxf(v, __int_as_float(__builtin_amdgcn_update_dpp(0, __float_as_int(v), 0x4E, 0xF, 0xF, true)));
    v = fmaxf(v, __int_as_float(__builtin_amdgcn_update_dpp(0, __float_as_int(v), 0x141, 0xF, 0xF, true)));
    v = fmaxf(v, __int_as_float(__builtin_amdgcn_update_dpp(0, __float_as_int(v), 0x140, 0xF, 0xF, true)));
    const int vi = __float_as_int(v);
    return fmaxf(fmaxf(__int_as_float(__builtin_amdgcn_readlane(vi, 0)), __int_as_float(__builtin_amdgcn_readlane(vi, 16))), fmaxf(__int_as_float(__builtin_amdgcn_readlane(vi, 32)), __int_as_float(__builtin_amdgcn_readlane(vi, 48))));
}

#ifndef SLICE_PROBE
#define SLICE_OF(b) ((b) & 7)
#define RANK_OF(b) ((b) >> 3)
#else
#define SLICE_OF(b) ((b) >> 5)
#define RANK_OF(b) ((b) & 31)
#endif

__device__ __forceinline__ float dpp_xor8(float v) { return __int_as_float(__builtin_amdgcn_update_dpp(0, __float_as_int(v), 0x128, 0xF, 0xF, true)); }
#define XB_TMO      128
#define XB_XCNT(j)  (256  + 64 * (j))
#define XB_XSUB(j)  (1280 + 64 * (j))
#define XB_XGEN(j)  (2304 + 64 * (j))
#define XB_TOP      3328
#define XB_TOPGEN   3392
#define XCD_BAR_WORDS 3456
#define XB_SPIN_CAP (1u << 18)

__device__ __forceinline__ unsigned xb_ld(unsigned* p)              { return __hip_atomic_load(p, __ATOMIC_RELAXED, __HIP_MEMORY_SCOPE_AGENT); }
__device__ __forceinline__ unsigned xb_add(unsigned* p, unsigned v) { return __hip_atomic_fetch_add(p, v, __ATOMIC_RELAXED, __HIP_MEMORY_SCOPE_AGENT); }
__device__ __forceinline__ unsigned xb_xcc_id() { return (unsigned)__builtin_amdgcn_s_getreg((3 << 11) | 20) & 0xFu; }
#define XB_SPIN(cond, bar) do { unsigned _sp = 0; while (cond) { __builtin_amdgcn_s_sleep(1); \
    if ((++_sp & 255u) == 0u) { if (xb_ld(&(bar)[XB_TMO])) break; if (_sp > XB_SPIN_CAP) { atomicAdd(&(bar)[XB_TMO], 1u); break; } } } } while (0)

struct XcdBarrier {
    unsigned* bar; unsigned x;
    volatile LAS unsigned* st;
};

__device__ __forceinline__ XcdBarrier xcd_barrier_post(unsigned* bar, volatile LAS unsigned* st) {
    XcdBarrier b; b.bar = bar; b.x = xb_xcc_id(); b.st = st;
    if (threadIdx.x == 0) (void)xb_add(&bar[XB_XCNT(b.x)], 1u);
    return b;
}
__device__ __forceinline__ void xcd_barrier_complete(unsigned* bar, unsigned x, unsigned& nloc, unsigned& nx) {
    const unsigned G = gridDim.x * gridDim.y * gridDim.z;
    unsigned sum, cnt, mine, sp = 0u;
    for (;;) {
        sum = 0u; cnt = 0u; mine = 0u;
#pragma unroll
        for (unsigned j = 0; j < 16; ++j) { const unsigned c = xb_ld(&bar[XB_XCNT(j)]); sum += c; cnt += (c > 0u) ? 1u : 0u; mine = (j == x) ? c : mine; }
        if (sum == G) break;
        __builtin_amdgcn_s_sleep(1);
        if ((++sp & 255u) == 0u) { if (xb_ld(&bar[XB_TMO])) break; if (sp > XB_SPIN_CAP) { atomicAdd(&bar[XB_TMO], 1u); break; } }
    }
    nloc = mine > 0u ? mine : 1u; nx = cnt > 0u ? cnt : 1u;
}

__device__ __forceinline__ void xcd_barrier(const XcdBarrier& b) {
    asm volatile("s_waitcnt vmcnt(0)" ::: "memory");
    __syncthreads();
    if (threadIdx.x == 0) {
        unsigned* bar = b.bar;
        __builtin_amdgcn_s_waitcnt(0);
        unsigned nloc = b.st[0], nx = b.st[1];
        if (nloc == 0u) { xcd_barrier_complete(bar, b.x, nloc, nx); b.st[0] = nloc; b.st[1] = nx; }
        const unsigned old = xb_add(&bar[XB_XSUB(b.x)], 1u);
        const unsigned gen = old / nloc;
        if (old + 1u == (gen + 1u) * nloc) {
            __builtin_amdgcn_fence(__ATOMIC_RELEASE, "agent");
            asm volatile("s_waitcnt vmcnt(0)" ::: "memory");
            const unsigned og = xb_add(&bar[XB_TOP], 1u);
            const unsigned tg = og / nx;
            if (og + 1u == (tg + 1u) * nx) xb_add(&bar[XB_TOPGEN], 1u);
            else XB_SPIN(xb_ld(&bar[XB_TOPGEN]) == tg, bar);
            __builtin_amdgcn_fence(__ATOMIC_ACQUIRE, "agent");
            xb_add(&bar[XB_XGEN(b.x)], 1u);
            asm volatile("s_waitcnt vmcnt(0)" ::: "memory");
        } else {
            XB_SPIN(xb_ld(&bar[XB_XGEN(b.x)]) == gen, bar);
            __builtin_amdgcn_fence(__ATOMIC_ACQUIRE, "agent");
            asm volatile("s_waitcnt vmcnt(0)" ::: "memory");
        }
    }
    __syncthreads();
}

__device__ __forceinline__ void p0_transpose_item(const float* W, int K, int N, bf16_t* WT, LAS float* scr, int item, int lane) {
    const int nblk = N / 32, kb = item / nblk, nb = item % nblk, k0 = 64 * kb, n0 = 32 * nb;
#pragma unroll 8
    for (int i = 0; i < 32; ++i) { const int kk = 2 * i + (lane >> 5); scr[kk * 33 + (lane & 31)] = W[(size_t)(k0 + kk) * N + n0 + (lane & 31)]; }
    asm volatile("s_waitcnt lgkmcnt(0)" ::: "memory");
    const int c = lane & 7;
#pragma unroll
    for (int j = 0; j < 4; ++j) { const int n = (lane >> 3) + 8 * j; const LAS float* s = scr + (8 * c) * 33 + n;
        u32x4 o; o.x = pk2(s[0 * 33], s[1 * 33]); o.y = pk2(s[2 * 33], s[3 * 33]); o.z = pk2(s[4 * 33], s[5 * 33]); o.w = pk2(s[6 * 33], s[7 * 33]);
        *(u32x4*)(WT + (size_t)(n0 + n) * K + k0 + 8 * c) = o; }
    asm volatile("s_waitcnt lgkmcnt(0)" ::: "memory");
}
__device__ __forceinline__ void p0_xn1_row(const float* xrow, const float* g, bf16_t* orow, int lane) {
    const f32x4* xr = (const f32x4*)xrow + lane; const f32x4* gr = (const f32x4*)g + lane;
    f32x4 v[4]; float s = 0.f;
#pragma unroll
    for (int j = 0; j < 4; ++j) { v[j] = xr[64 * j]; s += (v[j].x * v[j].x + v[j].y * v[j].y) + (v[j].z * v[j].z + v[j].w * v[j].w); }
    const float rstd = rsqrtf(wave_sum(s) * (1.f / DM) + EPSF);
    unsigned long long* o8 = (unsigned long long*)orow + lane;
#pragma unroll
    for (int j = 0; j < 4; ++j) { const f32x4 gv = gr[64 * j];
        o8[64 * j] = (unsigned long long)pk2(v[j].x * rstd * gv.x, v[j].y * rstd * gv.y) | ((unsigned long long)pk2(v[j].z * rstd * gv.z, v[j].w * rstd * gv.w) << 32); }
}
__device__ __forceinline__ void p0_fold_item(const Args& a, LAS unsigned char* lds, int item, int tid) {
    const int hp = item >> 4, k0 = (item & 15) * 64;
    LAS float* kl = (LAS float*)lds;
    LAS float* wl = (LAS float*)(lds + 128 * 129 * 4);
    const float* keys = a.in[I_KEYS] + (size_t)hp * 128 * 128; const float* wq = a.in[I_WQ];
    for (int i = tid; i < 128 * 128; i += NTHR) { const int key = i >> 7, d = i & 127; kl[key * 129 + d] = keys[i]; }
    for (int i = tid; i < 64 * 128; i += NTHR) { const int kk = i >> 7, d = i & 127; wl[i] = wq[(size_t)(k0 + kk) * 2048 + hp * 128 + d]; }
    __syncthreads();
    const int key = tid & 127, kq = tid >> 7;
    float acc[16];
#pragma unroll
    for (int i = 0; i < 16; ++i) acc[i] = 0.f;
#pragma unroll 2
    for (int d = 0; d < 128; ++d) { const float kv = kl[key * 129 + d];
#pragma unroll
        for (int i = 0; i < 16; ++i) acc[i] += wl[(kq * 16 + i) * 128 + d] * kv; }
    const float* gf = a.in[I_GFFN] + k0 + kq * 16;
    bf16_t* dst = (bf16_t*)(a.ws + WS_WST) + (size_t)(hp * 128 + key) * 1024 + k0 + kq * 16;
    u32x4 o0, o1;
    o0.x = pk2(acc[0] * gf[0], acc[1] * gf[1]); o0.y = pk2(acc[2] * gf[2], acc[3] * gf[3]); o0.z = pk2(acc[4] * gf[4], acc[5] * gf[5]); o0.w = pk2(acc[6] * gf[6], acc[7] * gf[7]);
    o1.x = pk2(acc[8] * gf[8], acc[9] * gf[9]); o1.y = pk2(acc[10] * gf[10], acc[11] * gf[11]); o1.z = pk2(acc[12] * gf[12], acc[13] * gf[13]); o1.w = pk2(acc[14] * gf[14], acc[15] * gf[15]);
    *(u32x4*)dst = o0; *(u32x4*)(dst + 8) = o1;
    __syncthreads();
}
__device__ __forceinline__ void p0_meta_item(const Args& a, LAS unsigned char* lds, int item, int tid, int wave, int lane) {
    LAS float* mt = (LAS float*)lds;
    for (int r = wave * 2; r < wave * 2 + 2; ++r) {
        const f32x4* xr = (const f32x4*)(a.in[I_META] + (size_t)r * DM) + lane; const f32x4* gr = (const f32x4*)a.in[I_GMIX] + lane;
        f32x4 v[4]; float s = 0.f;
#pragma unroll
        for (int j = 0; j < 4; ++j) { v[j] = xr[64 * j]; s += (v[j].x * v[j].x + v[j].y * v[j].y) + (v[j].z * v[j].z + v[j].w * v[j].w); }
        const float rstd = rsqrtf(wave_sum(s) * (1.f / DM) + EPSF);
#pragma unroll
        for (int j = 0; j < 4; ++j) { const f32x4 gv = gr[64 * j]; f32x4 o = v[j] * rstd * gv; *(LAS f32x4*)(mt + r * 1024 + 4 * (lane + 64 * j)) = o; }
    }
    __syncthreads();
    const int col = item * 256 + (tid & 255), rh = tid >> 8;
    float acc[8];
#pragma unroll
    for (int r = 0; r < 8; ++r) acc[r] = 0.f;
    const float* w = a.in[I_WIN] + col;
#pragma unroll 4
    for (int k = 0; k < 1024; ++k) { const float wv = w[(size_t)k * DIN];
#pragma unroll
        for (int r = 0; r < 8; ++r) acc[r] += mt[(rh * 8 + r) * 1024 + k] * wv; }
    bf16_t* hyin = (bf16_t*)(a.ws + WS_HYIN); bf16_t* rgx = (bf16_t*)(a.ws + WS_RGX);
#pragma unroll
    for (int r = 0; r < 8; ++r) { const int t = rh * 8 + r; const bf16_t v = (bf16_t)f2bf(acc[r]);
        for (int b = 0; b < NB; ++b) { if (col < 1536) hyin[((size_t)b * LT + t) * 1536 + col] = v; else rgx[((size_t)b * LT + t) * 1024 + (col - 1536)] = v; } }
    __syncthreads();
}
constexpr int FPP = 17, NFILT = (LT + FPP - 1) / FPP;
__device__ __forceinline__ void p0_filter_item(const Args& a, LAS unsigned char* lds, int item, int tid) {
    LAS float* z = (LAS float*)lds;
    LAS float* h1 = z + FPP * 33;
    LAS float* h2 = h1 + FPP * 64;
    LAS float* ko = h2 + FPP * 64;
    const int p0 = item * FPP;
    for (int idx = tid; idx < FPP * 33; idx += NTHR) { const int pp = idx / 33, f = idx % 33, p = p0 + pp;
        float v;
        if (f == 0) v = (float)p * (1.0f / (float)(LT - 1));
        else { const int bi = (f - 1) & 15; const float band = 1e-4f + (float)bi * ((15.0f - 1e-4f) / 15.0f); const float w = (float)(6.283185307179586 / (double)LT) * (float)p;
            float s, c; sincos_acc(band * w, s, c); v = (f <= 16) ? c : -s; }
        z[idx] = v; }
    __syncthreads();
    const float* w1 = a.in[I_HYW1]; const float* b1 = a.in[I_HYB1]; const float* w2 = a.in[I_HYW2]; const float* b2 = a.in[I_HYB2];
    const float* w3 = a.in[I_HYW3]; const float* b3 = a.in[I_HYB3]; const float* fr = a.in[I_HYFREQ];
    { const int j = tid & 63, pq = tid >> 6;
        float wv[33];
#pragma unroll
        for (int f = 0; f < 33; ++f) wv[f] = w1[f * 64 + j];
        const float bj = b1[j], fj = fr[j];
        for (int pp = pq; pp < FPP; pp += 8) { float acc = bj;
#pragma unroll
            for (int f = 0; f < 33; ++f) acc += z[pp * 33 + f] * wv[f];
            float s, c; sincos_acc(fj * acc, s, c); h1[pp * 64 + j] = s; } }
    __syncthreads();
    { const int j = tid & 63, pq = tid >> 6;
        const float bj = b2[j], fj = fr[64 + j]; float accp[3] = {bj, bj, bj};
#pragma unroll 1
        for (int fh = 0; fh < 2; ++fh) { float wv[32];
#pragma unroll
            for (int f = 0; f < 32; ++f) wv[f] = w2[(fh * 32 + f) * 64 + j];
#pragma unroll
            for (int t3 = 0; t3 < 3; ++t3) { const int pp = pq + 8 * t3; if (pp < FPP) { float acc = accp[t3];
#pragma unroll
                for (int f = 0; f < 32; ++f) acc += h1[pp * 64 + fh * 32 + f] * wv[f];
                accp[t3] = acc; } } }
#pragma unroll
        for (int t3 = 0; t3 < 3; ++t3) { const int pp = pq + 8 * t3; if (pp < FPP) { float s, c; sincos_acc(fj * accp[t3], s, c); h2[pp * 64 + j] = s; } } }
    __syncthreads();
#pragma unroll 1
    for (int half = 0; half < 2; ++half) { const int o = half * 512 + tid;
        const float bo = b3[o];
        const float delta = fabsf(-15.350567286626972f + (float)tid * ((-3.0701134573253945f + 15.350567286626972f) / 511.0f));
#pragma unroll 1
        for (int ih = 0; ih < 2; ++ih) { float wv[32];
#pragma unroll
            for (int i = 0; i < 32; ++i) wv[i] = w3[(ih * 32 + i) * 1024 + o];
#pragma unroll 1
            for (int pp = 0; pp < FPP; ++pp) { float acc = ih ? ko[o * (FPP + 1) + pp] : bo;
#pragma unroll
                for (int i = 0; i < 32; ++i) acc += h2[pp * 64 + ih * 32 + i] * wv[i];
                if (ih) { const float tn = (float)(p0 + pp) * (1.0f / (float)(LT - 1)); acc *= __expf(-tn * delta); }
                ko[o * (FPP + 1) + pp] = acc; } }
    }
    __syncthreads();
    bf16_t* kfb = (bf16_t*)(a.ws + WS_KFB);
    for (int idx = tid; idx < 1024 * FPP; idx += NTHR) { const int o = idx / FPP, pp = idx - o * FPP, dir = o >> 9, c = o & 511, p = p0 + pp;
        if (p < LT) { const float v = ko[o * (FPP + 1) + pp];
            if (dir == 0) kfb[(size_t)c * KFW + (LT - 1) + p] = (bf16_t)f2bf(p == 0 ? v + a.in[I_HYSKIP][c] : v);
            else if (p >= 1) kfb[(size_t)c * KFW + (LT - 1) - p] = (bf16_t)f2bf(v); } }
    if (item == 0) for (int c = tid; c < 512; c += NTHR) kfb[(size_t)c * KFW + KFW - 1] = 0;
    __syncthreads();
}
__device__ __forceinline__ void phase_p0(const Args& a, LAS unsigned char* lds, int tid, int wave, int lane) {
    const int G = gridDim.x, bx = blockIdx.x;
    { float* rs = (float*)(a.ws + WS_ROWSS); float* rs2 = (float*)(a.ws + WS_ROWSS2); for (int i = bx * NTHR + tid; i < T; i += G * NTHR) { rs[i] = 0.f; rs2[i] = 0.f; } }
    for (int it = bx; it < 256 + NFILT; it += G) {
#ifndef P0M
#define P0M 7
#endif
        if (it < 256) { if (P0M & 1) p0_fold_item(a, lds, it, tid); }
        else { if (P0M & 2) p0_filter_item(a, lds, it - 256, tid); }

    }
    LAS float* scr = (LAS float*)(lds + wave * 16384);
    const int gw = bx * NWAVES + wave, NGW = G * NWAVES;
    constexpr int I_IN = (1024 / 64) * (DIN / 32), I_H = (512 / 64) * (1024 / 32), I_R = (1024 / 64) * (1024 / 32), I_O = I_R;
    for (int it = gw; it < I_IN + I_H + I_R + I_O; it += NGW) {
        int r = it;
        if (r < I_IN) { p0_transpose_item(a.in[I_WIN], 1024, DIN, (bf16_t*)(a.ws + WS_WINT), scr, r, lane); continue; } r -= I_IN;
        if (r < I_H) { p0_transpose_item(a.in[I_HYOUT], 512, 1024, (bf16_t*)(a.ws + WS_WHT), scr, r, lane); continue; } r -= I_H;
        if (r < I_R) { p0_transpose_item(a.in[I_RGOUT], 1024, 1024, (bf16_t*)(a.ws + WS_WRT), scr, r, lane); continue; } r -= I_R;
        p0_transpose_item(a.in[I_WOUT], 1024, 1024, (bf16_t*)(a.ws + WS_WOT), scr, r, lane);
    }
    for (int m = gw; m < T; m += 2 * NGW) { p0_xn1_row(a.in[I_X] + (size_t)m * DM, a.in[I_GMIX], (bf16_t*)(a.ws + WS_XN1) + (size_t)m * DM, lane);
        if (m + NGW < T) p0_xn1_row(a.in[I_X] + (size_t)(m + NGW) * DM, a.in[I_GMIX], (bf16_t*)(a.ws + WS_XN1) + (size_t)(m + NGW) * DM, lane); }
}

__device__ __forceinline__ void p1_meta(const Args& a, LAS unsigned char* lds, int tid, int wave, int lane) {
    LAS float* mt = (LAS float*)lds;
    for (int r = wave * 2; r < wave * 2 + 2; ++r) {
        const f32x4* xr = (const f32x4*)(a.in[I_META] + (size_t)r * DM) + lane; const f32x4* gr = (const f32x4*)a.in[I_GMIX] + lane;
        f32x4 v[4]; float s = 0.f;
#pragma unroll
        for (int j = 0; j < 4; ++j) { v[j] = xr[64 * j]; s += (v[j].x * v[j].x + v[j].y * v[j].y) + (v[j].z * v[j].z + v[j].w * v[j].w); }
        const float rstd = rsqrtf(wave_sum(s) * (1.f / DM) + EPSF);
#pragma unroll
        for (int j = 0; j < 4; ++j) { const f32x4 gv = gr[64 * j]; f32x4 o = v[j] * rstd * gv; *(LAS f32x4*)(mt + r * 1024 + 4 * (lane + 64 * j)) = o; }
    }
    __syncthreads();
    const bf16_t* wint = (const bf16_t*)(a.ws + WS_WINT); bf16_t* hyin = (bf16_t*)(a.ws + WS_HYIN); bf16_t* rgx = (bf16_t*)(a.ws + WS_RGX);
    for (int cc = wave; cc < 10; cc += NWAVES) { const int n = blockIdx.x * 10 + cc; if (n >= 2560) break;
        float w[16]; { float t0[8], t1[8]; const bf16_t* wp = wint + (size_t)n * 1024; const u32x4 q0 = *(const u32x4*)(wp + 8 * lane), q1 = *(const u32x4*)(wp + 512 + 8 * lane);
            w[0] = bflo(q0.x); w[1] = bfhi(q0.x); w[2] = bflo(q0.y); w[3] = bfhi(q0.y); w[4] = bflo(q0.z); w[5] = bfhi(q0.z); w[6] = bflo(q0.w); w[7] = bfhi(q0.w);
            w[8] = bflo(q1.x); w[9] = bfhi(q1.x); w[10] = bflo(q1.y); w[11] = bfhi(q1.y); w[12] = bflo(q1.z); w[13] = bfhi(q1.z); w[14] = bflo(q1.w); w[15] = bfhi(q1.w); (void)t0; (void)t1; }
        float mine = 0.f;
#pragma unroll
        for (int r = 0; r < 16; ++r) { const LAS f32x4* mp = (const LAS f32x4*)(mt + r * 1024 + 8 * lane); const f32x4 m0 = mp[0], m1 = mp[1], m2 = mp[128], m3 = mp[129];
            float s = (w[0] * m0.x + w[1] * m0.y) + (w[2] * m0.z + w[3] * m0.w) + (w[4] * m1.x + w[5] * m1.y) + (w[6] * m1.z + w[7] * m1.w)
                    + (w[8] * m2.x + w[9] * m2.y) + (w[10] * m2.z + w[11] * m2.w) + (w[12] * m3.x + w[13] * m3.y) + (w[14] * m3.z + w[15] * m3.w);
            s = wave_sum_dpp(s); mine = ((lane & 15) == r) ? s : mine; }
        const bf16_t v = (bf16_t)f2bf(mine); const int t = lane & 15;
#pragma unroll
        for (int h = 0; h < 2; ++h) { const int b = (lane >> 4) + 4 * h;
            if (n < 1536) hyin[((size_t)b * LT + t) * 1536 + n] = v; else rgx[((size_t)b * LT + t) * 1024 + (n - 1536)] = v; }
    }
    __syncthreads();
}

typedef pg8::f32x4 pf4;
struct EpiProj {
    static constexpr bool PERM = true, AFTER_DRAIN = false;
    bf16_t *hyin, *rgx, *gg, *ga, *gb; const float* bgate;
    __device__ __forceinline__ void operator()(const pf4 (&acc)[2][2][4][2], const pg8::Unit& u, int wr, int wc, int fr, int fq) const {
        const int pn = u.pn, row0 = u.pm * 256 + wr * 64 + fr, cl0 = wc * 32 + 8 * fq;
#pragma unroll
        for (int ai = 0; ai < 2; ++ai)
#pragma unroll
            for (int m = 0; m < 4; ++m) { const int r = row0 + ai * 128 + m * 16; const size_t rl = (size_t)(r >> 12) * LT + NMETA + (r & 4095);
#pragma unroll
                for (int bj = 0; bj < 2; ++bj) { const int col = pn * 256 + bj * 128 + cl0; pf4 v0 = acc[ai][bj][m][0], v1 = acc[ai][bj][m][1]; bf16_t* dst;
                    if (pn < 6) dst = hyin + rl * 1536 + col;
                    else if (pn < 10) dst = rgx + rl * 1024 + (col - 1536);
                    else if (pn < 14) { dst = gg + (size_t)r * 1024 + (col - 2560);
#pragma unroll
                        for (int j = 0; j < 4; ++j) { v0[j] = gelu_tanh(v0[j]); v1[j] = gelu_tanh(v1[j]); } }
                    else { const int gc = col - 3584;
                        dst = (gc < 1024 ? ga + (size_t)r * 1024 + gc : gb + (size_t)r * 1024 + (gc - 1024));
                        const pf4 b0 = *(const pf4*)(bgate + gc), b1 = *(const pf4*)(bgate + gc + 4);
#pragma unroll
                        for (int j = 0; j < 4; ++j) { v0[j] = sigmoidf_(v0[j] + b0[j]); v1[j] = sigmoidf_(v1[j] + b1[j]); } }
                    u32x4 w; w.x = pk2(v0[0], v0[1]); w.y = pk2(v0[2], v0[3]); w.z = pk2(v1[0], v1[1]); w.w = pk2(v1[2], v1[3]);
                    *(u32x4*)dst = w; } }
    }
};
template <int MODE  > struct EpiGate {
    static constexpr bool PERM = true, AFTER_DRAIN = false;
    const bf16_t* gate; const bf16_t* tin; bf16_t* outp;
    __device__ __forceinline__ void operator()(const pf4 (&acc)[2][2][4][2], const pg8::Unit& u, int wr, int wc, int fr, int fq) const {
        const int row0 = u.pm * 256 + wr * 64 + fr, col0 = u.pn * 256 + wc * 32 + 8 * fq;
        u32x4 gq[2], tq[2];
#define EG_OFF(i) ((size_t)(row0 + ((i) >> 3) * 128 + (((i) >> 1) & 3) * 16) * 1024 + col0 + ((i) & 1) * 128)
        gq[0] = *(const u32x4*)(gate + EG_OFF(0)); if (MODE == 1) tq[0] = *(const u32x4*)(tin + EG_OFF(0));
#pragma unroll
        for (int i = 0; i < 16; ++i) { const int ai = i >> 3, m = (i >> 1) & 3, bj = i & 1; const size_t o = EG_OFF(i);
            if (i + 1 < 16) { gq[(i + 1) & 1] = *(const u32x4*)(gate + EG_OFF(i + 1)); if (MODE == 1) tq[(i + 1) & 1] = *(const u32x4*)(tin + EG_OFF(i + 1)); }
            const pf4 v0 = acc[ai][bj][m][0], v1 = acc[ai][bj][m][1]; const u32x4 g = gq[i & 1];
            float r[8];
            r[0] = v0[0] * bflo(g.x); r[1] = v0[1] * bfhi(g.x); r[2] = v0[2] * bflo(g.y); r[3] = v0[3] * bfhi(g.y);
            r[4] = v1[0] * bflo(g.z); r[5] = v1[1] * bfhi(g.z); r[6] = v1[2] * bflo(g.w); r[7] = v1[3] * bfhi(g.w);
            if (MODE == 1) { const u32x4 t = tq[i & 1];
                r[0] += bflo(t.x); r[1] += bfhi(t.x); r[2] += bflo(t.y); r[3] += bfhi(t.y); r[4] += bflo(t.z); r[5] += bfhi(t.z); r[6] += bflo(t.w); r[7] += bfhi(t.w); }
            u32x4 w; w.x = pk2(r[0], r[1]); w.y = pk2(r[2], r[3]); w.z = pk2(r[4], r[5]); w.w = pk2(r[6], r[7]);
            *(u32x4*)(outp + o) = w; }
#undef EG_OFF
    }
};
struct EpiResid {
    static constexpr bool PERM = true, AFTER_DRAIN = false;
    const float* x; bf16_t* h1b; float* rowss;
    __device__ __forceinline__ void operator()(const pf4 (&acc)[2][2][4][2], const pg8::Unit& u, int wr, int wc, int fr, int fq) const {
        const int row0 = u.pm * 256 + wr * 64 + fr, col0 = u.pn * 256 + wc * 32 + 8 * fq;
        pf4 xq[2][4];
#define ER_ROW(i) (row0 + ((i) >> 2) * 128 + ((i) & 3) * 16)
#define ER_LOAD(buf, i) do { const float* p_ = x + (size_t)ER_ROW(i) * 1024 + col0; xq[buf][0] = *(const pf4*)p_; xq[buf][1] = *(const pf4*)(p_ + 4); xq[buf][2] = *(const pf4*)(p_ + 128); xq[buf][3] = *(const pf4*)(p_ + 132); } while (0)
        ER_LOAD(0, 0);
#pragma unroll
        for (int i = 0; i < 8; ++i) { const int ai = i >> 2, m = i & 3, r = ER_ROW(i); const size_t ro = (size_t)r * 1024 + col0; float ss = 0.f;
            if (i + 1 < 8) ER_LOAD((i + 1) & 1, i + 1);
#pragma unroll
            for (int bj = 0; bj < 2; ++bj) { const size_t o = ro + bj * 128;
                const pf4 v0 = acc[ai][bj][m][0] + xq[i & 1][2 * bj], v1 = acc[ai][bj][m][1] + xq[i & 1][2 * bj + 1];
                u32x4 w; w.x = pk2(v0[0], v0[1]); w.y = pk2(v0[2], v0[3]); w.z = pk2(v1[0], v1[1]); w.w = pk2(v1[2], v1[3]);
                *(u32x4*)(h1b + o) = w;
                ss += (v0[0] * v0[0] + v0[1] * v0[1]) + (v0[2] * v0[2] + v0[3] * v0[3]) + (v1[0] * v1[0] + v1[1] * v1[1]) + (v1[2] * v1[2] + v1[3] * v1[3]); }
            ss += __shfl_xor(ss, 16); ss += __shfl_xor(ss, 32);
            if (fq == 0) atomicAdd(rowss + r, ss); }
#undef ER_ROW
#undef ER_LOAD
    }
};
struct EpiScores {
    static constexpr bool PERM = true, AFTER_DRAIN = false;
    const float* rowss; _Float16* sc;
    __device__ __forceinline__ void operator()(const pf4 (&acc)[2][2][4][2], const pg8::Unit& u, int wr, int wc, int fr, int fq) const {
        const int row0 = u.pm * 256 + wr * 64 + fr, k0 = wc * 32 + 8 * fq;
#pragma unroll
        for (int ai = 0; ai < 2; ++ai)
#pragma unroll
            for (int m = 0; m < 4; ++m) { const int r = row0 + ai * 128 + m * 16; const float rs = rsqrtf(rowss[r] * (1.f / DM) + EPSF);
#pragma unroll
                for (int bj = 0; bj < 2; ++bj) { _Float16* p = sc + (((size_t)(((r >> 6) * 8 + u.pn) * 2 + bj) * 16 + (k0 >> 3)) * 64 + (r & 63)) * 8;
                    typedef _Float16 h8 __attribute__((ext_vector_type(8)));
                    h8 v; v[0] = (_Float16)(acc[ai][bj][m][0][0] * rs); v[1] = (_Float16)(acc[ai][bj][m][0][1] * rs); v[2] = (_Float16)(acc[ai][bj][m][0][2] * rs); v[3] = (_Float16)(acc[ai][bj][m][0][3] * rs);
                    v[4] = (_Float16)(acc[ai][bj][m][1][0] * rs); v[5] = (_Float16)(acc[ai][bj][m][1][1] * rs); v[6] = (_Float16)(acc[ai][bj][m][1][2] * rs); v[7] = (_Float16)(acc[ai][bj][m][1][3] * rs);
                    *(h8*)p = v; } }
    }
};

__device__ __forceinline__ void unpack8(const u32x4 w, float (&f)[8]) {
    f[0] = bflo(w.x); f[1] = bfhi(w.x); f[2] = bflo(w.y); f[3] = bfhi(w.y); f[4] = bflo(w.z); f[5] = bfhi(w.z); f[6] = bflo(w.w); f[7] = bfhi(w.w); }
__device__ __forceinline__ void load8(const bf16_t* p, float (&f)[8]) { const u32x4 w = *(const u32x4*)p;
    f[0] = bflo(w.x); f[1] = bfhi(w.x); f[2] = bflo(w.y); f[3] = bfhi(w.y); f[4] = bflo(w.z); f[5] = bfhi(w.z); f[6] = bflo(w.w); f[7] = bfhi(w.w); }
__device__ __forceinline__ void short_conv8(const bf16_t* hb, const float* cw, const float* cb, int s, int ch, float (&o)[8]) {
    float xm[8], x0[8], xp[8];
    if (s >= 1) load8(hb + (size_t)(s - 1) * 1536 + ch, xm); else {
#pragma unroll
        for (int i = 0; i < 8; ++i) xm[i] = 0.f; }
    load8(hb + (size_t)s * 1536 + ch, x0);
    if (s + 1 < LT) load8(hb + (size_t)(s + 1) * 1536 + ch, xp); else {
#pragma unroll
        for (int i = 0; i < 8; ++i) xp[i] = 0.f; }
#pragma unroll
    for (int i = 0; i < 8; ++i) o[i] = xm[i] * cw[ch + i] + x0[i] * cw[1536 + ch + i] + xp[i] * cw[3072 + ch + i] + cb[ch + i];
}
__device__ __forceinline__ void short_conv8v(const u32x4& rm, const u32x4& r0, const u32x4& rp, const float* cw, const float* cb, int ch, float (&o)[8]) {
    float xm[8], x0[8], xp[8]; unpack8(rm, xm); unpack8(r0, x0); unpack8(rp, xp);
    const f32x4 wa0 = *(const f32x4*)(cw + ch), wa1 = *(const f32x4*)(cw + ch + 4), wb0 = *(const f32x4*)(cw + 1536 + ch), wb1 = *(const f32x4*)(cw + 1536 + ch + 4);
    const f32x4 wc0 = *(const f32x4*)(cw + 3072 + ch), wc1 = *(const f32x4*)(cw + 3072 + ch + 4), bb0 = *(const f32x4*)(cb + ch), bb1 = *(const f32x4*)(cb + ch + 4);
#pragma unroll
    for (int i = 0; i < 4; ++i) { o[i] = xm[i] * wa0[i] + x0[i] * wb0[i] + xp[i] * wc0[i] + bb0[i]; o[4 + i] = xm[4 + i] * wa1[i] + x0[4 + i] * wb1[i] + xp[4 + i] * wc1[i] + bb1[i]; }
}
__device__ __forceinline__ void phase_hy_pre(const Args& a, LAS unsigned char* lds, int tid) {
    const int wave = tid >> 6, lane = tid & 63, gw = blockIdx.x * NWAVES + wave, NGW = gridDim.x * NWAVES, l8 = lane >> 3, l7 = lane & 7;
    LAS bf16_t* tl = (LAS bf16_t*)(lds + wave * (64 * 144));
    const bf16_t* hyin = (const bf16_t*)(a.ws + WS_HYIN); bf16_t* uut = (bf16_t*)(a.ws + WS_UUT); bf16_t* x0out = (bf16_t*)(a.ws + WS_YH);
    const float* cw = a.in[I_HYCW]; const float* cb = a.in[I_HYCB];
    for (int it = gw; it < NB * 67 * 8; it += NGW) {
        const int ct = it & 7, ts = (it >> 3) % 67, b = (it >> 3) / 67, c0 = ct * 64 + l7 * 8;
        const bf16_t* hb = hyin + (size_t)b * LT * 1536;
#pragma unroll 2
        for (int k = 0; k < 8; ++k) { const int sr = 8 * k + l8, s = ts * 64 + sr - 16;
            float uu[8];
            if (s >= 0 && s < LT) {
                const int sm = (s >= 1) ? s - 1 : s, sp = (s + 1 < LT) ? s + 1 : s; const bool zm = (s < 1), zp = (s + 1 >= LT);
                u32x4 r[3][3];
#pragma unroll
                for (int gI = 0; gI < 3; ++gI) { const bf16_t* p = hb + 512 * gI + c0;
                    r[gI][0] = *(const u32x4*)(p + (size_t)sm * 1536); r[gI][1] = *(const u32x4*)(p + (size_t)s * 1536); r[gI][2] = *(const u32x4*)(p + (size_t)sp * 1536);
                    if (zm) r[gI][0] = (u32x4){0u, 0u, 0u, 0u}; if (zp) r[gI][2] = (u32x4){0u, 0u, 0u, 0u}; }
                float x1[8], v[8]; short_conv8v(r[1][0], r[1][1], r[1][2], cw, cb, 512 + c0, x1); short_conv8v(r[2][0], r[2][1], r[2][2], cw, cb, 1024 + c0, v);
#pragma unroll
                for (int i = 0; i < 8; ++i) uu[i] = v[i] * x1[i];
                if (s >= NMETA) { float x0[8]; short_conv8v(r[0][0], r[0][1], r[0][2], cw, cb, c0, x0);
                    u32x4 w; w.x = pk2(x0[0], x0[1]); w.y = pk2(x0[2], x0[3]); w.z = pk2(x0[4], x0[5]); w.w = pk2(x0[6], x0[7]);
                    *(u32x4*)(x0out + ((size_t)b * SEQ + (s - NMETA)) * DHY + c0) = w; } }
            else {
#pragma unroll
                for (int i = 0; i < 8; ++i) uu[i] = 0.f; }
            u32x4 w; w.x = pk2(uu[0], uu[1]); w.y = pk2(uu[2], uu[3]); w.z = pk2(uu[4], uu[5]); w.w = pk2(uu[6], uu[7]);
            *(LAS u32x4*)(tl + sr * 72 + l7 * 8) = w; }
#pragma unroll
        for (int k = 0; k < 8; ++k) { const int cl = 8 * k + l8, sp0 = ts * 64 + l7 * 8;
            if (sp0 < SP) { unsigned h[8];
#pragma unroll
                for (int i = 0; i < 8; ++i) h[i] = tl[(l7 * 8 + i) * 72 + cl];
                u32x4 w; w.x = h[0] | (h[1] << 16); w.y = h[2] | (h[3] << 16); w.z = h[4] | (h[5] << 16); w.w = h[6] | (h[7] << 16);
                *(u32x4*)(uut + ((size_t)(ct * 64 + cl) * NB + b) * SP + sp0) = w; } }
    }
}
__device__ __forceinline__ void phase_hy_conv_naive(const Args& a, LAS unsigned char* lds, int tid) {
    LAS bf16_t* uus = (LAS bf16_t*)lds;
    LAS float* filt = (LAS float*)(lds + LT * 16);
    const bf16_t* uut = (const bf16_t*)(a.ws + WS_UUT); const float* kf = (const float*)(a.ws + WS_KF); bf16_t* cvt = (bf16_t*)(a.ws + WS_CONVT);
    for (int c = blockIdx.x; c < DHY; c += gridDim.x) {
        for (int i = tid; i < NB * LT; i += NTHR) { const int b = i / LT, s = i - b * LT; uus[s * 8 + b] = uut[((size_t)c * NB + b) * SP + 16 + s]; }
        for (int i = tid; i < KFW; i += NTHR) filt[i] = kf[(size_t)c * KFW + i];
        __syncthreads();
        for (int tt = 0; tt < 8; ++tt) { const int tq = tt * 512 + tid, t = tq + 16; float acc[8];
#pragma unroll
            for (int b = 0; b < 8; ++b) acc[b] = 0.f;
            const LAS float* fp = filt + (LT - 1) + t;
            for (int s = 0; s < LT; ++s) { const float kv = fp[-s]; const u32x4 w = *(const LAS u32x4*)(uus + s * 8);
                acc[0] += kv * bflo(w.x); acc[1] += kv * bfhi(w.x); acc[2] += kv * bflo(w.y); acc[3] += kv * bfhi(w.y);
                acc[4] += kv * bflo(w.z); acc[5] += kv * bfhi(w.z); acc[6] += kv * bflo(w.w); acc[7] += kv * bfhi(w.w); }
#pragma unroll
            for (int b = 0; b < 8; ++b) cvt[((size_t)c * NB + b) * SEQ + tq] = (bf16_t)f2bf(acc[b]); }
        __syncthreads();
    }
}
__device__ __forceinline__ void phase_rg_naive(const Args& a, LAS unsigned char* lds, int tid) {
    LAS float* xc = (LAS float*)lds;
    LAS float* gbuf = xc + 32 * 128;
    const bf16_t* rgx = (const bf16_t*)(a.ws + WS_RGX);
    for (int it = blockIdx.x; it < NB * 2 * 8; it += gridDim.x) {
        const int head = it & 7, dir = (it >> 3) & 1, b = it >> 4;
        const float* cw = a.in[I_RGCW] + (size_t)dir * 4 * DRG + head * 128; const float* cb = a.in[I_RGCB] + (size_t)dir * DRG + head * 128;
        bf16_t* hout = (bf16_t*)a.out + (size_t)dir * T * DRG;
        const bf16_t* xb = rgx + (size_t)b * LT * DRG + head * 128;
        float h = 0.f, sp = 0.f;
        if (tid < 128) { const float lam = a.in[I_RGLAM][dir * DRG + head * 128 + tid]; sp = log1pf(__expf(-lam)); }
        for (int k = 0; k < 129; ++k) {
            { const int tok = tid >> 4, cg = tid & 15, u = 32 * k + tok; float o[8];
#pragma unroll
                for (int i = 0; i < 8; ++i) o[i] = (u < LT) ? cb[cg * 8 + i] : 0.f;
                if (u < LT) {
#pragma unroll
                    for (int j = 0; j < 4; ++j) { const int uu = u - j; if (uu >= 0) { const int t = dir ? (LT - 1 - uu) : uu; float xv[8]; load8(xb + (size_t)t * DRG + cg * 8, xv);
#pragma unroll
                            for (int i = 0; i < 8; ++i) o[i] += xv[i] * cw[j * DRG + cg * 8 + i]; } } }
#pragma unroll
                for (int i = 0; i < 8; ++i) xc[tok * 128 + cg * 8 + i] = o[i]; }
            __syncthreads();
            { const int j = tid & 127, g = (tid >> 7) & 1, th = tid >> 8; float acc[16];
#pragma unroll
                for (int q = 0; q < 16; ++q) acc[q] = 0.f;
                const float* gw = a.in[I_RGGW] + ((size_t)((dir * 2 + g) * 8 + head) * 128) * 128 + j;
                for (int i = 0; i < 128; ++i) { const float wv = gw[i * 128];
#pragma unroll
                    for (int q = 0; q < 16; ++q) acc[q] += xc[(th * 16 + q) * 128 + i] * wv; }
                const float gb = a.in[I_RGGB][(size_t)(dir * 2 + g) * DRG + head * 128 + j];
#pragma unroll
                for (int q = 0; q < 16; ++q) gbuf[(g * 32 + th * 16 + q) * 128 + j] = acc[q] + gb; }
            __syncthreads();
            if (tid < 128) {
                for (int tok = 0; tok < 32; ++tok) { const int u = 32 * k + tok; if (u >= LT) break;
                    const float r = sigmoidf_(gbuf[tok * 128 + tid]), ig = sigmoidf_(gbuf[(32 + tok) * 128 + tid]);
                    const float la = -8.0f * r * sp; const float av = __expf(la); const float mult = (u == 0) ? 1.0f : sqrtf(-expm1f(2.0f * la));
                    h = av * h + mult * ig * xc[tok * 128 + tid];
                    const int t = dir ? (LT - 1 - u) : u;
                    if (t >= NMETA) hout[((size_t)b * SEQ + (t - NMETA)) * DRG + head * 128 + tid] = (bf16_t)f2bf(h); } }
            __syncthreads();
        }
    }
}
__device__ __forceinline__ void phase_post(const Args& a, LAS unsigned char* lds, int tid) {
    const int wave = tid >> 6, lane = tid & 63, gw = blockIdx.x * NWAVES + wave, NGW = gridDim.x * NWAVES;
    LAS bf16_t* cv = (LAS bf16_t*)(lds + wave * (64 * 144));
    const bf16_t* cvt = (const bf16_t*)(a.ws + WS_CONVT); bf16_t* yh = (bf16_t*)(a.ws + WS_YH);
    const int l8 = lane >> 3, l7 = lane & 7;
    for (int it = gw; it < NB * 64 * 8; it += NGW) {
        const int ct = it & 7, tt = (it >> 3) & 63, b = it >> 9;
        u32x4 cw_[8], xw[8];
#pragma unroll
        for (int k = 0; k < 8; ++k) cw_[k] = *(const u32x4*)(cvt + ((size_t)(ct * 64 + 8 * k + l8) * NB + b) * SEQ + tt * 64 + l7 * 8);
        bf16_t* yp = yh + ((size_t)b * SEQ + tt * 64 + l8) * DHY + ct * 64 + l7 * 8;
#pragma unroll
        for (int k = 0; k < 8; ++k) xw[k] = *(const u32x4*)(yp + (size_t)(8 * k) * DHY);
#pragma unroll
        for (int k = 0; k < 8; ++k) *(LAS u32x4*)(cv + (8 * k + l8) * 72 + l7 * 8) = cw_[k];
#pragma unroll
        for (int k = 0; k < 8; ++k) { const int tr = 8 * k + l8; float x0[8], y[8]; unpack8(xw[k], x0);
#pragma unroll
            for (int i = 0; i < 8; ++i) y[i] = bf2f(cv[(l7 * 8 + i) * 72 + tr]) * x0[i];
            u32x4 w; w.x = pk2(y[0], y[1]); w.y = pk2(y[2], y[3]); w.z = pk2(y[4], y[5]); w.w = pk2(y[6], y[7]);
            *(u32x4*)(yp + (size_t)(8 * k) * DHY) = w; }
    }
    const bf16_t* hf = (const bf16_t*)a.out; const bf16_t* hb2 = hf + (size_t)T * DRG; const bf16_t* gg = (const bf16_t*)(a.ws + WS_GG); bf16_t* yr = (bf16_t*)(a.ws + WS_YR);
    const bf16_t* rgp = (const bf16_t*)(a.ws + WS_RGP); const float* rgc = (const float*)(a.ws + WS_RGC);
    for (size_t i = (size_t)blockIdx.x * NTHR + tid; i < (size_t)T * DRG / 8; i += (size_t)gridDim.x * NTHR) {
        const int c8 = (int)(i & 127) * 8, m = (int)(i >> 7), b = m >> 12, t = (m & 4095) + NMETA;
        float f[8], g[8], q[8]; load8(hf + i * 8, f); load8(hb2 + i * 8, g); load8(gg + i * 8, q);
        if (t >= RG_U1) { float p[8]; load8(rgp + ((size_t)(0 * NB + b) * RG_NF + (t - RG_U1)) * DRG + c8, p); const float* cc = rgc + (size_t)(0 * NB + b) * DRG + c8;
#pragma unroll
            for (int j = 0; j < 8; ++j) f[j] += p[j] * cc[j]; }
        const int ub = LT - 1 - t;
        if (ub >= RG_U1) { float p[8]; load8(rgp + ((size_t)(1 * NB + b) * RG_NF + (ub - RG_U1)) * DRG + c8, p); const float* cc = rgc + (size_t)(1 * NB + b) * DRG + c8;
#pragma unroll
            for (int j = 0; j < 8; ++j) g[j] += p[j] * cc[j]; }
        u32x4 w; w.x = pk2((f[0] + g[0]) * q[0], (f[1] + g[1]) * q[1]); w.y = pk2((f[2] + g[2]) * q[2], (f[3] + g[3]) * q[3]);
        w.z = pk2((f[4] + g[4]) * q[4], (f[5] + g[5]) * q[5]); w.w = pk2((f[6] + g[6]) * q[6], (f[7] + g[7]) * q[7]);
        *(u32x4*)(yr + i * 8) = w; }
}
__device__ __forceinline__ u32x4 quant_row16(const f32x4 (&v)[4], float amax, float& deq) {
    const float sc = (amax > 0.f) ? 256.0f / amax : 1.0f; deq = (amax > 0.f) ? amax * (1.0f / 256.0f) : 1.0f;
    u32x4 w; int t;
    t = __builtin_amdgcn_cvt_pk_fp8_f32(v[0].x * sc, v[0].y * sc, 0, false); t = __builtin_amdgcn_cvt_pk_fp8_f32(v[0].z * sc, v[0].w * sc, t, true); w.x = (unsigned)t;
    t = __builtin_amdgcn_cvt_pk_fp8_f32(v[1].x * sc, v[1].y * sc, 0, false); t = __builtin_amdgcn_cvt_pk_fp8_f32(v[1].z * sc, v[1].w * sc, t, true); w.y = (unsigned)t;
    t = __builtin_amdgcn_cvt_pk_fp8_f32(v[2].x * sc, v[2].y * sc, 0, false); t = __builtin_amdgcn_cvt_pk_fp8_f32(v[2].z * sc, v[2].w * sc, t, true); w.z = (unsigned)t;
    t = __builtin_amdgcn_cvt_pk_fp8_f32(v[3].x * sc, v[3].y * sc, 0, false); t = __builtin_amdgcn_cvt_pk_fp8_f32(v[3].z * sc, v[3].w * sc, t, true); w.w = (unsigned)t;
    return w;
}
__device__ __forceinline__ unsigned q8x4(f32x4 v, float sc) {
    const int a = (int)rintf(v.x * sc), b = (int)rintf(v.y * sc), c = (int)rintf(v.z * sc), d = (int)rintf(v.w * sc);
    return ((unsigned)a & 0xffu) | (((unsigned)b & 0xffu) << 8) | (((unsigned)c & 0xffu) << 16) | ((unsigned)d << 24);
}
__device__ __forceinline__ void phase_tables(const Args& a, int wave, int lane) {
    const int gw = blockIdx.x * NWAVES + wave, NGW = gridDim.x * NWAVES;
    const float* gf = a.in[I_GFFN] + 16 * lane; unsigned char* uq = a.ws + WS_UB; unsigned char* vq = a.ws + WS_VB; float* su = (float*)(a.ws + WS_SU); float* sv = (float*)(a.ws + WS_SV);
    f32x4 g[4];
#pragma unroll
    for (int j = 0; j < 4; ++j) g[j] = *(const f32x4*)(gf + 4 * j);
    for (int e = gw; e < NEXP; e += NGW) {
        const float* ur = a.in[I_PU] + (size_t)e * DM + 16 * lane; const float* vr = a.in[I_PV] + (size_t)e * DM + 16 * lane;
        f32x4 u[4], v[4]; float mu = 0.f, mv = 0.f;
#pragma unroll
        for (int j = 0; j < 4; ++j) { u[j] = *(const f32x4*)(ur + 4 * j) * g[j]; v[j] = *(const f32x4*)(vr + 4 * j);
            mu = fmaxf(mu, fmaxf(fmaxf(fabsf(u[j].x), fabsf(u[j].y)), fmaxf(fabsf(u[j].z), fabsf(u[j].w))));
            mv = fmaxf(mv, fmaxf(fmaxf(fabsf(v[j].x), fabsf(v[j].y)), fmaxf(fabsf(v[j].z), fabsf(v[j].w)))); }
        mu = wave_max_dpp(mu); mv = wave_max_dpp(mv);
        const float scu = (mu > 0.f) ? 127.0f / mu : 1.0f, du = (mu > 0.f) ? mu * (1.0f / 127.0f) : 1.0f;
        u32x4 qu; qu.x = q8x4(u[0], scu); qu.y = q8x4(u[1], scu); qu.z = q8x4(u[2], scu); qu.w = q8x4(u[3], scu);
        const float scv = (mv > 0.f) ? 127.0f / mv : 1.0f, dv = (mv > 0.f) ? mv * (1.0f / 127.0f) : 1.0f;
        u32x4 qv; qv.x = q8x4(v[0], scv); qv.y = q8x4(v[1], scv); qv.z = q8x4(v[2], scv); qv.w = q8x4(v[3], scv);
        { const size_t so = ((size_t)(lane >> 3) * NEXP + e) * 128 + 16 * (lane & 7); *(u32x4*)(uq + so) = qu; *(u32x4*)(vq + so) = qv; }
        if (lane == 0) { su[e] = du; sv[e] = dv; }
    }
}
__device__ __forceinline__ void ce_desc(float& a, float& b) { const float hi = fmaxf(a, b), lo = fminf(a, b); a = hi; b = lo; }
__device__ __forceinline__ void sort16_desc(float (&x)[16]) {
#pragma unroll
    for (int k = 2; k <= 16; k <<= 1)
#pragma unroll
        for (int j = k >> 1; j > 0; j >>= 1)
#pragma unroll
            for (int i = 0; i < 16; ++i) { const int l = i ^ j; if (l > i) { if ((i & k) == 0) ce_desc(x[i], x[l]); else ce_desc(x[l], x[i]); } }
}
__device__ __forceinline__ void merge_top16(float (&L)[16], const float (&X)[16]) {
#pragma unroll
    for (int i = 0; i < 16; ++i) L[i] = fmaxf(L[i], X[15 - i]);
#pragma unroll
    for (int j = 8; j > 0; j >>= 1)
#pragma unroll
        for (int i = 0; i < 16; ++i) { const int l = i ^ j; if (l > i) ce_desc(L[i], L[l]); }
}
__device__ __forceinline__ void top16_of_128(const _Float16* base  , float (&L)[16]) {
    typedef _Float16 h8 __attribute__((ext_vector_type(8)));
    h8 v0 = *(const h8*)(base), v1 = *(const h8*)(base + 512);
#pragma unroll 1
    for (int ch = 0; ch < 8; ++ch) { float X[16]; const int cn = (ch < 7) ? ch + 1 : 7;
        const h8 n0 = *(const h8*)(base + (2 * cn) * 512), n1 = *(const h8*)(base + (2 * cn + 1) * 512);
#pragma unroll
        for (int i = 0; i < 8; ++i) { X[i] = __uint_as_float((__float_as_uint((float)v0[i]) & ~0x7Fu) | (unsigned)(ch * 16 + i));
            X[8 + i] = __uint_as_float((__float_as_uint((float)v1[i]) & ~0x7Fu) | (unsigned)(ch * 16 + 8 + i)); }
        sort16_desc(X);
        if (ch == 0) {
#pragma unroll
            for (int i = 0; i < 16; ++i) L[i] = X[i]; }
        else merge_top16(L, X);
        v0 = n0; v1 = n1; }
}
struct CandTab { int ci[64], cj[64]; };
__host__ __device__ constexpr CandTab make_cand() { CandTab t{}; int n = 0; for (int i = 0; i < 16; ++i) for (int j = 0; j < 16; ++j) if ((i + 1) * (j + 1) <= 16) { t.ci[n] = i; t.cj[n] = j; ++n; }
    for (; n < 64; ++n) { t.ci[n] = -1; t.cj[n] = -1; } return t; }
__device__ __forceinline__ void phase_topk(const Args& a, LAS unsigned char* lds, const pg8::StaticOrder& S, int wave, int lane) {
    constexpr CandTab CT = make_cand();
    const _Float16* st = (const _Float16*)(a.ws + WS_SCORES); int* eidx = (int*)(a.ws + WS_EIDX); float* eg = (float*)(a.ws + WS_EG);
    LAS unsigned char* tab = lds + wave * (64 * 36) + lane * 36;
    for (int j = wave; ; j += NWAVES) { pg8::Unit un; if (!S.next(j >> 2, un)) break; const int tg = 4 * un.pm + (j & 3), hh = un.pn; const int m = tg * 64 + lane;
        float A[16], B[16];
        top16_of_128(st + (size_t)((tg * 8 + hh) * 2 + 0) * 128 * 64 + lane * 8, A);
        top16_of_128(st + (size_t)((tg * 8 + hh) * 2 + 1) * 128 * 64 + lane * 8, B);
#pragma unroll
        for (int q = 0; q < 4; ++q) {
            const unsigned wa = (__float_as_uint(A[4 * q]) & 0x7Fu) | ((__float_as_uint(A[4 * q + 1]) & 0x7Fu) << 8) | ((__float_as_uint(A[4 * q + 2]) & 0x7Fu) << 16) | ((__float_as_uint(A[4 * q + 3]) & 0x7Fu) << 24);
            const unsigned wb = (__float_as_uint(B[4 * q]) & 0x7Fu) | ((__float_as_uint(B[4 * q + 1]) & 0x7Fu) << 8) | ((__float_as_uint(B[4 * q + 2]) & 0x7Fu) << 16) | ((__float_as_uint(B[4 * q + 3]) & 0x7Fu) << 24);
            *(LAS unsigned*)(tab + 4 * q) = wa; *(LAS unsigned*)(tab + 16 + 4 * q) = wb; }
#pragma unroll
        for (int i = 0; i < 16; ++i) { A[i] = __uint_as_float(__float_as_uint(A[i]) & ~0x7Fu); B[i] = __uint_as_float(__float_as_uint(B[i]) & ~0x7Fu); }
        float K[16];
#pragma unroll
        for (int c0 = 0; c0 < 64; c0 += 16) { float X[16];
#pragma unroll
            for (int i = 0; i < 16; ++i) { const int c = c0 + i;
                if (CT.ci[c] >= 0) X[i] = __uint_as_float((__float_as_uint(A[CT.ci[c] < 0 ? 0 : CT.ci[c]] + B[CT.cj[c] < 0 ? 0 : CT.cj[c]]) & ~0xFFu) | (unsigned)(CT.ci[c] * 16 + CT.cj[c]));
                else X[i] = -INFINITY; }
            sort16_desc(X);
            if (c0 == 0) {
#pragma unroll
                for (int i = 0; i < 16; ++i) K[i] = X[i]; }
            else merge_top16(K, X); }
        asm volatile("s_waitcnt lgkmcnt(0)" ::: "memory");
        int ex_[16]; float cs[16]; float sum = 0.f;
#pragma unroll
        for (int r = 0; r < 16; ++r) { const unsigned kb = __float_as_uint(K[r]); const int id = kb & 0xFF; cs[r] = __expf(__uint_as_float(kb & ~0xFFu) - __uint_as_float(__float_as_uint(K[0]) & ~0xFFu)); sum += cs[r];
            ex_[r] = (int)tab[id >> 4] * 128 + (int)tab[16 + (id & 15)]; }
        const float inv = 1.0f / sum;
        unsigned short* ep = (unsigned short*)eidx + (size_t)m * 128 + hh * 16; float* gp = eg + (size_t)m * 128 + hh * 16;
        { u32x4 p0, p1; p0.x = ex_[0] | (ex_[1] << 16); p0.y = ex_[2] | (ex_[3] << 16); p0.z = ex_[4] | (ex_[5] << 16); p0.w = ex_[6] | (ex_[7] << 16);
          p1.x = ex_[8] | (ex_[9] << 16); p1.y = ex_[10] | (ex_[11] << 16); p1.z = ex_[12] | (ex_[13] << 16); p1.w = ex_[14] | (ex_[15] << 16); *(u32x4*)ep = p0; *(u32x4*)(ep + 8) = p1; }
#pragma unroll
        for (int q = 0; q < 4; ++q) {
            *(f32x4*)(gp + 4 * q) = (f32x4){cs[4 * q] * inv, cs[4 * q + 1] * inv, cs[4 * q + 2] * inv, cs[4 * q + 3] * inv}; }
    }
}
__device__ __forceinline__ void fp8x16_to_f32(const u32x4 w, float (&f)[16]) {
    f32x2v t;
    t = __builtin_amdgcn_cvt_pk_f32_fp8((int)w.x, false); f[0] = t.x; f[1] = t.y; t = __builtin_amdgcn_cvt_pk_f32_fp8((int)w.x, true); f[2] = t.x; f[3] = t.y;
    t = __builtin_amdgcn_cvt_pk_f32_fp8((int)w.y, false); f[4] = t.x; f[5] = t.y; t = __builtin_amdgcn_cvt_pk_f32_fp8((int)w.y, true); f[6] = t.x; f[7] = t.y;
    t = __builtin_amdgcn_cvt_pk_f32_fp8((int)w.z, false); f[8] = t.x; f[9] = t.y; t = __builtin_amdgcn_cvt_pk_f32_fp8((int)w.z, true); f[10] = t.x; f[11] = t.y;
    t = __builtin_amdgcn_cvt_pk_f32_fp8((int)w.w, false); f[12] = t.x; f[13] = t.y; t = __builtin_amdgcn_cvt_pk_f32_fp8((int)w.w, true); f[14] = t.x; f[15] = t.y;
}
__device__ __forceinline__ void fp8x16_to_f32x2(const u32x4 w, f32x2v (&f)[8]) {
    f[0] = __builtin_amdgcn_cvt_pk_f32_fp8((int)w.x, false); f[1] = __builtin_amdgcn_cvt_pk_f32_fp8((int)(w.x >> 16), false);
    f[2] = __builtin_amdgcn_cvt_pk_f32_fp8((int)w.y, false); f[3] = __builtin_amdgcn_cvt_pk_f32_fp8((int)(w.y >> 16), false);
    f[4] = __builtin_amdgcn_cvt_pk_f32_fp8((int)w.z, false); f[5] = __builtin_amdgcn_cvt_pk_f32_fp8((int)(w.z >> 16), false);
    f[6] = __builtin_amdgcn_cvt_pk_f32_fp8((int)w.w, false); f[7] = __builtin_amdgcn_cvt_pk_f32_fp8((int)(w.w >> 16), false);
}
__device__ __forceinline__ float dpp_sum8(float v) {
    v += __int_as_float(__builtin_amdgcn_update_dpp(0, __float_as_int(v), 0xB1, 0xF, 0xF, true));
    v += __int_as_float(__builtin_amdgcn_update_dpp(0, __float_as_int(v), 0x4E, 0xF, 0xF, true));
    v += __int_as_float(__builtin_amdgcn_update_dpp(0, __float_as_int(v), 0x141, 0xF, 0xF, true));
    return v;
}
struct UTok { u32x4 e0, e1, xa, xb; };
struct VTok { u32x4 e0, e1; f32x4 av[4]; };
__device__ __forceinline__ void pu_issue(const unsigned char* tab, unsigned loff, const u32x4& e, u32x4 (&w)[8]) {
    w[0] = *(const u32x4*)(tab + ((e.x & 0xffffu) * 128u + loff)); w[1] = *(const u32x4*)(tab + ((e.x >> 16) * 128u + loff));
    w[2] = *(const u32x4*)(tab + ((e.y & 0xffffu) * 128u + loff)); w[3] = *(const u32x4*)(tab + ((e.y >> 16) * 128u + loff));
    w[4] = *(const u32x4*)(tab + ((e.z & 0xffffu) * 128u + loff)); w[5] = *(const u32x4*)(tab + ((e.z >> 16) * 128u + loff));
    w[6] = *(const u32x4*)(tab + ((e.w & 0xffffu) * 128u + loff)); w[7] = *(const u32x4*)(tab + ((e.w >> 16) * 128u + loff));
}
__device__ __forceinline__ float pu_compute(const int (&xq)[4], const u32x4 (&w)[8], int i) {
    float keep = 0.f;
#pragma unroll
    for (int q = 0; q < 8; ++q) { int d = __builtin_amdgcn_sdot4((int)w[q].x, xq[0], 0, false); d = __builtin_amdgcn_sdot4((int)w[q].y, xq[1], d, false);
        d = __builtin_amdgcn_sdot4((int)w[q].z, xq[2], d, false); d = __builtin_amdgcn_sdot4((int)w[q].w, xq[3], d, false);
        d += __builtin_amdgcn_update_dpp(0, d, 0xB1, 0xF, 0xF, true); d += __builtin_amdgcn_update_dpp(0, d, 0x4E, 0xF, 0xF, true); d += __builtin_amdgcn_update_dpp(0, d, 0x141, 0xF, 0xF, true);
        keep = (q == i) ? (float)d : keep; }
    return keep;
}
__device__ __forceinline__ float pu_quant_x(const u32x4& xa, const u32x4& xb, int (&xq)[4]) {
    float f[16]; unpack8(xa, *(float(*)[8])&f[0]); unpack8(xb, *(float(*)[8])&f[8]);
    float mx = 0.f;
#pragma unroll
    for (int c = 0; c < 16; ++c) mx = fmaxf(mx, fabsf(f[c]));
    mx = fmaxf(mx, __int_as_float(__builtin_amdgcn_update_dpp(0, __float_as_int(mx), 0xB1, 0xF, 0xF, true)));
    mx = fmaxf(mx, __int_as_float(__builtin_amdgcn_update_dpp(0, __float_as_int(mx), 0x4E, 0xF, 0xF, true)));
    mx = fmaxf(mx, __int_as_float(__builtin_amdgcn_update_dpp(0, __float_as_int(mx), 0x141, 0xF, 0xF, true)));
    const float sc = (mx > 0.f) ? 127.0f * __builtin_amdgcn_rcpf(mx) * 0.99999f : 0.f;
#pragma unroll
    for (int c4 = 0; c4 < 4; ++c4) xq[c4] = (int)q8x4((f32x4){f[4 * c4], f[4 * c4 + 1], f[4 * c4 + 2], f[4 * c4 + 3]}, sc);
    return mx * (1.0f / 127.0f);
}
__device__ __forceinline__ void phase_peer_u(const Args& a, int wave, int lane) {
    const int s = SLICE_OF(blockIdx.x), rk = RANK_OF(blockIdx.x), nrk = gridDim.x >> 3, tper = T / nrk, i = lane & 7, j = lane >> 3;
    const bf16_t* h1b = (const bf16_t*)(a.ws + WS_H1B) + 128 * s + 16 * i; const unsigned char* uqs = a.ws + WS_UB + (size_t)s * NEXP * 128; const unsigned loff = 16u * (unsigned)i;
    const unsigned short* eidx = (const unsigned short*)(a.ws + WS_EIDX) + 16 * j; float* pd = (float*)(a.ws + WS_PD) + (size_t)s * T * 128 + 16 * j + i;
    const int m0 = rk * tper + wave, mlast = (rk + 1) * tper - NWAVES + wave;
#define PU_LOAD(t, mm) do { const int m_ = (mm) < mlast ? (mm) : mlast; const u32x4* ep_ = (const u32x4*)(eidx + (size_t)m_ * 128); (t).e0 = ep_[0]; (t).e1 = ep_[1]; \
        (t).xa = *(const u32x4*)(h1b + (size_t)m_ * DM); (t).xb = *(const u32x4*)(h1b + (size_t)m_ * DM + 8); } while (0)
#define PU_DO(t, w0, w1, mm) do { int xq_[4]; const float sx_ = pu_quant_x((t).xa, (t).xb, xq_); \
        const float k0_ = pu_compute(xq_, w0, i) * sx_, k1_ = pu_compute(xq_, w1, i) * sx_; pd[(size_t)(mm) * 128] = k0_; pd[(size_t)(mm) * 128 + 8] = k1_; } while (0)
    UTok tC, tN, tNN; u32x4 wA[8], wB[8], wC[8], wD[8];
    PU_LOAD(tC, m0); PU_LOAD(tN, m0 + NWAVES); PU_LOAD(tNN, m0 + 2 * NWAVES); pu_issue(uqs, loff, tC.e0, wA); pu_issue(uqs, loff, tC.e1, wB);
    for (int m = m0; m <= mlast; m += 2 * NWAVES) {
        pu_issue(uqs, loff, tN.e0, wC); pu_issue(uqs, loff, tN.e1, wD);
        PU_DO(tC, wA, wB, m);
        tC = tN; tN = tNN; PU_LOAD(tNN, m + 3 * NWAVES);
        pu_issue(uqs, loff, tN.e0, wA); pu_issue(uqs, loff, tN.e1, wB);
        PU_DO(tC, wC, wD, m + NWAVES);
        tC = tN; tN = tNN; PU_LOAD(tNN, m + 4 * NWAVES);
    }
#undef PU_LOAD
#undef PU_DO
}
typedef long i64_t;
__device__ __forceinline__ i64_t pack64(unsigned lo, unsigned hi) { return (i64_t)(((unsigned long long)hi << 32) | (unsigned long long)lo); }
struct MTokI { u32x4 ia, ib; };
struct MTokX { u32x4 xq[4]; };
__device__ __forceinline__ unsigned id16(const u32x4& v, int c) { const unsigned wv = (c >> 1) == 0 ? v.x : (c >> 1) == 1 ? v.y : (c >> 1) == 2 ? v.z : v.w; return (c & 1) ? (wv >> 16) : (wv & 0xffffu); }
__device__ __forceinline__ void pm_issue(const unsigned char* tab, unsigned loff, const MTokI& t, u32x4 (&W)[16]) {
#pragma unroll
    for (int c = 0; c < 8; ++c) { W[2 * c] = *(const u32x4*)(tab + (id16(t.ia, c) * 128u + loff)); W[2 * c + 1] = *(const u32x4*)(tab + (id16(t.ib, c) * 128u + loff)); }
}
template <bool HI> __device__ __forceinline__ unsigned bf2_to_fp8x2(unsigned w, int old) { const float a = fminf(fmaxf(bflo(w), -448.f), 448.f), b = fminf(fmaxf(bfhi(w), -448.f), 448.f); return (unsigned)__builtin_amdgcn_cvt_pk_fp8_f32(a, b, old, HI); }
__device__ __forceinline__ void pm_compute(const MTokX& t, const u32x4 (&W)[16], LAS unsigned char* wl  , float* pdrow  , int lane) {
    unsigned xb[8];
#pragma unroll
    for (int q = 0; q < 4; ++q) { unsigned lo = bf2_to_fp8x2<false>(t.xq[q].x, 0); lo = bf2_to_fp8x2<true>(t.xq[q].y, (int)lo); unsigned hi = bf2_to_fp8x2<false>(t.xq[q].z, 0); hi = bf2_to_fp8x2<true>(t.xq[q].w, (int)hi); xb[2 * q] = lo; xb[2 * q + 1] = hi; }
    const i64_t B0 = pack64(xb[0], xb[1]), B1 = pack64(xb[2], xb[3]), B2 = pack64(xb[4], xb[5]), B3 = pack64(xb[6], xb[7]);
    const int j8 = lane >> 3, i = lane & 7, r = lane & 15, g = lane >> 4;
    LAS unsigned char* wr0 = wl + j8 * 144 + i * 16;
    const LAS unsigned char* rd0 = wl + r * 144 + g * 32;
    f32x4 C[8];
#pragma unroll
    for (int c = 0; c < 8; ++c) { const int bo = (c & 1) * 2304;
        *(LAS u32x4*)(wr0 + bo) = W[2 * c]; *(LAS u32x4*)(wr0 + bo + 8 * 144) = W[2 * c + 1];
        const u32x4 a0 = *(const LAS u32x4*)(rd0 + bo), a1 = *(const LAS u32x4*)(rd0 + bo + 16);
        f32x4 acc = (f32x4){0.f, 0.f, 0.f, 0.f};
        acc = __builtin_amdgcn_mfma_f32_16x16x32_fp8_fp8(pack64(a0.x, a0.y), B0, acc, 0, 0, 0);
        acc = __builtin_amdgcn_mfma_f32_16x16x32_fp8_fp8(pack64(a0.z, a0.w), B1, acc, 0, 0, 0);
        acc = __builtin_amdgcn_mfma_f32_16x16x32_fp8_fp8(pack64(a1.x, a1.y), B2, acc, 0, 0, 0);
        acc = __builtin_amdgcn_mfma_f32_16x16x32_fp8_fp8(pack64(a1.z, a1.w), B3, acc, 0, 0, 0); C[c] = acc; }
    if ((lane & 15) == 0) {
#pragma unroll
        for (int reg = 0; reg < 4; ++reg) { *(f32x4*)(pdrow + 8 * reg) = (f32x4){C[0][reg], C[1][reg], C[2][reg], C[3][reg]}; *(f32x4*)(pdrow + 8 * reg + 4) = (f32x4){C[4][reg], C[5][reg], C[6][reg], C[7][reg]}; } }
}
__device__ __forceinline__ void phase_peer_u_mfma(const Args& a, LAS unsigned char* lds, int wave, int lane) {
    const int s = SLICE_OF(blockIdx.x), rk = RANK_OF(blockIdx.x), nrk = gridDim.x >> 3, tper = T / nrk, g = lane >> 4, j8 = lane >> 3;
    const bf16_t* h1b = (const bf16_t*)(a.ws + WS_H1B) + 128 * s + 32 * g; const unsigned char* uqs = a.ws + WS_UB + (size_t)s * NEXP * 128; const unsigned loff = 16u * (unsigned)(lane & 7);
    const unsigned short* eidx = (const unsigned short*)(a.ws + WS_EIDX) + 8 * j8; float* pd = (float*)(a.ws + WS_PD) + (size_t)s * T * 128 + 32 * g;
    LAS unsigned char* wl = lds + wave * 4608;
    const int m0 = rk * tper + wave, mlast = (rk + 1) * tper - NWAVES + wave;
#define PM_LOADI(t, mm) do { const int m_ = (mm) < mlast ? (mm) : mlast; (t).ia = *(const u32x4*)(eidx + (size_t)m_ * 128); (t).ib = *(const u32x4*)(eidx + (size_t)m_ * 128 + 64); } while (0)
#define PM_LOADX(t, mm) do { const int m_ = (mm) < mlast ? (mm) : mlast; const u32x4* xp_ = (const u32x4*)(h1b + (size_t)m_ * DM); (t).xq[0] = xp_[0]; (t).xq[1] = xp_[1]; (t).xq[2] = xp_[2]; (t).xq[3] = xp_[3]; } while (0)
    MTokI iC, iN, iNN; MTokX xC, xN; u32x4 WA[16], WB[16];
    PM_LOADI(iC, m0); PM_LOADI(iN, m0 + NWAVES); PM_LOADI(iNN, m0 + 2 * NWAVES); PM_LOADX(xC, m0); PM_LOADX(xN, m0 + NWAVES); pm_issue(uqs, loff, iC, WA);
    for (int m = m0; m <= mlast; m += 2 * NWAVES) {
        pm_issue(uqs, loff, iN, WB);
        pm_compute(xC, WA, wl, pd + (size_t)m * 128, lane);
        iC = iN; iN = iNN; PM_LOADI(iNN, m + 3 * NWAVES); xC = xN; PM_LOADX(xN, m + 2 * NWAVES);
        pm_issue(uqs, loff, iN, WA);
        pm_compute(xC, WB, wl, pd + (size_t)(m + NWAVES) * 128, lane);
        iC = iN; iN = iNN; PM_LOADI(iNN, m + 4 * NWAVES); xC = xN; PM_LOADX(xN, m + 3 * NWAVES);
    }
#undef PM_LOADI
#undef PM_LOADX
}
__device__ __forceinline__ void phase_peer_act(const Args& a, int tid) {
    const float* pd = (const float*)(a.ws + WS_PD); const unsigned short* eidx = (const unsigned short*)(a.ws + WS_EIDX); const float* eg = (const float*)(a.ws + WS_EG);
    const float* su = (const float*)(a.ws + WS_SU); const float* sv = (const float*)(a.ws + WS_SV); const float* rowss = (const float*)(a.ws + WS_ROWSS); float* act = (float*)(a.ws + WS_ACT);
    for (size_t i4 = (size_t)blockIdx.x * NTHR + tid; i4 < (size_t)T * 32; i4 += (size_t)gridDim.x * NTHR) { const size_t idx = i4 * 4;
        f32x4 d = *(const f32x4*)(pd + idx);
#pragma unroll
        for (int s = 1; s < 8; ++s) d += *(const f32x4*)(pd + (size_t)s * T * 128 + idx);
        const u32x2 ew = *(const u32x2*)(eidx + idx); const f32x4 g = *(const f32x4*)(eg + idx); const float rstd = rsqrtf(rowss[idx >> 7] * (1.f / DM) + EPSF);
        const unsigned e0 = ew.x & 0xffffu, e1 = ew.x >> 16, e2 = ew.y & 0xffffu, e3 = ew.y >> 16;
        f32x4 o; o.x = gelu_tanh(d.x * su[e0] * rstd) * g.x * sv[e0]; o.y = gelu_tanh(d.y * su[e1] * rstd) * g.y * sv[e1];
        o.z = gelu_tanh(d.z * su[e2] * rstd) * g.z * sv[e2]; o.w = gelu_tanh(d.w * su[e3] * rstd) * g.w * sv[e3];
        *(f32x4*)(act + idx) = o;
    }
}
__device__ __forceinline__ void pv_quad(const u32x4& w0, const u32x4& w1, const u32x4& w2, const u32x4& w3, int a4, int (&oi)[16]) {
#define PV_BLK(d, base) do { const unsigned lo01 = __builtin_amdgcn_perm(w1.d, w0.d, 0x05010400u), hi01 = __builtin_amdgcn_perm(w1.d, w0.d, 0x07030602u); \
        const unsigned lo23 = __builtin_amdgcn_perm(w3.d, w2.d, 0x05010400u), hi23 = __builtin_amdgcn_perm(w3.d, w2.d, 0x07030602u); \
        oi[base + 0] = __builtin_amdgcn_sdot4((int)__builtin_amdgcn_perm(lo23, lo01, 0x05040100u), a4, oi[base + 0], false); \
        oi[base + 1] = __builtin_amdgcn_sdot4((int)__builtin_amdgcn_perm(lo23, lo01, 0x07060302u), a4, oi[base + 1], false); \
        oi[base + 2] = __builtin_amdgcn_sdot4((int)__builtin_amdgcn_perm(hi23, hi01, 0x05040100u), a4, oi[base + 2], false); \
        oi[base + 3] = __builtin_amdgcn_sdot4((int)__builtin_amdgcn_perm(hi23, hi01, 0x07060302u), a4, oi[base + 3], false); } while (0)
    PV_BLK(x, 0); PV_BLK(y, 4); PV_BLK(z, 8); PV_BLK(w, 12);
#undef PV_BLK
}
__device__ __forceinline__ float pv_quant_act(const f32x4 (&av)[4], int (&a4)[4]) {
    float mx = 0.f;
#pragma unroll
    for (int q = 0; q < 4; ++q) mx = fmaxf(mx, fmaxf(fmaxf(fabsf(av[q].x), fabsf(av[q].y)), fmaxf(fabsf(av[q].z), fabsf(av[q].w))));
    const float sc = (mx > 0.f) ? 127.0f * __builtin_amdgcn_rcpf(mx) * 0.99999f : 0.f;
#pragma unroll
    for (int q = 0; q < 4; ++q) a4[q] = (int)q8x4(av[q], sc);
    return mx * (1.0f / 127.0f);
}
__device__ __forceinline__ void pv_finish(const int (&oi)[16], float sa, bf16_t* orow  , int lane) {
    float o[16];
#pragma unroll
    for (int c = 0; c < 16; ++c) o[c] = (float)oi[c] * sa;
    const bool b3 = (lane & 8) != 0, b4 = (lane & 16) != 0, b5 = (lane & 32) != 0;
    float k8[8], k4[4], k2[2];
#pragma unroll
    for (int c = 0; c < 8; ++c) { const float snd = b3 ? o[c] : o[8 + c], kp = b3 ? o[8 + c] : o[c]; k8[c] = kp + dpp_xor8(snd); }
#pragma unroll
    for (int c = 0; c < 4; ++c) { const float snd = b4 ? k8[c] : k8[4 + c], kp = b4 ? k8[4 + c] : k8[c]; k4[c] = kp + __shfl_xor(snd, 16); }
#pragma unroll
    for (int c = 0; c < 2; ++c) { const float snd = b5 ? k4[c] : k4[2 + c], kp = b5 ? k4[2 + c] : k4[c]; k2[c] = kp + __shfl_xor(snd, 32); }
    *(unsigned*)(orow + ((lane & 8) ? 8 : 0) + ((lane & 16) ? 4 : 0) + ((lane & 32) ? 2 : 0)) = pk2(k2[0], k2[1]);
}
__device__ __forceinline__ void phase_peer_v(const Args& a, int wave, int lane) {
    const int s = SLICE_OF(blockIdx.x), rk = RANK_OF(blockIdx.x), nrk = gridDim.x >> 3, tper = T / nrk, i = lane & 7, j = lane >> 3;
    const unsigned char* vqs = a.ws + WS_VB + (size_t)s * NEXP * 128; const unsigned loff = 16u * (unsigned)i;
    const unsigned short* eidx = (const unsigned short*)(a.ws + WS_EIDX) + 16 * j; const float* act = (const float*)(a.ws + WS_ACT) + 16 * j;
    bf16_t* obase = (bf16_t*)(a.ws + WS_PO) + 128 * s + 16 * i;
    const int m0 = rk * tper + wave, mlast = (rk + 1) * tper - NWAVES + wave;
#define PV_LOAD(t, mm) do { const int m_ = (mm) < mlast ? (mm) : mlast; const u32x4* ep_ = (const u32x4*)(eidx + (size_t)m_ * 128); const f32x4* ap_ = (const f32x4*)(act + (size_t)m_ * 128); \
        (t).e0 = ep_[0]; (t).e1 = ep_[1]; (t).av[0] = ap_[0]; (t).av[1] = ap_[1]; (t).av[2] = ap_[2]; (t).av[3] = ap_[3]; } while (0)
    VTok tC, tN, tNN; u32x4 wA[8], wB[8];
    PV_LOAD(tC, m0); PV_LOAD(tN, m0 + NWAVES); PV_LOAD(tNN, m0 + 2 * NWAVES); pu_issue(vqs, loff, tC.e0, wA);
    for (int m = m0; m <= mlast; m += NWAVES) {
        pu_issue(vqs, loff, tC.e1, wB);
        int oi_[16];
#pragma unroll
        for (int c = 0; c < 16; ++c) oi_[c] = 0;
        int a4_[4]; const float sa_ = pv_quant_act(tC.av, a4_);
        pv_quad(wA[0], wA[1], wA[2], wA[3], a4_[0], oi_); pv_quad(wA[4], wA[5], wA[6], wA[7], a4_[1], oi_);
        pu_issue(vqs, loff, tN.e0, wA);
        pv_quad(wB[0], wB[1], wB[2], wB[3], a4_[2], oi_); pv_quad(wB[4], wB[5], wB[6], wB[7], a4_[3], oi_);
        pv_finish(oi_, sa_, obase + (size_t)m * DM, lane);
        tC = tN; tN = tNN; PV_LOAD(tNN, m + 3 * NWAVES);
    }
#undef PV_LOAD
}
__device__ __forceinline__ void phase_final(const Args& a, int wave, int lane) {
    const int gw = blockIdx.x * NWAVES + wave, NGW = gridDim.x * NWAVES; const bf16_t* po = (const bf16_t*)(a.ws + WS_PO) + 16 * lane; const bf16_t* h1b = (const bf16_t*)(a.ws + WS_H1B) + 16 * lane;
    f32x4 gf[4];
#pragma unroll
    for (int jj = 0; jj < 4; ++jj) gf[jj] = *(const f32x4*)(a.in[I_GFINAL] + 16 * lane + 4 * jj);
    for (int m0 = gw; m0 < T; m0 += 4 * NGW) {
        u32x4 hq[4][2], pq[4][2];
#pragma unroll
        for (int r = 0; r < 4; ++r) { const int m = (m0 + r * NGW < T) ? m0 + r * NGW : m0;
            hq[r][0] = *(const u32x4*)(h1b + (size_t)m * DM); hq[r][1] = *(const u32x4*)(h1b + (size_t)m * DM + 8); pq[r][0] = *(const u32x4*)(po + (size_t)m * DM); pq[r][1] = *(const u32x4*)(po + (size_t)m * DM + 8); }
#pragma unroll
        for (int r = 0; r < 4; ++r) { const int m = m0 + r * NGW; if (m >= T) break;
            float hb[16], pp[16]; unpack8(hq[r][0], *(float(*)[8])&hb[0]); unpack8(hq[r][1], *(float(*)[8])&hb[8]); unpack8(pq[r][0], *(float(*)[8])&pp[0]); unpack8(pq[r][1], *(float(*)[8])&pp[8]);
            f32x4 h[4]; float ss = 0.f;
#pragma unroll
            for (int jj = 0; jj < 4; ++jj) { h[jj] = (f32x4){hb[4 * jj] + pp[4 * jj], hb[4 * jj + 1] + pp[4 * jj + 1], hb[4 * jj + 2] + pp[4 * jj + 2], hb[4 * jj + 3] + pp[4 * jj + 3]};
                ss += (h[jj].x * h[jj].x + h[jj].y * h[jj].y) + (h[jj].z * h[jj].z + h[jj].w * h[jj].w); }
            const float r2 = rsqrtf(wave_sum_dpp(ss) * (1.f / DM) + EPSF);
            float* orow = a.out + (size_t)m * DM + 16 * lane;
#pragma unroll
            for (int jj = 0; jj < 4; ++jj) *(f32x4*)(orow + 4 * jj) = h[jj] * r2 * gf[jj]; }
    }
}
typedef short bf16x8_t __attribute__((ext_vector_type(8)));
__device__ __forceinline__ bf16x8_t toep_frag(const LAS unsigned* R32, int base) {
    const int e = base >> 1, sh = (base & 1) * 16;
    const unsigned d0 = R32[e], d1 = R32[e + 1], d2 = R32[e + 2], d3 = R32[e + 3], d4 = R32[e + 4];
    u32x4 o; o.x = __builtin_amdgcn_alignbit(d1, d0, sh); o.y = __builtin_amdgcn_alignbit(d2, d1, sh); o.z = __builtin_amdgcn_alignbit(d3, d2, sh); o.w = __builtin_amdgcn_alignbit(d4, d3, sh);
    return __builtin_bit_cast(bf16x8_t, o);
}
__device__ __forceinline__ void hy_conv_channel(const Args& a, LAS unsigned char* lds, int c, int tid, int wave, int lane) {
    constexpr int UROW = SP * 2;
    LAS unsigned char* uus = lds;
    LAS unsigned short* R = (LAS unsigned short*)(lds + 8 * UROW);
    const bf16_t* uut = (const bf16_t*)(a.ws + WS_UUT); const bf16_t* kfb = (const bf16_t*)(a.ws + WS_KFB); bf16_t* cvt = (bf16_t*)(a.ws + WS_CONVT);
    { const u32x4* src = (const u32x4*)(uut + (size_t)c * NB * SP); for (int i = tid; i < 8 * UROW / 16; i += NTHR) ((LAS u32x4*)uus)[i] = src[i]; }
    for (int n = tid; n < KFW + 16; n += NTHR) R[n] = (n < KFW) ? kfb[(size_t)c * KFW + (KFW - 1) - n] : (unsigned short)0;
    __syncthreads();
    const LAS unsigned* R32 = (const LAS unsigned*)R;
    const int i = lane & 15, g = lane >> 4, p = (lane >> 3) & 1, b = lane & 7;
    f32x4 C[16]; bf16x8_t A[16];
    const int abase = LT - 32 * (1 + 16 * wave) - i + 8 * g;
#pragma unroll
    for (int tb = 0; tb < 16; ++tb) { C[tb] = (f32x4){0.f, 0.f, 0.f, 0.f}; A[tb] = toep_frag(R32, abase - 32 * tb); }
    const LAS unsigned char* bptr = uus + b * UROW + (16 * p + 8 * g) * 2;
#define HC_STEP(ph, n) do { A[(16 - (ph)) & 15] = toep_frag(R32, abase + 32 * (n)); const bf16x8_t Bf = *(const LAS bf16x8_t*)(bptr + (n) * 64); \
        _Pragma("unroll") for (int tb = 0; tb < 16; ++tb) C[tb] = __builtin_amdgcn_mfma_f32_16x16x32_bf16(A[(tb - (ph)) & 15], Bf, C[tb], 0, 0, 0); __builtin_amdgcn_sched_barrier(0); } while (0)
    for (int G = 0; G < 8; ++G) { const int n0 = G * 16;
        HC_STEP(0, n0); HC_STEP(1, n0 + 1); HC_STEP(2, n0 + 2); HC_STEP(3, n0 + 3); HC_STEP(4, n0 + 4); HC_STEP(5, n0 + 5); HC_STEP(6, n0 + 6); HC_STEP(7, n0 + 7);
        HC_STEP(8, n0 + 8); HC_STEP(9, n0 + 9); HC_STEP(10, n0 + 10); HC_STEP(11, n0 + 11); HC_STEP(12, n0 + 12); HC_STEP(13, n0 + 13); HC_STEP(14, n0 + 14); HC_STEP(15, n0 + 15); }
    HC_STEP(0, 128);
#undef HC_STEP
#pragma unroll
    for (int tb = 0; tb < 16; ++tb) { const int tq = 512 * wave + 32 * tb + 16 * p + 4 * g;
        u32x2 w; w.x = pk2(C[tb][0], C[tb][1]); w.y = pk2(C[tb][2], C[tb][3]);
        *(u32x2*)(cvt + ((size_t)c * NB + b) * SEQ + tq) = w; }
    __syncthreads();
}
__device__ __forceinline__ void rg_item(const Args& a, LAS unsigned char* lds, int it, int tid, int wave, int lane) {
    constexpr int XROW = 272;
    const int head = it & 7, dir = (it >> 3) & 1, b = it >> 4;
    const bf16_t* xb = (const bf16_t*)(a.ws + WS_RGX) + (size_t)b * LT * DRG + head * 128;
    bf16_t* hout = (bf16_t*)a.out + (size_t)dir * T * DRG + (size_t)b * SEQ * DRG + head * 128 + 16 * wave + (lane & 15);
    const int col = lane & 15, g = lane >> 4, ch = head * 128 + 16 * wave + col;
    LAS unsigned char* wl = lds + 2 * 64 * XROW + wave * 1024 + lane * 16;
#pragma unroll
    for (int gt = 0; gt < 2; ++gt)
#pragma unroll
        for (int ks = 0; ks < 4; ++ks) { const float* wp = a.in[I_RGGW] + ((size_t)((dir * 2 + gt) * 8 + head) * 128 + 32 * ks + 8 * g) * 128 + 16 * wave + col;
            u32x4 o; o.x = pk2(wp[0], wp[128]); o.y = pk2(wp[256], wp[384]); o.z = pk2(wp[512], wp[640]); o.w = pk2(wp[768], wp[896]); *(LAS u32x4*)(wl + (gt * 4 + ks) * 8192) = o; }
    const float br = a.in[I_RGGB][(size_t)(dir * 2 + 0) * DRG + ch], bi = a.in[I_RGGB][(size_t)(dir * 2 + 1) * DRG + ch];
    const float sp8 = -8.0f * log1pf(__expf(-a.in[I_RGLAM][dir * DRG + ch]));
    const int ctr = tid >> 4, ccg = tid & 15;
    float cwv[4][8], cbv[8];
#pragma unroll
    for (int i = 0; i < 8; ++i) { cbv[i] = a.in[I_RGCB][(size_t)dir * DRG + head * 128 + 8 * ccg + i];
#pragma unroll
        for (int j = 0; j < 4; ++j) cwv[j][i] = a.in[I_RGCW][((size_t)dir * 4 + j) * DRG + head * 128 + 8 * ccg + i]; }
    u32x4 xr[2][4];
#define RG_LOAD(k) do { _Pragma("unroll") for (int h_ = 0; h_ < 2; ++h_) { const int u_ = 64 * (k) + ctr + 32 * h_; _Pragma("unroll") for (int j = 0; j < 4; ++j) { const int uu_ = u_ - j; \
        if (uu_ >= 0 && uu_ < LT) { const int t_ = dir ? (LT - 1 - uu_) : uu_; xr[h_][j] = *(const u32x4*)(xb + (size_t)t_ * DRG + 8 * ccg); } \
        else xr[h_][j] = (u32x4){0u, 0u, 0u, 0u}; } } } while (0)
#define RG_CONV(k) do { _Pragma("unroll") for (int h_ = 0; h_ < 2; ++h_) { const int u_ = 64 * (k) + ctr + 32 * h_; float o_[8]; _Pragma("unroll") for (int i = 0; i < 8; ++i) o_[i] = (u_ < LT) ? cbv[i] : 0.f; \
        _Pragma("unroll") for (int j = 0; j < 4; ++j) { float f_[8]; unpack8(xr[h_][j], f_); _Pragma("unroll") for (int i = 0; i < 8; ++i) o_[i] += f_[i] * cwv[j][i]; } \
        u32x4 w0_; w0_.x = pk2(o_[0], o_[1]); w0_.y = pk2(o_[2], o_[3]); w0_.z = pk2(o_[4], o_[5]); w0_.w = pk2(o_[6], o_[7]); \
        *(LAS u32x4*)(lds + ((k) & 1) * (64 * XROW) + (ctr + 32 * h_) * XROW + ccg * 16) = w0_; } } while (0)
    RG_LOAD(0); RG_CONV(0); RG_LOAD(1);
    __syncthreads();
    float carry = 0.f;
    const int arow = 16 * (col >> 2) + (col & 3);
    for (int k = 0; k < 65; ++k) {
        if (k + 1 < 65) RG_CONV(k + 1);
        if (k + 2 < 65) RG_LOAD(k + 2);
        const LAS unsigned char* xa = lds + (k & 1) * (64 * XROW);
        unsigned hp[16]; float hh = 0.f, PP = 1.f;
#pragma unroll
        for (int mp = 0; mp < 2; ++mp) {
            f32x4 acc[2][2];
#pragma unroll
            for (int m2 = 0; m2 < 2; ++m2) { const int mb = 2 * mp + m2; acc[0][m2] = (f32x4){0.f, 0.f, 0.f, 0.f}; acc[1][m2] = (f32x4){0.f, 0.f, 0.f, 0.f};
#pragma unroll
                for (int ks = 0; ks < 4; ++ks) { const bf16x8_t Af = *(const LAS bf16x8_t*)(xa + (arow + 4 * mb) * XROW + (32 * ks + 8 * g) * 2);
                    acc[0][m2] = __builtin_amdgcn_mfma_f32_16x16x32_bf16(Af, *(const LAS bf16x8_t*)(wl + ks * 8192), acc[0][m2], 0, 0, 0);
                    acc[1][m2] = __builtin_amdgcn_mfma_f32_16x16x32_bf16(Af, *(const LAS bf16x8_t*)(wl + (4 + ks) * 8192), acc[1][m2], 0, 0, 0); } }
#pragma unroll
            for (int m2 = 0; m2 < 2; ++m2)
#pragma unroll
                for (int r = 0; r < 4; ++r) { const int e = 8 * mp + 4 * m2 + r, tau = 16 * g + e, u = 64 * k + tau;
                    const float rr = sigmoidf_(acc[0][m2][r] + br), ii = sigmoidf_(acc[1][m2][r] + bi);
                    float av = fexp(sp8 * rr); float mult = __builtin_amdgcn_sqrtf(fmaxf(1.0f - av * av, 0.f)); mult = (u == 0) ? 1.0f : mult;
                    const float xcv = bf2f(*(const LAS unsigned short*)(xa + tau * XROW + (16 * wave + col) * 2));
                    float bq = mult * ii * xcv; if (u >= LT) { av = 1.f; bq = 0.f; }
                    hh = av * hh + bq; PP *= av; hp[e] = pk2(hh, PP); }
        }
        float Pg[4], hg[4];
#pragma unroll
        for (int q = 0; q < 4; ++q) { Pg[q] = __shfl(PP, col + 16 * q); hg[q] = __shfl(hh, col + 16 * q); }
        const float H0 = carry, H1 = Pg[0] * H0 + hg[0], H2 = Pg[1] * H1 + hg[1], H3 = Pg[2] * H2 + hg[2], H4 = Pg[3] * H3 + hg[3];
        const float Hin = (g == 0) ? H0 : (g == 1) ? H1 : (g == 2) ? H2 : H3;
        carry = H4;
#pragma unroll
        for (int e = 0; e < 16; ++e) { const int u = 64 * k + 16 * g + e; const int t = dir ? (LT - 1 - u) : u;
            if (u < LT && t >= NMETA) hout[(size_t)(t - NMETA) * DRG] = (bf16_t)f2bf(bflo(hp[e]) + bfhi(hp[e]) * Hin); }
        __syncthreads();
    }
#undef RG_LOAD
#undef RG_CONV
}
__device__ __forceinline__ void rg_item2(const Args& a, LAS unsigned char* lds, int it, int tid, int wave, int lane) {
    constexpr int XROW = 272;
    const int hh = it & 1, head = (it >> 1) & 7, dir = (it >> 4) & 1, b = it >> 5;
    const bf16_t* xb = (const bf16_t*)(a.ws + WS_RGX) + (size_t)b * LT * DRG + head * 128;
    const int col = lane & 15, g = lane >> 4, gate = col >> 3, cj = col & 7, chl = 64 * hh + 8 * wave + cj, ch = head * 128 + chl, qg = 2 * g + gate;
    bf16_t* hout = (bf16_t*)a.out + (size_t)dir * T * DRG + (size_t)b * SEQ * DRG + ch;
    bf16x8_t Wf[4];
#pragma unroll
    for (int ks = 0; ks < 4; ++ks) { const float* wp = a.in[I_RGGW] + ((size_t)((dir * 2 + gate) * 8 + head) * 128 + 32 * ks + 8 * g) * 128 + chl;
        u32x4 o; o.x = pk2(wp[0], wp[128]); o.y = pk2(wp[256], wp[384]); o.z = pk2(wp[512], wp[640]); o.w = pk2(wp[768], wp[896]); Wf[ks] = __builtin_bit_cast(bf16x8_t, o); }
    const float LOG2E = 1.4426950408889634f;
    const float bgl = a.in[I_RGGB][(size_t)(dir * 2 + gate) * DRG + ch] * LOG2E;
    const float sp8l = -8.0f * log1pf(__expf(-a.in[I_RGLAM][dir * DRG + ch])) * LOG2E;
    const int ctr = tid >> 4, ccg = tid & 15;
    float cwv[4][8], cbv[8];
#pragma unroll
    for (int i = 0; i < 8; ++i) { cbv[i] = a.in[I_RGCB][(size_t)dir * DRG + head * 128 + 8 * ccg + i];
#pragma unroll
        for (int j = 0; j < 4; ++j) cwv[j][i] = a.in[I_RGCW][((size_t)dir * 4 + j) * DRG + head * 128 + 8 * ccg + i]; }
    u32x4 xr[2][4];
#define RG_LOAD(k) do { _Pragma("unroll") for (int h_ = 0; h_ < 2; ++h_) { const int u_ = 64 * (k) + ctr + 32 * h_; _Pragma("unroll") for (int j = 0; j < 4; ++j) { const int uu_ = u_ - j; \
        if (uu_ >= 0 && uu_ < LT) { const int t_ = dir ? (LT - 1 - uu_) : uu_; xr[h_][j] = *(const u32x4*)(xb + (size_t)t_ * DRG + 8 * ccg); } \
        else xr[h_][j] = (u32x4){0u, 0u, 0u, 0u}; } } } while (0)
#define RG_CONV(k) do { _Pragma("unroll") for (int h_ = 0; h_ < 2; ++h_) { const int u_ = 64 * (k) + ctr + 32 * h_; float o_[8]; _Pragma("unroll") for (int i = 0; i < 8; ++i) o_[i] = (u_ < LT) ? cbv[i] : 0.f; \
        _Pragma("unroll") for (int j = 0; j < 4; ++j) { float f_[8]; unpack8(xr[h_][j], f_); _Pragma("unroll") for (int i = 0; i < 8; ++i) o_[i] += f_[i] * cwv[j][i]; } \
        u32x4 w0_; w0_.x = pk2(o_[0], o_[1]); w0_.y = pk2(o_[2], o_[3]); w0_.z = pk2(o_[4], o_[5]); w0_.w = pk2(o_[6], o_[7]); \
        *(LAS u32x4*)(lds + ((k) & 1) * (64 * XROW) + (ctr + 32 * h_) * XROW + ccg * 16) = w0_; } } while (0)
    RG_LOAD(0); RG_CONV(0); RG_LOAD(1);
    __syncthreads();
    float carry = 0.f;
    const int arow = 16 * (col >> 2) + (col & 3);
    for (int k = 0; k < 65; ++k) {
        if (k + 1 < 65) RG_CONV(k + 1);
        if (k + 2 < 65) RG_LOAD(k + 2);
        const LAS unsigned char* xa = lds + (k & 1) * (64 * XROW);
        f32x4 acc[4];
#pragma unroll
        for (int mb = 0; mb < 4; ++mb) { acc[mb] = (f32x4){0.f, 0.f, 0.f, 0.f};
#pragma unroll
            for (int ks = 0; ks < 4; ++ks) acc[mb] = __builtin_amdgcn_mfma_f32_16x16x32_bf16(*(const LAS bf16x8_t*)(xa + (arow + 4 * mb) * XROW + (32 * ks + 8 * g) * 2), Wf[ks], acc[mb], 0, 0, 0); }
        float sg[16], ot[16];
#pragma unroll
        for (int e = 0; e < 16; ++e) { sg[e] = __builtin_amdgcn_rcpf(1.0f + __builtin_amdgcn_exp2f(-(acc[e >> 2][e & 3] * LOG2E + bgl))); ot[e] = dpp_xor8(sg[e]); }
        unsigned hp[8]; float hs = 0.f, PP = 1.f;
#pragma unroll
        for (int t = 0; t < 8; ++t) { const float rr = gate ? ot[8 + t] : sg[t], ii = gate ? sg[8 + t] : ot[t]; const int tau = 8 * qg + t, u = 64 * k + tau;
            float av = __builtin_amdgcn_exp2f(sp8l * rr); float mult = __builtin_amdgcn_sqrtf(fmaxf(1.0f - av * av, 0.f)); mult = (u == 0) ? 1.0f : mult;
            const float xcv = bf2f(*(const LAS unsigned short*)(xa + tau * XROW + chl * 2));
            float bq = mult * ii * xcv; if (u >= LT) { av = 1.f; bq = 0.f; }
            hs = av * hs + bq; PP *= av; hp[t] = pk2(hs, PP); }
        float H = carry, Hin = carry;
#pragma unroll
        for (int q = 0; q < 8; ++q) { const int src = cj + 8 * (q & 1) + 16 * (q >> 1); const float Pq = __shfl(PP, src), hq = __shfl(hs, src);
            Hin = (qg == q) ? H : Hin; H = Pq * H + hq; }
        carry = H;
#pragma unroll
        for (int t = 0; t < 8; ++t) { const int u = 64 * k + 8 * qg + t; const int tt = dir ? (LT - 1 - u) : u;
            if (u < LT && tt >= NMETA) hout[(size_t)(tt - NMETA) * DRG] = (bf16_t)f2bf(bflo(hp[t]) + bfhi(hp[t]) * Hin); }
        __syncthreads();
    }
#undef RG_LOAD
#undef RG_CONV
}

__device__ __forceinline__ int rg_lds_off(int row, int chunk) { return row * 320 + (((chunk + 2 * (row >> 4)) & 15) << 4); }
__device__ __forceinline__ void rg_item3(const Args& a, LAS unsigned char* lds, int it, int tid, int wave, int lane) {
    constexpr int XT = 64 * 320;
    const int th = it & 1, head = (it >> 1) & 7, dir = (it >> 4) & 1, b = it >> 5;
    const int k0 = th ? RG_SPLIT : 0, k1 = th ? 65 : RG_SPLIT;
    const bf16_t* xb = (const bf16_t*)(a.ws + WS_RGX) + (size_t)b * LT * DRG + head * 128;
    const int col = lane & 15, g = lane >> 4, chl = 16 * wave + col, ch = head * 128 + chl;
    bf16_t* hout = (bf16_t*)a.out + (size_t)dir * T * DRG + (size_t)b * SEQ * DRG + ch;
    bf16_t* pout = (bf16_t*)(a.ws + WS_RGP) + ((size_t)dir * NB + b) * RG_NF * DRG + ch;
    LAS unsigned char* wl = lds + 2 * XT + wave * 1024 + lane * 16;
#pragma unroll
    for (int gt = 0; gt < 2; ++gt)
#pragma unroll
        for (int ks = 0; ks < 4; ++ks) { const float* wp = a.in[I_RGGW] + ((size_t)((dir * 2 + gt) * 8 + head) * 128 + 32 * ks + 8 * g) * 128 + chl;
            u32x4 o; o.x = pk2(wp[0], wp[128]); o.y = pk2(wp[256], wp[384]); o.z = pk2(wp[512], wp[640]); o.w = pk2(wp[768], wp[896]); *(LAS u32x4*)(wl + (gt * 4 + ks) * 8192) = o; }
    const float LOG2E = 1.4426950408889634f;
    const float brl = a.in[I_RGGB][(size_t)(dir * 2 + 0) * DRG + ch] * LOG2E, bil = a.in[I_RGGB][(size_t)(dir * 2 + 1) * DRG + ch] * LOG2E;
    const float sp8l = -8.0f * log1pf(__expf(-a.in[I_RGLAM][dir * DRG + ch])) * LOG2E;
    const int ctr = tid >> 4, ccg = tid & 15;
    LAS float* cwl = (LAS float*)(lds + 2 * XT + 8 * 8192);
    for (int i = tid; i < 5 * 128; i += NTHR) { const int j = i >> 7, c = i & 127; cwl[i] = (j < 4) ? a.in[I_RGCW][((size_t)dir * 4 + j) * DRG + head * 128 + c] : a.in[I_RGCB][(size_t)dir * DRG + head * 128 + c]; }
    __syncthreads();
    u32x4 xr[2][4];
#define RG_LOAD(k) do { _Pragma("unroll") for (int h_ = 0; h_ < 2; ++h_) { const int u_ = 64 * (k) + ctr + 32 * h_; _Pragma("unroll") for (int j = 0; j < 4; ++j) { int uu_ = u_ - j; \
        const bool ok_ = (uu_ >= 0 && uu_ < LT); uu_ = ok_ ? uu_ : 0; const int t_ = dir ? (LT - 1 - uu_) : uu_; const u32x4 v_ = *(const u32x4*)(xb + (size_t)t_ * DRG + 8 * ccg); \
        xr[h_][j] = ok_ ? v_ : (u32x4){0u, 0u, 0u, 0u}; } } } while (0)
#define RG_CONV(k) do { _Pragma("unroll") for (int h_ = 0; h_ < 2; ++h_) { const int u_ = 64 * (k) + ctr + 32 * h_; float o_[8]; \
        { const f32x4 b0_ = *(const LAS f32x4*)(cwl + 4 * 128 + 8 * ccg), b1_ = *(const LAS f32x4*)(cwl + 4 * 128 + 8 * ccg + 4); const bool in_ = (u_ < LT); \
          o_[0] = in_ ? b0_.x : 0.f; o_[1] = in_ ? b0_.y : 0.f; o_[2] = in_ ? b0_.z : 0.f; o_[3] = in_ ? b0_.w : 0.f; o_[4] = in_ ? b1_.x : 0.f; o_[5] = in_ ? b1_.y : 0.f; o_[6] = in_ ? b1_.z : 0.f; o_[7] = in_ ? b1_.w : 0.f; } \
        _Pragma("unroll") for (int j = 0; j < 4; ++j) { float f_[8]; unpack8(xr[h_][j], f_); const f32x4 w0_ = *(const LAS f32x4*)(cwl + j * 128 + 8 * ccg), w1_ = *(const LAS f32x4*)(cwl + j * 128 + 8 * ccg + 4); \
            o_[0] += f_[0] * w0_.x; o_[1] += f_[1] * w0_.y; o_[2] += f_[2] * w0_.z; o_[3] += f_[3] * w0_.w; o_[4] += f_[4] * w1_.x; o_[5] += f_[5] * w1_.y; o_[6] += f_[6] * w1_.z; o_[7] += f_[7] * w1_.w; } \
        u32x4 w0_; w0_.x = pk2(o_[0], o_[1]); w0_.y = pk2(o_[2], o_[3]); w0_.z = pk2(o_[4], o_[5]); w0_.w = pk2(o_[6], o_[7]); \
        *(LAS u32x4*)(lds + ((k) & 1) * XT + rg_lds_off(ctr + 32 * h_, ccg)) = w0_; } } while (0)
    RG_LOAD(k0); RG_CONV(k0); RG_LOAD(k0 + 1);
    __syncthreads();
    float carry = 0.f, pcar = 1.f;
    const int arow = 16 * (col >> 2) + (col & 3);
    const int xoff = (chl & 7) * 2, xch = chl >> 3;
    unsigned char* hbase = (unsigned char*)((bf16_t*)a.out + (size_t)dir * T * DRG + (size_t)b * SEQ * DRG);
    unsigned char* pbase = (unsigned char*)((bf16_t*)(a.ws + WS_RGP) + ((size_t)dir * NB + b) * RG_NF * DRG);
    const int tsgn = dir ? -1 : 1, t0 = dir ? (LT - 1 - NMETA) : -NMETA;
#define RG_TILE(EDGE) do { \
        unsigned hp[16]; float hh = 0.f, PP = 1.f; \
        _Pragma("unroll") for (int mp = 0; mp < 2; ++mp) { f32x4 acc[2][2]; \
            _Pragma("unroll") for (int m2 = 0; m2 < 2; ++m2) { const int mb = 2 * mp + m2; acc[0][m2] = (f32x4){0.f, 0.f, 0.f, 0.f}; acc[1][m2] = (f32x4){0.f, 0.f, 0.f, 0.f}; \
                _Pragma("unroll") for (int ks = 0; ks < 4; ++ks) { const bf16x8_t Af = *(const LAS bf16x8_t*)(xa + rg_lds_off(arow + 4 * mb, 4 * ks + g)); \
                    acc[0][m2] = __builtin_amdgcn_mfma_f32_16x16x32_bf16(Af, *(const LAS bf16x8_t*)(wl + ks * 8192), acc[0][m2], 0, 0, 0); \
                    acc[1][m2] = __builtin_amdgcn_mfma_f32_16x16x32_bf16(Af, *(const LAS bf16x8_t*)(wl + (4 + ks) * 8192), acc[1][m2], 0, 0, 0); } } \
            _Pragma("unroll") for (int m2 = 0; m2 < 2; ++m2) _Pragma("unroll") for (int r = 0; r < 4; ++r) { const int e = 8 * mp + 4 * m2 + r, tau = 16 * g + e, u = 64 * k + tau; \
                    const float rr = __builtin_amdgcn_rcpf(1.0f + __builtin_amdgcn_exp2f(-(acc[0][m2][r] * LOG2E + brl))), ii = __builtin_amdgcn_rcpf(1.0f + __builtin_amdgcn_exp2f(-(acc[1][m2][r] * LOG2E + bil))); \
                    float av = __builtin_amdgcn_exp2f(sp8l * rr); float mult = __builtin_amdgcn_sqrtf(fmaxf(1.0f - av * av, 0.f)); if (EDGE) mult = (u == 0) ? 1.0f : mult; \
                    const float xcv = bf2f(*(const LAS unsigned short*)(xa + rg_lds_off(tau, xch) + xoff)); \
                    float bq = mult * ii * xcv; if (EDGE) { if (u >= LT) { av = 1.f; bq = 0.f; } } \
                    hh = av * hh + bq; PP *= av; hp[e] = pk2(hh, PP); } } \
        float Pg[4], hg[4]; \
        _Pragma("unroll") for (int q = 0; q < 4; ++q) { Pg[q] = __shfl(PP, col + 16 * q); hg[q] = __shfl(hh, col + 16 * q); } \
        const float H0 = carry, H1 = Pg[0] * H0 + hg[0], H2 = Pg[1] * H1 + hg[1], H3 = Pg[2] * H2 + hg[2], H4 = Pg[3] * H3 + hg[3]; \
        const float Q0 = pcar, Q1 = Pg[0] * Q0, Q2 = Pg[1] * Q1, Q3 = Pg[2] * Q2, Q4 = Pg[3] * Q3; \
        const float Hin = (g == 0) ? H0 : (g == 1) ? H1 : (g == 2) ? H2 : H3, Qin = (g == 0) ? Q0 : (g == 1) ? Q1 : (g == 2) ? Q2 : Q3; \
        carry = H4; pcar = Q4; \
        const int ub = 64 * k + 16 * g; \
        unsigned ho = (unsigned)((t0 + tsgn * ub) * (DRG * 2) + ch * 2), po = (unsigned)((ub - RG_U1) * (DRG * 2) + ch * 2); const unsigned hstep = (unsigned)(tsgn * DRG * 2); \
        _Pragma("unroll") for (int e = 0; e < 16; ++e) { const int u = ub + e; const int t = dir ? (LT - 1 - u) : u; \
            if (!EDGE || (u < LT && t >= NMETA)) { *(bf16_t*)(hbase + ho) = (bf16_t)f2bf(bflo(hp[e]) + bfhi(hp[e]) * Hin); \
                if (th) *(bf16_t*)(pbase + po) = (bf16_t)f2bf(bfhi(hp[e]) * Qin); } \
            ho += hstep; po += (unsigned)(DRG * 2); } \
    } while (0)
    for (int k = k0; k < k1; ++k) {
        if (k + 1 < k1) RG_CONV(k + 1);
        if (k + 2 < k1) RG_LOAD(k + 2);
        const LAS unsigned char* xa = lds + (k & 1) * XT;
        if (k == 0 || k >= 63) RG_TILE(true); else RG_TILE(false);
        __syncthreads();
    }
#undef RG_TILE
    if (th == 0 && g == 0) ((float*)(a.ws + WS_RGC))[((size_t)dir * NB + b) * DRG + ch] = carry;
#undef RG_LOAD
#undef RG_CONV
}

#ifndef RG_NAIVE
#define RG_NAIVE 0
#endif
#ifndef CONV_NAIVE
#define CONV_NAIVE 0
#endif
#ifndef ONE_LAUNCH
#define ONE_LAUNCH 0
#endif
constexpr int NPHASE = 13;
#ifndef NVGPR
#define NVGPR 248
#endif
__global__ void __launch_bounds__(NTHR, 2) __attribute__((amdgpu_num_vgpr(NVGPR))) mega(Args a) {
    extern __shared__ __attribute__((aligned(16))) unsigned char lds_raw[];
    LAS unsigned char* lds = (LAS unsigned char*)lds_raw;
    const int tid = threadIdx.x, lane = tid & 63, wave = __builtin_amdgcn_readfirstlane(tid >> 6);
    cg::grid_group grid = cg::this_grid();
    volatile LAS unsigned* bst = (volatile LAS unsigned*)(lds + LDS_BYTES - 64);
    if (tid == 0) { bst[0] = 0u; bst[1] = 0u; }
    __syncthreads();
    XcdBarrier xbar; xbar.bar = (unsigned*)(a.ws + WS_BAR); xbar.x = 0; xbar.st = bst;
    if (a.ph_hi - a.ph_lo > 1) xbar = xcd_barrier_post((unsigned*)(a.ws + WS_BAR), bst);
    const int lo = a.ph_lo, hi = a.ph_hi, G = gridDim.x, bx = blockIdx.x;
#ifndef PHMASK
#define PHMASK 0x1fff
#endif
#ifndef REPMASK
#define REPMASK 0
#endif
#define IN(k) (((PHMASK >> (k)) & 1) && lo <= (k) && (k) < hi)
#define REP(k)
#define SEAM(k) do { if (IN(k) && ((k) + 1) < hi) xcd_barrier(xbar); } while (0)
    if (a.ph_lo < 0) grid.sync();
    unsigned char* ws = a.ws;
    REP(0) if (IN(0)) phase_p0(a, lds, tid, wave, lane);
    SEAM(0);
    REP(1) if (IN(1)) {
        p1_meta(a, lds, tid, wave, lane);
        pg8::Gemm g{(const bf16_t*)(ws + WS_XN1), (const bf16_t*)(ws + WS_WINT), T, DIN, 1024}; pg8::StaticOrder S; S.init(T, DIN, G, bx);
        EpiProj E{(bf16_t*)(ws + WS_HYIN), (bf16_t*)(ws + WS_RGX), (bf16_t*)(ws + WS_GG), (bf16_t*)(ws + WS_GA), (bf16_t*)(ws + WS_GB), a.in[I_BGATE]};
        pg8::gemm_phase<EpiProj, pg8::StaticOrder>(lds, g, S, E, nullptr);
    }
    SEAM(1);
    REP(2) if (IN(2)) phase_hy_pre(a, lds, tid);
    SEAM(2);
    REP(3) if (IN(3)) {
#if CONV_NAIVE
        phase_hy_conv_naive(a, lds, tid);
#else
        for (int c = bx; c < DHY; c += G) hy_conv_channel(a, lds, c, tid, wave, lane);
#endif
#if RG_NAIVE
        phase_rg_naive(a, lds, tid);
#else
        for (int it = bx; it < NB * 2 * 8 * 2; it += G) rg_item3(a, lds, it, tid, wave, lane);
#endif
    }
    SEAM(3);
    REP(4) if (IN(4)) phase_post(a, lds, tid);
    SEAM(4);
    REP(5) if (IN(5)) {
        { pg8::Gemm g{(const bf16_t*)(ws + WS_YH), (const bf16_t*)(ws + WS_WHT), T, 1024, 512}; pg8::StaticOrder S; S.init(T, 1024, G, bx);
          EpiGate<0> E{(const bf16_t*)(ws + WS_GA), nullptr, (bf16_t*)(ws + WS_TMP)};
          pg8::gemm_phase<EpiGate<0>, pg8::StaticOrder>(lds, g, S, E, nullptr); }
        { pg8::Gemm g{(const bf16_t*)(ws + WS_YR), (const bf16_t*)(ws + WS_WRT), T, 1024, 1024}; pg8::StaticOrder S; S.init(T, 1024, G, bx);
          EpiGate<1> E{(const bf16_t*)(ws + WS_GB), (const bf16_t*)(ws + WS_TMP), (bf16_t*)(ws + WS_MERGED)};
          pg8::gemm_phase<EpiGate<1>, pg8::StaticOrder>(lds, g, S, E, nullptr); }
    }
    SEAM(5);
    REP(6) if (IN(6)) {
        pg8::Gemm g{(const bf16_t*)(ws + WS_MERGED), (const bf16_t*)(ws + WS_WOT), T, 1024, 1024}; pg8::StaticOrder S; S.init(T, 1024, G, bx);
        EpiResid E{a.in[I_X], (bf16_t*)(ws + WS_H1B), (float*)(ws + WS_ROWSS)};
        pg8::gemm_phase<EpiResid, pg8::StaticOrder>(lds, g, S, E, nullptr);
    }
    SEAM(6);
    REP(7) if (IN(7)) {
        phase_tables(a, wave, lane);
        pg8::Gemm g{(const bf16_t*)(ws + WS_H1B), (const bf16_t*)(ws + WS_WST), T, 2048, 1024}; pg8::StaticOrder S; S.init(T, 2048, G, bx);
        EpiScores E{(const float*)(ws + WS_ROWSS), (_Float16*)(ws + WS_SCORES)};
        pg8::gemm_phase<EpiScores, pg8::StaticOrder>(lds, g, S, E, nullptr);
        __syncthreads();
        phase_topk(a, lds, S, wave, lane);
    }
    SEAM(8);
#ifndef U_VALU
#define U_VALU 1
#endif
    REP(9) if (IN(9)) { if (U_VALU) phase_peer_u(a, wave, lane); else phase_peer_u_mfma(a, lds, wave, lane); }
    SEAM(9);
    if (IN(10)) phase_peer_act(a, tid);
    SEAM(10);
    if (IN(11)) phase_peer_v(a, wave, lane);
    SEAM(11);
    if (IN(12)) phase_final(a, wave, lane);
#undef IN
#undef SEAM
}

extern "C" void kernel_launch(void* const* d_in, const int* in_sizes, int n_in, void* d_out, int out_size, void* d_ws, size_t ws_size, hipStream_t stream) {
    static int grid = 0;
    if (grid == 0) {
        if (n_in != N_IN || out_size != T * DM || ws_size < WS_END) { fprintf(stderr, "kernel_launch: unexpected shapes (n_in %d out %d ws %zu)\n", n_in, out_size, ws_size); grid = -1; return; }
        if (hipFuncSetAttribute((const void*)mega, hipFuncAttributeMaxDynamicSharedMemorySize, LDS_BYTES) != hipSuccess) { fprintf(stderr, "kernel_launch: hipFuncSetAttribute failed\n"); grid = -1; return; }
        int dev = 0, cus = 0, per_cu = 0;
        hipGetDevice(&dev); hipDeviceGetAttribute(&cus, hipDeviceAttributeMultiprocessorCount, dev);
        hipOccupancyMaxActiveBlocksPerMultiprocessor(&per_cu, (const void*)mega, NTHR, LDS_BYTES);
        if (per_cu < 1) { fprintf(stderr, "kernel_launch: occupancy query says %d blocks per CU\n", per_cu); per_cu = 1; }
        (void)hipGetLastError();
        grid = cus;
    }
    if (grid < 0) return;
    Args a{};
    for (int i = 0; i < N_IN; ++i) a.in[i] = (const float*)d_in[i];
    a.out = (float*)d_out; a.ws = (unsigned char*)d_ws;
#if ONE_LAUNCH
    if (hipMemsetAsync((char*)d_ws + WS_BAR, 0, XCD_BAR_WORDS * 4, stream) != hipSuccess) { fprintf(stderr, "kernel_launch: memset of the barrier words failed\n"); return; }
    a.ph_lo = 0; a.ph_hi = NPHASE;
    void* args[] = {&a};
    hipError_t e = hipLaunchCooperativeKernel((const void*)mega, dim3(grid), dim3(NTHR), args, LDS_BYTES, stream);
    if (e != hipSuccess) fprintf(stderr, "cooperative launch failed: %s (grid %d)\n", hipGetErrorString(e), grid);
#else
    for (int ph = 0; ph < NPHASE; ++ph) for (int rep = 0; rep < 1 + ((REPMASK >> ph) & 1); ++rep) { a.ph_lo = ph; a.ph_hi = ph + 1;
        if (ph == 6 && rep == 1) (void)hipMemsetAsync((char*)d_ws + WS_ROWSS, 0, T * 4, stream);
        hipLaunchKernelGGL(mega, dim3(grid), dim3(NTHR), LDS_BYTES, stream, a);
        hipError_t e = hipPeekAtLastError(); if (e != hipSuccess) { fprintf(stderr, "launch %d failed: %s\n", ph, hipGetErrorString(e)); break; } }
#endif
}
```

```cpp
#define ONE_LAUNCH 1
#include <hip/hip_runtime.h>
#include <hip/hip_cooperative_groups.h>
#include <cstdio>
#include <cstdint>
#include <cmath>
namespace cg = cooperative_groups;
namespace pg8 {
#define PG8_LAS __attribute__((address_space(3)))
typedef unsigned short bf16_t;
typedef short bf16x8 __attribute__((ext_vector_type(8)));
typedef float f32x4 __attribute__((ext_vector_type(4)));
typedef unsigned u32x4 __attribute__((ext_vector_type(4)));
constexpr int BM = 256, BK = 64, HALF = 128, HTB = HALF * BK * 2  , STAGE_BYTES = 8 * HTB, NXCD = 8, WGM = 8;

__host__ __device__ __forceinline__ int lds_byte(int r, int c) { const int st = (r >> 4) * 2 + (c >> 5), rr = r & 15, cc = c & 31, ob = rr * 64 + cc * 2; return st * 1024 + (ob ^ (((ob >> 9) & 1) << 5)); }
__host__ __device__ __forceinline__ void stage_rc(int b, int& R, int& C) { const int st = b / 1024, sb = b % 1024, swz = sb ^ (((sb >> 9) & 1) << 5); R = (st >> 1) * 16 + swz / 64; C = (st & 1) * 32 + (swz % 64) / 2; }
__host__ __device__ __forceinline__ int perm32(int rho) { const int n = rho >> 4, i = rho & 15; return 8 * (i >> 2) + 4 * n + (i & 3); }

struct Unit { int pm, pn; };
struct Gemm { const bf16_t* A; const bf16_t* Bt; int M, N, K; };

struct StaticOrder {
    int nM, nN, nwg, G, c;
    __host__ __device__ void init(int M, int N, int G_, int c_) { nM = M / BM; nN = N / BM; nwg = nM * nN; G = G_; c = c_; }
    __host__ __device__ bool next(int i, Unit& u) const {
        const long L = (long)i * G + c; if (L >= nwg) return false;
        int wgid = (int)L; { const int q = nwg / NXCD, r = nwg % NXCD, xcd = wgid % NXCD, off = wgid / NXCD; wgid = (xcd < r ? xcd * (q + 1) : r * (q + 1) + (xcd - r) * q) + off; }
        const int nig = WGM * nN, gid = wgid / nig, fm = gid * WGM, gsz = (nM - fm) < WGM ? (nM - fm) : WGM;
        u.pm = fm + ((wgid % nig) % gsz); u.pn = (wgid % nig) / gsz; return true;
    }
    __device__ __forceinline__ void a_ready(const Unit&) const {}
    __device__ __forceinline__ void done(const Unit&) const {}
};
__device__ __forceinline__ unsigned cvt_pk_bf16(float lo, float hi) { unsigned r; asm volatile("v_cvt_pk_bf16_f32 %0, %1, %2" : "=v"(r) : "v"(lo), "v"(hi)); return r; }
typedef float f32x2 __attribute__((ext_vector_type(2)));
__device__ __forceinline__ f32x2 gelu_pk(f32x2 v) {
    const f32x2 av = __builtin_elementwise_abs(v), d = av * 0.2316418882f + 1.0f;
    f32x2 t; t.x = __builtin_amdgcn_rcpf(d.x); t.y = __builtin_amdgcn_rcpf(d.y);
    f32x2 q = t * 0.5307027145f + (-0.7265760135f); q = q * t + 0.7107068705f; q = q * t + (-0.142248368f); q = q * t + 0.127414796f; q = q * t;
    const f32x2 s = (v * v) * (-0.72134752044f);
    f32x2 e; e.x = __builtin_amdgcn_exp2f(s.x); e.y = __builtin_amdgcn_exp2f(s.y);
    const f32x2 m = v * (q * e), r = v - m;
    f32x2 o; o.x = v.x < 0.f ? m.x : r.x; o.y = v.y < 0.f ? m.y : r.y; return o;
}
template <class Epi, class Sched, bool STAMP = false>
__device__ __forceinline__ void gemm_phase(PG8_LAS unsigned char* lds, const Gemm g, const Sched& S, const Epi& E, unsigned long long* stamps) {
    const int tid = threadIdx.x, wid = __builtin_amdgcn_readfirstlane(tid >> 6), lane = tid & 63, wr = wid >> 2, wc = wid & 3, fr = lane & 15, fq = lane >> 4;
    const int K = g.K, nt = K / BK;
    int ts_lo = 0, ts_hi = 0, nts = 0; const unsigned long long rt_entry = STAMP ? (unsigned long long)wall_clock64() : 0ull;
#define PG8_STAMP() do { if (STAMP && wid == 0 && nts < 64) { const unsigned long long _c = (unsigned long long)clock64(); \
        ts_lo = (lane == nts) ? (int)(unsigned)_c : ts_lo; ts_hi = (lane == nts) ? (int)(unsigned)(_c >> 32) : ts_hi; ++nts; } } while (0)
    PG8_STAMP();
    unsigned voffA[2], voffB[2];
#pragma unroll
    for (int i = 0; i < 2; ++i) { int R, C; stage_rc(tid * 16 + i * 8192, R, C); const int Rb = Epi::PERM ? ((R & ~31) + perm32(R & 31)) : R;
        voffA[i] = (unsigned)(R * K + C) * 2u; voffB[i] = (unsigned)(Rb * K + C) * 2u; }
    const size_t kstep = (size_t)(BK * 2);
    const size_t hstep = (size_t)HALF * K * 2;
    const size_t tstep = 2 * hstep;
    const unsigned ldsw = (unsigned)wid * 1024u;
    const int aoff = lds_byte(wr * 64 + fr, fq * 8), boff = lds_byte(wc * 32 + fr, fq * 8);
#define PG8_SA(b, h) (((b) * 2 + (h)) * HTB)
#define PG8_SB(b, h) ((4 + (b) * 2 + (h)) * HTB)
#define PG8_STAGE(bufoff, gbase, voff) do { _Pragma("unroll") for (int _i = 0; _i < 2; ++_i) \
        __builtin_amdgcn_global_load_lds((const unsigned*)((const char*)(gbase) + (voff)[_i]), (PG8_LAS unsigned*)(lds + (bufoff) + ldsw + _i * 8192), 16, 0, 0); } while (0)
#define PG8_LDA(dst, b, h) do { _Pragma("unroll") for (int m = 0; m < 4; ++m) _Pragma("unroll") for (int k = 0; k < 2; ++k) dst[m][k] = *(const PG8_LAS bf16x8*)(lds + PG8_SA(b, h) + aoff + m * 2048 + k * 1024); } while (0)
#define PG8_LDB(dst, b, h) do { _Pragma("unroll") for (int n = 0; n < 2; ++n) _Pragma("unroll") for (int k = 0; k < 2; ++k) dst[n][k] = *(const PG8_LAS bf16x8*)(lds + PG8_SB(b, h) + boff + n * 2048 + k * 1024); } while (0)
#define PG8_MMA(ai, bj, At, Bt) do { __builtin_amdgcn_s_setprio(1); _Pragma("unroll") for (int m = 0; m < 4; ++m) _Pragma("unroll") for (int n = 0; n < 2; ++n) _Pragma("unroll") for (int k = 0; k < 2; ++k) \
        acc[ai][bj][m][n] = __builtin_amdgcn_mfma_f32_16x16x32_bf16(Bt[n][k], At[m][k], acc[ai][bj][m][n], 0, 0, 0); __builtin_amdgcn_s_setprio(0); } while (0)
#define PG8_WAIT_V(n) asm volatile("s_waitcnt vmcnt(" #n ")" ::: "memory")
#define PG8_WAIT_L(n) asm volatile("s_waitcnt lgkmcnt(" #n ")" ::: "memory")
#define PG8_BAR __builtin_amdgcn_s_barrier()
#define PG8_SCHED __builtin_amdgcn_sched_barrier(0)
    Unit cur, nxt; int ui = 0;
    if (!S.next(0, cur)) return;
    f32x4 acc[2][2][4][2];
#pragma unroll
    for (int a = 0; a < 2; ++a)
#pragma unroll
        for (int b = 0; b < 2; ++b)
#pragma unroll
            for (int m = 0; m < 4; ++m)
#pragma unroll
                for (int n = 0; n < 2; ++n) acc[a][b][m][n] = (f32x4){0.f, 0.f, 0.f, 0.f};
    bf16x8 At[4][2], B0[2][2], B1[2][2];
    const char* cA = (const char*)g.A + (size_t)cur.pm * tstep; const char* cB = (const char*)g.Bt + (size_t)cur.pn * tstep;
    S.a_ready(cur);
    PG8_STAGE(PG8_SB(0, 0), cB, voffB); PG8_STAGE(PG8_SA(0, 0), cA, voffA); PG8_STAGE(PG8_SB(0, 1), cB + hstep, voffB); PG8_STAGE(PG8_SA(0, 1), cA + hstep, voffA);
    if (wr == 1) PG8_BAR;
    PG8_WAIT_V(4); PG8_BAR;
    PG8_STAGE(PG8_SB(1, 0), cB + kstep, voffB); PG8_STAGE(PG8_SA(1, 0), cA + kstep, voffA); PG8_STAGE(PG8_SB(1, 1), cB + hstep + kstep, voffB);
    PG8_WAIT_V(6); PG8_BAR;
    PG8_STAMP();
    for (;;) {
        const bool has_next = S.next(ui + 1, nxt);
        const char* nA = has_next ? (const char*)g.A + (size_t)nxt.pm * tstep : cA; const char* nB = has_next ? (const char*)g.Bt + (size_t)nxt.pn * tstep : cB;
        for (int t = 0; t < nt; t += 2) {
            const bool last = (t == nt - 2);
            const char* a1 = cA + (size_t)(t + 1) * kstep;
            const char* a2 = last ? nA : cA + (size_t)(t + 2) * kstep; const char* b2 = last ? nB : cB + (size_t)(t + 2) * kstep;
            const char* a3 = a2 + kstep; const char* b3 = b2 + kstep;
            if (last && has_next) S.a_ready(nxt);
            PG8_LDB(B0, 0, 0); PG8_SCHED; PG8_LDA(At, 0, 0); PG8_STAGE(PG8_SA(1, 1), a1 + hstep, voffA);
            PG8_WAIT_L(8); PG8_BAR; PG8_WAIT_L(0); PG8_MMA(0, 0, At, B0); PG8_BAR; PG8_SCHED;
            PG8_LDB(B1, 0, 1); PG8_STAGE(PG8_SB(0, 0), b2, voffB);
            PG8_BAR; PG8_WAIT_L(0); PG8_MMA(0, 1, At, B1); PG8_BAR;
            PG8_LDA(At, 0, 1); PG8_STAGE(PG8_SA(0, 0), a2, voffA);
            PG8_BAR; PG8_WAIT_L(0); PG8_MMA(1, 0, At, B0); PG8_BAR; PG8_SCHED;
            PG8_STAGE(PG8_SB(0, 1), b2 + hstep, voffB);
            PG8_WAIT_V(6); PG8_BAR; PG8_MMA(1, 1, At, B1); PG8_BAR;
            PG8_LDB(B0, 1, 0); PG8_SCHED; PG8_LDA(At, 1, 0); PG8_STAGE(PG8_SA(0, 1), a2 + hstep, voffA);
            PG8_WAIT_L(8); PG8_BAR; PG8_WAIT_L(0); PG8_MMA(0, 0, At, B0); PG8_BAR; PG8_SCHED;
            PG8_LDB(B1, 1, 1); PG8_STAGE(PG8_SB(1, 0), b3, voffB);
            PG8_BAR; PG8_WAIT_L(0); PG8_MMA(0, 1, At, B1); PG8_BAR;
            PG8_LDA(At, 1, 1); PG8_STAGE(PG8_SA(1, 0), a3, voffA);
            PG8_BAR; PG8_WAIT_L(0); PG8_MMA(1, 0, At, B0); PG8_BAR; PG8_SCHED;
            PG8_STAGE(PG8_SB(1, 1), b3 + hstep, voffB);
            PG8_WAIT_V(6); PG8_BAR; PG8_MMA(1, 1, At, B1); PG8_BAR;
        }
        PG8_STAMP();
        if constexpr (!Epi::AFTER_DRAIN) { E(acc, cur, wr, wc, fr, fq); S.done(cur); }
        PG8_STAMP();
        if (!has_next) break;
#pragma unroll
        for (int a = 0; a < 2; ++a)
#pragma unroll
            for (int b = 0; b < 2; ++b)
#pragma unroll
                for (int m = 0; m < 4; ++m)
#pragma unroll
                    for (int n = 0; n < 2; ++n) acc[a][b][m][n] = (f32x4){0.f, 0.f, 0.f, 0.f};
        cur = nxt; cA = nA; cB = nB; ++ui;
    }
    PG8_WAIT_V(0);
    if (wr == 0) PG8_BAR;
    PG8_BAR;
    if constexpr (Epi::AFTER_DRAIN) { E.fused(acc, cur, wr, wc, fr, fq, lds, wid, lane); S.done(cur); }
    PG8_STAMP();
    if (STAMP && wid == 0) { stamps[lane] = lane < nts ? (((unsigned long long)(unsigned)ts_hi << 32) | (unsigned)ts_lo) : 0ull;
        if (lane == 62) stamps[62] = rt_entry; if (lane == 63) stamps[63] = (unsigned long long)wall_clock64(); }
#undef PG8_STAMP
#undef PG8_SA
#undef PG8_SB
#undef PG8_STAGE
#undef PG8_LDA
#undef PG8_LDB
#undef PG8_MMA
#undef PG8_WAIT_V
#undef PG8_WAIT_L
#undef PG8_BAR
#undef PG8_SCHED
}
}

#define LAS __attribute__((address_space(3)))
typedef unsigned short bf16_t;
typedef float f32x4 __attribute__((ext_vector_type(4)));
typedef float f32x2 __attribute__((ext_vector_type(2)));
typedef unsigned u32x4 __attribute__((ext_vector_type(4)));
typedef unsigned u32x2 __attribute__((ext_vector_type(2)));

constexpr int NB = 8, SEQ = 4096, NMETA = 16, LT = SEQ + NMETA, DM = 1024, T = NB * SEQ;
constexpr int DHY = 512, DRG = 1024, DIN = 3 * DHY + 2 * DRG + 2 * DM;
constexpr int NTHR = 512, NWAVES = 8;
constexpr int LDS_BYTES = 160 * 1024;
constexpr float EPSF = 1e-6f;
constexpr int KFW = 2 * LT;
constexpr int SP = 4256;
constexpr int NEXP = 16384;
constexpr int RG_SPLIT = 33, RG_U1 = RG_SPLIT * 64;
constexpr int RG_NF = LT - RG_U1;

enum { I_X = 0, I_META, I_GFINAL, I_GMIX, I_WIN, I_BGATE, I_HYCW, I_HYCB, I_HYW1, I_HYB1, I_HYW2, I_HYB2, I_HYW3, I_HYB3, I_HYFREQ, I_HYSKIP,
       I_HYOUT, I_RGCW, I_RGCB, I_RGGW, I_RGGB, I_RGLAM, I_RGOUT, I_WOUT, I_GFFN, I_WQ, I_KEYS, I_PU, I_PV, N_IN };

constexpr size_t MiB = 1024ull * 1024ull;
constexpr size_t WS_ROWSS = 64 * 1024;
constexpr size_t WS_SU = 256 * 1024;
constexpr size_t WS_SV = 320 * 1024;
constexpr size_t WS_ROWSS2 = 384 * 1024;
constexpr size_t WS_BAR = 512 * 1024;
constexpr size_t WS_WINT = 1 * MiB;
constexpr size_t WS_WHT = 12 * MiB;
constexpr size_t WS_WRT = 13 * MiB;
constexpr size_t WS_WOT = 15 * MiB;
constexpr size_t WS_WST = 17 * MiB;
constexpr size_t WS_GWT = 21 * MiB;
constexpr size_t WS_KF = 22 * MiB;
constexpr size_t WS_KFB = 39 * MiB;
constexpr size_t WS_HYIN = 48 * MiB;
constexpr size_t WS_RGX = 145 * MiB;
constexpr size_t WS_GG = 210 * MiB;
constexpr size_t WS_GA = 274 * MiB;
constexpr size_t WS_GB = 338 * MiB;
constexpr size_t WS_XN1 = 402 * MiB;
constexpr size_t WS_UUT = 402 * MiB;
constexpr size_t WS_CONVT = 436 * MiB;
constexpr size_t WS_YH = 468 * MiB;
constexpr size_t WS_YR = WS_RGX;
constexpr size_t WS_MERGED = WS_HYIN;
constexpr size_t WS_TMP = WS_GG;
constexpr size_t WS_H1B = WS_RGX;
constexpr size_t WS_SCORES = WS_GG;
constexpr size_t WS_EIDX = 468 * MiB;
constexpr size_t WS_EG = 484 * MiB;
constexpr size_t WS_UB = 48 * MiB;
constexpr size_t WS_VB = 64 * MiB;
constexpr size_t WS_PD = 210 * MiB;
constexpr size_t WS_PO = WS_PD;
constexpr size_t WS_ACT = 338 * MiB;
constexpr size_t WS_RGP = 48 * MiB;
constexpr size_t WS_RGC = 576 * 1024;
constexpr size_t WS_END = 500 * MiB;

struct Args { const float* in[N_IN]; float* out; unsigned char* ws; int ph_lo, ph_hi; };

__device__ __forceinline__ float bf2f(unsigned v) { return __uint_as_float(v << 16); }
typedef __bf16 bf16x2_t __attribute__((ext_vector_type(2)));
__device__ __forceinline__ unsigned pk2(float lo, float hi) { bf16x2_t v; v.x = (__bf16)lo; v.y = (__bf16)hi; return __builtin_bit_cast(unsigned, v); }
__device__ __forceinline__ unsigned f2bf(float f) { return pk2(f, f) & 0xffffu; }
__device__ __forceinline__ float bflo(unsigned w) { return __uint_as_float(w << 16); }
__device__ __forceinline__ float bfhi(unsigned w) { return __uint_as_float(w & 0xffff0000u); }
__device__ __forceinline__ float wave_sum(float v) {
#pragma unroll
    for (int o = 1; o < 64; o <<= 1) v += __shfl_xor(v, o);
    return v;
}
__device__ __forceinline__ float wave_max(float v) {
#pragma unroll
    for (int o = 1; o < 64; o <<= 1) v = fmaxf(v, __shfl_xor(v, o));
    return v;
}
__device__ __forceinline__ float fexp(float x) { return __builtin_amdgcn_exp2f(x * 1.4426950408889634f); }
__device__ __forceinline__ float sigmoidf_(float x) { return __builtin_amdgcn_rcpf(1.0f + fexp(-x)); }
__device__ __forceinline__ float gelu_tanh(float x) { const float u = 1.5957691216f * (x + 0.044715f * x * x * x); return x * __builtin_amdgcn_rcpf(1.0f + fexp(-u)); }
__device__ __forceinline__ void sincos_acc(float a, float& s, float& c) {
    const double x = (double)a;
    const double q = rint(x * 0.63661977236758134308);
    const double r = fma(-q, 1.57079632679489661923, x);
    const int n = (int)q;
    const float rf = (float)r, r2 = rf * rf;
    const float sp = rf * (1.f + r2 * (-1.6666667e-1f + r2 * (8.3333333e-3f + r2 * (-1.9841270e-4f + r2 * 2.7557319e-6f))));
    const float cp = 1.f + r2 * (-0.5f + r2 * (4.1666667e-2f + r2 * (-1.3888889e-3f + r2 * (2.4801587e-5f + r2 * (-2.7557319e-7f)))));
    const int k = n & 3;
    s = (k == 0) ? sp : (k == 1) ? cp : (k == 2) ? -sp : -cp;
    c = (k == 0) ? cp : (k == 1) ? -sp : (k == 2) ? -cp : sp;
}

typedef float f32x2v __attribute__((ext_vector_type(2)));
__device__ __forceinline__ float wave_sum_dpp(float v) {
    v += __int_as_float(__builtin_amdgcn_update_dpp(0, __float_as_int(v), 0xB1, 0xF, 0xF, true));
    v += __int_as_float(__builtin_amdgcn_update_dpp(0, __float_as_int(v), 0x4E, 0xF, 0xF, true));
    v += __int_as_float(__builtin_amdgcn_update_dpp(0, __float_as_int(v), 0x141, 0xF, 0xF, true));
    v += __int_as_float(__builtin_amdgcn_update_dpp(0, __float_as_int(v), 0x140, 0xF, 0xF, true));
    const int vi = __float_as_int(v);
    return (__int_as_float(__builtin_amdgcn_readlane(vi, 0)) + __int_as_float(__builtin_amdgcn_readlane(vi, 16))) + (__int_as_float(__builtin_amdgcn_readlane(vi, 32)) + __int_as_float(__builtin_amdgcn_readlane(vi, 48)));
}
__device__ __forceinline__ float wave_max_dpp(float v) {
    v = fmaxf(v, __int_as_float(__builtin_amdgcn_update_dpp(0, __float_as_int(v), 0xB1, 0xF, 0xF, true)));
    v = fmaxf(v, __int_as_float(__builtin_amdgcn_update_dpp(0, __float_as_int(v), 0x4E, 0xF, 0xF, true)));
    v = fmaxf(v, __int_as_float(__builtin_amdgcn_update_dpp(0, __float_as_int(v), 0x141, 0xF, 0xF, true)));
    v = fmaxf(v, __int_as_float(__builtin_amdgcn_update_dpp(0, __float_as_int(v), 0x140, 0xF, 0xF, true)));
    const int vi = __float_as_int(v);
    return fmaxf(fmaxf(__int_as_float(__builtin_amdgcn_readlane(vi, 0)), __int_as_float(__builtin_amdgcn_readlane(vi, 16))), fmaxf(__int_as_float(__builtin_amdgcn_readlane(vi, 32)), __int_as_float(__builtin_amdgcn_readlane(vi, 48))));
}

#ifndef SLICE_PROBE
#define SLICE_OF(b) ((b) & 7)
#define RANK_OF(b) ((b) >> 3)
#else
#define SLICE_OF(b) ((b) >> 5)
#define RANK_OF(b) ((b) & 31)
#endif

__device__ __forceinline__ float dpp_xor8(float v) { return __int_as_float(__builtin_amdgcn_update_dpp(0, __float_as_int(v), 0x128, 0xF, 0xF, true)); }
#define XB_TMO      128
#define XB_XCNT(j)  (256  + 64 * (j))
#define XB_XSUB(j)  (1280 + 64 * (j))
#define XB_XGEN(j)  (2304 + 64 * (j))
#define XB_TOP      3328
#define XB_TOPGEN   3392
#define XCD_BAR_WORDS 3456
#define XB_SPIN_CAP (1u << 18)

__device__ __forceinline__ unsigned xb_ld(unsigned* p)              { return __hip_atomic_load(p, __ATOMIC_RELAXED, __HIP_MEMORY_SCOPE_AGENT); }
__device__ __forceinline__ unsigned xb_add(unsigned* p, unsigned v) { return __hip_atomic_fetch_add(p, v, __ATOMIC_RELAXED, __HIP_MEMORY_SCOPE_AGENT); }
__device__ __forceinline__ unsigned xb_xcc_id() { return (unsigned)__builtin_amdgcn_s_getreg((3 << 11) | 20) & 0xFu; }
#define XB_SPIN(cond, bar) do { unsigned _sp = 0; while (cond) { __builtin_amdgcn_s_sleep(1); \
    if ((++_sp & 255u) == 0u) { if (xb_ld(&(bar)[XB_TMO])) break; if (_sp > XB_SPIN_CAP) { atomicAdd(&(bar)[XB_TMO], 1u); break; } } } } while (0)

struct XcdBarrier {
    unsigned* bar; unsigned x;
    volatile LAS unsigned* st;
};

__device__ __forceinline__ XcdBarrier xcd_barrier_post(unsigned* bar, volatile LAS unsigned* st) {
    XcdBarrier b; b.bar = bar; b.x = xb_xcc_id(); b.st = st;
    if (threadIdx.x == 0) (void)xb_add(&bar[XB_XCNT(b.x)], 1u);
    return b;
}
__device__ __forceinline__ void xcd_barrier_complete(unsigned* bar, unsigned x, unsigned& nloc, unsigned& nx) {
    const unsigned G = gridDim.x * gridDim.y * gridDim.z;
    unsigned sum, cnt, mine, sp = 0u;
    for (;;) {
        sum = 0u; cnt = 0u; mine = 0u;
#pragma unroll
        for (unsigned j = 0; j < 16; ++j) { const unsigned c = xb_ld(&bar[XB_XCNT(j)]); sum += c; cnt += (c > 0u) ? 1u : 0u; mine = (j == x) ? c : mine; }
        if (sum == G) break;
        __builtin_amdgcn_s_sleep(1);
        if ((++sp & 255u) == 0u) { if (xb_ld(&bar[XB_TMO])) break; if (sp > XB_SPIN_CAP) { atomicAdd(&bar[XB_TMO], 1u); break; } }
    }
    nloc = mine > 0u ? mine : 1u; nx = cnt > 0u ? cnt : 1u;
}

__device__ __forceinline__ void xcd_barrier(const XcdBarrier& b) {
    asm volatile("s_waitcnt vmcnt(0)" ::: "memory");
    __syncthreads();
    if (threadIdx.x == 0) {
        unsigned* bar = b.bar;
        __builtin_amdgcn_s_waitcnt(0);
        unsigned nloc = b.st[0], nx = b.st[1];
        if (nloc == 0u) { xcd_barrier_complete(bar, b.x, nloc, nx); b.st[0] = nloc; b.st[1] = nx; }
        const unsigned old = xb_add(&bar[XB_XSUB(b.x)], 1u);
        const unsigned gen = old / nloc;
        if (old + 1u == (gen + 1u) * nloc) {
            __builtin_amdgcn_fence(__ATOMIC_RELEASE, "agent");
            asm volatile("s_waitcnt vmcnt(0)" ::: "memory");
            const unsigned og = xb_add(&bar[XB_TOP], 1u);
            const unsigned tg = og / nx;
            if (og + 1u == (tg + 1u) * nx) xb_add(&bar[XB_TOPGEN], 1u);
            else XB_SPIN(xb_ld(&bar[XB_TOPGEN]) == tg, bar);
            __builtin_amdgcn_fence(__ATOMIC_ACQUIRE, "agent");
            xb_add(&bar[XB_XGEN(b.x)], 1u);
            asm volatile("s_waitcnt vmcnt(0)" ::: "memory");
        } else {
            XB_SPIN(xb_ld(&bar[XB_XGEN(b.x)]) == gen, bar);
            __builtin_amdgcn_fence(__ATOMIC_ACQUIRE, "agent");
            asm volatile("s_waitcnt vmcnt(0)" ::: "memory");
        }
    }
    __syncthreads();
}

__device__ __forceinline__ void p0_transpose_item(const float* W, int K, int N, bf16_t* WT, LAS float* scr, int item, int lane) {
    const int nblk = N / 32, kb = item / nblk, nb = item % nblk, k0 = 64 * kb, n0 = 32 * nb;
#pragma unroll 8
    for (int i = 0; i < 32; ++i) { const int kk = 2 * i + (lane >> 5); scr[kk * 33 + (lane & 31)] = W[(size_t)(k0 + kk) * N + n0 + (lane & 31)]; }
    asm volatile("s_waitcnt lgkmcnt(0)" ::: "memory");
    const int c = lane & 7;
#pragma unroll
    for (int j = 0; j < 4; ++j) { const int n = (lane >> 3) + 8 * j; const LAS float* s = scr + (8 * c) * 33 + n;
        u32x4 o; o.x = pk2(s[0 * 33], s[1 * 33]); o.y = pk2(s[2 * 33], s[3 * 33]); o.z = pk2(s[4 * 33], s[5 * 33]); o.w = pk2(s[6 * 33], s[7 * 33]);
        *(u32x4*)(WT + (size_t)(n0 + n) * K + k0 + 8 * c) = o; }
    asm volatile("s_waitcnt lgkmcnt(0)" ::: "memory");
}
__device__ __forceinline__ void p0_xn1_row(const float* xrow, const float* g, bf16_t* orow, int lane) {
    const f32x4* xr = (const f32x4*)xrow + lane; const f32x4* gr = (const f32x4*)g + lane;
    f32x4 v[4]; float s = 0.f;
#pragma unroll
    for (int j = 0; j < 4; ++j) { v[j] = xr[64 * j]; s += (v[j].x * v[j].x + v[j].y * v[j].y) + (v[j].z * v[j].z + v[j].w * v[j].w); }
    const float rstd = rsqrtf(wave_sum(s) * (1.f / DM) + EPSF);
    unsigned long long* o8 = (unsigned long long*)orow + lane;
#pragma unroll
    for (int j = 0; j < 4; ++j) { const f32x4 gv = gr[64 * j];
        o8[64 * j] = (unsigned long long)pk2(v[j].x * rstd * gv.x, v[j].y * rstd * gv.y) | ((unsigned long long)pk2(v[j].z * rstd * gv.z, v[j].w * rstd * gv.w) << 32); }
}
__device__ __forceinline__ void p0_fold_item(const Args& a, LAS unsigned char* lds, int item, int tid) {
    const int hp = item >> 4, k0 = (item & 15) * 64;
    LAS float* kl = (LAS float*)lds;
    LAS float* wl = (LAS float*)(lds + 128 * 129 * 4);
    const float* keys = a.in[I_KEYS] + (size_t)hp * 128 * 128; const float* wq = a.in[I_WQ];
    for (int i = tid; i < 128 * 128; i += NTHR) { const int key = i >> 7, d = i & 127; kl[key * 129 + d] = keys[i]; }
    for (int i = tid; i < 64 * 128; i += NTHR) { const int kk = i >> 7, d = i & 127; wl[i] = wq[(size_t)(k0 + kk) * 2048 + hp * 128 + d]; }
    __syncthreads();
    const int key = tid & 127, kq = tid >> 7;
    float acc[16];
#pragma unroll
    for (int i = 0; i < 16; ++i) acc[i] = 0.f;
#pragma unroll 2
    for (int d = 0; d < 128; ++d) { const float kv = kl[key * 129 + d];
#pragma unroll
        for (int i = 0; i < 16; ++i) acc[i] += wl[(kq * 16 + i) * 128 + d] * kv; }
    const float* gf = a.in[I_GFFN] + k0 + kq * 16;
    bf16_t* dst = (bf16_t*)(a.ws + WS_WST) + (size_t)(hp * 128 + key) * 1024 + k0 + kq * 16;
    u32x4 o0, o1;
    o0.x = pk2(acc[0] * gf[0], acc[1] * gf[1]); o0.y = pk2(acc[2] * gf[2], acc[3] * gf[3]); o0.z = pk2(acc[4] * gf[4], acc[5] * gf[5]); o0.w = pk2(acc[6] * gf[6], acc[7] * gf[7]);
    o1.x = pk2(acc[8] * gf[8], acc[9] * gf[9]); o1.y = pk2(acc[10] * gf[10], acc[11] * gf[11]); o1.z = pk2(acc[12] * gf[12], acc[13] * gf[13]); o1.w = pk2(acc[14] * gf[14], acc[15] * gf[15]);
    *(u32x4*)dst = o0; *(u32x4*)(dst + 8) = o1;
    __syncthreads();
}
__device__ __forceinline__ void p0_meta_item(const Args& a, LAS unsigned char* lds, int item, int tid, int wave, int lane) {
    LAS float* mt = (LAS float*)lds;
    for (int r = wave * 2; r < wave * 2 + 2; ++r) {
        const f32x4* xr = (const f32x4*)(a.in[I_META] + (size_t)r * DM) + lane; const f32x4* gr = (const f32x4*)a.in[I_GMIX] + lane;
        f32x4 v[4]; float s = 0.f;
#pragma unroll
        for (int j = 0; j < 4; ++j) { v[j] = xr[64 * j]; s += (v[j].x * v[j].x + v[j].y * v[j].y) + (v[j].z * v[j].z + v[j].w * v[j].w); }
        const float rstd = rsqrtf(wave_sum(s) * (1.f / DM) + EPSF);
#pragma unroll
        for (int j = 0; j < 4; ++j) { const f32x4 gv = gr[64 * j]; f32x4 o = v[j] * rstd * gv; *(LAS f32x4*)(mt + r * 1024 + 4 * (lane + 64 * j)) = o; }
    }
    __syncthreads();
    const int col = item * 256 + (tid & 255), rh = tid >> 8;
    float acc[8];
#pragma unroll
    for (int r = 0; r < 8; ++r) acc[r] = 0.f;
    const float* w = a.in[I_WIN] + col;
#pragma unroll 4
    for (int k = 0; k < 1024; ++k) { const float wv = w[(size_t)k * DIN];
#pragma unroll
        for (int r = 0; r < 8; ++r) acc[r] += mt[(rh * 8 + r) * 1024 + k] * wv; }
    bf16_t* hyin = (bf16_t*)(a.ws + WS_HYIN); bf16_t* rgx = (bf16_t*)(a.ws + WS_RGX);
#pragma unroll
    for (int r = 0; r < 8; ++r) { const int t = rh * 8 + r; const bf16_t v = (bf16_t)f2bf(acc[r]);
        for (int b = 0; b < NB; ++b) { if (col < 1536) hyin[((size_t)b * LT + t) * 1536 + col] = v; else rgx[((size_t)b * LT + t) * 1024 + (col - 1536)] = v; } }
    __syncthreads();
}
constexpr int FPP = 17, NFILT = (LT + FPP - 1) / FPP;
__device__ __forceinline__ void p0_filter_item(const Args& a, LAS unsigned char* lds, int item, int tid) {
    LAS float* z = (LAS float*)lds;
    LAS float* h1 = z + FPP * 33;
    LAS float* h2 = h1 + FPP * 64;
    LAS float* ko = h2 + FPP * 64;
    const int p0 = item * FPP;
    for (int idx = tid; idx < FPP * 33; idx += NTHR) { const int pp = idx / 33, f = idx % 33, p = p0 + pp;
        float v;
        if (f == 0) v = (float)p * (1.0f / (float)(LT - 1));
        else { const int bi = (f - 1) & 15; const float band = 1e-4f + (float)bi * ((15.0f - 1e-4f) / 15.0f); const float w = (float)(6.283185307179586 / (double)LT) * (float)p;
            float s, c; sincos_acc(band * w, s, c); v = (f <= 16) ? c : -s; }
        z[idx] = v; }
    __syncthreads();
    const float* w1 = a.in[I_HYW1]; const float* b1 = a.in[I_HYB1]; const float* w2 = a.in[I_HYW2]; const float* b2 = a.in[I_HYB2];
    const float* w3 = a.in[I_HYW3]; const float* b3 = a.in[I_HYB3]; const float* fr = a.in[I_HYFREQ];
    { const int j = tid & 63, pq = tid >> 6;
        float wv[33];
#pragma unroll
        for (int f = 0; f < 33; ++f) wv[f] = w1[f * 64 + j];
        const float bj = b1[j], fj = fr[j];
        for (int pp = pq; pp < FPP; pp += 8) { float acc = bj;
#pragma unroll
            for (int f = 0; f < 33; ++f) acc += z[pp * 33 + f] * wv[f];
            float s, c; sincos_acc(fj * acc, s, c); h1[pp * 64 + j] = s; } }
    __syncthreads();
    { const int j = tid & 63, pq = tid >> 6;
        const float bj = b2[j], fj = fr[64 + j]; float accp[3] = {bj, bj, bj};
#pragma unroll 1
        for (int fh = 0; fh < 2; ++fh) { float wv[32];
#pragma unroll
            for (int f = 0; f < 32; ++f) wv[f] = w2[(fh * 32 + f) * 64 + j];
#pragma unroll
            for (int t3 = 0; t3 < 3; ++t3) { const int pp = pq + 8 * t3; if (pp < FPP) { float acc = accp[t3];
#pragma unroll
                for (int f = 0; f < 32; ++f) acc += h1[pp * 64 + fh * 32 + f] * wv[f];
                accp[t3] = acc; } } }
#pragma unroll
        for (int t3 = 0; t3 < 3; ++t3) { const int pp = pq + 8 * t3; if (pp < FPP) { float s, c; sincos_acc(fj * accp[t3], s, c); h2[pp * 64 + j] = s; } } }
    __syncthreads();
#pragma unroll 1
    for (int half = 0; half < 2; ++half) { const int o = half * 512 + tid;
        const float bo = b3[o];
        const float delta = fabsf(-15.350567286626972f + (float)tid * ((-3.0701134573253945f + 15.350567286626972f) / 511.0f));
#pragma unroll 1
        for (int ih = 0; ih < 2; ++ih) { float wv[32];
#pragma unroll
            for (int i = 0; i < 32; ++i) wv[i] = w3[(ih * 32 + i) * 1024 + o];
#pragma unroll 1
            for (int pp = 0; pp < FPP; ++pp) { float acc = ih ? ko[o * (FPP + 1) + pp] : bo;
#pragma unroll
                for (int i = 0; i < 32; ++i) acc += h2[pp * 64 + ih * 32 + i] * wv[i];
                if (ih) { const float tn = (float)(p0 + pp) * (1.0f / (float)(LT - 1)); acc *= __expf(-tn * delta); }
                ko[o * (FPP + 1) + pp] = acc; } }
    }
    __syncthreads();
    bf16_t* kfb = (bf16_t*)(a.ws + WS_KFB);
    for (int idx = tid; idx < 1024 * FPP; idx += NTHR) { const int o = idx / FPP, pp = idx - o * FPP, dir = o >> 9, c = o & 511, p = p0 + pp;
        if (p < LT) { const float v = ko[o * (FPP + 1) + pp];
            if (dir == 0) kfb[(size_t)c * KFW + (LT - 1) + p] = (bf16_t)f2bf(p == 0 ? v + a.in[I_HYSKIP][c] : v);
            else if (p >= 1) kfb[(size_t)c * KFW + (LT - 1) - p] = (bf16_t)f2bf(v); } }
    if (item == 0) for (int c = tid; c < 512; c += NTHR) kfb[(size_t)c * KFW + KFW - 1] = 0;
    __syncthreads();
}
__device__ __forceinline__ void phase_p0(const Args& a, LAS unsigned char* lds, int tid, int wave, int lane) {
    const int G = gridDim.x, bx = blockIdx.x;
    { float* rs = (float*)(a.ws + WS_ROWSS); float* rs2 = (float*)(a.ws + WS_ROWSS2); for (int i = bx * NTHR + tid; i < T; i += G * NTHR) { rs[i] = 0.f; rs2[i] = 0.f; } }
    for (int it = bx; it < 256 + NFILT; it += G) {
#ifndef P0M
#define P0M 7
#endif
        if (it < 256) { if (P0M & 1) p0_fold_item(a, lds, it, tid); }
        else { if (P0M & 2) p0_filter_item(a, lds, it - 256, tid); }

    }
    LAS float* scr = (LAS float*)(lds + wave * 16384);
    const int gw = bx * NWAVES + wave, NGW = G * NWAVES;
    constexpr int I_IN = (1024 / 64) * (DIN / 32), I_H = (512 / 64) * (1024 / 32), I_R = (1024 / 64) * (1024 / 32), I_O = I_R;
    for (int it = gw; it < I_IN + I_H + I_R + I_O; it += NGW) {
        int r = it;
        if (r < I_IN) { p0_transpose_item(a.in[I_WIN], 1024, DIN, (bf16_t*)(a.ws + WS_WINT), scr, r, lane); continue; } r -= I_IN;
        if (r < I_H) { p0_transpose_item(a.in[I_HYOUT], 512, 1024, (bf16_t*)(a.ws + WS_WHT), scr, r, lane); continue; } r -= I_H;
        if (r < I_R) { p0_transpose_item(a.in[I_RGOUT], 1024, 1024, (bf16_t*)(a.ws + WS_WRT), scr, r, lane); continue; } r -= I_R;
        p0_transpose_item(a.in[I_WOUT], 1024, 1024, (bf16_t*)(a.ws + WS_WOT), scr, r, lane);
    }
    for (int m = gw; m < T; m += 2 * NGW) { p0_xn1_row(a.in[I_X] + (size_t)m * DM, a.in[I_GMIX], (bf16_t*)(a.ws + WS_XN1) + (size_t)m * DM, lane);
        if (m + NGW < T) p0_xn1_row(a.in[I_X] + (size_t)(m + NGW) * DM, a.in[I_GMIX], (bf16_t*)(a.ws + WS_XN1) + (size_t)(m + NGW) * DM, lane); }
}

__device__ __forceinline__ void p1_meta(const Args& a, LAS unsigned char* lds, int tid, int wave, int lane) {
    LAS float* mt = (LAS float*)lds;
    for (int r = wave * 2; r < wave * 2 + 2; ++r) {
        const f32x4* xr = (const f32x4*)(a.in[I_META] + (size_t)r * DM) + lane; const f32x4* gr = (const f32x4*)a.in[I_GMIX] + lane;
        f32x4 v[4]; float s = 0.f;
#pragma unroll
        for (int j = 0; j < 4; ++j) { v[j] = xr[64 * j]; s += (v[j].x * v[j].x + v[j].y * v[j].y) + (v[j].z * v[j].z + v[j].w * v[j].w); }
        const float rstd = rsqrtf(wave_sum(s) * (1.f / DM) + EPSF);
#pragma unroll
        for (int j = 0; j < 4; ++j) { const f32x4 gv = gr[64 * j]; f32x4 o = v[j] * rstd * gv; *(LAS f32x4*)(mt + r * 1024 + 4 * (lane + 64 * j)) = o; }
    }
    __syncthreads();
    const bf16_t* wint = (const bf16_t*)(a.ws + WS_WINT); bf16_t* hyin = (bf16_t*)(a.ws + WS_HYIN); bf16_t* rgx = (bf16_t*)(a.ws + WS_RGX);
    for (int cc = wave; cc < 10; cc += NWAVES) { const int n = blockIdx.x * 10 + cc; if (n >= 2560) break;
        float w[16]; { float t0[8], t1[8]; const bf16_t* wp = wint + (size_t)n * 1024; const u32x4 q0 = *(const u32x4*)(wp + 8 * lane), q1 = *(const u32x4*)(wp + 512 + 8 * lane);
            w[0] = bflo(q0.x); w[1] = bfhi(q0.x); w[2] = bflo(q0.y); w[3] = bfhi(q0.y); w[4] = bflo(q0.z); w[5] = bfhi(q0.z); w[6] = bflo(q0.w); w[7] = bfhi(q0.w);
            w[8] = bflo(q1.x); w[9] = bfhi(q1.x); w[10] = bflo(q1.y); w[11] = bfhi(q1.y); w[12] = bflo(q1.z); w[13] = bfhi(q1.z); w[14] = bflo(q1.w); w[15] = bfhi(q1.w); (void)t0; (void)t1; }
        float mine = 0.f;
#pragma unroll
        for (int r = 0; r < 16; ++r) { const LAS f32x4* mp = (const LAS f32x4*)(mt + r * 1024 + 8 * lane); const f32x4 m0 = mp[0], m1 = mp[1], m2 = mp[128], m3 = mp[129];
            float s = (w[0] * m0.x + w[1] * m0.y) + (w[2] * m0.z + w[3] * m0.w) + (w[4] * m1.x + w[5] * m1.y) + (w[6] * m1.z + w[7] * m1.w)
                    + (w[8] * m2.x + w[9] * m2.y) + (w[10] * m2.z + w[11] * m2.w) + (w[12] * m3.x + w[13] * m3.y) + (w[14] * m3.z + w[15] * m3.w);
            s = wave_sum_dpp(s); mine = ((lane & 15) == r) ? s : mine; }
        const bf16_t v = (bf16_t)f2bf(mine); const int t = lane & 15;
#pragma unroll
        for (int h = 0; h < 2; ++h) { const int b = (lane >> 4) + 4 * h;
            if (n < 1536) hyin[((size_t)b * LT + t) * 1536 + n] = v; else rgx[((size_t)b * LT + t) * 1024 + (n - 1536)] = v; }
    }
    __syncthreads();
}

typedef pg8::f32x4 pf4;
struct EpiProj {
    static constexpr bool PERM = true, AFTER_DRAIN = false;
    bf16_t *hyin, *rgx, *gg, *ga, *gb; const float* bgate;
    __device__ __forceinline__ void operator()(const pf4 (&acc)[2][2][4][2], const pg8::Unit& u, int wr, int wc, int fr, int fq) const {
        const int pn = u.pn, row0 = u.pm * 256 + wr * 64 + fr, cl0 = wc * 32 + 8 * fq;
#pragma unroll
        for (int ai = 0; ai < 2; ++ai)
#pragma unroll
            for (int m = 0; m < 4; ++m) { const int r = row0 + ai * 128 + m * 16; const size_t rl = (size_t)(r >> 12) * LT + NMETA + (r & 4095);
#pragma unroll
                for (int bj = 0; bj < 2; ++bj) { const int col = pn * 256 + bj * 128 + cl0; pf4 v0 = acc[ai][bj][m][0], v1 = acc[ai][bj][m][1]; bf16_t* dst;
                    if (pn < 6) dst = hyin + rl * 1536 + col;
                    else if (pn < 10) dst = rgx + rl * 1024 + (col - 1536);
                    else if (pn < 14) { dst = gg + (size_t)r * 1024 + (col - 2560);
#pragma unroll
                        for (int j = 0; j < 4; ++j) { v0[j] = gelu_tanh(v0[j]); v1[j] = gelu_tanh(v1[j]); } }
                    else { const int gc = col - 3584;
                        dst = (gc < 1024 ? ga + (size_t)r * 1024 + gc : gb + (size_t)r * 1024 + (gc - 1024));
                        const pf4 b0 = *(const pf4*)(bgate + gc), b1 = *(const pf4*)(bgate + gc + 4);
#pragma unroll
                        for (int j = 0; j < 4; ++j) { v0[j] = sigmoidf_(v0[j] + b0[j]); v1[j] = sigmoidf_(v1[j] + b1[j]); } }
                    u32x4 w; w.x = pk2(v0[0], v0[1]); w.y = pk2(v0[2], v0[3]); w.z = pk2(v1[0], v1[1]); w.w = pk2(v1[2], v1[3]);
                    *(u32x4*)dst = w; } }
    }
};
template <int MODE  > struct EpiGate {
    static constexpr bool PERM = true, AFTER_DRAIN = false;
    const bf16_t* gate; const bf16_t* tin; bf16_t* outp;
    __device__ __forceinline__ void operator()(const pf4 (&acc)[2][2][4][2], const pg8::Unit& u, int wr, int wc, int fr, int fq) const {
        const int row0 = u.pm * 256 + wr * 64 + fr, col0 = u.pn * 256 + wc * 32 + 8 * fq;
        u32x4 gq[2], tq[2];
#define EG_OFF(i) ((size_t)(row0 + ((i) >> 3) * 128 + (((i) >> 1) & 3) * 16) * 1024 + col0 + ((i) & 1) * 128)
        gq[0] = *(const u32x4*)(gate + EG_OFF(0)); if (MODE == 1) tq[0] = *(const u32x4*)(tin + EG_OFF(0));
#pragma unroll
        for (int i = 0; i < 16; ++i) { const int ai = i >> 3, m = (i >> 1) & 3, bj = i & 1; const size_t o = EG_OFF(i);
            if (i + 1 < 16) { gq[(i + 1) & 1] = *(const u32x4*)(gate + EG_OFF(i + 1)); if (MODE == 1) tq[(i + 1) & 1] = *(const u32x4*)(tin + EG_OFF(i + 1)); }
            const pf4 v0 = acc[ai][bj][m][0], v1 = acc[ai][bj][m][1]; const u32x4 g = gq[i & 1];
            float r[8];
            r[0] = v0[0] * bflo(g.x); r[1] = v0[1] * bfhi(g.x); r[2] = v0[2] * bflo(g.y); r[3] = v0[3] * bfhi(g.y);
            r[4] = v1[0] * bflo(g.z); r[5] = v1[1] * bfhi(g.z); r[6] = v1[2] * bflo(g.w); r[7] = v1[3] * bfhi(g.w);
            if (MODE == 1) { const u32x4 t = tq[i & 1];
                r[0] += bflo(t.x); r[1] += bfhi(t.x); r[2] += bflo(t.y); r[3] += bfhi(t.y); r[4] += bflo(t.z); r[5] += bfhi(t.z); r[6] += bflo(t.w); r[7] += bfhi(t.w); }
            u32x4 w; w.x = pk2(r[0], r[1]); w.y = pk2(r[2], r[3]); w.z = pk2(r[4], r[5]); w.w = pk2(r[6], r[7]);
            *(u32x4*)(outp + o) = w; }
#undef EG_OFF
    }
};
struct EpiResid {
    static constexpr bool PERM = true, AFTER_DRAIN = false;
    const float* x; bf16_t* h1b; float* rowss;
    __device__ __forceinline__ void operator()(const pf4 (&acc)[2][2][4][2], const pg8::Unit& u, int wr, int wc, int fr, int fq) const {
        const int row0 = u.pm * 256 + wr * 64 + fr, col0 = u.pn * 256 + wc * 32 + 8 * fq;
        pf4 xq[2][4];
#define ER_ROW(i) (row0 + ((i) >> 2) * 128 + ((i) & 3) * 16)
#define ER_LOAD(buf, i) do { const float* p_ = x + (size_t)ER_ROW(i) * 1024 + col0; xq[buf][0] = *(const pf4*)p_; xq[buf][1] = *(const pf4*)(p_ + 4); xq[buf][2] = *(const pf4*)(p_ + 128); xq[buf][3] = *(const pf4*)(p_ + 132); } while (0)
        ER_LOAD(0, 0);
#pragma unroll
        for (int i = 0; i < 8; ++i) { const int ai = i >> 2, m = i & 3, r = ER_ROW(i); const size_t ro = (size_t)r * 1024 + col0; float ss = 0.f;
            if (i + 1 < 8) ER_LOAD((i + 1) & 1, i + 1);
#pragma unroll
            for (int bj = 0; bj < 2; ++bj) { const size_t o = ro + bj * 128;
                const pf4 v0 = acc[ai][bj][m][0] + xq[i & 1][2 * bj], v1 = acc[ai][bj][m][1] + xq[i & 1][2 * bj + 1];
                u32x4 w; w.x = pk2(v0[0], v0[1]); w.y = pk2(v0[2], v0[3]); w.z = pk2(v1[0], v1[1]); w.w = pk2(v1[2], v1[3]);
                *(u32x4*)(h1b + o) = w;
                ss += (v0[0] * v0[0] + v0[1] * v0[1]) + (v0[2] * v0[2] + v0[3] * v0[3]) + (v1[0] * v1[0] + v1[1] * v1[1]) + (v1[2] * v1[2] + v1[3] * v1[3]); }
            ss += __shfl_xor(ss, 16); ss += __shfl_xor(ss, 32);
            if (fq == 0) atomicAdd(rowss + r, ss); }
#undef ER_ROW
#undef ER_LOAD
    }
};
struct EpiScores {
    static constexpr bool PERM = true, AFTER_DRAIN = false;
    const float* rowss; _Float16* sc;
    __device__ __forceinline__ void operator()(const pf4 (&acc)[2][2][4][2], const pg8::Unit& u, int wr, int wc, int fr, int fq) const {
        const int row0 = u.pm * 256 + wr * 64 + fr, k0 = wc * 32 + 8 * fq;
#pragma unroll
        for (int ai = 0; ai < 2; ++ai)
#pragma unroll
            for (int m = 0; m < 4; ++m) { const int r = row0 + ai * 128 + m * 16; const float rs = rsqrtf(rowss[r] * (1.f / DM) + EPSF);
#pragma unroll
                for (int bj = 0; bj < 2; ++bj) { _Float16* p = sc + (((size_t)(((r >> 6) * 8 + u.pn) * 2 + bj) * 16 + (k0 >> 3)) * 64 + (r & 63)) * 8;
                    typedef _Float16 h8 __attribute__((ext_vector_type(8)));
                    h8 v; v[0] = (_Float16)(acc[ai][bj][m][0][0] * rs); v[1] = (_Float16)(acc[ai][bj][m][0][1] * rs); v[2] = (_Float16)(acc[ai][bj][m][0][2] * rs); v[3] = (_Float16)(acc[ai][bj][m][0][3] * rs);
                    v[4] = (_Float16)(acc[ai][bj][m][1][0] * rs); v[5] = (_Float16)(acc[ai][bj][m][1][1] * rs); v[6] = (_Float16)(acc[ai][bj][m][1][2] * rs); v[7] = (_Float16)(acc[ai][bj][m][1][3] * rs);
                    *(h8*)p = v; } }
    }
};

__device__ __forceinline__ void unpack8(const u32x4 w, float (&f)[8]) {
    f[0] = bflo(w.x); f[1] = bfhi(w.x); f[2] = bflo(w.y); f[3] = bfhi(w.y); f[4] = bflo(w.z); f[5] = bfhi(w.z); f[6] = bflo(w.w); f[7] = bfhi(w.w); }
__device__ __forceinline__ void load8(const bf16_t* p, float (&f)[8]) { const u32x4 w = *(const u32x4*)p;
    f[0] = bflo(w.x); f[1] = bfhi(w.x); f[2] = bflo(w.y); f[3] = bfhi(w.y); f[4] = bflo(w.z); f[5] = bfhi(w.z); f[6] = bflo(w.w); f[7] = bfhi(w.w); }
__device__ __forceinline__ void short_conv8(const bf16_t* hb, const float* cw, const float* cb, int s, int ch, float (&o)[8]) {
    float xm[8], x0[8], xp[8];
    if (s >= 1) load8(hb + (size_t)(s - 1) * 1536 + ch, xm); else {
#pragma unroll
        for (int i = 0; i < 8; ++i) xm[i] = 0.f; }
    load8(hb + (size_t)s * 1536 + ch, x0);
    if (s + 1 < LT) load8(hb + (size_t)(s + 1) * 1536 + ch, xp); else {
#pragma unroll
        for (int i = 0; i < 8; ++i) xp[i] = 0.f; }
#pragma unroll
    for (int i = 0; i < 8; ++i) o[i] = xm[i] * cw[ch + i] + x0[i] * cw[1536 + ch + i] + xp[i] * cw[3072 + ch + i] + cb[ch + i];
}
__device__ __forceinline__ void short_conv8v(const u32x4& rm, const u32x4& r0, const u32x4& rp, const float* cw, const float* cb, int ch, float (&o)[8]) {
    float xm[8], x0[8], xp[8]; unpack8(rm, xm); unpack8(r0, x0); unpack8(rp, xp);
    const f32x4 wa0 = *(const f32x4*)(cw + ch), wa1 = *(const f32x4*)(cw + ch + 4), wb0 = *(const f32x4*)(cw + 1536 + ch), wb1 = *(const f32x4*)(cw + 1536 + ch + 4);
    const f32x4 wc0 = *(const f32x4*)(cw + 3072 + ch), wc1 = *(const f32x4*)(cw + 3072 + ch + 4), bb0 = *(const f32x4*)(cb + ch), bb1 = *(const f32x4*)(cb + ch + 4);
#pragma unroll
    for (int i = 0; i < 4; ++i) { o[i] = xm[i] * wa0[i] + x0[i] * wb0[i] + xp[i] * wc0[i] + bb0[i]; o[4 + i] = xm[4 + i] * wa1[i] + x0[4 + i] * wb1[i] + xp[4 + i] * wc1[i] + bb1[i]; }
}
__device__ __forceinline__ void phase_hy_pre(const Args& a, LAS unsigned char* lds, int tid) {
    const int wave = tid >> 6, lane = tid & 63, gw = blockIdx.x * NWAVES + wave, NGW = gridDim.x * NWAVES, l8 = lane >> 3, l7 = lane & 7;
    LAS bf16_t* tl = (LAS bf16_t*)(lds + wave * (64 * 144));
    const bf16_t* hyin = (const bf16_t*)(a.ws + WS_HYIN); bf16_t* uut = (bf16_t*)(a.ws + WS_UUT); bf16_t* x0out = (bf16_t*)(a.ws + WS_YH);
    const float* cw = a.in[I_HYCW]; const float* cb = a.in[I_HYCB];
    for (int it = gw; it < NB * 67 * 8; it += NGW) {
        const int ct = it & 7, ts = (it >> 3) % 67, b = (it >> 3) / 67, c0 = ct * 64 + l7 * 8;
        const bf16_t* hb = hyin + (size_t)b * LT * 1536;
#pragma unroll 2
        for (int k = 0; k < 8; ++k) { const int sr = 8 * k + l8, s = ts * 64 + sr - 16;
            float uu[8];
            if (s >= 0 && s < LT) {
                const int sm = (s >= 1) ? s - 1 : s, sp = (s + 1 < LT) ? s + 1 : s; const bool zm = (s < 1), zp = (s + 1 >= LT);
                u32x4 r[3][3];
#pragma unroll
                for (int gI = 0; gI < 3; ++gI) { const bf16_t* p = hb + 512 * gI + c0;
                    r[gI][0] = *(const u32x4*)(p + (size_t)sm * 1536); r[gI][1] = *(const u32x4*)(p + (size_t)s * 1536); r[gI][2] = *(const u32x4*)(p + (size_t)sp * 1536);
                    if (zm) r[gI][0] = (u32x4){0u, 0u, 0u, 0u}; if (zp) r[gI][2] = (u32x4){0u, 0u, 0u, 0u}; }
                float x1[8], v[8]; short_conv8v(r[1][0], r[1][1], r[1][2], cw, cb, 512 + c0, x1); short_conv8v(r[2][0], r[2][1], r[2][2], cw, cb, 1024 + c0, v);
#pragma unroll
                for (int i = 0; i < 8; ++i) uu[i] = v[i] * x1[i];
                if (s >= NMETA) { float x0[8]; short_conv8v(r[0][0], r[0][1], r[0][2], cw, cb, c0, x0);
                    u32x4 w; w.x = pk2(x0[0], x0[1]); w.y = pk2(x0[2], x0[3]); w.z = pk2(x0[4], x0[5]); w.w = pk2(x0[6], x0[7]);
                    *(u32x4*)(x0out + ((size_t)b * SEQ + (s - NMETA)) * DHY + c0) = w; } }
            else {
#pragma unroll
                for (int i = 0; i < 8; ++i) uu[i] = 0.f; }
            u32x4 w; w.x = pk2(uu[0], uu[1]); w.y = pk2(uu[2], uu[3]); w.z = pk2(uu[4], uu[5]); w.w = pk2(uu[6], uu[7]);
            *(LAS u32x4*)(tl + sr * 72 + l7 * 8) = w; }
#pragma unroll
        for (int k = 0; k < 8; ++k) { const int cl = 8 * k + l8, sp0 = ts * 64 + l7 * 8;
            if (sp0 < SP) { unsigned h[8];
#pragma unroll
                for (int i = 0; i < 8; ++i) h[i] = tl[(l7 * 8 + i) * 72 + cl];
                u32x4 w; w.x = h[0] | (h[1] << 16); w.y = h[2] | (h[3] << 16); w.z = h[4] | (h[5] << 16); w.w = h[6] | (h[7] << 16);
                *(u32x4*)(uut + ((size_t)(ct * 64 + cl) * NB + b) * SP + sp0) = w; } }
    }
}
__device__ __forceinline__ void phase_hy_conv_naive(const Args& a, LAS unsigned char* lds, int tid) {
    LAS bf16_t* uus = (LAS bf16_t*)lds;
    LAS float* filt = (LAS float*)(lds + LT * 16);
    const bf16_t* uut = (const bf16_t*)(a.ws + WS_UUT); const float* kf = (const float*)(a.ws + WS_KF); bf16_t* cvt = (bf16_t*)(a.ws + WS_CONVT);
    for (int c = blockIdx.x; c < DHY; c += gridDim.x) {
        for (int i = tid; i < NB * LT; i += NTHR) { const int b = i / LT, s = i - b * LT; uus[s * 8 + b] = uut[((size_t)c * NB + b) * SP + 16 + s]; }
        for (int i = tid; i < KFW; i += NTHR) filt[i] = kf[(size_t)c * KFW + i];
        __syncthreads();
        for (int tt = 0; tt < 8; ++tt) { const int tq = tt * 512 + tid, t = tq + 16; float acc[8];
#pragma unroll
            for (int b = 0; b < 8; ++b) acc[b] = 0.f;
            const LAS float* fp = filt + (LT - 1) + t;
            for (int s = 0; s < LT; ++s) { const float kv = fp[-s]; const u32x4 w = *(const LAS u32x4*)(uus + s * 8);
                acc[0] += kv * bflo(w.x); acc[1] += kv * bfhi(w.x); acc[2] += kv * bflo(w.y); acc[3] += kv * bfhi(w.y);
                acc[4] += kv * bflo(w.z); acc[5] += kv * bfhi(w.z); acc[6] += kv * bflo(w.w); acc[7] += kv * bfhi(w.w); }
#pragma unroll
            for (int b = 0; b < 8; ++b) cvt[((size_t)c * NB + b) * SEQ + tq] = (bf16_t)f2bf(acc[b]); }
        __syncthreads();
    }
}
__device__ __forceinline__ void phase_rg_naive(const Args& a, LAS unsigned char* lds, int tid) {
    LAS float* xc = (LAS float*)lds;
    LAS float* gbuf = xc + 32 * 128;
    const bf16_t* rgx = (const bf16_t*)(a.ws + WS_RGX);
    for (int it = blockIdx.x; it < NB * 2 * 8; it += gridDim.x) {
        const int head = it & 7, dir = (it >> 3) & 1, b = it >> 4;
        const float* cw = a.in[I_RGCW] + (size_t)dir * 4 * DRG + head * 128; const float* cb = a.in[I_RGCB] + (size_t)dir * DRG + head * 128;
        bf16_t* hout = (bf16_t*)a.out + (size_t)dir * T * DRG;
        const bf16_t* xb = rgx + (size_t)b * LT * DRG + head * 128;
        float h = 0.f, sp = 0.f;
        if (tid < 128) { const float lam = a.in[I_RGLAM][dir * DRG + head * 128 + tid]; sp = log1pf(__expf(-lam)); }
        for (int k = 0; k < 129; ++k) {
            { const int tok = tid >> 4, cg = tid & 15, u = 32 * k + tok; float o[8];
#pragma unroll
                for (int i = 0; i < 8; ++i) o[i] = (u < LT) ? cb[cg * 8 + i] : 0.f;
                if (u < LT) {
#pragma unroll
                    for (int j = 0; j < 4; ++j) { const int uu = u - j; if (uu >= 0) { const int t = dir ? (LT - 1 - uu) : uu; float xv[8]; load8(xb + (size_t)t * DRG + cg * 8, xv);
#pragma unroll
                            for (int i = 0; i < 8; ++i) o[i] += xv[i] * cw[j * DRG + cg * 8 + i]; } } }
#pragma unroll
                for (int i = 0; i < 8; ++i) xc[tok * 128 + cg * 8 + i] = o[i]; }
            __syncthreads();
            { const int j = tid & 127, g = (tid >> 7) & 1, th = tid >> 8; float acc[16];
#pragma unroll
                for (int q = 0; q < 16; ++q) acc[q] = 0.f;
                const float* gw = a.in[I_RGGW] + ((size_t)((dir * 2 + g) * 8 + head) * 128) * 128 + j;
                for (int i = 0; i < 128; ++i) { const float wv = gw[i * 128];
#pragma unroll
                    for (int q = 0; q < 16; ++q) acc[q] += xc[(th * 16 + q) * 128 + i] * wv; }
                const float gb = a.in[I_RGGB][(size_t)(dir * 2 + g) * DRG + head * 128 + j];
#pragma unroll
                for (int q = 0; q < 16; ++q) gbuf[(g * 32 + th * 16 + q) * 128 + j] = acc[q] + gb; }
            __syncthreads();
            if (tid < 128) {
                for (int tok = 0; tok < 32; ++tok) { const int u = 32 * k + tok; if (u >= LT) break;
                    const float r = sigmoidf_(gbuf[tok * 128 + tid]), ig = sigmoidf_(gbuf[(32 + tok) * 128 + tid]);
                    const float la = -8.0f * r * sp; const float av = __expf(la); const float mult = (u == 0) ? 1.0f : sqrtf(-expm1f(2.0f * la));
                    h = av * h + mult * ig * xc[tok * 128 + tid];
                    const int t = dir ? (LT - 1 - u) : u;
                    if (t >= NMETA) hout[((size_t)b * SEQ + (t - NMETA)) * DRG + head * 128 + tid] = (bf16_t)f2bf(h); } }
            __syncthreads();
        }
    }
}
__device__ __forceinline__ void phase_post(const Args& a, LAS unsigned char* lds, int tid) {
    const int wave = tid >> 6, lane = tid & 63, gw = blockIdx.x * NWAVES + wave, NGW = gridDim.x * NWAVES;
    LAS bf16_t* cv = (LAS bf16_t*)(lds + wave * (64 * 144));
    const bf16_t* cvt = (const bf16_t*)(a.ws + WS_CONVT); bf16_t* yh = (bf16_t*)(a.ws + WS_YH);
    const int l8 = lane >> 3, l7 = lane & 7;
    for (int it = gw; it < NB * 64 * 8; it += NGW) {
        const int ct = it & 7, tt = (it >> 3) & 63, b = it >> 9;
        u32x4 cw_[8], xw[8];
#pragma unroll
        for (int k = 0; k < 8; ++k) cw_[k] = *(const u32x4*)(cvt + ((size_t)(ct * 64 + 8 * k + l8) * NB + b) * SEQ + tt * 64 + l7 * 8);
        bf16_t* yp = yh + ((size_t)b * SEQ + tt * 64 + l8) * DHY + ct * 64 + l7 * 8;
#pragma unroll
        for (int k = 0; k < 8; ++k) xw[k] = *(const u32x4*)(yp + (size_t)(8 * k) * DHY);
#pragma unroll
        for (int k = 0; k < 8; ++k) *(LAS u32x4*)(cv + (8 * k + l8) * 72 + l7 * 8) = cw_[k];
#pragma unroll
        for (int k = 0; k < 8; ++k) { const int tr = 8 * k + l8; float x0[8], y[8]; unpack8(xw[k], x0);
#pragma unroll
            for (int i = 0; i < 8; ++i) y[i] = bf2f(cv[(l7 * 8 + i) * 72 + tr]) * x0[i];
            u32x4 w; w.x = pk2(y[0], y[1]); w.y = pk2(y[2], y[3]); w.z = pk2(y[4], y[5]); w.w = pk2(y[6], y[7]);
            *(u32x4*)(yp + (size_t)(8 * k) * DHY) = w; }
    }
    const bf16_t* hf = (const bf16_t*)a.out; const bf16_t* hb2 = hf + (size_t)T * DRG; const bf16_t* gg = (const bf16_t*)(a.ws + WS_GG); bf16_t* yr = (bf16_t*)(a.ws + WS_YR);
    const bf16_t* rgp = (const bf16_t*)(a.ws + WS_RGP); const float* rgc = (const float*)(a.ws + WS_RGC);
    for (size_t i = (size_t)blockIdx.x * NTHR + tid; i < (size_t)T * DRG / 8; i += (size_t)gridDim.x * NTHR) {
        const int c8 = (int)(i & 127) * 8, m = (int)(i >> 7), b = m >> 12, t = (m & 4095) + NMETA;
        float f[8], g[8], q[8]; load8(hf + i * 8, f); load8(hb2 + i * 8, g); load8(gg + i * 8, q);
        if (t >= RG_U1) { float p[8]; load8(rgp + ((size_t)(0 * NB + b) * RG_NF + (t - RG_U1)) * DRG + c8, p); const float* cc = rgc + (size_t)(0 * NB + b) * DRG + c8;
#pragma unroll
            for (int j = 0; j < 8; ++j) f[j] += p[j] * cc[j]; }
        const int ub = LT - 1 - t;
        if (ub >= RG_U1) { float p[8]; load8(rgp + ((size_t)(1 * NB + b) * RG_NF + (ub - RG_U1)) * DRG + c8, p); const float* cc = rgc + (size_t)(1 * NB + b) * DRG + c8;
#pragma unroll
            for (int j = 0; j < 8; ++j) g[j] += p[j] * cc[j]; }
        u32x4 w; w.x = pk2((f[0] + g[0]) * q[0], (f[1] + g[1]) * q[1]); w.y = pk2((f[2] + g[2]) * q[2], (f[3] + g[3]) * q[3]);
        w.z = pk2((f[4] + g[4]) * q[4], (f[5] + g[5]) * q[5]); w.w = pk2((f[6] + g[6]) * q[6], (f[7] + g[7]) * q[7]);
        *(u32x4*)(yr + i * 8) = w; }
}
__device__ __forceinline__ u32x4 quant_row16(const f32x4 (&v)[4], float amax, float& deq) {
    const float sc = (amax > 0.f) ? 256.0f / amax : 1.0f; deq = (amax > 0.f) ? amax * (1.0f / 256.0f) : 1.0f;
    u32x4 w; int t;
    t = __builtin_amdgcn_cvt_pk_fp8_f32(v[0].x * sc, v[0].y * sc, 0, false); t = __builtin_amdgcn_cvt_pk_fp8_f32(v[0].z * sc, v[0].w * sc, t, true); w.x = (unsigned)t;
    t = __builtin_amdgcn_cvt_pk_fp8_f32(v[1].x * sc, v[1].y * sc, 0, false); t = __builtin_amdgcn_cvt_pk_fp8_f32(v[1].z * sc, v[1].w * sc, t, true); w.y = (unsigned)t;
    t = __builtin_amdgcn_cvt_pk_fp8_f32(v[2].x * sc, v[2].y * sc, 0, false); t = __builtin_amdgcn_cvt_pk_fp8_f32(v[2].z * sc, v[2].w * sc, t, true); w.z = (unsigned)t;
    t = __builtin_amdgcn_cvt_pk_fp8_f32(v[3].x * sc, v[3].y * sc, 0, false); t = __builtin_amdgcn_cvt_pk_fp8_f32(v[3].z * sc, v[3].w * sc, t, true); w.w = (unsigned)t;
    return w;
}
__device__ __forceinline__ unsigned q8x4(f32x4 v, float sc) {
    const int a = (int)rintf(v.x * sc), b = (int)rintf(v.y * sc), c = (int)rintf(v.z * sc), d = (int)rintf(v.w * sc);
    return ((unsigned)a & 0xffu) | (((unsigned)b & 0xffu) << 8) | (((unsigned)c & 0xffu) << 16) | ((unsigned)d << 24);
}
__device__ __forceinline__ void phase_tables(const Args& a, int wave, int lane) {
    const int gw = blockIdx.x * NWAVES + wave, NGW = gridDim.x * NWAVES;
    const float* gf = a.in[I_GFFN] + 16 * lane; unsigned char* uq = a.ws + WS_UB; unsigned char* vq = a.ws + WS_VB; float* su = (float*)(a.ws + WS_SU); float* sv = (float*)(a.ws + WS_SV);
    f32x4 g[4];
#pragma unroll
    for (int j = 0; j < 4; ++j) g[j] = *(const f32x4*)(gf + 4 * j);
    for (int e = gw; e < NEXP; e += NGW) {
        const float* ur = a.in[I_PU] + (size_t)e * DM + 16 * lane; const float* vr = a.in[I_PV] + (size_t)e * DM + 16 * lane;
        f32x4 u[4], v[4]; float mu = 0.f, mv = 0.f;
#pragma unroll
        for (int j = 0; j < 4; ++j) { u[j] = *(const f32x4*)(ur + 4 * j) * g[j]; v[j] = *(const f32x4*)(vr + 4 * j);
            mu = fmaxf(mu, fmaxf(fmaxf(fabsf(u[j].x), fabsf(u[j].y)), fmaxf(fabsf(u[j].z), fabsf(u[j].w))));
            mv = fmaxf(mv, fmaxf(fmaxf(fabsf(v[j].x), fabsf(v[j].y)), fmaxf(fabsf(v[j].z), fabsf(v[j].w)))); }
        mu = wave_max_dpp(mu); mv = wave_max_dpp(mv);
        const float scu = (mu > 0.f) ? 127.0f / mu : 1.0f, du = (mu > 0.f) ? mu * (1.0f / 127.0f) : 1.0f;
        u32x4 qu; qu.x = q8x4(u[0], scu); qu.y = q8x4(u[1], scu); qu.z = q8x4(u[2], scu); qu.w = q8x4(u[3], scu);
        const float scv = (mv > 0.f) ? 127.0f / mv : 1.0f, dv = (mv > 0.f) ? mv * (1.0f / 127.0f) : 1.0f;
        u32x4 qv; qv.x = q8x4(v[0], scv); qv.y = q8x4(v[1], scv); qv.z = q8x4(v[2], scv); qv.w = q8x4(v[3], scv);
        { const size_t so = ((size_t)(lane >> 3) * NEXP + e) * 128 + 16 * (lane & 7); *(u32x4*)(uq + so) = qu; *(u32x4*)(vq + so) = qv; }
        if (lane == 0) { su[e] = du; sv[e] = dv; }
    }
}
__device__ __forceinline__ void ce_desc(float& a, float& b) { const float hi = fmaxf(a, b), lo = fminf(a, b); a = hi; b = lo; }
__device__ __forceinline__ void sort16_desc(float (&x)[16]) {
#pragma unroll
    for (int k = 2; k <= 16; k <<= 1)
#pragma unroll
        for (int j = k >> 1; j > 0; j >>= 1)
#pragma unroll
            for (int i = 0; i < 16; ++i) { const int l = i ^ j; if (l > i) { if ((i & k) == 0) ce_desc(x[i], x[l]); else ce_desc(x[l], x[i]); } }
}
__device__ __forceinline__ void merge_top16(float (&L)[16], const float (&X)[16]) {
#pragma unroll
    for (int i = 0; i < 16; ++i) L[i] = fmaxf(L[i], X[15 - i]);
#pragma unroll
    for (int j = 8; j > 0; j >>= 1)
#pragma unroll
        for (int i = 0; i < 16; ++i) { const int l = i ^ j; if (l > i) ce_desc(L[i], L[l]); }
}
__device__ __forceinline__ void top16_of_128(const _Float16* base  , float (&L)[16]) {
    typedef _Float16 h8 __attribute__((ext_vector_type(8)));
    h8 v0 = *(const h8*)(base), v1 = *(const h8*)(base + 512);
#pragma unroll 1
    for (int ch = 0; ch < 8; ++ch) { float X[16]; const int cn = (ch < 7) ? ch + 1 : 7;
        const h8 n0 = *(const h8*)(base + (2 * cn) * 512), n1 = *(const h8*)(base + (2 * cn + 1) * 512);
#pragma unroll
        for (int i = 0; i < 8; ++i) { X[i] = __uint_as_float((__float_as_uint((float)v0[i]) & ~0x7Fu) | (unsigned)(ch * 16 + i));
            X[8 + i] = __uint_as_float((__float_as_uint((float)v1[i]) & ~0x7Fu) | (unsigned)(ch * 16 + 8 + i)); }
        sort16_desc(X);
        if (ch == 0) {
#pragma unroll
            for (int i = 0; i < 16; ++i) L[i] = X[i]; }
        else merge_top16(L, X);
        v0 = n0; v1 = n1; }
}
struct CandTab { int ci[64], cj[64]; };
__host__ __device__ constexpr CandTab make_cand() { CandTab t{}; int n = 0; for (int i = 0; i < 16; ++i) for (int j = 0; j < 16; ++j) if ((i + 1) * (j + 1) <= 16) { t.ci[n] = i; t.cj[n] = j; ++n; }
    for (; n < 64; ++n) { t.ci[n] = -1; t.cj[n] = -1; } return t; }
__device__ __forceinline__ void phase_topk(const Args& a, LAS unsigned char* lds, const pg8::StaticOrder& S, int wave, int lane) {
    constexpr CandTab CT = make_cand();
    const _Float16* st = (const _Float16*)(a.ws + WS_SCORES); int* eidx = (int*)(a.ws + WS_EIDX); float* eg = (float*)(a.ws + WS_EG);
    LAS unsigned char* tab = lds + wave * (64 * 36) + lane * 36;
    for (int j = wave; ; j += NWAVES) { pg8::Unit un; if (!S.next(j >> 2, un)) break; const int tg = 4 * un.pm + (j & 3), hh = un.pn; const int m = tg * 64 + lane;
        float A[16], B[16];
        top16_of_128(st + (size_t)((tg * 8 + hh) * 2 + 0) * 128 * 64 + lane * 8, A);
        top16_of_128(st + (size_t)((tg * 8 + hh) * 2 + 1) * 128 * 64 + lane * 8, B);
#pragma unroll
        for (int q = 0; q < 4; ++q) {
            const unsigned wa = (__float_as_uint(A[4 * q]) & 0x7Fu) | ((__float_as_uint(A[4 * q + 1]) & 0x7Fu) << 8) | ((__float_as_uint(A[4 * q + 2]) & 0x7Fu) << 16) | ((__float_as_uint(A[4 * q + 3]) & 0x7Fu) << 24);
            const unsigned wb = (__float_as_uint(B[4 * q]) & 0x7Fu) | ((__float_as_uint(B[4 * q + 1]) & 0x7Fu) << 8) | ((__float_as_uint(B[4 * q + 2]) & 0x7Fu) << 16) | ((__float_as_uint(B[4 * q + 3]) & 0x7Fu) << 24);
            *(LAS unsigned*)(tab + 4 * q) = wa; *(LAS unsigned*)(tab + 16 + 4 * q) = wb; }
#pragma unroll
        for (int i = 0; i < 16; ++i) { A[i] = __uint_as_float(__float_as_uint(A[i]) & ~0x7Fu); B[i] = __uint_as_float(__float_as_uint(B[i]) & ~0x7Fu); }
        float K[16];
#pragma unroll
        for (int c0 = 0; c0 < 64; c0 += 16) { float X[16];
#pragma unroll
            for (int i = 0; i < 16; ++i) { const int c = c0 + i;
                if (CT.ci[c] >= 0) X[i] = __uint_as_float((__float_as_uint(A[CT.ci[c] < 0 ? 0 : CT.ci[c]] + B[CT.cj[c] < 0 ? 0 : CT.cj[c]]) & ~0xFFu) | (unsigned)(CT.ci[c] * 16 + CT.cj[c]));
                else X[i] = -INFINITY; }
            sort16_desc(X);
            if (c0 == 0) {
#pragma unroll
                for (int i = 0; i < 16; ++i) K[i] = X[i]; }
            else merge_top16(K, X); }
        asm volatile("s_waitcnt lgkmcnt(0)" ::: "memory");
        int ex_[16]; float cs[16]; float sum = 0.f;
#pragma unroll
        for (int r = 0; r < 16; ++r) { const unsigned kb = __float_as_uint(K[r]); const int id = kb & 0xFF; cs[r] = __expf(__uint_as_float(kb & ~0xFFu) - __uint_as_float(__float_as_uint(K[0]) & ~0xFFu)); sum += cs[r];
            ex_[r] = (int)tab[id >> 4] * 128 + (int)tab[16 + (id & 15)]; }
        const float inv = 1.0f / sum;
        unsigned short* ep = (unsigned short*)eidx + (size_t)m * 128 + hh * 16; float* gp = eg + (size_t)m * 128 + hh * 16;
        { u32x4 p0, p1; p0.x = ex_[0] | (ex_[1] << 16); p0.y = ex_[2] | (ex_[3] << 16); p0.z = ex_[4] | (ex_[5] << 16); p0.w = ex_[6] | (ex_[7] << 16);
          p1.x = ex_[8] | (ex_[9] << 16); p1.y = ex_[10] | (ex_[11] << 16); p1.z = ex_[12] | (ex_[13] << 16); p1.w = ex_[14] | (ex_[15] << 16); *(u32x4*)ep = p0; *(u32x4*)(ep + 8) = p1; }
#pragma unroll
        for (int q = 0; q < 4; ++q) {
            *(f32x4*)(gp + 4 * q) = (f32x4){cs[4 * q] * inv, cs[4 * q + 1] * inv, cs[4 * q + 2] * inv, cs[4 * q + 3] * inv}; }
    }
}
__device__ __forceinline__ void fp8x16_to_f32(const u32x4 w, float (&f)[16]) {
    f32x2v t;
    t = __builtin_amdgcn_cvt_pk_f32_fp8((int)w.x, false); f[0] = t.x; f[1] = t.y; t = __builtin_amdgcn_cvt_pk_f32_fp8((int)w.x, true); f[2] = t.x; f[3] = t.y;
    t = __builtin_amdgcn_cvt_pk_f32_fp8((int)w.y, false); f[4] = t.x; f[5] = t.y; t = __builtin_amdgcn_cvt_pk_f32_fp8((int)w.y, true); f[6] = t.x; f[7] = t.y;
    t = __builtin_amdgcn_cvt_pk_f32_fp8((int)w.z, false); f[8] = t.x; f[9] = t.y; t = __builtin_amdgcn_cvt_pk_f32_fp8((int)w.z, true); f[10] = t.x; f[11] = t.y;
    t = __builtin_amdgcn_cvt_pk_f32_fp8((int)w.w, false); f[12] = t.x; f[13] = t.y; t = __builtin_amdgcn_cvt_pk_f32_fp8((int)w.w, true); f[14] = t.x; f[15] = t.y;
}
__device__ __forceinline__ void fp8x16_to_f32x2(const u32x4 w, f32x2v (&f)[8]) {
    f[0] = __builtin_amdgcn_cvt_pk_f32_fp8((int)w.x, false); f[1] = __builtin_amdgcn_cvt_pk_f32_fp8((int)(w.x >> 16), false);
    f[2] = __builtin_amdgcn_cvt_pk_f32_fp8((int)w.y, false); f[3] = __builtin_amdgcn_cvt_pk_f32_fp8((int)(w.y >> 16), false);
    f[4] = __builtin_amdgcn_cvt_pk_f32_fp8((int)w.z, false); f[5] = __builtin_amdgcn_cvt_pk_f32_fp8((int)(w.z >> 16), false);
    f[6] = __builtin_amdgcn_cvt_pk_f32_fp8((int)w.w, false); f[7] = __builtin_amdgcn_cvt_pk_f32_fp8((int)(w.w >> 16), false);
}
__device__ __forceinline__ float dpp_sum8(float v) {
    v += __int_as_float(__builtin_amdgcn_update_dpp(0, __float_as_int(v), 0xB1, 0xF, 0xF, true));
    v += __int_as_float(__builtin_amdgcn_update_dpp(0, __float_as_int(v), 0x4E, 0xF, 0xF, true));
    v += __int_as_float(__builtin_amdgcn_update_dpp(0, __float_as_int(v), 0x141, 0xF, 0xF, true));
    return v;
}
struct UTok { u32x4 e0, e1, xa, xb; };
struct VTok { u32x4 e0, e1; f32x4 av[4]; };
__device__ __forceinline__ void pu_issue(const unsigned char* tab, unsigned loff, const u32x4& e, u32x4 (&w)[8]) {
    w[0] = *(const u32x4*)(tab + ((e.x & 0xffffu) * 128u + loff)); w[1] = *(const u32x4*)(tab + ((e.x >> 16) * 128u + loff));
    w[2] = *(const u32x4*)(tab + ((e.y & 0xffffu) * 128u + loff)); w[3] = *(const u32x4*)(tab + ((e.y >> 16) * 128u + loff));
    w[4] = *(const u32x4*)(tab + ((e.z & 0xffffu) * 128u + loff)); w[5] = *(const u32x4*)(tab + ((e.z >> 16) * 128u + loff));
    w[6] = *(const u32x4*)(tab + ((e.w & 0xffffu) * 128u + loff)); w[7] = *(const u32x4*)(tab + ((e.w >> 16) * 128u + loff));
}
__device__ __forceinline__ void pu_dots(const int (&xq)[4], const u32x4 (&w)[8], int (&d)[8]) {
#pragma unroll
    for (int q = 0; q < 8; ++q) { int t = __builtin_amdgcn_sdot4((int)w[q].x, xq[0], 0, false); t = __builtin_amdgcn_sdot4((int)w[q].y, xq[1], t, false);
        t = __builtin_amdgcn_sdot4((int)w[q].z, xq[2], t, false); d[q] = __builtin_amdgcn_sdot4((int)w[q].w, xq[3], t, false); }
}
__device__ __forceinline__ void pu_reduce(const int (&d0)[8], const int (&d1)[8], int lane, int& lo, int& hi) {
    const bool b2 = (lane & 4) != 0, b1 = (lane & 2) != 0, b0 = (lane & 1) != 0;
    int a[8];
#pragma unroll
    for (int q = 0; q < 4; ++q) { const int s0 = b2 ? d0[q] : d0[4 + q], k0 = b2 ? d0[4 + q] : d0[q], s1 = b2 ? d1[q] : d1[4 + q], k1 = b2 ? d1[4 + q] : d1[q];
        a[q] = k0 + __builtin_amdgcn_update_dpp(0, s0, 0x141, 0xF, 0xF, true); a[4 + q] = k1 + __builtin_amdgcn_update_dpp(0, s1, 0x141, 0xF, 0xF, true); }
    int bq[4];
#pragma unroll
    for (int q = 0; q < 2; ++q) { const int s0 = b1 ? a[q] : a[2 + q], k0 = b1 ? a[2 + q] : a[q], s1 = b1 ? a[4 + q] : a[6 + q], k1 = b1 ? a[6 + q] : a[4 + q];
        bq[q] = k0 + __builtin_amdgcn_update_dpp(0, s0, 0x4E, 0xF, 0xF, true); bq[2 + q] = k1 + __builtin_amdgcn_update_dpp(0, s1, 0x4E, 0xF, 0xF, true); }
    { const int s0 = b0 ? bq[0] : bq[1], k0 = b0 ? bq[1] : bq[0], s1 = b0 ? bq[2] : bq[3], k1 = b0 ? bq[3] : bq[2];
        lo = k0 + __builtin_amdgcn_update_dpp(0, s0, 0xB1, 0xF, 0xF, true); hi = k1 + __builtin_amdgcn_update_dpp(0, s1, 0xB1, 0xF, 0xF, true); }
}
__device__ __forceinline__ float pu_quant_x(const u32x4& xa, const u32x4& xb, int (&xq)[4]) {
    float f[16]; unpack8(xa, *(float(*)[8])&f[0]); unpack8(xb, *(float(*)[8])&f[8]);
    float mx = 0.f;
#pragma unroll
    for (int c = 0; c < 16; ++c) mx = fmaxf(mx, fabsf(f[c]));
    mx = fmaxf(mx, __int_as_float(__builtin_amdgcn_update_dpp(0, __float_as_int(mx), 0xB1, 0xF, 0xF, true)));
    mx = fmaxf(mx, __int_as_float(__builtin_amdgcn_update_dpp(0, __float_as_int(mx), 0x4E, 0xF, 0xF, true)));
    mx = fmaxf(mx, __int_as_float(__builtin_amdgcn_update_dpp(0, __float_as_int(mx), 0x141, 0xF, 0xF, true)));
    const float sc = (mx > 0.f) ? 127.0f * __builtin_amdgcn_rcpf(mx) * 0.99999f : 0.f;
#pragma unroll
    for (int c4 = 0; c4 < 4; ++c4) xq[c4] = (int)q8x4((f32x4){f[4 * c4], f[4 * c4 + 1], f[4 * c4 + 2], f[4 * c4 + 3]}, sc);
    return mx * (1.0f / 127.0f);
}
__device__ __forceinline__ void phase_peer_u(const Args& a, int wave, int lane) {
    const int s = SLICE_OF(blockIdx.x), rk = RANK_OF(blockIdx.x), nrk = gridDim.x >> 3, tper = T / nrk, i = lane & 7, j = lane >> 3;
    const bf16_t* h1b = (const bf16_t*)(a.ws + WS_H1B) + 128 * s + 16 * i; const unsigned char* uqs = a.ws + WS_UB + (size_t)s * NEXP * 128; const unsigned loff = 16u * (unsigned)i;
    const unsigned short* eidx = (const unsigned short*)(a.ws + WS_EIDX) + 16 * j; float* pd = (float*)(a.ws + WS_PD) + (size_t)s * T * 128 + 16 * j + i;
    const int m0 = rk * tper + wave, mlast = (rk + 1) * tper - NWAVES + wave;
#define PU_LOAD(t, mm) do { const int m_ = (mm) < mlast ? (mm) : mlast; const u32x4* ep_ = (const u32x4*)(eidx + (size_t)m_ * 128); (t).e0 = ep_[0]; (t).e1 = ep_[1]; \
        (t).xa = *(const u32x4*)(h1b + (size_t)m_ * DM); (t).xb = *(const u32x4*)(h1b + (size_t)m_ * DM + 8); } while (0)
#define PU_DO(t, w0, w1, mm) do { int xq_[4]; const float sx_ = pu_quant_x((t).xa, (t).xb, xq_); int d0_[8], d1_[8], lo_, hi_; pu_dots(xq_, w0, d0_); pu_dots(xq_, w1, d1_); \
        pu_reduce(d0_, d1_, lane, lo_, hi_); pd[(size_t)(mm) * 128] = (float)lo_ * sx_; pd[(size_t)(mm) * 128 + 8] = (float)hi_ * sx_; } while (0)
    UTok tC, tN, tNN; u32x4 wA[8], wB[8], wC[8], wD[8];
    PU_LOAD(tC, m0); PU_LOAD(tN, m0 + NWAVES); PU_LOAD(tNN, m0 + 2 * NWAVES); pu_issue(uqs, loff, tC.e0, wA); pu_issue(uqs, loff, tC.e1, wB);
    for (int m = m0; m <= mlast; m += 2 * NWAVES) {
        pu_issue(uqs, loff, tN.e0, wC); pu_issue(uqs, loff, tN.e1, wD);
        PU_DO(tC, wA, wB, m);
        tC = tN; tN = tNN; PU_LOAD(tNN, m + 3 * NWAVES);
        pu_issue(uqs, loff, tN.e0, wA); pu_issue(uqs, loff, tN.e1, wB);
        PU_DO(tC, wC, wD, m + NWAVES);
        tC = tN; tN = tNN; PU_LOAD(tNN, m + 4 * NWAVES);
    }
#undef PU_LOAD
#undef PU_DO
}
typedef long i64_t;
__device__ __forceinline__ i64_t pack64(unsigned lo, unsigned hi) { return (i64_t)(((unsigned long long)hi << 32) | (unsigned long long)lo); }
struct MTokI { u32x4 ia, ib; };
struct MTokX { u32x4 xq[4]; };
__device__ __forceinline__ unsigned id16(const u32x4& v, int c) { const unsigned wv = (c >> 1) == 0 ? v.x : (c >> 1) == 1 ? v.y : (c >> 1) == 2 ? v.z : v.w; return (c & 1) ? (wv >> 16) : (wv & 0xffffu); }
__device__ __forceinline__ void pm_issue(const unsigned char* tab, unsigned loff, const MTokI& t, u32x4 (&W)[16]) {
#pragma unroll
    for (int c = 0; c < 8; ++c) { W[2 * c] = *(const u32x4*)(tab + (id16(t.ia, c) * 128u + loff)); W[2 * c + 1] = *(const u32x4*)(tab + (id16(t.ib, c) * 128u + loff)); }
}
template <bool HI> __device__ __forceinline__ unsigned bf2_to_fp8x2(unsigned w, int old) { const float a = fminf(fmaxf(bflo(w), -448.f), 448.f), b = fminf(fmaxf(bfhi(w), -448.f), 448.f); return (unsigned)__builtin_amdgcn_cvt_pk_fp8_f32(a, b, old, HI); }
__device__ __forceinline__ void pm_compute(const MTokX& t, const u32x4 (&W)[16], LAS unsigned char* wl  , float* pdrow  , int lane) {
    unsigned xb[8];
#pragma unroll
    for (int q = 0; q < 4; ++q) { unsigned lo = bf2_to_fp8x2<false>(t.xq[q].x, 0); lo = bf2_to_fp8x2<true>(t.xq[q].y, (int)lo); unsigned hi = bf2_to_fp8x2<false>(t.xq[q].z, 0); hi = bf2_to_fp8x2<true>(t.xq[q].w, (int)hi); xb[2 * q] = lo; xb[2 * q + 1] = hi; }
    const i64_t B0 = pack64(xb[0], xb[1]), B1 = pack64(xb[2], xb[3]), B2 = pack64(xb[4], xb[5]), B3 = pack64(xb[6], xb[7]);
    const int j8 = lane >> 3, i = lane & 7, r = lane & 15, g = lane >> 4;
    LAS unsigned char* wr0 = wl + j8 * 144 + i * 16;
    const LAS unsigned char* rd0 = wl + r * 144 + g * 32;
    f32x4 C[8];
#pragma unroll
    for (int c = 0; c < 8; ++c) { const int bo = (c & 1) * 2304;
        *(LAS u32x4*)(wr0 + bo) = W[2 * c]; *(LAS u32x4*)(wr0 + bo + 8 * 144) = W[2 * c + 1];
        const u32x4 a0 = *(const LAS u32x4*)(rd0 + bo), a1 = *(const LAS u32x4*)(rd0 + bo + 16);
        f32x4 acc = (f32x4){0.f, 0.f, 0.f, 0.f};
        acc = __builtin_amdgcn_mfma_f32_16x16x32_fp8_fp8(pack64(a0.x, a0.y), B0, acc, 0, 0, 0);
        acc = __builtin_amdgcn_mfma_f32_16x16x32_fp8_fp8(pack64(a0.z, a0.w), B1, acc, 0, 0, 0);
        acc = __builtin_amdgcn_mfma_f32_16x16x32_fp8_fp8(pack64(a1.x, a1.y), B2, acc, 0, 0, 0);
        acc = __builtin_amdgcn_mfma_f32_16x16x32_fp8_fp8(pack64(a1.z, a1.w), B3, acc, 0, 0, 0); C[c] = acc; }
    if ((lane & 15) == 0) {
#pragma unroll
        for (int reg = 0; reg < 4; ++reg) { *(f32x4*)(pdrow + 8 * reg) = (f32x4){C[0][reg], C[1][reg], C[2][reg], C[3][reg]}; *(f32x4*)(pdrow + 8 * reg + 4) = (f32x4){C[4][reg], C[5][reg], C[6][reg], C[7][reg]}; } }
}
__device__ __forceinline__ void phase_peer_u_mfma(const Args& a, LAS unsigned char* lds, int wave, int lane) {
    const int s = SLICE_OF(blockIdx.x), rk = RANK_OF(blockIdx.x), nrk = gridDim.x >> 3, tper = T / nrk, g = lane >> 4, j8 = lane >> 3;
    const bf16_t* h1b = (const bf16_t*)(a.ws + WS_H1B) + 128 * s + 32 * g; const unsigned char* uqs = a.ws + WS_UB + (size_t)s * NEXP * 128; const unsigned loff = 16u * (unsigned)(lane & 7);
    const unsigned short* eidx = (const unsigned short*)(a.ws + WS_EIDX) + 8 * j8; float* pd = (float*)(a.ws + WS_PD) + (size_t)s * T * 128 + 32 * g;
    LAS unsigned char* wl = lds + wave * 4608;
    const int m0 = rk * tper + wave, mlast = (rk + 1) * tper - NWAVES + wave;
#define PM_LOADI(t, mm) do { const int m_ = (mm) < mlast ? (mm) : mlast; (t).ia = *(const u32x4*)(eidx + (size_t)m_ * 128); (t).ib = *(const u32x4*)(eidx + (size_t)m_ * 128 + 64); } while (0)
#define PM_LOADX(t, mm) do { const int m_ = (mm) < mlast ? (mm) : mlast; const u32x4* xp_ = (const u32x4*)(h1b + (size_t)m_ * DM); (t).xq[0] = xp_[0]; (t).xq[1] = xp_[1]; (t).xq[2] = xp_[2]; (t).xq[3] = xp_[3]; } while (0)
    MTokI iC, iN, iNN; MTokX xC, xN; u32x4 WA[16], WB[16];
    PM_LOADI(iC, m0); PM_LOADI(iN, m0 + NWAVES); PM_LOADI(iNN, m0 + 2 * NWAVES); PM_LOADX(xC, m0); PM_LOADX(xN, m0 + NWAVES); pm_issue(uqs, loff, iC, WA);
    for (int m = m0; m <= mlast; m += 2 * NWAVES) {
        pm_issue(uqs, loff, iN, WB);
        pm_compute(xC, WA, wl, pd + (size_t)m * 128, lane);
        iC = iN; iN = iNN; PM_LOADI(iNN, m + 3 * NWAVES); xC = xN; PM_LOADX(xN, m + 2 * NWAVES);
        pm_issue(uqs, loff, iN, WA);
        pm_compute(xC, WB, wl, pd + (size_t)(m + NWAVES) * 128, lane);
        iC = iN; iN = iNN; PM_LOADI(iNN, m + 4 * NWAVES); xC = xN; PM_LOADX(xN, m + 3 * NWAVES);
    }
#undef PM_LOADI
#undef PM_LOADX
}
__device__ __forceinline__ void phase_peer_act(const Args& a, int tid) {
    const float* pd = (const float*)(a.ws + WS_PD); const unsigned short* eidx = (const unsigned short*)(a.ws + WS_EIDX); const float* eg = (const float*)(a.ws + WS_EG);
    const float* su = (const float*)(a.ws + WS_SU); const float* sv = (const float*)(a.ws + WS_SV); const float* rowss = (const float*)(a.ws + WS_ROWSS); float* act = (float*)(a.ws + WS_ACT);
    for (size_t i4 = (size_t)blockIdx.x * NTHR + tid; i4 < (size_t)T * 32; i4 += (size_t)gridDim.x * NTHR) { const size_t idx = i4 * 4;
        f32x4 d = *(const f32x4*)(pd + idx);
#pragma unroll
        for (int s = 1; s < 8; ++s) d += *(const f32x4*)(pd + (size_t)s * T * 128 + idx);
        const u32x2 ew = *(const u32x2*)(eidx + idx); const f32x4 g = *(const f32x4*)(eg + idx); const float rstd = rsqrtf(rowss[idx >> 7] * (1.f / DM) + EPSF);
        const unsigned e0 = ew.x & 0xffffu, e1 = ew.x >> 16, e2 = ew.y & 0xffffu, e3 = ew.y >> 16;
        f32x4 o; o.x = gelu_tanh(d.x * su[e0] * rstd) * g.x * sv[e0]; o.y = gelu_tanh(d.y * su[e1] * rstd) * g.y * sv[e1];
        o.z = gelu_tanh(d.z * su[e2] * rstd) * g.z * sv[e2]; o.w = gelu_tanh(d.w * su[e3] * rstd) * g.w * sv[e3];
        *(f32x4*)(act + idx) = o;
    }
}
__device__ __forceinline__ void pv_quad(const u32x4& w0, const u32x4& w1, const u32x4& w2, const u32x4& w3, int a4, int (&oi)[16]) {
#define PV_BLK(d, base) do { const unsigned lo01 = __builtin_amdgcn_perm(w1.d, w0.d, 0x05010400u), hi01 = __builtin_amdgcn_perm(w1.d, w0.d, 0x07030602u); \
        const unsigned lo23 = __builtin_amdgcn_perm(w3.d, w2.d, 0x05010400u), hi23 = __builtin_amdgcn_perm(w3.d, w2.d, 0x07030602u); \
        oi[base + 0] = __builtin_amdgcn_sdot4((int)__builtin_amdgcn_perm(lo23, lo01, 0x05040100u), a4, oi[base + 0], false); \
        oi[base + 1] = __builtin_amdgcn_sdot4((int)__builtin_amdgcn_perm(lo23, lo01, 0x07060302u), a4, oi[base + 1], false); \
        oi[base + 2] = __builtin_amdgcn_sdot4((int)__builtin_amdgcn_perm(hi23, hi01, 0x05040100u), a4, oi[base + 2], false); \
        oi[base + 3] = __builtin_amdgcn_sdot4((int)__builtin_amdgcn_perm(hi23, hi01, 0x07060302u), a4, oi[base + 3], false); } while (0)
    PV_BLK(x, 0); PV_BLK(y, 4); PV_BLK(z, 8); PV_BLK(w, 12);
#undef PV_BLK
}
__device__ __forceinline__ float pv_quant_act(const f32x4 (&av)[4], int (&a4)[4]) {
    float mx = 0.f;
#pragma unroll
    for (int q = 0; q < 4; ++q) mx = fmaxf(mx, fmaxf(fmaxf(fabsf(av[q].x), fabsf(av[q].y)), fmaxf(fabsf(av[q].z), fabsf(av[q].w))));
    const float sc = (mx > 0.f) ? 127.0f * __builtin_amdgcn_rcpf(mx) * 0.99999f : 0.f;
#pragma unroll
    for (int q = 0; q < 4; ++q) a4[q] = (int)q8x4(av[q], sc);
    return mx * (1.0f / 127.0f);
}
__device__ __forceinline__ void pv_finish(const int (&oi)[16], float sa, bf16_t* orow  , int lane) {
    float o[16];
#pragma unroll
    for (int c = 0; c < 16; ++c) o[c] = (float)oi[c] * sa;
    const bool b3 = (lane & 8) != 0, b4 = (lane & 16) != 0, b5 = (lane & 32) != 0;
    float k8[8], k4[4], k2[2];
#pragma unroll
    for (int c = 0; c < 8; ++c) { const float snd = b3 ? o[c] : o[8 + c], kp = b3 ? o[8 + c] : o[c]; k8[c] = kp + dpp_xor8(snd); }
#pragma unroll
    for (int c = 0; c < 4; ++c) { const float snd = b4 ? k8[c] : k8[4 + c], kp = b4 ? k8[4 + c] : k8[c]; k4[c] = kp + __shfl_xor(snd, 16); }
#pragma unroll
    for (int c = 0; c < 2; ++c) { const float snd = b5 ? k4[c] : k4[2 + c], kp = b5 ? k4[2 + c] : k4[c]; k2[c] = kp + __shfl_xor(snd, 32); }
    *(unsigned*)(orow + ((lane & 8) ? 8 : 0) + ((lane & 16) ? 4 : 0) + ((lane & 32) ? 2 : 0)) = pk2(k2[0], k2[1]);
}
__device__ __forceinline__ void phase_peer_v(const Args& a, int wave, int lane) {
    const int s = SLICE_OF(blockIdx.x), rk = RANK_OF(blockIdx.x), nrk = gridDim.x >> 3, tper = T / nrk, i = lane & 7, j = lane >> 3;
    const unsigned char* vqs = a.ws + WS_VB + (size_t)s * NEXP * 128; const unsigned loff = 16u * (unsigned)i;
    const unsigned short* eidx = (const unsigned short*)(a.ws + WS_EIDX) + 16 * j; const float* act = (const float*)(a.ws + WS_ACT) + 16 * j;
    bf16_t* obase = (bf16_t*)(a.ws + WS_PO) + 128 * s + 16 * i;
    const int m0 = rk * tper + wave, mlast = (rk + 1) * tper - NWAVES + wave;
#define PV_LOAD(t, mm) do { const int m_ = (mm) < mlast ? (mm) : mlast; const u32x4* ep_ = (const u32x4*)(eidx + (size_t)m_ * 128); const f32x4* ap_ = (const f32x4*)(act + (size_t)m_ * 128); \
        (t).e0 = ep_[0]; (t).e1 = ep_[1]; (t).av[0] = ap_[0]; (t).av[1] = ap_[1]; (t).av[2] = ap_[2]; (t).av[3] = ap_[3]; } while (0)
    VTok tC, tN, tNN; u32x4 wA[8], wB[8];
    PV_LOAD(tC, m0); PV_LOAD(tN, m0 + NWAVES); PV_LOAD(tNN, m0 + 2 * NWAVES); pu_issue(vqs, loff, tC.e0, wA);
    for (int m = m0; m <= mlast; m += NWAVES) {
        pu_issue(vqs, loff, tC.e1, wB);
        int oi_[16];
#pragma unroll
        for (int c = 0; c < 16; ++c) oi_[c] = 0;
        int a4_[4]; const float sa_ = pv_quant_act(tC.av, a4_);
        pv_quad(wA[0], wA[1], wA[2], wA[3], a4_[0], oi_); pv_quad(wA[4], wA[5], wA[6], wA[7], a4_[1], oi_);
        pu_issue(vqs, loff, tN.e0, wA);
        pv_quad(wB[0], wB[1], wB[2], wB[3], a4_[2], oi_); pv_quad(wB[4], wB[5], wB[6], wB[7], a4_[3], oi_);
        pv_finish(oi_, sa_, obase + (size_t)m * DM, lane);
        tC = tN; tN = tNN; PV_LOAD(tNN, m + 3 * NWAVES);
    }
#undef PV_LOAD
}
__device__ __forceinline__ void phase_final(const Args& a, int wave, int lane) {
    const int gw = blockIdx.x * NWAVES + wave, NGW = gridDim.x * NWAVES; const bf16_t* po = (const bf16_t*)(a.ws + WS_PO) + 16 * lane; const bf16_t* h1b = (const bf16_t*)(a.ws + WS_H1B) + 16 * lane;
    f32x4 gf[4];
#pragma unroll
    for (int jj = 0; jj < 4; ++jj) gf[jj] = *(const f32x4*)(a.in[I_GFINAL] + 16 * lane + 4 * jj);
    for (int m0 = gw; m0 < T; m0 += 4 * NGW) {
        u32x4 hq[4][2], pq[4][2];
#pragma unroll
        for (int r = 0; r < 4; ++r) { const int m = (m0 + r * NGW < T) ? m0 + r * NGW : m0;
            hq[r][0] = *(const u32x4*)(h1b + (size_t)m * DM); hq[r][1] = *(const u32x4*)(h1b + (size_t)m * DM + 8); pq[r][0] = *(const u32x4*)(po + (size_t)m * DM); pq[r][1] = *(const u32x4*)(po + (size_t)m * DM + 8); }
#pragma unroll
        for (int r = 0; r < 4; ++r) { const int m = m0 + r * NGW; if (m >= T) break;
            float hb[16], pp[16]; unpack8(hq[r][0], *(float(*)[8])&hb[0]); unpack8(hq[r][1], *(float(*)[8])&hb[8]); unpack8(pq[r][0], *(float(*)[8])&pp[0]); unpack8(pq[r][1], *(float(*)[8])&pp[8]);
            f32x4 h[4]; float ss = 0.f;
#pragma unroll
            for (int jj = 0; jj < 4; ++jj) { h[jj] = (f32x4){hb[4 * jj] + pp[4 * jj], hb[4 * jj + 1] + pp[4 * jj + 1], hb[4 * jj + 2] + pp[4 * jj + 2], hb[4 * jj + 3] + pp[4 * jj + 3]};
                ss += (h[jj].x * h[jj].x + h[jj].y * h[jj].y) + (h[jj].z * h[jj].z + h[jj].w * h[jj].w); }
            const float r2 = rsqrtf(wave_sum_dpp(ss) * (1.f / DM) + EPSF);
            float* orow = a.out + (size_t)m * DM + 16 * lane;
#pragma unroll
            for (int jj = 0; jj < 4; ++jj) *(f32x4*)(orow + 4 * jj) = h[jj] * r2 * gf[jj]; }
    }
}
typedef short bf16x8_t __attribute__((ext_vector_type(8)));
__device__ __forceinline__ bf16x8_t toep_frag(const LAS unsigned* R32, int base) {
    const int e = base >> 1, sh = (base & 1) * 16;
    const unsigned d0 = R32[e], d1 = R32[e + 1], d2 = R32[e + 2], d3 = R32[e + 3], d4 = R32[e + 4];
    u32x4 o; o.x = __builtin_amdgcn_alignbit(d1, d0, sh); o.y = __builtin_amdgcn_alignbit(d2, d1, sh); o.z = __builtin_amdgcn_alignbit(d3, d2, sh); o.w = __builtin_amdgcn_alignbit(d4, d3, sh);
    return __builtin_bit_cast(bf16x8_t, o);
}
__device__ __forceinline__ void hy_conv_channel(const Args& a, LAS unsigned char* lds, int c, int tid, int wave, int lane) {
    constexpr int UROW = SP * 2;
    LAS unsigned char* uus = lds;
    LAS unsigned short* R = (LAS unsigned short*)(lds + 8 * UROW);
    const bf16_t* uut = (const bf16_t*)(a.ws + WS_UUT); const bf16_t* kfb = (const bf16_t*)(a.ws + WS_KFB); bf16_t* cvt = (bf16_t*)(a.ws + WS_CONVT);
    { const u32x4* src = (const u32x4*)(uut + (size_t)c * NB * SP); for (int i = tid; i < 8 * UROW / 16; i += NTHR) ((LAS u32x4*)uus)[i] = src[i]; }
    for (int n = tid; n < KFW + 16; n += NTHR) R[n] = (n < KFW) ? kfb[(size_t)c * KFW + (KFW - 1) - n] : (unsigned short)0;
    __syncthreads();
    const LAS unsigned* R32 = (const LAS unsigned*)R;
    const int i = lane & 15, g = lane >> 4, p = (lane >> 3) & 1, b = lane & 7;
    f32x4 C[16]; bf16x8_t A[16];
    const int abase = LT - 32 * (1 + 16 * wave) - i + 8 * g;
#pragma unroll
    for (int tb = 0; tb < 16; ++tb) { C[tb] = (f32x4){0.f, 0.f, 0.f, 0.f}; A[tb] = toep_frag(R32, abase - 32 * tb); }
    const LAS unsigned char* bptr = uus + b * UROW + (16 * p + 8 * g) * 2;
#define HC_STEP(ph, n) do { A[(16 - (ph)) & 15] = toep_frag(R32, abase + 32 * (n)); const bf16x8_t Bf = *(const LAS bf16x8_t*)(bptr + (n) * 64); \
        _Pragma("unroll") for (int tb = 0; tb < 16; ++tb) C[tb] = __builtin_amdgcn_mfma_f32_16x16x32_bf16(A[(tb - (ph)) & 15], Bf, C[tb], 0, 0, 0); __builtin_amdgcn_sched_barrier(0); } while (0)
    for (int G = 0; G < 8; ++G) { const int n0 = G * 16;
        HC_STEP(0, n0); HC_STEP(1, n0 + 1); HC_STEP(2, n0 + 2); HC_STEP(3, n0 + 3); HC_STEP(4, n0 + 4); HC_STEP(5, n0 + 5); HC_STEP(6, n0 + 6); HC_STEP(7, n0 + 7);
        HC_STEP(8, n0 + 8); HC_STEP(9, n0 + 9); HC_STEP(10, n0 + 10); HC_STEP(11, n0 + 11); HC_STEP(12, n0 + 12); HC_STEP(13, n0 + 13); HC_STEP(14, n0 + 14); HC_STEP(15, n0 + 15); }
    HC_STEP(0, 128);
#undef HC_STEP
#pragma unroll
    for (int tb = 0; tb < 16; ++tb) { const int tq = 512 * wave + 32 * tb + 16 * p + 4 * g;
        u32x2 w; w.x = pk2(C[tb][0], C[tb][1]); w.y = pk2(C[tb][2], C[tb][3]);
        *(u32x2*)(cvt + ((size_t)c * NB + b) * SEQ + tq) = w; }
    __syncthreads();
}
__device__ __forceinline__ void rg_item(const Args& a, LAS unsigned char* lds, int it, int tid, int wave, int lane) {
    constexpr int XROW = 272;
    const int head = it & 7, dir = (it >> 3) & 1, b = it >> 4;
    const bf16_t* xb = (const bf16_t*)(a.ws + WS_RGX) + (size_t)b * LT * DRG + head * 128;
    bf16_t* hout = (bf16_t*)a.out + (size_t)dir * T * DRG + (size_t)b * SEQ * DRG + head * 128 + 16 * wave + (lane & 15);
    const int col = lane & 15, g = lane >> 4, ch = head * 128 + 16 * wave + col;
    LAS unsigned char* wl = lds + 2 * 64 * XROW + wave * 1024 + lane * 16;
#pragma unroll
    for (int gt = 0; gt < 2; ++gt)
#pragma unroll
        for (int ks = 0; ks < 4; ++ks) { const float* wp = a.in[I_RGGW] + ((size_t)((dir * 2 + gt) * 8 + head) * 128 + 32 * ks + 8 * g) * 128 + 16 * wave + col;
            u32x4 o; o.x = pk2(wp[0], wp[128]); o.y = pk2(wp[256], wp[384]); o.z = pk2(wp[512], wp[640]); o.w = pk2(wp[768], wp[896]); *(LAS u32x4*)(wl + (gt * 4 + ks) * 8192) = o; }
    const float br = a.in[I_RGGB][(size_t)(dir * 2 + 0) * DRG + ch], bi = a.in[I_RGGB][(size_t)(dir * 2 + 1) * DRG + ch];
    const float sp8 = -8.0f * log1pf(__expf(-a.in[I_RGLAM][dir * DRG + ch]));
    const int ctr = tid >> 4, ccg = tid & 15;
    float cwv[4][8], cbv[8];
#pragma unroll
    for (int i = 0; i < 8; ++i) { cbv[i] = a.in[I_RGCB][(size_t)dir * DRG + head * 128 + 8 * ccg + i];
#pragma unroll
        for (int j = 0; j < 4; ++j) cwv[j][i] = a.in[I_RGCW][((size_t)dir * 4 + j) * DRG + head * 128 + 8 * ccg + i]; }
    u32x4 xr[2][4];
#define RG_LOAD(k) do { _Pragma("unroll") for (int h_ = 0; h_ < 2; ++h_) { const int u_ = 64 * (k) + ctr + 32 * h_; _Pragma("unroll") for (int j = 0; j < 4; ++j) { const int uu_ = u_ - j; \
        if (uu_ >= 0 && uu_ < LT) { const int t_ = dir ? (LT - 1 - uu_) : uu_; xr[h_][j] = *(const u32x4*)(xb + (size_t)t_ * DRG + 8 * ccg); } \
        else xr[h_][j] = (u32x4){0u, 0u, 0u, 0u}; } } } while (0)
#define RG_CONV(k) do { _Pragma("unroll") for (int h_ = 0; h_ < 2; ++h_) { const int u_ = 64 * (k) + ctr + 32 * h_; float o_[8]; _Pragma("unroll") for (int i = 0; i < 8; ++i) o_[i] = (u_ < LT) ? cbv[i] : 0.f; \
        _Pragma("unroll") for (int j = 0; j < 4; ++j) { float f_[8]; unpack8(xr[h_][j], f_); _Pragma("unroll") for (int i = 0; i < 8; ++i) o_[i] += f_[i] * cwv[j][i]; } \
        u32x4 w0_; w0_.x = pk2(o_[0], o_[1]); w0_.y = pk2(o_[2], o_[3]); w0_.z = pk2(o_[4], o_[5]); w0_.w = pk2(o_[6], o_[7]); \
        *(LAS u32x4*)(lds + ((k) & 1) * (64 * XROW) + (ctr + 32 * h_) * XROW + ccg * 16) = w0_; } } while (0)
    RG_LOAD(0); RG_CONV(0); RG_LOAD(1);
    __syncthreads();
    float carry = 0.f;
    const int arow = 16 * (col >> 2) + (col & 3);
    for (int k = 0; k < 65; ++k) {
        if (k + 1 < 65) RG_CONV(k + 1);
        if (k + 2 < 65) RG_LOAD(k + 2);
        const LAS unsigned char* xa = lds + (k & 1) * (64 * XROW);
        unsigned hp[16]; float hh = 0.f, PP = 1.f;
#pragma unroll
        for (int mp = 0; mp < 2; ++mp) {
            f32x4 acc[2][2];
#pragma unroll
            for (int m2 = 0; m2 < 2; ++m2) { const int mb = 2 * mp + m2; acc[0][m2] = (f32x4){0.f, 0.f, 0.f, 0.f}; acc[1][m2] = (f32x4){0.f, 0.f, 0.f, 0.f};
#pragma unroll
                for (int ks = 0; ks < 4; ++ks) { const bf16x8_t Af = *(const LAS bf16x8_t*)(xa + (arow + 4 * mb) * XROW + (32 * ks + 8 * g) * 2);
                    acc[0][m2] = __builtin_amdgcn_mfma_f32_16x16x32_bf16(Af, *(const LAS bf16x8_t*)(wl + ks * 8192), acc[0][m2], 0, 0, 0);
                    acc[1][m2] = __builtin_amdgcn_mfma_f32_16x16x32_bf16(Af, *(const LAS bf16x8_t*)(wl + (4 + ks) * 8192), acc[1][m2], 0, 0, 0); } }
#pragma unroll
            for (int m2 = 0; m2 < 2; ++m2)
#pragma unroll
                for (int r = 0; r < 4; ++r) { const int e = 8 * mp + 4 * m2 + r, tau = 16 * g + e, u = 64 * k + tau;
                    const float rr = sigmoidf_(acc[0][m2][r] + br), ii = sigmoidf_(acc[1][m2][r] + bi);
                    float av = fexp(sp8 * rr); float mult = __builtin_amdgcn_sqrtf(fmaxf(1.0f - av * av, 0.f)); mult = (u == 0) ? 1.0f : mult;
                    const float xcv = bf2f(*(const LAS unsigned short*)(xa + tau * XROW + (16 * wave + col) * 2));
                    float bq = mult * ii * xcv; if (u >= LT) { av = 1.f; bq = 0.f; }
                    hh = av * hh + bq; PP *= av; hp[e] = pk2(hh, PP); }
        }
        float Pg[4], hg[4];
#pragma unroll
        for (int q = 0; q < 4; ++q) { Pg[q] = __shfl(PP, col + 16 * q); hg[q] = __shfl(hh, col + 16 * q); }
        const float H0 = carry, H1 = Pg[0] * H0 + hg[0], H2 = Pg[1] * H1 + hg[1], H3 = Pg[2] * H2 + hg[2], H4 = Pg[3] * H3 + hg[3];
        const float Hin = (g == 0) ? H0 : (g == 1) ? H1 : (g == 2) ? H2 : H3;
        carry = H4;
#pragma unroll
        for (int e = 0; e < 16; ++e) { const int u = 64 * k + 16 * g + e; const int t = dir ? (LT - 1 - u) : u;
            if (u < LT && t >= NMETA) hout[(size_t)(t - NMETA) * DRG] = (bf16_t)f2bf(bflo(hp[e]) + bfhi(hp[e]) * Hin); }
        __syncthreads();
    }
#undef RG_LOAD
#undef RG_CONV
}
__device__ __forceinline__ void rg_item2(const Args& a, LAS unsigned char* lds, int it, int tid, int wave, int lane) {
    constexpr int XROW = 272;
    const int hh = it & 1, head = (it >> 1) & 7, dir = (it >> 4) & 1, b = it >> 5;
    const bf16_t* xb = (const bf16_t*)(a.ws + WS_RGX) + (size_t)b * LT * DRG + head * 128;
    const int col = lane & 15, g = lane >> 4, gate = col >> 3, cj = col & 7, chl = 64 * hh + 8 * wave + cj, ch = head * 128 + chl, qg = 2 * g + gate;
    bf16_t* hout = (bf16_t*)a.out + (size_t)dir * T * DRG + (size_t)b * SEQ * DRG + ch;
    bf16x8_t Wf[4];
#pragma unroll
    for (int ks = 0; ks < 4; ++ks) { const float* wp = a.in[I_RGGW] + ((size_t)((dir * 2 + gate) * 8 + head) * 128 + 32 * ks + 8 * g) * 128 + chl;
        u32x4 o; o.x = pk2(wp[0], wp[128]); o.y = pk2(wp[256], wp[384]); o.z = pk2(wp[512], wp[640]); o.w = pk2(wp[768], wp[896]); Wf[ks] = __builtin_bit_cast(bf16x8_t, o); }
    const float LOG2E = 1.4426950408889634f;
    const float bgl = a.in[I_RGGB][(size_t)(dir * 2 + gate) * DRG + ch] * LOG2E;
    const float sp8l = -8.0f * log1pf(__expf(-a.in[I_RGLAM][dir * DRG + ch])) * LOG2E;
    const int ctr = tid >> 4, ccg = tid & 15;
    float cwv[4][8], cbv[8];
#pragma unroll
    for (int i = 0; i < 8; ++i) { cbv[i] = a.in[I_RGCB][(size_t)dir * DRG + head * 128 + 8 * ccg + i];
#pragma unroll
        for (int j = 0; j < 4; ++j) cwv[j][i] = a.in[I_RGCW][((size_t)dir * 4 + j) * DRG + head * 128 + 8 * ccg + i]; }
    u32x4 xr[2][4];
#define RG_LOAD(k) do { _Pragma("unroll") for (int h_ = 0; h_ < 2; ++h_) { const int u_ = 64 * (k) + ctr + 32 * h_; _Pragma("unroll") for (int j = 0; j < 4; ++j) { const int uu_ = u_ - j; \
        if (uu_ >= 0 && uu_ < LT) { const int t_ = dir ? (LT - 1 - uu_) : uu_; xr[h_][j] = *(const u32x4*)(xb + (size_t)t_ * DRG + 8 * ccg); } \
        else xr[h_][j] = (u32x4){0u, 0u, 0u, 0u}; } } } while (0)
#define RG_CONV(k) do { _Pragma("unroll") for (int h_ = 0; h_ < 2; ++h_) { const int u_ = 64 * (k) + ctr + 32 * h_; float o_[8]; _Pragma("unroll") for (int i = 0; i < 8; ++i) o_[i] = (u_ < LT) ? cbv[i] : 0.f; \
        _Pragma("unroll") for (int j = 0; j < 4; ++j) { float f_[8]; unpack8(xr[h_][j], f_); _Pragma("unroll") for (int i = 0; i < 8; ++i) o_[i] += f_[i] * cwv[j][i]; } \
        u32x4 w0_; w0_.x = pk2(o_[0], o_[1]); w0_.y = pk2(o_[2], o_[3]); w0_.z = pk2(o_[4], o_[5]); w0_.w = pk2(o_[6], o_[7]); \
        *(LAS u32x4*)(lds + ((k) & 1) * (64 * XROW) + (ctr + 32 * h_) * XROW + ccg * 16) = w0_; } } while (0)
    RG_LOAD(0); RG_CONV(0); RG_LOAD(1);
    __syncthreads();
    float carry = 0.f;
    const int arow = 16 * (col >> 2) + (col & 3);
    for (int k = 0; k < 65; ++k) {
        if (k + 1 < 65) RG_CONV(k + 1);
        if (k + 2 < 65) RG_LOAD(k + 2);
        const LAS unsigned char* xa = lds + (k & 1) * (64 * XROW);
        f32x4 acc[4];
#pragma unroll
        for (int mb = 0; mb < 4; ++mb) { acc[mb] = (f32x4){0.f, 0.f, 0.f, 0.f};
#pragma unroll
            for (int ks = 0; ks < 4; ++ks) acc[mb] = __builtin_amdgcn_mfma_f32_16x16x32_bf16(*(const LAS bf16x8_t*)(xa + (arow + 4 * mb) * XROW + (32 * ks + 8 * g) * 2), Wf[ks], acc[mb], 0, 0, 0); }
        float sg[16], ot[16];
#pragma unroll
        for (int e = 0; e < 16; ++e) { sg[e] = __builtin_amdgcn_rcpf(1.0f + __builtin_amdgcn_exp2f(-(acc[e >> 2][e & 3] * LOG2E + bgl))); ot[e] = dpp_xor8(sg[e]); }
        unsigned hp[8]; float hs = 0.f, PP = 1.f;
#pragma unroll
        for (int t = 0; t < 8; ++t) { const float rr = gate ? ot[8 + t] : sg[t], ii = gate ? sg[8 + t] : ot[t]; const int tau = 8 * qg + t, u = 64 * k + tau;
            float av = __builtin_amdgcn_exp2f(sp8l * rr); float mult = __builtin_amdgcn_sqrtf(fmaxf(1.0f - av * av, 0.f)); mult = (u == 0) ? 1.0f : mult;
            const float xcv = bf2f(*(const LAS unsigned short*)(xa + tau * XROW + chl * 2));
            float bq = mult * ii * xcv; if (u >= LT) { av = 1.f; bq = 0.f; }
            hs = av * hs + bq; PP *= av; hp[t] = pk2(hs, PP); }
        float H = carry, Hin = carry;
#pragma unroll
        for (int q = 0; q < 8; ++q) { const int src = cj + 8 * (q & 1) + 16 * (q >> 1); const float Pq = __shfl(PP, src), hq = __shfl(hs, src);
            Hin = (qg == q) ? H : Hin; H = Pq * H + hq; }
        carry = H;
#pragma unroll
        for (int t = 0; t < 8; ++t) { const int u = 64 * k + 8 * qg + t; const int tt = dir ? (LT - 1 - u) : u;
            if (u < LT && tt >= NMETA) hout[(size_t)(tt - NMETA) * DRG] = (bf16_t)f2bf(bflo(hp[t]) + bfhi(hp[t]) * Hin); }
        __syncthreads();
    }
#undef RG_LOAD
#undef RG_CONV
}

__device__ __forceinline__ int rg_lds_off(int row, int chunk) { return row * 320 + (((chunk + 2 * (row >> 4)) & 15) << 4); }
__device__ __forceinline__ void rg_item3(const Args& a, LAS unsigned char* lds, int it, int tid, int wave, int lane) {
    constexpr int XT = 64 * 320;
    const int th = it & 1, head = (it >> 1) & 7, dir = (it >> 4) & 1, b = it >> 5;
    const int k0 = th ? RG_SPLIT : 0, k1 = th ? 65 : RG_SPLIT;
    const bf16_t* xb = (const bf16_t*)(a.ws + WS_RGX) + (size_t)b * LT * DRG + head * 128;
    const int col = lane & 15, g = lane >> 4, chl = 16 * wave + col, ch = head * 128 + chl;
    bf16_t* hout = (bf16_t*)a.out + (size_t)dir * T * DRG + (size_t)b * SEQ * DRG + ch;
    bf16_t* pout = (bf16_t*)(a.ws + WS_RGP) + ((size_t)dir * NB + b) * RG_NF * DRG + ch;
    LAS unsigned char* wl = lds + 2 * XT + wave * 1024 + lane * 16;
#pragma unroll
    for (int gt = 0; gt < 2; ++gt)
#pragma unroll
        for (int ks = 0; ks < 4; ++ks) { const float* wp = a.in[I_RGGW] + ((size_t)((dir * 2 + gt) * 8 + head) * 128 + 32 * ks + 8 * g) * 128 + chl;
            u32x4 o; o.x = pk2(wp[0], wp[128]); o.y = pk2(wp[256], wp[384]); o.z = pk2(wp[512], wp[640]); o.w = pk2(wp[768], wp[896]); *(LAS u32x4*)(wl + (gt * 4 + ks) * 8192) = o; }
    const float LOG2E = 1.4426950408889634f;
    const float brl = a.in[I_RGGB][(size_t)(dir * 2 + 0) * DRG + ch] * LOG2E, bil = a.in[I_RGGB][(size_t)(dir * 2 + 1) * DRG + ch] * LOG2E;
    const float sp8l = -8.0f * log1pf(__expf(-a.in[I_RGLAM][dir * DRG + ch])) * LOG2E;
    const int ctr = tid >> 4, ccg = tid & 15;
    LAS float* cwl = (LAS float*)(lds + 2 * XT + 8 * 8192);
    for (int i = tid; i < 5 * 128; i += NTHR) { const int j = i >> 7, c = i & 127; cwl[i] = (j < 4) ? a.in[I_RGCW][((size_t)dir * 4 + j) * DRG + head * 128 + c] : a.in[I_RGCB][(size_t)dir * DRG + head * 128 + c]; }
    __syncthreads();
    u32x4 xr[2][4];
#define RG_LOAD(k) do { _Pragma("unroll") for (int h_ = 0; h_ < 2; ++h_) { const int u_ = 64 * (k) + ctr + 32 * h_; _Pragma("unroll") for (int j = 0; j < 4; ++j) { int uu_ = u_ - j; \
        const bool ok_ = (uu_ >= 0 && uu_ < LT); uu_ = ok_ ? uu_ : 0; const int t_ = dir ? (LT - 1 - uu_) : uu_; const u32x4 v_ = *(const u32x4*)(xb + (size_t)t_ * DRG + 8 * ccg); \
        xr[h_][j] = ok_ ? v_ : (u32x4){0u, 0u, 0u, 0u}; } } } while (0)
#define RG_CONV(k) do { _Pragma("unroll") for (int h_ = 0; h_ < 2; ++h_) { const int u_ = 64 * (k) + ctr + 32 * h_; float o_[8]; \
        { const f32x4 b0_ = *(const LAS f32x4*)(cwl + 4 * 128 + 8 * ccg), b1_ = *(const LAS f32x4*)(cwl + 4 * 128 + 8 * ccg + 4); const bool in_ = (u_ < LT); \
          o_[0] = in_ ? b0_.x : 0.f; o_[1] = in_ ? b0_.y : 0.f; o_[2] = in_ ? b0_.z : 0.f; o_[3] = in_ ? b0_.w : 0.f; o_[4] = in_ ? b1_.x : 0.f; o_[5] = in_ ? b1_.y : 0.f; o_[6] = in_ ? b1_.z : 0.f; o_[7] = in_ ? b1_.w : 0.f; } \
        _Pragma("unroll") for (int j = 0; j < 4; ++j) { float f_[8]; unpack8(xr[h_][j], f_); const f32x4 w0_ = *(const LAS f32x4*)(cwl + j * 128 + 8 * ccg), w1_ = *(const LAS f32x4*)(cwl + j * 128 + 8 * ccg + 4); \
            o_[0] += f_[0] * w0_.x; o_[1] += f_[1] * w0_.y; o_[2] += f_[2] * w0_.z; o_[3] += f_[3] * w0_.w; o_[4] += f_[4] * w1_.x; o_[5] += f_[5] * w1_.y; o_[6] += f_[6] * w1_.z; o_[7] += f_[7] * w1_.w; } \
        u32x4 w0_; w0_.x = pk2(o_[0], o_[1]); w0_.y = pk2(o_[2], o_[3]); w0_.z = pk2(o_[4], o_[5]); w0_.w = pk2(o_[6], o_[7]); \
        *(LAS u32x4*)(lds + ((k) & 1) * XT + rg_lds_off(ctr + 32 * h_, ccg)) = w0_; } } while (0)
    RG_LOAD(k0); RG_CONV(k0); RG_LOAD(k0 + 1);
    __syncthreads();
    float carry = 0.f, pcar = 1.f;
    const int arow = 16 * (col >> 2) + (col & 3);
    const int xoff = (chl & 7) * 2, xch = chl >> 3;
    unsigned char* hbase = (unsigned char*)((bf16_t*)a.out + (size_t)dir * T * DRG + (size_t)b * SEQ * DRG);
    unsigned char* pbase = (unsigned char*)((bf16_t*)(a.ws + WS_RGP) + ((size_t)dir * NB + b) * RG_NF * DRG);
    const int tsgn = dir ? -1 : 1, t0 = dir ? (LT - 1 - NMETA) : -NMETA;
#define RG_TILE(EDGE) do { \
        unsigned hp[16]; float hh = 0.f, PP = 1.f; \
        _Pragma("unroll") for (int mp = 0; mp < 2; ++mp) { f32x4 acc[2][2]; \
            _Pragma("unroll") for (int m2 = 0; m2 < 2; ++m2) { const int mb = 2 * mp + m2; acc[0][m2] = (f32x4){0.f, 0.f, 0.f, 0.f}; acc[1][m2] = (f32x4){0.f, 0.f, 0.f, 0.f}; \
                _Pragma("unroll") for (int ks = 0; ks < 4; ++ks) { const bf16x8_t Af = *(const LAS bf16x8_t*)(xa + rg_lds_off(arow + 4 * mb, 4 * ks + g)); \
                    acc[0][m2] = __builtin_amdgcn_mfma_f32_16x16x32_bf16(Af, *(const LAS bf16x8_t*)(wl + ks * 8192), acc[0][m2], 0, 0, 0); \
                    acc[1][m2] = __builtin_amdgcn_mfma_f32_16x16x32_bf16(Af, *(const LAS bf16x8_t*)(wl + (4 + ks) * 8192), acc[1][m2], 0, 0, 0); } } \
            _Pragma("unroll") for (int m2 = 0; m2 < 2; ++m2) _Pragma("unroll") for (int r = 0; r < 4; ++r) { const int e = 8 * mp + 4 * m2 + r, tau = 16 * g + e, u = 64 * k + tau; \
                    const float rr = __builtin_amdgcn_rcpf(1.0f + __builtin_amdgcn_exp2f(-(acc[0][m2][r] * LOG2E + brl))), ii = __builtin_amdgcn_rcpf(1.0f + __builtin_amdgcn_exp2f(-(acc[1][m2][r] * LOG2E + bil))); \
                    float av = __builtin_amdgcn_exp2f(sp8l * rr); float mult = __builtin_amdgcn_sqrtf(fmaxf(1.0f - av * av, 0.f)); if (EDGE) mult = (u == 0) ? 1.0f : mult; \
                    const float xcv = bf2f(*(const LAS unsigned short*)(xa + rg_lds_off(tau, xch) + xoff)); \
                    float bq = mult * ii * xcv; if (EDGE) { if (u >= LT) { av = 1.f; bq = 0.f; } } \
                    hh = av * hh + bq; PP *= av; hp[e] = pk2(hh, PP); } } \
        float Pg[4], hg[4]; \
        _Pragma("unroll") for (int q = 0; q < 4; ++q) { Pg[q] = __shfl(PP, col + 16 * q); hg[q] = __shfl(hh, col + 16 * q); } \
        const float H0 = carry, H1 = Pg[0] * H0 + hg[0], H2 = Pg[1] * H1 + hg[1], H3 = Pg[2] * H2 + hg[2], H4 = Pg[3] * H3 + hg[3]; \
        const float Q0 = pcar, Q1 = Pg[0] * Q0, Q2 = Pg[1] * Q1, Q3 = Pg[2] * Q2, Q4 = Pg[3] * Q3; \
        const float Hin = (g == 0) ? H0 : (g == 1) ? H1 : (g == 2) ? H2 : H3, Qin = (g == 0) ? Q0 : (g == 1) ? Q1 : (g == 2) ? Q2 : Q3; \
        carry = H4; pcar = Q4; \
        const int ub = 64 * k + 16 * g; \
        unsigned ho = (unsigned)((t0 + tsgn * ub) * (DRG * 2) + ch * 2), po = (unsigned)((ub - RG_U1) * (DRG * 2) + ch * 2); const unsigned hstep = (unsigned)(tsgn * DRG * 2); \
        _Pragma("unroll") for (int e = 0; e < 16; ++e) { const int u = ub + e; const int t = dir ? (LT - 1 - u) : u; \
            if (!EDGE || (u < LT && t >= NMETA)) { *(bf16_t*)(hbase + ho) = (bf16_t)f2bf(bflo(hp[e]) + bfhi(hp[e]) * Hin); \
                if (th) *(bf16_t*)(pbase + po) = (bf16_t)f2bf(bfhi(hp[e]) * Qin); } \
            ho += hstep; po += (unsigned)(DRG * 2); } \
    } while (0)
    for (int k = k0; k < k1; ++k) {
        if (k + 1 < k1) RG_CONV(k + 1);
        if (k + 2 < k1) RG_LOAD(k + 2);
        const LAS unsigned char* xa = lds + (k & 1) * XT;
        if (k == 0 || k >= 63) RG_TILE(true); else RG_TILE(false);
        __syncthreads();
    }
#undef RG_TILE
    if (th == 0 && g == 0) ((float*)(a.ws + WS_RGC))[((size_t)dir * NB + b) * DRG + ch] = carry;
#undef RG_LOAD
#undef RG_CONV
}

#ifndef RG_NAIVE
#define RG_NAIVE 0
#endif
#ifndef CONV_NAIVE
#define CONV_NAIVE 0
#endif
#ifndef ONE_LAUNCH
#define ONE_LAUNCH 0
#endif
constexpr int NPHASE = 13;
#ifndef NVGPR
#define NVGPR 248
#endif
__global__ void __launch_bounds__(NTHR, 2) __attribute__((amdgpu_num_vgpr(NVGPR))) mega(Args a) {
    extern __shared__ __attribute__((aligned(16))) unsigned char lds_raw[];
    LAS unsigned char* lds = (LAS unsigned char*)lds_raw;
    const int tid = threadIdx.x, lane = tid & 63, wave = __builtin_amdgcn_readfirstlane(tid >> 6);
    cg::grid_group grid = cg::this_grid();
    volatile LAS unsigned* bst = (volatile LAS unsigned*)(lds + LDS_BYTES - 64);
    if (tid == 0) { bst[0] = 0u; bst[1] = 0u; }
    __syncthreads();
    XcdBarrier xbar; xbar.bar = (unsigned*)(a.ws + WS_BAR); xbar.x = 0; xbar.st = bst;
    if (a.ph_hi - a.ph_lo > 1) xbar = xcd_barrier_post((unsigned*)(a.ws + WS_BAR), bst);
    const int lo = a.ph_lo, hi = a.ph_hi, G = gridDim.x, bx = blockIdx.x;
#ifndef PHMASK
#define PHMASK 0x1fff
#endif
#ifndef REPMASK
#define REPMASK 0
#endif
#define IN(k) (((PHMASK >> (k)) & 1) && lo <= (k) && (k) < hi)
#define REP(k)
#define SEAM(k) do { if (IN(k) && ((k) + 1) < hi) xcd_barrier(xbar); } while (0)
    if (a.ph_lo < 0) grid.sync();
    unsigned char* ws = a.ws;
    REP(0) if (IN(0)) phase_p0(a, lds, tid, wave, lane);
    SEAM(0);
    REP(1) if (IN(1)) {
        p1_meta(a, lds, tid, wave, lane);
        pg8::Gemm g{(const bf16_t*)(ws + WS_XN1), (const bf16_t*)(ws + WS_WINT), T, DIN, 1024}; pg8::StaticOrder S; S.init(T, DIN, G, bx);
        EpiProj E{(bf16_t*)(ws + WS_HYIN), (bf16_t*)(ws + WS_RGX), (bf16_t*)(ws + WS_GG), (bf16_t*)(ws + WS_GA), (bf16_t*)(ws + WS_GB), a.in[I_BGATE]};
        pg8::gemm_phase<EpiProj, pg8::StaticOrder>(lds, g, S, E, nullptr);
    }
    SEAM(1);
    REP(2) if (IN(2)) phase_hy_pre(a, lds, tid);
    SEAM(2);
    REP(3) if (IN(3)) {
#if CONV_NAIVE
        phase_hy_conv_naive(a, lds, tid);
#else
        for (int c = bx; c < DHY; c += G) hy_conv_channel(a, lds, c, tid, wave, lane);
#endif
#if RG_NAIVE
        phase_rg_naive(a, lds, tid);
#else
        for (int it = bx; it < NB * 2 * 8 * 2; it += G) rg_item3(a, lds, it, tid, wave, lane);
#endif
    }
    SEAM(3);
    REP(4) if (IN(4)) phase_post(a, lds, tid);
    SEAM(4);
    REP(5) if (IN(5)) {
        { pg8::Gemm g{(const bf16_t*)(ws + WS_YH), (const bf16_t*)(ws + WS_WHT), T, 1024, 512}; pg8::StaticOrder S; S.init(T, 1024, G, bx);
          EpiGate<0> E{(const bf16_t*)(ws + WS_GA), nullptr, (bf16_t*)(ws + WS_TMP)};
          pg8::gemm_phase<EpiGate<0>, pg8::StaticOrder>(lds, g, S, E, nullptr); }
        { pg8::Gemm g{(const bf16_t*)(ws + WS_YR), (const bf16_t*)(ws + WS_WRT), T, 1024, 1024}; pg8::StaticOrder S; S.init(T, 1024, G, bx);
          EpiGate<1> E{(const bf16_t*)(ws + WS_GB), (const bf16_t*)(ws + WS_TMP), (bf16_t*)(ws + WS_MERGED)};
          pg8::gemm_phase<EpiGate<1>, pg8::StaticOrder>(lds, g, S, E, nullptr); }
    }
    SEAM(5);
    REP(6) if (IN(6)) {
        pg8::Gemm g{(const bf16_t*)(ws + WS_MERGED), (const bf16_t*)(ws + WS_WOT), T, 1024, 1024}; pg8::StaticOrder S; S.init(T, 1024, G, bx);
        EpiResid E{a.in[I_X], (bf16_t*)(ws + WS_H1B), (float*)(ws + WS_ROWSS)};
        pg8::gemm_phase<EpiResid, pg8::StaticOrder>(lds, g, S, E, nullptr);
    }
    SEAM(6);
    REP(7) if (IN(7)) {
        phase_tables(a, wave, lane);
        pg8::Gemm g{(const bf16_t*)(ws + WS_H1B), (const bf16_t*)(ws + WS_WST), T, 2048, 1024}; pg8::StaticOrder S; S.init(T, 2048, G, bx);
        EpiScores E{(const float*)(ws + WS_ROWSS), (_Float16*)(ws + WS_SCORES)};
        pg8::gemm_phase<EpiScores, pg8::StaticOrder>(lds, g, S, E, nullptr);
        __syncthreads();
        phase_topk(a, lds, S, wave, lane);
    }
    SEAM(8);
#ifndef U_VALU
#define U_VALU 1
#endif
    REP(9) if (IN(9)) { if (U_VALU) phase_peer_u(a, wave, lane); else phase_peer_u_mfma(a, lds, wave, lane); }
    SEAM(9);
    if (IN(10)) phase_peer_act(a, tid);
    SEAM(10);
    if (IN(11)) phase_peer_v(a, wave, lane);
    SEAM(11);
    if (IN(12)) phase_final(a, wave, lane);
#undef IN
#undef SEAM
}

extern "C" void kernel_launch(void* const* d_in, const int* in_sizes, int n_in, void* d_out, int out_size, void* d_ws, size_t ws_size, hipStream_t stream) {
    static int grid = 0;
    if (grid == 0) {
        if (n_in != N_IN || out_size != T * DM || ws_size < WS_END) { fprintf(stderr, "kernel_launch: unexpected shapes (n_in %d out %d ws %zu)\n", n_in, out_size, ws_size); grid = -1; return; }
        if (hipFuncSetAttribute((const void*)mega, hipFuncAttributeMaxDynamicSharedMemorySize, LDS_BYTES) != hipSuccess) { fprintf(stderr, "kernel_launch: hipFuncSetAttribute failed\n"); grid = -1; return; }
        int dev = 0, cus = 0, per_cu = 0;
        hipGetDevice(&dev); hipDeviceGetAttribute(&cus, hipDeviceAttributeMultiprocessorCount, dev);
        hipOccupancyMaxActiveBlocksPerMultiprocessor(&per_cu, (const void*)mega, NTHR, LDS_BYTES);
        if (per_cu < 1) { fprintf(stderr, "kernel_launch: occupancy query says %d blocks per CU\n", per_cu); per_cu = 1; }
        (void)hipGetLastError();
        grid = cus;
    }
    if (grid < 0) return;
    Args a{};
    for (int i = 0; i < N_IN; ++i) a.in[i] = (const float*)d_in[i];
    a.out = (float*)d_out; a.ws = (unsigned char*)d_ws;
#if ONE_LAUNCH
    if (hipMemsetAsync((char*)d_ws + WS_BAR, 0, XCD_BAR_WORDS * 4, stream) != hipSuccess) { fprintf(stderr, "kernel_launch: memset of the barrier words failed\n"); return; }
    a.ph_lo = 0; a.ph_hi = NPHASE;
    void* args[] = {&a};
    hipError_t e = hipLaunchCooperativeKernel((const void*)mega, dim3(grid), dim3(NTHR), args, LDS_BYTES, stream);
    if (e != hipSuccess) fprintf(stderr, "cooperative launch failed: %s (grid %d)\n", hipGetErrorString(e), grid);
#else
    for (int ph = 0; ph < NPHASE; ++ph) for (int rep = 0; rep < 1 + ((REPMASK >> ph) & 1); ++rep) { a.ph_lo = ph; a.ph_hi = ph + 1;
        if (ph == 6 && rep == 1) (void)hipMemsetAsync((char*)d_ws + WS_ROWSS, 0, T * 4, stream);
        hipLaunchKernelGGL(mega, dim3(grid), dim3(NTHR), LDS_BYTES, stream, a);
        hipError_t e = hipPeekAtLastError(); if (e != hipSuccess) { fprintf(stderr, "launch %d failed: %s\n", ph, hipGetErrorString(e)); break; } }
#endif
}
```

```cpp
#define ONE_LAUNCH 1
#define NT_STORES 1
#define NT_STORES2 1
#include <hip/hip_runtime.h>
#include <hip/hip_cooperative_groups.h>
#include <cstdio>
#include <cstdint>
#include <cmath>
namespace cg = cooperative_groups;
namespace pg8 {
#define PG8_LAS __attribute__((address_space(3)))
typedef unsigned short bf16_t;
typedef short bf16x8 __attribute__((ext_vector_type(8)));
typedef float f32x4 __attribute__((ext_vector_type(4)));
typedef unsigned u32x4 __attribute__((ext_vector_type(4)));
constexpr int BM = 256, BK = 64, HALF = 128, HTB = HALF * BK * 2  , STAGE_BYTES = 8 * HTB, NXCD = 8, WGM = 8;

__host__ __device__ __forceinline__ int lds_byte(int r, int c) { const int st = (r >> 4) * 2 + (c >> 5), rr = r & 15, cc = c & 31, ob = rr * 64 + cc * 2; return st * 1024 + (ob ^ (((ob >> 9) & 1) << 5)); }
__host__ __device__ __forceinline__ void stage_rc(int b, int& R, int& C) { const int st = b / 1024, sb = b % 1024, swz = sb ^ (((sb >> 9) & 1) << 5); R = (st >> 1) * 16 + swz / 64; C = (st & 1) * 32 + (swz % 64) / 2; }
__host__ __device__ __forceinline__ int perm32(int rho) { const int n = rho >> 4, i = rho & 15; return 8 * (i >> 2) + 4 * n + (i & 3); }

struct Unit { int pm, pn; int skip = 0; };
struct Gemm { const bf16_t* A; const bf16_t* Bt; int M, N, K; };

struct StaticOrder {
    int nM, nN, nwg, G, c;
    __host__ __device__ void init(int M, int N, int G_, int c_) { nM = M / BM; nN = N / BM; nwg = nM * nN; G = G_; c = c_; }
    __host__ __device__ bool next(int i, Unit& u) const {
        const long L = (long)i * G + c; if (L >= nwg) return false;
        int wgid = (int)L; { const int q = nwg / NXCD, r = nwg % NXCD, xcd = wgid % NXCD, off = wgid / NXCD; wgid = (xcd < r ? xcd * (q + 1) : r * (q + 1) + (xcd - r) * q) + off; }
        const int nig = WGM * nN, gid = wgid / nig, fm = gid * WGM, gsz = (nM - fm) < WGM ? (nM - fm) : WGM;
        u.pm = fm + ((wgid % nig) % gsz); u.pn = (wgid % nig) / gsz; return true;
    }
    __device__ __forceinline__ void a_ready(const Unit&) const {}
    __device__ __forceinline__ void done(const Unit&) const {}
};
__device__ __forceinline__ unsigned cvt_pk_bf16(float lo, float hi) { unsigned r; asm volatile("v_cvt_pk_bf16_f32 %0, %1, %2" : "=v"(r) : "v"(lo), "v"(hi)); return r; }
typedef float f32x2 __attribute__((ext_vector_type(2)));
__device__ __forceinline__ f32x2 gelu_pk(f32x2 v) {
    const f32x2 av = __builtin_elementwise_abs(v), d = av * 0.2316418882f + 1.0f;
    f32x2 t; t.x = __builtin_amdgcn_rcpf(d.x); t.y = __builtin_amdgcn_rcpf(d.y);
    f32x2 q = t * 0.5307027145f + (-0.7265760135f); q = q * t + 0.7107068705f; q = q * t + (-0.142248368f); q = q * t + 0.127414796f; q = q * t;
    const f32x2 s = (v * v) * (-0.72134752044f);
    f32x2 e; e.x = __builtin_amdgcn_exp2f(s.x); e.y = __builtin_amdgcn_exp2f(s.y);
    const f32x2 m = v * (q * e), r = v - m;
    f32x2 o; o.x = v.x < 0.f ? m.x : r.x; o.y = v.y < 0.f ? m.y : r.y; return o;
}
template <class Epi, class Sched, bool STAMP = false>
__device__ __forceinline__ void gemm_phase(PG8_LAS unsigned char* lds, const Gemm g, const Sched& S, const Epi& E, unsigned long long* stamps) {
    const int tid = threadIdx.x, wid = __builtin_amdgcn_readfirstlane(tid >> 6), lane = tid & 63, wr = wid >> 2, wc = wid & 3, fr = lane & 15, fq = lane >> 4;
    const int K = g.K, nt = K / BK;
    int ts_lo = 0, ts_hi = 0, nts = 0; const unsigned long long rt_entry = STAMP ? (unsigned long long)wall_clock64() : 0ull;
#define PG8_STAMP() do { if (STAMP && wid == 0 && nts < 64) { const unsigned long long _c = (unsigned long long)clock64(); \
        ts_lo = (lane == nts) ? (int)(unsigned)_c : ts_lo; ts_hi = (lane == nts) ? (int)(unsigned)(_c >> 32) : ts_hi; ++nts; } } while (0)
    PG8_STAMP();
    unsigned voffA[2], voffB[2];
#pragma unroll
    for (int i = 0; i < 2; ++i) { int R, C; stage_rc(tid * 16 + i * 8192, R, C); const int Rb = Epi::PERM ? ((R & ~31) + perm32(R & 31)) : R;
        voffA[i] = (unsigned)(R * K + C) * 2u; voffB[i] = (unsigned)(Rb * K + C) * 2u; }
    const size_t kstep = (size_t)(BK * 2);
    const size_t hstep = (size_t)HALF * K * 2;
    const size_t tstep = 2 * hstep;
    const unsigned ldsw = (unsigned)wid * 1024u;
    const int aoff = lds_byte(wr * 64 + fr, fq * 8), boff = lds_byte(wc * 32 + fr, fq * 8);
#define PG8_SA(b, h) (((b) * 2 + (h)) * HTB)
#define PG8_SB(b, h) ((4 + (b) * 2 + (h)) * HTB)
#define PG8_STAGE(bufoff, gbase, voff) do { _Pragma("unroll") for (int _i = 0; _i < 2; ++_i) \
        __builtin_amdgcn_global_load_lds((const unsigned*)((const char*)(gbase) + (voff)[_i]), (PG8_LAS unsigned*)(lds + (bufoff) + ldsw + _i * 8192), 16, 0, 0); } while (0)
#define PG8_LDA(dst, b, h) do { _Pragma("unroll") for (int m = 0; m < 4; ++m) _Pragma("unroll") for (int k = 0; k < 2; ++k) dst[m][k] = *(const PG8_LAS bf16x8*)(lds + PG8_SA(b, h) + aoff + m * 2048 + k * 1024); } while (0)
#define PG8_LDB(dst, b, h) do { _Pragma("unroll") for (int n = 0; n < 2; ++n) _Pragma("unroll") for (int k = 0; k < 2; ++k) dst[n][k] = *(const PG8_LAS bf16x8*)(lds + PG8_SB(b, h) + boff + n * 2048 + k * 1024); } while (0)
#define PG8_MMA(ai, bj, At, Bt) do { __builtin_amdgcn_s_setprio(1); _Pragma("unroll") for (int m = 0; m < 4; ++m) _Pragma("unroll") for (int n = 0; n < 2; ++n) _Pragma("unroll") for (int k = 0; k < 2; ++k) \
        acc[ai][bj][m][n] = __builtin_amdgcn_mfma_f32_16x16x32_bf16(Bt[n][k], At[m][k], acc[ai][bj][m][n], 0, 0, 0); __builtin_amdgcn_s_setprio(0); } while (0)
#define PG8_WAIT_V(n) asm volatile("s_waitcnt vmcnt(" #n ")" ::: "memory")
#define PG8_WAIT_L(n) asm volatile("s_waitcnt lgkmcnt(" #n ")" ::: "memory")
#define PG8_BAR __builtin_amdgcn_s_barrier()
#define PG8_SCHED __builtin_amdgcn_sched_barrier(0)
    Unit cur, nxt; int ui = 0;
    if (!S.next(0, cur)) return;
    f32x4 acc[2][2][4][2];
#pragma unroll
    for (int a = 0; a < 2; ++a)
#pragma unroll
        for (int b = 0; b < 2; ++b)
#pragma unroll
            for (int m = 0; m < 4; ++m)
#pragma unroll
                for (int n = 0; n < 2; ++n) acc[a][b][m][n] = (f32x4){0.f, 0.f, 0.f, 0.f};
    bf16x8 At[4][2], B0[2][2], B1[2][2];
    const char* cA = (const char*)g.A + (size_t)cur.pm * tstep; const char* cB = (const char*)g.Bt + (size_t)cur.pn * tstep;
    S.a_ready(cur);
    PG8_STAGE(PG8_SB(0, 0), cB, voffB); PG8_STAGE(PG8_SA(0, 0), cA, voffA); PG8_STAGE(PG8_SB(0, 1), cB + hstep, voffB); PG8_STAGE(PG8_SA(0, 1), cA + hstep, voffA);
    if (wr == 1) PG8_BAR;
    PG8_WAIT_V(4); PG8_BAR;
    PG8_STAGE(PG8_SB(1, 0), cB + kstep, voffB); PG8_STAGE(PG8_SA(1, 0), cA + kstep, voffA); PG8_STAGE(PG8_SB(1, 1), cB + hstep + kstep, voffB);
    PG8_WAIT_V(6); PG8_BAR;
    PG8_STAMP();
    for (;;) {
        const bool has_next = S.next(ui + 1, nxt);
        const char* nA = has_next ? (const char*)g.A + (size_t)nxt.pm * tstep : cA; const char* nB = has_next ? (const char*)g.Bt + (size_t)nxt.pn * tstep : cB;
        for (int t = 0; t < nt; t += 2) {
            const bool last = (t == nt - 2);
            const char* a1 = cA + (size_t)(t + 1) * kstep;
            const char* a2 = last ? nA : cA + (size_t)(t + 2) * kstep; const char* b2 = last ? nB : cB + (size_t)(t + 2) * kstep;
            const char* a3 = a2 + kstep; const char* b3 = b2 + kstep;
            if (last && has_next) S.a_ready(nxt);
            PG8_LDB(B0, 0, 0); PG8_SCHED; PG8_LDA(At, 0, 0); PG8_STAGE(PG8_SA(1, 1), a1 + hstep, voffA);
            PG8_WAIT_L(8); PG8_BAR; PG8_WAIT_L(0); PG8_MMA(0, 0, At, B0); PG8_BAR; PG8_SCHED;
            PG8_LDB(B1, 0, 1); PG8_STAGE(PG8_SB(0, 0), b2, voffB);
            PG8_BAR; PG8_WAIT_L(0); PG8_MMA(0, 1, At, B1); PG8_BAR;
            PG8_LDA(At, 0, 1); PG8_STAGE(PG8_SA(0, 0), a2, voffA);
            PG8_BAR; PG8_WAIT_L(0); PG8_MMA(1, 0, At, B0); PG8_BAR; PG8_SCHED;
            PG8_STAGE(PG8_SB(0, 1), b2 + hstep, voffB);
            PG8_WAIT_V(6); PG8_BAR; PG8_MMA(1, 1, At, B1); PG8_BAR;
            PG8_LDB(B0, 1, 0); PG8_SCHED; PG8_LDA(At, 1, 0); PG8_STAGE(PG8_SA(0, 1), a2 + hstep, voffA);
            PG8_WAIT_L(8); PG8_BAR; PG8_WAIT_L(0); PG8_MMA(0, 0, At, B0); PG8_BAR; PG8_SCHED;
            PG8_LDB(B1, 1, 1); PG8_STAGE(PG8_SB(1, 0), b3, voffB);
            PG8_BAR; PG8_WAIT_L(0); PG8_MMA(0, 1, At, B1); PG8_BAR;
            PG8_LDA(At, 1, 1); PG8_STAGE(PG8_SA(1, 0), a3, voffA);
            PG8_BAR; PG8_WAIT_L(0); PG8_MMA(1, 0, At, B0); PG8_BAR; PG8_SCHED;
            PG8_STAGE(PG8_SB(1, 1), b3 + hstep, voffB);
            PG8_WAIT_V(6); PG8_BAR; PG8_MMA(1, 1, At, B1); PG8_BAR;
        }
        PG8_STAMP();
        if constexpr (!Epi::AFTER_DRAIN) { E(acc, cur, wr, wc, fr, fq); S.done(cur); }
        PG8_STAMP();
        if (!has_next) break;
#pragma unroll
        for (int a = 0; a < 2; ++a)
#pragma unroll
            for (int b = 0; b < 2; ++b)
#pragma unroll
                for (int m = 0; m < 4; ++m)
#pragma unroll
                    for (int n = 0; n < 2; ++n) acc[a][b][m][n] = (f32x4){0.f, 0.f, 0.f, 0.f};
        cur = nxt; cA = nA; cB = nB; ++ui;
    }
    PG8_WAIT_V(0);
    if (wr == 0) PG8_BAR;
    PG8_BAR;
    if constexpr (Epi::AFTER_DRAIN) { E.fused(acc, cur, wr, wc, fr, fq, lds, wid, lane); S.done(cur); }
    PG8_STAMP();
    if (STAMP && wid == 0) { stamps[lane] = lane < nts ? (((unsigned long long)(unsigned)ts_hi << 32) | (unsigned)ts_lo) : 0ull;
        if (lane == 62) stamps[62] = rt_entry; if (lane == 63) stamps[63] = (unsigned long long)wall_clock64(); }
#undef PG8_STAMP
#undef PG8_SA
#undef PG8_SB
#undef PG8_STAGE
#undef PG8_LDA
#undef PG8_LDB
#undef PG8_MMA
#undef PG8_WAIT_V
#undef PG8_WAIT_L
#undef PG8_BAR
#undef PG8_SCHED
}
}

#define LAS __attribute__((address_space(3)))
typedef unsigned short bf16_t;
typedef float f32x4 __attribute__((ext_vector_type(4)));
typedef float f32x2 __attribute__((ext_vector_type(2)));
typedef unsigned u32x4 __attribute__((ext_vector_type(4)));
typedef unsigned u32x2 __attribute__((ext_vector_type(2)));

constexpr int NB = 8, SEQ = 4096, NMETA = 16, LT = SEQ + NMETA, DM = 1024, T = NB * SEQ;
constexpr int DHY = 512, DRG = 1024, DIN = 3 * DHY + 2 * DRG + 2 * DM;
constexpr int NTHR = 512, NWAVES = 8;
constexpr int LDS_BYTES = 160 * 1024;
constexpr float EPSF = 1e-6f;
constexpr int KFW = 2 * LT;
constexpr int SP = 4256;
constexpr int NEXP = 16384;
constexpr int RG_SPLIT = 33, RG_U1 = RG_SPLIT * 64;
constexpr int RG_NF = LT - RG_U1;

enum { I_X = 0, I_META, I_GFINAL, I_GMIX, I_WIN, I_BGATE, I_HYCW, I_HYCB, I_HYW1, I_HYB1, I_HYW2, I_HYB2, I_HYW3, I_HYB3, I_HYFREQ, I_HYSKIP,
       I_HYOUT, I_RGCW, I_RGCB, I_RGGW, I_RGGB, I_RGLAM, I_RGOUT, I_WOUT, I_GFFN, I_WQ, I_KEYS, I_PU, I_PV, N_IN };

constexpr size_t MiB = 1024ull * 1024ull;
constexpr size_t WS_ROWSS = 64 * 1024;
constexpr size_t WS_SU = 256 * 1024;
constexpr size_t WS_SV = 320 * 1024;
constexpr size_t WS_ROWSS2 = 384 * 1024;
constexpr size_t WS_BAR = 512 * 1024;
constexpr size_t WS_WINT = 1 * MiB;
constexpr size_t WS_WHT = 12 * MiB;
constexpr size_t WS_WRT = 13 * MiB;
constexpr size_t WS_WOT = 15 * MiB;
constexpr size_t WS_WST = 17 * MiB;
constexpr size_t WS_GWT = 21 * MiB;
constexpr size_t WS_KF = 22 * MiB;
constexpr size_t WS_KFB = 39 * MiB;
constexpr size_t WS_HYIN = 48 * MiB;
constexpr size_t WS_RGX = 145 * MiB;
constexpr size_t WS_GG = 210 * MiB;
constexpr size_t WS_GA = 274 * MiB;
constexpr size_t WS_GB = 338 * MiB;
constexpr size_t WS_XN1 = 402 * MiB;
constexpr size_t WS_UUT = 402 * MiB;
constexpr size_t WS_CONVT = 436 * MiB;
constexpr size_t WS_YH = 468 * MiB;
constexpr size_t WS_YR = WS_RGX;
constexpr size_t WS_MERGED = WS_HYIN;
constexpr size_t WS_TMP = WS_GG;
constexpr size_t WS_H1B = WS_RGX;
constexpr size_t WS_SCORES = WS_GG;
constexpr size_t WS_EIDX = 468 * MiB;
constexpr size_t WS_EG = 484 * MiB;
constexpr size_t WS_UB = 48 * MiB;
constexpr size_t WS_VB = 64 * MiB;
constexpr size_t WS_PD = 210 * MiB;
constexpr size_t WS_PO = WS_PD;
constexpr size_t WS_ACT = 338 * MiB;
constexpr size_t WS_RGP = 48 * MiB;
constexpr size_t WS_RGC = 576 * 1024;
constexpr size_t WS_END = 500 * MiB;

struct Args { const float* in[N_IN]; float* out; unsigned char* ws; int ph_lo, ph_hi; };

__device__ __forceinline__ float bf2f(unsigned v) { return __uint_as_float(v << 16); }
typedef __bf16 bf16x2_t __attribute__((ext_vector_type(2)));
__device__ __forceinline__ unsigned pk2(float lo, float hi) { bf16x2_t v; v.x = (__bf16)lo; v.y = (__bf16)hi; return __builtin_bit_cast(unsigned, v); }
__device__ __forceinline__ unsigned f2bf(float f) { return pk2(f, f) & 0xffffu; }
__device__ __forceinline__ float bflo(unsigned w) { return __uint_as_float(w << 16); }
__device__ __forceinline__ float bfhi(unsigned w) { return __uint_as_float(w & 0xffff0000u); }
__device__ __forceinline__ float wave_sum(float v) {
#pragma unroll
    for (int o = 1; o < 64; o <<= 1) v += __shfl_xor(v, o);
    return v;
}
__device__ __forceinline__ float wave_max(float v) {
#pragma unroll
    for (int o = 1; o < 64; o <<= 1) v = fmaxf(v, __shfl_xor(v, o));
    return v;
}
__device__ __forceinline__ float fexp(float x) { return __builtin_amdgcn_exp2f(x * 1.4426950408889634f); }
__device__ __forceinline__ float sigmoidf_(float x) { return __builtin_amdgcn_rcpf(1.0f + fexp(-x)); }
__device__ __forceinline__ float gelu_tanh(float x) { const float u = 1.5957691216f * (x + 0.044715f * x * x * x); return x * __builtin_amdgcn_rcpf(1.0f + fexp(-u)); }
__device__ __forceinline__ void sincos_acc(float a, float& s, float& c) {
    const double x = (double)a;
    const double q = rint(x * 0.63661977236758134308);
    const double r = fma(-q, 1.57079632679489661923, x);
    const int n = (int)q;
    const float rf = (float)r, r2 = rf * rf;
    const float sp = rf * (1.f + r2 * (-1.6666667e-1f + r2 * (8.3333333e-3f + r2 * (-1.9841270e-4f + r2 * 2.7557319e-6f))));
    const float cp = 1.f + r2 * (-0.5f + r2 * (4.1666667e-2f + r2 * (-1.3888889e-3f + r2 * (2.4801587e-5f + r2 * (-2.7557319e-7f)))));
    const int k = n & 3;
    s = (k == 0) ? sp : (k == 1) ? cp : (k == 2) ? -sp : -cp;
    c = (k == 0) ? cp : (k == 1) ? -sp : (k == 2) ? -cp : sp;
}

typedef float f32x2v __attribute__((ext_vector_type(2)));
__device__ __forceinline__ float wave_sum_dpp(float v) {
    v += __int_as_float(__builtin_amdgcn_update_dpp(0, __float_as_int(v), 0xB1, 0xF, 0xF, true));
    v += __int_as_float(__builtin_amdgcn_update_dpp(0, __float_as_int(v), 0x4E, 0xF, 0xF, true));
    v += __int_as_float(__builtin_amdgcn_update_dpp(0, __float_as_int(v), 0x141, 0xF, 0xF, true));
    v += __int_as_float(__builtin_amdgcn_update_dpp(0, __float_as_int(v), 0x140, 0xF, 0xF, true));
    const int vi = __float_as_int(v);
    return (__int_as_float(__builtin_amdgcn_readlane(vi, 0)) + __int_as_float(__builtin_amdgcn_readlane(vi, 16))) + (__int_as_float(__builtin_amdgcn_readlane(vi, 32)) + __int_as_float(__builtin_amdgcn_readlane(vi, 48)));
}
__device__ __forceinline__ float wave_max_dpp(float v) {
    v = fmaxf(v, __int_as_float(__builtin_amdgcn_update_dpp(0, __float_as_int(v), 0xB1, 0xF, 0xF, true)));
    v = fmaxf(v, __int_as_float(__builtin_amdgcn_update_dpp(0, __float_as_int(v), 0x4E, 0xF, 0xF, true)));
    v = fmaxf(v, __int_as_float(__builtin_amdgcn_update_dpp(0, __float_as_int(v), 0x141, 0xF, 0xF, true)));
    v = fmaxf(v, __int_as_float(__builtin_amdgcn_update_dpp(0, __float_as_int(v), 0x140, 0xF, 0xF, true)));
    const int vi = __float_as_int(v);
    return fmaxf(fmaxf(__int_as_float(__builtin_amdgcn_readlane(vi, 0)), __int_as_float(__builtin_amdgcn_readlane(vi, 16))), fmaxf(__int_as_float(__builtin_amdgcn_readlane(vi, 32)), __int_as_float(__builtin_amdgcn_readlane(vi, 48))));
}

#ifndef SLICE_PROBE
#define SLICE_OF(b) ((b) & 7)
#define RANK_OF(b) ((b) >> 3)
#else
#define SLICE_OF(b) ((b) >> 5)
#define RANK_OF(b) ((b) & 31)
#endif

__device__ __forceinline__ float dpp_xor8(float v) { return __int_as_float(__builtin_amdgcn_update_dpp(0, __float_as_int(v), 0x128, 0xF, 0xF, true)); }

#ifdef NT_STORES3
#define NT_ST(p, v) __builtin_nontemporal_store((v), (p))
#else
#define NT_ST(p, v) (*(p) = (v))
#endif
#define XB_TMO      128
#define XB_XCNT(j)  (256  + 64 * (j))
#define XB_XSUB(j)  (1280 + 64 * (j))
#define XB_XGEN(j)  (2304 + 64 * (j))
#define XB_TOP      3328
#define XB_TOPGEN   3392
#define XCD_BAR_WORDS 3456
#define XB_SPIN_CAP (1u << 18)

__device__ __forceinline__ unsigned xb_ld(unsigned* p)              { return __hip_atomic_load(p, __ATOMIC_RELAXED, __HIP_MEMORY_SCOPE_AGENT); }
__device__ __forceinline__ unsigned xb_add(unsigned* p, unsigned v) { return __hip_atomic_fetch_add(p, v, __ATOMIC_RELAXED, __HIP_MEMORY_SCOPE_AGENT); }
__device__ __forceinline__ unsigned xb_xcc_id() { return (unsigned)__builtin_amdgcn_s_getreg((3 << 11) | 20) & 0xFu; }
#define XB_SPIN(cond, bar) do { unsigned _sp = 0; while (cond) { __builtin_amdgcn_s_sleep(1); \
    if ((++_sp & 255u) == 0u) { if (xb_ld(&(bar)[XB_TMO])) break; if (_sp > XB_SPIN_CAP) { atomicAdd(&(bar)[XB_TMO], 1u); break; } } } } while (0)

struct XcdBarrier {
    unsigned* bar; unsigned x;
    volatile LAS unsigned* st;
};

__device__ __forceinline__ XcdBarrier xcd_barrier_post(unsigned* bar, volatile LAS unsigned* st) {
    XcdBarrier b; b.bar = bar; b.x = xb_xcc_id(); b.st = st;
    if (threadIdx.x == 0) (void)xb_add(&bar[XB_XCNT(b.x)], 1u);
    return b;
}
__device__ __forceinline__ void xcd_barrier_complete(unsigned* bar, unsigned x, unsigned& nloc, unsigned& nx) {
    const unsigned G = gridDim.x * gridDim.y * gridDim.z;
    unsigned sum, cnt, mine, sp = 0u;
    for (;;) {
        sum = 0u; cnt = 0u; mine = 0u;
#pragma unroll
        for (unsigned j = 0; j < 16; ++j) { const unsigned c = xb_ld(&bar[XB_XCNT(j)]); sum += c; cnt += (c > 0u) ? 1u : 0u; mine = (j == x) ? c : mine; }
        if (sum == G) break;
        __builtin_amdgcn_s_sleep(1);
        if ((++sp & 255u) == 0u) { if (xb_ld(&bar[XB_TMO])) break; if (sp > XB_SPIN_CAP) { atomicAdd(&bar[XB_TMO], 1u); break; } }
    }
    nloc = mine > 0u ? mine : 1u; nx = cnt > 0u ? cnt : 1u;
}

__device__ __forceinline__ void xcd_barrier(const XcdBarrier& b) {
    asm volatile("s_waitcnt vmcnt(0)" ::: "memory");
    __syncthreads();
    if (threadIdx.x == 0) {
        unsigned* bar = b.bar;
        __builtin_amdgcn_s_waitcnt(0);
        unsigned nloc = b.st[0], nx = b.st[1];
        if (nloc == 0u) { xcd_barrier_complete(bar, b.x, nloc, nx); b.st[0] = nloc; b.st[1] = nx; }
        const unsigned old = xb_add(&bar[XB_XSUB(b.x)], 1u);
        const unsigned gen = old / nloc;
        if (old + 1u == (gen + 1u) * nloc) {
            __builtin_amdgcn_fence(__ATOMIC_RELEASE, "agent");
            asm volatile("s_waitcnt vmcnt(0)" ::: "memory");
            const unsigned og = xb_add(&bar[XB_TOP], 1u);
            const unsigned tg = og / nx;
            if (og + 1u == (tg + 1u) * nx) xb_add(&bar[XB_TOPGEN], 1u);
            else XB_SPIN(xb_ld(&bar[XB_TOPGEN]) == tg, bar);
            __builtin_amdgcn_fence(__ATOMIC_ACQUIRE, "agent");
            xb_add(&bar[XB_XGEN(b.x)], 1u);
            asm volatile("s_waitcnt vmcnt(0)" ::: "memory");
        } else {
            XB_SPIN(xb_ld(&bar[XB_XGEN(b.x)]) == gen, bar);
            __builtin_amdgcn_fence(__ATOMIC_ACQUIRE, "agent");
            asm volatile("s_waitcnt vmcnt(0)" ::: "memory");
        }
    }
    __syncthreads();
}

__device__ __forceinline__ void p0_transpose_item(const float* W, int K, int N, bf16_t* WT, LAS float* scr, int item, int lane) {
    const int nblk = N / 32, kb = item / nblk, nb = item % nblk, k0 = 64 * kb, n0 = 32 * nb;
#pragma unroll 8
    for (int i = 0; i < 32; ++i) { const int kk = 2 * i + (lane >> 5); scr[kk * 33 + (lane & 31)] = W[(size_t)(k0 + kk) * N + n0 + (lane & 31)]; }
    asm volatile("s_waitcnt lgkmcnt(0)" ::: "memory");
    const int c = lane & 7;
#pragma unroll
    for (int j = 0; j < 4; ++j) { const int n = (lane >> 3) + 8 * j; const LAS float* s = scr + (8 * c) * 33 + n;
        u32x4 o; o.x = pk2(s[0 * 33], s[1 * 33]); o.y = pk2(s[2 * 33], s[3 * 33]); o.z = pk2(s[4 * 33], s[5 * 33]); o.w = pk2(s[6 * 33], s[7 * 33]);
        *(u32x4*)(WT + (size_t)(n0 + n) * K + k0 + 8 * c) = o; }
    asm volatile("s_waitcnt lgkmcnt(0)" ::: "memory");
}
__device__ __forceinline__ void p0_xn1_row(const float* xrow, const float* g, bf16_t* orow, int lane) {
    const f32x4* xr = (const f32x4*)xrow + lane; const f32x4* gr = (const f32x4*)g + lane;
    f32x4 v[4]; float s = 0.f;
#pragma unroll
    for (int j = 0; j < 4; ++j) { v[j] = xr[64 * j]; s += (v[j].x * v[j].x + v[j].y * v[j].y) + (v[j].z * v[j].z + v[j].w * v[j].w); }
    const float rstd = rsqrtf(wave_sum(s) * (1.f / DM) + EPSF);
    unsigned long long* o8 = (unsigned long long*)orow + lane;
#pragma unroll
    for (int j = 0; j < 4; ++j) { const f32x4 gv = gr[64 * j];
        o8[64 * j] = (unsigned long long)pk2(v[j].x * rstd * gv.x, v[j].y * rstd * gv.y) | ((unsigned long long)pk2(v[j].z * rstd * gv.z, v[j].w * rstd * gv.w) << 32); }
}
__device__ __forceinline__ void p0_fold_item(const Args& a, LAS unsigned char* lds, int item, int tid) {
    const int hp = item >> 4, k0 = (item & 15) * 64;
    LAS float* kl = (LAS float*)lds;
    LAS float* wl = (LAS float*)(lds + 128 * 129 * 4);
    const float* keys = a.in[I_KEYS] + (size_t)hp * 128 * 128; const float* wq = a.in[I_WQ];
    for (int i = tid; i < 128 * 128; i += NTHR) { const int key = i >> 7, d = i & 127; kl[key * 129 + d] = keys[i]; }
    for (int i = tid; i < 64 * 128; i += NTHR) { const int kk = i >> 7, d = i & 127; wl[i] = wq[(size_t)(k0 + kk) * 2048 + hp * 128 + d]; }
    __syncthreads();
    const int key = tid & 127, kq = tid >> 7;
    float acc[16];
#pragma unroll
    for (int i = 0; i < 16; ++i) acc[i] = 0.f;
#pragma unroll 2
    for (int d = 0; d < 128; ++d) { const float kv = kl[key * 129 + d];
#pragma unroll
        for (int i = 0; i < 16; ++i) acc[i] += wl[(kq * 16 + i) * 128 + d] * kv; }
    const float* gf = a.in[I_GFFN] + k0 + kq * 16;
    bf16_t* dst = (bf16_t*)(a.ws + WS_WST) + (size_t)(hp * 128 + key) * 1024 + k0 + kq * 16;
    u32x4 o0, o1;
    o0.x = pk2(acc[0] * gf[0], acc[1] * gf[1]); o0.y = pk2(acc[2] * gf[2], acc[3] * gf[3]); o0.z = pk2(acc[4] * gf[4], acc[5] * gf[5]); o0.w = pk2(acc[6] * gf[6], acc[7] * gf[7]);
    o1.x = pk2(acc[8] * gf[8], acc[9] * gf[9]); o1.y = pk2(acc[10] * gf[10], acc[11] * gf[11]); o1.z = pk2(acc[12] * gf[12], acc[13] * gf[13]); o1.w = pk2(acc[14] * gf[14], acc[15] * gf[15]);
    *(u32x4*)dst = o0; *(u32x4*)(dst + 8) = o1;
    __syncthreads();
}
__device__ __forceinline__ void p0_meta_item(const Args& a, LAS unsigned char* lds, int item, int tid, int wave, int lane) {
    LAS float* mt = (LAS float*)lds;
    for (int r = wave * 2; r < wave * 2 + 2; ++r) {
        const f32x4* xr = (const f32x4*)(a.in[I_META] + (size_t)r * DM) + lane; const f32x4* gr = (const f32x4*)a.in[I_GMIX] + lane;
        f32x4 v[4]; float s = 0.f;
#pragma unroll
        for (int j = 0; j < 4; ++j) { v[j] = xr[64 * j]; s += (v[j].x * v[j].x + v[j].y * v[j].y) + (v[j].z * v[j].z + v[j].w * v[j].w); }
        const float rstd = rsqrtf(wave_sum(s) * (1.f / DM) + EPSF);
#pragma unroll
        for (int j = 0; j < 4; ++j) { const f32x4 gv = gr[64 * j]; f32x4 o = v[j] * rstd * gv; *(LAS f32x4*)(mt + r * 1024 + 4 * (lane + 64 * j)) = o; }
    }
    __syncthreads();
    const int col = item * 256 + (tid & 255), rh = tid >> 8;
    float acc[8];
#pragma unroll
    for (int r = 0; r < 8; ++r) acc[r] = 0.f;
    const float* w = a.in[I_WIN] + col;
#pragma unroll 4
    for (int k = 0; k < 1024; ++k) { const float wv = w[(size_t)k * DIN];
#pragma unroll
        for (int r = 0; r < 8; ++r) acc[r] += mt[(rh * 8 + r) * 1024 + k] * wv; }
    bf16_t* hyin = (bf16_t*)(a.ws + WS_HYIN); bf16_t* rgx = (bf16_t*)(a.ws + WS_RGX);
#pragma unroll
    for (int r = 0; r < 8; ++r) { const int t = rh * 8 + r; const bf16_t v = (bf16_t)f2bf(acc[r]);
        for (int b = 0; b < NB; ++b) { if (col < 1536) hyin[((size_t)b * LT + t) * 1536 + col] = v; else rgx[((size_t)b * LT + t) * 1024 + (col - 1536)] = v; } }
    __syncthreads();
}
constexpr int FPP = 17, NFILT = (LT + FPP - 1) / FPP;
__device__ __forceinline__ void p0_filter_item(const Args& a, LAS unsigned char* lds, int item, int tid) {
    LAS float* z = (LAS float*)lds;
    LAS float* h1 = z + FPP * 33;
    LAS float* h2 = h1 + FPP * 64;
    LAS float* ko = h2 + FPP * 64;
    const int p0 = item * FPP;
    for (int idx = tid; idx < FPP * 33; idx += NTHR) { const int pp = idx / 33, f = idx % 33, p = p0 + pp;
        float v;
        if (f == 0) v = (float)p * (1.0f / (float)(LT - 1));
        else { const int bi = (f - 1) & 15; const float band = 1e-4f + (float)bi * ((15.0f - 1e-4f) / 15.0f); const float w = (float)(6.283185307179586 / (double)LT) * (float)p;
            float s, c; sincos_acc(band * w, s, c); v = (f <= 16) ? c : -s; }
        z[idx] = v; }
    __syncthreads();
    const float* w1 = a.in[I_HYW1]; const float* b1 = a.in[I_HYB1]; const float* w2 = a.in[I_HYW2]; const float* b2 = a.in[I_HYB2];
    const float* w3 = a.in[I_HYW3]; const float* b3 = a.in[I_HYB3]; const float* fr = a.in[I_HYFREQ];
    { const int j = tid & 63, pq = tid >> 6;
        float wv[33];
#pragma unroll
        for (int f = 0; f < 33; ++f) wv[f] = w1[f * 64 + j];
        const float bj = b1[j], fj = fr[j];
        for (int pp = pq; pp < FPP; pp += 8) { float acc = bj;
#pragma unroll
            for (int f = 0; f < 33; ++f) acc += z[pp * 33 + f] * wv[f];
            float s, c; sincos_acc(fj * acc, s, c); h1[pp * 64 + j] = s; } }
    __syncthreads();
    { const int j = tid & 63, pq = tid >> 6;
        const float bj = b2[j], fj = fr[64 + j]; float accp[3] = {bj, bj, bj};
#pragma unroll 1
        for (int fh = 0; fh < 2; ++fh) { float wv[32];
#pragma unroll
            for (int f = 0; f < 32; ++f) wv[f] = w2[(fh * 32 + f) * 64 + j];
#pragma unroll
            for (int t3 = 0; t3 < 3; ++t3) { const int pp = pq + 8 * t3; if (pp < FPP) { float acc = accp[t3];
#pragma unroll
                for (int f = 0; f < 32; ++f) acc += h1[pp * 64 + fh * 32 + f] * wv[f];
                accp[t3] = acc; } } }
#pragma unroll
        for (int t3 = 0; t3 < 3; ++t3) { const int pp = pq + 8 * t3; if (pp < FPP) { float s, c; sincos_acc(fj * accp[t3], s, c); h2[pp * 64 + j] = s; } } }
    __syncthreads();
#pragma unroll 1
    for (int half = 0; half < 2; ++half) { const int o = half * 512 + tid;
        const float bo = b3[o];
        const float delta = fabsf(-15.350567286626972f + (float)tid * ((-3.0701134573253945f + 15.350567286626972f) / 511.0f));
#pragma unroll 1
        for (int ih = 0; ih < 2; ++ih) { float wv[32];
#pragma unroll
            for (int i = 0; i < 32; ++i) wv[i] = w3[(ih * 32 + i) * 1024 + o];
#pragma unroll 1
            for (int pp = 0; pp < FPP; ++pp) { float acc = ih ? ko[o * (FPP + 1) + pp] : bo;
#pragma unroll
                for (int i = 0; i < 32; ++i) acc += h2[pp * 64 + ih * 32 + i] * wv[i];
                if (ih) { const float tn = (float)(p0 + pp) * (1.0f / (float)(LT - 1)); acc *= __expf(-tn * delta); }
                ko[o * (FPP + 1) + pp] = acc; } }
    }
    __syncthreads();
    bf16_t* kfb = (bf16_t*)(a.ws + WS_KFB);
    for (int idx = tid; idx < 1024 * FPP; idx += NTHR) { const int o = idx / FPP, pp = idx - o * FPP, dir = o >> 9, c = o & 511, p = p0 + pp;
        if (p < LT) { const float v = ko[o * (FPP + 1) + pp];
            if (dir == 0) kfb[(size_t)c * KFW + (LT - 1) + p] = (bf16_t)f2bf(p == 0 ? v + a.in[I_HYSKIP][c] : v);
            else if (p >= 1) kfb[(size_t)c * KFW + (LT - 1) - p] = (bf16_t)f2bf(v); } }
    if (item == 0) for (int c = tid; c < 512; c += NTHR) kfb[(size_t)c * KFW + KFW - 1] = 0;
    __syncthreads();
}
__device__ __forceinline__ void phase_p0(const Args& a, LAS unsigned char* lds, int tid, int wave, int lane) {
    const int G = gridDim.x, bx = blockIdx.x;
    { float* rs = (float*)(a.ws + WS_ROWSS); float* rs2 = (float*)(a.ws + WS_ROWSS2); for (int i = bx * NTHR + tid; i < T; i += G * NTHR) { rs[i] = 0.f; rs2[i] = 0.f; } }
    for (int it = bx; it < 256 + NFILT; it += G) {
#ifndef P0M
#define P0M 7
#endif
        if (it < 256) { if (P0M & 1) p0_fold_item(a, lds, it, tid); }
        else { if (P0M & 2) p0_filter_item(a, lds, it - 256, tid); }

    }
    LAS float* scr = (LAS float*)(lds + wave * 16384);
    const int gw = bx * NWAVES + wave, NGW = G * NWAVES;
    constexpr int I_IN = (1024 / 64) * (DIN / 32), I_H = (512 / 64) * (1024 / 32), I_R = (1024 / 64) * (1024 / 32), I_O = I_R;
    for (int it = gw; it < I_IN + I_H + I_R + I_O; it += NGW) {
        int r = it;
        if (r < I_IN) { p0_transpose_item(a.in[I_WIN], 1024, DIN, (bf16_t*)(a.ws + WS_WINT), scr, r, lane); continue; } r -= I_IN;
        if (r < I_H) { p0_transpose_item(a.in[I_HYOUT], 512, 1024, (bf16_t*)(a.ws + WS_WHT), scr, r, lane); continue; } r -= I_H;
        if (r < I_R) { p0_transpose_item(a.in[I_RGOUT], 1024, 1024, (bf16_t*)(a.ws + WS_WRT), scr, r, lane); continue; } r -= I_R;
        p0_transpose_item(a.in[I_WOUT], 1024, 1024, (bf16_t*)(a.ws + WS_WOT), scr, r, lane);
    }
    for (int m = gw; m < T; m += 2 * NGW) { p0_xn1_row(a.in[I_X] + (size_t)m * DM, a.in[I_GMIX], (bf16_t*)(a.ws + WS_XN1) + (size_t)m * DM, lane);
        if (m + NGW < T) p0_xn1_row(a.in[I_X] + (size_t)(m + NGW) * DM, a.in[I_GMIX], (bf16_t*)(a.ws + WS_XN1) + (size_t)(m + NGW) * DM, lane); }
}

__device__ __forceinline__ void p1_meta(const Args& a, LAS unsigned char* lds, int tid, int wave, int lane) {
    LAS float* mt = (LAS float*)lds;
    for (int r = wave * 2; r < wave * 2 + 2; ++r) {
        const f32x4* xr = (const f32x4*)(a.in[I_META] + (size_t)r * DM) + lane; const f32x4* gr = (const f32x4*)a.in[I_GMIX] + lane;
        f32x4 v[4]; float s = 0.f;
#pragma unroll
        for (int j = 0; j < 4; ++j) { v[j] = xr[64 * j]; s += (v[j].x * v[j].x + v[j].y * v[j].y) + (v[j].z * v[j].z + v[j].w * v[j].w); }
        const float rstd = rsqrtf(wave_sum(s) * (1.f / DM) + EPSF);
#pragma unroll
        for (int j = 0; j < 4; ++j) { const f32x4 gv = gr[64 * j]; f32x4 o = v[j] * rstd * gv; *(LAS f32x4*)(mt + r * 1024 + 4 * (lane + 64 * j)) = o; }
    }
    __syncthreads();
    const bf16_t* wint = (const bf16_t*)(a.ws + WS_WINT); bf16_t* hyin = (bf16_t*)(a.ws + WS_HYIN); bf16_t* rgx = (bf16_t*)(a.ws + WS_RGX);
    for (int cc = wave; cc < 10; cc += NWAVES) { const int n = blockIdx.x * 10 + cc; if (n >= 2560) break;
        float w[16]; { float t0[8], t1[8]; const bf16_t* wp = wint + (size_t)n * 1024; const u32x4 q0 = *(const u32x4*)(wp + 8 * lane), q1 = *(const u32x4*)(wp + 512 + 8 * lane);
            w[0] = bflo(q0.x); w[1] = bfhi(q0.x); w[2] = bflo(q0.y); w[3] = bfhi(q0.y); w[4] = bflo(q0.z); w[5] = bfhi(q0.z); w[6] = bflo(q0.w); w[7] = bfhi(q0.w);
            w[8] = bflo(q1.x); w[9] = bfhi(q1.x); w[10] = bflo(q1.y); w[11] = bfhi(q1.y); w[12] = bflo(q1.z); w[13] = bfhi(q1.z); w[14] = bflo(q1.w); w[15] = bfhi(q1.w); (void)t0; (void)t1; }
        float mine = 0.f;
#pragma unroll
        for (int r = 0; r < 16; ++r) { const LAS f32x4* mp = (const LAS f32x4*)(mt + r * 1024 + 8 * lane); const f32x4 m0 = mp[0], m1 = mp[1], m2 = mp[128], m3 = mp[129];
            float s = (w[0] * m0.x + w[1] * m0.y) + (w[2] * m0.z + w[3] * m0.w) + (w[4] * m1.x + w[5] * m1.y) + (w[6] * m1.z + w[7] * m1.w)
                    + (w[8] * m2.x + w[9] * m2.y) + (w[10] * m2.z + w[11] * m2.w) + (w[12] * m3.x + w[13] * m3.y) + (w[14] * m3.z + w[15] * m3.w);
            s = wave_sum_dpp(s); mine = ((lane & 15) == r) ? s : mine; }
        const bf16_t v = (bf16_t)f2bf(mine); const int t = lane & 15;
#pragma unroll
        for (int h = 0; h < 2; ++h) { const int b = (lane >> 4) + 4 * h;
            if (n < 1536) hyin[((size_t)b * LT + t) * 1536 + n] = v; else rgx[((size_t)b * LT + t) * 1024 + (n - 1536)] = v; }
    }
    __syncthreads();
}

typedef pg8::f32x4 pf4;
struct EpiProj {
    static constexpr bool PERM = true, AFTER_DRAIN = false;
    bf16_t *hyin, *rgx, *gg, *ga, *gb; const float* bgate;
    __device__ __forceinline__ void operator()(const pf4 (&acc)[2][2][4][2], const pg8::Unit& u, int wr, int wc, int fr, int fq) const {
        const int pn = u.pn, row0 = u.pm * 256 + wr * 64 + fr, cl0 = wc * 32 + 8 * fq;
#ifdef PROBE_P1_SKIPEPI
        if (u.skip) return;
#endif
#pragma unroll
        for (int ai = 0; ai < 2; ++ai)
#pragma unroll
            for (int m = 0; m < 4; ++m) { const int r = row0 + ai * 128 + m * 16; const size_t rl = (size_t)(r >> 12) * LT + NMETA + (r & 4095);
#pragma unroll
                for (int bj = 0; bj < 2; ++bj) { const int col = pn * 256 + bj * 128 + cl0; pf4 v0 = acc[ai][bj][m][0], v1 = acc[ai][bj][m][1]; bf16_t* dst;
                    if (pn < 6) dst = hyin + rl * 1536 + col;
                    else if (pn < 10) dst = rgx + rl * 1024 + (col - 1536);
                    else if (pn < 14) { dst = gg + (size_t)r * 1024 + (col - 2560);
#pragma unroll
                        for (int j = 0; j < 4; ++j) { v0[j] = gelu_tanh(v0[j]); v1[j] = gelu_tanh(v1[j]); } }
                    else { const int gc = col - 3584;
                        dst = (gc < 1024 ? ga + (size_t)r * 1024 + gc : gb + (size_t)r * 1024 + (gc - 1024));
                        const pf4 b0 = *(const pf4*)(bgate + gc), b1 = *(const pf4*)(bgate + gc + 4);
#pragma unroll
                        for (int j = 0; j < 4; ++j) { v0[j] = sigmoidf_(v0[j] + b0[j]); v1[j] = sigmoidf_(v1[j] + b1[j]); } }
                    u32x4 w; w.x = pk2(v0[0], v0[1]); w.y = pk2(v0[2], v0[3]); w.z = pk2(v1[0], v1[1]); w.w = pk2(v1[2], v1[3]);
#ifdef PROBE_P1_NOSTORE
                    if (u.skip) { asm volatile("" :: "v"(w.x), "v"(w.y), "v"(w.z), "v"(w.w)); } else __builtin_nontemporal_store(w, (u32x4*)dst);
#elif defined(NT_STORES)
                    __builtin_nontemporal_store(w, (u32x4*)dst);
#else
                    *(u32x4*)dst = w;
#endif
                } }
    }
};
template <int MODE  > struct EpiGate {
    static constexpr bool PERM = true, AFTER_DRAIN = false;
    const bf16_t* gate; const bf16_t* tin; bf16_t* outp;
    __device__ __forceinline__ void operator()(const pf4 (&acc)[2][2][4][2], const pg8::Unit& u, int wr, int wc, int fr, int fq) const {
        const int row0 = u.pm * 256 + wr * 64 + fr, col0 = u.pn * 256 + wc * 32 + 8 * fq;
        u32x4 gq[2], tq[2];
#define EG_OFF(i) ((size_t)(row0 + ((i) >> 3) * 128 + (((i) >> 1) & 3) * 16) * 1024 + col0 + ((i) & 1) * 128)
        gq[0] = *(const u32x4*)(gate + EG_OFF(0)); if (MODE == 1) tq[0] = *(const u32x4*)(tin + EG_OFF(0));
#pragma unroll
        for (int i = 0; i < 16; ++i) { const int ai = i >> 3, m = (i >> 1) & 3, bj = i & 1; const size_t o = EG_OFF(i);
            if (i + 1 < 16) { gq[(i + 1) & 1] = *(const u32x4*)(gate + EG_OFF(i + 1)); if (MODE == 1) tq[(i + 1) & 1] = *(const u32x4*)(tin + EG_OFF(i + 1)); }
            const pf4 v0 = acc[ai][bj][m][0], v1 = acc[ai][bj][m][1]; const u32x4 g = gq[i & 1];
            float r[8];
            r[0] = v0[0] * bflo(g.x); r[1] = v0[1] * bfhi(g.x); r[2] = v0[2] * bflo(g.y); r[3] = v0[3] * bfhi(g.y);
            r[4] = v1[0] * bflo(g.z); r[5] = v1[1] * bfhi(g.z); r[6] = v1[2] * bflo(g.w); r[7] = v1[3] * bfhi(g.w);
            if (MODE == 1) { const u32x4 t = tq[i & 1];
                r[0] += bflo(t.x); r[1] += bfhi(t.x); r[2] += bflo(t.y); r[3] += bfhi(t.y); r[4] += bflo(t.z); r[5] += bfhi(t.z); r[6] += bflo(t.w); r[7] += bfhi(t.w); }
            u32x4 w; w.x = pk2(r[0], r[1]); w.y = pk2(r[2], r[3]); w.z = pk2(r[4], r[5]); w.w = pk2(r[6], r[7]);
#ifdef NT_STORES2
            if (MODE == 1) __builtin_nontemporal_store(w, (u32x4*)(outp + o)); else *(u32x4*)(outp + o) = w; }
#else
            *(u32x4*)(outp + o) = w; }
#endif
#undef EG_OFF
    }
};
struct EpiResid {
    static constexpr bool PERM = true, AFTER_DRAIN = false;
    const float* x; bf16_t* h1b; float* rowss;
    __device__ __forceinline__ void operator()(const pf4 (&acc)[2][2][4][2], const pg8::Unit& u, int wr, int wc, int fr, int fq) const {
        const int row0 = u.pm * 256 + wr * 64 + fr, col0 = u.pn * 256 + wc * 32 + 8 * fq;
        pf4 xq[2][4];
#define ER_ROW(i) (row0 + ((i) >> 2) * 128 + ((i) & 3) * 16)
#define ER_LOAD(buf, i) do { const float* p_ = x + (size_t)ER_ROW(i) * 1024 + col0; xq[buf][0] = *(const pf4*)p_; xq[buf][1] = *(const pf4*)(p_ + 4); xq[buf][2] = *(const pf4*)(p_ + 128); xq[buf][3] = *(const pf4*)(p_ + 132); } while (0)
        ER_LOAD(0, 0);
#pragma unroll
        for (int i = 0; i < 8; ++i) { const int ai = i >> 2, m = i & 3, r = ER_ROW(i); const size_t ro = (size_t)r * 1024 + col0; float ss = 0.f;
            if (i + 1 < 8) ER_LOAD((i + 1) & 1, i + 1);
#pragma unroll
            for (int bj = 0; bj < 2; ++bj) { const size_t o = ro + bj * 128;
                const pf4 v0 = acc[ai][bj][m][0] + xq[i & 1][2 * bj], v1 = acc[ai][bj][m][1] + xq[i & 1][2 * bj + 1];
                u32x4 w; w.x = pk2(v0[0], v0[1]); w.y = pk2(v0[2], v0[3]); w.z = pk2(v1[0], v1[1]); w.w = pk2(v1[2], v1[3]);
#ifdef NT_STORES2
                __builtin_nontemporal_store(w, (u32x4*)(h1b + o));
#else
                *(u32x4*)(h1b + o) = w;
#endif
                ss += (v0[0] * v0[0] + v0[1] * v0[1]) + (v0[2] * v0[2] + v0[3] * v0[3]) + (v1[0] * v1[0] + v1[1] * v1[1]) + (v1[2] * v1[2] + v1[3] * v1[3]); }
            ss += __shfl_xor(ss, 16); ss += __shfl_xor(ss, 32);
            if (fq == 0) atomicAdd(rowss + r, ss); }
#undef ER_ROW
#undef ER_LOAD
    }
};
struct EpiScores {
    static constexpr bool PERM = true, AFTER_DRAIN = false;
    const float* rowss; _Float16* sc;
    __device__ __forceinline__ void operator()(const pf4 (&acc)[2][2][4][2], const pg8::Unit& u, int wr, int wc, int fr, int fq) const {
        const int row0 = u.pm * 256 + wr * 64 + fr, k0 = wc * 32 + 8 * fq;
#pragma unroll
        for (int ai = 0; ai < 2; ++ai)
#pragma unroll
            for (int m = 0; m < 4; ++m) { const int r = row0 + ai * 128 + m * 16; const float rs = rsqrtf(rowss[r] * (1.f / DM) + EPSF);
#pragma unroll
                for (int bj = 0; bj < 2; ++bj) { _Float16* p = sc + (((size_t)(((r >> 6) * 8 + u.pn) * 2 + bj) * 16 + (k0 >> 3)) * 64 + (r & 63)) * 8;
                    typedef _Float16 h8 __attribute__((ext_vector_type(8)));
                    h8 v; v[0] = (_Float16)(acc[ai][bj][m][0][0] * rs); v[1] = (_Float16)(acc[ai][bj][m][0][1] * rs); v[2] = (_Float16)(acc[ai][bj][m][0][2] * rs); v[3] = (_Float16)(acc[ai][bj][m][0][3] * rs);
                    v[4] = (_Float16)(acc[ai][bj][m][1][0] * rs); v[5] = (_Float16)(acc[ai][bj][m][1][1] * rs); v[6] = (_Float16)(acc[ai][bj][m][1][2] * rs); v[7] = (_Float16)(acc[ai][bj][m][1][3] * rs);
                    *(h8*)p = v; } }
    }
};

__device__ __forceinline__ void unpack8(const u32x4 w, float (&f)[8]) {
    f[0] = bflo(w.x); f[1] = bfhi(w.x); f[2] = bflo(w.y); f[3] = bfhi(w.y); f[4] = bflo(w.z); f[5] = bfhi(w.z); f[6] = bflo(w.w); f[7] = bfhi(w.w); }
__device__ __forceinline__ void load8(const bf16_t* p, float (&f)[8]) { const u32x4 w = *(const u32x4*)p;
    f[0] = bflo(w.x); f[1] = bfhi(w.x); f[2] = bflo(w.y); f[3] = bfhi(w.y); f[4] = bflo(w.z); f[5] = bfhi(w.z); f[6] = bflo(w.w); f[7] = bfhi(w.w); }
__device__ __forceinline__ void short_conv8(const bf16_t* hb, const float* cw, const float* cb, int s, int ch, float (&o)[8]) {
    float xm[8], x0[8], xp[8];
    if (s >= 1) load8(hb + (size_t)(s - 1) * 1536 + ch, xm); else {
#pragma unroll
        for (int i = 0; i < 8; ++i) xm[i] = 0.f; }
    load8(hb + (size_t)s * 1536 + ch, x0);
    if (s + 1 < LT) load8(hb + (size_t)(s + 1) * 1536 + ch, xp); else {
#pragma unroll
        for (int i = 0; i < 8; ++i) xp[i] = 0.f; }
#pragma unroll
    for (int i = 0; i < 8; ++i) o[i] = xm[i] * cw[ch + i] + x0[i] * cw[1536 + ch + i] + xp[i] * cw[3072 + ch + i] + cb[ch + i];
}
__device__ __forceinline__ void short_conv8v(const u32x4& rm, const u32x4& r0, const u32x4& rp, const float* cw, const float* cb, int ch, float (&o)[8]) {
    float xm[8], x0[8], xp[8]; unpack8(rm, xm); unpack8(r0, x0); unpack8(rp, xp);
    const f32x4 wa0 = *(const f32x4*)(cw + ch), wa1 = *(const f32x4*)(cw + ch + 4), wb0 = *(const f32x4*)(cw + 1536 + ch), wb1 = *(const f32x4*)(cw + 1536 + ch + 4);
    const f32x4 wc0 = *(const f32x4*)(cw + 3072 + ch), wc1 = *(const f32x4*)(cw + 3072 + ch + 4), bb0 = *(const f32x4*)(cb + ch), bb1 = *(const f32x4*)(cb + ch + 4);
#pragma unroll
    for (int i = 0; i < 4; ++i) { o[i] = xm[i] * wa0[i] + x0[i] * wb0[i] + xp[i] * wc0[i] + bb0[i]; o[4 + i] = xm[4 + i] * wa1[i] + x0[4 + i] * wb1[i] + xp[4 + i] * wc1[i] + bb1[i]; }
}
__device__ __forceinline__ void phase_hy_pre(const Args& a, LAS unsigned char* lds, int tid) {
    const int wave = tid >> 6, lane = tid & 63, gw = blockIdx.x * NWAVES + wave, NGW = gridDim.x * NWAVES, l8 = lane >> 3, l7 = lane & 7;
    LAS bf16_t* tl = (LAS bf16_t*)(lds + wave * (64 * 144));
    const bf16_t* hyin = (const bf16_t*)(a.ws + WS_HYIN); bf16_t* uut = (bf16_t*)(a.ws + WS_UUT); bf16_t* x0out = (bf16_t*)(a.ws + WS_YH);
    const float* cw = a.in[I_HYCW]; const float* cb = a.in[I_HYCB];
    for (int it = gw; it < NB * 67 * 8; it += NGW) {
        const int ct = it & 7, ts = (it >> 3) % 67, b = (it >> 3) / 67, c0 = ct * 64 + l7 * 8;
        const bf16_t* hb = hyin + (size_t)b * LT * 1536;
#pragma unroll 2
        for (int k = 0; k < 8; ++k) { const int sr = 8 * k + l8, s = ts * 64 + sr - 16;
            float uu[8];
            if (s >= 0 && s < LT) {
                const int sm = (s >= 1) ? s - 1 : s, sp = (s + 1 < LT) ? s + 1 : s; const bool zm = (s < 1), zp = (s + 1 >= LT);
                u32x4 r[3][3];
#pragma unroll
                for (int gI = 0; gI < 3; ++gI) { const bf16_t* p = hb + 512 * gI + c0;
                    r[gI][0] = *(const u32x4*)(p + (size_t)sm * 1536); r[gI][1] = *(const u32x4*)(p + (size_t)s * 1536); r[gI][2] = *(const u32x4*)(p + (size_t)sp * 1536);
                    if (zm) r[gI][0] = (u32x4){0u, 0u, 0u, 0u}; if (zp) r[gI][2] = (u32x4){0u, 0u, 0u, 0u}; }
                float x1[8], v[8]; short_conv8v(r[1][0], r[1][1], r[1][2], cw, cb, 512 + c0, x1); short_conv8v(r[2][0], r[2][1], r[2][2], cw, cb, 1024 + c0, v);
#pragma unroll
                for (int i = 0; i < 8; ++i) uu[i] = v[i] * x1[i];
                if (s >= NMETA) { float x0[8]; short_conv8v(r[0][0], r[0][1], r[0][2], cw, cb, c0, x0);
                    u32x4 w; w.x = pk2(x0[0], x0[1]); w.y = pk2(x0[2], x0[3]); w.z = pk2(x0[4], x0[5]); w.w = pk2(x0[6], x0[7]);
                    *(u32x4*)(x0out + ((size_t)b * SEQ + (s - NMETA)) * DHY + c0) = w; } }
            else {
#pragma unroll
                for (int i = 0; i < 8; ++i) uu[i] = 0.f; }
            u32x4 w; w.x = pk2(uu[0], uu[1]); w.y = pk2(uu[2], uu[3]); w.z = pk2(uu[4], uu[5]); w.w = pk2(uu[6], uu[7]);
            *(LAS u32x4*)(tl + sr * 72 + l7 * 8) = w; }
#pragma unroll
        for (int k = 0; k < 8; ++k) { const int cl = 8 * k + l8, sp0 = ts * 64 + l7 * 8;
            if (sp0 < SP) { unsigned h[8];
#pragma unroll
                for (int i = 0; i < 8; ++i) h[i] = tl[(l7 * 8 + i) * 72 + cl];
                u32x4 w; w.x = h[0] | (h[1] << 16); w.y = h[2] | (h[3] << 16); w.z = h[4] | (h[5] << 16); w.w = h[6] | (h[7] << 16);
                *(u32x4*)(uut + ((size_t)(ct * 64 + cl) * NB + b) * SP + sp0) = w; } }
    }
}
__device__ __forceinline__ void phase_hy_conv_naive(const Args& a, LAS unsigned char* lds, int tid) {
    LAS bf16_t* uus = (LAS bf16_t*)lds;
    LAS float* filt = (LAS float*)(lds + LT * 16);
    const bf16_t* uut = (const bf16_t*)(a.ws + WS_UUT); const float* kf = (const float*)(a.ws + WS_KF); bf16_t* cvt = (bf16_t*)(a.ws + WS_CONVT);
    for (int c = blockIdx.x; c < DHY; c += gridDim.x) {
        for (int i = tid; i < NB * LT; i += NTHR) { const int b = i / LT, s = i - b * LT; uus[s * 8 + b] = uut[((size_t)c * NB + b) * SP + 16 + s]; }
        for (int i = tid; i < KFW; i += NTHR) filt[i] = kf[(size_t)c * KFW + i];
        __syncthreads();
        for (int tt = 0; tt < 8; ++tt) { const int tq = tt * 512 + tid, t = tq + 16; float acc[8];
#pragma unroll
            for (int b = 0; b < 8; ++b) acc[b] = 0.f;
            const LAS float* fp = filt + (LT - 1) + t;
            for (int s = 0; s < LT; ++s) { const float kv = fp[-s]; const u32x4 w = *(const LAS u32x4*)(uus + s * 8);
                acc[0] += kv * bflo(w.x); acc[1] += kv * bfhi(w.x); acc[2] += kv * bflo(w.y); acc[3] += kv * bfhi(w.y);
                acc[4] += kv * bflo(w.z); acc[5] += kv * bfhi(w.z); acc[6] += kv * bflo(w.w); acc[7] += kv * bfhi(w.w); }
#pragma unroll
            for (int b = 0; b < 8; ++b) cvt[((size_t)c * NB + b) * SEQ + tq] = (bf16_t)f2bf(acc[b]); }
        __syncthreads();
    }
}
__device__ __forceinline__ void phase_rg_naive(const Args& a, LAS unsigned char* lds, int tid) {
    LAS float* xc = (LAS float*)lds;
    LAS float* gbuf = xc + 32 * 128;
    const bf16_t* rgx = (const bf16_t*)(a.ws + WS_RGX);
    for (int it = blockIdx.x; it < NB * 2 * 8; it += gridDim.x) {
        const int head = it & 7, dir = (it >> 3) & 1, b = it >> 4;
        const float* cw = a.in[I_RGCW] + (size_t)dir * 4 * DRG + head * 128; const float* cb = a.in[I_RGCB] + (size_t)dir * DRG + head * 128;
        bf16_t* hout = (bf16_t*)a.out + (size_t)dir * T * DRG;
        const bf16_t* xb = rgx + (size_t)b * LT * DRG + head * 128;
        float h = 0.f, sp = 0.f;
        if (tid < 128) { const float lam = a.in[I_RGLAM][dir * DRG + head * 128 + tid]; sp = log1pf(__expf(-lam)); }
        for (int k = 0; k < 129; ++k) {
            { const int tok = tid >> 4, cg = tid & 15, u = 32 * k + tok; float o[8];
#pragma unroll
                for (int i = 0; i < 8; ++i) o[i] = (u < LT) ? cb[cg * 8 + i] : 0.f;
                if (u < LT) {
#pragma unroll
                    for (int j = 0; j < 4; ++j) { const int uu = u - j; if (uu >= 0) { const int t = dir ? (LT - 1 - uu) : uu; float xv[8]; load8(xb + (size_t)t * DRG + cg * 8, xv);
#pragma unroll
                            for (int i = 0; i < 8; ++i) o[i] += xv[i] * cw[j * DRG + cg * 8 + i]; } } }
#pragma unroll
                for (int i = 0; i < 8; ++i) xc[tok * 128 + cg * 8 + i] = o[i]; }
            __syncthreads();
            { const int j = tid & 127, g = (tid >> 7) & 1, th = tid >> 8; float acc[16];
#pragma unroll
                for (int q = 0; q < 16; ++q) acc[q] = 0.f;
                const float* gw = a.in[I_RGGW] + ((size_t)((dir * 2 + g) * 8 + head) * 128) * 128 + j;
                for (int i = 0; i < 128; ++i) { const float wv = gw[i * 128];
#pragma unroll
                    for (int q = 0; q < 16; ++q) acc[q] += xc[(th * 16 + q) * 128 + i] * wv; }
                const float gb = a.in[I_RGGB][(size_t)(dir * 2 + g) * DRG + head * 128 + j];
#pragma unroll
                for (int q = 0; q < 16; ++q) gbuf[(g * 32 + th * 16 + q) * 128 + j] = acc[q] + gb; }
            __syncthreads();
            if (tid < 128) {
                for (int tok = 0; tok < 32; ++tok) { const int u = 32 * k + tok; if (u >= LT) break;
                    const float r = sigmoidf_(gbuf[tok * 128 + tid]), ig = sigmoidf_(gbuf[(32 + tok) * 128 + tid]);
                    const float la = -8.0f * r * sp; const float av = __expf(la); const float mult = (u == 0) ? 1.0f : sqrtf(-expm1f(2.0f * la));
                    h = av * h + mult * ig * xc[tok * 128 + tid];
                    const int t = dir ? (LT - 1 - u) : u;
                    if (t >= NMETA) hout[((size_t)b * SEQ + (t - NMETA)) * DRG + head * 128 + tid] = (bf16_t)f2bf(h); } }
            __syncthreads();
        }
    }
}
__device__ __forceinline__ void phase_post(const Args& a, LAS unsigned char* lds, int tid) {
    const int wave = tid >> 6, lane = tid & 63, gw = blockIdx.x * NWAVES + wave, NGW = gridDim.x * NWAVES;
    LAS bf16_t* cv = (LAS bf16_t*)(lds + wave * (64 * 144));
    const bf16_t* cvt = (const bf16_t*)(a.ws + WS_CONVT); bf16_t* yh = (bf16_t*)(a.ws + WS_YH);
    const int l8 = lane >> 3, l7 = lane & 7;
    for (int it = gw; it < NB * 64 * 8; it += NGW) {
        const int ct = it & 7, tt = (it >> 3) & 63, b = it >> 9;
        u32x4 cw_[8], xw[8];
#pragma unroll
        for (int k = 0; k < 8; ++k) cw_[k] = *(const u32x4*)(cvt + ((size_t)(ct * 64 + 8 * k + l8) * NB + b) * SEQ + tt * 64 + l7 * 8);
        bf16_t* yp = yh + ((size_t)b * SEQ + tt * 64 + l8) * DHY + ct * 64 + l7 * 8;
#pragma unroll
        for (int k = 0; k < 8; ++k) xw[k] = *(const u32x4*)(yp + (size_t)(8 * k) * DHY);
#pragma unroll
        for (int k = 0; k < 8; ++k) *(LAS u32x4*)(cv + (8 * k + l8) * 72 + l7 * 8) = cw_[k];
#pragma unroll
        for (int k = 0; k < 8; ++k) { const int tr = 8 * k + l8; float x0[8], y[8]; unpack8(xw[k], x0);
#pragma unroll
            for (int i = 0; i < 8; ++i) y[i] = bf2f(cv[(l7 * 8 + i) * 72 + tr]) * x0[i];
            u32x4 w; w.x = pk2(y[0], y[1]); w.y = pk2(y[2], y[3]); w.z = pk2(y[4], y[5]); w.w = pk2(y[6], y[7]);
            *(u32x4*)(yp + (size_t)(8 * k) * DHY) = w; }
    }
    const bf16_t* hf = (const bf16_t*)a.out; const bf16_t* hb2 = hf + (size_t)T * DRG; const bf16_t* gg = (const bf16_t*)(a.ws + WS_GG); bf16_t* yr = (bf16_t*)(a.ws + WS_YR);
    const bf16_t* rgp = (const bf16_t*)(a.ws + WS_RGP); const float* rgc = (const float*)(a.ws + WS_RGC);
    for (size_t i = (size_t)blockIdx.x * NTHR + tid; i < (size_t)T * DRG / 8; i += (size_t)gridDim.x * NTHR) {
        const int c8 = (int)(i & 127) * 8, m = (int)(i >> 7), b = m >> 12, t = (m & 4095) + NMETA;
        float f[8], g[8], q[8]; load8(hf + i * 8, f); load8(hb2 + i * 8, g); load8(gg + i * 8, q);
        if (t >= RG_U1) { float p[8]; load8(rgp + ((size_t)(0 * NB + b) * RG_NF + (t - RG_U1)) * DRG + c8, p); const float* cc = rgc + (size_t)(0 * NB + b) * DRG + c8;
#pragma unroll
            for (int j = 0; j < 8; ++j) f[j] += p[j] * cc[j]; }
        const int ub = LT - 1 - t;
        if (ub >= RG_U1) { float p[8]; load8(rgp + ((size_t)(1 * NB + b) * RG_NF + (ub - RG_U1)) * DRG + c8, p); const float* cc = rgc + (size_t)(1 * NB + b) * DRG + c8;
#pragma unroll
            for (int j = 0; j < 8; ++j) g[j] += p[j] * cc[j]; }
        u32x4 w; w.x = pk2((f[0] + g[0]) * q[0], (f[1] + g[1]) * q[1]); w.y = pk2((f[2] + g[2]) * q[2], (f[3] + g[3]) * q[3]);
        w.z = pk2((f[4] + g[4]) * q[4], (f[5] + g[5]) * q[5]); w.w = pk2((f[6] + g[6]) * q[6], (f[7] + g[7]) * q[7]);
        *(u32x4*)(yr + i * 8) = w; }
}
__device__ __forceinline__ u32x4 quant_row16(const f32x4 (&v)[4], float amax, float& deq) {
    const float sc = (amax > 0.f) ? 256.0f / amax : 1.0f; deq = (amax > 0.f) ? amax * (1.0f / 256.0f) : 1.0f;
    u32x4 w; int t;
    t = __builtin_amdgcn_cvt_pk_fp8_f32(v[0].x * sc, v[0].y * sc, 0, false); t = __builtin_amdgcn_cvt_pk_fp8_f32(v[0].z * sc, v[0].w * sc, t, true); w.x = (unsigned)t;
    t = __builtin_amdgcn_cvt_pk_fp8_f32(v[1].x * sc, v[1].y * sc, 0, false); t = __builtin_amdgcn_cvt_pk_fp8_f32(v[1].z * sc, v[1].w * sc, t, true); w.y = (unsigned)t;
    t = __builtin_amdgcn_cvt_pk_fp8_f32(v[2].x * sc, v[2].y * sc, 0, false); t = __builtin_amdgcn_cvt_pk_fp8_f32(v[2].z * sc, v[2].w * sc, t, true); w.z = (unsigned)t;
    t = __builtin_amdgcn_cvt_pk_fp8_f32(v[3].x * sc, v[3].y * sc, 0, false); t = __builtin_amdgcn_cvt_pk_fp8_f32(v[3].z * sc, v[3].w * sc, t, true); w.w = (unsigned)t;
    return w;
}
__device__ __forceinline__ unsigned q8x4(f32x4 v, float sc) {
    const int a = (int)rintf(v.x * sc), b = (int)rintf(v.y * sc), c = (int)rintf(v.z * sc), d = (int)rintf(v.w * sc);
    return ((unsigned)a & 0xffu) | (((unsigned)b & 0xffu) << 8) | (((unsigned)c & 0xffu) << 16) | ((unsigned)d << 24);
}
__device__ __forceinline__ void phase_tables(const Args& a, int wave, int lane) {
    const int gw = blockIdx.x * NWAVES + wave, NGW = gridDim.x * NWAVES;
    const float* gf = a.in[I_GFFN] + 16 * lane; unsigned char* uq = a.ws + WS_UB; unsigned char* vq = a.ws + WS_VB; float* su = (float*)(a.ws + WS_SU); float* sv = (float*)(a.ws + WS_SV);
    f32x4 g[4];
#pragma unroll
    for (int j = 0; j < 4; ++j) g[j] = *(const f32x4*)(gf + 4 * j);
    for (int e = gw; e < NEXP; e += NGW) {
        const float* ur = a.in[I_PU] + (size_t)e * DM + 16 * lane; const float* vr = a.in[I_PV] + (size_t)e * DM + 16 * lane;
        f32x4 u[4], v[4]; float mu = 0.f, mv = 0.f;
#pragma unroll
        for (int j = 0; j < 4; ++j) { u[j] = *(const f32x4*)(ur + 4 * j) * g[j]; v[j] = *(const f32x4*)(vr + 4 * j);
            mu = fmaxf(mu, fmaxf(fmaxf(fabsf(u[j].x), fabsf(u[j].y)), fmaxf(fabsf(u[j].z), fabsf(u[j].w))));
            mv = fmaxf(mv, fmaxf(fmaxf(fabsf(v[j].x), fabsf(v[j].y)), fmaxf(fabsf(v[j].z), fabsf(v[j].w)))); }
        mu = wave_max_dpp(mu); mv = wave_max_dpp(mv);
        const float scu = (mu > 0.f) ? 127.0f / mu : 1.0f, du = (mu > 0.f) ? mu * (1.0f / 127.0f) : 1.0f;
        u32x4 qu; qu.x = q8x4(u[0], scu); qu.y = q8x4(u[1], scu); qu.z = q8x4(u[2], scu); qu.w = q8x4(u[3], scu);
        const float scv = (mv > 0.f) ? 127.0f / mv : 1.0f, dv = (mv > 0.f) ? mv * (1.0f / 127.0f) : 1.0f;
        u32x4 qv; qv.x = q8x4(v[0], scv); qv.y = q8x4(v[1], scv); qv.z = q8x4(v[2], scv); qv.w = q8x4(v[3], scv);
        { const size_t so = ((size_t)(lane >> 3) * NEXP + e) * 128 + 16 * (lane & 7); *(u32x4*)(uq + so) = qu; *(u32x4*)(vq + so) = qv; }
        if (lane == 0) { su[e] = du; sv[e] = dv; }
    }
}
__device__ __forceinline__ void ce_desc(float& a, float& b) { const float hi = fmaxf(a, b), lo = fminf(a, b); a = hi; b = lo; }
__device__ __forceinline__ void sort16_desc(float (&x)[16]) {
#pragma unroll
    for (int k = 2; k <= 16; k <<= 1)
#pragma unroll
        for (int j = k >> 1; j > 0; j >>= 1)
#pragma unroll
            for (int i = 0; i < 16; ++i) { const int l = i ^ j; if (l > i) { if ((i & k) == 0) ce_desc(x[i], x[l]); else ce_desc(x[l], x[i]); } }
}
__device__ __forceinline__ void merge_top16(float (&L)[16], const float (&X)[16]) {
#pragma unroll
    for (int i = 0; i < 16; ++i) L[i] = fmaxf(L[i], X[15 - i]);
#pragma unroll
    for (int j = 8; j > 0; j >>= 1)
#pragma unroll
        for (int i = 0; i < 16; ++i) { const int l = i ^ j; if (l > i) ce_desc(L[i], L[l]); }
}
__device__ __forceinline__ void top16_of_128(const _Float16* base  , float (&L)[16]) {
    typedef _Float16 h8 __attribute__((ext_vector_type(8)));
    h8 v0 = *(const h8*)(base), v1 = *(const h8*)(base + 512);
#pragma unroll 1
    for (int ch = 0; ch < 8; ++ch) { float X[16]; const int cn = (ch < 7) ? ch + 1 : 7;
        const h8 n0 = *(const h8*)(base + (2 * cn) * 512), n1 = *(const h8*)(base + (2 * cn + 1) * 512);
#pragma unroll
        for (int i = 0; i < 8; ++i) { X[i] = __uint_as_float((__float_as_uint((float)v0[i]) & ~0x7Fu) | (unsigned)(ch * 16 + i));
            X[8 + i] = __uint_as_float((__float_as_uint((float)v1[i]) & ~0x7Fu) | (unsigned)(ch * 16 + 8 + i)); }
        sort16_desc(X);
        if (ch == 0) {
#pragma unroll
            for (int i = 0; i < 16; ++i) L[i] = X[i]; }
        else merge_top16(L, X);
        v0 = n0; v1 = n1; }
}
struct CandTab { int ci[64], cj[64]; };
__host__ __device__ constexpr CandTab make_cand() { CandTab t{}; int n = 0; for (int i = 0; i < 16; ++i) for (int j = 0; j < 16; ++j) if ((i + 1) * (j + 1) <= 16) { t.ci[n] = i; t.cj[n] = j; ++n; }
    for (; n < 64; ++n) { t.ci[n] = -1; t.cj[n] = -1; } return t; }
__device__ __forceinline__ void phase_topk(const Args& a, LAS unsigned char* lds, const pg8::StaticOrder& S, int wave, int lane) {
    constexpr CandTab CT = make_cand();
    const _Float16* st = (const _Float16*)(a.ws + WS_SCORES); int* eidx = (int*)(a.ws + WS_EIDX); float* eg = (float*)(a.ws + WS_EG);
    LAS unsigned char* tab = lds + wave * (64 * 36) + lane * 36;
    for (int j = wave; ; j += NWAVES) { pg8::Unit un; if (!S.next(j >> 2, un)) break; const int tg = 4 * un.pm + (j & 3), hh = un.pn; const int m = tg * 64 + lane;
        float A[16], B[16];
        top16_of_128(st + (size_t)((tg * 8 + hh) * 2 + 0) * 128 * 64 + lane * 8, A);
        top16_of_128(st + (size_t)((tg * 8 + hh) * 2 + 1) * 128 * 64 + lane * 8, B);
#pragma unroll
        for (int q = 0; q < 4; ++q) {
            const unsigned wa = (__float_as_uint(A[4 * q]) & 0x7Fu) | ((__float_as_uint(A[4 * q + 1]) & 0x7Fu) << 8) | ((__float_as_uint(A[4 * q + 2]) & 0x7Fu) << 16) | ((__float_as_uint(A[4 * q + 3]) & 0x7Fu) << 24);
            const unsigned wb = (__float_as_uint(B[4 * q]) & 0x7Fu) | ((__float_as_uint(B[4 * q + 1]) & 0x7Fu) << 8) | ((__float_as_uint(B[4 * q + 2]) & 0x7Fu) << 16) | ((__float_as_uint(B[4 * q + 3]) & 0x7Fu) << 24);
            *(LAS unsigned*)(tab + 4 * q) = wa; *(LAS unsigned*)(tab + 16 + 4 * q) = wb; }
#pragma unroll
        for (int i = 0; i < 16; ++i) { A[i] = __uint_as_float(__float_as_uint(A[i]) & ~0x7Fu); B[i] = __uint_as_float(__float_as_uint(B[i]) & ~0x7Fu); }
        float K[16];
#pragma unroll
        for (int c0 = 0; c0 < 64; c0 += 16) { float X[16];
#pragma unroll
            for (int i = 0; i < 16; ++i) { const int c = c0 + i;
                if (CT.ci[c] >= 0) X[i] = __uint_as_float((__float_as_uint(A[CT.ci[c] < 0 ? 0 : CT.ci[c]] + B[CT.cj[c] < 0 ? 0 : CT.cj[c]]) & ~0xFFu) | (unsigned)(CT.ci[c] * 16 + CT.cj[c]));
                else X[i] = -INFINITY; }
            sort16_desc(X);
            if (c0 == 0) {
#pragma unroll
                for (int i = 0; i < 16; ++i) K[i] = X[i]; }
            else merge_top16(K, X); }
        asm volatile("s_waitcnt lgkmcnt(0)" ::: "memory");
        int ex_[16]; float cs[16]; float sum = 0.f;
#pragma unroll
        for (int r = 0; r < 16; ++r) { const unsigned kb = __float_as_uint(K[r]); const int id = kb & 0xFF; cs[r] = __expf(__uint_as_float(kb & ~0xFFu) - __uint_as_float(__float_as_uint(K[0]) & ~0xFFu)); sum += cs[r];
            ex_[r] = (int)tab[id >> 4] * 128 + (int)tab[16 + (id & 15)]; }
        const float inv = 1.0f / sum;
        unsigned short* ep = (unsigned short*)eidx + (size_t)m * 128 + hh * 16; float* gp = eg + (size_t)m * 128 + hh * 16;
        { u32x4 p0, p1; p0.x = ex_[0] | (ex_[1] << 16); p0.y = ex_[2] | (ex_[3] << 16); p0.z = ex_[4] | (ex_[5] << 16); p0.w = ex_[6] | (ex_[7] << 16);
          p1.x = ex_[8] | (ex_[9] << 16); p1.y = ex_[10] | (ex_[11] << 16); p1.z = ex_[12] | (ex_[13] << 16); p1.w = ex_[14] | (ex_[15] << 16); *(u32x4*)ep = p0; *(u32x4*)(ep + 8) = p1; }
#pragma unroll
        for (int q = 0; q < 4; ++q) {
            *(f32x4*)(gp + 4 * q) = (f32x4){cs[4 * q] * inv, cs[4 * q + 1] * inv, cs[4 * q + 2] * inv, cs[4 * q + 3] * inv}; }
    }
}
__device__ __forceinline__ void fp8x16_to_f32(const u32x4 w, float (&f)[16]) {
    f32x2v t;
    t = __builtin_amdgcn_cvt_pk_f32_fp8((int)w.x, false); f[0] = t.x; f[1] = t.y; t = __builtin_amdgcn_cvt_pk_f32_fp8((int)w.x, true); f[2] = t.x; f[3] = t.y;
    t = __builtin_amdgcn_cvt_pk_f32_fp8((int)w.y, false); f[4] = t.x; f[5] = t.y; t = __builtin_amdgcn_cvt_pk_f32_fp8((int)w.y, true); f[6] = t.x; f[7] = t.y;
    t = __builtin_amdgcn_cvt_pk_f32_fp8((int)w.z, false); f[8] = t.x; f[9] = t.y; t = __builtin_amdgcn_cvt_pk_f32_fp8((int)w.z, true); f[10] = t.x; f[11] = t.y;
    t = __builtin_amdgcn_cvt_pk_f32_fp8((int)w.w, false); f[12] = t.x; f[13] = t.y; t = __builtin_amdgcn_cvt_pk_f32_fp8((int)w.w, true); f[14] = t.x; f[15] = t.y;
}
__device__ __forceinline__ void fp8x16_to_f32x2(const u32x4 w, f32x2v (&f)[8]) {
    f[0] = __builtin_amdgcn_cvt_pk_f32_fp8((int)w.x, false); f[1] = __builtin_amdgcn_cvt_pk_f32_fp8((int)(w.x >> 16), false);
    f[2] = __builtin_amdgcn_cvt_pk_f32_fp8((int)w.y, false); f[3] = __builtin_amdgcn_cvt_pk_f32_fp8((int)(w.y >> 16), false);
    f[4] = __builtin_amdgcn_cvt_pk_f32_fp8((int)w.z, false); f[5] = __builtin_amdgcn_cvt_pk_f32_fp8((int)(w.z >> 16), false);
    f[6] = __builtin_amdgcn_cvt_pk_f32_fp8((int)w.w, false); f[7] = __builtin_amdgcn_cvt_pk_f32_fp8((int)(w.w >> 16), false);
}
__device__ __forceinline__ float dpp_sum8(float v) {
    v += __int_as_float(__builtin_amdgcn_update_dpp(0, __float_as_int(v), 0xB1, 0xF, 0xF, true));
    v += __int_as_float(__builtin_amdgcn_update_dpp(0, __float_as_int(v), 0x4E, 0xF, 0xF, true));
    v += __int_as_float(__builtin_amdgcn_update_dpp(0, __float_as_int(v), 0x141, 0xF, 0xF, true));
    return v;
}
struct UTok { u32x4 e0, e1, xa, xb; };
struct VTok { u32x4 e0, e1; f32x4 av[4]; };
__device__ __forceinline__ void pu_issue(const unsigned char* tab, unsigned loff, const u32x4& e, u32x4 (&w)[8]) {
    w[0] = *(const u32x4*)(tab + ((e.x & 0xffffu) * 128u + loff)); w[1] = *(const u32x4*)(tab + ((e.x >> 16) * 128u + loff));
    w[2] = *(const u32x4*)(tab + ((e.y & 0xffffu) * 128u + loff)); w[3] = *(const u32x4*)(tab + ((e.y >> 16) * 128u + loff));
    w[4] = *(const u32x4*)(tab + ((e.z & 0xffffu) * 128u + loff)); w[5] = *(const u32x4*)(tab + ((e.z >> 16) * 128u + loff));
    w[6] = *(const u32x4*)(tab + ((e.w & 0xffffu) * 128u + loff)); w[7] = *(const u32x4*)(tab + ((e.w >> 16) * 128u + loff));
}
__device__ __forceinline__ void pu_dots(const int (&xq)[4], const u32x4 (&w)[8], int (&d)[8]) {
#pragma unroll
    for (int q = 0; q < 8; ++q) { int t = __builtin_amdgcn_sdot4((int)w[q].x, xq[0], 0, false); t = __builtin_amdgcn_sdot4((int)w[q].y, xq[1], t, false);
        t = __builtin_amdgcn_sdot4((int)w[q].z, xq[2], t, false); d[q] = __builtin_amdgcn_sdot4((int)w[q].w, xq[3], t, false); }
}
__device__ __forceinline__ void pu_reduce(const int (&d0)[8], const int (&d1)[8], int lane, int& lo, int& hi) {
    const bool b2 = (lane & 4) != 0, b1 = (lane & 2) != 0, b0 = (lane & 1) != 0;
    int a[8];
#pragma unroll
    for (int q = 0; q < 4; ++q) { const int s0 = b2 ? d0[q] : d0[4 + q], k0 = b2 ? d0[4 + q] : d0[q], s1 = b2 ? d1[q] : d1[4 + q], k1 = b2 ? d1[4 + q] : d1[q];
        a[q] = k0 + __builtin_amdgcn_update_dpp(0, s0, 0x141, 0xF, 0xF, true); a[4 + q] = k1 + __builtin_amdgcn_update_dpp(0, s1, 0x141, 0xF, 0xF, true); }
    int bq[4];
#pragma unroll
    for (int q = 0; q < 2; ++q) { const int s0 = b1 ? a[q] : a[2 + q], k0 = b1 ? a[2 + q] : a[q], s1 = b1 ? a[4 + q] : a[6 + q], k1 = b1 ? a[6 + q] : a[4 + q];
        bq[q] = k0 + __builtin_amdgcn_update_dpp(0, s0, 0x4E, 0xF, 0xF, true); bq[2 + q] = k1 + __builtin_amdgcn_update_dpp(0, s1, 0x4E, 0xF, 0xF, true); }
    { const int s0 = b0 ? bq[0] : bq[1], k0 = b0 ? bq[1] : bq[0], s1 = b0 ? bq[2] : bq[3], k1 = b0 ? bq[3] : bq[2];
        lo = k0 + __builtin_amdgcn_update_dpp(0, s0, 0xB1, 0xF, 0xF, true); hi = k1 + __builtin_amdgcn_update_dpp(0, s1, 0xB1, 0xF, 0xF, true); }
}
__device__ __forceinline__ float pu_quant_x(const u32x4& xa, const u32x4& xb, int (&xq)[4]) {
    float f[16]; unpack8(xa, *(float(*)[8])&f[0]); unpack8(xb, *(float(*)[8])&f[8]);
    float mx = 0.f;
#pragma unroll
    for (int c = 0; c < 16; ++c) mx = fmaxf(mx, fabsf(f[c]));
    mx = fmaxf(mx, __int_as_float(__builtin_amdgcn_update_dpp(0, __float_as_int(mx), 0xB1, 0xF, 0xF, true)));
    mx = fmaxf(mx, __int_as_float(__builtin_amdgcn_update_dpp(0, __float_as_int(mx), 0x4E, 0xF, 0xF, true)));
    mx = fmaxf(mx, __int_as_float(__builtin_amdgcn_update_dpp(0, __float_as_int(mx), 0x141, 0xF, 0xF, true)));
    const float sc = (mx > 0.f) ? 127.0f * __builtin_amdgcn_rcpf(mx) * 0.99999f : 0.f;
#pragma unroll
    for (int c4 = 0; c4 < 4; ++c4) xq[c4] = (int)q8x4((f32x4){f[4 * c4], f[4 * c4 + 1], f[4 * c4 + 2], f[4 * c4 + 3]}, sc);
    return mx * (1.0f / 127.0f);
}
__device__ __forceinline__ void phase_peer_u(const Args& a, int wave, int lane) {
    const int s = SLICE_OF(blockIdx.x), rk = RANK_OF(blockIdx.x), nrk = gridDim.x >> 3, tper = T / nrk, i = lane & 7, j = lane >> 3;
    const bf16_t* h1b = (const bf16_t*)(a.ws + WS_H1B) + 128 * s + 16 * i; const unsigned char* uqs = a.ws + WS_UB + (size_t)s * NEXP * 128; const unsigned loff = 16u * (unsigned)i;
    const unsigned short* eidx = (const unsigned short*)(a.ws + WS_EIDX) + 16 * j; float* pd = (float*)(a.ws + WS_PD) + (size_t)s * T * 128 + 16 * j + i;
    const int m0 = rk * tper + wave, mlast = (rk + 1) * tper - NWAVES + wave;
#define PU_LOAD(t, mm) do { const int m_ = (mm) < mlast ? (mm) : mlast; const u32x4* ep_ = (const u32x4*)(eidx + (size_t)m_ * 128); (t).e0 = ep_[0]; (t).e1 = ep_[1]; \
        (t).xa = *(const u32x4*)(h1b + (size_t)m_ * DM); (t).xb = *(const u32x4*)(h1b + (size_t)m_ * DM + 8); } while (0)
#define PU_DO(t, w0, w1, mm) do { int xq_[4]; const float sx_ = pu_quant_x((t).xa, (t).xb, xq_); int d0_[8], d1_[8], lo_, hi_; pu_dots(xq_, w0, d0_); pu_dots(xq_, w1, d1_); \
        pu_reduce(d0_, d1_, lane, lo_, hi_); pd[(size_t)(mm) * 128] = (float)lo_ * sx_; pd[(size_t)(mm) * 128 + 8] = (float)hi_ * sx_; } while (0)
    UTok tC, tN, tNN; u32x4 wA[8], wB[8], wC[8], wD[8];
    PU_LOAD(tC, m0); PU_LOAD(tN, m0 + NWAVES); PU_LOAD(tNN, m0 + 2 * NWAVES); pu_issue(uqs, loff, tC.e0, wA); pu_issue(uqs, loff, tC.e1, wB);
    for (int m = m0; m <= mlast; m += 2 * NWAVES) {
        pu_issue(uqs, loff, tN.e0, wC); pu_issue(uqs, loff, tN.e1, wD);
        PU_DO(tC, wA, wB, m);
        tC = tN; tN = tNN; PU_LOAD(tNN, m + 3 * NWAVES);
        pu_issue(uqs, loff, tN.e0, wA); pu_issue(uqs, loff, tN.e1, wB);
        PU_DO(tC, wC, wD, m + NWAVES);
        tC = tN; tN = tNN; PU_LOAD(tNN, m + 4 * NWAVES);
    }
#undef PU_LOAD
#undef PU_DO
}
typedef long i64_t;
__device__ __forceinline__ i64_t pack64(unsigned lo, unsigned hi) { return (i64_t)(((unsigned long long)hi << 32) | (unsigned long long)lo); }
struct MTokI { u32x4 ia, ib; };
struct MTokX { u32x4 xq[4]; };
__device__ __forceinline__ unsigned id16(const u32x4& v, int c) { const unsigned wv = (c >> 1) == 0 ? v.x : (c >> 1) == 1 ? v.y : (c >> 1) == 2 ? v.z : v.w; return (c & 1) ? (wv >> 16) : (wv & 0xffffu); }
__device__ __forceinline__ void pm_issue(const unsigned char* tab, unsigned loff, const MTokI& t, u32x4 (&W)[16]) {
#pragma unroll
    for (int c = 0; c < 8; ++c) { W[2 * c] = *(const u32x4*)(tab + (id16(t.ia, c) * 128u + loff)); W[2 * c + 1] = *(const u32x4*)(tab + (id16(t.ib, c) * 128u + loff)); }
}
template <bool HI> __device__ __forceinline__ unsigned bf2_to_fp8x2(unsigned w, int old) { const float a = fminf(fmaxf(bflo(w), -448.f), 448.f), b = fminf(fmaxf(bfhi(w), -448.f), 448.f); return (unsigned)__builtin_amdgcn_cvt_pk_fp8_f32(a, b, old, HI); }
__device__ __forceinline__ void pm_compute(const MTokX& t, const u32x4 (&W)[16], LAS unsigned char* wl  , float* pdrow  , int lane) {
    unsigned xb[8];
#pragma unroll
    for (int q = 0; q < 4; ++q) { unsigned lo = bf2_to_fp8x2<false>(t.xq[q].x, 0); lo = bf2_to_fp8x2<true>(t.xq[q].y, (int)lo); unsigned hi = bf2_to_fp8x2<false>(t.xq[q].z, 0); hi = bf2_to_fp8x2<true>(t.xq[q].w, (int)hi); xb[2 * q] = lo; xb[2 * q + 1] = hi; }
    const i64_t B0 = pack64(xb[0], xb[1]), B1 = pack64(xb[2], xb[3]), B2 = pack64(xb[4], xb[5]), B3 = pack64(xb[6], xb[7]);
    const int j8 = lane >> 3, i = lane & 7, r = lane & 15, g = lane >> 4;
    LAS unsigned char* wr0 = wl + j8 * 144 + i * 16;
    const LAS unsigned char* rd0 = wl + r * 144 + g * 32;
    f32x4 C[8];
#pragma unroll
    for (int c = 0; c < 8; ++c) { const int bo = (c & 1) * 2304;
        *(LAS u32x4*)(wr0 + bo) = W[2 * c]; *(LAS u32x4*)(wr0 + bo + 8 * 144) = W[2 * c + 1];
        const u32x4 a0 = *(const LAS u32x4*)(rd0 + bo), a1 = *(const LAS u32x4*)(rd0 + bo + 16);
        f32x4 acc = (f32x4){0.f, 0.f, 0.f, 0.f};
        acc = __builtin_amdgcn_mfma_f32_16x16x32_fp8_fp8(pack64(a0.x, a0.y), B0, acc, 0, 0, 0);
        acc = __builtin_amdgcn_mfma_f32_16x16x32_fp8_fp8(pack64(a0.z, a0.w), B1, acc, 0, 0, 0);
        acc = __builtin_amdgcn_mfma_f32_16x16x32_fp8_fp8(pack64(a1.x, a1.y), B2, acc, 0, 0, 0);
        acc = __builtin_amdgcn_mfma_f32_16x16x32_fp8_fp8(pack64(a1.z, a1.w), B3, acc, 0, 0, 0); C[c] = acc; }
    if ((lane & 15) == 0) {
#pragma unroll
        for (int reg = 0; reg < 4; ++reg) { *(f32x4*)(pdrow + 8 * reg) = (f32x4){C[0][reg], C[1][reg], C[2][reg], C[3][reg]}; *(f32x4*)(pdrow + 8 * reg + 4) = (f32x4){C[4][reg], C[5][reg], C[6][reg], C[7][reg]}; } }
}
__device__ __forceinline__ void phase_peer_u_mfma(const Args& a, LAS unsigned char* lds, int wave, int lane) {
    const int s = SLICE_OF(blockIdx.x), rk = RANK_OF(blockIdx.x), nrk = gridDim.x >> 3, tper = T / nrk, g = lane >> 4, j8 = lane >> 3;
    const bf16_t* h1b = (const bf16_t*)(a.ws + WS_H1B) + 128 * s + 32 * g; const unsigned char* uqs = a.ws + WS_UB + (size_t)s * NEXP * 128; const unsigned loff = 16u * (unsigned)(lane & 7);
    const unsigned short* eidx = (const unsigned short*)(a.ws + WS_EIDX) + 8 * j8; float* pd = (float*)(a.ws + WS_PD) + (size_t)s * T * 128 + 32 * g;
    LAS unsigned char* wl = lds + wave * 4608;
    const int m0 = rk * tper + wave, mlast = (rk + 1) * tper - NWAVES + wave;
#define PM_LOADI(t, mm) do { const int m_ = (mm) < mlast ? (mm) : mlast; (t).ia = *(const u32x4*)(eidx + (size_t)m_ * 128); (t).ib = *(const u32x4*)(eidx + (size_t)m_ * 128 + 64); } while (0)
#define PM_LOADX(t, mm) do { const int m_ = (mm) < mlast ? (mm) : mlast; const u32x4* xp_ = (const u32x4*)(h1b + (size_t)m_ * DM); (t).xq[0] = xp_[0]; (t).xq[1] = xp_[1]; (t).xq[2] = xp_[2]; (t).xq[3] = xp_[3]; } while (0)
    MTokI iC, iN, iNN; MTokX xC, xN; u32x4 WA[16], WB[16];
    PM_LOADI(iC, m0); PM_LOADI(iN, m0 + NWAVES); PM_LOADI(iNN, m0 + 2 * NWAVES); PM_LOADX(xC, m0); PM_LOADX(xN, m0 + NWAVES); pm_issue(uqs, loff, iC, WA);
    for (int m = m0; m <= mlast; m += 2 * NWAVES) {
        pm_issue(uqs, loff, iN, WB);
        pm_compute(xC, WA, wl, pd + (size_t)m * 128, lane);
        iC = iN; iN = iNN; PM_LOADI(iNN, m + 3 * NWAVES); xC = xN; PM_LOADX(xN, m + 2 * NWAVES);
        pm_issue(uqs, loff, iN, WA);
        pm_compute(xC, WB, wl, pd + (size_t)(m + NWAVES) * 128, lane);
        iC = iN; iN = iNN; PM_LOADI(iNN, m + 4 * NWAVES); xC = xN; PM_LOADX(xN, m + 3 * NWAVES);
    }
#undef PM_LOADI
#undef PM_LOADX
}
__device__ __forceinline__ void phase_peer_act(const Args& a, int tid) {
    const float* pd = (const float*)(a.ws + WS_PD); const unsigned short* eidx = (const unsigned short*)(a.ws + WS_EIDX); const float* eg = (const float*)(a.ws + WS_EG);
    const float* su = (const float*)(a.ws + WS_SU); const float* sv = (const float*)(a.ws + WS_SV); const float* rowss = (const float*)(a.ws + WS_ROWSS); float* act = (float*)(a.ws + WS_ACT);
    for (size_t i4 = (size_t)blockIdx.x * NTHR + tid; i4 < (size_t)T * 32; i4 += (size_t)gridDim.x * NTHR) { const size_t idx = i4 * 4;
        f32x4 d = *(const f32x4*)(pd + idx);
#pragma unroll
        for (int s = 1; s < 8; ++s) d += *(const f32x4*)(pd + (size_t)s * T * 128 + idx);
        const u32x2 ew = *(const u32x2*)(eidx + idx); const f32x4 g = *(const f32x4*)(eg + idx); const float rstd = rsqrtf(rowss[idx >> 7] * (1.f / DM) + EPSF);
        const unsigned e0 = ew.x & 0xffffu, e1 = ew.x >> 16, e2 = ew.y & 0xffffu, e3 = ew.y >> 16;
        f32x4 o; o.x = gelu_tanh(d.x * su[e0] * rstd) * g.x * sv[e0]; o.y = gelu_tanh(d.y * su[e1] * rstd) * g.y * sv[e1];
        o.z = gelu_tanh(d.z * su[e2] * rstd) * g.z * sv[e2]; o.w = gelu_tanh(d.w * su[e3] * rstd) * g.w * sv[e3];
        *(f32x4*)(act + idx) = o;
    }
}
__device__ __forceinline__ void pv_quad(const u32x4& w0, const u32x4& w1, const u32x4& w2, const u32x4& w3, int a4, int (&oi)[16]) {
#define PV_BLK(d, base) do { const unsigned lo01 = __builtin_amdgcn_perm(w1.d, w0.d, 0x05010400u), hi01 = __builtin_amdgcn_perm(w1.d, w0.d, 0x07030602u); \
        const unsigned lo23 = __builtin_amdgcn_perm(w3.d, w2.d, 0x05010400u), hi23 = __builtin_amdgcn_perm(w3.d, w2.d, 0x07030602u); \
        oi[base + 0] = __builtin_amdgcn_sdot4((int)__builtin_amdgcn_perm(lo23, lo01, 0x05040100u), a4, oi[base + 0], false); \
        oi[base + 1] = __builtin_amdgcn_sdot4((int)__builtin_amdgcn_perm(lo23, lo01, 0x07060302u), a4, oi[base + 1], false); \
        oi[base + 2] = __builtin_amdgcn_sdot4((int)__builtin_amdgcn_perm(hi23, hi01, 0x05040100u), a4, oi[base + 2], false); \
        oi[base + 3] = __builtin_amdgcn_sdot4((int)__builtin_amdgcn_perm(hi23, hi01, 0x07060302u), a4, oi[base + 3], false); } while (0)
    PV_BLK(x, 0); PV_BLK(y, 4); PV_BLK(z, 8); PV_BLK(w, 12);
#undef PV_BLK
}
__device__ __forceinline__ float pv_quant_act(const f32x4 (&av)[4], int (&a4)[4]) {
    float mx = 0.f;
#pragma unroll
    for (int q = 0; q < 4; ++q) mx = fmaxf(mx, fmaxf(fmaxf(fabsf(av[q].x), fabsf(av[q].y)), fmaxf(fabsf(av[q].z), fabsf(av[q].w))));
    const float sc = (mx > 0.f) ? 127.0f * __builtin_amdgcn_rcpf(mx) * 0.99999f : 0.f;
#pragma unroll
    for (int q = 0; q < 4; ++q) a4[q] = (int)q8x4(av[q], sc);
    return mx * (1.0f / 127.0f);
}
__device__ __forceinline__ void pv_finish(const int (&oi)[16], float sa, bf16_t* orow  , int lane) {
    float o[16];
#pragma unroll
    for (int c = 0; c < 16; ++c) o[c] = (float)oi[c] * sa;
    const bool b3 = (lane & 8) != 0, b4 = (lane & 16) != 0, b5 = (lane & 32) != 0;
    float k8[8], k4[4], k2[2];
#pragma unroll
    for (int c = 0; c < 8; ++c) { const float snd = b3 ? o[c] : o[8 + c], kp = b3 ? o[8 + c] : o[c]; k8[c] = kp + dpp_xor8(snd); }
#pragma unroll
    for (int c = 0; c < 4; ++c) { const float snd = b4 ? k8[c] : k8[4 + c], kp = b4 ? k8[4 + c] : k8[c]; k4[c] = kp + __shfl_xor(snd, 16); }
#pragma unroll
    for (int c = 0; c < 2; ++c) { const float snd = b5 ? k4[c] : k4[2 + c], kp = b5 ? k4[2 + c] : k4[c]; k2[c] = kp + __shfl_xor(snd, 32); }
    *(unsigned*)(orow + ((lane & 8) ? 8 : 0) + ((lane & 16) ? 4 : 0) + ((lane & 32) ? 2 : 0)) = pk2(k2[0], k2[1]);
}
__device__ __forceinline__ void phase_peer_v(const Args& a, int wave, int lane) {
    const int s = SLICE_OF(blockIdx.x), rk = RANK_OF(blockIdx.x), nrk = gridDim.x >> 3, tper = T / nrk, i = lane & 7, j = lane >> 3;
    const unsigned char* vqs = a.ws + WS_VB + (size_t)s * NEXP * 128; const unsigned loff = 16u * (unsigned)i;
    const unsigned short* eidx = (const unsigned short*)(a.ws + WS_EIDX) + 16 * j; const float* act = (const float*)(a.ws + WS_ACT) + 16 * j;
    bf16_t* obase = (bf16_t*)(a.ws + WS_PO) + 128 * s + 16 * i;
    const int m0 = rk * tper + wave, mlast = (rk + 1) * tper - NWAVES + wave;
#define PV_LOAD(t, mm) do { const int m_ = (mm) < mlast ? (mm) : mlast; const u32x4* ep_ = (const u32x4*)(eidx + (size_t)m_ * 128); const f32x4* ap_ = (const f32x4*)(act + (size_t)m_ * 128); \
        (t).e0 = ep_[0]; (t).e1 = ep_[1]; (t).av[0] = ap_[0]; (t).av[1] = ap_[1]; (t).av[2] = ap_[2]; (t).av[3] = ap_[3]; } while (0)
    VTok tC, tN, tNN; u32x4 wA[8], wB[8];
    PV_LOAD(tC, m0); PV_LOAD(tN, m0 + NWAVES); PV_LOAD(tNN, m0 + 2 * NWAVES); pu_issue(vqs, loff, tC.e0, wA);
    for (int m = m0; m <= mlast; m += NWAVES) {
        pu_issue(vqs, loff, tC.e1, wB);
        int oi_[16];
#pragma unroll
        for (int c = 0; c < 16; ++c) oi_[c] = 0;
        int a4_[4]; const float sa_ = pv_quant_act(tC.av, a4_);
        pv_quad(wA[0], wA[1], wA[2], wA[3], a4_[0], oi_); pv_quad(wA[4], wA[5], wA[6], wA[7], a4_[1], oi_);
        pu_issue(vqs, loff, tN.e0, wA);
        pv_quad(wB[0], wB[1], wB[2], wB[3], a4_[2], oi_); pv_quad(wB[4], wB[5], wB[6], wB[7], a4_[3], oi_);
        pv_finish(oi_, sa_, obase + (size_t)m * DM, lane);
        tC = tN; tN = tNN; PV_LOAD(tNN, m + 3 * NWAVES);
    }
#undef PV_LOAD
}
__device__ __forceinline__ void phase_final(const Args& a, int wave, int lane) {
    const int gw = blockIdx.x * NWAVES + wave, NGW = gridDim.x * NWAVES; const bf16_t* po = (const bf16_t*)(a.ws + WS_PO) + 16 * lane; const bf16_t* h1b = (const bf16_t*)(a.ws + WS_H1B) + 16 * lane;
    f32x4 gf[4];
#pragma unroll
    for (int jj = 0; jj < 4; ++jj) gf[jj] = *(const f32x4*)(a.in[I_GFINAL] + 16 * lane + 4 * jj);
    for (int m0 = gw; m0 < T; m0 += 4 * NGW) {
        u32x4 hq[4][2], pq[4][2];
#pragma unroll
        for (int r = 0; r < 4; ++r) { const int m = (m0 + r * NGW < T) ? m0 + r * NGW : m0;
            hq[r][0] = *(const u32x4*)(h1b + (size_t)m * DM); hq[r][1] = *(const u32x4*)(h1b + (size_t)m * DM + 8); pq[r][0] = *(const u32x4*)(po + (size_t)m * DM); pq[r][1] = *(const u32x4*)(po + (size_t)m * DM + 8); }
#pragma unroll
        for (int r = 0; r < 4; ++r) { const int m = m0 + r * NGW; if (m >= T) break;
            float hb[16], pp[16]; unpack8(hq[r][0], *(float(*)[8])&hb[0]); unpack8(hq[r][1], *(float(*)[8])&hb[8]); unpack8(pq[r][0], *(float(*)[8])&pp[0]); unpack8(pq[r][1], *(float(*)[8])&pp[8]);
            f32x4 h[4]; float ss = 0.f;
#pragma unroll
            for (int jj = 0; jj < 4; ++jj) { h[jj] = (f32x4){hb[4 * jj] + pp[4 * jj], hb[4 * jj + 1] + pp[4 * jj + 1], hb[4 * jj + 2] + pp[4 * jj + 2], hb[4 * jj + 3] + pp[4 * jj + 3]};
                ss += (h[jj].x * h[jj].x + h[jj].y * h[jj].y) + (h[jj].z * h[jj].z + h[jj].w * h[jj].w); }
            const float r2 = rsqrtf(wave_sum_dpp(ss) * (1.f / DM) + EPSF);
            float* orow = a.out + (size_t)m * DM + 16 * lane;
#pragma unroll
            for (int jj = 0; jj < 4; ++jj) NT_ST((f32x4*)(orow + 4 * jj), h[jj] * r2 * gf[jj]); }
    }
}
typedef short bf16x8_t __attribute__((ext_vector_type(8)));
__device__ __forceinline__ bf16x8_t toep_frag(const LAS unsigned* R32, int base) {
    const int e = base >> 1, sh = (base & 1) * 16;
    const unsigned d0 = R32[e], d1 = R32[e + 1], d2 = R32[e + 2], d3 = R32[e + 3], d4 = R32[e + 4];
    u32x4 o; o.x = __builtin_amdgcn_alignbit(d1, d0, sh); o.y = __builtin_amdgcn_alignbit(d2, d1, sh); o.z = __builtin_amdgcn_alignbit(d3, d2, sh); o.w = __builtin_amdgcn_alignbit(d4, d3, sh);
    return __builtin_bit_cast(bf16x8_t, o);
}
__device__ __forceinline__ void hy_conv_channel(const Args& a, LAS unsigned char* lds, int c, int tid, int wave, int lane) {
    constexpr int UROW = SP * 2;
    LAS unsigned char* uus = lds;
    LAS unsigned short* R = (LAS unsigned short*)(lds + 8 * UROW);
    const bf16_t* uut = (const bf16_t*)(a.ws + WS_UUT); const bf16_t* kfb = (const bf16_t*)(a.ws + WS_KFB); bf16_t* cvt = (bf16_t*)(a.ws + WS_CONVT);
    { const u32x4* src = (const u32x4*)(uut + (size_t)c * NB * SP); for (int i = tid; i < 8 * UROW / 16; i += NTHR) ((LAS u32x4*)uus)[i] = src[i]; }
    for (int n = tid; n < KFW + 16; n += NTHR) R[n] = (n < KFW) ? kfb[(size_t)c * KFW + (KFW - 1) - n] : (unsigned short)0;
    __syncthreads();
    const LAS unsigned* R32 = (const LAS unsigned*)R;
    const int i = lane & 15, g = lane >> 4, p = (lane >> 3) & 1, b = lane & 7;
    f32x4 C[16]; bf16x8_t A[16];
    const int abase = LT - 32 * (1 + 16 * wave) - i + 8 * g;
#pragma unroll
    for (int tb = 0; tb < 16; ++tb) { C[tb] = (f32x4){0.f, 0.f, 0.f, 0.f}; A[tb] = toep_frag(R32, abase - 32 * tb); }
    const LAS unsigned char* bptr = uus + b * UROW + (16 * p + 8 * g) * 2;
#define HC_STEP(ph, n) do { A[(16 - (ph)) & 15] = toep_frag(R32, abase + 32 * (n)); const bf16x8_t Bf = *(const LAS bf16x8_t*)(bptr + (n) * 64); \
        _Pragma("unroll") for (int tb = 0; tb < 16; ++tb) C[tb] = __builtin_amdgcn_mfma_f32_16x16x32_bf16(A[(tb - (ph)) & 15], Bf, C[tb], 0, 0, 0); __builtin_amdgcn_sched_barrier(0); } while (0)
    for (int G = 0; G < 8; ++G) { const int n0 = G * 16;
        HC_STEP(0, n0); HC_STEP(1, n0 + 1); HC_STEP(2, n0 + 2); HC_STEP(3, n0 + 3); HC_STEP(4, n0 + 4); HC_STEP(5, n0 + 5); HC_STEP(6, n0 + 6); HC_STEP(7, n0 + 7);
        HC_STEP(8, n0 + 8); HC_STEP(9, n0 + 9); HC_STEP(10, n0 + 10); HC_STEP(11, n0 + 11); HC_STEP(12, n0 + 12); HC_STEP(13, n0 + 13); HC_STEP(14, n0 + 14); HC_STEP(15, n0 + 15); }
    HC_STEP(0, 128);
#undef HC_STEP
#pragma unroll
    for (int tb = 0; tb < 16; ++tb) { const int tq = 512 * wave + 32 * tb + 16 * p + 4 * g;
        u32x2 w; w.x = pk2(C[tb][0], C[tb][1]); w.y = pk2(C[tb][2], C[tb][3]);
        *(u32x2*)(cvt + ((size_t)c * NB + b) * SEQ + tq) = w; }
    __syncthreads();
}
__device__ __forceinline__ void rg_item(const Args& a, LAS unsigned char* lds, int it, int tid, int wave, int lane) {
    constexpr int XROW = 272;
    const int head = it & 7, dir = (it >> 3) & 1, b = it >> 4;
    const bf16_t* xb = (const bf16_t*)(a.ws + WS_RGX) + (size_t)b * LT * DRG + head * 128;
    bf16_t* hout = (bf16_t*)a.out + (size_t)dir * T * DRG + (size_t)b * SEQ * DRG + head * 128 + 16 * wave + (lane & 15);
    const int col = lane & 15, g = lane >> 4, ch = head * 128 + 16 * wave + col;
    LAS unsigned char* wl = lds + 2 * 64 * XROW + wave * 1024 + lane * 16;
#pragma unroll
    for (int gt = 0; gt < 2; ++gt)
#pragma unroll
        for (int ks = 0; ks < 4; ++ks) { const float* wp = a.in[I_RGGW] + ((size_t)((dir * 2 + gt) * 8 + head) * 128 + 32 * ks + 8 * g) * 128 + 16 * wave + col;
            u32x4 o; o.x = pk2(wp[0], wp[128]); o.y = pk2(wp[256], wp[384]); o.z = pk2(wp[512], wp[640]); o.w = pk2(wp[768], wp[896]); *(LAS u32x4*)(wl + (gt * 4 + ks) * 8192) = o; }
    const float br = a.in[I_RGGB][(size_t)(dir * 2 + 0) * DRG + ch], bi = a.in[I_RGGB][(size_t)(dir * 2 + 1) * DRG + ch];
    const float sp8 = -8.0f * log1pf(__expf(-a.in[I_RGLAM][dir * DRG + ch]));
    const int ctr = tid >> 4, ccg = tid & 15;
    float cwv[4][8], cbv[8];
#pragma unroll
    for (int i = 0; i < 8; ++i) { cbv[i] = a.in[I_RGCB][(size_t)dir * DRG + head * 128 + 8 * ccg + i];
#pragma unroll
        for (int j = 0; j < 4; ++j) cwv[j][i] = a.in[I_RGCW][((size_t)dir * 4 + j) * DRG + head * 128 + 8 * ccg + i]; }
    u32x4 xr[2][4];
#define RG_LOAD(k) do { _Pragma("unroll") for (int h_ = 0; h_ < 2; ++h_) { const int u_ = 64 * (k) + ctr + 32 * h_; _Pragma("unroll") for (int j = 0; j < 4; ++j) { const int uu_ = u_ - j; \
        if (uu_ >= 0 && uu_ < LT) { const int t_ = dir ? (LT - 1 - uu_) : uu_; xr[h_][j] = *(const u32x4*)(xb + (size_t)t_ * DRG + 8 * ccg); } \
        else xr[h_][j] = (u32x4){0u, 0u, 0u, 0u}; } } } while (0)
#define RG_CONV(k) do { _Pragma("unroll") for (int h_ = 0; h_ < 2; ++h_) { const int u_ = 64 * (k) + ctr + 32 * h_; float o_[8]; _Pragma("unroll") for (int i = 0; i < 8; ++i) o_[i] = (u_ < LT) ? cbv[i] : 0.f; \
        _Pragma("unroll") for (int j = 0; j < 4; ++j) { float f_[8]; unpack8(xr[h_][j], f_); _Pragma("unroll") for (int i = 0; i < 8; ++i) o_[i] += f_[i] * cwv[j][i]; } \
        u32x4 w0_; w0_.x = pk2(o_[0], o_[1]); w0_.y = pk2(o_[2], o_[3]); w0_.z = pk2(o_[4], o_[5]); w0_.w = pk2(o_[6], o_[7]); \
        *(LAS u32x4*)(lds + ((k) & 1) * (64 * XROW) + (ctr + 32 * h_) * XROW + ccg * 16) = w0_; } } while (0)
    RG_LOAD(0); RG_CONV(0); RG_LOAD(1);
    __syncthreads();
    float carry = 0.f;
    const int arow = 16 * (col >> 2) + (col & 3);
    for (int k = 0; k < 65; ++k) {
        if (k + 1 < 65) RG_CONV(k + 1);
        if (k + 2 < 65) RG_LOAD(k + 2);
        const LAS unsigned char* xa = lds + (k & 1) * (64 * XROW);
        unsigned hp[16]; float hh = 0.f, PP = 1.f;
#pragma unroll
        for (int mp = 0; mp < 2; ++mp) {
            f32x4 acc[2][2];
#pragma unroll
            for (int m2 = 0; m2 < 2; ++m2) { const int mb = 2 * mp + m2; acc[0][m2] = (f32x4){0.f, 0.f, 0.f, 0.f}; acc[1][m2] = (f32x4){0.f, 0.f, 0.f, 0.f};
#pragma unroll
                for (int ks = 0; ks < 4; ++ks) { const bf16x8_t Af = *(const LAS bf16x8_t*)(xa + (arow + 4 * mb) * XROW + (32 * ks + 8 * g) * 2);
                    acc[0][m2] = __builtin_amdgcn_mfma_f32_16x16x32_bf16(Af, *(const LAS bf16x8_t*)(wl + ks * 8192), acc[0][m2], 0, 0, 0);
                    acc[1][m2] = __builtin_amdgcn_mfma_f32_16x16x32_bf16(Af, *(const LAS bf16x8_t*)(wl + (4 + ks) * 8192), acc[1][m2], 0, 0, 0); } }
#pragma unroll
            for (int m2 = 0; m2 < 2; ++m2)
#pragma unroll
                for (int r = 0; r < 4; ++r) { const int e = 8 * mp + 4 * m2 + r, tau = 16 * g + e, u = 64 * k + tau;
                    const float rr = sigmoidf_(acc[0][m2][r] + br), ii = sigmoidf_(acc[1][m2][r] + bi);
                    float av = fexp(sp8 * rr); float mult = __builtin_amdgcn_sqrtf(fmaxf(1.0f - av * av, 0.f)); mult = (u == 0) ? 1.0f : mult;
                    const float xcv = bf2f(*(const LAS unsigned short*)(xa + tau * XROW + (16 * wave + col) * 2));
                    float bq = mult * ii * xcv; if (u >= LT) { av = 1.f; bq = 0.f; }
                    hh = av * hh + bq; PP *= av; hp[e] = pk2(hh, PP); }
        }
        float Pg[4], hg[4];
#pragma unroll
        for (int q = 0; q < 4; ++q) { Pg[q] = __shfl(PP, col + 16 * q); hg[q] = __shfl(hh, col + 16 * q); }
        const float H0 = carry, H1 = Pg[0] * H0 + hg[0], H2 = Pg[1] * H1 + hg[1], H3 = Pg[2] * H2 + hg[2], H4 = Pg[3] * H3 + hg[3];
        const float Hin = (g == 0) ? H0 : (g == 1) ? H1 : (g == 2) ? H2 : H3;
        carry = H4;
#pragma unroll
        for (int e = 0; e < 16; ++e) { const int u = 64 * k + 16 * g + e; const int t = dir ? (LT - 1 - u) : u;
            if (u < LT && t >= NMETA) hout[(size_t)(t - NMETA) * DRG] = (bf16_t)f2bf(bflo(hp[e]) + bfhi(hp[e]) * Hin); }
        __syncthreads();
    }
#undef RG_LOAD
#undef RG_CONV
}
__device__ __forceinline__ void rg_item2(const Args& a, LAS unsigned char* lds, int it, int tid, int wave, int lane) {
    constexpr int XROW = 272;
    const int hh = it & 1, head = (it >> 1) & 7, dir = (it >> 4) & 1, b = it >> 5;
    const bf16_t* xb = (const bf16_t*)(a.ws + WS_RGX) + (size_t)b * LT * DRG + head * 128;
    const int col = lane & 15, g = lane >> 4, gate = col >> 3, cj = col & 7, chl = 64 * hh + 8 * wave + cj, ch = head * 128 + chl, qg = 2 * g + gate;
    bf16_t* hout = (bf16_t*)a.out + (size_t)dir * T * DRG + (size_t)b * SEQ * DRG + ch;
    bf16x8_t Wf[4];
#pragma unroll
    for (int ks = 0; ks < 4; ++ks) { const float* wp = a.in[I_RGGW] + ((size_t)((dir * 2 + gate) * 8 + head) * 128 + 32 * ks + 8 * g) * 128 + chl;
        u32x4 o; o.x = pk2(wp[0], wp[128]); o.y = pk2(wp[256], wp[384]); o.z = pk2(wp[512], wp[640]); o.w = pk2(wp[768], wp[896]); Wf[ks] = __builtin_bit_cast(bf16x8_t, o); }
    const float LOG2E = 1.4426950408889634f;
    const float bgl = a.in[I_RGGB][(size_t)(dir * 2 + gate) * DRG + ch] * LOG2E;
    const float sp8l = -8.0f * log1pf(__expf(-a.in[I_RGLAM][dir * DRG + ch])) * LOG2E;
    const int ctr = tid >> 4, ccg = tid & 15;
    float cwv[4][8], cbv[8];
#pragma unroll
    for (int i = 0; i < 8; ++i) { cbv[i] = a.in[I_RGCB][(size_t)dir * DRG + head * 128 + 8 * ccg + i];
#pragma unroll
        for (int j = 0; j < 4; ++j) cwv[j][i] = a.in[I_RGCW][((size_t)dir * 4 + j) * DRG + head * 128 + 8 * ccg + i]; }
    u32x4 xr[2][4];
#define RG_LOAD(k) do { _Pragma("unroll") for (int h_ = 0; h_ < 2; ++h_) { const int u_ = 64 * (k) + ctr + 32 * h_; _Pragma("unroll") for (int j = 0; j < 4; ++j) { const int uu_ = u_ - j; \
        if (uu_ >= 0 && uu_ < LT) { const int t_ = dir ? (LT - 1 - uu_) : uu_; xr[h_][j] = *(const u32x4*)(xb + (size_t)t_ * DRG + 8 * ccg); } \
        else xr[h_][j] = (u32x4){0u, 0u, 0u, 0u}; } } } while (0)
#define RG_CONV(k) do { _Pragma("unroll") for (int h_ = 0; h_ < 2; ++h_) { const int u_ = 64 * (k) + ctr + 32 * h_; float o_[8]; _Pragma("unroll") for (int i = 0; i < 8; ++i) o_[i] = (u_ < LT) ? cbv[i] : 0.f; \
        _Pragma("unroll") for (int j = 0; j < 4; ++j) { float f_[8]; unpack8(xr[h_][j], f_); _Pragma("unroll") for (int i = 0; i < 8; ++i) o_[i] += f_[i] * cwv[j][i]; } \
        u32x4 w0_; w0_.x = pk2(o_[0], o_[1]); w0_.y = pk2(o_[2], o_[3]); w0_.z = pk2(o_[4], o_[5]); w0_.w = pk2(o_[6], o_[7]); \
        *(LAS u32x4*)(lds + ((k) & 1) * (64 * XROW) + (ctr + 32 * h_) * XROW + ccg * 16) = w0_; } } while (0)
    RG_LOAD(0); RG_CONV(0); RG_LOAD(1);
    __syncthreads();
    float carry = 0.f;
    const int arow = 16 * (col >> 2) + (col & 3);
    for (int k = 0; k < 65; ++k) {
        if (k + 1 < 65) RG_CONV(k + 1);
        if (k + 2 < 65) RG_LOAD(k + 2);
        const LAS unsigned char* xa = lds + (k & 1) * (64 * XROW);
        f32x4 acc[4];
#pragma unroll
        for (int mb = 0; mb < 4; ++mb) { acc[mb] = (f32x4){0.f, 0.f, 0.f, 0.f};
#pragma unroll
            for (int ks = 0; ks < 4; ++ks) acc[mb] = __builtin_amdgcn_mfma_f32_16x16x32_bf16(*(const LAS bf16x8_t*)(xa + (arow + 4 * mb) * XROW + (32 * ks + 8 * g) * 2), Wf[ks], acc[mb], 0, 0, 0); }
        float sg[16], ot[16];
#pragma unroll
        for (int e = 0; e < 16; ++e) { sg[e] = __builtin_amdgcn_rcpf(1.0f + __builtin_amdgcn_exp2f(-(acc[e >> 2][e & 3] * LOG2E + bgl))); ot[e] = dpp_xor8(sg[e]); }
        unsigned hp[8]; float hs = 0.f, PP = 1.f;
#pragma unroll
        for (int t = 0; t < 8; ++t) { const float rr = gate ? ot[8 + t] : sg[t], ii = gate ? sg[8 + t] : ot[t]; const int tau = 8 * qg + t, u = 64 * k + tau;
            float av = __builtin_amdgcn_exp2f(sp8l * rr); float mult = __builtin_amdgcn_sqrtf(fmaxf(1.0f - av * av, 0.f)); mult = (u == 0) ? 1.0f : mult;
            const float xcv = bf2f(*(const LAS unsigned short*)(xa + tau * XROW + chl * 2));
            float bq = mult * ii * xcv; if (u >= LT) { av = 1.f; bq = 0.f; }
            hs = av * hs + bq; PP *= av; hp[t] = pk2(hs, PP); }
        float H = carry, Hin = carry;
#pragma unroll
        for (int q = 0; q < 8; ++q) { const int src = cj + 8 * (q & 1) + 16 * (q >> 1); const float Pq = __shfl(PP, src), hq = __shfl(hs, src);
            Hin = (qg == q) ? H : Hin; H = Pq * H + hq; }
        carry = H;
#pragma unroll
        for (int t = 0; t < 8; ++t) { const int u = 64 * k + 8 * qg + t; const int tt = dir ? (LT - 1 - u) : u;
            if (u < LT && tt >= NMETA) hout[(size_t)(tt - NMETA) * DRG] = (bf16_t)f2bf(bflo(hp[t]) + bfhi(hp[t]) * Hin); }
        __syncthreads();
    }
#undef RG_LOAD
#undef RG_CONV
}

__device__ __forceinline__ int rg_lds_off(int row, int chunk) { return row * 320 + (((chunk + 2 * (row >> 4)) & 15) << 4); }
__device__ __forceinline__ void rg_item3(const Args& a, LAS unsigned char* lds, int it, int tid, int wave, int lane) {
    constexpr int XT = 64 * 320;
    const int th = it & 1, head = (it >> 1) & 7, dir = (it >> 4) & 1, b = it >> 5;
    const int k0 = th ? RG_SPLIT : 0, k1 = th ? 65 : RG_SPLIT;
    const bf16_t* xb = (const bf16_t*)(a.ws + WS_RGX) + (size_t)b * LT * DRG + head * 128;
    const int col = lane & 15, g = lane >> 4, chl = 16 * wave + col, ch = head * 128 + chl;
    bf16_t* hout = (bf16_t*)a.out + (size_t)dir * T * DRG + (size_t)b * SEQ * DRG + ch;
    bf16_t* pout = (bf16_t*)(a.ws + WS_RGP) + ((size_t)dir * NB + b) * RG_NF * DRG + ch;
    LAS unsigned char* wl = lds + 2 * XT + wave * 1024 + lane * 16;
#pragma unroll
    for (int gt = 0; gt < 2; ++gt)
#pragma unroll
        for (int ks = 0; ks < 4; ++ks) { const float* wp = a.in[I_RGGW] + ((size_t)((dir * 2 + gt) * 8 + head) * 128 + 32 * ks + 8 * g) * 128 + chl;
            u32x4 o; o.x = pk2(wp[0], wp[128]); o.y = pk2(wp[256], wp[384]); o.z = pk2(wp[512], wp[640]); o.w = pk2(wp[768], wp[896]); *(LAS u32x4*)(wl + (gt * 4 + ks) * 8192) = o; }
    const float LOG2E = 1.4426950408889634f;
    const float brl = a.in[I_RGGB][(size_t)(dir * 2 + 0) * DRG + ch] * LOG2E, bil = a.in[I_RGGB][(size_t)(dir * 2 + 1) * DRG + ch] * LOG2E;
    const float sp8l = -8.0f * log1pf(__expf(-a.in[I_RGLAM][dir * DRG + ch])) * LOG2E;
    const int ctr = tid >> 4, ccg = tid & 15;
    LAS float* cwl = (LAS float*)(lds + 2 * XT + 8 * 8192);
    for (int i = tid; i < 5 * 128; i += NTHR) { const int j = i >> 7, c = i & 127; cwl[i] = (j < 4) ? a.in[I_RGCW][((size_t)dir * 4 + j) * DRG + head * 128 + c] : a.in[I_RGCB][(size_t)dir * DRG + head * 128 + c]; }
    __syncthreads();
    u32x4 xr[2][4];
#define RG_LOAD(k) do { _Pragma("unroll") for (int h_ = 0; h_ < 2; ++h_) { const int u_ = 64 * (k) + ctr + 32 * h_; _Pragma("unroll") for (int j = 0; j < 4; ++j) { int uu_ = u_ - j; \
        const bool ok_ = (uu_ >= 0 && uu_ < LT); uu_ = ok_ ? uu_ : 0; const int t_ = dir ? (LT - 1 - uu_) : uu_; const u32x4 v_ = *(const u32x4*)(xb + (size_t)t_ * DRG + 8 * ccg); \
        xr[h_][j] = ok_ ? v_ : (u32x4){0u, 0u, 0u, 0u}; } } } while (0)
#define RG_CONV(k) do { _Pragma("unroll") for (int h_ = 0; h_ < 2; ++h_) { const int u_ = 64 * (k) + ctr + 32 * h_; float o_[8]; \
        { const f32x4 b0_ = *(const LAS f32x4*)(cwl + 4 * 128 + 8 * ccg), b1_ = *(const LAS f32x4*)(cwl + 4 * 128 + 8 * ccg + 4); const bool in_ = (u_ < LT); \
          o_[0] = in_ ? b0_.x : 0.f; o_[1] = in_ ? b0_.y : 0.f; o_[2] = in_ ? b0_.z : 0.f; o_[3] = in_ ? b0_.w : 0.f; o_[4] = in_ ? b1_.x : 0.f; o_[5] = in_ ? b1_.y : 0.f; o_[6] = in_ ? b1_.z : 0.f; o_[7] = in_ ? b1_.w : 0.f; } \
        _Pragma("unroll") for (int j = 0; j < 4; ++j) { float f_[8]; unpack8(xr[h_][j], f_); const f32x4 w0_ = *(const LAS f32x4*)(cwl + j * 128 + 8 * ccg), w1_ = *(const LAS f32x4*)(cwl + j * 128 + 8 * ccg + 4); \
            o_[0] += f_[0] * w0_.x; o_[1] += f_[1] * w0_.y; o_[2] += f_[2] * w0_.z; o_[3] += f_[3] * w0_.w; o_[4] += f_[4] * w1_.x; o_[5] += f_[5] * w1_.y; o_[6] += f_[6] * w1_.z; o_[7] += f_[7] * w1_.w; } \
        u32x4 w0_; w0_.x = pk2(o_[0], o_[1]); w0_.y = pk2(o_[2], o_[3]); w0_.z = pk2(o_[4], o_[5]); w0_.w = pk2(o_[6], o_[7]); \
        *(LAS u32x4*)(lds + ((k) & 1) * XT + rg_lds_off(ctr + 32 * h_, ccg)) = w0_; } } while (0)
    RG_LOAD(k0); RG_CONV(k0); RG_LOAD(k0 + 1);
    __syncthreads();
    float carry = 0.f, pcar = 1.f;
    const int arow = 16 * (col >> 2) + (col & 3);
    const int xoff = (chl & 7) * 2, xch = chl >> 3;
    unsigned char* hbase = (unsigned char*)((bf16_t*)a.out + (size_t)dir * T * DRG + (size_t)b * SEQ * DRG);
    unsigned char* pbase = (unsigned char*)((bf16_t*)(a.ws + WS_RGP) + ((size_t)dir * NB + b) * RG_NF * DRG);
    const int tsgn = dir ? -1 : 1, t0 = dir ? (LT - 1 - NMETA) : -NMETA;
#define RG_TILE(EDGE) do { \
        unsigned hp[16]; float hh = 0.f, PP = 1.f; \
        _Pragma("unroll") for (int mp = 0; mp < 2; ++mp) { f32x4 acc[2][2]; \
            _Pragma("unroll") for (int m2 = 0; m2 < 2; ++m2) { const int mb = 2 * mp + m2; acc[0][m2] = (f32x4){0.f, 0.f, 0.f, 0.f}; acc[1][m2] = (f32x4){0.f, 0.f, 0.f, 0.f}; \
                _Pragma("unroll") for (int ks = 0; ks < 4; ++ks) { const bf16x8_t Af = *(const LAS bf16x8_t*)(xa + rg_lds_off(arow + 4 * mb, 4 * ks + g)); \
                    acc[0][m2] = __builtin_amdgcn_mfma_f32_16x16x32_bf16(Af, *(const LAS bf16x8_t*)(wl + ks * 8192), acc[0][m2], 0, 0, 0); \
                    acc[1][m2] = __builtin_amdgcn_mfma_f32_16x16x32_bf16(Af, *(const LAS bf16x8_t*)(wl + (4 + ks) * 8192), acc[1][m2], 0, 0, 0); } } \
            _Pragma("unroll") for (int m2 = 0; m2 < 2; ++m2) _Pragma("unroll") for (int r = 0; r < 4; ++r) { const int e = 8 * mp + 4 * m2 + r, tau = 16 * g + e, u = 64 * k + tau; \
                    const float rr = __builtin_amdgcn_rcpf(1.0f + __builtin_amdgcn_exp2f(-(acc[0][m2][r] * LOG2E + brl))), ii = __builtin_amdgcn_rcpf(1.0f + __builtin_amdgcn_exp2f(-(acc[1][m2][r] * LOG2E + bil))); \
                    float av = __builtin_amdgcn_exp2f(sp8l * rr); float mult = __builtin_amdgcn_sqrtf(fmaxf(1.0f - av * av, 0.f)); if (EDGE) mult = (u == 0) ? 1.0f : mult; \
                    const float xcv = bf2f(*(const LAS unsigned short*)(xa + rg_lds_off(tau, xch) + xoff)); \
                    float bq = mult * ii * xcv; if (EDGE) { if (u >= LT) { av = 1.f; bq = 0.f; } } \
                    hh = av * hh + bq; PP *= av; hp[e] = pk2(hh, PP); } } \
        float Pg[4], hg[4]; \
        _Pragma("unroll") for (int q = 0; q < 4; ++q) { Pg[q] = __shfl(PP, col + 16 * q); hg[q] = __shfl(hh, col + 16 * q); } \
        const float H0 = carry, H1 = Pg[0] * H0 + hg[0], H2 = Pg[1] * H1 + hg[1], H3 = Pg[2] * H2 + hg[2], H4 = Pg[3] * H3 + hg[3]; \
        const float Q0 = pcar, Q1 = Pg[0] * Q0, Q2 = Pg[1] * Q1, Q3 = Pg[2] * Q2, Q4 = Pg[3] * Q3; \
        const float Hin = (g == 0) ? H0 : (g == 1) ? H1 : (g == 2) ? H2 : H3, Qin = (g == 0) ? Q0 : (g == 1) ? Q1 : (g == 2) ? Q2 : Q3; \
        carry = H4; pcar = Q4; \
        const int ub = 64 * k + 16 * g; \
        unsigned ho = (unsigned)((t0 + tsgn * ub) * (DRG * 2) + ch * 2), po = (unsigned)((ub - RG_U1) * (DRG * 2) + ch * 2); const unsigned hstep = (unsigned)(tsgn * DRG * 2); \
        _Pragma("unroll") for (int e = 0; e < 16; ++e) { const int u = ub + e; const int t = dir ? (LT - 1 - u) : u; \
            if (!EDGE || (u < LT && t >= NMETA)) { *(bf16_t*)(hbase + ho) = (bf16_t)f2bf(bflo(hp[e]) + bfhi(hp[e]) * Hin); \
                if (th) *(bf16_t*)(pbase + po) = (bf16_t)f2bf(bfhi(hp[e]) * Qin); } \
            ho += hstep; po += (unsigned)(DRG * 2); } \
    } while (0)
    for (int k = k0; k < k1; ++k) {
        if (k + 1 < k1) RG_CONV(k + 1);
        if (k + 2 < k1) RG_LOAD(k + 2);
        const LAS unsigned char* xa = lds + (k & 1) * XT;
        if (k == 0 || k >= 63) RG_TILE(true); else RG_TILE(false);
        __syncthreads();
    }
#undef RG_TILE
    if (th == 0 && g == 0) ((float*)(a.ws + WS_RGC))[((size_t)dir * NB + b) * DRG + ch] = carry;
#undef RG_LOAD
#undef RG_CONV
}

#ifndef RG_NAIVE
#define RG_NAIVE 0
#endif
#ifndef CONV_NAIVE
#define CONV_NAIVE 0
#endif
#ifndef ONE_LAUNCH
#define ONE_LAUNCH 0
#endif
constexpr int NPHASE = 13;
#ifndef NVGPR
#define NVGPR 248
#endif
__global__ void __launch_bounds__(NTHR, 2) __attribute__((amdgpu_num_vgpr(NVGPR))) mega(Args a) {
    extern __shared__ __attribute__((aligned(16))) unsigned char lds_raw[];
    LAS unsigned char* lds = (LAS unsigned char*)lds_raw;
    const int tid = threadIdx.x, lane = tid & 63, wave = __builtin_amdgcn_readfirstlane(tid >> 6);
    cg::grid_group grid = cg::this_grid();
    volatile LAS unsigned* bst = (volatile LAS unsigned*)(lds + LDS_BYTES - 64);
    if (tid == 0) { bst[0] = 0u; bst[1] = 0u; }
    __syncthreads();
    XcdBarrier xbar; xbar.bar = (unsigned*)(a.ws + WS_BAR); xbar.x = 0; xbar.st = bst;
    if (a.ph_hi - a.ph_lo > 1) xbar = xcd_barrier_post((unsigned*)(a.ws + WS_BAR), bst);
    const int lo = a.ph_lo, hi = a.ph_hi, G = gridDim.x, bx = blockIdx.x;
#ifndef PHMASK
#define PHMASK 0x1fff
#endif
#ifndef REPMASK
#define REPMASK 0
#endif
#define IN(k) (((PHMASK >> (k)) & 1) && lo <= (k) && (k) < hi)
#define REP(k)
#define SEAM(k) do { if (IN(k) && ((k) + 1) < hi) xcd_barrier(xbar); } while (0)
    if (a.ph_lo < 0) grid.sync();
    unsigned char* ws = a.ws;
    REP(0) if (IN(0)) phase_p0(a, lds, tid, wave, lane);
    SEAM(0);
    REP(1) if (IN(1)) {
        p1_meta(a, lds, tid, wave, lane);
#ifdef STAGGER_P1
        for (int q = 0; q < ((bx >> 3) & 7) * STAGGER_P1; ++q) __builtin_amdgcn_s_sleep(64);
#endif
        pg8::Gemm g{(const bf16_t*)(ws + WS_XN1), (const bf16_t*)(ws + WS_WINT), T, DIN, 1024};
        EpiProj E{(bf16_t*)(ws + WS_HYIN), (bf16_t*)(ws + WS_RGX), (bf16_t*)(ws + WS_GG), (bf16_t*)(ws + WS_GA), (bf16_t*)(ws + WS_GB), a.in[I_BGATE]};
#ifdef PROBE_P1_EXTRA
        struct OrderX : pg8::StaticOrder { __device__ bool next(int i, pg8::Unit& u) const { const bool ok = pg8::StaticOrder::next(i < 11 ? i : i - 11, u) && i < 11 + PROBE_P1_EXTRA; u.skip = (i >= 11); return ok; } } S; S.init(T, DIN, G, bx);
        pg8::gemm_phase<EpiProj, OrderX>(lds, g, S, E, nullptr);
#else
        pg8::StaticOrder S; S.init(T, DIN, G, bx);
        pg8::gemm_phase<EpiProj, pg8::StaticOrder>(lds, g, S, E, nullptr);
#endif
    }
    SEAM(1);
    REP(2) if (IN(2)) phase_hy_pre(a, lds, tid);
    SEAM(2);
    REP(3) if (IN(3)) {
#if CONV_NAIVE
        phase_hy_conv_naive(a, lds, tid);
#else
        for (int c = bx; c < DHY; c += G) hy_conv_channel(a, lds, c, tid, wave, lane);
#endif
#if RG_NAIVE
        phase_rg_naive(a, lds, tid);
#else
        for (int it = bx; it < NB * 2 * 8 * 2; it += G) rg_item3(a, lds, it, tid, wave, lane);
#endif
    }
    SEAM(3);
    REP(4) if (IN(4)) phase_post(a, lds, tid);
    SEAM(4);
    REP(5) if (IN(5)) {
        { pg8::Gemm g{(const bf16_t*)(ws + WS_YH), (const bf16_t*)(ws + WS_WHT), T, 1024, 512}; pg8::StaticOrder S; S.init(T, 1024, G, bx);
          EpiGate<0> E{(const bf16_t*)(ws + WS_GA), nullptr, (bf16_t*)(ws + WS_TMP)};
          pg8::gemm_phase<EpiGate<0>, pg8::StaticOrder>(lds, g, S, E, nullptr); }
        { pg8::Gemm g{(const bf16_t*)(ws + WS_YR), (const bf16_t*)(ws + WS_WRT), T, 1024, 1024};
          EpiGate<1> E{(const bf16_t*)(ws + WS_GB), (const bf16_t*)(ws + WS_TMP), (bf16_t*)(ws + WS_MERGED)};
#ifdef PROBE_UNITS2X
          struct Order2x : pg8::StaticOrder { __device__ bool next(int i, pg8::Unit& u) const { return pg8::StaticOrder::next(i >> 1, u); } } S; S.init(T, 1024, G, bx);
          pg8::gemm_phase<EpiGate<1>, Order2x>(lds, g, S, E, nullptr);
#else
          pg8::StaticOrder S; S.init(T, 1024, G, bx);
          pg8::gemm_phase<EpiGate<1>, pg8::StaticOrder>(lds, g, S, E, nullptr);
#endif
        }
    }
    SEAM(5);
    REP(6) if (IN(6)) {
        pg8::Gemm g{(const bf16_t*)(ws + WS_MERGED), (const bf16_t*)(ws + WS_WOT), T, 1024, 1024}; pg8::StaticOrder S; S.init(T, 1024, G, bx);
        EpiResid E{a.in[I_X], (bf16_t*)(ws + WS_H1B), (float*)(ws + WS_ROWSS)};
        pg8::gemm_phase<EpiResid, pg8::StaticOrder>(lds, g, S, E, nullptr);
    }
    SEAM(6);
    REP(7) if (IN(7)) {
        phase_tables(a, wave, lane);
        pg8::Gemm g{(const bf16_t*)(ws + WS_H1B), (const bf16_t*)(ws + WS_WST), T, 2048, 1024}; pg8::StaticOrder S; S.init(T, 2048, G, bx);
        EpiScores E{(const float*)(ws + WS_ROWSS), (_Float16*)(ws + WS_SCORES)};
        pg8::gemm_phase<EpiScores, pg8::StaticOrder>(lds, g, S, E, nullptr);
        __syncthreads();
        phase_topk(a, lds, S, wave, lane);
    }
    SEAM(8);
#ifndef U_VALU
#define U_VALU 1
#endif
    REP(9) if (IN(9)) { if (U_VALU) phase_peer_u(a, wave, lane); else phase_peer_u_mfma(a, lds, wave, lane); }
    SEAM(9);
    if (IN(10)) phase_peer_act(a, tid);
    SEAM(10);
    if (IN(11)) phase_peer_v(a, wave, lane);
    SEAM(11);
    if (IN(12)) phase_final(a, wave, lane);
#undef IN
#undef SEAM
}

extern "C" void kernel_launch(void* const* d_in, const int* in_sizes, int n_in, void* d_out, int out_size, void* d_ws, size_t ws_size, hipStream_t stream) {
    static int grid = 0;
    if (grid == 0) {
        if (n_in != N_IN || out_size != T * DM || ws_size < WS_END) { fprintf(stderr, "kernel_launch: unexpected shapes (n_in %d out %d ws %zu)\n", n_in, out_size, ws_size); grid = -1; return; }
        if (hipFuncSetAttribute((const void*)mega, hipFuncAttributeMaxDynamicSharedMemorySize, LDS_BYTES) != hipSuccess) { fprintf(stderr, "kernel_launch: hipFuncSetAttribute failed\n"); grid = -1; return; }
        int dev = 0, cus = 0, per_cu = 0;
        hipGetDevice(&dev); hipDeviceGetAttribute(&cus, hipDeviceAttributeMultiprocessorCount, dev);
        hipOccupancyMaxActiveBlocksPerMultiprocessor(&per_cu, (const void*)mega, NTHR, LDS_BYTES);
        if (per_cu < 1) { fprintf(stderr, "kernel_launch: occupancy query says %d blocks per CU\n", per_cu); per_cu = 1; }
        (void)hipGetLastError();
        grid = cus;
    }
    if (grid < 0) return;
    Args a{};
    for (int i = 0; i < N_IN; ++i) a.in[i] = (const float*)d_in[i];
    a.out = (float*)d_out; a.ws = (unsigned char*)d_ws;
#if ONE_LAUNCH
    if (hipMemsetAsync((char*)d_ws + WS_BAR, 0, XCD_BAR_WORDS * 4, stream) != hipSuccess) { fprintf(stderr, "kernel_launch: memset of the barrier words failed\n"); return; }
    a.ph_lo = 0; a.ph_hi = NPHASE;
    void* args[] = {&a};
    hipError_t e = hipLaunchCooperativeKernel((const void*)mega, dim3(grid), dim3(NTHR), args, LDS_BYTES, stream);
    if (e != hipSuccess) fprintf(stderr, "cooperative launch failed: %s (grid %d)\n", hipGetErrorString(e), grid);
#else
    for (int ph = 0; ph < NPHASE; ++ph) for (int rep = 0; rep < 1 + ((REPMASK >> ph) & 1); ++rep) { a.ph_lo = ph; a.ph_hi = ph + 1;
        if (ph == 6 && rep == 1) (void)hipMemsetAsync((char*)d_ws + WS_ROWSS, 0, T * 4, stream);
        hipLaunchKernelGGL(mega, dim3(grid), dim3(NTHR), LDS_BYTES, stream, a);
        hipError_t e = hipPeekAtLastError(); if (e != hipSuccess) { fprintf(stderr, "launch %d failed: %s\n", ph, hipGetErrorString(e)); break; } }
#endif
}
```

```cpp
#define ONE_LAUNCH 1
#define NT_STORES 1
#define NT_STORES2 1
#include <hip/hip_runtime.h>
#include <hip/hip_cooperative_groups.h>
#include <cstdio>
#include <cstdint>
#include <cmath>
namespace cg = cooperative_groups;
namespace pg8 {
#define PG8_LAS __attribute__((address_space(3)))
typedef unsigned short bf16_t;
typedef short bf16x8 __attribute__((ext_vector_type(8)));
typedef float f32x4 __attribute__((ext_vector_type(4)));
typedef unsigned u32x4 __attribute__((ext_vector_type(4)));
constexpr int BM = 256, BK = 64, HALF = 128, HTB = HALF * BK * 2  , STAGE_BYTES = 8 * HTB, NXCD = 8, WGM = 8;

__host__ __device__ __forceinline__ int lds_byte(int r, int c) { const int st = (r >> 4) * 2 + (c >> 5), rr = r & 15, cc = c & 31, ob = rr * 64 + cc * 2; return st * 1024 + (ob ^ (((ob >> 9) & 1) << 5)); }
__host__ __device__ __forceinline__ void stage_rc(int b, int& R, int& C) { const int st = b / 1024, sb = b % 1024, swz = sb ^ (((sb >> 9) & 1) << 5); R = (st >> 1) * 16 + swz / 64; C = (st & 1) * 32 + (swz % 64) / 2; }
__host__ __device__ __forceinline__ int perm32(int rho) { const int n = rho >> 4, i = rho & 15; return 8 * (i >> 2) + 4 * n + (i & 3); }

struct Unit { int pm, pn; int skip = 0; };
struct Gemm { const bf16_t* A; const bf16_t* Bt; int M, N, K; };

struct StaticOrder {
    int nM, nN, nwg, G, c;
    __host__ __device__ void init(int M, int N, int G_, int c_) { nM = M / BM; nN = N / BM; nwg = nM * nN; G = G_; c = c_; }
    __host__ __device__ bool next(int i, Unit& u) const {
        const long L = (long)i * G + c; if (L >= nwg) return false;
        int wgid = (int)L; { const int q = nwg / NXCD, r = nwg % NXCD, xcd = wgid % NXCD, off = wgid / NXCD; wgid = (xcd < r ? xcd * (q + 1) : r * (q + 1) + (xcd - r) * q) + off; }
        const int nig = WGM * nN, gid = wgid / nig, fm = gid * WGM, gsz = (nM - fm) < WGM ? (nM - fm) : WGM;
        u.pm = fm + ((wgid % nig) % gsz); u.pn = (wgid % nig) / gsz; return true;
    }
    __device__ __forceinline__ void a_ready(const Unit&) const {}
    __device__ __forceinline__ void done(const Unit&) const {}
};
__device__ __forceinline__ unsigned cvt_pk_bf16(float lo, float hi) { unsigned r; asm volatile("v_cvt_pk_bf16_f32 %0, %1, %2" : "=v"(r) : "v"(lo), "v"(hi)); return r; }
typedef float f32x2 __attribute__((ext_vector_type(2)));
__device__ __forceinline__ f32x2 gelu_pk(f32x2 v) {
    const f32x2 av = __builtin_elementwise_abs(v), d = av * 0.2316418882f + 1.0f;
    f32x2 t; t.x = __builtin_amdgcn_rcpf(d.x); t.y = __builtin_amdgcn_rcpf(d.y);
    f32x2 q = t * 0.5307027145f + (-0.7265760135f); q = q * t + 0.7107068705f; q = q * t + (-0.142248368f); q = q * t + 0.127414796f; q = q * t;
    const f32x2 s = (v * v) * (-0.72134752044f);
    f32x2 e; e.x = __builtin_amdgcn_exp2f(s.x); e.y = __builtin_amdgcn_exp2f(s.y);
    const f32x2 m = v * (q * e), r = v - m;
    f32x2 o; o.x = v.x < 0.f ? m.x : r.x; o.y = v.y < 0.f ? m.y : r.y; return o;
}
template <class Epi, class Sched, bool STAMP = false>
__device__ __forceinline__ void gemm_phase(PG8_LAS unsigned char* lds, const Gemm g, const Sched& S, const Epi& E, unsigned long long* stamps) {
    const int tid = threadIdx.x, wid = __builtin_amdgcn_readfirstlane(tid >> 6), lane = tid & 63, wr = wid >> 2, wc = wid & 3, fr = lane & 15, fq = lane >> 4;
    const int K = g.K, nt = K / BK;
    int ts_lo = 0, ts_hi = 0, nts = 0; const unsigned long long rt_entry = STAMP ? (unsigned long long)wall_clock64() : 0ull;
#define PG8_STAMP() do { if (STAMP && wid == 0 && nts < 64) { const unsigned long long _c = (unsigned long long)clock64(); \
        ts_lo = (lane == nts) ? (int)(unsigned)_c : ts_lo; ts_hi = (lane == nts) ? (int)(unsigned)(_c >> 32) : ts_hi; ++nts; } } while (0)
    PG8_STAMP();
    unsigned voffA[2], voffB[2];
#pragma unroll
    for (int i = 0; i < 2; ++i) { int R, C; stage_rc(tid * 16 + i * 8192, R, C); const int Rb = Epi::PERM ? ((R & ~31) + perm32(R & 31)) : R;
        voffA[i] = (unsigned)(R * K + C) * 2u; voffB[i] = (unsigned)(Rb * K + C) * 2u; }
    const size_t kstep = (size_t)(BK * 2);
    const size_t hstep = (size_t)HALF * K * 2;
    const size_t tstep = 2 * hstep;
    const unsigned ldsw = (unsigned)wid * 1024u;
    const int aoff = lds_byte(wr * 64 + fr, fq * 8), boff = lds_byte(wc * 32 + fr, fq * 8);
#define PG8_SA(b, h) (((b) * 2 + (h)) * HTB)
#define PG8_SB(b, h) ((4 + (b) * 2 + (h)) * HTB)
#define PG8_STAGE(bufoff, gbase, voff) do { _Pragma("unroll") for (int _i = 0; _i < 2; ++_i) \
        __builtin_amdgcn_global_load_lds((const unsigned*)((const char*)(gbase) + (voff)[_i]), (PG8_LAS unsigned*)(lds + (bufoff) + ldsw + _i * 8192), 16, 0, 0); } while (0)
#define PG8_LDA(dst, b, h) do { _Pragma("unroll") for (int m = 0; m < 4; ++m) _Pragma("unroll") for (int k = 0; k < 2; ++k) dst[m][k] = *(const PG8_LAS bf16x8*)(lds + PG8_SA(b, h) + aoff + m * 2048 + k * 1024); } while (0)
#define PG8_LDB(dst, b, h) do { _Pragma("unroll") for (int n = 0; n < 2; ++n) _Pragma("unroll") for (int k = 0; k < 2; ++k) dst[n][k] = *(const PG8_LAS bf16x8*)(lds + PG8_SB(b, h) + boff + n * 2048 + k * 1024); } while (0)
#define PG8_MMA(ai, bj, At, Bt) do { __builtin_amdgcn_s_setprio(1); _Pragma("unroll") for (int m = 0; m < 4; ++m) _Pragma("unroll") for (int n = 0; n < 2; ++n) _Pragma("unroll") for (int k = 0; k < 2; ++k) \
        acc[ai][bj][m][n] = __builtin_amdgcn_mfma_f32_16x16x32_bf16(Bt[n][k], At[m][k], acc[ai][bj][m][n], 0, 0, 0); __builtin_amdgcn_s_setprio(0); } while (0)
#define PG8_WAIT_V(n) asm volatile("s_waitcnt vmcnt(" #n ")" ::: "memory")
#define PG8_WAIT_L(n) asm volatile("s_waitcnt lgkmcnt(" #n ")" ::: "memory")
#define PG8_BAR __builtin_amdgcn_s_barrier()
#define PG8_SCHED __builtin_amdgcn_sched_barrier(0)
    Unit cur, nxt; int ui = 0;
    if (!S.next(0, cur)) return;
    f32x4 acc[2][2][4][2];
#pragma unroll
    for (int a = 0; a < 2; ++a)
#pragma unroll
        for (int b = 0; b < 2; ++b)
#pragma unroll
            for (int m = 0; m < 4; ++m)
#pragma unroll
                for (int n = 0; n < 2; ++n) acc[a][b][m][n] = (f32x4){0.f, 0.f, 0.f, 0.f};
    bf16x8 At[4][2], B0[2][2], B1[2][2];
    const char* cA = (const char*)g.A + (size_t)cur.pm * tstep; const char* cB = (const char*)g.Bt + (size_t)cur.pn * tstep;
    S.a_ready(cur);
    PG8_STAGE(PG8_SB(0, 0), cB, voffB); PG8_STAGE(PG8_SA(0, 0), cA, voffA); PG8_STAGE(PG8_SB(0, 1), cB + hstep, voffB); PG8_STAGE(PG8_SA(0, 1), cA + hstep, voffA);
    if (wr == 1) PG8_BAR;
    PG8_WAIT_V(4); PG8_BAR;
    PG8_STAGE(PG8_SB(1, 0), cB + kstep, voffB); PG8_STAGE(PG8_SA(1, 0), cA + kstep, voffA); PG8_STAGE(PG8_SB(1, 1), cB + hstep + kstep, voffB);
    PG8_WAIT_V(6); PG8_BAR;
    PG8_STAMP();
    for (;;) {
        const bool has_next = S.next(ui + 1, nxt);
        const char* nA = has_next ? (const char*)g.A + (size_t)nxt.pm * tstep : cA; const char* nB = has_next ? (const char*)g.Bt + (size_t)nxt.pn * tstep : cB;
        for (int t = 0; t < nt; t += 2) {
            const bool last = (t == nt - 2);
            const char* a1 = cA + (size_t)(t + 1) * kstep;
            const char* a2 = last ? nA : cA + (size_t)(t + 2) * kstep; const char* b2 = last ? nB : cB + (size_t)(t + 2) * kstep;
            const char* a3 = a2 + kstep; const char* b3 = b2 + kstep;
            if (last && has_next) S.a_ready(nxt);
            PG8_LDB(B0, 0, 0); PG8_SCHED; PG8_LDA(At, 0, 0); PG8_STAGE(PG8_SA(1, 1), a1 + hstep, voffA);
            PG8_WAIT_L(8); PG8_BAR; PG8_WAIT_L(0); PG8_MMA(0, 0, At, B0); PG8_BAR; PG8_SCHED;
            PG8_LDB(B1, 0, 1); PG8_STAGE(PG8_SB(0, 0), b2, voffB);
            PG8_BAR; PG8_WAIT_L(0); PG8_MMA(0, 1, At, B1); PG8_BAR;
            PG8_LDA(At, 0, 1); PG8_STAGE(PG8_SA(0, 0), a2, voffA);
            PG8_BAR; PG8_WAIT_L(0); PG8_MMA(1, 0, At, B0); PG8_BAR; PG8_SCHED;
            PG8_STAGE(PG8_SB(0, 1), b2 + hstep, voffB);
            PG8_WAIT_V(6); PG8_BAR; PG8_MMA(1, 1, At, B1); PG8_BAR;
            PG8_LDB(B0, 1, 0); PG8_SCHED; PG8_LDA(At, 1, 0); PG8_STAGE(PG8_SA(0, 1), a2 + hstep, voffA);
            PG8_WAIT_L(8); PG8_BAR; PG8_WAIT_L(0); PG8_MMA(0, 0, At, B0); PG8_BAR; PG8_SCHED;
            PG8_LDB(B1, 1, 1); PG8_STAGE(PG8_SB(1, 0), b3, voffB);
            PG8_BAR; PG8_WAIT_L(0); PG8_MMA(0, 1, At, B1); PG8_BAR;
            PG8_LDA(At, 1, 1); PG8_STAGE(PG8_SA(1, 0), a3, voffA);
            PG8_BAR; PG8_WAIT_L(0); PG8_MMA(1, 0, At, B0); PG8_BAR; PG8_SCHED;
            PG8_STAGE(PG8_SB(1, 1), b3 + hstep, voffB);
            PG8_WAIT_V(6); PG8_BAR; PG8_MMA(1, 1, At, B1); PG8_BAR;
        }
        PG8_STAMP();
        if constexpr (!Epi::AFTER_DRAIN) { E(acc, cur, wr, wc, fr, fq); S.done(cur); }
        PG8_STAMP();
        if (!has_next) break;
#pragma unroll
        for (int a = 0; a < 2; ++a)
#pragma unroll
            for (int b = 0; b < 2; ++b)
#pragma unroll
                for (int m = 0; m < 4; ++m)
#pragma unroll
                    for (int n = 0; n < 2; ++n) acc[a][b][m][n] = (f32x4){0.f, 0.f, 0.f, 0.f};
        cur = nxt; cA = nA; cB = nB; ++ui;
    }
    PG8_WAIT_V(0);
    if (wr == 0) PG8_BAR;
    PG8_BAR;
    if constexpr (Epi::AFTER_DRAIN) { E.fused(acc, cur, wr, wc, fr, fq, lds, wid, lane); S.done(cur); }
    PG8_STAMP();
    if (STAMP && wid == 0) { stamps[lane] = lane < nts ? (((unsigned long long)(unsigned)ts_hi << 32) | (unsigned)ts_lo) : 0ull;
        if (lane == 62) stamps[62] = rt_entry; if (lane == 63) stamps[63] = (unsigned long long)wall_clock64(); }
#undef PG8_STAMP
#undef PG8_SA
#undef PG8_SB
#undef PG8_STAGE
#undef PG8_LDA
#undef PG8_LDB
#undef PG8_MMA
#undef PG8_WAIT_V
#undef PG8_WAIT_L
#undef PG8_BAR
#undef PG8_SCHED
}
}

#define LAS __attribute__((address_space(3)))
typedef unsigned short bf16_t;
typedef float f32x4 __attribute__((ext_vector_type(4)));
typedef float f32x2 __attribute__((ext_vector_type(2)));
typedef unsigned u32x4 __attribute__((ext_vector_type(4)));
typedef unsigned u32x2 __attribute__((ext_vector_type(2)));

constexpr int NB = 8, SEQ = 4096, NMETA = 16, LT = SEQ + NMETA, DM = 1024, T = NB * SEQ;
constexpr int DHY = 512, DRG = 1024, DIN = 3 * DHY + 2 * DRG + 2 * DM;
constexpr int NTHR = 512, NWAVES = 8;
constexpr int LDS_BYTES = 160 * 1024;
constexpr float EPSF = 1e-6f;
constexpr int KFW = 2 * LT;
constexpr int SP = 4256;
constexpr int NEXP = 16384;
constexpr int RG_SPLIT = 33, RG_U1 = RG_SPLIT * 64;
constexpr int RG_NF = LT - RG_U1;

enum { I_X = 0, I_META, I_GFINAL, I_GMIX, I_WIN, I_BGATE, I_HYCW, I_HYCB, I_HYW1, I_HYB1, I_HYW2, I_HYB2, I_HYW3, I_HYB3, I_HYFREQ, I_HYSKIP,
       I_HYOUT, I_RGCW, I_RGCB, I_RGGW, I_RGGB, I_RGLAM, I_RGOUT, I_WOUT, I_GFFN, I_WQ, I_KEYS, I_PU, I_PV, N_IN };

constexpr size_t MiB = 1024ull * 1024ull;
constexpr size_t WS_ROWSS = 64 * 1024;
constexpr size_t WS_SU = 256 * 1024;
constexpr size_t WS_SV = 320 * 1024;
constexpr size_t WS_ROWSS2 = 384 * 1024;
constexpr size_t WS_BAR = 512 * 1024;
constexpr size_t WS_WINT = 1 * MiB;
constexpr size_t WS_WHT = 12 * MiB;
constexpr size_t WS_WRT = 13 * MiB;
constexpr size_t WS_WOT = 15 * MiB;
constexpr size_t WS_WST = 17 * MiB;
constexpr size_t WS_GWT = 21 * MiB;
constexpr size_t WS_KF = 22 * MiB;
constexpr size_t WS_KFB = 39 * MiB;
constexpr size_t WS_HYIN = 48 * MiB;
constexpr size_t WS_RGX = 145 * MiB;
constexpr size_t WS_GG = 210 * MiB;
constexpr size_t WS_GA = 274 * MiB;
constexpr size_t WS_GB = 338 * MiB;
constexpr size_t WS_XN1 = 402 * MiB;
constexpr size_t WS_UUT = 402 * MiB;
constexpr size_t WS_CONVT = 436 * MiB;
constexpr size_t WS_YH = 468 * MiB;
constexpr size_t WS_YR = WS_RGX;
constexpr size_t WS_MERGED = WS_HYIN;
constexpr size_t WS_TMP = WS_GG;
constexpr size_t WS_H1B = WS_RGX;
constexpr size_t WS_SCORES = WS_GG;
constexpr size_t WS_EIDX = 468 * MiB;
constexpr size_t WS_EG = 484 * MiB;
constexpr size_t WS_UB = 48 * MiB;
constexpr size_t WS_VB = 64 * MiB;
constexpr size_t WS_PD = 210 * MiB;
constexpr size_t WS_PO = WS_PD;
constexpr size_t WS_ACT = 338 * MiB;
constexpr size_t WS_RGP = 48 * MiB;
constexpr size_t WS_RGC = 576 * 1024;
constexpr size_t WS_END = 500 * MiB;

struct Args { const float* in[N_IN]; float* out; unsigned char* ws; int ph_lo, ph_hi; };

__device__ __forceinline__ float bf2f(unsigned v) { return __uint_as_float(v << 16); }
typedef __bf16 bf16x2_t __attribute__((ext_vector_type(2)));
__device__ __forceinline__ unsigned pk2(float lo, float hi) { bf16x2_t v; v.x = (__bf16)lo; v.y = (__bf16)hi; return __builtin_bit_cast(unsigned, v); }
__device__ __forceinline__ unsigned f2bf(float f) { return pk2(f, f) & 0xffffu; }
__device__ __forceinline__ float bflo(unsigned w) { return __uint_as_float(w << 16); }
__device__ __forceinline__ float bfhi(unsigned w) { return __uint_as_float(w & 0xffff0000u); }
__device__ __forceinline__ float wave_sum(float v) {
#pragma unroll
    for (int o = 1; o < 64; o <<= 1) v += __shfl_xor(v, o);
    return v;
}
__device__ __forceinline__ float wave_max(float v) {
#pragma unroll
    for (int o = 1; o < 64; o <<= 1) v = fmaxf(v, __shfl_xor(v, o));
    return v;
}
__device__ __forceinline__ float fexp(float x) { return __builtin_amdgcn_exp2f(x * 1.4426950408889634f); }
__device__ __forceinline__ float sigmoidf_(float x) { return __builtin_amdgcn_rcpf(1.0f + fexp(-x)); }
__device__ __forceinline__ float gelu_tanh(float x) { const float u = 1.5957691216f * (x + 0.044715f * x * x * x); return x * __builtin_amdgcn_rcpf(1.0f + fexp(-u)); }
__device__ __forceinline__ void sincos_acc(float a, float& s, float& c) {
    const double x = (double)a;
    const double q = rint(x * 0.63661977236758134308);
    const double r = fma(-q, 1.57079632679489661923, x);
    const int n = (int)q;
    const float rf = (float)r, r2 = rf * rf;
    const float sp = rf * (1.f + r2 * (-1.6666667e-1f + r2 * (8.3333333e-3f + r2 * (-1.9841270e-4f + r2 * 2.7557319e-6f))));
    const float cp = 1.f + r2 * (-0.5f + r2 * (4.1666667e-2f + r2 * (-1.3888889e-3f + r2 * (2.4801587e-5f + r2 * (-2.7557319e-7f)))));
    const int k = n & 3;
    s = (k == 0) ? sp : (k == 1) ? cp : (k == 2) ? -sp : -cp;
    c = (k == 0) ? cp : (k == 1) ? -sp : (k == 2) ? -cp : sp;
}

typedef float f32x2v __attribute__((ext_vector_type(2)));
__device__ __forceinline__ float wave_sum_dpp(float v) {
    v += __int_as_float(__builtin_amdgcn_update_dpp(0, __float_as_int(v), 0xB1, 0xF, 0xF, true));
    v += __int_as_float(__builtin_amdgcn_update_dpp(0, __float_as_int(v), 0x4E, 0xF, 0xF, true));
    v += __int_as_float(__builtin_amdgcn_update_dpp(0, __float_as_int(v), 0x141, 0xF, 0xF, true));
    v += __int_as_float(__builtin_amdgcn_update_dpp(0, __float_as_int(v), 0x140, 0xF, 0xF, true));
    const int vi = __float_as_int(v);
    return (__int_as_float(__builtin_amdgcn_readlane(vi, 0)) + __int_as_float(__builtin_amdgcn_readlane(vi, 16))) + (__int_as_float(__builtin_amdgcn_readlane(vi, 32)) + __int_as_float(__builtin_amdgcn_readlane(vi, 48)));
}
__device__ __forceinline__ float wave_max_dpp(float v) {
    v = fmaxf(v, __int_as_float(__builtin_amdgcn_update_dpp(0, __float_as_int(v), 0xB1, 0xF, 0xF, true)));
    v = fmaxf(v, __int_as_float(__builtin_amdgcn_update_dpp(0, __float_as_int(v), 0x4E, 0xF, 0xF, true)));
    v = fmaxf(v, __int_as_float(__builtin_amdgcn_update_dpp(0, __float_as_int(v), 0x141, 0xF, 0xF, true)));
    v = fmaxf(v, __int_as_float(__builtin_amdgcn_update_dpp(0, __float_as_int(v), 0x140, 0xF, 0xF, true)));
    const int vi = __float_as_int(v);
    return fmaxf(fmaxf(__int_as_float(__builtin_amdgcn_readlane(vi, 0)), __int_as_float(__builtin_amdgcn_readlane(vi, 16))), fmaxf(__int_as_float(__builtin_amdgcn_readlane(vi, 32)), __int_as_float(__builtin_amdgcn_readlane(vi, 48))));
}

#ifndef SLICE_PROBE
#define SLICE_OF(b) ((b) & 7)
#define RANK_OF(b) ((b) >> 3)
#else
#define SLICE_OF(b) ((b) >> 5)
#define RANK_OF(b) ((b) & 31)
#endif

__device__ __forceinline__ float dpp_xor8(float v) { return __int_as_float(__builtin_amdgcn_update_dpp(0, __float_as_int(v), 0x128, 0xF, 0xF, true)); }

#ifdef NT_STORES3
#define NT_ST(p, v) __builtin_nontemporal_store((v), (p))
#else
#define NT_ST(p, v) (*(p) = (v))
#endif

#ifdef NT_LOADS
#define NT_LD(p) __builtin_nontemporal_load(p)
#else
#define NT_LD(p) (*(p))
#endif
#define XB_TMO      128
#define XB_XCNT(j)  (256  + 64 * (j))
#define XB_XSUB(j)  (1280 + 64 * (j))
#define XB_XGEN(j)  (2304 + 64 * (j))
#define XB_TOP      3328
#define XB_TOPGEN   3392
#define XCD_BAR_WORDS 3456
#define XB_SPIN_CAP (1u << 18)

__device__ __forceinline__ unsigned xb_ld(unsigned* p)              { return __hip_atomic_load(p, __ATOMIC_RELAXED, __HIP_MEMORY_SCOPE_AGENT); }
__device__ __forceinline__ unsigned xb_add(unsigned* p, unsigned v) { return __hip_atomic_fetch_add(p, v, __ATOMIC_RELAXED, __HIP_MEMORY_SCOPE_AGENT); }
__device__ __forceinline__ unsigned xb_xcc_id() { return (unsigned)__builtin_amdgcn_s_getreg((3 << 11) | 20) & 0xFu; }
#define XB_SPIN(cond, bar) do { unsigned _sp = 0; while (cond) { __builtin_amdgcn_s_sleep(1); \
    if ((++_sp & 255u) == 0u) { if (xb_ld(&(bar)[XB_TMO])) break; if (_sp > XB_SPIN_CAP) { atomicAdd(&(bar)[XB_TMO], 1u); break; } } } } while (0)

struct XcdBarrier {
    unsigned* bar; unsigned x;
    volatile LAS unsigned* st;
};

__device__ __forceinline__ XcdBarrier xcd_barrier_post(unsigned* bar, volatile LAS unsigned* st) {
    XcdBarrier b; b.bar = bar; b.x = xb_xcc_id(); b.st = st;
    if (threadIdx.x == 0) (void)xb_add(&bar[XB_XCNT(b.x)], 1u);
    return b;
}
__device__ __forceinline__ void xcd_barrier_complete(unsigned* bar, unsigned x, unsigned& nloc, unsigned& nx) {
    const unsigned G = gridDim.x * gridDim.y * gridDim.z;
    unsigned sum, cnt, mine, sp = 0u;
    for (;;) {
        sum = 0u; cnt = 0u; mine = 0u;
#pragma unroll
        for (unsigned j = 0; j < 16; ++j) { const unsigned c = xb_ld(&bar[XB_XCNT(j)]); sum += c; cnt += (c > 0u) ? 1u : 0u; mine = (j == x) ? c : mine; }
        if (sum == G) break;
        __builtin_amdgcn_s_sleep(1);
        if ((++sp & 255u) == 0u) { if (xb_ld(&bar[XB_TMO])) break; if (sp > XB_SPIN_CAP) { atomicAdd(&bar[XB_TMO], 1u); break; } }
    }
    nloc = mine > 0u ? mine : 1u; nx = cnt > 0u ? cnt : 1u;
}

__device__ __forceinline__ void xcd_barrier(const XcdBarrier& b) {
    asm volatile("s_waitcnt vmcnt(0)" ::: "memory");
    __syncthreads();
    if (threadIdx.x == 0) {
        unsigned* bar = b.bar;
        __builtin_amdgcn_s_waitcnt(0);
        unsigned nloc = b.st[0], nx = b.st[1];
        if (nloc == 0u) { xcd_barrier_complete(bar, b.x, nloc, nx); b.st[0] = nloc; b.st[1] = nx; }
        const unsigned old = xb_add(&bar[XB_XSUB(b.x)], 1u);
        const unsigned gen = old / nloc;
        if (old + 1u == (gen + 1u) * nloc) {
            __builtin_amdgcn_fence(__ATOMIC_RELEASE, "agent");
            asm volatile("s_waitcnt vmcnt(0)" ::: "memory");
            const unsigned og = xb_add(&bar[XB_TOP], 1u);
            const unsigned tg = og / nx;
            if (og + 1u == (tg + 1u) * nx) xb_add(&bar[XB_TOPGEN], 1u);
            else XB_SPIN(xb_ld(&bar[XB_TOPGEN]) == tg, bar);
            __builtin_amdgcn_fence(__ATOMIC_ACQUIRE, "agent");
            xb_add(&bar[XB_XGEN(b.x)], 1u);
            asm volatile("s_waitcnt vmcnt(0)" ::: "memory");
        } else {
            XB_SPIN(xb_ld(&bar[XB_XGEN(b.x)]) == gen, bar);
            __builtin_amdgcn_fence(__ATOMIC_ACQUIRE, "agent");
            asm volatile("s_waitcnt vmcnt(0)" ::: "memory");
        }
    }
    __syncthreads();
}

__device__ __forceinline__ void p0_transpose_item(const float* W, int K, int N, bf16_t* WT, LAS float* scr, int item, int lane) {
    const int nblk = N / 32, kb = item / nblk, nb = item % nblk, k0 = 64 * kb, n0 = 32 * nb;
#pragma unroll 8
    for (int i = 0; i < 32; ++i) { const int kk = 2 * i + (lane >> 5); scr[kk * 33 + (lane & 31)] = W[(size_t)(k0 + kk) * N + n0 + (lane & 31)]; }
    asm volatile("s_waitcnt lgkmcnt(0)" ::: "memory");
    const int c = lane & 7;
#pragma unroll
    for (int j = 0; j < 4; ++j) { const int n = (lane >> 3) + 8 * j; const LAS float* s = scr + (8 * c) * 33 + n;
        u32x4 o; o.x = pk2(s[0 * 33], s[1 * 33]); o.y = pk2(s[2 * 33], s[3 * 33]); o.z = pk2(s[4 * 33], s[5 * 33]); o.w = pk2(s[6 * 33], s[7 * 33]);
        *(u32x4*)(WT + (size_t)(n0 + n) * K + k0 + 8 * c) = o; }
    asm volatile("s_waitcnt lgkmcnt(0)" ::: "memory");
}
__device__ __forceinline__ void p0_xn1_row(const float* xrow, const float* g, bf16_t* orow, int lane) {
    const f32x4* xr = (const f32x4*)xrow + lane; const f32x4* gr = (const f32x4*)g + lane;
    f32x4 v[4]; float s = 0.f;
#pragma unroll
    for (int j = 0; j < 4; ++j) { v[j] = NT_LD(xr + 64 * j); s += (v[j].x * v[j].x + v[j].y * v[j].y) + (v[j].z * v[j].z + v[j].w * v[j].w); }
    const float rstd = rsqrtf(wave_sum(s) * (1.f / DM) + EPSF);
    unsigned long long* o8 = (unsigned long long*)orow + lane;
#pragma unroll
    for (int j = 0; j < 4; ++j) { const f32x4 gv = gr[64 * j];
        o8[64 * j] = (unsigned long long)pk2(v[j].x * rstd * gv.x, v[j].y * rstd * gv.y) | ((unsigned long long)pk2(v[j].z * rstd * gv.z, v[j].w * rstd * gv.w) << 32); }
}
__device__ __forceinline__ void p0_fold_item(const Args& a, LAS unsigned char* lds, int item, int tid) {
    const int hp = item >> 4, k0 = (item & 15) * 64;
    LAS float* kl = (LAS float*)lds;
    LAS float* wl = (LAS float*)(lds + 128 * 129 * 4);
    const float* keys = a.in[I_KEYS] + (size_t)hp * 128 * 128; const float* wq = a.in[I_WQ];
    for (int i = tid; i < 128 * 128; i += NTHR) { const int key = i >> 7, d = i & 127; kl[key * 129 + d] = keys[i]; }
    for (int i = tid; i < 64 * 128; i += NTHR) { const int kk = i >> 7, d = i & 127; wl[i] = wq[(size_t)(k0 + kk) * 2048 + hp * 128 + d]; }
    __syncthreads();
    const int key = tid & 127, kq = tid >> 7;
    float acc[16];
#pragma unroll
    for (int i = 0; i < 16; ++i) acc[i] = 0.f;
#pragma unroll 2
    for (int d = 0; d < 128; ++d) { const float kv = kl[key * 129 + d];
#pragma unroll
        for (int i = 0; i < 16; ++i) acc[i] += wl[(kq * 16 + i) * 128 + d] * kv; }
    const float* gf = a.in[I_GFFN] + k0 + kq * 16;
    bf16_t* dst = (bf16_t*)(a.ws + WS_WST) + (size_t)(hp * 128 + key) * 1024 + k0 + kq * 16;
    u32x4 o0, o1;
    o0.x = pk2(acc[0] * gf[0], acc[1] * gf[1]); o0.y = pk2(acc[2] * gf[2], acc[3] * gf[3]); o0.z = pk2(acc[4] * gf[4], acc[5] * gf[5]); o0.w = pk2(acc[6] * gf[6], acc[7] * gf[7]);
    o1.x = pk2(acc[8] * gf[8], acc[9] * gf[9]); o1.y = pk2(acc[10] * gf[10], acc[11] * gf[11]); o1.z = pk2(acc[12] * gf[12], acc[13] * gf[13]); o1.w = pk2(acc[14] * gf[14], acc[15] * gf[15]);
    *(u32x4*)dst = o0; *(u32x4*)(dst + 8) = o1;
    __syncthreads();
}
__device__ __forceinline__ void p0_meta_item(const Args& a, LAS unsigned char* lds, int item, int tid, int wave, int lane) {
    LAS float* mt = (LAS float*)lds;
    for (int r = wave * 2; r < wave * 2 + 2; ++r) {
        const f32x4* xr = (const f32x4*)(a.in[I_META] + (size_t)r * DM) + lane; const f32x4* gr = (const f32x4*)a.in[I_GMIX] + lane;
        f32x4 v[4]; float s = 0.f;
#pragma unroll
        for (int j = 0; j < 4; ++j) { v[j] = xr[64 * j]; s += (v[j].x * v[j].x + v[j].y * v[j].y) + (v[j].z * v[j].z + v[j].w * v[j].w); }
        const float rstd = rsqrtf(wave_sum(s) * (1.f / DM) + EPSF);
#pragma unroll
        for (int j = 0; j < 4; ++j) { const f32x4 gv = gr[64 * j]; f32x4 o = v[j] * rstd * gv; *(LAS f32x4*)(mt + r * 1024 + 4 * (lane + 64 * j)) = o; }
    }
    __syncthreads();
    const int col = item * 256 + (tid & 255), rh = tid >> 8;
    float acc[8];
#pragma unroll
    for (int r = 0; r < 8; ++r) acc[r] = 0.f;
    const float* w = a.in[I_WIN] + col;
#pragma unroll 4
    for (int k = 0; k < 1024; ++k) { const float wv = w[(size_t)k * DIN];
#pragma unroll
        for (int r = 0; r < 8; ++r) acc[r] += mt[(rh * 8 + r) * 1024 + k] * wv; }
    bf16_t* hyin = (bf16_t*)(a.ws + WS_HYIN); bf16_t* rgx = (bf16_t*)(a.ws + WS_RGX);
#pragma unroll
    for (int r = 0; r < 8; ++r) { const int t = rh * 8 + r; const bf16_t v = (bf16_t)f2bf(acc[r]);
        for (int b = 0; b < NB; ++b) { if (col < 1536) hyin[((size_t)b * LT + t) * 1536 + col] = v; else rgx[((size_t)b * LT + t) * 1024 + (col - 1536)] = v; } }
    __syncthreads();
}
constexpr int FPP = 17, NFILT = (LT + FPP - 1) / FPP;
__device__ __forceinline__ void p0_filter_item(const Args& a, LAS unsigned char* lds, int item, int tid) {
    LAS float* z = (LAS float*)lds;
    LAS float* h1 = z + FPP * 33;
    LAS float* h2 = h1 + FPP * 64;
    LAS float* ko = h2 + FPP * 64;
    const int p0 = item * FPP;
    for (int idx = tid; idx < FPP * 33; idx += NTHR) { const int pp = idx / 33, f = idx % 33, p = p0 + pp;
        float v;
        if (f == 0) v = (float)p * (1.0f / (float)(LT - 1));
        else { const int bi = (f - 1) & 15; const float band = 1e-4f + (float)bi * ((15.0f - 1e-4f) / 15.0f); const float w = (float)(6.283185307179586 / (double)LT) * (float)p;
            float s, c; sincos_acc(band * w, s, c); v = (f <= 16) ? c : -s; }
        z[idx] = v; }
    __syncthreads();
    const float* w1 = a.in[I_HYW1]; const float* b1 = a.in[I_HYB1]; const float* w2 = a.in[I_HYW2]; const float* b2 = a.in[I_HYB2];
    const float* w3 = a.in[I_HYW3]; const float* b3 = a.in[I_HYB3]; const float* fr = a.in[I_HYFREQ];
    { const int j = tid & 63, pq = tid >> 6;
        float wv[33];
#pragma unroll
        for (int f = 0; f < 33; ++f) wv[f] = w1[f * 64 + j];
        const float bj = b1[j], fj = fr[j];
        for (int pp = pq; pp < FPP; pp += 8) { float acc = bj;
#pragma unroll
            for (int f = 0; f < 33; ++f) acc += z[pp * 33 + f] * wv[f];
            float s, c; sincos_acc(fj * acc, s, c); h1[pp * 64 + j] = s; } }
    __syncthreads();
    { const int j = tid & 63, pq = tid >> 6;
        const float bj = b2[j], fj = fr[64 + j]; float accp[3] = {bj, bj, bj};
#pragma unroll 1
        for (int fh = 0; fh < 2; ++fh) { float wv[32];
#pragma unroll
            for (int f = 0; f < 32; ++f) wv[f] = w2[(fh * 32 + f) * 64 + j];
#pragma unroll
            for (int t3 = 0; t3 < 3; ++t3) { const int pp = pq + 8 * t3; if (pp < FPP) { float acc = accp[t3];
#pragma unroll
                for (int f = 0; f < 32; ++f) acc += h1[pp * 64 + fh * 32 + f] * wv[f];
                accp[t3] = acc; } } }
#pragma unroll
        for (int t3 = 0; t3 < 3; ++t3) { const int pp = pq + 8 * t3; if (pp < FPP) { float s, c; sincos_acc(fj * accp[t3], s, c); h2[pp * 64 + j] = s; } } }
    __syncthreads();
#pragma unroll 1
    for (int half = 0; half < 2; ++half) { const int o = half * 512 + tid;
        const float bo = b3[o];
        const float delta = fabsf(-15.350567286626972f + (float)tid * ((-3.0701134573253945f + 15.350567286626972f) / 511.0f));
#pragma unroll 1
        for (int ih = 0; ih < 2; ++ih) { float wv[32];
#pragma unroll
            for (int i = 0; i < 32; ++i) wv[i] = w3[(ih * 32 + i) * 1024 + o];
#pragma unroll 1
            for (int pp = 0; pp < FPP; ++pp) { float acc = ih ? ko[o * (FPP + 1) + pp] : bo;
#pragma unroll
                for (int i = 0; i < 32; ++i) acc += h2[pp * 64 + ih * 32 + i] * wv[i];
                if (ih) { const float tn = (float)(p0 + pp) * (1.0f / (float)(LT - 1)); acc *= __expf(-tn * delta); }
                ko[o * (FPP + 1) + pp] = acc; } }
    }
    __syncthreads();
    bf16_t* kfb = (bf16_t*)(a.ws + WS_KFB);
    for (int idx = tid; idx < 1024 * FPP; idx += NTHR) { const int o = idx / FPP, pp = idx - o * FPP, dir = o >> 9, c = o & 511, p = p0 + pp;
        if (p < LT) { const float v = ko[o * (FPP + 1) + pp];
            if (dir == 0) kfb[(size_t)c * KFW + (LT - 1) + p] = (bf16_t)f2bf(p == 0 ? v + a.in[I_HYSKIP][c] : v);
            else if (p >= 1) kfb[(size_t)c * KFW + (LT - 1) - p] = (bf16_t)f2bf(v); } }
    if (item == 0) for (int c = tid; c < 512; c += NTHR) kfb[(size_t)c * KFW + KFW - 1] = 0;
    __syncthreads();
}
__device__ __forceinline__ void phase_p0(const Args& a, LAS unsigned char* lds, int tid, int wave, int lane) {
    const int G = gridDim.x, bx = blockIdx.x;
    { float* rs = (float*)(a.ws + WS_ROWSS); float* rs2 = (float*)(a.ws + WS_ROWSS2); for (int i = bx * NTHR + tid; i < T; i += G * NTHR) { rs[i] = 0.f; rs2[i] = 0.f; } }
    for (int it = bx; it < 256 + NFILT; it += G) {
#ifndef P0M
#define P0M 7
#endif
        if (it < 256) { if (P0M & 1) p0_fold_item(a, lds, it, tid); }
        else { if (P0M & 2) p0_filter_item(a, lds, it - 256, tid); }

    }
    LAS float* scr = (LAS float*)(lds + wave * 16384);
    const int gw = bx * NWAVES + wave, NGW = G * NWAVES;
    constexpr int I_IN = (1024 / 64) * (DIN / 32), I_H = (512 / 64) * (1024 / 32), I_R = (1024 / 64) * (1024 / 32), I_O = I_R;
    for (int it = gw; it < I_IN + I_H + I_R + I_O; it += NGW) {
        int r = it;
        if (r < I_IN) { p0_transpose_item(a.in[I_WIN], 1024, DIN, (bf16_t*)(a.ws + WS_WINT), scr, r, lane); continue; } r -= I_IN;
        if (r < I_H) { p0_transpose_item(a.in[I_HYOUT], 512, 1024, (bf16_t*)(a.ws + WS_WHT), scr, r, lane); continue; } r -= I_H;
        if (r < I_R) { p0_transpose_item(a.in[I_RGOUT], 1024, 1024, (bf16_t*)(a.ws + WS_WRT), scr, r, lane); continue; } r -= I_R;
        p0_transpose_item(a.in[I_WOUT], 1024, 1024, (bf16_t*)(a.ws + WS_WOT), scr, r, lane);
    }
    for (int m = gw; m < T; m += 2 * NGW) { p0_xn1_row(a.in[I_X] + (size_t)m * DM, a.in[I_GMIX], (bf16_t*)(a.ws + WS_XN1) + (size_t)m * DM, lane);
        if (m + NGW < T) p0_xn1_row(a.in[I_X] + (size_t)(m + NGW) * DM, a.in[I_GMIX], (bf16_t*)(a.ws + WS_XN1) + (size_t)(m + NGW) * DM, lane); }
}

__device__ __forceinline__ void p1_meta(const Args& a, LAS unsigned char* lds, int tid, int wave, int lane) {
    LAS float* mt = (LAS float*)lds;
    for (int r = wave * 2; r < wave * 2 + 2; ++r) {
        const f32x4* xr = (const f32x4*)(a.in[I_META] + (size_t)r * DM) + lane; const f32x4* gr = (const f32x4*)a.in[I_GMIX] + lane;
        f32x4 v[4]; float s = 0.f;
#pragma unroll
        for (int j = 0; j < 4; ++j) { v[j] = xr[64 * j]; s += (v[j].x * v[j].x + v[j].y * v[j].y) + (v[j].z * v[j].z + v[j].w * v[j].w); }
        const float rstd = rsqrtf(wave_sum(s) * (1.f / DM) + EPSF);
#pragma unroll
        for (int j = 0; j < 4; ++j) { const f32x4 gv = gr[64 * j]; f32x4 o = v[j] * rstd * gv; *(LAS f32x4*)(mt + r * 1024 + 4 * (lane + 64 * j)) = o; }
    }
    __syncthreads();
    const bf16_t* wint = (const bf16_t*)(a.ws + WS_WINT); bf16_t* hyin = (bf16_t*)(a.ws + WS_HYIN); bf16_t* rgx = (bf16_t*)(a.ws + WS_RGX);
    for (int cc = wave; cc < 10; cc += NWAVES) { const int n = blockIdx.x * 10 + cc; if (n >= 2560) break;
        float w[16]; { float t0[8], t1[8]; const bf16_t* wp = wint + (size_t)n * 1024; const u32x4 q0 = *(const u32x4*)(wp + 8 * lane), q1 = *(const u32x4*)(wp + 512 + 8 * lane);
            w[0] = bflo(q0.x); w[1] = bfhi(q0.x); w[2] = bflo(q0.y); w[3] = bfhi(q0.y); w[4] = bflo(q0.z); w[5] = bfhi(q0.z); w[6] = bflo(q0.w); w[7] = bfhi(q0.w);
            w[8] = bflo(q1.x); w[9] = bfhi(q1.x); w[10] = bflo(q1.y); w[11] = bfhi(q1.y); w[12] = bflo(q1.z); w[13] = bfhi(q1.z); w[14] = bflo(q1.w); w[15] = bfhi(q1.w); (void)t0; (void)t1; }
        float mine = 0.f;
#pragma unroll
        for (int r = 0; r < 16; ++r) { const LAS f32x4* mp = (const LAS f32x4*)(mt + r * 1024 + 8 * lane); const f32x4 m0 = mp[0], m1 = mp[1], m2 = mp[128], m3 = mp[129];
            float s = (w[0] * m0.x + w[1] * m0.y) + (w[2] * m0.z + w[3] * m0.w) + (w[4] * m1.x + w[5] * m1.y) + (w[6] * m1.z + w[7] * m1.w)
                    + (w[8] * m2.x + w[9] * m2.y) + (w[10] * m2.z + w[11] * m2.w) + (w[12] * m3.x + w[13] * m3.y) + (w[14] * m3.z + w[15] * m3.w);
            s = wave_sum_dpp(s); mine = ((lane & 15) == r) ? s : mine; }
        const bf16_t v = (bf16_t)f2bf(mine); const int t = lane & 15;
#pragma unroll
        for (int h = 0; h < 2; ++h) { const int b = (lane >> 4) + 4 * h;
            if (n < 1536) hyin[((size_t)b * LT + t) * 1536 + n] = v; else rgx[((size_t)b * LT + t) * 1024 + (n - 1536)] = v; }
    }
    __syncthreads();
}

typedef pg8::f32x4 pf4;
struct EpiProj {
    static constexpr bool PERM = true, AFTER_DRAIN = false;
    bf16_t *hyin, *rgx, *gg, *ga, *gb; const float* bgate;
    __device__ __forceinline__ void operator()(const pf4 (&acc)[2][2][4][2], const pg8::Unit& u, int wr, int wc, int fr, int fq) const {
        const int pn = u.pn, row0 = u.pm * 256 + wr * 64 + fr, cl0 = wc * 32 + 8 * fq;
#ifdef PROBE_P1_SKIPEPI
        if (u.skip) return;
#endif
#pragma unroll
        for (int ai = 0; ai < 2; ++ai)
#pragma unroll
            for (int m = 0; m < 4; ++m) { const int r = row0 + ai * 128 + m * 16; const size_t rl = (size_t)(r >> 12) * LT + NMETA + (r & 4095);
#pragma unroll
                for (int bj = 0; bj < 2; ++bj) { const int col = pn * 256 + bj * 128 + cl0; pf4 v0 = acc[ai][bj][m][0], v1 = acc[ai][bj][m][1]; bf16_t* dst;
                    if (pn < 6) dst = hyin + rl * 1536 + col;
                    else if (pn < 10) dst = rgx + rl * 1024 + (col - 1536);
                    else if (pn < 14) { dst = gg + (size_t)r * 1024 + (col - 2560);
#pragma unroll
                        for (int j = 0; j < 4; ++j) { v0[j] = gelu_tanh(v0[j]); v1[j] = gelu_tanh(v1[j]); } }
                    else { const int gc = col - 3584;
                        dst = (gc < 1024 ? ga + (size_t)r * 1024 + gc : gb + (size_t)r * 1024 + (gc - 1024));
                        const pf4 b0 = *(const pf4*)(bgate + gc), b1 = *(const pf4*)(bgate + gc + 4);
#pragma unroll
                        for (int j = 0; j < 4; ++j) { v0[j] = sigmoidf_(v0[j] + b0[j]); v1[j] = sigmoidf_(v1[j] + b1[j]); } }
                    u32x4 w; w.x = pk2(v0[0], v0[1]); w.y = pk2(v0[2], v0[3]); w.z = pk2(v1[0], v1[1]); w.w = pk2(v1[2], v1[3]);
#ifdef PROBE_P1_NOSTORE
                    if (u.skip) { asm volatile("" :: "v"(w.x), "v"(w.y), "v"(w.z), "v"(w.w)); } else __builtin_nontemporal_store(w, (u32x4*)dst);
#elif defined(NT_STORES)
                    __builtin_nontemporal_store(w, (u32x4*)dst);
#else
                    *(u32x4*)dst = w;
#endif
                } }
    }
};
template <int MODE  > struct EpiGate {
    static constexpr bool PERM = true, AFTER_DRAIN = false;
    const bf16_t* gate; const bf16_t* tin; bf16_t* outp;
    __device__ __forceinline__ void operator()(const pf4 (&acc)[2][2][4][2], const pg8::Unit& u, int wr, int wc, int fr, int fq) const {
        const int row0 = u.pm * 256 + wr * 64 + fr, col0 = u.pn * 256 + wc * 32 + 8 * fq;
        u32x4 gq[2], tq[2];
#define EG_OFF(i) ((size_t)(row0 + ((i) >> 3) * 128 + (((i) >> 1) & 3) * 16) * 1024 + col0 + ((i) & 1) * 128)
        gq[0] = *(const u32x4*)(gate + EG_OFF(0)); if (MODE == 1) tq[0] = *(const u32x4*)(tin + EG_OFF(0));
#pragma unroll
        for (int i = 0; i < 16; ++i) { const int ai = i >> 3, m = (i >> 1) & 3, bj = i & 1; const size_t o = EG_OFF(i);
            if (i + 1 < 16) { gq[(i + 1) & 1] = *(const u32x4*)(gate + EG_OFF(i + 1)); if (MODE == 1) tq[(i + 1) & 1] = *(const u32x4*)(tin + EG_OFF(i + 1)); }
            const pf4 v0 = acc[ai][bj][m][0], v1 = acc[ai][bj][m][1]; const u32x4 g = gq[i & 1];
            float r[8];
            r[0] = v0[0] * bflo(g.x); r[1] = v0[1] * bfhi(g.x); r[2] = v0[2] * bflo(g.y); r[3] = v0[3] * bfhi(g.y);
            r[4] = v1[0] * bflo(g.z); r[5] = v1[1] * bfhi(g.z); r[6] = v1[2] * bflo(g.w); r[7] = v1[3] * bfhi(g.w);
            if (MODE == 1) { const u32x4 t = tq[i & 1];
                r[0] += bflo(t.x); r[1] += bfhi(t.x); r[2] += bflo(t.y); r[3] += bfhi(t.y); r[4] += bflo(t.z); r[5] += bfhi(t.z); r[6] += bflo(t.w); r[7] += bfhi(t.w); }
            u32x4 w; w.x = pk2(r[0], r[1]); w.y = pk2(r[2], r[3]); w.z = pk2(r[4], r[5]); w.w = pk2(r[6], r[7]);
#ifdef NT_STORES2
            if (MODE == 1) __builtin_nontemporal_store(w, (u32x4*)(outp + o)); else *(u32x4*)(outp + o) = w; }
#else
            *(u32x4*)(outp + o) = w; }
#endif
#undef EG_OFF
    }
};
struct EpiResid {
    static constexpr bool PERM = true, AFTER_DRAIN = false;
    const float* x; bf16_t* h1b; float* rowss;
    __device__ __forceinline__ void operator()(const pf4 (&acc)[2][2][4][2], const pg8::Unit& u, int wr, int wc, int fr, int fq) const {
        const int row0 = u.pm * 256 + wr * 64 + fr, col0 = u.pn * 256 + wc * 32 + 8 * fq;
        pf4 xq[2][4];
#define ER_ROW(i) (row0 + ((i) >> 2) * 128 + ((i) & 3) * 16)
#define ER_LOAD(buf, i) do { const float* p_ = x + (size_t)ER_ROW(i) * 1024 + col0; xq[buf][0] = *(const pf4*)p_; xq[buf][1] = *(const pf4*)(p_ + 4); xq[buf][2] = *(const pf4*)(p_ + 128); xq[buf][3] = *(const pf4*)(p_ + 132); } while (0)
        ER_LOAD(0, 0);
#pragma unroll
        for (int i = 0; i < 8; ++i) { const int ai = i >> 2, m = i & 3, r = ER_ROW(i); const size_t ro = (size_t)r * 1024 + col0; float ss = 0.f;
            if (i + 1 < 8) ER_LOAD((i + 1) & 1, i + 1);
#pragma unroll
            for (int bj = 0; bj < 2; ++bj) { const size_t o = ro + bj * 128;
                const pf4 v0 = acc[ai][bj][m][0] + xq[i & 1][2 * bj], v1 = acc[ai][bj][m][1] + xq[i & 1][2 * bj + 1];
                u32x4 w; w.x = pk2(v0[0], v0[1]); w.y = pk2(v0[2], v0[3]); w.z = pk2(v1[0], v1[1]); w.w = pk2(v1[2], v1[3]);
#ifdef NT_STORES2
                __builtin_nontemporal_store(w, (u32x4*)(h1b + o));
#else
                *(u32x4*)(h1b + o) = w;
#endif
                ss += (v0[0] * v0[0] + v0[1] * v0[1]) + (v0[2] * v0[2] + v0[3] * v0[3]) + (v1[0] * v1[0] + v1[1] * v1[1]) + (v1[2] * v1[2] + v1[3] * v1[3]); }
            ss += __shfl_xor(ss, 16); ss += __shfl_xor(ss, 32);
            if (fq == 0) atomicAdd(rowss + r, ss); }
#undef ER_ROW
#undef ER_LOAD
    }
};
struct EpiScores {
    static constexpr bool PERM = true, AFTER_DRAIN = false;
    const float* rowss; _Float16* sc;
    __device__ __forceinline__ void operator()(const pf4 (&acc)[2][2][4][2], const pg8::Unit& u, int wr, int wc, int fr, int fq) const {
        const int row0 = u.pm * 256 + wr * 64 + fr, k0 = wc * 32 + 8 * fq;
#pragma unroll
        for (int ai = 0; ai < 2; ++ai)
#pragma unroll
            for (int m = 0; m < 4; ++m) { const int r = row0 + ai * 128 + m * 16; const float rs = rsqrtf(rowss[r] * (1.f / DM) + EPSF);
#pragma unroll
                for (int bj = 0; bj < 2; ++bj) { _Float16* p = sc + (((size_t)(((r >> 6) * 8 + u.pn) * 2 + bj) * 16 + (k0 >> 3)) * 64 + (r & 63)) * 8;
                    typedef _Float16 h8 __attribute__((ext_vector_type(8)));
                    h8 v; v[0] = (_Float16)(acc[ai][bj][m][0][0] * rs); v[1] = (_Float16)(acc[ai][bj][m][0][1] * rs); v[2] = (_Float16)(acc[ai][bj][m][0][2] * rs); v[3] = (_Float16)(acc[ai][bj][m][0][3] * rs);
                    v[4] = (_Float16)(acc[ai][bj][m][1][0] * rs); v[5] = (_Float16)(acc[ai][bj][m][1][1] * rs); v[6] = (_Float16)(acc[ai][bj][m][1][2] * rs); v[7] = (_Float16)(acc[ai][bj][m][1][3] * rs);
                    *(h8*)p = v; } }
    }
};

__device__ __forceinline__ void unpack8(const u32x4 w, float (&f)[8]) {
    f[0] = bflo(w.x); f[1] = bfhi(w.x); f[2] = bflo(w.y); f[3] = bfhi(w.y); f[4] = bflo(w.z); f[5] = bfhi(w.z); f[6] = bflo(w.w); f[7] = bfhi(w.w); }
__device__ __forceinline__ void load8(const bf16_t* p, float (&f)[8]) { const u32x4 w = *(const u32x4*)p;
    f[0] = bflo(w.x); f[1] = bfhi(w.x); f[2] = bflo(w.y); f[3] = bfhi(w.y); f[4] = bflo(w.z); f[5] = bfhi(w.z); f[6] = bflo(w.w); f[7] = bfhi(w.w); }
__device__ __forceinline__ void short_conv8(const bf16_t* hb, const float* cw, const float* cb, int s, int ch, float (&o)[8]) {
    float xm[8], x0[8], xp[8];
    if (s >= 1) load8(hb + (size_t)(s - 1) * 1536 + ch, xm); else {
#pragma unroll
        for (int i = 0; i < 8; ++i) xm[i] = 0.f; }
    load8(hb + (size_t)s * 1536 + ch, x0);
    if (s + 1 < LT) load8(hb + (size_t)(s + 1) * 1536 + ch, xp); else {
#pragma unroll
        for (int i = 0; i < 8; ++i) xp[i] = 0.f; }
#pragma unroll
    for (int i = 0; i < 8; ++i) o[i] = xm[i] * cw[ch + i] + x0[i] * cw[1536 + ch + i] + xp[i] * cw[3072 + ch + i] + cb[ch + i];
}
__device__ __forceinline__ void short_conv8v(const u32x4& rm, const u32x4& r0, const u32x4& rp, const float* cw, const float* cb, int ch, float (&o)[8]) {
    float xm[8], x0[8], xp[8]; unpack8(rm, xm); unpack8(r0, x0); unpack8(rp, xp);
    const f32x4 wa0 = *(const f32x4*)(cw + ch), wa1 = *(const f32x4*)(cw + ch + 4), wb0 = *(const f32x4*)(cw + 1536 + ch), wb1 = *(const f32x4*)(cw + 1536 + ch + 4);
    const f32x4 wc0 = *(const f32x4*)(cw + 3072 + ch), wc1 = *(const f32x4*)(cw + 3072 + ch + 4), bb0 = *(const f32x4*)(cb + ch), bb1 = *(const f32x4*)(cb + ch + 4);
#pragma unroll
    for (int i = 0; i < 4; ++i) { o[i] = xm[i] * wa0[i] + x0[i] * wb0[i] + xp[i] * wc0[i] + bb0[i]; o[4 + i] = xm[4 + i] * wa1[i] + x0[4 + i] * wb1[i] + xp[4 + i] * wc1[i] + bb1[i]; }
}
__device__ __forceinline__ void phase_hy_pre(const Args& a, LAS unsigned char* lds, int tid) {
    const int wave = tid >> 6, lane = tid & 63, gw = blockIdx.x * NWAVES + wave, NGW = gridDim.x * NWAVES, l8 = lane >> 3, l7 = lane & 7;
    LAS bf16_t* tl = (LAS bf16_t*)(lds + wave * (64 * 144));
    const bf16_t* hyin = (const bf16_t*)(a.ws + WS_HYIN); bf16_t* uut = (bf16_t*)(a.ws + WS_UUT); bf16_t* x0out = (bf16_t*)(a.ws + WS_YH);
    const float* cw = a.in[I_HYCW]; const float* cb = a.in[I_HYCB];
    for (int it = gw; it < NB * 67 * 8; it += NGW) {
        const int ct = it & 7, ts = (it >> 3) % 67, b = (it >> 3) / 67, c0 = ct * 64 + l7 * 8;
        const bf16_t* hb = hyin + (size_t)b * LT * 1536;
#pragma unroll 2
        for (int k = 0; k < 8; ++k) { const int sr = 8 * k + l8, s = ts * 64 + sr - 16;
            float uu[8];
            if (s >= 0 && s < LT) {
                const int sm = (s >= 1) ? s - 1 : s, sp = (s + 1 < LT) ? s + 1 : s; const bool zm = (s < 1), zp = (s + 1 >= LT);
                u32x4 r[3][3];
#pragma unroll
                for (int gI = 0; gI < 3; ++gI) { const bf16_t* p = hb + 512 * gI + c0;
                    r[gI][0] = *(const u32x4*)(p + (size_t)sm * 1536); r[gI][1] = *(const u32x4*)(p + (size_t)s * 1536); r[gI][2] = *(const u32x4*)(p + (size_t)sp * 1536);
                    if (zm) r[gI][0] = (u32x4){0u, 0u, 0u, 0u}; if (zp) r[gI][2] = (u32x4){0u, 0u, 0u, 0u}; }
                float x1[8], v[8]; short_conv8v(r[1][0], r[1][1], r[1][2], cw, cb, 512 + c0, x1); short_conv8v(r[2][0], r[2][1], r[2][2], cw, cb, 1024 + c0, v);
#pragma unroll
                for (int i = 0; i < 8; ++i) uu[i] = v[i] * x1[i];
                if (s >= NMETA) { float x0[8]; short_conv8v(r[0][0], r[0][1], r[0][2], cw, cb, c0, x0);
                    u32x4 w; w.x = pk2(x0[0], x0[1]); w.y = pk2(x0[2], x0[3]); w.z = pk2(x0[4], x0[5]); w.w = pk2(x0[6], x0[7]);
                    *(u32x4*)(x0out + ((size_t)b * SEQ + (s - NMETA)) * DHY + c0) = w; } }
            else {
#pragma unroll
                for (int i = 0; i < 8; ++i) uu[i] = 0.f; }
            u32x4 w; w.x = pk2(uu[0], uu[1]); w.y = pk2(uu[2], uu[3]); w.z = pk2(uu[4], uu[5]); w.w = pk2(uu[6], uu[7]);
            *(LAS u32x4*)(tl + sr * 72 + ((l7 ^ ((sr >> 3) & 7)) << 3)) = w; }
#pragma unroll
        for (int k = 0; k < 8; ++k) { const int cl = 8 * k + l8, sp0 = ts * 64 + l7 * 8;
            if (sp0 < SP) { unsigned h[8];
#pragma unroll
                for (int i = 0; i < 8; ++i) h[i] = tl[(l7 * 8 + i) * 72 + ((((cl >> 3) ^ l7) << 3) | (cl & 7))];
                u32x4 w; w.x = h[0] | (h[1] << 16); w.y = h[2] | (h[3] << 16); w.z = h[4] | (h[5] << 16); w.w = h[6] | (h[7] << 16);
                *(u32x4*)(uut + ((size_t)(ct * 64 + cl) * NB + b) * SP + sp0) = w; } }
    }
}
__device__ __forceinline__ void phase_hy_conv_naive(const Args& a, LAS unsigned char* lds, int tid) {
    LAS bf16_t* uus = (LAS bf16_t*)lds;
    LAS float* filt = (LAS float*)(lds + LT * 16);
    const bf16_t* uut = (const bf16_t*)(a.ws + WS_UUT); const float* kf = (const float*)(a.ws + WS_KF); bf16_t* cvt = (bf16_t*)(a.ws + WS_CONVT);
    for (int c = blockIdx.x; c < DHY; c += gridDim.x) {
        for (int i = tid; i < NB * LT; i += NTHR) { const int b = i / LT, s = i - b * LT; uus[s * 8 + b] = uut[((size_t)c * NB + b) * SP + 16 + s]; }
        for (int i = tid; i < KFW; i += NTHR) filt[i] = kf[(size_t)c * KFW + i];
        __syncthreads();
        for (int tt = 0; tt < 8; ++tt) { const int tq = tt * 512 + tid, t = tq + 16; float acc[8];
#pragma unroll
            for (int b = 0; b < 8; ++b) acc[b] = 0.f;
            const LAS float* fp = filt + (LT - 1) + t;
            for (int s = 0; s < LT; ++s) { const float kv = fp[-s]; const u32x4 w = *(const LAS u32x4*)(uus + s * 8);
                acc[0] += kv * bflo(w.x); acc[1] += kv * bfhi(w.x); acc[2] += kv * bflo(w.y); acc[3] += kv * bfhi(w.y);
                acc[4] += kv * bflo(w.z); acc[5] += kv * bfhi(w.z); acc[6] += kv * bflo(w.w); acc[7] += kv * bfhi(w.w); }
#pragma unroll
            for (int b = 0; b < 8; ++b) cvt[((size_t)c * NB + b) * SEQ + tq] = (bf16_t)f2bf(acc[b]); }
        __syncthreads();
    }
}
__device__ __forceinline__ void phase_rg_naive(const Args& a, LAS unsigned char* lds, int tid) {
    LAS float* xc = (LAS float*)lds;
    LAS float* gbuf = xc + 32 * 128;
    const bf16_t* rgx = (const bf16_t*)(a.ws + WS_RGX);
    for (int it = blockIdx.x; it < NB * 2 * 8; it += gridDim.x) {
        const int head = it & 7, dir = (it >> 3) & 1, b = it >> 4;
        const float* cw = a.in[I_RGCW] + (size_t)dir * 4 * DRG + head * 128; const float* cb = a.in[I_RGCB] + (size_t)dir * DRG + head * 128;
        bf16_t* hout = (bf16_t*)a.out + (size_t)dir * T * DRG;
        const bf16_t* xb = rgx + (size_t)b * LT * DRG + head * 128;
        float h = 0.f, sp = 0.f;
        if (tid < 128) { const float lam = a.in[I_RGLAM][dir * DRG + head * 128 + tid]; sp = log1pf(__expf(-lam)); }
        for (int k = 0; k < 129; ++k) {
            { const int tok = tid >> 4, cg = tid & 15, u = 32 * k + tok; float o[8];
#pragma unroll
                for (int i = 0; i < 8; ++i) o[i] = (u < LT) ? cb[cg * 8 + i] : 0.f;
                if (u < LT) {
#pragma unroll
                    for (int j = 0; j < 4; ++j) { const int uu = u - j; if (uu >= 0) { const int t = dir ? (LT - 1 - uu) : uu; float xv[8]; load8(xb + (size_t)t * DRG + cg * 8, xv);
#pragma unroll
                            for (int i = 0; i < 8; ++i) o[i] += xv[i] * cw[j * DRG + cg * 8 + i]; } } }
#pragma unroll
                for (int i = 0; i < 8; ++i) xc[tok * 128 + cg * 8 + i] = o[i]; }
            __syncthreads();
            { const int j = tid & 127, g = (tid >> 7) & 1, th = tid >> 8; float acc[16];
#pragma unroll
                for (int q = 0; q < 16; ++q) acc[q] = 0.f;
                const float* gw = a.in[I_RGGW] + ((size_t)((dir * 2 + g) * 8 + head) * 128) * 128 + j;
                for (int i = 0; i < 128; ++i) { const float wv = gw[i * 128];
#pragma unroll
                    for (int q = 0; q < 16; ++q) acc[q] += xc[(th * 16 + q) * 128 + i] * wv; }
                const float gb = a.in[I_RGGB][(size_t)(dir * 2 + g) * DRG + head * 128 + j];
#pragma unroll
                for (int q = 0; q < 16; ++q) gbuf[(g * 32 + th * 16 + q) * 128 + j] = acc[q] + gb; }
            __syncthreads();
            if (tid < 128) {
                for (int tok = 0; tok < 32; ++tok) { const int u = 32 * k + tok; if (u >= LT) break;
                    const float r = sigmoidf_(gbuf[tok * 128 + tid]), ig = sigmoidf_(gbuf[(32 + tok) * 128 + tid]);
                    const float la = -8.0f * r * sp; const float av = __expf(la); const float mult = (u == 0) ? 1.0f : sqrtf(-expm1f(2.0f * la));
                    h = av * h + mult * ig * xc[tok * 128 + tid];
                    const int t = dir ? (LT - 1 - u) : u;
                    if (t >= NMETA) hout[((size_t)b * SEQ + (t - NMETA)) * DRG + head * 128 + tid] = (bf16_t)f2bf(h); } }
            __syncthreads();
        }
    }
}
__device__ __forceinline__ void phase_post(const Args& a, LAS unsigned char* lds, int tid) {
    const int wave = tid >> 6, lane = tid & 63, gw = blockIdx.x * NWAVES + wave, NGW = gridDim.x * NWAVES;
    LAS bf16_t* cv = (LAS bf16_t*)(lds + wave * (64 * 144));
    const bf16_t* cvt = (const bf16_t*)(a.ws + WS_CONVT); bf16_t* yh = (bf16_t*)(a.ws + WS_YH);
    const int l8 = lane >> 3, l7 = lane & 7;
    for (int it = gw; it < NB * 64 * 8; it += NGW) {
        const int ct = it & 7, tt = (it >> 3) & 63, b = it >> 9;
        u32x4 cw_[8], xw[8];
#pragma unroll
        for (int k = 0; k < 8; ++k) cw_[k] = *(const u32x4*)(cvt + ((size_t)(ct * 64 + 8 * k + l8) * NB + b) * SEQ + tt * 64 + l7 * 8);
        bf16_t* yp = yh + ((size_t)b * SEQ + tt * 64 + l8) * DHY + ct * 64 + l7 * 8;
#pragma unroll
        for (int k = 0; k < 8; ++k) xw[k] = *(const u32x4*)(yp + (size_t)(8 * k) * DHY);
#pragma unroll
        for (int k = 0; k < 8; ++k) *(LAS u32x4*)(cv + (8 * k + l8) * 72 + ((l7 ^ k) << 3)) = cw_[k];
#pragma unroll
        for (int k = 0; k < 8; ++k) { const int tr = 8 * k + l8; float x0[8], y[8]; unpack8(xw[k], x0);
#pragma unroll
            for (int i = 0; i < 8; ++i) y[i] = bf2f(cv[(l7 * 8 + i) * 72 + (((k ^ l7) << 3) | l8)]) * x0[i];
            u32x4 w; w.x = pk2(y[0], y[1]); w.y = pk2(y[2], y[3]); w.z = pk2(y[4], y[5]); w.w = pk2(y[6], y[7]);
            *(u32x4*)(yp + (size_t)(8 * k) * DHY) = w; }
    }
    const bf16_t* hf = (const bf16_t*)a.out; const bf16_t* hb2 = hf + (size_t)T * DRG; const bf16_t* gg = (const bf16_t*)(a.ws + WS_GG); bf16_t* yr = (bf16_t*)(a.ws + WS_YR);
    const bf16_t* rgp = (const bf16_t*)(a.ws + WS_RGP); const float* rgc = (const float*)(a.ws + WS_RGC);
    for (size_t i = (size_t)blockIdx.x * NTHR + tid; i < (size_t)T * DRG / 8; i += (size_t)gridDim.x * NTHR) {
        const int c8 = (int)(i & 127) * 8, m = (int)(i >> 7), b = m >> 12, t = (m & 4095) + NMETA;
        float f[8], g[8], q[8]; load8(hf + i * 8, f); load8(hb2 + i * 8, g); load8(gg + i * 8, q);
        if (t >= RG_U1) { float p[8]; load8(rgp + ((size_t)(0 * NB + b) * RG_NF + (t - RG_U1)) * DRG + c8, p); const float* cc = rgc + (size_t)(0 * NB + b) * DRG + c8;
#pragma unroll
            for (int j = 0; j < 8; ++j) f[j] += p[j] * cc[j]; }
        const int ub = LT - 1 - t;
        if (ub >= RG_U1) { float p[8]; load8(rgp + ((size_t)(1 * NB + b) * RG_NF + (ub - RG_U1)) * DRG + c8, p); const float* cc = rgc + (size_t)(1 * NB + b) * DRG + c8;
#pragma unroll
            for (int j = 0; j < 8; ++j) g[j] += p[j] * cc[j]; }
        u32x4 w; w.x = pk2((f[0] + g[0]) * q[0], (f[1] + g[1]) * q[1]); w.y = pk2((f[2] + g[2]) * q[2], (f[3] + g[3]) * q[3]);
        w.z = pk2((f[4] + g[4]) * q[4], (f[5] + g[5]) * q[5]); w.w = pk2((f[6] + g[6]) * q[6], (f[7] + g[7]) * q[7]);
        *(u32x4*)(yr + i * 8) = w; }
}
__device__ __forceinline__ u32x4 quant_row16(const f32x4 (&v)[4], float amax, float& deq) {
    const float sc = (amax > 0.f) ? 256.0f / amax : 1.0f; deq = (amax > 0.f) ? amax * (1.0f / 256.0f) : 1.0f;
    u32x4 w; int t;
    t = __builtin_amdgcn_cvt_pk_fp8_f32(v[0].x * sc, v[0].y * sc, 0, false); t = __builtin_amdgcn_cvt_pk_fp8_f32(v[0].z * sc, v[0].w * sc, t, true); w.x = (unsigned)t;
    t = __builtin_amdgcn_cvt_pk_fp8_f32(v[1].x * sc, v[1].y * sc, 0, false); t = __builtin_amdgcn_cvt_pk_fp8_f32(v[1].z * sc, v[1].w * sc, t, true); w.y = (unsigned)t;
    t = __builtin_amdgcn_cvt_pk_fp8_f32(v[2].x * sc, v[2].y * sc, 0, false); t = __builtin_amdgcn_cvt_pk_fp8_f32(v[2].z * sc, v[2].w * sc, t, true); w.z = (unsigned)t;
    t = __builtin_amdgcn_cvt_pk_fp8_f32(v[3].x * sc, v[3].y * sc, 0, false); t = __builtin_amdgcn_cvt_pk_fp8_f32(v[3].z * sc, v[3].w * sc, t, true); w.w = (unsigned)t;
    return w;
}
__device__ __forceinline__ unsigned q8x4(f32x4 v, float sc) {
    const int a = (int)rintf(v.x * sc), b = (int)rintf(v.y * sc), c = (int)rintf(v.z * sc), d = (int)rintf(v.w * sc);
    return ((unsigned)a & 0xffu) | (((unsigned)b & 0xffu) << 8) | (((unsigned)c & 0xffu) << 16) | ((unsigned)d << 24);
}
__device__ __forceinline__ void phase_tables(const Args& a, int wave, int lane) {
    const int gw = blockIdx.x * NWAVES + wave, NGW = gridDim.x * NWAVES;
    const float* gf = a.in[I_GFFN] + 16 * lane; unsigned char* uq = a.ws + WS_UB; unsigned char* vq = a.ws + WS_VB; float* su = (float*)(a.ws + WS_SU); float* sv = (float*)(a.ws + WS_SV);
    f32x4 g[4];
#pragma unroll
    for (int j = 0; j < 4; ++j) g[j] = *(const f32x4*)(gf + 4 * j);
    for (int e = gw; e < NEXP; e += NGW) {
        const float* ur = a.in[I_PU] + (size_t)e * DM + 16 * lane; const float* vr = a.in[I_PV] + (size_t)e * DM + 16 * lane;
        f32x4 u[4], v[4]; float mu = 0.f, mv = 0.f;
#pragma unroll
        for (int j = 0; j < 4; ++j) { u[j] = NT_LD((const f32x4*)(ur + 4 * j)) * g[j]; v[j] = NT_LD((const f32x4*)(vr + 4 * j));
            mu = fmaxf(mu, fmaxf(fmaxf(fabsf(u[j].x), fabsf(u[j].y)), fmaxf(fabsf(u[j].z), fabsf(u[j].w))));
            mv = fmaxf(mv, fmaxf(fmaxf(fabsf(v[j].x), fabsf(v[j].y)), fmaxf(fabsf(v[j].z), fabsf(v[j].w)))); }
        mu = wave_max_dpp(mu); mv = wave_max_dpp(mv);
        const float scu = (mu > 0.f) ? 127.0f / mu : 1.0f, du = (mu > 0.f) ? mu * (1.0f / 127.0f) : 1.0f;
        u32x4 qu; qu.x = q8x4(u[0], scu); qu.y = q8x4(u[1], scu); qu.z = q8x4(u[2], scu); qu.w = q8x4(u[3], scu);
        const float scv = (mv > 0.f) ? 127.0f / mv : 1.0f, dv = (mv > 0.f) ? mv * (1.0f / 127.0f) : 1.0f;
        u32x4 qv; qv.x = q8x4(v[0], scv); qv.y = q8x4(v[1], scv); qv.z = q8x4(v[2], scv); qv.w = q8x4(v[3], scv);
        { const size_t so = ((size_t)(lane >> 3) * NEXP + e) * 128 + 16 * (lane & 7); *(u32x4*)(uq + so) = qu; *(u32x4*)(vq + so) = qv; }
        if (lane == 0) { su[e] = du; sv[e] = dv; }
    }
}
__device__ __forceinline__ void ce_desc(float& a, float& b) { const float hi = fmaxf(a, b), lo = fminf(a, b); a = hi; b = lo; }
__device__ __forceinline__ void sort16_desc(float (&x)[16]) {
#pragma unroll
    for (int k = 2; k <= 16; k <<= 1)
#pragma unroll
        for (int j = k >> 1; j > 0; j >>= 1)
#pragma unroll
            for (int i = 0; i < 16; ++i) { const int l = i ^ j; if (l > i) { if ((i & k) == 0) ce_desc(x[i], x[l]); else ce_desc(x[l], x[i]); } }
}
__device__ __forceinline__ void merge_top16(float (&L)[16], const float (&X)[16]) {
#pragma unroll
    for (int i = 0; i < 16; ++i) L[i] = fmaxf(L[i], X[15 - i]);
#pragma unroll
    for (int j = 8; j > 0; j >>= 1)
#pragma unroll
        for (int i = 0; i < 16; ++i) { const int l = i ^ j; if (l > i) ce_desc(L[i], L[l]); }
}
__device__ __forceinline__ void top16_of_128(const _Float16* base  , float (&L)[16]) {
    typedef _Float16 h8 __attribute__((ext_vector_type(8)));
    h8 v0 = *(const h8*)(base), v1 = *(const h8*)(base + 512);
#pragma unroll 1
    for (int ch = 0; ch < 8; ++ch) { float X[16]; const int cn = (ch < 7) ? ch + 1 : 7;
        const h8 n0 = *(const h8*)(base + (2 * cn) * 512), n1 = *(const h8*)(base + (2 * cn + 1) * 512);
#pragma unroll
        for (int i = 0; i < 8; ++i) { X[i] = __uint_as_float((__float_as_uint((float)v0[i]) & ~0x7Fu) | (unsigned)(ch * 16 + i));
            X[8 + i] = __uint_as_float((__float_as_uint((float)v1[i]) & ~0x7Fu) | (unsigned)(ch * 16 + 8 + i)); }
        sort16_desc(X);
        if (ch == 0) {
#pragma unroll
            for (int i = 0; i < 16; ++i) L[i] = X[i]; }
        else merge_top16(L, X);
        v0 = n0; v1 = n1; }
}
struct CandTab { int ci[64], cj[64]; };
__host__ __device__ constexpr CandTab make_cand() { CandTab t{}; int n = 0; for (int i = 0; i < 16; ++i) for (int j = 0; j < 16; ++j) if ((i + 1) * (j + 1) <= 16) { t.ci[n] = i; t.cj[n] = j; ++n; }
    for (; n < 64; ++n) { t.ci[n] = -1; t.cj[n] = -1; } return t; }
__device__ __forceinline__ void phase_topk(const Args& a, LAS unsigned char* lds, const pg8::StaticOrder& S, int wave, int lane) {
    constexpr CandTab CT = make_cand();
    const _Float16* st = (const _Float16*)(a.ws + WS_SCORES); int* eidx = (int*)(a.ws + WS_EIDX); float* eg = (float*)(a.ws + WS_EG);
    LAS unsigned char* tab = lds + wave * (64 * 36) + lane * 36;
    for (int j = wave; ; j += NWAVES) { pg8::Unit un; if (!S.next(j >> 2, un)) break; const int tg = 4 * un.pm + (j & 3), hh = un.pn; const int m = tg * 64 + lane;
        float A[16], B[16];
        top16_of_128(st + (size_t)((tg * 8 + hh) * 2 + 0) * 128 * 64 + lane * 8, A);
        top16_of_128(st + (size_t)((tg * 8 + hh) * 2 + 1) * 128 * 64 + lane * 8, B);
#pragma unroll
        for (int q = 0; q < 4; ++q) {
            const unsigned wa = (__float_as_uint(A[4 * q]) & 0x7Fu) | ((__float_as_uint(A[4 * q + 1]) & 0x7Fu) << 8) | ((__float_as_uint(A[4 * q + 2]) & 0x7Fu) << 16) | ((__float_as_uint(A[4 * q + 3]) & 0x7Fu) << 24);
            const unsigned wb = (__float_as_uint(B[4 * q]) & 0x7Fu) | ((__float_as_uint(B[4 * q + 1]) & 0x7Fu) << 8) | ((__float_as_uint(B[4 * q + 2]) & 0x7Fu) << 16) | ((__float_as_uint(B[4 * q + 3]) & 0x7Fu) << 24);
            *(LAS unsigned*)(tab + 4 * q) = wa; *(LAS unsigned*)(tab + 16 + 4 * q) = wb; }
#pragma unroll
        for (int i = 0; i < 16; ++i) { A[i] = __uint_as_float(__float_as_uint(A[i]) & ~0x7Fu); B[i] = __uint_as_float(__float_as_uint(B[i]) & ~0x7Fu); }
        float K[16];
#pragma unroll
        for (int c0 = 0; c0 < 64; c0 += 16) { float X[16];
#pragma unroll
            for (int i = 0; i < 16; ++i) { const int c = c0 + i;
                if (CT.ci[c] >= 0) X[i] = __uint_as_float((__float_as_uint(A[CT.ci[c] < 0 ? 0 : CT.ci[c]] + B[CT.cj[c] < 0 ? 0 : CT.cj[c]]) & ~0xFFu) | (unsigned)(CT.ci[c] * 16 + CT.cj[c]));
                else X[i] = -INFINITY; }
            sort16_desc(X);
            if (c0 == 0) {
#pragma unroll
                for (int i = 0; i < 16; ++i) K[i] = X[i]; }
            else merge_top16(K, X); }
        asm volatile("s_waitcnt lgkmcnt(0)" ::: "memory");
        int ex_[16]; float cs[16]; float sum = 0.f;
#pragma unroll
        for (int r = 0; r < 16; ++r) { const unsigned kb = __float_as_uint(K[r]); const int id = kb & 0xFF; cs[r] = __expf(__uint_as_float(kb & ~0xFFu) - __uint_as_float(__float_as_uint(K[0]) & ~0xFFu)); sum += cs[r];
            ex_[r] = (int)tab[id >> 4] * 128 + (int)tab[16 + (id & 15)]; }
        const float inv = 1.0f / sum;
        unsigned short* ep = (unsigned short*)eidx + (size_t)m * 128 + hh * 16; float* gp = eg + (size_t)m * 128 + hh * 16;
        { u32x4 p0, p1; p0.x = ex_[0] | (ex_[1] << 16); p0.y = ex_[2] | (ex_[3] << 16); p0.z = ex_[4] | (ex_[5] << 16); p0.w = ex_[6] | (ex_[7] << 16);
          p1.x = ex_[8] | (ex_[9] << 16); p1.y = ex_[10] | (ex_[11] << 16); p1.z = ex_[12] | (ex_[13] << 16); p1.w = ex_[14] | (ex_[15] << 16); *(u32x4*)ep = p0; *(u32x4*)(ep + 8) = p1; }
#pragma unroll
        for (int q = 0; q < 4; ++q) {
            *(f32x4*)(gp + 4 * q) = (f32x4){cs[4 * q] * inv, cs[4 * q + 1] * inv, cs[4 * q + 2] * inv, cs[4 * q + 3] * inv}; }
    }
}
__device__ __forceinline__ void fp8x16_to_f32(const u32x4 w, float (&f)[16]) {
    f32x2v t;
    t = __builtin_amdgcn_cvt_pk_f32_fp8((int)w.x, false); f[0] = t.x; f[1] = t.y; t = __builtin_amdgcn_cvt_pk_f32_fp8((int)w.x, true); f[2] = t.x; f[3] = t.y;
    t = __builtin_amdgcn_cvt_pk_f32_fp8((int)w.y, false); f[4] = t.x; f[5] = t.y; t = __builtin_amdgcn_cvt_pk_f32_fp8((int)w.y, true); f[6] = t.x; f[7] = t.y;
    t = __builtin_amdgcn_cvt_pk_f32_fp8((int)w.z, false); f[8] = t.x; f[9] = t.y; t = __builtin_amdgcn_cvt_pk_f32_fp8((int)w.z, true); f[10] = t.x; f[11] = t.y;
    t = __builtin_amdgcn_cvt_pk_f32_fp8((int)w.w, false); f[12] = t.x; f[13] = t.y; t = __builtin_amdgcn_cvt_pk_f32_fp8((int)w.w, true); f[14] = t.x; f[15] = t.y;
}
__device__ __forceinline__ void fp8x16_to_f32x2(const u32x4 w, f32x2v (&f)[8]) {
    f[0] = __builtin_amdgcn_cvt_pk_f32_fp8((int)w.x, false); f[1] = __builtin_amdgcn_cvt_pk_f32_fp8((int)(w.x >> 16), false);
    f[2] = __builtin_amdgcn_cvt_pk_f32_fp8((int)w.y, false); f[3] = __builtin_amdgcn_cvt_pk_f32_fp8((int)(w.y >> 16), false);
    f[4] = __builtin_amdgcn_cvt_pk_f32_fp8((int)w.z, false); f[5] = __builtin_amdgcn_cvt_pk_f32_fp8((int)(w.z >> 16), false);
    f[6] = __builtin_amdgcn_cvt_pk_f32_fp8((int)w.w, false); f[7] = __builtin_amdgcn_cvt_pk_f32_fp8((int)(w.w >> 16), false);
}
__device__ __forceinline__ float dpp_sum8(float v) {
    v += __int_as_float(__builtin_amdgcn_update_dpp(0, __float_as_int(v), 0xB1, 0xF, 0xF, true));
    v += __int_as_float(__builtin_amdgcn_update_dpp(0, __float_as_int(v), 0x4E, 0xF, 0xF, true));
    v += __int_as_float(__builtin_amdgcn_update_dpp(0, __float_as_int(v), 0x141, 0xF, 0xF, true));
    return v;
}
struct UTok { u32x4 e0, e1, xa, xb; };
struct VTok { u32x4 e0, e1; f32x4 av[4]; };
__device__ __forceinline__ void pu_issue(const unsigned char* tab, unsigned loff, const u32x4& e, u32x4 (&w)[8]) {
    w[0] = *(const u32x4*)(tab + ((e.x & 0xffffu) * 128u + loff)); w[1] = *(const u32x4*)(tab + ((e.x >> 16) * 128u + loff));
    w[2] = *(const u32x4*)(tab + ((e.y & 0xffffu) * 128u + loff)); w[3] = *(const u32x4*)(tab + ((e.y >> 16) * 128u + loff));
    w[4] = *(const u32x4*)(tab + ((e.z & 0xffffu) * 128u + loff)); w[5] = *(const u32x4*)(tab + ((e.z >> 16) * 128u + loff));
    w[6] = *(const u32x4*)(tab + ((e.w & 0xffffu) * 128u + loff)); w[7] = *(const u32x4*)(tab + ((e.w >> 16) * 128u + loff));
}
__device__ __forceinline__ void pu_dots(const int (&xq)[4], const u32x4 (&w)[8], int (&d)[8]) {
#pragma unroll
    for (int q = 0; q < 8; ++q) { int t = __builtin_amdgcn_sdot4((int)w[q].x, xq[0], 0, false); t = __builtin_amdgcn_sdot4((int)w[q].y, xq[1], t, false);
        t = __builtin_amdgcn_sdot4((int)w[q].z, xq[2], t, false); d[q] = __builtin_amdgcn_sdot4((int)w[q].w, xq[3], t, false); }
}
__device__ __forceinline__ void pu_reduce(const int (&d0)[8], const int (&d1)[8], int lane, int& lo, int& hi) {
    const bool b2 = (lane & 4) != 0, b1 = (lane & 2) != 0, b0 = (lane & 1) != 0;
    int a[8];
#pragma unroll
    for (int q = 0; q < 4; ++q) { const int s0 = b2 ? d0[q] : d0[4 + q], k0 = b2 ? d0[4 + q] : d0[q], s1 = b2 ? d1[q] : d1[4 + q], k1 = b2 ? d1[4 + q] : d1[q];
        a[q] = k0 + __builtin_amdgcn_update_dpp(0, s0, 0x141, 0xF, 0xF, true); a[4 + q] = k1 + __builtin_amdgcn_update_dpp(0, s1, 0x141, 0xF, 0xF, true); }
    int bq[4];
#pragma unroll
    for (int q = 0; q < 2; ++q) { const int s0 = b1 ? a[q] : a[2 + q], k0 = b1 ? a[2 + q] : a[q], s1 = b1 ? a[4 + q] : a[6 + q], k1 = b1 ? a[6 + q] : a[4 + q];
        bq[q] = k0 + __builtin_amdgcn_update_dpp(0, s0, 0x4E, 0xF, 0xF, true); bq[2 + q] = k1 + __builtin_amdgcn_update_dpp(0, s1, 0x4E, 0xF, 0xF, true); }
    { const int s0 = b0 ? bq[0] : bq[1], k0 = b0 ? bq[1] : bq[0], s1 = b0 ? bq[2] : bq[3], k1 = b0 ? bq[3] : bq[2];
        lo = k0 + __builtin_amdgcn_update_dpp(0, s0, 0xB1, 0xF, 0xF, true); hi = k1 + __builtin_amdgcn_update_dpp(0, s1, 0xB1, 0xF, 0xF, true); }
}
__device__ __forceinline__ float pu_quant_x(const u32x4& xa, const u32x4& xb, int (&xq)[4]) {
    float f[16]; unpack8(xa, *(float(*)[8])&f[0]); unpack8(xb, *(float(*)[8])&f[8]);
    float mx = 0.f;
#pragma unroll
    for (int c = 0; c < 16; ++c) mx = fmaxf(mx, fabsf(f[c]));
    mx = fmaxf(mx, __int_as_float(__builtin_amdgcn_update_dpp(0, __float_as_int(mx), 0xB1, 0xF, 0xF, true)));
    mx = fmaxf(mx, __int_as_float(__builtin_amdgcn_update_dpp(0, __float_as_int(mx), 0x4E, 0xF, 0xF, true)));
    mx = fmaxf(mx, __int_as_float(__builtin_amdgcn_update_dpp(0, __float_as_int(mx), 0x141, 0xF, 0xF, true)));
    const float sc = (mx > 0.f) ? 127.0f * __builtin_amdgcn_rcpf(mx) * 0.99999f : 0.f;
#pragma unroll
    for (int c4 = 0; c4 < 4; ++c4) xq[c4] = (int)q8x4((f32x4){f[4 * c4], f[4 * c4 + 1], f[4 * c4 + 2], f[4 * c4 + 3]}, sc);
    return mx * (1.0f / 127.0f);
}
__device__ __forceinline__ void phase_peer_u(const Args& a, int wave, int lane) {
    const int s = SLICE_OF(blockIdx.x), rk = RANK_OF(blockIdx.x), nrk = gridDim.x >> 3, tper = T / nrk, i = lane & 7, j = lane >> 3;
    const bf16_t* h1b = (const bf16_t*)(a.ws + WS_H1B) + 128 * s + 16 * i; const unsigned char* uqs = a.ws + WS_UB + (size_t)s * NEXP * 128; const unsigned loff = 16u * (unsigned)i;
    const unsigned short* eidx = (const unsigned short*)(a.ws + WS_EIDX) + 16 * j; float* pd = (float*)(a.ws + WS_PD) + (size_t)s * T * 128 + 16 * j + i;
    const int m0 = rk * tper + wave, mlast = (rk + 1) * tper - NWAVES + wave;
#define PU_LOAD(t, mm) do { const int m_ = (mm) < mlast ? (mm) : mlast; const u32x4* ep_ = (const u32x4*)(eidx + (size_t)m_ * 128); (t).e0 = ep_[0]; (t).e1 = ep_[1]; \
        (t).xa = *(const u32x4*)(h1b + (size_t)m_ * DM); (t).xb = *(const u32x4*)(h1b + (size_t)m_ * DM + 8); } while (0)
#define PU_DO(t, w0, w1, mm) do { int xq_[4]; const float sx_ = pu_quant_x((t).xa, (t).xb, xq_); int d0_[8], d1_[8], lo_, hi_; pu_dots(xq_, w0, d0_); pu_dots(xq_, w1, d1_); \
        pu_reduce(d0_, d1_, lane, lo_, hi_); pd[(size_t)(mm) * 128] = (float)lo_ * sx_; pd[(size_t)(mm) * 128 + 8] = (float)hi_ * sx_; } while (0)
    UTok tC, tN, tNN; u32x4 wA[8], wB[8], wC[8], wD[8];
    PU_LOAD(tC, m0); PU_LOAD(tN, m0 + NWAVES); PU_LOAD(tNN, m0 + 2 * NWAVES); pu_issue(uqs, loff, tC.e0, wA); pu_issue(uqs, loff, tC.e1, wB);
    for (int m = m0; m <= mlast; m += 2 * NWAVES) {
        pu_issue(uqs, loff, tN.e0, wC); pu_issue(uqs, loff, tN.e1, wD);
        PU_DO(tC, wA, wB, m);
        tC = tN; tN = tNN; PU_LOAD(tNN, m + 3 * NWAVES);
        pu_issue(uqs, loff, tN.e0, wA); pu_issue(uqs, loff, tN.e1, wB);
        PU_DO(tC, wC, wD, m + NWAVES);
        tC = tN; tN = tNN; PU_LOAD(tNN, m + 4 * NWAVES);
    }
#undef PU_LOAD
#undef PU_DO
}
typedef long i64_t;
__device__ __forceinline__ i64_t pack64(unsigned lo, unsigned hi) { return (i64_t)(((unsigned long long)hi << 32) | (unsigned long long)lo); }
struct MTokI { u32x4 ia, ib; };
struct MTokX { u32x4 xq[4]; };
__device__ __forceinline__ unsigned id16(const u32x4& v, int c) { const unsigned wv = (c >> 1) == 0 ? v.x : (c >> 1) == 1 ? v.y : (c >> 1) == 2 ? v.z : v.w; return (c & 1) ? (wv >> 16) : (wv & 0xffffu); }
__device__ __forceinline__ void pm_issue(const unsigned char* tab, unsigned loff, const MTokI& t, u32x4 (&W)[16]) {
#pragma unroll
    for (int c = 0; c < 8; ++c) { W[2 * c] = *(const u32x4*)(tab + (id16(t.ia, c) * 128u + loff)); W[2 * c + 1] = *(const u32x4*)(tab + (id16(t.ib, c) * 128u + loff)); }
}
template <bool HI> __device__ __forceinline__ unsigned bf2_to_fp8x2(unsigned w, int old) { const float a = fminf(fmaxf(bflo(w), -448.f), 448.f), b = fminf(fmaxf(bfhi(w), -448.f), 448.f); return (unsigned)__builtin_amdgcn_cvt_pk_fp8_f32(a, b, old, HI); }
__device__ __forceinline__ void pm_compute(const MTokX& t, const u32x4 (&W)[16], LAS unsigned char* wl  , float* pdrow  , int lane) {
    unsigned xb[8];
#pragma unroll
    for (int q = 0; q < 4; ++q) { unsigned lo = bf2_to_fp8x2<false>(t.xq[q].x, 0); lo = bf2_to_fp8x2<true>(t.xq[q].y, (int)lo); unsigned hi = bf2_to_fp8x2<false>(t.xq[q].z, 0); hi = bf2_to_fp8x2<true>(t.xq[q].w, (int)hi); xb[2 * q] = lo; xb[2 * q + 1] = hi; }
    const i64_t B0 = pack64(xb[0], xb[1]), B1 = pack64(xb[2], xb[3]), B2 = pack64(xb[4], xb[5]), B3 = pack64(xb[6], xb[7]);
    const int j8 = lane >> 3, i = lane & 7, r = lane & 15, g = lane >> 4;
    LAS unsigned char* wr0 = wl + j8 * 144 + i * 16;
    const LAS unsigned char* rd0 = wl + r * 144 + g * 32;
    f32x4 C[8];
#pragma unroll
    for (int c = 0; c < 8; ++c) { const int bo = (c & 1) * 2304;
        *(LAS u32x4*)(wr0 + bo) = W[2 * c]; *(LAS u32x4*)(wr0 + bo + 8 * 144) = W[2 * c + 1];
        const u32x4 a0 = *(const LAS u32x4*)(rd0 + bo), a1 = *(const LAS u32x4*)(rd0 + bo + 16);
        f32x4 acc = (f32x4){0.f, 0.f, 0.f, 0.f};
        acc = __builtin_amdgcn_mfma_f32_16x16x32_fp8_fp8(pack64(a0.x, a0.y), B0, acc, 0, 0, 0);
        acc = __builtin_amdgcn_mfma_f32_16x16x32_fp8_fp8(pack64(a0.z, a0.w), B1, acc, 0, 0, 0);
        acc = __builtin_amdgcn_mfma_f32_16x16x32_fp8_fp8(pack64(a1.x, a1.y), B2, acc, 0, 0, 0);
        acc = __builtin_amdgcn_mfma_f32_16x16x32_fp8_fp8(pack64(a1.z, a1.w), B3, acc, 0, 0, 0); C[c] = acc; }
    if ((lane & 15) == 0) {
#pragma unroll
        for (int reg = 0; reg < 4; ++reg) { *(f32x4*)(pdrow + 8 * reg) = (f32x4){C[0][reg], C[1][reg], C[2][reg], C[3][reg]}; *(f32x4*)(pdrow + 8 * reg + 4) = (f32x4){C[4][reg], C[5][reg], C[6][reg], C[7][reg]}; } }
}
__device__ __forceinline__ void phase_peer_u_mfma(const Args& a, LAS unsigned char* lds, int wave, int lane) {
    const int s = SLICE_OF(blockIdx.x), rk = RANK_OF(blockIdx.x), nrk = gridDim.x >> 3, tper = T / nrk, g = lane >> 4, j8 = lane >> 3;
    const bf16_t* h1b = (const bf16_t*)(a.ws + WS_H1B) + 128 * s + 32 * g; const unsigned char* uqs = a.ws + WS_UB + (size_t)s * NEXP * 128; const unsigned loff = 16u * (unsigned)(lane & 7);
    const unsigned short* eidx = (const unsigned short*)(a.ws + WS_EIDX) + 8 * j8; float* pd = (float*)(a.ws + WS_PD) + (size_t)s * T * 128 + 32 * g;
    LAS unsigned char* wl = lds + wave * 4608;
    const int m0 = rk * tper + wave, mlast = (rk + 1) * tper - NWAVES + wave;
#define PM_LOADI(t, mm) do { const int m_ = (mm) < mlast ? (mm) : mlast; (t).ia = *(const u32x4*)(eidx + (size_t)m_ * 128); (t).ib = *(const u32x4*)(eidx + (size_t)m_ * 128 + 64); } while (0)
#define PM_LOADX(t, mm) do { const int m_ = (mm) < mlast ? (mm) : mlast; const u32x4* xp_ = (const u32x4*)(h1b + (size_t)m_ * DM); (t).xq[0] = xp_[0]; (t).xq[1] = xp_[1]; (t).xq[2] = xp_[2]; (t).xq[3] = xp_[3]; } while (0)
    MTokI iC, iN, iNN; MTokX xC, xN; u32x4 WA[16], WB[16];
    PM_LOADI(iC, m0); PM_LOADI(iN, m0 + NWAVES); PM_LOADI(iNN, m0 + 2 * NWAVES); PM_LOADX(xC, m0); PM_LOADX(xN, m0 + NWAVES); pm_issue(uqs, loff, iC, WA);
    for (int m = m0; m <= mlast; m += 2 * NWAVES) {
        pm_issue(uqs, loff, iN, WB);
        pm_compute(xC, WA, wl, pd + (size_t)m * 128, lane);
        iC = iN; iN = iNN; PM_LOADI(iNN, m + 3 * NWAVES); xC = xN; PM_LOADX(xN, m + 2 * NWAVES);
        pm_issue(uqs, loff, iN, WA);
        pm_compute(xC, WB, wl, pd + (size_t)(m + NWAVES) * 128, lane);
        iC = iN; iN = iNN; PM_LOADI(iNN, m + 4 * NWAVES); xC = xN; PM_LOADX(xN, m + 3 * NWAVES);
    }
#undef PM_LOADI
#undef PM_LOADX
}
__device__ __forceinline__ void phase_peer_act(const Args& a, int tid) {
    const float* pd = (const float*)(a.ws + WS_PD); const unsigned short* eidx = (const unsigned short*)(a.ws + WS_EIDX); const float* eg = (const float*)(a.ws + WS_EG);
    const float* su = (const float*)(a.ws + WS_SU); const float* sv = (const float*)(a.ws + WS_SV); const float* rowss = (const float*)(a.ws + WS_ROWSS); float* act = (float*)(a.ws + WS_ACT);
    for (size_t i4 = (size_t)blockIdx.x * NTHR + tid; i4 < (size_t)T * 32; i4 += (size_t)gridDim.x * NTHR) { const size_t idx = i4 * 4;
        f32x4 d = *(const f32x4*)(pd + idx);
#pragma unroll
        for (int s = 1; s < 8; ++s) d += *(const f32x4*)(pd + (size_t)s * T * 128 + idx);
        const u32x2 ew = *(const u32x2*)(eidx + idx); const f32x4 g = *(const f32x4*)(eg + idx); const float rstd = rsqrtf(rowss[idx >> 7] * (1.f / DM) + EPSF);
        const unsigned e0 = ew.x & 0xffffu, e1 = ew.x >> 16, e2 = ew.y & 0xffffu, e3 = ew.y >> 16;
        f32x4 o; o.x = gelu_tanh(d.x * su[e0] * rstd) * g.x * sv[e0]; o.y = gelu_tanh(d.y * su[e1] * rstd) * g.y * sv[e1];
        o.z = gelu_tanh(d.z * su[e2] * rstd) * g.z * sv[e2]; o.w = gelu_tanh(d.w * su[e3] * rstd) * g.w * sv[e3];
        *(f32x4*)(act + idx) = o;
    }
}
__device__ __forceinline__ void pv_quad(const u32x4& w0, const u32x4& w1, const u32x4& w2, const u32x4& w3, int a4, int (&oi)[16]) {
#define PV_BLK(d, base) do { const unsigned lo01 = __builtin_amdgcn_perm(w1.d, w0.d, 0x05010400u), hi01 = __builtin_amdgcn_perm(w1.d, w0.d, 0x07030602u); \
        const unsigned lo23 = __builtin_amdgcn_perm(w3.d, w2.d, 0x05010400u), hi23 = __builtin_amdgcn_perm(w3.d, w2.d, 0x07030602u); \
        oi[base + 0] = __builtin_amdgcn_sdot4((int)__builtin_amdgcn_perm(lo23, lo01, 0x05040100u), a4, oi[base + 0], false); \
        oi[base + 1] = __builtin_amdgcn_sdot4((int)__builtin_amdgcn_perm(lo23, lo01, 0x07060302u), a4, oi[base + 1], false); \
        oi[base + 2] = __builtin_amdgcn_sdot4((int)__builtin_amdgcn_perm(hi23, hi01, 0x05040100u), a4, oi[base + 2], false); \
        oi[base + 3] = __builtin_amdgcn_sdot4((int)__builtin_amdgcn_perm(hi23, hi01, 0x07060302u), a4, oi[base + 3], false); } while (0)
    PV_BLK(x, 0); PV_BLK(y, 4); PV_BLK(z, 8); PV_BLK(w, 12);
#undef PV_BLK
}
__device__ __forceinline__ float pv_quant_act(const f32x4 (&av)[4], int (&a4)[4]) {
    float mx = 0.f;
#pragma unroll
    for (int q = 0; q < 4; ++q) mx = fmaxf(mx, fmaxf(fmaxf(fabsf(av[q].x), fabsf(av[q].y)), fmaxf(fabsf(av[q].z), fabsf(av[q].w))));
    const float sc = (mx > 0.f) ? 127.0f * __builtin_amdgcn_rcpf(mx) * 0.99999f : 0.f;
#pragma unroll
    for (int q = 0; q < 4; ++q) a4[q] = (int)q8x4(av[q], sc);
    return mx * (1.0f / 127.0f);
}
__device__ __forceinline__ void pv_finish(const int (&oi)[16], float sa, bf16_t* orow  , int lane) {
    float o[16];
#pragma unroll
    for (int c = 0; c < 16; ++c) o[c] = (float)oi[c] * sa;
    const bool b3 = (lane & 8) != 0, b4 = (lane & 16) != 0, b5 = (lane & 32) != 0;
    float k8[8], k4[4], k2[2];
#pragma unroll
    for (int c = 0; c < 8; ++c) { const float snd = b3 ? o[c] : o[8 + c], kp = b3 ? o[8 + c] : o[c]; k8[c] = kp + dpp_xor8(snd); }
#pragma unroll
    for (int c = 0; c < 4; ++c) { const float snd = b4 ? k8[c] : k8[4 + c], kp = b4 ? k8[4 + c] : k8[c]; k4[c] = kp + __shfl_xor(snd, 16); }
#pragma unroll
    for (int c = 0; c < 2; ++c) { const float snd = b5 ? k4[c] : k4[2 + c], kp = b5 ? k4[2 + c] : k4[c]; k2[c] = kp + __shfl_xor(snd, 32); }
    *(unsigned*)(orow + ((lane & 8) ? 8 : 0) + ((lane & 16) ? 4 : 0) + ((lane & 32) ? 2 : 0)) = pk2(k2[0], k2[1]);
}
__device__ __forceinline__ void phase_peer_v(const Args& a, int wave, int lane) {
    const int s = SLICE_OF(blockIdx.x), rk = RANK_OF(blockIdx.x), nrk = gridDim.x >> 3, tper = T / nrk, i = lane & 7, j = lane >> 3;
    const unsigned char* vqs = a.ws + WS_VB + (size_t)s * NEXP * 128; const unsigned loff = 16u * (unsigned)i;
    const unsigned short* eidx = (const unsigned short*)(a.ws + WS_EIDX) + 16 * j; const float* act = (const float*)(a.ws + WS_ACT) + 16 * j;
    bf16_t* obase = (bf16_t*)(a.ws + WS_PO) + 128 * s + 16 * i;
    const int m0 = rk * tper + wave, mlast = (rk + 1) * tper - NWAVES + wave;
#define PV_LOAD(t, mm) do { const int m_ = (mm) < mlast ? (mm) : mlast; const u32x4* ep_ = (const u32x4*)(eidx + (size_t)m_ * 128); const f32x4* ap_ = (const f32x4*)(act + (size_t)m_ * 128); \
        (t).e0 = ep_[0]; (t).e1 = ep_[1]; (t).av[0] = ap_[0]; (t).av[1] = ap_[1]; (t).av[2] = ap_[2]; (t).av[3] = ap_[3]; } while (0)
    VTok tC, tN, tNN; u32x4 wA[8], wB[8];
    PV_LOAD(tC, m0); PV_LOAD(tN, m0 + NWAVES); PV_LOAD(tNN, m0 + 2 * NWAVES); pu_issue(vqs, loff, tC.e0, wA);
    for (int m = m0; m <= mlast; m += NWAVES) {
        pu_issue(vqs, loff, tC.e1, wB);
        int oi_[16];
#pragma unroll
        for (int c = 0; c < 16; ++c) oi_[c] = 0;
        int a4_[4]; const float sa_ = pv_quant_act(tC.av, a4_);
        pv_quad(wA[0], wA[1], wA[2], wA[3], a4_[0], oi_); pv_quad(wA[4], wA[5], wA[6], wA[7], a4_[1], oi_);
        pu_issue(vqs, loff, tN.e0, wA);
        pv_quad(wB[0], wB[1], wB[2], wB[3], a4_[2], oi_); pv_quad(wB[4], wB[5], wB[6], wB[7], a4_[3], oi_);
        pv_finish(oi_, sa_, obase + (size_t)m * DM, lane);
        tC = tN; tN = tNN; PV_LOAD(tNN, m + 3 * NWAVES);
    }
#undef PV_LOAD
}
__device__ __forceinline__ void phase_final(const Args& a, int wave, int lane) {
    const int gw = blockIdx.x * NWAVES + wave, NGW = gridDim.x * NWAVES; const bf16_t* po = (const bf16_t*)(a.ws + WS_PO) + 16 * lane; const bf16_t* h1b = (const bf16_t*)(a.ws + WS_H1B) + 16 * lane;
    f32x4 gf[4];
#pragma unroll
    for (int jj = 0; jj < 4; ++jj) gf[jj] = *(const f32x4*)(a.in[I_GFINAL] + 16 * lane + 4 * jj);
    for (int m0 = gw; m0 < T; m0 += 4 * NGW) {
        u32x4 hq[4][2], pq[4][2];
#pragma unroll
        for (int r = 0; r < 4; ++r) { const int m = (m0 + r * NGW < T) ? m0 + r * NGW : m0;
            hq[r][0] = *(const u32x4*)(h1b + (size_t)m * DM); hq[r][1] = *(const u32x4*)(h1b + (size_t)m * DM + 8); pq[r][0] = *(const u32x4*)(po + (size_t)m * DM); pq[r][1] = *(const u32x4*)(po + (size_t)m * DM + 8); }
#pragma unroll
        for (int r = 0; r < 4; ++r) { const int m = m0 + r * NGW; if (m >= T) break;
            float hb[16], pp[16]; unpack8(hq[r][0], *(float(*)[8])&hb[0]); unpack8(hq[r][1], *(float(*)[8])&hb[8]); unpack8(pq[r][0], *(float(*)[8])&pp[0]); unpack8(pq[r][1], *(float(*)[8])&pp[8]);
            f32x4 h[4]; float ss = 0.f;
#pragma unroll
            for (int jj = 0; jj < 4; ++jj) { h[jj] = (f32x4){hb[4 * jj] + pp[4 * jj], hb[4 * jj + 1] + pp[4 * jj + 1], hb[4 * jj + 2] + pp[4 * jj + 2], hb[4 * jj + 3] + pp[4 * jj + 3]};
                ss += (h[jj].x * h[jj].x + h[jj].y * h[jj].y) + (h[jj].z * h[jj].z + h[jj].w * h[jj].w); }
            const float r2 = rsqrtf(wave_sum_dpp(ss) * (1.f / DM) + EPSF);
            float* orow = a.out + (size_t)m * DM + 16 * lane;
#pragma unroll
            for (int jj = 0; jj < 4; ++jj) NT_ST((f32x4*)(orow + 4 * jj), h[jj] * r2 * gf[jj]); }
    }
}
typedef short bf16x8_t __attribute__((ext_vector_type(8)));
__device__ __forceinline__ bf16x8_t toep_frag(const LAS unsigned* R32, int base) {
    const int e = base >> 1, sh = (base & 1) * 16;
    const unsigned d0 = R32[e], d1 = R32[e + 1], d2 = R32[e + 2], d3 = R32[e + 3], d4 = R32[e + 4];
    u32x4 o; o.x = __builtin_amdgcn_alignbit(d1, d0, sh); o.y = __builtin_amdgcn_alignbit(d2, d1, sh); o.z = __builtin_amdgcn_alignbit(d3, d2, sh); o.w = __builtin_amdgcn_alignbit(d4, d3, sh);
    return __builtin_bit_cast(bf16x8_t, o);
}
__device__ __forceinline__ void hy_conv_channel(const Args& a, LAS unsigned char* lds, int c, int tid, int wave, int lane) {
    constexpr int UROW = SP * 2;
    LAS unsigned char* uus = lds;
    LAS unsigned short* R = (LAS unsigned short*)(lds + 8 * UROW);
    const bf16_t* uut = (const bf16_t*)(a.ws + WS_UUT); const bf16_t* kfb = (const bf16_t*)(a.ws + WS_KFB); bf16_t* cvt = (bf16_t*)(a.ws + WS_CONVT);
    { const u32x4* src = (const u32x4*)(uut + (size_t)c * NB * SP); for (int i = tid; i < 8 * UROW / 16; i += NTHR) ((LAS u32x4*)uus)[i] = src[i]; }
    for (int n = tid; n < KFW + 16; n += NTHR) R[n] = (n < KFW) ? kfb[(size_t)c * KFW + (KFW - 1) - n] : (unsigned short)0;
    __syncthreads();
    const LAS unsigned* R32 = (const LAS unsigned*)R;
    const int i = lane & 15, g = lane >> 4, p = (lane >> 3) & 1, b = lane & 7;
    f32x4 C[16]; bf16x8_t A[16];
    const int abase = LT - 32 * (1 + 16 * wave) - i + 8 * g;
#pragma unroll
    for (int tb = 0; tb < 16; ++tb) { C[tb] = (f32x4){0.f, 0.f, 0.f, 0.f}; A[tb] = toep_frag(R32, abase - 32 * tb); }
    const LAS unsigned char* bptr = uus + b * UROW + (16 * p + 8 * g) * 2;
#define HC_STEP(ph, n) do { A[(16 - (ph)) & 15] = toep_frag(R32, abase + 32 * (n)); const bf16x8_t Bf = *(const LAS bf16x8_t*)(bptr + (n) * 64); \
        _Pragma("unroll") for (int tb = 0; tb < 16; ++tb) C[tb] = __builtin_amdgcn_mfma_f32_16x16x32_bf16(A[(tb - (ph)) & 15], Bf, C[tb], 0, 0, 0); __builtin_amdgcn_sched_barrier(0); } while (0)
    for (int G = 0; G < 8; ++G) { const int n0 = G * 16;
        HC_STEP(0, n0); HC_STEP(1, n0 + 1); HC_STEP(2, n0 + 2); HC_STEP(3, n0 + 3); HC_STEP(4, n0 + 4); HC_STEP(5, n0 + 5); HC_STEP(6, n0 + 6); HC_STEP(7, n0 + 7);
        HC_STEP(8, n0 + 8); HC_STEP(9, n0 + 9); HC_STEP(10, n0 + 10); HC_STEP(11, n0 + 11); HC_STEP(12, n0 + 12); HC_STEP(13, n0 + 13); HC_STEP(14, n0 + 14); HC_STEP(15, n0 + 15); }
    HC_STEP(0, 128);
#undef HC_STEP
#pragma unroll
    for (int tb = 0; tb < 16; ++tb) { const int tq = 512 * wave + 32 * tb + 16 * p + 4 * g;
        u32x2 w; w.x = pk2(C[tb][0], C[tb][1]); w.y = pk2(C[tb][2], C[tb][3]);
        *(u32x2*)(cvt + ((size_t)c * NB + b) * SEQ + tq) = w; }
    __syncthreads();
}
__device__ __forceinline__ void rg_item(const Args& a, LAS unsigned char* lds, int it, int tid, int wave, int lane) {
    constexpr int XROW = 272;
    const int head = it & 7, dir = (it >> 3) & 1, b = it >> 4;
    const bf16_t* xb = (const bf16_t*)(a.ws + WS_RGX) + (size_t)b * LT * DRG + head * 128;
    bf16_t* hout = (bf16_t*)a.out + (size_t)dir * T * DRG + (size_t)b * SEQ * DRG + head * 128 + 16 * wave + (lane & 15);
    const int col = lane & 15, g = lane >> 4, ch = head * 128 + 16 * wave + col;
    LAS unsigned char* wl = lds + 2 * 64 * XROW + wave * 1024 + lane * 16;
#pragma unroll
    for (int gt = 0; gt < 2; ++gt)
#pragma unroll
        for (int ks = 0; ks < 4; ++ks) { const float* wp = a.in[I_RGGW] + ((size_t)((dir * 2 + gt) * 8 + head) * 128 + 32 * ks + 8 * g) * 128 + 16 * wave + col;
            u32x4 o; o.x = pk2(wp[0], wp[128]); o.y = pk2(wp[256], wp[384]); o.z = pk2(wp[512], wp[640]); o.w = pk2(wp[768], wp[896]); *(LAS u32x4*)(wl + (gt * 4 + ks) * 8192) = o; }
    const float br = a.in[I_RGGB][(size_t)(dir * 2 + 0) * DRG + ch], bi = a.in[I_RGGB][(size_t)(dir * 2 + 1) * DRG + ch];
    const float sp8 = -8.0f * log1pf(__expf(-a.in[I_RGLAM][dir * DRG + ch]));
    const int ctr = tid >> 4, ccg = tid & 15;
    float cwv[4][8], cbv[8];
#pragma unroll
    for (int i = 0; i < 8; ++i) { cbv[i] = a.in[I_RGCB][(size_t)dir * DRG + head * 128 + 8 * ccg + i];
#pragma unroll
        for (int j = 0; j < 4; ++j) cwv[j][i] = a.in[I_RGCW][((size_t)dir * 4 + j) * DRG + head * 128 + 8 * ccg + i]; }
    u32x4 xr[2][4];
#define RG_LOAD(k) do { _Pragma("unroll") for (int h_ = 0; h_ < 2; ++h_) { const int u_ = 64 * (k) + ctr + 32 * h_; _Pragma("unroll") for (int j = 0; j < 4; ++j) { const int uu_ = u_ - j; \
        if (uu_ >= 0 && uu_ < LT) { const int t_ = dir ? (LT - 1 - uu_) : uu_; xr[h_][j] = *(const u32x4*)(xb + (size_t)t_ * DRG + 8 * ccg); } \
        else xr[h_][j] = (u32x4){0u, 0u, 0u, 0u}; } } } while (0)
#define RG_CONV(k) do { _Pragma("unroll") for (int h_ = 0; h_ < 2; ++h_) { const int u_ = 64 * (k) + ctr + 32 * h_; float o_[8]; _Pragma("unroll") for (int i = 0; i < 8; ++i) o_[i] = (u_ < LT) ? cbv[i] : 0.f; \
        _Pragma("unroll") for (int j = 0; j < 4; ++j) { float f_[8]; unpack8(xr[h_][j], f_); _Pragma("unroll") for (int i = 0; i < 8; ++i) o_[i] += f_[i] * cwv[j][i]; } \
        u32x4 w0_; w0_.x = pk2(o_[0], o_[1]); w0_.y = pk2(o_[2], o_[3]); w0_.z = pk2(o_[4], o_[5]); w0_.w = pk2(o_[6], o_[7]); \
        *(LAS u32x4*)(lds + ((k) & 1) * (64 * XROW) + (ctr + 32 * h_) * XROW + ccg * 16) = w0_; } } while (0)
    RG_LOAD(0); RG_CONV(0); RG_LOAD(1);
    __syncthreads();
    float carry = 0.f;
    const int arow = 16 * (col >> 2) + (col & 3);
    for (int k = 0; k < 65; ++k) {
        if (k + 1 < 65) RG_CONV(k + 1);
        if (k + 2 < 65) RG_LOAD(k + 2);
        const LAS unsigned char* xa = lds + (k & 1) * (64 * XROW);
        unsigned hp[16]; float hh = 0.f, PP = 1.f;
#pragma unroll
        for (int mp = 0; mp < 2; ++mp) {
            f32x4 acc[2][2];
#pragma unroll
            for (int m2 = 0; m2 < 2; ++m2) { const int mb = 2 * mp + m2; acc[0][m2] = (f32x4){0.f, 0.f, 0.f, 0.f}; acc[1][m2] = (f32x4){0.f, 0.f, 0.f, 0.f};
#pragma unroll
                for (int ks = 0; ks < 4; ++ks) { const bf16x8_t Af = *(const LAS bf16x8_t*)(xa + (arow + 4 * mb) * XROW + (32 * ks + 8 * g) * 2);
                    acc[0][m2] = __builtin_amdgcn_mfma_f32_16x16x32_bf16(Af, *(const LAS bf16x8_t*)(wl + ks * 8192), acc[0][m2], 0, 0, 0);
                    acc[1][m2] = __builtin_amdgcn_mfma_f32_16x16x32_bf16(Af, *(const LAS bf16x8_t*)(wl + (4 + ks) * 8192), acc[1][m2], 0, 0, 0); } }
#pragma unroll
            for (int m2 = 0; m2 < 2; ++m2)
#pragma unroll
                for (int r = 0; r < 4; ++r) { const int e = 8 * mp + 4 * m2 + r, tau = 16 * g + e, u = 64 * k + tau;
                    const float rr = sigmoidf_(acc[0][m2][r] + br), ii = sigmoidf_(acc[1][m2][r] + bi);
                    float av = fexp(sp8 * rr); float mult = __builtin_amdgcn_sqrtf(fmaxf(1.0f - av * av, 0.f)); mult = (u == 0) ? 1.0f : mult;
                    const float xcv = bf2f(*(const LAS unsigned short*)(xa + tau * XROW + (16 * wave + col) * 2));
                    float bq = mult * ii * xcv; if (u >= LT) { av = 1.f; bq = 0.f; }
                    hh = av * hh + bq; PP *= av; hp[e] = pk2(hh, PP); }
        }
        float Pg[4], hg[4];
#pragma unroll
        for (int q = 0; q < 4; ++q) { Pg[q] = __shfl(PP, col + 16 * q); hg[q] = __shfl(hh, col + 16 * q); }
        const float H0 = carry, H1 = Pg[0] * H0 + hg[0], H2 = Pg[1] * H1 + hg[1], H3 = Pg[2] * H2 + hg[2], H4 = Pg[3] * H3 + hg[3];
        const float Hin = (g == 0) ? H0 : (g == 1) ? H1 : (g == 2) ? H2 : H3;
        carry = H4;
#pragma unroll
        for (int e = 0; e < 16; ++e) { const int u = 64 * k + 16 * g + e; const int t = dir ? (LT - 1 - u) : u;
            if (u < LT && t >= NMETA) hout[(size_t)(t - NMETA) * DRG] = (bf16_t)f2bf(bflo(hp[e]) + bfhi(hp[e]) * Hin); }
        __syncthreads();
    }
#undef RG_LOAD
#undef RG_CONV
}
__device__ __forceinline__ void rg_item2(const Args& a, LAS unsigned char* lds, int it, int tid, int wave, int lane) {
    constexpr int XROW = 272;
    const int hh = it & 1, head = (it >> 1) & 7, dir = (it >> 4) & 1, b = it >> 5;
    const bf16_t* xb = (const bf16_t*)(a.ws + WS_RGX) + (size_t)b * LT * DRG + head * 128;
    const int col = lane & 15, g = lane >> 4, gate = col >> 3, cj = col & 7, chl = 64 * hh + 8 * wave + cj, ch = head * 128 + chl, qg = 2 * g + gate;
    bf16_t* hout = (bf16_t*)a.out + (size_t)dir * T * DRG + (size_t)b * SEQ * DRG + ch;
    bf16x8_t Wf[4];
#pragma unroll
    for (int ks = 0; ks < 4; ++ks) { const float* wp = a.in[I_RGGW] + ((size_t)((dir * 2 + gate) * 8 + head) * 128 + 32 * ks + 8 * g) * 128 + chl;
        u32x4 o; o.x = pk2(wp[0], wp[128]); o.y = pk2(wp[256], wp[384]); o.z = pk2(wp[512], wp[640]); o.w = pk2(wp[768], wp[896]); Wf[ks] = __builtin_bit_cast(bf16x8_t, o); }
    const float LOG2E = 1.4426950408889634f;
    const float bgl = a.in[I_RGGB][(size_t)(dir * 2 + gate) * DRG + ch] * LOG2E;
    const float sp8l = -8.0f * log1pf(__expf(-a.in[I_RGLAM][dir * DRG + ch])) * LOG2E;
    const int ctr = tid >> 4, ccg = tid & 15;
    float cwv[4][8], cbv[8];
#pragma unroll
    for (int i = 0; i < 8; ++i) { cbv[i] = a.in[I_RGCB][(size_t)dir * DRG + head * 128 + 8 * ccg + i];
#pragma unroll
        for (int j = 0; j < 4; ++j) cwv[j][i] = a.in[I_RGCW][((size_t)dir * 4 + j) * DRG + head * 128 + 8 * ccg + i]; }
    u32x4 xr[2][4];
#define RG_LOAD(k) do { _Pragma("unroll") for (int h_ = 0; h_ < 2; ++h_) { const int u_ = 64 * (k) + ctr + 32 * h_; _Pragma("unroll") for (int j = 0; j < 4; ++j) { const int uu_ = u_ - j; \
        if (uu_ >= 0 && uu_ < LT) { const int t_ = dir ? (LT - 1 - uu_) : uu_; xr[h_][j] = *(const u32x4*)(xb + (size_t)t_ * DRG + 8 * ccg); } \
        else xr[h_][j] = (u32x4){0u, 0u, 0u, 0u}; } } } while (0)
#define RG_CONV(k) do { _Pragma("unroll") for (int h_ = 0; h_ < 2; ++h_) { const int u_ = 64 * (k) + ctr + 32 * h_; float o_[8]; _Pragma("unroll") for (int i = 0; i < 8; ++i) o_[i] = (u_ < LT) ? cbv[i] : 0.f; \
        _Pragma("unroll") for (int j = 0; j < 4; ++j) { float f_[8]; unpack8(xr[h_][j], f_); _Pragma("unroll") for (int i = 0; i < 8; ++i) o_[i] += f_[i] * cwv[j][i]; } \
        u32x4 w0_; w0_.x = pk2(o_[0], o_[1]); w0_.y = pk2(o_[2], o_[3]); w0_.z = pk2(o_[4], o_[5]); w0_.w = pk2(o_[6], o_[7]); \
        *(LAS u32x4*)(lds + ((k) & 1) * (64 * XROW) + (ctr + 32 * h_) * XROW + ccg * 16) = w0_; } } while (0)
    RG_LOAD(0); RG_CONV(0); RG_LOAD(1);
    __syncthreads();
    float carry = 0.f;
    const int arow = 16 * (col >> 2) + (col & 3);
    for (int k = 0; k < 65; ++k) {
        if (k + 1 < 65) RG_CONV(k + 1);
        if (k + 2 < 65) RG_LOAD(k + 2);
        const LAS unsigned char* xa = lds + (k & 1) * (64 * XROW);
        f32x4 acc[4];
#pragma unroll
        for (int mb = 0; mb < 4; ++mb) { acc[mb] = (f32x4){0.f, 0.f, 0.f, 0.f};
#pragma unroll
            for (int ks = 0; ks < 4; ++ks) acc[mb] = __builtin_amdgcn_mfma_f32_16x16x32_bf16(*(const LAS bf16x8_t*)(xa + (arow + 4 * mb) * XROW + (32 * ks + 8 * g) * 2), Wf[ks], acc[mb], 0, 0, 0); }
        float sg[16], ot[16];
#pragma unroll
        for (int e = 0; e < 16; ++e) { sg[e] = __builtin_amdgcn_rcpf(1.0f + __builtin_amdgcn_exp2f(-(acc[e >> 2][e & 3] * LOG2E + bgl))); ot[e] = dpp_xor8(sg[e]); }
        unsigned hp[8]; float hs = 0.f, PP = 1.f;
#pragma unroll
        for (int t = 0; t < 8; ++t) { const float rr = gate ? ot[8 + t] : sg[t], ii = gate ? sg[8 + t] : ot[t]; const int tau = 8 * qg + t, u = 64 * k + tau;
            float av = __builtin_amdgcn_exp2f(sp8l * rr); float mult = __builtin_amdgcn_sqrtf(fmaxf(1.0f - av * av, 0.f)); mult = (u == 0) ? 1.0f : mult;
            const float xcv = bf2f(*(const LAS unsigned short*)(xa + tau * XROW + chl * 2));
            float bq = mult * ii * xcv; if (u >= LT) { av = 1.f; bq = 0.f; }
            hs = av * hs + bq; PP *= av; hp[t] = pk2(hs, PP); }
        float H = carry, Hin = carry;
#pragma unroll
        for (int q = 0; q < 8; ++q) { const int src = cj + 8 * (q & 1) + 16 * (q >> 1); const float Pq = __shfl(PP, src), hq = __shfl(hs, src);
            Hin = (qg == q) ? H : Hin; H = Pq * H + hq; }
        carry = H;
#pragma unroll
        for (int t = 0; t < 8; ++t) { const int u = 64 * k + 8 * qg + t; const int tt = dir ? (LT - 1 - u) : u;
            if (u < LT && tt >= NMETA) hout[(size_t)(tt - NMETA) * DRG] = (bf16_t)f2bf(bflo(hp[t]) + bfhi(hp[t]) * Hin); }
        __syncthreads();
    }
#undef RG_LOAD
#undef RG_CONV
}

__device__ __forceinline__ int rg_lds_off(int row, int chunk) { return row * 320 + (((chunk + 2 * (row >> 4)) & 15) << 4); }
__device__ __forceinline__ void rg_item3(const Args& a, LAS unsigned char* lds, int it, int tid, int wave, int lane) {
    constexpr int XT = 64 * 320;
    const int th = it & 1, head = (it >> 1) & 7, dir = (it >> 4) & 1, b = it >> 5;
    const int k0 = th ? RG_SPLIT : 0, k1 = th ? 65 : RG_SPLIT;
    const bf16_t* xb = (const bf16_t*)(a.ws + WS_RGX) + (size_t)b * LT * DRG + head * 128;
    const int col = lane & 15, g = lane >> 4, chl = 16 * wave + col, ch = head * 128 + chl;
    bf16_t* hout = (bf16_t*)a.out + (size_t)dir * T * DRG + (size_t)b * SEQ * DRG + ch;
    bf16_t* pout = (bf16_t*)(a.ws + WS_RGP) + ((size_t)dir * NB + b) * RG_NF * DRG + ch;
    LAS unsigned char* wl = lds + 2 * XT + wave * 1024 + lane * 16;
#pragma unroll
    for (int gt = 0; gt < 2; ++gt)
#pragma unroll
        for (int ks = 0; ks < 4; ++ks) { const float* wp = a.in[I_RGGW] + ((size_t)((dir * 2 + gt) * 8 + head) * 128 + 32 * ks + 8 * g) * 128 + chl;
            u32x4 o; o.x = pk2(wp[0], wp[128]); o.y = pk2(wp[256], wp[384]); o.z = pk2(wp[512], wp[640]); o.w = pk2(wp[768], wp[896]); *(LAS u32x4*)(wl + (gt * 4 + ks) * 8192) = o; }
    const float LOG2E = 1.4426950408889634f;
    const float brl = a.in[I_RGGB][(size_t)(dir * 2 + 0) * DRG + ch] * LOG2E, bil = a.in[I_RGGB][(size_t)(dir * 2 + 1) * DRG + ch] * LOG2E;
    const float sp8l = -8.0f * log1pf(__expf(-a.in[I_RGLAM][dir * DRG + ch])) * LOG2E;
    const int ctr = tid >> 4, ccg = tid & 15;
    LAS float* cwl = (LAS float*)(lds + 2 * XT + 8 * 8192);
    for (int i = tid; i < 5 * 128; i += NTHR) { const int j = i >> 7, c = i & 127; cwl[i] = (j < 4) ? a.in[I_RGCW][((size_t)dir * 4 + j) * DRG + head * 128 + c] : a.in[I_RGCB][(size_t)dir * DRG + head * 128 + c]; }
    __syncthreads();
    u32x4 xr[2][4];
#define RG_LOAD(k) do { _Pragma("unroll") for (int h_ = 0; h_ < 2; ++h_) { const int u_ = 64 * (k) + ctr + 32 * h_; _Pragma("unroll") for (int j = 0; j < 4; ++j) { int uu_ = u_ - j; \
        const bool ok_ = (uu_ >= 0 && uu_ < LT); uu_ = ok_ ? uu_ : 0; const int t_ = dir ? (LT - 1 - uu_) : uu_; const u32x4 v_ = *(const u32x4*)(xb + (size_t)t_ * DRG + 8 * ccg); \
        xr[h_][j] = ok_ ? v_ : (u32x4){0u, 0u, 0u, 0u}; } } } while (0)
#define RG_CONV(k) do { _Pragma("unroll") for (int h_ = 0; h_ < 2; ++h_) { const int u_ = 64 * (k) + ctr + 32 * h_; float o_[8]; \
        { const f32x4 b0_ = *(const LAS f32x4*)(cwl + 4 * 128 + 8 * ccg), b1_ = *(const LAS f32x4*)(cwl + 4 * 128 + 8 * ccg + 4); const bool in_ = (u_ < LT); \
          o_[0] = in_ ? b0_.x : 0.f; o_[1] = in_ ? b0_.y : 0.f; o_[2] = in_ ? b0_.z : 0.f; o_[3] = in_ ? b0_.w : 0.f; o_[4] = in_ ? b1_.x : 0.f; o_[5] = in_ ? b1_.y : 0.f; o_[6] = in_ ? b1_.z : 0.f; o_[7] = in_ ? b1_.w : 0.f; } \
        _Pragma("unroll") for (int j = 0; j < 4; ++j) { float f_[8]; unpack8(xr[h_][j], f_); const f32x4 w0_ = *(const LAS f32x4*)(cwl + j * 128 + 8 * ccg), w1_ = *(const LAS f32x4*)(cwl + j * 128 + 8 * ccg + 4); \
            o_[0] += f_[0] * w0_.x; o_[1] += f_[1] * w0_.y; o_[2] += f_[2] * w0_.z; o_[3] += f_[3] * w0_.w; o_[4] += f_[4] * w1_.x; o_[5] += f_[5] * w1_.y; o_[6] += f_[6] * w1_.z; o_[7] += f_[7] * w1_.w; } \
        u32x4 w0_; w0_.x = pk2(o_[0], o_[1]); w0_.y = pk2(o_[2], o_[3]); w0_.z = pk2(o_[4], o_[5]); w0_.w = pk2(o_[6], o_[7]); \
        *(LAS u32x4*)(lds + ((k) & 1) * XT + rg_lds_off(ctr + 32 * h_, ccg)) = w0_; } } while (0)
    RG_LOAD(k0); RG_CONV(k0); RG_LOAD(k0 + 1);
    __syncthreads();
    float carry = 0.f, pcar = 1.f;
    const int arow = 16 * (col >> 2) + (col & 3);
    const int xoff = (chl & 7) * 2, xch = chl >> 3;
    unsigned char* hbase = (unsigned char*)((bf16_t*)a.out + (size_t)dir * T * DRG + (size_t)b * SEQ * DRG);
    unsigned char* pbase = (unsigned char*)((bf16_t*)(a.ws + WS_RGP) + ((size_t)dir * NB + b) * RG_NF * DRG);
    const int tsgn = dir ? -1 : 1, t0 = dir ? (LT - 1 - NMETA) : -NMETA;
#define RG_TILE(EDGE) do { \
        unsigned hp[16]; float hh = 0.f, PP = 1.f; \
        _Pragma("unroll") for (int mp = 0; mp < 2; ++mp) { f32x4 acc[2][2]; \
            _Pragma("unroll") for (int m2 = 0; m2 < 2; ++m2) { const int mb = 2 * mp + m2; acc[0][m2] = (f32x4){0.f, 0.f, 0.f, 0.f}; acc[1][m2] = (f32x4){0.f, 0.f, 0.f, 0.f}; \
                _Pragma("unroll") for (int ks = 0; ks < 4; ++ks) { const bf16x8_t Af = *(const LAS bf16x8_t*)(xa + rg_lds_off(arow + 4 * mb, 4 * ks + g)); \
                    acc[0][m2] = __builtin_amdgcn_mfma_f32_16x16x32_bf16(Af, *(const LAS bf16x8_t*)(wl + ks * 8192), acc[0][m2], 0, 0, 0); \
                    acc[1][m2] = __builtin_amdgcn_mfma_f32_16x16x32_bf16(Af, *(const LAS bf16x8_t*)(wl + (4 + ks) * 8192), acc[1][m2], 0, 0, 0); } } \
            _Pragma("unroll") for (int m2 = 0; m2 < 2; ++m2) _Pragma("unroll") for (int r = 0; r < 4; ++r) { const int e = 8 * mp + 4 * m2 + r, tau = 16 * g + e, u = 64 * k + tau; \
                    const float rr = __builtin_amdgcn_rcpf(1.0f + __builtin_amdgcn_exp2f(-(acc[0][m2][r] * LOG2E + brl))), ii = __builtin_amdgcn_rcpf(1.0f + __builtin_amdgcn_exp2f(-(acc[1][m2][r] * LOG2E + bil))); \
                    float av = __builtin_amdgcn_exp2f(sp8l * rr); float mult = __builtin_amdgcn_sqrtf(fmaxf(1.0f - av * av, 0.f)); if (EDGE) mult = (u == 0) ? 1.0f : mult; \
                    const float xcv = bf2f(*(const LAS unsigned short*)(xa + rg_lds_off(tau, xch) + xoff)); \
                    float bq = mult * ii * xcv; if (EDGE) { if (u >= LT) { av = 1.f; bq = 0.f; } } \
                    hh = av * hh + bq; PP *= av; hp[e] = pk2(hh, PP); } } \
        float Pg[4], hg[4]; \
        _Pragma("unroll") for (int q = 0; q < 4; ++q) { Pg[q] = __shfl(PP, col + 16 * q); hg[q] = __shfl(hh, col + 16 * q); } \
        const float H0 = carry, H1 = Pg[0] * H0 + hg[0], H2 = Pg[1] * H1 + hg[1], H3 = Pg[2] * H2 + hg[2], H4 = Pg[3] * H3 + hg[3]; \
        const float Q0 = pcar, Q1 = Pg[0] * Q0, Q2 = Pg[1] * Q1, Q3 = Pg[2] * Q2, Q4 = Pg[3] * Q3; \
        const float Hin = (g == 0) ? H0 : (g == 1) ? H1 : (g == 2) ? H2 : H3, Qin = (g == 0) ? Q0 : (g == 1) ? Q1 : (g == 2) ? Q2 : Q3; \
        carry = H4; pcar = Q4; \
        const int ub = 64 * k + 16 * g; \
        unsigned ho = (unsigned)((t0 + tsgn * ub) * (DRG * 2) + ch * 2), po = (unsigned)((ub - RG_U1) * (DRG * 2) + ch * 2); const unsigned hstep = (unsigned)(tsgn * DRG * 2); \
        _Pragma("unroll") for (int e = 0; e < 16; ++e) { const int u = ub + e; const int t = dir ? (LT - 1 - u) : u; \
            if (!EDGE || (u < LT && t >= NMETA)) { *(bf16_t*)(hbase + ho) = (bf16_t)f2bf(bflo(hp[e]) + bfhi(hp[e]) * Hin); \
                if (th) *(bf16_t*)(pbase + po) = (bf16_t)f2bf(bfhi(hp[e]) * Qin); } \
            ho += hstep; po += (unsigned)(DRG * 2); } \
    } while (0)
    for (int k = k0; k < k1; ++k) {
        if (k + 1 < k1) RG_CONV(k + 1);
        if (k + 2 < k1) RG_LOAD(k + 2);
        const LAS unsigned char* xa = lds + (k & 1) * XT;
        if (k == 0 || k >= 63) RG_TILE(true); else RG_TILE(false);
        __syncthreads();
    }
#undef RG_TILE
    if (th == 0 && g == 0) ((float*)(a.ws + WS_RGC))[((size_t)dir * NB + b) * DRG + ch] = carry;
#undef RG_LOAD
#undef RG_CONV
}

#ifndef RG_NAIVE
#define RG_NAIVE 0
#endif
#ifndef CONV_NAIVE
#define CONV_NAIVE 0
#endif
#ifndef ONE_LAUNCH
#define ONE_LAUNCH 0
#endif
constexpr int NPHASE = 13;
#ifndef NVGPR
#define NVGPR 248
#endif
__global__ void __launch_bounds__(NTHR, 2) __attribute__((amdgpu_num_vgpr(NVGPR))) mega(Args a) {
    extern __shared__ __attribute__((aligned(16))) unsigned char lds_raw[];
    LAS unsigned char* lds = (LAS unsigned char*)lds_raw;
    const int tid = threadIdx.x, lane = tid & 63, wave = __builtin_amdgcn_readfirstlane(tid >> 6);
    cg::grid_group grid = cg::this_grid();
    volatile LAS unsigned* bst = (volatile LAS unsigned*)(lds + LDS_BYTES - 64);
    if (tid == 0) { bst[0] = 0u; bst[1] = 0u; }
    __syncthreads();
    XcdBarrier xbar; xbar.bar = (unsigned*)(a.ws + WS_BAR); xbar.x = 0; xbar.st = bst;
    if (a.ph_hi - a.ph_lo > 1) xbar = xcd_barrier_post((unsigned*)(a.ws + WS_BAR), bst);
    const int lo = a.ph_lo, hi = a.ph_hi, G = gridDim.x, bx = blockIdx.x;
#ifndef PHMASK
#define PHMASK 0x1fff
#endif
#ifndef REPMASK
#define REPMASK 0
#endif
#define IN(k) (((PHMASK >> (k)) & 1) && lo <= (k) && (k) < hi)
#define REP(k)
#ifdef PROBE_BAR2X
#define SEAM(k) do { if (IN(k) && ((k) + 1) < hi) { xcd_barrier(xbar); xcd_barrier(xbar); } } while (0)
#else
#define SEAM(k) do { if (IN(k) && ((k) + 1) < hi) xcd_barrier(xbar); } while (0)
#endif
    if (a.ph_lo < 0) grid.sync();
    unsigned char* ws = a.ws;
    REP(0) if (IN(0)) phase_p0(a, lds, tid, wave, lane);
    SEAM(0);
    REP(1) if (IN(1)) {
        p1_meta(a, lds, tid, wave, lane);
#ifdef STAGGER_P1
        for (int q = 0; q < ((bx >> 3) & 7) * STAGGER_P1; ++q) __builtin_amdgcn_s_sleep(64);
#endif
        pg8::Gemm g{(const bf16_t*)(ws + WS_XN1), (const bf16_t*)(ws + WS_WINT), T, DIN, 1024};
        EpiProj E{(bf16_t*)(ws + WS_HYIN), (bf16_t*)(ws + WS_RGX), (bf16_t*)(ws + WS_GG), (bf16_t*)(ws + WS_GA), (bf16_t*)(ws + WS_GB), a.in[I_BGATE]};
#ifdef PROBE_P1_EXTRA
        struct OrderX : pg8::StaticOrder { __device__ bool next(int i, pg8::Unit& u) const { const bool ok = pg8::StaticOrder::next(i < 11 ? i : i - 11, u) && i < 11 + PROBE_P1_EXTRA; u.skip = (i >= 11); return ok; } } S; S.init(T, DIN, G, bx);
        pg8::gemm_phase<EpiProj, OrderX>(lds, g, S, E, nullptr);
#else
        pg8::StaticOrder S; S.init(T, DIN, G, bx);
        pg8::gemm_phase<EpiProj, pg8::StaticOrder>(lds, g, S, E, nullptr);
#endif
    }
    SEAM(1);
    REP(2) if (IN(2)) phase_hy_pre(a, lds, tid);
    SEAM(2);
    REP(3) if (IN(3)) {
#if CONV_NAIVE
        phase_hy_conv_naive(a, lds, tid);
#else
        for (int c = bx; c < DHY; c += G) hy_conv_channel(a, lds, c, tid, wave, lane);
#endif
#if RG_NAIVE
        phase_rg_naive(a, lds, tid);
#else
        for (int it = bx; it < NB * 2 * 8 * 2; it += G) rg_item3(a, lds, it, tid, wave, lane);
#endif
    }
    SEAM(3);
    REP(4) if (IN(4)) phase_post(a, lds, tid);
    SEAM(4);
    REP(5) if (IN(5)) {
        { pg8::Gemm g{(const bf16_t*)(ws + WS_YH), (const bf16_t*)(ws + WS_WHT), T, 1024, 512}; pg8::StaticOrder S; S.init(T, 1024, G, bx);
          EpiGate<0> E{(const bf16_t*)(ws + WS_GA), nullptr, (bf16_t*)(ws + WS_TMP)};
          pg8::gemm_phase<EpiGate<0>, pg8::StaticOrder>(lds, g, S, E, nullptr); }
        { pg8::Gemm g{(const bf16_t*)(ws + WS_YR), (const bf16_t*)(ws + WS_WRT), T, 1024, 1024};
          EpiGate<1> E{(const bf16_t*)(ws + WS_GB), (const bf16_t*)(ws + WS_TMP), (bf16_t*)(ws + WS_MERGED)};
#ifdef PROBE_UNITS2X
          struct Order2x : pg8::StaticOrder { __device__ bool next(int i, pg8::Unit& u) const { return pg8::StaticOrder::next(i >> 1, u); } } S; S.init(T, 1024, G, bx);
          pg8::gemm_phase<EpiGate<1>, Order2x>(lds, g, S, E, nullptr);
#else
          pg8::StaticOrder S; S.init(T, 1024, G, bx);
          pg8::gemm_phase<EpiGate<1>, pg8::StaticOrder>(lds, g, S, E, nullptr);
#endif
        }
    }
    SEAM(5);
    REP(6) if (IN(6)) {
        pg8::Gemm g{(const bf16_t*)(ws + WS_MERGED), (const bf16_t*)(ws + WS_WOT), T, 1024, 1024}; pg8::StaticOrder S; S.init(T, 1024, G, bx);
        EpiResid E{a.in[I_X], (bf16_t*)(ws + WS_H1B), (float*)(ws + WS_ROWSS)};
        pg8::gemm_phase<EpiResid, pg8::StaticOrder>(lds, g, S, E, nullptr);
    }
    SEAM(6);
    REP(7) if (IN(7)) {
        phase_tables(a, wave, lane);
        pg8::Gemm g{(const bf16_t*)(ws + WS_H1B), (const bf16_t*)(ws + WS_WST), T, 2048, 1024}; pg8::StaticOrder S; S.init(T, 2048, G, bx);
        EpiScores E{(const float*)(ws + WS_ROWSS), (_Float16*)(ws + WS_SCORES)};
        pg8::gemm_phase<EpiScores, pg8::StaticOrder>(lds, g, S, E, nullptr);
        __syncthreads();
        phase_topk(a, lds, S, wave, lane);
    }
    SEAM(8);
#ifndef U_VALU
#define U_VALU 1
#endif
    REP(9) if (IN(9)) { if (U_VALU) phase_peer_u(a, wave, lane); else phase_peer_u_mfma(a, lds, wave, lane); }
    SEAM(9);
    if (IN(10)) phase_peer_act(a, tid);
    SEAM(10);
    if (IN(11)) phase_peer_v(a, wave, lane);
    SEAM(11);
    if (IN(12)) phase_final(a, wave, lane);
#undef IN
#undef SEAM
}

extern "C" void kernel_launch(void* const* d_in, const int* in_sizes, int n_in, void* d_out, int out_size, void* d_ws, size_t ws_size, hipStream_t stream) {
    static int grid = 0;
    if (grid == 0) {
        if (n_in != N_IN || out_size != T * DM || ws_size < WS_END) { fprintf(stderr, "kernel_launch: unexpected shapes (n_in %d out %d ws %zu)\n", n_in, out_size, ws_size); grid = -1; return; }
        if (hipFuncSetAttribute((const void*)mega, hipFuncAttributeMaxDynamicSharedMemorySize, LDS_BYTES) != hipSuccess) { fprintf(stderr, "kernel_launch: hipFuncSetAttribute failed\n"); grid = -1; return; }
        int dev = 0, cus = 0, per_cu = 0;
        hipGetDevice(&dev); hipDeviceGetAttribute(&cus, hipDeviceAttributeMultiprocessorCount, dev);
        hipOccupancyMaxActiveBlocksPerMultiprocessor(&per_cu, (const void*)mega, NTHR, LDS_BYTES);
        if (per_cu < 1) { fprintf(stderr, "kernel_launch: occupancy query says %d blocks per CU\n", per_cu); per_cu = 1; }
        (void)hipGetLastError();
        grid = cus;
    }
    if (grid < 0) return;
    Args a{};
    for (int i = 0; i < N_IN; ++i) a.in[i] = (const float*)d_in[i];
    a.out = (float*)d_out; a.ws = (unsigned char*)d_ws;
#if ONE_LAUNCH
    if (hipMemsetAsync((char*)d_ws + WS_BAR, 0, XCD_BAR_WORDS * 4, stream) != hipSuccess) { fprintf(stderr, "kernel_launch: memset of the barrier words failed\n"); return; }
    a.ph_lo = 0; a.ph_hi = NPHASE;
    void* args[] = {&a};
    hipError_t e = hipLaunchCooperativeKernel((const void*)mega, dim3(grid), dim3(NTHR), args, LDS_BYTES, stream);
    if (e != hipSuccess) fprintf(stderr, "cooperative launch failed: %s (grid %d)\n", hipGetErrorString(e), grid);
#else
    for (int ph = 0; ph < NPHASE; ++ph) for (int rep = 0; rep < 1 + ((REPMASK >> ph) & 1); ++rep) { a.ph_lo = ph; a.ph_hi = ph + 1;
        if (ph == 6 && rep == 1) (void)hipMemsetAsync((char*)d_ws + WS_ROWSS, 0, T * 4, stream);
        hipLaunchKernelGGL(mega, dim3(grid), dim3(NTHR), LDS_BYTES, stream, a);
        hipError_t e = hipPeekAtLastError(); if (e != hipSuccess) { fprintf(stderr, "launch %d failed: %s\n", ph, hipGetErrorString(e)); break; } }
#endif
}
```

```cpp
#define ONE_LAUNCH 1
#define NT_STORES 1
#define NT_STORES2 1
#define ACT_TOKEN_SCALE 1
#include <hip/hip_runtime.h>
#include <hip/hip_cooperative_groups.h>
#include <cstdio>
#include <cstdint>
#include <cmath>
namespace cg = cooperative_groups;
namespace pg8 {
#define PG8_LAS __attribute__((address_space(3)))
typedef unsigned short bf16_t;
typedef short bf16x8 __attribute__((ext_vector_type(8)));
typedef float f32x4 __attribute__((ext_vector_type(4)));
typedef unsigned u32x4 __attribute__((ext_vector_type(4)));
constexpr int BM = 256, BK = 64, HALF = 128, HTB = HALF * BK * 2  , STAGE_BYTES = 8 * HTB, NXCD = 8, WGM = 8;

__host__ __device__ __forceinline__ int lds_byte(int r, int c) { const int st = (r >> 4) * 2 + (c >> 5), rr = r & 15, cc = c & 31, ob = rr * 64 + cc * 2; return st * 1024 + (ob ^ (((ob >> 9) & 1) << 5)); }
__host__ __device__ __forceinline__ void stage_rc(int b, int& R, int& C) { const int st = b / 1024, sb = b % 1024, swz = sb ^ (((sb >> 9) & 1) << 5); R = (st >> 1) * 16 + swz / 64; C = (st & 1) * 32 + (swz % 64) / 2; }
__host__ __device__ __forceinline__ int perm32(int rho) { const int n = rho >> 4, i = rho & 15; return 8 * (i >> 2) + 4 * n + (i & 3); }

struct Unit { int pm, pn; int skip = 0; };
struct Gemm { const bf16_t* A; const bf16_t* Bt; int M, N, K; };

struct StaticOrder {
    int nM, nN, nwg, G, c;
    __host__ __device__ void init(int M, int N, int G_, int c_) { nM = M / BM; nN = N / BM; nwg = nM * nN; G = G_; c = c_; }
    __host__ __device__ bool next(int i, Unit& u) const {
        const long L = (long)i * G + c; if (L >= nwg) return false;
        int wgid = (int)L; { const int q = nwg / NXCD, r = nwg % NXCD, xcd = wgid % NXCD, off = wgid / NXCD; wgid = (xcd < r ? xcd * (q + 1) : r * (q + 1) + (xcd - r) * q) + off; }
        const int nig = WGM * nN, gid = wgid / nig, fm = gid * WGM, gsz = (nM - fm) < WGM ? (nM - fm) : WGM;
        u.pm = fm + ((wgid % nig) % gsz); u.pn = (wgid % nig) / gsz; return true;
    }
    __device__ __forceinline__ void a_ready(const Unit&) const {}
    __device__ __forceinline__ void done(const Unit&) const {}
};
__device__ __forceinline__ unsigned cvt_pk_bf16(float lo, float hi) { unsigned r; asm volatile("v_cvt_pk_bf16_f32 %0, %1, %2" : "=v"(r) : "v"(lo), "v"(hi)); return r; }
typedef float f32x2 __attribute__((ext_vector_type(2)));
__device__ __forceinline__ f32x2 gelu_pk(f32x2 v) {
    const f32x2 av = __builtin_elementwise_abs(v), d = av * 0.2316418882f + 1.0f;
    f32x2 t; t.x = __builtin_amdgcn_rcpf(d.x); t.y = __builtin_amdgcn_rcpf(d.y);
    f32x2 q = t * 0.5307027145f + (-0.7265760135f); q = q * t + 0.7107068705f; q = q * t + (-0.142248368f); q = q * t + 0.127414796f; q = q * t;
    const f32x2 s = (v * v) * (-0.72134752044f);
    f32x2 e; e.x = __builtin_amdgcn_exp2f(s.x); e.y = __builtin_amdgcn_exp2f(s.y);
    const f32x2 m = v * (q * e), r = v - m;
    f32x2 o; o.x = v.x < 0.f ? m.x : r.x; o.y = v.y < 0.f ? m.y : r.y; return o;
}
template <class Epi, class Sched, bool STAMP = false>
__device__ __forceinline__ void gemm_phase(PG8_LAS unsigned char* lds, const Gemm g, const Sched& S, const Epi& E, unsigned long long* stamps) {
    const int tid = threadIdx.x, wid = __builtin_amdgcn_readfirstlane(tid >> 6), lane = tid & 63, wr = wid >> 2, wc = wid & 3, fr = lane & 15, fq = lane >> 4;
    const int K = g.K, nt = K / BK;
    int ts_lo = 0, ts_hi = 0, nts = 0; const unsigned long long rt_entry = STAMP ? (unsigned long long)wall_clock64() : 0ull;
#define PG8_STAMP() do { if (STAMP && wid == 0 && nts < 64) { const unsigned long long _c = (unsigned long long)clock64(); \
        ts_lo = (lane == nts) ? (int)(unsigned)_c : ts_lo; ts_hi = (lane == nts) ? (int)(unsigned)(_c >> 32) : ts_hi; ++nts; } } while (0)
    PG8_STAMP();
    unsigned voffA[2], voffB[2];
#pragma unroll
    for (int i = 0; i < 2; ++i) { int R, C; stage_rc(tid * 16 + i * 8192, R, C); const int Rb = Epi::LINE ? (2 * (R & ~31) + perm32(R & 31)) : Epi::PERM ? ((R & ~31) + perm32(R & 31)) : R;
        voffA[i] = (unsigned)(R * K + C) * 2u; voffB[i] = (unsigned)(Rb * K + C) * 2u; }
    const size_t kstep = (size_t)(BK * 2);
    const size_t hstep = (size_t)HALF * K * 2;
    const size_t hstepB = Epi::LINE ? (size_t)32 * K * 2 : hstep;
    const size_t tstep = 2 * hstep;
    const unsigned ldsw = (unsigned)wid * 1024u;
    const int aoff = lds_byte(wr * 64 + fr, fq * 8), boff = lds_byte(wc * 32 + fr, fq * 8);
#define PG8_SA(b, h) (((b) * 2 + (h)) * HTB)
#define PG8_SB(b, h) ((4 + (b) * 2 + (h)) * HTB)
#define PG8_STAGE(bufoff, gbase, voff) do { _Pragma("unroll") for (int _i = 0; _i < 2; ++_i) \
        __builtin_amdgcn_global_load_lds((const unsigned*)((const char*)(gbase) + (voff)[_i]), (PG8_LAS unsigned*)(lds + (bufoff) + ldsw + _i * 8192), 16, 0, 0); } while (0)
#define PG8_LDA(dst, b, h) do { _Pragma("unroll") for (int m = 0; m < 4; ++m) _Pragma("unroll") for (int k = 0; k < 2; ++k) dst[m][k] = *(const PG8_LAS bf16x8*)(lds + PG8_SA(b, h) + aoff + m * 2048 + k * 1024); } while (0)
#define PG8_LDB(dst, b, h) do { _Pragma("unroll") for (int n = 0; n < 2; ++n) _Pragma("unroll") for (int k = 0; k < 2; ++k) dst[n][k] = *(const PG8_LAS bf16x8*)(lds + PG8_SB(b, h) + boff + n * 2048 + k * 1024); } while (0)
#define PG8_MMA(ai, bj, At, Bt) do { __builtin_amdgcn_s_setprio(1); _Pragma("unroll") for (int m = 0; m < 4; ++m) _Pragma("unroll") for (int n = 0; n < 2; ++n) _Pragma("unroll") for (int k = 0; k < 2; ++k) \
        acc[ai][bj][m][n] = __builtin_amdgcn_mfma_f32_16x16x32_bf16(Bt[n][k], At[m][k], acc[ai][bj][m][n], 0, 0, 0); __builtin_amdgcn_s_setprio(0); } while (0)
#define PG8_WAIT_V(n) asm volatile("s_waitcnt vmcnt(" #n ")" ::: "memory")
#define PG8_WAIT_L(n) asm volatile("s_waitcnt lgkmcnt(" #n ")" ::: "memory")
#define PG8_BAR __builtin_amdgcn_s_barrier()
#define PG8_SCHED __builtin_amdgcn_sched_barrier(0)
    Unit cur, nxt; int ui = 0;
    if (!S.next(0, cur)) return;
    f32x4 acc[2][2][4][2];
#pragma unroll
    for (int a = 0; a < 2; ++a)
#pragma unroll
        for (int b = 0; b < 2; ++b)
#pragma unroll
            for (int m = 0; m < 4; ++m)
#pragma unroll
                for (int n = 0; n < 2; ++n) acc[a][b][m][n] = (f32x4){0.f, 0.f, 0.f, 0.f};
    bf16x8 At[4][2], B0[2][2], B1[2][2];
    const char* cA = (const char*)g.A + (size_t)cur.pm * tstep; const char* cB = (const char*)g.Bt + (size_t)cur.pn * tstep;
    S.a_ready(cur);
    PG8_STAGE(PG8_SB(0, 0), cB, voffB); PG8_STAGE(PG8_SA(0, 0), cA, voffA); PG8_STAGE(PG8_SB(0, 1), cB + hstepB, voffB); PG8_STAGE(PG8_SA(0, 1), cA + hstep, voffA);
    if (wr == 1) PG8_BAR;
    PG8_WAIT_V(4); PG8_BAR;
    PG8_STAGE(PG8_SB(1, 0), cB + kstep, voffB); PG8_STAGE(PG8_SA(1, 0), cA + kstep, voffA); PG8_STAGE(PG8_SB(1, 1), cB + hstepB + kstep, voffB);
    PG8_WAIT_V(6); PG8_BAR;
    PG8_STAMP();
    for (;;) {
        const bool has_next = S.next(ui + 1, nxt);
        const char* nA = has_next ? (const char*)g.A + (size_t)nxt.pm * tstep : cA; const char* nB = has_next ? (const char*)g.Bt + (size_t)nxt.pn * tstep : cB;
        for (int t = 0; t < nt; t += 2) {
            const bool last = (t == nt - 2);
            const char* a1 = cA + (size_t)(t + 1) * kstep;
            const char* a2 = last ? nA : cA + (size_t)(t + 2) * kstep; const char* b2 = last ? nB : cB + (size_t)(t + 2) * kstep;
            const char* a3 = a2 + kstep; const char* b3 = b2 + kstep;
            if (last && has_next) S.a_ready(nxt);
            PG8_LDB(B0, 0, 0); PG8_SCHED; PG8_LDA(At, 0, 0); PG8_STAGE(PG8_SA(1, 1), a1 + hstep, voffA);
            PG8_WAIT_L(8); PG8_BAR; PG8_WAIT_L(0); PG8_MMA(0, 0, At, B0); PG8_BAR; PG8_SCHED;
            PG8_LDB(B1, 0, 1); PG8_STAGE(PG8_SB(0, 0), b2, voffB);
            PG8_BAR; PG8_WAIT_L(0); PG8_MMA(0, 1, At, B1); PG8_BAR;
            PG8_LDA(At, 0, 1); PG8_STAGE(PG8_SA(0, 0), a2, voffA);
            PG8_BAR; PG8_WAIT_L(0); PG8_MMA(1, 0, At, B0); PG8_BAR; PG8_SCHED;
            PG8_STAGE(PG8_SB(0, 1), b2 + hstepB, voffB);
            PG8_WAIT_V(6); PG8_BAR; PG8_MMA(1, 1, At, B1); PG8_BAR;
            PG8_LDB(B0, 1, 0); PG8_SCHED; PG8_LDA(At, 1, 0); PG8_STAGE(PG8_SA(0, 1), a2 + hstep, voffA);
            PG8_WAIT_L(8); PG8_BAR; PG8_WAIT_L(0); PG8_MMA(0, 0, At, B0); PG8_BAR; PG8_SCHED;
            PG8_LDB(B1, 1, 1); PG8_STAGE(PG8_SB(1, 0), b3, voffB);
            PG8_BAR; PG8_WAIT_L(0); PG8_MMA(0, 1, At, B1); PG8_BAR;
            PG8_LDA(At, 1, 1); PG8_STAGE(PG8_SA(1, 0), a3, voffA);
            PG8_BAR; PG8_WAIT_L(0); PG8_MMA(1, 0, At, B0); PG8_BAR; PG8_SCHED;
            PG8_STAGE(PG8_SB(1, 1), b3 + hstepB, voffB);
            PG8_WAIT_V(6); PG8_BAR; PG8_MMA(1, 1, At, B1); PG8_BAR;
        }
        PG8_STAMP();
        if constexpr (!Epi::AFTER_DRAIN) { E(acc, cur, wr, wc, fr, fq); S.done(cur); }
        PG8_STAMP();
        if (!has_next) break;
#pragma unroll
        for (int a = 0; a < 2; ++a)
#pragma unroll
            for (int b = 0; b < 2; ++b)
#pragma unroll
                for (int m = 0; m < 4; ++m)
#pragma unroll
                    for (int n = 0; n < 2; ++n) acc[a][b][m][n] = (f32x4){0.f, 0.f, 0.f, 0.f};
        cur = nxt; cA = nA; cB = nB; ++ui;
    }
    PG8_WAIT_V(0);
    if (wr == 0) PG8_BAR;
    PG8_BAR;
    if constexpr (Epi::AFTER_DRAIN) { E.fused(acc, cur, wr, wc, fr, fq, lds, wid, lane); S.done(cur); }
    PG8_STAMP();
    if (STAMP && wid == 0) { stamps[lane] = lane < nts ? (((unsigned long long)(unsigned)ts_hi << 32) | (unsigned)ts_lo) : 0ull;
        if (lane == 62) stamps[62] = rt_entry; if (lane == 63) stamps[63] = (unsigned long long)wall_clock64(); }
#undef PG8_STAMP
#undef PG8_SA
#undef PG8_SB
#undef PG8_STAGE
#undef PG8_LDA
#undef PG8_LDB
#undef PG8_MMA
#undef PG8_WAIT_V
#undef PG8_WAIT_L
#undef PG8_BAR
#undef PG8_SCHED
}
}
namespace pg8 {
struct Gemm2 { const bf16_t* A0; const bf16_t* B0; int K0; const bf16_t* A1; const bf16_t* B1; int K1; };
template <class Epi, class Sched>
__device__ __forceinline__ void gemm_phase2(PG8_LAS unsigned char* lds, const Gemm2 g, const Sched& S, const Epi& E) {
    const int tid = threadIdx.x, wid = __builtin_amdgcn_readfirstlane(tid >> 6), lane = tid & 63, wr = wid >> 2, wc = wid & 3, fr = lane & 15, fq = lane >> 4;
    const int Ks[2] = {g.K0, g.K1};
    unsigned voffA[2][2], voffB[2][2]; size_t hstepA[2], hstepB[2], tstep[2];
#pragma unroll
    for (int s = 0; s < 2; ++s) { const int K = Ks[s];
#pragma unroll
        for (int i = 0; i < 2; ++i) { int R, C; stage_rc(tid * 16 + i * 8192, R, C); const int Rb = Epi::LINE ? (2 * (R & ~31) + perm32(R & 31)) : Epi::PERM ? ((R & ~31) + perm32(R & 31)) : R;
            voffA[s][i] = (unsigned)(R * K + C) * 2u; voffB[s][i] = (unsigned)(Rb * K + C) * 2u; }
        hstepA[s] = (size_t)HALF * K * 2; hstepB[s] = Epi::LINE ? (size_t)32 * K * 2 : hstepA[s]; tstep[s] = (size_t)BM * K * 2; }
    const size_t kstep = (size_t)(BK * 2);
    const unsigned ldsw = (unsigned)wid * 1024u;
    const int aoff = lds_byte(wr * 64 + fr, fq * 8), boff = lds_byte(wc * 32 + fr, fq * 8);
#define PG8_SA(b, h) (((b) * 2 + (h)) * HTB)
#define PG8_SB(b, h) ((4 + (b) * 2 + (h)) * HTB)
#define PG8_STAGE(bufoff, gbase, voff) do { _Pragma("unroll") for (int _i = 0; _i < 2; ++_i) \
        __builtin_amdgcn_global_load_lds((const unsigned*)((const char*)(gbase) + (voff)[_i]), (PG8_LAS unsigned*)(lds + (bufoff) + ldsw + _i * 8192), 16, 0, 0); } while (0)
#define PG8_LDA(dst, b, h) do { _Pragma("unroll") for (int m = 0; m < 4; ++m) _Pragma("unroll") for (int k = 0; k < 2; ++k) dst[m][k] = *(const PG8_LAS bf16x8*)(lds + PG8_SA(b, h) + aoff + m * 2048 + k * 1024); } while (0)
#define PG8_LDB(dst, b, h) do { _Pragma("unroll") for (int n = 0; n < 2; ++n) _Pragma("unroll") for (int k = 0; k < 2; ++k) dst[n][k] = *(const PG8_LAS bf16x8*)(lds + PG8_SB(b, h) + boff + n * 2048 + k * 1024); } while (0)
#define PG8_MMA(ai, bj, At, Bt) do { __builtin_amdgcn_s_setprio(1); _Pragma("unroll") for (int m = 0; m < 4; ++m) _Pragma("unroll") for (int n = 0; n < 2; ++n) _Pragma("unroll") for (int k = 0; k < 2; ++k) \
        acc[ai][bj][m][n] = __builtin_amdgcn_mfma_f32_16x16x32_bf16(Bt[n][k], At[m][k], acc[ai][bj][m][n], 0, 0, 0); __builtin_amdgcn_s_setprio(0); } while (0)
#define PG8_WAIT_V(n) asm volatile("s_waitcnt vmcnt(" #n ")" ::: "memory")
#define PG8_WAIT_L(n) asm volatile("s_waitcnt lgkmcnt(" #n ")" ::: "memory")
#define PG8_BAR __builtin_amdgcn_s_barrier()
#define PG8_SCHED __builtin_amdgcn_sched_barrier(0)
    Unit cur, nxt; int ui = 0;
    if (!S.next(0, cur)) return;
    f32x4 acc[2][2][4][2];
#pragma unroll
    for (int a = 0; a < 2; ++a)
#pragma unroll
        for (int b = 0; b < 2; ++b)
#pragma unroll
            for (int m = 0; m < 4; ++m)
#pragma unroll
                for (int n = 0; n < 2; ++n) acc[a][b][m][n] = (f32x4){0.f, 0.f, 0.f, 0.f};
    bf16x8 At[4][2], B0[2][2], B1[2][2];
    int seg = 0;
    const char* cA = (const char*)g.A0 + (size_t)cur.pm * tstep[0]; const char* cB = (const char*)g.B0 + (size_t)cur.pn * tstep[0];
    S.a_ready(cur);
    PG8_STAGE(PG8_SB(0, 0), cB, voffB[0]); PG8_STAGE(PG8_SA(0, 0), cA, voffA[0]); PG8_STAGE(PG8_SB(0, 1), cB + hstepB[0], voffB[0]); PG8_STAGE(PG8_SA(0, 1), cA + hstepA[0], voffA[0]);
    if (wr == 1) PG8_BAR;
    PG8_WAIT_V(4); PG8_BAR;
    PG8_STAGE(PG8_SB(1, 0), cB + kstep, voffB[0]); PG8_STAGE(PG8_SA(1, 0), cA + kstep, voffA[0]); PG8_STAGE(PG8_SB(1, 1), cB + hstepB[0] + kstep, voffB[0]);
    PG8_WAIT_V(6); PG8_BAR;
    for (;;) {
        bool has_next = true; const char* nA; const char* nB; const int nseg = 1 - seg;
        if (seg == 0) { nA = (const char*)g.A1 + (size_t)cur.pm * tstep[1]; nB = (const char*)g.B1 + (size_t)cur.pn * tstep[1]; }
        else { has_next = S.next(ui + 1, nxt); const Unit& q = has_next ? nxt : cur; nA = (const char*)g.A0 + (size_t)q.pm * tstep[0]; nB = (const char*)g.B0 + (size_t)q.pn * tstep[0]; }
        const int nt = (seg ? g.K1 : g.K0) / BK;
        for (int t = 0; t < nt; t += 2) {
            const bool last = (t == nt - 2);
            const char* a1 = cA + (size_t)(t + 1) * kstep;
            const char* a2 = last ? nA : cA + (size_t)(t + 2) * kstep; const char* b2 = last ? nB : cB + (size_t)(t + 2) * kstep;
            const char* a3 = a2 + kstep; const char* b3 = b2 + kstep;
            const int s2 = last ? nseg : seg;
            unsigned vA2[2], vB2[2]; vA2[0] = s2 ? voffA[1][0] : voffA[0][0]; vA2[1] = s2 ? voffA[1][1] : voffA[0][1]; vB2[0] = s2 ? voffB[1][0] : voffB[0][0]; vB2[1] = s2 ? voffB[1][1] : voffB[0][1];
            unsigned vA1[2]; vA1[0] = seg ? voffA[1][0] : voffA[0][0]; vA1[1] = seg ? voffA[1][1] : voffA[0][1];
            const size_t hA1 = seg ? hstepA[1] : hstepA[0], hA2 = s2 ? hstepA[1] : hstepA[0], hB2 = s2 ? hstepB[1] : hstepB[0];
            if (last && seg == 1 && has_next) S.a_ready(nxt);
            PG8_LDB(B0, 0, 0); PG8_SCHED; PG8_LDA(At, 0, 0); PG8_STAGE(PG8_SA(1, 1), a1 + hA1, vA1);
            PG8_WAIT_L(8); PG8_BAR; PG8_WAIT_L(0); PG8_MMA(0, 0, At, B0); PG8_BAR; PG8_SCHED;
            PG8_LDB(B1, 0, 1); PG8_STAGE(PG8_SB(0, 0), b2, vB2);
            PG8_BAR; PG8_WAIT_L(0); PG8_MMA(0, 1, At, B1); PG8_BAR;
            PG8_LDA(At, 0, 1); PG8_STAGE(PG8_SA(0, 0), a2, vA2);
            PG8_BAR; PG8_WAIT_L(0); PG8_MMA(1, 0, At, B0); PG8_BAR; PG8_SCHED;
            PG8_STAGE(PG8_SB(0, 1), b2 + hB2, vB2);
            PG8_WAIT_V(6); PG8_BAR; PG8_MMA(1, 1, At, B1); PG8_BAR;
            PG8_LDB(B0, 1, 0); PG8_SCHED; PG8_LDA(At, 1, 0); PG8_STAGE(PG8_SA(0, 1), a2 + hA2, vA2);
            PG8_WAIT_L(8); PG8_BAR; PG8_WAIT_L(0); PG8_MMA(0, 0, At, B0); PG8_BAR; PG8_SCHED;
            PG8_LDB(B1, 1, 1); PG8_STAGE(PG8_SB(1, 0), b3, vB2);
            PG8_BAR; PG8_WAIT_L(0); PG8_MMA(0, 1, At, B1); PG8_BAR;
            PG8_LDA(At, 1, 1); PG8_STAGE(PG8_SA(1, 0), a3, vA2);
            PG8_BAR; PG8_WAIT_L(0); PG8_MMA(1, 0, At, B0); PG8_BAR; PG8_SCHED;
            PG8_STAGE(PG8_SB(1, 1), b3 + hB2, vB2);
            PG8_WAIT_V(6); PG8_BAR; PG8_MMA(1, 1, At, B1); PG8_BAR;
        }
        if (seg == 0) { E.mid(acc, cur, wr, wc, fr, fq); seg = 1; cA = nA; cB = nB; continue; }
        E(acc, cur, wr, wc, fr, fq); S.done(cur);
        if (!has_next) break;
#pragma unroll
        for (int a = 0; a < 2; ++a)
#pragma unroll
            for (int b = 0; b < 2; ++b)
#pragma unroll
                for (int m = 0; m < 4; ++m)
#pragma unroll
                    for (int n = 0; n < 2; ++n) acc[a][b][m][n] = (f32x4){0.f, 0.f, 0.f, 0.f};
        cur = nxt; cA = nA; cB = nB; seg = 0; ++ui;
    }
    PG8_WAIT_V(0);
    if (wr == 0) PG8_BAR;
    PG8_BAR;
#undef PG8_SA
#undef PG8_SB
#undef PG8_STAGE
#undef PG8_LDA
#undef PG8_LDB
#undef PG8_MMA
#undef PG8_WAIT_V
#undef PG8_WAIT_L
#undef PG8_BAR
#undef PG8_SCHED
}
}

#define LAS __attribute__((address_space(3)))
typedef unsigned short bf16_t;
typedef float f32x4 __attribute__((ext_vector_type(4)));
typedef float f32x2 __attribute__((ext_vector_type(2)));
typedef unsigned u32x4 __attribute__((ext_vector_type(4)));
typedef unsigned u32x2 __attribute__((ext_vector_type(2)));

constexpr int NB = 8, SEQ = 4096, NMETA = 16, LT = SEQ + NMETA, DM = 1024, T = NB * SEQ;
constexpr int DHY = 512, DRG = 1024, DIN = 3 * DHY + 2 * DRG + 2 * DM;
constexpr int NTHR = 512, NWAVES = 8;
constexpr int LDS_BYTES = 160 * 1024;
constexpr float EPSF = 1e-6f;
constexpr int KFW = 2 * LT;
constexpr int SP = 4256;
constexpr int NEXP = 16384;
constexpr int RG_SPLIT = 33, RG_U1 = RG_SPLIT * 64;
constexpr int RG_NF = LT - RG_U1;

enum { I_X = 0, I_META, I_GFINAL, I_GMIX, I_WIN, I_BGATE, I_HYCW, I_HYCB, I_HYW1, I_HYB1, I_HYW2, I_HYB2, I_HYW3, I_HYB3, I_HYFREQ, I_HYSKIP,
       I_HYOUT, I_RGCW, I_RGCB, I_RGGW, I_RGGB, I_RGLAM, I_RGOUT, I_WOUT, I_GFFN, I_WQ, I_KEYS, I_PU, I_PV, N_IN };

constexpr size_t MiB = 1024ull * 1024ull;
constexpr size_t WS_ROWSS = 64 * 1024;
constexpr size_t WS_SU = 256 * 1024;
constexpr size_t WS_SV = 320 * 1024;
constexpr size_t WS_ROWSS2 = 384 * 1024;
constexpr size_t WS_BAR = 512 * 1024;
constexpr size_t WS_WINT = 1 * MiB;
constexpr size_t WS_WHT = 12 * MiB;
constexpr size_t WS_WRT = 13 * MiB;
constexpr size_t WS_WOT = 15 * MiB;
constexpr size_t WS_WST = 17 * MiB;
constexpr size_t WS_GWT = 21 * MiB;
constexpr size_t WS_KF = 22 * MiB;
constexpr size_t WS_KFB = 39 * MiB;
constexpr size_t WS_HYIN = 48 * MiB;
constexpr size_t WS_RGX = 145 * MiB;
constexpr size_t WS_GG = 210 * MiB;
constexpr size_t WS_GA = 274 * MiB;
constexpr size_t WS_GB = 338 * MiB;
constexpr size_t WS_XN1 = 402 * MiB;
constexpr size_t WS_UUT = 402 * MiB;
constexpr size_t WS_CONVT = 436 * MiB;
constexpr size_t WS_YH = 468 * MiB;
constexpr size_t WS_YR = WS_RGX;
constexpr size_t WS_MERGED = WS_HYIN;
constexpr size_t WS_TMP = WS_GG;
constexpr size_t WS_H1B = WS_RGX;
constexpr size_t WS_SCORES = WS_GG;
constexpr size_t WS_EIDX = 468 * MiB;
constexpr size_t WS_EG = 484 * MiB;
constexpr size_t WS_UB = 48 * MiB;
constexpr size_t WS_VB = 64 * MiB;
constexpr size_t WS_PD = 210 * MiB;
constexpr size_t WS_PO = WS_PD;
constexpr size_t WS_ACT = 338 * MiB;
constexpr size_t WS_RGP = 48 * MiB;
constexpr size_t WS_RGC = 576 * 1024;
constexpr size_t WS_END = 500 * MiB;

struct Args { const float* in[N_IN]; float* out; unsigned char* ws; int ph_lo, ph_hi; };

__device__ __forceinline__ float bf2f(unsigned v) { return __uint_as_float(v << 16); }
typedef __bf16 bf16x2_t __attribute__((ext_vector_type(2)));
__device__ __forceinline__ unsigned pk2(float lo, float hi) { bf16x2_t v; v.x = (__bf16)lo; v.y = (__bf16)hi; return __builtin_bit_cast(unsigned, v); }
__device__ __forceinline__ unsigned f2bf(float f) { return pk2(f, f) & 0xffffu; }
__device__ __forceinline__ float bflo(unsigned w) { return __uint_as_float(w << 16); }
__device__ __forceinline__ float bfhi(unsigned w) { return __uint_as_float(w & 0xffff0000u); }
__device__ __forceinline__ float wave_sum(float v) {
#pragma unroll
    for (int o = 1; o < 64; o <<= 1) v += __shfl_xor(v, o);
    return v;
}
__device__ __forceinline__ float wave_max(float v) {
#pragma unroll
    for (int o = 1; o < 64; o <<= 1) v = fmaxf(v, __shfl_xor(v, o));
    return v;
}
__device__ __forceinline__ float fexp(float x) { return __builtin_amdgcn_exp2f(x * 1.4426950408889634f); }
__device__ __forceinline__ float sigmoidf_(float x) { return __builtin_amdgcn_rcpf(1.0f + fexp(-x)); }
__device__ __forceinline__ float gelu_tanh(float x) { const float u = 1.5957691216f * (x + 0.044715f * x * x * x); return x * __builtin_amdgcn_rcpf(1.0f + fexp(-u)); }
__device__ __forceinline__ void sincos_acc(float a, float& s, float& c) {
    const double x = (double)a;
    const double q = rint(x * 0.63661977236758134308);
    const double r = fma(-q, 1.57079632679489661923, x);
    const int n = (int)q;
    const float rf = (float)r, r2 = rf * rf;
    const float sp = rf * (1.f + r2 * (-1.6666667e-1f + r2 * (8.3333333e-3f + r2 * (-1.9841270e-4f + r2 * 2.7557319e-6f))));
    const float cp = 1.f + r2 * (-0.5f + r2 * (4.1666667e-2f + r2 * (-1.3888889e-3f + r2 * (2.4801587e-5f + r2 * (-2.7557319e-7f)))));
    const int k = n & 3;
    s = (k == 0) ? sp : (k == 1) ? cp : (k == 2) ? -sp : -cp;
    c = (k == 0) ? cp : (k == 1) ? -sp : (k == 2) ? -cp : sp;
}

typedef float f32x2v __attribute__((ext_vector_type(2)));
__device__ __forceinline__ float wave_sum_dpp(float v) {
    v += __int_as_float(__builtin_amdgcn_update_dpp(0, __float_as_int(v), 0xB1, 0xF, 0xF, true));
    v += __int_as_float(__builtin_amdgcn_update_dpp(0, __float_as_int(v), 0x4E, 0xF, 0xF, true));
    v += __int_as_float(__builtin_amdgcn_update_dpp(0, __float_as_int(v), 0x141, 0xF, 0xF, true));
    v += __int_as_float(__builtin_amdgcn_update_dpp(0, __float_as_int(v), 0x140, 0xF, 0xF, true));
    const int vi = __float_as_int(v);
    return (__int_as_float(__builtin_amdgcn_readlane(vi, 0)) + __int_as_float(__builtin_amdgcn_readlane(vi, 16))) + (__int_as_float(__builtin_amdgcn_readlane(vi, 32)) + __int_as_float(__builtin_amdgcn_readlane(vi, 48)));
}
__device__ __forceinline__ float wave_max_dpp(float v) {
    v = fmaxf(v, __int_as_float(__builtin_amdgcn_update_dpp(0, __float_as_int(v), 0xB1, 0xF, 0xF, true)));
    v = fmaxf(v, __int_as_float(__builtin_amdgcn_update_dpp(0, __float_as_int(v), 0x4E, 0xF, 0xF, true)));
    v = fmaxf(v, __int_as_float(__builtin_amdgcn_update_dpp(0, __float_as_int(v), 0x141, 0xF, 0xF, true)));
    v = fmaxf(v, __int_as_float(__builtin_amdgcn_update_dpp(0, __float_as_int(v), 0x140, 0xF, 0xF, true)));
    const int vi = __float_as_int(v);
    return fmaxf(fmaxf(__int_as_float(__builtin_amdgcn_readlane(vi, 0)), __int_as_float(__builtin_amdgcn_readlane(vi, 16))), fmaxf(__int_as_float(__builtin_amdgcn_readlane(vi, 32)), __int_as_float(__builtin_amdgcn_readlane(vi, 48))));
}

#ifndef SLICE_PROBE
#define SLICE_OF(b) ((b) & 7)
#define RANK_OF(b) ((b) >> 3)
#else
#define SLICE_OF(b) ((b) >> 5)
#define RANK_OF(b) ((b) & 31)
#endif

__device__ __forceinline__ float dpp_xor8(float v) { return __int_as_float(__builtin_amdgcn_update_dpp(0, __float_as_int(v), 0x128, 0xF, 0xF, true)); }

#ifdef NT_STORES3
#define NT_ST(p, v) __builtin_nontemporal_store((v), (p))
#else
#define NT_ST(p, v) (*(p) = (v))
#endif

#ifdef NT_LOADS
#define NT_LD(p) __builtin_nontemporal_load(p)
#else
#define NT_LD(p) (*(p))
#endif
#define XB_TMO      128
#define XB_XCNT(j)  (256  + 64 * (j))
#define XB_XSUB(j)  (1280 + 64 * (j))
#define XB_XGEN(j)  (2304 + 64 * (j))
#define XB_TOP      3328
#define XB_TOPGEN   3392
#define XCD_BAR_WORDS 3456
#define XB_SPIN_CAP (1u << 18)

__device__ __forceinline__ unsigned xb_ld(unsigned* p)              { return __hip_atomic_load(p, __ATOMIC_RELAXED, __HIP_MEMORY_SCOPE_AGENT); }
__device__ __forceinline__ unsigned xb_add(unsigned* p, unsigned v) { return __hip_atomic_fetch_add(p, v, __ATOMIC_RELAXED, __HIP_MEMORY_SCOPE_AGENT); }
__device__ __forceinline__ unsigned xb_xcc_id() { return (unsigned)__builtin_amdgcn_s_getreg((3 << 11) | 20) & 0xFu; }
#define XB_SPIN(cond, bar) do { unsigned _sp = 0; while (cond) { __builtin_amdgcn_s_sleep(1); \
    if ((++_sp & 255u) == 0u) { if (xb_ld(&(bar)[XB_TMO])) break; if (_sp > XB_SPIN_CAP) { atomicAdd(&(bar)[XB_TMO], 1u); break; } } } } while (0)

struct XcdBarrier {
    unsigned* bar; unsigned x;
    volatile LAS unsigned* st;
};

__device__ __forceinline__ XcdBarrier xcd_barrier_post(unsigned* bar, volatile LAS unsigned* st) {
    XcdBarrier b; b.bar = bar; b.x = xb_xcc_id(); b.st = st;
    if (threadIdx.x == 0) (void)xb_add(&bar[XB_XCNT(b.x)], 1u);
    return b;
}
__device__ __forceinline__ void xcd_barrier_complete(unsigned* bar, unsigned x, unsigned& nloc, unsigned& nx) {
    const unsigned G = gridDim.x * gridDim.y * gridDim.z;
    unsigned sum, cnt, mine, sp = 0u;
    for (;;) {
        sum = 0u; cnt = 0u; mine = 0u;
#pragma unroll
        for (unsigned j = 0; j < 16; ++j) { const unsigned c = xb_ld(&bar[XB_XCNT(j)]); sum += c; cnt += (c > 0u) ? 1u : 0u; mine = (j == x) ? c : mine; }
        if (sum == G) break;
        __builtin_amdgcn_s_sleep(1);
        if ((++sp & 255u) == 0u) { if (xb_ld(&bar[XB_TMO])) break; if (sp > XB_SPIN_CAP) { atomicAdd(&bar[XB_TMO], 1u); break; } }
    }
    nloc = mine > 0u ? mine : 1u; nx = cnt > 0u ? cnt : 1u;
}

__device__ __forceinline__ void xcd_barrier(const XcdBarrier& b) {
    asm volatile("s_waitcnt vmcnt(0)" ::: "memory");
    __syncthreads();
    if (threadIdx.x == 0) {
        unsigned* bar = b.bar;
        __builtin_amdgcn_s_waitcnt(0);
        unsigned nloc = b.st[0], nx = b.st[1];
        if (nloc == 0u) { xcd_barrier_complete(bar, b.x, nloc, nx); b.st[0] = nloc; b.st[1] = nx; }
        const unsigned old = xb_add(&bar[XB_XSUB(b.x)], 1u);
        const unsigned gen = old / nloc;
        if (old + 1u == (gen + 1u) * nloc) {
            __builtin_amdgcn_fence(__ATOMIC_RELEASE, "agent");
            asm volatile("s_waitcnt vmcnt(0)" ::: "memory");
            const unsigned og = xb_add(&bar[XB_TOP], 1u);
            const unsigned tg = og / nx;
            if (og + 1u == (tg + 1u) * nx) xb_add(&bar[XB_TOPGEN], 1u);
            else XB_SPIN(xb_ld(&bar[XB_TOPGEN]) == tg, bar);
            __builtin_amdgcn_fence(__ATOMIC_ACQUIRE, "agent");
            xb_add(&bar[XB_XGEN(b.x)], 1u);
            asm volatile("s_waitcnt vmcnt(0)" ::: "memory");
        } else {
            XB_SPIN(xb_ld(&bar[XB_XGEN(b.x)]) == gen, bar);
            __builtin_amdgcn_fence(__ATOMIC_ACQUIRE, "agent");
            asm volatile("s_waitcnt vmcnt(0)" ::: "memory");
        }
    }
    __syncthreads();
}

__device__ __forceinline__ void p0_transpose_item(const float* W, int K, int N, bf16_t* WT, LAS float* scr, int item, int lane) {
    const int nblk = N / 32, kb = item / nblk, nb = item % nblk, k0 = 64 * kb, n0 = 32 * nb;
#pragma unroll 8
    for (int i = 0; i < 32; ++i) { const int kk = 2 * i + (lane >> 5); scr[kk * 33 + (lane & 31)] = W[(size_t)(k0 + kk) * N + n0 + (lane & 31)]; }
    asm volatile("s_waitcnt lgkmcnt(0)" ::: "memory");
    const int c = lane & 7;
#pragma unroll
    for (int j = 0; j < 4; ++j) { const int n = (lane >> 3) + 8 * j; const LAS float* s = scr + (8 * c) * 33 + n;
        u32x4 o; o.x = pk2(s[0 * 33], s[1 * 33]); o.y = pk2(s[2 * 33], s[3 * 33]); o.z = pk2(s[4 * 33], s[5 * 33]); o.w = pk2(s[6 * 33], s[7 * 33]);
        *(u32x4*)(WT + (size_t)(n0 + n) * K + k0 + 8 * c) = o; }
    asm volatile("s_waitcnt lgkmcnt(0)" ::: "memory");
}
__device__ __forceinline__ void p0_xn1_row(const float* xrow, const float* g, bf16_t* orow, int lane) {
    const f32x4* xr = (const f32x4*)xrow + lane; const f32x4* gr = (const f32x4*)g + lane;
    f32x4 v[4]; float s = 0.f;
#pragma unroll
    for (int j = 0; j < 4; ++j) { v[j] = NT_LD(xr + 64 * j); s += (v[j].x * v[j].x + v[j].y * v[j].y) + (v[j].z * v[j].z + v[j].w * v[j].w); }
    const float rstd = rsqrtf(wave_sum(s) * (1.f / DM) + EPSF);
    unsigned long long* o8 = (unsigned long long*)orow + lane;
#pragma unroll
    for (int j = 0; j < 4; ++j) { const f32x4 gv = gr[64 * j];
        o8[64 * j] = (unsigned long long)pk2(v[j].x * rstd * gv.x, v[j].y * rstd * gv.y) | ((unsigned long long)pk2(v[j].z * rstd * gv.z, v[j].w * rstd * gv.w) << 32); }
}
__device__ __forceinline__ void p0_fold_item(const Args& a, LAS unsigned char* lds, int item, int tid) {
    const int hp = item >> 4, k0 = (item & 15) * 64;
    LAS float* kl = (LAS float*)lds;
    LAS float* wl = (LAS float*)(lds + 128 * 129 * 4);
    const float* keys = a.in[I_KEYS] + (size_t)hp * 128 * 128; const float* wq = a.in[I_WQ];
    for (int i = tid; i < 128 * 128; i += NTHR) { const int key = i >> 7, d = i & 127; kl[key * 129 + d] = keys[i]; }
    for (int i = tid; i < 64 * 128; i += NTHR) { const int kk = i >> 7, d = i & 127; wl[i] = wq[(size_t)(k0 + kk) * 2048 + hp * 128 + d]; }
    __syncthreads();
    const int key = tid & 127, kq = tid >> 7;
    float acc[16];
#pragma unroll
    for (int i = 0; i < 16; ++i) acc[i] = 0.f;
#pragma unroll 2
    for (int d = 0; d < 128; d += 4) { const float kv0 = kl[key * 129 + d], kv1 = kl[key * 129 + d + 1], kv2 = kl[key * 129 + d + 2], kv3 = kl[key * 129 + d + 3];
#pragma unroll
        for (int i = 0; i < 16; ++i) { const f32x4 wv = *(const LAS f32x4*)(wl + (kq * 16 + i) * 128 + d);
            acc[i] += wv.x * kv0; acc[i] += wv.y * kv1; acc[i] += wv.z * kv2; acc[i] += wv.w * kv3; } }
    const float* gf = a.in[I_GFFN] + k0 + kq * 16;
    bf16_t* dst = (bf16_t*)(a.ws + WS_WST) + (size_t)(hp * 128 + key) * 1024 + k0 + kq * 16;
    u32x4 o0, o1;
    o0.x = pk2(acc[0] * gf[0], acc[1] * gf[1]); o0.y = pk2(acc[2] * gf[2], acc[3] * gf[3]); o0.z = pk2(acc[4] * gf[4], acc[5] * gf[5]); o0.w = pk2(acc[6] * gf[6], acc[7] * gf[7]);
    o1.x = pk2(acc[8] * gf[8], acc[9] * gf[9]); o1.y = pk2(acc[10] * gf[10], acc[11] * gf[11]); o1.z = pk2(acc[12] * gf[12], acc[13] * gf[13]); o1.w = pk2(acc[14] * gf[14], acc[15] * gf[15]);
    *(u32x4*)dst = o0; *(u32x4*)(dst + 8) = o1;
    __syncthreads();
}
__device__ __forceinline__ void p0_meta_item(const Args& a, LAS unsigned char* lds, int item, int tid, int wave, int lane) {
    LAS float* mt = (LAS float*)lds;
    for (int r = wave * 2; r < wave * 2 + 2; ++r) {
        const f32x4* xr = (const f32x4*)(a.in[I_META] + (size_t)r * DM) + lane; const f32x4* gr = (const f32x4*)a.in[I_GMIX] + lane;
        f32x4 v[4]; float s = 0.f;
#pragma unroll
        for (int j = 0; j < 4; ++j) { v[j] = xr[64 * j]; s += (v[j].x * v[j].x + v[j].y * v[j].y) + (v[j].z * v[j].z + v[j].w * v[j].w); }
        const float rstd = rsqrtf(wave_sum(s) * (1.f / DM) + EPSF);
#pragma unroll
        for (int j = 0; j < 4; ++j) { const f32x4 gv = gr[64 * j]; f32x4 o = v[j] * rstd * gv; *(LAS f32x4*)(mt + r * 1024 + 4 * (lane + 64 * j)) = o; }
    }
    __syncthreads();
    const int col = item * 256 + (tid & 255), rh = tid >> 8;
    float acc[8];
#pragma unroll
    for (int r = 0; r < 8; ++r) acc[r] = 0.f;
    const float* w = a.in[I_WIN] + col;
#pragma unroll 4
    for (int k = 0; k < 1024; ++k) { const float wv = w[(size_t)k * DIN];
#pragma unroll
        for (int r = 0; r < 8; ++r) acc[r] += mt[(rh * 8 + r) * 1024 + k] * wv; }
    bf16_t* hyin = (bf16_t*)(a.ws + WS_HYIN); bf16_t* rgx = (bf16_t*)(a.ws + WS_RGX);
#pragma unroll
    for (int r = 0; r < 8; ++r) { const int t = rh * 8 + r; const bf16_t v = (bf16_t)f2bf(acc[r]);
        for (int b = 0; b < NB; ++b) { if (col < 1536) hyin[((size_t)b * LT + t) * 1536 + col] = v; else rgx[((size_t)b * LT + t) * 1024 + (col - 1536)] = v; } }
    __syncthreads();
}
constexpr int FPP = 17, NFILT = (LT + FPP - 1) / FPP;
__device__ __forceinline__ void sincos_hw(float a, float& s, float& c) { const float r = a * 0.15915494309189535f; const float f = r - rintf(r); s = __builtin_amdgcn_sinf(f); c = __builtin_amdgcn_cosf(f); }
__device__ __forceinline__ void p0_filter_item(const Args& a, LAS unsigned char* lds, int item, int tid) {
    LAS float* z = (LAS float*)lds;
    LAS float* h1 = z + FPP * 33;
    LAS float* h2 = h1 + FPP * 64;
    LAS float* ko = h2 + FPP * 64;
    const int p0 = item * FPP;
    for (int idx = tid; idx < FPP * 33; idx += NTHR) { const int pp = idx / 33, f = idx % 33, p = p0 + pp;
        float v;
        if (f == 0) v = (float)p * (1.0f / (float)(LT - 1));
        else { const int bi = (f - 1) & 15; const float band = 1e-4f + (float)bi * ((15.0f - 1e-4f) / 15.0f); const float w = (float)(6.283185307179586 / (double)LT) * (float)p;
            float s, c; sincos_hw(band * w, s, c); v = (f <= 16) ? c : -s; }
        z[idx] = v; }
    __syncthreads();
    const float* w1 = a.in[I_HYW1]; const float* b1 = a.in[I_HYB1]; const float* w2 = a.in[I_HYW2]; const float* b2 = a.in[I_HYB2];
    const float* w3 = a.in[I_HYW3]; const float* b3 = a.in[I_HYB3]; const float* fr = a.in[I_HYFREQ];
    { const int j = tid & 63, pq = tid >> 6;
        float wv[33];
#pragma unroll
        for (int f = 0; f < 33; ++f) wv[f] = w1[f * 64 + j];
        const float bj = b1[j], fj = fr[j];
        for (int pp = pq; pp < FPP; pp += 8) { float acc = bj;
#pragma unroll
            for (int f = 0; f < 33; ++f) acc += z[pp * 33 + f] * wv[f];
            float s, c; sincos_hw(fj * acc, s, c); h1[pp * 64 + j] = s; } }
    __syncthreads();
    { const int j = tid & 63, pq = tid >> 6;
        const float bj = b2[j], fj = fr[64 + j]; float accp[3] = {bj, bj, bj};
#pragma unroll 1
        for (int fh = 0; fh < 2; ++fh) { float wv[32];
#pragma unroll
            for (int f = 0; f < 32; ++f) wv[f] = w2[(fh * 32 + f) * 64 + j];
#pragma unroll
            for (int t3 = 0; t3 < 3; ++t3) { const int pp = pq + 8 * t3; if (pp < FPP) { float acc = accp[t3];
#pragma unroll
                for (int f = 0; f < 32; ++f) acc += h1[pp * 64 + fh * 32 + f] * wv[f];
                accp[t3] = acc; } } }
#pragma unroll
        for (int t3 = 0; t3 < 3; ++t3) { const int pp = pq + 8 * t3; if (pp < FPP) { float s, c; sincos_hw(fj * accp[t3], s, c); h2[pp * 64 + j] = s; } } }
    __syncthreads();
#pragma unroll 1
    for (int half = 0; half < 2; ++half) { const int o = half * 512 + tid;
        const float bo = b3[o];
        const float delta = fabsf(-15.350567286626972f + (float)tid * ((-3.0701134573253945f + 15.350567286626972f) / 511.0f));
#pragma unroll 1
        for (int ih = 0; ih < 2; ++ih) { float wv[32];
#pragma unroll
            for (int i = 0; i < 32; ++i) wv[i] = w3[(ih * 32 + i) * 1024 + o];
#pragma unroll 1
            for (int pp = 0; pp < FPP; ++pp) { float acc = ih ? ko[o * (FPP + 1) + pp] : bo;
#pragma unroll
                for (int i = 0; i < 32; ++i) acc += h2[pp * 64 + ih * 32 + i] * wv[i];
                if (ih) { const float tn = (float)(p0 + pp) * (1.0f / (float)(LT - 1)); acc *= __expf(-tn * delta); }
                ko[o * (FPP + 1) + pp] = acc; } }
    }
    __syncthreads();
    bf16_t* kfb = (bf16_t*)(a.ws + WS_KFB);
    for (int idx = tid; idx < 1024 * FPP; idx += NTHR) { const int o = idx / FPP, pp = idx - o * FPP, dir = o >> 9, c = o & 511, p = p0 + pp;
        if (p < LT) { const float v = ko[o * (FPP + 1) + pp];
            if (dir == 0) kfb[(size_t)c * KFW + (LT - 1) + p] = (bf16_t)f2bf(p == 0 ? v + a.in[I_HYSKIP][c] : v);
            else if (p >= 1) kfb[(size_t)c * KFW + (LT - 1) - p] = (bf16_t)f2bf(v); } }
    if (item == 0) for (int c = tid; c < 512; c += NTHR) kfb[(size_t)c * KFW + KFW - 1] = 0;
    __syncthreads();
}
template <int PART> __device__ __forceinline__ void phase_p0(const Args& a, LAS unsigned char* lds, int tid, int wave, int lane) {
    const int G = gridDim.x, bx = blockIdx.x;
    if (PART == 0)
    { float* rs = (float*)(a.ws + WS_ROWSS); float* rs2 = (float*)(a.ws + WS_ROWSS2); for (int i = bx * NTHR + tid; i < T; i += G * NTHR) { rs[i] = 0.f; rs2[i] = 0.f; } }
    for (int it = bx; it < 256 + NFILT; it += G) {
#ifndef P0M
#define P0M 7
#endif
        if (it < 256) { if (PART == 0) p0_fold_item(a, lds, it, tid); }
        else { if (PART == 1) p0_filter_item(a, lds, it - 256, tid); }

    }
}
__device__ __forceinline__ void phase_p0b(const Args& a, LAS unsigned char* lds, int tid, int wave, int lane) {
    const int G = gridDim.x, bx = blockIdx.x;
    LAS float* scr = (LAS float*)(lds + wave * 16384);
    const int gw = bx * NWAVES + wave, NGW = G * NWAVES;
    constexpr int I_IN = (1024 / 64) * (DIN / 32), I_H = (512 / 64) * (1024 / 32), I_R = (1024 / 64) * (1024 / 32), I_O = I_R;
    for (int it = gw; it < I_IN + I_H + I_R + I_O; it += NGW) {
        int r = it;
        if (r < I_IN) { p0_transpose_item(a.in[I_WIN], 1024, DIN, (bf16_t*)(a.ws + WS_WINT), scr, r, lane); continue; } r -= I_IN;
        if (r < I_H) { p0_transpose_item(a.in[I_HYOUT], 512, 1024, (bf16_t*)(a.ws + WS_WHT), scr, r, lane); continue; } r -= I_H;
        if (r < I_R) { p0_transpose_item(a.in[I_RGOUT], 1024, 1024, (bf16_t*)(a.ws + WS_WRT), scr, r, lane); continue; } r -= I_R;
        p0_transpose_item(a.in[I_WOUT], 1024, 1024, (bf16_t*)(a.ws + WS_WOT), scr, r, lane);
    }
}
__device__ __forceinline__ void phase_p0c(const Args& a, LAS unsigned char* lds, int tid, int wave, int lane) {
    const int G = gridDim.x, bx = blockIdx.x; const int gw = bx * NWAVES + wave, NGW = G * NWAVES;
    const f32x4* gr = (const f32x4*)a.in[I_GMIX] + lane; f32x4 gv[4];
#pragma unroll
    for (int j = 0; j < 4; ++j) gv[j] = gr[64 * j];
    for (int m0 = gw; m0 < T; m0 += 4 * NGW) {
        f32x4 v[4][4];
#pragma unroll
        for (int r = 0; r < 4; ++r) { const int m = (m0 + r * NGW < T) ? m0 + r * NGW : m0; const f32x4* xr = (const f32x4*)(a.in[I_X] + (size_t)m * DM) + lane;
#pragma unroll
            for (int j = 0; j < 4; ++j) v[r][j] = xr[64 * j]; }
#pragma unroll
        for (int r = 0; r < 4; ++r) { const int m = m0 + r * NGW; if (m >= T) break;
            float ss = 0.f;
#pragma unroll
            for (int j = 0; j < 4; ++j) ss += (v[r][j].x * v[r][j].x + v[r][j].y * v[r][j].y) + (v[r][j].z * v[r][j].z + v[r][j].w * v[r][j].w);
            const float rstd = rsqrtf(wave_sum_dpp(ss) * (1.f / DM) + EPSF);
            unsigned long long* o8 = (unsigned long long*)((bf16_t*)(a.ws + WS_XN1) + (size_t)m * DM) + lane;
#pragma unroll
            for (int j = 0; j < 4; ++j) o8[64 * j] = (unsigned long long)pk2(v[r][j].x * rstd * gv[j].x, v[r][j].y * rstd * gv[j].y) | ((unsigned long long)pk2(v[r][j].z * rstd * gv[j].z, v[r][j].w * rstd * gv[j].w) << 32); }
    }
}

__device__ __forceinline__ void p1_meta(const Args& a, LAS unsigned char* lds, int tid, int wave, int lane) {
    LAS float* mt = (LAS float*)lds;
    for (int r = wave * 2; r < wave * 2 + 2; ++r) {
        const f32x4* xr = (const f32x4*)(a.in[I_META] + (size_t)r * DM) + lane; const f32x4* gr = (const f32x4*)a.in[I_GMIX] + lane;
        f32x4 v[4]; float s = 0.f;
#pragma unroll
        for (int j = 0; j < 4; ++j) { v[j] = xr[64 * j]; s += (v[j].x * v[j].x + v[j].y * v[j].y) + (v[j].z * v[j].z + v[j].w * v[j].w); }
        const float rstd = rsqrtf(wave_sum(s) * (1.f / DM) + EPSF);
#pragma unroll
        for (int j = 0; j < 4; ++j) { const f32x4 gv = gr[64 * j]; f32x4 o = v[j] * rstd * gv; *(LAS f32x4*)(mt + r * 1024 + 4 * (lane + 64 * j)) = o; }
    }
    __syncthreads();
    const bf16_t* wint = (const bf16_t*)(a.ws + WS_WINT); bf16_t* hyin = (bf16_t*)(a.ws + WS_HYIN); bf16_t* rgx = (bf16_t*)(a.ws + WS_RGX);
    for (int cc = wave; cc < 10; cc += NWAVES) { const int n = blockIdx.x * 10 + cc; if (n >= 2560) break;
        float w[16]; { float t0[8], t1[8]; const bf16_t* wp = wint + (size_t)n * 1024; const u32x4 q0 = *(const u32x4*)(wp + 8 * lane), q1 = *(const u32x4*)(wp + 512 + 8 * lane);
            w[0] = bflo(q0.x); w[1] = bfhi(q0.x); w[2] = bflo(q0.y); w[3] = bfhi(q0.y); w[4] = bflo(q0.z); w[5] = bfhi(q0.z); w[6] = bflo(q0.w); w[7] = bfhi(q0.w);
            w[8] = bflo(q1.x); w[9] = bfhi(q1.x); w[10] = bflo(q1.y); w[11] = bfhi(q1.y); w[12] = bflo(q1.z); w[13] = bfhi(q1.z); w[14] = bflo(q1.w); w[15] = bfhi(q1.w); (void)t0; (void)t1; }
        float mine = 0.f;
#pragma unroll
        for (int r = 0; r < 16; ++r) { const LAS f32x4* mp = (const LAS f32x4*)(mt + r * 1024 + 8 * lane); const f32x4 m0 = mp[0], m1 = mp[1], m2 = mp[128], m3 = mp[129];
            float s = (w[0] * m0.x + w[1] * m0.y) + (w[2] * m0.z + w[3] * m0.w) + (w[4] * m1.x + w[5] * m1.y) + (w[6] * m1.z + w[7] * m1.w)
                    + (w[8] * m2.x + w[9] * m2.y) + (w[10] * m2.z + w[11] * m2.w) + (w[12] * m3.x + w[13] * m3.y) + (w[14] * m3.z + w[15] * m3.w);
            s = wave_sum_dpp(s); mine = ((lane & 15) == r) ? s : mine; }
        const bf16_t v = (bf16_t)f2bf(mine); const int t = lane & 15;
#pragma unroll
        for (int h = 0; h < 2; ++h) { const int b = (lane >> 4) + 4 * h;
            if (n < 1536) hyin[((size_t)b * LT + t) * 1536 + n] = v; else rgx[((size_t)b * LT + t) * 1024 + (n - 1536)] = v; }
    }
    __syncthreads();
}

typedef pg8::f32x4 pf4;
__device__ __forceinline__ unsigned ror8u(unsigned v) { return (unsigned)__builtin_amdgcn_update_dpp(0, (int)v, 0x128, 0xF, 0xF, true); }
__device__ __forceinline__ void line_pair(const u32x4& w0, const u32x4& w1, bool hi, u32x4& dA, u32x4& dB) {
    u32x4 x0, x1; x0.x = ror8u(w0.x); x0.y = ror8u(w0.y); x0.z = ror8u(w0.z); x0.w = ror8u(w0.w); x1.x = ror8u(w1.x); x1.y = ror8u(w1.y); x1.z = ror8u(w1.z); x1.w = ror8u(w1.w);
    dA = hi ? x1 : w0; dB = hi ? w1 : x0; }
__device__ __forceinline__ unsigned pack_u8x4(float a, float b, float c, float d) {
    unsigned p = __builtin_amdgcn_cvt_pk_u8_f32(a * 255.0f, 0, 0u); p = __builtin_amdgcn_cvt_pk_u8_f32(b * 255.0f, 1, p); p = __builtin_amdgcn_cvt_pk_u8_f32(c * 255.0f, 2, p); return __builtin_amdgcn_cvt_pk_u8_f32(d * 255.0f, 3, p); }
struct EpiProj {
    static constexpr bool PERM = true, AFTER_DRAIN = false, LINE = true;
    bf16_t *hyin, *rgx, *gg; unsigned char *ga, *gb; const float* bgate;
    __device__ __forceinline__ void operator()(const pf4 (&acc)[2][2][4][2], const pg8::Unit& u, int wr, int wc, int fr, int fq) const {
        const int pn = u.pn, rbase = u.pm * 256 + wr * 64, cw = pn * 256 + wc * 64 + 8 * fq, f7 = fr & 7; const bool hi = (fr & 8) != 0; const int colS = cw + (hi ? 32 : 0);
        if (pn >= 14) {
            unsigned char* gbase = (pn < 18) ? ga : gb; const int gcS = colS - (pn < 18 ? 3584 : 4608);
#pragma unroll
            for (int ai = 0; ai < 2; ++ai)
#pragma unroll
                for (int m = 0; m < 4; ++m) { u32x2 q[2];
#pragma unroll
                    for (int bj = 0; bj < 2; ++bj) { const int gc = cw + bj * 32 - 3584; pf4 v0 = acc[ai][bj][m][0], v1 = acc[ai][bj][m][1];
                        const pf4 b0 = *(const pf4*)(bgate + gc), b1 = *(const pf4*)(bgate + gc + 4);
#pragma unroll
                        for (int j = 0; j < 4; j += 2) { f32x2 a = {v0[j], v0[j + 1]}, b = {v1[j], v1[j + 1]}; const f32x2 ba = {b0[j], b0[j + 1]}, bb = {b1[j], b1[j + 1]};
                            a = (a + ba) * (-1.4426950408889634f); b = (b + bb) * (-1.4426950408889634f);
                            f32x2 da, db; da.x = __builtin_amdgcn_exp2f(a.x); da.y = __builtin_amdgcn_exp2f(a.y); db.x = __builtin_amdgcn_exp2f(b.x); db.y = __builtin_amdgcn_exp2f(b.y);
                            da += 1.0f; db += 1.0f;
                            v0[j] = __builtin_amdgcn_rcpf(da.x); v0[j + 1] = __builtin_amdgcn_rcpf(da.y); v1[j] = __builtin_amdgcn_rcpf(db.x); v1[j + 1] = __builtin_amdgcn_rcpf(db.y); }
                        q[bj].x = pack_u8x4(v0[0], v0[1], v0[2], v0[3]); q[bj].y = pack_u8x4(v1[0], v1[1], v1[2], v1[3]); }
                    u32x2 x0, x1; x0.x = ror8u(q[0].x); x0.y = ror8u(q[0].y); x1.x = ror8u(q[1].x); x1.y = ror8u(q[1].y);
                    const u32x2 dA = hi ? x1 : q[0], dB = hi ? q[1] : x0;
                    const int rA = rbase + ai * 128 + m * 16 + f7;
                    unsigned char* pA = gbase + (size_t)rA * 1024 + gcS;
#ifdef NT_STORES
                    __builtin_nontemporal_store(dA, (u32x2*)pA); __builtin_nontemporal_store(dB, (u32x2*)(pA + 8 * 1024));
#else
                    *(u32x2*)pA = dA; *(u32x2*)(pA + 8 * 1024) = dB;
#endif
                }
            return; }
#pragma unroll
        for (int ai = 0; ai < 2; ++ai)
#pragma unroll
            for (int m = 0; m < 4; ++m) { u32x4 w[2];
#pragma unroll
                for (int bj = 0; bj < 2; ++bj) { pf4 v0 = acc[ai][bj][m][0], v1 = acc[ai][bj][m][1];
                    if (pn >= 10) {
#pragma unroll
                        for (int j = 0; j < 4; j += 2) { f32x2 a = {v0[j], v0[j + 1]}, b = {v1[j], v1[j + 1]};
                            const f32x2 ta = (a * a) * (0.044715f * 1.5957691216f * 1.4426950408889634f) + (1.5957691216f * 1.4426950408889634f), tb = (b * b) * (0.044715f * 1.5957691216f * 1.4426950408889634f) + (1.5957691216f * 1.4426950408889634f);
                            const f32x2 ua = a * ta, ub = b * tb;
                            f32x2 da, db; da.x = __builtin_amdgcn_exp2f(-ua.x); da.y = __builtin_amdgcn_exp2f(-ua.y); db.x = __builtin_amdgcn_exp2f(-ub.x); db.y = __builtin_amdgcn_exp2f(-ub.y);
                            da += 1.0f; db += 1.0f;
                            f32x2 ra, rb; ra.x = __builtin_amdgcn_rcpf(da.x); ra.y = __builtin_amdgcn_rcpf(da.y); rb.x = __builtin_amdgcn_rcpf(db.x); rb.y = __builtin_amdgcn_rcpf(db.y);
                            a *= ra; b *= rb; v0[j] = a.x; v0[j + 1] = a.y; v1[j] = b.x; v1[j + 1] = b.y; } }
                    w[bj].x = pk2(v0[0], v0[1]); w[bj].y = pk2(v0[2], v0[3]); w[bj].z = pk2(v1[0], v1[1]); w[bj].w = pk2(v1[2], v1[3]); }
                u32x4 dA, dB; line_pair(w[0], w[1], hi, dA, dB);
                const int rA = rbase + ai * 128 + m * 16 + f7, rB = rA + 8;
                const size_t lA = (size_t)(rA >> 12) * LT + NMETA + (rA & 4095), lB = lA + 8;
                bf16_t *pA, *pB;
                if (pn < 6) { pA = hyin + lA * 1536 + colS; pB = hyin + lB * 1536 + colS; }
                else if (pn < 10) { pA = rgx + lA * 1024 + (colS - 1536); pB = rgx + lB * 1024 + (colS - 1536); }
                else { pA = gg + (size_t)rA * 1024 + (colS - 2560); pB = gg + (size_t)rB * 1024 + (colS - 2560); }
#ifdef NT_STORES
                __builtin_nontemporal_store(dA, (u32x4*)pA); __builtin_nontemporal_store(dB, (u32x4*)pB);
#else
                *(u32x4*)pA = dA; *(u32x4*)pB = dB;
#endif
            }
    }
};
template <int MODE  > struct EpiGate {
    static constexpr bool PERM = true, AFTER_DRAIN = false, LINE = true;
    const unsigned char* gate; const bf16_t* tin; bf16_t* outp;
    __device__ __forceinline__ void operator()(const pf4 (&acc)[2][2][4][2], const pg8::Unit& u, int wr, int wc, int fr, int fq) const {
        const int row0 = u.pm * 256 + wr * 64 + fr, col0 = u.pn * 256 + wc * 64 + 8 * fq, f7 = fr & 7; const bool hi = (fr & 8) != 0;
        u32x2 gq[2][2]; u32x4 tq[2][2];
#define EG_OFF(i, bj) ((size_t)(row0 + ((i) >> 2) * 128 + ((i) & 3) * 16) * 1024 + col0 + (bj) * 32)
#define EG_LOAD(buf, i) do { gq[buf][0] = *(const u32x2*)(gate + EG_OFF(i, 0)); gq[buf][1] = *(const u32x2*)(gate + EG_OFF(i, 1)); \
        if (MODE == 1) { tq[buf][0] = *(const u32x4*)(tin + EG_OFF(i, 0)); tq[buf][1] = *(const u32x4*)(tin + EG_OFF(i, 1)); } } while (0)
        EG_LOAD(0, 0);
#pragma unroll
        for (int i = 0; i < 8; ++i) { const int ai = i >> 2, m = i & 3;
            if (i + 1 < 8) EG_LOAD((i + 1) & 1, i + 1);
            u32x4 w[2];
#pragma unroll
            for (int bj = 0; bj < 2; ++bj) { const pf4 v0 = acc[ai][bj][m][0] * (1.0f / 255.0f), v1 = acc[ai][bj][m][1] * (1.0f / 255.0f); const u32x2 g = gq[i & 1][bj];
                float r[8];
                r[0] = v0[0] * (float)(g.x & 0xffu); r[1] = v0[1] * (float)((g.x >> 8) & 0xffu); r[2] = v0[2] * (float)((g.x >> 16) & 0xffu); r[3] = v0[3] * (float)(g.x >> 24);
                r[4] = v1[0] * (float)(g.y & 0xffu); r[5] = v1[1] * (float)((g.y >> 8) & 0xffu); r[6] = v1[2] * (float)((g.y >> 16) & 0xffu); r[7] = v1[3] * (float)(g.y >> 24);
                if (MODE == 1) { const u32x4 t = tq[i & 1][bj];
                    r[0] += bflo(t.x); r[1] += bfhi(t.x); r[2] += bflo(t.y); r[3] += bfhi(t.y); r[4] += bflo(t.z); r[5] += bfhi(t.z); r[6] += bflo(t.w); r[7] += bfhi(t.w); }
                w[bj].x = pk2(r[0], r[1]); w[bj].y = pk2(r[2], r[3]); w[bj].z = pk2(r[4], r[5]); w[bj].w = pk2(r[6], r[7]); }
            u32x4 dA, dB; line_pair(w[0], w[1], hi, dA, dB);
            const size_t oA = (size_t)(row0 - fr + ai * 128 + m * 16 + f7) * 1024 + u.pn * 256 + wc * 64 + (hi ? 32 : 0) + 8 * fq, oB = oA + 8 * 1024;
#ifdef NT_STORES2
            if (MODE == 1) { __builtin_nontemporal_store(dA, (u32x4*)(outp + oA)); __builtin_nontemporal_store(dB, (u32x4*)(outp + oB)); } else { *(u32x4*)(outp + oA) = dA; *(u32x4*)(outp + oB) = dB; }
#else
            *(u32x4*)(outp + oA) = dA; *(u32x4*)(outp + oB) = dB;
#endif
        }
#undef EG_OFF
#undef EG_LOAD
    }
};
struct EpiMerge {
    static constexpr bool PERM = true, AFTER_DRAIN = false, LINE = true;
    const unsigned char* ga; const unsigned char* gb; bf16_t* outp;
#define EM_OFF(i, bj) ((size_t)(row0 + ((i) >> 2) * 128 + ((i) & 3) * 16) * 1024 + col0 + (bj) * 32)
    __device__ __forceinline__ void mid(pf4 (&acc)[2][2][4][2], const pg8::Unit& u, int wr, int wc, int fr, int fq) const {
        const int row0 = u.pm * 256 + wr * 64 + fr, col0 = u.pn * 256 + wc * 64 + 8 * fq;
        u32x2 qa[2][2], qb[2][2];
#define EM_LOAD(buf, i) do { qa[buf][0] = *(const u32x2*)(ga + EM_OFF(i, 0)); qa[buf][1] = *(const u32x2*)(ga + EM_OFF(i, 1)); qb[buf][0] = *(const u32x2*)(gb + EM_OFF(i, 0)); qb[buf][1] = *(const u32x2*)(gb + EM_OFF(i, 1)); } while (0)
        EM_LOAD(0, 0);
#pragma unroll
        for (int i = 0; i < 8; ++i) { const int ai = i >> 2, m = i & 3;
            if (i + 1 < 8) EM_LOAD((i + 1) & 1, i + 1);
#pragma unroll
            for (int bj = 0; bj < 2; ++bj) { const u32x2 a8 = qa[i & 1][bj], b8 = qb[i & 1][bj];
#pragma unroll
                for (int j = 0; j < 4; ++j) { const float fa0 = fmaxf((float)((a8.x >> (8 * j)) & 0xffu), 1.0f), fa1 = fmaxf((float)((a8.y >> (8 * j)) & 0xffu), 1.0f);
                    acc[ai][bj][m][0][j] *= (float)((b8.x >> (8 * j)) & 0xffu) * __builtin_amdgcn_rcpf(fa0); acc[ai][bj][m][1][j] *= (float)((b8.y >> (8 * j)) & 0xffu) * __builtin_amdgcn_rcpf(fa1); } } }
#undef EM_LOAD
    }
    __device__ __forceinline__ void operator()(const pf4 (&acc)[2][2][4][2], const pg8::Unit& u, int wr, int wc, int fr, int fq) const {
        const int row0 = u.pm * 256 + wr * 64 + fr, col0 = u.pn * 256 + wc * 64 + 8 * fq, f7 = fr & 7; const bool hi = (fr & 8) != 0;
        u32x2 qa[2][2];
#define EM_LOAD(buf, i) do { qa[buf][0] = *(const u32x2*)(ga + EM_OFF(i, 0)); qa[buf][1] = *(const u32x2*)(ga + EM_OFF(i, 1)); } while (0)
        EM_LOAD(0, 0);
#pragma unroll
        for (int i = 0; i < 8; ++i) { const int ai = i >> 2, m = i & 3;
            if (i + 1 < 8) EM_LOAD((i + 1) & 1, i + 1);
            u32x4 w[2];
#pragma unroll
            for (int bj = 0; bj < 2; ++bj) { const u32x2 a8 = qa[i & 1][bj]; float r[8];
#pragma unroll
                for (int j = 0; j < 4; ++j) { r[j] = acc[ai][bj][m][0][j] * (fmaxf((float)((a8.x >> (8 * j)) & 0xffu), 1.0f) * (1.0f / 255.0f)); r[4 + j] = acc[ai][bj][m][1][j] * (fmaxf((float)((a8.y >> (8 * j)) & 0xffu), 1.0f) * (1.0f / 255.0f)); }
                w[bj].x = pk2(r[0], r[1]); w[bj].y = pk2(r[2], r[3]); w[bj].z = pk2(r[4], r[5]); w[bj].w = pk2(r[6], r[7]); }
            u32x4 dA, dB; line_pair(w[0], w[1], hi, dA, dB);
            const size_t oA = (size_t)(row0 - fr + ai * 128 + m * 16 + f7) * 1024 + u.pn * 256 + wc * 64 + (hi ? 32 : 0) + 8 * fq, oB = oA + 8 * 1024;
#ifdef NT_STORES2
            __builtin_nontemporal_store(dA, (u32x4*)(outp + oA)); __builtin_nontemporal_store(dB, (u32x4*)(outp + oB));
#else
            *(u32x4*)(outp + oA) = dA; *(u32x4*)(outp + oB) = dB;
#endif
        }
#undef EM_LOAD
    }
#undef EM_OFF
};
struct EpiResid {
    static constexpr bool PERM = true, AFTER_DRAIN = false, LINE = true;
    const float* x; bf16_t* h1b; float* rowss;
    __device__ __forceinline__ void operator()(const pf4 (&acc)[2][2][4][2], const pg8::Unit& u, int wr, int wc, int fr, int fq) const {
        const int row0 = u.pm * 256 + wr * 64 + fr, col0 = u.pn * 256 + wc * 64 + 8 * fq, f7 = fr & 7; const bool hi = (fr & 8) != 0;
        pf4 xq[2][4];
#define ER_ROW(i) (row0 + ((i) >> 2) * 128 + ((i) & 3) * 16)
#define ER_LOAD(buf, i) do { const float* p_ = x + (size_t)ER_ROW(i) * 1024 + col0; xq[buf][0] = *(const pf4*)p_; xq[buf][1] = *(const pf4*)(p_ + 4); xq[buf][2] = *(const pf4*)(p_ + 32); xq[buf][3] = *(const pf4*)(p_ + 36); } while (0)
        ER_LOAD(0, 0);
#pragma unroll
        for (int i = 0; i < 8; ++i) { const int ai = i >> 2, m = i & 3, r = ER_ROW(i); float ss = 0.f;
            if (i + 1 < 8) ER_LOAD((i + 1) & 1, i + 1);
            u32x4 w[2];
#pragma unroll
            for (int bj = 0; bj < 2; ++bj) {
                const pf4 v0 = acc[ai][bj][m][0] + xq[i & 1][2 * bj], v1 = acc[ai][bj][m][1] + xq[i & 1][2 * bj + 1];
                w[bj].x = pk2(v0[0], v0[1]); w[bj].y = pk2(v0[2], v0[3]); w[bj].z = pk2(v1[0], v1[1]); w[bj].w = pk2(v1[2], v1[3]);
                ss += (v0[0] * v0[0] + v0[1] * v0[1]) + (v0[2] * v0[2] + v0[3] * v0[3]) + (v1[0] * v1[0] + v1[1] * v1[1]) + (v1[2] * v1[2] + v1[3] * v1[3]); }
            u32x4 dA, dB; line_pair(w[0], w[1], hi, dA, dB);
            const size_t oA = (size_t)(r - fr + f7) * 1024 + u.pn * 256 + wc * 64 + (hi ? 32 : 0) + 8 * fq, oB = oA + 8 * 1024;
#ifdef NT_STORES2
            __builtin_nontemporal_store(dA, (u32x4*)(h1b + oA)); __builtin_nontemporal_store(dB, (u32x4*)(h1b + oB));
#else
            *(u32x4*)(h1b + oA) = dA; *(u32x4*)(h1b + oB) = dB;
#endif
            ss += __shfl_xor(ss, 16); ss += __shfl_xor(ss, 32);
            if (fq == 0) atomicAdd(rowss + r, ss); }
#undef ER_ROW
#undef ER_LOAD
    }
};
struct EpiScores {
    static constexpr bool PERM = true, AFTER_DRAIN = false, LINE = false;
    const float* rowss; _Float16* sc;
    __device__ __forceinline__ void operator()(const pf4 (&acc)[2][2][4][2], const pg8::Unit& u, int wr, int wc, int fr, int fq) const {
        const int row0 = u.pm * 256 + wr * 64 + fr, k0 = wc * 32 + 8 * fq;
#pragma unroll
        for (int ai = 0; ai < 2; ++ai)
#pragma unroll
            for (int m = 0; m < 4; ++m) { const int r = row0 + ai * 128 + m * 16; const float rs = rsqrtf(rowss[r] * (1.f / DM) + EPSF);
#pragma unroll
                for (int bj = 0; bj < 2; ++bj) { _Float16* p = sc + (((size_t)(((r >> 6) * 8 + u.pn) * 2 + bj) * 16 + (k0 >> 3)) * 64 + (r & 63)) * 8;
                    typedef _Float16 h8 __attribute__((ext_vector_type(8)));
                    h8 v; v[0] = (_Float16)(acc[ai][bj][m][0][0] * rs); v[1] = (_Float16)(acc[ai][bj][m][0][1] * rs); v[2] = (_Float16)(acc[ai][bj][m][0][2] * rs); v[3] = (_Float16)(acc[ai][bj][m][0][3] * rs);
                    v[4] = (_Float16)(acc[ai][bj][m][1][0] * rs); v[5] = (_Float16)(acc[ai][bj][m][1][1] * rs); v[6] = (_Float16)(acc[ai][bj][m][1][2] * rs); v[7] = (_Float16)(acc[ai][bj][m][1][3] * rs);
                    *(h8*)p = v; } }
    }
};

__device__ __forceinline__ void unpack8(const u32x4 w, float (&f)[8]) {
    f[0] = bflo(w.x); f[1] = bfhi(w.x); f[2] = bflo(w.y); f[3] = bfhi(w.y); f[4] = bflo(w.z); f[5] = bfhi(w.z); f[6] = bflo(w.w); f[7] = bfhi(w.w); }
__device__ __forceinline__ void load8(const bf16_t* p, float (&f)[8]) { const u32x4 w = *(const u32x4*)p;
    f[0] = bflo(w.x); f[1] = bfhi(w.x); f[2] = bflo(w.y); f[3] = bfhi(w.y); f[4] = bflo(w.z); f[5] = bfhi(w.z); f[6] = bflo(w.w); f[7] = bfhi(w.w); }
__device__ __forceinline__ void short_conv8(const bf16_t* hb, const float* cw, const float* cb, int s, int ch, float (&o)[8]) {
    float xm[8], x0[8], xp[8];
    if (s >= 1) load8(hb + (size_t)(s - 1) * 1536 + ch, xm); else {
#pragma unroll
        for (int i = 0; i < 8; ++i) xm[i] = 0.f; }
    load8(hb + (size_t)s * 1536 + ch, x0);
    if (s + 1 < LT) load8(hb + (size_t)(s + 1) * 1536 + ch, xp); else {
#pragma unroll
        for (int i = 0; i < 8; ++i) xp[i] = 0.f; }
#pragma unroll
    for (int i = 0; i < 8; ++i) o[i] = xm[i] * cw[ch + i] + x0[i] * cw[1536 + ch + i] + xp[i] * cw[3072 + ch + i] + cb[ch + i];
}
__device__ __forceinline__ void short_conv8v(const u32x4& rm, const u32x4& r0, const u32x4& rp, const float* cw, const float* cb, int ch, float (&o)[8]) {
    float xm[8], x0[8], xp[8]; unpack8(rm, xm); unpack8(r0, x0); unpack8(rp, xp);
    const f32x4 wa0 = *(const f32x4*)(cw + ch), wa1 = *(const f32x4*)(cw + ch + 4), wb0 = *(const f32x4*)(cw + 1536 + ch), wb1 = *(const f32x4*)(cw + 1536 + ch + 4);
    const f32x4 wc0 = *(const f32x4*)(cw + 3072 + ch), wc1 = *(const f32x4*)(cw + 3072 + ch + 4), bb0 = *(const f32x4*)(cb + ch), bb1 = *(const f32x4*)(cb + ch + 4);
#pragma unroll
    for (int i = 0; i < 4; ++i) { o[i] = xm[i] * wa0[i] + x0[i] * wb0[i] + xp[i] * wc0[i] + bb0[i]; o[4 + i] = xm[4 + i] * wa1[i] + x0[4 + i] * wb1[i] + xp[4 + i] * wc1[i] + bb1[i]; }
}
struct HyW { f32x4 a0, a1, b0, b1, c0, c1, d0, d1; };
__device__ __forceinline__ HyW hy_w(const float* cw, const float* cb, int ch) { HyW w; w.a0 = *(const f32x4*)(cw + ch); w.a1 = *(const f32x4*)(cw + ch + 4); w.b0 = *(const f32x4*)(cw + 1536 + ch); w.b1 = *(const f32x4*)(cw + 1536 + ch + 4);
    w.c0 = *(const f32x4*)(cw + 3072 + ch); w.c1 = *(const f32x4*)(cw + 3072 + ch + 4); w.d0 = *(const f32x4*)(cb + ch); w.d1 = *(const f32x4*)(cb + ch + 4); return w; }
__device__ __forceinline__ void hy_rows(const bf16_t* p, int s0, u32x4 (&r)[10]) {
#pragma unroll
    for (int j = 0; j < 10; ++j) { const int sj = s0 - 1 + j; const bool ok = (unsigned)sj < (unsigned)LT; const u32x4 v = *(const u32x4*)(p + (size_t)(ok ? sj : 0) * 1536); r[j] = ok ? v : (u32x4){0u, 0u, 0u, 0u}; }
}
__device__ __forceinline__ void hy_tap(const float (&xm)[8], const float (&x0)[8], const float (&xp)[8], const HyW& w, float (&o)[8]) {
#pragma unroll
    for (int i = 0; i < 4; ++i) { o[i] = xm[i] * w.a0[i] + x0[i] * w.b0[i] + xp[i] * w.c0[i] + w.d0[i]; o[4 + i] = xm[4 + i] * w.a1[i] + x0[4 + i] * w.b1[i] + xp[4 + i] * w.c1[i] + w.d1[i]; }
}
__device__ __forceinline__ void phase_hy_pre(const Args& a, LAS unsigned char* lds, int tid) {
    const int wave = tid >> 6, lane = tid & 63, gw = blockIdx.x * NWAVES + wave, NGW = gridDim.x * NWAVES, l8 = lane >> 3, l7 = lane & 7;
    LAS bf16_t* tl = (LAS bf16_t*)(lds + wave * (64 * 144));
    const bf16_t* hyin = (const bf16_t*)(a.ws + WS_HYIN); bf16_t* uut = (bf16_t*)(a.ws + WS_UUT); bf16_t* x0out = (bf16_t*)(a.ws + WS_YH);
    const float* cw = a.in[I_HYCW]; const float* cb = a.in[I_HYCB];
    for (int it = gw; it < NB * 67 * 8; it += NGW) {
        const int ct = it & 7, ts = (it >> 3) % 67, b = (it >> 3) / 67, c0 = ct * 64 + l7 * 8, s0 = ts * 64 - 16 + 8 * l8;
        const bf16_t* hb = hyin + (size_t)b * LT * 1536 + c0;
        u32x4 r1[10], r2[10];
        hy_rows(hb + 512, s0, r1); hy_rows(hb + 1024, s0, r2);
        float x1[8][8];
        { const HyW w = hy_w(cw, cb, 512 + c0); float wm[8], w0[8], wp[8]; unpack8(r1[0], wm); unpack8(r1[1], w0);
#pragma unroll
          for (int p = 0; p < 8; ++p) { unpack8(r1[p + 2], wp); hy_tap(wm, w0, wp, w, x1[p]);
#pragma unroll
              for (int i = 0; i < 8; ++i) { wm[i] = w0[i]; w0[i] = wp[i]; } } }
        __builtin_amdgcn_sched_barrier(0);
        u32x4 r0[10];
        hy_rows(hb, s0, r0);
        __builtin_amdgcn_sched_barrier(0);
        { const HyW w = hy_w(cw, cb, 1024 + c0); float wm[8], w0[8], wp[8]; unpack8(r2[0], wm); unpack8(r2[1], w0);
#pragma unroll
          for (int p = 0; p < 8; ++p) { unpack8(r2[p + 2], wp); float v[8]; hy_tap(wm, w0, wp, w, v); const bool ok = (unsigned)(s0 + p) < (unsigned)LT;
              float uu[8];
#pragma unroll
              for (int i = 0; i < 8; ++i) { uu[i] = ok ? v[i] * x1[p][i] : 0.f; wm[i] = w0[i]; w0[i] = wp[i]; }
              u32x4 q; q.x = pk2(uu[0], uu[1]); q.y = pk2(uu[2], uu[3]); q.z = pk2(uu[4], uu[5]); q.w = pk2(uu[6], uu[7]);
              const int sr = 8 * l8 + p;
              *(LAS u32x4*)(tl + sr * 72 + ((l7 ^ ((sr >> 3) & 7)) << 3)) = q; } }
        __builtin_amdgcn_sched_barrier(0);
        { const HyW w = hy_w(cw, cb, c0); float wm[8], w0[8], wp[8]; unpack8(r0[0], wm); unpack8(r0[1], w0);
#pragma unroll
          for (int p = 0; p < 8; ++p) { unpack8(r0[p + 2], wp); float x0[8]; hy_tap(wm, w0, wp, w, x0); const int sp_ = s0 + p;
#pragma unroll
              for (int i = 0; i < 8; ++i) { wm[i] = w0[i]; w0[i] = wp[i]; }
              if (sp_ >= NMETA && sp_ < LT) { u32x4 q; q.x = pk2(x0[0], x0[1]); q.y = pk2(x0[2], x0[3]); q.z = pk2(x0[4], x0[5]); q.w = pk2(x0[6], x0[7]);
                  *(u32x4*)(x0out + ((size_t)b * SEQ + (sp_ - NMETA)) * DHY + c0) = q; } } }
#pragma unroll
        for (int k = 0; k < 8; ++k) { const int cl = 8 * k + l8, sp0 = ts * 64 + l7 * 8;
            if (sp0 < SP) { unsigned h[8];
#pragma unroll
                for (int i = 0; i < 8; ++i) h[i] = tl[(l7 * 8 + i) * 72 + ((((cl >> 3) ^ l7) << 3) | (cl & 7))];
                u32x4 w; w.x = h[0] | (h[1] << 16); w.y = h[2] | (h[3] << 16); w.z = h[4] | (h[5] << 16); w.w = h[6] | (h[7] << 16);
                *(u32x4*)(uut + ((size_t)(ct * 64 + cl) * NB + b) * SP + sp0) = w; } }
    }
}
__device__ __forceinline__ void phase_hy_conv_naive(const Args& a, LAS unsigned char* lds, int tid) {
    LAS bf16_t* uus = (LAS bf16_t*)lds;
    LAS float* filt = (LAS float*)(lds + LT * 16);
    const bf16_t* uut = (const bf16_t*)(a.ws + WS_UUT); const float* kf = (const float*)(a.ws + WS_KF); bf16_t* cvt = (bf16_t*)(a.ws + WS_CONVT);
    for (int c = blockIdx.x; c < DHY; c += gridDim.x) {
        for (int i = tid; i < NB * LT; i += NTHR) { const int b = i / LT, s = i - b * LT; uus[s * 8 + b] = uut[((size_t)c * NB + b) * SP + 16 + s]; }
        for (int i = tid; i < KFW; i += NTHR) filt[i] = kf[(size_t)c * KFW + i];
        __syncthreads();
        for (int tt = 0; tt < 8; ++tt) { const int tq = tt * 512 + tid, t = tq + 16; float acc[8];
#pragma unroll
            for (int b = 0; b < 8; ++b) acc[b] = 0.f;
            const LAS float* fp = filt + (LT - 1) + t;
            for (int s = 0; s < LT; ++s) { const float kv = fp[-s]; const u32x4 w = *(const LAS u32x4*)(uus + s * 8);
                acc[0] += kv * bflo(w.x); acc[1] += kv * bfhi(w.x); acc[2] += kv * bflo(w.y); acc[3] += kv * bfhi(w.y);
                acc[4] += kv * bflo(w.z); acc[5] += kv * bfhi(w.z); acc[6] += kv * bflo(w.w); acc[7] += kv * bfhi(w.w); }
#pragma unroll
            for (int b = 0; b < 8; ++b) cvt[((size_t)c * NB + b) * SEQ + tq] = (bf16_t)f2bf(acc[b]); }
        __syncthreads();
    }
}
__device__ __forceinline__ void phase_rg_naive(const Args& a, LAS unsigned char* lds, int tid) {
    LAS float* xc = (LAS float*)lds;
    LAS float* gbuf = xc + 32 * 128;
    const bf16_t* rgx = (const bf16_t*)(a.ws + WS_RGX);
    for (int it = blockIdx.x; it < NB * 2 * 8; it += gridDim.x) {
        const int head = it & 7, dir = (it >> 3) & 1, b = it >> 4;
        const float* cw = a.in[I_RGCW] + (size_t)dir * 4 * DRG + head * 128; const float* cb = a.in[I_RGCB] + (size_t)dir * DRG + head * 128;
        bf16_t* hout = (bf16_t*)a.out + (size_t)dir * T * DRG;
        const bf16_t* xb = rgx + (size_t)b * LT * DRG + head * 128;
        float h = 0.f, sp = 0.f;
        if (tid < 128) { const float lam = a.in[I_RGLAM][dir * DRG + head * 128 + tid]; sp = log1pf(__expf(-lam)); }
        for (int k = 0; k < 129; ++k) {
            { const int tok = tid >> 4, cg = tid & 15, u = 32 * k + tok; float o[8];
#pragma unroll
                for (int i = 0; i < 8; ++i) o[i] = (u < LT) ? cb[cg * 8 + i] : 0.f;
                if (u < LT) {
#pragma unroll
                    for (int j = 0; j < 4; ++j) { const int uu = u - j; if (uu >= 0) { const int t = dir ? (LT - 1 - uu) : uu; float xv[8]; load8(xb + (size_t)t * DRG + cg * 8, xv);
#pragma unroll
                            for (int i = 0; i < 8; ++i) o[i] += xv[i] * cw[j * DRG + cg * 8 + i]; } } }
#pragma unroll
                for (int i = 0; i < 8; ++i) xc[tok * 128 + cg * 8 + i] = o[i]; }
            __syncthreads();
            { const int j = tid & 127, g = (tid >> 7) & 1, th = tid >> 8; float acc[16];
#pragma unroll
                for (int q = 0; q < 16; ++q) acc[q] = 0.f;
                const float* gw = a.in[I_RGGW] + ((size_t)((dir * 2 + g) * 8 + head) * 128) * 128 + j;
                for (int i = 0; i < 128; ++i) { const float wv = gw[i * 128];
#pragma unroll
                    for (int q = 0; q < 16; ++q) acc[q] += xc[(th * 16 + q) * 128 + i] * wv; }
                const float gb = a.in[I_RGGB][(size_t)(dir * 2 + g) * DRG + head * 128 + j];
#pragma unroll
                for (int q = 0; q < 16; ++q) gbuf[(g * 32 + th * 16 + q) * 128 + j] = acc[q] + gb; }
            __syncthreads();
            if (tid < 128) {
                for (int tok = 0; tok < 32; ++tok) { const int u = 32 * k + tok; if (u >= LT) break;
                    const float r = sigmoidf_(gbuf[tok * 128 + tid]), ig = sigmoidf_(gbuf[(32 + tok) * 128 + tid]);
                    const float la = -8.0f * r * sp; const float av = __expf(la); const float mult = (u == 0) ? 1.0f : sqrtf(-expm1f(2.0f * la));
                    h = av * h + mult * ig * xc[tok * 128 + tid];
                    const int t = dir ? (LT - 1 - u) : u;
                    if (t >= NMETA) hout[((size_t)b * SEQ + (t - NMETA)) * DRG + head * 128 + tid] = (bf16_t)f2bf(h); } }
            __syncthreads();
        }
    }
}
__device__ __forceinline__ void phase_post(const Args& a, LAS unsigned char* lds, int tid) {
    const int wave = tid >> 6, lane = tid & 63, gw = blockIdx.x * NWAVES + wave, NGW = gridDim.x * NWAVES;
    LAS bf16_t* cv = (LAS bf16_t*)(lds + wave * (64 * 144));
    const bf16_t* cvt = (const bf16_t*)(a.ws + WS_CONVT); bf16_t* yh = (bf16_t*)(a.ws + WS_YH);
    const int l8 = lane >> 3, l7 = lane & 7;
    for (int it = gw; it < NB * 64 * 8; it += NGW) {
        const int ct = it & 7, tt = (it >> 3) & 63, b = it >> 9;
        u32x4 cw_[8], xw[8];
#pragma unroll
        for (int k = 0; k < 8; ++k) cw_[k] = *(const u32x4*)(cvt + ((size_t)(ct * 64 + 8 * k + l8) * NB + b) * SEQ + tt * 64 + l7 * 8);
        bf16_t* yp = yh + ((size_t)b * SEQ + tt * 64 + l8) * DHY + ct * 64 + l7 * 8;
#pragma unroll
        for (int k = 0; k < 8; ++k) xw[k] = *(const u32x4*)(yp + (size_t)(8 * k) * DHY);
#pragma unroll
        for (int k = 0; k < 8; ++k) *(LAS u32x4*)(cv + (8 * k + l8) * 72 + ((l7 ^ k) << 3)) = cw_[k];
#pragma unroll
        for (int k = 0; k < 8; ++k) { const int tr = 8 * k + l8; float x0[8], y[8]; unpack8(xw[k], x0);
#pragma unroll
            for (int i = 0; i < 8; ++i) y[i] = bf2f(cv[(l7 * 8 + i) * 72 + (((k ^ l7) << 3) | l8)]) * x0[i];
            u32x4 w; w.x = pk2(y[0], y[1]); w.y = pk2(y[2], y[3]); w.z = pk2(y[4], y[5]); w.w = pk2(y[6], y[7]);
            *(u32x4*)(yp + (size_t)(8 * k) * DHY) = w; }
    }
    const bf16_t* hf = (const bf16_t*)a.out; const bf16_t* hb2 = hf + (size_t)T * DRG; const bf16_t* gg = (const bf16_t*)(a.ws + WS_GG); bf16_t* yr = (bf16_t*)(a.ws + WS_YR);
    const unsigned char* rgp = a.ws + WS_RGP; const float* rgc = (const float*)(a.ws + WS_RGC);
    const size_t NI = (size_t)T * DRG / 8, istr = (size_t)gridDim.x * NTHR;
    for (size_t i0 = (size_t)blockIdx.x * NTHR + tid; i0 < NI; i0 += 4 * istr) {
        u32x4 F[4], Gv[4], Q[4]; u32x2 PF[4], PB[4];
#pragma unroll
        for (int r = 0; r < 4; ++r) { const size_t i = (i0 + r * istr < NI) ? i0 + r * istr : i0; const int c8 = (int)(i & 127) * 8, m = (int)(i >> 7), b = m >> 12, t = (m & 4095) + NMETA;
            F[r] = *(const u32x4*)(hf + i * 8); Gv[r] = *(const u32x4*)(hb2 + i * 8); Q[r] = *(const u32x4*)(gg + i * 8);
            const int tf = t - RG_U1, tb = (LT - 1 - t) - RG_U1;
            PF[r] = *(const u32x2*)(rgp + ((size_t)(0 * NB + b) * RG_NF + (tf > 0 ? tf : 0)) * DRG + c8); PB[r] = *(const u32x2*)(rgp + ((size_t)(1 * NB + b) * RG_NF + (tb > 0 ? tb : 0)) * DRG + c8); }
#pragma unroll
        for (int r = 0; r < 4; ++r) { const size_t i = i0 + r * istr; if (i >= NI) break; const int c8 = (int)(i & 127) * 8, m = (int)(i >> 7), b = m >> 12, t = (m & 4095) + NMETA;
            float f[8], g[8], q[8], pf[8], pb[8]; unpack8(F[r], f); unpack8(Gv[r], g); unpack8(Q[r], q);
#pragma unroll
            for (int j = 0; j < 4; ++j) { pf[j] = (float)((PF[r].x >> (8 * j)) & 0xffu); pf[4 + j] = (float)((PF[r].y >> (8 * j)) & 0xffu); pb[j] = (float)((PB[r].x >> (8 * j)) & 0xffu); pb[4 + j] = (float)((PB[r].y >> (8 * j)) & 0xffu); }
            const float* cf = rgc + (size_t)(0 * NB + b) * DRG + c8; const float* cb = rgc + (size_t)(1 * NB + b) * DRG + c8;
            const f32x4 cf0 = *(const f32x4*)cf, cf1 = *(const f32x4*)(cf + 4), cb0 = *(const f32x4*)cb, cb1 = *(const f32x4*)(cb + 4);
            const float mf = (t >= RG_U1) ? (1.0f / 255.0f) : 0.f, mb = ((LT - 1 - t) >= RG_U1) ? (1.0f / 255.0f) : 0.f;
#pragma unroll
            for (int j = 0; j < 4; ++j) { f[j] += mf * pf[j] * cf0[j]; f[4 + j] += mf * pf[4 + j] * cf1[j]; g[j] += mb * pb[j] * cb0[j]; g[4 + j] += mb * pb[4 + j] * cb1[j]; }
            u32x4 w; w.x = pk2((f[0] + g[0]) * q[0], (f[1] + g[1]) * q[1]); w.y = pk2((f[2] + g[2]) * q[2], (f[3] + g[3]) * q[3]);
            w.z = pk2((f[4] + g[4]) * q[4], (f[5] + g[5]) * q[5]); w.w = pk2((f[6] + g[6]) * q[6], (f[7] + g[7]) * q[7]);
            *(u32x4*)(yr + i * 8) = w; }
    }
}
__device__ __forceinline__ u32x4 quant_row16(const f32x4 (&v)[4], float amax, float& deq) {
    const float sc = (amax > 0.f) ? 256.0f / amax : 1.0f; deq = (amax > 0.f) ? amax * (1.0f / 256.0f) : 1.0f;
    u32x4 w; int t;
    t = __builtin_amdgcn_cvt_pk_fp8_f32(v[0].x * sc, v[0].y * sc, 0, false); t = __builtin_amdgcn_cvt_pk_fp8_f32(v[0].z * sc, v[0].w * sc, t, true); w.x = (unsigned)t;
    t = __builtin_amdgcn_cvt_pk_fp8_f32(v[1].x * sc, v[1].y * sc, 0, false); t = __builtin_amdgcn_cvt_pk_fp8_f32(v[1].z * sc, v[1].w * sc, t, true); w.y = (unsigned)t;
    t = __builtin_amdgcn_cvt_pk_fp8_f32(v[2].x * sc, v[2].y * sc, 0, false); t = __builtin_amdgcn_cvt_pk_fp8_f32(v[2].z * sc, v[2].w * sc, t, true); w.z = (unsigned)t;
    t = __builtin_amdgcn_cvt_pk_fp8_f32(v[3].x * sc, v[3].y * sc, 0, false); t = __builtin_amdgcn_cvt_pk_fp8_f32(v[3].z * sc, v[3].w * sc, t, true); w.w = (unsigned)t;
    return w;
}
__device__ __forceinline__ unsigned q8x4(f32x4 v, float sc) {
    const float M = 12582912.0f;
    const unsigned a = __float_as_uint(v.x * sc + M), b = __float_as_uint(v.y * sc + M), c = __float_as_uint(v.z * sc + M), d = __float_as_uint(v.w * sc + M);
    const unsigned lo = __builtin_amdgcn_perm(b, a, 0x0c0c0400u), hi = __builtin_amdgcn_perm(d, c, 0x0c0c0400u);
    return __builtin_amdgcn_perm(hi, lo, 0x05040100u);
}
__device__ __forceinline__ void phase_tables(const Args& a, int wave, int lane) {
    const int gw = blockIdx.x * NWAVES + wave, NGW = gridDim.x * NWAVES;
    const float* gf = a.in[I_GFFN] + 16 * lane; unsigned char* uq = a.ws + WS_UB; unsigned char* vq = a.ws + WS_VB; float* su = (float*)(a.ws + WS_SU); float* sv = (float*)(a.ws + WS_SV);
    f32x4 g[4];
#pragma unroll
    for (int j = 0; j < 4; ++j) g[j] = *(const f32x4*)(gf + 4 * j);
    for (int e = gw; e < NEXP; e += NGW) {
        const float* ur = a.in[I_PU] + (size_t)e * DM + 16 * lane; const float* vr = a.in[I_PV] + (size_t)e * DM + 16 * lane;
        f32x4 u[4], v[4]; float mu = 0.f, mv = 0.f;
#pragma unroll
        for (int j = 0; j < 4; ++j) { u[j] = NT_LD((const f32x4*)(ur + 4 * j)) * g[j]; v[j] = NT_LD((const f32x4*)(vr + 4 * j));
            mu = fmaxf(mu, fmaxf(fmaxf(fabsf(u[j].x), fabsf(u[j].y)), fmaxf(fabsf(u[j].z), fabsf(u[j].w))));
            mv = fmaxf(mv, fmaxf(fmaxf(fabsf(v[j].x), fabsf(v[j].y)), fmaxf(fabsf(v[j].z), fabsf(v[j].w)))); }
        mu = wave_max_dpp(mu); mv = wave_max_dpp(mv);
        const float scu = (mu > 0.f) ? 127.0f / mu : 1.0f, du = (mu > 0.f) ? mu * (1.0f / 127.0f) : 1.0f;
        u32x4 qu; qu.x = q8x4(u[0], scu); qu.y = q8x4(u[1], scu); qu.z = q8x4(u[2], scu); qu.w = q8x4(u[3], scu);
        const float scv = (mv > 0.f) ? 127.0f / mv : 1.0f, dv = (mv > 0.f) ? mv * (1.0f / 127.0f) : 1.0f;
        u32x4 qv; qv.x = q8x4(v[0], scv); qv.y = q8x4(v[1], scv); qv.z = q8x4(v[2], scv); qv.w = q8x4(v[3], scv);
        { const size_t so = ((size_t)(lane >> 3) * NEXP + e) * 128 + 16 * (lane & 7); *(u32x4*)(uq + so) = qu; *(u32x4*)(vq + so) = qv; }
        if (lane == 0) { su[e] = du; sv[e] = dv; }
    }
}
__device__ __forceinline__ void ce_desc(float& a, float& b) { const float hi = fmaxf(a, b), lo = fminf(a, b); a = hi; b = lo; }
__device__ __forceinline__ void sort16_desc(float (&x)[16]) {
#pragma unroll
    for (int k = 2; k <= 16; k <<= 1)
#pragma unroll
        for (int j = k >> 1; j > 0; j >>= 1)
#pragma unroll
            for (int i = 0; i < 16; ++i) { const int l = i ^ j; if (l > i) { if ((i & k) == 0) ce_desc(x[i], x[l]); else ce_desc(x[l], x[i]); } }
}
__device__ __forceinline__ void merge_top16(float (&L)[16], const float (&X)[16]) {
#pragma unroll
    for (int i = 0; i < 16; ++i) L[i] = fmaxf(L[i], X[15 - i]);
#pragma unroll
    for (int j = 8; j > 0; j >>= 1)
#pragma unroll
        for (int i = 0; i < 16; ++i) { const int l = i ^ j; if (l > i) ce_desc(L[i], L[l]); }
}
__device__ __forceinline__ void top16_of_128(const _Float16* base  , float (&L)[16]) {
    typedef _Float16 h8 __attribute__((ext_vector_type(8)));
    h8 v0 = *(const h8*)(base), v1 = *(const h8*)(base + 512);
#pragma unroll 1
    for (int ch = 0; ch < 8; ++ch) { float X[16]; const int cn = (ch < 7) ? ch + 1 : 7;
        const h8 n0 = *(const h8*)(base + (2 * cn) * 512), n1 = *(const h8*)(base + (2 * cn + 1) * 512);
#pragma unroll
        for (int i = 0; i < 8; ++i) { X[i] = __uint_as_float((__float_as_uint((float)v0[i]) & ~0x7Fu) | (unsigned)(ch * 16 + i));
            X[8 + i] = __uint_as_float((__float_as_uint((float)v1[i]) & ~0x7Fu) | (unsigned)(ch * 16 + 8 + i)); }
        sort16_desc(X);
        if (ch == 0) {
#pragma unroll
            for (int i = 0; i < 16; ++i) L[i] = X[i]; }
        else merge_top16(L, X);
        v0 = n0; v1 = n1; }
}
struct CandTab { int ci[64], cj[64]; };
__host__ __device__ constexpr CandTab make_cand() { CandTab t{}; int n = 0; for (int i = 0; i < 16; ++i) for (int j = 0; j < 16; ++j) if ((i + 1) * (j + 1) <= 16) { t.ci[n] = i; t.cj[n] = j; ++n; }
    for (; n < 64; ++n) { t.ci[n] = -1; t.cj[n] = -1; } return t; }
__device__ __forceinline__ void phase_topk(const Args& a, LAS unsigned char* lds, const pg8::StaticOrder& S, int wave, int lane) {
    constexpr CandTab CT = make_cand();
    const _Float16* st = (const _Float16*)(a.ws + WS_SCORES); int* eidx = (int*)(a.ws + WS_EIDX); float* eg = (float*)(a.ws + WS_EG);
    LAS unsigned char* tab = lds + wave * (64 * 36) + lane * 36;
    for (int j = wave; ; j += NWAVES) { pg8::Unit un; if (!S.next(j >> 2, un)) break; const int tg = 4 * un.pm + (j & 3), hh = un.pn; const int m = tg * 64 + lane;
        float A[16], B[16];
        top16_of_128(st + (size_t)((tg * 8 + hh) * 2 + 0) * 128 * 64 + lane * 8, A);
        top16_of_128(st + (size_t)((tg * 8 + hh) * 2 + 1) * 128 * 64 + lane * 8, B);
#pragma unroll
        for (int q = 0; q < 4; ++q) {
            const unsigned wa = (__float_as_uint(A[4 * q]) & 0x7Fu) | ((__float_as_uint(A[4 * q + 1]) & 0x7Fu) << 8) | ((__float_as_uint(A[4 * q + 2]) & 0x7Fu) << 16) | ((__float_as_uint(A[4 * q + 3]) & 0x7Fu) << 24);
            const unsigned wb = (__float_as_uint(B[4 * q]) & 0x7Fu) | ((__float_as_uint(B[4 * q + 1]) & 0x7Fu) << 8) | ((__float_as_uint(B[4 * q + 2]) & 0x7Fu) << 16) | ((__float_as_uint(B[4 * q + 3]) & 0x7Fu) << 24);
            *(LAS unsigned*)(tab + 4 * q) = wa; *(LAS unsigned*)(tab + 16 + 4 * q) = wb; }
#pragma unroll
        for (int i = 0; i < 16; ++i) { A[i] = __uint_as_float(__float_as_uint(A[i]) & ~0x7Fu); B[i] = __uint_as_float(__float_as_uint(B[i]) & ~0x7Fu); }
        float K[16];
#pragma unroll
        for (int c0 = 0; c0 < 64; c0 += 16) { float X[16];
#pragma unroll
            for (int i = 0; i < 16; ++i) { const int c = c0 + i;
                if (CT.ci[c] >= 0) X[i] = __uint_as_float((__float_as_uint(A[CT.ci[c] < 0 ? 0 : CT.ci[c]] + B[CT.cj[c] < 0 ? 0 : CT.cj[c]]) & ~0xFFu) | (unsigned)(CT.ci[c] * 16 + CT.cj[c]));
                else X[i] = -INFINITY; }
            sort16_desc(X);
            if (c0 == 0) {
#pragma unroll
                for (int i = 0; i < 16; ++i) K[i] = X[i]; }
            else merge_top16(K, X); }
        asm volatile("s_waitcnt lgkmcnt(0)" ::: "memory");
        int ex_[16]; float cs[16]; float sum = 0.f;
#pragma unroll
        for (int r = 0; r < 16; ++r) { const unsigned kb = __float_as_uint(K[r]); const int id = kb & 0xFF; cs[r] = __expf(__uint_as_float(kb & ~0xFFu) - __uint_as_float(__float_as_uint(K[0]) & ~0xFFu)); sum += cs[r];
            ex_[r] = (int)tab[id >> 4] * 128 + (int)tab[16 + (id & 15)]; }
        const float inv = 1.0f / sum;
        unsigned short* ep = (unsigned short*)eidx + (size_t)m * 128 + hh * 16; float* gp = eg + (size_t)m * 128 + hh * 16;
        { u32x4 p0, p1; p0.x = ex_[0] | (ex_[1] << 16); p0.y = ex_[2] | (ex_[3] << 16); p0.z = ex_[4] | (ex_[5] << 16); p0.w = ex_[6] | (ex_[7] << 16);
          p1.x = ex_[8] | (ex_[9] << 16); p1.y = ex_[10] | (ex_[11] << 16); p1.z = ex_[12] | (ex_[13] << 16); p1.w = ex_[14] | (ex_[15] << 16); *(u32x4*)ep = p0; *(u32x4*)(ep + 8) = p1; }
#pragma unroll
        for (int q = 0; q < 4; ++q) {
            *(f32x4*)(gp + 4 * q) = (f32x4){cs[4 * q] * inv, cs[4 * q + 1] * inv, cs[4 * q + 2] * inv, cs[4 * q + 3] * inv}; }
    }
}
__device__ __forceinline__ void fp8x16_to_f32(const u32x4 w, float (&f)[16]) {
    f32x2v t;
    t = __builtin_amdgcn_cvt_pk_f32_fp8((int)w.x, false); f[0] = t.x; f[1] = t.y; t = __builtin_amdgcn_cvt_pk_f32_fp8((int)w.x, true); f[2] = t.x; f[3] = t.y;
    t = __builtin_amdgcn_cvt_pk_f32_fp8((int)w.y, false); f[4] = t.x; f[5] = t.y; t = __builtin_amdgcn_cvt_pk_f32_fp8((int)w.y, true); f[6] = t.x; f[7] = t.y;
    t = __builtin_amdgcn_cvt_pk_f32_fp8((int)w.z, false); f[8] = t.x; f[9] = t.y; t = __builtin_amdgcn_cvt_pk_f32_fp8((int)w.z, true); f[10] = t.x; f[11] = t.y;
    t = __builtin_amdgcn_cvt_pk_f32_fp8((int)w.w, false); f[12] = t.x; f[13] = t.y; t = __builtin_amdgcn_cvt_pk_f32_fp8((int)w.w, true); f[14] = t.x; f[15] = t.y;
}
__device__ __forceinline__ void fp8x16_to_f32x2(const u32x4 w, f32x2v (&f)[8]) {
    f[0] = __builtin_amdgcn_cvt_pk_f32_fp8((int)w.x, false); f[1] = __builtin_amdgcn_cvt_pk_f32_fp8((int)(w.x >> 16), false);
    f[2] = __builtin_amdgcn_cvt_pk_f32_fp8((int)w.y, false); f[3] = __builtin_amdgcn_cvt_pk_f32_fp8((int)(w.y >> 16), false);
    f[4] = __builtin_amdgcn_cvt_pk_f32_fp8((int)w.z, false); f[5] = __builtin_amdgcn_cvt_pk_f32_fp8((int)(w.z >> 16), false);
    f[6] = __builtin_amdgcn_cvt_pk_f32_fp8((int)w.w, false); f[7] = __builtin_amdgcn_cvt_pk_f32_fp8((int)(w.w >> 16), false);
}
__device__ __forceinline__ float dpp_sum8(float v) {
    v += __int_as_float(__builtin_amdgcn_update_dpp(0, __float_as_int(v), 0xB1, 0xF, 0xF, true));
    v += __int_as_float(__builtin_amdgcn_update_dpp(0, __float_as_int(v), 0x4E, 0xF, 0xF, true));
    v += __int_as_float(__builtin_amdgcn_update_dpp(0, __float_as_int(v), 0x141, 0xF, 0xF, true));
    return v;
}
struct UTok { u32x4 e0, e1, xa, xb; };
struct VTok { u32x4 e0, e1, aq; float sa; };
__device__ __forceinline__ void pu_issue(const unsigned char* tab, unsigned loff, const u32x4& e, u32x4 (&w)[8]) {
    w[0] = *(const u32x4*)(tab + ((e.x & 0xffffu) * 128u + loff)); w[1] = *(const u32x4*)(tab + ((e.x >> 16) * 128u + loff));
    w[2] = *(const u32x4*)(tab + ((e.y & 0xffffu) * 128u + loff)); w[3] = *(const u32x4*)(tab + ((e.y >> 16) * 128u + loff));
    w[4] = *(const u32x4*)(tab + ((e.z & 0xffffu) * 128u + loff)); w[5] = *(const u32x4*)(tab + ((e.z >> 16) * 128u + loff));
    w[6] = *(const u32x4*)(tab + ((e.w & 0xffffu) * 128u + loff)); w[7] = *(const u32x4*)(tab + ((e.w >> 16) * 128u + loff));
}
__device__ __forceinline__ int dot4z(int a, int b) { int d; asm("v_dot4_i32_i8 %0, %1, %2, 0" : "=v"(d) : "v"(a), "v"(b)); return d; }
__device__ __forceinline__ void pu_dots(const int (&xq)[4], const u32x4 (&w)[8], int (&d)[8]) {
#pragma unroll
    for (int q = 0; q < 8; ++q) { int t = dot4z((int)w[q].x, xq[0]); t = __builtin_amdgcn_sdot4((int)w[q].y, xq[1], t, false);
        t = __builtin_amdgcn_sdot4((int)w[q].z, xq[2], t, false); d[q] = __builtin_amdgcn_sdot4((int)w[q].w, xq[3], t, false); }
}
__device__ __forceinline__ void pu_reduce(const int (&d0)[8], const int (&d1)[8], int lane, int& lo, int& hi) {
    const bool b2 = (lane & 4) != 0, b1 = (lane & 2) != 0, b0 = (lane & 1) != 0;
    int a[8];
#pragma unroll
    for (int q = 0; q < 4; ++q) { const int s0 = b2 ? d0[q] : d0[4 + q], k0 = b2 ? d0[4 + q] : d0[q], s1 = b2 ? d1[q] : d1[4 + q], k1 = b2 ? d1[4 + q] : d1[q];
        a[q] = k0 + __builtin_amdgcn_update_dpp(0, s0, 0x141, 0xF, 0xF, true); a[4 + q] = k1 + __builtin_amdgcn_update_dpp(0, s1, 0x141, 0xF, 0xF, true); }
    int bq[4];
#pragma unroll
    for (int q = 0; q < 2; ++q) { const int s0 = b1 ? a[q] : a[2 + q], k0 = b1 ? a[2 + q] : a[q], s1 = b1 ? a[4 + q] : a[6 + q], k1 = b1 ? a[6 + q] : a[4 + q];
        bq[q] = k0 + __builtin_amdgcn_update_dpp(0, s0, 0x4E, 0xF, 0xF, true); bq[2 + q] = k1 + __builtin_amdgcn_update_dpp(0, s1, 0x4E, 0xF, 0xF, true); }
    { const int s0 = b0 ? bq[0] : bq[1], k0 = b0 ? bq[1] : bq[0], s1 = b0 ? bq[2] : bq[3], k1 = b0 ? bq[3] : bq[2];
        lo = k0 + __builtin_amdgcn_update_dpp(0, s0, 0xB1, 0xF, 0xF, true); hi = k1 + __builtin_amdgcn_update_dpp(0, s1, 0xB1, 0xF, 0xF, true); }
}
__device__ __forceinline__ float pu_quant_x(const u32x4& xa, const u32x4& xb, int (&xq)[4]) {
    float f[16]; unpack8(xa, *(float(*)[8])&f[0]); unpack8(xb, *(float(*)[8])&f[8]);
    float mx = 0.f;
#pragma unroll
    for (int c = 0; c < 16; ++c) mx = fmaxf(mx, fabsf(f[c]));
    mx = fmaxf(mx, __int_as_float(__builtin_amdgcn_update_dpp(0, __float_as_int(mx), 0xB1, 0xF, 0xF, true)));
    mx = fmaxf(mx, __int_as_float(__builtin_amdgcn_update_dpp(0, __float_as_int(mx), 0x4E, 0xF, 0xF, true)));
    mx = fmaxf(mx, __int_as_float(__builtin_amdgcn_update_dpp(0, __float_as_int(mx), 0x141, 0xF, 0xF, true)));
    const float sc = (mx > 0.f) ? 127.0f * __builtin_amdgcn_rcpf(mx) * 0.99999f : 0.f;
#pragma unroll
    for (int c4 = 0; c4 < 4; ++c4) xq[c4] = (int)q8x4((f32x4){f[4 * c4], f[4 * c4 + 1], f[4 * c4 + 2], f[4 * c4 + 3]}, sc);
    return mx * (1.0f / 127.0f);
}
__device__ __forceinline__ void phase_peer_u(const Args& a, int wave, int lane) {
    const int s = SLICE_OF(blockIdx.x), rk = RANK_OF(blockIdx.x), nrk = gridDim.x >> 3, tper = T / nrk, i = lane & 7, j = lane >> 3;
    const bf16_t* h1b = (const bf16_t*)(a.ws + WS_H1B) + 128 * s + 16 * i; const unsigned char* uqs = a.ws + WS_UB + (size_t)s * NEXP * 128; const unsigned loff = 16u * (unsigned)i;
    const unsigned short* eidx = (const unsigned short*)(a.ws + WS_EIDX) + 16 * j; bf16_t* pd = (bf16_t*)(a.ws + WS_PD) + (size_t)s * T * 128 + 16 * j + 2 * i;
    const int m0 = rk * tper + wave, mlast = (rk + 1) * tper - NWAVES + wave;
#define PU_LOAD(t, mm) do { const int m_ = (mm) < mlast ? (mm) : mlast; const u32x4* ep_ = (const u32x4*)(eidx + (size_t)m_ * 128); (t).e0 = ep_[0]; (t).e1 = ep_[1]; \
        (t).xa = *(const u32x4*)(h1b + (size_t)m_ * DM); (t).xb = *(const u32x4*)(h1b + (size_t)m_ * DM + 8); } while (0)
#define PU_DO(t, w0, w1, mm) do { int xq_[4]; const float sx_ = pu_quant_x((t).xa, (t).xb, xq_); int d0_[8], d1_[8], lo_, hi_; pu_dots(xq_, w0, d0_); pu_dots(xq_, w1, d1_); \
        pu_reduce(d0_, d1_, lane, lo_, hi_); *(unsigned*)(pd + (size_t)(mm) * 128) = pk2((float)lo_ * sx_, (float)hi_ * sx_); } while (0)
    UTok tC, tN, tNN; u32x4 wA[8], wB[8], wC[8], wD[8];
#define PU_ISSUE(t, w0, w1) do { u32x4 ev_, od_; \
        ev_.x = __builtin_amdgcn_perm((t).e0.y, (t).e0.x, 0x05040100u); ev_.y = __builtin_amdgcn_perm((t).e0.w, (t).e0.z, 0x05040100u); ev_.z = __builtin_amdgcn_perm((t).e1.y, (t).e1.x, 0x05040100u); ev_.w = __builtin_amdgcn_perm((t).e1.w, (t).e1.z, 0x05040100u); \
        od_.x = __builtin_amdgcn_perm((t).e0.y, (t).e0.x, 0x07060302u); od_.y = __builtin_amdgcn_perm((t).e0.w, (t).e0.z, 0x07060302u); od_.z = __builtin_amdgcn_perm((t).e1.y, (t).e1.x, 0x07060302u); od_.w = __builtin_amdgcn_perm((t).e1.w, (t).e1.z, 0x07060302u); \
        pu_issue(uqs, loff, ev_, w0); pu_issue(uqs, loff, od_, w1); } while (0)
#define PU_STEP(C, N, wc0, wc1, wn0, wn1, mm) do { PU_ISSUE(N, wn0, wn1); PU_DO(C, wc0, wc1, mm); PU_LOAD(C, (mm) + 3 * NWAVES); } while (0)
    PU_LOAD(tC, m0); PU_LOAD(tN, m0 + NWAVES); PU_LOAD(tNN, m0 + 2 * NWAVES); PU_ISSUE(tC, wA, wB);
    for (int m = m0;;) {
        PU_STEP(tC, tN, wA, wB, wC, wD, m); m += NWAVES;
        PU_STEP(tN, tNN, wC, wD, wA, wB, m); m += NWAVES; if (m > mlast) break;
        PU_STEP(tNN, tC, wA, wB, wC, wD, m); m += NWAVES;
        PU_STEP(tC, tN, wC, wD, wA, wB, m); m += NWAVES; if (m > mlast) break;
        PU_STEP(tN, tNN, wA, wB, wC, wD, m); m += NWAVES;
        PU_STEP(tNN, tC, wC, wD, wA, wB, m); m += NWAVES; if (m > mlast) break;
    }
#undef PU_STEP
#undef PU_LOAD
#undef PU_DO
#undef PU_ISSUE
}
typedef long i64_t;
__device__ __forceinline__ i64_t pack64(unsigned lo, unsigned hi) { return (i64_t)(((unsigned long long)hi << 32) | (unsigned long long)lo); }
struct MTokI { u32x4 ia, ib; };
struct MTokX { u32x4 xq[4]; };
__device__ __forceinline__ unsigned id16(const u32x4& v, int c) { const unsigned wv = (c >> 1) == 0 ? v.x : (c >> 1) == 1 ? v.y : (c >> 1) == 2 ? v.z : v.w; return (c & 1) ? (wv >> 16) : (wv & 0xffffu); }
__device__ __forceinline__ void pm_issue(const unsigned char* tab, unsigned loff, const MTokI& t, u32x4 (&W)[16]) {
#pragma unroll
    for (int c = 0; c < 8; ++c) { W[2 * c] = *(const u32x4*)(tab + (id16(t.ia, c) * 128u + loff)); W[2 * c + 1] = *(const u32x4*)(tab + (id16(t.ib, c) * 128u + loff)); }
}
template <bool HI> __device__ __forceinline__ unsigned bf2_to_fp8x2(unsigned w, int old) { const float a = fminf(fmaxf(bflo(w), -448.f), 448.f), b = fminf(fmaxf(bfhi(w), -448.f), 448.f); return (unsigned)__builtin_amdgcn_cvt_pk_fp8_f32(a, b, old, HI); }
__device__ __forceinline__ void pm_compute(const MTokX& t, const u32x4 (&W)[16], LAS unsigned char* wl  , float* pdrow  , int lane) {
    unsigned xb[8];
#pragma unroll
    for (int q = 0; q < 4; ++q) { unsigned lo = bf2_to_fp8x2<false>(t.xq[q].x, 0); lo = bf2_to_fp8x2<true>(t.xq[q].y, (int)lo); unsigned hi = bf2_to_fp8x2<false>(t.xq[q].z, 0); hi = bf2_to_fp8x2<true>(t.xq[q].w, (int)hi); xb[2 * q] = lo; xb[2 * q + 1] = hi; }
    const i64_t B0 = pack64(xb[0], xb[1]), B1 = pack64(xb[2], xb[3]), B2 = pack64(xb[4], xb[5]), B3 = pack64(xb[6], xb[7]);
    const int j8 = lane >> 3, i = lane & 7, r = lane & 15, g = lane >> 4;
    LAS unsigned char* wr0 = wl + j8 * 144 + i * 16;
    const LAS unsigned char* rd0 = wl + r * 144 + g * 32;
    f32x4 C[8];
#pragma unroll
    for (int c = 0; c < 8; ++c) { const int bo = (c & 1) * 2304;
        *(LAS u32x4*)(wr0 + bo) = W[2 * c]; *(LAS u32x4*)(wr0 + bo + 8 * 144) = W[2 * c + 1];
        const u32x4 a0 = *(const LAS u32x4*)(rd0 + bo), a1 = *(const LAS u32x4*)(rd0 + bo + 16);
        f32x4 acc = (f32x4){0.f, 0.f, 0.f, 0.f};
        acc = __builtin_amdgcn_mfma_f32_16x16x32_fp8_fp8(pack64(a0.x, a0.y), B0, acc, 0, 0, 0);
        acc = __builtin_amdgcn_mfma_f32_16x16x32_fp8_fp8(pack64(a0.z, a0.w), B1, acc, 0, 0, 0);
        acc = __builtin_amdgcn_mfma_f32_16x16x32_fp8_fp8(pack64(a1.x, a1.y), B2, acc, 0, 0, 0);
        acc = __builtin_amdgcn_mfma_f32_16x16x32_fp8_fp8(pack64(a1.z, a1.w), B3, acc, 0, 0, 0); C[c] = acc; }
    if ((lane & 15) == 0) {
#pragma unroll
        for (int reg = 0; reg < 4; ++reg) { *(f32x4*)(pdrow + 8 * reg) = (f32x4){C[0][reg], C[1][reg], C[2][reg], C[3][reg]}; *(f32x4*)(pdrow + 8 * reg + 4) = (f32x4){C[4][reg], C[5][reg], C[6][reg], C[7][reg]}; } }
}
__device__ __forceinline__ void phase_peer_u_mfma(const Args& a, LAS unsigned char* lds, int wave, int lane) {
    const int s = SLICE_OF(blockIdx.x), rk = RANK_OF(blockIdx.x), nrk = gridDim.x >> 3, tper = T / nrk, g = lane >> 4, j8 = lane >> 3;
    const bf16_t* h1b = (const bf16_t*)(a.ws + WS_H1B) + 128 * s + 32 * g; const unsigned char* uqs = a.ws + WS_UB + (size_t)s * NEXP * 128; const unsigned loff = 16u * (unsigned)(lane & 7);
    const unsigned short* eidx = (const unsigned short*)(a.ws + WS_EIDX) + 8 * j8; float* pd = (float*)(a.ws + WS_PD) + (size_t)s * T * 128 + 32 * g;
    LAS unsigned char* wl = lds + wave * 4608;
    const int m0 = rk * tper + wave, mlast = (rk + 1) * tper - NWAVES + wave;
#define PM_LOADI(t, mm) do { const int m_ = (mm) < mlast ? (mm) : mlast; (t).ia = *(const u32x4*)(eidx + (size_t)m_ * 128); (t).ib = *(const u32x4*)(eidx + (size_t)m_ * 128 + 64); } while (0)
#define PM_LOADX(t, mm) do { const int m_ = (mm) < mlast ? (mm) : mlast; const u32x4* xp_ = (const u32x4*)(h1b + (size_t)m_ * DM); (t).xq[0] = xp_[0]; (t).xq[1] = xp_[1]; (t).xq[2] = xp_[2]; (t).xq[3] = xp_[3]; } while (0)
    MTokI iC, iN, iNN; MTokX xC, xN; u32x4 WA[16], WB[16];
    PM_LOADI(iC, m0); PM_LOADI(iN, m0 + NWAVES); PM_LOADI(iNN, m0 + 2 * NWAVES); PM_LOADX(xC, m0); PM_LOADX(xN, m0 + NWAVES); pm_issue(uqs, loff, iC, WA);
    for (int m = m0; m <= mlast; m += 2 * NWAVES) {
        pm_issue(uqs, loff, iN, WB);
        pm_compute(xC, WA, wl, pd + (size_t)m * 128, lane);
        iC = iN; iN = iNN; PM_LOADI(iNN, m + 3 * NWAVES); xC = xN; PM_LOADX(xN, m + 2 * NWAVES);
        pm_issue(uqs, loff, iN, WA);
        pm_compute(xC, WB, wl, pd + (size_t)(m + NWAVES) * 128, lane);
        iC = iN; iN = iNN; PM_LOADI(iNN, m + 4 * NWAVES); xC = xN; PM_LOADX(xN, m + 3 * NWAVES);
    }
#undef PM_LOADI
#undef PM_LOADX
}
__device__ __forceinline__ void phase_peer_act(const Args& a, int tid) {
    const bf16_t* pd = (const bf16_t*)(a.ws + WS_PD); const unsigned short* eidx = (const unsigned short*)(a.ws + WS_EIDX); const float* eg = (const float*)(a.ws + WS_EG);
    const float* su = (const float*)(a.ws + WS_SU); const float* sv = (const float*)(a.ws + WS_SV); const float* rowss = (const float*)(a.ws + WS_ROWSS); unsigned* actq = (unsigned*)(a.ws + WS_ACT); float* asc = (float*)(a.ws + WS_ACT + 8 * MiB);
    for (size_t i4 = (size_t)blockIdx.x * NTHR + tid; i4 < (size_t)T * 32; i4 += (size_t)gridDim.x * NTHR) { const size_t idx = i4 * 4;
        f32x4 d = (f32x4){0.f, 0.f, 0.f, 0.f};
#pragma unroll
        for (int s = 0; s < 8; ++s) { const u32x2 w = *(const u32x2*)(pd + (size_t)s * T * 128 + idx); d.x += bflo(w.x); d.y += bfhi(w.x); d.z += bflo(w.y); d.w += bfhi(w.y); }
        const u32x2 ew = *(const u32x2*)(eidx + idx); const f32x4 g = *(const f32x4*)(eg + idx); const float rstd = rsqrtf(rowss[idx >> 7] * (1.f / DM) + EPSF);
        const unsigned e0 = ew.x & 0xffffu, e1 = ew.x >> 16, e2 = ew.y & 0xffffu, e3 = ew.y >> 16;
        f32x4 o; o.x = gelu_tanh(d.x * su[e0] * rstd) * g.x * sv[e0]; o.y = gelu_tanh(d.y * su[e1] * rstd) * g.y * sv[e1];
        o.z = gelu_tanh(d.z * su[e2] * rstd) * g.z * sv[e2]; o.w = gelu_tanh(d.w * su[e3] * rstd) * g.w * sv[e3];
        float mx = fmaxf(fmaxf(fabsf(o.x), fabsf(o.y)), fmaxf(fabsf(o.z), fabsf(o.w)));
        mx = fmaxf(mx, __int_as_float(__builtin_amdgcn_update_dpp(0, __float_as_int(mx), 0xB1, 0xF, 0xF, true)));
        mx = fmaxf(mx, __int_as_float(__builtin_amdgcn_update_dpp(0, __float_as_int(mx), 0x4E, 0xF, 0xF, true)));
#ifdef ACT_TOKEN_SCALE
        mx = fmaxf(mx, __int_as_float(__builtin_amdgcn_update_dpp(0, __float_as_int(mx), 0x141, 0xF, 0xF, true)));
        mx = fmaxf(mx, __int_as_float(__builtin_amdgcn_update_dpp(0, __float_as_int(mx), 0x140, 0xF, 0xF, true)));
        mx = fmaxf(mx, __shfl_xor(mx, 16));
#endif
        const float sc = (mx > 0.f) ? 127.0f * __builtin_amdgcn_rcpf(mx) * 0.99999f : 0.f;
        actq[i4] = q8x4(o, sc);
        if ((i4 & 3) == 0) asc[i4 >> 2] = mx * (1.0f / 127.0f);
    }
}
template <bool FIRST = false> __device__ __forceinline__ void pv_quad(const u32x4& w0, const u32x4& w1, const u32x4& w2, const u32x4& w3, int a4, int (&oi)[16]) {
#define PV_BLK(d, base) do { const unsigned lo01 = __builtin_amdgcn_perm(w1.d, w0.d, 0x05010400u), hi01 = __builtin_amdgcn_perm(w1.d, w0.d, 0x07030602u); \
        const unsigned lo23 = __builtin_amdgcn_perm(w3.d, w2.d, 0x05010400u), hi23 = __builtin_amdgcn_perm(w3.d, w2.d, 0x07030602u); \
        oi[base + 0] = FIRST ? dot4z((int)__builtin_amdgcn_perm(lo23, lo01, 0x05040100u), a4) : __builtin_amdgcn_sdot4((int)__builtin_amdgcn_perm(lo23, lo01, 0x05040100u), a4, oi[base + 0], false); \
        oi[base + 1] = FIRST ? dot4z((int)__builtin_amdgcn_perm(lo23, lo01, 0x07060302u), a4) : __builtin_amdgcn_sdot4((int)__builtin_amdgcn_perm(lo23, lo01, 0x07060302u), a4, oi[base + 1], false); \
        oi[base + 2] = FIRST ? dot4z((int)__builtin_amdgcn_perm(hi23, hi01, 0x05040100u), a4) : __builtin_amdgcn_sdot4((int)__builtin_amdgcn_perm(hi23, hi01, 0x05040100u), a4, oi[base + 2], false); \
        oi[base + 3] = FIRST ? dot4z((int)__builtin_amdgcn_perm(hi23, hi01, 0x07060302u), a4) : __builtin_amdgcn_sdot4((int)__builtin_amdgcn_perm(hi23, hi01, 0x07060302u), a4, oi[base + 3], false); } while (0)
    PV_BLK(x, 0); PV_BLK(y, 4); PV_BLK(z, 8); PV_BLK(w, 12);
#undef PV_BLK
}
__device__ __forceinline__ float pv_quant_act(const f32x4 (&av)[4], int (&a4)[4]) {
    float mx = 0.f;
#pragma unroll
    for (int q = 0; q < 4; ++q) mx = fmaxf(mx, fmaxf(fmaxf(fabsf(av[q].x), fabsf(av[q].y)), fmaxf(fabsf(av[q].z), fabsf(av[q].w))));
    const float sc = (mx > 0.f) ? 127.0f * __builtin_amdgcn_rcpf(mx) * 0.99999f : 0.f;
#pragma unroll
    for (int q = 0; q < 4; ++q) a4[q] = (int)q8x4(av[q], sc);
    return mx * (1.0f / 127.0f);
}
__device__ __forceinline__ void pv_finish(const int (&oi)[16], float sa, bf16_t* orow  , int lane) {
    const bool b3 = (lane & 8) != 0, b4 = (lane & 16) != 0, b5 = (lane & 32) != 0;
#ifdef ACT_TOKEN_SCALE
    int k8[8], k4[4], k2[2];
#pragma unroll
    for (int c = 0; c < 8; ++c) { const int snd = b3 ? oi[c] : oi[8 + c], kp = b3 ? oi[8 + c] : oi[c]; k8[c] = kp + __builtin_amdgcn_update_dpp(0, snd, 0x128, 0xF, 0xF, true); }
#pragma unroll
    for (int c = 0; c < 4; ++c) { const auto r = __builtin_amdgcn_permlane16_swap((unsigned)k8[c], (unsigned)k8[4 + c], false, false); k4[c] = (int)(r[0] + r[1]); }
#pragma unroll
    for (int c = 0; c < 2; ++c) { const auto r = __builtin_amdgcn_permlane32_swap((unsigned)k4[c], (unsigned)k4[2 + c], false, false); k2[c] = (int)(r[0] + r[1]); }
    (void)b4; (void)b5;
    *(unsigned*)(orow + ((lane & 8) ? 8 : 0) + ((lane & 16) ? 4 : 0) + ((lane & 32) ? 2 : 0)) = pk2((float)k2[0] * sa, (float)k2[1] * sa);
#else
    float o[16];
#pragma unroll
    for (int c = 0; c < 16; ++c) o[c] = (float)oi[c] * sa;
    float k8[8], k4[4], k2[2];
#pragma unroll
    for (int c = 0; c < 8; ++c) { const float snd = b3 ? o[c] : o[8 + c], kp = b3 ? o[8 + c] : o[c]; k8[c] = kp + dpp_xor8(snd); }
#pragma unroll
    for (int c = 0; c < 4; ++c) { const float snd = b4 ? k8[c] : k8[4 + c], kp = b4 ? k8[4 + c] : k8[c]; k4[c] = kp + __shfl_xor(snd, 16); }
#pragma unroll
    for (int c = 0; c < 2; ++c) { const float snd = b5 ? k4[c] : k4[2 + c], kp = b5 ? k4[2 + c] : k4[c]; k2[c] = kp + __shfl_xor(snd, 32); }
    *(unsigned*)(orow + ((lane & 8) ? 8 : 0) + ((lane & 16) ? 4 : 0) + ((lane & 32) ? 2 : 0)) = pk2(k2[0], k2[1]);
#endif
}
__device__ __forceinline__ void phase_peer_v(const Args& a, int wave, int lane) {
    const int s = SLICE_OF(blockIdx.x), rk = RANK_OF(blockIdx.x), nrk = gridDim.x >> 3, tper = T / nrk, i = lane & 7, j = lane >> 3;
    const unsigned char* vqs = a.ws + WS_VB + (size_t)s * NEXP * 128; const unsigned loff = 16u * (unsigned)i;
    const unsigned short* eidx = (const unsigned short*)(a.ws + WS_EIDX) + 16 * j; const unsigned char* actq = a.ws + WS_ACT + 16 * j; const float* asc = (const float*)(a.ws + WS_ACT + 8 * MiB) + j;
    bf16_t* obase = (bf16_t*)(a.ws + WS_PO) + 128 * s + 16 * i;
    constexpr int MST = NWAVES; const int m0 = rk * tper + wave, mlast = (rk + 1) * tper - NWAVES + wave;
#define PV_LOAD(t, mm) do { const int m_ = (mm) < mlast ? (mm) : mlast; const u32x4* ep_ = (const u32x4*)(eidx + (size_t)m_ * 128); \
        (t).e0 = ep_[0]; (t).e1 = ep_[1]; (t).aq = *(const u32x4*)(actq + (size_t)m_ * 128); (t).sa = asc[(size_t)m_ * 8]; } while (0)
    VTok t0, t1, t2; u32x4 wA[8], wB[8];
#define PV_STEP(C, N, mm) do { pu_issue(vqs, loff, (C).e1, wB); \
        int oi_[16]; \
        pv_quad<true>(wA[0], wA[1], wA[2], wA[3], (int)(C).aq.x, oi_); pv_quad(wA[4], wA[5], wA[6], wA[7], (int)(C).aq.y, oi_); \
        pu_issue(vqs, loff, (N).e0, wA); \
        pv_quad(wB[0], wB[1], wB[2], wB[3], (int)(C).aq.z, oi_); pv_quad(wB[4], wB[5], wB[6], wB[7], (int)(C).aq.w, oi_); \
        pv_finish(oi_, (C).sa, obase + (size_t)(mm) * DM, lane); \
        PV_LOAD(C, (mm) + 3 * MST); } while (0)
    PV_LOAD(t0, m0); PV_LOAD(t1, m0 + MST); PV_LOAD(t2, m0 + 2 * MST); pu_issue(vqs, loff, t0.e0, wA);
    for (int m = m0;;) {
        PV_STEP(t0, t1, m); m += MST; if (m > mlast) break;
        PV_STEP(t1, t2, m); m += MST; if (m > mlast) break;
        PV_STEP(t2, t0, m); m += MST; if (m > mlast) break;
    }
#undef PV_STEP
#undef PV_LOAD
}
__device__ __forceinline__ void phase_final(const Args& a, int wave, int lane) {
    const int gw = blockIdx.x * NWAVES + wave, NGW = gridDim.x * NWAVES; const bf16_t* po = (const bf16_t*)(a.ws + WS_PO) + 16 * lane; const bf16_t* h1b = (const bf16_t*)(a.ws + WS_H1B) + 16 * lane;
    f32x4 gf[4];
#pragma unroll
    for (int jj = 0; jj < 4; ++jj) gf[jj] = *(const f32x4*)(a.in[I_GFINAL] + 16 * lane + 4 * jj);
    for (int m0 = gw; m0 < T; m0 += 4 * NGW) {
        u32x4 hq[4][2], pq[4][2];
#pragma unroll
        for (int r = 0; r < 4; ++r) { const int m = (m0 + r * NGW < T) ? m0 + r * NGW : m0;
            hq[r][0] = *(const u32x4*)(h1b + (size_t)m * DM); hq[r][1] = *(const u32x4*)(h1b + (size_t)m * DM + 8); pq[r][0] = *(const u32x4*)(po + (size_t)m * DM); pq[r][1] = *(const u32x4*)(po + (size_t)m * DM + 8); }
#pragma unroll
        for (int r = 0; r < 4; ++r) { const int m = m0 + r * NGW; if (m >= T) break;
            float hb[16], pp[16]; unpack8(hq[r][0], *(float(*)[8])&hb[0]); unpack8(hq[r][1], *(float(*)[8])&hb[8]); unpack8(pq[r][0], *(float(*)[8])&pp[0]); unpack8(pq[r][1], *(float(*)[8])&pp[8]);
            f32x4 h[4]; float ss = 0.f;
#pragma unroll
            for (int jj = 0; jj < 4; ++jj) { h[jj] = (f32x4){hb[4 * jj] + pp[4 * jj], hb[4 * jj + 1] + pp[4 * jj + 1], hb[4 * jj + 2] + pp[4 * jj + 2], hb[4 * jj + 3] + pp[4 * jj + 3]};
                ss += (h[jj].x * h[jj].x + h[jj].y * h[jj].y) + (h[jj].z * h[jj].z + h[jj].w * h[jj].w); }
            const float r2 = rsqrtf(wave_sum_dpp(ss) * (1.f / DM) + EPSF);
            float* orow = a.out + (size_t)m * DM + 16 * lane;
#pragma unroll
            for (int jj = 0; jj < 4; ++jj) NT_ST((f32x4*)(orow + 4 * jj), h[jj] * r2 * gf[jj]); }
    }
}
typedef short bf16x8_t __attribute__((ext_vector_type(8)));
__device__ __forceinline__ bf16x8_t toep_frag(const LAS unsigned* R32, int base) {
    const int e = base >> 1, sh = (base & 1) * 16;
    const unsigned d0 = R32[e], d1 = R32[e + 1], d2 = R32[e + 2], d3 = R32[e + 3], d4 = R32[e + 4];
    u32x4 o; o.x = __builtin_amdgcn_alignbit(d1, d0, sh); o.y = __builtin_amdgcn_alignbit(d2, d1, sh); o.z = __builtin_amdgcn_alignbit(d3, d2, sh); o.w = __builtin_amdgcn_alignbit(d4, d3, sh);
    return __builtin_bit_cast(bf16x8_t, o);
}
__device__ __forceinline__ void hy_conv_channel(const Args& a, LAS unsigned char* lds, int c, int tid, int wave, int lane) {
    constexpr int UROW = SP * 2;
    LAS unsigned char* uus = lds;
    LAS unsigned short* R = (LAS unsigned short*)(lds + 8 * UROW);
    const bf16_t* uut = (const bf16_t*)(a.ws + WS_UUT); const bf16_t* kfb = (const bf16_t*)(a.ws + WS_KFB); bf16_t* cvt = (bf16_t*)(a.ws + WS_CONVT);
    { const u32x4* src = (const u32x4*)(uut + (size_t)c * NB * SP); constexpr int NV = 8 * UROW / 16, NFV = KFW / 8;
      const u32x4* fsrc = (const u32x4*)(kfb + (size_t)c * KFW);
      u32x4 t_[9], f_[3];
#pragma unroll
      for (int q = 0; q < 9; ++q) { const int i = tid + q * NTHR; t_[q] = src[i < NV ? i : NV - 1]; }
#pragma unroll
      for (int q = 0; q < 3; ++q) { const int j = tid + q * NTHR; f_[q] = fsrc[j < NFV ? j : NFV - 1]; }
#pragma unroll
      for (int q = 0; q < 9; ++q) { const int i = tid + q * NTHR; if (i < NV) ((LAS u32x4*)uus)[i] = t_[q]; }
#pragma unroll
      for (int q = 0; q < 3; ++q) { const int j = tid + q * NTHR;
          if (j < NFV) { u32x4 rv; rv.x = __builtin_amdgcn_alignbit(f_[q].w, f_[q].w, 16); rv.y = __builtin_amdgcn_alignbit(f_[q].z, f_[q].z, 16); rv.z = __builtin_amdgcn_alignbit(f_[q].y, f_[q].y, 16); rv.w = __builtin_amdgcn_alignbit(f_[q].x, f_[q].x, 16);
              *(LAS u32x4*)(R + (KFW - 8) - 8 * j) = rv; } }
      if (tid < 2) *(LAS u32x4*)(R + KFW + 8 * tid) = (u32x4){0u, 0u, 0u, 0u}; }
    __syncthreads();
    const LAS unsigned* R32 = (const LAS unsigned*)R;
    const int i = lane & 15, g = lane >> 4, p = (lane >> 3) & 1, b = lane & 7;
    f32x4 C[16]; bf16x8_t A[16];
    const int abase = LT - 32 * (1 + 16 * wave) - i + 8 * g;
#pragma unroll
    for (int tb = 0; tb < 16; ++tb) { C[tb] = (f32x4){0.f, 0.f, 0.f, 0.f}; A[tb] = toep_frag(R32, abase - 32 * tb); }
    const LAS unsigned char* bptr = uus + b * UROW + (16 * p + 8 * g) * 2;
#define HC_STEP(ph, n) do { A[(16 - (ph)) & 15] = toep_frag(R32, abase + 32 * (n)); const bf16x8_t Bf = *(const LAS bf16x8_t*)(bptr + (n) * 64); \
        _Pragma("unroll") for (int tb = 0; tb < 16; ++tb) C[tb] = __builtin_amdgcn_mfma_f32_16x16x32_bf16(A[(tb - (ph)) & 15], Bf, C[tb], 0, 0, 0); __builtin_amdgcn_sched_barrier(0); } while (0)
    for (int G = 0; G < 8; ++G) { const int n0 = G * 16;
        HC_STEP(0, n0); HC_STEP(1, n0 + 1); HC_STEP(2, n0 + 2); HC_STEP(3, n0 + 3); HC_STEP(4, n0 + 4); HC_STEP(5, n0 + 5); HC_STEP(6, n0 + 6); HC_STEP(7, n0 + 7);
        HC_STEP(8, n0 + 8); HC_STEP(9, n0 + 9); HC_STEP(10, n0 + 10); HC_STEP(11, n0 + 11); HC_STEP(12, n0 + 12); HC_STEP(13, n0 + 13); HC_STEP(14, n0 + 14); HC_STEP(15, n0 + 15); }
    HC_STEP(0, 128);
#undef HC_STEP
#pragma unroll
    for (int tb = 0; tb < 16; ++tb) { const int tq = 512 * wave + 32 * tb + 16 * p + 4 * g;
        u32x2 w; w.x = pk2(C[tb][0], C[tb][1]); w.y = pk2(C[tb][2], C[tb][3]);
        *(u32x2*)(cvt + ((size_t)c * NB + b) * SEQ + tq) = w; }
    __syncthreads();
}
__device__ __forceinline__ void rg_item(const Args& a, LAS unsigned char* lds, int it, int tid, int wave, int lane) {
    constexpr int XROW = 272;
    const int head = it & 7, dir = (it >> 3) & 1, b = it >> 4;
    const bf16_t* xb = (const bf16_t*)(a.ws + WS_RGX) + (size_t)b * LT * DRG + head * 128;
    bf16_t* hout = (bf16_t*)a.out + (size_t)dir * T * DRG + (size_t)b * SEQ * DRG + head * 128 + 16 * wave + (lane & 15);
    const int col = lane & 15, g = lane >> 4, ch = head * 128 + 16 * wave + col;
    LAS unsigned char* wl = lds + 2 * 64 * XROW + wave * 1024 + lane * 16;
#pragma unroll
    for (int gt = 0; gt < 2; ++gt)
#pragma unroll
        for (int ks = 0; ks < 4; ++ks) { const float* wp = a.in[I_RGGW] + ((size_t)((dir * 2 + gt) * 8 + head) * 128 + 32 * ks + 8 * g) * 128 + 16 * wave + col;
            u32x4 o; o.x = pk2(wp[0], wp[128]); o.y = pk2(wp[256], wp[384]); o.z = pk2(wp[512], wp[640]); o.w = pk2(wp[768], wp[896]); *(LAS u32x4*)(wl + (gt * 4 + ks) * 8192) = o; }
    const float br = a.in[I_RGGB][(size_t)(dir * 2 + 0) * DRG + ch], bi = a.in[I_RGGB][(size_t)(dir * 2 + 1) * DRG + ch];
    const float sp8 = -8.0f * log1pf(__expf(-a.in[I_RGLAM][dir * DRG + ch]));
    const int ctr = tid >> 4, ccg = tid & 15;
    float cwv[4][8], cbv[8];
#pragma unroll
    for (int i = 0; i < 8; ++i) { cbv[i] = a.in[I_RGCB][(size_t)dir * DRG + head * 128 + 8 * ccg + i];
#pragma unroll
        for (int j = 0; j < 4; ++j) cwv[j][i] = a.in[I_RGCW][((size_t)dir * 4 + j) * DRG + head * 128 + 8 * ccg + i]; }
    u32x4 xr[2][4];
#define RG_LOAD(k) do { _Pragma("unroll") for (int h_ = 0; h_ < 2; ++h_) { const int u_ = 64 * (k) + ctr + 32 * h_; _Pragma("unroll") for (int j = 0; j < 4; ++j) { const int uu_ = u_ - j; \
        if (uu_ >= 0 && uu_ < LT) { const int t_ = dir ? (LT - 1 - uu_) : uu_; xr[h_][j] = *(const u32x4*)(xb + (size_t)t_ * DRG + 8 * ccg); } \
        else xr[h_][j] = (u32x4){0u, 0u, 0u, 0u}; } } } while (0)
#define RG_CONV(k) do { _Pragma("unroll") for (int h_ = 0; h_ < 2; ++h_) { const int u_ = 64 * (k) + ctr + 32 * h_; float o_[8]; _Pragma("unroll") for (int i = 0; i < 8; ++i) o_[i] = (u_ < LT) ? cbv[i] : 0.f; \
        _Pragma("unroll") for (int j = 0; j < 4; ++j) { float f_[8]; unpack8(xr[h_][j], f_); _Pragma("unroll") for (int i = 0; i < 8; ++i) o_[i] += f_[i] * cwv[j][i]; } \
        u32x4 w0_; w0_.x = pk2(o_[0], o_[1]); w0_.y = pk2(o_[2], o_[3]); w0_.z = pk2(o_[4], o_[5]); w0_.w = pk2(o_[6], o_[7]); \
        *(LAS u32x4*)(lds + ((k) & 1) * (64 * XROW) + (ctr + 32 * h_) * XROW + ccg * 16) = w0_; } } while (0)
    RG_LOAD(0); RG_CONV(0); RG_LOAD(1);
    __syncthreads();
    float carry = 0.f;
    const int arow = 16 * (col >> 2) + (col & 3);
    for (int k = 0; k < 65; ++k) {
        if (k + 1 < 65) RG_CONV(k + 1);
        if (k + 2 < 65) RG_LOAD(k + 2);
        const LAS unsigned char* xa = lds + (k & 1) * (64 * XROW);
        unsigned hp[16]; float hh = 0.f, PP = 1.f;
#pragma unroll
        for (int mp = 0; mp < 2; ++mp) {
            f32x4 acc[2][2];
#pragma unroll
            for (int m2 = 0; m2 < 2; ++m2) { const int mb = 2 * mp + m2; acc[0][m2] = (f32x4){0.f, 0.f, 0.f, 0.f}; acc[1][m2] = (f32x4){0.f, 0.f, 0.f, 0.f};
#pragma unroll
                for (int ks = 0; ks < 4; ++ks) { const bf16x8_t Af = *(const LAS bf16x8_t*)(xa + (arow + 4 * mb) * XROW + (32 * ks + 8 * g) * 2);
                    acc[0][m2] = __builtin_amdgcn_mfma_f32_16x16x32_bf16(Af, *(const LAS bf16x8_t*)(wl + ks * 8192), acc[0][m2], 0, 0, 0);
                    acc[1][m2] = __builtin_amdgcn_mfma_f32_16x16x32_bf16(Af, *(const LAS bf16x8_t*)(wl + (4 + ks) * 8192), acc[1][m2], 0, 0, 0); } }
#pragma unroll
            for (int m2 = 0; m2 < 2; ++m2)
#pragma unroll
                for (int r = 0; r < 4; ++r) { const int e = 8 * mp + 4 * m2 + r, tau = 16 * g + e, u = 64 * k + tau;
                    const float rr = sigmoidf_(acc[0][m2][r] + br), ii = sigmoidf_(acc[1][m2][r] + bi);
                    float av = fexp(sp8 * rr); float mult = __builtin_amdgcn_sqrtf(fmaxf(1.0f - av * av, 0.f)); mult = (u == 0) ? 1.0f : mult;
                    const float xcv = bf2f(*(const LAS unsigned short*)(xa + tau * XROW + (16 * wave + col) * 2));
                    float bq = mult * ii * xcv; if (u >= LT) { av = 1.f; bq = 0.f; }
                    hh = av * hh + bq; PP *= av; hp[e] = pk2(hh, PP); }
        }
        float Pg[4], hg[4];
#pragma unroll
        for (int q = 0; q < 4; ++q) { Pg[q] = __shfl(PP, col + 16 * q); hg[q] = __shfl(hh, col + 16 * q); }
        const float H0 = carry, H1 = Pg[0] * H0 + hg[0], H2 = Pg[1] * H1 + hg[1], H3 = Pg[2] * H2 + hg[2], H4 = Pg[3] * H3 + hg[3];
        const float Hin = (g == 0) ? H0 : (g == 1) ? H1 : (g == 2) ? H2 : H3;
        carry = H4;
#pragma unroll
        for (int e = 0; e < 16; ++e) { const int u = 64 * k + 16 * g + e; const int t = dir ? (LT - 1 - u) : u;
            if (u < LT && t >= NMETA) hout[(size_t)(t - NMETA) * DRG] = (bf16_t)f2bf(bflo(hp[e]) + bfhi(hp[e]) * Hin); }
        __syncthreads();
    }
#undef RG_LOAD
#undef RG_CONV
}
__device__ __forceinline__ void rg_item2(const Args& a, LAS unsigned char* lds, int it, int tid, int wave, int lane) {
    constexpr int XROW = 272;
    const int hh = it & 1, head = (it >> 1) & 7, dir = (it >> 4) & 1, b = it >> 5;
    const bf16_t* xb = (const bf16_t*)(a.ws + WS_RGX) + (size_t)b * LT * DRG + head * 128;
    const int col = lane & 15, g = lane >> 4, gate = col >> 3, cj = col & 7, chl = 64 * hh + 8 * wave + cj, ch = head * 128 + chl, qg = 2 * g + gate;
    bf16_t* hout = (bf16_t*)a.out + (size_t)dir * T * DRG + (size_t)b * SEQ * DRG + ch;
    bf16x8_t Wf[4];
#pragma unroll
    for (int ks = 0; ks < 4; ++ks) { const float* wp = a.in[I_RGGW] + ((size_t)((dir * 2 + gate) * 8 + head) * 128 + 32 * ks + 8 * g) * 128 + chl;
        u32x4 o; o.x = pk2(wp[0], wp[128]); o.y = pk2(wp[256], wp[384]); o.z = pk2(wp[512], wp[640]); o.w = pk2(wp[768], wp[896]); Wf[ks] = __builtin_bit_cast(bf16x8_t, o); }
    const float LOG2E = 1.4426950408889634f;
    const float bgl = a.in[I_RGGB][(size_t)(dir * 2 + gate) * DRG + ch] * LOG2E;
    const float sp8l = -8.0f * log1pf(__expf(-a.in[I_RGLAM][dir * DRG + ch])) * LOG2E;
    const int ctr = tid >> 4, ccg = tid & 15;
    float cwv[4][8], cbv[8];
#pragma unroll
    for (int i = 0; i < 8; ++i) { cbv[i] = a.in[I_RGCB][(size_t)dir * DRG + head * 128 + 8 * ccg + i];
#pragma unroll
        for (int j = 0; j < 4; ++j) cwv[j][i] = a.in[I_RGCW][((size_t)dir * 4 + j) * DRG + head * 128 + 8 * ccg + i]; }
    u32x4 xr[2][4];
#define RG_LOAD(k) do { _Pragma("unroll") for (int h_ = 0; h_ < 2; ++h_) { const int u_ = 64 * (k) + ctr + 32 * h_; _Pragma("unroll") for (int j = 0; j < 4; ++j) { const int uu_ = u_ - j; \
        if (uu_ >= 0 && uu_ < LT) { const int t_ = dir ? (LT - 1 - uu_) : uu_; xr[h_][j] = *(const u32x4*)(xb + (size_t)t_ * DRG + 8 * ccg); } \
        else xr[h_][j] = (u32x4){0u, 0u, 0u, 0u}; } } } while (0)
#define RG_CONV(k) do { _Pragma("unroll") for (int h_ = 0; h_ < 2; ++h_) { const int u_ = 64 * (k) + ctr + 32 * h_; float o_[8]; _Pragma("unroll") for (int i = 0; i < 8; ++i) o_[i] = (u_ < LT) ? cbv[i] : 0.f; \
        _Pragma("unroll") for (int j = 0; j < 4; ++j) { float f_[8]; unpack8(xr[h_][j], f_); _Pragma("unroll") for (int i = 0; i < 8; ++i) o_[i] += f_[i] * cwv[j][i]; } \
        u32x4 w0_; w0_.x = pk2(o_[0], o_[1]); w0_.y = pk2(o_[2], o_[3]); w0_.z = pk2(o_[4], o_[5]); w0_.w = pk2(o_[6], o_[7]); \
        *(LAS u32x4*)(lds + ((k) & 1) * (64 * XROW) + (ctr + 32 * h_) * XROW + ccg * 16) = w0_; } } while (0)
    RG_LOAD(0); RG_CONV(0); RG_LOAD(1);
    __syncthreads();
    float carry = 0.f;
    const int arow = 16 * (col >> 2) + (col & 3);
    for (int k = 0; k < 65; ++k) {
        if (k + 1 < 65) RG_CONV(k + 1);
        if (k + 2 < 65) RG_LOAD(k + 2);
        const LAS unsigned char* xa = lds + (k & 1) * (64 * XROW);
        f32x4 acc[4];
#pragma unroll
        for (int mb = 0; mb < 4; ++mb) { acc[mb] = (f32x4){0.f, 0.f, 0.f, 0.f};
#pragma unroll
            for (int ks = 0; ks < 4; ++ks) acc[mb] = __builtin_amdgcn_mfma_f32_16x16x32_bf16(*(const LAS bf16x8_t*)(xa + (arow + 4 * mb) * XROW + (32 * ks + 8 * g) * 2), Wf[ks], acc[mb], 0, 0, 0); }
        float sg[16], ot[16];
#pragma unroll
        for (int e = 0; e < 16; ++e) { sg[e] = __builtin_amdgcn_rcpf(1.0f + __builtin_amdgcn_exp2f(-(acc[e >> 2][e & 3] * LOG2E + bgl))); ot[e] = dpp_xor8(sg[e]); }
        unsigned hp[8]; float hs = 0.f, PP = 1.f;
#pragma unroll
        for (int t = 0; t < 8; ++t) { const float rr = gate ? ot[8 + t] : sg[t], ii = gate ? sg[8 + t] : ot[t]; const int tau = 8 * qg + t, u = 64 * k + tau;
            float av = __builtin_amdgcn_exp2f(sp8l * rr); float mult = __builtin_amdgcn_sqrtf(fmaxf(1.0f - av * av, 0.f)); mult = (u == 0) ? 1.0f : mult;
            const float xcv = bf2f(*(const LAS unsigned short*)(xa + tau * XROW + chl * 2));
            float bq = mult * ii * xcv; if (u >= LT) { av = 1.f; bq = 0.f; }
            hs = av * hs + bq; PP *= av; hp[t] = pk2(hs, PP); }
        float H = carry, Hin = carry;
#pragma unroll
        for (int q = 0; q < 8; ++q) { const int src = cj + 8 * (q & 1) + 16 * (q >> 1); const float Pq = __shfl(PP, src), hq = __shfl(hs, src);
            Hin = (qg == q) ? H : Hin; H = Pq * H + hq; }
        carry = H;
#pragma unroll
        for (int t = 0; t < 8; ++t) { const int u = 64 * k + 8 * qg + t; const int tt = dir ? (LT - 1 - u) : u;
            if (u < LT && tt >= NMETA) hout[(size_t)(tt - NMETA) * DRG] = (bf16_t)f2bf(bflo(hp[t]) + bfhi(hp[t]) * Hin); }
        __syncthreads();
    }
#undef RG_LOAD
#undef RG_CONV
}

__device__ __forceinline__ int rg_lds_off(int row, int chunk) { return row * 320 + (((chunk + 2 * (row >> 4)) & 15) << 4); }
__device__ __forceinline__ void rg_item3(const Args& a, LAS unsigned char* lds, int it, int tid, int wave, int lane) {
    constexpr int XT = 64 * 320;
    const int th = it & 1, head = (it >> 1) & 7, dir = (it >> 4) & 1, b = it >> 5;
    const int k0 = th ? RG_SPLIT : 0, k1 = th ? 65 : RG_SPLIT;
    const bf16_t* xb = (const bf16_t*)(a.ws + WS_RGX) + (size_t)b * LT * DRG + head * 128;
    const int col = lane & 15, g = lane >> 4, chl = 16 * wave + col, ch = head * 128 + chl;
    bf16_t* hout = (bf16_t*)a.out + (size_t)dir * T * DRG + (size_t)b * SEQ * DRG + ch;
    bf16_t* pout = (bf16_t*)(a.ws + WS_RGP) + ((size_t)dir * NB + b) * RG_NF * DRG + ch;
    LAS unsigned char* wl = lds + 2 * XT + wave * 1024 + lane * 16;
#pragma unroll
    for (int gt = 0; gt < 2; ++gt)
#pragma unroll
        for (int ks = 0; ks < 4; ++ks) { const float* wp = a.in[I_RGGW] + ((size_t)((dir * 2 + gt) * 8 + head) * 128 + 32 * ks + 8 * g) * 128 + chl;
            u32x4 o; o.x = pk2(wp[0], wp[128]); o.y = pk2(wp[256], wp[384]); o.z = pk2(wp[512], wp[640]); o.w = pk2(wp[768], wp[896]); *(LAS u32x4*)(wl + (gt * 4 + ks) * 8192) = o; }
    const float LOG2E = 1.4426950408889634f;
    const float brl = a.in[I_RGGB][(size_t)(dir * 2 + 0) * DRG + ch] * LOG2E, bil = a.in[I_RGGB][(size_t)(dir * 2 + 1) * DRG + ch] * LOG2E;
    const float sp8l = -8.0f * log1pf(__expf(-a.in[I_RGLAM][dir * DRG + ch])) * LOG2E;
    const f32x2 nl2 = {-LOG2E, -LOG2E}, nbr2 = {-brl, -brl}, nbi2 = {-bil, -bil}, sp2 = {sp8l, sp8l}, one2 = {1.0f, 1.0f};
    const int ctr = tid >> 4, ccg = tid & 15;
    LAS float* cwl = (LAS float*)(lds + 2 * XT + 8 * 8192);
    for (int i = tid; i < 5 * 128; i += NTHR) { const int j = i >> 7, c = i & 127; cwl[i] = (j < 4) ? a.in[I_RGCW][((size_t)dir * 4 + j) * DRG + head * 128 + c] : a.in[I_RGCB][(size_t)dir * DRG + head * 128 + c]; }
    __syncthreads();
    u32x4 xr[2][4];
#define RG_LOAD(k) do { _Pragma("unroll") for (int h_ = 0; h_ < 2; ++h_) { const int u_ = 64 * (k) + ctr + 32 * h_; _Pragma("unroll") for (int j = 0; j < 4; ++j) { int uu_ = u_ - j; \
        const bool ok_ = (uu_ >= 0 && uu_ < LT); uu_ = ok_ ? uu_ : 0; const int t_ = dir ? (LT - 1 - uu_) : uu_; const u32x4 v_ = *(const u32x4*)(xb + (size_t)t_ * DRG + 8 * ccg); \
        xr[h_][j] = ok_ ? v_ : (u32x4){0u, 0u, 0u, 0u}; } } } while (0)
#define RG_CONV(k) do { _Pragma("unroll") for (int h_ = 0; h_ < 2; ++h_) { const int u_ = 64 * (k) + ctr + 32 * h_; float o_[8]; \
        { const f32x4 b0_ = *(const LAS f32x4*)(cwl + 4 * 128 + 8 * ccg), b1_ = *(const LAS f32x4*)(cwl + 4 * 128 + 8 * ccg + 4); const bool in_ = (u_ < LT); \
          o_[0] = in_ ? b0_.x : 0.f; o_[1] = in_ ? b0_.y : 0.f; o_[2] = in_ ? b0_.z : 0.f; o_[3] = in_ ? b0_.w : 0.f; o_[4] = in_ ? b1_.x : 0.f; o_[5] = in_ ? b1_.y : 0.f; o_[6] = in_ ? b1_.z : 0.f; o_[7] = in_ ? b1_.w : 0.f; } \
        _Pragma("unroll") for (int j = 0; j < 4; ++j) { float f_[8]; unpack8(xr[h_][j], f_); const f32x4 w0_ = *(const LAS f32x4*)(cwl + j * 128 + 8 * ccg), w1_ = *(const LAS f32x4*)(cwl + j * 128 + 8 * ccg + 4); \
            o_[0] += f_[0] * w0_.x; o_[1] += f_[1] * w0_.y; o_[2] += f_[2] * w0_.z; o_[3] += f_[3] * w0_.w; o_[4] += f_[4] * w1_.x; o_[5] += f_[5] * w1_.y; o_[6] += f_[6] * w1_.z; o_[7] += f_[7] * w1_.w; } \
        u32x4 w0_; w0_.x = pk2(o_[0], o_[1]); w0_.y = pk2(o_[2], o_[3]); w0_.z = pk2(o_[4], o_[5]); w0_.w = pk2(o_[6], o_[7]); \
        *(LAS u32x4*)(lds + ((k) & 1) * XT + rg_lds_off(ctr + 32 * h_, ccg)) = w0_; } } while (0)
    RG_LOAD(k0); RG_CONV(k0); RG_LOAD(k0 + 1);
    __syncthreads();
    float carry = 0.f, pcar = 1.f;
    const int arow = 16 * (col >> 2) + (col & 3);
    const int xoff = (chl & 7) * 2, xch = chl >> 3;
    unsigned char* hbase = (unsigned char*)((bf16_t*)a.out + (size_t)dir * T * DRG + (size_t)b * SEQ * DRG);
    unsigned char* pbase = a.ws + WS_RGP + ((size_t)dir * NB + b) * RG_NF * DRG;
    const int tsgn = dir ? -1 : 1, t0 = dir ? (LT - 1 - NMETA) : -NMETA;
#define RG_TILE(EDGE) do { \
        float hv[16], pv[16]; float hh = 0.f, PP = 1.f; \
        _Pragma("unroll") for (int mp = 0; mp < 2; ++mp) { f32x4 acc[2][2]; \
            _Pragma("unroll") for (int m2 = 0; m2 < 2; ++m2) { const int mb = 2 * mp + m2; acc[0][m2] = (f32x4){0.f, 0.f, 0.f, 0.f}; acc[1][m2] = (f32x4){0.f, 0.f, 0.f, 0.f}; \
                _Pragma("unroll") for (int ks = 0; ks < 4; ++ks) { const bf16x8_t Af = *(const LAS bf16x8_t*)(xa + rg_lds_off(arow + 4 * mb, 4 * ks + g)); \
                    acc[0][m2] = __builtin_amdgcn_mfma_f32_16x16x32_bf16(Af, *(const LAS bf16x8_t*)(wl + ks * 8192), acc[0][m2], 0, 0, 0); \
                    acc[1][m2] = __builtin_amdgcn_mfma_f32_16x16x32_bf16(Af, *(const LAS bf16x8_t*)(wl + (4 + ks) * 8192), acc[1][m2], 0, 0, 0); } } \
              \
            _Pragma("unroll") for (int m2 = 0; m2 < 2; ++m2) _Pragma("unroll") for (int rp = 0; rp < 4; rp += 2) { const int e = 8 * mp + 4 * m2 + rp, tau = 16 * g + e, u = 64 * k + tau; \
                    const f32x2 ar_ = {acc[0][m2][rp], acc[0][m2][rp + 1]}, ai_ = {acc[1][m2][rp], acc[1][m2][rp + 1]}; \
                    const f32x2 er_ = ar_ * nl2 + nbr2, ei_ = ai_ * nl2 + nbi2; \
                    f32x2 dr_, di_; dr_.x = __builtin_amdgcn_exp2f(er_.x); dr_.y = __builtin_amdgcn_exp2f(er_.y); di_.x = __builtin_amdgcn_exp2f(ei_.x); di_.y = __builtin_amdgcn_exp2f(ei_.y); \
                    dr_ += one2; di_ += one2; const f32x2 pr_ = dr_ * di_; \
                    f32x2 inv_; inv_.x = __builtin_amdgcn_rcpf(pr_.x); inv_.y = __builtin_amdgcn_rcpf(pr_.y);        \
                    const f32x2 rr_ = di_ * inv_, ii_ = dr_ * inv_, ag_ = rr_ * sp2; \
                    f32x2 av_; av_.x = __builtin_amdgcn_exp2f(ag_.x); av_.y = __builtin_amdgcn_exp2f(ag_.y); \
                    const f32x2 w_ = one2 - av_ * av_; \
                    f32x2 mu_; mu_.x = __builtin_amdgcn_sqrtf(__builtin_fabsf(w_.x)); mu_.y = __builtin_amdgcn_sqrtf(__builtin_fabsf(w_.y));        \
                    if (EDGE) { if (u == 0) mu_.x = 1.0f; } \
                    f32x2 xc_; xc_.x = bf2f(*(const LAS unsigned short*)(xa + rg_lds_off(tau, xch) + xoff)); xc_.y = bf2f(*(const LAS unsigned short*)(xa + rg_lds_off(tau + 1, xch) + xoff)); \
                    f32x2 bq_ = mu_ * ii_ * xc_; \
                    if (EDGE) { if (u >= LT) { av_.x = 1.f; bq_.x = 0.f; } if (u + 1 >= LT) { av_.y = 1.f; bq_.y = 0.f; } } \
                    hh = av_.x * hh + bq_.x; PP *= av_.x; hv[e] = hh; pv[e] = PP; \
                    hh = av_.y * hh + bq_.y; PP *= av_.y; hv[e + 1] = hh; pv[e + 1] = PP; } } \
        float Pg[4], hg[4]; \
        _Pragma("unroll") for (int q = 0; q < 4; ++q) { Pg[q] = __shfl(PP, col + 16 * q); hg[q] = __shfl(hh, col + 16 * q); } \
        const float H0 = carry, H1 = Pg[0] * H0 + hg[0], H2 = Pg[1] * H1 + hg[1], H3 = Pg[2] * H2 + hg[2], H4 = Pg[3] * H3 + hg[3]; \
        const float Q0 = pcar, Q1 = Pg[0] * Q0, Q2 = Pg[1] * Q1, Q3 = Pg[2] * Q2, Q4 = Pg[3] * Q3; \
        const float Hin = (g == 0) ? H0 : (g == 1) ? H1 : (g == 2) ? H2 : H3, Qin = (g == 0) ? Q0 : (g == 1) ? Q1 : (g == 2) ? Q2 : Q3; \
        carry = H4; pcar = Q4; \
        const int ub = 64 * k + 16 * g; \
        unsigned ho = (unsigned)((t0 + tsgn * ub) * (DRG * 2) + ch * 2), po = (unsigned)((ub - RG_U1) * DRG + ch); const unsigned hstep = (unsigned)(tsgn * DRG * 2); \
        _Pragma("unroll") for (int e = 0; e < 16; ++e) { const int u = ub + e; const int t = dir ? (LT - 1 - u) : u; \
            if (!EDGE || (u < LT && t >= NMETA)) { *(bf16_t*)(hbase + ho) = (bf16_t)f2bf(hv[e] + pv[e] * Hin); \
                if (th) *(pbase + po) = (unsigned char)__builtin_amdgcn_cvt_pk_u8_f32(pv[e] * Qin * 255.0f, 0, 0u); } \
            ho += hstep; po += (unsigned)DRG; } \
    } while (0)
    for (int k = k0; k < k1; ++k) {
        if (k + 1 < k1) RG_CONV(k + 1);
        if (k + 2 < k1) RG_LOAD(k + 2);
        const LAS unsigned char* xa = lds + (k & 1) * XT;
        if (k == 0 || k >= 63) RG_TILE(true); else RG_TILE(false);
        __syncthreads();
    }
#undef RG_TILE
    if (th == 0 && g == 0) ((float*)(a.ws + WS_RGC))[((size_t)dir * NB + b) * DRG + ch] = carry;
#undef RG_LOAD
#undef RG_CONV
}

#ifndef RG_NAIVE
#define RG_NAIVE 0
#endif
#ifndef CONV_NAIVE
#define CONV_NAIVE 0
#endif
#ifndef ONE_LAUNCH
#define ONE_LAUNCH 0
#endif
constexpr int NPHASE = 13;
#ifndef NVGPR
#define NVGPR 248
#endif
__global__ void __launch_bounds__(NTHR, 2) __attribute__((amdgpu_num_vgpr(NVGPR))) mega(Args a) {
    extern __shared__ __attribute__((aligned(16))) unsigned char lds_raw[];
    LAS unsigned char* lds = (LAS unsigned char*)lds_raw;
    const int tid = threadIdx.x, lane = tid & 63, wave = __builtin_amdgcn_readfirstlane(tid >> 6);
    cg::grid_group grid = cg::this_grid();
    volatile LAS unsigned* bst = (volatile LAS unsigned*)(lds + LDS_BYTES - 64);
    if (tid == 0) { bst[0] = 0u; bst[1] = 0u; }
    __syncthreads();
    XcdBarrier xbar; xbar.bar = (unsigned*)(a.ws + WS_BAR); xbar.x = 0; xbar.st = bst;
    if (a.ph_hi - a.ph_lo > 1) xbar = xcd_barrier_post((unsigned*)(a.ws + WS_BAR), bst);
    const int lo = a.ph_lo, hi = a.ph_hi, G = gridDim.x, bx = blockIdx.x;
#ifndef PHMASK
#define PHMASK 0x1fff
#endif
#ifndef REPMASK
#define REPMASK 0
#endif
#define IN(k) (((PHMASK >> (k)) & 1) && lo <= (k) && (k) < hi)
#define REP(k)
#ifdef PROBE_BAR2X
#define SEAM(k) do { if (IN(k) && ((k) + 1) < hi) { xcd_barrier(xbar); xcd_barrier(xbar); } } while (0)
#else
#define SEAM(k) do { if (IN(k) && ((k) + 1) < hi) xcd_barrier(xbar); } while (0)
#endif
    if (a.ph_lo < 0) grid.sync();
#ifdef PROBE_TIME
    unsigned long long pt0 = 0ull, pt1 = 0ull;
#define PT_BEGIN(k) do { if ((k) == PROBE_TIME) pt0 = __builtin_amdgcn_s_memrealtime(); } while (0)
#ifndef PROBE_TEND
#define PROBE_TEND PROBE_TIME
#endif
#define PT_END(k) do { if ((k) == PROBE_TEND) pt1 = __builtin_amdgcn_s_memrealtime(); } while (0)
#else
#define PT_BEGIN(k)
#define PT_END(k)
#endif
    unsigned char* ws = a.ws;
    PT_BEGIN(0);
    REP(0) if (IN(0)) {
        if (bx & 1) { phase_p0c(a, lds, tid, wave, lane); phase_p0<0>(a, lds, tid, wave, lane); phase_p0<1>(a, lds, tid, wave, lane); phase_p0b(a, lds, tid, wave, lane); }
        else { phase_p0<0>(a, lds, tid, wave, lane); phase_p0<1>(a, lds, tid, wave, lane); phase_p0b(a, lds, tid, wave, lane); phase_p0c(a, lds, tid, wave, lane); }
    }
    SEAM(0); PT_END(0);
    PT_BEGIN(1);
    REP(1) if (IN(1)) {
        PT_BEGIN(50); p1_meta(a, lds, tid, wave, lane); PT_END(50); PT_BEGIN(51);
#ifdef STAGGER_P1
        for (int q = 0; q < ((bx >> 3) & 7) * STAGGER_P1; ++q) __builtin_amdgcn_s_sleep(64);
#endif
        pg8::Gemm g{(const bf16_t*)(ws + WS_XN1), (const bf16_t*)(ws + WS_WINT), T, DIN, 1024};
        EpiProj E{(bf16_t*)(ws + WS_HYIN), (bf16_t*)(ws + WS_RGX), (bf16_t*)(ws + WS_GG), ws + WS_GA, ws + WS_GB, a.in[I_BGATE]};
#ifdef PROBE_P1_EXTRA
        struct OrderX : pg8::StaticOrder { __device__ bool next(int i, pg8::Unit& u) const { const bool ok = pg8::StaticOrder::next(i < 11 ? i : i - 11, u) && i < 11 + PROBE_P1_EXTRA; u.skip = (i >= 11); return ok; } } S; S.init(T, DIN, G, bx);
        pg8::gemm_phase<EpiProj, OrderX>(lds, g, S, E, nullptr);
#else
        pg8::StaticOrder S; S.init(T, DIN, G, bx);
        pg8::gemm_phase<EpiProj, pg8::StaticOrder>(lds, g, S, E, nullptr);
#endif
        PT_END(51);
    }
    SEAM(1); PT_END(1);
    PT_BEGIN(2);
    REP(2) if (IN(2)) phase_hy_pre(a, lds, tid);
    SEAM(2); PT_END(2);
    PT_BEGIN(3);
    REP(3) if (IN(3)) {
#if CONV_NAIVE
        phase_hy_conv_naive(a, lds, tid);
#else
        PT_BEGIN(30);
        for (int c = bx; c < DHY; c += G) hy_conv_channel(a, lds, c, tid, wave, lane);
        PT_END(30); PT_BEGIN(31);
#endif
#if RG_NAIVE
        phase_rg_naive(a, lds, tid);
#else
        for (int it = bx; it < NB * 2 * 8 * 2; it += G) rg_item3(a, lds, it, tid, wave, lane);
        PT_END(31);
#endif
    }
    SEAM(3); PT_END(3);
    PT_BEGIN(4);
    REP(4) if (IN(4)) phase_post(a, lds, tid);
    SEAM(4); PT_END(4);
    PT_BEGIN(5);
    REP(5) if (IN(5)) {
#ifndef P5_SPLIT
        pg8::Gemm2 g{(const bf16_t*)(ws + WS_YR), (const bf16_t*)(ws + WS_WRT), 1024, (const bf16_t*)(ws + WS_YH), (const bf16_t*)(ws + WS_WHT), 512};
        pg8::StaticOrder S; S.init(T, 1024, G, bx);
        EpiMerge E{ws + WS_GA, ws + WS_GB, (bf16_t*)(ws + WS_MERGED)};
        pg8::gemm_phase2<EpiMerge, pg8::StaticOrder>(lds, g, S, E);
#else
        { pg8::Gemm g{(const bf16_t*)(ws + WS_YH), (const bf16_t*)(ws + WS_WHT), T, 1024, 512}; pg8::StaticOrder S; S.init(T, 1024, G, bx);
          EpiGate<0> E{ws + WS_GA, nullptr, (bf16_t*)(ws + WS_TMP)};
          pg8::gemm_phase<EpiGate<0>, pg8::StaticOrder>(lds, g, S, E, nullptr); }
        { pg8::Gemm g{(const bf16_t*)(ws + WS_YR), (const bf16_t*)(ws + WS_WRT), T, 1024, 1024};
          EpiGate<1> E{ws + WS_GB, (const bf16_t*)(ws + WS_TMP), (bf16_t*)(ws + WS_MERGED)};
          pg8::StaticOrder S; S.init(T, 1024, G, bx);
          pg8::gemm_phase<EpiGate<1>, pg8::StaticOrder>(lds, g, S, E, nullptr); }
#endif
    }
    SEAM(5); PT_END(5);
    PT_BEGIN(6);
    REP(6) if (IN(6)) {
        pg8::Gemm g{(const bf16_t*)(ws + WS_MERGED), (const bf16_t*)(ws + WS_WOT), T, 1024, 1024}; pg8::StaticOrder S; S.init(T, 1024, G, bx);
        EpiResid E{a.in[I_X], (bf16_t*)(ws + WS_H1B), (float*)(ws + WS_ROWSS)};
        pg8::gemm_phase<EpiResid, pg8::StaticOrder>(lds, g, S, E, nullptr);
    }
    SEAM(6); PT_END(6);
    PT_BEGIN(7);
    REP(7) if (IN(7)) {
        PT_BEGIN(70); phase_tables(a, wave, lane); PT_END(70); PT_BEGIN(71);
        pg8::Gemm g{(const bf16_t*)(ws + WS_H1B), (const bf16_t*)(ws + WS_WST), T, 2048, 1024}; pg8::StaticOrder S; S.init(T, 2048, G, bx);
        EpiScores E{(const float*)(ws + WS_ROWSS), (_Float16*)(ws + WS_SCORES)};
        pg8::gemm_phase<EpiScores, pg8::StaticOrder>(lds, g, S, E, nullptr);
        __syncthreads();
        PT_END(71); PT_BEGIN(72);
        phase_topk(a, lds, S, wave, lane);
        PT_END(72);
    }
    SEAM(8); PT_END(7);
#ifndef U_VALU
#define U_VALU 1
#endif
    PT_BEGIN(9);
    REP(9) if (IN(9)) { if (U_VALU) phase_peer_u(a, wave, lane); else phase_peer_u_mfma(a, lds, wave, lane); }
    SEAM(9); PT_END(9);
    PT_BEGIN(10);
    if (IN(10)) phase_peer_act(a, tid);
    SEAM(10); PT_END(10);
    PT_BEGIN(11);
    if (IN(11)) phase_peer_v(a, wave, lane);
    SEAM(11); PT_END(11);
    PT_BEGIN(12);
    if (IN(12)) phase_final(a, wave, lane);
    PT_END(12);
#ifdef PROBE_TIME
    if (bx == 0 && ONE_LAUNCH) { const unsigned long long t_ = __builtin_amdgcn_s_memrealtime(); while (__builtin_amdgcn_s_memrealtime() - t_ < pt1 - pt0) __builtin_amdgcn_s_sleep(8); }
#endif
#undef IN
#undef SEAM
}

extern "C" void kernel_launch(void* const* d_in, const int* in_sizes, int n_in, void* d_out, int out_size, void* d_ws, size_t ws_size, hipStream_t stream) {
    static int grid = 0;
    if (grid == 0) {
        if (n_in != N_IN || out_size != T * DM || ws_size < WS_END) { fprintf(stderr, "kernel_launch: unexpected shapes (n_in %d out %d ws %zu)\n", n_in, out_size, ws_size); grid = -1; return; }
        if (hipFuncSetAttribute((const void*)mega, hipFuncAttributeMaxDynamicSharedMemorySize, LDS_BYTES) != hipSuccess) { fprintf(stderr, "kernel_launch: hipFuncSetAttribute failed\n"); grid = -1; return; }
        int dev = 0, cus = 0, per_cu = 0;
        hipGetDevice(&dev); hipDeviceGetAttribute(&cus, hipDeviceAttributeMultiprocessorCount, dev);
        hipOccupancyMaxActiveBlocksPerMultiprocessor(&per_cu, (const void*)mega, NTHR, LDS_BYTES);
        if (per_cu < 1) { fprintf(stderr, "kernel_launch: occupancy query says %d blocks per CU\n", per_cu); per_cu = 1; }
        (void)hipGetLastError();
        grid = cus;
    }
    if (grid < 0) return;
    Args a{};
    for (int i = 0; i < N_IN; ++i) a.in[i] = (const float*)d_in[i];
    a.out = (float*)d_out; a.ws = (unsigned char*)d_ws;
#if ONE_LAUNCH
    if (hipMemsetAsync((char*)d_ws + WS_BAR, 0, XCD_BAR_WORDS * 4, stream) != hipSuccess) { fprintf(stderr, "kernel_launch: memset of the barrier words failed\n"); return; }
    a.ph_lo = 0; a.ph_hi = NPHASE;
    void* args[] = {&a};
    hipError_t e = hipLaunchCooperativeKernel((const void*)mega, dim3(grid), dim3(NTHR), args, LDS_BYTES, stream);
    if (e != hipSuccess) fprintf(stderr, "cooperative launch failed: %s (grid %d)\n", hipGetErrorString(e), grid);
#else
    for (int ph = 0; ph < NPHASE; ++ph) for (int rep = 0; rep < 1 + ((REPMASK >> ph) & 1); ++rep) { a.ph_lo = ph; a.ph_hi = ph + 1;
        if (ph == 6 && rep == 1) (void)hipMemsetAsync((char*)d_ws + WS_ROWSS, 0, T * 4, stream);
        hipLaunchKernelGGL(mega, dim3(grid), dim3(NTHR), LDS_BYTES, stream, a);
        hipError_t e = hipPeekAtLastError(); if (e != hipSuccess) { fprintf(stderr, "launch %d failed: %s\n", ph, hipGetErrorString(e)); break; } }
#endif
}
```
